# Optimizing an MI355X kernel written in HIP

```python
import jax, jax.numpy as jnp
from jax import lax
import numpy as np

D_MODEL = 1024
BATCH = 4
SEQ = 4096
DEPTH = 2

EPS = 1e-6
GRID_W = 64
NEG = -1e30

POOL_WINDOWS = (2, 4, 8, 16)
POOL_GROUP = D_MODEL // 16
POOL_WIDTH = POOL_GROUP * len(POOL_WINDOWS)

RET_HEADS = 4
RET_DK = D_MODEL // 16
RET_DV = 2 * RET_DK
RET_QK = RET_HEADS * RET_DK
RET_V = RET_HEADS * RET_DV
RET_CHUNK = 128
ROPE_BASE = 10000.0

NA_HEADS = 4
NA_DH = D_MODEL // 16
NA_WIDTH = NA_HEADS * NA_DH
NA_ROWS_MAX = 8
NA_COLS = 16

N_BRANCH = 3
IN_SPLITS = (POOL_WIDTH, RET_QK, RET_QK, RET_V, RET_V, NA_WIDTH, NA_WIDTH, NA_WIDTH, N_BRANCH * D_MODEL)
IN_WIDTH = sum(IN_SPLITS)

PEER_KEYS = 128
PEER_EXPERTS = PEER_KEYS * PEER_KEYS
PEER_HEADS = 8
PEER_DK = 128
PEER_TOPK = 16
PEER_BLOCK = 128

kernel_name = "hybrid_pool_retention_natten_peer_encoder"


def rmsnorm(x, g):
    xf = x.astype(jnp.float32)
    y = xf * lax.rsqrt(jnp.mean(xf * xf, axis=-1, keepdims=True) + EPS)
    return (y * g.astype(jnp.float32)).astype(x.dtype)


def rms_heads(y):
    yf = y.astype(jnp.float32)
    return yf * lax.rsqrt(jnp.mean(yf * yf, axis=-1, keepdims=True) + EPS)


def rotary(x):
    S, dk = x.shape[2], x.shape[3]
    half = dk // 2
    inv = 1.0 / (ROPE_BASE ** jnp.linspace(0.0, 1.0, half, dtype=jnp.float32))
    ang = jnp.arange(S, dtype=jnp.float32)[:, None] * inv[None, :]
    cos, sin = jnp.cos(ang), jnp.sin(ang)
    x1, x2 = x[..., :half], x[..., half:]
    return jnp.concatenate([x1 * cos - x2 * sin, x1 * sin + x2 * cos], axis=-1)


def pool_mixer(xp, w_group, scale):
    B, S, _ = xp.shape
    xf = xp.astype(jnp.float32)
    cs = jnp.concatenate([jnp.zeros((B, 1, POOL_WIDTH), jnp.float32), jnp.cumsum(xf, axis=1)], axis=1)
    t = jnp.arange(S)
    outs = []
    for gi, w in enumerate(POOL_WINDOWS):
        lo, hi = w // 2, w - w // 2
        a = jnp.clip(t - lo, 0, S)
        b = jnp.clip(t + hi, 0, S)
        sl = slice(gi * POOL_GROUP, (gi + 1) * POOL_GROUP)
        csg = cs[..., sl]
        cnt = (b - a).astype(jnp.float32)[None, :, None]
        mean = (jnp.take(csg, b, axis=1) - jnp.take(csg, a, axis=1)) / cnt
        outs.append(jnp.einsum('bsc,ce->bse', mean - xf[..., sl], w_group[gi].astype(jnp.float32)))
    return (jnp.concatenate(outs, axis=-1) * scale).astype(xp.dtype)


def retention_direction(q, k, v, log_gamma, strict):
    B, H, S, dk = q.shape
    dv = v.shape[-1]
    C = RET_CHUNK
    n = S // C
    qc = q.reshape(B, H, n, C, dk)
    kc = k.reshape(B, H, n, C, dk)
    vc = v.reshape(B, H, n, C, dv)
    pos = jnp.arange(C, dtype=jnp.float32)
    lg = log_gamma.astype(jnp.float32)
    diff = pos[:, None] - pos[None, :]
    mask = (diff > 0) if strict else (diff >= 0)
    d_intra = jnp.where(mask, jnp.exp(lg[:, None, None] * jnp.where(mask, diff, 0.0)), 0.0)
    scores = jnp.einsum('bhncd,bhnmd->bhncm', qc, kc) * d_intra[None, :, None]
    intra = jnp.einsum('bhncm,bhnme->bhnce', scores, vc)
    lgv = lg[None, :, None, None, None]
    k_dec = kc * jnp.exp(lgv * (C - 1 - pos)[:, None])
    chunk_kv = jnp.einsum('bhncd,bhnce->nbhde', k_dec, vc)
    chunk_decay = jnp.exp(lg * C)[None, :, None, None]

    def step(state, kv):
        return state * chunk_decay + kv, state

    _, prev = lax.scan(step, jnp.zeros((B, H, dk, dv), jnp.float32), chunk_kv.astype(jnp.float32))
    q_dec = qc * jnp.exp(lgv * (pos + 1.0)[:, None])
    cross = jnp.einsum('bhncd,nbhde->bhnce', q_dec, prev)
    return (intra + cross).reshape(B, H, S, dv)


def retention_mixer(q, k, v, g, decay_logit):
    B, S, _ = q.shape
    heads = lambda t, d: t.reshape(B, S, RET_HEADS, d).transpose(0, 2, 1, 3)
    qh = rotary(heads(q, RET_DK))
    kh = rotary(heads(k, RET_DK)) * (RET_DK ** -0.5)
    vh = heads(v, RET_DV)
    lg = jax.nn.log_sigmoid(decay_logit.astype(jnp.float32))
    fwd = retention_direction(qh, kh, vh, lg[0], strict=False)
    bwd = retention_direction(jnp.flip(qh, 2), jnp.flip(kh, 2), jnp.flip(vh, 2), lg[1], strict=True)
    y = rms_heads(fwd + jnp.flip(bwd, 2))
    y = y.transpose(0, 2, 1, 3).reshape(B, S, RET_V)
    return (jax.nn.silu(g.astype(jnp.float32)) * y).astype(q.dtype)


def neighbourhood_attention(q, k, v, rpb):
    B, S, _ = q.shape
    rows = S // GRID_W
    kr = min(NA_ROWS_MAX, rows)
    grid = lambda t: t.reshape(B, rows, GRID_W, NA_HEADS, NA_DH).transpose(0, 3, 1, 2, 4)
    r = jnp.arange(rows)
    row_idx = jnp.clip(r - kr // 2, 0, rows - kr)[:, None] + jnp.arange(kr)[None, :]
    c = jnp.arange(GRID_W)
    col_start = jnp.clip(c - NA_COLS // 2, 0, GRID_W - NA_COLS)
    col_in = (c[None, :] >= col_start[:, None]) & (c[None, :] < col_start[:, None] + NA_COLS)
    di = row_idx - r[:, None] + (NA_ROWS_MAX - 1)
    dj = jnp.clip(c[None, :] - c[:, None], -(NA_COLS - 1), NA_COLS - 1) + (NA_COLS - 1)
    bias = rpb[:, di[:, None, :, None], dj[None, :, None, :]].astype(jnp.float32)
    bias = jnp.where(col_in[None, None, :, None, :], bias, NEG)
    qg = grid(q) * (NA_DH ** -0.5)
    kg = grid(k)[:, :, row_idx]
    vg = grid(v)[:, :, row_idx]
    s = jnp.einsum('bhrcd,bhrivd->bhrciv', qg, kg).astype(jnp.float32) + bias[None]
    p = jax.nn.softmax(s.reshape(B, NA_HEADS, rows, GRID_W, kr * GRID_W), axis=-1)
    p = p.reshape(s.shape).astype(v.dtype)
    o = jnp.einsum('bhrciv,bhrivd->bhrcd', p, vg)
    return o.transpose(0, 2, 3, 1, 4).reshape(B, S, NA_WIDTH)


def mixer_block(xn, w_in, pool_w, pool_scale, ret_decay, na_rpb, w_br_pool, w_br_ret, w_br_na, w_out):
    B, S, D = xn.shape
    proj = jnp.einsum('bsd,de->bse', xn, w_in)
    splits = [int(i) for i in np.cumsum(IN_SPLITS)[:-1]]
    p_pool, r_q, r_k, r_v, r_g, n_q, n_k, n_v, gate_logits = jnp.split(proj, splits, axis=-1)
    y_pool = pool_mixer(p_pool, pool_w, pool_scale)
    y_ret = retention_mixer(r_q, r_k, r_v, r_g, ret_decay)
    y_na = neighbourhood_attention(n_q, n_k, n_v, na_rpb)
    gates = jax.nn.sigmoid(gate_logits.astype(jnp.float32)).reshape(B, S, N_BRANCH, D).astype(xn.dtype)
    merged = (gates[:, :, 0] * jnp.einsum('bsc,cd->bsd', y_pool, w_br_pool)
              + gates[:, :, 1] * jnp.einsum('bsc,cd->bsd', y_ret, w_br_ret)
              + gates[:, :, 2] * jnp.einsum('bsc,cd->bsd', y_na, w_br_na))
    return jnp.einsum('bsd,de->bse', merged, w_out).astype(xn.dtype)


def peer_ffn(xn, w_query, sub_keys, w_u, w_v):
    B, S, D = xn.shape
    T = B * S
    xt = xn.reshape(T, D)
    q = jnp.einsum('td,de->te', xt, w_query).reshape(T, PEER_HEADS, 2, PEER_DK)
    s = jnp.einsum('thpd,pnd->thpn', q, sub_keys).astype(jnp.float32)
    s1, i1 = lax.top_k(s[:, :, 0], PEER_TOPK)
    s2, i2 = lax.top_k(s[:, :, 1], PEER_TOPK)
    cand_s = (s1[..., :, None] + s2[..., None, :]).reshape(T, PEER_HEADS, PEER_TOPK * PEER_TOPK)
    cand_i = (i1[..., :, None] * PEER_KEYS + i2[..., None, :]).reshape(T, PEER_HEADS, PEER_TOPK * PEER_TOPK)
    top_s, top_pos = lax.top_k(cand_s, PEER_TOPK)
    idx = jnp.take_along_axis(cand_i, top_pos, axis=-1).reshape(T, PEER_HEADS * PEER_TOPK)
    gate = jax.nn.softmax(top_s, axis=-1).reshape(T, PEER_HEADS * PEER_TOPK)
    nb = T // PEER_BLOCK

    def expert_block(args):
        xb, ib, gb = args
        a = jnp.einsum('td,tkd->tk', xb, w_u[ib]).astype(jnp.float32)
        h = (jax.nn.gelu(a, approximate=False) * gb).astype(xb.dtype)
        return jnp.einsum('tk,tkd->td', h, w_v[ib]).astype(xb.dtype)

    out = lax.map(expert_block, (xt.reshape(nb, PEER_BLOCK, D),
                                 idx.reshape(nb, PEER_BLOCK, -1),
                                 gate.reshape(nb, PEER_BLOCK, -1)))
    return out.reshape(B, S, D)


def setup_inputs(seed: int = 0) -> dict:
    key = jax.random.key(seed)
    ks = jax.random.split(key, 20)
    f32 = jnp.float32
    nrm = lambda k, shape, sc: jax.random.normal(k, shape, f32) * sc
    gam = 1.0 - 2.0 ** (-5.0 - np.arange(RET_HEADS, dtype=np.float64))
    logit0 = jnp.asarray(np.log(gam / (1.0 - gam)), dtype=f32)
    return {
        "x": nrm(ks[0], (BATCH, SEQ, D_MODEL), 1.0),
        "norm_mix": 1.0 + nrm(ks[1], (DEPTH, D_MODEL), 0.02),
        "w_in": nrm(ks[2], (DEPTH, D_MODEL, IN_WIDTH), D_MODEL ** -0.5),
        "pool_w": nrm(ks[3], (DEPTH, len(POOL_WINDOWS), POOL_GROUP, POOL_GROUP), POOL_GROUP ** -0.5),
        "pool_scale": 1.0 + nrm(ks[4], (DEPTH, POOL_WIDTH), 0.02),
        "ret_decay": logit0[None, None, :] + nrm(ks[5], (DEPTH, 2, RET_HEADS), 0.1),
        "na_rpb": nrm(ks[6], (DEPTH, NA_HEADS, 2 * NA_ROWS_MAX - 1, 2 * NA_COLS - 1), 0.1),
        "w_br_pool": nrm(ks[7], (DEPTH, POOL_WIDTH, D_MODEL), POOL_WIDTH ** -0.5),
        "w_br_ret": nrm(ks[8], (DEPTH, RET_V, D_MODEL), RET_V ** -0.5),
        "w_br_na": nrm(ks[9], (DEPTH, NA_WIDTH, D_MODEL), NA_WIDTH ** -0.5),
        "w_out": nrm(ks[10], (DEPTH, D_MODEL, D_MODEL), D_MODEL ** -0.5),
        "norm_ffn": 1.0 + nrm(ks[11], (DEPTH, D_MODEL), 0.02),
        "peer_w_query": nrm(ks[12], (DEPTH, D_MODEL, PEER_HEADS * 2 * PEER_DK), D_MODEL ** -0.5),
        "peer_sub_keys": nrm(ks[13], (DEPTH, 2, PEER_KEYS, PEER_DK), PEER_DK ** -0.5),
        "peer_u": nrm(ks[14], (DEPTH, PEER_EXPERTS, D_MODEL), D_MODEL ** -0.5),
        "peer_v": nrm(ks[15], (DEPTH, PEER_EXPERTS, D_MODEL), 0.25),
        "norm_final": 1.0 + nrm(ks[16], (D_MODEL,), 0.02),
    }


def reference(x, norm_mix, w_in, pool_w, pool_scale, ret_decay, na_rpb, w_br_pool, w_br_ret, w_br_na,
              w_out, norm_ffn, peer_w_query, peer_sub_keys, peer_u, peer_v, norm_final):
    for l in range(DEPTH):
        xn = rmsnorm(x, norm_mix[l])
        x = x + mixer_block(xn, w_in[l], pool_w[l], pool_scale[l], ret_decay[l], na_rpb[l],
                            w_br_pool[l], w_br_ret[l], w_br_na[l], w_out[l])
        hn = rmsnorm(x, norm_ffn[l])
        x = x + peer_ffn(hn, peer_w_query[l], peer_sub_keys[l], peer_u[l], peer_v[l])
    return rmsnorm(x, norm_final)
```

```cpp
#include <hip/hip_runtime.h>
#include <stdint.h>

#define D_MODEL 1024
#define SEQ 4096
#define BATCH 4
#define DEPTH 2
#define IN_WIDTH 5632
#define C_POOL 0
#define C_RQ 256
#define C_RK 512
#define C_RV 768
#define C_RG 1280
#define C_NQ 1792
#define C_NK 2048
#define C_NV 2304
#define C_GATE 2560
#define EPS 1e-6f

__device__ __forceinline__ float wave_sum(float v) {
#pragma unroll
  for (int o = 32; o > 0; o >>= 1) v += __shfl_xor(v, o, 64);
  return v;
}
__device__ __forceinline__ float wave_max(float v) {
#pragma unroll
  for (int o = 32; o > 0; o >>= 1) v = fmaxf(v, __shfl_xor(v, o, 64));
  return v;
}

__global__ __launch_bounds__(256) void nk_rmsnorm(const float* __restrict__ x, const float* __restrict__ g,
                                                  float* __restrict__ y, int rows) {
  int wave = (blockIdx.x * 256 + threadIdx.x) >> 6, lane = threadIdx.x & 63;
  if (wave >= rows) return;
  const float* xr = x + (size_t)wave * D_MODEL;
  float4 v[4];
  float ss = 0.f;
#pragma unroll
  for (int i = 0; i < 4; ++i) {
    v[i] = *(const float4*)(xr + i * 256 + lane * 4);
    ss += v[i].x * v[i].x + v[i].y * v[i].y + v[i].z * v[i].z + v[i].w * v[i].w;
  }
  ss = wave_sum(ss);
  float r = rsqrtf(ss * (1.0f / D_MODEL) + EPS);
  float* yr = y + (size_t)wave * D_MODEL;
#pragma unroll
  for (int i = 0; i < 4; ++i) {
    float4 gg = *(const float4*)(g + i * 256 + lane * 4);
    float4 o;
    o.x = v[i].x * r * gg.x; o.y = v[i].y * r * gg.y; o.z = v[i].z * r * gg.z; o.w = v[i].w * r * gg.w;
    *(float4*)(yr + i * 256 + lane * 4) = o;
  }
}

__global__ __launch_bounds__(256) void nk_gemm(const float* __restrict__ A, int lda, long sA,
                                               const float* __restrict__ B, int ldb, long sB, int transB,
                                               float* __restrict__ C, int ldc, long sC, int K, int accumulate) {
  __shared__ float As[16][68];
  __shared__ float Bs[16][68];
  const int bm = blockIdx.y * 64, bn = blockIdx.x * 64, z = blockIdx.z;
  A += (size_t)z * sA; B += (size_t)z * sB; C += (size_t)z * sC;
  const int tid = threadIdx.x, tx = tid & 15, ty = tid >> 4;
  float acc[4][4];
#pragma unroll
  for (int i = 0; i < 4; ++i)
#pragma unroll
    for (int j = 0; j < 4; ++j) acc[i][j] = 0.f;
  for (int k0 = 0; k0 < K; k0 += 16) {
#pragma unroll
    for (int i = 0; i < 4; ++i) {
      int idx = tid + i * 256;
      int m = idx >> 4, k = idx & 15;
      As[k][m] = A[(size_t)(bm + m) * lda + k0 + k];
      if (transB) {
        int n = idx >> 4, kk = idx & 15;
        Bs[kk][n] = B[(size_t)(bn + n) * ldb + k0 + kk];
      } else {
        int kk = idx >> 6, n = idx & 63;
        Bs[kk][n] = B[(size_t)(k0 + kk) * ldb + bn + n];
      }
    }
    __syncthreads();
#pragma unroll
    for (int k = 0; k < 16; ++k) {
      float a[4], b[4];
#pragma unroll
      for (int i = 0; i < 4; ++i) a[i] = As[k][ty * 4 + i];
#pragma unroll
      for (int j = 0; j < 4; ++j) b[j] = Bs[k][tx * 4 + j];
#pragma unroll
      for (int i = 0; i < 4; ++i)
#pragma unroll
        for (int j = 0; j < 4; ++j) acc[i][j] = fmaf(a[i], b[j], acc[i][j]);
    }
    __syncthreads();
  }
#pragma unroll
  for (int i = 0; i < 4; ++i)
#pragma unroll
    for (int j = 0; j < 4; ++j) {
      size_t o = (size_t)(bm + ty * 4 + i) * ldc + bn + tx * 4 + j;
      C[o] = accumulate ? C[o] + acc[i][j] : acc[i][j];
    }
}

__global__ __launch_bounds__(256) void nk_pool(const float* __restrict__ proj, const float* __restrict__ pw,
                                               const float* __restrict__ pscale, float* __restrict__ ypool) {
  __shared__ float diff[256];
  const int t = blockIdx.x, c = threadIdx.x;
  const int gi = c >> 6;
  const int w = 2 << gi;
  const int lo = w / 2, hi = w - w / 2;
  int a = t - lo; if (a < 0) a = 0;
  int b = t + hi; if (b > SEQ) b = SEQ;
  float s = 0.f;
  for (int tt = a; tt < b; ++tt) s += proj[(size_t)tt * IN_WIDTH + C_POOL + c];
  float mean = s / (float)(b - a);
  diff[c] = mean - proj[(size_t)t * IN_WIDTH + C_POOL + c];
  __syncthreads();
  const int e = c & 63;
  const float* wg = pw + gi * 64 * 64;
  float acc = 0.f;
  for (int cc = 0; cc < 64; ++cc) acc = fmaf(diff[gi * 64 + cc], wg[cc * 64 + e], acc);
  ypool[(size_t)t * 256 + c] = acc * pscale[c];
}

__global__ __launch_bounds__(256) void nk_rope(float* __restrict__ proj) {
  int gid = blockIdx.x * 256 + threadIdx.x;
  int i = gid & 31, h = (gid >> 5) & 3, qk = (gid >> 7) & 1, t = gid >> 8;
  if (t >= SEQ) return;
  float inv = 1.0f / powf(10000.0f, (float)i / 31.0f);
  float ang = (float)t * inv;
  double rev = (double)ang * 0.15915494309189535;
  rev -= floor(rev);
  float rf = (float)rev;
  float cs = __builtin_amdgcn_cosf(rf), sn = __builtin_amdgcn_sinf(rf);
  float* p = proj + (size_t)t * IN_WIDTH + (qk ? C_RK : C_RQ) + h * 64 + i;
  float x1 = p[0], x2 = p[32];
  p[0] = x1 * cs - x2 * sn;
  p[32] = x1 * sn + x2 * cs;
}

__global__ __launch_bounds__(256) void nk_retention(const float* __restrict__ proj, const float* __restrict__ decay,
                                                    float* __restrict__ yret) {
  __shared__ float Qs[64][65];
  __shared__ float Ks[32][65];
  __shared__ float Vs[32][128];
  __shared__ float Ps[64][33];
  const int h = blockIdx.y, q0 = blockIdx.x * 64, tid = threadIdx.x;
  float dlf = decay[h], dlb = decay[4 + h];
  float lgf = fminf(dlf, 0.f) - log1pf(expf(-fabsf(dlf)));
  float lgb = fminf(dlb, 0.f) - log1pf(expf(-fabsf(dlb)));
  for (int idx = tid; idx < 64 * 64; idx += 256) {
    int r = idx >> 6, d = idx & 63;
    Qs[r][d] = proj[(size_t)(q0 + r) * IN_WIDTH + C_RQ + h * 64 + d];
  }
  const int rg = tid >> 5, cl = tid & 31;
  float acc[8][4];
#pragma unroll
  for (int i = 0; i < 8; ++i)
#pragma unroll
    for (int j = 0; j < 4; ++j) acc[i][j] = 0.f;
  for (int k0 = 0; k0 < SEQ; k0 += 32) {
    __syncthreads();
    for (int idx = tid; idx < 32 * 64; idx += 256) {
      int r = idx >> 6, d = idx & 63;
      Ks[r][d] = proj[(size_t)(k0 + r) * IN_WIDTH + C_RK + h * 64 + d];
    }
    for (int idx = tid; idx < 32 * 128; idx += 256) {
      int r = idx >> 7, d = idx & 127;
      Vs[r][d] = proj[(size_t)(k0 + r) * IN_WIDTH + C_RV + h * 128 + d];
    }
    __syncthreads();
    float sc[8];
#pragma unroll
    for (int i = 0; i < 8; ++i) sc[i] = 0.f;
    for (int d = 0; d < 64; ++d) {
      float kv = Ks[cl][d];
#pragma unroll
      for (int i = 0; i < 8; ++i) sc[i] = fmaf(Qs[rg * 8 + i][d], kv, sc[i]);
    }
    const int j = k0 + cl;
#pragma unroll
    for (int i = 0; i < 8; ++i) {
      int qi = q0 + rg * 8 + i;
      float dd = (j <= qi) ? expf(lgf * (float)(qi - j)) : expf(lgb * (float)(j - qi));
      Ps[rg * 8 + i][cl] = sc[i] * 0.125f * dd;
    }
    __syncthreads();
    for (int jj = 0; jj < 32; ++jj) {
      float v[4];
#pragma unroll
      for (int c = 0; c < 4; ++c) v[c] = Vs[jj][cl + 32 * c];
#pragma unroll
      for (int i = 0; i < 8; ++i) {
        float p = Ps[rg * 8 + i][jj];
#pragma unroll
        for (int c = 0; c < 4; ++c) acc[i][c] = fmaf(p, v[c], acc[i][c]);
      }
    }
  }
#pragma unroll
  for (int i = 0; i < 8; ++i) {
    float ss = acc[i][0] * acc[i][0] + acc[i][1] * acc[i][1] + acc[i][2] * acc[i][2] + acc[i][3] * acc[i][3];
#pragma unroll
    for (int o = 16; o > 0; o >>= 1) ss += __shfl_xor(ss, o, 64);
    float r = rsqrtf(ss * (1.0f / 128.0f) + EPS);
    int qi = q0 + rg * 8 + i;
#pragma unroll
    for (int c = 0; c < 4; ++c) {
      int col = h * 128 + cl + 32 * c;
      float g = proj[(size_t)qi * IN_WIDTH + C_RG + col];
      float sg = g / (1.0f + expf(-g));
      yret[(size_t)qi * 512 + col] = sg * acc[i][c] * r;
    }
  }
}

__global__ __launch_bounds__(256) void nk_na(const float* __restrict__ proj, const float* __restrict__ rpb,
                                             float* __restrict__ yna) {
  int wave = (blockIdx.x * 256 + threadIdx.x) >> 6, lane = threadIdx.x & 63;
  int h = wave & 3, t = wave >> 2;
  if (t >= SEQ) return;
  int r = t >> 6, c = t & 63;
  int rs = r - 4; rs = rs < 0 ? 0 : (rs > 56 ? 56 : rs);
  int cs = c - 8; cs = cs < 0 ? 0 : (cs > 48 ? 48 : cs);
  float qv = proj[(size_t)t * IN_WIDTH + C_NQ + h * 64 + lane] * 0.125f;
  float s[2];
#pragma unroll
  for (int u = 0; u < 2; ++u) {
    int kk = lane + 64 * u;
    int ri = kk >> 4, cj = kk & 15;
    int kt = (rs + ri) * 64 + cs + cj;
    const float* kp = proj + (size_t)kt * IN_WIDTH + C_NK + h * 64;
    float a = 0.f;
    for (int d = 0; d < 64; ++d) a = fmaf(__shfl(qv, d, 64), kp[d], a);
    int di = rs + ri - r + 7;
    int dj = cs + cj - c + 15;
    s[u] = a + rpb[(h * 15 + di) * 31 + dj];
  }
  float m = wave_max(fmaxf(s[0], s[1]));
  float e0 = expf(s[0] - m), e1 = expf(s[1] - m);
  float den = wave_sum(e0 + e1);
  float p0 = e0 / den, p1 = e1 / den;
  float o = 0.f;
  for (int kk = 0; kk < 128; ++kk) {
    float p = __shfl((kk < 64) ? p0 : p1, kk & 63, 64);
    int ri = kk >> 4, cj = kk & 15;
    int kt = (rs + ri) * 64 + cs + cj;
    o = fmaf(p, proj[(size_t)kt * IN_WIDTH + C_NV + h * 64 + lane], o);
  }
  yna[(size_t)t * 256 + h * 64 + lane] = o;
}

__global__ __launch_bounds__(256) void nk_merge(const float* __restrict__ proj, const float* __restrict__ t0,
                                                const float* __restrict__ t1, const float* __restrict__ t2,
                                                float* __restrict__ merged) {
  size_t gid = (size_t)blockIdx.x * 256 + threadIdx.x;
  int t = (int)(gid >> 10), d = (int)(gid & 1023);
  const float* gp = proj + (size_t)t * IN_WIDTH + C_GATE + d;
  float g0 = 1.f / (1.f + expf(-gp[0])), g1 = 1.f / (1.f + expf(-gp[1024])), g2 = 1.f / (1.f + expf(-gp[2048]));
  merged[gid] = g0 * t0[gid] + g1 * t1[gid] + g2 * t2[gid];
}

#define TK_THREADS 128
__device__ __forceinline__ void lds_insert(float* v, int* id, float x, int xi) {
  if (x > v[15 * TK_THREADS]) {
    int j = 15;
    while (j > 0 && v[(j - 1) * TK_THREADS] < x) {
      v[j * TK_THREADS] = v[(j - 1) * TK_THREADS];
      id[j * TK_THREADS] = id[(j - 1) * TK_THREADS];
      --j;
    }
    v[j * TK_THREADS] = x;
    id[j * TK_THREADS] = xi;
  }
}
__global__ __launch_bounds__(TK_THREADS) void nk_topk(const float* __restrict__ scores, int* __restrict__ idx,
                                                      float* __restrict__ gate, int ntok) {
  __shared__ float v1[16 * TK_THREADS], v2[16 * TK_THREADS], v3[16 * TK_THREADS];
  __shared__ int i1[16 * TK_THREADS], i2[16 * TK_THREADS], i3[16 * TK_THREADS];
  int gid = blockIdx.x * TK_THREADS + threadIdx.x;
  if (gid >= ntok * 8) return;
  const int tid = threadIdx.x;
  const float* s = scores + (size_t)gid * 256;
  for (int j = 0; j < 16; ++j) {
    v1[j * TK_THREADS + tid] = -3.0e38f; v2[j * TK_THREADS + tid] = -3.0e38f; v3[j * TK_THREADS + tid] = -3.0e38f;
    i1[j * TK_THREADS + tid] = 0; i2[j * TK_THREADS + tid] = 0; i3[j * TK_THREADS + tid] = 0;
  }
  for (int n = 0; n < 128; ++n) lds_insert(v1 + tid, i1 + tid, s[n], n);
  for (int n = 0; n < 128; ++n) lds_insert(v2 + tid, i2 + tid, s[128 + n], n);
  for (int a = 0; a < 16; ++a) {
    float va = v1[a * TK_THREADS + tid];
    int ia = i1[a * TK_THREADS + tid];
    for (int b = 0; b < 16; ++b)
      lds_insert(v3 + tid, i3 + tid, va + v2[b * TK_THREADS + tid], ia * 128 + i2[b * TK_THREADS + tid]);
  }
  float m = v3[tid];
  float den = 0.f;
  for (int j = 0; j < 16; ++j) den += expf(v3[j * TK_THREADS + tid] - m);
  for (int j = 0; j < 16; ++j) {
    idx[(size_t)gid * 16 + j] = i3[j * TK_THREADS + tid];
    gate[(size_t)gid * 16 + j] = expf(v3[j * TK_THREADS + tid] - m) / den;
  }
}

__global__ __launch_bounds__(256) void nk_experts(const float* __restrict__ hn, const int* __restrict__ idx,
                                                  const float* __restrict__ gate, const float* __restrict__ wu,
                                                  const float* __restrict__ wv, float* __restrict__ x, int ntok) {
  int wave = (blockIdx.x * 256 + threadIdx.x) >> 6, lane = threadIdx.x & 63;
  if (wave >= ntok) return;
  const float* hr = hn + (size_t)wave * D_MODEL;
  float4 hv[4], acc[4];
#pragma unroll
  for (int i = 0; i < 4; ++i) {
    hv[i] = *(const float4*)(hr + i * 256 + lane * 4);
    acc[i] = make_float4(0.f, 0.f, 0.f, 0.f);
  }
  for (int k = 0; k < 128; ++k) {
    int e = idx[(size_t)wave * 128 + k];
    float g = gate[(size_t)wave * 128 + k];
    const float* ur = wu + (size_t)e * D_MODEL;
    float a = 0.f;
#pragma unroll
    for (int i = 0; i < 4; ++i) {
      float4 u = *(const float4*)(ur + i * 256 + lane * 4);
      a += hv[i].x * u.x + hv[i].y * u.y + hv[i].z * u.z + hv[i].w * u.w;
    }
    a = wave_sum(a);
    float hh = 0.5f * a * (1.0f + erff(a * 0.70710678118654752f)) * g;
    const float* vr = wv + (size_t)e * D_MODEL;
#pragma unroll
    for (int i = 0; i < 4; ++i) {
      float4 v = *(const float4*)(vr + i * 256 + lane * 4);
      acc[i].x = fmaf(hh, v.x, acc[i].x); acc[i].y = fmaf(hh, v.y, acc[i].y);
      acc[i].z = fmaf(hh, v.z, acc[i].z); acc[i].w = fmaf(hh, v.w, acc[i].w);
    }
  }
  float* xr = x + (size_t)wave * D_MODEL;
#pragma unroll
  for (int i = 0; i < 4; ++i) {
    float4 o = *(float4*)(xr + i * 256 + lane * 4);
    o.x += acc[i].x; o.y += acc[i].y; o.z += acc[i].z; o.w += acc[i].w;
    *(float4*)(xr + i * 256 + lane * 4) = o;
  }
}

static void gemm(hipStream_t st, const float* A, int lda, long sA, const float* B, int ldb, long sB, int transB,
                 float* C, int ldc, long sC, int M, int N, int K, int Z, int accumulate) {
  dim3 grid(N / 64, M / 64, Z);
  hipLaunchKernelGGL(nk_gemm, grid, dim3(256), 0, st, A, lda, sA, B, ldb, sB, transB, C, ldc, sC, K, accumulate);
}

extern "C" void kernel_launch(void* const* d_in, const int* in_sizes, int n_in, void* d_out, int out_size,
                              void* d_ws, size_t ws_size, hipStream_t stream) {
  const float* x_in = (const float*)d_in[0];
  const float* norm_mix = (const float*)d_in[1];
  const float* w_in = (const float*)d_in[2];
  const float* pool_w = (const float*)d_in[3];
  const float* pool_scale = (const float*)d_in[4];
  const float* ret_decay = (const float*)d_in[5];
  const float* na_rpb = (const float*)d_in[6];
  const float* w_br_pool = (const float*)d_in[7];
  const float* w_br_ret = (const float*)d_in[8];
  const float* w_br_na = (const float*)d_in[9];
  const float* w_out = (const float*)d_in[10];
  const float* norm_ffn = (const float*)d_in[11];
  const float* w_query = (const float*)d_in[12];
  const float* sub_keys = (const float*)d_in[13];
  const float* peer_u = (const float*)d_in[14];
  const float* peer_v = (const float*)d_in[15];
  const float* norm_final = (const float*)d_in[16];
  float* out = (float*)d_out;

  char* ws = (char*)d_ws;
  size_t off = 0;
  auto alloc = [&](size_t bytes) { char* p = ws + off; off += (bytes + 255) & ~(size_t)255; return p; };
  const size_t T = (size_t)BATCH * SEQ;
  float* xres = (float*)alloc(T * D_MODEL * 4);
  float* xn = (float*)alloc((size_t)SEQ * D_MODEL * 4);
  float* proj = (float*)alloc((size_t)SEQ * IN_WIDTH * 4);
  float* ypool = (float*)alloc((size_t)SEQ * 256 * 4);
  float* yret = (float*)alloc((size_t)SEQ * 512 * 4);
  float* yna = (float*)alloc((size_t)SEQ * 256 * 4);
  float* tmp0 = (float*)alloc((size_t)SEQ * D_MODEL * 4);
  float* tmp1 = (float*)alloc((size_t)SEQ * D_MODEL * 4);
  float* tmp2 = (float*)alloc((size_t)SEQ * D_MODEL * 4);
  float* merged = (float*)alloc((size_t)SEQ * D_MODEL * 4);
  float* pq = (float*)alloc((size_t)SEQ * 2048 * 4);
  float* psc = (float*)alloc((size_t)SEQ * 2048 * 4);
  int* pidx = (int*)alloc((size_t)SEQ * 128 * 4);
  float* pgate = (float*)alloc((size_t)SEQ * 128 * 4);

  (void)hipMemcpyAsync(xres, x_in, T * D_MODEL * 4, hipMemcpyDeviceToDevice, stream);

  for (int l = 0; l < DEPTH; ++l) {
    for (int b = 0; b < BATCH; ++b) {
      float* xb = xres + (size_t)b * SEQ * D_MODEL;
      hipLaunchKernelGGL(nk_rmsnorm, dim3(SEQ / 4), dim3(256), 0, stream, xb, norm_mix + l * D_MODEL, xn, SEQ);
      gemm(stream, xn, D_MODEL, 0, w_in + (size_t)l * D_MODEL * IN_WIDTH, IN_WIDTH, 0, 0, proj, IN_WIDTH, 0, SEQ,
           IN_WIDTH, D_MODEL, 1, 0);
      hipLaunchKernelGGL(nk_pool, dim3(SEQ), dim3(256), 0, stream, proj, pool_w + (size_t)l * 4 * 64 * 64,
                         pool_scale + l * 256, ypool);
      hipLaunchKernelGGL(nk_rope, dim3(SEQ), dim3(256), 0, stream, proj);
      hipLaunchKernelGGL(nk_retention, dim3(SEQ / 64, 4), dim3(256), 0, stream, proj, ret_decay + l * 8, yret);
      hipLaunchKernelGGL(nk_na, dim3(SEQ), dim3(256), 0, stream, proj, na_rpb + (size_t)l * 4 * 15 * 31, yna);
      gemm(stream, ypool, 256, 0, w_br_pool + (size_t)l * 256 * D_MODEL, D_MODEL, 0, 0, tmp0, D_MODEL, 0, SEQ,
           D_MODEL, 256, 1, 0);
      gemm(stream, yret, 512, 0, w_br_ret + (size_t)l * 512 * D_MODEL, D_MODEL, 0, 0, tmp1, D_MODEL, 0, SEQ,
           D_MODEL, 512, 1, 0);
      gemm(stream, yna, 256, 0, w_br_na + (size_t)l * 256 * D_MODEL, D_MODEL, 0, 0, tmp2, D_MODEL, 0, SEQ, D_MODEL,
           256, 1, 0);
      hipLaunchKernelGGL(nk_merge, dim3(SEQ * D_MODEL / 256), dim3(256), 0, stream, proj, tmp0, tmp1, tmp2, merged);
      gemm(stream, merged, D_MODEL, 0, w_out + (size_t)l * D_MODEL * D_MODEL, D_MODEL, 0, 0, xb, D_MODEL, 0, SEQ,
           D_MODEL, D_MODEL, 1, 1);
      hipLaunchKernelGGL(nk_rmsnorm, dim3(SEQ / 4), dim3(256), 0, stream, xb, norm_ffn + l * D_MODEL, xn, SEQ);
      gemm(stream, xn, D_MODEL, 0, w_query + (size_t)l * D_MODEL * 2048, 2048, 0, 0, pq, 2048, 0, SEQ, 2048,
           D_MODEL, 1, 0);
      for (int p = 0; p < 2; ++p)
        gemm(stream, pq + p * 128, 2048, 256, sub_keys + (size_t)l * 2 * 128 * 128 + (size_t)p * 128 * 128, 128, 0,
             1, psc + p * 128, 2048, 256, SEQ, 128, 128, 8, 0);
      hipLaunchKernelGGL(nk_topk, dim3(SEQ * 8 / TK_THREADS), dim3(TK_THREADS), 0, stream, psc, pidx, pgate, SEQ);
      hipLaunchKernelGGL(nk_experts, dim3(SEQ / 4), dim3(256), 0, stream, xn, pidx, pgate,
                         peer_u + (size_t)l * 16384 * D_MODEL, peer_v + (size_t)l * 16384 * D_MODEL, xb, SEQ);
    }
  }
  hipLaunchKernelGGL(nk_rmsnorm, dim3((int)(T / 4)), dim3(256), 0, stream, xres, norm_final, out, (int)T);
}
```

```cpp
#include <hip/hip_runtime.h>
#include <hip/hip_cooperative_groups.h>
#include <stdint.h>
#include <cstdio>
namespace cg = cooperative_groups;

#define D_MODEL 1024
#define SEQ 4096
#define BATCH 4
#define NTOK (BATCH * SEQ)
#define DEPTH 2
#define IN_WIDTH 5632
#define C_POOL 0
#define C_RQ 256
#define C_RK 512
#define C_RV 768
#define C_RG 1280
#define C_NQ 1792
#define C_NK 2048
#define C_NV 2304
#define C_GATE 2560
#define EPS 1e-6f
#define NTHREADS 512

typedef unsigned short bf16_t;

struct Params {
  const float* x_in; const float* norm_mix; const float* w_in; const float* pool_w; const float* pool_scale;
  const float* ret_decay; const float* na_rpb; const float* w_br_pool; const float* w_br_ret; const float* w_br_na;
  const float* w_out; const float* norm_ffn; const float* w_query; const float* sub_keys; const float* peer_u;
  const float* peer_v; const float* norm_final;
  float* out;
  float* xres;
  bf16_t* xn;
  bf16_t* proj;
  bf16_t* ycat;
  float* merged;
  float* pq;
  float* psc;
  int* pidx;
  float* pgate;
};

__device__ __forceinline__ bf16_t f2bf(float f) {
  unsigned u = __float_as_uint(f);
  u += 0x7fffu + ((u >> 16) & 1u);
  return (bf16_t)(u >> 16);
}
__device__ __forceinline__ float bf2f(bf16_t h) { return __uint_as_float(((unsigned)h) << 16); }

__device__ __forceinline__ float wave_sum(float v) {
#pragma unroll
  for (int o = 32; o > 0; o >>= 1) v += __shfl_xor(v, o, 64);
  return v;
}
__device__ __forceinline__ float wave_max(float v) {
#pragma unroll
  for (int o = 32; o > 0; o >>= 1) v = fmaxf(v, __shfl_xor(v, o, 64));
  return v;
}
__device__ __forceinline__ float sigmoidf_(float x) { return 1.0f / (1.0f + expf(-x)); }

__device__ __forceinline__ int opaque_tid() { int t = threadIdx.x; asm volatile("" : "+v"(t)); return t; }
__device__ __forceinline__ int opaque_bid() { int b = blockIdx.x; asm volatile("" : "+s"(b)); return b; }

template <bool OUT_F32>
__device__ __forceinline__ void n_rmsnorm(const float* __restrict__ x, const float* __restrict__ g, void* outp, int rows) {
  const int tidx_ = opaque_tid(); const int bidx_ = opaque_bid();
  const int lane = tidx_ & 63;
  const int nw = gridDim.x * (NTHREADS / 64);
  for (int row = bidx_ * (NTHREADS / 64) + (tidx_ >> 6); row < rows; row += nw) {
    const float* xr = x + (size_t)row * D_MODEL;
    float4 v[4];
    float ss = 0.f;
#pragma unroll
    for (int i = 0; i < 4; ++i) {
      v[i] = *(const float4*)(xr + i * 256 + lane * 4);
      ss += v[i].x * v[i].x + v[i].y * v[i].y + v[i].z * v[i].z + v[i].w * v[i].w;
    }
    ss = wave_sum(ss);
    float r = rsqrtf(ss * (1.0f / D_MODEL) + EPS);
#pragma unroll
    for (int i = 0; i < 4; ++i) {
      float4 gg = *(const float4*)(g + i * 256 + lane * 4);
      float o0 = v[i].x * r * gg.x, o1 = v[i].y * r * gg.y, o2 = v[i].z * r * gg.z, o3 = v[i].w * r * gg.w;
      if (OUT_F32) {
        *(float4*)((float*)outp + (size_t)row * D_MODEL + i * 256 + lane * 4) = make_float4(o0, o1, o2, o3);
      } else {
        ushort4 o; o.x = f2bf(o0); o.y = f2bf(o1); o.z = f2bf(o2); o.w = f2bf(o3);
        *(ushort4*)((bf16_t*)outp + (size_t)row * D_MODEL + i * 256 + lane * 4) = o;
      }
    }
  }
}

template <bool A_BF16, typename Epi>
__device__ __forceinline__ void n_gemm(const void* Av, int lda, long sA, const float* __restrict__ B, int ldb, long sB,
                                       int transB, int M, int N, int K, int Z, float* smem, Epi epi) {
  const int tidx_ = opaque_tid(); const int bidx_ = opaque_bid();
  const int grp = tidx_ >> 8, tid = tidx_ & 255;
  float(*As)[68] = (float(*)[68])(smem + grp * 2 * 16 * 68);
  float(*Bs)[68] = (float(*)[68])(smem + grp * 2 * 16 * 68 + 16 * 68);
  const int tx = tid & 15, ty = tid >> 4;
  const int tn = N / 64, tm = M / 64;
  const int nwork = tn * tm * Z;
  for (int wb = bidx_ * 2; wb < nwork; wb += gridDim.x * 2) {
    const int w = wb + grp;
    const int z = w / (tn * tm);
    const int rem = w - z * (tn * tm);
    const int bm = (rem / tn) * 64, bn = (rem % tn) * 64;
    const float* Af = (const float*)Av + (size_t)z * sA;
    const bf16_t* Ab = (const bf16_t*)Av + (size_t)z * sA;
    const float* Bz = B + (size_t)z * sB;
    float acc[4][4];
#pragma unroll
    for (int i = 0; i < 4; ++i)
#pragma unroll
      for (int j = 0; j < 4; ++j) acc[i][j] = 0.f;
    for (int k0 = 0; k0 < K; k0 += 16) {
#pragma unroll
      for (int i = 0; i < 4; ++i) {
        int idx = tid + i * 256;
        int m = idx >> 4, k = idx & 15;
        size_t ao = (size_t)(bm + m) * lda + k0 + k;
        As[k][m] = A_BF16 ? bf2f(Ab[ao]) : Af[ao];
        if (transB) {
          int n = idx >> 4, kk = idx & 15;
          Bs[kk][n] = Bz[(size_t)(bn + n) * ldb + k0 + kk];
        } else {
          int kk = idx >> 6, n = idx & 63;
          Bs[kk][n] = Bz[(size_t)(k0 + kk) * ldb + bn + n];
        }
      }
      __syncthreads();
#pragma unroll
      for (int k = 0; k < 16; ++k) {
        float a[4], b[4];
#pragma unroll
        for (int i = 0; i < 4; ++i) a[i] = As[k][ty * 4 + i];
#pragma unroll
        for (int j = 0; j < 4; ++j) b[j] = Bs[k][tx * 4 + j];
#pragma unroll
        for (int i = 0; i < 4; ++i)
#pragma unroll
          for (int j = 0; j < 4; ++j) acc[i][j] = fmaf(a[i], b[j], acc[i][j]);
      }
      __syncthreads();
    }
#pragma unroll
    for (int i = 0; i < 4; ++i)
#pragma unroll
      for (int j = 0; j < 4; ++j) epi(z, bm + ty * 4 + i, bn + tx * 4 + j, acc[i][j]);
  }
}

__device__ __forceinline__ void n_rope(bf16_t* __restrict__ proj) {
  const int tidx_ = opaque_tid(); const int bidx_ = opaque_bid();
  const int total = NTOK * 256;
  for (int gid = bidx_ * NTHREADS + tidx_; gid < total; gid += gridDim.x * NTHREADS) {
    int i = gid & 31, h = (gid >> 5) & 3, qk = (gid >> 7) & 1, t = gid >> 8;
    int pos = t & (SEQ - 1);
    float inv = 1.0f / powf(10000.0f, (float)i / 31.0f);
    float ang = (float)pos * inv;
    double rev = (double)ang * 0.15915494309189535;
    rev -= floor(rev);
    float rf = (float)rev;
    float cs = __builtin_amdgcn_cosf(rf), sn = __builtin_amdgcn_sinf(rf);
    bf16_t* p = proj + (size_t)t * IN_WIDTH + (qk ? C_RK : C_RQ) + h * 64 + i;
    float x1 = bf2f(p[0]), x2 = bf2f(p[32]);
    p[0] = f2bf(x1 * cs - x2 * sn);
    p[32] = f2bf(x1 * sn + x2 * cs);
  }
}

__device__ __forceinline__ void n_pool(const bf16_t* __restrict__ proj, const float* __restrict__ pw,
                                       const float* __restrict__ pscale, bf16_t* __restrict__ ycat, float* smem) {
  const int tidx_ = opaque_tid(); const int bidx_ = opaque_bid();
  const int grp = tidx_ >> 8, c = tidx_ & 255;
  float* diff = smem + grp * 256;
  const int gi = c >> 6;
  const int w = 2 << gi;
  const int lo = w / 2, hi = w - w / 2;
  for (int wb = bidx_ * 2; wb < NTOK; wb += gridDim.x * 2) {
    const int t = wb + grp;
    const int b0 = t & ~(SEQ - 1), pos = t & (SEQ - 1);
    int a = pos - lo; if (a < 0) a = 0;
    int b = pos + hi; if (b > SEQ) b = SEQ;
    float s = 0.f;
    for (int tt = a; tt < b; ++tt) s += bf2f(proj[(size_t)(b0 + tt) * IN_WIDTH + C_POOL + c]);
    float mean = s / (float)(b - a);
    __syncthreads();
    diff[c] = mean - bf2f(proj[(size_t)t * IN_WIDTH + C_POOL + c]);
    __syncthreads();
    const int e = c & 63;
    const float* wg = pw + gi * 64 * 64;
    float acc = 0.f;
    for (int cc = 0; cc < 64; ++cc) acc = fmaf(diff[gi * 64 + cc], wg[cc * 64 + e], acc);
    ycat[(size_t)t * 1024 + c] = f2bf(acc * pscale[c]);
  }
}

__device__ __forceinline__ void n_retention(const bf16_t* __restrict__ proj, const float* __restrict__ decay,
                                            bf16_t* __restrict__ ycat, float* smem) {
  const int tidx_ = opaque_tid(); const int bidx_ = opaque_bid();
  const int grp = tidx_ >> 8, tid = tidx_ & 255;
  float* base = smem + grp * 12544;
  float(*Qs)[65] = (float(*)[65])base;
  float(*Ks)[65] = (float(*)[65])(base + 64 * 65);
  float(*Vs)[128] = (float(*)[128])(base + 64 * 65 + 32 * 65);
  float(*Ps)[33] = (float(*)[33])(base + 64 * 65 + 32 * 65 + 32 * 128);
  const int rg = tid >> 5, cl = tid & 31;
  const int nwork = (NTOK / 64) * 4;
  for (int wb = bidx_ * 2; wb < nwork; wb += gridDim.x * 2) {
    const int w = wb + grp;
    const int h = w & 3, qt = w >> 2;
    const int t0 = qt * 64;
    const int b0 = t0 & ~(SEQ - 1);
    const int q0 = t0 & (SEQ - 1);
    float dlf = decay[h], dlb = decay[4 + h];
    float lgf = fminf(dlf, 0.f) - log1pf(expf(-fabsf(dlf)));
    float lgb = fminf(dlb, 0.f) - log1pf(expf(-fabsf(dlb)));
    __syncthreads();
    for (int idx = tid; idx < 64 * 64; idx += 256) {
      int r = idx >> 6, d = idx & 63;
      Qs[r][d] = bf2f(proj[(size_t)(t0 + r) * IN_WIDTH + C_RQ + h * 64 + d]);
    }
    float acc[8][4];
#pragma unroll
    for (int i = 0; i < 8; ++i)
#pragma unroll
      for (int j = 0; j < 4; ++j) acc[i][j] = 0.f;
    for (int k0 = 0; k0 < SEQ; k0 += 32) {
      __syncthreads();
      for (int idx = tid; idx < 32 * 64; idx += 256) {
        int r = idx >> 6, d = idx & 63;
        Ks[r][d] = bf2f(proj[(size_t)(b0 + k0 + r) * IN_WIDTH + C_RK + h * 64 + d]);
      }
      for (int idx = tid; idx < 32 * 128; idx += 256) {
        int r = idx >> 7, d = idx & 127;
        Vs[r][d] = bf2f(proj[(size_t)(b0 + k0 + r) * IN_WIDTH + C_RV + h * 128 + d]);
      }
      __syncthreads();
      float sc[8];
#pragma unroll
      for (int i = 0; i < 8; ++i) sc[i] = 0.f;
      for (int d = 0; d < 64; ++d) {
        float kv = Ks[cl][d];
#pragma unroll
        for (int i = 0; i < 8; ++i) sc[i] = fmaf(Qs[rg * 8 + i][d], kv, sc[i]);
      }
      const int j = k0 + cl;
#pragma unroll
      for (int i = 0; i < 8; ++i) {
        int qi = q0 + rg * 8 + i;
        float dd = (j <= qi) ? expf(lgf * (float)(qi - j)) : expf(lgb * (float)(j - qi));
        Ps[rg * 8 + i][cl] = sc[i] * dd;
      }
      __syncthreads();
      for (int jj = 0; jj < 32; ++jj) {
        float v[4];
#pragma unroll
        for (int c = 0; c < 4; ++c) v[c] = Vs[jj][cl + 32 * c];
#pragma unroll
        for (int i = 0; i < 8; ++i) {
          float p = Ps[rg * 8 + i][jj];
#pragma unroll
          for (int c = 0; c < 4; ++c) acc[i][c] = fmaf(p, v[c], acc[i][c]);
        }
      }
    }
#pragma unroll
    for (int i = 0; i < 8; ++i) {
      float ss = acc[i][0] * acc[i][0] + acc[i][1] * acc[i][1] + acc[i][2] * acc[i][2] + acc[i][3] * acc[i][3];
#pragma unroll
      for (int o = 16; o > 0; o >>= 1) ss += __shfl_xor(ss, o, 64);
      float r = rsqrtf(ss * (1.0f / 128.0f) + EPS);
      int t = t0 + rg * 8 + i;
#pragma unroll
      for (int c = 0; c < 4; ++c) {
        int col = h * 128 + cl + 32 * c;
        float g = bf2f(proj[(size_t)t * IN_WIDTH + C_RG + col]);
        float sg = g / (1.0f + expf(-g));
        ycat[(size_t)t * 1024 + 256 + col] = f2bf(sg * acc[i][c] * r);
      }
    }
  }
}

__device__ __forceinline__ void n_na(const bf16_t* __restrict__ proj, const float* __restrict__ rpb,
                                     bf16_t* __restrict__ ycat) {
  const int tidx_ = opaque_tid(); const int bidx_ = opaque_bid();
  const int lane = tidx_ & 63;
  const int nw = gridDim.x * (NTHREADS / 64);
  for (int wv = bidx_ * (NTHREADS / 64) + (tidx_ >> 6); wv < NTOK * 4; wv += nw) {
    int h = wv & 3, t = wv >> 2;
    int b0 = t & ~(SEQ - 1), pos = t & (SEQ - 1);
    int r = pos >> 6, c = pos & 63;
    int rs = r - 4; rs = rs < 0 ? 0 : (rs > 56 ? 56 : rs);
    int cs = c - 8; cs = cs < 0 ? 0 : (cs > 48 ? 48 : cs);
    float qv = bf2f(proj[(size_t)t * IN_WIDTH + C_NQ + h * 64 + lane]);
    float s[2];
#pragma unroll
    for (int u = 0; u < 2; ++u) {
      int kk = lane + 64 * u;
      int ri = kk >> 4, cj = kk & 15;
      int kt = b0 + (rs + ri) * 64 + cs + cj;
      const bf16_t* kp = proj + (size_t)kt * IN_WIDTH + C_NK + h * 64;
      float a = 0.f;
      for (int d = 0; d < 64; ++d) a = fmaf(__shfl(qv, d, 64), bf2f(kp[d]), a);
      int di = rs + ri - r + 7;
      int dj = cs + cj - c + 15;
      s[u] = a + rpb[(h * 15 + di) * 31 + dj];
    }
    float m = wave_max(fmaxf(s[0], s[1]));
    float e0 = expf(s[0] - m), e1 = expf(s[1] - m);
    float den = wave_sum(e0 + e1);
    float p0 = e0 / den, p1 = e1 / den;
    float o = 0.f;
    for (int kk = 0; kk < 128; ++kk) {
      float p = __shfl((kk < 64) ? p0 : p1, kk & 63, 64);
      int ri = kk >> 4, cj = kk & 15;
      int kt = b0 + (rs + ri) * 64 + cs + cj;
      o = fmaf(p, bf2f(proj[(size_t)kt * IN_WIDTH + C_NV + h * 64 + lane]), o);
    }
    ycat[(size_t)t * 1024 + 768 + h * 64 + lane] = f2bf(o);
  }
}

#define TKS 256
__device__ __forceinline__ void lds_insert(float* v, int* id, float x, int xi) {
  if (x > v[15 * TKS]) {
    int j = 15;
    while (j > 0 && v[(j - 1) * TKS] < x) {
      v[j * TKS] = v[(j - 1) * TKS];
      id[j * TKS] = id[(j - 1) * TKS];
      --j;
    }
    v[j * TKS] = x;
    id[j * TKS] = xi;
  }
}
__device__ __forceinline__ void n_topk(const float* __restrict__ scores, int* __restrict__ idx,
                                       float* __restrict__ gate, float* smem) {
  const int tidx_ = opaque_tid(); const int bidx_ = opaque_bid();
  const int tid = tidx_;
  if (tid >= TKS) return;
  float* v1 = smem + tid;
  float* v2 = smem + 16 * TKS + tid;
  float* v3 = smem + 32 * TKS + tid;
  int* i1 = (int*)(smem + 48 * TKS) + tid;
  int* i2 = (int*)(smem + 64 * TKS) + tid;
  int* i3 = (int*)(smem + 80 * TKS) + tid;
  for (int gid = bidx_ * TKS + tid; gid < SEQ * 8; gid += gridDim.x * TKS) {
    const float* s = scores + (size_t)gid * 256;
    for (int j = 0; j < 16; ++j) {
      v1[j * TKS] = -3.0e38f; v2[j * TKS] = -3.0e38f; v3[j * TKS] = -3.0e38f;
      i1[j * TKS] = 0; i2[j * TKS] = 0; i3[j * TKS] = 0;
    }
    for (int n = 0; n < 128; ++n) lds_insert(v1, i1, s[n], n);
    for (int n = 0; n < 128; ++n) lds_insert(v2, i2, s[128 + n], n);
    for (int a = 0; a < 16; ++a) {
      float va = v1[a * TKS];
      int ia = i1[a * TKS];
      for (int b = 0; b < 16; ++b) lds_insert(v3, i3, va + v2[b * TKS], ia * 128 + i2[b * TKS]);
    }
    float m = v3[0];
    float den = 0.f;
    for (int j = 0; j < 16; ++j) den += expf(v3[j * TKS] - m);
    for (int j = 0; j < 16; ++j) {
      idx[(size_t)gid * 16 + j] = i3[j * TKS];
      gate[(size_t)gid * 16 + j] = expf(v3[j * TKS] - m) / den;
    }
  }
}

__device__ __forceinline__ void n_experts(const bf16_t* __restrict__ hn, const int* __restrict__ idx,
                                          const float* __restrict__ gate, const float* __restrict__ wu,
                                          const float* __restrict__ wv, float* __restrict__ x, int ntok) {
  const int tidx_ = opaque_tid(); const int bidx_ = opaque_bid();
  const int lane = tidx_ & 63;
  const int nw = gridDim.x * (NTHREADS / 64);
  for (int t = bidx_ * (NTHREADS / 64) + (tidx_ >> 6); t < ntok; t += nw) {
    const bf16_t* hr = hn + (size_t)t * D_MODEL;
    float4 hv[4], acc[4];
#pragma unroll
    for (int i = 0; i < 4; ++i) {
      ushort4 hb = *(const ushort4*)(hr + i * 256 + lane * 4);
      hv[i] = make_float4(bf2f(hb.x), bf2f(hb.y), bf2f(hb.z), bf2f(hb.w));
      acc[i] = make_float4(0.f, 0.f, 0.f, 0.f);
    }
    for (int k = 0; k < 128; ++k) {
      int e = idx[(size_t)t * 128 + k];
      float g = gate[(size_t)t * 128 + k];
      const float* ur = wu + (size_t)e * D_MODEL;
      float a = 0.f;
#pragma unroll
      for (int i = 0; i < 4; ++i) {
        float4 u = *(const float4*)(ur + i * 256 + lane * 4);
        a += hv[i].x * u.x + hv[i].y * u.y + hv[i].z * u.z + hv[i].w * u.w;
      }
      a = wave_sum(a);
      float hh = 0.5f * a * (1.0f + erff(a * 0.70710678118654752f)) * g;
      const float* vr = wv + (size_t)e * D_MODEL;
#pragma unroll
      for (int i = 0; i < 4; ++i) {
        float4 v = *(const float4*)(vr + i * 256 + lane * 4);
        acc[i].x = fmaf(hh, v.x, acc[i].x); acc[i].y = fmaf(hh, v.y, acc[i].y);
        acc[i].z = fmaf(hh, v.z, acc[i].z); acc[i].w = fmaf(hh, v.w, acc[i].w);
      }
    }
    float* xr = x + (size_t)t * D_MODEL;
#pragma unroll
    for (int i = 0; i < 4; ++i) {
      float4 o = *(float4*)(xr + i * 256 + lane * 4);
      o.x += acc[i].x; o.y += acc[i].y; o.z += acc[i].z; o.w += acc[i].w;
      *(float4*)(xr + i * 256 + lane * 4) = o;
    }
  }
}


__global__ void __launch_bounds__(NTHREADS) fwd_megakernel(Params p) {
  cg::grid_group grid = cg::this_grid();
  extern __shared__ __attribute__((aligned(16))) float smem[];

#pragma unroll 1
  for (int l = 0; l < DEPTH; ++l) {
    const float* xcur = (l == 0) ? p.x_in : p.xres;
    n_rmsnorm<false>(xcur, p.norm_mix + l * D_MODEL, p.xn, NTOK);
    grid.sync();
    {
      bf16_t* proj = p.proj;
      n_gemm<true>(p.xn, D_MODEL, 0, p.w_in + (size_t)l * D_MODEL * IN_WIDTH, IN_WIDTH, 0, 0, NTOK, IN_WIDTH, D_MODEL, 1,
                   smem, [=](int z, int m, int n, float v) {
                     float o = v;
                     if (n >= C_GATE) o = sigmoidf_(v);
                     else if ((n >= C_RK && n < C_RV) || (n >= C_NQ && n < C_NK)) o = v * 0.125f;
                     proj[(size_t)m * IN_WIDTH + n] = f2bf(o);
                   });
    }
    grid.sync();
    n_rope(p.proj);
    grid.sync();
    n_pool(p.proj, p.pool_w + (size_t)l * 4 * 64 * 64, p.pool_scale + l * 256, p.ycat, smem);
    n_retention(p.proj, p.ret_decay + l * 8, p.ycat, smem);
    n_na(p.proj, p.na_rpb + (size_t)l * 4 * 15 * 31, p.ycat);
    grid.sync();
    {
      float* merged = p.merged;
      const bf16_t* proj = p.proj;
      n_gemm<true>(p.ycat, 1024, 0, p.w_br_pool + (size_t)l * 256 * D_MODEL, D_MODEL, 0, 0, NTOK, D_MODEL, 256, 1, smem,
                   [=](int z, int m, int n, float v) {
                     merged[(size_t)m * 1024 + n] = bf2f(proj[(size_t)m * IN_WIDTH + C_GATE + n]) * v;
                   });
      n_gemm<true>(p.ycat + 256, 1024, 0, p.w_br_ret + (size_t)l * 512 * D_MODEL, D_MODEL, 0, 0, NTOK, D_MODEL, 512, 1,
                   smem, [=](int z, int m, int n, float v) {
                     merged[(size_t)m * 1024 + n] += bf2f(proj[(size_t)m * IN_WIDTH + C_GATE + 1024 + n]) * v;
                   });
      n_gemm<true>(p.ycat + 768, 1024, 0, p.w_br_na + (size_t)l * 256 * D_MODEL, D_MODEL, 0, 0, NTOK, D_MODEL, 256, 1,
                   smem, [=](int z, int m, int n, float v) {
                     merged[(size_t)m * 1024 + n] += bf2f(proj[(size_t)m * IN_WIDTH + C_GATE + 2048 + n]) * v;
                   });
    }
    grid.sync();
    {
      float* xres = p.xres;
      n_gemm<false>(p.merged, D_MODEL, 0, p.w_out + (size_t)l * D_MODEL * D_MODEL, D_MODEL, 0, 0, NTOK, D_MODEL, D_MODEL, 1,
                    smem, [=](int z, int m, int n, float v) {
                      size_t o = (size_t)m * 1024 + n;
                      xres[o] = xcur[o] + v;
                    });
    }
    grid.sync();
    n_rmsnorm<false>(p.xres, p.norm_ffn + l * D_MODEL, p.xn, NTOK);
    grid.sync();
#pragma unroll 1
    for (int b = 0; b < BATCH; ++b) {
      const bf16_t* hn = p.xn + (size_t)b * SEQ * D_MODEL;
      {
        float* pq = p.pq;
        n_gemm<true>(hn, D_MODEL, 0, p.w_query + (size_t)l * D_MODEL * 2048, 2048, 0, 0, SEQ, 2048, D_MODEL, 1, smem,
                     [=](int z, int m, int n, float v) { pq[(size_t)m * 2048 + n] = v; });
      }
      grid.sync();
      for (int pp = 0; pp < 2; ++pp) {
        float* psc = p.psc + pp * 128;
        n_gemm<false>(p.pq + pp * 128, 2048, 256, p.sub_keys + (size_t)l * 2 * 128 * 128 + (size_t)pp * 128 * 128, 128, 0,
                      1, SEQ, 128, 128, 8, smem,
                      [=](int z, int m, int n, float v) { psc[(size_t)m * 2048 + z * 256 + n] = v; });
      }
      grid.sync();
      n_topk(p.psc, p.pidx + (size_t)b * SEQ * 128, p.pgate + (size_t)b * SEQ * 128, smem);
      grid.sync();
      n_experts(hn, p.pidx + (size_t)b * SEQ * 128, p.pgate + (size_t)b * SEQ * 128,
                p.peer_u + (size_t)l * 16384 * D_MODEL, p.peer_v + (size_t)l * 16384 * D_MODEL,
                p.xres + (size_t)b * SEQ * D_MODEL, SEQ);
      grid.sync();
    }
  }
  n_rmsnorm<true>(p.xres, p.norm_final, p.out, NTOK);
}

extern "C" void kernel_launch(void* const* d_in, const int* in_sizes, int n_in, void* d_out, int out_size,
                              void* d_ws, size_t ws_size, hipStream_t stream) {
  Params p{};
  p.x_in = (const float*)d_in[0]; p.norm_mix = (const float*)d_in[1]; p.w_in = (const float*)d_in[2];
  p.pool_w = (const float*)d_in[3]; p.pool_scale = (const float*)d_in[4]; p.ret_decay = (const float*)d_in[5];
  p.na_rpb = (const float*)d_in[6]; p.w_br_pool = (const float*)d_in[7]; p.w_br_ret = (const float*)d_in[8];
  p.w_br_na = (const float*)d_in[9]; p.w_out = (const float*)d_in[10]; p.norm_ffn = (const float*)d_in[11];
  p.w_query = (const float*)d_in[12]; p.sub_keys = (const float*)d_in[13]; p.peer_u = (const float*)d_in[14];
  p.peer_v = (const float*)d_in[15]; p.norm_final = (const float*)d_in[16];
  p.out = (float*)d_out;
  char* ws = (char*)d_ws;
  size_t off = 0;
  auto alloc = [&](size_t bytes) { char* q = ws + off; off += (bytes + 255) & ~(size_t)255; return q; };
  p.xres = (float*)alloc((size_t)NTOK * D_MODEL * 4);
  p.xn = (bf16_t*)alloc((size_t)NTOK * D_MODEL * 2);
  p.proj = (bf16_t*)alloc((size_t)NTOK * IN_WIDTH * 2);
  p.ycat = (bf16_t*)alloc((size_t)NTOK * 1024 * 2);
  p.merged = (float*)alloc((size_t)NTOK * 1024 * 4);
  p.pq = (float*)alloc((size_t)SEQ * 2048 * 4);
  p.psc = (float*)alloc((size_t)SEQ * 2048 * 4);
  p.pidx = (int*)alloc((size_t)NTOK * 128 * 4);
  p.pgate = (float*)alloc((size_t)NTOK * 128 * 4);

  const size_t kDynLds = 160 * 1024;
  static int grid_blocks = 0;
  if (!grid_blocks) {
    int dev = 0, cus = 0, per_cu = 0;
    (void)hipGetDevice(&dev);
    (void)hipDeviceGetAttribute(&cus, hipDeviceAttributeMultiprocessorCount, dev);
    (void)hipFuncSetAttribute((const void*)fwd_megakernel, hipFuncAttributeMaxDynamicSharedMemorySize, (int)kDynLds);
    (void)hipOccupancyMaxActiveBlocksPerMultiprocessor(&per_cu, fwd_megakernel, NTHREADS, kDynLds);
    if (per_cu < 1) per_cu = 1;
    grid_blocks = cus * per_cu;
  }
  void* args[] = {&p};
  hipError_t e = hipLaunchCooperativeKernel((void*)fwd_megakernel, dim3(grid_blocks), dim3(NTHREADS), args, kDynLds, stream);
  if (e != hipSuccess) fprintf(stderr, "cooperative launch failed: %s (grid %d)\n", hipGetErrorString(e), grid_blocks);
}
```

```cpp
#include <hip/hip_runtime.h>
#include <hip/hip_cooperative_groups.h>
#include <stdint.h>
#include <cstdio>
namespace cg = cooperative_groups;

#define D_MODEL 1024
#define SEQ 4096
#define BATCH 4
#define NTOK (BATCH * SEQ)
#define DEPTH 2
#define IN_WIDTH 5632
#define C_POOL 0
#define C_RQ 256
#define C_RK 512
#define C_RV 768
#define C_RG 1280
#define C_NQ 1792
#define C_NK 2048
#define C_NV 2304
#define C_GATE 2560
#define EPS 1e-6f
#define NTHREADS 512

typedef unsigned short bf16_t;

struct Params {
  const float* x_in; const float* norm_mix; const float* w_in; const float* pool_w; const float* pool_scale;
  const float* ret_decay; const float* na_rpb; const float* w_br_pool; const float* w_br_ret; const float* w_br_na;
  const float* w_out; const float* norm_ffn; const float* w_query; const float* sub_keys; const float* peer_u;
  const float* peer_v; const float* norm_final;
  float* out;
  float* xres;
  bf16_t* xn;
  bf16_t* proj;
  bf16_t* ycat;
  float* merged;
  float* pq;
  float* psc;
  int* pidx;
  float* pgate;
  bf16_t* wf_in;
  bf16_t* wf_br;
  bf16_t* wf_out;
  bf16_t* wf_q;
  bf16_t* kf;
  bf16_t* u16;
  bf16_t* v16;
  float2* rope;
  bf16_t* mrg;
};

__device__ __forceinline__ bf16_t f2bf(float f) {
  unsigned u = __float_as_uint(f);
  u += 0x7fffu + ((u >> 16) & 1u);
  return (bf16_t)(u >> 16);
}
__device__ __forceinline__ float bf2f(bf16_t h) { return __uint_as_float(((unsigned)h) << 16); }

__device__ __forceinline__ float wave_sum(float v) {
#pragma unroll
  for (int o = 32; o > 0; o >>= 1) v += __shfl_xor(v, o, 64);
  return v;
}
__device__ __forceinline__ float wave_max(float v) {
#pragma unroll
  for (int o = 32; o > 0; o >>= 1) v = fmaxf(v, __shfl_xor(v, o, 64));
  return v;
}
__device__ __forceinline__ float sigmoidf_(float x) { return 1.0f / (1.0f + expf(-x)); }

__device__ __forceinline__ int opaque_tid() { int t = threadIdx.x; asm volatile("" : "+v"(t)); return t; }
__device__ __forceinline__ int opaque_bid() { int b = blockIdx.x; asm volatile("" : "+s"(b)); return b; }

template <bool OUT_F32>
__device__ __forceinline__ void n_rmsnorm(const float* __restrict__ x, const float* __restrict__ g, void* outp, int rows) {
  const int tidx_ = opaque_tid(); const int bidx_ = opaque_bid();
  const int lane = tidx_ & 63;
  const int nw = gridDim.x * (NTHREADS / 64);
  for (int row = bidx_ * (NTHREADS / 64) + (tidx_ >> 6); row < rows; row += nw) {
    const float* xr = x + (size_t)row * D_MODEL;
    float4 v[4];
    float ss = 0.f;
#pragma unroll
    for (int i = 0; i < 4; ++i) {
      v[i] = *(const float4*)(xr + i * 256 + lane * 4);
      ss += v[i].x * v[i].x + v[i].y * v[i].y + v[i].z * v[i].z + v[i].w * v[i].w;
    }
    ss = wave_sum(ss);
    float r = rsqrtf(ss * (1.0f / D_MODEL) + EPS);
#pragma unroll
    for (int i = 0; i < 4; ++i) {
      float4 gg = *(const float4*)(g + i * 256 + lane * 4);
      float o0 = v[i].x * r * gg.x, o1 = v[i].y * r * gg.y, o2 = v[i].z * r * gg.z, o3 = v[i].w * r * gg.w;
      if (OUT_F32) {
        *(float4*)((float*)outp + (size_t)row * D_MODEL + i * 256 + lane * 4) = make_float4(o0, o1, o2, o3);
      } else {
        ushort4 o; o.x = f2bf(o0); o.y = f2bf(o1); o.z = f2bf(o2); o.w = f2bf(o3);
        *(ushort4*)((bf16_t*)outp + (size_t)row * D_MODEL + i * 256 + lane * 4) = o;
      }
    }
  }
}

template <bool A_BF16, typename Epi>
__device__ __forceinline__ void n_gemm(const void* Av, int lda, long sA, const float* __restrict__ B, int ldb, long sB,
                                       int transB, int M, int N, int K, int Z, float* smem, Epi epi) {
  const int tidx_ = opaque_tid(); const int bidx_ = opaque_bid();
  const int grp = tidx_ >> 8, tid = tidx_ & 255;
  float(*As)[68] = (float(*)[68])(smem + grp * 2 * 16 * 68);
  float(*Bs)[68] = (float(*)[68])(smem + grp * 2 * 16 * 68 + 16 * 68);
  const int tx = tid & 15, ty = tid >> 4;
  const int tn = N / 64, tm = M / 64;
  const int nwork = tn * tm * Z;
  for (int wb = bidx_ * 2; wb < nwork; wb += gridDim.x * 2) {
    const int w = wb + grp;
    const int z = w / (tn * tm);
    const int rem = w - z * (tn * tm);
    const int bm = (rem / tn) * 64, bn = (rem % tn) * 64;
    const float* Af = (const float*)Av + (size_t)z * sA;
    const bf16_t* Ab = (const bf16_t*)Av + (size_t)z * sA;
    const float* Bz = B + (size_t)z * sB;
    float acc[4][4];
#pragma unroll
    for (int i = 0; i < 4; ++i)
#pragma unroll
      for (int j = 0; j < 4; ++j) acc[i][j] = 0.f;
    for (int k0 = 0; k0 < K; k0 += 16) {
#pragma unroll
      for (int i = 0; i < 4; ++i) {
        int idx = tid + i * 256;
        int m = idx >> 4, k = idx & 15;
        size_t ao = (size_t)(bm + m) * lda + k0 + k;
        As[k][m] = A_BF16 ? bf2f(Ab[ao]) : Af[ao];
        if (transB) {
          int n = idx >> 4, kk = idx & 15;
          Bs[kk][n] = Bz[(size_t)(bn + n) * ldb + k0 + kk];
        } else {
          int kk = idx >> 6, n = idx & 63;
          Bs[kk][n] = Bz[(size_t)(k0 + kk) * ldb + bn + n];
        }
      }
      __syncthreads();
#pragma unroll
      for (int k = 0; k < 16; ++k) {
        float a[4], b[4];
#pragma unroll
        for (int i = 0; i < 4; ++i) a[i] = As[k][ty * 4 + i];
#pragma unroll
        for (int j = 0; j < 4; ++j) b[j] = Bs[k][tx * 4 + j];
#pragma unroll
        for (int i = 0; i < 4; ++i)
#pragma unroll
          for (int j = 0; j < 4; ++j) acc[i][j] = fmaf(a[i], b[j], acc[i][j]);
      }
      __syncthreads();
    }
#pragma unroll
    for (int i = 0; i < 4; ++i)
#pragma unroll
      for (int j = 0; j < 4; ++j) epi(z, bm + ty * 4 + i, bn + tx * 4 + j, acc[i][j]);
  }
}

__device__ __forceinline__ void n_rope(bf16_t* __restrict__ proj) {
  const int tidx_ = opaque_tid(); const int bidx_ = opaque_bid();
  const int total = NTOK * 256;
  for (int gid = bidx_ * NTHREADS + tidx_; gid < total; gid += gridDim.x * NTHREADS) {
    int i = gid & 31, h = (gid >> 5) & 3, qk = (gid >> 7) & 1, t = gid >> 8;
    int pos = t & (SEQ - 1);
    float inv = 1.0f / powf(10000.0f, (float)i / 31.0f);
    float ang = (float)pos * inv;
    double rev = (double)ang * 0.15915494309189535;
    rev -= floor(rev);
    float rf = (float)rev;
    float cs = __builtin_amdgcn_cosf(rf), sn = __builtin_amdgcn_sinf(rf);
    bf16_t* p = proj + (size_t)t * IN_WIDTH + (qk ? C_RK : C_RQ) + h * 64 + i;
    float x1 = bf2f(p[0]), x2 = bf2f(p[32]);
    p[0] = f2bf(x1 * cs - x2 * sn);
    p[32] = f2bf(x1 * sn + x2 * cs);
  }
}

__device__ __forceinline__ void n_pool(const bf16_t* __restrict__ proj, const float* __restrict__ pw,
                                       const float* __restrict__ pscale, bf16_t* __restrict__ ycat, float* smem) {
  const int tidx_ = opaque_tid(); const int bidx_ = opaque_bid();
  const int grp = tidx_ >> 8, c = tidx_ & 255;
  float* diff = smem + grp * 256;
  const int gi = c >> 6;
  const int w = 2 << gi;
  const int lo = w / 2, hi = w - w / 2;
  for (int wb = bidx_ * 2; wb < NTOK; wb += gridDim.x * 2) {
    const int t = wb + grp;
    const int b0 = t & ~(SEQ - 1), pos = t & (SEQ - 1);
    int a = pos - lo; if (a < 0) a = 0;
    int b = pos + hi; if (b > SEQ) b = SEQ;
    float s = 0.f;
    for (int tt = a; tt < b; ++tt) s += bf2f(proj[(size_t)(b0 + tt) * IN_WIDTH + C_POOL + c]);
    float mean = s / (float)(b - a);
    __syncthreads();
    diff[c] = mean - bf2f(proj[(size_t)t * IN_WIDTH + C_POOL + c]);
    __syncthreads();
    const int e = c & 63;
    const float* wg = pw + gi * 64 * 64;
    float acc = 0.f;
    for (int cc = 0; cc < 64; ++cc) acc = fmaf(diff[gi * 64 + cc], wg[cc * 64 + e], acc);
    ycat[(size_t)t * 1024 + c] = f2bf(acc * pscale[c]);
  }
}

__device__ __forceinline__ void n_retention(const bf16_t* __restrict__ proj, const float* __restrict__ decay,
                                            bf16_t* __restrict__ ycat, float* smem) {
  const int tidx_ = opaque_tid(); const int bidx_ = opaque_bid();
  const int grp = tidx_ >> 8, tid = tidx_ & 255;
  float* base = smem + grp * 12544;
  float(*Qs)[65] = (float(*)[65])base;
  float(*Ks)[65] = (float(*)[65])(base + 64 * 65);
  float(*Vs)[128] = (float(*)[128])(base + 64 * 65 + 32 * 65);
  float(*Ps)[33] = (float(*)[33])(base + 64 * 65 + 32 * 65 + 32 * 128);
  const int rg = tid >> 5, cl = tid & 31;
  const int nwork = (NTOK / 64) * 4;
  for (int wb = bidx_ * 2; wb < nwork; wb += gridDim.x * 2) {
    const int w = wb + grp;
    const int h = w & 3, qt = w >> 2;
    const int t0 = qt * 64;
    const int b0 = t0 & ~(SEQ - 1);
    const int q0 = t0 & (SEQ - 1);
    float dlf = decay[h], dlb = decay[4 + h];
    float lgf = fminf(dlf, 0.f) - log1pf(expf(-fabsf(dlf)));
    float lgb = fminf(dlb, 0.f) - log1pf(expf(-fabsf(dlb)));
    __syncthreads();
    for (int idx = tid; idx < 64 * 64; idx += 256) {
      int r = idx >> 6, d = idx & 63;
      Qs[r][d] = bf2f(proj[(size_t)(t0 + r) * IN_WIDTH + C_RQ + h * 64 + d]);
    }
    float acc[8][4];
#pragma unroll
    for (int i = 0; i < 8; ++i)
#pragma unroll
      for (int j = 0; j < 4; ++j) acc[i][j] = 0.f;
    for (int k0 = 0; k0 < SEQ; k0 += 32) {
      __syncthreads();
      for (int idx = tid; idx < 32 * 64; idx += 256) {
        int r = idx >> 6, d = idx & 63;
        Ks[r][d] = bf2f(proj[(size_t)(b0 + k0 + r) * IN_WIDTH + C_RK + h * 64 + d]);
      }
      for (int idx = tid; idx < 32 * 128; idx += 256) {
        int r = idx >> 7, d = idx & 127;
        Vs[r][d] = bf2f(proj[(size_t)(b0 + k0 + r) * IN_WIDTH + C_RV + h * 128 + d]);
      }
      __syncthreads();
      float sc[8];
#pragma unroll
      for (int i = 0; i < 8; ++i) sc[i] = 0.f;
      for (int d = 0; d < 64; ++d) {
        float kv = Ks[cl][d];
#pragma unroll
        for (int i = 0; i < 8; ++i) sc[i] = fmaf(Qs[rg * 8 + i][d], kv, sc[i]);
      }
      const int j = k0 + cl;
#pragma unroll
      for (int i = 0; i < 8; ++i) {
        int qi = q0 + rg * 8 + i;
        float dd = (j <= qi) ? expf(lgf * (float)(qi - j)) : expf(lgb * (float)(j - qi));
        Ps[rg * 8 + i][cl] = sc[i] * dd;
      }
      __syncthreads();
      for (int jj = 0; jj < 32; ++jj) {
        float v[4];
#pragma unroll
        for (int c = 0; c < 4; ++c) v[c] = Vs[jj][cl + 32 * c];
#pragma unroll
        for (int i = 0; i < 8; ++i) {
          float p = Ps[rg * 8 + i][jj];
#pragma unroll
          for (int c = 0; c < 4; ++c) acc[i][c] = fmaf(p, v[c], acc[i][c]);
        }
      }
    }
#pragma unroll
    for (int i = 0; i < 8; ++i) {
      float ss = acc[i][0] * acc[i][0] + acc[i][1] * acc[i][1] + acc[i][2] * acc[i][2] + acc[i][3] * acc[i][3];
#pragma unroll
      for (int o = 16; o > 0; o >>= 1) ss += __shfl_xor(ss, o, 64);
      float r = rsqrtf(ss * (1.0f / 128.0f) + EPS);
      int t = t0 + rg * 8 + i;
#pragma unroll
      for (int c = 0; c < 4; ++c) {
        int col = h * 128 + cl + 32 * c;
        float g = bf2f(proj[(size_t)t * IN_WIDTH + C_RG + col]);
        float sg = g / (1.0f + expf(-g));
        ycat[(size_t)t * 1024 + 256 + col] = f2bf(sg * acc[i][c] * r);
      }
    }
  }
}

__device__ __forceinline__ void n_na(const bf16_t* __restrict__ proj, const float* __restrict__ rpb,
                                     bf16_t* __restrict__ ycat) {
  const int tidx_ = opaque_tid(); const int bidx_ = opaque_bid();
  const int lane = tidx_ & 63;
  const int nw = gridDim.x * (NTHREADS / 64);
  for (int wv = bidx_ * (NTHREADS / 64) + (tidx_ >> 6); wv < NTOK * 4; wv += nw) {
    int h = wv & 3, t = wv >> 2;
    int b0 = t & ~(SEQ - 1), pos = t & (SEQ - 1);
    int r = pos >> 6, c = pos & 63;
    int rs = r - 4; rs = rs < 0 ? 0 : (rs > 56 ? 56 : rs);
    int cs = c - 8; cs = cs < 0 ? 0 : (cs > 48 ? 48 : cs);
    float qv = bf2f(proj[(size_t)t * IN_WIDTH + C_NQ + h * 64 + lane]);
    float s[2];
#pragma unroll
    for (int u = 0; u < 2; ++u) {
      int kk = lane + 64 * u;
      int ri = kk >> 4, cj = kk & 15;
      int kt = b0 + (rs + ri) * 64 + cs + cj;
      const bf16_t* kp = proj + (size_t)kt * IN_WIDTH + C_NK + h * 64;
      float a = 0.f;
      for (int d = 0; d < 64; ++d) a = fmaf(__shfl(qv, d, 64), bf2f(kp[d]), a);
      int di = rs + ri - r + 7;
      int dj = cs + cj - c + 15;
      s[u] = a + rpb[(h * 15 + di) * 31 + dj];
    }
    float m = wave_max(fmaxf(s[0], s[1]));
    float e0 = expf(s[0] - m), e1 = expf(s[1] - m);
    float den = wave_sum(e0 + e1);
    float p0 = e0 / den, p1 = e1 / den;
    float o = 0.f;
    for (int kk = 0; kk < 128; ++kk) {
      float p = __shfl((kk < 64) ? p0 : p1, kk & 63, 64);
      int ri = kk >> 4, cj = kk & 15;
      int kt = b0 + (rs + ri) * 64 + cs + cj;
      o = fmaf(p, bf2f(proj[(size_t)kt * IN_WIDTH + C_NV + h * 64 + lane]), o);
    }
    ycat[(size_t)t * 1024 + 768 + h * 64 + lane] = f2bf(o);
  }
}

#define TKS 256
__device__ __forceinline__ void lds_insert(float* v, int* id, float x, int xi) {
  if (x > v[15 * TKS]) {
    int j = 15;
    while (j > 0 && v[(j - 1) * TKS] < x) {
      v[j * TKS] = v[(j - 1) * TKS];
      id[j * TKS] = id[(j - 1) * TKS];
      --j;
    }
    v[j * TKS] = x;
    id[j * TKS] = xi;
  }
}
__device__ __forceinline__ void n_topk(const float* __restrict__ scores, int* __restrict__ idx,
                                       float* __restrict__ gate, float* smem) {
  const int tidx_ = opaque_tid(); const int bidx_ = opaque_bid();
  const int tid = tidx_;
  if (tid >= TKS) return;
  float* v1 = smem + tid;
  float* v2 = smem + 16 * TKS + tid;
  float* v3 = smem + 32 * TKS + tid;
  int* i1 = (int*)(smem + 48 * TKS) + tid;
  int* i2 = (int*)(smem + 64 * TKS) + tid;
  int* i3 = (int*)(smem + 80 * TKS) + tid;
  for (int gid = bidx_ * TKS + tid; gid < SEQ * 8; gid += gridDim.x * TKS) {
    const float* s = scores + (size_t)gid * 256;
    for (int j = 0; j < 16; ++j) {
      v1[j * TKS] = -3.0e38f; v2[j * TKS] = -3.0e38f; v3[j * TKS] = -3.0e38f;
      i1[j * TKS] = 0; i2[j * TKS] = 0; i3[j * TKS] = 0;
    }
    for (int n = 0; n < 128; ++n) lds_insert(v1, i1, s[n], n);
    for (int n = 0; n < 128; ++n) lds_insert(v2, i2, s[128 + n], n);
    for (int a = 0; a < 16; ++a) {
      float va = v1[a * TKS];
      int ia = i1[a * TKS];
      for (int b = 0; b < 16; ++b) lds_insert(v3, i3, va + v2[b * TKS], ia * 128 + i2[b * TKS]);
    }
    float m = v3[0];
    float den = 0.f;
    for (int j = 0; j < 16; ++j) den += expf(v3[j * TKS] - m);
    for (int j = 0; j < 16; ++j) {
      idx[(size_t)gid * 16 + j] = i3[j * TKS];
      gate[(size_t)gid * 16 + j] = expf(v3[j * TKS] - m) / den;
    }
  }
}

__device__ __forceinline__ void n_experts(const bf16_t* __restrict__ hn, const int* __restrict__ idx,
                                          const float* __restrict__ gate, const float* __restrict__ wu,
                                          const float* __restrict__ wv, float* __restrict__ x, int ntok) {
  const int tidx_ = opaque_tid(); const int bidx_ = opaque_bid();
  const int lane = tidx_ & 63;
  const int nw = gridDim.x * (NTHREADS / 64);
  for (int t = bidx_ * (NTHREADS / 64) + (tidx_ >> 6); t < ntok; t += nw) {
    const bf16_t* hr = hn + (size_t)t * D_MODEL;
    float4 hv[4], acc[4];
#pragma unroll
    for (int i = 0; i < 4; ++i) {
      ushort4 hb = *(const ushort4*)(hr + i * 256 + lane * 4);
      hv[i] = make_float4(bf2f(hb.x), bf2f(hb.y), bf2f(hb.z), bf2f(hb.w));
      acc[i] = make_float4(0.f, 0.f, 0.f, 0.f);
    }
    for (int k = 0; k < 128; ++k) {
      int e = idx[(size_t)t * 128 + k];
      float g = gate[(size_t)t * 128 + k];
      const float* ur = wu + (size_t)e * D_MODEL;
      float a = 0.f;
#pragma unroll
      for (int i = 0; i < 4; ++i) {
        float4 u = *(const float4*)(ur + i * 256 + lane * 4);
        a += hv[i].x * u.x + hv[i].y * u.y + hv[i].z * u.z + hv[i].w * u.w;
      }
      a = wave_sum(a);
      float hh = 0.5f * a * (1.0f + erff(a * 0.70710678118654752f)) * g;
      const float* vr = wv + (size_t)e * D_MODEL;
#pragma unroll
      for (int i = 0; i < 4; ++i) {
        float4 v = *(const float4*)(vr + i * 256 + lane * 4);
        acc[i].x = fmaf(hh, v.x, acc[i].x); acc[i].y = fmaf(hh, v.y, acc[i].y);
        acc[i].z = fmaf(hh, v.z, acc[i].z); acc[i].w = fmaf(hh, v.w, acc[i].w);
      }
    }
    float* xr = x + (size_t)t * D_MODEL;
#pragma unroll
    for (int i = 0; i < 4; ++i) {
      float4 o = *(float4*)(xr + i * 256 + lane * 4);
      o.x += acc[i].x; o.y += acc[i].y; o.z += acc[i].z; o.w += acc[i].w;
      *(float4*)(xr + i * 256 + lane * 4) = o;
    }
  }
}


typedef __attribute__((ext_vector_type(8))) short bf16x8;
typedef __attribute__((ext_vector_type(4))) float f32x4;
#define LDX 1032
#define LDXB (LDX * 2)
#define XTILE_BYTES (64 * LDXB)

__device__ __forceinline__ unsigned pack2bf(float a, float b) { return (unsigned)f2bf(a) | ((unsigned)f2bf(b) << 16); }

__device__ __forceinline__ void prep_frag(const float* __restrict__ W, int K, int N, bf16_t* __restrict__ dst, float* smem) {
  const int tidx_ = opaque_tid(); const int bidx_ = opaque_bid();
  const int grp = tidx_ >> 8, tid = tidx_ & 255;
  float(*T)[65] = (float(*)[65])(smem + grp * 32 * 65);
  const int KS = K / 32, NC = N / 64;
  const int ntiles = KS * NC;
  for (int wb = bidx_ * 2; wb < ntiles; wb += gridDim.x * 2) {
    const int w = wb + grp;
    const int c = w / KS, ks = w - c * KS;
    {
      const int row = tid >> 3, col = (tid & 7) * 8;
      const float* src = W + (size_t)(ks * 32 + row) * N + c * 64 + col;
      float4 a = *(const float4*)src, b = *(const float4*)(src + 4);
      __syncthreads();
      T[row][col + 0] = a.x; T[row][col + 1] = a.y; T[row][col + 2] = a.z; T[row][col + 3] = a.w;
      T[row][col + 4] = b.x; T[row][col + 5] = b.y; T[row][col + 6] = b.z; T[row][col + 7] = b.w;
    }
    __syncthreads();
    {
      const int nt = tid >> 6, lane = tid & 63;
      const int kr = 8 * (lane >> 4), nc = nt * 16 + (lane & 15);
      uint4 o;
      o.x = pack2bf(T[kr + 0][nc], T[kr + 1][nc]);
      o.y = pack2bf(T[kr + 2][nc], T[kr + 3][nc]);
      o.z = pack2bf(T[kr + 4][nc], T[kr + 5][nc]);
      o.w = pack2bf(T[kr + 6][nc], T[kr + 7][nc]);
      *(uint4*)(dst + ((size_t)((c * KS + ks) * 4 + nt) * 64 + lane) * 8) = o;
    }
  }
}

__device__ __forceinline__ void o_prep(const Params& p, float* smem) {
  for (int l = 0; l < DEPTH; ++l) {
    prep_frag(p.w_in + (size_t)l * D_MODEL * IN_WIDTH, D_MODEL, IN_WIDTH, p.wf_in + (size_t)l * D_MODEL * IN_WIDTH, smem);
    prep_frag(p.w_br_pool + (size_t)l * 256 * 1024, 256, 1024, p.wf_br + (size_t)l * 1024 * 1024, smem);
    prep_frag(p.w_br_ret + (size_t)l * 512 * 1024, 512, 1024, p.wf_br + (size_t)l * 1024 * 1024 + 256 * 1024, smem);
    prep_frag(p.w_br_na + (size_t)l * 256 * 1024, 256, 1024, p.wf_br + (size_t)l * 1024 * 1024 + 768 * 1024, smem);
    prep_frag(p.w_out + (size_t)l * 1024 * 1024, 1024, 1024, p.wf_out + (size_t)l * 1024 * 1024, smem);
    prep_frag(p.w_query + (size_t)l * 1024 * 2048, 1024, 2048, p.wf_q + (size_t)l * 1024 * 2048, smem);
  }
  const int tidx_ = opaque_tid(); const int bidx_ = opaque_bid();
  const int gtid = bidx_ * NTHREADS + tidx_, gsz = gridDim.x * NTHREADS;
  for (int u = gtid; u < DEPTH * 2 * 8 * 4 * 64; u += gsz) {
    const int lane = u & 63, s2 = (u >> 6) & 3, kt = (u >> 8) & 7, lp = u >> 11;
    const float* kr = p.sub_keys + ((size_t)lp * 128 + kt * 16 + (lane & 15)) * 128;
    float v[8];
#pragma unroll
    for (int j = 0; j < 8; ++j) v[j] = kr[16 * (2 * s2 + (j >> 2)) + 4 * (lane >> 4) + (j & 3)];
    uint4 o;
    o.x = pack2bf(v[0], v[1]); o.y = pack2bf(v[2], v[3]); o.z = pack2bf(v[4], v[5]); o.w = pack2bf(v[6], v[7]);
    *(uint4*)(p.kf + (size_t)u * 8) = o;
  }
  if (p.u16) {
    const size_t nunits = (size_t)DEPTH * 16384 * 1024 / 8;
    for (size_t u = gtid; u < nunits; u += gsz) {
      float4 a = *(const float4*)(p.peer_u + u * 8), b = *(const float4*)(p.peer_u + u * 8 + 4);
      uint4 o;
      o.x = pack2bf(a.x, a.y); o.y = pack2bf(a.z, a.w); o.z = pack2bf(b.x, b.y); o.w = pack2bf(b.z, b.w);
      *(uint4*)(p.u16 + u * 8) = o;
      a = *(const float4*)(p.peer_v + u * 8); b = *(const float4*)(p.peer_v + u * 8 + 4);
      o.x = pack2bf(a.x, a.y); o.y = pack2bf(a.z, a.w); o.z = pack2bf(b.x, b.y); o.w = pack2bf(b.z, b.w);
      *(uint4*)(p.v16 + u * 8) = o;
    }
  }
  for (int u = gtid; u < SEQ * 32; u += gsz) {
    const int i = u & 31, pos = u >> 5;
    float inv = 1.0f / powf(10000.0f, (float)i / 31.0f);
    float ang = (float)pos * inv;
    double rev = (double)ang * 0.15915494309189535;
    rev -= floor(rev);
    float rf = (float)rev;
    p.rope[u] = make_float2(__builtin_amdgcn_cosf(rf), __builtin_amdgcn_sinf(rf));
  }
}

__device__ __forceinline__ void tl_gemm_chunk(const bf16_t* __restrict__ wf, const int KS, const char* xt, const int kbyte0,
                                              f32x4 (&acc)[4][4], const int lane) {
  const bf16x8* wp = (const bf16x8*)wf + lane;
  const char* xp = xt + (lane & 15) * LDXB + kbyte0 + (lane >> 4) * 16;
  bf16x8 wb[4][4];
#pragma unroll
  for (int s = 0; s < 3; ++s)
#pragma unroll
    for (int nt = 0; nt < 4; ++nt) wb[s][nt] = wp[(s * 4 + nt) * 64];
  for (int ks = 0; ks < KS; ks += 4) {
#pragma unroll
    for (int u = 0; u < 4; ++u) {
      int kpre = ks + u + 3;
      kpre = kpre < KS ? kpre : KS - 1;
#pragma unroll
      for (int nt = 0; nt < 4; ++nt) wb[(u + 3) & 3][nt] = wp[(kpre * 4 + nt) * 64];
      bf16x8 xf[4];
#pragma unroll
      for (int mt = 0; mt < 4; ++mt) xf[mt] = *(const bf16x8*)(xp + mt * 16 * LDXB + (ks + u) * 64);
#pragma unroll
      for (int nt = 0; nt < 4; ++nt)
#pragma unroll
        for (int mt = 0; mt < 4; ++mt)
          acc[nt][mt] = __builtin_amdgcn_mfma_f32_16x16x32_bf16(wb[u][nt], xf[mt], acc[nt][mt], 0, 0, 0);
    }
  }
}

__device__ __forceinline__ void tile_rmsnorm_to_lds(const float* __restrict__ xsrc, const float* __restrict__ g, int t0,
                                                    char* xt, int wave, int lane) {
#pragma unroll 2
  for (int i = 0; i < 8; ++i) {
    const int tok = wave * 8 + i;
    const float* xr = xsrc + (size_t)(t0 + tok) * D_MODEL;
    float4 v[4];
    float ss = 0.f;
#pragma unroll
    for (int q = 0; q < 4; ++q) {
      v[q] = *(const float4*)(xr + q * 256 + lane * 4);
      ss += v[q].x * v[q].x + v[q].y * v[q].y + v[q].z * v[q].z + v[q].w * v[q].w;
    }
    ss = wave_sum(ss);
    const float r = rsqrtf(ss * (1.0f / D_MODEL) + EPS);
#pragma unroll
    for (int q = 0; q < 4; ++q) {
      float4 gg = *(const float4*)(g + q * 256 + lane * 4);
      uint2 o;
      o.x = pack2bf(v[q].x * r * gg.x, v[q].y * r * gg.y);
      o.y = pack2bf(v[q].z * r * gg.z, v[q].w * r * gg.w);
      *(uint2*)(xt + tok * LDXB + (q * 256 + lane * 4) * 2) = o;
    }
  }
}

__device__ __forceinline__ void o_p1(const Params& p, int l, const float* __restrict__ xsrc, char* smem) {
  const int tidx_ = opaque_tid(); const int bidx_ = opaque_bid();
  const int wave = tidx_ >> 6, lane = tidx_ & 63;
  const bf16_t* wf = p.wf_in + (size_t)l * D_MODEL * IN_WIDTH;
  const float* g = p.norm_mix + l * D_MODEL;
  for (int tile = bidx_; tile < NTOK / 64; tile += gridDim.x) {
    const int t0 = tile * 64;
    __syncthreads();
    tile_rmsnorm_to_lds(xsrc, g, t0, smem, wave, lane);
    __syncthreads();
    for (int c = wave; c < IN_WIDTH / 64; c += 8) {
      f32x4 acc[4][4];
#pragma unroll
      for (int a = 0; a < 4; ++a)
#pragma unroll
        for (int b = 0; b < 4; ++b) acc[a][b] = (f32x4){0.f, 0.f, 0.f, 0.f};
      tl_gemm_chunk(wf + (size_t)c * 32 * 4 * 64 * 8, 32, smem, 0, acc, lane);
      if (c >= 4 && c < 12) {
        const float sc = (c >= 8) ? 0.125f : 1.0f;
#pragma unroll
        for (int mt = 0; mt < 4; ++mt) {
          const int tok = t0 + mt * 16 + (lane & 15);
          const int pos = tok & (SEQ - 1);
#pragma unroll
          for (int nt = 0; nt < 2; ++nt) {
            const int i0 = nt * 16 + 4 * (lane >> 4);
            const float4 cs01 = *(const float4*)(p.rope + pos * 32 + i0);
            const float4 cs23 = *(const float4*)(p.rope + pos * 32 + i0 + 2);
            const float cc[4] = {cs01.x, cs01.z, cs23.x, cs23.z};
            const float sn[4] = {cs01.y, cs01.w, cs23.y, cs23.w};
#pragma unroll
            for (int r = 0; r < 4; ++r) {
              const float x1 = acc[nt][mt][r], x2 = acc[nt + 2][mt][r];
              acc[nt][mt][r] = (x1 * cc[r] - x2 * sn[r]) * sc;
              acc[nt + 2][mt][r] = (x1 * sn[r] + x2 * cc[r]) * sc;
            }
          }
        }
      } else if (c >= 28 && c < 32) {
#pragma unroll
        for (int a = 0; a < 4; ++a)
#pragma unroll
          for (int b = 0; b < 4; ++b) acc[a][b] *= 0.125f;
      } else if (c >= 40) {
#pragma unroll
        for (int a = 0; a < 4; ++a)
#pragma unroll
          for (int b = 0; b < 4; ++b)
#pragma unroll
            for (int r = 0; r < 4; ++r) acc[a][b][r] = 1.0f / (1.0f + __expf(-acc[a][b][r]));
      }
#pragma unroll
      for (int mt = 0; mt < 4; ++mt) {
        const int tok = t0 + mt * 16 + (lane & 15);
        bf16_t* dst = p.proj + (size_t)tok * IN_WIDTH + c * 64 + 4 * (lane >> 4);
#pragma unroll
        for (int nt = 0; nt < 4; ++nt) {
          uint2 o;
          o.x = pack2bf(acc[nt][mt][0], acc[nt][mt][1]);
          o.y = pack2bf(acc[nt][mt][2], acc[nt][mt][3]);
          *(uint2*)(dst + nt * 16) = o;
        }
      }
    }
  }
}


__global__ void __launch_bounds__(NTHREADS) fwd_megakernel(Params p) {
  cg::grid_group grid = cg::this_grid();
  extern __shared__ __attribute__((aligned(16))) float smem[];

  o_prep(p, smem);
  grid.sync();
#pragma unroll 1
  for (int l = 0; l < DEPTH; ++l) {
    const float* xcur = (l == 0) ? p.x_in : p.xres;
    o_p1(p, l, xcur, (char*)smem);
    grid.sync();
    n_pool(p.proj, p.pool_w + (size_t)l * 4 * 64 * 64, p.pool_scale + l * 256, p.ycat, smem);
    n_retention(p.proj, p.ret_decay + l * 8, p.ycat, smem);
    n_na(p.proj, p.na_rpb + (size_t)l * 4 * 15 * 31, p.ycat);
    grid.sync();
    {
      float* merged = p.merged;
      const bf16_t* proj = p.proj;
      n_gemm<true>(p.ycat, 1024, 0, p.w_br_pool + (size_t)l * 256 * D_MODEL, D_MODEL, 0, 0, NTOK, D_MODEL, 256, 1, smem,
                   [=](int z, int m, int n, float v) {
                     merged[(size_t)m * 1024 + n] = bf2f(proj[(size_t)m * IN_WIDTH + C_GATE + n]) * v;
                   });
      n_gemm<true>(p.ycat + 256, 1024, 0, p.w_br_ret + (size_t)l * 512 * D_MODEL, D_MODEL, 0, 0, NTOK, D_MODEL, 512, 1,
                   smem, [=](int z, int m, int n, float v) {
                     merged[(size_t)m * 1024 + n] += bf2f(proj[(size_t)m * IN_WIDTH + C_GATE + 1024 + n]) * v;
                   });
      n_gemm<true>(p.ycat + 768, 1024, 0, p.w_br_na + (size_t)l * 256 * D_MODEL, D_MODEL, 0, 0, NTOK, D_MODEL, 256, 1,
                   smem, [=](int z, int m, int n, float v) {
                     merged[(size_t)m * 1024 + n] += bf2f(proj[(size_t)m * IN_WIDTH + C_GATE + 2048 + n]) * v;
                   });
    }
    grid.sync();
    {
      float* xres = p.xres;
      n_gemm<false>(p.merged, D_MODEL, 0, p.w_out + (size_t)l * D_MODEL * D_MODEL, D_MODEL, 0, 0, NTOK, D_MODEL, D_MODEL, 1,
                    smem, [=](int z, int m, int n, float v) {
                      size_t o = (size_t)m * 1024 + n;
                      xres[o] = xcur[o] + v;
                    });
    }
    grid.sync();
    n_rmsnorm<false>(p.xres, p.norm_ffn + l * D_MODEL, p.xn, NTOK);
    grid.sync();
#pragma unroll 1
    for (int b = 0; b < BATCH; ++b) {
      const bf16_t* hn = p.xn + (size_t)b * SEQ * D_MODEL;
      {
        float* pq = p.pq;
        n_gemm<true>(hn, D_MODEL, 0, p.w_query + (size_t)l * D_MODEL * 2048, 2048, 0, 0, SEQ, 2048, D_MODEL, 1, smem,
                     [=](int z, int m, int n, float v) { pq[(size_t)m * 2048 + n] = v; });
      }
      grid.sync();
      for (int pp = 0; pp < 2; ++pp) {
        float* psc = p.psc + pp * 128;
        n_gemm<false>(p.pq + pp * 128, 2048, 256, p.sub_keys + (size_t)l * 2 * 128 * 128 + (size_t)pp * 128 * 128, 128, 0,
                      1, SEQ, 128, 128, 8, smem,
                      [=](int z, int m, int n, float v) { psc[(size_t)m * 2048 + z * 256 + n] = v; });
      }
      grid.sync();
      n_topk(p.psc, p.pidx + (size_t)b * SEQ * 128, p.pgate + (size_t)b * SEQ * 128, smem);
      grid.sync();
      n_experts(hn, p.pidx + (size_t)b * SEQ * 128, p.pgate + (size_t)b * SEQ * 128,
                p.peer_u + (size_t)l * 16384 * D_MODEL, p.peer_v + (size_t)l * 16384 * D_MODEL,
                p.xres + (size_t)b * SEQ * D_MODEL, SEQ);
      grid.sync();
    }
  }
  n_rmsnorm<true>(p.xres, p.norm_final, p.out, NTOK);
}

extern "C" void kernel_launch(void* const* d_in, const int* in_sizes, int n_in, void* d_out, int out_size,
                              void* d_ws, size_t ws_size, hipStream_t stream) {
  Params p{};
  p.x_in = (const float*)d_in[0]; p.norm_mix = (const float*)d_in[1]; p.w_in = (const float*)d_in[2];
  p.pool_w = (const float*)d_in[3]; p.pool_scale = (const float*)d_in[4]; p.ret_decay = (const float*)d_in[5];
  p.na_rpb = (const float*)d_in[6]; p.w_br_pool = (const float*)d_in[7]; p.w_br_ret = (const float*)d_in[8];
  p.w_br_na = (const float*)d_in[9]; p.w_out = (const float*)d_in[10]; p.norm_ffn = (const float*)d_in[11];
  p.w_query = (const float*)d_in[12]; p.sub_keys = (const float*)d_in[13]; p.peer_u = (const float*)d_in[14];
  p.peer_v = (const float*)d_in[15]; p.norm_final = (const float*)d_in[16];
  p.out = (float*)d_out;
  char* ws = (char*)d_ws;
  size_t off = 0;
  auto alloc = [&](size_t bytes) { char* q = ws + off; off += (bytes + 255) & ~(size_t)255; return q; };
  p.xres = (float*)alloc((size_t)NTOK * D_MODEL * 4);
  p.xn = (bf16_t*)alloc((size_t)NTOK * D_MODEL * 2);
  p.proj = (bf16_t*)alloc((size_t)NTOK * IN_WIDTH * 2);
  p.ycat = (bf16_t*)alloc((size_t)NTOK * 1024 * 2);
  p.merged = (float*)alloc((size_t)NTOK * 1024 * 4);
  p.pq = (float*)alloc((size_t)SEQ * 2048 * 4);
  p.psc = (float*)alloc((size_t)SEQ * 2048 * 4);
  p.pidx = (int*)alloc((size_t)NTOK * 128 * 4);
  p.pgate = (float*)alloc((size_t)NTOK * 128 * 4);
  p.wf_in = (bf16_t*)alloc((size_t)DEPTH * D_MODEL * IN_WIDTH * 2);
  p.wf_br = (bf16_t*)alloc((size_t)DEPTH * 1024 * 1024 * 2);
  p.wf_out = (bf16_t*)alloc((size_t)DEPTH * 1024 * 1024 * 2);
  p.wf_q = (bf16_t*)alloc((size_t)DEPTH * 1024 * 2048 * 2);
  p.kf = (bf16_t*)alloc((size_t)DEPTH * 2 * 128 * 128 * 2);
  p.u16 = nullptr; p.v16 = nullptr;
  p.rope = (float2*)alloc((size_t)SEQ * 32 * 8);
  p.mrg = nullptr;
  if (off > ws_size) fprintf(stderr, "WORKSPACE OVERFLOW: need %zu have %zu\n", off, ws_size);

  const size_t kDynLds = 160 * 1024;
  static int grid_blocks = 0;
  if (!grid_blocks) {
    int dev = 0, cus = 0, per_cu = 0;
    (void)hipGetDevice(&dev);
    (void)hipDeviceGetAttribute(&cus, hipDeviceAttributeMultiprocessorCount, dev);
    (void)hipFuncSetAttribute((const void*)fwd_megakernel, hipFuncAttributeMaxDynamicSharedMemorySize, (int)kDynLds);
    (void)hipOccupancyMaxActiveBlocksPerMultiprocessor(&per_cu, fwd_megakernel, NTHREADS, kDynLds);
    if (per_cu < 1) per_cu = 1;
    grid_blocks = cus * per_cu;
  }
  void* args[] = {&p};
  hipError_t e = hipLaunchCooperativeKernel((void*)fwd_megakernel, dim3(grid_blocks), dim3(NTHREADS), args, kDynLds, stream);
  if (e != hipSuccess) fprintf(stderr, "cooperative launch failed: %s (grid %d)\n", hipGetErrorString(e), grid_blocks);
}
```

```cpp
#include <hip/hip_runtime.h>
#include <hip/hip_cooperative_groups.h>
#include <stdint.h>
#include <cstdio>
namespace cg = cooperative_groups;

#define D_MODEL 1024
#define SEQ 4096
#define BATCH 4
#define NTOK (BATCH * SEQ)
#define DEPTH 2
#define IN_WIDTH 5632
#define C_POOL 0
#define C_RQ 256
#define C_RK 512
#define C_RV 768
#define C_RG 1280
#define C_NQ 1792
#define C_NK 2048
#define C_NV 2304
#define C_GATE 2560
#define EPS 1e-6f
#define NTHREADS 512

typedef unsigned short bf16_t;

struct Params {
  const float* x_in; const float* norm_mix; const float* w_in; const float* pool_w; const float* pool_scale;
  const float* ret_decay; const float* na_rpb; const float* w_br_pool; const float* w_br_ret; const float* w_br_na;
  const float* w_out; const float* norm_ffn; const float* w_query; const float* sub_keys; const float* peer_u;
  const float* peer_v; const float* norm_final;
  float* out;
  float* xres;
  bf16_t* xn;
  bf16_t* proj;
  bf16_t* ycat;
  float* merged;
  float* pq;
  float* psc;
  int* pidx;
  float* pgate;
  bf16_t* wf_in;
  bf16_t* wf_br;
  bf16_t* wf_out;
  bf16_t* wf_q;
  bf16_t* kf;
  bf16_t* u16;
  bf16_t* v16;
  float2* rope;
  bf16_t* mrg;
  unsigned* tklist;
};

__device__ __forceinline__ bf16_t f2bf(float f) {
  unsigned u = __float_as_uint(f);
  u += 0x7fffu + ((u >> 16) & 1u);
  return (bf16_t)(u >> 16);
}
__device__ __forceinline__ float bf2f(bf16_t h) { return __uint_as_float(((unsigned)h) << 16); }

__device__ __forceinline__ float wave_sum(float v) {
#pragma unroll
  for (int o = 32; o > 0; o >>= 1) v += __shfl_xor(v, o, 64);
  return v;
}
__device__ __forceinline__ float wave_max(float v) {
#pragma unroll
  for (int o = 32; o > 0; o >>= 1) v = fmaxf(v, __shfl_xor(v, o, 64));
  return v;
}
__device__ __forceinline__ float sigmoidf_(float x) { return 1.0f / (1.0f + expf(-x)); }

__device__ __forceinline__ int opaque_tid(int wv) {
  int w = wv;
  asm volatile("" : "+s"(w));
  int lane = __builtin_amdgcn_mbcnt_hi(~0u, __builtin_amdgcn_mbcnt_lo(~0u, 0u));
  asm volatile("" : "+v"(lane));
  return w * 64 + lane;
}
__device__ __forceinline__ int opaque_bid() { int b = blockIdx.x; asm volatile("" : "+s"(b)); return b; }

template <bool OUT_F32>
__device__ __forceinline__ void n_rmsnorm(const int wv_, const float* __restrict__ x, const float* __restrict__ g, void* outp, int rows) {
  const int tidx_ = opaque_tid(wv_); const int bidx_ = opaque_bid();
  const int lane = tidx_ & 63;
  const int nw = gridDim.x * (NTHREADS / 64);
  for (int row = bidx_ * (NTHREADS / 64) + (tidx_ >> 6); row < rows; row += nw) {
    const float* xr = x + (size_t)row * D_MODEL;
    float4 v[4];
    float ss = 0.f;
#pragma unroll
    for (int i = 0; i < 4; ++i) {
      v[i] = *(const float4*)(xr + i * 256 + lane * 4);
      ss += v[i].x * v[i].x + v[i].y * v[i].y + v[i].z * v[i].z + v[i].w * v[i].w;
    }
    ss = wave_sum(ss);
    float r = rsqrtf(ss * (1.0f / D_MODEL) + EPS);
#pragma unroll
    for (int i = 0; i < 4; ++i) {
      float4 gg = *(const float4*)(g + i * 256 + lane * 4);
      float o0 = v[i].x * r * gg.x, o1 = v[i].y * r * gg.y, o2 = v[i].z * r * gg.z, o3 = v[i].w * r * gg.w;
      if (OUT_F32) {
        *(float4*)((float*)outp + (size_t)row * D_MODEL + i * 256 + lane * 4) = make_float4(o0, o1, o2, o3);
      } else {
        ushort4 o; o.x = f2bf(o0); o.y = f2bf(o1); o.z = f2bf(o2); o.w = f2bf(o3);
        *(ushort4*)((bf16_t*)outp + (size_t)row * D_MODEL + i * 256 + lane * 4) = o;
      }
    }
  }
}

template <bool A_BF16, typename Epi>
__device__ __forceinline__ void n_gemm(const int wv_, const void* Av, int lda, long sA, const float* __restrict__ B, int ldb, long sB,
                                       int transB, int M, int N, int K, int Z, float* smem, Epi epi) {
  const int tidx_ = opaque_tid(wv_); const int bidx_ = opaque_bid();
  const int grp = tidx_ >> 8, tid = tidx_ & 255;
  float(*As)[68] = (float(*)[68])(smem + grp * 2 * 16 * 68);
  float(*Bs)[68] = (float(*)[68])(smem + grp * 2 * 16 * 68 + 16 * 68);
  const int tx = tid & 15, ty = tid >> 4;
  const int tn = N / 64, tm = M / 64;
  const int nwork = tn * tm * Z;
  for (int wb = bidx_ * 2; wb < nwork; wb += gridDim.x * 2) {
    const int w = wb + grp;
    const int z = w / (tn * tm);
    const int rem = w - z * (tn * tm);
    const int bm = (rem / tn) * 64, bn = (rem % tn) * 64;
    const float* Af = (const float*)Av + (size_t)z * sA;
    const bf16_t* Ab = (const bf16_t*)Av + (size_t)z * sA;
    const float* Bz = B + (size_t)z * sB;
    float acc[4][4];
#pragma unroll
    for (int i = 0; i < 4; ++i)
#pragma unroll
      for (int j = 0; j < 4; ++j) acc[i][j] = 0.f;
    for (int k0 = 0; k0 < K; k0 += 16) {
#pragma unroll
      for (int i = 0; i < 4; ++i) {
        int idx = tid + i * 256;
        int m = idx >> 4, k = idx & 15;
        size_t ao = (size_t)(bm + m) * lda + k0 + k;
        As[k][m] = A_BF16 ? bf2f(Ab[ao]) : Af[ao];
        if (transB) {
          int n = idx >> 4, kk = idx & 15;
          Bs[kk][n] = Bz[(size_t)(bn + n) * ldb + k0 + kk];
        } else {
          int kk = idx >> 6, n = idx & 63;
          Bs[kk][n] = Bz[(size_t)(k0 + kk) * ldb + bn + n];
        }
      }
      __syncthreads();
#pragma unroll
      for (int k = 0; k < 16; ++k) {
        float a[4], b[4];
#pragma unroll
        for (int i = 0; i < 4; ++i) a[i] = As[k][ty * 4 + i];
#pragma unroll
        for (int j = 0; j < 4; ++j) b[j] = Bs[k][tx * 4 + j];
#pragma unroll
        for (int i = 0; i < 4; ++i)
#pragma unroll
          for (int j = 0; j < 4; ++j) acc[i][j] = fmaf(a[i], b[j], acc[i][j]);
      }
      __syncthreads();
    }
#pragma unroll
    for (int i = 0; i < 4; ++i)
#pragma unroll
      for (int j = 0; j < 4; ++j) epi(z, bm + ty * 4 + i, bn + tx * 4 + j, acc[i][j]);
  }
}

__device__ __forceinline__ void n_rope(const int wv_, bf16_t* __restrict__ proj) {
  const int tidx_ = opaque_tid(wv_); const int bidx_ = opaque_bid();
  const int total = NTOK * 256;
  for (int gid = bidx_ * NTHREADS + tidx_; gid < total; gid += gridDim.x * NTHREADS) {
    int i = gid & 31, h = (gid >> 5) & 3, qk = (gid >> 7) & 1, t = gid >> 8;
    int pos = t & (SEQ - 1);
    float inv = 1.0f / powf(10000.0f, (float)i / 31.0f);
    float ang = (float)pos * inv;
    double rev = (double)ang * 0.15915494309189535;
    rev -= floor(rev);
    float rf = (float)rev;
    float cs = __builtin_amdgcn_cosf(rf), sn = __builtin_amdgcn_sinf(rf);
    bf16_t* p = proj + (size_t)t * IN_WIDTH + (qk ? C_RK : C_RQ) + h * 64 + i;
    float x1 = bf2f(p[0]), x2 = bf2f(p[32]);
    p[0] = f2bf(x1 * cs - x2 * sn);
    p[32] = f2bf(x1 * sn + x2 * cs);
  }
}

__device__ __forceinline__ void n_pool(const int wv_, const bf16_t* __restrict__ proj, const float* __restrict__ pw,
                                       const float* __restrict__ pscale, bf16_t* __restrict__ ycat, float* smem) {
  const int tidx_ = opaque_tid(wv_); const int bidx_ = opaque_bid();
  const int grp = tidx_ >> 8, c = tidx_ & 255;
  float* diff = smem + grp * 256;
  const int gi = c >> 6;
  const int w = 2 << gi;
  const int lo = w / 2, hi = w - w / 2;
  for (int wb = bidx_ * 2; wb < NTOK; wb += gridDim.x * 2) {
    const int t = wb + grp;
    const int b0 = t & ~(SEQ - 1), pos = t & (SEQ - 1);
    int a = pos - lo; if (a < 0) a = 0;
    int b = pos + hi; if (b > SEQ) b = SEQ;
    float s = 0.f;
    for (int tt = a; tt < b; ++tt) s += bf2f(proj[(size_t)(b0 + tt) * IN_WIDTH + C_POOL + c]);
    float mean = s / (float)(b - a);
    __syncthreads();
    diff[c] = mean - bf2f(proj[(size_t)t * IN_WIDTH + C_POOL + c]);
    __syncthreads();
    const int e = c & 63;
    const float* wg = pw + gi * 64 * 64;
    float acc = 0.f;
    for (int cc = 0; cc < 64; ++cc) acc = fmaf(diff[gi * 64 + cc], wg[cc * 64 + e], acc);
    ycat[(size_t)t * 1024 + c] = f2bf(acc * pscale[c]);
  }
}

__device__ __forceinline__ void n_retention(const int wv_, const bf16_t* __restrict__ proj, const float* __restrict__ decay,
                                            bf16_t* __restrict__ ycat, float* smem) {
  const int tidx_ = opaque_tid(wv_); const int bidx_ = opaque_bid();
  const int grp = tidx_ >> 8, tid = tidx_ & 255;
  float* base = smem + grp * 12544;
  float(*Qs)[65] = (float(*)[65])base;
  float(*Ks)[65] = (float(*)[65])(base + 64 * 65);
  float(*Vs)[128] = (float(*)[128])(base + 64 * 65 + 32 * 65);
  float(*Ps)[33] = (float(*)[33])(base + 64 * 65 + 32 * 65 + 32 * 128);
  const int rg = tid >> 5, cl = tid & 31;
  const int nwork = (NTOK / 64) * 4;
  for (int wb = bidx_ * 2; wb < nwork; wb += gridDim.x * 2) {
    const int w = wb + grp;
    const int h = w & 3, qt = w >> 2;
    const int t0 = qt * 64;
    const int b0 = t0 & ~(SEQ - 1);
    const int q0 = t0 & (SEQ - 1);
    float dlf = decay[h], dlb = decay[4 + h];
    float lgf = fminf(dlf, 0.f) - log1pf(expf(-fabsf(dlf)));
    float lgb = fminf(dlb, 0.f) - log1pf(expf(-fabsf(dlb)));
    __syncthreads();
    for (int idx = tid; idx < 64 * 64; idx += 256) {
      int r = idx >> 6, d = idx & 63;
      Qs[r][d] = bf2f(proj[(size_t)(t0 + r) * IN_WIDTH + C_RQ + h * 64 + d]);
    }
    float acc[8][4];
#pragma unroll
    for (int i = 0; i < 8; ++i)
#pragma unroll
      for (int j = 0; j < 4; ++j) acc[i][j] = 0.f;
    for (int k0 = 0; k0 < SEQ; k0 += 32) {
      __syncthreads();
      for (int idx = tid; idx < 32 * 64; idx += 256) {
        int r = idx >> 6, d = idx & 63;
        Ks[r][d] = bf2f(proj[(size_t)(b0 + k0 + r) * IN_WIDTH + C_RK + h * 64 + d]);
      }
      for (int idx = tid; idx < 32 * 128; idx += 256) {
        int r = idx >> 7, d = idx & 127;
        Vs[r][d] = bf2f(proj[(size_t)(b0 + k0 + r) * IN_WIDTH + C_RV + h * 128 + d]);
      }
      __syncthreads();
      float sc[8];
#pragma unroll
      for (int i = 0; i < 8; ++i) sc[i] = 0.f;
      for (int d = 0; d < 64; ++d) {
        float kv = Ks[cl][d];
#pragma unroll
        for (int i = 0; i < 8; ++i) sc[i] = fmaf(Qs[rg * 8 + i][d], kv, sc[i]);
      }
      const int j = k0 + cl;
#pragma unroll
      for (int i = 0; i < 8; ++i) {
        int qi = q0 + rg * 8 + i;
        float dd = (j <= qi) ? expf(lgf * (float)(qi - j)) : expf(lgb * (float)(j - qi));
        Ps[rg * 8 + i][cl] = sc[i] * dd;
      }
      __syncthreads();
      for (int jj = 0; jj < 32; ++jj) {
        float v[4];
#pragma unroll
        for (int c = 0; c < 4; ++c) v[c] = Vs[jj][cl + 32 * c];
#pragma unroll
        for (int i = 0; i < 8; ++i) {
          float p = Ps[rg * 8 + i][jj];
#pragma unroll
          for (int c = 0; c < 4; ++c) acc[i][c] = fmaf(p, v[c], acc[i][c]);
        }
      }
    }
#pragma unroll
    for (int i = 0; i < 8; ++i) {
      float ss = acc[i][0] * acc[i][0] + acc[i][1] * acc[i][1] + acc[i][2] * acc[i][2] + acc[i][3] * acc[i][3];
#pragma unroll
      for (int o = 16; o > 0; o >>= 1) ss += __shfl_xor(ss, o, 64);
      float r = rsqrtf(ss * (1.0f / 128.0f) + EPS);
      int t = t0 + rg * 8 + i;
#pragma unroll
      for (int c = 0; c < 4; ++c) {
        int col = h * 128 + cl + 32 * c;
        float g = bf2f(proj[(size_t)t * IN_WIDTH + C_RG + col]);
        float sg = g / (1.0f + expf(-g));
        ycat[(size_t)t * 1024 + 256 + col] = f2bf(sg * acc[i][c] * r);
      }
    }
  }
}

__device__ __forceinline__ void n_na(const int wv_, const bf16_t* __restrict__ proj, const float* __restrict__ rpb,
                                     bf16_t* __restrict__ ycat) {
  const int tidx_ = opaque_tid(wv_); const int bidx_ = opaque_bid();
  const int lane = tidx_ & 63;
  const int nw = gridDim.x * (NTHREADS / 64);
  for (int wv = bidx_ * (NTHREADS / 64) + (tidx_ >> 6); wv < NTOK * 4; wv += nw) {
    int h = wv & 3, t = wv >> 2;
    int b0 = t & ~(SEQ - 1), pos = t & (SEQ - 1);
    int r = pos >> 6, c = pos & 63;
    int rs = r - 4; rs = rs < 0 ? 0 : (rs > 56 ? 56 : rs);
    int cs = c - 8; cs = cs < 0 ? 0 : (cs > 48 ? 48 : cs);
    float qv = bf2f(proj[(size_t)t * IN_WIDTH + C_NQ + h * 64 + lane]);
    float s[2];
#pragma unroll
    for (int u = 0; u < 2; ++u) {
      int kk = lane + 64 * u;
      int ri = kk >> 4, cj = kk & 15;
      int kt = b0 + (rs + ri) * 64 + cs + cj;
      const bf16_t* kp = proj + (size_t)kt * IN_WIDTH + C_NK + h * 64;
      float a = 0.f;
      for (int d = 0; d < 64; ++d) a = fmaf(__shfl(qv, d, 64), bf2f(kp[d]), a);
      int di = rs + ri - r + 7;
      int dj = cs + cj - c + 15;
      s[u] = a + rpb[(h * 15 + di) * 31 + dj];
    }
    float m = wave_max(fmaxf(s[0], s[1]));
    float e0 = expf(s[0] - m), e1 = expf(s[1] - m);
    float den = wave_sum(e0 + e1);
    float p0 = e0 / den, p1 = e1 / den;
    float o = 0.f;
    for (int kk = 0; kk < 128; ++kk) {
      float p = __shfl((kk < 64) ? p0 : p1, kk & 63, 64);
      int ri = kk >> 4, cj = kk & 15;
      int kt = b0 + (rs + ri) * 64 + cs + cj;
      o = fmaf(p, bf2f(proj[(size_t)kt * IN_WIDTH + C_NV + h * 64 + lane]), o);
    }
    ycat[(size_t)t * 1024 + 768 + h * 64 + lane] = f2bf(o);
  }
}

#define TKS 256
__device__ __forceinline__ void lds_insert(float* v, int* id, float x, int xi) {
  if (x > v[15 * TKS]) {
    int j = 15;
    while (j > 0 && v[(j - 1) * TKS] < x) {
      v[j * TKS] = v[(j - 1) * TKS];
      id[j * TKS] = id[(j - 1) * TKS];
      --j;
    }
    v[j * TKS] = x;
    id[j * TKS] = xi;
  }
}
__device__ __forceinline__ void n_topk(const int wv_, const float* __restrict__ scores, int* __restrict__ idx,
                                       float* __restrict__ gate, float* smem) {
  const int tidx_ = opaque_tid(wv_); const int bidx_ = opaque_bid();
  const int tid = tidx_;
  if (tid >= TKS) return;
  float* v1 = smem + tid;
  float* v2 = smem + 16 * TKS + tid;
  float* v3 = smem + 32 * TKS + tid;
  int* i1 = (int*)(smem + 48 * TKS) + tid;
  int* i2 = (int*)(smem + 64 * TKS) + tid;
  int* i3 = (int*)(smem + 80 * TKS) + tid;
  for (int gid = bidx_ * TKS + tid; gid < SEQ * 8; gid += gridDim.x * TKS) {
    const float* s = scores + (size_t)gid * 256;
    for (int j = 0; j < 16; ++j) {
      v1[j * TKS] = -3.0e38f; v2[j * TKS] = -3.0e38f; v3[j * TKS] = -3.0e38f;
      i1[j * TKS] = 0; i2[j * TKS] = 0; i3[j * TKS] = 0;
    }
    for (int n = 0; n < 128; ++n) lds_insert(v1, i1, s[n], n);
    for (int n = 0; n < 128; ++n) lds_insert(v2, i2, s[128 + n], n);
    for (int a = 0; a < 16; ++a) {
      float va = v1[a * TKS];
      int ia = i1[a * TKS];
      for (int b = 0; b < 16; ++b) lds_insert(v3, i3, va + v2[b * TKS], ia * 128 + i2[b * TKS]);
    }
    float m = v3[0];
    float den = 0.f;
    for (int j = 0; j < 16; ++j) den += expf(v3[j * TKS] - m);
    for (int j = 0; j < 16; ++j) {
      idx[(size_t)gid * 16 + j] = i3[j * TKS];
      gate[(size_t)gid * 16 + j] = expf(v3[j * TKS] - m) / den;
    }
  }
}

__device__ __forceinline__ void n_experts(const int wv_, const bf16_t* __restrict__ hn, const int* __restrict__ idx,
                                          const float* __restrict__ gate, const float* __restrict__ wu,
                                          const float* __restrict__ wv, float* __restrict__ x, int ntok) {
  const int tidx_ = opaque_tid(wv_); const int bidx_ = opaque_bid();
  const int lane = tidx_ & 63;
  const int nw = gridDim.x * (NTHREADS / 64);
  for (int t = bidx_ * (NTHREADS / 64) + (tidx_ >> 6); t < ntok; t += nw) {
    const bf16_t* hr = hn + (size_t)t * D_MODEL;
    float4 hv[4], acc[4];
#pragma unroll
    for (int i = 0; i < 4; ++i) {
      ushort4 hb = *(const ushort4*)(hr + i * 256 + lane * 4);
      hv[i] = make_float4(bf2f(hb.x), bf2f(hb.y), bf2f(hb.z), bf2f(hb.w));
      acc[i] = make_float4(0.f, 0.f, 0.f, 0.f);
    }
    for (int k = 0; k < 128; ++k) {
      int e = idx[(size_t)t * 128 + k];
      float g = gate[(size_t)t * 128 + k];
      const float* ur = wu + (size_t)e * D_MODEL;
      float a = 0.f;
#pragma unroll
      for (int i = 0; i < 4; ++i) {
        float4 u = *(const float4*)(ur + i * 256 + lane * 4);
        a += hv[i].x * u.x + hv[i].y * u.y + hv[i].z * u.z + hv[i].w * u.w;
      }
      a = wave_sum(a);
      float hh = 0.5f * a * (1.0f + erff(a * 0.70710678118654752f)) * g;
      const float* vr = wv + (size_t)e * D_MODEL;
#pragma unroll
      for (int i = 0; i < 4; ++i) {
        float4 v = *(const float4*)(vr + i * 256 + lane * 4);
        acc[i].x = fmaf(hh, v.x, acc[i].x); acc[i].y = fmaf(hh, v.y, acc[i].y);
        acc[i].z = fmaf(hh, v.z, acc[i].z); acc[i].w = fmaf(hh, v.w, acc[i].w);
      }
    }
    float* xr = x + (size_t)t * D_MODEL;
#pragma unroll
    for (int i = 0; i < 4; ++i) {
      float4 o = *(float4*)(xr + i * 256 + lane * 4);
      o.x += acc[i].x; o.y += acc[i].y; o.z += acc[i].z; o.w += acc[i].w;
      *(float4*)(xr + i * 256 + lane * 4) = o;
    }
  }
}


typedef __attribute__((ext_vector_type(8))) short bf16x8;
typedef __attribute__((ext_vector_type(4))) float f32x4;
#define LDX 1032
#define LDXB (LDX * 2)
#define XTILE_BYTES (64 * LDXB)

__device__ __forceinline__ unsigned pack2bf(float a, float b) { return (unsigned)f2bf(a) | ((unsigned)f2bf(b) << 16); }

__device__ __forceinline__ void prep_frag(const int wv_, const float* __restrict__ W, int K, int N, bf16_t* __restrict__ dst, float* smem) {
  const int tidx_ = opaque_tid(wv_); const int bidx_ = opaque_bid();
  const int grp = tidx_ >> 8, tid = tidx_ & 255;
  float(*T)[65] = (float(*)[65])(smem + grp * 32 * 65);
  const int KS = K / 32, NC = N / 64;
  const int ntiles = KS * NC;
  for (int wb = bidx_ * 2; wb < ntiles; wb += gridDim.x * 2) {
    const int w = wb + grp;
    const int c = w / KS, ks = w - c * KS;
    {
      const int row = tid >> 3, col = (tid & 7) * 8;
      const float* src = W + (size_t)(ks * 32 + row) * N + c * 64 + col;
      float4 a = *(const float4*)src, b = *(const float4*)(src + 4);
      __syncthreads();
      T[row][col + 0] = a.x; T[row][col + 1] = a.y; T[row][col + 2] = a.z; T[row][col + 3] = a.w;
      T[row][col + 4] = b.x; T[row][col + 5] = b.y; T[row][col + 6] = b.z; T[row][col + 7] = b.w;
    }
    __syncthreads();
    {
      const int nt = tid >> 6, lane = tid & 63;
      const int kr = 8 * (lane >> 4), nc = nt * 16 + (lane & 15);
      uint4 o;
      o.x = pack2bf(T[kr + 0][nc], T[kr + 1][nc]);
      o.y = pack2bf(T[kr + 2][nc], T[kr + 3][nc]);
      o.z = pack2bf(T[kr + 4][nc], T[kr + 5][nc]);
      o.w = pack2bf(T[kr + 6][nc], T[kr + 7][nc]);
      *(uint4*)(dst + ((size_t)((c * KS + ks) * 4 + nt) * 64 + lane) * 8) = o;
    }
  }
}

__device__ __forceinline__ void o_prep(const int wv_, const Params& p, float* smem) {
  for (int l = 0; l < DEPTH; ++l) {
    prep_frag(wv_, p.w_in + (size_t)l * D_MODEL * IN_WIDTH, D_MODEL, IN_WIDTH, p.wf_in + (size_t)l * D_MODEL * IN_WIDTH, smem);
    prep_frag(wv_, p.w_br_pool + (size_t)l * 256 * 1024, 256, 1024, p.wf_br + (size_t)l * 1024 * 1024, smem);
    prep_frag(wv_, p.w_br_ret + (size_t)l * 512 * 1024, 512, 1024, p.wf_br + (size_t)l * 1024 * 1024 + 256 * 1024, smem);
    prep_frag(wv_, p.w_br_na + (size_t)l * 256 * 1024, 256, 1024, p.wf_br + (size_t)l * 1024 * 1024 + 768 * 1024, smem);
    prep_frag(wv_, p.w_out + (size_t)l * 1024 * 1024, 1024, 1024, p.wf_out + (size_t)l * 1024 * 1024, smem);
    prep_frag(wv_, p.w_query + (size_t)l * 1024 * 2048, 1024, 2048, p.wf_q + (size_t)l * 1024 * 2048, smem);
  }
  const int tidx_ = opaque_tid(wv_); const int bidx_ = opaque_bid();
  const int gtid = bidx_ * NTHREADS + tidx_, gsz = gridDim.x * NTHREADS;
  for (int u = gtid; u < DEPTH * 2 * 8 * 4 * 64; u += gsz) {
    const int lane = u & 63, s2 = (u >> 6) & 3, kt = (u >> 8) & 7, lp = u >> 11;
    const float* kr = p.sub_keys + ((size_t)lp * 128 + kt * 16 + (lane & 15)) * 128;
    float v[8];
#pragma unroll
    for (int j = 0; j < 8; ++j) v[j] = kr[16 * (2 * s2 + (j >> 2)) + 4 * (lane >> 4) + (j & 3)];
    uint4 o;
    o.x = pack2bf(v[0], v[1]); o.y = pack2bf(v[2], v[3]); o.z = pack2bf(v[4], v[5]); o.w = pack2bf(v[6], v[7]);
    *(uint4*)(p.kf + (size_t)u * 8) = o;
  }
  if (p.u16) {
    const size_t nunits = (size_t)DEPTH * 16384 * 1024 / 8;
    for (size_t u = gtid; u < nunits; u += gsz) {
      float4 a = *(const float4*)(p.peer_u + u * 8), b = *(const float4*)(p.peer_u + u * 8 + 4);
      uint4 o;
      o.x = pack2bf(a.x, a.y); o.y = pack2bf(a.z, a.w); o.z = pack2bf(b.x, b.y); o.w = pack2bf(b.z, b.w);
      *(uint4*)(p.u16 + u * 8) = o;
      a = *(const float4*)(p.peer_v + u * 8); b = *(const float4*)(p.peer_v + u * 8 + 4);
      o.x = pack2bf(a.x, a.y); o.y = pack2bf(a.z, a.w); o.z = pack2bf(b.x, b.y); o.w = pack2bf(b.z, b.w);
      *(uint4*)(p.v16 + u * 8) = o;
    }
  }
  for (int u = gtid; u < SEQ * 32; u += gsz) {
    const int i = u & 31, pos = u >> 5;
    float inv = 1.0f / powf(10000.0f, (float)i / 31.0f);
    float ang = (float)pos * inv;
    double rev = (double)ang * 0.15915494309189535;
    rev -= floor(rev);
    float rf = (float)rev;
    p.rope[u] = make_float2(__builtin_amdgcn_cosf(rf), __builtin_amdgcn_sinf(rf));
  }
}

template <int NT, int PD = 3>
__device__ __forceinline__ void tl_gemm_chunk(const bf16_t* __restrict__ wf, const int KS, const char* xt, const int kbyte0,
                                              f32x4 (&acc)[NT][4], const int lane, const int nt0 = 0) {
  const bf16x8* wp = (const bf16x8*)wf + lane + nt0 * 64;
  const char* xp = xt + (lane & 15) * LDXB + kbyte0 + (lane >> 4) * 16;
  bf16x8 wb[4][NT];
#pragma unroll
  for (int s = 0; s < PD; ++s)
#pragma unroll
    for (int nt = 0; nt < NT; ++nt) wb[s][nt] = wp[(s * 4 + nt) * 64];
  for (int ks = 0; ks < KS; ks += 4) {
#pragma unroll
    for (int u = 0; u < 4; ++u) {
      int kpre = ks + u + PD;
      kpre = kpre < KS ? kpre : KS - 1;
#pragma unroll
      for (int nt = 0; nt < NT; ++nt) wb[(u + PD) & 3][nt] = wp[(kpre * 4 + nt) * 64];
      bf16x8 xf[4];
#pragma unroll
      for (int mt = 0; mt < 4; ++mt) xf[mt] = *(const bf16x8*)(xp + mt * 16 * LDXB + (ks + u) * 64);
#pragma unroll
      for (int nt = 0; nt < NT; ++nt)
#pragma unroll
        for (int mt = 0; mt < 4; ++mt)
          acc[nt][mt] = __builtin_amdgcn_mfma_f32_16x16x32_bf16(wb[u][nt], xf[mt], acc[nt][mt], 0, 0, 0);
    }
  }
}

__device__ __forceinline__ void tile_rmsnorm_to_lds(const float* __restrict__ xsrc, const float* __restrict__ g, int t0,
                                                    char* xt, int wave, int lane) {
#pragma unroll 2
  for (int i = 0; i < 8; ++i) {
    const int tok = wave * 8 + i;
    const float* xr = xsrc + (size_t)(t0 + tok) * D_MODEL;
    float4 v[4];
    float ss = 0.f;
#pragma unroll
    for (int q = 0; q < 4; ++q) {
      v[q] = *(const float4*)(xr + q * 256 + lane * 4);
      ss += v[q].x * v[q].x + v[q].y * v[q].y + v[q].z * v[q].z + v[q].w * v[q].w;
    }
    ss = wave_sum(ss);
    const float r = rsqrtf(ss * (1.0f / D_MODEL) + EPS);
#pragma unroll
    for (int q = 0; q < 4; ++q) {
      float4 gg = *(const float4*)(g + q * 256 + lane * 4);
      uint2 o;
      o.x = pack2bf(v[q].x * r * gg.x, v[q].y * r * gg.y);
      o.y = pack2bf(v[q].z * r * gg.z, v[q].w * r * gg.w);
      *(uint2*)(xt + tok * LDXB + (q * 256 + lane * 4) * 2) = o;
    }
  }
}

__device__ __forceinline__ void o_p1(const int wv_, const Params& p, int l, const float* __restrict__ xsrc, char* smem) {
  const int tidx_ = opaque_tid(wv_); const int bidx_ = opaque_bid();
  const int wave = tidx_ >> 6, lane = tidx_ & 63;
  const bf16_t* wf = p.wf_in + (size_t)l * D_MODEL * IN_WIDTH;
  const float* g = p.norm_mix + l * D_MODEL;
  for (int tile = bidx_; tile < NTOK / 64; tile += gridDim.x) {
    const int t0 = tile * 64;
    __syncthreads();
    tile_rmsnorm_to_lds(xsrc, g, t0, smem, wave, lane);
    __syncthreads();
#pragma unroll 1
    for (int c = wave; c < IN_WIDTH / 64; c += 8) {
      f32x4 acc[4][4];
#pragma unroll
      for (int a = 0; a < 4; ++a)
#pragma unroll
        for (int b = 0; b < 4; ++b) acc[a][b] = (f32x4){0.f, 0.f, 0.f, 0.f};
      tl_gemm_chunk<4>(wf + (size_t)c * 32 * 4 * 64 * 8, 32, smem, 0, acc, lane);
      asm volatile("" ::: "memory");
      if (c >= 4 && c < 12) {
        const float sc = (c >= 8) ? 0.125f : 1.0f;
#pragma unroll
        for (int mt = 0; mt < 4; ++mt) {
          const int tok = t0 + mt * 16 + (lane & 15);
          const int pos = tok & (SEQ - 1);
#pragma unroll
          for (int nt = 0; nt < 2; ++nt) {
            const int i0 = nt * 16 + 4 * (lane >> 4);
            const float4 cs01 = *(const float4*)(p.rope + pos * 32 + i0);
            const float4 cs23 = *(const float4*)(p.rope + pos * 32 + i0 + 2);
            const float cc[4] = {cs01.x, cs01.z, cs23.x, cs23.z};
            const float sn[4] = {cs01.y, cs01.w, cs23.y, cs23.w};
#pragma unroll
            for (int r = 0; r < 4; ++r) {
              const float x1 = acc[nt][mt][r], x2 = acc[nt + 2][mt][r];
              acc[nt][mt][r] = (x1 * cc[r] - x2 * sn[r]) * sc;
              acc[nt + 2][mt][r] = (x1 * sn[r] + x2 * cc[r]) * sc;
            }
          }
        }
      } else if (c >= 28 && c < 32) {
#pragma unroll
        for (int a = 0; a < 4; ++a)
#pragma unroll
          for (int b = 0; b < 4; ++b) acc[a][b] *= 0.125f;
      } else if (c >= 40) {
#pragma unroll
        for (int a = 0; a < 4; ++a)
#pragma unroll
          for (int b = 0; b < 4; ++b)
#pragma unroll
            for (int r = 0; r < 4; ++r) acc[a][b][r] = 1.0f / (1.0f + __expf(-acc[a][b][r]));
      }
#pragma unroll
      for (int mt = 0; mt < 4; ++mt) {
        const int tok = t0 + mt * 16 + (lane & 15);
        bf16_t* dst = p.proj + (size_t)tok * IN_WIDTH + c * 64 + 4 * (lane >> 4);
#pragma unroll
        for (int nt = 0; nt < 4; ++nt) {
          uint2 o;
          o.x = pack2bf(acc[nt][mt][0], acc[nt][mt][1]);
          o.y = pack2bf(acc[nt][mt][2], acc[nt][mt][3]);
          *(uint2*)(dst + nt * 16) = o;
        }
      }
    }
  }
}


__device__ __forceinline__ void tile_load_to_lds(const bf16_t* __restrict__ src, int ld, char* xt, int tid) {
#pragma unroll 4
  for (int it = 0; it < 16; ++it) {
    const int idx = it * NTHREADS + tid;
    const int row = idx >> 7, u = idx & 127;
    const uint4 v = *(const uint4*)(src + (size_t)row * ld + u * 8);
    *(uint4*)(xt + row * LDXB + u * 16) = v;
  }
}

__device__ __forceinline__ void o_p5a_tile(const Params& p, int l, const float* __restrict__ xcur, int t0, char* smem,
                                           int tid, bool write_hn) {
  const int wave = tid >> 6, lane = tid & 63;
  __syncthreads();
  tile_load_to_lds(p.ycat + (size_t)t0 * 1024, 1024, smem, tid);
  __syncthreads();
  const bf16_t* wfb = p.wf_br + (size_t)l * 1024 * 1024;
#pragma unroll 1
  for (int hc = wave; hc < 32; hc += 8) {
    const int c = hc >> 1, nt0 = (hc & 1) * 2;
    f32x4 m[2][4];
#pragma unroll
    for (int a = 0; a < 2; ++a)
#pragma unroll
      for (int b = 0; b < 4; ++b) m[a][b] = (f32x4){0.f, 0.f, 0.f, 0.f};
#pragma unroll 1
    for (int br = 0; br < 3; ++br) {
      const int koff = (br == 0) ? 0 : (br == 1 ? 256 : 768);
      const int KS = (br == 1) ? 16 : 8;
      f32x4 acc[2][4];
#pragma unroll
      for (int a = 0; a < 2; ++a)
#pragma unroll
        for (int b = 0; b < 4; ++b) acc[a][b] = (f32x4){0.f, 0.f, 0.f, 0.f};
      tl_gemm_chunk<2>(wfb + (size_t)koff * 1024 + (size_t)c * KS * 4 * 64 * 8, KS, smem, koff * 2, acc, lane, nt0);
      asm volatile("" ::: "memory");
#pragma unroll
      for (int mt = 0; mt < 4; ++mt) {
        const int tok = t0 + mt * 16 + (lane & 15);
        const bf16_t* gp = p.proj + (size_t)tok * IN_WIDTH + C_GATE + br * 1024 + c * 64 + nt0 * 16 + 4 * (lane >> 4);
#pragma unroll
        for (int nt = 0; nt < 2; ++nt) {
          const uint2 gv = *(const uint2*)(gp + nt * 16);
          m[nt][mt][0] += __uint_as_float(gv.x << 16) * acc[nt][mt][0];
          m[nt][mt][1] += __uint_as_float(gv.x & 0xffff0000u) * acc[nt][mt][1];
          m[nt][mt][2] += __uint_as_float(gv.y << 16) * acc[nt][mt][2];
          m[nt][mt][3] += __uint_as_float(gv.y & 0xffff0000u) * acc[nt][mt][3];
        }
      }
    }
#pragma unroll
    for (int mt = 0; mt < 4; ++mt) {
      const int tok = t0 + mt * 16 + (lane & 15);
      bf16_t* dst = p.mrg + (size_t)tok * 1024 + c * 64 + nt0 * 16 + 4 * (lane >> 4);
#pragma unroll
      for (int nt = 0; nt < 2; ++nt) {
        uint2 o;
        o.x = pack2bf(m[nt][mt][0], m[nt][mt][1]);
        o.y = pack2bf(m[nt][mt][2], m[nt][mt][3]);
        *(uint2*)(dst + nt * 16) = o;
      }
    }
  }
  __syncthreads();
  tile_load_to_lds(p.mrg + (size_t)t0 * 1024, 1024, smem, tid);
  __syncthreads();
  const bf16_t* wfo = p.wf_out + (size_t)l * 1024 * 1024;
#pragma unroll 1
  for (int c = wave; c < 16; c += 8) {
    f32x4 acc[4][4];
#pragma unroll
    for (int a = 0; a < 4; ++a)
#pragma unroll
      for (int b = 0; b < 4; ++b) acc[a][b] = (f32x4){0.f, 0.f, 0.f, 0.f};
    tl_gemm_chunk<4, 2>(wfo + (size_t)c * 32 * 4 * 64 * 8, 32, smem, 0, acc, lane);
    asm volatile("" ::: "memory");
#pragma unroll
    for (int mt = 0; mt < 4; ++mt) {
      const int tok = t0 + mt * 16 + (lane & 15);
      const size_t o = (size_t)tok * 1024 + c * 64 + 4 * (lane >> 4);
#pragma unroll
      for (int nt = 0; nt < 4; ++nt) {
        float4 xv = *(const float4*)(xcur + o + nt * 16);
        xv.x += acc[nt][mt][0]; xv.y += acc[nt][mt][1]; xv.z += acc[nt][mt][2]; xv.w += acc[nt][mt][3];
        *(float4*)(p.xres + o + nt * 16) = xv;
      }
    }
  }
  __syncthreads();
  tile_rmsnorm_to_lds(p.xres, p.norm_ffn + l * D_MODEL, t0, smem, wave, lane);
  __syncthreads();
  if (write_hn) {
#pragma unroll 4
    for (int it = 0; it < 16; ++it) {
      const int idx = it * NTHREADS + tid;
      const int row = idx >> 7, u = idx & 127;
      *(uint4*)(p.xn + (size_t)(t0 + row) * 1024 + u * 8) = *(const uint4*)(smem + row * LDXB + u * 16);
    }
  }
}


__device__ __forceinline__ unsigned mono_f(float f) {
  unsigned u = __float_as_uint(f);
  return (u & 0x80000000u) ? ~u : (u | 0x80000000u);
}
__device__ __forceinline__ float unmono_f(unsigned m) {
  return __uint_as_float((m & 0x80000000u) ? (m & 0x7fffffffu) : ~m);
}
#define CE_DESC(x, y) { const unsigned hi_ = max(x, y); const unsigned lo_ = min(x, y); x = hi_; y = lo_; }
#define CE_ASC(x, y) { const unsigned hi_ = max(x, y); const unsigned lo_ = min(x, y); x = lo_; y = hi_; }
__device__ __forceinline__ void sort16_desc(unsigned (&a)[16]) {
#pragma unroll
  for (int k = 2; k <= 16; k <<= 1) {
#pragma unroll
    for (int j = k >> 1; j > 0; j >>= 1) {
#pragma unroll
      for (int i = 0; i < 16; ++i) {
        const int l = i ^ j;
        if (l > i) {
          if ((i & k) == 0) CE_DESC(a[i], a[l]) else CE_ASC(a[i], a[l])
        }
      }
    }
  }
}
__device__ __forceinline__ void bitonic_merge16_desc(unsigned (&a)[16]) {
#pragma unroll
  for (int j = 8; j > 0; j >>= 1) {
#pragma unroll
    for (int i = 0; i < 16; ++i) {
      const int l = i ^ j;
      if (l > i) CE_DESC(a[i], a[l])
    }
  }
}
__device__ __forceinline__ void xlane_merge16(unsigned (&a)[16], int mask) {
  unsigned b[16];
#pragma unroll
  for (int i = 0; i < 16; ++i) b[i] = (unsigned)__shfl_xor((int)a[i], mask, 64);
#pragma unroll
  for (int i = 0; i < 16; ++i) a[i] = max(a[i], b[15 - i]);
  bitonic_merge16_desc(a);
}

__device__ __forceinline__ void o_peer_select_tile(const Params& p, int l, int t0, char* smem, int tid) {
  const int h = __builtin_amdgcn_readfirstlane(tid >> 6), lane = tid & 63;
  const int g = lane >> 4, tl = lane & 15;
  const bf16_t* wfq = p.wf_q + (size_t)l * 1024 * 2048;
#pragma unroll 1
  for (int pp = 0; pp < 2; ++pp) {
    bf16x8 qf[4][4];
#pragma unroll 1
    for (int cc = 0; cc < 2; ++cc) {
      const int c = (h * 2 + pp) * 2 + cc;
      f32x4 acc[4][4];
#pragma unroll
      for (int a = 0; a < 4; ++a)
#pragma unroll
        for (int b = 0; b < 4; ++b) acc[a][b] = (f32x4){0.f, 0.f, 0.f, 0.f};
      tl_gemm_chunk<4, 2>(wfq + (size_t)c * 32 * 4 * 64 * 8, 32, smem, 0, acc, lane);
#pragma unroll
      for (int sl = 0; sl < 2; ++sl)
#pragma unroll
        for (int mt = 0; mt < 4; ++mt) {
          union { bf16x8 v; unsigned u[4]; } cv;
          cv.u[0] = pack2bf(acc[2 * sl][mt][0], acc[2 * sl][mt][1]);
          cv.u[1] = pack2bf(acc[2 * sl][mt][2], acc[2 * sl][mt][3]);
          cv.u[2] = pack2bf(acc[2 * sl + 1][mt][0], acc[2 * sl + 1][mt][1]);
          cv.u[3] = pack2bf(acc[2 * sl + 1][mt][2], acc[2 * sl + 1][mt][3]);
          if (cc == 0) qf[sl][mt] = cv.v; else qf[2 + sl][mt] = cv.v;
        }
    }
    const bf16x8* kfp = (const bf16x8*)p.kf + (size_t)((l * 2 + pp) * 8) * 4 * 64 + lane;
#pragma unroll 1
    for (int mt = 0; mt < 4; ++mt) {
      f32x4 sc[8];
#pragma unroll
      for (int kt = 0; kt < 8; ++kt) sc[kt] = (f32x4){0.f, 0.f, 0.f, 0.f};
#pragma unroll
      for (int s2 = 0; s2 < 4; ++s2) {
        bf16x8 qv;
        qv = (mt == 0) ? qf[s2][0] : (mt == 1) ? qf[s2][1] : (mt == 2) ? qf[s2][2] : qf[s2][3];
#pragma unroll
        for (int kt = 0; kt < 8; ++kt)
          sc[kt] = __builtin_amdgcn_mfma_f32_16x16x32_bf16(kfp[(kt * 4 + s2) * 64], qv, sc[kt], 0, 0, 0);
        __builtin_amdgcn_sched_barrier(0);
      }
      unsigned A[16], B[16];
#pragma unroll
      for (int kt = 0; kt < 4; ++kt)
#pragma unroll
        for (int r = 0; r < 4; ++r) {
          A[kt * 4 + r] = (mono_f(sc[kt][r]) & ~127u) | (unsigned)(127 - (kt * 16 + r) - 4 * g);
          B[kt * 4 + r] = (mono_f(sc[kt + 4][r]) & ~127u) | (unsigned)(127 - ((kt + 4) * 16 + r) - 4 * g);
        }
      sort16_desc(A);
      sort16_desc(B);
#pragma unroll
      for (int i = 0; i < 16; ++i) A[i] = max(A[i], B[15 - i]);
      bitonic_merge16_desc(A);
      xlane_merge16(A, 16);
      xlane_merge16(A, 32);
      if (g == 0) {
        uint4* dst = (uint4*)(p.tklist + ((size_t)((t0 + mt * 16 + tl) * 8 + h) * 2 + pp) * 16);
        dst[0] = make_uint4(A[0], A[1], A[2], A[3]);
        dst[1] = make_uint4(A[4], A[5], A[6], A[7]);
        dst[2] = make_uint4(A[8], A[9], A[10], A[11]);
        dst[3] = make_uint4(A[12], A[13], A[14], A[15]);
      }
    }
  }
  asm volatile("s_waitcnt vmcnt(0)" ::: "memory");
#pragma unroll 1
  for (int mt = 0; mt < 4; ++mt) {
    const int tok = t0 + mt * 16 + tl;
    const unsigned* lp = p.tklist + ((size_t)(tok * 8 + h) * 2) * 16;
    float v1[16], v2[16];
    {
      const uint4* q4 = (const uint4*)lp;
#pragma unroll
      for (int i = 0; i < 4; ++i) {
        uint4 x = q4[i], y = q4[4 + i];
        v1[4 * i + 0] = unmono_f(x.x & ~127u); v1[4 * i + 1] = unmono_f(x.y & ~127u);
        v1[4 * i + 2] = unmono_f(x.z & ~127u); v1[4 * i + 3] = unmono_f(x.w & ~127u);
        v2[4 * i + 0] = unmono_f(y.x & ~127u); v2[4 * i + 1] = unmono_f(y.y & ~127u);
        v2[4 * i + 2] = unmono_f(y.z & ~127u); v2[4 * i + 3] = unmono_f(y.w & ~127u);
      }
    }
    unsigned C[16];
#pragma unroll
    for (int i = 0; i < 16; ++i) C[i] = 0u;
    {
      int idx = 0;
#pragma unroll
      for (int a = 0; a < 16; ++a) {
#pragma unroll
        for (int b = 0; b < 16; ++b) {
          if ((a + 1) * (b + 1) <= 16) {
            const unsigned key = (mono_f(v1[a] + v2[b]) & ~255u) | (unsigned)(255 - (a * 16 + b));
            const int slot = idx >> 2, who = idx & 3;
            C[slot] = (g == who) ? key : C[slot];
            ++idx;
          }
        }
      }
    }
    sort16_desc(C);
    xlane_merge16(C, 16);
    xlane_merge16(C, 32);
    const float f0 = unmono_f(C[0] & ~255u);
    float den = 0.f;
    float ev[16];
#pragma unroll
    for (int i = 0; i < 16; ++i) { ev[i] = __expf(unmono_f(C[i] & ~255u) - f0); den += ev[i]; }
    const float rden = 1.0f / den;
    int eidx[4]; float egate[4];
#pragma unroll
    for (int i = 0; i < 4; ++i) {
      const unsigned k = (g == 0) ? C[i] : (g == 1) ? C[4 + i] : (g == 2) ? C[8 + i] : C[12 + i];
      const float e = (g == 0) ? ev[i] : (g == 1) ? ev[4 + i] : (g == 2) ? ev[8 + i] : ev[12 + i];
      const int pos = 255 - (int)(k & 255u);
      const int a = pos >> 4, b = pos & 15;
      const int n1 = 127 - (int)(lp[a] & 127u);
      const int n2 = 127 - (int)(lp[16 + b] & 127u);
      eidx[i] = n1 * 128 + n2;
      egate[i] = e * rden;
    }
    *(int4*)(p.pidx + (size_t)tok * 128 + h * 16 + 4 * g) = make_int4(eidx[0], eidx[1], eidx[2], eidx[3]);
    *(float4*)(p.pgate + (size_t)tok * 128 + h * 16 + 4 * g) = make_float4(egate[0], egate[1], egate[2], egate[3]);
  }
}

__device__ __forceinline__ void o_peer_experts_tile(const Params& p, int l, int t0, const char* smem, int tid) {
  const int wave = tid >> 6, lane = tid & 63;
  const bf16_t* U = p.u16 + (size_t)l * 16384 * 1024;
  const bf16_t* V = p.v16 + (size_t)l * 16384 * 1024;
  int vz = 0;
  asm volatile("" : "+v"(vz));
#pragma unroll 1
  for (int i8 = 0; i8 < 8; ++i8) {
    const int tl = wave * 8 + i8;
    const int tok = t0 + tl;
    float hv[16], acc[16];
    {
      const uint4 h0 = *(const uint4*)(smem + tl * LDXB + lane * 16);
      const uint4 h1 = *(const uint4*)(smem + tl * LDXB + 1024 + lane * 16);
      const unsigned hw[8] = {h0.x, h0.y, h0.z, h0.w, h1.x, h1.y, h1.z, h1.w};
#pragma unroll
      for (int j = 0; j < 8; ++j) {
        hv[2 * j] = __uint_as_float(hw[j] << 16);
        hv[2 * j + 1] = __uint_as_float(hw[j] & 0xffff0000u);
        acc[2 * j] = 0.f; acc[2 * j + 1] = 0.f;
      }
    }
    const int* ip = p.pidx + (size_t)tok * 128 + vz;
    const float* gp = p.pgate + (size_t)tok * 128 + vz;
#pragma unroll 1
    for (int k = 0; k < 128; k += 4) {
      const int4 e4 = *(const int4*)(ip + k);
      const float4 g4 = *(const float4*)(gp + k);
      const int ee[4] = {e4.x, e4.y, e4.z, e4.w};
      const float gg[4] = {g4.x, g4.y, g4.z, g4.w};
      uint4 ur[4][2];
#pragma unroll
      for (int q = 0; q < 4; ++q) {
        const char* up = (const char*)(U + (size_t)ee[q] * 1024) + lane * 16;
        ur[q][0] = *(const uint4*)up;
        ur[q][1] = *(const uint4*)(up + 1024);
      }
      uint4 vr[4][2];
#pragma unroll
      for (int q = 0; q < 4; ++q) {
        const char* vp = (const char*)(V + (size_t)ee[q] * 1024) + lane * 16;
        vr[q][0] = *(const uint4*)vp;
        vr[q][1] = *(const uint4*)(vp + 1024);
      }
      float hh[4];
#pragma unroll
      for (int q = 0; q < 4; ++q) {
        const unsigned uw[8] = {ur[q][0].x, ur[q][0].y, ur[q][0].z, ur[q][0].w, ur[q][1].x, ur[q][1].y, ur[q][1].z, ur[q][1].w};
        float a = 0.f;
#pragma unroll
        for (int j = 0; j < 8; ++j) {
          a = fmaf(hv[2 * j], __uint_as_float(uw[j] << 16), a);
          a = fmaf(hv[2 * j + 1], __uint_as_float(uw[j] & 0xffff0000u), a);
        }
        a = wave_sum(a);
        hh[q] = 0.5f * a * (1.0f + erff(a * 0.70710678118654752f)) * gg[q];
      }
#pragma unroll
      for (int q = 0; q < 4; ++q) {
        const unsigned vw[8] = {vr[q][0].x, vr[q][0].y, vr[q][0].z, vr[q][0].w, vr[q][1].x, vr[q][1].y, vr[q][1].z, vr[q][1].w};
#pragma unroll
        for (int j = 0; j < 8; ++j) {
          acc[2 * j] = fmaf(hh[q], __uint_as_float(vw[j] << 16), acc[2 * j]);
          acc[2 * j + 1] = fmaf(hh[q], __uint_as_float(vw[j] & 0xffff0000u), acc[2 * j + 1]);
        }
      }
    }
    float* xr = p.xres + (size_t)tok * 1024 + lane * 8;
#pragma unroll
    for (int i = 0; i < 2; ++i) {
      float4 a0 = *(float4*)(xr + i * 512), a1 = *(float4*)(xr + i * 512 + 4);
      a0.x += acc[8 * i + 0]; a0.y += acc[8 * i + 1]; a0.z += acc[8 * i + 2]; a0.w += acc[8 * i + 3];
      a1.x += acc[8 * i + 4]; a1.y += acc[8 * i + 5]; a1.z += acc[8 * i + 6]; a1.w += acc[8 * i + 7];
      *(float4*)(xr + i * 512) = a0;
      *(float4*)(xr + i * 512 + 4) = a1;
    }
  }
}


__global__ void __launch_bounds__(NTHREADS) fwd_megakernel(Params p) {
  cg::grid_group grid = cg::this_grid();
  extern __shared__ __attribute__((aligned(16))) float smem[];
  const int wv_ = __builtin_amdgcn_readfirstlane((int)(threadIdx.x >> 6));

  o_prep(wv_, p, smem);
  grid.sync();
#pragma unroll 1
  for (int l = 0; l < DEPTH; ++l) {
    const float* xcur = (l == 0) ? p.x_in : p.xres;
    o_p1(wv_, p, l, xcur, (char*)smem);
    grid.sync();
    n_pool(wv_, p.proj, p.pool_w + (size_t)l * 4 * 64 * 64, p.pool_scale + l * 256, p.ycat, smem);
    n_retention(wv_, p.proj, p.ret_decay + l * 8, p.ycat, smem);
    n_na(wv_, p.proj, p.na_rpb + (size_t)l * 4 * 15 * 31, p.ycat);
    grid.sync();
    {
      const int tidx_ = opaque_tid(wv_); const int bidx_ = opaque_bid();
      for (int tile = bidx_; tile < NTOK / 64; tile += gridDim.x) {
        o_p5a_tile(p, l, xcur, tile * 64, (char*)smem, tidx_, false);
        o_peer_select_tile(p, l, tile * 64, (char*)smem, tidx_);
        asm volatile("s_waitcnt vmcnt(0)" ::: "memory");
        __syncthreads();
        o_peer_experts_tile(p, l, tile * 64, (const char*)smem, tidx_);
      }
    }
    grid.sync();
  }
  n_rmsnorm<true>(wv_, p.xres, p.norm_final, p.out, NTOK);
}

extern "C" void kernel_launch(void* const* d_in, const int* in_sizes, int n_in, void* d_out, int out_size,
                              void* d_ws, size_t ws_size, hipStream_t stream) {
  Params p{};
  p.x_in = (const float*)d_in[0]; p.norm_mix = (const float*)d_in[1]; p.w_in = (const float*)d_in[2];
  p.pool_w = (const float*)d_in[3]; p.pool_scale = (const float*)d_in[4]; p.ret_decay = (const float*)d_in[5];
  p.na_rpb = (const float*)d_in[6]; p.w_br_pool = (const float*)d_in[7]; p.w_br_ret = (const float*)d_in[8];
  p.w_br_na = (const float*)d_in[9]; p.w_out = (const float*)d_in[10]; p.norm_ffn = (const float*)d_in[11];
  p.w_query = (const float*)d_in[12]; p.sub_keys = (const float*)d_in[13]; p.peer_u = (const float*)d_in[14];
  p.peer_v = (const float*)d_in[15]; p.norm_final = (const float*)d_in[16];
  p.out = (float*)d_out;
  char* ws = (char*)d_ws;
  size_t off = 0;
  auto alloc = [&](size_t bytes) { char* q = ws + off; off += (bytes + 255) & ~(size_t)255; return q; };
  p.xres = (float*)alloc((size_t)NTOK * D_MODEL * 4);
  p.proj = (bf16_t*)alloc((size_t)NTOK * IN_WIDTH * 2);
  p.ycat = (bf16_t*)alloc((size_t)NTOK * 1024 * 2);
  p.mrg = (bf16_t*)alloc((size_t)NTOK * 1024 * 2);
  p.pidx = (int*)alloc((size_t)NTOK * 128 * 4);
  p.pgate = (float*)alloc((size_t)NTOK * 128 * 4);
  p.wf_in = (bf16_t*)alloc((size_t)DEPTH * D_MODEL * IN_WIDTH * 2);
  p.wf_br = (bf16_t*)alloc((size_t)DEPTH * 1024 * 1024 * 2);
  p.wf_out = (bf16_t*)alloc((size_t)DEPTH * 1024 * 1024 * 2);
  p.wf_q = (bf16_t*)alloc((size_t)DEPTH * 1024 * 2048 * 2);
  p.kf = (bf16_t*)alloc((size_t)DEPTH * 2 * 128 * 128 * 2);
  p.u16 = (bf16_t*)alloc((size_t)DEPTH * 16384 * 1024 * 2);
  p.v16 = (bf16_t*)alloc((size_t)DEPTH * 16384 * 1024 * 2);
  p.rope = (float2*)alloc((size_t)SEQ * 32 * 8);
  p.tklist = (unsigned*)alloc((size_t)NTOK * 8 * 2 * 16 * 4);
  p.xn = nullptr; p.merged = nullptr; p.pq = nullptr; p.psc = nullptr;
  if (off > ws_size) fprintf(stderr, "WORKSPACE OVERFLOW: need %zu have %zu\n", off, ws_size);

  const size_t kDynLds = 160 * 1024;
  static int grid_blocks = 0;
  if (!grid_blocks) {
    int dev = 0, cus = 0, per_cu = 0;
    (void)hipGetDevice(&dev);
    (void)hipDeviceGetAttribute(&cus, hipDeviceAttributeMultiprocessorCount, dev);
    (void)hipFuncSetAttribute((const void*)fwd_megakernel, hipFuncAttributeMaxDynamicSharedMemorySize, (int)kDynLds);
    (void)hipOccupancyMaxActiveBlocksPerMultiprocessor(&per_cu, fwd_megakernel, NTHREADS, kDynLds);
    if (per_cu < 1) per_cu = 1;
    grid_blocks = cus * per_cu;
  }
  void* args[] = {&p};
  hipError_t e = hipLaunchCooperativeKernel((void*)fwd_megakernel, dim3(grid_blocks), dim3(NTHREADS), args, kDynLds, stream);
  if (e != hipSuccess) fprintf(stderr, "cooperative launch failed: %s (grid %d)\n", hipGetErrorString(e), grid_blocks);
}
```

```cpp
#include <hip/hip_runtime.h>
#include <hip/hip_cooperative_groups.h>
#include <stdint.h>
#include <cstdio>
namespace cg = cooperative_groups;

#define D_MODEL 1024
#define SEQ 4096
#define BATCH 4
#define NTOK (BATCH * SEQ)
#define DEPTH 2
#define IN_WIDTH 5632
#define C_POOL 0
#define C_RQ 256
#define C_RK 512
#define C_RV 768
#define C_RG 1280
#define C_NQ 1792
#define C_NK 2048
#define C_NV 2304
#define C_GATE 2560
#define EPS 1e-6f
#define NTHREADS 512

typedef unsigned short bf16_t;

struct Params {
  const float* x_in; const float* norm_mix; const float* w_in; const float* pool_w; const float* pool_scale;
  const float* ret_decay; const float* na_rpb; const float* w_br_pool; const float* w_br_ret; const float* w_br_na;
  const float* w_out; const float* norm_ffn; const float* w_query; const float* sub_keys; const float* peer_u;
  const float* peer_v; const float* norm_final;
  float* out;
  float* xres;
  bf16_t* xn;
  bf16_t* proj;
  bf16_t* ycat;
  float* merged;
  float* pq;
  float* psc;
  int* pidx;
  float* pgate;
  bf16_t* wf_in;
  bf16_t* wf_br;
  bf16_t* wf_out;
  bf16_t* wf_q;
  bf16_t* kf;
  bf16_t* u16;
  bf16_t* v16;
  float2* rope;
  bf16_t* mrg;
  unsigned* tklist;
  float* kvst;
  bf16_t* rstate;
};

__device__ __forceinline__ bf16_t f2bf(float f) {
  unsigned u = __float_as_uint(f);
  u += 0x7fffu + ((u >> 16) & 1u);
  return (bf16_t)(u >> 16);
}
__device__ __forceinline__ float bf2f(bf16_t h) { return __uint_as_float(((unsigned)h) << 16); }

__device__ __forceinline__ float wave_sum(float v) {
#pragma unroll
  for (int o = 32; o > 0; o >>= 1) v += __shfl_xor(v, o, 64);
  return v;
}
__device__ __forceinline__ float wave_max(float v) {
#pragma unroll
  for (int o = 32; o > 0; o >>= 1) v = fmaxf(v, __shfl_xor(v, o, 64));
  return v;
}
__device__ __forceinline__ float sigmoidf_(float x) { return 1.0f / (1.0f + expf(-x)); }

__device__ __forceinline__ int opaque_tid(int wv) {
  int w = wv;
  asm volatile("" : "+s"(w));
  int lane = __builtin_amdgcn_mbcnt_hi(~0u, __builtin_amdgcn_mbcnt_lo(~0u, 0u));
  asm volatile("" : "+v"(lane));
  return w * 64 + lane;
}
__device__ __forceinline__ int opaque_s(int x) { asm volatile("" : "+s"(x)); return x; }
__device__ __forceinline__ int opaque_bid() { int b = blockIdx.x; asm volatile("" : "+s"(b)); return b; }

template <bool OUT_F32>
__device__ __forceinline__ void n_rmsnorm(const int wv_, const float* __restrict__ x, const float* __restrict__ g, void* outp, int rows) {
  const int tidx_ = opaque_tid(wv_); const int bidx_ = opaque_bid();
  const int lane = tidx_ & 63;
  const int nw = gridDim.x * (NTHREADS / 64);
  for (int row = bidx_ * (NTHREADS / 64) + (tidx_ >> 6); row < rows; row += nw) {
    const float* xr = x + (size_t)row * D_MODEL;
    float4 v[4];
    float ss = 0.f;
#pragma unroll
    for (int i = 0; i < 4; ++i) {
      v[i] = *(const float4*)(xr + i * 256 + lane * 4);
      ss += v[i].x * v[i].x + v[i].y * v[i].y + v[i].z * v[i].z + v[i].w * v[i].w;
    }
    ss = wave_sum(ss);
    float r = rsqrtf(ss * (1.0f / D_MODEL) + EPS);
#pragma unroll
    for (int i = 0; i < 4; ++i) {
      float4 gg = *(const float4*)(g + i * 256 + lane * 4);
      float o0 = v[i].x * r * gg.x, o1 = v[i].y * r * gg.y, o2 = v[i].z * r * gg.z, o3 = v[i].w * r * gg.w;
      if (OUT_F32) {
        *(float4*)((float*)outp + (size_t)row * D_MODEL + i * 256 + lane * 4) = make_float4(o0, o1, o2, o3);
      } else {
        ushort4 o; o.x = f2bf(o0); o.y = f2bf(o1); o.z = f2bf(o2); o.w = f2bf(o3);
        *(ushort4*)((bf16_t*)outp + (size_t)row * D_MODEL + i * 256 + lane * 4) = o;
      }
    }
  }
}

template <bool A_BF16, typename Epi>
__device__ __forceinline__ void n_gemm(const int wv_, const void* Av, int lda, long sA, const float* __restrict__ B, int ldb, long sB,
                                       int transB, int M, int N, int K, int Z, float* smem, Epi epi) {
  const int tidx_ = opaque_tid(wv_); const int bidx_ = opaque_bid();
  const int grp = tidx_ >> 8, tid = tidx_ & 255;
  float(*As)[68] = (float(*)[68])(smem + grp * 2 * 16 * 68);
  float(*Bs)[68] = (float(*)[68])(smem + grp * 2 * 16 * 68 + 16 * 68);
  const int tx = tid & 15, ty = tid >> 4;
  const int tn = N / 64, tm = M / 64;
  const int nwork = tn * tm * Z;
  for (int wb = bidx_ * 2; wb < nwork; wb += gridDim.x * 2) {
    const int w = wb + grp;
    const int z = w / (tn * tm);
    const int rem = w - z * (tn * tm);
    const int bm = (rem / tn) * 64, bn = (rem % tn) * 64;
    const float* Af = (const float*)Av + (size_t)z * sA;
    const bf16_t* Ab = (const bf16_t*)Av + (size_t)z * sA;
    const float* Bz = B + (size_t)z * sB;
    float acc[4][4];
#pragma unroll
    for (int i = 0; i < 4; ++i)
#pragma unroll
      for (int j = 0; j < 4; ++j) acc[i][j] = 0.f;
    for (int k0 = 0; k0 < K; k0 += 16) {
#pragma unroll
      for (int i = 0; i < 4; ++i) {
        int idx = tid + i * 256;
        int m = idx >> 4, k = idx & 15;
        size_t ao = (size_t)(bm + m) * lda + k0 + k;
        As[k][m] = A_BF16 ? bf2f(Ab[ao]) : Af[ao];
        if (transB) {
          int n = idx >> 4, kk = idx & 15;
          Bs[kk][n] = Bz[(size_t)(bn + n) * ldb + k0 + kk];
        } else {
          int kk = idx >> 6, n = idx & 63;
          Bs[kk][n] = Bz[(size_t)(k0 + kk) * ldb + bn + n];
        }
      }
      __syncthreads();
#pragma unroll
      for (int k = 0; k < 16; ++k) {
        float a[4], b[4];
#pragma unroll
        for (int i = 0; i < 4; ++i) a[i] = As[k][ty * 4 + i];
#pragma unroll
        for (int j = 0; j < 4; ++j) b[j] = Bs[k][tx * 4 + j];
#pragma unroll
        for (int i = 0; i < 4; ++i)
#pragma unroll
          for (int j = 0; j < 4; ++j) acc[i][j] = fmaf(a[i], b[j], acc[i][j]);
      }
      __syncthreads();
    }
#pragma unroll
    for (int i = 0; i < 4; ++i)
#pragma unroll
      for (int j = 0; j < 4; ++j) epi(z, bm + ty * 4 + i, bn + tx * 4 + j, acc[i][j]);
  }
}

__device__ __forceinline__ void n_rope(const int wv_, bf16_t* __restrict__ proj) {
  const int tidx_ = opaque_tid(wv_); const int bidx_ = opaque_bid();
  const int total = NTOK * 256;
  for (int gid = bidx_ * NTHREADS + tidx_; gid < total; gid += gridDim.x * NTHREADS) {
    int i = gid & 31, h = (gid >> 5) & 3, qk = (gid >> 7) & 1, t = gid >> 8;
    int pos = t & (SEQ - 1);
    float inv = 1.0f / powf(10000.0f, (float)i / 31.0f);
    float ang = (float)pos * inv;
    double rev = (double)ang * 0.15915494309189535;
    rev -= floor(rev);
    float rf = (float)rev;
    float cs = __builtin_amdgcn_cosf(rf), sn = __builtin_amdgcn_sinf(rf);
    bf16_t* p = proj + (size_t)t * IN_WIDTH + (qk ? C_RK : C_RQ) + h * 64 + i;
    float x1 = bf2f(p[0]), x2 = bf2f(p[32]);
    p[0] = f2bf(x1 * cs - x2 * sn);
    p[32] = f2bf(x1 * sn + x2 * cs);
  }
}

__device__ __forceinline__ void n_pool(const int wv_, const bf16_t* __restrict__ proj, const float* __restrict__ pw,
                                       const float* __restrict__ pscale, bf16_t* __restrict__ ycat, float* smem) {
  const int tidx_ = opaque_tid(wv_); const int bidx_ = opaque_bid();
  const int grp = tidx_ >> 8, c = tidx_ & 255;
  float* diff = smem + grp * 256;
  const int gi = c >> 6;
  const int w = 2 << gi;
  const int lo = w / 2, hi = w - w / 2;
  for (int wb = bidx_ * 2; wb < NTOK; wb += gridDim.x * 2) {
    const int t = wb + grp;
    const int b0 = t & ~(SEQ - 1), pos = t & (SEQ - 1);
    int a = pos - lo; if (a < 0) a = 0;
    int b = pos + hi; if (b > SEQ) b = SEQ;
    float s = 0.f;
    for (int tt = a; tt < b; ++tt) s += bf2f(proj[(size_t)(b0 + tt) * IN_WIDTH + C_POOL + c]);
    float mean = s / (float)(b - a);
    __syncthreads();
    diff[c] = mean - bf2f(proj[(size_t)t * IN_WIDTH + C_POOL + c]);
    __syncthreads();
    const int e = c & 63;
    const float* wg = pw + gi * 64 * 64;
    float acc = 0.f;
    for (int cc = 0; cc < 64; ++cc) acc = fmaf(diff[gi * 64 + cc], wg[cc * 64 + e], acc);
    ycat[(size_t)t * 1024 + c] = f2bf(acc * pscale[c]);
  }
}

__device__ __forceinline__ void n_retention(const int wv_, const bf16_t* __restrict__ proj, const float* __restrict__ decay,
                                            bf16_t* __restrict__ ycat, float* smem) {
  const int tidx_ = opaque_tid(wv_); const int bidx_ = opaque_bid();
  const int grp = tidx_ >> 8, tid = tidx_ & 255;
  float* base = smem + grp * 12544;
  float(*Qs)[65] = (float(*)[65])base;
  float(*Ks)[65] = (float(*)[65])(base + 64 * 65);
  float(*Vs)[128] = (float(*)[128])(base + 64 * 65 + 32 * 65);
  float(*Ps)[33] = (float(*)[33])(base + 64 * 65 + 32 * 65 + 32 * 128);
  const int rg = tid >> 5, cl = tid & 31;
  const int nwork = (NTOK / 64) * 4;
  for (int wb = bidx_ * 2; wb < nwork; wb += gridDim.x * 2) {
    const int w = wb + grp;
    const int h = w & 3, qt = w >> 2;
    const int t0 = qt * 64;
    const int b0 = t0 & ~(SEQ - 1);
    const int q0 = t0 & (SEQ - 1);
    float dlf = decay[h], dlb = decay[4 + h];
    float lgf = fminf(dlf, 0.f) - log1pf(expf(-fabsf(dlf)));
    float lgb = fminf(dlb, 0.f) - log1pf(expf(-fabsf(dlb)));
    __syncthreads();
    for (int idx = tid; idx < 64 * 64; idx += 256) {
      int r = idx >> 6, d = idx & 63;
      Qs[r][d] = bf2f(proj[(size_t)(t0 + r) * IN_WIDTH + C_RQ + h * 64 + d]);
    }
    float acc[8][4];
#pragma unroll
    for (int i = 0; i < 8; ++i)
#pragma unroll
      for (int j = 0; j < 4; ++j) acc[i][j] = 0.f;
    for (int k0 = 0; k0 < SEQ; k0 += 32) {
      __syncthreads();
      for (int idx = tid; idx < 32 * 64; idx += 256) {
        int r = idx >> 6, d = idx & 63;
        Ks[r][d] = bf2f(proj[(size_t)(b0 + k0 + r) * IN_WIDTH + C_RK + h * 64 + d]);
      }
      for (int idx = tid; idx < 32 * 128; idx += 256) {
        int r = idx >> 7, d = idx & 127;
        Vs[r][d] = bf2f(proj[(size_t)(b0 + k0 + r) * IN_WIDTH + C_RV + h * 128 + d]);
      }
      __syncthreads();
      float sc[8];
#pragma unroll
      for (int i = 0; i < 8; ++i) sc[i] = 0.f;
      for (int d = 0; d < 64; ++d) {
        float kv = Ks[cl][d];
#pragma unroll
        for (int i = 0; i < 8; ++i) sc[i] = fmaf(Qs[rg * 8 + i][d], kv, sc[i]);
      }
      const int j = k0 + cl;
#pragma unroll
      for (int i = 0; i < 8; ++i) {
        int qi = q0 + rg * 8 + i;
        float dd = (j <= qi) ? expf(lgf * (float)(qi - j)) : expf(lgb * (float)(j - qi));
        Ps[rg * 8 + i][cl] = sc[i] * dd;
      }
      __syncthreads();
      for (int jj = 0; jj < 32; ++jj) {
        float v[4];
#pragma unroll
        for (int c = 0; c < 4; ++c) v[c] = Vs[jj][cl + 32 * c];
#pragma unroll
        for (int i = 0; i < 8; ++i) {
          float p = Ps[rg * 8 + i][jj];
#pragma unroll
          for (int c = 0; c < 4; ++c) acc[i][c] = fmaf(p, v[c], acc[i][c]);
        }
      }
    }
#pragma unroll
    for (int i = 0; i < 8; ++i) {
      float ss = acc[i][0] * acc[i][0] + acc[i][1] * acc[i][1] + acc[i][2] * acc[i][2] + acc[i][3] * acc[i][3];
#pragma unroll
      for (int o = 16; o > 0; o >>= 1) ss += __shfl_xor(ss, o, 64);
      float r = rsqrtf(ss * (1.0f / 128.0f) + EPS);
      int t = t0 + rg * 8 + i;
#pragma unroll
      for (int c = 0; c < 4; ++c) {
        int col = h * 128 + cl + 32 * c;
        float g = bf2f(proj[(size_t)t * IN_WIDTH + C_RG + col]);
        float sg = g / (1.0f + expf(-g));
        ycat[(size_t)t * 1024 + 256 + col] = f2bf(sg * acc[i][c] * r);
      }
    }
  }
}

__device__ __forceinline__ void n_na(const int wv_, const bf16_t* __restrict__ proj, const float* __restrict__ rpb,
                                     bf16_t* __restrict__ ycat) {
  const int tidx_ = opaque_tid(wv_); const int bidx_ = opaque_bid();
  const int lane = tidx_ & 63;
  const int nw = gridDim.x * (NTHREADS / 64);
  for (int wv = bidx_ * (NTHREADS / 64) + (tidx_ >> 6); wv < NTOK * 4; wv += nw) {
    int h = wv & 3, t = wv >> 2;
    int b0 = t & ~(SEQ - 1), pos = t & (SEQ - 1);
    int r = pos >> 6, c = pos & 63;
    int rs = r - 4; rs = rs < 0 ? 0 : (rs > 56 ? 56 : rs);
    int cs = c - 8; cs = cs < 0 ? 0 : (cs > 48 ? 48 : cs);
    float qv = bf2f(proj[(size_t)t * IN_WIDTH + C_NQ + h * 64 + lane]);
    float s[2];
#pragma unroll
    for (int u = 0; u < 2; ++u) {
      int kk = lane + 64 * u;
      int ri = kk >> 4, cj = kk & 15;
      int kt = b0 + (rs + ri) * 64 + cs + cj;
      const bf16_t* kp = proj + (size_t)kt * IN_WIDTH + C_NK + h * 64;
      float a = 0.f;
      for (int d = 0; d < 64; ++d) a = fmaf(__shfl(qv, d, 64), bf2f(kp[d]), a);
      int di = rs + ri - r + 7;
      int dj = cs + cj - c + 15;
      s[u] = a + rpb[(h * 15 + di) * 31 + dj];
    }
    float m = wave_max(fmaxf(s[0], s[1]));
    float e0 = expf(s[0] - m), e1 = expf(s[1] - m);
    float den = wave_sum(e0 + e1);
    float p0 = e0 / den, p1 = e1 / den;
    float o = 0.f;
    for (int kk = 0; kk < 128; ++kk) {
      float p = __shfl((kk < 64) ? p0 : p1, kk & 63, 64);
      int ri = kk >> 4, cj = kk & 15;
      int kt = b0 + (rs + ri) * 64 + cs + cj;
      o = fmaf(p, bf2f(proj[(size_t)kt * IN_WIDTH + C_NV + h * 64 + lane]), o);
    }
    ycat[(size_t)t * 1024 + 768 + h * 64 + lane] = f2bf(o);
  }
}

#define TKS 256
__device__ __forceinline__ void lds_insert(float* v, int* id, float x, int xi) {
  if (x > v[15 * TKS]) {
    int j = 15;
    while (j > 0 && v[(j - 1) * TKS] < x) {
      v[j * TKS] = v[(j - 1) * TKS];
      id[j * TKS] = id[(j - 1) * TKS];
      --j;
    }
    v[j * TKS] = x;
    id[j * TKS] = xi;
  }
}
__device__ __forceinline__ void n_topk(const int wv_, const float* __restrict__ scores, int* __restrict__ idx,
                                       float* __restrict__ gate, float* smem) {
  const int tidx_ = opaque_tid(wv_); const int bidx_ = opaque_bid();
  const int tid = tidx_;
  if (tid >= TKS) return;
  float* v1 = smem + tid;
  float* v2 = smem + 16 * TKS + tid;
  float* v3 = smem + 32 * TKS + tid;
  int* i1 = (int*)(smem + 48 * TKS) + tid;
  int* i2 = (int*)(smem + 64 * TKS) + tid;
  int* i3 = (int*)(smem + 80 * TKS) + tid;
  for (int gid = bidx_ * TKS + tid; gid < SEQ * 8; gid += gridDim.x * TKS) {
    const float* s = scores + (size_t)gid * 256;
    for (int j = 0; j < 16; ++j) {
      v1[j * TKS] = -3.0e38f; v2[j * TKS] = -3.0e38f; v3[j * TKS] = -3.0e38f;
      i1[j * TKS] = 0; i2[j * TKS] = 0; i3[j * TKS] = 0;
    }
    for (int n = 0; n < 128; ++n) lds_insert(v1, i1, s[n], n);
    for (int n = 0; n < 128; ++n) lds_insert(v2, i2, s[128 + n], n);
    for (int a = 0; a < 16; ++a) {
      float va = v1[a * TKS];
      int ia = i1[a * TKS];
      for (int b = 0; b < 16; ++b) lds_insert(v3, i3, va + v2[b * TKS], ia * 128 + i2[b * TKS]);
    }
    float m = v3[0];
    float den = 0.f;
    for (int j = 0; j < 16; ++j) den += expf(v3[j * TKS] - m);
    for (int j = 0; j < 16; ++j) {
      idx[(size_t)gid * 16 + j] = i3[j * TKS];
      gate[(size_t)gid * 16 + j] = expf(v3[j * TKS] - m) / den;
    }
  }
}

__device__ __forceinline__ void n_experts(const int wv_, const bf16_t* __restrict__ hn, const int* __restrict__ idx,
                                          const float* __restrict__ gate, const float* __restrict__ wu,
                                          const float* __restrict__ wv, float* __restrict__ x, int ntok) {
  const int tidx_ = opaque_tid(wv_); const int bidx_ = opaque_bid();
  const int lane = tidx_ & 63;
  const int nw = gridDim.x * (NTHREADS / 64);
  for (int t = bidx_ * (NTHREADS / 64) + (tidx_ >> 6); t < ntok; t += nw) {
    const bf16_t* hr = hn + (size_t)t * D_MODEL;
    float4 hv[4], acc[4];
#pragma unroll
    for (int i = 0; i < 4; ++i) {
      ushort4 hb = *(const ushort4*)(hr + i * 256 + lane * 4);
      hv[i] = make_float4(bf2f(hb.x), bf2f(hb.y), bf2f(hb.z), bf2f(hb.w));
      acc[i] = make_float4(0.f, 0.f, 0.f, 0.f);
    }
    for (int k = 0; k < 128; ++k) {
      int e = idx[(size_t)t * 128 + k];
      float g = gate[(size_t)t * 128 + k];
      const float* ur = wu + (size_t)e * D_MODEL;
      float a = 0.f;
#pragma unroll
      for (int i = 0; i < 4; ++i) {
        float4 u = *(const float4*)(ur + i * 256 + lane * 4);
        a += hv[i].x * u.x + hv[i].y * u.y + hv[i].z * u.z + hv[i].w * u.w;
      }
      a = wave_sum(a);
      float hh = 0.5f * a * (1.0f + erff(a * 0.70710678118654752f)) * g;
      const float* vr = wv + (size_t)e * D_MODEL;
#pragma unroll
      for (int i = 0; i < 4; ++i) {
        float4 v = *(const float4*)(vr + i * 256 + lane * 4);
        acc[i].x = fmaf(hh, v.x, acc[i].x); acc[i].y = fmaf(hh, v.y, acc[i].y);
        acc[i].z = fmaf(hh, v.z, acc[i].z); acc[i].w = fmaf(hh, v.w, acc[i].w);
      }
    }
    float* xr = x + (size_t)t * D_MODEL;
#pragma unroll
    for (int i = 0; i < 4; ++i) {
      float4 o = *(float4*)(xr + i * 256 + lane * 4);
      o.x += acc[i].x; o.y += acc[i].y; o.z += acc[i].z; o.w += acc[i].w;
      *(float4*)(xr + i * 256 + lane * 4) = o;
    }
  }
}


typedef __attribute__((ext_vector_type(8))) short bf16x8;
typedef __attribute__((ext_vector_type(4))) float f32x4;
#define LDX 1032
#define LDXB (LDX * 2)
#define XTILE_BYTES (64 * LDXB)

__device__ __forceinline__ unsigned pack2bf(float a, float b) { return (unsigned)f2bf(a) | ((unsigned)f2bf(b) << 16); }

__device__ __forceinline__ void prep_frag(const int wv_, const float* __restrict__ W, int K, int N, bf16_t* __restrict__ dst, float* smem) {
  const int tidx_ = opaque_tid(wv_); const int bidx_ = opaque_bid();
  const int grp = tidx_ >> 8, tid = tidx_ & 255;
  float(*T)[65] = (float(*)[65])(smem + grp * 32 * 65);
  const int KS = K / 32, NC = N / 64;
  const int ntiles = KS * NC;
  for (int wb = bidx_ * 2; wb < ntiles; wb += gridDim.x * 2) {
    const int w = wb + grp;
    const int c = w / KS, ks = w - c * KS;
    {
      const int row = tid >> 3, col = (tid & 7) * 8;
      const float* src = W + (size_t)(ks * 32 + row) * N + c * 64 + col;
      float4 a = *(const float4*)src, b = *(const float4*)(src + 4);
      __syncthreads();
      T[row][col + 0] = a.x; T[row][col + 1] = a.y; T[row][col + 2] = a.z; T[row][col + 3] = a.w;
      T[row][col + 4] = b.x; T[row][col + 5] = b.y; T[row][col + 6] = b.z; T[row][col + 7] = b.w;
    }
    __syncthreads();
    {
      const int nt = tid >> 6, lane = tid & 63;
      const int kr = 8 * (lane >> 4), nc = nt * 16 + (lane & 15);
      uint4 o;
      o.x = pack2bf(T[kr + 0][nc], T[kr + 1][nc]);
      o.y = pack2bf(T[kr + 2][nc], T[kr + 3][nc]);
      o.z = pack2bf(T[kr + 4][nc], T[kr + 5][nc]);
      o.w = pack2bf(T[kr + 6][nc], T[kr + 7][nc]);
      *(uint4*)(dst + ((size_t)((c * KS + ks) * 4 + nt) * 64 + lane) * 8) = o;
    }
  }
}

__device__ __forceinline__ void o_prep(const int wv_, const Params& p, float* smem) {
  for (int l = 0; l < DEPTH; ++l) {
    prep_frag(wv_, p.w_in + (size_t)l * D_MODEL * IN_WIDTH, D_MODEL, IN_WIDTH, p.wf_in + (size_t)l * D_MODEL * IN_WIDTH, smem);
    prep_frag(wv_, p.w_br_pool + (size_t)l * 256 * 1024, 256, 1024, p.wf_br + (size_t)l * 1024 * 1024, smem);
    prep_frag(wv_, p.w_br_ret + (size_t)l * 512 * 1024, 512, 1024, p.wf_br + (size_t)l * 1024 * 1024 + 256 * 1024, smem);
    prep_frag(wv_, p.w_br_na + (size_t)l * 256 * 1024, 256, 1024, p.wf_br + (size_t)l * 1024 * 1024 + 768 * 1024, smem);
    prep_frag(wv_, p.w_out + (size_t)l * 1024 * 1024, 1024, 1024, p.wf_out + (size_t)l * 1024 * 1024, smem);
    prep_frag(wv_, p.w_query + (size_t)l * 1024 * 2048, 1024, 2048, p.wf_q + (size_t)l * 1024 * 2048, smem);
  }
  const int tidx_ = opaque_tid(wv_); const int bidx_ = opaque_bid();
  const int gtid = bidx_ * NTHREADS + tidx_, gsz = gridDim.x * NTHREADS;
  for (int u = gtid; u < DEPTH * 2 * 8 * 4 * 64; u += gsz) {
    const int lane = u & 63, s2 = (u >> 6) & 3, kt = (u >> 8) & 7, lp = u >> 11;
    const float* kr = p.sub_keys + ((size_t)lp * 128 + kt * 16 + (lane & 15)) * 128;
    float v[8];
#pragma unroll
    for (int j = 0; j < 8; ++j) v[j] = kr[16 * (2 * s2 + (j >> 2)) + 4 * (lane >> 4) + (j & 3)];
    uint4 o;
    o.x = pack2bf(v[0], v[1]); o.y = pack2bf(v[2], v[3]); o.z = pack2bf(v[4], v[5]); o.w = pack2bf(v[6], v[7]);
    *(uint4*)(p.kf + (size_t)u * 8) = o;
  }
  if (p.u16) {
    const size_t nunits = (size_t)DEPTH * 16384 * 1024 / 8;
    for (size_t u = gtid; u < nunits; u += gsz) {
      float4 a = *(const float4*)(p.peer_u + u * 8), b = *(const float4*)(p.peer_u + u * 8 + 4);
      uint4 o;
      o.x = pack2bf(a.x, a.y); o.y = pack2bf(a.z, a.w); o.z = pack2bf(b.x, b.y); o.w = pack2bf(b.z, b.w);
      *(uint4*)(p.u16 + u * 8) = o;
      a = *(const float4*)(p.peer_v + u * 8); b = *(const float4*)(p.peer_v + u * 8 + 4);
      o.x = pack2bf(a.x, a.y); o.y = pack2bf(a.z, a.w); o.z = pack2bf(b.x, b.y); o.w = pack2bf(b.z, b.w);
      *(uint4*)(p.v16 + u * 8) = o;
    }
  }
  for (int u = gtid; u < SEQ * 32; u += gsz) {
    const int i = u & 31, pos = u >> 5;
    float inv = 1.0f / powf(10000.0f, (float)i / 31.0f);
    float ang = (float)pos * inv;
    double rev = (double)ang * 0.15915494309189535;
    rev -= floor(rev);
    float rf = (float)rev;
    p.rope[u] = make_float2(__builtin_amdgcn_cosf(rf), __builtin_amdgcn_sinf(rf));
  }
}

template <int NT, int PD = 3>
__device__ __forceinline__ void tl_gemm_chunk(const bf16_t* __restrict__ wf, const int KS, const char* xt, const int kbyte0,
                                              f32x4 (&acc)[NT][4], const int lane, const int nt0 = 0) {
  const bf16x8* wp = (const bf16x8*)wf + lane + nt0 * 64;
  const char* xp = xt + (lane & 15) * LDXB + kbyte0 + (lane >> 4) * 16;
  bf16x8 wb[4][NT];
#pragma unroll
  for (int s = 0; s < PD; ++s)
#pragma unroll
    for (int nt = 0; nt < NT; ++nt) wb[s][nt] = wp[(s * 4 + nt) * 64];
  for (int ks = 0; ks < KS; ks += 4) {
#pragma unroll
    for (int u = 0; u < 4; ++u) {
      int kpre = ks + u + PD;
      kpre = kpre < KS ? kpre : KS - 1;
#pragma unroll
      for (int nt = 0; nt < NT; ++nt) wb[(u + PD) & 3][nt] = wp[(kpre * 4 + nt) * 64];
      bf16x8 xf[4];
#pragma unroll
      for (int mt = 0; mt < 4; ++mt) xf[mt] = *(const bf16x8*)(xp + mt * 16 * LDXB + (ks + u) * 64);
#pragma unroll
      for (int nt = 0; nt < NT; ++nt)
#pragma unroll
        for (int mt = 0; mt < 4; ++mt)
          acc[nt][mt] = __builtin_amdgcn_mfma_f32_16x16x32_bf16(wb[u][nt], xf[mt], acc[nt][mt], 0, 0, 0);
    }
  }
}

__device__ __forceinline__ void tile_rmsnorm_to_lds(const float* __restrict__ xsrc, const float* __restrict__ g, int t0,
                                                    char* xt, int wave, int lane) {
#pragma unroll 2
  for (int i = 0; i < 8; ++i) {
    const int tok = wave * 8 + i;
    const float* xr = xsrc + (size_t)(t0 + tok) * D_MODEL;
    float4 v[4];
    float ss = 0.f;
#pragma unroll
    for (int q = 0; q < 4; ++q) {
      v[q] = *(const float4*)(xr + q * 256 + lane * 4);
      ss += v[q].x * v[q].x + v[q].y * v[q].y + v[q].z * v[q].z + v[q].w * v[q].w;
    }
    ss = wave_sum(ss);
    const float r = rsqrtf(ss * (1.0f / D_MODEL) + EPS);
#pragma unroll
    for (int q = 0; q < 4; ++q) {
      float4 gg = *(const float4*)(g + q * 256 + lane * 4);
      uint2 o;
      o.x = pack2bf(v[q].x * r * gg.x, v[q].y * r * gg.y);
      o.y = pack2bf(v[q].z * r * gg.z, v[q].w * r * gg.w);
      *(uint2*)(xt + tok * LDXB + (q * 256 + lane * 4) * 2) = o;
    }
  }
}

__device__ __forceinline__ void o_p1(const int wv_, const Params& p, int l, const float* __restrict__ xsrc, char* smem) {
  const int tidx_ = opaque_tid(wv_); const int bidx_ = opaque_bid();
  const int wave = tidx_ >> 6, lane = tidx_ & 63;
  const bf16_t* wf = p.wf_in + (size_t)l * D_MODEL * IN_WIDTH;
  const float* g = p.norm_mix + l * D_MODEL;
  for (int tile = bidx_; tile < NTOK / 64; tile += gridDim.x) {
    const int t0 = tile * 64;
    __syncthreads();
    tile_rmsnorm_to_lds(xsrc, g, t0, smem, wave, lane);
    __syncthreads();
#pragma unroll 1
    for (int c = wave; c < IN_WIDTH / 64; c += 8) {
      f32x4 acc[4][4];
#pragma unroll
      for (int a = 0; a < 4; ++a)
#pragma unroll
        for (int b = 0; b < 4; ++b) acc[a][b] = (f32x4){0.f, 0.f, 0.f, 0.f};
      tl_gemm_chunk<4>(wf + (size_t)c * 32 * 4 * 64 * 8, 32, smem, 0, acc, lane);
      asm volatile("" ::: "memory");
      if (c >= 4 && c < 12) {
        const float sc = (c >= 8) ? 0.125f : 1.0f;
#pragma unroll
        for (int mt = 0; mt < 4; ++mt) {
          const int tok = t0 + mt * 16 + (lane & 15);
          const int pos = tok & (SEQ - 1);
#pragma unroll
          for (int nt = 0; nt < 2; ++nt) {
            const int i0 = nt * 16 + 4 * (lane >> 4);
            const float4 cs01 = *(const float4*)(p.rope + pos * 32 + i0);
            const float4 cs23 = *(const float4*)(p.rope + pos * 32 + i0 + 2);
            const float cc[4] = {cs01.x, cs01.z, cs23.x, cs23.z};
            const float sn[4] = {cs01.y, cs01.w, cs23.y, cs23.w};
#pragma unroll
            for (int r = 0; r < 4; ++r) {
              const float x1 = acc[nt][mt][r], x2 = acc[nt + 2][mt][r];
              acc[nt][mt][r] = (x1 * cc[r] - x2 * sn[r]) * sc;
              acc[nt + 2][mt][r] = (x1 * sn[r] + x2 * cc[r]) * sc;
            }
          }
        }
      } else if (c >= 28 && c < 32) {
#pragma unroll
        for (int a = 0; a < 4; ++a)
#pragma unroll
          for (int b = 0; b < 4; ++b) acc[a][b] *= 0.125f;
      } else if (c >= 40) {
#pragma unroll
        for (int a = 0; a < 4; ++a)
#pragma unroll
          for (int b = 0; b < 4; ++b)
#pragma unroll
            for (int r = 0; r < 4; ++r) acc[a][b][r] = 1.0f / (1.0f + __expf(-acc[a][b][r]));
      }
#pragma unroll
      for (int mt = 0; mt < 4; ++mt) {
        const int tok = t0 + mt * 16 + (lane & 15);
        bf16_t* dst = p.proj + (size_t)tok * IN_WIDTH + c * 64 + 4 * (lane >> 4);
#pragma unroll
        for (int nt = 0; nt < 4; ++nt) {
          uint2 o;
          o.x = pack2bf(acc[nt][mt][0], acc[nt][mt][1]);
          o.y = pack2bf(acc[nt][mt][2], acc[nt][mt][3]);
          *(uint2*)(dst + nt * 16) = o;
        }
      }
    }
  }
}


__device__ __forceinline__ void tile_load_to_lds(const bf16_t* __restrict__ src, int ld, char* xt, int tid) {
#pragma unroll 4
  for (int it = 0; it < 16; ++it) {
    const int idx = it * NTHREADS + tid;
    const int row = idx >> 7, u = idx & 127;
    const uint4 v = *(const uint4*)(src + (size_t)row * ld + u * 8);
    *(uint4*)(xt + row * LDXB + u * 16) = v;
  }
}

__device__ __forceinline__ void o_p5a1_tile(const Params& p, int l, int t0, char* smem, int tid) {
  const int wave = tid >> 6, lane = tid & 63;
  __syncthreads();
  tile_load_to_lds(p.ycat + (size_t)t0 * 1024, 1024, smem, tid);
  __syncthreads();
  const bf16_t* wfb = p.wf_br + (size_t)l * 1024 * 1024;
#pragma unroll 1
  for (int hc = wave; hc < 32; hc += 8) {
    const int c = hc >> 1, nt0 = (hc & 1) * 2;
    f32x4 m[2][4];
#pragma unroll
    for (int a = 0; a < 2; ++a)
#pragma unroll
      for (int b = 0; b < 4; ++b) m[a][b] = (f32x4){0.f, 0.f, 0.f, 0.f};
#pragma unroll 1
    for (int br = 0; br < 3; ++br) {
      const int koff = (br == 0) ? 0 : (br == 1 ? 256 : 768);
      const int KS = (br == 1) ? 16 : 8;
      f32x4 acc[2][4];
#pragma unroll
      for (int a = 0; a < 2; ++a)
#pragma unroll
        for (int b = 0; b < 4; ++b) acc[a][b] = (f32x4){0.f, 0.f, 0.f, 0.f};
      tl_gemm_chunk<2>(wfb + (size_t)koff * 1024 + (size_t)c * KS * 4 * 64 * 8, KS, smem, koff * 2, acc, lane, nt0);
      asm volatile("" ::: "memory");
#pragma unroll
      for (int mt = 0; mt < 4; ++mt) {
        const int tok = t0 + mt * 16 + (lane & 15);
        const bf16_t* gp = p.proj + (size_t)tok * IN_WIDTH + C_GATE + br * 1024 + c * 64 + nt0 * 16 + 4 * (lane >> 4);
#pragma unroll
        for (int nt = 0; nt < 2; ++nt) {
          const uint2 gv = *(const uint2*)(gp + nt * 16);
          m[nt][mt][0] += __uint_as_float(gv.x << 16) * acc[nt][mt][0];
          m[nt][mt][1] += __uint_as_float(gv.x & 0xffff0000u) * acc[nt][mt][1];
          m[nt][mt][2] += __uint_as_float(gv.y << 16) * acc[nt][mt][2];
          m[nt][mt][3] += __uint_as_float(gv.y & 0xffff0000u) * acc[nt][mt][3];
        }
      }
    }
#pragma unroll
    for (int mt = 0; mt < 4; ++mt) {
      const int tok = t0 + mt * 16 + (lane & 15);
      bf16_t* dst = p.mrg + (size_t)tok * 1024 + c * 64 + nt0 * 16 + 4 * (lane >> 4);
#pragma unroll
      for (int nt = 0; nt < 2; ++nt) {
        uint2 o;
        o.x = pack2bf(m[nt][mt][0], m[nt][mt][1]);
        o.y = pack2bf(m[nt][mt][2], m[nt][mt][3]);
        *(uint2*)(dst + nt * 16) = o;
      }
    }
  }
}
__device__ __forceinline__ void o_p5a2_tile(const Params& p, int l, const float* __restrict__ xcur, int t0, char* smem, int tid) {
  const int wave = tid >> 6, lane = tid & 63;
  __syncthreads();
  tile_load_to_lds(p.mrg + (size_t)t0 * 1024, 1024, smem, tid);
  __syncthreads();
  const bf16_t* wfo = p.wf_out + (size_t)l * 1024 * 1024;
#pragma unroll 1
  for (int c = wave; c < 16; c += 8) {
    f32x4 acc[4][4];
#pragma unroll
    for (int a = 0; a < 4; ++a)
#pragma unroll
      for (int b = 0; b < 4; ++b) acc[a][b] = (f32x4){0.f, 0.f, 0.f, 0.f};
    tl_gemm_chunk<4, 2>(wfo + (size_t)c * 32 * 4 * 64 * 8, 32, smem, 0, acc, lane);
    asm volatile("" ::: "memory");
#pragma unroll
    for (int mt = 0; mt < 4; ++mt) {
      const int tok = t0 + mt * 16 + (lane & 15);
      const size_t o = (size_t)tok * 1024 + c * 64 + 4 * (lane >> 4);
#pragma unroll
      for (int nt = 0; nt < 4; ++nt) {
        float4 xv = *(const float4*)(xcur + o + nt * 16);
        xv.x += acc[nt][mt][0]; xv.y += acc[nt][mt][1]; xv.z += acc[nt][mt][2]; xv.w += acc[nt][mt][3];
        *(float4*)(p.xres + o + nt * 16) = xv;
      }
    }
  }
}
__device__ __forceinline__ void o_p5a3_tile(const Params& p, int l, int t0, char* smem, int tid) {
  const int wave = tid >> 6, lane = tid & 63;
  __syncthreads();
  tile_rmsnorm_to_lds(p.xres, p.norm_ffn + l * D_MODEL, t0, smem, wave, lane);
  __syncthreads();
}


__device__ __forceinline__ unsigned mono_f(float f) {
  unsigned u = __float_as_uint(f);
  return (u & 0x80000000u) ? ~u : (u | 0x80000000u);
}
__device__ __forceinline__ float unmono_f(unsigned m) {
  return __uint_as_float((m & 0x80000000u) ? (m & 0x7fffffffu) : ~m);
}
#define CE_DESC(x, y) { const unsigned hi_ = max(x, y); const unsigned lo_ = min(x, y); x = hi_; y = lo_; }
#define CE_ASC(x, y) { const unsigned hi_ = max(x, y); const unsigned lo_ = min(x, y); x = lo_; y = hi_; }
__device__ __forceinline__ void sort16_desc(unsigned (&a)[16]) {
#pragma unroll
  for (int k = 2; k <= 16; k <<= 1) {
#pragma unroll
    for (int j = k >> 1; j > 0; j >>= 1) {
#pragma unroll
      for (int i = 0; i < 16; ++i) {
        const int l = i ^ j;
        if (l > i) {
          if ((i & k) == 0) CE_DESC(a[i], a[l]) else CE_ASC(a[i], a[l])
        }
      }
    }
  }
}
__device__ __forceinline__ void bitonic_merge16_desc(unsigned (&a)[16]) {
#pragma unroll
  for (int j = 8; j > 0; j >>= 1) {
#pragma unroll
    for (int i = 0; i < 16; ++i) {
      const int l = i ^ j;
      if (l > i) CE_DESC(a[i], a[l])
    }
  }
}
__device__ __forceinline__ void xlane_merge16(unsigned (&a)[16], int mask) {
  unsigned b[16];
#pragma unroll
  for (int i = 0; i < 16; ++i) b[i] = (unsigned)__shfl_xor((int)a[i], mask, 64);
#pragma unroll
  for (int i = 0; i < 16; ++i) a[i] = max(a[i], b[15 - i]);
  bitonic_merge16_desc(a);
}

__device__ __forceinline__ void o_peer_select_tile(const Params& p, int l, int t0, char* smem, int tid) {
  const int h = __builtin_amdgcn_readfirstlane(tid >> 6), lane = tid & 63;
  const int g = lane >> 4, tl = lane & 15;
  const bf16_t* wfq = p.wf_q + (size_t)l * 1024 * 2048;
#pragma unroll 1
  for (int pp = 0; pp < 2; ++pp) {
    bf16x8 qf[4][4];
#pragma unroll 1
    for (int cc = 0; cc < 2; ++cc) {
      const int c = (h * 2 + pp) * 2 + cc;
      f32x4 acc[4][4];
#pragma unroll
      for (int a = 0; a < 4; ++a)
#pragma unroll
        for (int b = 0; b < 4; ++b) acc[a][b] = (f32x4){0.f, 0.f, 0.f, 0.f};
      tl_gemm_chunk<4, 2>(wfq + (size_t)c * 32 * 4 * 64 * 8, 32, smem, 0, acc, lane);
#pragma unroll
      for (int sl = 0; sl < 2; ++sl)
#pragma unroll
        for (int mt = 0; mt < 4; ++mt) {
          union { bf16x8 v; unsigned u[4]; } cv;
          cv.u[0] = pack2bf(acc[2 * sl][mt][0], acc[2 * sl][mt][1]);
          cv.u[1] = pack2bf(acc[2 * sl][mt][2], acc[2 * sl][mt][3]);
          cv.u[2] = pack2bf(acc[2 * sl + 1][mt][0], acc[2 * sl + 1][mt][1]);
          cv.u[3] = pack2bf(acc[2 * sl + 1][mt][2], acc[2 * sl + 1][mt][3]);
          if (cc == 0) qf[sl][mt] = cv.v; else qf[2 + sl][mt] = cv.v;
        }
    }
    const bf16x8* kfp = (const bf16x8*)p.kf + (size_t)((l * 2 + pp) * 8) * 4 * 64 + lane;
#pragma unroll
    for (int mt = 0; mt < 4; ++mt) {
      f32x4 sc[8];
#pragma unroll
      for (int kt = 0; kt < 8; ++kt) sc[kt] = (f32x4){0.f, 0.f, 0.f, 0.f};
#pragma unroll
      for (int s2 = 0; s2 < 4; ++s2) {
        bf16x8 qv;
        qv = qf[s2][mt];
#pragma unroll
        for (int kt = 0; kt < 8; ++kt)
          sc[kt] = __builtin_amdgcn_mfma_f32_16x16x32_bf16(kfp[(kt * 4 + s2) * 64], qv, sc[kt], 0, 0, 0);
        __builtin_amdgcn_sched_barrier(0);
      }
      unsigned A[16], B[16];
#pragma unroll
      for (int kt = 0; kt < 4; ++kt)
#pragma unroll
        for (int r = 0; r < 4; ++r) {
          A[kt * 4 + r] = (mono_f(sc[kt][r]) & ~127u) | (unsigned)(127 - (kt * 16 + r) - 4 * g);
          B[kt * 4 + r] = (mono_f(sc[kt + 4][r]) & ~127u) | (unsigned)(127 - ((kt + 4) * 16 + r) - 4 * g);
        }
      sort16_desc(A);
      sort16_desc(B);
#pragma unroll
      for (int i = 0; i < 16; ++i) A[i] = max(A[i], B[15 - i]);
      bitonic_merge16_desc(A);
      xlane_merge16(A, 16);
      xlane_merge16(A, 32);
      if (g == 0) {
        uint4* dst = (uint4*)(p.tklist + ((size_t)((t0 + mt * 16 + tl) * 8 + h) * 2 + pp) * 16);
        dst[0] = make_uint4(A[0], A[1], A[2], A[3]);
        dst[1] = make_uint4(A[4], A[5], A[6], A[7]);
        dst[2] = make_uint4(A[8], A[9], A[10], A[11]);
        dst[3] = make_uint4(A[12], A[13], A[14], A[15]);
      }
    }
  }
  asm volatile("s_waitcnt vmcnt(0)" ::: "memory");
}

__device__ __forceinline__ void o_peer_select2_tile(const Params& p, int l, int t0, int tid) {
  const int h = __builtin_amdgcn_readfirstlane(tid >> 6), lane = tid & 63;
  const int g = lane >> 4, tl = lane & 15;
#pragma unroll 1
  for (int mt = 0; mt < 4; ++mt) {
    const int tok = t0 + mt * 16 + tl;
    const unsigned* lp = p.tklist + ((size_t)(tok * 8 + h) * 2) * 16;
    float v1[16], v2[16];
    {
      const uint4* q4 = (const uint4*)lp;
#pragma unroll
      for (int i = 0; i < 4; ++i) {
        uint4 x = q4[i], y = q4[4 + i];
        v1[4 * i + 0] = unmono_f(x.x & ~127u); v1[4 * i + 1] = unmono_f(x.y & ~127u);
        v1[4 * i + 2] = unmono_f(x.z & ~127u); v1[4 * i + 3] = unmono_f(x.w & ~127u);
        v2[4 * i + 0] = unmono_f(y.x & ~127u); v2[4 * i + 1] = unmono_f(y.y & ~127u);
        v2[4 * i + 2] = unmono_f(y.z & ~127u); v2[4 * i + 3] = unmono_f(y.w & ~127u);
      }
    }
    unsigned C[16];
#pragma unroll
    for (int i = 0; i < 16; ++i) C[i] = 0u;
    {
      int idx = 0;
#pragma unroll
      for (int a = 0; a < 16; ++a) {
#pragma unroll
        for (int b = 0; b < 16; ++b) {
          if ((a + 1) * (b + 1) <= 16) {
            const unsigned key = (mono_f(v1[a] + v2[b]) & ~255u) | (unsigned)(255 - (a * 16 + b));
            const int slot = idx >> 2, who = idx & 3;
            C[slot] = (g == who) ? key : C[slot];
            ++idx;
          }
        }
      }
    }
    sort16_desc(C);
    xlane_merge16(C, 16);
    xlane_merge16(C, 32);
    const float f0 = unmono_f(C[0] & ~255u);
    float den = 0.f;
    float ev[16];
#pragma unroll
    for (int i = 0; i < 16; ++i) { ev[i] = __expf(unmono_f(C[i] & ~255u) - f0); den += ev[i]; }
    const float rden = 1.0f / den;
    int eidx[4]; float egate[4];
#pragma unroll
    for (int i = 0; i < 4; ++i) {
      const unsigned k = (g == 0) ? C[i] : (g == 1) ? C[4 + i] : (g == 2) ? C[8 + i] : C[12 + i];
      const float e = (g == 0) ? ev[i] : (g == 1) ? ev[4 + i] : (g == 2) ? ev[8 + i] : ev[12 + i];
      const int pos = 255 - (int)(k & 255u);
      const int a = pos >> 4, b = pos & 15;
      const int n1 = 127 - (int)(lp[a] & 127u);
      const int n2 = 127 - (int)(lp[16 + b] & 127u);
      eidx[i] = n1 * 128 + n2;
      egate[i] = e * rden;
    }
    *(int4*)(p.pidx + (size_t)tok * 128 + h * 16 + 4 * g) = make_int4(eidx[0], eidx[1], eidx[2], eidx[3]);
    *(float4*)(p.pgate + (size_t)tok * 128 + h * 16 + 4 * g) = make_float4(egate[0], egate[1], egate[2], egate[3]);
  }
}

__device__ __forceinline__ void o_peer_experts_tile(const Params& p, int l, int t0, const char* smem, int tid) {
  const int wave = tid >> 6, lane = tid & 63;
  const bf16_t* U = p.u16 + (size_t)l * 16384 * 1024;
  const bf16_t* V = p.v16 + (size_t)l * 16384 * 1024;
  int vz = 0;
  asm volatile("" : "+v"(vz));
#pragma unroll 1
  for (int i8 = 0; i8 < 8; ++i8) {
    const int tl = wave * 8 + i8;
    const int tok = t0 + tl;
    float hv[16], acc[16];
    {
      const uint4 h0 = *(const uint4*)(smem + tl * LDXB + lane * 16);
      const uint4 h1 = *(const uint4*)(smem + tl * LDXB + 1024 + lane * 16);
      const unsigned hw[8] = {h0.x, h0.y, h0.z, h0.w, h1.x, h1.y, h1.z, h1.w};
#pragma unroll
      for (int j = 0; j < 8; ++j) {
        hv[2 * j] = __uint_as_float(hw[j] << 16);
        hv[2 * j + 1] = __uint_as_float(hw[j] & 0xffff0000u);
        acc[2 * j] = 0.f; acc[2 * j + 1] = 0.f;
      }
    }
    const int* ip = p.pidx + (size_t)tok * 128 + vz;
    const float* gp = p.pgate + (size_t)tok * 128 + vz;
#pragma unroll 1
    for (int k = 0; k < 128; k += 4) {
      const int4 e4 = *(const int4*)(ip + k);
      const float4 g4 = *(const float4*)(gp + k);
      const int ee[4] = {e4.x, e4.y, e4.z, e4.w};
      const float gg[4] = {g4.x, g4.y, g4.z, g4.w};
      uint4 ur[4][2];
#pragma unroll
      for (int q = 0; q < 4; ++q) {
        const char* up = (const char*)(U + (size_t)ee[q] * 1024) + lane * 16;
        ur[q][0] = *(const uint4*)up;
        ur[q][1] = *(const uint4*)(up + 1024);
      }
      uint4 vr[4][2];
#pragma unroll
      for (int q = 0; q < 4; ++q) {
        const char* vp = (const char*)(V + (size_t)ee[q] * 1024) + lane * 16;
        vr[q][0] = *(const uint4*)vp;
        vr[q][1] = *(const uint4*)(vp + 1024);
      }
      float hh[4];
#pragma unroll
      for (int q = 0; q < 4; ++q) {
        const unsigned uw[8] = {ur[q][0].x, ur[q][0].y, ur[q][0].z, ur[q][0].w, ur[q][1].x, ur[q][1].y, ur[q][1].z, ur[q][1].w};
        float a = 0.f;
#pragma unroll
        for (int j = 0; j < 8; ++j) {
          a = fmaf(hv[2 * j], __uint_as_float(uw[j] << 16), a);
          a = fmaf(hv[2 * j + 1], __uint_as_float(uw[j] & 0xffff0000u), a);
        }
        a = wave_sum(a);
        hh[q] = 0.5f * a * (1.0f + erff(a * 0.70710678118654752f)) * gg[q];
      }
#pragma unroll
      for (int q = 0; q < 4; ++q) {
        const unsigned vw[8] = {vr[q][0].x, vr[q][0].y, vr[q][0].z, vr[q][0].w, vr[q][1].x, vr[q][1].y, vr[q][1].z, vr[q][1].w};
#pragma unroll
        for (int j = 0; j < 8; ++j) {
          acc[2 * j] = fmaf(hh[q], __uint_as_float(vw[j] << 16), acc[2 * j]);
          acc[2 * j + 1] = fmaf(hh[q], __uint_as_float(vw[j] & 0xffff0000u), acc[2 * j + 1]);
        }
      }
    }
    float* xr = p.xres + (size_t)tok * 1024 + lane * 8;
#pragma unroll
    for (int i = 0; i < 2; ++i) {
      float4 a0 = *(float4*)(xr + i * 512), a1 = *(float4*)(xr + i * 512 + 4);
      a0.x += acc[8 * i + 0]; a0.y += acc[8 * i + 1]; a0.z += acc[8 * i + 2]; a0.w += acc[8 * i + 3];
      a1.x += acc[8 * i + 4]; a1.y += acc[8 * i + 5]; a1.z += acc[8 * i + 6]; a1.w += acc[8 * i + 7];
      *(float4*)(xr + i * 512) = a0;
      *(float4*)(xr + i * 512 + 4) = a1;
    }
  }
}


__device__ __forceinline__ float logsigmoid_(float x) { return fminf(x, 0.f) - log1pf(expf(-fabsf(x))); }
__device__ __forceinline__ float bf_lo(unsigned w) { return __uint_as_float(w << 16); }
__device__ __forceinline__ float bf_hi(unsigned w) { return __uint_as_float(w & 0xffff0000u); }

#define RKV_LD 136
__device__ __forceinline__ void o_ret_kv_task(const Params& p, int l, int task, char* smem, int tid) {
  const int wave = tid >> 6, lane = tid & 63, g = lane >> 4, tl = lane & 15;
  const int bh = task >> 5, n = task & 31, b = bh >> 2, h = bh & 3;
  const int tok0 = b * SEQ + n * 128;
  const float lgf = logsigmoid_(p.ret_decay[l * 8 + h]), lgb = logsigmoid_(p.ret_decay[l * 8 + 4 + h]);
  bf16_t* KTf = (bf16_t*)smem;
  bf16_t* KTb = KTf + 64 * RKV_LD;
  bf16_t* VT = KTb + 64 * RKV_LD;
  __syncthreads();
#pragma unroll
  for (int it = 0; it < 2; ++it) {
    const int u = tid + it * NTHREADS;
    const int j = u >> 3, d0 = (u & 7) * 8;
    const uint4 kv = *(const uint4*)(p.proj + (size_t)(tok0 + j) * IN_WIDTH + C_RK + h * 64 + d0);
    const float wf = __expf(lgf * (float)(127 - j)), wb = __expf(lgb * (float)(j + 1));
    const unsigned kw[4] = {kv.x, kv.y, kv.z, kv.w};
#pragma unroll
    for (int e = 0; e < 4; ++e) {
      const float x0 = bf_lo(kw[e]), x1 = bf_hi(kw[e]);
      KTf[(d0 + 2 * e) * RKV_LD + j] = f2bf(x0 * wf);
      KTf[(d0 + 2 * e + 1) * RKV_LD + j] = f2bf(x1 * wf);
      KTb[(d0 + 2 * e) * RKV_LD + j] = f2bf(x0 * wb);
      KTb[(d0 + 2 * e + 1) * RKV_LD + j] = f2bf(x1 * wb);
    }
  }
#pragma unroll
  for (int it = 0; it < 4; ++it) {
    const int u = tid + it * NTHREADS;
    const int j = u >> 4, e0 = (u & 15) * 8;
    const uint4 vv = *(const uint4*)(p.proj + (size_t)(tok0 + j) * IN_WIDTH + C_RV + h * 128 + e0);
    const unsigned vw[4] = {vv.x, vv.y, vv.z, vv.w};
#pragma unroll
    for (int e = 0; e < 4; ++e) {
      VT[(e0 + 2 * e) * RKV_LD + j] = (bf16_t)(vw[e] & 0xffffu);
      VT[(e0 + 2 * e + 1) * RKV_LD + j] = (bf16_t)(vw[e] >> 16);
    }
  }
  __syncthreads();
  bf16x8 a[4];
#pragma unroll
  for (int ks = 0; ks < 4; ++ks) a[ks] = *(const bf16x8*)(VT + (wave * 16 + tl) * RKV_LD + ks * 32 + 8 * g);
#pragma unroll
  for (int dir = 0; dir < 2; ++dir) {
    const bf16_t* KT = dir ? KTb : KTf;
#pragma unroll
    for (int dt = 0; dt < 4; ++dt) {
      f32x4 acc = (f32x4){0.f, 0.f, 0.f, 0.f};
#pragma unroll
      for (int ks = 0; ks < 4; ++ks) {
        const bf16x8 bb = *(const bf16x8*)(KT + (dt * 16 + tl) * RKV_LD + ks * 32 + 8 * g);
        acc = __builtin_amdgcn_mfma_f32_16x16x32_bf16(a[ks], bb, acc, 0, 0, 0);
      }
      float* dst = p.kvst + ((size_t)(task * 2 + dir) * 128 + wave * 16 + 4 * g) * 64 + dt * 16 + tl;
#pragma unroll
      for (int r = 0; r < 4; ++r) dst[r * 64] = acc[r];
    }
  }
}

__device__ __forceinline__ void o_ret_scan(const int wv_, const Params& p, int l) {
  const int tidx_ = opaque_tid(wv_); const int bidx_ = opaque_bid();
  const int gsz = gridDim.x * NTHREADS;
  for (int u = bidx_ * NTHREADS + tidx_; u < 16 * 2 * 128 * 16; u += gsz) {
    const int dq = u & 15, e = (u >> 4) & 127, dir = (u >> 11) & 1, bh = u >> 12, h = bh & 3;
    const float lg = logsigmoid_(p.ret_decay[l * 8 + dir * 4 + h]);
    const float gC = __expf(lg * 128.0f);
    float4 st = make_float4(0.f, 0.f, 0.f, 0.f);
#pragma unroll 8
    for (int nn = 0; nn < 32; ++nn) {
      const int n = dir ? (31 - nn) : nn;
      const size_t idx = ((size_t)((bh * 32 + n) * 2 + dir) * 128 + e) * 64 + dq * 4;
      const float4 kv = *(const float4*)(p.kvst + idx);
      uint2 o;
      o.x = pack2bf(st.x, st.y); o.y = pack2bf(st.z, st.w);
      *(uint2*)(p.rstate + idx) = o;
      st.x = fmaf(st.x, gC, kv.x); st.y = fmaf(st.y, gC, kv.y); st.z = fmaf(st.z, gC, kv.z); st.w = fmaf(st.w, gC, kv.w);
    }
  }
}

#define RO_LD 264
#define RK_LD 72
__device__ __forceinline__ void o_ret_out_task(const Params& p, int l, int task, char* smem, int tid) {
  const int wave = tid >> 6, lane = tid & 63, g = lane >> 4, tl = lane & 15;
  const int bh = task >> 5, n = task & 31, b = bh >> 2, h = bh & 3;
  const int tok0 = b * SEQ + n * 128;
  const float lgf = logsigmoid_(p.ret_decay[l * 8 + h]), lgb = logsigmoid_(p.ret_decay[l * 8 + 4 + h]);
  bf16_t* Acat = (bf16_t*)smem;
  bf16_t* Bcat = Acat + 128 * RO_LD;
  bf16_t* Kl = Bcat + 128 * RO_LD;
  __syncthreads();
#pragma unroll
  for (int it = 0; it < 2; ++it) {
    const int u = tid + it * NTHREADS;
    const int i = u >> 3, d0 = (u & 7) * 8;
    const size_t row = (size_t)(tok0 + i) * IN_WIDTH;
    const uint4 qv = *(const uint4*)(p.proj + row + C_RQ + h * 64 + d0);
    const uint4 kv = *(const uint4*)(p.proj + row + C_RK + h * 64 + d0);
    *(uint4*)(Acat + i * RO_LD + d0) = qv;
    *(uint4*)(Kl + i * RK_LD + d0) = kv;
    const float wf = __expf(lgf * (float)(i + 1)), wb = __expf(lgb * (float)(127 - i));
    const unsigned qw[4] = {qv.x, qv.y, qv.z, qv.w};
    uint4 of, ob;
    of.x = pack2bf(bf_lo(qw[0]) * wf, bf_hi(qw[0]) * wf); ob.x = pack2bf(bf_lo(qw[0]) * wb, bf_hi(qw[0]) * wb);
    of.y = pack2bf(bf_lo(qw[1]) * wf, bf_hi(qw[1]) * wf); ob.y = pack2bf(bf_lo(qw[1]) * wb, bf_hi(qw[1]) * wb);
    of.z = pack2bf(bf_lo(qw[2]) * wf, bf_hi(qw[2]) * wf); ob.z = pack2bf(bf_lo(qw[2]) * wb, bf_hi(qw[2]) * wb);
    of.w = pack2bf(bf_lo(qw[3]) * wf, bf_hi(qw[3]) * wf); ob.w = pack2bf(bf_lo(qw[3]) * wb, bf_hi(qw[3]) * wb);
    *(uint4*)(Acat + i * RO_LD + 128 + d0) = of;
    *(uint4*)(Acat + i * RO_LD + 192 + d0) = ob;
  }
#pragma unroll
  for (int it = 0; it < 4; ++it) {
    const int u = tid + it * NTHREADS;
    const int j = u >> 4, e0 = (u & 15) * 8;
    const uint4 vv = *(const uint4*)(p.proj + (size_t)(tok0 + j) * IN_WIDTH + C_RV + h * 128 + e0);
    const unsigned vw[4] = {vv.x, vv.y, vv.z, vv.w};
#pragma unroll
    for (int e = 0; e < 4; ++e) {
      Bcat[(e0 + 2 * e) * RO_LD + j] = (bf16_t)(vw[e] & 0xffffu);
      Bcat[(e0 + 2 * e + 1) * RO_LD + j] = (bf16_t)(vw[e] >> 16);
    }
  }
#pragma unroll
  for (int it = 0; it < 4; ++it) {
    const int u = tid + it * NTHREADS;
    const int d0 = (u & 7) * 8, e = (u >> 3) & 127, dir = u >> 10;
    const uint4 sv = *(const uint4*)(p.rstate + ((size_t)(task * 2 + dir) * 128 + e) * 64 + d0);
    *(uint4*)(Bcat + e * RO_LD + 128 + dir * 64 + d0) = sv;
  }
  __syncthreads();
  f32x4 sc[8];
#pragma unroll
  for (int jt = 0; jt < 8; ++jt) sc[jt] = (f32x4){0.f, 0.f, 0.f, 0.f};
#pragma unroll
  for (int ks = 0; ks < 2; ++ks) {
    const bf16x8 qb = *(const bf16x8*)(Acat + (wave * 16 + tl) * RO_LD + ks * 32 + 8 * g);
#pragma unroll
    for (int jt = 0; jt < 8; ++jt) {
      const bf16x8 ka = *(const bf16x8*)(Kl + (jt * 16 + tl) * RK_LD + ks * 32 + 8 * g);
      sc[jt] = __builtin_amdgcn_mfma_f32_16x16x32_bf16(ka, qb, sc[jt], 0, 0, 0);
    }
  }
  {
    const int i = wave * 16 + tl;
#pragma unroll
    for (int jt = 0; jt < 8; ++jt) {
      float pv[4];
#pragma unroll
      for (int r = 0; r < 4; ++r) {
        const int j = jt * 16 + 4 * g + r;
        const float dd = (j <= i) ? __expf(lgf * (float)(i - j)) : __expf(lgb * (float)(j - i));
        pv[r] = sc[jt][r] * dd;
      }
      uint2 o;
      o.x = pack2bf(pv[0], pv[1]); o.y = pack2bf(pv[2], pv[3]);
      *(uint2*)(Acat + i * RO_LD + jt * 16 + 4 * g) = o;
    }
  }
  f32x4 y[8];
#pragma unroll
  for (int et = 0; et < 8; ++et) y[et] = (f32x4){0.f, 0.f, 0.f, 0.f};
#pragma unroll
  for (int ks = 0; ks < 8; ++ks) {
    const bf16x8 ab = *(const bf16x8*)(Acat + (wave * 16 + tl) * RO_LD + ks * 32 + 8 * g);
#pragma unroll
    for (int et = 0; et < 8; ++et) {
      const bf16x8 ba = *(const bf16x8*)(Bcat + (et * 16 + tl) * RO_LD + ks * 32 + 8 * g);
      y[et] = __builtin_amdgcn_mfma_f32_16x16x32_bf16(ba, ab, y[et], 0, 0, 0);
    }
  }
  float ss = 0.f;
#pragma unroll
  for (int et = 0; et < 8; ++et)
#pragma unroll
    for (int r = 0; r < 4; ++r) ss = fmaf(y[et][r], y[et][r], ss);
  ss += __shfl_xor(ss, 16, 64);
  ss += __shfl_xor(ss, 32, 64);
  const float rstd = rsqrtf(ss * (1.0f / 128.0f) + EPS);
  {
    const int tok = tok0 + wave * 16 + tl;
    const bf16_t* gp = p.proj + (size_t)tok * IN_WIDTH + C_RG + h * 128 + 4 * g;
    bf16_t* dst = p.ycat + (size_t)tok * 1024 + 256 + h * 128 + 4 * g;
#pragma unroll
    for (int et = 0; et < 8; ++et) {
      const uint2 gv = *(const uint2*)(gp + et * 16);
      const float g0 = bf_lo(gv.x), g1 = bf_hi(gv.x), g2 = bf_lo(gv.y), g3 = bf_hi(gv.y);
      uint2 o;
      o.x = pack2bf(g0 / (1.0f + __expf(-g0)) * y[et][0] * rstd, g1 / (1.0f + __expf(-g1)) * y[et][1] * rstd);
      o.y = pack2bf(g2 / (1.0f + __expf(-g2)) * y[et][2] * rstd, g3 / (1.0f + __expf(-g3)) * y[et][3] * rstd);
      *(uint2*)(dst + et * 16) = o;
    }
  }
}


__global__ void __launch_bounds__(NTHREADS) fwd_megakernel(Params p) {
  cg::grid_group grid = cg::this_grid();
  extern __shared__ __attribute__((aligned(16))) float smem[];
  const int wv_ = __builtin_amdgcn_readfirstlane((int)(threadIdx.x >> 6));

  o_prep(wv_, p, smem);
  grid.sync();
#pragma unroll 1
  for (int l = 0; l < DEPTH; ++l) {
    const float* xcur = (l == 0) ? p.x_in : p.xres;
    o_p1(wv_, p, l, xcur, (char*)smem);
    grid.sync();
    n_pool(wv_, p.proj, p.pool_w + (size_t)l * 4 * 64 * 64, p.pool_scale + l * 256, p.ycat, smem);
    n_na(wv_, p.proj, p.na_rpb + (size_t)l * 4 * 15 * 31, p.ycat);
    {
      const int tidx_ = opaque_tid(wv_); const int bidx_ = opaque_bid();
      for (int task = bidx_; task < 512; task += gridDim.x) o_ret_kv_task(p, l, task, (char*)smem, tidx_);
    }
    grid.sync();
    o_ret_scan(wv_, p, l);
    grid.sync();
    {
      const int tidx_ = opaque_tid(wv_); const int bidx_ = opaque_bid();
      for (int task = bidx_; task < 512; task += gridDim.x) o_ret_out_task(p, l, task, (char*)smem, tidx_);
    }
    grid.sync();
    {
      const int tidx_ = opaque_tid(wv_); const int bidx_ = opaque_bid();
      for (int tile = bidx_; tile < NTOK / 64; tile += gridDim.x) {
        { const int t0_ = opaque_s(tile * 64), l_ = opaque_s(l), td_ = opaque_tid(wv_); o_p5a1_tile(p, l_, t0_, (char*)smem, td_); }
        { const int t0_ = opaque_s(tile * 64), l_ = opaque_s(l), td_ = opaque_tid(wv_); o_p5a2_tile(p, l_, xcur, t0_, (char*)smem, td_); }
        { const int t0_ = opaque_s(tile * 64), l_ = opaque_s(l), td_ = opaque_tid(wv_); o_p5a3_tile(p, l_, t0_, (char*)smem, td_); }
        { const int t0_ = opaque_s(tile * 64), l_ = opaque_s(l), td_ = opaque_tid(wv_); o_peer_select_tile(p, l_, t0_, (char*)smem, td_); }
        { const int t0_ = opaque_s(tile * 64), l_ = opaque_s(l), td_ = opaque_tid(wv_); o_peer_select2_tile(p, l_, t0_, td_); }
        asm volatile("s_waitcnt vmcnt(0)" ::: "memory");
        __syncthreads();
        { const int t0_ = opaque_s(tile * 64), l_ = opaque_s(l), td_ = opaque_tid(wv_); o_peer_experts_tile(p, l_, t0_, (const char*)smem, td_); }
      }
    }
    grid.sync();
  }
  n_rmsnorm<true>(wv_, p.xres, p.norm_final, p.out, NTOK);
}

extern "C" void kernel_launch(void* const* d_in, const int* in_sizes, int n_in, void* d_out, int out_size,
                              void* d_ws, size_t ws_size, hipStream_t stream) {
  Params p{};
  p.x_in = (const float*)d_in[0]; p.norm_mix = (const float*)d_in[1]; p.w_in = (const float*)d_in[2];
  p.pool_w = (const float*)d_in[3]; p.pool_scale = (const float*)d_in[4]; p.ret_decay = (const float*)d_in[5];
  p.na_rpb = (const float*)d_in[6]; p.w_br_pool = (const float*)d_in[7]; p.w_br_ret = (const float*)d_in[8];
  p.w_br_na = (const float*)d_in[9]; p.w_out = (const float*)d_in[10]; p.norm_ffn = (const float*)d_in[11];
  p.w_query = (const float*)d_in[12]; p.sub_keys = (const float*)d_in[13]; p.peer_u = (const float*)d_in[14];
  p.peer_v = (const float*)d_in[15]; p.norm_final = (const float*)d_in[16];
  p.out = (float*)d_out;
  char* ws = (char*)d_ws;
  size_t off = 0;
  auto alloc = [&](size_t bytes) { char* q = ws + off; off += (bytes + 255) & ~(size_t)255; return q; };
  p.xres = (float*)alloc((size_t)NTOK * D_MODEL * 4);
  p.proj = (bf16_t*)alloc((size_t)NTOK * IN_WIDTH * 2);
  p.ycat = (bf16_t*)alloc((size_t)NTOK * 1024 * 2);
  p.mrg = (bf16_t*)alloc((size_t)NTOK * 1024 * 2);
  p.pidx = (int*)alloc((size_t)NTOK * 128 * 4);
  p.pgate = (float*)alloc((size_t)NTOK * 128 * 4);
  p.wf_in = (bf16_t*)alloc((size_t)DEPTH * D_MODEL * IN_WIDTH * 2);
  p.wf_br = (bf16_t*)alloc((size_t)DEPTH * 1024 * 1024 * 2);
  p.wf_out = (bf16_t*)alloc((size_t)DEPTH * 1024 * 1024 * 2);
  p.wf_q = (bf16_t*)alloc((size_t)DEPTH * 1024 * 2048 * 2);
  p.kf = (bf16_t*)alloc((size_t)DEPTH * 2 * 128 * 128 * 2);
  p.u16 = (bf16_t*)alloc((size_t)DEPTH * 16384 * 1024 * 2);
  p.v16 = (bf16_t*)alloc((size_t)DEPTH * 16384 * 1024 * 2);
  p.rope = (float2*)alloc((size_t)SEQ * 32 * 8);
  p.tklist = (unsigned*)alloc((size_t)NTOK * 8 * 2 * 16 * 4);
  p.kvst = (float*)p.mrg;
  p.rstate = (bf16_t*)p.tklist;
  p.xn = nullptr; p.merged = nullptr; p.pq = nullptr; p.psc = nullptr;
  if (off > ws_size) fprintf(stderr, "WORKSPACE OVERFLOW: need %zu have %zu\n", off, ws_size);

  const size_t kDynLds = 160 * 1024;
  static int grid_blocks = 0;
  if (!grid_blocks) {
    int dev = 0, cus = 0, per_cu = 0;
    (void)hipGetDevice(&dev);
    (void)hipDeviceGetAttribute(&cus, hipDeviceAttributeMultiprocessorCount, dev);
    (void)hipFuncSetAttribute((const void*)fwd_megakernel, hipFuncAttributeMaxDynamicSharedMemorySize, (int)kDynLds);
    (void)hipOccupancyMaxActiveBlocksPerMultiprocessor(&per_cu, fwd_megakernel, NTHREADS, kDynLds);
    if (per_cu < 1) per_cu = 1;
    grid_blocks = cus * per_cu;
  }
  void* args[] = {&p};
  hipError_t e = hipLaunchCooperativeKernel((void*)fwd_megakernel, dim3(grid_blocks), dim3(NTHREADS), args, kDynLds, stream);
  if (e != hipSuccess) fprintf(stderr, "cooperative launch failed: %s (grid %d)\n", hipGetErrorString(e), grid_blocks);
}
```

```cpp
#include <hip/hip_runtime.h>
#include <hip/hip_cooperative_groups.h>
#include <stdint.h>
#include <cstdio>
namespace cg = cooperative_groups;

#define D_MODEL 1024
#define SEQ 4096
#define BATCH 4
#define NTOK (BATCH * SEQ)
#define DEPTH 2
#define IN_WIDTH 5632
#define C_POOL 0
#define C_RQ 256
#define C_RK 512
#define C_RV 768
#define C_RG 1280
#define C_NQ 1792
#define C_NK 2048
#define C_NV 2304
#define C_GATE 2560
#define EPS 1e-6f
#define NTHREADS 512

typedef unsigned short bf16_t;

struct Params {
  const float* x_in; const float* norm_mix; const float* w_in; const float* pool_w; const float* pool_scale;
  const float* ret_decay; const float* na_rpb; const float* w_br_pool; const float* w_br_ret; const float* w_br_na;
  const float* w_out; const float* norm_ffn; const float* w_query; const float* sub_keys; const float* peer_u;
  const float* peer_v; const float* norm_final;
  float* out;
  float* xres;
  bf16_t* xn;
  bf16_t* proj;
  bf16_t* ycat;
  float* merged;
  float* pq;
  float* psc;
  int* pidx;
  float* pgate;
  bf16_t* wf_in;
  bf16_t* wf_br;
  bf16_t* wf_out;
  bf16_t* wf_q;
  bf16_t* kf;
  bf16_t* u16;
  bf16_t* v16;
  float2* rope;
  bf16_t* mrg;
  unsigned* tklist;
  float* kvst;
  bf16_t* rstate;
};

__device__ __forceinline__ bf16_t f2bf(float f) {
  unsigned u = __float_as_uint(f);
  u += 0x7fffu + ((u >> 16) & 1u);
  return (bf16_t)(u >> 16);
}
__device__ __forceinline__ float bf2f(bf16_t h) { return __uint_as_float(((unsigned)h) << 16); }

__device__ __forceinline__ float wave_sum(float v) {
#pragma unroll
  for (int o = 32; o > 0; o >>= 1) v += __shfl_xor(v, o, 64);
  return v;
}
__device__ __forceinline__ float wave_max(float v) {
#pragma unroll
  for (int o = 32; o > 0; o >>= 1) v = fmaxf(v, __shfl_xor(v, o, 64));
  return v;
}
__device__ __forceinline__ float sigmoidf_(float x) { return 1.0f / (1.0f + expf(-x)); }

__device__ __forceinline__ int opaque_tid(int wv) {
  int w = wv;
  asm volatile("" : "+s"(w));
  int lane = __builtin_amdgcn_mbcnt_hi(~0u, __builtin_amdgcn_mbcnt_lo(~0u, 0u));
  asm volatile("" : "+v"(lane));
  return w * 64 + lane;
}
__device__ __forceinline__ int opaque_s(int x) { asm volatile("" : "+s"(x)); return x; }
__device__ __forceinline__ int opaque_bid() { int b = blockIdx.x; asm volatile("" : "+s"(b)); return b; }

template <bool OUT_F32>
__device__ __forceinline__ void n_rmsnorm(const int wv_, const float* __restrict__ x, const float* __restrict__ g, void* outp, int rows) {
  const int tidx_ = opaque_tid(wv_); const int bidx_ = opaque_bid();
  const int lane = tidx_ & 63;
  const int nw = gridDim.x * (NTHREADS / 64);
  for (int row = bidx_ * (NTHREADS / 64) + (tidx_ >> 6); row < rows; row += nw) {
    const float* xr = x + (size_t)row * D_MODEL;
    float4 v[4];
    float ss = 0.f;
#pragma unroll
    for (int i = 0; i < 4; ++i) {
      v[i] = *(const float4*)(xr + i * 256 + lane * 4);
      ss += v[i].x * v[i].x + v[i].y * v[i].y + v[i].z * v[i].z + v[i].w * v[i].w;
    }
    ss = wave_sum(ss);
    float r = rsqrtf(ss * (1.0f / D_MODEL) + EPS);
#pragma unroll
    for (int i = 0; i < 4; ++i) {
      float4 gg = *(const float4*)(g + i * 256 + lane * 4);
      float o0 = v[i].x * r * gg.x, o1 = v[i].y * r * gg.y, o2 = v[i].z * r * gg.z, o3 = v[i].w * r * gg.w;
      if (OUT_F32) {
        *(float4*)((float*)outp + (size_t)row * D_MODEL + i * 256 + lane * 4) = make_float4(o0, o1, o2, o3);
      } else {
        ushort4 o; o.x = f2bf(o0); o.y = f2bf(o1); o.z = f2bf(o2); o.w = f2bf(o3);
        *(ushort4*)((bf16_t*)outp + (size_t)row * D_MODEL + i * 256 + lane * 4) = o;
      }
    }
  }
}

template <bool A_BF16, typename Epi>
__device__ __forceinline__ void n_gemm(const int wv_, const void* Av, int lda, long sA, const float* __restrict__ B, int ldb, long sB,
                                       int transB, int M, int N, int K, int Z, float* smem, Epi epi) {
  const int tidx_ = opaque_tid(wv_); const int bidx_ = opaque_bid();
  const int grp = tidx_ >> 8, tid = tidx_ & 255;
  float(*As)[68] = (float(*)[68])(smem + grp * 2 * 16 * 68);
  float(*Bs)[68] = (float(*)[68])(smem + grp * 2 * 16 * 68 + 16 * 68);
  const int tx = tid & 15, ty = tid >> 4;
  const int tn = N / 64, tm = M / 64;
  const int nwork = tn * tm * Z;
  for (int wb = bidx_ * 2; wb < nwork; wb += gridDim.x * 2) {
    const int w = wb + grp;
    const int z = w / (tn * tm);
    const int rem = w - z * (tn * tm);
    const int bm = (rem / tn) * 64, bn = (rem % tn) * 64;
    const float* Af = (const float*)Av + (size_t)z * sA;
    const bf16_t* Ab = (const bf16_t*)Av + (size_t)z * sA;
    const float* Bz = B + (size_t)z * sB;
    float acc[4][4];
#pragma unroll
    for (int i = 0; i < 4; ++i)
#pragma unroll
      for (int j = 0; j < 4; ++j) acc[i][j] = 0.f;
    for (int k0 = 0; k0 < K; k0 += 16) {
#pragma unroll
      for (int i = 0; i < 4; ++i) {
        int idx = tid + i * 256;
        int m = idx >> 4, k = idx & 15;
        size_t ao = (size_t)(bm + m) * lda + k0 + k;
        As[k][m] = A_BF16 ? bf2f(Ab[ao]) : Af[ao];
        if (transB) {
          int n = idx >> 4, kk = idx & 15;
          Bs[kk][n] = Bz[(size_t)(bn + n) * ldb + k0 + kk];
        } else {
          int kk = idx >> 6, n = idx & 63;
          Bs[kk][n] = Bz[(size_t)(k0 + kk) * ldb + bn + n];
        }
      }
      __syncthreads();
#pragma unroll
      for (int k = 0; k < 16; ++k) {
        float a[4], b[4];
#pragma unroll
        for (int i = 0; i < 4; ++i) a[i] = As[k][ty * 4 + i];
#pragma unroll
        for (int j = 0; j < 4; ++j) b[j] = Bs[k][tx * 4 + j];
#pragma unroll
        for (int i = 0; i < 4; ++i)
#pragma unroll
          for (int j = 0; j < 4; ++j) acc[i][j] = fmaf(a[i], b[j], acc[i][j]);
      }
      __syncthreads();
    }
#pragma unroll
    for (int i = 0; i < 4; ++i)
#pragma unroll
      for (int j = 0; j < 4; ++j) epi(z, bm + ty * 4 + i, bn + tx * 4 + j, acc[i][j]);
  }
}

__device__ __forceinline__ void n_rope(const int wv_, bf16_t* __restrict__ proj) {
  const int tidx_ = opaque_tid(wv_); const int bidx_ = opaque_bid();
  const int total = NTOK * 256;
  for (int gid = bidx_ * NTHREADS + tidx_; gid < total; gid += gridDim.x * NTHREADS) {
    int i = gid & 31, h = (gid >> 5) & 3, qk = (gid >> 7) & 1, t = gid >> 8;
    int pos = t & (SEQ - 1);
    float inv = 1.0f / powf(10000.0f, (float)i / 31.0f);
    float ang = (float)pos * inv;
    double rev = (double)ang * 0.15915494309189535;
    rev -= floor(rev);
    float rf = (float)rev;
    float cs = __builtin_amdgcn_cosf(rf), sn = __builtin_amdgcn_sinf(rf);
    bf16_t* p = proj + (size_t)t * IN_WIDTH + (qk ? C_RK : C_RQ) + h * 64 + i;
    float x1 = bf2f(p[0]), x2 = bf2f(p[32]);
    p[0] = f2bf(x1 * cs - x2 * sn);
    p[32] = f2bf(x1 * sn + x2 * cs);
  }
}

__device__ __forceinline__ void n_pool(const int wv_, const bf16_t* __restrict__ proj, const float* __restrict__ pw,
                                       const float* __restrict__ pscale, bf16_t* __restrict__ ycat, float* smem) {
  const int tidx_ = opaque_tid(wv_); const int bidx_ = opaque_bid();
  const int grp = tidx_ >> 8, c = tidx_ & 255;
  float* diff = smem + grp * 256;
  const int gi = c >> 6;
  const int w = 2 << gi;
  const int lo = w / 2, hi = w - w / 2;
  for (int wb = bidx_ * 2; wb < NTOK; wb += gridDim.x * 2) {
    const int t = wb + grp;
    const int b0 = t & ~(SEQ - 1), pos = t & (SEQ - 1);
    int a = pos - lo; if (a < 0) a = 0;
    int b = pos + hi; if (b > SEQ) b = SEQ;
    float s = 0.f;
    for (int tt = a; tt < b; ++tt) s += bf2f(proj[(size_t)(b0 + tt) * IN_WIDTH + C_POOL + c]);
    float mean = s / (float)(b - a);
    __syncthreads();
    diff[c] = mean - bf2f(proj[(size_t)t * IN_WIDTH + C_POOL + c]);
    __syncthreads();
    const int e = c & 63;
    const float* wg = pw + gi * 64 * 64;
    float acc = 0.f;
    for (int cc = 0; cc < 64; ++cc) acc = fmaf(diff[gi * 64 + cc], wg[cc * 64 + e], acc);
    ycat[(size_t)t * 1024 + c] = f2bf(acc * pscale[c]);
  }
}

__device__ __forceinline__ void n_retention(const int wv_, const bf16_t* __restrict__ proj, const float* __restrict__ decay,
                                            bf16_t* __restrict__ ycat, float* smem) {
  const int tidx_ = opaque_tid(wv_); const int bidx_ = opaque_bid();
  const int grp = tidx_ >> 8, tid = tidx_ & 255;
  float* base = smem + grp * 12544;
  float(*Qs)[65] = (float(*)[65])base;
  float(*Ks)[65] = (float(*)[65])(base + 64 * 65);
  float(*Vs)[128] = (float(*)[128])(base + 64 * 65 + 32 * 65);
  float(*Ps)[33] = (float(*)[33])(base + 64 * 65 + 32 * 65 + 32 * 128);
  const int rg = tid >> 5, cl = tid & 31;
  const int nwork = (NTOK / 64) * 4;
  for (int wb = bidx_ * 2; wb < nwork; wb += gridDim.x * 2) {
    const int w = wb + grp;
    const int h = w & 3, qt = w >> 2;
    const int t0 = qt * 64;
    const int b0 = t0 & ~(SEQ - 1);
    const int q0 = t0 & (SEQ - 1);
    float dlf = decay[h], dlb = decay[4 + h];
    float lgf = fminf(dlf, 0.f) - log1pf(expf(-fabsf(dlf)));
    float lgb = fminf(dlb, 0.f) - log1pf(expf(-fabsf(dlb)));
    __syncthreads();
    for (int idx = tid; idx < 64 * 64; idx += 256) {
      int r = idx >> 6, d = idx & 63;
      Qs[r][d] = bf2f(proj[(size_t)(t0 + r) * IN_WIDTH + C_RQ + h * 64 + d]);
    }
    float acc[8][4];
#pragma unroll
    for (int i = 0; i < 8; ++i)
#pragma unroll
      for (int j = 0; j < 4; ++j) acc[i][j] = 0.f;
    for (int k0 = 0; k0 < SEQ; k0 += 32) {
      __syncthreads();
      for (int idx = tid; idx < 32 * 64; idx += 256) {
        int r = idx >> 6, d = idx & 63;
        Ks[r][d] = bf2f(proj[(size_t)(b0 + k0 + r) * IN_WIDTH + C_RK + h * 64 + d]);
      }
      for (int idx = tid; idx < 32 * 128; idx += 256) {
        int r = idx >> 7, d = idx & 127;
        Vs[r][d] = bf2f(proj[(size_t)(b0 + k0 + r) * IN_WIDTH + C_RV + h * 128 + d]);
      }
      __syncthreads();
      float sc[8];
#pragma unroll
      for (int i = 0; i < 8; ++i) sc[i] = 0.f;
      for (int d = 0; d < 64; ++d) {
        float kv = Ks[cl][d];
#pragma unroll
        for (int i = 0; i < 8; ++i) sc[i] = fmaf(Qs[rg * 8 + i][d], kv, sc[i]);
      }
      const int j = k0 + cl;
#pragma unroll
      for (int i = 0; i < 8; ++i) {
        int qi = q0 + rg * 8 + i;
        float dd = (j <= qi) ? expf(lgf * (float)(qi - j)) : expf(lgb * (float)(j - qi));
        Ps[rg * 8 + i][cl] = sc[i] * dd;
      }
      __syncthreads();
      for (int jj = 0; jj < 32; ++jj) {
        float v[4];
#pragma unroll
        for (int c = 0; c < 4; ++c) v[c] = Vs[jj][cl + 32 * c];
#pragma unroll
        for (int i = 0; i < 8; ++i) {
          float p = Ps[rg * 8 + i][jj];
#pragma unroll
          for (int c = 0; c < 4; ++c) acc[i][c] = fmaf(p, v[c], acc[i][c]);
        }
      }
    }
#pragma unroll
    for (int i = 0; i < 8; ++i) {
      float ss = acc[i][0] * acc[i][0] + acc[i][1] * acc[i][1] + acc[i][2] * acc[i][2] + acc[i][3] * acc[i][3];
#pragma unroll
      for (int o = 16; o > 0; o >>= 1) ss += __shfl_xor(ss, o, 64);
      float r = rsqrtf(ss * (1.0f / 128.0f) + EPS);
      int t = t0 + rg * 8 + i;
#pragma unroll
      for (int c = 0; c < 4; ++c) {
        int col = h * 128 + cl + 32 * c;
        float g = bf2f(proj[(size_t)t * IN_WIDTH + C_RG + col]);
        float sg = g / (1.0f + expf(-g));
        ycat[(size_t)t * 1024 + 256 + col] = f2bf(sg * acc[i][c] * r);
      }
    }
  }
}

__device__ __forceinline__ void n_na(const int wv_, const bf16_t* __restrict__ proj, const float* __restrict__ rpb,
                                     bf16_t* __restrict__ ycat) {
  const int tidx_ = opaque_tid(wv_); const int bidx_ = opaque_bid();
  const int lane = tidx_ & 63;
  const int nw = gridDim.x * (NTHREADS / 64);
  for (int wv = bidx_ * (NTHREADS / 64) + (tidx_ >> 6); wv < NTOK * 4; wv += nw) {
    int h = wv & 3, t = wv >> 2;
    int b0 = t & ~(SEQ - 1), pos = t & (SEQ - 1);
    int r = pos >> 6, c = pos & 63;
    int rs = r - 4; rs = rs < 0 ? 0 : (rs > 56 ? 56 : rs);
    int cs = c - 8; cs = cs < 0 ? 0 : (cs > 48 ? 48 : cs);
    float qv = bf2f(proj[(size_t)t * IN_WIDTH + C_NQ + h * 64 + lane]);
    float s[2];
#pragma unroll
    for (int u = 0; u < 2; ++u) {
      int kk = lane + 64 * u;
      int ri = kk >> 4, cj = kk & 15;
      int kt = b0 + (rs + ri) * 64 + cs + cj;
      const bf16_t* kp = proj + (size_t)kt * IN_WIDTH + C_NK + h * 64;
      float a = 0.f;
      for (int d = 0; d < 64; ++d) a = fmaf(__shfl(qv, d, 64), bf2f(kp[d]), a);
      int di = rs + ri - r + 7;
      int dj = cs + cj - c + 15;
      s[u] = a + rpb[(h * 15 + di) * 31 + dj];
    }
    float m = wave_max(fmaxf(s[0], s[1]));
    float e0 = expf(s[0] - m), e1 = expf(s[1] - m);
    float den = wave_sum(e0 + e1);
    float p0 = e0 / den, p1 = e1 / den;
    float o = 0.f;
    for (int kk = 0; kk < 128; ++kk) {
      float p = __shfl((kk < 64) ? p0 : p1, kk & 63, 64);
      int ri = kk >> 4, cj = kk & 15;
      int kt = b0 + (rs + ri) * 64 + cs + cj;
      o = fmaf(p, bf2f(proj[(size_t)kt * IN_WIDTH + C_NV + h * 64 + lane]), o);
    }
    ycat[(size_t)t * 1024 + 768 + h * 64 + lane] = f2bf(o);
  }
}

#define TKS 256
__device__ __forceinline__ void lds_insert(float* v, int* id, float x, int xi) {
  if (x > v[15 * TKS]) {
    int j = 15;
    while (j > 0 && v[(j - 1) * TKS] < x) {
      v[j * TKS] = v[(j - 1) * TKS];
      id[j * TKS] = id[(j - 1) * TKS];
      --j;
    }
    v[j * TKS] = x;
    id[j * TKS] = xi;
  }
}
__device__ __forceinline__ void n_topk(const int wv_, const float* __restrict__ scores, int* __restrict__ idx,
                                       float* __restrict__ gate, float* smem) {
  const int tidx_ = opaque_tid(wv_); const int bidx_ = opaque_bid();
  const int tid = tidx_;
  if (tid >= TKS) return;
  float* v1 = smem + tid;
  float* v2 = smem + 16 * TKS + tid;
  float* v3 = smem + 32 * TKS + tid;
  int* i1 = (int*)(smem + 48 * TKS) + tid;
  int* i2 = (int*)(smem + 64 * TKS) + tid;
  int* i3 = (int*)(smem + 80 * TKS) + tid;
  for (int gid = bidx_ * TKS + tid; gid < SEQ * 8; gid += gridDim.x * TKS) {
    const float* s = scores + (size_t)gid * 256;
    for (int j = 0; j < 16; ++j) {
      v1[j * TKS] = -3.0e38f; v2[j * TKS] = -3.0e38f; v3[j * TKS] = -3.0e38f;
      i1[j * TKS] = 0; i2[j * TKS] = 0; i3[j * TKS] = 0;
    }
    for (int n = 0; n < 128; ++n) lds_insert(v1, i1, s[n], n);
    for (int n = 0; n < 128; ++n) lds_insert(v2, i2, s[128 + n], n);
    for (int a = 0; a < 16; ++a) {
      float va = v1[a * TKS];
      int ia = i1[a * TKS];
      for (int b = 0; b < 16; ++b) lds_insert(v3, i3, va + v2[b * TKS], ia * 128 + i2[b * TKS]);
    }
    float m = v3[0];
    float den = 0.f;
    for (int j = 0; j < 16; ++j) den += expf(v3[j * TKS] - m);
    for (int j = 0; j < 16; ++j) {
      idx[(size_t)gid * 16 + j] = i3[j * TKS];
      gate[(size_t)gid * 16 + j] = expf(v3[j * TKS] - m) / den;
    }
  }
}

__device__ __forceinline__ void n_experts(const int wv_, const bf16_t* __restrict__ hn, const int* __restrict__ idx,
                                          const float* __restrict__ gate, const float* __restrict__ wu,
                                          const float* __restrict__ wv, float* __restrict__ x, int ntok) {
  const int tidx_ = opaque_tid(wv_); const int bidx_ = opaque_bid();
  const int lane = tidx_ & 63;
  const int nw = gridDim.x * (NTHREADS / 64);
  for (int t = bidx_ * (NTHREADS / 64) + (tidx_ >> 6); t < ntok; t += nw) {
    const bf16_t* hr = hn + (size_t)t * D_MODEL;
    float4 hv[4], acc[4];
#pragma unroll
    for (int i = 0; i < 4; ++i) {
      ushort4 hb = *(const ushort4*)(hr + i * 256 + lane * 4);
      hv[i] = make_float4(bf2f(hb.x), bf2f(hb.y), bf2f(hb.z), bf2f(hb.w));
      acc[i] = make_float4(0.f, 0.f, 0.f, 0.f);
    }
    for (int k = 0; k < 128; ++k) {
      int e = idx[(size_t)t * 128 + k];
      float g = gate[(size_t)t * 128 + k];
      const float* ur = wu + (size_t)e * D_MODEL;
      float a = 0.f;
#pragma unroll
      for (int i = 0; i < 4; ++i) {
        float4 u = *(const float4*)(ur + i * 256 + lane * 4);
        a += hv[i].x * u.x + hv[i].y * u.y + hv[i].z * u.z + hv[i].w * u.w;
      }
      a = wave_sum(a);
      float hh = 0.5f * a * (1.0f + erff(a * 0.70710678118654752f)) * g;
      const float* vr = wv + (size_t)e * D_MODEL;
#pragma unroll
      for (int i = 0; i < 4; ++i) {
        float4 v = *(const float4*)(vr + i * 256 + lane * 4);
        acc[i].x = fmaf(hh, v.x, acc[i].x); acc[i].y = fmaf(hh, v.y, acc[i].y);
        acc[i].z = fmaf(hh, v.z, acc[i].z); acc[i].w = fmaf(hh, v.w, acc[i].w);
      }
    }
    float* xr = x + (size_t)t * D_MODEL;
#pragma unroll
    for (int i = 0; i < 4; ++i) {
      float4 o = *(float4*)(xr + i * 256 + lane * 4);
      o.x += acc[i].x; o.y += acc[i].y; o.z += acc[i].z; o.w += acc[i].w;
      *(float4*)(xr + i * 256 + lane * 4) = o;
    }
  }
}


typedef __attribute__((ext_vector_type(8))) short bf16x8;
typedef __attribute__((ext_vector_type(4))) float f32x4;
#define LDX 1032
#define LDXB (LDX * 2)
#define XTILE_BYTES (64 * LDXB)

__device__ __forceinline__ unsigned pack2bf(float a, float b) { return (unsigned)f2bf(a) | ((unsigned)f2bf(b) << 16); }

__device__ __forceinline__ void prep_frag(const int wv_, const float* __restrict__ W, int K, int N, bf16_t* __restrict__ dst, float* smem) {
  const int tidx_ = opaque_tid(wv_); const int bidx_ = opaque_bid();
  const int grp = tidx_ >> 8, tid = tidx_ & 255;
  float(*T)[65] = (float(*)[65])(smem + grp * 32 * 65);
  const int KS = K / 32, NC = N / 64;
  const int ntiles = KS * NC;
  for (int wb = bidx_ * 2; wb < ntiles; wb += gridDim.x * 2) {
    const int w = wb + grp;
    const int c = w / KS, ks = w - c * KS;
    {
      const int row = tid >> 3, col = (tid & 7) * 8;
      const float* src = W + (size_t)(ks * 32 + row) * N + c * 64 + col;
      float4 a = *(const float4*)src, b = *(const float4*)(src + 4);
      __syncthreads();
      T[row][col + 0] = a.x; T[row][col + 1] = a.y; T[row][col + 2] = a.z; T[row][col + 3] = a.w;
      T[row][col + 4] = b.x; T[row][col + 5] = b.y; T[row][col + 6] = b.z; T[row][col + 7] = b.w;
    }
    __syncthreads();
    {
      const int nt = tid >> 6, lane = tid & 63;
      const int kr = 8 * (lane >> 4), nc = nt * 16 + (lane & 15);
      uint4 o;
      o.x = pack2bf(T[kr + 0][nc], T[kr + 1][nc]);
      o.y = pack2bf(T[kr + 2][nc], T[kr + 3][nc]);
      o.z = pack2bf(T[kr + 4][nc], T[kr + 5][nc]);
      o.w = pack2bf(T[kr + 6][nc], T[kr + 7][nc]);
      *(uint4*)(dst + ((size_t)((c * KS + ks) * 4 + nt) * 64 + lane) * 8) = o;
    }
  }
}

__device__ __forceinline__ void o_prep(const int wv_, const Params& p, float* smem) {
  for (int l = 0; l < DEPTH; ++l) {
    prep_frag(wv_, p.w_in + (size_t)l * D_MODEL * IN_WIDTH, D_MODEL, IN_WIDTH, p.wf_in + (size_t)l * D_MODEL * IN_WIDTH, smem);
    prep_frag(wv_, p.w_br_pool + (size_t)l * 256 * 1024, 256, 1024, p.wf_br + (size_t)l * 1024 * 1024, smem);
    prep_frag(wv_, p.w_br_ret + (size_t)l * 512 * 1024, 512, 1024, p.wf_br + (size_t)l * 1024 * 1024 + 256 * 1024, smem);
    prep_frag(wv_, p.w_br_na + (size_t)l * 256 * 1024, 256, 1024, p.wf_br + (size_t)l * 1024 * 1024 + 768 * 1024, smem);
    prep_frag(wv_, p.w_out + (size_t)l * 1024 * 1024, 1024, 1024, p.wf_out + (size_t)l * 1024 * 1024, smem);
    prep_frag(wv_, p.w_query + (size_t)l * 1024 * 2048, 1024, 2048, p.wf_q + (size_t)l * 1024 * 2048, smem);
  }
  const int tidx_ = opaque_tid(wv_); const int bidx_ = opaque_bid();
  const int gtid = bidx_ * NTHREADS + tidx_, gsz = gridDim.x * NTHREADS;
  for (int u = gtid; u < DEPTH * 2 * 8 * 4 * 64; u += gsz) {
    const int lane = u & 63, s2 = (u >> 6) & 3, kt = (u >> 8) & 7, lp = u >> 11;
    const float* kr = p.sub_keys + ((size_t)lp * 128 + kt * 16 + (lane & 15)) * 128;
    float v[8];
#pragma unroll
    for (int j = 0; j < 8; ++j) v[j] = kr[16 * (2 * s2 + (j >> 2)) + 4 * (lane >> 4) + (j & 3)];
    uint4 o;
    o.x = pack2bf(v[0], v[1]); o.y = pack2bf(v[2], v[3]); o.z = pack2bf(v[4], v[5]); o.w = pack2bf(v[6], v[7]);
    *(uint4*)(p.kf + (size_t)u * 8) = o;
  }
  if (p.u16) {
    const size_t nunits = (size_t)DEPTH * 16384 * 1024 / 8;
    for (size_t u = gtid; u < nunits; u += gsz) {
      float4 a = *(const float4*)(p.peer_u + u * 8), b = *(const float4*)(p.peer_u + u * 8 + 4);
      uint4 o;
      o.x = pack2bf(a.x, a.y); o.y = pack2bf(a.z, a.w); o.z = pack2bf(b.x, b.y); o.w = pack2bf(b.z, b.w);
      *(uint4*)(p.u16 + u * 8) = o;
      a = *(const float4*)(p.peer_v + u * 8); b = *(const float4*)(p.peer_v + u * 8 + 4);
      o.x = pack2bf(a.x, a.y); o.y = pack2bf(a.z, a.w); o.z = pack2bf(b.x, b.y); o.w = pack2bf(b.z, b.w);
      *(uint4*)(p.v16 + u * 8) = o;
    }
  }
  for (int u = gtid; u < SEQ * 32; u += gsz) {
    const int i = u & 31, pos = u >> 5;
    float inv = 1.0f / powf(10000.0f, (float)i / 31.0f);
    float ang = (float)pos * inv;
    double rev = (double)ang * 0.15915494309189535;
    rev -= floor(rev);
    float rf = (float)rev;
    p.rope[u] = make_float2(__builtin_amdgcn_cosf(rf), __builtin_amdgcn_sinf(rf));
  }
}

template <int NT, int PD = 3>
__device__ __forceinline__ void tl_gemm_chunk(const bf16_t* __restrict__ wf, const int KS, const char* xt, const int kbyte0,
                                              f32x4 (&acc)[NT][4], const int lane, const int nt0 = 0) {
  const bf16x8* wp = (const bf16x8*)wf + lane + nt0 * 64;
  const char* xp = xt + (lane & 15) * LDXB + kbyte0 + (lane >> 4) * 16;
  bf16x8 wb[4][NT];
#pragma unroll
  for (int s = 0; s < PD; ++s)
#pragma unroll
    for (int nt = 0; nt < NT; ++nt) wb[s][nt] = wp[(s * 4 + nt) * 64];
  for (int ks = 0; ks < KS; ks += 4) {
#pragma unroll
    for (int u = 0; u < 4; ++u) {
      int kpre = ks + u + PD;
      kpre = kpre < KS ? kpre : KS - 1;
#pragma unroll
      for (int nt = 0; nt < NT; ++nt) wb[(u + PD) & 3][nt] = wp[(kpre * 4 + nt) * 64];
      bf16x8 xf[4];
#pragma unroll
      for (int mt = 0; mt < 4; ++mt) xf[mt] = *(const bf16x8*)(xp + mt * 16 * LDXB + (ks + u) * 64);
#pragma unroll
      for (int nt = 0; nt < NT; ++nt)
#pragma unroll
        for (int mt = 0; mt < 4; ++mt)
          acc[nt][mt] = __builtin_amdgcn_mfma_f32_16x16x32_bf16(wb[u][nt], xf[mt], acc[nt][mt], 0, 0, 0);
    }
  }
}

__device__ __forceinline__ void tile_rmsnorm_to_lds(const float* __restrict__ xsrc, const float* __restrict__ g, int t0,
                                                    char* xt, int wave, int lane) {
#pragma unroll 2
  for (int i = 0; i < 8; ++i) {
    const int tok = wave * 8 + i;
    const float* xr = xsrc + (size_t)(t0 + tok) * D_MODEL;
    float4 v[4];
    float ss = 0.f;
#pragma unroll
    for (int q = 0; q < 4; ++q) {
      v[q] = *(const float4*)(xr + q * 256 + lane * 4);
      ss += v[q].x * v[q].x + v[q].y * v[q].y + v[q].z * v[q].z + v[q].w * v[q].w;
    }
    ss = wave_sum(ss);
    const float r = rsqrtf(ss * (1.0f / D_MODEL) + EPS);
#pragma unroll
    for (int q = 0; q < 4; ++q) {
      float4 gg = *(const float4*)(g + q * 256 + lane * 4);
      uint2 o;
      o.x = pack2bf(v[q].x * r * gg.x, v[q].y * r * gg.y);
      o.y = pack2bf(v[q].z * r * gg.z, v[q].w * r * gg.w);
      *(uint2*)(xt + tok * LDXB + (q * 256 + lane * 4) * 2) = o;
    }
  }
}

__device__ __forceinline__ void o_p1(const int wv_, const Params& p, int l, const float* __restrict__ xsrc, char* smem) {
  const int tidx_ = opaque_tid(wv_); const int bidx_ = opaque_bid();
  const int wave = tidx_ >> 6, lane = tidx_ & 63;
  const bf16_t* wf = p.wf_in + (size_t)l * D_MODEL * IN_WIDTH;
  const float* g = p.norm_mix + l * D_MODEL;
  for (int tile = bidx_; tile < NTOK / 64; tile += gridDim.x) {
    const int t0 = tile * 64;
    __syncthreads();
    tile_rmsnorm_to_lds(xsrc, g, t0, smem, wave, lane);
    __syncthreads();
#pragma unroll 1
    for (int c = wave; c < IN_WIDTH / 64; c += 8) {
      f32x4 acc[4][4];
#pragma unroll
      for (int a = 0; a < 4; ++a)
#pragma unroll
        for (int b = 0; b < 4; ++b) acc[a][b] = (f32x4){0.f, 0.f, 0.f, 0.f};
      tl_gemm_chunk<4>(wf + (size_t)c * 32 * 4 * 64 * 8, 32, smem, 0, acc, lane);
      asm volatile("" ::: "memory");
      if (c >= 4 && c < 12) {
        const float sc = (c >= 8) ? 0.125f : 1.0f;
#pragma unroll
        for (int mt = 0; mt < 4; ++mt) {
          const int tok = t0 + mt * 16 + (lane & 15);
          const int pos = tok & (SEQ - 1);
#pragma unroll
          for (int nt = 0; nt < 2; ++nt) {
            const int i0 = nt * 16 + 4 * (lane >> 4);
            const float4 cs01 = *(const float4*)(p.rope + pos * 32 + i0);
            const float4 cs23 = *(const float4*)(p.rope + pos * 32 + i0 + 2);
            const float cc[4] = {cs01.x, cs01.z, cs23.x, cs23.z};
            const float sn[4] = {cs01.y, cs01.w, cs23.y, cs23.w};
#pragma unroll
            for (int r = 0; r < 4; ++r) {
              const float x1 = acc[nt][mt][r], x2 = acc[nt + 2][mt][r];
              acc[nt][mt][r] = (x1 * cc[r] - x2 * sn[r]) * sc;
              acc[nt + 2][mt][r] = (x1 * sn[r] + x2 * cc[r]) * sc;
            }
          }
        }
      } else if (c >= 28 && c < 32) {
#pragma unroll
        for (int a = 0; a < 4; ++a)
#pragma unroll
          for (int b = 0; b < 4; ++b) acc[a][b] *= 0.125f;
      } else if (c >= 40) {
#pragma unroll
        for (int a = 0; a < 4; ++a)
#pragma unroll
          for (int b = 0; b < 4; ++b)
#pragma unroll
            for (int r = 0; r < 4; ++r) acc[a][b][r] = 1.0f / (1.0f + __expf(-acc[a][b][r]));
      }
#pragma unroll
      for (int mt = 0; mt < 4; ++mt) {
        const int tok = t0 + mt * 16 + (lane & 15);
        bf16_t* dst = p.proj + (size_t)tok * IN_WIDTH + c * 64 + 4 * (lane >> 4);
#pragma unroll
        for (int nt = 0; nt < 4; ++nt) {
          uint2 o;
          o.x = pack2bf(acc[nt][mt][0], acc[nt][mt][1]);
          o.y = pack2bf(acc[nt][mt][2], acc[nt][mt][3]);
          *(uint2*)(dst + nt * 16) = o;
        }
      }
    }
  }
}


__device__ __forceinline__ void tile_load_to_lds(const bf16_t* __restrict__ src, int ld, char* xt, int tid) {
#pragma unroll 4
  for (int it = 0; it < 16; ++it) {
    const int idx = it * NTHREADS + tid;
    const int row = idx >> 7, u = idx & 127;
    const uint4 v = *(const uint4*)(src + (size_t)row * ld + u * 8);
    *(uint4*)(xt + row * LDXB + u * 16) = v;
  }
}

__device__ __forceinline__ void o_p5a1_tile(const Params& p, int l, int t0, char* smem, int tid) {
  const int wave = tid >> 6, lane = tid & 63;
  __syncthreads();
  tile_load_to_lds(p.ycat + (size_t)t0 * 1024, 1024, smem, tid);
  __syncthreads();
  const bf16_t* wfb = p.wf_br + (size_t)l * 1024 * 1024;
#pragma unroll 1
  for (int hc = wave; hc < 32; hc += 8) {
    const int c = hc >> 1, nt0 = (hc & 1) * 2;
    f32x4 m[2][4];
#pragma unroll
    for (int a = 0; a < 2; ++a)
#pragma unroll
      for (int b = 0; b < 4; ++b) m[a][b] = (f32x4){0.f, 0.f, 0.f, 0.f};
#pragma unroll 1
    for (int br = 0; br < 3; ++br) {
      const int koff = (br == 0) ? 0 : (br == 1 ? 256 : 768);
      const int KS = (br == 1) ? 16 : 8;
      f32x4 acc[2][4];
#pragma unroll
      for (int a = 0; a < 2; ++a)
#pragma unroll
        for (int b = 0; b < 4; ++b) acc[a][b] = (f32x4){0.f, 0.f, 0.f, 0.f};
      tl_gemm_chunk<2>(wfb + (size_t)koff * 1024 + (size_t)c * KS * 4 * 64 * 8, KS, smem, koff * 2, acc, lane, nt0);
      asm volatile("" ::: "memory");
#pragma unroll
      for (int mt = 0; mt < 4; ++mt) {
        const int tok = t0 + mt * 16 + (lane & 15);
        const bf16_t* gp = p.proj + (size_t)tok * IN_WIDTH + C_GATE + br * 1024 + c * 64 + nt0 * 16 + 4 * (lane >> 4);
#pragma unroll
        for (int nt = 0; nt < 2; ++nt) {
          const uint2 gv = *(const uint2*)(gp + nt * 16);
          m[nt][mt][0] += __uint_as_float(gv.x << 16) * acc[nt][mt][0];
          m[nt][mt][1] += __uint_as_float(gv.x & 0xffff0000u) * acc[nt][mt][1];
          m[nt][mt][2] += __uint_as_float(gv.y << 16) * acc[nt][mt][2];
          m[nt][mt][3] += __uint_as_float(gv.y & 0xffff0000u) * acc[nt][mt][3];
        }
      }
    }
#pragma unroll
    for (int mt = 0; mt < 4; ++mt) {
      const int tok = t0 + mt * 16 + (lane & 15);
      bf16_t* dst = p.mrg + (size_t)tok * 1024 + c * 64 + nt0 * 16 + 4 * (lane >> 4);
#pragma unroll
      for (int nt = 0; nt < 2; ++nt) {
        uint2 o;
        o.x = pack2bf(m[nt][mt][0], m[nt][mt][1]);
        o.y = pack2bf(m[nt][mt][2], m[nt][mt][3]);
        *(uint2*)(dst + nt * 16) = o;
      }
    }
  }
}
__device__ __forceinline__ void o_p5a2_tile(const Params& p, int l, const float* __restrict__ xcur, int t0, char* smem, int tid) {
  const int wave = tid >> 6, lane = tid & 63;
  __syncthreads();
  tile_load_to_lds(p.mrg + (size_t)t0 * 1024, 1024, smem, tid);
  __syncthreads();
  const bf16_t* wfo = p.wf_out + (size_t)l * 1024 * 1024;
#pragma unroll 1
  for (int c = wave; c < 16; c += 8) {
    f32x4 acc[4][4];
#pragma unroll
    for (int a = 0; a < 4; ++a)
#pragma unroll
      for (int b = 0; b < 4; ++b) acc[a][b] = (f32x4){0.f, 0.f, 0.f, 0.f};
    tl_gemm_chunk<4, 2>(wfo + (size_t)c * 32 * 4 * 64 * 8, 32, smem, 0, acc, lane);
    asm volatile("" ::: "memory");
#pragma unroll
    for (int mt = 0; mt < 4; ++mt) {
      const int tok = t0 + mt * 16 + (lane & 15);
      const size_t o = (size_t)tok * 1024 + c * 64 + 4 * (lane >> 4);
#pragma unroll
      for (int nt = 0; nt < 4; ++nt) {
        float4 xv = *(const float4*)(xcur + o + nt * 16);
        xv.x += acc[nt][mt][0]; xv.y += acc[nt][mt][1]; xv.z += acc[nt][mt][2]; xv.w += acc[nt][mt][3];
        *(float4*)(p.xres + o + nt * 16) = xv;
      }
    }
  }
}
__device__ __forceinline__ void o_p5a3_tile(const Params& p, int l, int t0, char* smem, int tid) {
  const int wave = tid >> 6, lane = tid & 63;
  __syncthreads();
  tile_rmsnorm_to_lds(p.xres, p.norm_ffn + l * D_MODEL, t0, smem, wave, lane);
  __syncthreads();
}


__device__ __forceinline__ unsigned mono_f(float f) {
  unsigned u = __float_as_uint(f);
  return (u & 0x80000000u) ? ~u : (u | 0x80000000u);
}
__device__ __forceinline__ float unmono_f(unsigned m) {
  return __uint_as_float((m & 0x80000000u) ? (m & 0x7fffffffu) : ~m);
}
#define CE_DESC(x, y) { const unsigned hi_ = max(x, y); const unsigned lo_ = min(x, y); x = hi_; y = lo_; }
#define CE_ASC(x, y) { const unsigned hi_ = max(x, y); const unsigned lo_ = min(x, y); x = lo_; y = hi_; }
__device__ __forceinline__ void sort16_desc(unsigned (&a)[16]) {
#pragma unroll
  for (int k = 2; k <= 16; k <<= 1) {
#pragma unroll
    for (int j = k >> 1; j > 0; j >>= 1) {
#pragma unroll
      for (int i = 0; i < 16; ++i) {
        const int l = i ^ j;
        if (l > i) {
          if ((i & k) == 0) CE_DESC(a[i], a[l]) else CE_ASC(a[i], a[l])
        }
      }
    }
  }
}
__device__ __forceinline__ void bitonic_merge16_desc(unsigned (&a)[16]) {
#pragma unroll
  for (int j = 8; j > 0; j >>= 1) {
#pragma unroll
    for (int i = 0; i < 16; ++i) {
      const int l = i ^ j;
      if (l > i) CE_DESC(a[i], a[l])
    }
  }
}
__device__ __forceinline__ void xlane_merge16(unsigned (&a)[16], int mask) {
  unsigned b[16];
#pragma unroll
  for (int i = 0; i < 16; ++i) b[i] = (unsigned)__shfl_xor((int)a[i], mask, 64);
#pragma unroll
  for (int i = 0; i < 16; ++i) a[i] = max(a[i], b[15 - i]);
  bitonic_merge16_desc(a);
}

__device__ __forceinline__ void o_peer_select_tile(const Params& p, int l, int t0, char* smem, int tid) {
  const int h = __builtin_amdgcn_readfirstlane(tid >> 6), lane = tid & 63;
  const int g = lane >> 4, tl = lane & 15;
  const bf16_t* wfq = p.wf_q + (size_t)l * 1024 * 2048;
#pragma unroll 1
  for (int pp = 0; pp < 2; ++pp) {
    bf16x8 qf[4][4];
#pragma unroll 1
    for (int cc = 0; cc < 2; ++cc) {
      const int c = (h * 2 + pp) * 2 + cc;
      f32x4 acc[4][4];
#pragma unroll
      for (int a = 0; a < 4; ++a)
#pragma unroll
        for (int b = 0; b < 4; ++b) acc[a][b] = (f32x4){0.f, 0.f, 0.f, 0.f};
      tl_gemm_chunk<4, 2>(wfq + (size_t)c * 32 * 4 * 64 * 8, 32, smem, 0, acc, lane);
#pragma unroll
      for (int sl = 0; sl < 2; ++sl)
#pragma unroll
        for (int mt = 0; mt < 4; ++mt) {
          union { bf16x8 v; unsigned u[4]; } cv;
          cv.u[0] = pack2bf(acc[2 * sl][mt][0], acc[2 * sl][mt][1]);
          cv.u[1] = pack2bf(acc[2 * sl][mt][2], acc[2 * sl][mt][3]);
          cv.u[2] = pack2bf(acc[2 * sl + 1][mt][0], acc[2 * sl + 1][mt][1]);
          cv.u[3] = pack2bf(acc[2 * sl + 1][mt][2], acc[2 * sl + 1][mt][3]);
          if (cc == 0) qf[sl][mt] = cv.v; else qf[2 + sl][mt] = cv.v;
        }
    }
    const bf16x8* kfp = (const bf16x8*)p.kf + (size_t)((l * 2 + pp) * 8) * 4 * 64 + lane;
#pragma unroll
    for (int mt = 0; mt < 4; ++mt) {
      f32x4 sc[8];
#pragma unroll
      for (int kt = 0; kt < 8; ++kt) sc[kt] = (f32x4){0.f, 0.f, 0.f, 0.f};
#pragma unroll
      for (int s2 = 0; s2 < 4; ++s2) {
        bf16x8 qv;
        qv = qf[s2][mt];
#pragma unroll
        for (int kt = 0; kt < 8; ++kt)
          sc[kt] = __builtin_amdgcn_mfma_f32_16x16x32_bf16(kfp[(kt * 4 + s2) * 64], qv, sc[kt], 0, 0, 0);
        __builtin_amdgcn_sched_barrier(0);
      }
      unsigned A[16], B[16];
#pragma unroll
      for (int kt = 0; kt < 4; ++kt)
#pragma unroll
        for (int r = 0; r < 4; ++r) {
          A[kt * 4 + r] = (mono_f(sc[kt][r]) & ~127u) | (unsigned)(127 - (kt * 16 + r) - 4 * g);
          B[kt * 4 + r] = (mono_f(sc[kt + 4][r]) & ~127u) | (unsigned)(127 - ((kt + 4) * 16 + r) - 4 * g);
        }
      sort16_desc(A);
      sort16_desc(B);
#pragma unroll
      for (int i = 0; i < 16; ++i) A[i] = max(A[i], B[15 - i]);
      bitonic_merge16_desc(A);
      xlane_merge16(A, 16);
      xlane_merge16(A, 32);
      if (g == 0) {
        uint4* dst = (uint4*)(p.tklist + ((size_t)((t0 + mt * 16 + tl) * 8 + h) * 2 + pp) * 16);
        dst[0] = make_uint4(A[0], A[1], A[2], A[3]);
        dst[1] = make_uint4(A[4], A[5], A[6], A[7]);
        dst[2] = make_uint4(A[8], A[9], A[10], A[11]);
        dst[3] = make_uint4(A[12], A[13], A[14], A[15]);
      }
    }
  }
  asm volatile("s_waitcnt vmcnt(0)" ::: "memory");
}

__device__ __forceinline__ void o_peer_select2_tile(const Params& p, int l, int t0, int tid) {
  const int h = __builtin_amdgcn_readfirstlane(tid >> 6), lane = tid & 63;
  const int g = lane >> 4, tl = lane & 15;
#pragma unroll 1
  for (int mt = 0; mt < 4; ++mt) {
    const int tok = t0 + mt * 16 + tl;
    const unsigned* lp = p.tklist + ((size_t)(tok * 8 + h) * 2) * 16;
    float v1[16], v2[16];
    {
      const uint4* q4 = (const uint4*)lp;
#pragma unroll
      for (int i = 0; i < 4; ++i) {
        uint4 x = q4[i], y = q4[4 + i];
        v1[4 * i + 0] = unmono_f(x.x & ~127u); v1[4 * i + 1] = unmono_f(x.y & ~127u);
        v1[4 * i + 2] = unmono_f(x.z & ~127u); v1[4 * i + 3] = unmono_f(x.w & ~127u);
        v2[4 * i + 0] = unmono_f(y.x & ~127u); v2[4 * i + 1] = unmono_f(y.y & ~127u);
        v2[4 * i + 2] = unmono_f(y.z & ~127u); v2[4 * i + 3] = unmono_f(y.w & ~127u);
      }
    }
    unsigned C[16];
#pragma unroll
    for (int i = 0; i < 16; ++i) C[i] = 0u;
    {
      int idx = 0;
#pragma unroll
      for (int a = 0; a < 16; ++a) {
#pragma unroll
        for (int b = 0; b < 16; ++b) {
          if ((a + 1) * (b + 1) <= 16) {
            const unsigned key = (mono_f(v1[a] + v2[b]) & ~255u) | (unsigned)(255 - (a * 16 + b));
            const int slot = idx >> 2, who = idx & 3;
            C[slot] = (g == who) ? key : C[slot];
            ++idx;
          }
        }
      }
    }
    sort16_desc(C);
    xlane_merge16(C, 16);
    xlane_merge16(C, 32);
    const float f0 = unmono_f(C[0] & ~255u);
    float den = 0.f;
    float ev[16];
#pragma unroll
    for (int i = 0; i < 16; ++i) { ev[i] = __expf(unmono_f(C[i] & ~255u) - f0); den += ev[i]; }
    const float rden = 1.0f / den;
    int eidx[4]; float egate[4];
#pragma unroll
    for (int i = 0; i < 4; ++i) {
      const unsigned k = (g == 0) ? C[i] : (g == 1) ? C[4 + i] : (g == 2) ? C[8 + i] : C[12 + i];
      const float e = (g == 0) ? ev[i] : (g == 1) ? ev[4 + i] : (g == 2) ? ev[8 + i] : ev[12 + i];
      const int pos = 255 - (int)(k & 255u);
      const int a = pos >> 4, b = pos & 15;
      const int n1 = 127 - (int)(lp[a] & 127u);
      const int n2 = 127 - (int)(lp[16 + b] & 127u);
      eidx[i] = n1 * 128 + n2;
      egate[i] = e * rden;
    }
    *(int4*)(p.pidx + (size_t)tok * 128 + h * 16 + 4 * g) = make_int4(eidx[0], eidx[1], eidx[2], eidx[3]);
    *(float4*)(p.pgate + (size_t)tok * 128 + h * 16 + 4 * g) = make_float4(egate[0], egate[1], egate[2], egate[3]);
  }
}

__device__ __forceinline__ void o_peer_experts_tile(const Params& p, int l, int t0, const char* smem, int tid) {
  const int wave = tid >> 6, lane = tid & 63;
  const bf16_t* U = p.u16 + (size_t)l * 16384 * 1024;
  const bf16_t* V = p.v16 + (size_t)l * 16384 * 1024;
  int vz = 0;
  asm volatile("" : "+v"(vz));
#pragma unroll 1
  for (int i8 = 0; i8 < 8; ++i8) {
    const int tl = wave * 8 + i8;
    const int tok = t0 + tl;
    float hv[16], acc[16];
    {
      const uint4 h0 = *(const uint4*)(smem + tl * LDXB + lane * 16);
      const uint4 h1 = *(const uint4*)(smem + tl * LDXB + 1024 + lane * 16);
      const unsigned hw[8] = {h0.x, h0.y, h0.z, h0.w, h1.x, h1.y, h1.z, h1.w};
#pragma unroll
      for (int j = 0; j < 8; ++j) {
        hv[2 * j] = __uint_as_float(hw[j] << 16);
        hv[2 * j + 1] = __uint_as_float(hw[j] & 0xffff0000u);
        acc[2 * j] = 0.f; acc[2 * j + 1] = 0.f;
      }
    }
    const int* ip = p.pidx + (size_t)tok * 128 + vz;
    const float* gp = p.pgate + (size_t)tok * 128 + vz;
#pragma unroll 1
    for (int k = 0; k < 128; k += 4) {
      const int4 e4 = *(const int4*)(ip + k);
      const float4 g4 = *(const float4*)(gp + k);
      const int ee[4] = {e4.x, e4.y, e4.z, e4.w};
      const float gg[4] = {g4.x, g4.y, g4.z, g4.w};
      uint4 ur[4][2];
#pragma unroll
      for (int q = 0; q < 4; ++q) {
        const char* up = (const char*)(U + (size_t)ee[q] * 1024) + lane * 16;
        ur[q][0] = *(const uint4*)up;
        ur[q][1] = *(const uint4*)(up + 1024);
      }
      uint4 vr[4][2];
#pragma unroll
      for (int q = 0; q < 4; ++q) {
        const char* vp = (const char*)(V + (size_t)ee[q] * 1024) + lane * 16;
        vr[q][0] = *(const uint4*)vp;
        vr[q][1] = *(const uint4*)(vp + 1024);
      }
      float hh[4];
#pragma unroll
      for (int q = 0; q < 4; ++q) {
        const unsigned uw[8] = {ur[q][0].x, ur[q][0].y, ur[q][0].z, ur[q][0].w, ur[q][1].x, ur[q][1].y, ur[q][1].z, ur[q][1].w};
        float a = 0.f;
#pragma unroll
        for (int j = 0; j < 8; ++j) {
          a = fmaf(hv[2 * j], __uint_as_float(uw[j] << 16), a);
          a = fmaf(hv[2 * j + 1], __uint_as_float(uw[j] & 0xffff0000u), a);
        }
        a = wave_sum(a);
        hh[q] = 0.5f * a * (1.0f + erff(a * 0.70710678118654752f)) * gg[q];
      }
#pragma unroll
      for (int q = 0; q < 4; ++q) {
        const unsigned vw[8] = {vr[q][0].x, vr[q][0].y, vr[q][0].z, vr[q][0].w, vr[q][1].x, vr[q][1].y, vr[q][1].z, vr[q][1].w};
#pragma unroll
        for (int j = 0; j < 8; ++j) {
          acc[2 * j] = fmaf(hh[q], __uint_as_float(vw[j] << 16), acc[2 * j]);
          acc[2 * j + 1] = fmaf(hh[q], __uint_as_float(vw[j] & 0xffff0000u), acc[2 * j + 1]);
        }
      }
    }
    float* xr = p.xres + (size_t)tok * 1024 + lane * 8;
#pragma unroll
    for (int i = 0; i < 2; ++i) {
      float4 a0 = *(float4*)(xr + i * 512), a1 = *(float4*)(xr + i * 512 + 4);
      a0.x += acc[8 * i + 0]; a0.y += acc[8 * i + 1]; a0.z += acc[8 * i + 2]; a0.w += acc[8 * i + 3];
      a1.x += acc[8 * i + 4]; a1.y += acc[8 * i + 5]; a1.z += acc[8 * i + 6]; a1.w += acc[8 * i + 7];
      *(float4*)(xr + i * 512) = a0;
      *(float4*)(xr + i * 512 + 4) = a1;
    }
  }
}


__device__ __forceinline__ float logsigmoid_(float x) { return fminf(x, 0.f) - log1pf(expf(-fabsf(x))); }
__device__ __forceinline__ float bf_lo(unsigned w) { return __uint_as_float(w << 16); }
__device__ __forceinline__ float bf_hi(unsigned w) { return __uint_as_float(w & 0xffff0000u); }

#define RKV_LD 136
__device__ __forceinline__ void o_ret_kv_task(const Params& p, int l, int task, char* smem, int tid) {
  const int wave = tid >> 6, lane = tid & 63, g = lane >> 4, tl = lane & 15;
  const int bh = task >> 5, n = task & 31, b = bh >> 2, h = bh & 3;
  const int tok0 = b * SEQ + n * 128;
  const float lgf = logsigmoid_(p.ret_decay[l * 8 + h]), lgb = logsigmoid_(p.ret_decay[l * 8 + 4 + h]);
  bf16_t* KTf = (bf16_t*)smem;
  bf16_t* KTb = KTf + 64 * RKV_LD;
  bf16_t* VT = KTb + 64 * RKV_LD;
  __syncthreads();
#pragma unroll
  for (int it = 0; it < 2; ++it) {
    const int u = tid + it * NTHREADS;
    const int j = u >> 3, d0 = (u & 7) * 8;
    const uint4 kv = *(const uint4*)(p.proj + (size_t)(tok0 + j) * IN_WIDTH + C_RK + h * 64 + d0);
    const float wf = __expf(lgf * (float)(127 - j)), wb = __expf(lgb * (float)(j + 1));
    const unsigned kw[4] = {kv.x, kv.y, kv.z, kv.w};
#pragma unroll
    for (int e = 0; e < 4; ++e) {
      const float x0 = bf_lo(kw[e]), x1 = bf_hi(kw[e]);
      KTf[(d0 + 2 * e) * RKV_LD + j] = f2bf(x0 * wf);
      KTf[(d0 + 2 * e + 1) * RKV_LD + j] = f2bf(x1 * wf);
      KTb[(d0 + 2 * e) * RKV_LD + j] = f2bf(x0 * wb);
      KTb[(d0 + 2 * e + 1) * RKV_LD + j] = f2bf(x1 * wb);
    }
  }
#pragma unroll
  for (int it = 0; it < 4; ++it) {
    const int u = tid + it * NTHREADS;
    const int j = u >> 4, e0 = (u & 15) * 8;
    const uint4 vv = *(const uint4*)(p.proj + (size_t)(tok0 + j) * IN_WIDTH + C_RV + h * 128 + e0);
    const unsigned vw[4] = {vv.x, vv.y, vv.z, vv.w};
#pragma unroll
    for (int e = 0; e < 4; ++e) {
      VT[(e0 + 2 * e) * RKV_LD + j] = (bf16_t)(vw[e] & 0xffffu);
      VT[(e0 + 2 * e + 1) * RKV_LD + j] = (bf16_t)(vw[e] >> 16);
    }
  }
  __syncthreads();
  bf16x8 a[4];
#pragma unroll
  for (int ks = 0; ks < 4; ++ks) a[ks] = *(const bf16x8*)(VT + (wave * 16 + tl) * RKV_LD + ks * 32 + 8 * g);
#pragma unroll
  for (int dir = 0; dir < 2; ++dir) {
    const bf16_t* KT = dir ? KTb : KTf;
#pragma unroll
    for (int dt = 0; dt < 4; ++dt) {
      f32x4 acc = (f32x4){0.f, 0.f, 0.f, 0.f};
#pragma unroll
      for (int ks = 0; ks < 4; ++ks) {
        const bf16x8 bb = *(const bf16x8*)(KT + (dt * 16 + tl) * RKV_LD + ks * 32 + 8 * g);
        acc = __builtin_amdgcn_mfma_f32_16x16x32_bf16(a[ks], bb, acc, 0, 0, 0);
      }
      float* dst = p.kvst + ((size_t)(task * 2 + dir) * 128 + wave * 16 + 4 * g) * 64 + dt * 16 + tl;
#pragma unroll
      for (int r = 0; r < 4; ++r) dst[r * 64] = acc[r];
    }
  }
}

__device__ __forceinline__ void o_ret_scan(const int wv_, const Params& p, int l) {
  const int tidx_ = opaque_tid(wv_); const int bidx_ = opaque_bid();
  const int gsz = gridDim.x * NTHREADS;
  for (int u = bidx_ * NTHREADS + tidx_; u < 16 * 2 * 128 * 16; u += gsz) {
    const int dq = u & 15, e = (u >> 4) & 127, dir = (u >> 11) & 1, bh = u >> 12, h = bh & 3;
    const float lg = logsigmoid_(p.ret_decay[l * 8 + dir * 4 + h]);
    const float gC = __expf(lg * 128.0f);
    float4 st = make_float4(0.f, 0.f, 0.f, 0.f);
#pragma unroll 8
    for (int nn = 0; nn < 32; ++nn) {
      const int n = dir ? (31 - nn) : nn;
      const size_t idx = ((size_t)((bh * 32 + n) * 2 + dir) * 128 + e) * 64 + dq * 4;
      const float4 kv = *(const float4*)(p.kvst + idx);
      uint2 o;
      o.x = pack2bf(st.x, st.y); o.y = pack2bf(st.z, st.w);
      *(uint2*)(p.rstate + idx) = o;
      st.x = fmaf(st.x, gC, kv.x); st.y = fmaf(st.y, gC, kv.y); st.z = fmaf(st.z, gC, kv.z); st.w = fmaf(st.w, gC, kv.w);
    }
  }
}

#define RO_LD 264
#define RK_LD 72
__device__ __forceinline__ void o_ret_out_task(const Params& p, int l, int task, char* smem, int tid) {
  const int wave = tid >> 6, lane = tid & 63, g = lane >> 4, tl = lane & 15;
  const int bh = task >> 5, n = task & 31, b = bh >> 2, h = bh & 3;
  const int tok0 = b * SEQ + n * 128;
  const float lgf = logsigmoid_(p.ret_decay[l * 8 + h]), lgb = logsigmoid_(p.ret_decay[l * 8 + 4 + h]);
  bf16_t* Acat = (bf16_t*)smem;
  bf16_t* Bcat = Acat + 128 * RO_LD;
  bf16_t* Kl = Bcat + 128 * RO_LD;
  __syncthreads();
#pragma unroll
  for (int it = 0; it < 2; ++it) {
    const int u = tid + it * NTHREADS;
    const int i = u >> 3, d0 = (u & 7) * 8;
    const size_t row = (size_t)(tok0 + i) * IN_WIDTH;
    const uint4 qv = *(const uint4*)(p.proj + row + C_RQ + h * 64 + d0);
    const uint4 kv = *(const uint4*)(p.proj + row + C_RK + h * 64 + d0);
    *(uint4*)(Acat + i * RO_LD + d0) = qv;
    *(uint4*)(Kl + i * RK_LD + d0) = kv;
    const float wf = __expf(lgf * (float)(i + 1)), wb = __expf(lgb * (float)(127 - i));
    const unsigned qw[4] = {qv.x, qv.y, qv.z, qv.w};
    uint4 of, ob;
    of.x = pack2bf(bf_lo(qw[0]) * wf, bf_hi(qw[0]) * wf); ob.x = pack2bf(bf_lo(qw[0]) * wb, bf_hi(qw[0]) * wb);
    of.y = pack2bf(bf_lo(qw[1]) * wf, bf_hi(qw[1]) * wf); ob.y = pack2bf(bf_lo(qw[1]) * wb, bf_hi(qw[1]) * wb);
    of.z = pack2bf(bf_lo(qw[2]) * wf, bf_hi(qw[2]) * wf); ob.z = pack2bf(bf_lo(qw[2]) * wb, bf_hi(qw[2]) * wb);
    of.w = pack2bf(bf_lo(qw[3]) * wf, bf_hi(qw[3]) * wf); ob.w = pack2bf(bf_lo(qw[3]) * wb, bf_hi(qw[3]) * wb);
    *(uint4*)(Acat + i * RO_LD + 128 + d0) = of;
    *(uint4*)(Acat + i * RO_LD + 192 + d0) = ob;
  }
#pragma unroll
  for (int it = 0; it < 4; ++it) {
    const int u = tid + it * NTHREADS;
    const int j = u >> 4, e0 = (u & 15) * 8;
    const uint4 vv = *(const uint4*)(p.proj + (size_t)(tok0 + j) * IN_WIDTH + C_RV + h * 128 + e0);
    const unsigned vw[4] = {vv.x, vv.y, vv.z, vv.w};
#pragma unroll
    for (int e = 0; e < 4; ++e) {
      Bcat[(e0 + 2 * e) * RO_LD + j] = (bf16_t)(vw[e] & 0xffffu);
      Bcat[(e0 + 2 * e + 1) * RO_LD + j] = (bf16_t)(vw[e] >> 16);
    }
  }
#pragma unroll
  for (int it = 0; it < 4; ++it) {
    const int u = tid + it * NTHREADS;
    const int d0 = (u & 7) * 8, e = (u >> 3) & 127, dir = u >> 10;
    const uint4 sv = *(const uint4*)(p.rstate + ((size_t)(task * 2 + dir) * 128 + e) * 64 + d0);
    *(uint4*)(Bcat + e * RO_LD + 128 + dir * 64 + d0) = sv;
  }
  __syncthreads();
  f32x4 sc[8];
#pragma unroll
  for (int jt = 0; jt < 8; ++jt) sc[jt] = (f32x4){0.f, 0.f, 0.f, 0.f};
#pragma unroll
  for (int ks = 0; ks < 2; ++ks) {
    const bf16x8 qb = *(const bf16x8*)(Acat + (wave * 16 + tl) * RO_LD + ks * 32 + 8 * g);
#pragma unroll
    for (int jt = 0; jt < 8; ++jt) {
      const bf16x8 ka = *(const bf16x8*)(Kl + (jt * 16 + tl) * RK_LD + ks * 32 + 8 * g);
      sc[jt] = __builtin_amdgcn_mfma_f32_16x16x32_bf16(ka, qb, sc[jt], 0, 0, 0);
    }
  }
  {
    const int i = wave * 16 + tl;
#pragma unroll
    for (int jt = 0; jt < 8; ++jt) {
      float pv[4];
#pragma unroll
      for (int r = 0; r < 4; ++r) {
        const int j = jt * 16 + 4 * g + r;
        const float dd = (j <= i) ? __expf(lgf * (float)(i - j)) : __expf(lgb * (float)(j - i));
        pv[r] = sc[jt][r] * dd;
      }
      uint2 o;
      o.x = pack2bf(pv[0], pv[1]); o.y = pack2bf(pv[2], pv[3]);
      *(uint2*)(Acat + i * RO_LD + jt * 16 + 4 * g) = o;
    }
  }
  f32x4 y[8];
#pragma unroll
  for (int et = 0; et < 8; ++et) y[et] = (f32x4){0.f, 0.f, 0.f, 0.f};
#pragma unroll
  for (int ks = 0; ks < 8; ++ks) {
    const bf16x8 ab = *(const bf16x8*)(Acat + (wave * 16 + tl) * RO_LD + ks * 32 + 8 * g);
#pragma unroll
    for (int et = 0; et < 8; ++et) {
      const bf16x8 ba = *(const bf16x8*)(Bcat + (et * 16 + tl) * RO_LD + ks * 32 + 8 * g);
      y[et] = __builtin_amdgcn_mfma_f32_16x16x32_bf16(ba, ab, y[et], 0, 0, 0);
    }
  }
  float ss = 0.f;
#pragma unroll
  for (int et = 0; et < 8; ++et)
#pragma unroll
    for (int r = 0; r < 4; ++r) ss = fmaf(y[et][r], y[et][r], ss);
  ss += __shfl_xor(ss, 16, 64);
  ss += __shfl_xor(ss, 32, 64);
  const float rstd = rsqrtf(ss * (1.0f / 128.0f) + EPS);
  {
    const int tok = tok0 + wave * 16 + tl;
    const bf16_t* gp = p.proj + (size_t)tok * IN_WIDTH + C_RG + h * 128 + 4 * g;
    bf16_t* dst = p.ycat + (size_t)tok * 1024 + 256 + h * 128 + 4 * g;
#pragma unroll
    for (int et = 0; et < 8; ++et) {
      const uint2 gv = *(const uint2*)(gp + et * 16);
      const float g0 = bf_lo(gv.x), g1 = bf_hi(gv.x), g2 = bf_lo(gv.y), g3 = bf_hi(gv.y);
      uint2 o;
      o.x = pack2bf(g0 / (1.0f + __expf(-g0)) * y[et][0] * rstd, g1 / (1.0f + __expf(-g1)) * y[et][1] * rstd);
      o.y = pack2bf(g2 / (1.0f + __expf(-g2)) * y[et][2] * rstd, g3 / (1.0f + __expf(-g3)) * y[et][3] * rstd);
      *(uint2*)(dst + et * 16) = o;
    }
  }
}


#define NA_KLD 72
#define NA_VLD 520
__device__ __forceinline__ void o_na_task(const Params& p, int l, int task, char* smem, int tid) {
  const int wave = tid >> 6, lane = tid & 63, g = lane >> 4, tl = lane & 15;
  const int rr = task & 63, h = (task >> 6) & 3, b = task >> 8;
  int rs = rr - 4; rs = rs < 0 ? 0 : (rs > 56 ? 56 : rs);
  const int ktok0 = b * SEQ + rs * 64;
  const int qtok0 = b * SEQ + rr * 64;
  bf16_t* Kl = (bf16_t*)smem;
  bf16_t* VT = Kl + 512 * NA_KLD;
  bf16_t* Ql = VT + 64 * NA_VLD;
  float* rpbl = (float*)(Ql + 64 * NA_KLD);
  __syncthreads();
#pragma unroll
  for (int it = 0; it < 8; ++it) {
    const int u = tid + it * NTHREADS;
    const int key = u >> 3, d0 = (u & 7) * 8;
    const size_t row = (size_t)(ktok0 + key) * IN_WIDTH;
    const uint4 kv = *(const uint4*)(p.proj + row + C_NK + h * 64 + d0);
    const uint4 vv = *(const uint4*)(p.proj + row + C_NV + h * 64 + d0);
    *(uint4*)(Kl + key * NA_KLD + d0) = kv;
    const unsigned vw[4] = {vv.x, vv.y, vv.z, vv.w};
#pragma unroll
    for (int e = 0; e < 4; ++e) {
      VT[(d0 + 2 * e) * NA_VLD + key] = (bf16_t)(vw[e] & 0xffffu);
      VT[(d0 + 2 * e + 1) * NA_VLD + key] = (bf16_t)(vw[e] >> 16);
    }
  }
  {
    const int q = tid >> 3, d0 = (tid & 7) * 8;
    *(uint4*)(Ql + q * NA_KLD + d0) = *(const uint4*)(p.proj + (size_t)(qtok0 + q) * IN_WIDTH + C_NQ + h * 64 + d0);
    if (tid < 465) rpbl[tid] = p.na_rpb[((size_t)l * 4 + h) * 465 + tid];
  }
  __syncthreads();
  if (wave < 4) {
    const int qt = wave;
    int cw0 = 16 * qt - 8; cw0 = cw0 < 0 ? 0 : (cw0 > 32 ? 32 : cw0);
    f32x4 sc[16];
#pragma unroll
    for (int T = 0; T < 16; ++T) sc[T] = (f32x4){0.f, 0.f, 0.f, 0.f};
#pragma unroll
    for (int ks = 0; ks < 2; ++ks) {
      const bf16x8 qb = *(const bf16x8*)(Ql + (qt * 16 + tl) * NA_KLD + ks * 32 + 8 * g);
#pragma unroll
      for (int T = 0; T < 16; ++T) {
        const int key = (T >> 1) * 64 + cw0 + (T & 1) * 16 + tl;
        const bf16x8 ka = *(const bf16x8*)(Kl + key * NA_KLD + ks * 32 + 8 * g);
        sc[T] = __builtin_amdgcn_mfma_f32_16x16x32_bf16(ka, qb, sc[T], 0, 0, 0);
      }
    }
    const int cq = qt * 16 + tl;
    int cs = cq - 8; cs = cs < 0 ? 0 : (cs > 48 ? 48 : cs);
    float m = -3.0e38f;
#pragma unroll
    for (int T = 0; T < 16; ++T) {
      const int ri = T >> 1;
      const int di = rs + ri - rr + 7;
#pragma unroll
      for (int r = 0; r < 4; ++r) {
        const int ck = cw0 + (T & 1) * 16 + 4 * g + r;
        const bool valid = (ck >= cs) && (ck < cs + 16);
        int dj = ck - cq + 15; dj = dj < 0 ? 0 : (dj > 30 ? 30 : dj);
        const float sv = valid ? (sc[T][r] + rpbl[di * 31 + dj]) : -1.0e30f;
        sc[T][r] = sv;
        m = fmaxf(m, sv);
      }
    }
    m = fmaxf(m, __shfl_xor(m, 16, 64));
    m = fmaxf(m, __shfl_xor(m, 32, 64));
    float den = 0.f;
#pragma unroll
    for (int T = 0; T < 16; ++T)
#pragma unroll
      for (int r = 0; r < 4; ++r) {
        const float e = __expf(sc[T][r] - m);
        sc[T][r] = e;
        den += e;
      }
    den += __shfl_xor(den, 16, 64);
    den += __shfl_xor(den, 32, 64);
    const float rden = 1.0f / den;
    f32x4 o[4];
#pragma unroll
    for (int dt = 0; dt < 4; ++dt) o[dt] = (f32x4){0.f, 0.f, 0.f, 0.f};
#pragma unroll
    for (int ri = 0; ri < 8; ++ri) {
      union { bf16x8 v; unsigned u[4]; } pb;
      pb.u[0] = pack2bf(sc[2 * ri][0], sc[2 * ri][1]);
      pb.u[1] = pack2bf(sc[2 * ri][2], sc[2 * ri][3]);
      pb.u[2] = pack2bf(sc[2 * ri + 1][0], sc[2 * ri + 1][1]);
      pb.u[3] = pack2bf(sc[2 * ri + 1][2], sc[2 * ri + 1][3]);
#pragma unroll
      for (int dt = 0; dt < 4; ++dt) {
        const bf16_t* vp = VT + (dt * 16 + tl) * NA_VLD + ri * 64 + cw0 + 4 * g;
        union { bf16x8 v; uint2 h[2]; } va;
        va.h[0] = *(const uint2*)vp;
        va.h[1] = *(const uint2*)(vp + 16);
        o[dt] = __builtin_amdgcn_mfma_f32_16x16x32_bf16(va.v, pb.v, o[dt], 0, 0, 0);
      }
    }
    bf16_t* dst = p.ycat + (size_t)(qtok0 + qt * 16 + tl) * 1024 + 768 + h * 64 + 4 * g;
#pragma unroll
    for (int dt = 0; dt < 4; ++dt) {
      uint2 ov;
      ov.x = pack2bf(o[dt][0] * rden, o[dt][1] * rden);
      ov.y = pack2bf(o[dt][2] * rden, o[dt][3] * rden);
      *(uint2*)(dst + dt * 16) = ov;
    }
  }
}

#define PL_LD 264
__device__ __forceinline__ void o_pool_task(const Params& p, int l, int task, char* smem, int tid) {
  const int wave = tid >> 6, lane = tid & 63, g = lane >> 4, tl = lane & 15;
  const int t0 = task * 64, pos0 = t0 & (SEQ - 1);
  bf16_t* Xp = (bf16_t*)smem;
  bf16_t* WT = Xp + 80 * PL_LD;
  bf16_t* Df = WT + 4 * 64 * 72;
  __syncthreads();
#pragma unroll
  for (int it = 0; it < 5; ++it) {
    const int u = tid + it * NTHREADS;
    const int rw = u >> 5, c0 = (u & 31) * 8;
    const int pos = pos0 - 8 + rw;
    uint4 v = make_uint4(0u, 0u, 0u, 0u);
    if (pos >= 0 && pos < SEQ) v = *(const uint4*)(p.proj + (size_t)(t0 - 8 + rw) * IN_WIDTH + C_POOL + c0);
    *(uint4*)(Xp + rw * PL_LD + c0) = v;
  }
#pragma unroll
  for (int it = 0; it < 4; ++it) {
    const int u = tid + it * NTHREADS;
    const int e0 = (u & 7) * 8, c = (u >> 3) & 63, gi = u >> 9;
    const float* wp = p.pool_w + (((size_t)l * 4 + gi) * 64 + c) * 64 + e0;
    const float4 a = *(const float4*)wp, bq = *(const float4*)(wp + 4);
    const float wv[8] = {a.x, a.y, a.z, a.w, bq.x, bq.y, bq.z, bq.w};
#pragma unroll
    for (int k = 0; k < 8; ++k) WT[(gi * 64 + e0 + k) * 72 + c] = f2bf(wv[k]);
  }
  __syncthreads();
#pragma unroll 1
  for (int it = 0; it < 4; ++it) {
    const int u = tid + it * NTHREADS;
    const int t = u >> 5, c0 = (u & 31) * 8;
    const int gi = c0 >> 6;
    const int hw = 1 << gi;
    const int pos = pos0 + t;
    int a = pos - hw; a = a < 0 ? 0 : a;
    int bnd = pos + hw; bnd = bnd > SEQ ? SEQ : bnd;
    float sum[8];
#pragma unroll
    for (int k = 0; k < 8; ++k) sum[k] = 0.f;
    for (int rp = a; rp < bnd; ++rp) {
      const uint4 v = *(const uint4*)(Xp + (rp - pos0 + 8) * PL_LD + c0);
      sum[0] += bf_lo(v.x); sum[1] += bf_hi(v.x); sum[2] += bf_lo(v.y); sum[3] += bf_hi(v.y);
      sum[4] += bf_lo(v.z); sum[5] += bf_hi(v.z); sum[6] += bf_lo(v.w); sum[7] += bf_hi(v.w);
    }
    const float rc = 1.0f / (float)(bnd - a);
    const uint4 xv = *(const uint4*)(Xp + (t + 8) * PL_LD + c0);
    uint4 o;
    o.x = pack2bf(sum[0] * rc - bf_lo(xv.x), sum[1] * rc - bf_hi(xv.x));
    o.y = pack2bf(sum[2] * rc - bf_lo(xv.y), sum[3] * rc - bf_hi(xv.y));
    o.z = pack2bf(sum[4] * rc - bf_lo(xv.z), sum[5] * rc - bf_hi(xv.z));
    o.w = pack2bf(sum[6] * rc - bf_lo(xv.w), sum[7] * rc - bf_hi(xv.w));
    *(uint4*)(Df + t * PL_LD + c0) = o;
  }
  __syncthreads();
  {
    const int gi = wave >> 1, tt0 = (wave & 1) * 2;
    f32x4 acc[4][2];
#pragma unroll
    for (int et = 0; et < 4; ++et)
#pragma unroll
      for (int tt = 0; tt < 2; ++tt) acc[et][tt] = (f32x4){0.f, 0.f, 0.f, 0.f};
#pragma unroll
    for (int ks = 0; ks < 2; ++ks) {
      bf16x8 bx[2];
#pragma unroll
      for (int tt = 0; tt < 2; ++tt) bx[tt] = *(const bf16x8*)(Df + ((tt0 + tt) * 16 + tl) * PL_LD + gi * 64 + ks * 32 + 8 * g);
#pragma unroll
      for (int et = 0; et < 4; ++et) {
        const bf16x8 wa = *(const bf16x8*)(WT + (gi * 64 + et * 16 + tl) * 72 + ks * 32 + 8 * g);
#pragma unroll
        for (int tt = 0; tt < 2; ++tt) acc[et][tt] = __builtin_amdgcn_mfma_f32_16x16x32_bf16(wa, bx[tt], acc[et][tt], 0, 0, 0);
      }
    }
#pragma unroll
    for (int et = 0; et < 4; ++et) {
      const float4 sc4 = *(const float4*)(p.pool_scale + l * 256 + gi * 64 + et * 16 + 4 * g);
#pragma unroll
      for (int tt = 0; tt < 2; ++tt) {
        const int tok = t0 + (tt0 + tt) * 16 + tl;
        uint2 o;
        o.x = pack2bf(acc[et][tt][0] * sc4.x, acc[et][tt][1] * sc4.y);
        o.y = pack2bf(acc[et][tt][2] * sc4.z, acc[et][tt][3] * sc4.w);
        *(uint2*)(p.ycat + (size_t)tok * 1024 + gi * 64 + et * 16 + 4 * g) = o;
      }
    }
  }
}


__global__ void __launch_bounds__(NTHREADS) fwd_megakernel(Params p) {
  cg::grid_group grid = cg::this_grid();
  extern __shared__ __attribute__((aligned(16))) float smem[];
  const int wv_ = __builtin_amdgcn_readfirstlane((int)(threadIdx.x >> 6));

  o_prep(wv_, p, smem);
  grid.sync();
#pragma unroll 1
  for (int l = 0; l < DEPTH; ++l) {
    const float* xcur = (l == 0) ? p.x_in : p.xres;
    o_p1(wv_, p, l, xcur, (char*)smem);
    grid.sync();
    {
      const int bidx_ = opaque_bid();
      for (int task = bidx_; task < 1792; task += gridDim.x) {
        const int l_ = opaque_s(l), td_ = opaque_tid(wv_), tk_ = opaque_s(task);
        if (tk_ < 1024) o_na_task(p, l_, tk_, (char*)smem, td_);
        else if (tk_ < 1536) o_ret_kv_task(p, l_, tk_ - 1024, (char*)smem, td_);
        else o_pool_task(p, l_, tk_ - 1536, (char*)smem, td_);
      }
    }
    grid.sync();
    o_ret_scan(wv_, p, l);
    grid.sync();
    {
      const int tidx_ = opaque_tid(wv_); const int bidx_ = opaque_bid();
      for (int task = bidx_; task < 512; task += gridDim.x) o_ret_out_task(p, l, task, (char*)smem, tidx_);
    }
    grid.sync();
    {
      const int tidx_ = opaque_tid(wv_); const int bidx_ = opaque_bid();
      for (int tile = bidx_; tile < NTOK / 64; tile += gridDim.x) {
        { const int t0_ = opaque_s(tile * 64), l_ = opaque_s(l), td_ = opaque_tid(wv_); o_p5a1_tile(p, l_, t0_, (char*)smem, td_); }
        { const int t0_ = opaque_s(tile * 64), l_ = opaque_s(l), td_ = opaque_tid(wv_); o_p5a2_tile(p, l_, xcur, t0_, (char*)smem, td_); }
        { const int t0_ = opaque_s(tile * 64), l_ = opaque_s(l), td_ = opaque_tid(wv_); o_p5a3_tile(p, l_, t0_, (char*)smem, td_); }
        { const int t0_ = opaque_s(tile * 64), l_ = opaque_s(l), td_ = opaque_tid(wv_); o_peer_select_tile(p, l_, t0_, (char*)smem, td_); }
        { const int t0_ = opaque_s(tile * 64), l_ = opaque_s(l), td_ = opaque_tid(wv_); o_peer_select2_tile(p, l_, t0_, td_); }
        asm volatile("s_waitcnt vmcnt(0)" ::: "memory");
        __syncthreads();
        { const int t0_ = opaque_s(tile * 64), l_ = opaque_s(l), td_ = opaque_tid(wv_); o_peer_experts_tile(p, l_, t0_, (const char*)smem, td_); }
      }
    }
    grid.sync();
  }
  n_rmsnorm<true>(wv_, p.xres, p.norm_final, p.out, NTOK);
}

extern "C" void kernel_launch(void* const* d_in, const int* in_sizes, int n_in, void* d_out, int out_size,
                              void* d_ws, size_t ws_size, hipStream_t stream) {
  Params p{};
  p.x_in = (const float*)d_in[0]; p.norm_mix = (const float*)d_in[1]; p.w_in = (const float*)d_in[2];
  p.pool_w = (const float*)d_in[3]; p.pool_scale = (const float*)d_in[4]; p.ret_decay = (const float*)d_in[5];
  p.na_rpb = (const float*)d_in[6]; p.w_br_pool = (const float*)d_in[7]; p.w_br_ret = (const float*)d_in[8];
  p.w_br_na = (const float*)d_in[9]; p.w_out = (const float*)d_in[10]; p.norm_ffn = (const float*)d_in[11];
  p.w_query = (const float*)d_in[12]; p.sub_keys = (const float*)d_in[13]; p.peer_u = (const float*)d_in[14];
  p.peer_v = (const float*)d_in[15]; p.norm_final = (const float*)d_in[16];
  p.out = (float*)d_out;
  char* ws = (char*)d_ws;
  size_t off = 0;
  auto alloc = [&](size_t bytes) { char* q = ws + off; off += (bytes + 255) & ~(size_t)255; return q; };
  p.xres = (float*)alloc((size_t)NTOK * D_MODEL * 4);
  p.proj = (bf16_t*)alloc((size_t)NTOK * IN_WIDTH * 2);
  p.ycat = (bf16_t*)alloc((size_t)NTOK * 1024 * 2);
  p.mrg = (bf16_t*)alloc((size_t)NTOK * 1024 * 2);
  p.pidx = (int*)alloc((size_t)NTOK * 128 * 4);
  p.pgate = (float*)alloc((size_t)NTOK * 128 * 4);
  p.wf_in = (bf16_t*)alloc((size_t)DEPTH * D_MODEL * IN_WIDTH * 2);
  p.wf_br = (bf16_t*)alloc((size_t)DEPTH * 1024 * 1024 * 2);
  p.wf_out = (bf16_t*)alloc((size_t)DEPTH * 1024 * 1024 * 2);
  p.wf_q = (bf16_t*)alloc((size_t)DEPTH * 1024 * 2048 * 2);
  p.kf = (bf16_t*)alloc((size_t)DEPTH * 2 * 128 * 128 * 2);
  p.u16 = (bf16_t*)alloc((size_t)DEPTH * 16384 * 1024 * 2);
  p.v16 = (bf16_t*)alloc((size_t)DEPTH * 16384 * 1024 * 2);
  p.rope = (float2*)alloc((size_t)SEQ * 32 * 8);
  p.tklist = (unsigned*)alloc((size_t)NTOK * 8 * 2 * 16 * 4);
  p.kvst = (float*)p.mrg;
  p.rstate = (bf16_t*)p.tklist;
  p.xn = nullptr; p.merged = nullptr; p.pq = nullptr; p.psc = nullptr;
  if (off > ws_size) fprintf(stderr, "WORKSPACE OVERFLOW: need %zu have %zu\n", off, ws_size);

  const size_t kDynLds = 160 * 1024;
  static int grid_blocks = 0;
  if (!grid_blocks) {
    int dev = 0, cus = 0, per_cu = 0;
    (void)hipGetDevice(&dev);
    (void)hipDeviceGetAttribute(&cus, hipDeviceAttributeMultiprocessorCount, dev);
    (void)hipFuncSetAttribute((const void*)fwd_megakernel, hipFuncAttributeMaxDynamicSharedMemorySize, (int)kDynLds);
    (void)hipOccupancyMaxActiveBlocksPerMultiprocessor(&per_cu, fwd_megakernel, NTHREADS, kDynLds);
    if (per_cu < 1) per_cu = 1;
    grid_blocks = cus * per_cu;
  }
  void* args[] = {&p};
  hipError_t e = hipLaunchCooperativeKernel((void*)fwd_megakernel, dim3(grid_blocks), dim3(NTHREADS), args, kDynLds, stream);
  if (e != hipSuccess) fprintf(stderr, "cooperative launch failed: %s (grid %d)\n", hipGetErrorString(e), grid_blocks);
}
```

```cpp
#include <hip/hip_runtime.h>
#include <hip/hip_cooperative_groups.h>
#include <stdint.h>
#include <cstdio>
namespace cg = cooperative_groups;

#define D_MODEL 1024
#define SEQ 4096
#define BATCH 4
#define NTOK (BATCH * SEQ)
#define DEPTH 2
#define IN_WIDTH 5632
#define C_POOL 0
#define C_RQ 256
#define C_RK 512
#define C_RV 768
#define C_RG 1280
#define C_NQ 1792
#define C_NK 2048
#define C_NV 2304
#define C_GATE 2560
#define EPS 1e-6f
#define NTHREADS 512

typedef unsigned short bf16_t;

struct Params {
  const float* x_in; const float* norm_mix; const float* w_in; const float* pool_w; const float* pool_scale;
  const float* ret_decay; const float* na_rpb; const float* w_br_pool; const float* w_br_ret; const float* w_br_na;
  const float* w_out; const float* norm_ffn; const float* w_query; const float* sub_keys; const float* peer_u;
  const float* peer_v; const float* norm_final;
  float* out;
  float* xres;
  bf16_t* xn;
  bf16_t* proj;
  bf16_t* ycat;
  float* merged;
  float* pq;
  float* psc;
  int* pidx;
  float* pgate;
  bf16_t* wf_in;
  bf16_t* wf_br;
  bf16_t* wf_out;
  bf16_t* wf_q;
  bf16_t* kf;
  bf16_t* u16;
  bf16_t* v16;
  float2* rope;
  bf16_t* mrg;
  unsigned* tklist;
  float* kvst;
  bf16_t* rstate;
};

__device__ __forceinline__ bf16_t f2bf(float f) {
  unsigned u = __float_as_uint(f);
  u += 0x7fffu + ((u >> 16) & 1u);
  return (bf16_t)(u >> 16);
}
__device__ __forceinline__ float bf2f(bf16_t h) { return __uint_as_float(((unsigned)h) << 16); }

__device__ __forceinline__ float wave_sum(float v) {
#pragma unroll
  for (int o = 32; o > 0; o >>= 1) v += __shfl_xor(v, o, 64);
  return v;
}
__device__ __forceinline__ float wave_max(float v) {
#pragma unroll
  for (int o = 32; o > 0; o >>= 1) v = fmaxf(v, __shfl_xor(v, o, 64));
  return v;
}
__device__ __forceinline__ float sigmoidf_(float x) { return 1.0f / (1.0f + expf(-x)); }

__device__ __forceinline__ int opaque_tid(int wv) {
  int w = wv;
  asm volatile("" : "+s"(w));
  int lane = __builtin_amdgcn_mbcnt_hi(~0u, __builtin_amdgcn_mbcnt_lo(~0u, 0u));
  asm volatile("" : "+v"(lane));
  return w * 64 + lane;
}
__device__ __forceinline__ int opaque_s(int x) { asm volatile("" : "+s"(x)); return x; }
__device__ __forceinline__ int opaque_bid() { int b = blockIdx.x; asm volatile("" : "+s"(b)); return b; }

template <bool OUT_F32>
__device__ __forceinline__ void n_rmsnorm(const int wv_, const float* __restrict__ x, const float* __restrict__ g, void* outp, int rows) {
  const int tidx_ = opaque_tid(wv_); const int bidx_ = opaque_bid();
  const int lane = tidx_ & 63;
  const int nw = gridDim.x * (NTHREADS / 64);
  for (int row = bidx_ * (NTHREADS / 64) + (tidx_ >> 6); row < rows; row += nw) {
    const float* xr = x + (size_t)row * D_MODEL;
    float4 v[4];
    float ss = 0.f;
#pragma unroll
    for (int i = 0; i < 4; ++i) {
      v[i] = *(const float4*)(xr + i * 256 + lane * 4);
      ss += v[i].x * v[i].x + v[i].y * v[i].y + v[i].z * v[i].z + v[i].w * v[i].w;
    }
    ss = wave_sum(ss);
    float r = rsqrtf(ss * (1.0f / D_MODEL) + EPS);
#pragma unroll
    for (int i = 0; i < 4; ++i) {
      float4 gg = *(const float4*)(g + i * 256 + lane * 4);
      float o0 = v[i].x * r * gg.x, o1 = v[i].y * r * gg.y, o2 = v[i].z * r * gg.z, o3 = v[i].w * r * gg.w;
      if (OUT_F32) {
        *(float4*)((float*)outp + (size_t)row * D_MODEL + i * 256 + lane * 4) = make_float4(o0, o1, o2, o3);
      } else {
        ushort4 o; o.x = f2bf(o0); o.y = f2bf(o1); o.z = f2bf(o2); o.w = f2bf(o3);
        *(ushort4*)((bf16_t*)outp + (size_t)row * D_MODEL + i * 256 + lane * 4) = o;
      }
    }
  }
}

template <bool A_BF16, typename Epi>
__device__ __forceinline__ void n_gemm(const int wv_, const void* Av, int lda, long sA, const float* __restrict__ B, int ldb, long sB,
                                       int transB, int M, int N, int K, int Z, float* smem, Epi epi) {
  const int tidx_ = opaque_tid(wv_); const int bidx_ = opaque_bid();
  const int grp = tidx_ >> 8, tid = tidx_ & 255;
  float(*As)[68] = (float(*)[68])(smem + grp * 2 * 16 * 68);
  float(*Bs)[68] = (float(*)[68])(smem + grp * 2 * 16 * 68 + 16 * 68);
  const int tx = tid & 15, ty = tid >> 4;
  const int tn = N / 64, tm = M / 64;
  const int nwork = tn * tm * Z;
  for (int wb = bidx_ * 2; wb < nwork; wb += gridDim.x * 2) {
    const int w = wb + grp;
    const int z = w / (tn * tm);
    const int rem = w - z * (tn * tm);
    const int bm = (rem / tn) * 64, bn = (rem % tn) * 64;
    const float* Af = (const float*)Av + (size_t)z * sA;
    const bf16_t* Ab = (const bf16_t*)Av + (size_t)z * sA;
    const float* Bz = B + (size_t)z * sB;
    float acc[4][4];
#pragma unroll
    for (int i = 0; i < 4; ++i)
#pragma unroll
      for (int j = 0; j < 4; ++j) acc[i][j] = 0.f;
    for (int k0 = 0; k0 < K; k0 += 16) {
#pragma unroll
      for (int i = 0; i < 4; ++i) {
        int idx = tid + i * 256;
        int m = idx >> 4, k = idx & 15;
        size_t ao = (size_t)(bm + m) * lda + k0 + k;
        As[k][m] = A_BF16 ? bf2f(Ab[ao]) : Af[ao];
        if (transB) {
          int n = idx >> 4, kk = idx & 15;
          Bs[kk][n] = Bz[(size_t)(bn + n) * ldb + k0 + kk];
        } else {
          int kk = idx >> 6, n = idx & 63;
          Bs[kk][n] = Bz[(size_t)(k0 + kk) * ldb + bn + n];
        }
      }
      __syncthreads();
#pragma unroll
      for (int k = 0; k < 16; ++k) {
        float a[4], b[4];
#pragma unroll
        for (int i = 0; i < 4; ++i) a[i] = As[k][ty * 4 + i];
#pragma unroll
        for (int j = 0; j < 4; ++j) b[j] = Bs[k][tx * 4 + j];
#pragma unroll
        for (int i = 0; i < 4; ++i)
#pragma unroll
          for (int j = 0; j < 4; ++j) acc[i][j] = fmaf(a[i], b[j], acc[i][j]);
      }
      __syncthreads();
    }
#pragma unroll
    for (int i = 0; i < 4; ++i)
#pragma unroll
      for (int j = 0; j < 4; ++j) epi(z, bm + ty * 4 + i, bn + tx * 4 + j, acc[i][j]);
  }
}

__device__ __forceinline__ void n_rope(const int wv_, bf16_t* __restrict__ proj) {
  const int tidx_ = opaque_tid(wv_); const int bidx_ = opaque_bid();
  const int total = NTOK * 256;
  for (int gid = bidx_ * NTHREADS + tidx_; gid < total; gid += gridDim.x * NTHREADS) {
    int i = gid & 31, h = (gid >> 5) & 3, qk = (gid >> 7) & 1, t = gid >> 8;
    int pos = t & (SEQ - 1);
    float inv = 1.0f / powf(10000.0f, (float)i / 31.0f);
    float ang = (float)pos * inv;
    double rev = (double)ang * 0.15915494309189535;
    rev -= floor(rev);
    float rf = (float)rev;
    float cs = __builtin_amdgcn_cosf(rf), sn = __builtin_amdgcn_sinf(rf);
    bf16_t* p = proj + (size_t)t * IN_WIDTH + (qk ? C_RK : C_RQ) + h * 64 + i;
    float x1 = bf2f(p[0]), x2 = bf2f(p[32]);
    p[0] = f2bf(x1 * cs - x2 * sn);
    p[32] = f2bf(x1 * sn + x2 * cs);
  }
}

__device__ __forceinline__ void n_pool(const int wv_, const bf16_t* __restrict__ proj, const float* __restrict__ pw,
                                       const float* __restrict__ pscale, bf16_t* __restrict__ ycat, float* smem) {
  const int tidx_ = opaque_tid(wv_); const int bidx_ = opaque_bid();
  const int grp = tidx_ >> 8, c = tidx_ & 255;
  float* diff = smem + grp * 256;
  const int gi = c >> 6;
  const int w = 2 << gi;
  const int lo = w / 2, hi = w - w / 2;
  for (int wb = bidx_ * 2; wb < NTOK; wb += gridDim.x * 2) {
    const int t = wb + grp;
    const int b0 = t & ~(SEQ - 1), pos = t & (SEQ - 1);
    int a = pos - lo; if (a < 0) a = 0;
    int b = pos + hi; if (b > SEQ) b = SEQ;
    float s = 0.f;
    for (int tt = a; tt < b; ++tt) s += bf2f(proj[(size_t)(b0 + tt) * IN_WIDTH + C_POOL + c]);
    float mean = s / (float)(b - a);
    __syncthreads();
    diff[c] = mean - bf2f(proj[(size_t)t * IN_WIDTH + C_POOL + c]);
    __syncthreads();
    const int e = c & 63;
    const float* wg = pw + gi * 64 * 64;
    float acc = 0.f;
    for (int cc = 0; cc < 64; ++cc) acc = fmaf(diff[gi * 64 + cc], wg[cc * 64 + e], acc);
    ycat[(size_t)t * 1024 + c] = f2bf(acc * pscale[c]);
  }
}

__device__ __forceinline__ void n_retention(const int wv_, const bf16_t* __restrict__ proj, const float* __restrict__ decay,
                                            bf16_t* __restrict__ ycat, float* smem) {
  const int tidx_ = opaque_tid(wv_); const int bidx_ = opaque_bid();
  const int grp = tidx_ >> 8, tid = tidx_ & 255;
  float* base = smem + grp * 12544;
  float(*Qs)[65] = (float(*)[65])base;
  float(*Ks)[65] = (float(*)[65])(base + 64 * 65);
  float(*Vs)[128] = (float(*)[128])(base + 64 * 65 + 32 * 65);
  float(*Ps)[33] = (float(*)[33])(base + 64 * 65 + 32 * 65 + 32 * 128);
  const int rg = tid >> 5, cl = tid & 31;
  const int nwork = (NTOK / 64) * 4;
  for (int wb = bidx_ * 2; wb < nwork; wb += gridDim.x * 2) {
    const int w = wb + grp;
    const int h = w & 3, qt = w >> 2;
    const int t0 = qt * 64;
    const int b0 = t0 & ~(SEQ - 1);
    const int q0 = t0 & (SEQ - 1);
    float dlf = decay[h], dlb = decay[4 + h];
    float lgf = fminf(dlf, 0.f) - log1pf(expf(-fabsf(dlf)));
    float lgb = fminf(dlb, 0.f) - log1pf(expf(-fabsf(dlb)));
    __syncthreads();
    for (int idx = tid; idx < 64 * 64; idx += 256) {
      int r = idx >> 6, d = idx & 63;
      Qs[r][d] = bf2f(proj[(size_t)(t0 + r) * IN_WIDTH + C_RQ + h * 64 + d]);
    }
    float acc[8][4];
#pragma unroll
    for (int i = 0; i < 8; ++i)
#pragma unroll
      for (int j = 0; j < 4; ++j) acc[i][j] = 0.f;
    for (int k0 = 0; k0 < SEQ; k0 += 32) {
      __syncthreads();
      for (int idx = tid; idx < 32 * 64; idx += 256) {
        int r = idx >> 6, d = idx & 63;
        Ks[r][d] = bf2f(proj[(size_t)(b0 + k0 + r) * IN_WIDTH + C_RK + h * 64 + d]);
      }
      for (int idx = tid; idx < 32 * 128; idx += 256) {
        int r = idx >> 7, d = idx & 127;
        Vs[r][d] = bf2f(proj[(size_t)(b0 + k0 + r) * IN_WIDTH + C_RV + h * 128 + d]);
      }
      __syncthreads();
      float sc[8];
#pragma unroll
      for (int i = 0; i < 8; ++i) sc[i] = 0.f;
      for (int d = 0; d < 64; ++d) {
        float kv = Ks[cl][d];
#pragma unroll
        for (int i = 0; i < 8; ++i) sc[i] = fmaf(Qs[rg * 8 + i][d], kv, sc[i]);
      }
      const int j = k0 + cl;
#pragma unroll
      for (int i = 0; i < 8; ++i) {
        int qi = q0 + rg * 8 + i;
        float dd = (j <= qi) ? expf(lgf * (float)(qi - j)) : expf(lgb * (float)(j - qi));
        Ps[rg * 8 + i][cl] = sc[i] * dd;
      }
      __syncthreads();
      for (int jj = 0; jj < 32; ++jj) {
        float v[4];
#pragma unroll
        for (int c = 0; c < 4; ++c) v[c] = Vs[jj][cl + 32 * c];
#pragma unroll
        for (int i = 0; i < 8; ++i) {
          float p = Ps[rg * 8 + i][jj];
#pragma unroll
          for (int c = 0; c < 4; ++c) acc[i][c] = fmaf(p, v[c], acc[i][c]);
        }
      }
    }
#pragma unroll
    for (int i = 0; i < 8; ++i) {
      float ss = acc[i][0] * acc[i][0] + acc[i][1] * acc[i][1] + acc[i][2] * acc[i][2] + acc[i][3] * acc[i][3];
#pragma unroll
      for (int o = 16; o > 0; o >>= 1) ss += __shfl_xor(ss, o, 64);
      float r = rsqrtf(ss * (1.0f / 128.0f) + EPS);
      int t = t0 + rg * 8 + i;
#pragma unroll
      for (int c = 0; c < 4; ++c) {
        int col = h * 128 + cl + 32 * c;
        float g = bf2f(proj[(size_t)t * IN_WIDTH + C_RG + col]);
        float sg = g / (1.0f + expf(-g));
        ycat[(size_t)t * 1024 + 256 + col] = f2bf(sg * acc[i][c] * r);
      }
    }
  }
}

__device__ __forceinline__ void n_na(const int wv_, const bf16_t* __restrict__ proj, const float* __restrict__ rpb,
                                     bf16_t* __restrict__ ycat) {
  const int tidx_ = opaque_tid(wv_); const int bidx_ = opaque_bid();
  const int lane = tidx_ & 63;
  const int nw = gridDim.x * (NTHREADS / 64);
  for (int wv = bidx_ * (NTHREADS / 64) + (tidx_ >> 6); wv < NTOK * 4; wv += nw) {
    int h = wv & 3, t = wv >> 2;
    int b0 = t & ~(SEQ - 1), pos = t & (SEQ - 1);
    int r = pos >> 6, c = pos & 63;
    int rs = r - 4; rs = rs < 0 ? 0 : (rs > 56 ? 56 : rs);
    int cs = c - 8; cs = cs < 0 ? 0 : (cs > 48 ? 48 : cs);
    float qv = bf2f(proj[(size_t)t * IN_WIDTH + C_NQ + h * 64 + lane]);
    float s[2];
#pragma unroll
    for (int u = 0; u < 2; ++u) {
      int kk = lane + 64 * u;
      int ri = kk >> 4, cj = kk & 15;
      int kt = b0 + (rs + ri) * 64 + cs + cj;
      const bf16_t* kp = proj + (size_t)kt * IN_WIDTH + C_NK + h * 64;
      float a = 0.f;
      for (int d = 0; d < 64; ++d) a = fmaf(__shfl(qv, d, 64), bf2f(kp[d]), a);
      int di = rs + ri - r + 7;
      int dj = cs + cj - c + 15;
      s[u] = a + rpb[(h * 15 + di) * 31 + dj];
    }
    float m = wave_max(fmaxf(s[0], s[1]));
    float e0 = expf(s[0] - m), e1 = expf(s[1] - m);
    float den = wave_sum(e0 + e1);
    float p0 = e0 / den, p1 = e1 / den;
    float o = 0.f;
    for (int kk = 0; kk < 128; ++kk) {
      float p = __shfl((kk < 64) ? p0 : p1, kk & 63, 64);
      int ri = kk >> 4, cj = kk & 15;
      int kt = b0 + (rs + ri) * 64 + cs + cj;
      o = fmaf(p, bf2f(proj[(size_t)kt * IN_WIDTH + C_NV + h * 64 + lane]), o);
    }
    ycat[(size_t)t * 1024 + 768 + h * 64 + lane] = f2bf(o);
  }
}

#define TKS 256
__device__ __forceinline__ void lds_insert(float* v, int* id, float x, int xi) {
  if (x > v[15 * TKS]) {
    int j = 15;
    while (j > 0 && v[(j - 1) * TKS] < x) {
      v[j * TKS] = v[(j - 1) * TKS];
      id[j * TKS] = id[(j - 1) * TKS];
      --j;
    }
    v[j * TKS] = x;
    id[j * TKS] = xi;
  }
}
__device__ __forceinline__ void n_topk(const int wv_, const float* __restrict__ scores, int* __restrict__ idx,
                                       float* __restrict__ gate, float* smem) {
  const int tidx_ = opaque_tid(wv_); const int bidx_ = opaque_bid();
  const int tid = tidx_;
  if (tid >= TKS) return;
  float* v1 = smem + tid;
  float* v2 = smem + 16 * TKS + tid;
  float* v3 = smem + 32 * TKS + tid;
  int* i1 = (int*)(smem + 48 * TKS) + tid;
  int* i2 = (int*)(smem + 64 * TKS) + tid;
  int* i3 = (int*)(smem + 80 * TKS) + tid;
  for (int gid = bidx_ * TKS + tid; gid < SEQ * 8; gid += gridDim.x * TKS) {
    const float* s = scores + (size_t)gid * 256;
    for (int j = 0; j < 16; ++j) {
      v1[j * TKS] = -3.0e38f; v2[j * TKS] = -3.0e38f; v3[j * TKS] = -3.0e38f;
      i1[j * TKS] = 0; i2[j * TKS] = 0; i3[j * TKS] = 0;
    }
    for (int n = 0; n < 128; ++n) lds_insert(v1, i1, s[n], n);
    for (int n = 0; n < 128; ++n) lds_insert(v2, i2, s[128 + n], n);
    for (int a = 0; a < 16; ++a) {
      float va = v1[a * TKS];
      int ia = i1[a * TKS];
      for (int b = 0; b < 16; ++b) lds_insert(v3, i3, va + v2[b * TKS], ia * 128 + i2[b * TKS]);
    }
    float m = v3[0];
    float den = 0.f;
    for (int j = 0; j < 16; ++j) den += expf(v3[j * TKS] - m);
    for (int j = 0; j < 16; ++j) {
      idx[(size_t)gid * 16 + j] = i3[j * TKS];
      gate[(size_t)gid * 16 + j] = expf(v3[j * TKS] - m) / den;
    }
  }
}

__device__ __forceinline__ void n_experts(const int wv_, const bf16_t* __restrict__ hn, const int* __restrict__ idx,
                                          const float* __restrict__ gate, const float* __restrict__ wu,
                                          const float* __restrict__ wv, float* __restrict__ x, int ntok) {
  const int tidx_ = opaque_tid(wv_); const int bidx_ = opaque_bid();
  const int lane = tidx_ & 63;
  const int nw = gridDim.x * (NTHREADS / 64);
  for (int t = bidx_ * (NTHREADS / 64) + (tidx_ >> 6); t < ntok; t += nw) {
    const bf16_t* hr = hn + (size_t)t * D_MODEL;
    float4 hv[4], acc[4];
#pragma unroll
    for (int i = 0; i < 4; ++i) {
      ushort4 hb = *(const ushort4*)(hr + i * 256 + lane * 4);
      hv[i] = make_float4(bf2f(hb.x), bf2f(hb.y), bf2f(hb.z), bf2f(hb.w));
      acc[i] = make_float4(0.f, 0.f, 0.f, 0.f);
    }
    for (int k = 0; k < 128; ++k) {
      int e = idx[(size_t)t * 128 + k];
      float g = gate[(size_t)t * 128 + k];
      const float* ur = wu + (size_t)e * D_MODEL;
      float a = 0.f;
#pragma unroll
      for (int i = 0; i < 4; ++i) {
        float4 u = *(const float4*)(ur + i * 256 + lane * 4);
        a += hv[i].x * u.x + hv[i].y * u.y + hv[i].z * u.z + hv[i].w * u.w;
      }
      a = wave_sum(a);
      float hh = 0.5f * a * (1.0f + erff(a * 0.70710678118654752f)) * g;
      const float* vr = wv + (size_t)e * D_MODEL;
#pragma unroll
      for (int i = 0; i < 4; ++i) {
        float4 v = *(const float4*)(vr + i * 256 + lane * 4);
        acc[i].x = fmaf(hh, v.x, acc[i].x); acc[i].y = fmaf(hh, v.y, acc[i].y);
        acc[i].z = fmaf(hh, v.z, acc[i].z); acc[i].w = fmaf(hh, v.w, acc[i].w);
      }
    }
    float* xr = x + (size_t)t * D_MODEL;
#pragma unroll
    for (int i = 0; i < 4; ++i) {
      float4 o = *(float4*)(xr + i * 256 + lane * 4);
      o.x += acc[i].x; o.y += acc[i].y; o.z += acc[i].z; o.w += acc[i].w;
      *(float4*)(xr + i * 256 + lane * 4) = o;
    }
  }
}


typedef __attribute__((ext_vector_type(8))) short bf16x8;
typedef __attribute__((ext_vector_type(4))) float f32x4;
#define LDX 1032
#define LDXB (LDX * 2)
#define XTILE_BYTES (64 * LDXB)

__device__ __forceinline__ unsigned pack2bf(float a, float b) { return (unsigned)f2bf(a) | ((unsigned)f2bf(b) << 16); }

__device__ __forceinline__ void prep_frag(const int wv_, const float* __restrict__ W, int K, int N, bf16_t* __restrict__ dst, float* smem) {
  const int tidx_ = opaque_tid(wv_); const int bidx_ = opaque_bid();
  const int grp = tidx_ >> 8, tid = tidx_ & 255;
  float(*T)[65] = (float(*)[65])(smem + grp * 32 * 65);
  const int KS = K / 32, NC = N / 64;
  const int ntiles = KS * NC;
  for (int wb = bidx_ * 2; wb < ntiles; wb += gridDim.x * 2) {
    const int w = wb + grp;
    const int c = w / KS, ks = w - c * KS;
    {
      const int row = tid >> 3, col = (tid & 7) * 8;
      const float* src = W + (size_t)(ks * 32 + row) * N + c * 64 + col;
      float4 a = *(const float4*)src, b = *(const float4*)(src + 4);
      __syncthreads();
      T[row][col + 0] = a.x; T[row][col + 1] = a.y; T[row][col + 2] = a.z; T[row][col + 3] = a.w;
      T[row][col + 4] = b.x; T[row][col + 5] = b.y; T[row][col + 6] = b.z; T[row][col + 7] = b.w;
    }
    __syncthreads();
    {
      const int nt = tid >> 6, lane = tid & 63;
      const int kr = 8 * (lane >> 4), nc = nt * 16 + (lane & 15);
      uint4 o;
      o.x = pack2bf(T[kr + 0][nc], T[kr + 1][nc]);
      o.y = pack2bf(T[kr + 2][nc], T[kr + 3][nc]);
      o.z = pack2bf(T[kr + 4][nc], T[kr + 5][nc]);
      o.w = pack2bf(T[kr + 6][nc], T[kr + 7][nc]);
      *(uint4*)(dst + ((size_t)((c * KS + ks) * 4 + nt) * 64 + lane) * 8) = o;
    }
  }
}

__device__ __forceinline__ void o_prep(const int wv_, const Params& p, float* smem) {
  for (int l = 0; l < DEPTH; ++l) {
    prep_frag(wv_, p.w_in + (size_t)l * D_MODEL * IN_WIDTH, D_MODEL, IN_WIDTH, p.wf_in + (size_t)l * D_MODEL * IN_WIDTH, smem);
    prep_frag(wv_, p.w_br_pool + (size_t)l * 256 * 1024, 256, 1024, p.wf_br + (size_t)l * 1024 * 1024, smem);
    prep_frag(wv_, p.w_br_ret + (size_t)l * 512 * 1024, 512, 1024, p.wf_br + (size_t)l * 1024 * 1024 + 256 * 1024, smem);
    prep_frag(wv_, p.w_br_na + (size_t)l * 256 * 1024, 256, 1024, p.wf_br + (size_t)l * 1024 * 1024 + 768 * 1024, smem);
    prep_frag(wv_, p.w_out + (size_t)l * 1024 * 1024, 1024, 1024, p.wf_out + (size_t)l * 1024 * 1024, smem);
    prep_frag(wv_, p.w_query + (size_t)l * 1024 * 2048, 1024, 2048, p.wf_q + (size_t)l * 1024 * 2048, smem);
  }
  const int tidx_ = opaque_tid(wv_); const int bidx_ = opaque_bid();
  const int gtid = bidx_ * NTHREADS + tidx_, gsz = gridDim.x * NTHREADS;
  for (int u = gtid; u < DEPTH * 2 * 8 * 4 * 64; u += gsz) {
    const int lane = u & 63, s2 = (u >> 6) & 3, kt = (u >> 8) & 7, lp = u >> 11;
    const float* kr = p.sub_keys + ((size_t)lp * 128 + kt * 16 + (lane & 15)) * 128;
    float v[8];
#pragma unroll
    for (int j = 0; j < 8; ++j) v[j] = kr[16 * (2 * s2 + (j >> 2)) + 4 * (lane >> 4) + (j & 3)];
    uint4 o;
    o.x = pack2bf(v[0], v[1]); o.y = pack2bf(v[2], v[3]); o.z = pack2bf(v[4], v[5]); o.w = pack2bf(v[6], v[7]);
    *(uint4*)(p.kf + (size_t)u * 8) = o;
  }
  if (p.u16) {
    const size_t nunits = (size_t)DEPTH * 16384 * 1024 / 8;
    for (size_t u = gtid; u < nunits; u += gsz) {
      float4 a = *(const float4*)(p.peer_u + u * 8), b = *(const float4*)(p.peer_u + u * 8 + 4);
      uint4 o;
      o.x = pack2bf(a.x, a.y); o.y = pack2bf(a.z, a.w); o.z = pack2bf(b.x, b.y); o.w = pack2bf(b.z, b.w);
      *(uint4*)(p.u16 + u * 8) = o;
      a = *(const float4*)(p.peer_v + u * 8); b = *(const float4*)(p.peer_v + u * 8 + 4);
      o.x = pack2bf(a.x, a.y); o.y = pack2bf(a.z, a.w); o.z = pack2bf(b.x, b.y); o.w = pack2bf(b.z, b.w);
      *(uint4*)(p.v16 + u * 8) = o;
    }
  }
  for (int u = gtid; u < SEQ * 32; u += gsz) {
    const int i = u & 31, pos = u >> 5;
    float inv = 1.0f / powf(10000.0f, (float)i / 31.0f);
    float ang = (float)pos * inv;
    double rev = (double)ang * 0.15915494309189535;
    rev -= floor(rev);
    float rf = (float)rev;
    p.rope[u] = make_float2(__builtin_amdgcn_cosf(rf), __builtin_amdgcn_sinf(rf));
  }
}

template <int NT, int PD = 3>
__device__ __forceinline__ void tl_gemm_chunk(const bf16_t* __restrict__ wf, const int KS, const char* xt, const int kbyte0,
                                              f32x4 (&acc)[NT][4], const int lane, const int nt0 = 0) {
  const bf16x8* wp = (const bf16x8*)wf + lane + nt0 * 64;
  const char* xp = xt + (lane & 15) * LDXB + kbyte0 + (lane >> 4) * 16;
  bf16x8 wb[4][NT];
#pragma unroll
  for (int s = 0; s < PD; ++s)
#pragma unroll
    for (int nt = 0; nt < NT; ++nt) wb[s][nt] = wp[(s * 4 + nt) * 64];
  for (int ks = 0; ks < KS; ks += 4) {
#pragma unroll
    for (int u = 0; u < 4; ++u) {
      int kpre = ks + u + PD;
      kpre = kpre < KS ? kpre : KS - 1;
#pragma unroll
      for (int nt = 0; nt < NT; ++nt) wb[(u + PD) & 3][nt] = wp[(kpre * 4 + nt) * 64];
      bf16x8 xf[4];
#pragma unroll
      for (int mt = 0; mt < 4; ++mt) xf[mt] = *(const bf16x8*)(xp + mt * 16 * LDXB + (ks + u) * 64);
#pragma unroll
      for (int nt = 0; nt < NT; ++nt)
#pragma unroll
        for (int mt = 0; mt < 4; ++mt)
          acc[nt][mt] = __builtin_amdgcn_mfma_f32_16x16x32_bf16(wb[u][nt], xf[mt], acc[nt][mt], 0, 0, 0);
    }
  }
}

__device__ __forceinline__ void tile_rmsnorm_to_lds(const float* __restrict__ xsrc, const float* __restrict__ g, int t0,
                                                    char* xt, int wave, int lane) {
#pragma unroll 2
  for (int i = 0; i < 8; ++i) {
    const int tok = wave * 8 + i;
    const float* xr = xsrc + (size_t)(t0 + tok) * D_MODEL;
    float4 v[4];
    float ss = 0.f;
#pragma unroll
    for (int q = 0; q < 4; ++q) {
      v[q] = *(const float4*)(xr + q * 256 + lane * 4);
      ss += v[q].x * v[q].x + v[q].y * v[q].y + v[q].z * v[q].z + v[q].w * v[q].w;
    }
    ss = wave_sum(ss);
    const float r = rsqrtf(ss * (1.0f / D_MODEL) + EPS);
#pragma unroll
    for (int q = 0; q < 4; ++q) {
      float4 gg = *(const float4*)(g + q * 256 + lane * 4);
      uint2 o;
      o.x = pack2bf(v[q].x * r * gg.x, v[q].y * r * gg.y);
      o.y = pack2bf(v[q].z * r * gg.z, v[q].w * r * gg.w);
      *(uint2*)(xt + tok * LDXB + (q * 256 + lane * 4) * 2) = o;
    }
  }
}

__device__ __forceinline__ void o_p1(const int wv_, const Params& p, int l, const float* __restrict__ xsrc, char* smem) {
  const int tidx_ = opaque_tid(wv_); const int bidx_ = opaque_bid();
  const int wave = tidx_ >> 6, lane = tidx_ & 63;
  const bf16_t* wf = p.wf_in + (size_t)l * D_MODEL * IN_WIDTH;
  const float* g = p.norm_mix + l * D_MODEL;
  for (int tile = bidx_; tile < NTOK / 64; tile += gridDim.x) {
    const int t0 = tile * 64;
    __syncthreads();
    tile_rmsnorm_to_lds(xsrc, g, t0, smem, wave, lane);
    __syncthreads();
#pragma unroll 1
    for (int c = wave; c < IN_WIDTH / 64; c += 8) {
      f32x4 acc[4][4];
#pragma unroll
      for (int a = 0; a < 4; ++a)
#pragma unroll
        for (int b = 0; b < 4; ++b) acc[a][b] = (f32x4){0.f, 0.f, 0.f, 0.f};
      tl_gemm_chunk<4>(wf + (size_t)c * 32 * 4 * 64 * 8, 32, smem, 0, acc, lane);
      asm volatile("" ::: "memory");
      if (c >= 4 && c < 12) {
        const float sc = (c >= 8) ? 0.125f : 1.0f;
#pragma unroll
        for (int mt = 0; mt < 4; ++mt) {
          const int tok = t0 + mt * 16 + (lane & 15);
          const int pos = tok & (SEQ - 1);
#pragma unroll
          for (int nt = 0; nt < 2; ++nt) {
            const int i0 = nt * 16 + 4 * (lane >> 4);
            const float4 cs01 = *(const float4*)(p.rope + pos * 32 + i0);
            const float4 cs23 = *(const float4*)(p.rope + pos * 32 + i0 + 2);
            const float cc[4] = {cs01.x, cs01.z, cs23.x, cs23.z};
            const float sn[4] = {cs01.y, cs01.w, cs23.y, cs23.w};
#pragma unroll
            for (int r = 0; r < 4; ++r) {
              const float x1 = acc[nt][mt][r], x2 = acc[nt + 2][mt][r];
              acc[nt][mt][r] = (x1 * cc[r] - x2 * sn[r]) * sc;
              acc[nt + 2][mt][r] = (x1 * sn[r] + x2 * cc[r]) * sc;
            }
          }
        }
      } else if (c >= 28 && c < 32) {
#pragma unroll
        for (int a = 0; a < 4; ++a)
#pragma unroll
          for (int b = 0; b < 4; ++b) acc[a][b] *= 0.125f;
      } else if (c >= 40) {
#pragma unroll
        for (int a = 0; a < 4; ++a)
#pragma unroll
          for (int b = 0; b < 4; ++b)
#pragma unroll
            for (int r = 0; r < 4; ++r) acc[a][b][r] = 1.0f / (1.0f + __expf(-acc[a][b][r]));
      }
#pragma unroll
      for (int mt = 0; mt < 4; ++mt) {
        const int tok = t0 + mt * 16 + (lane & 15);
        bf16_t* dst = p.proj + (size_t)tok * IN_WIDTH + c * 64 + 4 * (lane >> 4);
#pragma unroll
        for (int nt = 0; nt < 4; ++nt) {
          uint2 o;
          o.x = pack2bf(acc[nt][mt][0], acc[nt][mt][1]);
          o.y = pack2bf(acc[nt][mt][2], acc[nt][mt][3]);
          *(uint2*)(dst + nt * 16) = o;
        }
      }
    }
  }
}


__device__ __forceinline__ void tile_load_to_lds(const bf16_t* __restrict__ src, int ld, char* xt, int tid) {
#pragma unroll 4
  for (int it = 0; it < 16; ++it) {
    const int idx = it * NTHREADS + tid;
    const int row = idx >> 7, u = idx & 127;
    const uint4 v = *(const uint4*)(src + (size_t)row * ld + u * 8);
    *(uint4*)(xt + row * LDXB + u * 16) = v;
  }
}

__device__ __forceinline__ void o_p5a1_tile(const Params& p, int l, int t0, char* smem, int tid) {
  const int wave = tid >> 6, lane = tid & 63;
  __syncthreads();
  tile_load_to_lds(p.ycat + (size_t)t0 * 1024, 1024, smem, tid);
  __syncthreads();
  const bf16_t* wfb = p.wf_br + (size_t)l * 1024 * 1024;
#pragma unroll 1
  for (int hc = wave; hc < 32; hc += 8) {
    const int c = hc >> 1, nt0 = (hc & 1) * 2;
    f32x4 m[2][4];
#pragma unroll
    for (int a = 0; a < 2; ++a)
#pragma unroll
      for (int b = 0; b < 4; ++b) m[a][b] = (f32x4){0.f, 0.f, 0.f, 0.f};
#pragma unroll 1
    for (int br = 0; br < 3; ++br) {
      const int koff = (br == 0) ? 0 : (br == 1 ? 256 : 768);
      const int KS = (br == 1) ? 16 : 8;
      f32x4 acc[2][4];
#pragma unroll
      for (int a = 0; a < 2; ++a)
#pragma unroll
        for (int b = 0; b < 4; ++b) acc[a][b] = (f32x4){0.f, 0.f, 0.f, 0.f};
      tl_gemm_chunk<2>(wfb + (size_t)koff * 1024 + (size_t)c * KS * 4 * 64 * 8, KS, smem, koff * 2, acc, lane, nt0);
      asm volatile("" ::: "memory");
#pragma unroll
      for (int mt = 0; mt < 4; ++mt) {
        const int tok = t0 + mt * 16 + (lane & 15);
        const bf16_t* gp = p.proj + (size_t)tok * IN_WIDTH + C_GATE + br * 1024 + c * 64 + nt0 * 16 + 4 * (lane >> 4);
#pragma unroll
        for (int nt = 0; nt < 2; ++nt) {
          const uint2 gv = *(const uint2*)(gp + nt * 16);
          m[nt][mt][0] += __uint_as_float(gv.x << 16) * acc[nt][mt][0];
          m[nt][mt][1] += __uint_as_float(gv.x & 0xffff0000u) * acc[nt][mt][1];
          m[nt][mt][2] += __uint_as_float(gv.y << 16) * acc[nt][mt][2];
          m[nt][mt][3] += __uint_as_float(gv.y & 0xffff0000u) * acc[nt][mt][3];
        }
      }
    }
#pragma unroll
    for (int mt = 0; mt < 4; ++mt) {
      const int tok = t0 + mt * 16 + (lane & 15);
      bf16_t* dst = p.mrg + (size_t)tok * 1024 + c * 64 + nt0 * 16 + 4 * (lane >> 4);
#pragma unroll
      for (int nt = 0; nt < 2; ++nt) {
        uint2 o;
        o.x = pack2bf(m[nt][mt][0], m[nt][mt][1]);
        o.y = pack2bf(m[nt][mt][2], m[nt][mt][3]);
        *(uint2*)(dst + nt * 16) = o;
      }
    }
  }
}
__device__ __forceinline__ void o_p5a2_tile(const Params& p, int l, const float* __restrict__ xcur, int t0, char* smem, int tid) {
  const int wave = tid >> 6, lane = tid & 63;
  __syncthreads();
  tile_load_to_lds(p.mrg + (size_t)t0 * 1024, 1024, smem, tid);
  __syncthreads();
  const bf16_t* wfo = p.wf_out + (size_t)l * 1024 * 1024;
#pragma unroll 1
  for (int c = wave; c < 16; c += 8) {
    f32x4 acc[4][4];
#pragma unroll
    for (int a = 0; a < 4; ++a)
#pragma unroll
      for (int b = 0; b < 4; ++b) acc[a][b] = (f32x4){0.f, 0.f, 0.f, 0.f};
    tl_gemm_chunk<4, 2>(wfo + (size_t)c * 32 * 4 * 64 * 8, 32, smem, 0, acc, lane);
    asm volatile("" ::: "memory");
#pragma unroll
    for (int mt = 0; mt < 4; ++mt) {
      const int tok = t0 + mt * 16 + (lane & 15);
      const size_t o = (size_t)tok * 1024 + c * 64 + 4 * (lane >> 4);
#pragma unroll
      for (int nt = 0; nt < 4; ++nt) {
        float4 xv = *(const float4*)(xcur + o + nt * 16);
        xv.x += acc[nt][mt][0]; xv.y += acc[nt][mt][1]; xv.z += acc[nt][mt][2]; xv.w += acc[nt][mt][3];
        *(float4*)(p.xres + o + nt * 16) = xv;
      }
    }
  }
}
__device__ __forceinline__ void o_p5a3_tile(const Params& p, int l, int t0, char* smem, int tid) {
  const int wave = tid >> 6, lane = tid & 63;
  __syncthreads();
  tile_rmsnorm_to_lds(p.xres, p.norm_ffn + l * D_MODEL, t0, smem, wave, lane);
  __syncthreads();
}


__device__ __forceinline__ unsigned mono_f(float f) {
  unsigned u = __float_as_uint(f);
  return (u & 0x80000000u) ? ~u : (u | 0x80000000u);
}
__device__ __forceinline__ float unmono_f(unsigned m) {
  return __uint_as_float((m & 0x80000000u) ? (m & 0x7fffffffu) : ~m);
}
#define CE_DESC(x, y) { const unsigned hi_ = max(x, y); const unsigned lo_ = min(x, y); x = hi_; y = lo_; }
#define CE_ASC(x, y) { const unsigned hi_ = max(x, y); const unsigned lo_ = min(x, y); x = lo_; y = hi_; }
__device__ __forceinline__ void sort16_desc(unsigned (&a)[16]) {
#pragma unroll
  for (int k = 2; k <= 16; k <<= 1) {
#pragma unroll
    for (int j = k >> 1; j > 0; j >>= 1) {
#pragma unroll
      for (int i = 0; i < 16; ++i) {
        const int l = i ^ j;
        if (l > i) {
          if ((i & k) == 0) CE_DESC(a[i], a[l]) else CE_ASC(a[i], a[l])
        }
      }
    }
  }
}
__device__ __forceinline__ void bitonic_merge16_desc(unsigned (&a)[16]) {
#pragma unroll
  for (int j = 8; j > 0; j >>= 1) {
#pragma unroll
    for (int i = 0; i < 16; ++i) {
      const int l = i ^ j;
      if (l > i) CE_DESC(a[i], a[l])
    }
  }
}
__device__ __forceinline__ void xlane_merge16(unsigned (&a)[16], int mask) {
  unsigned b[16];
#pragma unroll
  for (int i = 0; i < 16; ++i) b[i] = (unsigned)__shfl_xor((int)a[i], mask, 64);
#pragma unroll
  for (int i = 0; i < 16; ++i) a[i] = max(a[i], b[15 - i]);
  bitonic_merge16_desc(a);
}

__device__ __forceinline__ void o_peer_select_tile(const Params& p, int l, int t0, char* smem, int tid) {
  const int h = __builtin_amdgcn_readfirstlane(tid >> 6), lane = tid & 63;
  const int g = lane >> 4, tl = lane & 15;
  const bf16_t* wfq = p.wf_q + (size_t)l * 1024 * 2048;
#pragma unroll 1
  for (int pp = 0; pp < 2; ++pp) {
    bf16x8 qf[4][4];
#pragma unroll 1
    for (int cc = 0; cc < 2; ++cc) {
      const int c = (h * 2 + pp) * 2 + cc;
      f32x4 acc[4][4];
#pragma unroll
      for (int a = 0; a < 4; ++a)
#pragma unroll
        for (int b = 0; b < 4; ++b) acc[a][b] = (f32x4){0.f, 0.f, 0.f, 0.f};
      tl_gemm_chunk<4, 2>(wfq + (size_t)c * 32 * 4 * 64 * 8, 32, smem, 0, acc, lane);
#pragma unroll
      for (int sl = 0; sl < 2; ++sl)
#pragma unroll
        for (int mt = 0; mt < 4; ++mt) {
          union { bf16x8 v; unsigned u[4]; } cv;
          cv.u[0] = pack2bf(acc[2 * sl][mt][0], acc[2 * sl][mt][1]);
          cv.u[1] = pack2bf(acc[2 * sl][mt][2], acc[2 * sl][mt][3]);
          cv.u[2] = pack2bf(acc[2 * sl + 1][mt][0], acc[2 * sl + 1][mt][1]);
          cv.u[3] = pack2bf(acc[2 * sl + 1][mt][2], acc[2 * sl + 1][mt][3]);
          if (cc == 0) qf[sl][mt] = cv.v; else qf[2 + sl][mt] = cv.v;
        }
    }
    const bf16x8* kfp = (const bf16x8*)p.kf + (size_t)((l * 2 + pp) * 8) * 4 * 64 + lane;
#pragma unroll
    for (int mt = 0; mt < 4; ++mt) {
      f32x4 sc[8];
#pragma unroll
      for (int kt = 0; kt < 8; ++kt) sc[kt] = (f32x4){0.f, 0.f, 0.f, 0.f};
#pragma unroll
      for (int s2 = 0; s2 < 4; ++s2) {
        bf16x8 qv;
        qv = qf[s2][mt];
#pragma unroll
        for (int kt = 0; kt < 8; ++kt)
          sc[kt] = __builtin_amdgcn_mfma_f32_16x16x32_bf16(kfp[(kt * 4 + s2) * 64], qv, sc[kt], 0, 0, 0);
        __builtin_amdgcn_sched_barrier(0);
      }
      unsigned A[16], B[16];
#pragma unroll
      for (int kt = 0; kt < 4; ++kt)
#pragma unroll
        for (int r = 0; r < 4; ++r) {
          A[kt * 4 + r] = (mono_f(sc[kt][r]) & ~127u) | (unsigned)(127 - (kt * 16 + r) - 4 * g);
          B[kt * 4 + r] = (mono_f(sc[kt + 4][r]) & ~127u) | (unsigned)(127 - ((kt + 4) * 16 + r) - 4 * g);
        }
      sort16_desc(A);
      sort16_desc(B);
#pragma unroll
      for (int i = 0; i < 16; ++i) A[i] = max(A[i], B[15 - i]);
      bitonic_merge16_desc(A);
      xlane_merge16(A, 16);
      xlane_merge16(A, 32);
      if (g == 0) {
        uint4* dst = (uint4*)(p.tklist + ((size_t)((t0 + mt * 16 + tl) * 8 + h) * 2 + pp) * 16);
        dst[0] = make_uint4(A[0], A[1], A[2], A[3]);
        dst[1] = make_uint4(A[4], A[5], A[6], A[7]);
        dst[2] = make_uint4(A[8], A[9], A[10], A[11]);
        dst[3] = make_uint4(A[12], A[13], A[14], A[15]);
      }
    }
  }
  asm volatile("s_waitcnt vmcnt(0)" ::: "memory");
}

__device__ __forceinline__ void o_peer_select2_tile(const Params& p, int l, int t0, int tid) {
  const int h = __builtin_amdgcn_readfirstlane(tid >> 6), lane = tid & 63;
  const int g = lane >> 4, tl = lane & 15;
#pragma unroll 1
  for (int mt = 0; mt < 4; ++mt) {
    const int tok = t0 + mt * 16 + tl;
    const unsigned* lp = p.tklist + ((size_t)(tok * 8 + h) * 2) * 16;
    float v1[16], v2[16];
    {
      const uint4* q4 = (const uint4*)lp;
#pragma unroll
      for (int i = 0; i < 4; ++i) {
        uint4 x = q4[i], y = q4[4 + i];
        v1[4 * i + 0] = unmono_f(x.x & ~127u); v1[4 * i + 1] = unmono_f(x.y & ~127u);
        v1[4 * i + 2] = unmono_f(x.z & ~127u); v1[4 * i + 3] = unmono_f(x.w & ~127u);
        v2[4 * i + 0] = unmono_f(y.x & ~127u); v2[4 * i + 1] = unmono_f(y.y & ~127u);
        v2[4 * i + 2] = unmono_f(y.z & ~127u); v2[4 * i + 3] = unmono_f(y.w & ~127u);
      }
    }
    unsigned C[16];
#pragma unroll
    for (int i = 0; i < 16; ++i) C[i] = 0u;
    {
      int idx = 0;
#pragma unroll
      for (int a = 0; a < 16; ++a) {
#pragma unroll
        for (int b = 0; b < 16; ++b) {
          if ((a + 1) * (b + 1) <= 16) {
            const unsigned key = (mono_f(v1[a] + v2[b]) & ~255u) | (unsigned)(255 - (a * 16 + b));
            const int slot = idx >> 2, who = idx & 3;
            C[slot] = (g == who) ? key : C[slot];
            ++idx;
          }
        }
      }
    }
    sort16_desc(C);
    xlane_merge16(C, 16);
    xlane_merge16(C, 32);
    const float f0 = unmono_f(C[0] & ~255u);
    float den = 0.f;
    float ev[16];
#pragma unroll
    for (int i = 0; i < 16; ++i) { ev[i] = __expf(unmono_f(C[i] & ~255u) - f0); den += ev[i]; }
    const float rden = 1.0f / den;
    int eidx[4]; float egate[4];
#pragma unroll
    for (int i = 0; i < 4; ++i) {
      const unsigned k = (g == 0) ? C[i] : (g == 1) ? C[4 + i] : (g == 2) ? C[8 + i] : C[12 + i];
      const float e = (g == 0) ? ev[i] : (g == 1) ? ev[4 + i] : (g == 2) ? ev[8 + i] : ev[12 + i];
      const int pos = 255 - (int)(k & 255u);
      const int a = pos >> 4, b = pos & 15;
      const int n1 = 127 - (int)(lp[a] & 127u);
      const int n2 = 127 - (int)(lp[16 + b] & 127u);
      eidx[i] = n1 * 128 + n2;
      egate[i] = e * rden;
    }
    *(int4*)(p.pidx + (size_t)tok * 128 + h * 16 + 4 * g) = make_int4(eidx[0], eidx[1], eidx[2], eidx[3]);
    *(float4*)(p.pgate + (size_t)tok * 128 + h * 16 + 4 * g) = make_float4(egate[0], egate[1], egate[2], egate[3]);
  }
}

__device__ __forceinline__ void o_peer_experts_tile(const Params& p, int l, int t0, const char* smem, int tid) {
  const int wave = tid >> 6, lane = tid & 63;
  const bf16_t* U = p.u16 + (size_t)l * 16384 * 1024;
  const bf16_t* V = p.v16 + (size_t)l * 16384 * 1024;
  int vz = 0;
  asm volatile("" : "+v"(vz));
#pragma unroll 1
  for (int i8 = 0; i8 < 8; ++i8) {
    const int tl = wave * 8 + i8;
    const int tok = t0 + tl;
    float hv[16], acc[16];
    {
      const uint4 h0 = *(const uint4*)(smem + tl * LDXB + lane * 16);
      const uint4 h1 = *(const uint4*)(smem + tl * LDXB + 1024 + lane * 16);
      const unsigned hw[8] = {h0.x, h0.y, h0.z, h0.w, h1.x, h1.y, h1.z, h1.w};
#pragma unroll
      for (int j = 0; j < 8; ++j) {
        hv[2 * j] = __uint_as_float(hw[j] << 16);
        hv[2 * j + 1] = __uint_as_float(hw[j] & 0xffff0000u);
        acc[2 * j] = 0.f; acc[2 * j + 1] = 0.f;
      }
    }
    const int* ip = p.pidx + (size_t)tok * 128 + vz;
    const float* gp = p.pgate + (size_t)tok * 128 + vz;
#pragma unroll 1
    for (int k = 0; k < 128; k += 4) {
      const int4 e4 = *(const int4*)(ip + k);
      const float4 g4 = *(const float4*)(gp + k);
      const int ee[4] = {e4.x, e4.y, e4.z, e4.w};
      const float gg[4] = {g4.x, g4.y, g4.z, g4.w};
      uint4 ur[4][2];
#pragma unroll
      for (int q = 0; q < 4; ++q) {
        const char* up = (const char*)(U + (size_t)ee[q] * 1024) + lane * 16;
        ur[q][0] = *(const uint4*)up;
        ur[q][1] = *(const uint4*)(up + 1024);
      }
      uint4 vr[4][2];
#pragma unroll
      for (int q = 0; q < 4; ++q) {
        const char* vp = (const char*)(V + (size_t)ee[q] * 1024) + lane * 16;
        vr[q][0] = *(const uint4*)vp;
        vr[q][1] = *(const uint4*)(vp + 1024);
      }
      float hh[4];
#pragma unroll
      for (int q = 0; q < 4; ++q) {
        const unsigned uw[8] = {ur[q][0].x, ur[q][0].y, ur[q][0].z, ur[q][0].w, ur[q][1].x, ur[q][1].y, ur[q][1].z, ur[q][1].w};
        float a = 0.f;
#pragma unroll
        for (int j = 0; j < 8; ++j) {
          a = fmaf(hv[2 * j], __uint_as_float(uw[j] << 16), a);
          a = fmaf(hv[2 * j + 1], __uint_as_float(uw[j] & 0xffff0000u), a);
        }
        a = wave_sum(a);
        hh[q] = 0.5f * a * (1.0f + erff(a * 0.70710678118654752f)) * gg[q];
      }
#pragma unroll
      for (int q = 0; q < 4; ++q) {
        const unsigned vw[8] = {vr[q][0].x, vr[q][0].y, vr[q][0].z, vr[q][0].w, vr[q][1].x, vr[q][1].y, vr[q][1].z, vr[q][1].w};
#pragma unroll
        for (int j = 0; j < 8; ++j) {
          acc[2 * j] = fmaf(hh[q], __uint_as_float(vw[j] << 16), acc[2 * j]);
          acc[2 * j + 1] = fmaf(hh[q], __uint_as_float(vw[j] & 0xffff0000u), acc[2 * j + 1]);
        }
      }
    }
    float* xr = p.xres + (size_t)tok * 1024 + lane * 8;
#pragma unroll
    for (int i = 0; i < 2; ++i) {
      float4 a0 = *(float4*)(xr + i * 512), a1 = *(float4*)(xr + i * 512 + 4);
      a0.x += acc[8 * i + 0]; a0.y += acc[8 * i + 1]; a0.z += acc[8 * i + 2]; a0.w += acc[8 * i + 3];
      a1.x += acc[8 * i + 4]; a1.y += acc[8 * i + 5]; a1.z += acc[8 * i + 6]; a1.w += acc[8 * i + 7];
      *(float4*)(xr + i * 512) = a0;
      *(float4*)(xr + i * 512 + 4) = a1;
    }
  }
}


__device__ __forceinline__ float logsigmoid_(float x) { return fminf(x, 0.f) - log1pf(expf(-fabsf(x))); }
__device__ __forceinline__ float bf_lo(unsigned w) { return __uint_as_float(w << 16); }
__device__ __forceinline__ float bf_hi(unsigned w) { return __uint_as_float(w & 0xffff0000u); }

#define RKV_LD 136
__device__ __forceinline__ void o_ret_kv_task(const Params& p, int l, int task, char* smem, int tid) {
  const int wave = tid >> 6, lane = tid & 63, g = lane >> 4, tl = lane & 15;
  const int bh = task >> 5, n = task & 31, b = bh >> 2, h = bh & 3;
  const int tok0 = b * SEQ + n * 128;
  const float lgf = logsigmoid_(p.ret_decay[l * 8 + h]), lgb = logsigmoid_(p.ret_decay[l * 8 + 4 + h]);
  bf16_t* KTf = (bf16_t*)smem;
  bf16_t* KTb = KTf + 64 * RKV_LD;
  bf16_t* VT = KTb + 64 * RKV_LD;
  __syncthreads();
#pragma unroll
  for (int it = 0; it < 2; ++it) {
    const int u = tid + it * NTHREADS;
    const int j = u >> 3, d0 = (u & 7) * 8;
    const uint4 kv = *(const uint4*)(p.proj + (size_t)(tok0 + j) * IN_WIDTH + C_RK + h * 64 + d0);
    const float wf = __expf(lgf * (float)(127 - j)), wb = __expf(lgb * (float)(j + 1));
    const unsigned kw[4] = {kv.x, kv.y, kv.z, kv.w};
#pragma unroll
    for (int e = 0; e < 4; ++e) {
      const float x0 = bf_lo(kw[e]), x1 = bf_hi(kw[e]);
      KTf[(d0 + 2 * e) * RKV_LD + j] = f2bf(x0 * wf);
      KTf[(d0 + 2 * e + 1) * RKV_LD + j] = f2bf(x1 * wf);
      KTb[(d0 + 2 * e) * RKV_LD + j] = f2bf(x0 * wb);
      KTb[(d0 + 2 * e + 1) * RKV_LD + j] = f2bf(x1 * wb);
    }
  }
#pragma unroll
  for (int it = 0; it < 4; ++it) {
    const int u = tid + it * NTHREADS;
    const int j = u >> 4, e0 = (u & 15) * 8;
    const uint4 vv = *(const uint4*)(p.proj + (size_t)(tok0 + j) * IN_WIDTH + C_RV + h * 128 + e0);
    const unsigned vw[4] = {vv.x, vv.y, vv.z, vv.w};
#pragma unroll
    for (int e = 0; e < 4; ++e) {
      VT[(e0 + 2 * e) * RKV_LD + j] = (bf16_t)(vw[e] & 0xffffu);
      VT[(e0 + 2 * e + 1) * RKV_LD + j] = (bf16_t)(vw[e] >> 16);
    }
  }
  __syncthreads();
  bf16x8 a[4];
#pragma unroll
  for (int ks = 0; ks < 4; ++ks) a[ks] = *(const bf16x8*)(VT + (wave * 16 + tl) * RKV_LD + ks * 32 + 8 * g);
#pragma unroll
  for (int dir = 0; dir < 2; ++dir) {
    const bf16_t* KT = dir ? KTb : KTf;
#pragma unroll
    for (int dt = 0; dt < 4; ++dt) {
      f32x4 acc = (f32x4){0.f, 0.f, 0.f, 0.f};
#pragma unroll
      for (int ks = 0; ks < 4; ++ks) {
        const bf16x8 bb = *(const bf16x8*)(KT + (dt * 16 + tl) * RKV_LD + ks * 32 + 8 * g);
        acc = __builtin_amdgcn_mfma_f32_16x16x32_bf16(a[ks], bb, acc, 0, 0, 0);
      }
      float* dst = p.kvst + ((size_t)(task * 2 + dir) * 128 + wave * 16 + 4 * g) * 64 + dt * 16 + tl;
#pragma unroll
      for (int r = 0; r < 4; ++r) dst[r * 64] = acc[r];
    }
  }
}

__device__ __forceinline__ void o_ret_scan(const int wv_, const Params& p, int l) {
  const int tidx_ = opaque_tid(wv_); const int bidx_ = opaque_bid();
  const int gsz = gridDim.x * NTHREADS;
  for (int u = bidx_ * NTHREADS + tidx_; u < 16 * 2 * 128 * 16; u += gsz) {
    const int dq = u & 15, e = (u >> 4) & 127, dir = (u >> 11) & 1, bh = u >> 12, h = bh & 3;
    const float lg = logsigmoid_(p.ret_decay[l * 8 + dir * 4 + h]);
    const float gC = __expf(lg * 128.0f);
    float4 st = make_float4(0.f, 0.f, 0.f, 0.f);
#pragma unroll 8
    for (int nn = 0; nn < 32; ++nn) {
      const int n = dir ? (31 - nn) : nn;
      const size_t idx = ((size_t)((bh * 32 + n) * 2 + dir) * 128 + e) * 64 + dq * 4;
      const float4 kv = *(const float4*)(p.kvst + idx);
      uint2 o;
      o.x = pack2bf(st.x, st.y); o.y = pack2bf(st.z, st.w);
      *(uint2*)(p.rstate + idx) = o;
      st.x = fmaf(st.x, gC, kv.x); st.y = fmaf(st.y, gC, kv.y); st.z = fmaf(st.z, gC, kv.z); st.w = fmaf(st.w, gC, kv.w);
    }
  }
}

#define RO_LD 264
#define RK_LD 72
__device__ __forceinline__ void o_ret_out_task(const Params& p, int l, int task, char* smem, int tid) {
  const int wave = tid >> 6, lane = tid & 63, g = lane >> 4, tl = lane & 15;
  const int bh = task >> 5, n = task & 31, b = bh >> 2, h = bh & 3;
  const int tok0 = b * SEQ + n * 128;
  const float lgf = logsigmoid_(p.ret_decay[l * 8 + h]), lgb = logsigmoid_(p.ret_decay[l * 8 + 4 + h]);
  bf16_t* Acat = (bf16_t*)smem;
  bf16_t* Bcat = Acat + 128 * RO_LD;
  bf16_t* Kl = Bcat + 128 * RO_LD;
  __syncthreads();
#pragma unroll
  for (int it = 0; it < 2; ++it) {
    const int u = tid + it * NTHREADS;
    const int i = u >> 3, d0 = (u & 7) * 8;
    const size_t row = (size_t)(tok0 + i) * IN_WIDTH;
    const uint4 qv = *(const uint4*)(p.proj + row + C_RQ + h * 64 + d0);
    const uint4 kv = *(const uint4*)(p.proj + row + C_RK + h * 64 + d0);
    *(uint4*)(Acat + i * RO_LD + d0) = qv;
    *(uint4*)(Kl + i * RK_LD + d0) = kv;
    const float wf = __expf(lgf * (float)(i + 1)), wb = __expf(lgb * (float)(127 - i));
    const unsigned qw[4] = {qv.x, qv.y, qv.z, qv.w};
    uint4 of, ob;
    of.x = pack2bf(bf_lo(qw[0]) * wf, bf_hi(qw[0]) * wf); ob.x = pack2bf(bf_lo(qw[0]) * wb, bf_hi(qw[0]) * wb);
    of.y = pack2bf(bf_lo(qw[1]) * wf, bf_hi(qw[1]) * wf); ob.y = pack2bf(bf_lo(qw[1]) * wb, bf_hi(qw[1]) * wb);
    of.z = pack2bf(bf_lo(qw[2]) * wf, bf_hi(qw[2]) * wf); ob.z = pack2bf(bf_lo(qw[2]) * wb, bf_hi(qw[2]) * wb);
    of.w = pack2bf(bf_lo(qw[3]) * wf, bf_hi(qw[3]) * wf); ob.w = pack2bf(bf_lo(qw[3]) * wb, bf_hi(qw[3]) * wb);
    *(uint4*)(Acat + i * RO_LD + 128 + d0) = of;
    *(uint4*)(Acat + i * RO_LD + 192 + d0) = ob;
  }
#pragma unroll
  for (int it = 0; it < 4; ++it) {
    const int u = tid + it * NTHREADS;
    const int j = u >> 4, e0 = (u & 15) * 8;
    const uint4 vv = *(const uint4*)(p.proj + (size_t)(tok0 + j) * IN_WIDTH + C_RV + h * 128 + e0);
    const unsigned vw[4] = {vv.x, vv.y, vv.z, vv.w};
#pragma unroll
    for (int e = 0; e < 4; ++e) {
      Bcat[(e0 + 2 * e) * RO_LD + j] = (bf16_t)(vw[e] & 0xffffu);
      Bcat[(e0 + 2 * e + 1) * RO_LD + j] = (bf16_t)(vw[e] >> 16);
    }
  }
#pragma unroll
  for (int it = 0; it < 4; ++it) {
    const int u = tid + it * NTHREADS;
    const int d0 = (u & 7) * 8, e = (u >> 3) & 127, dir = u >> 10;
    const uint4 sv = *(const uint4*)(p.rstate + ((size_t)(task * 2 + dir) * 128 + e) * 64 + d0);
    *(uint4*)(Bcat + e * RO_LD + 128 + dir * 64 + d0) = sv;
  }
  __syncthreads();
  f32x4 sc[8];
#pragma unroll
  for (int jt = 0; jt < 8; ++jt) sc[jt] = (f32x4){0.f, 0.f, 0.f, 0.f};
#pragma unroll
  for (int ks = 0; ks < 2; ++ks) {
    const bf16x8 qb = *(const bf16x8*)(Acat + (wave * 16 + tl) * RO_LD + ks * 32 + 8 * g);
#pragma unroll
    for (int jt = 0; jt < 8; ++jt) {
      const bf16x8 ka = *(const bf16x8*)(Kl + (jt * 16 + tl) * RK_LD + ks * 32 + 8 * g);
      sc[jt] = __builtin_amdgcn_mfma_f32_16x16x32_bf16(ka, qb, sc[jt], 0, 0, 0);
    }
  }
  {
    const int i = wave * 16 + tl;
#pragma unroll
    for (int jt = 0; jt < 8; ++jt) {
      float pv[4];
#pragma unroll
      for (int r = 0; r < 4; ++r) {
        const int j = jt * 16 + 4 * g + r;
        const float dd = (j <= i) ? __expf(lgf * (float)(i - j)) : __expf(lgb * (float)(j - i));
        pv[r] = sc[jt][r] * dd;
      }
      uint2 o;
      o.x = pack2bf(pv[0], pv[1]); o.y = pack2bf(pv[2], pv[3]);
      *(uint2*)(Acat + i * RO_LD + jt * 16 + 4 * g) = o;
    }
  }
  f32x4 y[8];
#pragma unroll
  for (int et = 0; et < 8; ++et) y[et] = (f32x4){0.f, 0.f, 0.f, 0.f};
#pragma unroll
  for (int ks = 0; ks < 8; ++ks) {
    const bf16x8 ab = *(const bf16x8*)(Acat + (wave * 16 + tl) * RO_LD + ks * 32 + 8 * g);
#pragma unroll
    for (int et = 0; et < 8; ++et) {
      const bf16x8 ba = *(const bf16x8*)(Bcat + (et * 16 + tl) * RO_LD + ks * 32 + 8 * g);
      y[et] = __builtin_amdgcn_mfma_f32_16x16x32_bf16(ba, ab, y[et], 0, 0, 0);
    }
  }
  float ss = 0.f;
#pragma unroll
  for (int et = 0; et < 8; ++et)
#pragma unroll
    for (int r = 0; r < 4; ++r) ss = fmaf(y[et][r], y[et][r], ss);
  ss += __shfl_xor(ss, 16, 64);
  ss += __shfl_xor(ss, 32, 64);
  const float rstd = rsqrtf(ss * (1.0f / 128.0f) + EPS);
  {
    const int tok = tok0 + wave * 16 + tl;
    const bf16_t* gp = p.proj + (size_t)tok * IN_WIDTH + C_RG + h * 128 + 4 * g;
    bf16_t* dst = p.ycat + (size_t)tok * 1024 + 256 + h * 128 + 4 * g;
#pragma unroll
    for (int et = 0; et < 8; ++et) {
      const uint2 gv = *(const uint2*)(gp + et * 16);
      const float g0 = bf_lo(gv.x), g1 = bf_hi(gv.x), g2 = bf_lo(gv.y), g3 = bf_hi(gv.y);
      uint2 o;
      o.x = pack2bf(g0 / (1.0f + __expf(-g0)) * y[et][0] * rstd, g1 / (1.0f + __expf(-g1)) * y[et][1] * rstd);
      o.y = pack2bf(g2 / (1.0f + __expf(-g2)) * y[et][2] * rstd, g3 / (1.0f + __expf(-g3)) * y[et][3] * rstd);
      *(uint2*)(dst + et * 16) = o;
    }
  }
}


#define NA_KLD 72
#define NA_VLD 520
__device__ __forceinline__ void o_na_task(const Params& p, int l, int task, char* smem, int tid) {
  const int wave = tid >> 6, lane = tid & 63, g = lane >> 4, tl = lane & 15;
  const int rr = task & 63, h = (task >> 6) & 3, b = task >> 8;
  int rs = rr - 4; rs = rs < 0 ? 0 : (rs > 56 ? 56 : rs);
  const int ktok0 = b * SEQ + rs * 64;
  const int qtok0 = b * SEQ + rr * 64;
  bf16_t* Kl = (bf16_t*)smem;
  bf16_t* VT = Kl + 512 * NA_KLD;
  bf16_t* Ql = VT + 64 * NA_VLD;
  float* rpbl = (float*)(Ql + 64 * NA_KLD);
  __syncthreads();
#pragma unroll
  for (int it = 0; it < 8; ++it) {
    const int u = tid + it * NTHREADS;
    const int key = u >> 3, d0 = (u & 7) * 8;
    const size_t row = (size_t)(ktok0 + key) * IN_WIDTH;
    const uint4 kv = *(const uint4*)(p.proj + row + C_NK + h * 64 + d0);
    const uint4 vv = *(const uint4*)(p.proj + row + C_NV + h * 64 + d0);
    *(uint4*)(Kl + key * NA_KLD + d0) = kv;
    const unsigned vw[4] = {vv.x, vv.y, vv.z, vv.w};
#pragma unroll
    for (int e = 0; e < 4; ++e) {
      VT[(d0 + 2 * e) * NA_VLD + key] = (bf16_t)(vw[e] & 0xffffu);
      VT[(d0 + 2 * e + 1) * NA_VLD + key] = (bf16_t)(vw[e] >> 16);
    }
  }
  {
    const int q = tid >> 3, d0 = (tid & 7) * 8;
    *(uint4*)(Ql + q * NA_KLD + d0) = *(const uint4*)(p.proj + (size_t)(qtok0 + q) * IN_WIDTH + C_NQ + h * 64 + d0);
    if (tid < 465) rpbl[tid] = p.na_rpb[((size_t)l * 4 + h) * 465 + tid];
  }
  __syncthreads();
  if (wave < 4) {
    const int qt = wave;
    int cw0 = 16 * qt - 8; cw0 = cw0 < 0 ? 0 : (cw0 > 32 ? 32 : cw0);
    f32x4 sc[16];
#pragma unroll
    for (int T = 0; T < 16; ++T) sc[T] = (f32x4){0.f, 0.f, 0.f, 0.f};
#pragma unroll
    for (int ks = 0; ks < 2; ++ks) {
      const bf16x8 qb = *(const bf16x8*)(Ql + (qt * 16 + tl) * NA_KLD + ks * 32 + 8 * g);
#pragma unroll
      for (int T = 0; T < 16; ++T) {
        const int key = (T >> 1) * 64 + cw0 + (T & 1) * 16 + tl;
        const bf16x8 ka = *(const bf16x8*)(Kl + key * NA_KLD + ks * 32 + 8 * g);
        sc[T] = __builtin_amdgcn_mfma_f32_16x16x32_bf16(ka, qb, sc[T], 0, 0, 0);
      }
    }
    const int cq = qt * 16 + tl;
    int cs = cq - 8; cs = cs < 0 ? 0 : (cs > 48 ? 48 : cs);
    float m = -3.0e38f;
#pragma unroll
    for (int T = 0; T < 16; ++T) {
      const int ri = T >> 1;
      const int di = rs + ri - rr + 7;
#pragma unroll
      for (int r = 0; r < 4; ++r) {
        const int ck = cw0 + (T & 1) * 16 + 4 * g + r;
        const bool valid = (ck >= cs) && (ck < cs + 16);
        int dj = ck - cq + 15; dj = dj < 0 ? 0 : (dj > 30 ? 30 : dj);
        const float sv = valid ? (sc[T][r] + rpbl[di * 31 + dj]) : -1.0e30f;
        sc[T][r] = sv;
        m = fmaxf(m, sv);
      }
    }
    m = fmaxf(m, __shfl_xor(m, 16, 64));
    m = fmaxf(m, __shfl_xor(m, 32, 64));
    float den = 0.f;
#pragma unroll
    for (int T = 0; T < 16; ++T)
#pragma unroll
      for (int r = 0; r < 4; ++r) {
        const float e = __expf(sc[T][r] - m);
        sc[T][r] = e;
        den += e;
      }
    den += __shfl_xor(den, 16, 64);
    den += __shfl_xor(den, 32, 64);
    const float rden = 1.0f / den;
    f32x4 o[4];
#pragma unroll
    for (int dt = 0; dt < 4; ++dt) o[dt] = (f32x4){0.f, 0.f, 0.f, 0.f};
#pragma unroll
    for (int ri = 0; ri < 8; ++ri) {
      union { bf16x8 v; unsigned u[4]; } pb;
      pb.u[0] = pack2bf(sc[2 * ri][0], sc[2 * ri][1]);
      pb.u[1] = pack2bf(sc[2 * ri][2], sc[2 * ri][3]);
      pb.u[2] = pack2bf(sc[2 * ri + 1][0], sc[2 * ri + 1][1]);
      pb.u[3] = pack2bf(sc[2 * ri + 1][2], sc[2 * ri + 1][3]);
#pragma unroll
      for (int dt = 0; dt < 4; ++dt) {
        const bf16_t* vp = VT + (dt * 16 + tl) * NA_VLD + ri * 64 + cw0 + 4 * g;
        union { bf16x8 v; uint2 h[2]; } va;
        va.h[0] = *(const uint2*)vp;
        va.h[1] = *(const uint2*)(vp + 16);
        o[dt] = __builtin_amdgcn_mfma_f32_16x16x32_bf16(va.v, pb.v, o[dt], 0, 0, 0);
      }
    }
    bf16_t* dst = p.ycat + (size_t)(qtok0 + qt * 16 + tl) * 1024 + 768 + h * 64 + 4 * g;
#pragma unroll
    for (int dt = 0; dt < 4; ++dt) {
      uint2 ov;
      ov.x = pack2bf(o[dt][0] * rden, o[dt][1] * rden);
      ov.y = pack2bf(o[dt][2] * rden, o[dt][3] * rden);
      *(uint2*)(dst + dt * 16) = ov;
    }
  }
}

#define PL_LD 264
__device__ __forceinline__ void o_pool_task(const Params& p, int l, int task, char* smem, int tid) {
  const int wave = tid >> 6, lane = tid & 63, g = lane >> 4, tl = lane & 15;
  const int t0 = task * 64, pos0 = t0 & (SEQ - 1);
  bf16_t* Xp = (bf16_t*)smem;
  bf16_t* WT = Xp + 80 * PL_LD;
  bf16_t* Df = WT + 4 * 64 * 72;
  __syncthreads();
#pragma unroll
  for (int it = 0; it < 5; ++it) {
    const int u = tid + it * NTHREADS;
    const int rw = u >> 5, c0 = (u & 31) * 8;
    const int pos = pos0 - 8 + rw;
    uint4 v = make_uint4(0u, 0u, 0u, 0u);
    if (pos >= 0 && pos < SEQ) v = *(const uint4*)(p.proj + (size_t)(t0 - 8 + rw) * IN_WIDTH + C_POOL + c0);
    *(uint4*)(Xp + rw * PL_LD + c0) = v;
  }
#pragma unroll
  for (int it = 0; it < 4; ++it) {
    const int u = tid + it * NTHREADS;
    const int e0 = (u & 7) * 8, c = (u >> 3) & 63, gi = u >> 9;
    const float* wp = p.pool_w + (((size_t)l * 4 + gi) * 64 + c) * 64 + e0;
    const float4 a = *(const float4*)wp, bq = *(const float4*)(wp + 4);
    const float wv[8] = {a.x, a.y, a.z, a.w, bq.x, bq.y, bq.z, bq.w};
#pragma unroll
    for (int k = 0; k < 8; ++k) WT[(gi * 64 + e0 + k) * 72 + c] = f2bf(wv[k]);
  }
  __syncthreads();
#pragma unroll 1
  for (int it = 0; it < 4; ++it) {
    const int u = tid + it * NTHREADS;
    const int t = u >> 5, c0 = (u & 31) * 8;
    const int gi = c0 >> 6;
    const int hw = 1 << gi;
    const int pos = pos0 + t;
    int a = pos - hw; a = a < 0 ? 0 : a;
    int bnd = pos + hw; bnd = bnd > SEQ ? SEQ : bnd;
    float sum[8];
#pragma unroll
    for (int k = 0; k < 8; ++k) sum[k] = 0.f;
    for (int rp = a; rp < bnd; ++rp) {
      const uint4 v = *(const uint4*)(Xp + (rp - pos0 + 8) * PL_LD + c0);
      sum[0] += bf_lo(v.x); sum[1] += bf_hi(v.x); sum[2] += bf_lo(v.y); sum[3] += bf_hi(v.y);
      sum[4] += bf_lo(v.z); sum[5] += bf_hi(v.z); sum[6] += bf_lo(v.w); sum[7] += bf_hi(v.w);
    }
    const float rc = 1.0f / (float)(bnd - a);
    const uint4 xv = *(const uint4*)(Xp + (t + 8) * PL_LD + c0);
    uint4 o;
    o.x = pack2bf(sum[0] * rc - bf_lo(xv.x), sum[1] * rc - bf_hi(xv.x));
    o.y = pack2bf(sum[2] * rc - bf_lo(xv.y), sum[3] * rc - bf_hi(xv.y));
    o.z = pack2bf(sum[4] * rc - bf_lo(xv.z), sum[5] * rc - bf_hi(xv.z));
    o.w = pack2bf(sum[6] * rc - bf_lo(xv.w), sum[7] * rc - bf_hi(xv.w));
    *(uint4*)(Df + t * PL_LD + c0) = o;
  }
  __syncthreads();
  {
    const int gi = wave >> 1, tt0 = (wave & 1) * 2;
    f32x4 acc[4][2];
#pragma unroll
    for (int et = 0; et < 4; ++et)
#pragma unroll
      for (int tt = 0; tt < 2; ++tt) acc[et][tt] = (f32x4){0.f, 0.f, 0.f, 0.f};
#pragma unroll
    for (int ks = 0; ks < 2; ++ks) {
      bf16x8 bx[2];
#pragma unroll
      for (int tt = 0; tt < 2; ++tt) bx[tt] = *(const bf16x8*)(Df + ((tt0 + tt) * 16 + tl) * PL_LD + gi * 64 + ks * 32 + 8 * g);
#pragma unroll
      for (int et = 0; et < 4; ++et) {
        const bf16x8 wa = *(const bf16x8*)(WT + (gi * 64 + et * 16 + tl) * 72 + ks * 32 + 8 * g);
#pragma unroll
        for (int tt = 0; tt < 2; ++tt) acc[et][tt] = __builtin_amdgcn_mfma_f32_16x16x32_bf16(wa, bx[tt], acc[et][tt], 0, 0, 0);
      }
    }
#pragma unroll
    for (int et = 0; et < 4; ++et) {
      const float4 sc4 = *(const float4*)(p.pool_scale + l * 256 + gi * 64 + et * 16 + 4 * g);
#pragma unroll
      for (int tt = 0; tt < 2; ++tt) {
        const int tok = t0 + (tt0 + tt) * 16 + tl;
        uint2 o;
        o.x = pack2bf(acc[et][tt][0] * sc4.x, acc[et][tt][1] * sc4.y);
        o.y = pack2bf(acc[et][tt][2] * sc4.z, acc[et][tt][3] * sc4.w);
        *(uint2*)(p.ycat + (size_t)tok * 1024 + gi * 64 + et * 16 + 4 * g) = o;
      }
    }
  }
}


typedef __attribute__((ext_vector_type(2))) __bf16 bf16x2_t;
__device__ __forceinline__ float dot2bf(unsigned a, unsigned b, float c) {
  return __builtin_amdgcn_fdot2_f32_bf16(__builtin_bit_cast(bf16x2_t, a), __builtin_bit_cast(bf16x2_t, b), c, false);
}
__device__ __forceinline__ float gelu_exact(float a) { return 0.5f * a * (1.0f + erff(a * 0.70710678118654752f)); }

struct PickPair { int eA, eB; float gA, gB; };

__device__ __forceinline__ void experts_process2(const bf16_t* __restrict__ U, const bf16_t* __restrict__ V, const PickPair pk,
                                                 const unsigned (&hw)[8], float (&acc)[16], int lane) {
  const char* uA = (const char*)(U + (size_t)pk.eA * 1024) + lane * 16;
  const char* uB = (const char*)(U + (size_t)pk.eB * 1024) + lane * 16;
  const char* vA = (const char*)(V + (size_t)pk.eA * 1024) + lane * 16;
  const char* vB = (const char*)(V + (size_t)pk.eB * 1024) + lane * 16;
  const uint4 ua0 = *(const uint4*)uA, ua1 = *(const uint4*)(uA + 1024);
  const uint4 ub0 = *(const uint4*)uB, ub1 = *(const uint4*)(uB + 1024);
  const uint4 va0 = *(const uint4*)vA, va1 = *(const uint4*)(vA + 1024);
  const uint4 vb0 = *(const uint4*)vB, vb1 = *(const uint4*)(vB + 1024);
  float aA = 0.f, aB = 0.f;
  aA = dot2bf(ua0.x, hw[0], aA); aA = dot2bf(ua0.y, hw[1], aA); aA = dot2bf(ua0.z, hw[2], aA); aA = dot2bf(ua0.w, hw[3], aA);
  aA = dot2bf(ua1.x, hw[4], aA); aA = dot2bf(ua1.y, hw[5], aA); aA = dot2bf(ua1.z, hw[6], aA); aA = dot2bf(ua1.w, hw[7], aA);
  aB = dot2bf(ub0.x, hw[0], aB); aB = dot2bf(ub0.y, hw[1], aB); aB = dot2bf(ub0.z, hw[2], aB); aB = dot2bf(ub0.w, hw[3], aB);
  aB = dot2bf(ub1.x, hw[4], aB); aB = dot2bf(ub1.y, hw[5], aB); aB = dot2bf(ub1.z, hw[6], aB); aB = dot2bf(ub1.w, hw[7], aB);
#pragma unroll
  for (int o = 32; o > 0; o >>= 1) { aA += __shfl_xor(aA, o, 64); aB += __shfl_xor(aB, o, 64); }
  const float hA = gelu_exact(aA) * pk.gA, hB = gelu_exact(aB) * pk.gB;
  const unsigned hAl = (unsigned)f2bf(hA), hAh = hAl << 16;
  const unsigned hBl = (unsigned)f2bf(hB), hBh = hBl << 16;
  const unsigned vaw[8] = {va0.x, va0.y, va0.z, va0.w, va1.x, va1.y, va1.z, va1.w};
  const unsigned vbw[8] = {vb0.x, vb0.y, vb0.z, vb0.w, vb1.x, vb1.y, vb1.z, vb1.w};
#pragma unroll
  for (int i = 0; i < 8; ++i) {
    acc[2 * i] = dot2bf(vaw[i], hAl, acc[2 * i]);
    acc[2 * i + 1] = dot2bf(vaw[i], hAh, acc[2 * i + 1]);
    acc[2 * i] = dot2bf(vbw[i], hBl, acc[2 * i]);
    acc[2 * i + 1] = dot2bf(vbw[i], hBh, acc[2 * i + 1]);
  }
}

__device__ __forceinline__ void o_peer_experts2_tile(const Params& p, int l, int t0, const char* smem, int tid) {
  const int wave = __builtin_amdgcn_readfirstlane(tid >> 6), lane = tid & 63;
  const bf16_t* U = p.u16 + (size_t)l * 16384 * 1024;
  const bf16_t* V = p.v16 + (size_t)l * 16384 * 1024;
  int vz = 0;
  asm volatile("" : "+v"(vz));
  int pe[8][2]; float pg[8][2];
  float acc[8][16];
#pragma unroll
  for (int tk = 0; tk < 8; ++tk) {
    const size_t base = (size_t)(t0 + wave * 8 + tk) * 128 + lane + vz;
    pe[tk][0] = p.pidx[base]; pe[tk][1] = p.pidx[base + 64];
    pg[tk][0] = p.pgate[base]; pg[tk][1] = p.pgate[base + 64];
#pragma unroll
    for (int i = 0; i < 16; ++i) acc[tk][i] = 0.f;
  }
  const int s0 = ((int)(__builtin_amdgcn_s_getreg((3 << 11) | 20) & 0xF) * 4) & 31;
#pragma unroll 1
  for (int si = 0; si < 32; ++si) {
    const int s = (s0 + si) & 31;
#pragma unroll
    for (int tk = 0; tk < 8; ++tk) {
      unsigned long long m0 = __ballot((pe[tk][0] >> 9) == s);
      unsigned long long m1 = __ballot((pe[tk][1] >> 9) == s);
      if ((m0 | m1) == 0ull) continue;
      unsigned hw[8];
      {
        const int tl = wave * 8 + tk;
        const uint4 h0 = *(const uint4*)(smem + tl * LDXB + lane * 16);
        const uint4 h1 = *(const uint4*)(smem + tl * LDXB + 1024 + lane * 16);
        hw[0] = h0.x; hw[1] = h0.y; hw[2] = h0.z; hw[3] = h0.w; hw[4] = h1.x; hw[5] = h1.y; hw[6] = h1.z; hw[7] = h1.w;
      }
#pragma unroll
      for (int hf = 0; hf < 2; ++hf) {
        unsigned long long m = hf ? m1 : m0;
        while (m) {
          PickPair pk;
          const int la = (int)__builtin_ctzll(m);
          m &= m - 1;
          pk.eA = __builtin_amdgcn_readlane(pe[tk][hf], la);
          pk.gA = __builtin_bit_cast(float, __builtin_amdgcn_readlane(__builtin_bit_cast(int, pg[tk][hf]), la));
          pk.eB = pk.eA; pk.gB = 0.f;
          if (m) {
            const int lb = (int)__builtin_ctzll(m);
            m &= m - 1;
            pk.eB = __builtin_amdgcn_readlane(pe[tk][hf], lb);
            pk.gB = __builtin_bit_cast(float, __builtin_amdgcn_readlane(__builtin_bit_cast(int, pg[tk][hf]), lb));
          }
          experts_process2(U, V, pk, hw, acc[tk], lane);
        }
      }
    }
  }
#pragma unroll
  for (int tk = 0; tk < 8; ++tk) {
    float* xr = p.xres + (size_t)(t0 + wave * 8 + tk) * 1024 + lane * 8;
#pragma unroll
    for (int i = 0; i < 2; ++i) {
      float4 a0 = *(float4*)(xr + i * 512), a1 = *(float4*)(xr + i * 512 + 4);
      a0.x += acc[tk][8 * i + 0]; a0.y += acc[tk][8 * i + 1]; a0.z += acc[tk][8 * i + 2]; a0.w += acc[tk][8 * i + 3];
      a1.x += acc[tk][8 * i + 4]; a1.y += acc[tk][8 * i + 5]; a1.z += acc[tk][8 * i + 6]; a1.w += acc[tk][8 * i + 7];
      *(float4*)(xr + i * 512) = a0;
      *(float4*)(xr + i * 512 + 4) = a1;
    }
  }
}


__global__ void __launch_bounds__(NTHREADS) fwd_megakernel(Params p) {
  cg::grid_group grid = cg::this_grid();
  extern __shared__ __attribute__((aligned(16))) float smem[];
  const int wv_ = __builtin_amdgcn_readfirstlane((int)(threadIdx.x >> 6));

  o_prep(wv_, p, smem);
  grid.sync();
#pragma unroll 1
  for (int l = 0; l < DEPTH; ++l) {
    const float* xcur = (l == 0) ? p.x_in : p.xres;
    o_p1(wv_, p, l, xcur, (char*)smem);
    grid.sync();
    {
      const int bidx_ = opaque_bid();
      for (int task = bidx_; task < 1792; task += gridDim.x) {
        const int l_ = opaque_s(l), td_ = opaque_tid(wv_), tk_ = opaque_s(task);
        if (tk_ < 1024) o_na_task(p, l_, tk_, (char*)smem, td_);
        else if (tk_ < 1536) o_ret_kv_task(p, l_, tk_ - 1024, (char*)smem, td_);
        else o_pool_task(p, l_, tk_ - 1536, (char*)smem, td_);
      }
    }
    grid.sync();
    o_ret_scan(wv_, p, l);
    grid.sync();
    {
      const int tidx_ = opaque_tid(wv_); const int bidx_ = opaque_bid();
      for (int task = bidx_; task < 512; task += gridDim.x) o_ret_out_task(p, l, task, (char*)smem, tidx_);
    }
    grid.sync();
    {
      const int tidx_ = opaque_tid(wv_); const int bidx_ = opaque_bid();
      for (int tile = bidx_; tile < NTOK / 64; tile += gridDim.x) {
        { const int t0_ = opaque_s(tile * 64), l_ = opaque_s(l), td_ = opaque_tid(wv_); o_p5a1_tile(p, l_, t0_, (char*)smem, td_); }
        { const int t0_ = opaque_s(tile * 64), l_ = opaque_s(l), td_ = opaque_tid(wv_); o_p5a2_tile(p, l_, xcur, t0_, (char*)smem, td_); }
        { const int t0_ = opaque_s(tile * 64), l_ = opaque_s(l), td_ = opaque_tid(wv_); o_p5a3_tile(p, l_, t0_, (char*)smem, td_); }
        { const int t0_ = opaque_s(tile * 64), l_ = opaque_s(l), td_ = opaque_tid(wv_); o_peer_select_tile(p, l_, t0_, (char*)smem, td_); }
        { const int t0_ = opaque_s(tile * 64), l_ = opaque_s(l), td_ = opaque_tid(wv_); o_peer_select2_tile(p, l_, t0_, td_); }
        asm volatile("s_waitcnt vmcnt(0)" ::: "memory");
        __syncthreads();
        { const int t0_ = opaque_s(tile * 64), l_ = opaque_s(l), td_ = opaque_tid(wv_); o_peer_experts2_tile(p, l_, t0_, (const char*)smem, td_); }
      }
    }
    grid.sync();
  }
  n_rmsnorm<true>(wv_, p.xres, p.norm_final, p.out, NTOK);
}

extern "C" void kernel_launch(void* const* d_in, const int* in_sizes, int n_in, void* d_out, int out_size,
                              void* d_ws, size_t ws_size, hipStream_t stream) {
  Params p{};
  p.x_in = (const float*)d_in[0]; p.norm_mix = (const float*)d_in[1]; p.w_in = (const float*)d_in[2];
  p.pool_w = (const float*)d_in[3]; p.pool_scale = (const float*)d_in[4]; p.ret_decay = (const float*)d_in[5];
  p.na_rpb = (const float*)d_in[6]; p.w_br_pool = (const float*)d_in[7]; p.w_br_ret = (const float*)d_in[8];
  p.w_br_na = (const float*)d_in[9]; p.w_out = (const float*)d_in[10]; p.norm_ffn = (const float*)d_in[11];
  p.w_query = (const float*)d_in[12]; p.sub_keys = (const float*)d_in[13]; p.peer_u = (const float*)d_in[14];
  p.peer_v = (const float*)d_in[15]; p.norm_final = (const float*)d_in[16];
  p.out = (float*)d_out;
  char* ws = (char*)d_ws;
  size_t off = 0;
  auto alloc = [&](size_t bytes) { char* q = ws + off; off += (bytes + 255) & ~(size_t)255; return q; };
  p.xres = (float*)alloc((size_t)NTOK * D_MODEL * 4);
  p.proj = (bf16_t*)alloc((size_t)NTOK * IN_WIDTH * 2);
  p.ycat = (bf16_t*)alloc((size_t)NTOK * 1024 * 2);
  p.mrg = (bf16_t*)alloc((size_t)NTOK * 1024 * 2);
  p.pidx = (int*)alloc((size_t)NTOK * 128 * 4);
  p.pgate = (float*)alloc((size_t)NTOK * 128 * 4);
  p.wf_in = (bf16_t*)alloc((size_t)DEPTH * D_MODEL * IN_WIDTH * 2);
  p.wf_br = (bf16_t*)alloc((size_t)DEPTH * 1024 * 1024 * 2);
  p.wf_out = (bf16_t*)alloc((size_t)DEPTH * 1024 * 1024 * 2);
  p.wf_q = (bf16_t*)alloc((size_t)DEPTH * 1024 * 2048 * 2);
  p.kf = (bf16_t*)alloc((size_t)DEPTH * 2 * 128 * 128 * 2);
  p.u16 = (bf16_t*)alloc((size_t)DEPTH * 16384 * 1024 * 2);
  p.v16 = (bf16_t*)alloc((size_t)DEPTH * 16384 * 1024 * 2);
  p.rope = (float2*)alloc((size_t)SEQ * 32 * 8);
  p.tklist = (unsigned*)alloc((size_t)NTOK * 8 * 2 * 16 * 4);
  p.kvst = (float*)p.mrg;
  p.rstate = (bf16_t*)p.tklist;
  p.xn = nullptr; p.merged = nullptr; p.pq = nullptr; p.psc = nullptr;
  if (off > ws_size) fprintf(stderr, "WORKSPACE OVERFLOW: need %zu have %zu\n", off, ws_size);

  const size_t kDynLds = 160 * 1024;
  static int grid_blocks = 0;
  if (!grid_blocks) {
    int dev = 0, cus = 0, per_cu = 0;
    (void)hipGetDevice(&dev);
    (void)hipDeviceGetAttribute(&cus, hipDeviceAttributeMultiprocessorCount, dev);
    (void)hipFuncSetAttribute((const void*)fwd_megakernel, hipFuncAttributeMaxDynamicSharedMemorySize, (int)kDynLds);
    (void)hipOccupancyMaxActiveBlocksPerMultiprocessor(&per_cu, fwd_megakernel, NTHREADS, kDynLds);
    if (per_cu < 1) per_cu = 1;
    grid_blocks = cus * per_cu;
  }
  void* args[] = {&p};
  hipError_t e = hipLaunchCooperativeKernel((void*)fwd_megakernel, dim3(grid_blocks), dim3(NTHREADS), args, kDynLds, stream);
  if (e != hipSuccess) fprintf(stderr, "cooperative launch failed: %s (grid %d)\n", hipGetErrorString(e), grid_blocks);
}
```

```cpp
#include <hip/hip_runtime.h>
#include <hip/hip_cooperative_groups.h>
#include <stdint.h>
#include <cstdio>
namespace cg = cooperative_groups;

#define D_MODEL 1024
#define SEQ 4096
#define BATCH 4
#define NTOK (BATCH * SEQ)
#define DEPTH 2
#define IN_WIDTH 5632
#define C_POOL 0
#define C_RQ 256
#define C_RK 512
#define C_RV 768
#define C_RG 1280
#define C_NQ 1792
#define C_NK 2048
#define C_NV 2304
#define C_GATE 2560
#define EPS 1e-6f
#define NTHREADS 512
#define PROBE_DUP 0

typedef unsigned short bf16_t;

struct Params {
  const float* x_in; const float* norm_mix; const float* w_in; const float* pool_w; const float* pool_scale;
  const float* ret_decay; const float* na_rpb; const float* w_br_pool; const float* w_br_ret; const float* w_br_na;
  const float* w_out; const float* norm_ffn; const float* w_query; const float* sub_keys; const float* peer_u;
  const float* peer_v; const float* norm_final;
  float* out;
  float* xres;
  bf16_t* xn;
  bf16_t* proj;
  bf16_t* ycat;
  float* merged;
  float* pq;
  float* psc;
  int* pidx;
  float* pgate;
  bf16_t* wf_in;
  bf16_t* wf_br;
  bf16_t* wf_out;
  bf16_t* wf_q;
  bf16_t* kf;
  bf16_t* u16;
  bf16_t* v16;
  float2* rope;
  bf16_t* mrg;
  unsigned* tklist;
  float* kvst;
  bf16_t* rstate;
  unsigned* bar;
};

__device__ __forceinline__ bf16_t f2bf(float f) {
  unsigned u = __float_as_uint(f);
  u += 0x7fffu + ((u >> 16) & 1u);
  return (bf16_t)(u >> 16);
}
__device__ __forceinline__ float bf2f(bf16_t h) { return __uint_as_float(((unsigned)h) << 16); }

__device__ __forceinline__ float wave_sum(float v) {
#pragma unroll
  for (int o = 32; o > 0; o >>= 1) v += __shfl_xor(v, o, 64);
  return v;
}
__device__ __forceinline__ float wave_max(float v) {
#pragma unroll
  for (int o = 32; o > 0; o >>= 1) v = fmaxf(v, __shfl_xor(v, o, 64));
  return v;
}
__device__ __forceinline__ float sigmoidf_(float x) { return 1.0f / (1.0f + expf(-x)); }

__device__ __forceinline__ int opaque_tid(int wv) {
  int w = wv;
  asm volatile("" : "+s"(w));
  int lane = __builtin_amdgcn_mbcnt_hi(~0u, __builtin_amdgcn_mbcnt_lo(~0u, 0u));
  asm volatile("" : "+v"(lane));
  return w * 64 + lane;
}
__device__ __forceinline__ int opaque_s(int x) { asm volatile("" : "+s"(x)); return x; }
__device__ __forceinline__ int opaque_bid() { int b = blockIdx.x; asm volatile("" : "+s"(b)); return b; }

template <bool OUT_F32>
__device__ __forceinline__ void n_rmsnorm(const int wv_, const float* __restrict__ x, const float* __restrict__ g, void* outp, int rows) {
  const int tidx_ = opaque_tid(wv_); const int bidx_ = opaque_bid();
  const int lane = tidx_ & 63;
  const int nw = gridDim.x * (NTHREADS / 64);
  for (int row = bidx_ * (NTHREADS / 64) + (tidx_ >> 6); row < rows; row += nw) {
    const float* xr = x + (size_t)row * D_MODEL;
    float4 v[4];
    float ss = 0.f;
#pragma unroll
    for (int i = 0; i < 4; ++i) {
      v[i] = *(const float4*)(xr + i * 256 + lane * 4);
      ss += v[i].x * v[i].x + v[i].y * v[i].y + v[i].z * v[i].z + v[i].w * v[i].w;
    }
    ss = wave_sum(ss);
    float r = rsqrtf(ss * (1.0f / D_MODEL) + EPS);
#pragma unroll
    for (int i = 0; i < 4; ++i) {
      float4 gg = *(const float4*)(g + i * 256 + lane * 4);
      float o0 = v[i].x * r * gg.x, o1 = v[i].y * r * gg.y, o2 = v[i].z * r * gg.z, o3 = v[i].w * r * gg.w;
      if (OUT_F32) {
        *(float4*)((float*)outp + (size_t)row * D_MODEL + i * 256 + lane * 4) = make_float4(o0, o1, o2, o3);
      } else {
        ushort4 o; o.x = f2bf(o0); o.y = f2bf(o1); o.z = f2bf(o2); o.w = f2bf(o3);
        *(ushort4*)((bf16_t*)outp + (size_t)row * D_MODEL + i * 256 + lane * 4) = o;
      }
    }
  }
}

template <bool A_BF16, typename Epi>
__device__ __forceinline__ void n_gemm(const int wv_, const void* Av, int lda, long sA, const float* __restrict__ B, int ldb, long sB,
                                       int transB, int M, int N, int K, int Z, float* smem, Epi epi) {
  const int tidx_ = opaque_tid(wv_); const int bidx_ = opaque_bid();
  const int grp = tidx_ >> 8, tid = tidx_ & 255;
  float(*As)[68] = (float(*)[68])(smem + grp * 2 * 16 * 68);
  float(*Bs)[68] = (float(*)[68])(smem + grp * 2 * 16 * 68 + 16 * 68);
  const int tx = tid & 15, ty = tid >> 4;
  const int tn = N / 64, tm = M / 64;
  const int nwork = tn * tm * Z;
  for (int wb = bidx_ * 2; wb < nwork; wb += gridDim.x * 2) {
    const int w = wb + grp;
    const int z = w / (tn * tm);
    const int rem = w - z * (tn * tm);
    const int bm = (rem / tn) * 64, bn = (rem % tn) * 64;
    const float* Af = (const float*)Av + (size_t)z * sA;
    const bf16_t* Ab = (const bf16_t*)Av + (size_t)z * sA;
    const float* Bz = B + (size_t)z * sB;
    float acc[4][4];
#pragma unroll
    for (int i = 0; i < 4; ++i)
#pragma unroll
      for (int j = 0; j < 4; ++j) acc[i][j] = 0.f;
    for (int k0 = 0; k0 < K; k0 += 16) {
#pragma unroll
      for (int i = 0; i < 4; ++i) {
        int idx = tid + i * 256;
        int m = idx >> 4, k = idx & 15;
        size_t ao = (size_t)(bm + m) * lda + k0 + k;
        As[k][m] = A_BF16 ? bf2f(Ab[ao]) : Af[ao];
        if (transB) {
          int n = idx >> 4, kk = idx & 15;
          Bs[kk][n] = Bz[(size_t)(bn + n) * ldb + k0 + kk];
        } else {
          int kk = idx >> 6, n = idx & 63;
          Bs[kk][n] = Bz[(size_t)(k0 + kk) * ldb + bn + n];
        }
      }
      __syncthreads();
#pragma unroll
      for (int k = 0; k < 16; ++k) {
        float a[4], b[4];
#pragma unroll
        for (int i = 0; i < 4; ++i) a[i] = As[k][ty * 4 + i];
#pragma unroll
        for (int j = 0; j < 4; ++j) b[j] = Bs[k][tx * 4 + j];
#pragma unroll
        for (int i = 0; i < 4; ++i)
#pragma unroll
          for (int j = 0; j < 4; ++j) acc[i][j] = fmaf(a[i], b[j], acc[i][j]);
      }
      __syncthreads();
    }
#pragma unroll
    for (int i = 0; i < 4; ++i)
#pragma unroll
      for (int j = 0; j < 4; ++j) epi(z, bm + ty * 4 + i, bn + tx * 4 + j, acc[i][j]);
  }
}

__device__ __forceinline__ void n_rope(const int wv_, bf16_t* __restrict__ proj) {
  const int tidx_ = opaque_tid(wv_); const int bidx_ = opaque_bid();
  const int total = NTOK * 256;
  for (int gid = bidx_ * NTHREADS + tidx_; gid < total; gid += gridDim.x * NTHREADS) {
    int i = gid & 31, h = (gid >> 5) & 3, qk = (gid >> 7) & 1, t = gid >> 8;
    int pos = t & (SEQ - 1);
    float inv = 1.0f / powf(10000.0f, (float)i / 31.0f);
    float ang = (float)pos * inv;
    double rev = (double)ang * 0.15915494309189535;
    rev -= floor(rev);
    float rf = (float)rev;
    float cs = __builtin_amdgcn_cosf(rf), sn = __builtin_amdgcn_sinf(rf);
    bf16_t* p = proj + (size_t)t * IN_WIDTH + (qk ? C_RK : C_RQ) + h * 64 + i;
    float x1 = bf2f(p[0]), x2 = bf2f(p[32]);
    p[0] = f2bf(x1 * cs - x2 * sn);
    p[32] = f2bf(x1 * sn + x2 * cs);
  }
}

__device__ __forceinline__ void n_pool(const int wv_, const bf16_t* __restrict__ proj, const float* __restrict__ pw,
                                       const float* __restrict__ pscale, bf16_t* __restrict__ ycat, float* smem) {
  const int tidx_ = opaque_tid(wv_); const int bidx_ = opaque_bid();
  const int grp = tidx_ >> 8, c = tidx_ & 255;
  float* diff = smem + grp * 256;
  const int gi = c >> 6;
  const int w = 2 << gi;
  const int lo = w / 2, hi = w - w / 2;
  for (int wb = bidx_ * 2; wb < NTOK; wb += gridDim.x * 2) {
    const int t = wb + grp;
    const int b0 = t & ~(SEQ - 1), pos = t & (SEQ - 1);
    int a = pos - lo; if (a < 0) a = 0;
    int b = pos + hi; if (b > SEQ) b = SEQ;
    float s = 0.f;
    for (int tt = a; tt < b; ++tt) s += bf2f(proj[(size_t)(b0 + tt) * IN_WIDTH + C_POOL + c]);
    float mean = s / (float)(b - a);
    __syncthreads();
    diff[c] = mean - bf2f(proj[(size_t)t * IN_WIDTH + C_POOL + c]);
    __syncthreads();
    const int e = c & 63;
    const float* wg = pw + gi * 64 * 64;
    float acc = 0.f;
    for (int cc = 0; cc < 64; ++cc) acc = fmaf(diff[gi * 64 + cc], wg[cc * 64 + e], acc);
    ycat[(size_t)t * 1024 + c] = f2bf(acc * pscale[c]);
  }
}

__device__ __forceinline__ void n_retention(const int wv_, const bf16_t* __restrict__ proj, const float* __restrict__ decay,
                                            bf16_t* __restrict__ ycat, float* smem) {
  const int tidx_ = opaque_tid(wv_); const int bidx_ = opaque_bid();
  const int grp = tidx_ >> 8, tid = tidx_ & 255;
  float* base = smem + grp * 12544;
  float(*Qs)[65] = (float(*)[65])base;
  float(*Ks)[65] = (float(*)[65])(base + 64 * 65);
  float(*Vs)[128] = (float(*)[128])(base + 64 * 65 + 32 * 65);
  float(*Ps)[33] = (float(*)[33])(base + 64 * 65 + 32 * 65 + 32 * 128);
  const int rg = tid >> 5, cl = tid & 31;
  const int nwork = (NTOK / 64) * 4;
  for (int wb = bidx_ * 2; wb < nwork; wb += gridDim.x * 2) {
    const int w = wb + grp;
    const int h = w & 3, qt = w >> 2;
    const int t0 = qt * 64;
    const int b0 = t0 & ~(SEQ - 1);
    const int q0 = t0 & (SEQ - 1);
    float dlf = decay[h], dlb = decay[4 + h];
    float lgf = fminf(dlf, 0.f) - log1pf(expf(-fabsf(dlf)));
    float lgb = fminf(dlb, 0.f) - log1pf(expf(-fabsf(dlb)));
    __syncthreads();
    for (int idx = tid; idx < 64 * 64; idx += 256) {
      int r = idx >> 6, d = idx & 63;
      Qs[r][d] = bf2f(proj[(size_t)(t0 + r) * IN_WIDTH + C_RQ + h * 64 + d]);
    }
    float acc[8][4];
#pragma unroll
    for (int i = 0; i < 8; ++i)
#pragma unroll
      for (int j = 0; j < 4; ++j) acc[i][j] = 0.f;
    for (int k0 = 0; k0 < SEQ; k0 += 32) {
      __syncthreads();
      for (int idx = tid; idx < 32 * 64; idx += 256) {
        int r = idx >> 6, d = idx & 63;
        Ks[r][d] = bf2f(proj[(size_t)(b0 + k0 + r) * IN_WIDTH + C_RK + h * 64 + d]);
      }
      for (int idx = tid; idx < 32 * 128; idx += 256) {
        int r = idx >> 7, d = idx & 127;
        Vs[r][d] = bf2f(proj[(size_t)(b0 + k0 + r) * IN_WIDTH + C_RV + h * 128 + d]);
      }
      __syncthreads();
      float sc[8];
#pragma unroll
      for (int i = 0; i < 8; ++i) sc[i] = 0.f;
      for (int d = 0; d < 64; ++d) {
        float kv = Ks[cl][d];
#pragma unroll
        for (int i = 0; i < 8; ++i) sc[i] = fmaf(Qs[rg * 8 + i][d], kv, sc[i]);
      }
      const int j = k0 + cl;
#pragma unroll
      for (int i = 0; i < 8; ++i) {
        int qi = q0 + rg * 8 + i;
        float dd = (j <= qi) ? expf(lgf * (float)(qi - j)) : expf(lgb * (float)(j - qi));
        Ps[rg * 8 + i][cl] = sc[i] * dd;
      }
      __syncthreads();
      for (int jj = 0; jj < 32; ++jj) {
        float v[4];
#pragma unroll
        for (int c = 0; c < 4; ++c) v[c] = Vs[jj][cl + 32 * c];
#pragma unroll
        for (int i = 0; i < 8; ++i) {
          float p = Ps[rg * 8 + i][jj];
#pragma unroll
          for (int c = 0; c < 4; ++c) acc[i][c] = fmaf(p, v[c], acc[i][c]);
        }
      }
    }
#pragma unroll
    for (int i = 0; i < 8; ++i) {
      float ss = acc[i][0] * acc[i][0] + acc[i][1] * acc[i][1] + acc[i][2] * acc[i][2] + acc[i][3] * acc[i][3];
#pragma unroll
      for (int o = 16; o > 0; o >>= 1) ss += __shfl_xor(ss, o, 64);
      float r = rsqrtf(ss * (1.0f / 128.0f) + EPS);
      int t = t0 + rg * 8 + i;
#pragma unroll
      for (int c = 0; c < 4; ++c) {
        int col = h * 128 + cl + 32 * c;
        float g = bf2f(proj[(size_t)t * IN_WIDTH + C_RG + col]);
        float sg = g / (1.0f + expf(-g));
        ycat[(size_t)t * 1024 + 256 + col] = f2bf(sg * acc[i][c] * r);
      }
    }
  }
}

__device__ __forceinline__ void n_na(const int wv_, const bf16_t* __restrict__ proj, const float* __restrict__ rpb,
                                     bf16_t* __restrict__ ycat) {
  const int tidx_ = opaque_tid(wv_); const int bidx_ = opaque_bid();
  const int lane = tidx_ & 63;
  const int nw = gridDim.x * (NTHREADS / 64);
  for (int wv = bidx_ * (NTHREADS / 64) + (tidx_ >> 6); wv < NTOK * 4; wv += nw) {
    int h = wv & 3, t = wv >> 2;
    int b0 = t & ~(SEQ - 1), pos = t & (SEQ - 1);
    int r = pos >> 6, c = pos & 63;
    int rs = r - 4; rs = rs < 0 ? 0 : (rs > 56 ? 56 : rs);
    int cs = c - 8; cs = cs < 0 ? 0 : (cs > 48 ? 48 : cs);
    float qv = bf2f(proj[(size_t)t * IN_WIDTH + C_NQ + h * 64 + lane]);
    float s[2];
#pragma unroll
    for (int u = 0; u < 2; ++u) {
      int kk = lane + 64 * u;
      int ri = kk >> 4, cj = kk & 15;
      int kt = b0 + (rs + ri) * 64 + cs + cj;
      const bf16_t* kp = proj + (size_t)kt * IN_WIDTH + C_NK + h * 64;
      float a = 0.f;
      for (int d = 0; d < 64; ++d) a = fmaf(__shfl(qv, d, 64), bf2f(kp[d]), a);
      int di = rs + ri - r + 7;
      int dj = cs + cj - c + 15;
      s[u] = a + rpb[(h * 15 + di) * 31 + dj];
    }
    float m = wave_max(fmaxf(s[0], s[1]));
    float e0 = expf(s[0] - m), e1 = expf(s[1] - m);
    float den = wave_sum(e0 + e1);
    float p0 = e0 / den, p1 = e1 / den;
    float o = 0.f;
    for (int kk = 0; kk < 128; ++kk) {
      float p = __shfl((kk < 64) ? p0 : p1, kk & 63, 64);
      int ri = kk >> 4, cj = kk & 15;
      int kt = b0 + (rs + ri) * 64 + cs + cj;
      o = fmaf(p, bf2f(proj[(size_t)kt * IN_WIDTH + C_NV + h * 64 + lane]), o);
    }
    ycat[(size_t)t * 1024 + 768 + h * 64 + lane] = f2bf(o);
  }
}

#define TKS 256
__device__ __forceinline__ void lds_insert(float* v, int* id, float x, int xi) {
  if (x > v[15 * TKS]) {
    int j = 15;
    while (j > 0 && v[(j - 1) * TKS] < x) {
      v[j * TKS] = v[(j - 1) * TKS];
      id[j * TKS] = id[(j - 1) * TKS];
      --j;
    }
    v[j * TKS] = x;
    id[j * TKS] = xi;
  }
}
__device__ __forceinline__ void n_topk(const int wv_, const float* __restrict__ scores, int* __restrict__ idx,
                                       float* __restrict__ gate, float* smem) {
  const int tidx_ = opaque_tid(wv_); const int bidx_ = opaque_bid();
  const int tid = tidx_;
  if (tid >= TKS) return;
  float* v1 = smem + tid;
  float* v2 = smem + 16 * TKS + tid;
  float* v3 = smem + 32 * TKS + tid;
  int* i1 = (int*)(smem + 48 * TKS) + tid;
  int* i2 = (int*)(smem + 64 * TKS) + tid;
  int* i3 = (int*)(smem + 80 * TKS) + tid;
  for (int gid = bidx_ * TKS + tid; gid < SEQ * 8; gid += gridDim.x * TKS) {
    const float* s = scores + (size_t)gid * 256;
    for (int j = 0; j < 16; ++j) {
      v1[j * TKS] = -3.0e38f; v2[j * TKS] = -3.0e38f; v3[j * TKS] = -3.0e38f;
      i1[j * TKS] = 0; i2[j * TKS] = 0; i3[j * TKS] = 0;
    }
    for (int n = 0; n < 128; ++n) lds_insert(v1, i1, s[n], n);
    for (int n = 0; n < 128; ++n) lds_insert(v2, i2, s[128 + n], n);
    for (int a = 0; a < 16; ++a) {
      float va = v1[a * TKS];
      int ia = i1[a * TKS];
      for (int b = 0; b < 16; ++b) lds_insert(v3, i3, va + v2[b * TKS], ia * 128 + i2[b * TKS]);
    }
    float m = v3[0];
    float den = 0.f;
    for (int j = 0; j < 16; ++j) den += expf(v3[j * TKS] - m);
    for (int j = 0; j < 16; ++j) {
      idx[(size_t)gid * 16 + j] = i3[j * TKS];
      gate[(size_t)gid * 16 + j] = expf(v3[j * TKS] - m) / den;
    }
  }
}

__device__ __forceinline__ void n_experts(const int wv_, const bf16_t* __restrict__ hn, const int* __restrict__ idx,
                                          const float* __restrict__ gate, const float* __restrict__ wu,
                                          const float* __restrict__ wv, float* __restrict__ x, int ntok) {
  const int tidx_ = opaque_tid(wv_); const int bidx_ = opaque_bid();
  const int lane = tidx_ & 63;
  const int nw = gridDim.x * (NTHREADS / 64);
  for (int t = bidx_ * (NTHREADS / 64) + (tidx_ >> 6); t < ntok; t += nw) {
    const bf16_t* hr = hn + (size_t)t * D_MODEL;
    float4 hv[4], acc[4];
#pragma unroll
    for (int i = 0; i < 4; ++i) {
      ushort4 hb = *(const ushort4*)(hr + i * 256 + lane * 4);
      hv[i] = make_float4(bf2f(hb.x), bf2f(hb.y), bf2f(hb.z), bf2f(hb.w));
      acc[i] = make_float4(0.f, 0.f, 0.f, 0.f);
    }
    for (int k = 0; k < 128; ++k) {
      int e = idx[(size_t)t * 128 + k];
      float g = gate[(size_t)t * 128 + k];
      const float* ur = wu + (size_t)e * D_MODEL;
      float a = 0.f;
#pragma unroll
      for (int i = 0; i < 4; ++i) {
        float4 u = *(const float4*)(ur + i * 256 + lane * 4);
        a += hv[i].x * u.x + hv[i].y * u.y + hv[i].z * u.z + hv[i].w * u.w;
      }
      a = wave_sum(a);
      float hh = 0.5f * a * (1.0f + erff(a * 0.70710678118654752f)) * g;
      const float* vr = wv + (size_t)e * D_MODEL;
#pragma unroll
      for (int i = 0; i < 4; ++i) {
        float4 v = *(const float4*)(vr + i * 256 + lane * 4);
        acc[i].x = fmaf(hh, v.x, acc[i].x); acc[i].y = fmaf(hh, v.y, acc[i].y);
        acc[i].z = fmaf(hh, v.z, acc[i].z); acc[i].w = fmaf(hh, v.w, acc[i].w);
      }
    }
    float* xr = x + (size_t)t * D_MODEL;
#pragma unroll
    for (int i = 0; i < 4; ++i) {
      float4 o = *(float4*)(xr + i * 256 + lane * 4);
      o.x += acc[i].x; o.y += acc[i].y; o.z += acc[i].z; o.w += acc[i].w;
      *(float4*)(xr + i * 256 + lane * 4) = o;
    }
  }
}


typedef __attribute__((ext_vector_type(8))) short bf16x8;
typedef __attribute__((ext_vector_type(4))) float f32x4;
#define LDX 1032
#define LDXB (LDX * 2)
#define XTILE_BYTES (64 * LDXB)

__device__ __forceinline__ unsigned pack2bf(float a, float b) { return (unsigned)f2bf(a) | ((unsigned)f2bf(b) << 16); }

__device__ __forceinline__ void prep_frag(const int wv_, const float* __restrict__ W, int K, int N, bf16_t* __restrict__ dst, float* smem) {
  const int tidx_ = opaque_tid(wv_); const int bidx_ = opaque_bid();
  const int grp = tidx_ >> 8, tid = tidx_ & 255;
  float(*T)[65] = (float(*)[65])(smem + grp * 32 * 65);
  const int KS = K / 32, NC = N / 64;
  const int ntiles = KS * NC;
  for (int wb = bidx_ * 2; wb < ntiles; wb += gridDim.x * 2) {
    const int w = wb + grp;
    const int c = w / KS, ks = w - c * KS;
    {
      const int row = tid >> 3, col = (tid & 7) * 8;
      const float* src = W + (size_t)(ks * 32 + row) * N + c * 64 + col;
      float4 a = *(const float4*)src, b = *(const float4*)(src + 4);
      __syncthreads();
      T[row][col + 0] = a.x; T[row][col + 1] = a.y; T[row][col + 2] = a.z; T[row][col + 3] = a.w;
      T[row][col + 4] = b.x; T[row][col + 5] = b.y; T[row][col + 6] = b.z; T[row][col + 7] = b.w;
    }
    __syncthreads();
    {
      const int nt = tid >> 6, lane = tid & 63;
      const int kr = 8 * (lane >> 4), nc = nt * 16 + (lane & 15);
      uint4 o;
      o.x = pack2bf(T[kr + 0][nc], T[kr + 1][nc]);
      o.y = pack2bf(T[kr + 2][nc], T[kr + 3][nc]);
      o.z = pack2bf(T[kr + 4][nc], T[kr + 5][nc]);
      o.w = pack2bf(T[kr + 6][nc], T[kr + 7][nc]);
      *(uint4*)(dst + ((size_t)((c * KS + ks) * 4 + nt) * 64 + lane) * 8) = o;
    }
  }
}

__device__ __forceinline__ void o_prep(const int wv_, const Params& p, float* smem) {
  for (int l = 0; l < DEPTH; ++l) {
    prep_frag(wv_, p.w_in + (size_t)l * D_MODEL * IN_WIDTH, D_MODEL, IN_WIDTH, p.wf_in + (size_t)l * D_MODEL * IN_WIDTH, smem);
    prep_frag(wv_, p.w_br_pool + (size_t)l * 256 * 1024, 256, 1024, p.wf_br + (size_t)l * 1024 * 1024, smem);
    prep_frag(wv_, p.w_br_ret + (size_t)l * 512 * 1024, 512, 1024, p.wf_br + (size_t)l * 1024 * 1024 + 256 * 1024, smem);
    prep_frag(wv_, p.w_br_na + (size_t)l * 256 * 1024, 256, 1024, p.wf_br + (size_t)l * 1024 * 1024 + 768 * 1024, smem);
    prep_frag(wv_, p.w_out + (size_t)l * 1024 * 1024, 1024, 1024, p.wf_out + (size_t)l * 1024 * 1024, smem);
    prep_frag(wv_, p.w_query + (size_t)l * 1024 * 2048, 1024, 2048, p.wf_q + (size_t)l * 1024 * 2048, smem);
  }
  const int tidx_ = opaque_tid(wv_); const int bidx_ = opaque_bid();
  const int gtid = bidx_ * NTHREADS + tidx_, gsz = gridDim.x * NTHREADS;
  for (int u = gtid; u < DEPTH * 2 * 8 * 4 * 64; u += gsz) {
    const int lane = u & 63, s2 = (u >> 6) & 3, kt = (u >> 8) & 7, lp = u >> 11;
    const float* kr = p.sub_keys + ((size_t)lp * 128 + kt * 16 + (lane & 15)) * 128;
    float v[8];
#pragma unroll
    for (int j = 0; j < 8; ++j) v[j] = kr[16 * (2 * s2 + (j >> 2)) + 4 * (lane >> 4) + (j & 3)];
    uint4 o;
    o.x = pack2bf(v[0], v[1]); o.y = pack2bf(v[2], v[3]); o.z = pack2bf(v[4], v[5]); o.w = pack2bf(v[6], v[7]);
    *(uint4*)(p.kf + (size_t)u * 8) = o;
  }
  if (p.u16) {
    const size_t nunits = (size_t)DEPTH * 16384 * 1024 / 8;
    for (size_t u = gtid; u < nunits; u += gsz) {
      float4 a = *(const float4*)(p.peer_u + u * 8), b = *(const float4*)(p.peer_u + u * 8 + 4);
      uint4 o;
      o.x = pack2bf(a.x, a.y); o.y = pack2bf(a.z, a.w); o.z = pack2bf(b.x, b.y); o.w = pack2bf(b.z, b.w);
      *(uint4*)(p.u16 + u * 8) = o;
      a = *(const float4*)(p.peer_v + u * 8); b = *(const float4*)(p.peer_v + u * 8 + 4);
      o.x = pack2bf(a.x, a.y); o.y = pack2bf(a.z, a.w); o.z = pack2bf(b.x, b.y); o.w = pack2bf(b.z, b.w);
      *(uint4*)(p.v16 + u * 8) = o;
    }
  }
  for (int u = gtid; u < SEQ * 32; u += gsz) {
    const int i = u & 31, pos = u >> 5;
    float inv = 1.0f / powf(10000.0f, (float)i / 31.0f);
    float ang = (float)pos * inv;
    double rev = (double)ang * 0.15915494309189535;
    rev -= floor(rev);
    float rf = (float)rev;
    p.rope[u] = make_float2(__builtin_amdgcn_cosf(rf), __builtin_amdgcn_sinf(rf));
  }
}

template <int NT, int PD = 3>
__device__ __forceinline__ void tl_gemm_chunk(const bf16_t* __restrict__ wf, const int KS, const char* xt, const int kbyte0,
                                              f32x4 (&acc)[NT][4], const int lane, const int nt0 = 0) {
  const bf16x8* wp = (const bf16x8*)wf + lane + nt0 * 64;
  const char* xp = xt + (lane & 15) * LDXB + kbyte0 + (lane >> 4) * 16;
  bf16x8 wb[4][NT];
#pragma unroll
  for (int s = 0; s < PD; ++s)
#pragma unroll
    for (int nt = 0; nt < NT; ++nt) wb[s][nt] = wp[(s * 4 + nt) * 64];
  for (int ks = 0; ks < KS; ks += 4) {
#pragma unroll
    for (int u = 0; u < 4; ++u) {
      int kpre = ks + u + PD;
      kpre = kpre < KS ? kpre : KS - 1;
#pragma unroll
      for (int nt = 0; nt < NT; ++nt) wb[(u + PD) & 3][nt] = wp[(kpre * 4 + nt) * 64];
      bf16x8 xf[4];
#pragma unroll
      for (int mt = 0; mt < 4; ++mt) xf[mt] = *(const bf16x8*)(xp + mt * 16 * LDXB + (ks + u) * 64);
#pragma unroll
      for (int nt = 0; nt < NT; ++nt)
#pragma unroll
        for (int mt = 0; mt < 4; ++mt)
          acc[nt][mt] = __builtin_amdgcn_mfma_f32_16x16x32_bf16(wb[u][nt], xf[mt], acc[nt][mt], 0, 0, 0);
    }
  }
}

__device__ __forceinline__ void tile_rmsnorm_to_lds(const float* __restrict__ xsrc, const float* __restrict__ g, int t0,
                                                    char* xt, int wave, int lane) {
#pragma unroll 2
  for (int i = 0; i < 8; ++i) {
    const int tok = wave * 8 + i;
    const float* xr = xsrc + (size_t)(t0 + tok) * D_MODEL;
    float4 v[4];
    float ss = 0.f;
#pragma unroll
    for (int q = 0; q < 4; ++q) {
      v[q] = *(const float4*)(xr + q * 256 + lane * 4);
      ss += v[q].x * v[q].x + v[q].y * v[q].y + v[q].z * v[q].z + v[q].w * v[q].w;
    }
    ss = wave_sum(ss);
    const float r = rsqrtf(ss * (1.0f / D_MODEL) + EPS);
#pragma unroll
    for (int q = 0; q < 4; ++q) {
      float4 gg = *(const float4*)(g + q * 256 + lane * 4);
      uint2 o;
      o.x = pack2bf(v[q].x * r * gg.x, v[q].y * r * gg.y);
      o.y = pack2bf(v[q].z * r * gg.z, v[q].w * r * gg.w);
      *(uint2*)(xt + tok * LDXB + (q * 256 + lane * 4) * 2) = o;
    }
  }
}

__device__ __forceinline__ void o_p1(const int wv_, const Params& p, int l, const float* __restrict__ xsrc, char* smem) {
  const int tidx_ = opaque_tid(wv_); const int bidx_ = opaque_bid();
  const int wave = tidx_ >> 6, lane = tidx_ & 63;
  const bf16_t* wf = p.wf_in + (size_t)l * D_MODEL * IN_WIDTH;
  const float* g = p.norm_mix + l * D_MODEL;
  for (int tile = bidx_; tile < NTOK / 64; tile += gridDim.x) {
    const int t0 = tile * 64;
    __syncthreads();
    tile_rmsnorm_to_lds(xsrc, g, t0, smem, wave, lane);
    __syncthreads();
#pragma unroll 1
    for (int c = wave; c < IN_WIDTH / 64; c += 8) {
      f32x4 acc[4][4];
#pragma unroll
      for (int a = 0; a < 4; ++a)
#pragma unroll
        for (int b = 0; b < 4; ++b) acc[a][b] = (f32x4){0.f, 0.f, 0.f, 0.f};
      tl_gemm_chunk<4>(wf + (size_t)c * 32 * 4 * 64 * 8, 32, smem, 0, acc, lane);
      asm volatile("" ::: "memory");
      if (c >= 4 && c < 12) {
        const float sc = (c >= 8) ? 0.125f : 1.0f;
#pragma unroll
        for (int mt = 0; mt < 4; ++mt) {
          const int tok = t0 + mt * 16 + (lane & 15);
          const int pos = tok & (SEQ - 1);
#pragma unroll
          for (int nt = 0; nt < 2; ++nt) {
            const int i0 = nt * 16 + 4 * (lane >> 4);
            const float4 cs01 = *(const float4*)(p.rope + pos * 32 + i0);
            const float4 cs23 = *(const float4*)(p.rope + pos * 32 + i0 + 2);
            const float cc[4] = {cs01.x, cs01.z, cs23.x, cs23.z};
            const float sn[4] = {cs01.y, cs01.w, cs23.y, cs23.w};
#pragma unroll
            for (int r = 0; r < 4; ++r) {
              const float x1 = acc[nt][mt][r], x2 = acc[nt + 2][mt][r];
              acc[nt][mt][r] = (x1 * cc[r] - x2 * sn[r]) * sc;
              acc[nt + 2][mt][r] = (x1 * sn[r] + x2 * cc[r]) * sc;
            }
          }
        }
      } else if (c >= 28 && c < 32) {
#pragma unroll
        for (int a = 0; a < 4; ++a)
#pragma unroll
          for (int b = 0; b < 4; ++b) acc[a][b] *= 0.125f;
      } else if (c >= 40) {
#pragma unroll
        for (int a = 0; a < 4; ++a)
#pragma unroll
          for (int b = 0; b < 4; ++b)
#pragma unroll
            for (int r = 0; r < 4; ++r) acc[a][b][r] = 1.0f / (1.0f + __expf(-acc[a][b][r]));
      }
#pragma unroll
      for (int mt = 0; mt < 4; ++mt) {
        const int tok = t0 + mt * 16 + (lane & 15);
        bf16_t* dst = p.proj + (size_t)tok * IN_WIDTH + c * 64 + 4 * (lane >> 4);
#pragma unroll
        for (int nt = 0; nt < 4; ++nt) {
          uint2 o;
          o.x = pack2bf(acc[nt][mt][0], acc[nt][mt][1]);
          o.y = pack2bf(acc[nt][mt][2], acc[nt][mt][3]);
          *(uint2*)(dst + nt * 16) = o;
        }
      }
    }
  }
}


__device__ __forceinline__ void tile_load_to_lds(const bf16_t* __restrict__ src, int ld, char* xt, int tid) {
#pragma unroll 4
  for (int it = 0; it < 16; ++it) {
    const int idx = it * NTHREADS + tid;
    const int row = idx >> 7, u = idx & 127;
    const uint4 v = *(const uint4*)(src + (size_t)row * ld + u * 8);
    *(uint4*)(xt + row * LDXB + u * 16) = v;
  }
}

__device__ __forceinline__ void o_p5a1_tile(const Params& p, int l, int t0, char* smem, int tid) {
  const int wave = tid >> 6, lane = tid & 63;
  __syncthreads();
  tile_load_to_lds(p.ycat + (size_t)t0 * 1024, 1024, smem, tid);
  __syncthreads();
  const bf16_t* wfb = p.wf_br + (size_t)l * 1024 * 1024;
#pragma unroll 1
  for (int hc = wave; hc < 32; hc += 8) {
    const int c = hc >> 1, nt0 = (hc & 1) * 2;
    f32x4 m[2][4];
#pragma unroll
    for (int a = 0; a < 2; ++a)
#pragma unroll
      for (int b = 0; b < 4; ++b) m[a][b] = (f32x4){0.f, 0.f, 0.f, 0.f};
#pragma unroll 1
    for (int br = 0; br < 3; ++br) {
      const int koff = (br == 0) ? 0 : (br == 1 ? 256 : 768);
      const int KS = (br == 1) ? 16 : 8;
      f32x4 acc[2][4];
#pragma unroll
      for (int a = 0; a < 2; ++a)
#pragma unroll
        for (int b = 0; b < 4; ++b) acc[a][b] = (f32x4){0.f, 0.f, 0.f, 0.f};
      tl_gemm_chunk<2>(wfb + (size_t)koff * 1024 + (size_t)c * KS * 4 * 64 * 8, KS, smem, koff * 2, acc, lane, nt0);
      asm volatile("" ::: "memory");
#pragma unroll
      for (int mt = 0; mt < 4; ++mt) {
        const int tok = t0 + mt * 16 + (lane & 15);
        const bf16_t* gp = p.proj + (size_t)tok * IN_WIDTH + C_GATE + br * 1024 + c * 64 + nt0 * 16 + 4 * (lane >> 4);
#pragma unroll
        for (int nt = 0; nt < 2; ++nt) {
          const uint2 gv = *(const uint2*)(gp + nt * 16);
          m[nt][mt][0] += __uint_as_float(gv.x << 16) * acc[nt][mt][0];
          m[nt][mt][1] += __uint_as_float(gv.x & 0xffff0000u) * acc[nt][mt][1];
          m[nt][mt][2] += __uint_as_float(gv.y << 16) * acc[nt][mt][2];
          m[nt][mt][3] += __uint_as_float(gv.y & 0xffff0000u) * acc[nt][mt][3];
        }
      }
    }
#pragma unroll
    for (int mt = 0; mt < 4; ++mt) {
      const int tok = t0 + mt * 16 + (lane & 15);
      bf16_t* dst = p.mrg + (size_t)tok * 1024 + c * 64 + nt0 * 16 + 4 * (lane >> 4);
#pragma unroll
      for (int nt = 0; nt < 2; ++nt) {
        uint2 o;
        o.x = pack2bf(m[nt][mt][0], m[nt][mt][1]);
        o.y = pack2bf(m[nt][mt][2], m[nt][mt][3]);
        *(uint2*)(dst + nt * 16) = o;
      }
    }
  }
}
__device__ __forceinline__ void o_p5a2_tile(const Params& p, int l, const float* __restrict__ xcur, int t0, char* smem, int tid) {
  const int wave = tid >> 6, lane = tid & 63;
  __syncthreads();
  tile_load_to_lds(p.mrg + (size_t)t0 * 1024, 1024, smem, tid);
  __syncthreads();
  const bf16_t* wfo = p.wf_out + (size_t)l * 1024 * 1024;
#pragma unroll 1
  for (int c = wave; c < 16; c += 8) {
    f32x4 acc[4][4];
#pragma unroll
    for (int a = 0; a < 4; ++a)
#pragma unroll
      for (int b = 0; b < 4; ++b) acc[a][b] = (f32x4){0.f, 0.f, 0.f, 0.f};
    tl_gemm_chunk<4, 2>(wfo + (size_t)c * 32 * 4 * 64 * 8, 32, smem, 0, acc, lane);
    asm volatile("" ::: "memory");
#pragma unroll
    for (int mt = 0; mt < 4; ++mt) {
      const int tok = t0 + mt * 16 + (lane & 15);
      const size_t o = (size_t)tok * 1024 + c * 64 + 4 * (lane >> 4);
#pragma unroll
      for (int nt = 0; nt < 4; ++nt) {
        float4 xv = *(const float4*)(xcur + o + nt * 16);
        xv.x += acc[nt][mt][0]; xv.y += acc[nt][mt][1]; xv.z += acc[nt][mt][2]; xv.w += acc[nt][mt][3];
        *(float4*)(p.xres + o + nt * 16) = xv;
      }
    }
  }
}
__device__ __forceinline__ void o_p5a3_tile(const Params& p, int l, int t0, char* smem, int tid) {
  const int wave = tid >> 6, lane = tid & 63;
  __syncthreads();
  tile_rmsnorm_to_lds(p.xres, p.norm_ffn + l * D_MODEL, t0, smem, wave, lane);
  __syncthreads();
}


__device__ __forceinline__ unsigned mono_f(float f) {
  unsigned u = __float_as_uint(f);
  return (u & 0x80000000u) ? ~u : (u | 0x80000000u);
}
__device__ __forceinline__ float unmono_f(unsigned m) {
  return __uint_as_float((m & 0x80000000u) ? (m & 0x7fffffffu) : ~m);
}
#define CE_DESC(x, y) { const unsigned hi_ = max(x, y); const unsigned lo_ = min(x, y); x = hi_; y = lo_; }
#define CE_ASC(x, y) { const unsigned hi_ = max(x, y); const unsigned lo_ = min(x, y); x = lo_; y = hi_; }
__device__ __forceinline__ void sort16_desc(unsigned (&a)[16]) {
#pragma unroll
  for (int k = 2; k <= 16; k <<= 1) {
#pragma unroll
    for (int j = k >> 1; j > 0; j >>= 1) {
#pragma unroll
      for (int i = 0; i < 16; ++i) {
        const int l = i ^ j;
        if (l > i) {
          if ((i & k) == 0) CE_DESC(a[i], a[l]) else CE_ASC(a[i], a[l])
        }
      }
    }
  }
}
__device__ __forceinline__ void bitonic_merge16_desc(unsigned (&a)[16]) {
#pragma unroll
  for (int j = 8; j > 0; j >>= 1) {
#pragma unroll
    for (int i = 0; i < 16; ++i) {
      const int l = i ^ j;
      if (l > i) CE_DESC(a[i], a[l])
    }
  }
}
__device__ __forceinline__ void xlane_merge16(unsigned (&a)[16], int mask) {
  unsigned b[16];
#pragma unroll
  for (int i = 0; i < 16; ++i) b[i] = (unsigned)__shfl_xor((int)a[i], mask, 64);
#pragma unroll
  for (int i = 0; i < 16; ++i) a[i] = max(a[i], b[15 - i]);
  bitonic_merge16_desc(a);
}

__device__ __forceinline__ void o_peer_select_tile(const Params& p, int l, int t0, char* smem, int tid) {
  const int h = __builtin_amdgcn_readfirstlane(tid >> 6), lane = tid & 63;
  const int g = lane >> 4, tl = lane & 15;
  const bf16_t* wfq = p.wf_q + (size_t)l * 1024 * 2048;
#pragma unroll 1
  for (int pp = 0; pp < 2; ++pp) {
    bf16x8 qf[4][4];
#pragma unroll 1
    for (int cc = 0; cc < 2; ++cc) {
      const int c = (h * 2 + pp) * 2 + cc;
      f32x4 acc[4][4];
#pragma unroll
      for (int a = 0; a < 4; ++a)
#pragma unroll
        for (int b = 0; b < 4; ++b) acc[a][b] = (f32x4){0.f, 0.f, 0.f, 0.f};
      tl_gemm_chunk<4, 2>(wfq + (size_t)c * 32 * 4 * 64 * 8, 32, smem, 0, acc, lane);
#pragma unroll
      for (int sl = 0; sl < 2; ++sl)
#pragma unroll
        for (int mt = 0; mt < 4; ++mt) {
          union { bf16x8 v; unsigned u[4]; } cv;
          cv.u[0] = pack2bf(acc[2 * sl][mt][0], acc[2 * sl][mt][1]);
          cv.u[1] = pack2bf(acc[2 * sl][mt][2], acc[2 * sl][mt][3]);
          cv.u[2] = pack2bf(acc[2 * sl + 1][mt][0], acc[2 * sl + 1][mt][1]);
          cv.u[3] = pack2bf(acc[2 * sl + 1][mt][2], acc[2 * sl + 1][mt][3]);
          if (cc == 0) qf[sl][mt] = cv.v; else qf[2 + sl][mt] = cv.v;
        }
    }
    const bf16x8* kfp = (const bf16x8*)p.kf + (size_t)((l * 2 + pp) * 8) * 4 * 64 + lane;
#pragma unroll
    for (int mt = 0; mt < 4; ++mt) {
      f32x4 sc[8];
#pragma unroll
      for (int kt = 0; kt < 8; ++kt) sc[kt] = (f32x4){0.f, 0.f, 0.f, 0.f};
#pragma unroll
      for (int s2 = 0; s2 < 4; ++s2) {
        bf16x8 qv;
        qv = qf[s2][mt];
#pragma unroll
        for (int kt = 0; kt < 8; ++kt)
          sc[kt] = __builtin_amdgcn_mfma_f32_16x16x32_bf16(kfp[(kt * 4 + s2) * 64], qv, sc[kt], 0, 0, 0);
        __builtin_amdgcn_sched_barrier(0);
      }
      unsigned A[16], B[16];
#pragma unroll
      for (int kt = 0; kt < 4; ++kt)
#pragma unroll
        for (int r = 0; r < 4; ++r) {
          A[kt * 4 + r] = (mono_f(sc[kt][r]) & ~127u) | (unsigned)(127 - (kt * 16 + r) - 4 * g);
          B[kt * 4 + r] = (mono_f(sc[kt + 4][r]) & ~127u) | (unsigned)(127 - ((kt + 4) * 16 + r) - 4 * g);
        }
      sort16_desc(A);
      sort16_desc(B);
#pragma unroll
      for (int i = 0; i < 16; ++i) A[i] = max(A[i], B[15 - i]);
      bitonic_merge16_desc(A);
      xlane_merge16(A, 16);
      xlane_merge16(A, 32);
      if (g == 0) {
        uint4* dst = (uint4*)(p.tklist + ((size_t)((t0 + mt * 16 + tl) * 8 + h) * 2 + pp) * 16);
        dst[0] = make_uint4(A[0], A[1], A[2], A[3]);
        dst[1] = make_uint4(A[4], A[5], A[6], A[7]);
        dst[2] = make_uint4(A[8], A[9], A[10], A[11]);
        dst[3] = make_uint4(A[12], A[13], A[14], A[15]);
      }
    }
  }
  asm volatile("s_waitcnt vmcnt(0)" ::: "memory");
}

__device__ __forceinline__ void o_peer_select2_tile(const Params& p, int l, int t0, int tid) {
  const int h = __builtin_amdgcn_readfirstlane(tid >> 6), lane = tid & 63;
  const int g = lane >> 4, tl = lane & 15;
#pragma unroll 1
  for (int mt = 0; mt < 4; ++mt) {
    const int tok = t0 + mt * 16 + tl;
    const unsigned* lp = p.tklist + ((size_t)(tok * 8 + h) * 2) * 16;
    float v1[16], v2[16];
    {
      const uint4* q4 = (const uint4*)lp;
#pragma unroll
      for (int i = 0; i < 4; ++i) {
        uint4 x = q4[i], y = q4[4 + i];
        v1[4 * i + 0] = unmono_f(x.x & ~127u); v1[4 * i + 1] = unmono_f(x.y & ~127u);
        v1[4 * i + 2] = unmono_f(x.z & ~127u); v1[4 * i + 3] = unmono_f(x.w & ~127u);
        v2[4 * i + 0] = unmono_f(y.x & ~127u); v2[4 * i + 1] = unmono_f(y.y & ~127u);
        v2[4 * i + 2] = unmono_f(y.z & ~127u); v2[4 * i + 3] = unmono_f(y.w & ~127u);
      }
    }
    unsigned C[16];
#pragma unroll
    for (int i = 0; i < 16; ++i) C[i] = 0u;
    {
      int idx = 0;
#pragma unroll
      for (int a = 0; a < 16; ++a) {
#pragma unroll
        for (int b = 0; b < 16; ++b) {
          if ((a + 1) * (b + 1) <= 16) {
            const unsigned key = (mono_f(v1[a] + v2[b]) & ~255u) | (unsigned)(255 - (a * 16 + b));
            const int slot = idx >> 2, who = idx & 3;
            C[slot] = (g == who) ? key : C[slot];
            ++idx;
          }
        }
      }
    }
    sort16_desc(C);
    xlane_merge16(C, 16);
    xlane_merge16(C, 32);
    const float f0 = unmono_f(C[0] & ~255u);
    float den = 0.f;
    float ev[16];
#pragma unroll
    for (int i = 0; i < 16; ++i) { ev[i] = __expf(unmono_f(C[i] & ~255u) - f0); den += ev[i]; }
    const float rden = 1.0f / den;
    int eidx[4]; float egate[4];
#pragma unroll
    for (int i = 0; i < 4; ++i) {
      const unsigned k = (g == 0) ? C[i] : (g == 1) ? C[4 + i] : (g == 2) ? C[8 + i] : C[12 + i];
      const float e = (g == 0) ? ev[i] : (g == 1) ? ev[4 + i] : (g == 2) ? ev[8 + i] : ev[12 + i];
      const int pos = 255 - (int)(k & 255u);
      const int a = pos >> 4, b = pos & 15;
      const int n1 = 127 - (int)(lp[a] & 127u);
      const int n2 = 127 - (int)(lp[16 + b] & 127u);
      eidx[i] = n1 * 128 + n2;
      egate[i] = e * rden;
    }
    *(int4*)(p.pidx + (size_t)tok * 128 + h * 16 + 4 * g) = make_int4(eidx[0], eidx[1], eidx[2], eidx[3]);
    *(float4*)(p.pgate + (size_t)tok * 128 + h * 16 + 4 * g) = make_float4(egate[0], egate[1], egate[2], egate[3]);
  }
}

__device__ __forceinline__ void o_peer_experts_tile(const Params& p, int l, int t0, const char* smem, int tid) {
  const int wave = tid >> 6, lane = tid & 63;
  const bf16_t* U = p.u16 + (size_t)l * 16384 * 1024;
  const bf16_t* V = p.v16 + (size_t)l * 16384 * 1024;
  int vz = 0;
  asm volatile("" : "+v"(vz));
#pragma unroll 1
  for (int i8 = 0; i8 < 8; ++i8) {
    const int tl = wave * 8 + i8;
    const int tok = t0 + tl;
    float hv[16], acc[16];
    {
      const uint4 h0 = *(const uint4*)(smem + tl * LDXB + lane * 16);
      const uint4 h1 = *(const uint4*)(smem + tl * LDXB + 1024 + lane * 16);
      const unsigned hw[8] = {h0.x, h0.y, h0.z, h0.w, h1.x, h1.y, h1.z, h1.w};
#pragma unroll
      for (int j = 0; j < 8; ++j) {
        hv[2 * j] = __uint_as_float(hw[j] << 16);
        hv[2 * j + 1] = __uint_as_float(hw[j] & 0xffff0000u);
        acc[2 * j] = 0.f; acc[2 * j + 1] = 0.f;
      }
    }
    const int* ip = p.pidx + (size_t)tok * 128 + vz;
    const float* gp = p.pgate + (size_t)tok * 128 + vz;
#pragma unroll 1
    for (int k = 0; k < 128; k += 4) {
      const int4 e4 = *(const int4*)(ip + k);
      const float4 g4 = *(const float4*)(gp + k);
      const int ee[4] = {e4.x, e4.y, e4.z, e4.w};
      const float gg[4] = {g4.x, g4.y, g4.z, g4.w};
      uint4 ur[4][2];
#pragma unroll
      for (int q = 0; q < 4; ++q) {
        const char* up = (const char*)(U + (size_t)ee[q] * 1024) + lane * 16;
        ur[q][0] = *(const uint4*)up;
        ur[q][1] = *(const uint4*)(up + 1024);
      }
      uint4 vr[4][2];
#pragma unroll
      for (int q = 0; q < 4; ++q) {
        const char* vp = (const char*)(V + (size_t)ee[q] * 1024) + lane * 16;
        vr[q][0] = *(const uint4*)vp;
        vr[q][1] = *(const uint4*)(vp + 1024);
      }
      float hh[4];
#pragma unroll
      for (int q = 0; q < 4; ++q) {
        const unsigned uw[8] = {ur[q][0].x, ur[q][0].y, ur[q][0].z, ur[q][0].w, ur[q][1].x, ur[q][1].y, ur[q][1].z, ur[q][1].w};
        float a = 0.f;
#pragma unroll
        for (int j = 0; j < 8; ++j) {
          a = fmaf(hv[2 * j], __uint_as_float(uw[j] << 16), a);
          a = fmaf(hv[2 * j + 1], __uint_as_float(uw[j] & 0xffff0000u), a);
        }
        a = wave_sum(a);
        hh[q] = 0.5f * a * (1.0f + erff(a * 0.70710678118654752f)) * gg[q];
      }
#pragma unroll
      for (int q = 0; q < 4; ++q) {
        const unsigned vw[8] = {vr[q][0].x, vr[q][0].y, vr[q][0].z, vr[q][0].w, vr[q][1].x, vr[q][1].y, vr[q][1].z, vr[q][1].w};
#pragma unroll
        for (int j = 0; j < 8; ++j) {
          acc[2 * j] = fmaf(hh[q], __uint_as_float(vw[j] << 16), acc[2 * j]);
          acc[2 * j + 1] = fmaf(hh[q], __uint_as_float(vw[j] & 0xffff0000u), acc[2 * j + 1]);
        }
      }
    }
    float* xr = p.xres + (size_t)tok * 1024 + lane * 8;
#pragma unroll
    for (int i = 0; i < 2; ++i) {
      float4 a0 = *(float4*)(xr + i * 512), a1 = *(float4*)(xr + i * 512 + 4);
      a0.x += acc[8 * i + 0]; a0.y += acc[8 * i + 1]; a0.z += acc[8 * i + 2]; a0.w += acc[8 * i + 3];
      a1.x += acc[8 * i + 4]; a1.y += acc[8 * i + 5]; a1.z += acc[8 * i + 6]; a1.w += acc[8 * i + 7];
      *(float4*)(xr + i * 512) = a0;
      *(float4*)(xr + i * 512 + 4) = a1;
    }
  }
}


__device__ __forceinline__ float logsigmoid_(float x) { return fminf(x, 0.f) - log1pf(expf(-fabsf(x))); }
__device__ __forceinline__ float bf_lo(unsigned w) { return __uint_as_float(w << 16); }
__device__ __forceinline__ float bf_hi(unsigned w) { return __uint_as_float(w & 0xffff0000u); }

#define RKV_LD 136
__device__ __forceinline__ void o_ret_kv_task(const Params& p, int l, int task, char* smem, int tid) {
  const int wave = tid >> 6, lane = tid & 63, g = lane >> 4, tl = lane & 15;
  const int bh = task >> 5, n = task & 31, b = bh >> 2, h = bh & 3;
  const int tok0 = b * SEQ + n * 128;
  const float lgf = logsigmoid_(p.ret_decay[l * 8 + h]), lgb = logsigmoid_(p.ret_decay[l * 8 + 4 + h]);
  bf16_t* KTf = (bf16_t*)smem;
  bf16_t* KTb = KTf + 64 * RKV_LD;
  bf16_t* VT = KTb + 64 * RKV_LD;
  __syncthreads();
#pragma unroll
  for (int it = 0; it < 2; ++it) {
    const int u = tid + it * NTHREADS;
    const int j = u >> 3, d0 = (u & 7) * 8;
    const uint4 kv = *(const uint4*)(p.proj + (size_t)(tok0 + j) * IN_WIDTH + C_RK + h * 64 + d0);
    const float wf = __expf(lgf * (float)(127 - j)), wb = __expf(lgb * (float)(j + 1));
    const unsigned kw[4] = {kv.x, kv.y, kv.z, kv.w};
#pragma unroll
    for (int e = 0; e < 4; ++e) {
      const float x0 = bf_lo(kw[e]), x1 = bf_hi(kw[e]);
      KTf[(d0 + 2 * e) * RKV_LD + j] = f2bf(x0 * wf);
      KTf[(d0 + 2 * e + 1) * RKV_LD + j] = f2bf(x1 * wf);
      KTb[(d0 + 2 * e) * RKV_LD + j] = f2bf(x0 * wb);
      KTb[(d0 + 2 * e + 1) * RKV_LD + j] = f2bf(x1 * wb);
    }
  }
#pragma unroll
  for (int it = 0; it < 4; ++it) {
    const int u = tid + it * NTHREADS;
    const int j = u >> 4, e0 = (u & 15) * 8;
    const uint4 vv = *(const uint4*)(p.proj + (size_t)(tok0 + j) * IN_WIDTH + C_RV + h * 128 + e0);
    const unsigned vw[4] = {vv.x, vv.y, vv.z, vv.w};
#pragma unroll
    for (int e = 0; e < 4; ++e) {
      VT[(e0 + 2 * e) * RKV_LD + j] = (bf16_t)(vw[e] & 0xffffu);
      VT[(e0 + 2 * e + 1) * RKV_LD + j] = (bf16_t)(vw[e] >> 16);
    }
  }
  __syncthreads();
  bf16x8 a[4];
#pragma unroll
  for (int ks = 0; ks < 4; ++ks) a[ks] = *(const bf16x8*)(VT + (wave * 16 + tl) * RKV_LD + ks * 32 + 8 * g);
#pragma unroll
  for (int dir = 0; dir < 2; ++dir) {
    const bf16_t* KT = dir ? KTb : KTf;
#pragma unroll
    for (int dt = 0; dt < 4; ++dt) {
      f32x4 acc = (f32x4){0.f, 0.f, 0.f, 0.f};
#pragma unroll
      for (int ks = 0; ks < 4; ++ks) {
        const bf16x8 bb = *(const bf16x8*)(KT + (dt * 16 + tl) * RKV_LD + ks * 32 + 8 * g);
        acc = __builtin_amdgcn_mfma_f32_16x16x32_bf16(a[ks], bb, acc, 0, 0, 0);
      }
      float* dst = p.kvst + ((size_t)(task * 2 + dir) * 128 + wave * 16 + 4 * g) * 64 + dt * 16 + tl;
#pragma unroll
      for (int r = 0; r < 4; ++r) dst[r * 64] = acc[r];
    }
  }
}

__device__ __forceinline__ void o_ret_scan(const int wv_, const Params& p, int l) {
  const int tidx_ = opaque_tid(wv_); const int bidx_ = opaque_bid();
  const int gsz = gridDim.x * NTHREADS;
  for (int u = bidx_ * NTHREADS + tidx_; u < 16 * 2 * 128 * 16; u += gsz) {
    const int dq = u & 15, e = (u >> 4) & 127, dir = (u >> 11) & 1, bh = u >> 12, h = bh & 3;
    const float lg = logsigmoid_(p.ret_decay[l * 8 + dir * 4 + h]);
    const float gC = __expf(lg * 128.0f);
    float4 st = make_float4(0.f, 0.f, 0.f, 0.f);
#pragma unroll 8
    for (int nn = 0; nn < 32; ++nn) {
      const int n = dir ? (31 - nn) : nn;
      const size_t idx = ((size_t)((bh * 32 + n) * 2 + dir) * 128 + e) * 64 + dq * 4;
      const float4 kv = *(const float4*)(p.kvst + idx);
      uint2 o;
      o.x = pack2bf(st.x, st.y); o.y = pack2bf(st.z, st.w);
      *(uint2*)(p.rstate + idx) = o;
      st.x = fmaf(st.x, gC, kv.x); st.y = fmaf(st.y, gC, kv.y); st.z = fmaf(st.z, gC, kv.z); st.w = fmaf(st.w, gC, kv.w);
    }
  }
}

#define RO_LD 264
#define RK_LD 72
__device__ __forceinline__ void o_ret_out_task(const Params& p, int l, int task, char* smem, int tid) {
  const int wave = tid >> 6, lane = tid & 63, g = lane >> 4, tl = lane & 15;
  const int bh = task >> 5, n = task & 31, b = bh >> 2, h = bh & 3;
  const int tok0 = b * SEQ + n * 128;
  const float lgf = logsigmoid_(p.ret_decay[l * 8 + h]), lgb = logsigmoid_(p.ret_decay[l * 8 + 4 + h]);
  bf16_t* Acat = (bf16_t*)smem;
  bf16_t* Bcat = Acat + 128 * RO_LD;
  bf16_t* Kl = Bcat + 128 * RO_LD;
  __syncthreads();
#pragma unroll
  for (int it = 0; it < 2; ++it) {
    const int u = tid + it * NTHREADS;
    const int i = u >> 3, d0 = (u & 7) * 8;
    const size_t row = (size_t)(tok0 + i) * IN_WIDTH;
    const uint4 qv = *(const uint4*)(p.proj + row + C_RQ + h * 64 + d0);
    const uint4 kv = *(const uint4*)(p.proj + row + C_RK + h * 64 + d0);
    *(uint4*)(Acat + i * RO_LD + d0) = qv;
    *(uint4*)(Kl + i * RK_LD + d0) = kv;
    const float wf = __expf(lgf * (float)(i + 1)), wb = __expf(lgb * (float)(127 - i));
    const unsigned qw[4] = {qv.x, qv.y, qv.z, qv.w};
    uint4 of, ob;
    of.x = pack2bf(bf_lo(qw[0]) * wf, bf_hi(qw[0]) * wf); ob.x = pack2bf(bf_lo(qw[0]) * wb, bf_hi(qw[0]) * wb);
    of.y = pack2bf(bf_lo(qw[1]) * wf, bf_hi(qw[1]) * wf); ob.y = pack2bf(bf_lo(qw[1]) * wb, bf_hi(qw[1]) * wb);
    of.z = pack2bf(bf_lo(qw[2]) * wf, bf_hi(qw[2]) * wf); ob.z = pack2bf(bf_lo(qw[2]) * wb, bf_hi(qw[2]) * wb);
    of.w = pack2bf(bf_lo(qw[3]) * wf, bf_hi(qw[3]) * wf); ob.w = pack2bf(bf_lo(qw[3]) * wb, bf_hi(qw[3]) * wb);
    *(uint4*)(Acat + i * RO_LD + 128 + d0) = of;
    *(uint4*)(Acat + i * RO_LD + 192 + d0) = ob;
  }
#pragma unroll
  for (int it = 0; it < 4; ++it) {
    const int u = tid + it * NTHREADS;
    const int j = u >> 4, e0 = (u & 15) * 8;
    const uint4 vv = *(const uint4*)(p.proj + (size_t)(tok0 + j) * IN_WIDTH + C_RV + h * 128 + e0);
    const unsigned vw[4] = {vv.x, vv.y, vv.z, vv.w};
#pragma unroll
    for (int e = 0; e < 4; ++e) {
      Bcat[(e0 + 2 * e) * RO_LD + j] = (bf16_t)(vw[e] & 0xffffu);
      Bcat[(e0 + 2 * e + 1) * RO_LD + j] = (bf16_t)(vw[e] >> 16);
    }
  }
#pragma unroll
  for (int it = 0; it < 4; ++it) {
    const int u = tid + it * NTHREADS;
    const int d0 = (u & 7) * 8, e = (u >> 3) & 127, dir = u >> 10;
    const uint4 sv = *(const uint4*)(p.rstate + ((size_t)(task * 2 + dir) * 128 + e) * 64 + d0);
    *(uint4*)(Bcat + e * RO_LD + 128 + dir * 64 + d0) = sv;
  }
  __syncthreads();
  f32x4 sc[8];
#pragma unroll
  for (int jt = 0; jt < 8; ++jt) sc[jt] = (f32x4){0.f, 0.f, 0.f, 0.f};
#pragma unroll
  for (int ks = 0; ks < 2; ++ks) {
    const bf16x8 qb = *(const bf16x8*)(Acat + (wave * 16 + tl) * RO_LD + ks * 32 + 8 * g);
#pragma unroll
    for (int jt = 0; jt < 8; ++jt) {
      const bf16x8 ka = *(const bf16x8*)(Kl + (jt * 16 + tl) * RK_LD + ks * 32 + 8 * g);
      sc[jt] = __builtin_amdgcn_mfma_f32_16x16x32_bf16(ka, qb, sc[jt], 0, 0, 0);
    }
  }
  {
    const int i = wave * 16 + tl;
#pragma unroll
    for (int jt = 0; jt < 8; ++jt) {
      float pv[4];
#pragma unroll
      for (int r = 0; r < 4; ++r) {
        const int j = jt * 16 + 4 * g + r;
        const float dd = (j <= i) ? __expf(lgf * (float)(i - j)) : __expf(lgb * (float)(j - i));
        pv[r] = sc[jt][r] * dd;
      }
      uint2 o;
      o.x = pack2bf(pv[0], pv[1]); o.y = pack2bf(pv[2], pv[3]);
      *(uint2*)(Acat + i * RO_LD + jt * 16 + 4 * g) = o;
    }
  }
  f32x4 y[8];
#pragma unroll
  for (int et = 0; et < 8; ++et) y[et] = (f32x4){0.f, 0.f, 0.f, 0.f};
#pragma unroll
  for (int ks = 0; ks < 8; ++ks) {
    const bf16x8 ab = *(const bf16x8*)(Acat + (wave * 16 + tl) * RO_LD + ks * 32 + 8 * g);
#pragma unroll
    for (int et = 0; et < 8; ++et) {
      const bf16x8 ba = *(const bf16x8*)(Bcat + (et * 16 + tl) * RO_LD + ks * 32 + 8 * g);
      y[et] = __builtin_amdgcn_mfma_f32_16x16x32_bf16(ba, ab, y[et], 0, 0, 0);
    }
  }
  float ss = 0.f;
#pragma unroll
  for (int et = 0; et < 8; ++et)
#pragma unroll
    for (int r = 0; r < 4; ++r) ss = fmaf(y[et][r], y[et][r], ss);
  ss += __shfl_xor(ss, 16, 64);
  ss += __shfl_xor(ss, 32, 64);
  const float rstd = rsqrtf(ss * (1.0f / 128.0f) + EPS);
  {
    const int tok = tok0 + wave * 16 + tl;
    const bf16_t* gp = p.proj + (size_t)tok * IN_WIDTH + C_RG + h * 128 + 4 * g;
    bf16_t* dst = p.ycat + (size_t)tok * 1024 + 256 + h * 128 + 4 * g;
#pragma unroll
    for (int et = 0; et < 8; ++et) {
      const uint2 gv = *(const uint2*)(gp + et * 16);
      const float g0 = bf_lo(gv.x), g1 = bf_hi(gv.x), g2 = bf_lo(gv.y), g3 = bf_hi(gv.y);
      uint2 o;
      o.x = pack2bf(g0 / (1.0f + __expf(-g0)) * y[et][0] * rstd, g1 / (1.0f + __expf(-g1)) * y[et][1] * rstd);
      o.y = pack2bf(g2 / (1.0f + __expf(-g2)) * y[et][2] * rstd, g3 / (1.0f + __expf(-g3)) * y[et][3] * rstd);
      *(uint2*)(dst + et * 16) = o;
    }
  }
}


#define NA_KLD 72
#define NA_VLD 520
__device__ __forceinline__ void o_na_task(const Params& p, int l, int task, char* smem, int tid) {
  const int wave = tid >> 6, lane = tid & 63, g = lane >> 4, tl = lane & 15;
  const int rr = task & 63, h = (task >> 6) & 3, b = task >> 8;
  int rs = rr - 4; rs = rs < 0 ? 0 : (rs > 56 ? 56 : rs);
  const int ktok0 = b * SEQ + rs * 64;
  const int qtok0 = b * SEQ + rr * 64;
  bf16_t* Kl = (bf16_t*)smem;
  bf16_t* VT = Kl + 512 * NA_KLD;
  bf16_t* Ql = VT + 64 * NA_VLD;
  float* rpbl = (float*)(Ql + 64 * NA_KLD);
  __syncthreads();
#pragma unroll
  for (int it = 0; it < 8; ++it) {
    const int u = tid + it * NTHREADS;
    const int key = u >> 3, d0 = (u & 7) * 8;
    const size_t row = (size_t)(ktok0 + key) * IN_WIDTH;
    const uint4 kv = *(const uint4*)(p.proj + row + C_NK + h * 64 + d0);
    const uint4 vv = *(const uint4*)(p.proj + row + C_NV + h * 64 + d0);
    *(uint4*)(Kl + key * NA_KLD + d0) = kv;
    const unsigned vw[4] = {vv.x, vv.y, vv.z, vv.w};
#pragma unroll
    for (int e = 0; e < 4; ++e) {
      VT[(d0 + 2 * e) * NA_VLD + key] = (bf16_t)(vw[e] & 0xffffu);
      VT[(d0 + 2 * e + 1) * NA_VLD + key] = (bf16_t)(vw[e] >> 16);
    }
  }
  {
    const int q = tid >> 3, d0 = (tid & 7) * 8;
    *(uint4*)(Ql + q * NA_KLD + d0) = *(const uint4*)(p.proj + (size_t)(qtok0 + q) * IN_WIDTH + C_NQ + h * 64 + d0);
    if (tid < 465) rpbl[tid] = p.na_rpb[((size_t)l * 4 + h) * 465 + tid];
  }
  __syncthreads();
  if (wave < 4) {
    const int qt = wave;
    int cw0 = 16 * qt - 8; cw0 = cw0 < 0 ? 0 : (cw0 > 32 ? 32 : cw0);
    f32x4 sc[16];
#pragma unroll
    for (int T = 0; T < 16; ++T) sc[T] = (f32x4){0.f, 0.f, 0.f, 0.f};
#pragma unroll
    for (int ks = 0; ks < 2; ++ks) {
      const bf16x8 qb = *(const bf16x8*)(Ql + (qt * 16 + tl) * NA_KLD + ks * 32 + 8 * g);
#pragma unroll
      for (int T = 0; T < 16; ++T) {
        const int key = (T >> 1) * 64 + cw0 + (T & 1) * 16 + tl;
        const bf16x8 ka = *(const bf16x8*)(Kl + key * NA_KLD + ks * 32 + 8 * g);
        sc[T] = __builtin_amdgcn_mfma_f32_16x16x32_bf16(ka, qb, sc[T], 0, 0, 0);
      }
    }
    const int cq = qt * 16 + tl;
    int cs = cq - 8; cs = cs < 0 ? 0 : (cs > 48 ? 48 : cs);
    float m = -3.0e38f;
#pragma unroll
    for (int T = 0; T < 16; ++T) {
      const int ri = T >> 1;
      const int di = rs + ri - rr + 7;
#pragma unroll
      for (int r = 0; r < 4; ++r) {
        const int ck = cw0 + (T & 1) * 16 + 4 * g + r;
        const bool valid = (ck >= cs) && (ck < cs + 16);
        int dj = ck - cq + 15; dj = dj < 0 ? 0 : (dj > 30 ? 30 : dj);
        const float sv = valid ? (sc[T][r] + rpbl[di * 31 + dj]) : -1.0e30f;
        sc[T][r] = sv;
        m = fmaxf(m, sv);
      }
    }
    m = fmaxf(m, __shfl_xor(m, 16, 64));
    m = fmaxf(m, __shfl_xor(m, 32, 64));
    float den = 0.f;
#pragma unroll
    for (int T = 0; T < 16; ++T)
#pragma unroll
      for (int r = 0; r < 4; ++r) {
        const float e = __expf(sc[T][r] - m);
        sc[T][r] = e;
        den += e;
      }
    den += __shfl_xor(den, 16, 64);
    den += __shfl_xor(den, 32, 64);
    const float rden = 1.0f / den;
    f32x4 o[4];
#pragma unroll
    for (int dt = 0; dt < 4; ++dt) o[dt] = (f32x4){0.f, 0.f, 0.f, 0.f};
#pragma unroll
    for (int ri = 0; ri < 8; ++ri) {
      union { bf16x8 v; unsigned u[4]; } pb;
      pb.u[0] = pack2bf(sc[2 * ri][0], sc[2 * ri][1]);
      pb.u[1] = pack2bf(sc[2 * ri][2], sc[2 * ri][3]);
      pb.u[2] = pack2bf(sc[2 * ri + 1][0], sc[2 * ri + 1][1]);
      pb.u[3] = pack2bf(sc[2 * ri + 1][2], sc[2 * ri + 1][3]);
#pragma unroll
      for (int dt = 0; dt < 4; ++dt) {
        const bf16_t* vp = VT + (dt * 16 + tl) * NA_VLD + ri * 64 + cw0 + 4 * g;
        union { bf16x8 v; uint2 h[2]; } va;
        va.h[0] = *(const uint2*)vp;
        va.h[1] = *(const uint2*)(vp + 16);
        o[dt] = __builtin_amdgcn_mfma_f32_16x16x32_bf16(va.v, pb.v, o[dt], 0, 0, 0);
      }
    }
    bf16_t* dst = p.ycat + (size_t)(qtok0 + qt * 16 + tl) * 1024 + 768 + h * 64 + 4 * g;
#pragma unroll
    for (int dt = 0; dt < 4; ++dt) {
      uint2 ov;
      ov.x = pack2bf(o[dt][0] * rden, o[dt][1] * rden);
      ov.y = pack2bf(o[dt][2] * rden, o[dt][3] * rden);
      *(uint2*)(dst + dt * 16) = ov;
    }
  }
}

#define PL_LD 264
__device__ __forceinline__ void o_pool_task(const Params& p, int l, int task, char* smem, int tid) {
  const int wave = tid >> 6, lane = tid & 63, g = lane >> 4, tl = lane & 15;
  const int t0 = task * 64, pos0 = t0 & (SEQ - 1);
  bf16_t* Xp = (bf16_t*)smem;
  bf16_t* WT = Xp + 80 * PL_LD;
  bf16_t* Df = WT + 4 * 64 * 72;
  __syncthreads();
#pragma unroll
  for (int it = 0; it < 5; ++it) {
    const int u = tid + it * NTHREADS;
    const int rw = u >> 5, c0 = (u & 31) * 8;
    const int pos = pos0 - 8 + rw;
    uint4 v = make_uint4(0u, 0u, 0u, 0u);
    if (pos >= 0 && pos < SEQ) v = *(const uint4*)(p.proj + (size_t)(t0 - 8 + rw) * IN_WIDTH + C_POOL + c0);
    *(uint4*)(Xp + rw * PL_LD + c0) = v;
  }
#pragma unroll
  for (int it = 0; it < 4; ++it) {
    const int u = tid + it * NTHREADS;
    const int e0 = (u & 7) * 8, c = (u >> 3) & 63, gi = u >> 9;
    const float* wp = p.pool_w + (((size_t)l * 4 + gi) * 64 + c) * 64 + e0;
    const float4 a = *(const float4*)wp, bq = *(const float4*)(wp + 4);
    const float wv[8] = {a.x, a.y, a.z, a.w, bq.x, bq.y, bq.z, bq.w};
#pragma unroll
    for (int k = 0; k < 8; ++k) WT[(gi * 64 + e0 + k) * 72 + c] = f2bf(wv[k]);
  }
  __syncthreads();
#pragma unroll 1
  for (int it = 0; it < 4; ++it) {
    const int u = tid + it * NTHREADS;
    const int t = u >> 5, c0 = (u & 31) * 8;
    const int gi = c0 >> 6;
    const int hw = 1 << gi;
    const int pos = pos0 + t;
    int a = pos - hw; a = a < 0 ? 0 : a;
    int bnd = pos + hw; bnd = bnd > SEQ ? SEQ : bnd;
    float sum[8];
#pragma unroll
    for (int k = 0; k < 8; ++k) sum[k] = 0.f;
    for (int rp = a; rp < bnd; ++rp) {
      const uint4 v = *(const uint4*)(Xp + (rp - pos0 + 8) * PL_LD + c0);
      sum[0] += bf_lo(v.x); sum[1] += bf_hi(v.x); sum[2] += bf_lo(v.y); sum[3] += bf_hi(v.y);
      sum[4] += bf_lo(v.z); sum[5] += bf_hi(v.z); sum[6] += bf_lo(v.w); sum[7] += bf_hi(v.w);
    }
    const float rc = 1.0f / (float)(bnd - a);
    const uint4 xv = *(const uint4*)(Xp + (t + 8) * PL_LD + c0);
    uint4 o;
    o.x = pack2bf(sum[0] * rc - bf_lo(xv.x), sum[1] * rc - bf_hi(xv.x));
    o.y = pack2bf(sum[2] * rc - bf_lo(xv.y), sum[3] * rc - bf_hi(xv.y));
    o.z = pack2bf(sum[4] * rc - bf_lo(xv.z), sum[5] * rc - bf_hi(xv.z));
    o.w = pack2bf(sum[6] * rc - bf_lo(xv.w), sum[7] * rc - bf_hi(xv.w));
    *(uint4*)(Df + t * PL_LD + c0) = o;
  }
  __syncthreads();
  {
    const int gi = wave >> 1, tt0 = (wave & 1) * 2;
    f32x4 acc[4][2];
#pragma unroll
    for (int et = 0; et < 4; ++et)
#pragma unroll
      for (int tt = 0; tt < 2; ++tt) acc[et][tt] = (f32x4){0.f, 0.f, 0.f, 0.f};
#pragma unroll
    for (int ks = 0; ks < 2; ++ks) {
      bf16x8 bx[2];
#pragma unroll
      for (int tt = 0; tt < 2; ++tt) bx[tt] = *(const bf16x8*)(Df + ((tt0 + tt) * 16 + tl) * PL_LD + gi * 64 + ks * 32 + 8 * g);
#pragma unroll
      for (int et = 0; et < 4; ++et) {
        const bf16x8 wa = *(const bf16x8*)(WT + (gi * 64 + et * 16 + tl) * 72 + ks * 32 + 8 * g);
#pragma unroll
        for (int tt = 0; tt < 2; ++tt) acc[et][tt] = __builtin_amdgcn_mfma_f32_16x16x32_bf16(wa, bx[tt], acc[et][tt], 0, 0, 0);
      }
    }
#pragma unroll
    for (int et = 0; et < 4; ++et) {
      const float4 sc4 = *(const float4*)(p.pool_scale + l * 256 + gi * 64 + et * 16 + 4 * g);
#pragma unroll
      for (int tt = 0; tt < 2; ++tt) {
        const int tok = t0 + (tt0 + tt) * 16 + tl;
        uint2 o;
        o.x = pack2bf(acc[et][tt][0] * sc4.x, acc[et][tt][1] * sc4.y);
        o.y = pack2bf(acc[et][tt][2] * sc4.z, acc[et][tt][3] * sc4.w);
        *(uint2*)(p.ycat + (size_t)tok * 1024 + gi * 64 + et * 16 + 4 * g) = o;
      }
    }
  }
}


typedef __attribute__((ext_vector_type(2))) __bf16 bf16x2_t;
__device__ __forceinline__ float dot2bf(unsigned a, unsigned b, float c) {
  return __builtin_amdgcn_fdot2_f32_bf16(__builtin_bit_cast(bf16x2_t, a), __builtin_bit_cast(bf16x2_t, b), c, false);
}
__device__ __forceinline__ float gelu_exact(float a) { return 0.5f * a * (1.0f + erff(a * 0.70710678118654752f)); }

struct PickPair { int eA, eB; float gA, gB; };

__device__ __forceinline__ void experts_process2(const bf16_t* __restrict__ U, const bf16_t* __restrict__ V, const PickPair pk,
                                                 const unsigned (&hw)[8], float (&acc)[16], int lane) {
  const char* uA = (const char*)(U + (size_t)pk.eA * 1024) + lane * 16;
  const char* uB = (const char*)(U + (size_t)pk.eB * 1024) + lane * 16;
  const char* vA = (const char*)(V + (size_t)pk.eA * 1024) + lane * 16;
  const char* vB = (const char*)(V + (size_t)pk.eB * 1024) + lane * 16;
  const uint4 ua0 = *(const uint4*)uA, ua1 = *(const uint4*)(uA + 1024);
  const uint4 ub0 = *(const uint4*)uB, ub1 = *(const uint4*)(uB + 1024);
  const uint4 va0 = *(const uint4*)vA, va1 = *(const uint4*)(vA + 1024);
  const uint4 vb0 = *(const uint4*)vB, vb1 = *(const uint4*)(vB + 1024);
  float aA = 0.f, aB = 0.f;
  aA = dot2bf(ua0.x, hw[0], aA); aA = dot2bf(ua0.y, hw[1], aA); aA = dot2bf(ua0.z, hw[2], aA); aA = dot2bf(ua0.w, hw[3], aA);
  aA = dot2bf(ua1.x, hw[4], aA); aA = dot2bf(ua1.y, hw[5], aA); aA = dot2bf(ua1.z, hw[6], aA); aA = dot2bf(ua1.w, hw[7], aA);
  aB = dot2bf(ub0.x, hw[0], aB); aB = dot2bf(ub0.y, hw[1], aB); aB = dot2bf(ub0.z, hw[2], aB); aB = dot2bf(ub0.w, hw[3], aB);
  aB = dot2bf(ub1.x, hw[4], aB); aB = dot2bf(ub1.y, hw[5], aB); aB = dot2bf(ub1.z, hw[6], aB); aB = dot2bf(ub1.w, hw[7], aB);
#pragma unroll
  for (int o = 32; o > 0; o >>= 1) { aA += __shfl_xor(aA, o, 64); aB += __shfl_xor(aB, o, 64); }
  const float hA = gelu_exact(aA) * pk.gA, hB = gelu_exact(aB) * pk.gB;
  const unsigned hAl = (unsigned)f2bf(hA), hAh = hAl << 16;
  const unsigned hBl = (unsigned)f2bf(hB), hBh = hBl << 16;
  const unsigned vaw[8] = {va0.x, va0.y, va0.z, va0.w, va1.x, va1.y, va1.z, va1.w};
  const unsigned vbw[8] = {vb0.x, vb0.y, vb0.z, vb0.w, vb1.x, vb1.y, vb1.z, vb1.w};
#pragma unroll
  for (int i = 0; i < 8; ++i) {
    acc[2 * i] = fmaf(__uint_as_float(vaw[i] << 16), hA, acc[2 * i]);
    acc[2 * i + 1] = fmaf(__uint_as_float(vaw[i] & 0xffff0000u), hA, acc[2 * i + 1]);
    acc[2 * i] = fmaf(__uint_as_float(vbw[i] << 16), hB, acc[2 * i]);
    acc[2 * i + 1] = fmaf(__uint_as_float(vbw[i] & 0xffff0000u), hB, acc[2 * i + 1]);
  }
}

__device__ __forceinline__ void o_peer_experts2_tile(const Params& p, int l, int t0, const char* smem, int tid, bool dry = false) {
  const int wave = __builtin_amdgcn_readfirstlane(tid >> 6), lane = tid & 63;
  const bf16_t* U = p.u16 + (size_t)l * 16384 * 1024;
  const bf16_t* V = p.v16 + (size_t)l * 16384 * 1024;
  int vz = 0;
  asm volatile("" : "+v"(vz));
  int pe[8][2]; float pg[8][2];
  float acc[8][16];
#pragma unroll
  for (int tk = 0; tk < 8; ++tk) {
    const size_t base = (size_t)(t0 + wave * 8 + tk) * 128 + lane + vz;
    pe[tk][0] = p.pidx[base]; pe[tk][1] = p.pidx[base + 64];
    pg[tk][0] = p.pgate[base]; pg[tk][1] = p.pgate[base + 64];
#pragma unroll
    for (int i = 0; i < 16; ++i) acc[tk][i] = 0.f;
  }
  const int s0 = ((int)(__builtin_amdgcn_s_getreg((3 << 11) | 20) & 0xF) * 4) & 31;
#pragma unroll 1
  for (int si = 0; si < 32; ++si) {
    const int s = (s0 + si) & 31;
#pragma unroll
    for (int tk = 0; tk < 8; ++tk) {
      unsigned long long m0 = __ballot((pe[tk][0] >> 9) == s);
      unsigned long long m1 = __ballot((pe[tk][1] >> 9) == s);
      if ((m0 | m1) == 0ull) continue;
      unsigned hw[8];
      {
        const int tl = wave * 8 + tk;
        const uint4 h0 = *(const uint4*)(smem + tl * LDXB + lane * 16);
        const uint4 h1 = *(const uint4*)(smem + tl * LDXB + 1024 + lane * 16);
        hw[0] = h0.x; hw[1] = h0.y; hw[2] = h0.z; hw[3] = h0.w; hw[4] = h1.x; hw[5] = h1.y; hw[6] = h1.z; hw[7] = h1.w;
      }
#pragma unroll
      for (int hf = 0; hf < 2; ++hf) {
        unsigned long long m = hf ? m1 : m0;
        while (m) {
          PickPair pk;
          const int la = (int)__builtin_ctzll(m);
          m &= m - 1;
          pk.eA = __builtin_amdgcn_readlane(pe[tk][hf], la);
          pk.gA = __builtin_bit_cast(float, __builtin_amdgcn_readlane(__builtin_bit_cast(int, pg[tk][hf]), la));
          pk.eB = pk.eA; pk.gB = 0.f;
          if (m) {
            const int lb = (int)__builtin_ctzll(m);
            m &= m - 1;
            pk.eB = __builtin_amdgcn_readlane(pe[tk][hf], lb);
            pk.gB = __builtin_bit_cast(float, __builtin_amdgcn_readlane(__builtin_bit_cast(int, pg[tk][hf]), lb));
          }
          experts_process2(U, V, pk, hw, acc[tk], lane);
        }
      }
    }
  }
  if (dry) {
#pragma unroll
    for (int tk = 0; tk < 8; ++tk)
#pragma unroll
      for (int i = 0; i < 16; ++i) asm volatile("" :: "v"(acc[tk][i]));
    return;
  }
#pragma unroll
  for (int tk = 0; tk < 8; ++tk) {
    float* xr = p.xres + (size_t)(t0 + wave * 8 + tk) * 1024 + lane * 8;
#pragma unroll
    for (int i = 0; i < 2; ++i) {
      float4 a0 = *(float4*)(xr + i * 512), a1 = *(float4*)(xr + i * 512 + 4);
      a0.x += acc[tk][8 * i + 0]; a0.y += acc[tk][8 * i + 1]; a0.z += acc[tk][8 * i + 2]; a0.w += acc[tk][8 * i + 3];
      a1.x += acc[tk][8 * i + 4]; a1.y += acc[tk][8 * i + 5]; a1.z += acc[tk][8 * i + 6]; a1.w += acc[tk][8 * i + 7];
      *(float4*)(xr + i * 512) = a0;
      *(float4*)(xr + i * 512 + 4) = a1;
    }
  }
}


#define EQ_CAP 520
#define EQ_BYTES (EQ_CAP * 4)
struct ExRows { uint4 uA0, uA1, uB0, uB1, vA0, vA1, vB0, vB1; };
struct ExDesc { int eA, eB; float gA, gB; };
#define DPP_F(v, ctrl) __builtin_bit_cast(float, __builtin_amdgcn_update_dpp(0, __builtin_bit_cast(int, v), ctrl, 0xf, 0xf, false))
#define RDLANE_F(v, l) __builtin_bit_cast(float, __builtin_amdgcn_readlane(__builtin_bit_cast(int, v), l))

__device__ __forceinline__ ExDesc ex_read_pair(const unsigned* q, int j) {
  const uint2 w = *(const uint2*)(q + 2 * j);
  const unsigned w0 = (unsigned)__builtin_amdgcn_readfirstlane((int)w.x);
  const unsigned w1 = (unsigned)__builtin_amdgcn_readfirstlane((int)w.y);
  ExDesc d;
  d.eA = (int)(w0 & 0x3fffu); d.gA = __uint_as_float(w0 & 0xffff0000u);
  d.eB = (int)(w1 & 0x3fffu); d.gB = __uint_as_float(w1 & 0xffff0000u);
  return d;
}
__device__ __forceinline__ void ex_load_rows(ExRows& r, const bf16_t* __restrict__ U, const bf16_t* __restrict__ V,
                                             const ExDesc& d, int lane) {
  const char* uA = (const char*)(U + (size_t)d.eA * 1024) + lane * 16;
  const char* uB = (const char*)(U + (size_t)d.eB * 1024) + lane * 16;
  const char* vA = (const char*)(V + (size_t)d.eA * 1024) + lane * 16;
  const char* vB = (const char*)(V + (size_t)d.eB * 1024) + lane * 16;
  r.uA0 = *(const uint4*)uA; r.uA1 = *(const uint4*)(uA + 1024);
  r.uB0 = *(const uint4*)uB; r.uB1 = *(const uint4*)(uB + 1024);
  r.vA0 = *(const uint4*)vA; r.vA1 = *(const uint4*)(vA + 1024);
  r.vB0 = *(const uint4*)vB; r.vB1 = *(const uint4*)(vB + 1024);
}
__device__ __forceinline__ void ex_fma16(float (&acc)[16], const uint4& v0, const uint4& v1, unsigned hl, unsigned hh) {
  const unsigned w[8] = {v0.x, v0.y, v0.z, v0.w, v1.x, v1.y, v1.z, v1.w};
#pragma unroll
  for (int i = 0; i < 8; ++i) {
    acc[2 * i] = dot2bf(w[i], hl, acc[2 * i]);
    acc[2 * i + 1] = dot2bf(w[i], hh, acc[2 * i + 1]);
  }
}

__device__ __forceinline__ void o_peer_experts3_tile(const Params& p, int l, int t0, char* smem, int tid, bool dry = false) {
  const int wave = __builtin_amdgcn_readfirstlane(tid >> 6), lane = tid & 63;
  const bool odd = lane & 1;
  const bf16_t* U = p.u16 + (size_t)l * 16384 * 1024;
  const bf16_t* V = p.v16 + (size_t)l * 16384 * 1024;
  unsigned* q = (unsigned*)(smem + XTILE_BYTES + wave * EQ_BYTES);
  int vz = 0;
  asm volatile("" : "+v"(vz));
  const int s0 = ((int)(__builtin_amdgcn_s_getreg((3 << 11) | 20) & 0xF) * 4) & 31;
#pragma unroll 1
  for (int pass = 0; pass < 2; ++pass) {
    const int tl0 = wave * 8 + pass * 4;
    unsigned pk[4][2];
    float acc[4][16];
#pragma unroll
    for (int k = 0; k < 4; ++k) {
      const size_t base = (size_t)(t0 + tl0 + k) * 128 + lane + vz;
#pragma unroll
      for (int hf = 0; hf < 2; ++hf) {
        const unsigned e = (unsigned)p.pidx[base + hf * 64];
        const float gt = p.pgate[base + hf * 64];
        pk[k][hf] = e | ((unsigned)f2bf(gt) << 16);
      }
#pragma unroll
      for (int i = 0; i < 16; ++i) acc[k][i] = 0.f;
    }
#pragma unroll 1
    for (int si = 0; si < 32; ++si) {
      const unsigned s = (unsigned)((s0 + si) & 31);
      int np[4];
      int off = 0;
#pragma unroll
      for (int k = 0; k < 4; ++k) {
        const bool p0 = ((pk[k][0] >> 9) & 31u) == s, p1 = ((pk[k][1] >> 9) & 31u) == s;
        const unsigned long long m0 = __ballot(p0), m1 = __ballot(p1);
        const int c0 = (int)__builtin_popcountll(m0), ck = c0 + (int)__builtin_popcountll(m1);
        const int r0 = (int)__builtin_amdgcn_mbcnt_hi((unsigned)(m0 >> 32), __builtin_amdgcn_mbcnt_lo((unsigned)m0, 0u));
        const int r1 = c0 + (int)__builtin_amdgcn_mbcnt_hi((unsigned)(m1 >> 32), __builtin_amdgcn_mbcnt_lo((unsigned)m1, 0u));
        if (p0) { q[off + r0] = pk[k][0]; if (r0 == ck - 1) q[off + ck] = pk[k][0] & 0xffffu; }
        if (p1) { q[off + r1] = pk[k][1]; if (r1 == ck - 1) q[off + ck] = pk[k][1] & 0xffffu; }
        np[k] = (ck + 1) >> 1;
        off += 2 * np[k];
      }
      const int npt = __builtin_amdgcn_readfirstlane(off >> 1);
      if (npt == 0) continue;
      int j = 0;
      ExDesc dn = ex_read_pair(q, 0);
      ExRows rn;
      ex_load_rows(rn, U, V, dn, lane);
#pragma unroll
      for (int k = 0; k < 4; ++k) {
        const int npk = __builtin_amdgcn_readfirstlane(np[k]);
        if (npk == 0) continue;
        const char* xr = smem + (tl0 + k) * LDXB + lane * 16;
        const uint4 h0 = *(const uint4*)xr, h1 = *(const uint4*)(xr + 1024);
#pragma unroll 1
        for (int c = 0; c < npk; ++c) {
          float aA = 0.f, aB = 0.f;
          aA = dot2bf(rn.uA0.x, h0.x, aA); aA = dot2bf(rn.uA0.y, h0.y, aA); aA = dot2bf(rn.uA0.z, h0.z, aA); aA = dot2bf(rn.uA0.w, h0.w, aA);
          aA = dot2bf(rn.uA1.x, h1.x, aA); aA = dot2bf(rn.uA1.y, h1.y, aA); aA = dot2bf(rn.uA1.z, h1.z, aA); aA = dot2bf(rn.uA1.w, h1.w, aA);
          aB = dot2bf(rn.uB0.x, h0.x, aB); aB = dot2bf(rn.uB0.y, h0.y, aB); aB = dot2bf(rn.uB0.z, h0.z, aB); aB = dot2bf(rn.uB0.w, h0.w, aB);
          aB = dot2bf(rn.uB1.x, h1.x, aB); aB = dot2bf(rn.uB1.y, h1.y, aB); aB = dot2bf(rn.uB1.z, h1.z, aB); aB = dot2bf(rn.uB1.w, h1.w, aB);
          const uint4 vA0 = rn.vA0, vA1 = rn.vA1, vB0 = rn.vB0, vB1 = rn.vB1;
          const float gA = dn.gA, gB = dn.gB;
          ++j;
          if (j < npt) { dn = ex_read_pair(q, j); ex_load_rows(rn, U, V, dn, lane); }
          const float give = odd ? aA : aB;
          const float keep = odd ? aB : aA;
          float x = keep + DPP_F(give, 0xB1);
          x += DPP_F(x, 0x4E);
          x += DPP_F(x, 0x124);
          x += DPP_F(x, 0x128);
          const float sA = RDLANE_F(x, 0) + RDLANE_F(x, 16) + RDLANE_F(x, 32) + RDLANE_F(x, 48);
          const float sB = RDLANE_F(x, 1) + RDLANE_F(x, 17) + RDLANE_F(x, 33) + RDLANE_F(x, 49);
          const float ge = gelu_exact(odd ? sB : sA) * (odd ? gB : gA);
          const unsigned gb = (unsigned)f2bf(ge);
          const unsigned hAl = (unsigned)__builtin_amdgcn_readlane((int)gb, 0), hBl = (unsigned)__builtin_amdgcn_readlane((int)gb, 1);
          ex_fma16(acc[k], vA0, vA1, hAl, hAl << 16);
          ex_fma16(acc[k], vB0, vB1, hBl, hBl << 16);
        }
      }
    }
    if (dry) {
#pragma unroll
      for (int k = 0; k < 4; ++k)
#pragma unroll
        for (int i = 0; i < 16; ++i) asm volatile("" :: "v"(acc[k][i]));
    } else {
#pragma unroll
      for (int k = 0; k < 4; ++k) {
        float* xr = p.xres + (size_t)(t0 + tl0 + k) * 1024 + lane * 8;
#pragma unroll
        for (int i = 0; i < 2; ++i) {
          float4 a0 = *(float4*)(xr + i * 512), a1 = *(float4*)(xr + i * 512 + 4);
          a0.x += acc[k][8 * i + 0]; a0.y += acc[k][8 * i + 1]; a0.z += acc[k][8 * i + 2]; a0.w += acc[k][8 * i + 3];
          a1.x += acc[k][8 * i + 4]; a1.y += acc[k][8 * i + 5]; a1.z += acc[k][8 * i + 6]; a1.w += acc[k][8 * i + 7];
          *(float4*)(xr + i * 512) = a0;
          *(float4*)(xr + i * 512 + 4) = a1;
        }
      }
    }
  }
}


#define XB_TMO      128
#define XB_XCNT(j)  (256  + 64 * (j))
#define XB_XSUB(j)  (1280 + 64 * (j))
#define XB_XGEN(j)  (2304 + 64 * (j))
#define XB_TOP      3328
#define XB_TOPGEN   3392
#define XCD_BAR_WORDS 3456
#define XB_SPIN_CAP (1u << 22)
#define LAS __attribute__((address_space(3)))
__device__ __forceinline__ unsigned xb_ld(unsigned* p)              { return __hip_atomic_load(p, __ATOMIC_RELAXED, __HIP_MEMORY_SCOPE_AGENT); }
__device__ __forceinline__ unsigned xb_add(unsigned* p, unsigned v) { return __hip_atomic_fetch_add(p, v, __ATOMIC_RELAXED, __HIP_MEMORY_SCOPE_AGENT); }
__device__ __forceinline__ unsigned xb_xcc_id() { return (unsigned)__builtin_amdgcn_s_getreg((3 << 11) | 20) & 0xFu; }
#define XB_SPIN(cond, bar) do { unsigned _sp = 0; while (cond) { __builtin_amdgcn_s_sleep(1); \
    if ((++_sp & 255u) == 0u) { if (xb_ld(&(bar)[XB_TMO])) break; if (_sp > XB_SPIN_CAP) { atomicAdd(&(bar)[XB_TMO], 1u); break; } } } } while (0)
struct XcdBarrier { unsigned* bar; unsigned x; volatile LAS unsigned* st; };
__device__ __forceinline__ XcdBarrier xcd_barrier_post(unsigned* bar, volatile LAS unsigned* st, int tid) {
  XcdBarrier b; b.bar = bar; b.x = xb_xcc_id(); b.st = st;
  if (tid == 0) (void)xb_add(&bar[XB_XCNT(b.x)], 1u);
  return b;
}
__device__ __forceinline__ void xcd_barrier_complete(unsigned* bar, unsigned x, unsigned& nloc, unsigned& nx) {
  const unsigned G = gridDim.x * gridDim.y * gridDim.z;
  unsigned sum, cnt, mine, sp = 0u;
  for (;;) {
    sum = 0u; cnt = 0u; mine = 0u;
#pragma unroll
    for (unsigned j = 0; j < 16; ++j) { const unsigned c = xb_ld(&bar[XB_XCNT(j)]); sum += c; cnt += (c > 0u) ? 1u : 0u; mine = (j == x) ? c : mine; }
    if (sum == G) break;
    __builtin_amdgcn_s_sleep(1);
    if ((++sp & 255u) == 0u) { if (xb_ld(&bar[XB_TMO])) break; if (sp > XB_SPIN_CAP) { atomicAdd(&bar[XB_TMO], 1u); break; } }
  }
  nloc = mine > 0u ? mine : 1u; nx = cnt > 0u ? cnt : 1u;
}
__device__ __forceinline__ void xcd_barrier(const XcdBarrier& b, int tid) {
  asm volatile("s_waitcnt vmcnt(0)" ::: "memory");
  __syncthreads();
  if (tid == 0) {
    unsigned* bar = b.bar;
    __builtin_amdgcn_s_waitcnt(0);
    unsigned nloc = b.st[0], nx = b.st[1];
    if (nloc == 0u) { xcd_barrier_complete(bar, b.x, nloc, nx); b.st[0] = nloc; b.st[1] = nx; }
    const unsigned old = xb_add(&bar[XB_XSUB(b.x)], 1u);
    const unsigned gen = old / nloc;
    if (old + 1u == (gen + 1u) * nloc) {
      __builtin_amdgcn_fence(__ATOMIC_RELEASE, "agent");
      asm volatile("s_waitcnt vmcnt(0)" ::: "memory");
      const unsigned og = xb_add(&bar[XB_TOP], 1u);
      const unsigned tg = og / nx;
      if (og + 1u == (tg + 1u) * nx) xb_add(&bar[XB_TOPGEN], 1u);
      else XB_SPIN(xb_ld(&bar[XB_TOPGEN]) == tg, bar);
      __builtin_amdgcn_fence(__ATOMIC_ACQUIRE, "agent");
      xb_add(&bar[XB_XGEN(b.x)], 1u);
      asm volatile("s_waitcnt vmcnt(0)" ::: "memory");
    } else {
      XB_SPIN(xb_ld(&bar[XB_XGEN(b.x)]) == gen, bar);
      __builtin_amdgcn_fence(__ATOMIC_ACQUIRE, "agent");
      asm volatile("s_waitcnt vmcnt(0)" ::: "memory");
    }
  }
  __syncthreads();
}


__global__ void __launch_bounds__(NTHREADS) fwd_megakernel(Params p) {
  cg::grid_group grid = cg::this_grid();
  extern __shared__ __attribute__((aligned(16))) float smem[];
  const int wv_ = __builtin_amdgcn_readfirstlane((int)(threadIdx.x >> 6));
  volatile LAS unsigned* xb_st = (volatile LAS unsigned*)((LAS char*)(LAS float*)smem + (160 * 1024 - 16));
  if (threadIdx.x == 0) { xb_st[0] = 0u; xb_st[1] = 0u; }
  __syncthreads();
  const XcdBarrier xb = xcd_barrier_post(p.bar, xb_st, (int)threadIdx.x);
#define GRID_BARRIER() xcd_barrier(xb, opaque_tid(wv_))

  o_prep(wv_, p, smem);
  grid.sync();
#if PROBE_DUP == 1
  o_prep(wv_, p, smem);
  grid.sync();
#endif
#pragma unroll 1
  for (int l = 0; l < DEPTH; ++l) {
    const float* xcur = (l == 0) ? p.x_in : p.xres;
    o_p1(wv_, p, l, xcur, (char*)smem);
    GRID_BARRIER();
#if PROBE_DUP == 2
    o_p1(wv_, p, l, xcur, (char*)smem);
    GRID_BARRIER();
#endif
#if PROBE_DUP == 3
    for (int rep_ = 0; rep_ < 2; ++rep_) {
#else
    {
#endif
    {
      const int bidx_ = opaque_bid();
      for (int task = bidx_; task < 1792; task += gridDim.x) {
        const int l_ = opaque_s(l), td_ = opaque_tid(wv_), tk_ = opaque_s(task);
        if (tk_ < 1024) o_na_task(p, l_, tk_, (char*)smem, td_);
        else if (tk_ < 1536) o_ret_kv_task(p, l_, tk_ - 1024, (char*)smem, td_);
        else o_pool_task(p, l_, tk_ - 1536, (char*)smem, td_);
      }
    }
    GRID_BARRIER();
    o_ret_scan(wv_, p, l);
    GRID_BARRIER();
    {
      const int tidx_ = opaque_tid(wv_); const int bidx_ = opaque_bid();
      for (int task = bidx_; task < 512; task += gridDim.x) o_ret_out_task(p, l, task, (char*)smem, tidx_);
    }
    GRID_BARRIER();
    }
    {
      const int tidx_ = opaque_tid(wv_); const int bidx_ = opaque_bid();
      for (int tile = bidx_; tile < NTOK / 64; tile += gridDim.x) {
        { const int t0_ = opaque_s(tile * 64), l_ = opaque_s(l), td_ = opaque_tid(wv_); o_p5a1_tile(p, l_, t0_, (char*)smem, td_); }
#if PROBE_DUP == 4
        { const int t0_ = opaque_s(tile * 64), l_ = opaque_s(l), td_ = opaque_tid(wv_); o_p5a1_tile(p, l_, t0_, (char*)smem, td_); }
#endif
        { const int t0_ = opaque_s(tile * 64), l_ = opaque_s(l), td_ = opaque_tid(wv_); o_p5a2_tile(p, l_, xcur, t0_, (char*)smem, td_); }
        { const int t0_ = opaque_s(tile * 64), l_ = opaque_s(l), td_ = opaque_tid(wv_); o_p5a3_tile(p, l_, t0_, (char*)smem, td_); }
        { const int t0_ = opaque_s(tile * 64), l_ = opaque_s(l), td_ = opaque_tid(wv_); o_peer_select_tile(p, l_, t0_, (char*)smem, td_); }
        { const int t0_ = opaque_s(tile * 64), l_ = opaque_s(l), td_ = opaque_tid(wv_); o_peer_select2_tile(p, l_, t0_, td_); }
#if PROBE_DUP == 5
        { const int t0_ = opaque_s(tile * 64), l_ = opaque_s(l), td_ = opaque_tid(wv_); o_peer_select_tile(p, l_, t0_, (char*)smem, td_); }
        { const int t0_ = opaque_s(tile * 64), l_ = opaque_s(l), td_ = opaque_tid(wv_); o_peer_select2_tile(p, l_, t0_, td_); }
#endif
        asm volatile("s_waitcnt vmcnt(0)" ::: "memory");
        __syncthreads();
#if PROBE_DUP == 6
        { const int t0_ = opaque_s(tile * 64), l_ = opaque_s(l), td_ = opaque_tid(wv_); o_peer_experts2_tile(p, l_, t0_, (const char*)smem, td_, true); }
#endif
        { const int t0_ = opaque_s(tile * 64), l_ = opaque_s(l), td_ = opaque_tid(wv_); o_peer_experts2_tile(p, l_, t0_, (const char*)smem, td_); }
      }
    }
    GRID_BARRIER();
  }
  n_rmsnorm<true>(wv_, p.xres, p.norm_final, p.out, NTOK);
}

extern "C" void kernel_launch(void* const* d_in, const int* in_sizes, int n_in, void* d_out, int out_size,
                              void* d_ws, size_t ws_size, hipStream_t stream) {
  Params p{};
  p.x_in = (const float*)d_in[0]; p.norm_mix = (const float*)d_in[1]; p.w_in = (const float*)d_in[2];
  p.pool_w = (const float*)d_in[3]; p.pool_scale = (const float*)d_in[4]; p.ret_decay = (const float*)d_in[5];
  p.na_rpb = (const float*)d_in[6]; p.w_br_pool = (const float*)d_in[7]; p.w_br_ret = (const float*)d_in[8];
  p.w_br_na = (const float*)d_in[9]; p.w_out = (const float*)d_in[10]; p.norm_ffn = (const float*)d_in[11];
  p.w_query = (const float*)d_in[12]; p.sub_keys = (const float*)d_in[13]; p.peer_u = (const float*)d_in[14];
  p.peer_v = (const float*)d_in[15]; p.norm_final = (const float*)d_in[16];
  p.out = (float*)d_out;
  char* ws = (char*)d_ws;
  size_t off = 0;
  auto alloc = [&](size_t bytes) { char* q = ws + off; off += (bytes + 255) & ~(size_t)255; return q; };
  p.xres = (float*)alloc((size_t)NTOK * D_MODEL * 4);
  p.proj = (bf16_t*)alloc((size_t)NTOK * IN_WIDTH * 2);
  p.ycat = (bf16_t*)alloc((size_t)NTOK * 1024 * 2);
  p.mrg = (bf16_t*)alloc((size_t)NTOK * 1024 * 2);
  p.pidx = (int*)alloc((size_t)NTOK * 128 * 4);
  p.pgate = (float*)alloc((size_t)NTOK * 128 * 4);
  p.wf_in = (bf16_t*)alloc((size_t)DEPTH * D_MODEL * IN_WIDTH * 2);
  p.wf_br = (bf16_t*)alloc((size_t)DEPTH * 1024 * 1024 * 2);
  p.wf_out = (bf16_t*)alloc((size_t)DEPTH * 1024 * 1024 * 2);
  p.wf_q = (bf16_t*)alloc((size_t)DEPTH * 1024 * 2048 * 2);
  p.kf = (bf16_t*)alloc((size_t)DEPTH * 2 * 128 * 128 * 2);
  p.u16 = (bf16_t*)alloc((size_t)DEPTH * 16384 * 1024 * 2);
  p.v16 = (bf16_t*)alloc((size_t)DEPTH * 16384 * 1024 * 2);
  p.rope = (float2*)alloc((size_t)SEQ * 32 * 8);
  p.tklist = (unsigned*)alloc((size_t)NTOK * 8 * 2 * 16 * 4);
  p.kvst = (float*)p.mrg;
  p.rstate = (bf16_t*)p.tklist;
  p.bar = (unsigned*)alloc(XCD_BAR_WORDS * 4);
  p.xn = nullptr; p.merged = nullptr; p.pq = nullptr; p.psc = nullptr;
  if (off > ws_size) fprintf(stderr, "WORKSPACE OVERFLOW: need %zu have %zu\n", off, ws_size);

  const size_t kDynLds = 160 * 1024;
  static int grid_blocks = 0;
  if (!grid_blocks) {
    int dev = 0, cus = 0, per_cu = 0;
    (void)hipGetDevice(&dev);
    (void)hipDeviceGetAttribute(&cus, hipDeviceAttributeMultiprocessorCount, dev);
    (void)hipFuncSetAttribute((const void*)fwd_megakernel, hipFuncAttributeMaxDynamicSharedMemorySize, (int)kDynLds);
    (void)hipOccupancyMaxActiveBlocksPerMultiprocessor(&per_cu, fwd_megakernel, NTHREADS, kDynLds);
    if (per_cu < 1) per_cu = 1;
    grid_blocks = cus * per_cu;
  }
  (void)hipMemsetAsync(p.bar, 0, XCD_BAR_WORDS * 4, stream);
  void* args[] = {&p};
  hipError_t e = hipLaunchCooperativeKernel((void*)fwd_megakernel, dim3(grid_blocks), dim3(NTHREADS), args, kDynLds, stream);
  if (e != hipSuccess) fprintf(stderr, "cooperative launch failed: %s (grid %d)\n", hipGetErrorString(e), grid_blocks);
}
```

```cpp
#include <hip/hip_runtime.h>
#include <hip/hip_cooperative_groups.h>
#include <stdint.h>
#include <cstdio>
namespace cg = cooperative_groups;

#define D_MODEL 1024
#define SEQ 4096
#define BATCH 4
#define NTOK (BATCH * SEQ)
#define DEPTH 2
#define IN_WIDTH 5632
#define C_POOL 0
#define C_RQ 256
#define C_RK 512
#define C_RV 768
#define C_RG 1280
#define C_NQ 1792
#define C_NK 2048
#define C_NV 2304
#define C_GATE 2560
#define EPS 1e-6f
#define NTHREADS 512
#define PROBE_DUP 0

typedef unsigned short bf16_t;

struct Params {
  const float* x_in; const float* norm_mix; const float* w_in; const float* pool_w; const float* pool_scale;
  const float* ret_decay; const float* na_rpb; const float* w_br_pool; const float* w_br_ret; const float* w_br_na;
  const float* w_out; const float* norm_ffn; const float* w_query; const float* sub_keys; const float* peer_u;
  const float* peer_v; const float* norm_final;
  float* out;
  float* xres;
  bf16_t* xn;
  bf16_t* proj;
  bf16_t* ycat;
  float* merged;
  float* pq;
  float* psc;
  int* pidx;
  float* pgate;
  bf16_t* wf_in;
  bf16_t* wf_br;
  bf16_t* wf_out;
  bf16_t* wf_q;
  bf16_t* kf;
  bf16_t* u16;
  bf16_t* v16;
  float2* rope;
  bf16_t* mrg;
  unsigned* tklist;
  float* kvst;
  bf16_t* rstate;
  unsigned* bar;
  unsigned char* u8; unsigned char* v8;
  float2* escale;
};

__device__ __forceinline__ bf16_t f2bf(float f) {
  unsigned u = __float_as_uint(f);
  u += 0x7fffu + ((u >> 16) & 1u);
  return (bf16_t)(u >> 16);
}
__device__ __forceinline__ float bf2f(bf16_t h) { return __uint_as_float(((unsigned)h) << 16); }

__device__ __forceinline__ float wave_sum(float v) {
#pragma unroll
  for (int o = 32; o > 0; o >>= 1) v += __shfl_xor(v, o, 64);
  return v;
}
__device__ __forceinline__ float wave_max(float v) {
#pragma unroll
  for (int o = 32; o > 0; o >>= 1) v = fmaxf(v, __shfl_xor(v, o, 64));
  return v;
}
__device__ __forceinline__ float sigmoidf_(float x) { return 1.0f / (1.0f + expf(-x)); }

__device__ __forceinline__ int opaque_tid(int wv) {
  int w = wv;
  asm volatile("" : "+s"(w));
  int lane = __builtin_amdgcn_mbcnt_hi(~0u, __builtin_amdgcn_mbcnt_lo(~0u, 0u));
  asm volatile("" : "+v"(lane));
  return w * 64 + lane;
}
__device__ __forceinline__ int opaque_s(int x) { asm volatile("" : "+s"(x)); return x; }
__device__ __forceinline__ int opaque_bid() { int b = blockIdx.x; asm volatile("" : "+s"(b)); return b; }

template <bool OUT_F32>
__device__ __forceinline__ void n_rmsnorm(const int wv_, const float* __restrict__ x, const float* __restrict__ g, void* outp, int rows) {
  const int tidx_ = opaque_tid(wv_); const int bidx_ = opaque_bid();
  const int lane = tidx_ & 63;
  const int nw = gridDim.x * (NTHREADS / 64);
  for (int row = bidx_ * (NTHREADS / 64) + (tidx_ >> 6); row < rows; row += nw) {
    const float* xr = x + (size_t)row * D_MODEL;
    float4 v[4];
    float ss = 0.f;
#pragma unroll
    for (int i = 0; i < 4; ++i) {
      v[i] = *(const float4*)(xr + i * 256 + lane * 4);
      ss += v[i].x * v[i].x + v[i].y * v[i].y + v[i].z * v[i].z + v[i].w * v[i].w;
    }
    ss = wave_sum(ss);
    float r = rsqrtf(ss * (1.0f / D_MODEL) + EPS);
#pragma unroll
    for (int i = 0; i < 4; ++i) {
      float4 gg = *(const float4*)(g + i * 256 + lane * 4);
      float o0 = v[i].x * r * gg.x, o1 = v[i].y * r * gg.y, o2 = v[i].z * r * gg.z, o3 = v[i].w * r * gg.w;
      if (OUT_F32) {
        *(float4*)((float*)outp + (size_t)row * D_MODEL + i * 256 + lane * 4) = make_float4(o0, o1, o2, o3);
      } else {
        ushort4 o; o.x = f2bf(o0); o.y = f2bf(o1); o.z = f2bf(o2); o.w = f2bf(o3);
        *(ushort4*)((bf16_t*)outp + (size_t)row * D_MODEL + i * 256 + lane * 4) = o;
      }
    }
  }
}

template <bool A_BF16, typename Epi>
__device__ __forceinline__ void n_gemm(const int wv_, const void* Av, int lda, long sA, const float* __restrict__ B, int ldb, long sB,
                                       int transB, int M, int N, int K, int Z, float* smem, Epi epi) {
  const int tidx_ = opaque_tid(wv_); const int bidx_ = opaque_bid();
  const int grp = tidx_ >> 8, tid = tidx_ & 255;
  float(*As)[68] = (float(*)[68])(smem + grp * 2 * 16 * 68);
  float(*Bs)[68] = (float(*)[68])(smem + grp * 2 * 16 * 68 + 16 * 68);
  const int tx = tid & 15, ty = tid >> 4;
  const int tn = N / 64, tm = M / 64;
  const int nwork = tn * tm * Z;
  for (int wb = bidx_ * 2; wb < nwork; wb += gridDim.x * 2) {
    const int w = wb + grp;
    const int z = w / (tn * tm);
    const int rem = w - z * (tn * tm);
    const int bm = (rem / tn) * 64, bn = (rem % tn) * 64;
    const float* Af = (const float*)Av + (size_t)z * sA;
    const bf16_t* Ab = (const bf16_t*)Av + (size_t)z * sA;
    const float* Bz = B + (size_t)z * sB;
    float acc[4][4];
#pragma unroll
    for (int i = 0; i < 4; ++i)
#pragma unroll
      for (int j = 0; j < 4; ++j) acc[i][j] = 0.f;
    for (int k0 = 0; k0 < K; k0 += 16) {
#pragma unroll
      for (int i = 0; i < 4; ++i) {
        int idx = tid + i * 256;
        int m = idx >> 4, k = idx & 15;
        size_t ao = (size_t)(bm + m) * lda + k0 + k;
        As[k][m] = A_BF16 ? bf2f(Ab[ao]) : Af[ao];
        if (transB) {
          int n = idx >> 4, kk = idx & 15;
          Bs[kk][n] = Bz[(size_t)(bn + n) * ldb + k0 + kk];
        } else {
          int kk = idx >> 6, n = idx & 63;
          Bs[kk][n] = Bz[(size_t)(k0 + kk) * ldb + bn + n];
        }
      }
      __syncthreads();
#pragma unroll
      for (int k = 0; k < 16; ++k) {
        float a[4], b[4];
#pragma unroll
        for (int i = 0; i < 4; ++i) a[i] = As[k][ty * 4 + i];
#pragma unroll
        for (int j = 0; j < 4; ++j) b[j] = Bs[k][tx * 4 + j];
#pragma unroll
        for (int i = 0; i < 4; ++i)
#pragma unroll
          for (int j = 0; j < 4; ++j) acc[i][j] = fmaf(a[i], b[j], acc[i][j]);
      }
      __syncthreads();
    }
#pragma unroll
    for (int i = 0; i < 4; ++i)
#pragma unroll
      for (int j = 0; j < 4; ++j) epi(z, bm + ty * 4 + i, bn + tx * 4 + j, acc[i][j]);
  }
}

__device__ __forceinline__ void n_rope(const int wv_, bf16_t* __restrict__ proj) {
  const int tidx_ = opaque_tid(wv_); const int bidx_ = opaque_bid();
  const int total = NTOK * 256;
  for (int gid = bidx_ * NTHREADS + tidx_; gid < total; gid += gridDim.x * NTHREADS) {
    int i = gid & 31, h = (gid >> 5) & 3, qk = (gid >> 7) & 1, t = gid >> 8;
    int pos = t & (SEQ - 1);
    float inv = 1.0f / powf(10000.0f, (float)i / 31.0f);
    float ang = (float)pos * inv;
    double rev = (double)ang * 0.15915494309189535;
    rev -= floor(rev);
    float rf = (float)rev;
    float cs = __builtin_amdgcn_cosf(rf), sn = __builtin_amdgcn_sinf(rf);
    bf16_t* p = proj + (size_t)t * IN_WIDTH + (qk ? C_RK : C_RQ) + h * 64 + i;
    float x1 = bf2f(p[0]), x2 = bf2f(p[32]);
    p[0] = f2bf(x1 * cs - x2 * sn);
    p[32] = f2bf(x1 * sn + x2 * cs);
  }
}

__device__ __forceinline__ void n_pool(const int wv_, const bf16_t* __restrict__ proj, const float* __restrict__ pw,
                                       const float* __restrict__ pscale, bf16_t* __restrict__ ycat, float* smem) {
  const int tidx_ = opaque_tid(wv_); const int bidx_ = opaque_bid();
  const int grp = tidx_ >> 8, c = tidx_ & 255;
  float* diff = smem + grp * 256;
  const int gi = c >> 6;
  const int w = 2 << gi;
  const int lo = w / 2, hi = w - w / 2;
  for (int wb = bidx_ * 2; wb < NTOK; wb += gridDim.x * 2) {
    const int t = wb + grp;
    const int b0 = t & ~(SEQ - 1), pos = t & (SEQ - 1);
    int a = pos - lo; if (a < 0) a = 0;
    int b = pos + hi; if (b > SEQ) b = SEQ;
    float s = 0.f;
    for (int tt = a; tt < b; ++tt) s += bf2f(proj[(size_t)(b0 + tt) * IN_WIDTH + C_POOL + c]);
    float mean = s / (float)(b - a);
    __syncthreads();
    diff[c] = mean - bf2f(proj[(size_t)t * IN_WIDTH + C_POOL + c]);
    __syncthreads();
    const int e = c & 63;
    const float* wg = pw + gi * 64 * 64;
    float acc = 0.f;
    for (int cc = 0; cc < 64; ++cc) acc = fmaf(diff[gi * 64 + cc], wg[cc * 64 + e], acc);
    ycat[(size_t)t * 1024 + c] = f2bf(acc * pscale[c]);
  }
}

__device__ __forceinline__ void n_retention(const int wv_, const bf16_t* __restrict__ proj, const float* __restrict__ decay,
                                            bf16_t* __restrict__ ycat, float* smem) {
  const int tidx_ = opaque_tid(wv_); const int bidx_ = opaque_bid();
  const int grp = tidx_ >> 8, tid = tidx_ & 255;
  float* base = smem + grp * 12544;
  float(*Qs)[65] = (float(*)[65])base;
  float(*Ks)[65] = (float(*)[65])(base + 64 * 65);
  float(*Vs)[128] = (float(*)[128])(base + 64 * 65 + 32 * 65);
  float(*Ps)[33] = (float(*)[33])(base + 64 * 65 + 32 * 65 + 32 * 128);
  const int rg = tid >> 5, cl = tid & 31;
  const int nwork = (NTOK / 64) * 4;
  for (int wb = bidx_ * 2; wb < nwork; wb += gridDim.x * 2) {
    const int w = wb + grp;
    const int h = w & 3, qt = w >> 2;
    const int t0 = qt * 64;
    const int b0 = t0 & ~(SEQ - 1);
    const int q0 = t0 & (SEQ - 1);
    float dlf = decay[h], dlb = decay[4 + h];
    float lgf = fminf(dlf, 0.f) - log1pf(expf(-fabsf(dlf)));
    float lgb = fminf(dlb, 0.f) - log1pf(expf(-fabsf(dlb)));
    __syncthreads();
    for (int idx = tid; idx < 64 * 64; idx += 256) {
      int r = idx >> 6, d = idx & 63;
      Qs[r][d] = bf2f(proj[(size_t)(t0 + r) * IN_WIDTH + C_RQ + h * 64 + d]);
    }
    float acc[8][4];
#pragma unroll
    for (int i = 0; i < 8; ++i)
#pragma unroll
      for (int j = 0; j < 4; ++j) acc[i][j] = 0.f;
    for (int k0 = 0; k0 < SEQ; k0 += 32) {
      __syncthreads();
      for (int idx = tid; idx < 32 * 64; idx += 256) {
        int r = idx >> 6, d = idx & 63;
        Ks[r][d] = bf2f(proj[(size_t)(b0 + k0 + r) * IN_WIDTH + C_RK + h * 64 + d]);
      }
      for (int idx = tid; idx < 32 * 128; idx += 256) {
        int r = idx >> 7, d = idx & 127;
        Vs[r][d] = bf2f(proj[(size_t)(b0 + k0 + r) * IN_WIDTH + C_RV + h * 128 + d]);
      }
      __syncthreads();
      float sc[8];
#pragma unroll
      for (int i = 0; i < 8; ++i) sc[i] = 0.f;
      for (int d = 0; d < 64; ++d) {
        float kv = Ks[cl][d];
#pragma unroll
        for (int i = 0; i < 8; ++i) sc[i] = fmaf(Qs[rg * 8 + i][d], kv, sc[i]);
      }
      const int j = k0 + cl;
#pragma unroll
      for (int i = 0; i < 8; ++i) {
        int qi = q0 + rg * 8 + i;
        float dd = (j <= qi) ? expf(lgf * (float)(qi - j)) : expf(lgb * (float)(j - qi));
        Ps[rg * 8 + i][cl] = sc[i] * dd;
      }
      __syncthreads();
      for (int jj = 0; jj < 32; ++jj) {
        float v[4];
#pragma unroll
        for (int c = 0; c < 4; ++c) v[c] = Vs[jj][cl + 32 * c];
#pragma unroll
        for (int i = 0; i < 8; ++i) {
          float p = Ps[rg * 8 + i][jj];
#pragma unroll
          for (int c = 0; c < 4; ++c) acc[i][c] = fmaf(p, v[c], acc[i][c]);
        }
      }
    }
#pragma unroll
    for (int i = 0; i < 8; ++i) {
      float ss = acc[i][0] * acc[i][0] + acc[i][1] * acc[i][1] + acc[i][2] * acc[i][2] + acc[i][3] * acc[i][3];
#pragma unroll
      for (int o = 16; o > 0; o >>= 1) ss += __shfl_xor(ss, o, 64);
      float r = rsqrtf(ss * (1.0f / 128.0f) + EPS);
      int t = t0 + rg * 8 + i;
#pragma unroll
      for (int c = 0; c < 4; ++c) {
        int col = h * 128 + cl + 32 * c;
        float g = bf2f(proj[(size_t)t * IN_WIDTH + C_RG + col]);
        float sg = g / (1.0f + expf(-g));
        ycat[(size_t)t * 1024 + 256 + col] = f2bf(sg * acc[i][c] * r);
      }
    }
  }
}

__device__ __forceinline__ void n_na(const int wv_, const bf16_t* __restrict__ proj, const float* __restrict__ rpb,
                                     bf16_t* __restrict__ ycat) {
  const int tidx_ = opaque_tid(wv_); const int bidx_ = opaque_bid();
  const int lane = tidx_ & 63;
  const int nw = gridDim.x * (NTHREADS / 64);
  for (int wv = bidx_ * (NTHREADS / 64) + (tidx_ >> 6); wv < NTOK * 4; wv += nw) {
    int h = wv & 3, t = wv >> 2;
    int b0 = t & ~(SEQ - 1), pos = t & (SEQ - 1);
    int r = pos >> 6, c = pos & 63;
    int rs = r - 4; rs = rs < 0 ? 0 : (rs > 56 ? 56 : rs);
    int cs = c - 8; cs = cs < 0 ? 0 : (cs > 48 ? 48 : cs);
    float qv = bf2f(proj[(size_t)t * IN_WIDTH + C_NQ + h * 64 + lane]);
    float s[2];
#pragma unroll
    for (int u = 0; u < 2; ++u) {
      int kk = lane + 64 * u;
      int ri = kk >> 4, cj = kk & 15;
      int kt = b0 + (rs + ri) * 64 + cs + cj;
      const bf16_t* kp = proj + (size_t)kt * IN_WIDTH + C_NK + h * 64;
      float a = 0.f;
      for (int d = 0; d < 64; ++d) a = fmaf(__shfl(qv, d, 64), bf2f(kp[d]), a);
      int di = rs + ri - r + 7;
      int dj = cs + cj - c + 15;
      s[u] = a + rpb[(h * 15 + di) * 31 + dj];
    }
    float m = wave_max(fmaxf(s[0], s[1]));
    float e0 = expf(s[0] - m), e1 = expf(s[1] - m);
    float den = wave_sum(e0 + e1);
    float p0 = e0 / den, p1 = e1 / den;
    float o = 0.f;
    for (int kk = 0; kk < 128; ++kk) {
      float p = __shfl((kk < 64) ? p0 : p1, kk & 63, 64);
      int ri = kk >> 4, cj = kk & 15;
      int kt = b0 + (rs + ri) * 64 + cs + cj;
      o = fmaf(p, bf2f(proj[(size_t)kt * IN_WIDTH + C_NV + h * 64 + lane]), o);
    }
    ycat[(size_t)t * 1024 + 768 + h * 64 + lane] = f2bf(o);
  }
}

#define TKS 256
__device__ __forceinline__ void lds_insert(float* v, int* id, float x, int xi) {
  if (x > v[15 * TKS]) {
    int j = 15;
    while (j > 0 && v[(j - 1) * TKS] < x) {
      v[j * TKS] = v[(j - 1) * TKS];
      id[j * TKS] = id[(j - 1) * TKS];
      --j;
    }
    v[j * TKS] = x;
    id[j * TKS] = xi;
  }
}
__device__ __forceinline__ void n_topk(const int wv_, const float* __restrict__ scores, int* __restrict__ idx,
                                       float* __restrict__ gate, float* smem) {
  const int tidx_ = opaque_tid(wv_); const int bidx_ = opaque_bid();
  const int tid = tidx_;
  if (tid >= TKS) return;
  float* v1 = smem + tid;
  float* v2 = smem + 16 * TKS + tid;
  float* v3 = smem + 32 * TKS + tid;
  int* i1 = (int*)(smem + 48 * TKS) + tid;
  int* i2 = (int*)(smem + 64 * TKS) + tid;
  int* i3 = (int*)(smem + 80 * TKS) + tid;
  for (int gid = bidx_ * TKS + tid; gid < SEQ * 8; gid += gridDim.x * TKS) {
    const float* s = scores + (size_t)gid * 256;
    for (int j = 0; j < 16; ++j) {
      v1[j * TKS] = -3.0e38f; v2[j * TKS] = -3.0e38f; v3[j * TKS] = -3.0e38f;
      i1[j * TKS] = 0; i2[j * TKS] = 0; i3[j * TKS] = 0;
    }
    for (int n = 0; n < 128; ++n) lds_insert(v1, i1, s[n], n);
    for (int n = 0; n < 128; ++n) lds_insert(v2, i2, s[128 + n], n);
    for (int a = 0; a < 16; ++a) {
      float va = v1[a * TKS];
      int ia = i1[a * TKS];
      for (int b = 0; b < 16; ++b) lds_insert(v3, i3, va + v2[b * TKS], ia * 128 + i2[b * TKS]);
    }
    float m = v3[0];
    float den = 0.f;
    for (int j = 0; j < 16; ++j) den += expf(v3[j * TKS] - m);
    for (int j = 0; j < 16; ++j) {
      idx[(size_t)gid * 16 + j] = i3[j * TKS];
      gate[(size_t)gid * 16 + j] = expf(v3[j * TKS] - m) / den;
    }
  }
}

__device__ __forceinline__ void n_experts(const int wv_, const bf16_t* __restrict__ hn, const int* __restrict__ idx,
                                          const float* __restrict__ gate, const float* __restrict__ wu,
                                          const float* __restrict__ wv, float* __restrict__ x, int ntok) {
  const int tidx_ = opaque_tid(wv_); const int bidx_ = opaque_bid();
  const int lane = tidx_ & 63;
  const int nw = gridDim.x * (NTHREADS / 64);
  for (int t = bidx_ * (NTHREADS / 64) + (tidx_ >> 6); t < ntok; t += nw) {
    const bf16_t* hr = hn + (size_t)t * D_MODEL;
    float4 hv[4], acc[4];
#pragma unroll
    for (int i = 0; i < 4; ++i) {
      ushort4 hb = *(const ushort4*)(hr + i * 256 + lane * 4);
      hv[i] = make_float4(bf2f(hb.x), bf2f(hb.y), bf2f(hb.z), bf2f(hb.w));
      acc[i] = make_float4(0.f, 0.f, 0.f, 0.f);
    }
    for (int k = 0; k < 128; ++k) {
      int e = idx[(size_t)t * 128 + k];
      float g = gate[(size_t)t * 128 + k];
      const float* ur = wu + (size_t)e * D_MODEL;
      float a = 0.f;
#pragma unroll
      for (int i = 0; i < 4; ++i) {
        float4 u = *(const float4*)(ur + i * 256 + lane * 4);
        a += hv[i].x * u.x + hv[i].y * u.y + hv[i].z * u.z + hv[i].w * u.w;
      }
      a = wave_sum(a);
      float hh = 0.5f * a * (1.0f + erff(a * 0.70710678118654752f)) * g;
      const float* vr = wv + (size_t)e * D_MODEL;
#pragma unroll
      for (int i = 0; i < 4; ++i) {
        float4 v = *(const float4*)(vr + i * 256 + lane * 4);
        acc[i].x = fmaf(hh, v.x, acc[i].x); acc[i].y = fmaf(hh, v.y, acc[i].y);
        acc[i].z = fmaf(hh, v.z, acc[i].z); acc[i].w = fmaf(hh, v.w, acc[i].w);
      }
    }
    float* xr = x + (size_t)t * D_MODEL;
#pragma unroll
    for (int i = 0; i < 4; ++i) {
      float4 o = *(float4*)(xr + i * 256 + lane * 4);
      o.x += acc[i].x; o.y += acc[i].y; o.z += acc[i].z; o.w += acc[i].w;
      *(float4*)(xr + i * 256 + lane * 4) = o;
    }
  }
}


typedef __attribute__((ext_vector_type(8))) short bf16x8;
typedef __attribute__((ext_vector_type(4))) float f32x4;
#define LDX 1032
#define LDXB (LDX * 2)
#define XTILE_BYTES (64 * LDXB)

__device__ __forceinline__ unsigned pack2bf(float a, float b) { return (unsigned)f2bf(a) | ((unsigned)f2bf(b) << 16); }

__device__ __forceinline__ void prep_frag(const int wv_, const float* __restrict__ W, int K, int N, bf16_t* __restrict__ dst, float* smem) {
  const int tidx_ = opaque_tid(wv_); const int bidx_ = opaque_bid();
  const int grp = tidx_ >> 8, tid = tidx_ & 255;
  float(*T)[65] = (float(*)[65])(smem + grp * 32 * 65);
  const int KS = K / 32, NC = N / 64;
  const int ntiles = KS * NC;
  for (int wb = bidx_ * 2; wb < ntiles; wb += gridDim.x * 2) {
    const int w = wb + grp;
    const int c = w / KS, ks = w - c * KS;
    {
      const int row = tid >> 3, col = (tid & 7) * 8;
      const float* src = W + (size_t)(ks * 32 + row) * N + c * 64 + col;
      float4 a = *(const float4*)src, b = *(const float4*)(src + 4);
      __syncthreads();
      T[row][col + 0] = a.x; T[row][col + 1] = a.y; T[row][col + 2] = a.z; T[row][col + 3] = a.w;
      T[row][col + 4] = b.x; T[row][col + 5] = b.y; T[row][col + 6] = b.z; T[row][col + 7] = b.w;
    }
    __syncthreads();
    {
      const int nt = tid >> 6, lane = tid & 63;
      const int kr = 8 * (lane >> 4), nc = nt * 16 + (lane & 15);
      uint4 o;
      o.x = pack2bf(T[kr + 0][nc], T[kr + 1][nc]);
      o.y = pack2bf(T[kr + 2][nc], T[kr + 3][nc]);
      o.z = pack2bf(T[kr + 4][nc], T[kr + 5][nc]);
      o.w = pack2bf(T[kr + 6][nc], T[kr + 7][nc]);
      *(uint4*)(dst + ((size_t)((c * KS + ks) * 4 + nt) * 64 + lane) * 8) = o;
    }
  }
}

__device__ __forceinline__ void o_prep(const int wv_, const Params& p, float* smem) {
  for (int l = 0; l < DEPTH; ++l) {
    prep_frag(wv_, p.w_in + (size_t)l * D_MODEL * IN_WIDTH, D_MODEL, IN_WIDTH, p.wf_in + (size_t)l * D_MODEL * IN_WIDTH, smem);
    prep_frag(wv_, p.w_br_pool + (size_t)l * 256 * 1024, 256, 1024, p.wf_br + (size_t)l * 1024 * 1024, smem);
    prep_frag(wv_, p.w_br_ret + (size_t)l * 512 * 1024, 512, 1024, p.wf_br + (size_t)l * 1024 * 1024 + 256 * 1024, smem);
    prep_frag(wv_, p.w_br_na + (size_t)l * 256 * 1024, 256, 1024, p.wf_br + (size_t)l * 1024 * 1024 + 768 * 1024, smem);
    prep_frag(wv_, p.w_out + (size_t)l * 1024 * 1024, 1024, 1024, p.wf_out + (size_t)l * 1024 * 1024, smem);
    prep_frag(wv_, p.w_query + (size_t)l * 1024 * 2048, 1024, 2048, p.wf_q + (size_t)l * 1024 * 2048, smem);
  }
  const int tidx_ = opaque_tid(wv_); const int bidx_ = opaque_bid();
  const int gtid = bidx_ * NTHREADS + tidx_, gsz = gridDim.x * NTHREADS;
  for (int u = gtid; u < DEPTH * 2 * 8 * 4 * 64; u += gsz) {
    const int lane = u & 63, s2 = (u >> 6) & 3, kt = (u >> 8) & 7, lp = u >> 11;
    const float* kr = p.sub_keys + ((size_t)lp * 128 + kt * 16 + (lane & 15)) * 128;
    float v[8];
#pragma unroll
    for (int j = 0; j < 8; ++j) v[j] = kr[16 * (2 * s2 + (j >> 2)) + 4 * (lane >> 4) + (j & 3)];
    uint4 o;
    o.x = pack2bf(v[0], v[1]); o.y = pack2bf(v[2], v[3]); o.z = pack2bf(v[4], v[5]); o.w = pack2bf(v[6], v[7]);
    *(uint4*)(p.kf + (size_t)u * 8) = o;
  }
  {
    const int lane = tidx_ & 63;
    const int gw = (bidx_ * NTHREADS + tidx_) >> 6, nw = gsz >> 6;
    for (int row = gw; row < DEPTH * 16384 * 2; row += nw) {
      const int tbl = row & 1, er = row >> 1;
      const float* src = (tbl ? p.peer_v : p.peer_u) + (size_t)er * 1024 + lane * 16;
      float4 f[4];
#pragma unroll
      for (int i = 0; i < 4; ++i) f[i] = *(const float4*)(src + 4 * i);
      float m = 0.f;
#pragma unroll
      for (int i = 0; i < 4; ++i) m = fmaxf(m, fmaxf(fmaxf(fabsf(f[i].x), fabsf(f[i].y)), fmaxf(fabsf(f[i].z), fabsf(f[i].w))));
      m = wave_max(m);
      int k = 0;
      if (m > 0.f) {
        int e;
        const float fr = __builtin_frexpf(m, &e);
        k = ((fr <= 0.875f) ? 9 : 8) - e;
        k = k < -100 ? -100 : (k > 100 ? 100 : k);
      }
      const float sc = __builtin_ldexpf(1.0f, k);
      uint4 o;
      unsigned w[4];
#pragma unroll
      for (int i = 0; i < 4; ++i) {
        int pkd = 0;
        pkd = __builtin_amdgcn_cvt_pk_fp8_f32(f[i].x * sc, f[i].y * sc, pkd, false);
        pkd = __builtin_amdgcn_cvt_pk_fp8_f32(f[i].z * sc, f[i].w * sc, pkd, true);
        w[i] = (unsigned)pkd;
      }
      o.x = w[0]; o.y = w[1]; o.z = w[2]; o.w = w[3];
      *(uint4*)((tbl ? p.v8 : p.u8) + (size_t)er * 1024 + lane * 16) = o;
      if (lane == 0) ((float*)p.escale)[(size_t)er * 2 + tbl] = __builtin_ldexpf(1.0f, -k);
    }
  }
  for (int u = gtid; u < SEQ * 32; u += gsz) {
    const int i = u & 31, pos = u >> 5;
    float inv = 1.0f / powf(10000.0f, (float)i / 31.0f);
    float ang = (float)pos * inv;
    double rev = (double)ang * 0.15915494309189535;
    rev -= floor(rev);
    float rf = (float)rev;
    p.rope[u] = make_float2(__builtin_amdgcn_cosf(rf), __builtin_amdgcn_sinf(rf));
  }
}

template <int NT, int PD = 3, bool XPF = false>
__device__ __forceinline__ void tl_gemm_chunk(const bf16_t* __restrict__ wf, const int KS, const char* xt, const int kbyte0,
                                              f32x4 (&acc)[NT][4], const int lane, const int nt0 = 0) {
  const bf16x8* wp = (const bf16x8*)wf + lane + nt0 * 64;
  const char* xp = xt + (lane & 15) * LDXB + kbyte0 + (lane >> 4) * 16;
  bf16x8 wb[4][NT];
#pragma unroll
  for (int s = 0; s < PD; ++s)
#pragma unroll
    for (int nt = 0; nt < NT; ++nt) wb[s][nt] = wp[(s * 4 + nt) * 64];
  bf16x8 xn[4];
  if (XPF) {
#pragma unroll
    for (int mt = 0; mt < 4; ++mt) xn[mt] = *(const bf16x8*)(xp + mt * 16 * LDXB);
  }
  for (int ks = 0; ks < KS; ks += 4) {
#pragma unroll
    for (int u = 0; u < 4; ++u) {
      int kpre = ks + u + PD;
      kpre = kpre < KS ? kpre : KS - 1;
#pragma unroll
      for (int nt = 0; nt < NT; ++nt) wb[(u + PD) & 3][nt] = wp[(kpre * 4 + nt) * 64];
      bf16x8 xf[4];
      if (XPF) {
        int kx = ks + u + 1;
        kx = kx < KS ? kx : KS - 1;
#pragma unroll
        for (int mt = 0; mt < 4; ++mt) { xf[mt] = xn[mt]; xn[mt] = *(const bf16x8*)(xp + mt * 16 * LDXB + kx * 64); }
      } else {
#pragma unroll
        for (int mt = 0; mt < 4; ++mt) xf[mt] = *(const bf16x8*)(xp + mt * 16 * LDXB + (ks + u) * 64);
      }
#pragma unroll
      for (int nt = 0; nt < NT; ++nt)
#pragma unroll
        for (int mt = 0; mt < 4; ++mt)
          acc[nt][mt] = __builtin_amdgcn_mfma_f32_16x16x32_bf16(wb[u][nt], xf[mt], acc[nt][mt], 0, 0, 0);
    }
  }
}

__device__ __forceinline__ void tile_rmsnorm_to_lds(const float* __restrict__ xsrc, const float* __restrict__ g, int t0,
                                                    char* xt, int wave, int lane) {
#pragma unroll 2
  for (int i = 0; i < 8; ++i) {
    const int tok = wave * 8 + i;
    const float* xr = xsrc + (size_t)(t0 + tok) * D_MODEL;
    float4 v[4];
    float ss = 0.f;
#pragma unroll
    for (int q = 0; q < 4; ++q) {
      v[q] = *(const float4*)(xr + q * 256 + lane * 4);
      ss += v[q].x * v[q].x + v[q].y * v[q].y + v[q].z * v[q].z + v[q].w * v[q].w;
    }
    ss = wave_sum(ss);
    const float r = rsqrtf(ss * (1.0f / D_MODEL) + EPS);
#pragma unroll
    for (int q = 0; q < 4; ++q) {
      float4 gg = *(const float4*)(g + q * 256 + lane * 4);
      uint2 o;
      o.x = pack2bf(v[q].x * r * gg.x, v[q].y * r * gg.y);
      o.y = pack2bf(v[q].z * r * gg.z, v[q].w * r * gg.w);
      *(uint2*)(xt + tok * LDXB + (q * 256 + lane * 4) * 2) = o;
    }
  }
}

__device__ __forceinline__ void o_p1(const int wv_, const Params& p, int l, const float* __restrict__ xsrc, char* smem) {
  const int tidx_ = opaque_tid(wv_); const int bidx_ = opaque_bid();
  const int wave = tidx_ >> 6, lane = tidx_ & 63;
  const bf16_t* wf = p.wf_in + (size_t)l * D_MODEL * IN_WIDTH;
  const float* g = p.norm_mix + l * D_MODEL;
  for (int tile = bidx_; tile < NTOK / 64; tile += gridDim.x) {
    const int t0 = tile * 64;
    __syncthreads();
    tile_rmsnorm_to_lds(xsrc, g, t0, smem, wave, lane);
    __syncthreads();
#pragma unroll 1
    for (int c = wave; c < IN_WIDTH / 64; c += 8) {
      f32x4 acc[4][4];
#pragma unroll
      for (int a = 0; a < 4; ++a)
#pragma unroll
        for (int b = 0; b < 4; ++b) acc[a][b] = (f32x4){0.f, 0.f, 0.f, 0.f};
      tl_gemm_chunk<4>(wf + (size_t)c * 32 * 4 * 64 * 8, 32, smem, 0, acc, lane);
      asm volatile("" ::: "memory");
      if (c >= 4 && c < 12) {
        const float sc = (c >= 8) ? 0.125f : 1.0f;
#pragma unroll
        for (int mt = 0; mt < 4; ++mt) {
          const int tok = t0 + mt * 16 + (lane & 15);
          const int pos = tok & (SEQ - 1);
#pragma unroll
          for (int nt = 0; nt < 2; ++nt) {
            const int i0 = nt * 16 + 4 * (lane >> 4);
            const float4 cs01 = *(const float4*)(p.rope + pos * 32 + i0);
            const float4 cs23 = *(const float4*)(p.rope + pos * 32 + i0 + 2);
            const float cc[4] = {cs01.x, cs01.z, cs23.x, cs23.z};
            const float sn[4] = {cs01.y, cs01.w, cs23.y, cs23.w};
#pragma unroll
            for (int r = 0; r < 4; ++r) {
              const float x1 = acc[nt][mt][r], x2 = acc[nt + 2][mt][r];
              acc[nt][mt][r] = (x1 * cc[r] - x2 * sn[r]) * sc;
              acc[nt + 2][mt][r] = (x1 * sn[r] + x2 * cc[r]) * sc;
            }
          }
        }
      } else if (c >= 28 && c < 32) {
#pragma unroll
        for (int a = 0; a < 4; ++a)
#pragma unroll
          for (int b = 0; b < 4; ++b) acc[a][b] *= 0.125f;
      } else if (c >= 40) {
#pragma unroll
        for (int a = 0; a < 4; ++a)
#pragma unroll
          for (int b = 0; b < 4; ++b)
#pragma unroll
            for (int r = 0; r < 4; ++r) acc[a][b][r] = 1.0f / (1.0f + __expf(-acc[a][b][r]));
      }
#pragma unroll
      for (int mt = 0; mt < 4; ++mt) {
        const int tok = t0 + mt * 16 + (lane & 15);
        bf16_t* dst = p.proj + (size_t)tok * IN_WIDTH + c * 64 + 4 * (lane >> 4);
#pragma unroll
        for (int nt = 0; nt < 4; ++nt) {
          uint2 o;
          o.x = pack2bf(acc[nt][mt][0], acc[nt][mt][1]);
          o.y = pack2bf(acc[nt][mt][2], acc[nt][mt][3]);
          *(uint2*)(dst + nt * 16) = o;
        }
      }
    }
  }
}


__device__ __forceinline__ void tile_load_to_lds(const bf16_t* __restrict__ src, int ld, char* xt, int tid) {
#pragma unroll 4
  for (int it = 0; it < 16; ++it) {
    const int idx = it * NTHREADS + tid;
    const int row = idx >> 7, u = idx & 127;
    const uint4 v = *(const uint4*)(src + (size_t)row * ld + u * 8);
    *(uint4*)(xt + row * LDXB + u * 16) = v;
  }
}

__device__ __forceinline__ void o_p5a1_tile(const Params& p, int l, int t0, char* smem, int tid) {
  const int wave = tid >> 6, lane = tid & 63;
  __syncthreads();
  tile_load_to_lds(p.ycat + (size_t)t0 * 1024, 1024, smem, tid);
  __syncthreads();
  const bf16_t* wfb = p.wf_br + (size_t)l * 1024 * 1024;
#pragma unroll 1
  for (int hc = wave; hc < 32; hc += 8) {
    const int c = hc >> 1, nt0 = (hc & 1) * 2;
    f32x4 m[2][4];
#pragma unroll
    for (int a = 0; a < 2; ++a)
#pragma unroll
      for (int b = 0; b < 4; ++b) m[a][b] = (f32x4){0.f, 0.f, 0.f, 0.f};
#pragma unroll 1
    for (int br = 0; br < 3; ++br) {
      const int koff = (br == 0) ? 0 : (br == 1 ? 256 : 768);
      const int KS = (br == 1) ? 16 : 8;
      f32x4 acc[2][4];
#pragma unroll
      for (int a = 0; a < 2; ++a)
#pragma unroll
        for (int b = 0; b < 4; ++b) acc[a][b] = (f32x4){0.f, 0.f, 0.f, 0.f};
      tl_gemm_chunk<2>(wfb + (size_t)koff * 1024 + (size_t)c * KS * 4 * 64 * 8, KS, smem, koff * 2, acc, lane, nt0);
      asm volatile("" ::: "memory");
#pragma unroll
      for (int mt = 0; mt < 4; ++mt) {
        const int tok = t0 + mt * 16 + (lane & 15);
        const bf16_t* gp = p.proj + (size_t)tok * IN_WIDTH + C_GATE + br * 1024 + c * 64 + nt0 * 16 + 4 * (lane >> 4);
#pragma unroll
        for (int nt = 0; nt < 2; ++nt) {
          const uint2 gv = *(const uint2*)(gp + nt * 16);
          m[nt][mt][0] += __uint_as_float(gv.x << 16) * acc[nt][mt][0];
          m[nt][mt][1] += __uint_as_float(gv.x & 0xffff0000u) * acc[nt][mt][1];
          m[nt][mt][2] += __uint_as_float(gv.y << 16) * acc[nt][mt][2];
          m[nt][mt][3] += __uint_as_float(gv.y & 0xffff0000u) * acc[nt][mt][3];
        }
      }
    }
#pragma unroll
    for (int mt = 0; mt < 4; ++mt) {
      const int tok = t0 + mt * 16 + (lane & 15);
      bf16_t* dst = p.mrg + (size_t)tok * 1024 + c * 64 + nt0 * 16 + 4 * (lane >> 4);
#pragma unroll
      for (int nt = 0; nt < 2; ++nt) {
        uint2 o;
        o.x = pack2bf(m[nt][mt][0], m[nt][mt][1]);
        o.y = pack2bf(m[nt][mt][2], m[nt][mt][3]);
        *(uint2*)(dst + nt * 16) = o;
      }
    }
  }
}
__device__ __forceinline__ void o_p5a2_tile(const Params& p, int l, const float* __restrict__ xcur, int t0, char* smem, int tid) {
  const int wave = tid >> 6, lane = tid & 63;
  __syncthreads();
  tile_load_to_lds(p.mrg + (size_t)t0 * 1024, 1024, smem, tid);
  __syncthreads();
  const bf16_t* wfo = p.wf_out + (size_t)l * 1024 * 1024;
#pragma unroll 1
  for (int c = wave; c < 16; c += 8) {
    f32x4 acc[4][4];
#pragma unroll
    for (int a = 0; a < 4; ++a)
#pragma unroll
      for (int b = 0; b < 4; ++b) acc[a][b] = (f32x4){0.f, 0.f, 0.f, 0.f};
    tl_gemm_chunk<4, 2>(wfo + (size_t)c * 32 * 4 * 64 * 8, 32, smem, 0, acc, lane);
    asm volatile("" ::: "memory");
#pragma unroll
    for (int mt = 0; mt < 4; ++mt) {
      const int tok = t0 + mt * 16 + (lane & 15);
      const size_t o = (size_t)tok * 1024 + c * 64 + 4 * (lane >> 4);
#pragma unroll
      for (int nt = 0; nt < 4; ++nt) {
        float4 xv = *(const float4*)(xcur + o + nt * 16);
        xv.x += acc[nt][mt][0]; xv.y += acc[nt][mt][1]; xv.z += acc[nt][mt][2]; xv.w += acc[nt][mt][3];
        *(float4*)(p.xres + o + nt * 16) = xv;
      }
    }
  }
}
__device__ __forceinline__ void o_p5a3_tile(const Params& p, int l, int t0, char* smem, int tid) {
  const int wave = tid >> 6, lane = tid & 63;
  __syncthreads();
  tile_rmsnorm_to_lds(p.xres, p.norm_ffn + l * D_MODEL, t0, smem, wave, lane);
  __syncthreads();
}


__device__ __forceinline__ unsigned mono_f(float f) {
  unsigned u = __float_as_uint(f);
  return (u & 0x80000000u) ? ~u : (u | 0x80000000u);
}
__device__ __forceinline__ float unmono_f(unsigned m) {
  return __uint_as_float((m & 0x80000000u) ? (m & 0x7fffffffu) : ~m);
}
#define CE_DESC(x, y) { const unsigned hi_ = max(x, y); const unsigned lo_ = min(x, y); x = hi_; y = lo_; }
#define CE_ASC(x, y) { const unsigned hi_ = max(x, y); const unsigned lo_ = min(x, y); x = lo_; y = hi_; }
__device__ __forceinline__ void sort16_desc(unsigned (&a)[16]) {
#pragma unroll
  for (int k = 2; k <= 16; k <<= 1) {
#pragma unroll
    for (int j = k >> 1; j > 0; j >>= 1) {
#pragma unroll
      for (int i = 0; i < 16; ++i) {
        const int l = i ^ j;
        if (l > i) {
          if ((i & k) == 0) CE_DESC(a[i], a[l]) else CE_ASC(a[i], a[l])
        }
      }
    }
  }
}
__device__ __forceinline__ void bitonic_merge16_desc(unsigned (&a)[16]) {
#pragma unroll
  for (int j = 8; j > 0; j >>= 1) {
#pragma unroll
    for (int i = 0; i < 16; ++i) {
      const int l = i ^ j;
      if (l > i) CE_DESC(a[i], a[l])
    }
  }
}
__device__ __forceinline__ void xlane_merge16(unsigned (&a)[16], int mask) {
  unsigned b[16];
#pragma unroll
  for (int i = 0; i < 16; ++i) b[i] = (unsigned)__shfl_xor((int)a[i], mask, 64);
#pragma unroll
  for (int i = 0; i < 16; ++i) a[i] = max(a[i], b[15 - i]);
  bitonic_merge16_desc(a);
}

__device__ __forceinline__ void o_peer_select_tile(const Params& p, int l, int t0, char* smem, int tid) {
  const int h = __builtin_amdgcn_readfirstlane(tid >> 6), lane = tid & 63;
  const int g = lane >> 4, tl = lane & 15;
  const bf16_t* wfq = p.wf_q + (size_t)l * 1024 * 2048;
#pragma unroll 1
  for (int pp = 0; pp < 2; ++pp) {
    bf16x8 qf[4][4];
#pragma unroll 1
    for (int cc = 0; cc < 2; ++cc) {
      const int c = (h * 2 + pp) * 2 + cc;
      f32x4 acc[4][4];
#pragma unroll
      for (int a = 0; a < 4; ++a)
#pragma unroll
        for (int b = 0; b < 4; ++b) acc[a][b] = (f32x4){0.f, 0.f, 0.f, 0.f};
      tl_gemm_chunk<4, 2, false>(wfq + (size_t)c * 32 * 4 * 64 * 8, 32, smem, 0, acc, lane);
#pragma unroll
      for (int sl = 0; sl < 2; ++sl)
#pragma unroll
        for (int mt = 0; mt < 4; ++mt) {
          union { bf16x8 v; unsigned u[4]; } cv;
          cv.u[0] = pack2bf(acc[2 * sl][mt][0], acc[2 * sl][mt][1]);
          cv.u[1] = pack2bf(acc[2 * sl][mt][2], acc[2 * sl][mt][3]);
          cv.u[2] = pack2bf(acc[2 * sl + 1][mt][0], acc[2 * sl + 1][mt][1]);
          cv.u[3] = pack2bf(acc[2 * sl + 1][mt][2], acc[2 * sl + 1][mt][3]);
          if (cc == 0) qf[sl][mt] = cv.v; else qf[2 + sl][mt] = cv.v;
        }
    }
    const bf16x8* kfp = (const bf16x8*)p.kf + (size_t)((l * 2 + pp) * 8) * 4 * 64 + lane;
#pragma unroll
    for (int mt = 0; mt < 4; ++mt) {
      f32x4 sc[8];
#pragma unroll
      for (int kt = 0; kt < 8; ++kt) sc[kt] = (f32x4){0.f, 0.f, 0.f, 0.f};
#pragma unroll
      for (int s2 = 0; s2 < 4; ++s2) {
        bf16x8 qv;
        qv = qf[s2][mt];
#pragma unroll
        for (int kt = 0; kt < 8; ++kt)
          sc[kt] = __builtin_amdgcn_mfma_f32_16x16x32_bf16(kfp[(kt * 4 + s2) * 64], qv, sc[kt], 0, 0, 0);
        __builtin_amdgcn_sched_barrier(0);
      }
      unsigned A[16], B[16];
#pragma unroll
      for (int kt = 0; kt < 4; ++kt)
#pragma unroll
        for (int r = 0; r < 4; ++r) {
          A[kt * 4 + r] = (mono_f(sc[kt][r]) & ~127u) | (unsigned)(127 - (kt * 16 + r) - 4 * g);
          B[kt * 4 + r] = (mono_f(sc[kt + 4][r]) & ~127u) | (unsigned)(127 - ((kt + 4) * 16 + r) - 4 * g);
        }
      sort16_desc(A);
      sort16_desc(B);
#pragma unroll
      for (int i = 0; i < 16; ++i) A[i] = max(A[i], B[15 - i]);
      bitonic_merge16_desc(A);
      xlane_merge16(A, 16);
      xlane_merge16(A, 32);
      if (g == 0) {
        uint4* dst = (uint4*)(p.tklist + ((size_t)((t0 + mt * 16 + tl) * 8 + h) * 2 + pp) * 16);
        dst[0] = make_uint4(A[0], A[1], A[2], A[3]);
        dst[1] = make_uint4(A[4], A[5], A[6], A[7]);
        dst[2] = make_uint4(A[8], A[9], A[10], A[11]);
        dst[3] = make_uint4(A[12], A[13], A[14], A[15]);
      }
    }
  }
  asm volatile("s_waitcnt vmcnt(0)" ::: "memory");
}

__device__ __forceinline__ void o_peer_select2_tile(const Params& p, int l, int t0, int tid) {
  const int h = __builtin_amdgcn_readfirstlane(tid >> 6), lane = tid & 63;
  const int g = lane >> 4, tl = lane & 15;
#pragma unroll 1
  for (int mt = 0; mt < 4; ++mt) {
    const int tok = t0 + mt * 16 + tl;
    const unsigned* lp = p.tklist + ((size_t)(tok * 8 + h) * 2) * 16;
    float v1[16], v2[16];
    {
      const uint4* q4 = (const uint4*)lp;
#pragma unroll
      for (int i = 0; i < 4; ++i) {
        uint4 x = q4[i], y = q4[4 + i];
        v1[4 * i + 0] = unmono_f(x.x & ~127u); v1[4 * i + 1] = unmono_f(x.y & ~127u);
        v1[4 * i + 2] = unmono_f(x.z & ~127u); v1[4 * i + 3] = unmono_f(x.w & ~127u);
        v2[4 * i + 0] = unmono_f(y.x & ~127u); v2[4 * i + 1] = unmono_f(y.y & ~127u);
        v2[4 * i + 2] = unmono_f(y.z & ~127u); v2[4 * i + 3] = unmono_f(y.w & ~127u);
      }
    }
    unsigned C[16];
#pragma unroll
    for (int i = 0; i < 16; ++i) C[i] = 0u;
    {
      int idx = 0;
#pragma unroll
      for (int a = 0; a < 16; ++a) {
#pragma unroll
        for (int b = 0; b < 16; ++b) {
          if ((a + 1) * (b + 1) <= 16) {
            const unsigned key = (mono_f(v1[a] + v2[b]) & ~255u) | (unsigned)(255 - (a * 16 + b));
            const int slot = idx >> 2, who = idx & 3;
            C[slot] = (g == who) ? key : C[slot];
            ++idx;
          }
        }
      }
    }
    sort16_desc(C);
    xlane_merge16(C, 16);
    xlane_merge16(C, 32);
    const float f0 = unmono_f(C[0] & ~255u);
    float den = 0.f;
    float ev[16];
#pragma unroll
    for (int i = 0; i < 16; ++i) { ev[i] = __expf(unmono_f(C[i] & ~255u) - f0); den += ev[i]; }
    const float rden = 1.0f / den;
    int eidx[4]; float egate[4];
#pragma unroll
    for (int i = 0; i < 4; ++i) {
      const unsigned k = (g == 0) ? C[i] : (g == 1) ? C[4 + i] : (g == 2) ? C[8 + i] : C[12 + i];
      const float e = (g == 0) ? ev[i] : (g == 1) ? ev[4 + i] : (g == 2) ? ev[8 + i] : ev[12 + i];
      const int pos = 255 - (int)(k & 255u);
      const int a = pos >> 4, b = pos & 15;
      const int n1 = 127 - (int)(lp[a] & 127u);
      const int n2 = 127 - (int)(lp[16 + b] & 127u);
      eidx[i] = n1 * 128 + n2;
      egate[i] = e * rden;
    }
    *(int4*)(p.pidx + (size_t)tok * 128 + h * 16 + 4 * g) = make_int4(eidx[0], eidx[1], eidx[2], eidx[3]);
    *(float4*)(p.pgate + (size_t)tok * 128 + h * 16 + 4 * g) = make_float4(egate[0], egate[1], egate[2], egate[3]);
  }
}

__device__ __forceinline__ void o_peer_experts_tile(const Params& p, int l, int t0, const char* smem, int tid) {
  const int wave = tid >> 6, lane = tid & 63;
  const bf16_t* U = p.u16 + (size_t)l * 16384 * 1024;
  const bf16_t* V = p.v16 + (size_t)l * 16384 * 1024;
  int vz = 0;
  asm volatile("" : "+v"(vz));
#pragma unroll 1
  for (int i8 = 0; i8 < 8; ++i8) {
    const int tl = wave * 8 + i8;
    const int tok = t0 + tl;
    float hv[16], acc[16];
    {
      const uint4 h0 = *(const uint4*)(smem + tl * LDXB + lane * 16);
      const uint4 h1 = *(const uint4*)(smem + tl * LDXB + 1024 + lane * 16);
      const unsigned hw[8] = {h0.x, h0.y, h0.z, h0.w, h1.x, h1.y, h1.z, h1.w};
#pragma unroll
      for (int j = 0; j < 8; ++j) {
        hv[2 * j] = __uint_as_float(hw[j] << 16);
        hv[2 * j + 1] = __uint_as_float(hw[j] & 0xffff0000u);
        acc[2 * j] = 0.f; acc[2 * j + 1] = 0.f;
      }
    }
    const int* ip = p.pidx + (size_t)tok * 128 + vz;
    const float* gp = p.pgate + (size_t)tok * 128 + vz;
#pragma unroll 1
    for (int k = 0; k < 128; k += 4) {
      const int4 e4 = *(const int4*)(ip + k);
      const float4 g4 = *(const float4*)(gp + k);
      const int ee[4] = {e4.x, e4.y, e4.z, e4.w};
      const float gg[4] = {g4.x, g4.y, g4.z, g4.w};
      uint4 ur[4][2];
#pragma unroll
      for (int q = 0; q < 4; ++q) {
        const char* up = (const char*)(U + (size_t)ee[q] * 1024) + lane * 16;
        ur[q][0] = *(const uint4*)up;
        ur[q][1] = *(const uint4*)(up + 1024);
      }
      uint4 vr[4][2];
#pragma unroll
      for (int q = 0; q < 4; ++q) {
        const char* vp = (const char*)(V + (size_t)ee[q] * 1024) + lane * 16;
        vr[q][0] = *(const uint4*)vp;
        vr[q][1] = *(const uint4*)(vp + 1024);
      }
      float hh[4];
#pragma unroll
      for (int q = 0; q < 4; ++q) {
        const unsigned uw[8] = {ur[q][0].x, ur[q][0].y, ur[q][0].z, ur[q][0].w, ur[q][1].x, ur[q][1].y, ur[q][1].z, ur[q][1].w};
        float a = 0.f;
#pragma unroll
        for (int j = 0; j < 8; ++j) {
          a = fmaf(hv[2 * j], __uint_as_float(uw[j] << 16), a);
          a = fmaf(hv[2 * j + 1], __uint_as_float(uw[j] & 0xffff0000u), a);
        }
        a = wave_sum(a);
        hh[q] = 0.5f * a * (1.0f + erff(a * 0.70710678118654752f)) * gg[q];
      }
#pragma unroll
      for (int q = 0; q < 4; ++q) {
        const unsigned vw[8] = {vr[q][0].x, vr[q][0].y, vr[q][0].z, vr[q][0].w, vr[q][1].x, vr[q][1].y, vr[q][1].z, vr[q][1].w};
#pragma unroll
        for (int j = 0; j < 8; ++j) {
          acc[2 * j] = fmaf(hh[q], __uint_as_float(vw[j] << 16), acc[2 * j]);
          acc[2 * j + 1] = fmaf(hh[q], __uint_as_float(vw[j] & 0xffff0000u), acc[2 * j + 1]);
        }
      }
    }
    float* xr = p.xres + (size_t)tok * 1024 + lane * 8;
#pragma unroll
    for (int i = 0; i < 2; ++i) {
      float4 a0 = *(float4*)(xr + i * 512), a1 = *(float4*)(xr + i * 512 + 4);
      a0.x += acc[8 * i + 0]; a0.y += acc[8 * i + 1]; a0.z += acc[8 * i + 2]; a0.w += acc[8 * i + 3];
      a1.x += acc[8 * i + 4]; a1.y += acc[8 * i + 5]; a1.z += acc[8 * i + 6]; a1.w += acc[8 * i + 7];
      *(float4*)(xr + i * 512) = a0;
      *(float4*)(xr + i * 512 + 4) = a1;
    }
  }
}


__device__ __forceinline__ float logsigmoid_(float x) { return fminf(x, 0.f) - log1pf(expf(-fabsf(x))); }
__device__ __forceinline__ float bf_lo(unsigned w) { return __uint_as_float(w << 16); }
__device__ __forceinline__ float bf_hi(unsigned w) { return __uint_as_float(w & 0xffff0000u); }

#define RKV_LD 136
__device__ __forceinline__ void o_ret_kv_task(const Params& p, int l, int task, char* smem, int tid) {
  const int wave = tid >> 6, lane = tid & 63, g = lane >> 4, tl = lane & 15;
  const int bh = task >> 5, n = task & 31, b = bh >> 2, h = bh & 3;
  const int tok0 = b * SEQ + n * 128;
  const float lgf = logsigmoid_(p.ret_decay[l * 8 + h]), lgb = logsigmoid_(p.ret_decay[l * 8 + 4 + h]);
  bf16_t* KTf = (bf16_t*)smem;
  bf16_t* KTb = KTf + 64 * RKV_LD;
  bf16_t* VT = KTb + 64 * RKV_LD;
  __syncthreads();
#pragma unroll
  for (int it = 0; it < 2; ++it) {
    const int u = tid + it * NTHREADS;
    const int j = u >> 3, d0 = (u & 7) * 8;
    const uint4 kv = *(const uint4*)(p.proj + (size_t)(tok0 + j) * IN_WIDTH + C_RK + h * 64 + d0);
    const float wf = __expf(lgf * (float)(127 - j)), wb = __expf(lgb * (float)(j + 1));
    const unsigned kw[4] = {kv.x, kv.y, kv.z, kv.w};
#pragma unroll
    for (int e = 0; e < 4; ++e) {
      const float x0 = bf_lo(kw[e]), x1 = bf_hi(kw[e]);
      KTf[(d0 + 2 * e) * RKV_LD + j] = f2bf(x0 * wf);
      KTf[(d0 + 2 * e + 1) * RKV_LD + j] = f2bf(x1 * wf);
      KTb[(d0 + 2 * e) * RKV_LD + j] = f2bf(x0 * wb);
      KTb[(d0 + 2 * e + 1) * RKV_LD + j] = f2bf(x1 * wb);
    }
  }
#pragma unroll
  for (int it = 0; it < 4; ++it) {
    const int u = tid + it * NTHREADS;
    const int j = u >> 4, e0 = (u & 15) * 8;
    const uint4 vv = *(const uint4*)(p.proj + (size_t)(tok0 + j) * IN_WIDTH + C_RV + h * 128 + e0);
    const unsigned vw[4] = {vv.x, vv.y, vv.z, vv.w};
#pragma unroll
    for (int e = 0; e < 4; ++e) {
      VT[(e0 + 2 * e) * RKV_LD + j] = (bf16_t)(vw[e] & 0xffffu);
      VT[(e0 + 2 * e + 1) * RKV_LD + j] = (bf16_t)(vw[e] >> 16);
    }
  }
  __syncthreads();
  bf16x8 a[4];
#pragma unroll
  for (int ks = 0; ks < 4; ++ks) a[ks] = *(const bf16x8*)(VT + (wave * 16 + tl) * RKV_LD + ks * 32 + 8 * g);
#pragma unroll
  for (int dir = 0; dir < 2; ++dir) {
    const bf16_t* KT = dir ? KTb : KTf;
#pragma unroll
    for (int dt = 0; dt < 4; ++dt) {
      f32x4 acc = (f32x4){0.f, 0.f, 0.f, 0.f};
#pragma unroll
      for (int ks = 0; ks < 4; ++ks) {
        const bf16x8 bb = *(const bf16x8*)(KT + (dt * 16 + tl) * RKV_LD + ks * 32 + 8 * g);
        acc = __builtin_amdgcn_mfma_f32_16x16x32_bf16(a[ks], bb, acc, 0, 0, 0);
      }
      float* dst = p.kvst + ((size_t)(task * 2 + dir) * 128 + wave * 16 + 4 * g) * 64 + dt * 16 + tl;
#pragma unroll
      for (int r = 0; r < 4; ++r) dst[r * 64] = acc[r];
    }
  }
}

__device__ __forceinline__ void o_ret_scan(const int wv_, const Params& p, int l) {
  const int tidx_ = opaque_tid(wv_); const int bidx_ = opaque_bid();
  const int gsz = gridDim.x * NTHREADS;
  for (int u = bidx_ * NTHREADS + tidx_; u < 16 * 2 * 128 * 16; u += gsz) {
    const int dq = u & 15, e = (u >> 4) & 127, dir = (u >> 11) & 1, bh = u >> 12, h = bh & 3;
    const float lg = logsigmoid_(p.ret_decay[l * 8 + dir * 4 + h]);
    const float gC = __expf(lg * 128.0f);
    float4 st = make_float4(0.f, 0.f, 0.f, 0.f);
#pragma unroll 8
    for (int nn = 0; nn < 32; ++nn) {
      const int n = dir ? (31 - nn) : nn;
      const size_t idx = ((size_t)((bh * 32 + n) * 2 + dir) * 128 + e) * 64 + dq * 4;
      const float4 kv = *(const float4*)(p.kvst + idx);
      uint2 o;
      o.x = pack2bf(st.x, st.y); o.y = pack2bf(st.z, st.w);
      *(uint2*)(p.rstate + idx) = o;
      st.x = fmaf(st.x, gC, kv.x); st.y = fmaf(st.y, gC, kv.y); st.z = fmaf(st.z, gC, kv.z); st.w = fmaf(st.w, gC, kv.w);
    }
  }
}

#define RO_LD 264
#define RK_LD 72
__device__ __forceinline__ void o_ret_out_task(const Params& p, int l, int task, char* smem, int tid) {
  const int wave = tid >> 6, lane = tid & 63, g = lane >> 4, tl = lane & 15;
  const int bh = task >> 5, n = task & 31, b = bh >> 2, h = bh & 3;
  const int tok0 = b * SEQ + n * 128;
  const float lgf = logsigmoid_(p.ret_decay[l * 8 + h]), lgb = logsigmoid_(p.ret_decay[l * 8 + 4 + h]);
  bf16_t* Acat = (bf16_t*)smem;
  bf16_t* Bcat = Acat + 128 * RO_LD;
  bf16_t* Kl = Bcat + 128 * RO_LD;
  __syncthreads();
#pragma unroll
  for (int it = 0; it < 2; ++it) {
    const int u = tid + it * NTHREADS;
    const int i = u >> 3, d0 = (u & 7) * 8;
    const size_t row = (size_t)(tok0 + i) * IN_WIDTH;
    const uint4 qv = *(const uint4*)(p.proj + row + C_RQ + h * 64 + d0);
    const uint4 kv = *(const uint4*)(p.proj + row + C_RK + h * 64 + d0);
    *(uint4*)(Acat + i * RO_LD + d0) = qv;
    *(uint4*)(Kl + i * RK_LD + d0) = kv;
    const float wf = __expf(lgf * (float)(i + 1)), wb = __expf(lgb * (float)(127 - i));
    const unsigned qw[4] = {qv.x, qv.y, qv.z, qv.w};
    uint4 of, ob;
    of.x = pack2bf(bf_lo(qw[0]) * wf, bf_hi(qw[0]) * wf); ob.x = pack2bf(bf_lo(qw[0]) * wb, bf_hi(qw[0]) * wb);
    of.y = pack2bf(bf_lo(qw[1]) * wf, bf_hi(qw[1]) * wf); ob.y = pack2bf(bf_lo(qw[1]) * wb, bf_hi(qw[1]) * wb);
    of.z = pack2bf(bf_lo(qw[2]) * wf, bf_hi(qw[2]) * wf); ob.z = pack2bf(bf_lo(qw[2]) * wb, bf_hi(qw[2]) * wb);
    of.w = pack2bf(bf_lo(qw[3]) * wf, bf_hi(qw[3]) * wf); ob.w = pack2bf(bf_lo(qw[3]) * wb, bf_hi(qw[3]) * wb);
    *(uint4*)(Acat + i * RO_LD + 128 + d0) = of;
    *(uint4*)(Acat + i * RO_LD + 192 + d0) = ob;
  }
#pragma unroll
  for (int it = 0; it < 4; ++it) {
    const int u = tid + it * NTHREADS;
    const int j = u >> 4, e0 = (u & 15) * 8;
    const uint4 vv = *(const uint4*)(p.proj + (size_t)(tok0 + j) * IN_WIDTH + C_RV + h * 128 + e0);
    const unsigned vw[4] = {vv.x, vv.y, vv.z, vv.w};
#pragma unroll
    for (int e = 0; e < 4; ++e) {
      Bcat[(e0 + 2 * e) * RO_LD + j] = (bf16_t)(vw[e] & 0xffffu);
      Bcat[(e0 + 2 * e + 1) * RO_LD + j] = (bf16_t)(vw[e] >> 16);
    }
  }
#pragma unroll
  for (int it = 0; it < 4; ++it) {
    const int u = tid + it * NTHREADS;
    const int d0 = (u & 7) * 8, e = (u >> 3) & 127, dir = u >> 10;
    const uint4 sv = *(const uint4*)(p.rstate + ((size_t)(task * 2 + dir) * 128 + e) * 64 + d0);
    *(uint4*)(Bcat + e * RO_LD + 128 + dir * 64 + d0) = sv;
  }
  __syncthreads();
  f32x4 sc[8];
#pragma unroll
  for (int jt = 0; jt < 8; ++jt) sc[jt] = (f32x4){0.f, 0.f, 0.f, 0.f};
#pragma unroll
  for (int ks = 0; ks < 2; ++ks) {
    const bf16x8 qb = *(const bf16x8*)(Acat + (wave * 16 + tl) * RO_LD + ks * 32 + 8 * g);
#pragma unroll
    for (int jt = 0; jt < 8; ++jt) {
      const bf16x8 ka = *(const bf16x8*)(Kl + (jt * 16 + tl) * RK_LD + ks * 32 + 8 * g);
      sc[jt] = __builtin_amdgcn_mfma_f32_16x16x32_bf16(ka, qb, sc[jt], 0, 0, 0);
    }
  }
  {
    const int i = wave * 16 + tl;
#pragma unroll
    for (int jt = 0; jt < 8; ++jt) {
      float pv[4];
#pragma unroll
      for (int r = 0; r < 4; ++r) {
        const int j = jt * 16 + 4 * g + r;
        const float dd = (j <= i) ? __expf(lgf * (float)(i - j)) : __expf(lgb * (float)(j - i));
        pv[r] = sc[jt][r] * dd;
      }
      uint2 o;
      o.x = pack2bf(pv[0], pv[1]); o.y = pack2bf(pv[2], pv[3]);
      *(uint2*)(Acat + i * RO_LD + jt * 16 + 4 * g) = o;
    }
  }
  f32x4 y[8];
#pragma unroll
  for (int et = 0; et < 8; ++et) y[et] = (f32x4){0.f, 0.f, 0.f, 0.f};
#pragma unroll
  for (int ks = 0; ks < 8; ++ks) {
    const bf16x8 ab = *(const bf16x8*)(Acat + (wave * 16 + tl) * RO_LD + ks * 32 + 8 * g);
#pragma unroll
    for (int et = 0; et < 8; ++et) {
      const bf16x8 ba = *(const bf16x8*)(Bcat + (et * 16 + tl) * RO_LD + ks * 32 + 8 * g);
      y[et] = __builtin_amdgcn_mfma_f32_16x16x32_bf16(ba, ab, y[et], 0, 0, 0);
    }
  }
  float ss = 0.f;
#pragma unroll
  for (int et = 0; et < 8; ++et)
#pragma unroll
    for (int r = 0; r < 4; ++r) ss = fmaf(y[et][r], y[et][r], ss);
  ss += __shfl_xor(ss, 16, 64);
  ss += __shfl_xor(ss, 32, 64);
  const float rstd = rsqrtf(ss * (1.0f / 128.0f) + EPS);
  {
    const int tok = tok0 + wave * 16 + tl;
    const bf16_t* gp = p.proj + (size_t)tok * IN_WIDTH + C_RG + h * 128 + 4 * g;
    bf16_t* dst = p.ycat + (size_t)tok * 1024 + 256 + h * 128 + 4 * g;
#pragma unroll
    for (int et = 0; et < 8; ++et) {
      const uint2 gv = *(const uint2*)(gp + et * 16);
      const float g0 = bf_lo(gv.x), g1 = bf_hi(gv.x), g2 = bf_lo(gv.y), g3 = bf_hi(gv.y);
      uint2 o;
      o.x = pack2bf(g0 / (1.0f + __expf(-g0)) * y[et][0] * rstd, g1 / (1.0f + __expf(-g1)) * y[et][1] * rstd);
      o.y = pack2bf(g2 / (1.0f + __expf(-g2)) * y[et][2] * rstd, g3 / (1.0f + __expf(-g3)) * y[et][3] * rstd);
      *(uint2*)(dst + et * 16) = o;
    }
  }
}


#define NA_KLD 72
#define NA_VLD 520
__device__ __forceinline__ void o_na_task(const Params& p, int l, int task, char* smem, int tid) {
  const int wave = tid >> 6, lane = tid & 63, g = lane >> 4, tl = lane & 15;
  const int rr = task & 63, h = (task >> 6) & 3, b = task >> 8;
  int rs = rr - 4; rs = rs < 0 ? 0 : (rs > 56 ? 56 : rs);
  const int ktok0 = b * SEQ + rs * 64;
  const int qtok0 = b * SEQ + rr * 64;
  bf16_t* Kl = (bf16_t*)smem;
  bf16_t* VT = Kl + 512 * NA_KLD;
  bf16_t* Ql = VT + 64 * NA_VLD;
  float* rpbl = (float*)(Ql + 64 * NA_KLD);
  __syncthreads();
#pragma unroll
  for (int it = 0; it < 8; ++it) {
    const int u = tid + it * NTHREADS;
    const int key = u >> 3, d0 = (u & 7) * 8;
    const size_t row = (size_t)(ktok0 + key) * IN_WIDTH;
    const uint4 kv = *(const uint4*)(p.proj + row + C_NK + h * 64 + d0);
    const uint4 vv = *(const uint4*)(p.proj + row + C_NV + h * 64 + d0);
    *(uint4*)(Kl + key * NA_KLD + d0) = kv;
    const unsigned vw[4] = {vv.x, vv.y, vv.z, vv.w};
#pragma unroll
    for (int e = 0; e < 4; ++e) {
      VT[(d0 + 2 * e) * NA_VLD + key] = (bf16_t)(vw[e] & 0xffffu);
      VT[(d0 + 2 * e + 1) * NA_VLD + key] = (bf16_t)(vw[e] >> 16);
    }
  }
  {
    const int q = tid >> 3, d0 = (tid & 7) * 8;
    *(uint4*)(Ql + q * NA_KLD + d0) = *(const uint4*)(p.proj + (size_t)(qtok0 + q) * IN_WIDTH + C_NQ + h * 64 + d0);
    if (tid < 465) rpbl[tid] = p.na_rpb[((size_t)l * 4 + h) * 465 + tid];
  }
  __syncthreads();
  if (wave < 4) {
    const int qt = wave;
    int cw0 = 16 * qt - 8; cw0 = cw0 < 0 ? 0 : (cw0 > 32 ? 32 : cw0);
    f32x4 sc[16];
#pragma unroll
    for (int T = 0; T < 16; ++T) sc[T] = (f32x4){0.f, 0.f, 0.f, 0.f};
#pragma unroll
    for (int ks = 0; ks < 2; ++ks) {
      const bf16x8 qb = *(const bf16x8*)(Ql + (qt * 16 + tl) * NA_KLD + ks * 32 + 8 * g);
#pragma unroll
      for (int T = 0; T < 16; ++T) {
        const int key = (T >> 1) * 64 + cw0 + (T & 1) * 16 + tl;
        const bf16x8 ka = *(const bf16x8*)(Kl + key * NA_KLD + ks * 32 + 8 * g);
        sc[T] = __builtin_amdgcn_mfma_f32_16x16x32_bf16(ka, qb, sc[T], 0, 0, 0);
      }
    }
    const int cq = qt * 16 + tl;
    int cs = cq - 8; cs = cs < 0 ? 0 : (cs > 48 ? 48 : cs);
    float m = -3.0e38f;
#pragma unroll
    for (int T = 0; T < 16; ++T) {
      const int ri = T >> 1;
      const int di = rs + ri - rr + 7;
#pragma unroll
      for (int r = 0; r < 4; ++r) {
        const int ck = cw0 + (T & 1) * 16 + 4 * g + r;
        const bool valid = (ck >= cs) && (ck < cs + 16);
        int dj = ck - cq + 15; dj = dj < 0 ? 0 : (dj > 30 ? 30 : dj);
        const float sv = valid ? (sc[T][r] + rpbl[di * 31 + dj]) : -1.0e30f;
        sc[T][r] = sv;
        m = fmaxf(m, sv);
      }
    }
    m = fmaxf(m, __shfl_xor(m, 16, 64));
    m = fmaxf(m, __shfl_xor(m, 32, 64));
    float den = 0.f;
#pragma unroll
    for (int T = 0; T < 16; ++T)
#pragma unroll
      for (int r = 0; r < 4; ++r) {
        const float e = __expf(sc[T][r] - m);
        sc[T][r] = e;
        den += e;
      }
    den += __shfl_xor(den, 16, 64);
    den += __shfl_xor(den, 32, 64);
    const float rden = 1.0f / den;
    f32x4 o[4];
#pragma unroll
    for (int dt = 0; dt < 4; ++dt) o[dt] = (f32x4){0.f, 0.f, 0.f, 0.f};
#pragma unroll
    for (int ri = 0; ri < 8; ++ri) {
      union { bf16x8 v; unsigned u[4]; } pb;
      pb.u[0] = pack2bf(sc[2 * ri][0], sc[2 * ri][1]);
      pb.u[1] = pack2bf(sc[2 * ri][2], sc[2 * ri][3]);
      pb.u[2] = pack2bf(sc[2 * ri + 1][0], sc[2 * ri + 1][1]);
      pb.u[3] = pack2bf(sc[2 * ri + 1][2], sc[2 * ri + 1][3]);
#pragma unroll
      for (int dt = 0; dt < 4; ++dt) {
        const bf16_t* vp = VT + (dt * 16 + tl) * NA_VLD + ri * 64 + cw0 + 4 * g;
        union { bf16x8 v; uint2 h[2]; } va;
        va.h[0] = *(const uint2*)vp;
        va.h[1] = *(const uint2*)(vp + 16);
        o[dt] = __builtin_amdgcn_mfma_f32_16x16x32_bf16(va.v, pb.v, o[dt], 0, 0, 0);
      }
    }
    bf16_t* dst = p.ycat + (size_t)(qtok0 + qt * 16 + tl) * 1024 + 768 + h * 64 + 4 * g;
#pragma unroll
    for (int dt = 0; dt < 4; ++dt) {
      uint2 ov;
      ov.x = pack2bf(o[dt][0] * rden, o[dt][1] * rden);
      ov.y = pack2bf(o[dt][2] * rden, o[dt][3] * rden);
      *(uint2*)(dst + dt * 16) = ov;
    }
  }
}

#define PL_LD 264
__device__ __forceinline__ void o_pool_task(const Params& p, int l, int task, char* smem, int tid) {
  const int wave = tid >> 6, lane = tid & 63, g = lane >> 4, tl = lane & 15;
  const int t0 = task * 64, pos0 = t0 & (SEQ - 1);
  bf16_t* Xp = (bf16_t*)smem;
  bf16_t* WT = Xp + 80 * PL_LD;
  bf16_t* Df = WT + 4 * 64 * 72;
  __syncthreads();
#pragma unroll
  for (int it = 0; it < 5; ++it) {
    const int u = tid + it * NTHREADS;
    const int rw = u >> 5, c0 = (u & 31) * 8;
    const int pos = pos0 - 8 + rw;
    uint4 v = make_uint4(0u, 0u, 0u, 0u);
    if (pos >= 0 && pos < SEQ) v = *(const uint4*)(p.proj + (size_t)(t0 - 8 + rw) * IN_WIDTH + C_POOL + c0);
    *(uint4*)(Xp + rw * PL_LD + c0) = v;
  }
#pragma unroll
  for (int it = 0; it < 4; ++it) {
    const int u = tid + it * NTHREADS;
    const int e0 = (u & 7) * 8, c = (u >> 3) & 63, gi = u >> 9;
    const float* wp = p.pool_w + (((size_t)l * 4 + gi) * 64 + c) * 64 + e0;
    const float4 a = *(const float4*)wp, bq = *(const float4*)(wp + 4);
    const float wv[8] = {a.x, a.y, a.z, a.w, bq.x, bq.y, bq.z, bq.w};
#pragma unroll
    for (int k = 0; k < 8; ++k) WT[(gi * 64 + e0 + k) * 72 + c] = f2bf(wv[k]);
  }
  __syncthreads();
#pragma unroll 1
  for (int it = 0; it < 4; ++it) {
    const int u = tid + it * NTHREADS;
    const int t = u >> 5, c0 = (u & 31) * 8;
    const int gi = c0 >> 6;
    const int hw = 1 << gi;
    const int pos = pos0 + t;
    int a = pos - hw; a = a < 0 ? 0 : a;
    int bnd = pos + hw; bnd = bnd > SEQ ? SEQ : bnd;
    float sum[8];
#pragma unroll
    for (int k = 0; k < 8; ++k) sum[k] = 0.f;
    for (int rp = a; rp < bnd; ++rp) {
      const uint4 v = *(const uint4*)(Xp + (rp - pos0 + 8) * PL_LD + c0);
      sum[0] += bf_lo(v.x); sum[1] += bf_hi(v.x); sum[2] += bf_lo(v.y); sum[3] += bf_hi(v.y);
      sum[4] += bf_lo(v.z); sum[5] += bf_hi(v.z); sum[6] += bf_lo(v.w); sum[7] += bf_hi(v.w);
    }
    const float rc = 1.0f / (float)(bnd - a);
    const uint4 xv = *(const uint4*)(Xp + (t + 8) * PL_LD + c0);
    uint4 o;
    o.x = pack2bf(sum[0] * rc - bf_lo(xv.x), sum[1] * rc - bf_hi(xv.x));
    o.y = pack2bf(sum[2] * rc - bf_lo(xv.y), sum[3] * rc - bf_hi(xv.y));
    o.z = pack2bf(sum[4] * rc - bf_lo(xv.z), sum[5] * rc - bf_hi(xv.z));
    o.w = pack2bf(sum[6] * rc - bf_lo(xv.w), sum[7] * rc - bf_hi(xv.w));
    *(uint4*)(Df + t * PL_LD + c0) = o;
  }
  __syncthreads();
  {
    const int gi = wave >> 1, tt0 = (wave & 1) * 2;
    f32x4 acc[4][2];
#pragma unroll
    for (int et = 0; et < 4; ++et)
#pragma unroll
      for (int tt = 0; tt < 2; ++tt) acc[et][tt] = (f32x4){0.f, 0.f, 0.f, 0.f};
#pragma unroll
    for (int ks = 0; ks < 2; ++ks) {
      bf16x8 bx[2];
#pragma unroll
      for (int tt = 0; tt < 2; ++tt) bx[tt] = *(const bf16x8*)(Df + ((tt0 + tt) * 16 + tl) * PL_LD + gi * 64 + ks * 32 + 8 * g);
#pragma unroll
      for (int et = 0; et < 4; ++et) {
        const bf16x8 wa = *(const bf16x8*)(WT + (gi * 64 + et * 16 + tl) * 72 + ks * 32 + 8 * g);
#pragma unroll
        for (int tt = 0; tt < 2; ++tt) acc[et][tt] = __builtin_amdgcn_mfma_f32_16x16x32_bf16(wa, bx[tt], acc[et][tt], 0, 0, 0);
      }
    }
#pragma unroll
    for (int et = 0; et < 4; ++et) {
      const float4 sc4 = *(const float4*)(p.pool_scale + l * 256 + gi * 64 + et * 16 + 4 * g);
#pragma unroll
      for (int tt = 0; tt < 2; ++tt) {
        const int tok = t0 + (tt0 + tt) * 16 + tl;
        uint2 o;
        o.x = pack2bf(acc[et][tt][0] * sc4.x, acc[et][tt][1] * sc4.y);
        o.y = pack2bf(acc[et][tt][2] * sc4.z, acc[et][tt][3] * sc4.w);
        *(uint2*)(p.ycat + (size_t)tok * 1024 + gi * 64 + et * 16 + 4 * g) = o;
      }
    }
  }
}


typedef __attribute__((ext_vector_type(2))) __bf16 bf16x2_t;
__device__ __forceinline__ float dot2bf(unsigned a, unsigned b, float c) {
  return __builtin_amdgcn_fdot2_f32_bf16(__builtin_bit_cast(bf16x2_t, a), __builtin_bit_cast(bf16x2_t, b), c, false);
}
__device__ __forceinline__ float gelu_exact(float a) { return 0.5f * a * (1.0f + erff(a * 0.70710678118654752f)); }

struct PickPair { int eA, eB; float gA, gB; };

#define DPP_F(v, ctrl) __builtin_bit_cast(float, __builtin_amdgcn_update_dpp(0, __builtin_bit_cast(int, v), ctrl, 0xf, 0xf, false))
#define RDLANE_F(v, l) __builtin_bit_cast(float, __builtin_amdgcn_readlane(__builtin_bit_cast(int, v), l))
__device__ __forceinline__ float erf_as(float x) {
  const float ax = fabsf(x);
  const float t = __builtin_amdgcn_rcpf(fmaf(0.3275911f, ax, 1.0f));
  float y = fmaf(1.061405429f, t, -1.453152027f);
  y = fmaf(y, t, 1.421413741f);
  y = fmaf(y, t, -0.284496736f);
  y = fmaf(y, t, 0.254829592f);
  y = y * t * __expf(-ax * ax);
  return copysignf(1.0f - y, x);
}
__device__ __forceinline__ float gelu_fast_exact(float a) { return 0.5f * a * (1.0f + erf_as(a * 0.70710678118654752f)); }

__device__ __forceinline__ void experts_process2(const bf16_t* __restrict__ U, const bf16_t* __restrict__ V, const PickPair pk,
                                                 const unsigned (&hw)[8], float (&acc)[16], int lane) {
  const char* uA = (const char*)(U + (size_t)pk.eA * 1024) + lane * 16;
  const char* uB = (const char*)(U + (size_t)pk.eB * 1024) + lane * 16;
  const char* vA = (const char*)(V + (size_t)pk.eA * 1024) + lane * 16;
  const char* vB = (const char*)(V + (size_t)pk.eB * 1024) + lane * 16;
  const uint4 ua0 = *(const uint4*)uA, ua1 = *(const uint4*)(uA + 1024);
  const uint4 ub0 = *(const uint4*)uB, ub1 = *(const uint4*)(uB + 1024);
  const uint4 va0 = *(const uint4*)vA, va1 = *(const uint4*)(vA + 1024);
  const uint4 vb0 = *(const uint4*)vB, vb1 = *(const uint4*)(vB + 1024);
  float aA = 0.f, aB = 0.f;
  aA = dot2bf(ua0.x, hw[0], aA); aA = dot2bf(ua0.y, hw[1], aA); aA = dot2bf(ua0.z, hw[2], aA); aA = dot2bf(ua0.w, hw[3], aA);
  aA = dot2bf(ua1.x, hw[4], aA); aA = dot2bf(ua1.y, hw[5], aA); aA = dot2bf(ua1.z, hw[6], aA); aA = dot2bf(ua1.w, hw[7], aA);
  aB = dot2bf(ub0.x, hw[0], aB); aB = dot2bf(ub0.y, hw[1], aB); aB = dot2bf(ub0.z, hw[2], aB); aB = dot2bf(ub0.w, hw[3], aB);
  aB = dot2bf(ub1.x, hw[4], aB); aB = dot2bf(ub1.y, hw[5], aB); aB = dot2bf(ub1.z, hw[6], aB); aB = dot2bf(ub1.w, hw[7], aB);
  const bool odd = lane & 1;
  const float give = odd ? aA : aB;
  const float keep = odd ? aB : aA;
  float x = keep + DPP_F(give, 0xB1);
  x += DPP_F(x, 0x4E);
  x += DPP_F(x, 0x124);
  x += DPP_F(x, 0x128);
  const float sA = RDLANE_F(x, 0) + RDLANE_F(x, 16) + RDLANE_F(x, 32) + RDLANE_F(x, 48);
  const float sB = RDLANE_F(x, 1) + RDLANE_F(x, 17) + RDLANE_F(x, 33) + RDLANE_F(x, 49);
  const float ge = gelu_fast_exact(odd ? sB : sA) * (odd ? pk.gB : pk.gA);
  const unsigned gb = (unsigned)f2bf(ge);
  const unsigned hAl = (unsigned)__builtin_amdgcn_readlane((int)gb, 0), hBl = (unsigned)__builtin_amdgcn_readlane((int)gb, 1);
  const unsigned hAh = hAl << 16, hBh = hBl << 16;
  const unsigned vaw[8] = {va0.x, va0.y, va0.z, va0.w, va1.x, va1.y, va1.z, va1.w};
  const unsigned vbw[8] = {vb0.x, vb0.y, vb0.z, vb0.w, vb1.x, vb1.y, vb1.z, vb1.w};
#pragma unroll
  for (int i = 0; i < 8; ++i) {
    acc[2 * i] = dot2bf(vaw[i], hAl, acc[2 * i]);
    acc[2 * i + 1] = dot2bf(vaw[i], hAh, acc[2 * i + 1]);
    acc[2 * i] = dot2bf(vbw[i], hBl, acc[2 * i]);
    acc[2 * i + 1] = dot2bf(vbw[i], hBh, acc[2 * i + 1]);
  }
}

__device__ __forceinline__ void o_peer_experts2_tile(const Params& p, int l, int t0, const char* smem, int tid, bool dry = false) {
  const int wave = __builtin_amdgcn_readfirstlane(tid >> 6), lane = tid & 63;
  const bf16_t* U = p.u16 + (size_t)l * 16384 * 1024;
  const bf16_t* V = p.v16 + (size_t)l * 16384 * 1024;
  int vz = 0;
  asm volatile("" : "+v"(vz));
  int pe[8][2]; float pg[8][2];
  float acc[8][16];
#pragma unroll
  for (int tk = 0; tk < 8; ++tk) {
    const size_t base = (size_t)(t0 + wave * 8 + tk) * 128 + lane + vz;
    pe[tk][0] = p.pidx[base]; pe[tk][1] = p.pidx[base + 64];
    pg[tk][0] = p.pgate[base]; pg[tk][1] = p.pgate[base + 64];
#pragma unroll
    for (int i = 0; i < 16; ++i) acc[tk][i] = 0.f;
  }
  const int s0 = ((int)(__builtin_amdgcn_s_getreg((3 << 11) | 20) & 0xF) * 2) & 15;
#pragma unroll 1
  for (int si = 0; si < 16; ++si) {
    const int s = (s0 + si) & 15;
#pragma unroll
    for (int tk = 0; tk < 8; ++tk) {
      unsigned long long m0 = __ballot((pe[tk][0] >> 10) == s);
      unsigned long long m1 = __ballot((pe[tk][1] >> 10) == s);
      if ((m0 | m1) == 0ull) continue;
      unsigned hw[8];
      {
        const int tl = wave * 8 + tk;
        const uint4 h0 = *(const uint4*)(smem + tl * LDXB + lane * 16);
        const uint4 h1 = *(const uint4*)(smem + tl * LDXB + 1024 + lane * 16);
        hw[0] = h0.x; hw[1] = h0.y; hw[2] = h0.z; hw[3] = h0.w; hw[4] = h1.x; hw[5] = h1.y; hw[6] = h1.z; hw[7] = h1.w;
      }
#pragma unroll
      for (int hf = 0; hf < 2; ++hf) {
        unsigned long long m = hf ? m1 : m0;
        while (m) {
          PickPair pk;
          const int la = (int)__builtin_ctzll(m);
          m &= m - 1;
          pk.eA = __builtin_amdgcn_readlane(pe[tk][hf], la);
          pk.gA = __builtin_bit_cast(float, __builtin_amdgcn_readlane(__builtin_bit_cast(int, pg[tk][hf]), la));
          pk.eB = pk.eA; pk.gB = 0.f;
          if (m) {
            const int lb = (int)__builtin_ctzll(m);
            m &= m - 1;
            pk.eB = __builtin_amdgcn_readlane(pe[tk][hf], lb);
            pk.gB = __builtin_bit_cast(float, __builtin_amdgcn_readlane(__builtin_bit_cast(int, pg[tk][hf]), lb));
          }
          experts_process2(U, V, pk, hw, acc[tk], lane);
        }
      }
    }
  }
  if (dry) {
#pragma unroll
    for (int tk = 0; tk < 8; ++tk)
#pragma unroll
      for (int i = 0; i < 16; ++i) asm volatile("" :: "v"(acc[tk][i]));
    return;
  }
#pragma unroll
  for (int tk = 0; tk < 8; ++tk) {
    float* xr = p.xres + (size_t)(t0 + wave * 8 + tk) * 1024 + lane * 8;
#pragma unroll
    for (int i = 0; i < 2; ++i) {
      float4 a0 = *(float4*)(xr + i * 512), a1 = *(float4*)(xr + i * 512 + 4);
      a0.x += acc[tk][8 * i + 0]; a0.y += acc[tk][8 * i + 1]; a0.z += acc[tk][8 * i + 2]; a0.w += acc[tk][8 * i + 3];
      a1.x += acc[tk][8 * i + 4]; a1.y += acc[tk][8 * i + 5]; a1.z += acc[tk][8 * i + 6]; a1.w += acc[tk][8 * i + 7];
      *(float4*)(xr + i * 512) = a0;
      *(float4*)(xr + i * 512 + 4) = a1;
    }
  }
}


#define EQ_CAP 520
#define EQ_BYTES (EQ_CAP * 4)
struct ExRows { uint4 uA0, uA1, uB0, uB1, vA0, vA1, vB0, vB1; };
struct ExDesc { int eA, eB; float gA, gB; };

__device__ __forceinline__ ExDesc ex_read_pair(const unsigned* q, int j) {
  const uint2 w = *(const uint2*)(q + 2 * j);
  const unsigned w0 = (unsigned)__builtin_amdgcn_readfirstlane((int)w.x);
  const unsigned w1 = (unsigned)__builtin_amdgcn_readfirstlane((int)w.y);
  ExDesc d;
  d.eA = (int)(w0 & 0x3fffu); d.gA = __uint_as_float(w0 & 0xffff0000u);
  d.eB = (int)(w1 & 0x3fffu); d.gB = __uint_as_float(w1 & 0xffff0000u);
  return d;
}
__device__ __forceinline__ void ex_load_rows(ExRows& r, const bf16_t* __restrict__ U, const bf16_t* __restrict__ V,
                                             const ExDesc& d, int lane) {
  const char* uA = (const char*)(U + (size_t)d.eA * 1024) + lane * 16;
  const char* uB = (const char*)(U + (size_t)d.eB * 1024) + lane * 16;
  const char* vA = (const char*)(V + (size_t)d.eA * 1024) + lane * 16;
  const char* vB = (const char*)(V + (size_t)d.eB * 1024) + lane * 16;
  r.uA0 = *(const uint4*)uA; r.uA1 = *(const uint4*)(uA + 1024);
  r.uB0 = *(const uint4*)uB; r.uB1 = *(const uint4*)(uB + 1024);
  r.vA0 = *(const uint4*)vA; r.vA1 = *(const uint4*)(vA + 1024);
  r.vB0 = *(const uint4*)vB; r.vB1 = *(const uint4*)(vB + 1024);
}
__device__ __forceinline__ void ex_fma16(float (&acc)[16], const uint4& v0, const uint4& v1, unsigned hl, unsigned hh) {
  const unsigned w[8] = {v0.x, v0.y, v0.z, v0.w, v1.x, v1.y, v1.z, v1.w};
#pragma unroll
  for (int i = 0; i < 8; ++i) {
    acc[2 * i] = dot2bf(w[i], hl, acc[2 * i]);
    acc[2 * i + 1] = dot2bf(w[i], hh, acc[2 * i + 1]);
  }
}

__device__ __forceinline__ void o_peer_experts3_tile(const Params& p, int l, int t0, char* smem, int tid, bool dry = false) {
  const int wave = __builtin_amdgcn_readfirstlane(tid >> 6), lane = tid & 63;
  const bool odd = lane & 1;
  const bf16_t* U = p.u16 + (size_t)l * 16384 * 1024;
  const bf16_t* V = p.v16 + (size_t)l * 16384 * 1024;
  unsigned* q = (unsigned*)(smem + XTILE_BYTES + wave * EQ_BYTES);
  int vz = 0;
  asm volatile("" : "+v"(vz));
  const int s0 = ((int)(__builtin_amdgcn_s_getreg((3 << 11) | 20) & 0xF) * 4) & 31;
#pragma unroll 1
  for (int pass = 0; pass < 2; ++pass) {
    const int tl0 = wave * 8 + pass * 4;
    unsigned pk[4][2];
    float acc[4][16];
#pragma unroll
    for (int k = 0; k < 4; ++k) {
      const size_t base = (size_t)(t0 + tl0 + k) * 128 + lane + vz;
#pragma unroll
      for (int hf = 0; hf < 2; ++hf) {
        const unsigned e = (unsigned)p.pidx[base + hf * 64];
        const float gt = p.pgate[base + hf * 64];
        pk[k][hf] = e | ((unsigned)f2bf(gt) << 16);
      }
#pragma unroll
      for (int i = 0; i < 16; ++i) acc[k][i] = 0.f;
    }
#pragma unroll 1
    for (int si = 0; si < 32; ++si) {
      const unsigned s = (unsigned)((s0 + si) & 31);
      int np[4];
      int off = 0;
#pragma unroll
      for (int k = 0; k < 4; ++k) {
        const bool p0 = ((pk[k][0] >> 9) & 31u) == s, p1 = ((pk[k][1] >> 9) & 31u) == s;
        const unsigned long long m0 = __ballot(p0), m1 = __ballot(p1);
        const int c0 = (int)__builtin_popcountll(m0), ck = c0 + (int)__builtin_popcountll(m1);
        const int r0 = (int)__builtin_amdgcn_mbcnt_hi((unsigned)(m0 >> 32), __builtin_amdgcn_mbcnt_lo((unsigned)m0, 0u));
        const int r1 = c0 + (int)__builtin_amdgcn_mbcnt_hi((unsigned)(m1 >> 32), __builtin_amdgcn_mbcnt_lo((unsigned)m1, 0u));
        if (p0) { q[off + r0] = pk[k][0]; if (r0 == ck - 1) q[off + ck] = pk[k][0] & 0xffffu; }
        if (p1) { q[off + r1] = pk[k][1]; if (r1 == ck - 1) q[off + ck] = pk[k][1] & 0xffffu; }
        np[k] = (ck + 1) >> 1;
        off += 2 * np[k];
      }
      const int npt = __builtin_amdgcn_readfirstlane(off >> 1);
      if (npt == 0) continue;
      int j = 0;
      ExDesc dn = ex_read_pair(q, 0);
      ExRows rn;
      ex_load_rows(rn, U, V, dn, lane);
#pragma unroll
      for (int k = 0; k < 4; ++k) {
        const int npk = __builtin_amdgcn_readfirstlane(np[k]);
        if (npk == 0) continue;
        const char* xr = smem + (tl0 + k) * LDXB + lane * 16;
        const uint4 h0 = *(const uint4*)xr, h1 = *(const uint4*)(xr + 1024);
#pragma unroll 1
        for (int c = 0; c < npk; ++c) {
          float aA = 0.f, aB = 0.f;
          aA = dot2bf(rn.uA0.x, h0.x, aA); aA = dot2bf(rn.uA0.y, h0.y, aA); aA = dot2bf(rn.uA0.z, h0.z, aA); aA = dot2bf(rn.uA0.w, h0.w, aA);
          aA = dot2bf(rn.uA1.x, h1.x, aA); aA = dot2bf(rn.uA1.y, h1.y, aA); aA = dot2bf(rn.uA1.z, h1.z, aA); aA = dot2bf(rn.uA1.w, h1.w, aA);
          aB = dot2bf(rn.uB0.x, h0.x, aB); aB = dot2bf(rn.uB0.y, h0.y, aB); aB = dot2bf(rn.uB0.z, h0.z, aB); aB = dot2bf(rn.uB0.w, h0.w, aB);
          aB = dot2bf(rn.uB1.x, h1.x, aB); aB = dot2bf(rn.uB1.y, h1.y, aB); aB = dot2bf(rn.uB1.z, h1.z, aB); aB = dot2bf(rn.uB1.w, h1.w, aB);
          const uint4 vA0 = rn.vA0, vA1 = rn.vA1, vB0 = rn.vB0, vB1 = rn.vB1;
          const float gA = dn.gA, gB = dn.gB;
          ++j;
          if (j < npt) { dn = ex_read_pair(q, j); ex_load_rows(rn, U, V, dn, lane); }
          const float give = odd ? aA : aB;
          const float keep = odd ? aB : aA;
          float x = keep + DPP_F(give, 0xB1);
          x += DPP_F(x, 0x4E);
          x += DPP_F(x, 0x124);
          x += DPP_F(x, 0x128);
          const float sA = RDLANE_F(x, 0) + RDLANE_F(x, 16) + RDLANE_F(x, 32) + RDLANE_F(x, 48);
          const float sB = RDLANE_F(x, 1) + RDLANE_F(x, 17) + RDLANE_F(x, 33) + RDLANE_F(x, 49);
          const float ge = gelu_exact(odd ? sB : sA) * (odd ? gB : gA);
          const unsigned gb = (unsigned)f2bf(ge);
          const unsigned hAl = (unsigned)__builtin_amdgcn_readlane((int)gb, 0), hBl = (unsigned)__builtin_amdgcn_readlane((int)gb, 1);
          ex_fma16(acc[k], vA0, vA1, hAl, hAl << 16);
          ex_fma16(acc[k], vB0, vB1, hBl, hBl << 16);
        }
      }
    }
    if (dry) {
#pragma unroll
      for (int k = 0; k < 4; ++k)
#pragma unroll
        for (int i = 0; i < 16; ++i) asm volatile("" :: "v"(acc[k][i]));
    } else {
#pragma unroll
      for (int k = 0; k < 4; ++k) {
        float* xr = p.xres + (size_t)(t0 + tl0 + k) * 1024 + lane * 8;
#pragma unroll
        for (int i = 0; i < 2; ++i) {
          float4 a0 = *(float4*)(xr + i * 512), a1 = *(float4*)(xr + i * 512 + 4);
          a0.x += acc[k][8 * i + 0]; a0.y += acc[k][8 * i + 1]; a0.z += acc[k][8 * i + 2]; a0.w += acc[k][8 * i + 3];
          a1.x += acc[k][8 * i + 4]; a1.y += acc[k][8 * i + 5]; a1.z += acc[k][8 * i + 6]; a1.w += acc[k][8 * i + 7];
          *(float4*)(xr + i * 512) = a0;
          *(float4*)(xr + i * 512 + 4) = a1;
        }
      }
    }
  }
}


#define EX4_SHIFT 11
#define EX4_NSLICE (16384 >> EX4_SHIFT)
struct Ex4Meta { float gA, gB; int tk; };

__device__ __forceinline__ void ex4_issue(ExRows& r, Ex4Meta& m, const unsigned* q, int j, const bf16_t* __restrict__ U,
                                          const bf16_t* __restrict__ V, int lane) {
  const uint2 w = *(const uint2*)(q + 2 * j);
  const unsigned w0 = (unsigned)__builtin_amdgcn_readfirstlane((int)w.x);
  const unsigned w1 = (unsigned)__builtin_amdgcn_readfirstlane((int)w.y);
  ExDesc d;
  d.eA = (int)(w0 & 0x3fffu); d.eB = (int)(w1 & 0x3fffu);
  m.gA = __uint_as_float(w0 & 0xffff0000u); m.gB = __uint_as_float(w1 & 0xffff0000u);
  m.tk = (int)((w0 >> 14) & 3u);
  ex_load_rows(r, U, V, d, lane);
}

struct Ex4State { float acc[16]; uint4 h0, h1; int cur; };

__device__ __forceinline__ void ex4_store_acc(const Ex4State& st, float* __restrict__ xrow) {
#pragma unroll
  for (int i = 0; i < 2; ++i) {
    *(float4*)(xrow + i * 512) = make_float4(st.acc[8 * i + 0], st.acc[8 * i + 1], st.acc[8 * i + 2], st.acc[8 * i + 3]);
    *(float4*)(xrow + i * 512 + 4) = make_float4(st.acc[8 * i + 4], st.acc[8 * i + 5], st.acc[8 * i + 6], st.acc[8 * i + 7]);
  }
}
__device__ __forceinline__ void ex4_load_acc(Ex4State& st, const float* __restrict__ xrow) {
#pragma unroll
  for (int i = 0; i < 2; ++i) {
    const float4 a0 = *(const float4*)(xrow + i * 512), a1 = *(const float4*)(xrow + i * 512 + 4);
    st.acc[8 * i + 0] = a0.x; st.acc[8 * i + 1] = a0.y; st.acc[8 * i + 2] = a0.z; st.acc[8 * i + 3] = a0.w;
    st.acc[8 * i + 4] = a1.x; st.acc[8 * i + 5] = a1.y; st.acc[8 * i + 6] = a1.z; st.acc[8 * i + 7] = a1.w;
  }
}

__device__ __forceinline__ void ex4_compute(const ExRows& r, const Ex4Meta& m, Ex4State& st, float* __restrict__ xbase,
                                            const char* xl, int lane, bool odd) {
  if (m.tk != st.cur) {
    if (st.cur >= 0) ex4_store_acc(st, xbase + (size_t)st.cur * 1024);
    st.cur = m.tk;
    ex4_load_acc(st, xbase + (size_t)st.cur * 1024);
    const char* xr = xl + st.cur * LDXB;
    st.h0 = *(const uint4*)xr; st.h1 = *(const uint4*)(xr + 1024);
  }
  float aA = 0.f, aB = 0.f;
  aA = dot2bf(r.uA0.x, st.h0.x, aA); aA = dot2bf(r.uA0.y, st.h0.y, aA); aA = dot2bf(r.uA0.z, st.h0.z, aA); aA = dot2bf(r.uA0.w, st.h0.w, aA);
  aA = dot2bf(r.uA1.x, st.h1.x, aA); aA = dot2bf(r.uA1.y, st.h1.y, aA); aA = dot2bf(r.uA1.z, st.h1.z, aA); aA = dot2bf(r.uA1.w, st.h1.w, aA);
  aB = dot2bf(r.uB0.x, st.h0.x, aB); aB = dot2bf(r.uB0.y, st.h0.y, aB); aB = dot2bf(r.uB0.z, st.h0.z, aB); aB = dot2bf(r.uB0.w, st.h0.w, aB);
  aB = dot2bf(r.uB1.x, st.h1.x, aB); aB = dot2bf(r.uB1.y, st.h1.y, aB); aB = dot2bf(r.uB1.z, st.h1.z, aB); aB = dot2bf(r.uB1.w, st.h1.w, aB);
  const float give = odd ? aA : aB;
  const float keep = odd ? aB : aA;
  float x = keep + DPP_F(give, 0xB1);
  x += DPP_F(x, 0x4E);
  x += DPP_F(x, 0x124);
  x += DPP_F(x, 0x128);
  const float sA = RDLANE_F(x, 0) + RDLANE_F(x, 16) + RDLANE_F(x, 32) + RDLANE_F(x, 48);
  const float sB = RDLANE_F(x, 1) + RDLANE_F(x, 17) + RDLANE_F(x, 33) + RDLANE_F(x, 49);
  const float ge = gelu_fast_exact(odd ? sB : sA) * (odd ? m.gB : m.gA);
  const unsigned gb = (unsigned)f2bf(ge);
  const unsigned hAl = (unsigned)__builtin_amdgcn_readlane((int)gb, 0), hBl = (unsigned)__builtin_amdgcn_readlane((int)gb, 1);
  ex_fma16(st.acc, r.vA0, r.vA1, hAl, hAl << 16);
  ex_fma16(st.acc, r.vB0, r.vB1, hBl, hBl << 16);
}

__device__ __forceinline__ void o_peer_experts4_tile(const Params& p, int l, int t0, char* smem, int tid, bool dry = false) {
  const int wave = __builtin_amdgcn_readfirstlane(tid >> 6), lane = tid & 63;
  const bool odd = lane & 1;
  const bf16_t* U = p.u16 + (size_t)l * 16384 * 1024;
  const bf16_t* V = p.v16 + (size_t)l * 16384 * 1024;
  unsigned* q = (unsigned*)(smem + XTILE_BYTES + wave * EQ_BYTES);
  int vz = 0;
  asm volatile("" : "+v"(vz));
  const int s0 = ((int)(__builtin_amdgcn_s_getreg((3 << 11) | 20) & 0xF) * (EX4_NSLICE / 8)) & (EX4_NSLICE - 1);
  unsigned pk[8][2];
#pragma unroll
  for (int k = 0; k < 8; ++k) {
    const size_t base = (size_t)(t0 + wave * 8 + k) * 128 + lane + vz;
#pragma unroll
    for (int hf = 0; hf < 2; ++hf) {
      const unsigned e = (unsigned)p.pidx[base + hf * 64];
      const float gt = p.pgate[base + hf * 64];
      pk[k][hf] = e | ((unsigned)(k & 3) << 14) | ((unsigned)f2bf(gt) << 16);
    }
  }
  float* xdummy = (float*)p.mrg;
#pragma unroll 1
  for (int si = 0; si < EX4_NSLICE; ++si) {
    const unsigned s = (unsigned)((s0 + si) & (EX4_NSLICE - 1));
#pragma unroll
    for (int half = 0; half < 2; ++half) {
      const int tl0 = wave * 8 + half * 4;
      int off = 0;
#pragma unroll
      for (int kk = 0; kk < 4; ++kk) {
        const int k = half * 4 + kk;
        const bool p0 = ((pk[k][0] & 0x3fffu) >> EX4_SHIFT) == s, p1 = ((pk[k][1] & 0x3fffu) >> EX4_SHIFT) == s;
        const unsigned long long m0 = __ballot(p0), m1 = __ballot(p1);
        const int c0 = (int)__builtin_popcountll(m0), ck = c0 + (int)__builtin_popcountll(m1);
        const int r0 = (int)__builtin_amdgcn_mbcnt_hi((unsigned)(m0 >> 32), __builtin_amdgcn_mbcnt_lo((unsigned)m0, 0u));
        const int r1 = c0 + (int)__builtin_amdgcn_mbcnt_hi((unsigned)(m1 >> 32), __builtin_amdgcn_mbcnt_lo((unsigned)m1, 0u));
        if (p0) { q[off + r0] = pk[k][0]; if (r0 == ck - 1) q[off + ck] = pk[k][0] & 0xffffu; }
        if (p1) { q[off + r1] = pk[k][1]; if (r1 == ck - 1) q[off + ck] = pk[k][1] & 0xffffu; }
        off += (ck + 1) & ~1;
      }
      const int npt = __builtin_amdgcn_readfirstlane(off >> 1);
      if (npt == 0) continue;
      float* xbase = dry ? xdummy + (size_t)(t0 + tl0) * 1024 + lane * 8 : p.xres + (size_t)(t0 + tl0) * 1024 + lane * 8;
      const char* xl = smem + tl0 * LDXB + lane * 16;
      Ex4State st;
      st.cur = -1;
      ExRows r0_, r1_, r2_;
      Ex4Meta m0_, m1_, m2_;
      ex4_issue(r0_, m0_, q, 0, U, V, lane);
      if (npt > 1) ex4_issue(r1_, m1_, q, 1, U, V, lane);
      if (npt > 2) ex4_issue(r2_, m2_, q, 2, U, V, lane);
      int j = 0;
#pragma unroll 1
      for (;;) {
        ex4_compute(r0_, m0_, st, xbase, xl, lane, odd);
        if (j + 3 < npt) ex4_issue(r0_, m0_, q, j + 3, U, V, lane);
        if (++j >= npt) break;
        ex4_compute(r1_, m1_, st, xbase, xl, lane, odd);
        if (j + 3 < npt) ex4_issue(r1_, m1_, q, j + 3, U, V, lane);
        if (++j >= npt) break;
        ex4_compute(r2_, m2_, st, xbase, xl, lane, odd);
        if (j + 3 < npt) ex4_issue(r2_, m2_, q, j + 3, U, V, lane);
        if (++j >= npt) break;
      }
      ex4_store_acc(st, xbase + (size_t)st.cur * 1024);
    }
  }
}


#define EX5_SHIFT 10
#define EX5_NSLICE (16384 >> EX5_SHIFT)
__device__ __forceinline__ void experts_process4(const bf16_t* __restrict__ U, const bf16_t* __restrict__ V, const int (&e)[4],
                                                 const float (&g)[4], const uint4& h0, const uint4& h1, float (&acc)[16], int lane) {
  uint4 u0[4], u1[4], v0[4], v1[4];
#pragma unroll
  for (int i = 0; i < 4; ++i) {
    const char* up = (const char*)(U + (size_t)e[i] * 1024) + lane * 16;
    u0[i] = *(const uint4*)up; u1[i] = *(const uint4*)(up + 1024);
  }
#pragma unroll
  for (int i = 0; i < 4; ++i) {
    const char* vp = (const char*)(V + (size_t)e[i] * 1024) + lane * 16;
    v0[i] = *(const uint4*)vp; v1[i] = *(const uint4*)(vp + 1024);
  }
  float a[4];
#pragma unroll
  for (int i = 0; i < 4; ++i) {
    float t = 0.f;
    t = dot2bf(u0[i].x, h0.x, t); t = dot2bf(u0[i].y, h0.y, t); t = dot2bf(u0[i].z, h0.z, t); t = dot2bf(u0[i].w, h0.w, t);
    t = dot2bf(u1[i].x, h1.x, t); t = dot2bf(u1[i].y, h1.y, t); t = dot2bf(u1[i].z, h1.z, t); t = dot2bf(u1[i].w, h1.w, t);
    a[i] = t;
  }
  const bool b0 = lane & 1, b1 = lane & 2;
  const float x01 = (b0 ? a[1] : a[0]) + DPP_F((b0 ? a[0] : a[1]), 0xB1);
  const float x23 = (b0 ? a[3] : a[2]) + DPP_F((b0 ? a[2] : a[3]), 0xB1);
  float y = (b1 ? x23 : x01) + DPP_F((b1 ? x01 : x23), 0x4E);
  y += DPP_F(y, 0x124);
  y += DPP_F(y, 0x128);
  float sum[4];
#pragma unroll
  for (int i = 0; i < 4; ++i) sum[i] = RDLANE_F(y, i) + RDLANE_F(y, 16 + i) + RDLANE_F(y, 32 + i) + RDLANE_F(y, 48 + i);
  const int li = lane & 3;
  const float mine = (li == 0) ? sum[0] : (li == 1) ? sum[1] : (li == 2) ? sum[2] : sum[3];
  const float gmine = (li == 0) ? g[0] : (li == 1) ? g[1] : (li == 2) ? g[2] : g[3];
  const unsigned gb = (unsigned)f2bf(gelu_fast_exact(mine) * gmine);
#pragma unroll
  for (int i = 0; i < 4; ++i) {
    const unsigned hl = (unsigned)__builtin_amdgcn_readlane((int)gb, i);
    ex_fma16(acc, v0[i], v1[i], hl, hl << 16);
  }
}

__device__ __forceinline__ void o_peer_experts5_tile(const Params& p, int l, int t0, const char* smem, int tid, bool dry = false) {
  const int wave = __builtin_amdgcn_readfirstlane(tid >> 6), lane = tid & 63;
  const bf16_t* U = p.u16 + (size_t)l * 16384 * 1024;
  const bf16_t* V = p.v16 + (size_t)l * 16384 * 1024;
  int vz = 0;
  asm volatile("" : "+v"(vz));
  const int s0 = ((int)(__builtin_amdgcn_s_getreg((3 << 11) | 20) & 0xF) * (EX5_NSLICE / 8)) & (EX5_NSLICE - 1);
#pragma unroll 1
  for (int pass = 0; pass < 2; ++pass) {
    const int tl0 = wave * 8 + pass * 4;
    unsigned pk[4][2];
    float acc[4][16];
#pragma unroll
    for (int k = 0; k < 4; ++k) {
      const size_t base = (size_t)(t0 + tl0 + k) * 128 + lane + vz;
#pragma unroll
      for (int hf = 0; hf < 2; ++hf) pk[k][hf] = (unsigned)p.pidx[base + hf * 64] | ((unsigned)f2bf(p.pgate[base + hf * 64]) << 16);
#pragma unroll
      for (int i = 0; i < 16; ++i) acc[k][i] = 0.f;
    }
#pragma unroll 1
    for (int si = 0; si < EX5_NSLICE; ++si) {
      const unsigned s = (unsigned)((s0 + si) & (EX5_NSLICE - 1));
#pragma unroll
      for (int k = 0; k < 4; ++k) {
        unsigned long long m0 = __ballot(((pk[k][0] & 0x3fffu) >> EX5_SHIFT) == s);
        unsigned long long m1 = __ballot(((pk[k][1] & 0x3fffu) >> EX5_SHIFT) == s);
        if ((m0 | m1) == 0ull) continue;
        const char* xr = smem + (tl0 + k) * LDXB + lane * 16;
        const uint4 h0 = *(const uint4*)xr, h1 = *(const uint4*)(xr + 1024);
        while (m0 | m1) {
          int e[4]; float g[4];
#pragma unroll
          for (int i = 0; i < 4; ++i) {
            unsigned w;
            if (m0) { const int la = (int)__builtin_ctzll(m0); m0 &= m0 - 1; w = (unsigned)__builtin_amdgcn_readlane((int)pk[k][0], la); }
            else if (m1) { const int la = (int)__builtin_ctzll(m1); m1 &= m1 - 1; w = (unsigned)__builtin_amdgcn_readlane((int)pk[k][1], la); }
            else { w = (unsigned)e[0]; }
            e[i] = (int)(w & 0x3fffu);
            g[i] = __uint_as_float(w & 0xffff0000u);
          }
          experts_process4(U, V, e, g, h0, h1, acc[k], lane);
        }
      }
    }
    if (dry) {
#pragma unroll
      for (int k = 0; k < 4; ++k)
#pragma unroll
        for (int i = 0; i < 16; ++i) asm volatile("" :: "v"(acc[k][i]));
    } else {
#pragma unroll
      for (int k = 0; k < 4; ++k) {
        float* xr = p.xres + (size_t)(t0 + tl0 + k) * 1024 + lane * 8;
#pragma unroll
        for (int i = 0; i < 2; ++i) {
          float4 a0 = *(float4*)(xr + i * 512), a1 = *(float4*)(xr + i * 512 + 4);
          a0.x += acc[k][8 * i + 0]; a0.y += acc[k][8 * i + 1]; a0.z += acc[k][8 * i + 2]; a0.w += acc[k][8 * i + 3];
          a1.x += acc[k][8 * i + 4]; a1.y += acc[k][8 * i + 5]; a1.z += acc[k][8 * i + 6]; a1.w += acc[k][8 * i + 7];
          *(float4*)(xr + i * 512) = a0;
          *(float4*)(xr + i * 512 + 4) = a1;
        }
      }
    }
  }
}


#define EX6_SHIFT 10
#define EX6_NSLICE (16384 >> EX6_SHIFT)
__device__ __forceinline__ unsigned cvt8_bf16x2(unsigned w, float scale, const bool hi) {
  return hi ? __builtin_bit_cast(unsigned, __builtin_amdgcn_cvt_scalef32_pk_bf16_fp8((int)w, scale, true))
            : __builtin_bit_cast(unsigned, __builtin_amdgcn_cvt_scalef32_pk_bf16_fp8((int)w, scale, false));
}
__device__ __forceinline__ void experts6_process4(const unsigned char* __restrict__ U8, const unsigned char* __restrict__ V8,
                                                  const float2* __restrict__ ES, const int (&e)[4], const float (&g)[4],
                                                  const unsigned (&hw)[8], float (&acc)[16], int lane, int vz) {
  uint4 u[4], v[4];
  float2 sc[4];
#pragma unroll
  for (int i = 0; i < 4; ++i) u[i] = *(const uint4*)(U8 + (size_t)e[i] * 1024 + lane * 16);
#pragma unroll
  for (int i = 0; i < 4; ++i) sc[i] = ES[e[i] + vz];
#pragma unroll
  for (int i = 0; i < 4; ++i) v[i] = *(const uint4*)(V8 + (size_t)e[i] * 1024 + lane * 16);
  float a[4];
#pragma unroll
  for (int i = 0; i < 4; ++i) {
    const unsigned uw[4] = {u[i].x, u[i].y, u[i].z, u[i].w};
    float t = 0.f;
#pragma unroll
    for (int w = 0; w < 4; ++w) {
      t = dot2bf(cvt8_bf16x2(uw[w], sc[i].x, false), hw[2 * w], t);
      t = dot2bf(cvt8_bf16x2(uw[w], sc[i].x, true), hw[2 * w + 1], t);
    }
    a[i] = t;
  }
  const bool b0 = lane & 1, b1 = lane & 2;
  const float x01 = (b0 ? a[1] : a[0]) + DPP_F((b0 ? a[0] : a[1]), 0xB1);
  const float x23 = (b0 ? a[3] : a[2]) + DPP_F((b0 ? a[2] : a[3]), 0xB1);
  float y = (b1 ? x23 : x01) + DPP_F((b1 ? x01 : x23), 0x4E);
  y += DPP_F(y, 0x124);
  y += DPP_F(y, 0x128);
  float sum[4];
#pragma unroll
  for (int i = 0; i < 4; ++i) sum[i] = RDLANE_F(y, i) + RDLANE_F(y, 16 + i) + RDLANE_F(y, 32 + i) + RDLANE_F(y, 48 + i);
  const int li = lane & 3;
  const float mine = (li == 0) ? sum[0] : (li == 1) ? sum[1] : (li == 2) ? sum[2] : sum[3];
  const float gmine = (li == 0) ? g[0] : (li == 1) ? g[1] : (li == 2) ? g[2] : g[3];
  const unsigned gb = (unsigned)f2bf(gelu_fast_exact(mine) * gmine);
#pragma unroll
  for (int i = 0; i < 4; ++i) {
    const unsigned hl = (unsigned)__builtin_amdgcn_readlane((int)gb, i);
    const unsigned hh = hl << 16;
    const unsigned vw[4] = {v[i].x, v[i].y, v[i].z, v[i].w};
#pragma unroll
    for (int w = 0; w < 4; ++w) {
      const unsigned p0 = cvt8_bf16x2(vw[w], sc[i].y, false), p1 = cvt8_bf16x2(vw[w], sc[i].y, true);
      acc[4 * w + 0] = dot2bf(p0, hl, acc[4 * w + 0]);
      acc[4 * w + 1] = dot2bf(p0, hh, acc[4 * w + 1]);
      acc[4 * w + 2] = dot2bf(p1, hl, acc[4 * w + 2]);
      acc[4 * w + 3] = dot2bf(p1, hh, acc[4 * w + 3]);
    }
  }
}

__device__ __forceinline__ void o_peer_experts6_tile(const Params& p, int l, int t0, const char* smem, int tid, bool dry = false) {
  const int wave = __builtin_amdgcn_readfirstlane(tid >> 6), lane = tid & 63;
  const unsigned char* U8 = p.u8 + (size_t)l * 16384 * 1024;
  const unsigned char* V8 = p.v8 + (size_t)l * 16384 * 1024;
  const float2* ES = p.escale + (size_t)l * 16384;
  int vz = 0;
  asm volatile("" : "+v"(vz));
  const int s0 = ((int)(__builtin_amdgcn_s_getreg((3 << 11) | 20) & 0xF) * (EX6_NSLICE / 8)) & (EX6_NSLICE - 1);
  unsigned pk[8][2];
  float acc[8][16];
#pragma unroll
  for (int k = 0; k < 8; ++k) {
    const size_t base = (size_t)(t0 + wave * 8 + k) * 128 + lane + vz;
#pragma unroll
    for (int hf = 0; hf < 2; ++hf) pk[k][hf] = (unsigned)p.pidx[base + hf * 64] | ((unsigned)f2bf(p.pgate[base + hf * 64]) << 16);
#pragma unroll
    for (int i = 0; i < 16; ++i) acc[k][i] = 0.f;
  }
#pragma unroll 1
  for (int si = 0; si < EX6_NSLICE; ++si) {
    const unsigned s = (unsigned)((s0 + si) & (EX6_NSLICE - 1));
#pragma unroll
    for (int k = 0; k < 8; ++k) {
      unsigned long long m0 = __ballot(((pk[k][0] & 0x3fffu) >> EX6_SHIFT) == s);
      unsigned long long m1 = __ballot(((pk[k][1] & 0x3fffu) >> EX6_SHIFT) == s);
      if ((m0 | m1) == 0ull) continue;
      unsigned hw[8];
      {
        const char* xr = smem + (wave * 8 + k) * LDXB + lane * 32;
        const uint4 h0 = *(const uint4*)xr, h1 = *(const uint4*)(xr + 16);
        hw[0] = h0.x; hw[1] = h0.y; hw[2] = h0.z; hw[3] = h0.w; hw[4] = h1.x; hw[5] = h1.y; hw[6] = h1.z; hw[7] = h1.w;
      }
      while (m0 | m1) {
        int e[4]; float g[4];
#pragma unroll
        for (int i = 0; i < 4; ++i) {
          unsigned w;
          if (m0) { const int la = (int)__builtin_ctzll(m0); m0 &= m0 - 1; w = (unsigned)__builtin_amdgcn_readlane((int)pk[k][0], la); }
          else if (m1) { const int la = (int)__builtin_ctzll(m1); m1 &= m1 - 1; w = (unsigned)__builtin_amdgcn_readlane((int)pk[k][1], la); }
          else { w = (unsigned)e[0]; }
          e[i] = (int)(w & 0x3fffu);
          g[i] = __uint_as_float(w & 0xffff0000u);
        }
        experts6_process4(U8, V8, ES, e, g, hw, acc[k], lane, vz);
      }
    }
  }
  if (dry) {
#pragma unroll
    for (int k = 0; k < 8; ++k)
#pragma unroll
      for (int i = 0; i < 16; ++i) asm volatile("" :: "v"(acc[k][i]));
    return;
  }
#pragma unroll
  for (int k = 0; k < 8; ++k) {
    float* xr = p.xres + (size_t)(t0 + wave * 8 + k) * 1024 + lane * 16;
#pragma unroll
    for (int i = 0; i < 4; ++i) {
      float4 a0 = *(float4*)(xr + 4 * i);
      a0.x += acc[k][4 * i + 0]; a0.y += acc[k][4 * i + 1]; a0.z += acc[k][4 * i + 2]; a0.w += acc[k][4 * i + 3];
      *(float4*)(xr + 4 * i) = a0;
    }
  }
}

#define XB_TMO      128
#define XB_XCNT(j)  (256  + 64 * (j))
#define XB_XSUB(j)  (1280 + 64 * (j))
#define XB_XGEN(j)  (2304 + 64 * (j))
#define XB_TOP      3328
#define XB_TOPGEN   3392
#define XCD_BAR_WORDS 3456
#define XB_SPIN_CAP (1u << 22)
#define LAS __attribute__((address_space(3)))
__device__ __forceinline__ unsigned xb_ld(unsigned* p)              { return __hip_atomic_load(p, __ATOMIC_RELAXED, __HIP_MEMORY_SCOPE_AGENT); }
__device__ __forceinline__ unsigned xb_add(unsigned* p, unsigned v) { return __hip_atomic_fetch_add(p, v, __ATOMIC_RELAXED, __HIP_MEMORY_SCOPE_AGENT); }
__device__ __forceinline__ unsigned xb_xcc_id() { return (unsigned)__builtin_amdgcn_s_getreg((3 << 11) | 20) & 0xFu; }
#define XB_SPIN(cond, bar) do { unsigned _sp = 0; while (cond) { __builtin_amdgcn_s_sleep(1); \
    if ((++_sp & 255u) == 0u) { if (xb_ld(&(bar)[XB_TMO])) break; if (_sp > XB_SPIN_CAP) { atomicAdd(&(bar)[XB_TMO], 1u); break; } } } } while (0)
struct XcdBarrier { unsigned* bar; unsigned x; volatile LAS unsigned* st; };
__device__ __forceinline__ XcdBarrier xcd_barrier_post(unsigned* bar, volatile LAS unsigned* st, int tid) {
  XcdBarrier b; b.bar = bar; b.x = xb_xcc_id(); b.st = st;
  if (tid == 0) (void)xb_add(&bar[XB_XCNT(b.x)], 1u);
  return b;
}
__device__ __forceinline__ void xcd_barrier_complete(unsigned* bar, unsigned x, unsigned& nloc, unsigned& nx) {
  const unsigned G = gridDim.x * gridDim.y * gridDim.z;
  unsigned sum, cnt, mine, sp = 0u;
  for (;;) {
    sum = 0u; cnt = 0u; mine = 0u;
#pragma unroll
    for (unsigned j = 0; j < 16; ++j) { const unsigned c = xb_ld(&bar[XB_XCNT(j)]); sum += c; cnt += (c > 0u) ? 1u : 0u; mine = (j == x) ? c : mine; }
    if (sum == G) break;
    __builtin_amdgcn_s_sleep(1);
    if ((++sp & 255u) == 0u) { if (xb_ld(&bar[XB_TMO])) break; if (sp > XB_SPIN_CAP) { atomicAdd(&bar[XB_TMO], 1u); break; } }
  }
  nloc = mine > 0u ? mine : 1u; nx = cnt > 0u ? cnt : 1u;
}
__device__ __forceinline__ void xcd_barrier(const XcdBarrier& b, int tid) {
  asm volatile("s_waitcnt vmcnt(0)" ::: "memory");
  __syncthreads();
  if (tid == 0) {
    unsigned* bar = b.bar;
    __builtin_amdgcn_s_waitcnt(0);
    unsigned nloc = b.st[0], nx = b.st[1];
    if (nloc == 0u) { xcd_barrier_complete(bar, b.x, nloc, nx); b.st[0] = nloc; b.st[1] = nx; }
    const unsigned old = xb_add(&bar[XB_XSUB(b.x)], 1u);
    const unsigned gen = old / nloc;
    if (old + 1u == (gen + 1u) * nloc) {
      __builtin_amdgcn_fence(__ATOMIC_RELEASE, "agent");
      asm volatile("s_waitcnt vmcnt(0)" ::: "memory");
      const unsigned og = xb_add(&bar[XB_TOP], 1u);
      const unsigned tg = og / nx;
      if (og + 1u == (tg + 1u) * nx) xb_add(&bar[XB_TOPGEN], 1u);
      else XB_SPIN(xb_ld(&bar[XB_TOPGEN]) == tg, bar);
      __builtin_amdgcn_fence(__ATOMIC_ACQUIRE, "agent");
      xb_add(&bar[XB_XGEN(b.x)], 1u);
      asm volatile("s_waitcnt vmcnt(0)" ::: "memory");
    } else {
      XB_SPIN(xb_ld(&bar[XB_XGEN(b.x)]) == gen, bar);
      __builtin_amdgcn_fence(__ATOMIC_ACQUIRE, "agent");
      asm volatile("s_waitcnt vmcnt(0)" ::: "memory");
    }
  }
  __syncthreads();
}


__global__ void __launch_bounds__(NTHREADS) fwd_megakernel(Params p) {
  cg::grid_group grid = cg::this_grid();
  extern __shared__ __attribute__((aligned(16))) float smem[];
  const int wv_ = __builtin_amdgcn_readfirstlane((int)(threadIdx.x >> 6));
  volatile LAS unsigned* xb_st = (volatile LAS unsigned*)((LAS char*)(LAS float*)smem + (160 * 1024 - 16));
  if (threadIdx.x == 0) { xb_st[0] = 0u; xb_st[1] = 0u; }
  __syncthreads();
  const XcdBarrier xb = xcd_barrier_post(p.bar, xb_st, (int)threadIdx.x);
#define GRID_BARRIER() xcd_barrier(xb, opaque_tid(wv_))

  o_prep(wv_, p, smem);
  grid.sync();
#if PROBE_DUP == 1
  o_prep(wv_, p, smem);
  grid.sync();
#endif
#pragma unroll 1
  for (int l = 0; l < DEPTH; ++l) {
    const float* xcur = (l == 0) ? p.x_in : p.xres;
    o_p1(wv_, p, l, xcur, (char*)smem);
    GRID_BARRIER();
#if PROBE_DUP == 2
    o_p1(wv_, p, l, xcur, (char*)smem);
    GRID_BARRIER();
#endif
#if PROBE_DUP == 3
    for (int rep_ = 0; rep_ < 2; ++rep_) {
#else
    {
#endif
    {
      const int bidx_ = opaque_bid();
      for (int task = bidx_; task < 1792; task += gridDim.x) {
        const int l_ = opaque_s(l), td_ = opaque_tid(wv_), tk_ = opaque_s(task);
        if (tk_ < 1024) o_na_task(p, l_, tk_, (char*)smem, td_);
        else if (tk_ < 1536) o_ret_kv_task(p, l_, tk_ - 1024, (char*)smem, td_);
        else o_pool_task(p, l_, tk_ - 1536, (char*)smem, td_);
      }
    }
    GRID_BARRIER();
    o_ret_scan(wv_, p, l);
    GRID_BARRIER();
    {
      const int tidx_ = opaque_tid(wv_); const int bidx_ = opaque_bid();
      for (int task = bidx_; task < 512; task += gridDim.x) o_ret_out_task(p, l, task, (char*)smem, tidx_);
    }
    GRID_BARRIER();
    }
    {
      const int tidx_ = opaque_tid(wv_); const int bidx_ = opaque_bid();
      for (int tile = bidx_; tile < NTOK / 64; tile += gridDim.x) {
        { const int t0_ = opaque_s(tile * 64), l_ = opaque_s(l), td_ = opaque_tid(wv_); o_p5a1_tile(p, l_, t0_, (char*)smem, td_); }
#if PROBE_DUP == 4
        { const int t0_ = opaque_s(tile * 64), l_ = opaque_s(l), td_ = opaque_tid(wv_); o_p5a1_tile(p, l_, t0_, (char*)smem, td_); }
#endif
        { const int t0_ = opaque_s(tile * 64), l_ = opaque_s(l), td_ = opaque_tid(wv_); o_p5a2_tile(p, l_, xcur, t0_, (char*)smem, td_); }
        { const int t0_ = opaque_s(tile * 64), l_ = opaque_s(l), td_ = opaque_tid(wv_); o_p5a3_tile(p, l_, t0_, (char*)smem, td_); }
        { const int t0_ = opaque_s(tile * 64), l_ = opaque_s(l), td_ = opaque_tid(wv_); o_peer_select_tile(p, l_, t0_, (char*)smem, td_); }
        { const int t0_ = opaque_s(tile * 64), l_ = opaque_s(l), td_ = opaque_tid(wv_); o_peer_select2_tile(p, l_, t0_, td_); }
#if PROBE_DUP == 5
        { const int t0_ = opaque_s(tile * 64), l_ = opaque_s(l), td_ = opaque_tid(wv_); o_peer_select_tile(p, l_, t0_, (char*)smem, td_); }
        { const int t0_ = opaque_s(tile * 64), l_ = opaque_s(l), td_ = opaque_tid(wv_); o_peer_select2_tile(p, l_, t0_, td_); }
#endif
        asm volatile("s_waitcnt vmcnt(0)" ::: "memory");
        __syncthreads();
#if PROBE_DUP == 6
        { const int t0_ = opaque_s(tile * 64), l_ = opaque_s(l), td_ = opaque_tid(wv_); o_peer_experts6_tile(p, l_, t0_, (const char*)smem, td_, true); }
#endif
        { const int t0_ = opaque_s(tile * 64), l_ = opaque_s(l), td_ = opaque_tid(wv_); o_peer_experts6_tile(p, l_, t0_, (const char*)smem, td_); }
      }
    }
    GRID_BARRIER();
  }
  n_rmsnorm<true>(wv_, p.xres, p.norm_final, p.out, NTOK);
}

extern "C" void kernel_launch(void* const* d_in, const int* in_sizes, int n_in, void* d_out, int out_size,
                              void* d_ws, size_t ws_size, hipStream_t stream) {
  Params p{};
  p.x_in = (const float*)d_in[0]; p.norm_mix = (const float*)d_in[1]; p.w_in = (const float*)d_in[2];
  p.pool_w = (const float*)d_in[3]; p.pool_scale = (const float*)d_in[4]; p.ret_decay = (const float*)d_in[5];
  p.na_rpb = (const float*)d_in[6]; p.w_br_pool = (const float*)d_in[7]; p.w_br_ret = (const float*)d_in[8];
  p.w_br_na = (const float*)d_in[9]; p.w_out = (const float*)d_in[10]; p.norm_ffn = (const float*)d_in[11];
  p.w_query = (const float*)d_in[12]; p.sub_keys = (const float*)d_in[13]; p.peer_u = (const float*)d_in[14];
  p.peer_v = (const float*)d_in[15]; p.norm_final = (const float*)d_in[16];
  p.out = (float*)d_out;
  char* ws = (char*)d_ws;
  size_t off = 0;
  auto alloc = [&](size_t bytes) { char* q = ws + off; off += (bytes + 255) & ~(size_t)255; return q; };
  p.xres = (float*)alloc((size_t)NTOK * D_MODEL * 4);
  p.proj = (bf16_t*)alloc((size_t)NTOK * IN_WIDTH * 2);
  p.ycat = (bf16_t*)alloc((size_t)NTOK * 1024 * 2);
  p.mrg = (bf16_t*)alloc((size_t)NTOK * 1024 * 2);
  p.pidx = (int*)alloc((size_t)NTOK * 128 * 4);
  p.pgate = (float*)alloc((size_t)NTOK * 128 * 4);
  p.wf_in = (bf16_t*)alloc((size_t)DEPTH * D_MODEL * IN_WIDTH * 2);
  p.wf_br = (bf16_t*)alloc((size_t)DEPTH * 1024 * 1024 * 2);
  p.wf_out = (bf16_t*)alloc((size_t)DEPTH * 1024 * 1024 * 2);
  p.wf_q = (bf16_t*)alloc((size_t)DEPTH * 1024 * 2048 * 2);
  p.kf = (bf16_t*)alloc((size_t)DEPTH * 2 * 128 * 128 * 2);
  p.u16 = nullptr; p.v16 = nullptr;
  p.u8 = (unsigned char*)alloc((size_t)DEPTH * 16384 * 1024);
  p.v8 = (unsigned char*)alloc((size_t)DEPTH * 16384 * 1024);
  p.escale = (float2*)alloc((size_t)DEPTH * 16384 * 8);
  p.rope = (float2*)alloc((size_t)SEQ * 32 * 8);
  p.tklist = (unsigned*)alloc((size_t)NTOK * 8 * 2 * 16 * 4);
  p.kvst = (float*)p.mrg;
  p.rstate = (bf16_t*)p.tklist;
  p.bar = (unsigned*)alloc(XCD_BAR_WORDS * 4);
  p.xn = nullptr; p.merged = nullptr; p.pq = nullptr; p.psc = nullptr;
  if (off > ws_size) fprintf(stderr, "WORKSPACE OVERFLOW: need %zu have %zu\n", off, ws_size);

  const size_t kDynLds = 160 * 1024;
  static int grid_blocks = 0;
  if (!grid_blocks) {
    int dev = 0, cus = 0, per_cu = 0;
    (void)hipGetDevice(&dev);
    (void)hipDeviceGetAttribute(&cus, hipDeviceAttributeMultiprocessorCount, dev);
    (void)hipFuncSetAttribute((const void*)fwd_megakernel, hipFuncAttributeMaxDynamicSharedMemorySize, (int)kDynLds);
    (void)hipOccupancyMaxActiveBlocksPerMultiprocessor(&per_cu, fwd_megakernel, NTHREADS, kDynLds);
    if (per_cu < 1) per_cu = 1;
    grid_blocks = cus * per_cu;
  }
  (void)hipMemsetAsync(p.bar, 0, XCD_BAR_WORDS * 4, stream);
  void* args[] = {&p};
  hipError_t e = hipLaunchCooperativeKernel((void*)fwd_megakernel, dim3(grid_blocks), dim3(NTHREADS), args, kDynLds, stream);
  if (e != hipSuccess) fprintf(stderr, "cooperative launch failed: %s (grid %d)\n", hipGetErrorString(e), grid_blocks);
}
```

```cpp
#include <hip/hip_runtime.h>
#include <hip/hip_cooperative_groups.h>
#include <stdint.h>
#include <cstdio>
namespace cg = cooperative_groups;

#define D_MODEL 1024
#define SEQ 4096
#define BATCH 4
#define NTOK (BATCH * SEQ)
#define DEPTH 2
#define IN_WIDTH 5632
#define C_POOL 0
#define C_RQ 256
#define C_RK 512
#define C_RV 768
#define C_RG 1280
#define C_NQ 1792
#define C_NK 2048
#define C_NV 2304
#define C_GATE 2560
#define EPS 1e-6f
#define NTHREADS 512
#define PROBE_DUP 0

typedef unsigned short bf16_t;

struct Params {
  const float* x_in; const float* norm_mix; const float* w_in; const float* pool_w; const float* pool_scale;
  const float* ret_decay; const float* na_rpb; const float* w_br_pool; const float* w_br_ret; const float* w_br_na;
  const float* w_out; const float* norm_ffn; const float* w_query; const float* sub_keys; const float* peer_u;
  const float* peer_v; const float* norm_final;
  float* out;
  float* xres;
  bf16_t* xn;
  bf16_t* proj;
  bf16_t* ycat;
  float* merged;
  float* pq;
  float* psc;
  int* pidx;
  float* pgate;
  bf16_t* wf_in;
  bf16_t* wf_br;
  bf16_t* wf_out;
  bf16_t* wf_q;
  bf16_t* kf;
  bf16_t* u16;
  bf16_t* v16;
  float2* rope;
  bf16_t* mrg;
  unsigned* tklist;
  float* kvst;
  bf16_t* rstate;
  unsigned* bar;
  unsigned char* u8; unsigned char* v8;
  float2* escale;
};

__device__ __forceinline__ bf16_t f2bf(float f) {
  unsigned u = __float_as_uint(f);
  u += 0x7fffu + ((u >> 16) & 1u);
  return (bf16_t)(u >> 16);
}
__device__ __forceinline__ float bf2f(bf16_t h) { return __uint_as_float(((unsigned)h) << 16); }

__device__ __forceinline__ float wave_sum(float v) {
#pragma unroll
  for (int o = 32; o > 0; o >>= 1) v += __shfl_xor(v, o, 64);
  return v;
}
__device__ __forceinline__ float wave_max(float v) {
#pragma unroll
  for (int o = 32; o > 0; o >>= 1) v = fmaxf(v, __shfl_xor(v, o, 64));
  return v;
}
__device__ __forceinline__ float sigmoidf_(float x) { return 1.0f / (1.0f + expf(-x)); }

__device__ __forceinline__ int opaque_tid(int wv) {
  int w = wv;
  asm volatile("" : "+s"(w));
  int lane = __builtin_amdgcn_mbcnt_hi(~0u, __builtin_amdgcn_mbcnt_lo(~0u, 0u));
  asm volatile("" : "+v"(lane));
  return w * 64 + lane;
}
__device__ __forceinline__ int opaque_s(int x) { asm volatile("" : "+s"(x)); return x; }
__device__ __forceinline__ int opaque_bid() { int b = blockIdx.x; asm volatile("" : "+s"(b)); return b; }

template <bool OUT_F32>
__device__ __forceinline__ void n_rmsnorm(const int wv_, const float* __restrict__ x, const float* __restrict__ g, void* outp, int rows) {
  const int tidx_ = opaque_tid(wv_); const int bidx_ = opaque_bid();
  const int lane = tidx_ & 63;
  const int nw = gridDim.x * (NTHREADS / 64);
  for (int row = bidx_ * (NTHREADS / 64) + (tidx_ >> 6); row < rows; row += nw) {
    const float* xr = x + (size_t)row * D_MODEL;
    float4 v[4];
    float ss = 0.f;
#pragma unroll
    for (int i = 0; i < 4; ++i) {
      v[i] = *(const float4*)(xr + i * 256 + lane * 4);
      ss += v[i].x * v[i].x + v[i].y * v[i].y + v[i].z * v[i].z + v[i].w * v[i].w;
    }
    ss = wave_sum(ss);
    float r = rsqrtf(ss * (1.0f / D_MODEL) + EPS);
#pragma unroll
    for (int i = 0; i < 4; ++i) {
      float4 gg = *(const float4*)(g + i * 256 + lane * 4);
      float o0 = v[i].x * r * gg.x, o1 = v[i].y * r * gg.y, o2 = v[i].z * r * gg.z, o3 = v[i].w * r * gg.w;
      if (OUT_F32) {
        *(float4*)((float*)outp + (size_t)row * D_MODEL + i * 256 + lane * 4) = make_float4(o0, o1, o2, o3);
      } else {
        ushort4 o; o.x = f2bf(o0); o.y = f2bf(o1); o.z = f2bf(o2); o.w = f2bf(o3);
        *(ushort4*)((bf16_t*)outp + (size_t)row * D_MODEL + i * 256 + lane * 4) = o;
      }
    }
  }
}

typedef __attribute__((ext_vector_type(8))) short bf16x8;
typedef __attribute__((ext_vector_type(4))) float f32x4;
#define LDX 1032
#define LDXB (LDX * 2)
#define XTILE_BYTES (64 * LDXB)

__device__ __forceinline__ unsigned pack2bf(float a, float b) { return (unsigned)f2bf(a) | ((unsigned)f2bf(b) << 16); }

__device__ __forceinline__ void prep_frag(const int wv_, const float* __restrict__ W, int K, int N, bf16_t* __restrict__ dst, float* smem) {
  const int tidx_ = opaque_tid(wv_); const int bidx_ = opaque_bid();
  const int grp = tidx_ >> 8, tid = tidx_ & 255;
  float(*T)[65] = (float(*)[65])(smem + grp * 32 * 65);
  const int KS = K / 32, NC = N / 64;
  const int ntiles = KS * NC;
  for (int wb = bidx_ * 2; wb < ntiles; wb += gridDim.x * 2) {
    const int w = wb + grp;
    const int c = w / KS, ks = w - c * KS;
    {
      const int row = tid >> 3, col = (tid & 7) * 8;
      const float* src = W + (size_t)(ks * 32 + row) * N + c * 64 + col;
      float4 a = *(const float4*)src, b = *(const float4*)(src + 4);
      __syncthreads();
      T[row][col + 0] = a.x; T[row][col + 1] = a.y; T[row][col + 2] = a.z; T[row][col + 3] = a.w;
      T[row][col + 4] = b.x; T[row][col + 5] = b.y; T[row][col + 6] = b.z; T[row][col + 7] = b.w;
    }
    __syncthreads();
    {
      const int nt = tid >> 6, lane = tid & 63;
      const int kr = 8 * (lane >> 4), nc = nt * 16 + (lane & 15);
      uint4 o;
      o.x = pack2bf(T[kr + 0][nc], T[kr + 1][nc]);
      o.y = pack2bf(T[kr + 2][nc], T[kr + 3][nc]);
      o.z = pack2bf(T[kr + 4][nc], T[kr + 5][nc]);
      o.w = pack2bf(T[kr + 6][nc], T[kr + 7][nc]);
      *(uint4*)(dst + ((size_t)((c * KS + ks) * 4 + nt) * 64 + lane) * 8) = o;
    }
  }
}

__device__ __forceinline__ void o_prep(const int wv_, const Params& p, float* smem) {
  for (int l = 0; l < DEPTH; ++l) {
    prep_frag(wv_, p.w_in + (size_t)l * D_MODEL * IN_WIDTH, D_MODEL, IN_WIDTH, p.wf_in + (size_t)l * D_MODEL * IN_WIDTH, smem);
    prep_frag(wv_, p.w_br_pool + (size_t)l * 256 * 1024, 256, 1024, p.wf_br + (size_t)l * 1024 * 1024, smem);
    prep_frag(wv_, p.w_br_ret + (size_t)l * 512 * 1024, 512, 1024, p.wf_br + (size_t)l * 1024 * 1024 + 256 * 1024, smem);
    prep_frag(wv_, p.w_br_na + (size_t)l * 256 * 1024, 256, 1024, p.wf_br + (size_t)l * 1024 * 1024 + 768 * 1024, smem);
    prep_frag(wv_, p.w_out + (size_t)l * 1024 * 1024, 1024, 1024, p.wf_out + (size_t)l * 1024 * 1024, smem);
    prep_frag(wv_, p.w_query + (size_t)l * 1024 * 2048, 1024, 2048, p.wf_q + (size_t)l * 1024 * 2048, smem);
  }
  const int tidx_ = opaque_tid(wv_); const int bidx_ = opaque_bid();
  const int gtid = bidx_ * NTHREADS + tidx_, gsz = gridDim.x * NTHREADS;
  for (int u = gtid; u < DEPTH * 2 * 8 * 4 * 64; u += gsz) {
    const int lane = u & 63, s2 = (u >> 6) & 3, kt = (u >> 8) & 7, lp = u >> 11;
    const float* kr = p.sub_keys + ((size_t)lp * 128 + kt * 16 + (lane & 15)) * 128;
    float v[8];
#pragma unroll
    for (int j = 0; j < 8; ++j) v[j] = kr[16 * (2 * s2 + (j >> 2)) + 4 * (lane >> 4) + (j & 3)];
    uint4 o;
    o.x = pack2bf(v[0], v[1]); o.y = pack2bf(v[2], v[3]); o.z = pack2bf(v[4], v[5]); o.w = pack2bf(v[6], v[7]);
    *(uint4*)(p.kf + (size_t)u * 8) = o;
  }
  {
    const int lane = tidx_ & 63;
    const int gw = (bidx_ * NTHREADS + tidx_) >> 6, nw = gsz >> 6;
    for (int row = gw; row < DEPTH * 16384 * 2; row += nw) {
      const int tbl = row & 1, er = row >> 1;
      const float* src = (tbl ? p.peer_v : p.peer_u) + (size_t)er * 1024 + lane * 16;
      float4 f[4];
#pragma unroll
      for (int i = 0; i < 4; ++i) f[i] = *(const float4*)(src + 4 * i);
      float m = 0.f;
#pragma unroll
      for (int i = 0; i < 4; ++i) m = fmaxf(m, fmaxf(fmaxf(fabsf(f[i].x), fabsf(f[i].y)), fmaxf(fabsf(f[i].z), fabsf(f[i].w))));
      m = wave_max(m);
      int k = 0;
      if (m > 0.f) {
        int e;
        const float fr = __builtin_frexpf(m, &e);
        k = ((fr <= 0.875f) ? 9 : 8) - e;
        k = k < -100 ? -100 : (k > 100 ? 100 : k);
      }
      const float sc = __builtin_ldexpf(1.0f, k);
      uint4 o;
      unsigned w[4];
#pragma unroll
      for (int i = 0; i < 4; ++i) {
        int pkd = 0;
        pkd = __builtin_amdgcn_cvt_pk_fp8_f32(f[i].x * sc, f[i].y * sc, pkd, false);
        pkd = __builtin_amdgcn_cvt_pk_fp8_f32(f[i].z * sc, f[i].w * sc, pkd, true);
        w[i] = (unsigned)pkd;
      }
      o.x = w[0]; o.y = w[1]; o.z = w[2]; o.w = w[3];
      *(uint4*)((tbl ? p.v8 : p.u8) + (size_t)er * 1024 + lane * 16) = o;
      if (lane == 0) ((float*)p.escale)[(size_t)er * 2 + tbl] = __builtin_ldexpf(1.0f, -k);
    }
  }
  for (int u = gtid; u < SEQ * 32; u += gsz) {
    const int i = u & 31, pos = u >> 5;
    float inv = 1.0f / powf(10000.0f, (float)i / 31.0f);
    float ang = (float)pos * inv;
    double rev = (double)ang * 0.15915494309189535;
    rev -= floor(rev);
    float rf = (float)rev;
    p.rope[u] = make_float2(__builtin_amdgcn_cosf(rf), __builtin_amdgcn_sinf(rf));
  }
}

template <int NT, int PD = 3, int RING = 4>
__device__ __forceinline__ void tl_gemm_chunk(const bf16_t* __restrict__ wf, const int KS, const char* xt, const int kbyte0,
                                              f32x4 (&acc)[NT][4], const int lane, const int nt0 = 0) {
  const bf16x8* wp = (const bf16x8*)wf + lane + nt0 * 64;
  const char* xp = xt + (lane & 15) * LDXB + kbyte0 + (lane >> 4) * 16;
  bf16x8 wb[RING][NT];
#pragma unroll
  for (int s = 0; s < PD; ++s)
#pragma unroll
    for (int nt = 0; nt < NT; ++nt) wb[s][nt] = wp[(s * 4 + nt) * 64];
  for (int ks = 0; ks < KS; ks += RING) {
#pragma unroll
    for (int u = 0; u < RING; ++u) {
      int kpre = ks + u + PD;
      kpre = kpre < KS ? kpre : KS - 1;
#pragma unroll
      for (int nt = 0; nt < NT; ++nt) wb[(u + PD) % RING][nt] = wp[(kpre * 4 + nt) * 64];
      bf16x8 xf[4];
#pragma unroll
      for (int mt = 0; mt < 4; ++mt) xf[mt] = *(const bf16x8*)(xp + mt * 16 * LDXB + (ks + u) * 64);
#pragma unroll
      for (int nt = 0; nt < NT; ++nt)
#pragma unroll
        for (int mt = 0; mt < 4; ++mt)
          acc[nt][mt] = __builtin_amdgcn_mfma_f32_16x16x32_bf16(wb[u][nt], xf[mt], acc[nt][mt], 0, 0, 0);
    }
  }
}

__device__ __forceinline__ void tile_rmsnorm_to_lds(const float* __restrict__ xsrc, const float* __restrict__ g, int t0,
                                                    char* xt, int wave, int lane) {
#pragma unroll 2
  for (int i = 0; i < 8; ++i) {
    const int tok = wave * 8 + i;
    const float* xr = xsrc + (size_t)(t0 + tok) * D_MODEL;
    float4 v[4];
    float ss = 0.f;
#pragma unroll
    for (int q = 0; q < 4; ++q) {
      v[q] = *(const float4*)(xr + q * 256 + lane * 4);
      ss += v[q].x * v[q].x + v[q].y * v[q].y + v[q].z * v[q].z + v[q].w * v[q].w;
    }
    ss = wave_sum(ss);
    const float r = rsqrtf(ss * (1.0f / D_MODEL) + EPS);
#pragma unroll
    for (int q = 0; q < 4; ++q) {
      float4 gg = *(const float4*)(g + q * 256 + lane * 4);
      uint2 o;
      o.x = pack2bf(v[q].x * r * gg.x, v[q].y * r * gg.y);
      o.y = pack2bf(v[q].z * r * gg.z, v[q].w * r * gg.w);
      *(uint2*)(xt + tok * LDXB + (q * 256 + lane * 4) * 2) = o;
    }
  }
}

__device__ __forceinline__ void o_p1(const int wv_, const Params& p, int l, const float* __restrict__ xsrc, char* smem) {
  const int tidx_ = opaque_tid(wv_); const int bidx_ = opaque_bid();
  const int wave = tidx_ >> 6, lane = tidx_ & 63;
  const bf16_t* wf = p.wf_in + (size_t)l * D_MODEL * IN_WIDTH;
  const float* g = p.norm_mix + l * D_MODEL;
  for (int tile = bidx_; tile < NTOK / 64; tile += gridDim.x) {
    const int t0 = tile * 64;
    __syncthreads();
    tile_rmsnorm_to_lds(xsrc, g, t0, smem, wave, lane);
    __syncthreads();
#pragma unroll 1
    for (int c = wave; c < IN_WIDTH / 64; c += 8) {
      f32x4 acc[4][4];
#pragma unroll
      for (int a = 0; a < 4; ++a)
#pragma unroll
        for (int b = 0; b < 4; ++b) acc[a][b] = (f32x4){0.f, 0.f, 0.f, 0.f};
      tl_gemm_chunk<4, 5, 8>(wf + (size_t)c * 32 * 4 * 64 * 8, 32, smem, 0, acc, lane);
      asm volatile("" ::: "memory");
      if (c >= 4 && c < 12) {
        const float sc = (c >= 8) ? 0.125f : 1.0f;
#pragma unroll
        for (int mt = 0; mt < 4; ++mt) {
          const int tok = t0 + mt * 16 + (lane & 15);
          const int pos = tok & (SEQ - 1);
#pragma unroll
          for (int nt = 0; nt < 2; ++nt) {
            const int i0 = nt * 16 + 4 * (lane >> 4);
            const float4 cs01 = *(const float4*)(p.rope + pos * 32 + i0);
            const float4 cs23 = *(const float4*)(p.rope + pos * 32 + i0 + 2);
            const float cc[4] = {cs01.x, cs01.z, cs23.x, cs23.z};
            const float sn[4] = {cs01.y, cs01.w, cs23.y, cs23.w};
#pragma unroll
            for (int r = 0; r < 4; ++r) {
              const float x1 = acc[nt][mt][r], x2 = acc[nt + 2][mt][r];
              acc[nt][mt][r] = (x1 * cc[r] - x2 * sn[r]) * sc;
              acc[nt + 2][mt][r] = (x1 * sn[r] + x2 * cc[r]) * sc;
            }
          }
        }
      } else if (c >= 28 && c < 32) {
#pragma unroll
        for (int a = 0; a < 4; ++a)
#pragma unroll
          for (int b = 0; b < 4; ++b) acc[a][b] *= 0.125f;
      } else if (c >= 40) {
#pragma unroll
        for (int a = 0; a < 4; ++a)
#pragma unroll
          for (int b = 0; b < 4; ++b)
#pragma unroll
            for (int r = 0; r < 4; ++r) acc[a][b][r] = 1.0f / (1.0f + __expf(-acc[a][b][r]));
      }
#pragma unroll
      for (int mt = 0; mt < 4; ++mt) {
        const int tok = t0 + mt * 16 + (lane & 15);
        bf16_t* dst = p.proj + (size_t)tok * IN_WIDTH + c * 64 + 4 * (lane >> 4);
#pragma unroll
        for (int nt = 0; nt < 4; ++nt) {
          uint2 o;
          o.x = pack2bf(acc[nt][mt][0], acc[nt][mt][1]);
          o.y = pack2bf(acc[nt][mt][2], acc[nt][mt][3]);
          *(uint2*)(dst + nt * 16) = o;
        }
      }
    }
  }
}


__device__ __forceinline__ void o_final_norm_tile(const Params& p, int t0, int tid) {
  const int wave = tid >> 6, lane = tid & 63;
#pragma unroll 2
  for (int i = 0; i < 8; ++i) {
    const size_t row = (size_t)(t0 + wave * 8 + i) * D_MODEL;
    float4 v[4];
    float ss = 0.f;
#pragma unroll
    for (int q = 0; q < 4; ++q) {
      v[q] = *(const float4*)(p.xres + row + q * 256 + lane * 4);
      ss += v[q].x * v[q].x + v[q].y * v[q].y + v[q].z * v[q].z + v[q].w * v[q].w;
    }
    ss = wave_sum(ss);
    const float r = rsqrtf(ss * (1.0f / D_MODEL) + EPS);
#pragma unroll
    for (int q = 0; q < 4; ++q) {
      const float4 gg = *(const float4*)(p.norm_final + q * 256 + lane * 4);
      *(float4*)(p.out + row + q * 256 + lane * 4) = make_float4(v[q].x * r * gg.x, v[q].y * r * gg.y, v[q].z * r * gg.z, v[q].w * r * gg.w);
    }
  }
}

__device__ __forceinline__ void tile_load_to_lds(const bf16_t* __restrict__ src, int ld, char* xt, int tid) {
#pragma unroll 4
  for (int it = 0; it < 16; ++it) {
    const int idx = it * NTHREADS + tid;
    const int row = idx >> 7, u = idx & 127;
    const uint4 v = *(const uint4*)(src + (size_t)row * ld + u * 8);
    *(uint4*)(xt + row * LDXB + u * 16) = v;
  }
}

__device__ __forceinline__ void o_p5a1_tile(const Params& p, int l, int t0, char* smem, int tid) {
  const int wave = tid >> 6, lane = tid & 63;
  __syncthreads();
  tile_load_to_lds(p.ycat + (size_t)t0 * 1024, 1024, smem, tid);
  __syncthreads();
  const bf16_t* wfb = p.wf_br + (size_t)l * 1024 * 1024;
#pragma unroll 1
  for (int hc = wave; hc < 32; hc += 8) {
    const int c = hc >> 1, nt0 = (hc & 1) * 2;
    f32x4 m[2][4];
#pragma unroll
    for (int a = 0; a < 2; ++a)
#pragma unroll
      for (int b = 0; b < 4; ++b) m[a][b] = (f32x4){0.f, 0.f, 0.f, 0.f};
#pragma unroll 1
    for (int br = 0; br < 3; ++br) {
      const int koff = (br == 0) ? 0 : (br == 1 ? 256 : 768);
      const int KS = (br == 1) ? 16 : 8;
      f32x4 acc[2][4];
#pragma unroll
      for (int a = 0; a < 2; ++a)
#pragma unroll
        for (int b = 0; b < 4; ++b) acc[a][b] = (f32x4){0.f, 0.f, 0.f, 0.f};
      tl_gemm_chunk<2>(wfb + (size_t)koff * 1024 + (size_t)c * KS * 4 * 64 * 8, KS, smem, koff * 2, acc, lane, nt0);
      asm volatile("" ::: "memory");
#pragma unroll
      for (int mt = 0; mt < 4; ++mt) {
        const int tok = t0 + mt * 16 + (lane & 15);
        const bf16_t* gp = p.proj + (size_t)tok * IN_WIDTH + C_GATE + br * 1024 + c * 64 + nt0 * 16 + 4 * (lane >> 4);
#pragma unroll
        for (int nt = 0; nt < 2; ++nt) {
          const uint2 gv = *(const uint2*)(gp + nt * 16);
          m[nt][mt][0] += __uint_as_float(gv.x << 16) * acc[nt][mt][0];
          m[nt][mt][1] += __uint_as_float(gv.x & 0xffff0000u) * acc[nt][mt][1];
          m[nt][mt][2] += __uint_as_float(gv.y << 16) * acc[nt][mt][2];
          m[nt][mt][3] += __uint_as_float(gv.y & 0xffff0000u) * acc[nt][mt][3];
        }
      }
    }
#pragma unroll
    for (int mt = 0; mt < 4; ++mt) {
      const int tok = t0 + mt * 16 + (lane & 15);
      bf16_t* dst = p.mrg + (size_t)tok * 1024 + c * 64 + nt0 * 16 + 4 * (lane >> 4);
#pragma unroll
      for (int nt = 0; nt < 2; ++nt) {
        uint2 o;
        o.x = pack2bf(m[nt][mt][0], m[nt][mt][1]);
        o.y = pack2bf(m[nt][mt][2], m[nt][mt][3]);
        *(uint2*)(dst + nt * 16) = o;
      }
    }
  }
}
__device__ __forceinline__ void o_p5a2_tile(const Params& p, int l, const float* __restrict__ xcur, int t0, char* smem, int tid) {
  const int wave = tid >> 6, lane = tid & 63;
  __syncthreads();
  tile_load_to_lds(p.mrg + (size_t)t0 * 1024, 1024, smem, tid);
  __syncthreads();
  const bf16_t* wfo = p.wf_out + (size_t)l * 1024 * 1024;
#pragma unroll 1
  for (int c = wave; c < 16; c += 8) {
    f32x4 acc[4][4];
#pragma unroll
    for (int a = 0; a < 4; ++a)
#pragma unroll
      for (int b = 0; b < 4; ++b) acc[a][b] = (f32x4){0.f, 0.f, 0.f, 0.f};
    tl_gemm_chunk<4, 2>(wfo + (size_t)c * 32 * 4 * 64 * 8, 32, smem, 0, acc, lane);
    asm volatile("" ::: "memory");
#pragma unroll
    for (int mt = 0; mt < 4; ++mt) {
      const int tok = t0 + mt * 16 + (lane & 15);
      const size_t o = (size_t)tok * 1024 + c * 64 + 4 * (lane >> 4);
#pragma unroll
      for (int nt = 0; nt < 4; ++nt) {
        float4 xv = *(const float4*)(xcur + o + nt * 16);
        xv.x += acc[nt][mt][0]; xv.y += acc[nt][mt][1]; xv.z += acc[nt][mt][2]; xv.w += acc[nt][mt][3];
        *(float4*)(p.xres + o + nt * 16) = xv;
      }
    }
  }
}
__device__ __forceinline__ void o_p5a3_tile(const Params& p, int l, int t0, char* smem, int tid) {
  const int wave = tid >> 6, lane = tid & 63;
  __syncthreads();
  tile_rmsnorm_to_lds(p.xres, p.norm_ffn + l * D_MODEL, t0, smem, wave, lane);
  __syncthreads();
}


__device__ __forceinline__ unsigned mono_f(float f) {
  unsigned u = __float_as_uint(f);
  return (u & 0x80000000u) ? ~u : (u | 0x80000000u);
}
__device__ __forceinline__ float unmono_f(unsigned m) {
  return __uint_as_float((m & 0x80000000u) ? (m & 0x7fffffffu) : ~m);
}
#define CE_DESC(x, y) { const unsigned hi_ = max(x, y); const unsigned lo_ = min(x, y); x = hi_; y = lo_; }
#define CE_ASC(x, y) { const unsigned hi_ = max(x, y); const unsigned lo_ = min(x, y); x = lo_; y = hi_; }
__device__ __forceinline__ void sort16_desc(unsigned (&a)[16]) {
#pragma unroll
  for (int k = 2; k <= 16; k <<= 1) {
#pragma unroll
    for (int j = k >> 1; j > 0; j >>= 1) {
#pragma unroll
      for (int i = 0; i < 16; ++i) {
        const int l = i ^ j;
        if (l > i) {
          if ((i & k) == 0) CE_DESC(a[i], a[l]) else CE_ASC(a[i], a[l])
        }
      }
    }
  }
}
__device__ __forceinline__ void bitonic_merge16_desc(unsigned (&a)[16]) {
#pragma unroll
  for (int j = 8; j > 0; j >>= 1) {
#pragma unroll
    for (int i = 0; i < 16; ++i) {
      const int l = i ^ j;
      if (l > i) CE_DESC(a[i], a[l])
    }
  }
}
__device__ __forceinline__ void xlane_merge16(unsigned (&a)[16], int mask) {
  unsigned b[16];
#pragma unroll
  for (int i = 0; i < 16; ++i) b[i] = (unsigned)__shfl_xor((int)a[i], mask, 64);
#pragma unroll
  for (int i = 0; i < 16; ++i) a[i] = max(a[i], b[15 - i]);
  bitonic_merge16_desc(a);
}

__device__ __forceinline__ void o_peer_select_tile(const Params& p, int l, int t0, char* smem, int tid) {
  const int h = __builtin_amdgcn_readfirstlane(tid >> 6), lane = tid & 63;
  const int g = lane >> 4, tl = lane & 15;
  const bf16_t* wfq = p.wf_q + (size_t)l * 1024 * 2048;
#pragma unroll 1
  for (int pp = 0; pp < 2; ++pp) {
    bf16x8 qf[4][4];
#pragma unroll 1
    for (int cc = 0; cc < 2; ++cc) {
      const int c = (h * 2 + pp) * 2 + cc;
      f32x4 acc[4][4];
#pragma unroll
      for (int a = 0; a < 4; ++a)
#pragma unroll
        for (int b = 0; b < 4; ++b) acc[a][b] = (f32x4){0.f, 0.f, 0.f, 0.f};
      tl_gemm_chunk<4, 2>(wfq + (size_t)c * 32 * 4 * 64 * 8, 32, smem, 0, acc, lane);
#pragma unroll
      for (int sl = 0; sl < 2; ++sl)
#pragma unroll
        for (int mt = 0; mt < 4; ++mt) {
          union { bf16x8 v; unsigned u[4]; } cv;
          cv.u[0] = pack2bf(acc[2 * sl][mt][0], acc[2 * sl][mt][1]);
          cv.u[1] = pack2bf(acc[2 * sl][mt][2], acc[2 * sl][mt][3]);
          cv.u[2] = pack2bf(acc[2 * sl + 1][mt][0], acc[2 * sl + 1][mt][1]);
          cv.u[3] = pack2bf(acc[2 * sl + 1][mt][2], acc[2 * sl + 1][mt][3]);
          if (cc == 0) qf[sl][mt] = cv.v; else qf[2 + sl][mt] = cv.v;
        }
    }
    const bf16x8* kfp = (const bf16x8*)p.kf + (size_t)((l * 2 + pp) * 8) * 4 * 64 + lane;
#pragma unroll
    for (int mt = 0; mt < 4; ++mt) {
      f32x4 sc[8];
#pragma unroll
      for (int kt = 0; kt < 8; ++kt) sc[kt] = (f32x4){0.f, 0.f, 0.f, 0.f};
#pragma unroll
      for (int s2 = 0; s2 < 4; ++s2) {
        bf16x8 qv;
        qv = qf[s2][mt];
#pragma unroll
        for (int kt = 0; kt < 8; ++kt)
          sc[kt] = __builtin_amdgcn_mfma_f32_16x16x32_bf16(kfp[(kt * 4 + s2) * 64], qv, sc[kt], 0, 0, 0);
        __builtin_amdgcn_sched_barrier(0);
      }
      unsigned A[16], B[16];
#pragma unroll
      for (int kt = 0; kt < 4; ++kt)
#pragma unroll
        for (int r = 0; r < 4; ++r) {
          A[kt * 4 + r] = (mono_f(sc[kt][r]) & ~127u) | (unsigned)(127 - (kt * 16 + r) - 4 * g);
          B[kt * 4 + r] = (mono_f(sc[kt + 4][r]) & ~127u) | (unsigned)(127 - ((kt + 4) * 16 + r) - 4 * g);
        }
      sort16_desc(A);
      sort16_desc(B);
#pragma unroll
      for (int i = 0; i < 16; ++i) A[i] = max(A[i], B[15 - i]);
      bitonic_merge16_desc(A);
      xlane_merge16(A, 16);
      xlane_merge16(A, 32);
      if (g == 0) {
        uint4* dst = (uint4*)(p.tklist + ((size_t)((t0 + mt * 16 + tl) * 8 + h) * 2 + pp) * 16);
        dst[0] = make_uint4(A[0], A[1], A[2], A[3]);
        dst[1] = make_uint4(A[4], A[5], A[6], A[7]);
        dst[2] = make_uint4(A[8], A[9], A[10], A[11]);
        dst[3] = make_uint4(A[12], A[13], A[14], A[15]);
      }
    }
  }
  asm volatile("s_waitcnt vmcnt(0)" ::: "memory");
}

__device__ __forceinline__ void o_peer_select2_tile(const Params& p, int l, int t0, int tid) {
  const int h = __builtin_amdgcn_readfirstlane(tid >> 6), lane = tid & 63;
  const int g = lane >> 4, tl = lane & 15;
#pragma unroll 1
  for (int mt = 0; mt < 4; ++mt) {
    const int tok = t0 + mt * 16 + tl;
    const unsigned* lp = p.tklist + ((size_t)(tok * 8 + h) * 2) * 16;
    float v1[16], v2[16];
    {
      const uint4* q4 = (const uint4*)lp;
#pragma unroll
      for (int i = 0; i < 4; ++i) {
        uint4 x = q4[i], y = q4[4 + i];
        v1[4 * i + 0] = unmono_f(x.x & ~127u); v1[4 * i + 1] = unmono_f(x.y & ~127u);
        v1[4 * i + 2] = unmono_f(x.z & ~127u); v1[4 * i + 3] = unmono_f(x.w & ~127u);
        v2[4 * i + 0] = unmono_f(y.x & ~127u); v2[4 * i + 1] = unmono_f(y.y & ~127u);
        v2[4 * i + 2] = unmono_f(y.z & ~127u); v2[4 * i + 3] = unmono_f(y.w & ~127u);
      }
    }
    unsigned C[16];
#pragma unroll
    for (int i = 0; i < 16; ++i) C[i] = 0u;
    {
      int idx = 0;
#pragma unroll
      for (int a = 0; a < 16; ++a) {
#pragma unroll
        for (int b = 0; b < 16; ++b) {
          if ((a + 1) * (b + 1) <= 16) {
            const unsigned key = (mono_f(v1[a] + v2[b]) & ~255u) | (unsigned)(255 - (a * 16 + b));
            const int slot = idx >> 2, who = idx & 3;
            C[slot] = (g == who) ? key : C[slot];
            ++idx;
          }
        }
      }
    }
    sort16_desc(C);
    xlane_merge16(C, 16);
    xlane_merge16(C, 32);
    const float f0 = unmono_f(C[0] & ~255u);
    float den = 0.f;
    float ev[16];
#pragma unroll
    for (int i = 0; i < 16; ++i) { ev[i] = __expf(unmono_f(C[i] & ~255u) - f0); den += ev[i]; }
    const float rden = 1.0f / den;
    int eidx[4]; float egate[4];
#pragma unroll
    for (int i = 0; i < 4; ++i) {
      const unsigned k = (g == 0) ? C[i] : (g == 1) ? C[4 + i] : (g == 2) ? C[8 + i] : C[12 + i];
      const float e = (g == 0) ? ev[i] : (g == 1) ? ev[4 + i] : (g == 2) ? ev[8 + i] : ev[12 + i];
      const int pos = 255 - (int)(k & 255u);
      const int a = pos >> 4, b = pos & 15;
      const int n1 = 127 - (int)(lp[a] & 127u);
      const int n2 = 127 - (int)(lp[16 + b] & 127u);
      eidx[i] = n1 * 128 + n2;
      egate[i] = e * rden;
    }
    *(int4*)(p.pidx + (size_t)tok * 128 + h * 16 + 4 * g) = make_int4(eidx[0], eidx[1], eidx[2], eidx[3]);
    *(float4*)(p.pgate + (size_t)tok * 128 + h * 16 + 4 * g) = make_float4(egate[0], egate[1], egate[2], egate[3]);
  }
}

__device__ __forceinline__ float logsigmoid_(float x) { return fminf(x, 0.f) - log1pf(expf(-fabsf(x))); }
__device__ __forceinline__ float bf_lo(unsigned w) { return __uint_as_float(w << 16); }
__device__ __forceinline__ float bf_hi(unsigned w) { return __uint_as_float(w & 0xffff0000u); }

#define RKV_LD 136
__device__ __forceinline__ void o_ret_kv_task(const Params& p, int l, int task, char* smem, int tid) {
  const int wave = tid >> 6, lane = tid & 63, g = lane >> 4, tl = lane & 15;
  const int bh = task >> 5, n = task & 31, b = bh >> 2, h = bh & 3;
  const int tok0 = b * SEQ + n * 128;
  const float lgf = logsigmoid_(p.ret_decay[l * 8 + h]), lgb = logsigmoid_(p.ret_decay[l * 8 + 4 + h]);
  bf16_t* KTf = (bf16_t*)smem;
  bf16_t* KTb = KTf + 64 * RKV_LD;
  bf16_t* VT = KTb + 64 * RKV_LD;
  __syncthreads();
#pragma unroll
  for (int it = 0; it < 2; ++it) {
    const int u = tid + it * NTHREADS;
    const int j = u >> 3, d0 = (u & 7) * 8;
    const uint4 kv = *(const uint4*)(p.proj + (size_t)(tok0 + j) * IN_WIDTH + C_RK + h * 64 + d0);
    const float wf = __expf(lgf * (float)(127 - j)), wb = __expf(lgb * (float)(j + 1));
    const unsigned kw[4] = {kv.x, kv.y, kv.z, kv.w};
#pragma unroll
    for (int e = 0; e < 4; ++e) {
      const float x0 = bf_lo(kw[e]), x1 = bf_hi(kw[e]);
      KTf[(d0 + 2 * e) * RKV_LD + j] = f2bf(x0 * wf);
      KTf[(d0 + 2 * e + 1) * RKV_LD + j] = f2bf(x1 * wf);
      KTb[(d0 + 2 * e) * RKV_LD + j] = f2bf(x0 * wb);
      KTb[(d0 + 2 * e + 1) * RKV_LD + j] = f2bf(x1 * wb);
    }
  }
#pragma unroll
  for (int it = 0; it < 4; ++it) {
    const int u = tid + it * NTHREADS;
    const int j = u >> 4, e0 = (u & 15) * 8;
    const uint4 vv = *(const uint4*)(p.proj + (size_t)(tok0 + j) * IN_WIDTH + C_RV + h * 128 + e0);
    const unsigned vw[4] = {vv.x, vv.y, vv.z, vv.w};
#pragma unroll
    for (int e = 0; e < 4; ++e) {
      VT[(e0 + 2 * e) * RKV_LD + j] = (bf16_t)(vw[e] & 0xffffu);
      VT[(e0 + 2 * e + 1) * RKV_LD + j] = (bf16_t)(vw[e] >> 16);
    }
  }
  __syncthreads();
  bf16x8 a[4];
#pragma unroll
  for (int ks = 0; ks < 4; ++ks) a[ks] = *(const bf16x8*)(VT + (wave * 16 + tl) * RKV_LD + ks * 32 + 8 * g);
#pragma unroll
  for (int dir = 0; dir < 2; ++dir) {
    const bf16_t* KT = dir ? KTb : KTf;
#pragma unroll
    for (int dt = 0; dt < 4; ++dt) {
      f32x4 acc = (f32x4){0.f, 0.f, 0.f, 0.f};
#pragma unroll
      for (int ks = 0; ks < 4; ++ks) {
        const bf16x8 bb = *(const bf16x8*)(KT + (dt * 16 + tl) * RKV_LD + ks * 32 + 8 * g);
        acc = __builtin_amdgcn_mfma_f32_16x16x32_bf16(a[ks], bb, acc, 0, 0, 0);
      }
      float* dst = p.kvst + ((size_t)(task * 2 + dir) * 128 + wave * 16 + 4 * g) * 64 + dt * 16 + tl;
#pragma unroll
      for (int r = 0; r < 4; ++r) dst[r * 64] = acc[r];
    }
  }
}

__device__ __forceinline__ void o_ret_scan(const int wv_, const Params& p, int l) {
  const int tidx_ = opaque_tid(wv_); const int bidx_ = opaque_bid();
  const int gsz = gridDim.x * NTHREADS;
  for (int u = bidx_ * NTHREADS + tidx_; u < 16 * 2 * 128 * 16; u += gsz) {
    const int dq = u & 15, e = (u >> 4) & 127, dir = (u >> 11) & 1, bh = u >> 12, h = bh & 3;
    const float lg = logsigmoid_(p.ret_decay[l * 8 + dir * 4 + h]);
    const float gC = __expf(lg * 128.0f);
    float4 st = make_float4(0.f, 0.f, 0.f, 0.f);
#pragma unroll 8
    for (int nn = 0; nn < 32; ++nn) {
      const int n = dir ? (31 - nn) : nn;
      const size_t idx = ((size_t)((bh * 32 + n) * 2 + dir) * 128 + e) * 64 + dq * 4;
      const float4 kv = *(const float4*)(p.kvst + idx);
      uint2 o;
      o.x = pack2bf(st.x, st.y); o.y = pack2bf(st.z, st.w);
      *(uint2*)(p.rstate + idx) = o;
      st.x = fmaf(st.x, gC, kv.x); st.y = fmaf(st.y, gC, kv.y); st.z = fmaf(st.z, gC, kv.z); st.w = fmaf(st.w, gC, kv.w);
    }
  }
}

#define RO_LD 264
#define RK_LD 72
__device__ __forceinline__ void o_ret_out_task(const Params& p, int l, int task, char* smem, int tid) {
  const int wave = tid >> 6, lane = tid & 63, g = lane >> 4, tl = lane & 15;
  const int bh = task >> 5, n = task & 31, b = bh >> 2, h = bh & 3;
  const int tok0 = b * SEQ + n * 128;
  const float lgf = logsigmoid_(p.ret_decay[l * 8 + h]), lgb = logsigmoid_(p.ret_decay[l * 8 + 4 + h]);
  bf16_t* Acat = (bf16_t*)smem;
  bf16_t* Bcat = Acat + 128 * RO_LD;
  bf16_t* Kl = Bcat + 128 * RO_LD;
  __syncthreads();
#pragma unroll
  for (int it = 0; it < 2; ++it) {
    const int u = tid + it * NTHREADS;
    const int i = u >> 3, d0 = (u & 7) * 8;
    const size_t row = (size_t)(tok0 + i) * IN_WIDTH;
    const uint4 qv = *(const uint4*)(p.proj + row + C_RQ + h * 64 + d0);
    const uint4 kv = *(const uint4*)(p.proj + row + C_RK + h * 64 + d0);
    *(uint4*)(Acat + i * RO_LD + d0) = qv;
    *(uint4*)(Kl + i * RK_LD + d0) = kv;
    const float wf = __expf(lgf * (float)(i + 1)), wb = __expf(lgb * (float)(127 - i));
    const unsigned qw[4] = {qv.x, qv.y, qv.z, qv.w};
    uint4 of, ob;
    of.x = pack2bf(bf_lo(qw[0]) * wf, bf_hi(qw[0]) * wf); ob.x = pack2bf(bf_lo(qw[0]) * wb, bf_hi(qw[0]) * wb);
    of.y = pack2bf(bf_lo(qw[1]) * wf, bf_hi(qw[1]) * wf); ob.y = pack2bf(bf_lo(qw[1]) * wb, bf_hi(qw[1]) * wb);
    of.z = pack2bf(bf_lo(qw[2]) * wf, bf_hi(qw[2]) * wf); ob.z = pack2bf(bf_lo(qw[2]) * wb, bf_hi(qw[2]) * wb);
    of.w = pack2bf(bf_lo(qw[3]) * wf, bf_hi(qw[3]) * wf); ob.w = pack2bf(bf_lo(qw[3]) * wb, bf_hi(qw[3]) * wb);
    *(uint4*)(Acat + i * RO_LD + 128 + d0) = of;
    *(uint4*)(Acat + i * RO_LD + 192 + d0) = ob;
  }
#pragma unroll
  for (int it = 0; it < 4; ++it) {
    const int u = tid + it * NTHREADS;
    const int j = u >> 4, e0 = (u & 15) * 8;
    const uint4 vv = *(const uint4*)(p.proj + (size_t)(tok0 + j) * IN_WIDTH + C_RV + h * 128 + e0);
    const unsigned vw[4] = {vv.x, vv.y, vv.z, vv.w};
#pragma unroll
    for (int e = 0; e < 4; ++e) {
      Bcat[(e0 + 2 * e) * RO_LD + j] = (bf16_t)(vw[e] & 0xffffu);
      Bcat[(e0 + 2 * e + 1) * RO_LD + j] = (bf16_t)(vw[e] >> 16);
    }
  }
#pragma unroll
  for (int it = 0; it < 4; ++it) {
    const int u = tid + it * NTHREADS;
    const int d0 = (u & 7) * 8, e = (u >> 3) & 127, dir = u >> 10;
    const uint4 sv = *(const uint4*)(p.rstate + ((size_t)(task * 2 + dir) * 128 + e) * 64 + d0);
    *(uint4*)(Bcat + e * RO_LD + 128 + dir * 64 + d0) = sv;
  }
  __syncthreads();
  f32x4 sc[8];
#pragma unroll
  for (int jt = 0; jt < 8; ++jt) sc[jt] = (f32x4){0.f, 0.f, 0.f, 0.f};
#pragma unroll
  for (int ks = 0; ks < 2; ++ks) {
    const bf16x8 qb = *(const bf16x8*)(Acat + (wave * 16 + tl) * RO_LD + ks * 32 + 8 * g);
#pragma unroll
    for (int jt = 0; jt < 8; ++jt) {
      const bf16x8 ka = *(const bf16x8*)(Kl + (jt * 16 + tl) * RK_LD + ks * 32 + 8 * g);
      sc[jt] = __builtin_amdgcn_mfma_f32_16x16x32_bf16(ka, qb, sc[jt], 0, 0, 0);
    }
  }
  {
    const int i = wave * 16 + tl;
#pragma unroll
    for (int jt = 0; jt < 8; ++jt) {
      float pv[4];
#pragma unroll
      for (int r = 0; r < 4; ++r) {
        const int j = jt * 16 + 4 * g + r;
        const float dd = (j <= i) ? __expf(lgf * (float)(i - j)) : __expf(lgb * (float)(j - i));
        pv[r] = sc[jt][r] * dd;
      }
      uint2 o;
      o.x = pack2bf(pv[0], pv[1]); o.y = pack2bf(pv[2], pv[3]);
      *(uint2*)(Acat + i * RO_LD + jt * 16 + 4 * g) = o;
    }
  }
  f32x4 y[8];
#pragma unroll
  for (int et = 0; et < 8; ++et) y[et] = (f32x4){0.f, 0.f, 0.f, 0.f};
#pragma unroll
  for (int ks = 0; ks < 8; ++ks) {
    const bf16x8 ab = *(const bf16x8*)(Acat + (wave * 16 + tl) * RO_LD + ks * 32 + 8 * g);
#pragma unroll
    for (int et = 0; et < 8; ++et) {
      const bf16x8 ba = *(const bf16x8*)(Bcat + (et * 16 + tl) * RO_LD + ks * 32 + 8 * g);
      y[et] = __builtin_amdgcn_mfma_f32_16x16x32_bf16(ba, ab, y[et], 0, 0, 0);
    }
  }
  float ss = 0.f;
#pragma unroll
  for (int et = 0; et < 8; ++et)
#pragma unroll
    for (int r = 0; r < 4; ++r) ss = fmaf(y[et][r], y[et][r], ss);
  ss += __shfl_xor(ss, 16, 64);
  ss += __shfl_xor(ss, 32, 64);
  const float rstd = rsqrtf(ss * (1.0f / 128.0f) + EPS);
  {
    const int tok = tok0 + wave * 16 + tl;
    const bf16_t* gp = p.proj + (size_t)tok * IN_WIDTH + C_RG + h * 128 + 4 * g;
    bf16_t* dst = p.ycat + (size_t)tok * 1024 + 256 + h * 128 + 4 * g;
#pragma unroll
    for (int et = 0; et < 8; ++et) {
      const uint2 gv = *(const uint2*)(gp + et * 16);
      const float g0 = bf_lo(gv.x), g1 = bf_hi(gv.x), g2 = bf_lo(gv.y), g3 = bf_hi(gv.y);
      uint2 o;
      o.x = pack2bf(g0 / (1.0f + __expf(-g0)) * y[et][0] * rstd, g1 / (1.0f + __expf(-g1)) * y[et][1] * rstd);
      o.y = pack2bf(g2 / (1.0f + __expf(-g2)) * y[et][2] * rstd, g3 / (1.0f + __expf(-g3)) * y[et][3] * rstd);
      *(uint2*)(dst + et * 16) = o;
    }
  }
}


#define NA_KLD 72
#define NA_VLD 520
__device__ __forceinline__ void o_na_task(const Params& p, int l, int task, char* smem, int tid) {
  const int wave = tid >> 6, lane = tid & 63, g = lane >> 4, tl = lane & 15;
  const int rr = task & 63, h = (task >> 6) & 3, b = task >> 8;
  int rs = rr - 4; rs = rs < 0 ? 0 : (rs > 56 ? 56 : rs);
  const int ktok0 = b * SEQ + rs * 64;
  const int qtok0 = b * SEQ + rr * 64;
  bf16_t* Kl = (bf16_t*)smem;
  bf16_t* VT = Kl + 512 * NA_KLD;
  bf16_t* Ql = VT + 64 * NA_VLD;
  float* rpbl = (float*)(Ql + 64 * NA_KLD);
  __syncthreads();
#pragma unroll
  for (int it = 0; it < 8; ++it) {
    const int u = tid + it * NTHREADS;
    const int key = u >> 3, d0 = (u & 7) * 8;
    const size_t row = (size_t)(ktok0 + key) * IN_WIDTH;
    const uint4 kv = *(const uint4*)(p.proj + row + C_NK + h * 64 + d0);
    const uint4 vv = *(const uint4*)(p.proj + row + C_NV + h * 64 + d0);
    *(uint4*)(Kl + key * NA_KLD + d0) = kv;
    const unsigned vw[4] = {vv.x, vv.y, vv.z, vv.w};
#pragma unroll
    for (int e = 0; e < 4; ++e) {
      VT[(d0 + 2 * e) * NA_VLD + key] = (bf16_t)(vw[e] & 0xffffu);
      VT[(d0 + 2 * e + 1) * NA_VLD + key] = (bf16_t)(vw[e] >> 16);
    }
  }
  {
    const int q = tid >> 3, d0 = (tid & 7) * 8;
    *(uint4*)(Ql + q * NA_KLD + d0) = *(const uint4*)(p.proj + (size_t)(qtok0 + q) * IN_WIDTH + C_NQ + h * 64 + d0);
    if (tid < 465) rpbl[tid] = p.na_rpb[((size_t)l * 4 + h) * 465 + tid];
  }
  __syncthreads();
  if (wave < 4) {
    const int qt = wave;
    int cw0 = 16 * qt - 8; cw0 = cw0 < 0 ? 0 : (cw0 > 32 ? 32 : cw0);
    f32x4 sc[16];
#pragma unroll
    for (int T = 0; T < 16; ++T) sc[T] = (f32x4){0.f, 0.f, 0.f, 0.f};
#pragma unroll
    for (int ks = 0; ks < 2; ++ks) {
      const bf16x8 qb = *(const bf16x8*)(Ql + (qt * 16 + tl) * NA_KLD + ks * 32 + 8 * g);
#pragma unroll
      for (int T = 0; T < 16; ++T) {
        const int key = (T >> 1) * 64 + cw0 + (T & 1) * 16 + tl;
        const bf16x8 ka = *(const bf16x8*)(Kl + key * NA_KLD + ks * 32 + 8 * g);
        sc[T] = __builtin_amdgcn_mfma_f32_16x16x32_bf16(ka, qb, sc[T], 0, 0, 0);
      }
    }
    const int cq = qt * 16 + tl;
    int cs = cq - 8; cs = cs < 0 ? 0 : (cs > 48 ? 48 : cs);
    float m = -3.0e38f;
#pragma unroll
    for (int T = 0; T < 16; ++T) {
      const int ri = T >> 1;
      const int di = rs + ri - rr + 7;
#pragma unroll
      for (int r = 0; r < 4; ++r) {
        const int ck = cw0 + (T & 1) * 16 + 4 * g + r;
        const bool valid = (ck >= cs) && (ck < cs + 16);
        int dj = ck - cq + 15; dj = dj < 0 ? 0 : (dj > 30 ? 30 : dj);
        const float sv = valid ? (sc[T][r] + rpbl[di * 31 + dj]) : -1.0e30f;
        sc[T][r] = sv;
        m = fmaxf(m, sv);
      }
    }
    m = fmaxf(m, __shfl_xor(m, 16, 64));
    m = fmaxf(m, __shfl_xor(m, 32, 64));
    float den = 0.f;
#pragma unroll
    for (int T = 0; T < 16; ++T)
#pragma unroll
      for (int r = 0; r < 4; ++r) {
        const float e = __expf(sc[T][r] - m);
        sc[T][r] = e;
        den += e;
      }
    den += __shfl_xor(den, 16, 64);
    den += __shfl_xor(den, 32, 64);
    const float rden = 1.0f / den;
    f32x4 o[4];
#pragma unroll
    for (int dt = 0; dt < 4; ++dt) o[dt] = (f32x4){0.f, 0.f, 0.f, 0.f};
#pragma unroll
    for (int ri = 0; ri < 8; ++ri) {
      union { bf16x8 v; unsigned u[4]; } pb;
      pb.u[0] = pack2bf(sc[2 * ri][0], sc[2 * ri][1]);
      pb.u[1] = pack2bf(sc[2 * ri][2], sc[2 * ri][3]);
      pb.u[2] = pack2bf(sc[2 * ri + 1][0], sc[2 * ri + 1][1]);
      pb.u[3] = pack2bf(sc[2 * ri + 1][2], sc[2 * ri + 1][3]);
#pragma unroll
      for (int dt = 0; dt < 4; ++dt) {
        const bf16_t* vp = VT + (dt * 16 + tl) * NA_VLD + ri * 64 + cw0 + 4 * g;
        union { bf16x8 v; uint2 h[2]; } va;
        va.h[0] = *(const uint2*)vp;
        va.h[1] = *(const uint2*)(vp + 16);
        o[dt] = __builtin_amdgcn_mfma_f32_16x16x32_bf16(va.v, pb.v, o[dt], 0, 0, 0);
      }
    }
    bf16_t* dst = p.ycat + (size_t)(qtok0 + qt * 16 + tl) * 1024 + 768 + h * 64 + 4 * g;
#pragma unroll
    for (int dt = 0; dt < 4; ++dt) {
      uint2 ov;
      ov.x = pack2bf(o[dt][0] * rden, o[dt][1] * rden);
      ov.y = pack2bf(o[dt][2] * rden, o[dt][3] * rden);
      *(uint2*)(dst + dt * 16) = ov;
    }
  }
}

#define PL_LD 264
__device__ __forceinline__ void o_pool_task(const Params& p, int l, int task, char* smem, int tid) {
  const int wave = tid >> 6, lane = tid & 63, g = lane >> 4, tl = lane & 15;
  const int t0 = task * 64, pos0 = t0 & (SEQ - 1);
  bf16_t* Xp = (bf16_t*)smem;
  bf16_t* WT = Xp + 80 * PL_LD;
  bf16_t* Df = WT + 4 * 64 * 72;
  __syncthreads();
#pragma unroll
  for (int it = 0; it < 5; ++it) {
    const int u = tid + it * NTHREADS;
    const int rw = u >> 5, c0 = (u & 31) * 8;
    const int pos = pos0 - 8 + rw;
    uint4 v = make_uint4(0u, 0u, 0u, 0u);
    if (pos >= 0 && pos < SEQ) v = *(const uint4*)(p.proj + (size_t)(t0 - 8 + rw) * IN_WIDTH + C_POOL + c0);
    *(uint4*)(Xp + rw * PL_LD + c0) = v;
  }
#pragma unroll
  for (int it = 0; it < 4; ++it) {
    const int u = tid + it * NTHREADS;
    const int e0 = (u & 7) * 8, c = (u >> 3) & 63, gi = u >> 9;
    const float* wp = p.pool_w + (((size_t)l * 4 + gi) * 64 + c) * 64 + e0;
    const float4 a = *(const float4*)wp, bq = *(const float4*)(wp + 4);
    const float wv[8] = {a.x, a.y, a.z, a.w, bq.x, bq.y, bq.z, bq.w};
#pragma unroll
    for (int k = 0; k < 8; ++k) WT[(gi * 64 + e0 + k) * 72 + c] = f2bf(wv[k]);
  }
  __syncthreads();
#pragma unroll 1
  for (int it = 0; it < 4; ++it) {
    const int u = tid + it * NTHREADS;
    const int t = u >> 5, c0 = (u & 31) * 8;
    const int gi = c0 >> 6;
    const int hw = 1 << gi;
    const int pos = pos0 + t;
    int a = pos - hw; a = a < 0 ? 0 : a;
    int bnd = pos + hw; bnd = bnd > SEQ ? SEQ : bnd;
    float sum[8];
#pragma unroll
    for (int k = 0; k < 8; ++k) sum[k] = 0.f;
    for (int rp = a; rp < bnd; ++rp) {
      const uint4 v = *(const uint4*)(Xp + (rp - pos0 + 8) * PL_LD + c0);
      sum[0] += bf_lo(v.x); sum[1] += bf_hi(v.x); sum[2] += bf_lo(v.y); sum[3] += bf_hi(v.y);
      sum[4] += bf_lo(v.z); sum[5] += bf_hi(v.z); sum[6] += bf_lo(v.w); sum[7] += bf_hi(v.w);
    }
    const float rc = 1.0f / (float)(bnd - a);
    const uint4 xv = *(const uint4*)(Xp + (t + 8) * PL_LD + c0);
    uint4 o;
    o.x = pack2bf(sum[0] * rc - bf_lo(xv.x), sum[1] * rc - bf_hi(xv.x));
    o.y = pack2bf(sum[2] * rc - bf_lo(xv.y), sum[3] * rc - bf_hi(xv.y));
    o.z = pack2bf(sum[4] * rc - bf_lo(xv.z), sum[5] * rc - bf_hi(xv.z));
    o.w = pack2bf(sum[6] * rc - bf_lo(xv.w), sum[7] * rc - bf_hi(xv.w));
    *(uint4*)(Df + t * PL_LD + c0) = o;
  }
  __syncthreads();
  {
    const int gi = wave >> 1, tt0 = (wave & 1) * 2;
    f32x4 acc[4][2];
#pragma unroll
    for (int et = 0; et < 4; ++et)
#pragma unroll
      for (int tt = 0; tt < 2; ++tt) acc[et][tt] = (f32x4){0.f, 0.f, 0.f, 0.f};
#pragma unroll
    for (int ks = 0; ks < 2; ++ks) {
      bf16x8 bx[2];
#pragma unroll
      for (int tt = 0; tt < 2; ++tt) bx[tt] = *(const bf16x8*)(Df + ((tt0 + tt) * 16 + tl) * PL_LD + gi * 64 + ks * 32 + 8 * g);
#pragma unroll
      for (int et = 0; et < 4; ++et) {
        const bf16x8 wa = *(const bf16x8*)(WT + (gi * 64 + et * 16 + tl) * 72 + ks * 32 + 8 * g);
#pragma unroll
        for (int tt = 0; tt < 2; ++tt) acc[et][tt] = __builtin_amdgcn_mfma_f32_16x16x32_bf16(wa, bx[tt], acc[et][tt], 0, 0, 0);
      }
    }
#pragma unroll
    for (int et = 0; et < 4; ++et) {
      const float4 sc4 = *(const float4*)(p.pool_scale + l * 256 + gi * 64 + et * 16 + 4 * g);
#pragma unroll
      for (int tt = 0; tt < 2; ++tt) {
        const int tok = t0 + (tt0 + tt) * 16 + tl;
        uint2 o;
        o.x = pack2bf(acc[et][tt][0] * sc4.x, acc[et][tt][1] * sc4.y);
        o.y = pack2bf(acc[et][tt][2] * sc4.z, acc[et][tt][3] * sc4.w);
        *(uint2*)(p.ycat + (size_t)tok * 1024 + gi * 64 + et * 16 + 4 * g) = o;
      }
    }
  }
}


typedef __attribute__((ext_vector_type(2))) __bf16 bf16x2_t;
__device__ __forceinline__ float dot2bf(unsigned a, unsigned b, float c) {
  return __builtin_amdgcn_fdot2_f32_bf16(__builtin_bit_cast(bf16x2_t, a), __builtin_bit_cast(bf16x2_t, b), c, false);
}
#define DPP_F(v, ctrl) __builtin_bit_cast(float, __builtin_amdgcn_update_dpp(0, __builtin_bit_cast(int, v), ctrl, 0xf, 0xf, false))
#define RDLANE_F(v, l) __builtin_bit_cast(float, __builtin_amdgcn_readlane(__builtin_bit_cast(int, v), l))
__device__ __forceinline__ float erf_as(float x) {
  const float ax = fabsf(x);
  const float t = __builtin_amdgcn_rcpf(fmaf(0.3275911f, ax, 1.0f));
  float y = fmaf(1.061405429f, t, -1.453152027f);
  y = fmaf(y, t, 1.421413741f);
  y = fmaf(y, t, -0.284496736f);
  y = fmaf(y, t, 0.254829592f);
  y = y * t * __expf(-ax * ax);
  return copysignf(1.0f - y, x);
}
__device__ __forceinline__ float gelu_fast_exact(float a) { return 0.5f * a * (1.0f + erf_as(a * 0.70710678118654752f)); }
struct PickPair { int eA, eB; float gA, gB; };

#define EX6_SHIFT 11
#define EX6_NSLICE (16384 >> EX6_SHIFT)
__device__ __forceinline__ unsigned cvt8_bf16x2(unsigned w, float scale, const bool hi) {
  return hi ? __builtin_bit_cast(unsigned, __builtin_amdgcn_cvt_scalef32_pk_bf16_fp8((int)w, scale, true))
            : __builtin_bit_cast(unsigned, __builtin_amdgcn_cvt_scalef32_pk_bf16_fp8((int)w, scale, false));
}
__device__ __forceinline__ void experts6_process4(const unsigned char* __restrict__ U8, const unsigned char* __restrict__ V8,
                                                  const float2* __restrict__ ES, const int (&e)[4], const float (&g)[4],
                                                  const unsigned (&hw)[8], float (&acc)[16], int lane, int vz) {
  uint4 u[4], v[4];
  float2 sc[4];
#pragma unroll
  for (int i = 0; i < 4; ++i) u[i] = *(const uint4*)(U8 + (size_t)e[i] * 1024 + lane * 16);
#pragma unroll
  for (int i = 0; i < 4; ++i) sc[i] = ES[e[i] + vz];
#pragma unroll
  for (int i = 0; i < 4; ++i) v[i] = *(const uint4*)(V8 + (size_t)e[i] * 1024 + lane * 16);
  float a[4];
#pragma unroll
  for (int i = 0; i < 4; ++i) {
    const unsigned uw[4] = {u[i].x, u[i].y, u[i].z, u[i].w};
    float t = 0.f;
#pragma unroll
    for (int w = 0; w < 4; ++w) {
      t = dot2bf(cvt8_bf16x2(uw[w], sc[i].x, false), hw[2 * w], t);
      t = dot2bf(cvt8_bf16x2(uw[w], sc[i].x, true), hw[2 * w + 1], t);
    }
    a[i] = t;
  }
  const bool b0 = lane & 1, b1 = lane & 2;
  const float x01 = (b0 ? a[1] : a[0]) + DPP_F((b0 ? a[0] : a[1]), 0xB1);
  const float x23 = (b0 ? a[3] : a[2]) + DPP_F((b0 ? a[2] : a[3]), 0xB1);
  float y = (b1 ? x23 : x01) + DPP_F((b1 ? x01 : x23), 0x4E);
  y += DPP_F(y, 0x124);
  y += DPP_F(y, 0x128);
  float sum[4];
#pragma unroll
  for (int i = 0; i < 4; ++i) sum[i] = RDLANE_F(y, i) + RDLANE_F(y, 16 + i) + RDLANE_F(y, 32 + i) + RDLANE_F(y, 48 + i);
  const int li = lane & 3;
  const float mine = (li == 0) ? sum[0] : (li == 1) ? sum[1] : (li == 2) ? sum[2] : sum[3];
  const float gmine = (li == 0) ? g[0] : (li == 1) ? g[1] : (li == 2) ? g[2] : g[3];
  const unsigned gb = (unsigned)f2bf(gelu_fast_exact(mine) * gmine);
#pragma unroll
  for (int i = 0; i < 4; ++i) {
    const unsigned hl = (unsigned)__builtin_amdgcn_readlane((int)gb, i);
    const unsigned hh = hl << 16;
    const unsigned vw[4] = {v[i].x, v[i].y, v[i].z, v[i].w};
#pragma unroll
    for (int w = 0; w < 4; ++w) {
      const unsigned p0 = cvt8_bf16x2(vw[w], sc[i].y, false), p1 = cvt8_bf16x2(vw[w], sc[i].y, true);
      acc[4 * w + 0] = dot2bf(p0, hl, acc[4 * w + 0]);
      acc[4 * w + 1] = dot2bf(p0, hh, acc[4 * w + 1]);
      acc[4 * w + 2] = dot2bf(p1, hl, acc[4 * w + 2]);
      acc[4 * w + 3] = dot2bf(p1, hh, acc[4 * w + 3]);
    }
  }
}

__device__ __forceinline__ void o_peer_experts6_tile(const Params& p, int l, int t0, const char* smem, int tid, bool dry = false) {
  const int wave = __builtin_amdgcn_readfirstlane(tid >> 6), lane = tid & 63;
  const unsigned char* U8 = p.u8 + (size_t)l * 16384 * 1024;
  const unsigned char* V8 = p.v8 + (size_t)l * 16384 * 1024;
  const float2* ES = p.escale + (size_t)l * 16384;
  int vz = 0;
  asm volatile("" : "+v"(vz));
  const int s0 = ((int)(__builtin_amdgcn_s_getreg((3 << 11) | 20) & 0xF) * (EX6_NSLICE / 8)) & (EX6_NSLICE - 1);
  unsigned pk[8][2];
  float acc[8][16];
#pragma unroll
  for (int k = 0; k < 8; ++k) {
    const size_t base = (size_t)(t0 + wave * 8 + k) * 128 + lane + vz;
#pragma unroll
    for (int hf = 0; hf < 2; ++hf) pk[k][hf] = (unsigned)p.pidx[base + hf * 64] | ((unsigned)f2bf(p.pgate[base + hf * 64]) << 16);
#pragma unroll
    for (int i = 0; i < 16; ++i) acc[k][i] = 0.f;
  }
#pragma unroll 1
  for (int si = 0; si < EX6_NSLICE; ++si) {
    const unsigned s = (unsigned)((s0 + si) & (EX6_NSLICE - 1));
#pragma unroll
    for (int k = 0; k < 8; ++k) {
      unsigned long long m0 = __ballot(((pk[k][0] & 0x3fffu) >> EX6_SHIFT) == s);
      unsigned long long m1 = __ballot(((pk[k][1] & 0x3fffu) >> EX6_SHIFT) == s);
      if ((m0 | m1) == 0ull) continue;
      unsigned hw[8];
      {
        const char* xr = smem + (wave * 8 + k) * LDXB + lane * 32;
        const uint4 h0 = *(const uint4*)xr, h1 = *(const uint4*)(xr + 16);
        hw[0] = h0.x; hw[1] = h0.y; hw[2] = h0.z; hw[3] = h0.w; hw[4] = h1.x; hw[5] = h1.y; hw[6] = h1.z; hw[7] = h1.w;
      }
      while (m0 | m1) {
        int e[4]; float g[4];
#pragma unroll
        for (int i = 0; i < 4; ++i) {
          unsigned w;
          if (m0) { const int la = (int)__builtin_ctzll(m0); m0 &= m0 - 1; w = (unsigned)__builtin_amdgcn_readlane((int)pk[k][0], la); }
          else if (m1) { const int la = (int)__builtin_ctzll(m1); m1 &= m1 - 1; w = (unsigned)__builtin_amdgcn_readlane((int)pk[k][1], la); }
          else { w = (unsigned)e[0]; }
          e[i] = (int)(w & 0x3fffu);
          g[i] = __uint_as_float(w & 0xffff0000u);
        }
        experts6_process4(U8, V8, ES, e, g, hw, acc[k], lane, vz);
      }
    }
  }
  if (dry) {
#pragma unroll
    for (int k = 0; k < 8; ++k)
#pragma unroll
      for (int i = 0; i < 16; ++i) asm volatile("" :: "v"(acc[k][i]));
    return;
  }
#pragma unroll
  for (int k = 0; k < 8; ++k) {
    float* xr = p.xres + (size_t)(t0 + wave * 8 + k) * 1024 + lane * 16;
#pragma unroll
    for (int i = 0; i < 4; ++i) {
      float4 a0 = *(float4*)(xr + 4 * i);
      a0.x += acc[k][4 * i + 0]; a0.y += acc[k][4 * i + 1]; a0.z += acc[k][4 * i + 2]; a0.w += acc[k][4 * i + 3];
      *(float4*)(xr + 4 * i) = a0;
    }
  }
}

#define XB_TMO      128
#define XB_XCNT(j)  (256  + 64 * (j))
#define XB_XSUB(j)  (1280 + 64 * (j))
#define XB_XGEN(j)  (2304 + 64 * (j))
#define XB_TOP      3328
#define XB_TOPGEN   3392
#define XCD_BAR_WORDS 3456
#define XB_SPIN_CAP (1u << 22)
#define LAS __attribute__((address_space(3)))
__device__ __forceinline__ unsigned xb_ld(unsigned* p)              { return __hip_atomic_load(p, __ATOMIC_RELAXED, __HIP_MEMORY_SCOPE_AGENT); }
__device__ __forceinline__ unsigned xb_add(unsigned* p, unsigned v) { return __hip_atomic_fetch_add(p, v, __ATOMIC_RELAXED, __HIP_MEMORY_SCOPE_AGENT); }
__device__ __forceinline__ unsigned xb_xcc_id() { return (unsigned)__builtin_amdgcn_s_getreg((3 << 11) | 20) & 0xFu; }
#define XB_SPIN(cond, bar) do { unsigned _sp = 0; while (cond) { __builtin_amdgcn_s_sleep(1); \
    if ((++_sp & 255u) == 0u) { if (xb_ld(&(bar)[XB_TMO])) break; if (_sp > XB_SPIN_CAP) { atomicAdd(&(bar)[XB_TMO], 1u); break; } } } } while (0)
struct XcdBarrier { unsigned* bar; unsigned x; volatile LAS unsigned* st; };
__device__ __forceinline__ XcdBarrier xcd_barrier_post(unsigned* bar, volatile LAS unsigned* st, int tid) {
  XcdBarrier b; b.bar = bar; b.x = xb_xcc_id(); b.st = st;
  if (tid == 0) (void)xb_add(&bar[XB_XCNT(b.x)], 1u);
  return b;
}
__device__ __forceinline__ void xcd_barrier_complete(unsigned* bar, unsigned x, unsigned& nloc, unsigned& nx) {
  const unsigned G = gridDim.x * gridDim.y * gridDim.z;
  unsigned sum, cnt, mine, sp = 0u;
  for (;;) {
    sum = 0u; cnt = 0u; mine = 0u;
#pragma unroll
    for (unsigned j = 0; j < 16; ++j) { const unsigned c = xb_ld(&bar[XB_XCNT(j)]); sum += c; cnt += (c > 0u) ? 1u : 0u; mine = (j == x) ? c : mine; }
    if (sum == G) break;
    __builtin_amdgcn_s_sleep(1);
    if ((++sp & 255u) == 0u) { if (xb_ld(&bar[XB_TMO])) break; if (sp > XB_SPIN_CAP) { atomicAdd(&bar[XB_TMO], 1u); break; } }
  }
  nloc = mine > 0u ? mine : 1u; nx = cnt > 0u ? cnt : 1u;
}
__device__ __forceinline__ void xcd_barrier(const XcdBarrier& b, int tid) {
  asm volatile("s_waitcnt vmcnt(0)" ::: "memory");
  __syncthreads();
  if (tid == 0) {
    unsigned* bar = b.bar;
    __builtin_amdgcn_s_waitcnt(0);
    unsigned nloc = b.st[0], nx = b.st[1];
    if (nloc == 0u) { xcd_barrier_complete(bar, b.x, nloc, nx); b.st[0] = nloc; b.st[1] = nx; }
    const unsigned old = xb_add(&bar[XB_XSUB(b.x)], 1u);
    const unsigned gen = old / nloc;
    if (old + 1u == (gen + 1u) * nloc) {
      __builtin_amdgcn_fence(__ATOMIC_RELEASE, "agent");
      asm volatile("s_waitcnt vmcnt(0)" ::: "memory");
      const unsigned og = xb_add(&bar[XB_TOP], 1u);
      const unsigned tg = og / nx;
      if (og + 1u == (tg + 1u) * nx) xb_add(&bar[XB_TOPGEN], 1u);
      else XB_SPIN(xb_ld(&bar[XB_TOPGEN]) == tg, bar);
      __builtin_amdgcn_fence(__ATOMIC_ACQUIRE, "agent");
      xb_add(&bar[XB_XGEN(b.x)], 1u);
      asm volatile("s_waitcnt vmcnt(0)" ::: "memory");
    } else {
      XB_SPIN(xb_ld(&bar[XB_XGEN(b.x)]) == gen, bar);
      __builtin_amdgcn_fence(__ATOMIC_ACQUIRE, "agent");
      asm volatile("s_waitcnt vmcnt(0)" ::: "memory");
    }
  }
  __syncthreads();
}


__global__ void __launch_bounds__(NTHREADS) fwd_megakernel(Params p) {
  cg::grid_group grid = cg::this_grid();
  extern __shared__ __attribute__((aligned(16))) float smem[];
  const int wv_ = __builtin_amdgcn_readfirstlane((int)(threadIdx.x >> 6));
  volatile LAS unsigned* xb_st = (volatile LAS unsigned*)((LAS char*)(LAS float*)smem + (160 * 1024 - 16));
  if (threadIdx.x == 0) { xb_st[0] = 0u; xb_st[1] = 0u; }
  __syncthreads();
  const XcdBarrier xb = xcd_barrier_post(p.bar, xb_st, (int)threadIdx.x);
#define GRID_BARRIER() xcd_barrier(xb, opaque_tid(wv_))

  o_prep(wv_, p, smem);
  grid.sync();
#if PROBE_DUP == 1
  o_prep(wv_, p, smem);
  grid.sync();
#endif
#pragma unroll 1
  for (int l = 0; l < DEPTH; ++l) {
    const float* xcur = (l == 0) ? p.x_in : p.xres;
    o_p1(wv_, p, l, xcur, (char*)smem);
    GRID_BARRIER();
#if PROBE_DUP == 2
    o_p1(wv_, p, l, xcur, (char*)smem);
    GRID_BARRIER();
#endif
#if PROBE_DUP == 3
    for (int rep_ = 0; rep_ < 2; ++rep_) {
#else
    {
#endif
    {
      const int bidx_ = opaque_bid();
      for (int task = bidx_; task < 1792; task += gridDim.x) {
        const int l_ = opaque_s(l), td_ = opaque_tid(wv_), tk_ = opaque_s(task);
        if (tk_ < 1024) o_na_task(p, l_, tk_, (char*)smem, td_);
        else if (tk_ < 1536) o_ret_kv_task(p, l_, tk_ - 1024, (char*)smem, td_);
        else o_pool_task(p, l_, tk_ - 1536, (char*)smem, td_);
      }
    }
    GRID_BARRIER();
    o_ret_scan(wv_, p, l);
    GRID_BARRIER();
    {
      const int tidx_ = opaque_tid(wv_); const int bidx_ = opaque_bid();
      for (int task = bidx_; task < 512; task += gridDim.x) o_ret_out_task(p, l, task, (char*)smem, tidx_);
    }
    GRID_BARRIER();
    }
    {
      const int tidx_ = opaque_tid(wv_); const int bidx_ = opaque_bid();
      for (int tile = bidx_; tile < NTOK / 64; tile += gridDim.x) {
        { const int t0_ = opaque_s(tile * 64), l_ = opaque_s(l), td_ = opaque_tid(wv_); o_p5a1_tile(p, l_, t0_, (char*)smem, td_); }
#if PROBE_DUP == 4
        { const int t0_ = opaque_s(tile * 64), l_ = opaque_s(l), td_ = opaque_tid(wv_); o_p5a1_tile(p, l_, t0_, (char*)smem, td_); }
#endif
        { const int t0_ = opaque_s(tile * 64), l_ = opaque_s(l), td_ = opaque_tid(wv_); o_p5a2_tile(p, l_, xcur, t0_, (char*)smem, td_); }
        { const int t0_ = opaque_s(tile * 64), l_ = opaque_s(l), td_ = opaque_tid(wv_); o_p5a3_tile(p, l_, t0_, (char*)smem, td_); }
        { const int t0_ = opaque_s(tile * 64), l_ = opaque_s(l), td_ = opaque_tid(wv_); o_peer_select_tile(p, l_, t0_, (char*)smem, td_); }
        { const int t0_ = opaque_s(tile * 64), l_ = opaque_s(l), td_ = opaque_tid(wv_); o_peer_select2_tile(p, l_, t0_, td_); }
#if PROBE_DUP == 5
        { const int t0_ = opaque_s(tile * 64), l_ = opaque_s(l), td_ = opaque_tid(wv_); o_peer_select_tile(p, l_, t0_, (char*)smem, td_); }
        { const int t0_ = opaque_s(tile * 64), l_ = opaque_s(l), td_ = opaque_tid(wv_); o_peer_select2_tile(p, l_, t0_, td_); }
#endif
        asm volatile("s_waitcnt vmcnt(0)" ::: "memory");
        __syncthreads();
#if PROBE_DUP == 6
        { const int t0_ = opaque_s(tile * 64), l_ = opaque_s(l), td_ = opaque_tid(wv_); o_peer_experts6_tile(p, l_, t0_, (const char*)smem, td_, true); }
#endif
        { const int t0_ = opaque_s(tile * 64), l_ = opaque_s(l), td_ = opaque_tid(wv_); o_peer_experts6_tile(p, l_, t0_, (const char*)smem, td_); }
        if (l + 1 == DEPTH) {
          asm volatile("s_waitcnt vmcnt(0)" ::: "memory");
          const int t0_ = opaque_s(tile * 64), td_ = opaque_tid(wv_);
          o_final_norm_tile(p, t0_, td_);
        }
      }
    }
    if (l + 1 < DEPTH) GRID_BARRIER();
  }
}

extern "C" void kernel_launch(void* const* d_in, const int* in_sizes, int n_in, void* d_out, int out_size,
                              void* d_ws, size_t ws_size, hipStream_t stream) {
  Params p{};
  p.x_in = (const float*)d_in[0]; p.norm_mix = (const float*)d_in[1]; p.w_in = (const float*)d_in[2];
  p.pool_w = (const float*)d_in[3]; p.pool_scale = (const float*)d_in[4]; p.ret_decay = (const float*)d_in[5];
  p.na_rpb = (const float*)d_in[6]; p.w_br_pool = (const float*)d_in[7]; p.w_br_ret = (const float*)d_in[8];
  p.w_br_na = (const float*)d_in[9]; p.w_out = (const float*)d_in[10]; p.norm_ffn = (const float*)d_in[11];
  p.w_query = (const float*)d_in[12]; p.sub_keys = (const float*)d_in[13]; p.peer_u = (const float*)d_in[14];
  p.peer_v = (const float*)d_in[15]; p.norm_final = (const float*)d_in[16];
  p.out = (float*)d_out;
  char* ws = (char*)d_ws;
  size_t off = 0;
  auto alloc = [&](size_t bytes) { char* q = ws + off; off += (bytes + 255) & ~(size_t)255; return q; };
  p.xres = (float*)alloc((size_t)NTOK * D_MODEL * 4);
  p.proj = (bf16_t*)alloc((size_t)NTOK * IN_WIDTH * 2);
  p.ycat = (bf16_t*)alloc((size_t)NTOK * 1024 * 2);
  p.mrg = (bf16_t*)alloc((size_t)NTOK * 1024 * 2);
  p.pidx = (int*)alloc((size_t)NTOK * 128 * 4);
  p.pgate = (float*)alloc((size_t)NTOK * 128 * 4);
  p.wf_in = (bf16_t*)alloc((size_t)DEPTH * D_MODEL * IN_WIDTH * 2);
  p.wf_br = (bf16_t*)alloc((size_t)DEPTH * 1024 * 1024 * 2);
  p.wf_out = (bf16_t*)alloc((size_t)DEPTH * 1024 * 1024 * 2);
  p.wf_q = (bf16_t*)alloc((size_t)DEPTH * 1024 * 2048 * 2);
  p.kf = (bf16_t*)alloc((size_t)DEPTH * 2 * 128 * 128 * 2);
  p.u16 = nullptr; p.v16 = nullptr;
  p.u8 = (unsigned char*)alloc((size_t)DEPTH * 16384 * 1024);
  p.v8 = (unsigned char*)alloc((size_t)DEPTH * 16384 * 1024);
  p.escale = (float2*)alloc((size_t)DEPTH * 16384 * 8);
  p.rope = (float2*)alloc((size_t)SEQ * 32 * 8);
  p.tklist = (unsigned*)alloc((size_t)NTOK * 8 * 2 * 16 * 4);
  p.kvst = (float*)p.mrg;
  p.rstate = (bf16_t*)p.tklist;
  p.bar = (unsigned*)alloc(XCD_BAR_WORDS * 4);
  p.xn = nullptr; p.merged = nullptr; p.pq = nullptr; p.psc = nullptr;
  if (off > ws_size) fprintf(stderr, "WORKSPACE OVERFLOW: need %zu have %zu\n", off, ws_size);

  const size_t kDynLds = 160 * 1024;
  static int grid_blocks = 0;
  if (!grid_blocks) {
    int dev = 0, cus = 0, per_cu = 0;
    (void)hipGetDevice(&dev);
    (void)hipDeviceGetAttribute(&cus, hipDeviceAttributeMultiprocessorCount, dev);
    (void)hipFuncSetAttribute((const void*)fwd_megakernel, hipFuncAttributeMaxDynamicSharedMemorySize, (int)kDynLds);
    (void)hipOccupancyMaxActiveBlocksPerMultiprocessor(&per_cu, fwd_megakernel, NTHREADS, kDynLds);
    if (per_cu < 1) per_cu = 1;
    grid_blocks = cus * per_cu;
  }
  (void)hipMemsetAsync(p.bar, 0, XCD_BAR_WORDS * 4, stream);
  void* args[] = {&p};
  hipError_t e = hipLaunchCooperativeKernel((void*)fwd_megakernel, dim3(grid_blocks), dim3(NTHREADS), args, kDynLds, stream);
  if (e != hipSuccess) fprintf(stderr, "cooperative launch failed: %s (grid %d)\n", hipGetErrorString(e), grid_blocks);
}
```

```cpp
#include <hip/hip_runtime.h>
#include <hip/hip_cooperative_groups.h>
#include <stdint.h>
#include <cstdio>
namespace cg = cooperative_groups;

#define D_MODEL 1024
#define SEQ 4096
#define BATCH 4
#define NTOK (BATCH * SEQ)
#define DEPTH 2
#define IN_WIDTH 5632
#define C_POOL 0
#define C_RQ 256
#define C_RK 512
#define C_RV 768
#define C_RG 1280
#define C_NQ 1792
#define C_NK 2048
#define C_NV 2304
#define C_GATE 2560
#define EPS 1e-6f
#define NTHREADS 512
#define PROBE_DUP 0

typedef unsigned short bf16_t;

struct Params {
  const float* x_in; const float* norm_mix; const float* w_in; const float* pool_w; const float* pool_scale;
  const float* ret_decay; const float* na_rpb; const float* w_br_pool; const float* w_br_ret; const float* w_br_na;
  const float* w_out; const float* norm_ffn; const float* w_query; const float* sub_keys; const float* peer_u;
  const float* peer_v; const float* norm_final;
  float* out;
  float* xres;
  bf16_t* xn;
  bf16_t* proj;
  bf16_t* ycat;
  float* merged;
  float* pq;
  float* psc;
  int* pidx;
  float* pgate;
  bf16_t* wf_in;
  bf16_t* wf_br;
  bf16_t* wf_out;
  bf16_t* wf_q;
  bf16_t* kf;
  bf16_t* u16;
  bf16_t* v16;
  float2* rope;
  bf16_t* mrg;
  unsigned* tklist;
  float* kvst;
  bf16_t* rstate;
  unsigned* bar;
  unsigned char* u8; unsigned char* v8;
  float2* escale;
};

__device__ __forceinline__ bf16_t f2bf(float f) {
  unsigned u = __float_as_uint(f);
  u += 0x7fffu + ((u >> 16) & 1u);
  return (bf16_t)(u >> 16);
}
__device__ __forceinline__ float bf2f(bf16_t h) { return __uint_as_float(((unsigned)h) << 16); }

__device__ __forceinline__ float wave_sum(float v) {
#pragma unroll
  for (int o = 32; o > 0; o >>= 1) v += __shfl_xor(v, o, 64);
  return v;
}
__device__ __forceinline__ float wave_max(float v) {
#pragma unroll
  for (int o = 32; o > 0; o >>= 1) v = fmaxf(v, __shfl_xor(v, o, 64));
  return v;
}
__device__ __forceinline__ float sigmoidf_(float x) { return 1.0f / (1.0f + expf(-x)); }

__device__ __forceinline__ int opaque_tid(int wv) {
  int w = wv;
  asm volatile("" : "+s"(w));
  int lane = __builtin_amdgcn_mbcnt_hi(~0u, __builtin_amdgcn_mbcnt_lo(~0u, 0u));
  asm volatile("" : "+v"(lane));
  return w * 64 + lane;
}
__device__ __forceinline__ int opaque_s(int x) { asm volatile("" : "+s"(x)); return x; }
__device__ __forceinline__ int opaque_bid() { int b = blockIdx.x; asm volatile("" : "+s"(b)); return b; }

template <bool OUT_F32>
__device__ __forceinline__ void n_rmsnorm(const int wv_, const float* __restrict__ x, const float* __restrict__ g, void* outp, int rows) {
  const int tidx_ = opaque_tid(wv_); const int bidx_ = opaque_bid();
  const int lane = tidx_ & 63;
  const int nw = gridDim.x * (NTHREADS / 64);
  for (int row = bidx_ * (NTHREADS / 64) + (tidx_ >> 6); row < rows; row += nw) {
    const float* xr = x + (size_t)row * D_MODEL;
    float4 v[4];
    float ss = 0.f;
#pragma unroll
    for (int i = 0; i < 4; ++i) {
      v[i] = *(const float4*)(xr + i * 256 + lane * 4);
      ss += v[i].x * v[i].x + v[i].y * v[i].y + v[i].z * v[i].z + v[i].w * v[i].w;
    }
    ss = wave_sum(ss);
    float r = rsqrtf(ss * (1.0f / D_MODEL) + EPS);
#pragma unroll
    for (int i = 0; i < 4; ++i) {
      float4 gg = *(const float4*)(g + i * 256 + lane * 4);
      float o0 = v[i].x * r * gg.x, o1 = v[i].y * r * gg.y, o2 = v[i].z * r * gg.z, o3 = v[i].w * r * gg.w;
      if (OUT_F32) {
        *(float4*)((float*)outp + (size_t)row * D_MODEL + i * 256 + lane * 4) = make_float4(o0, o1, o2, o3);
      } else {
        ushort4 o; o.x = f2bf(o0); o.y = f2bf(o1); o.z = f2bf(o2); o.w = f2bf(o3);
        *(ushort4*)((bf16_t*)outp + (size_t)row * D_MODEL + i * 256 + lane * 4) = o;
      }
    }
  }
}

typedef __attribute__((ext_vector_type(8))) short bf16x8;
typedef __attribute__((ext_vector_type(4))) float f32x4;
#define LDX 1032
#define LDXB (LDX * 2)
#define XTILE_BYTES (64 * LDXB)

__device__ __forceinline__ unsigned pack2bf(float a, float b) { return (unsigned)f2bf(a) | ((unsigned)f2bf(b) << 16); }

__device__ __forceinline__ void prep_frag(const int wv_, const float* __restrict__ W, int K, int N, bf16_t* __restrict__ dst, float* smem) {
  const int tidx_ = opaque_tid(wv_); const int bidx_ = opaque_bid();
  const int grp = tidx_ >> 8, tid = tidx_ & 255;
  float(*T)[65] = (float(*)[65])(smem + grp * 32 * 65);
  const int KS = K / 32, NC = N / 64;
  const int ntiles = KS * NC;
  for (int wb = bidx_ * 2; wb < ntiles; wb += gridDim.x * 2) {
    const int w = wb + grp;
    const int c = w / KS, ks = w - c * KS;
    {
      const int row = tid >> 3, col = (tid & 7) * 8;
      const float* src = W + (size_t)(ks * 32 + row) * N + c * 64 + col;
      float4 a = *(const float4*)src, b = *(const float4*)(src + 4);
      __syncthreads();
      T[row][col + 0] = a.x; T[row][col + 1] = a.y; T[row][col + 2] = a.z; T[row][col + 3] = a.w;
      T[row][col + 4] = b.x; T[row][col + 5] = b.y; T[row][col + 6] = b.z; T[row][col + 7] = b.w;
    }
    __syncthreads();
    {
      const int nt = tid >> 6, lane = tid & 63;
      const int kr = 8 * (lane >> 4), nc = nt * 16 + (lane & 15);
      uint4 o;
      o.x = pack2bf(T[kr + 0][nc], T[kr + 1][nc]);
      o.y = pack2bf(T[kr + 2][nc], T[kr + 3][nc]);
      o.z = pack2bf(T[kr + 4][nc], T[kr + 5][nc]);
      o.w = pack2bf(T[kr + 6][nc], T[kr + 7][nc]);
      *(uint4*)(dst + ((size_t)((c * KS + ks) * 4 + nt) * 64 + lane) * 8) = o;
    }
  }
}

__device__ __forceinline__ void o_prep(const int wv_, const Params& p, float* smem) {
  for (int l = 0; l < DEPTH; ++l) {
    prep_frag(wv_, p.w_in + (size_t)l * D_MODEL * IN_WIDTH, D_MODEL, IN_WIDTH, p.wf_in + (size_t)l * D_MODEL * IN_WIDTH, smem);
    prep_frag(wv_, p.w_br_pool + (size_t)l * 256 * 1024, 256, 1024, p.wf_br + (size_t)l * 1024 * 1024, smem);
    prep_frag(wv_, p.w_br_ret + (size_t)l * 512 * 1024, 512, 1024, p.wf_br + (size_t)l * 1024 * 1024 + 256 * 1024, smem);
    prep_frag(wv_, p.w_br_na + (size_t)l * 256 * 1024, 256, 1024, p.wf_br + (size_t)l * 1024 * 1024 + 768 * 1024, smem);
    prep_frag(wv_, p.w_out + (size_t)l * 1024 * 1024, 1024, 1024, p.wf_out + (size_t)l * 1024 * 1024, smem);
    prep_frag(wv_, p.w_query + (size_t)l * 1024 * 2048, 1024, 2048, p.wf_q + (size_t)l * 1024 * 2048, smem);
  }
  const int tidx_ = opaque_tid(wv_); const int bidx_ = opaque_bid();
  const int gtid = bidx_ * NTHREADS + tidx_, gsz = gridDim.x * NTHREADS;
  for (int u = gtid; u < DEPTH * 2 * 8 * 4 * 64; u += gsz) {
    const int lane = u & 63, s2 = (u >> 6) & 3, kt = (u >> 8) & 7, lp = u >> 11;
    const float* kr = p.sub_keys + ((size_t)lp * 128 + kt * 16 + (lane & 15)) * 128;
    float v[8];
#pragma unroll
    for (int j = 0; j < 8; ++j) v[j] = kr[16 * (2 * s2 + (j >> 2)) + 4 * (lane >> 4) + (j & 3)];
    uint4 o;
    o.x = pack2bf(v[0], v[1]); o.y = pack2bf(v[2], v[3]); o.z = pack2bf(v[4], v[5]); o.w = pack2bf(v[6], v[7]);
    *(uint4*)(p.kf + (size_t)u * 8) = o;
  }
  {
    const int lane = tidx_ & 63;
    const int gw = (bidx_ * NTHREADS + tidx_) >> 6, nw = gsz >> 6;
    for (int row = gw; row < DEPTH * 16384 * 2; row += nw) {
      const int tbl = row & 1, er = row >> 1;
      const float* src = (tbl ? p.peer_v : p.peer_u) + (size_t)er * 1024 + lane * 16;
      float4 f[4];
#pragma unroll
      for (int i = 0; i < 4; ++i) f[i] = *(const float4*)(src + 4 * i);
      float m = 0.f;
#pragma unroll
      for (int i = 0; i < 4; ++i) m = fmaxf(m, fmaxf(fmaxf(fabsf(f[i].x), fabsf(f[i].y)), fmaxf(fabsf(f[i].z), fabsf(f[i].w))));
      m = wave_max(m);
      int k = 0;
      if (m > 0.f) {
        int e;
        const float fr = __builtin_frexpf(m, &e);
        k = ((fr <= 0.875f) ? 9 : 8) - e;
        k = k < -100 ? -100 : (k > 100 ? 100 : k);
      }
      const float sc = __builtin_ldexpf(1.0f, k);
      uint4 o;
      unsigned w[4];
#pragma unroll
      for (int i = 0; i < 4; ++i) {
        int pkd = 0;
        pkd = __builtin_amdgcn_cvt_pk_fp8_f32(f[i].x * sc, f[i].y * sc, pkd, false);
        pkd = __builtin_amdgcn_cvt_pk_fp8_f32(f[i].z * sc, f[i].w * sc, pkd, true);
        w[i] = (unsigned)pkd;
      }
      o.x = w[0]; o.y = w[1]; o.z = w[2]; o.w = w[3];
      *(uint4*)((tbl ? p.v8 : p.u8) + (size_t)er * 1024 + lane * 16) = o;
      if (lane == 0) ((float*)p.escale)[(size_t)er * 2 + tbl] = __builtin_ldexpf(1.0f, -k);
    }
  }
  for (int u = gtid; u < SEQ * 32; u += gsz) {
    const int i = u & 31, pos = u >> 5;
    float inv = 1.0f / powf(10000.0f, (float)i / 31.0f);
    float ang = (float)pos * inv;
    double rev = (double)ang * 0.15915494309189535;
    rev -= floor(rev);
    float rf = (float)rev;
    p.rope[u] = make_float2(__builtin_amdgcn_cosf(rf), __builtin_amdgcn_sinf(rf));
  }
}

template <int NT, int PD, int RING>
__device__ __forceinline__ void tl_gemm_prologue(const bf16_t* __restrict__ wf, bf16x8 (&wb)[RING][NT], const int lane, const int nt0 = 0) {
  const bf16x8* wp = (const bf16x8*)wf + lane + nt0 * 64;
#pragma unroll
  for (int s = 0; s < PD; ++s)
#pragma unroll
    for (int nt = 0; nt < NT; ++nt) wb[s][nt] = wp[(s * 4 + nt) * 64];
}
template <int NT, int PD, int RING>
__device__ __forceinline__ void tl_gemm_main(const bf16_t* __restrict__ wf, const int KS, const char* xt, const int kbyte0,
                                             f32x4 (&acc)[NT][4], bf16x8 (&wb)[RING][NT], const int lane, const int nt0 = 0) {
  const bf16x8* wp = (const bf16x8*)wf + lane + nt0 * 64;
  const char* xp = xt + (lane & 15) * LDXB + kbyte0 + (lane >> 4) * 16;
  for (int ks = 0; ks < KS; ks += RING) {
#pragma unroll
    for (int u = 0; u < RING; ++u) {
      int kpre = ks + u + PD;
      kpre = kpre < KS ? kpre : KS - 1;
#pragma unroll
      for (int nt = 0; nt < NT; ++nt) wb[(u + PD) % RING][nt] = wp[(kpre * 4 + nt) * 64];
      bf16x8 xf[4];
#pragma unroll
      for (int mt = 0; mt < 4; ++mt) xf[mt] = *(const bf16x8*)(xp + mt * 16 * LDXB + (ks + u) * 64);
#pragma unroll
      for (int nt = 0; nt < NT; ++nt)
#pragma unroll
        for (int mt = 0; mt < 4; ++mt)
          acc[nt][mt] = __builtin_amdgcn_mfma_f32_16x16x32_bf16(wb[u][nt], xf[mt], acc[nt][mt], 0, 0, 0);
    }
  }
}
template <int NT, int PD = 3, int RING = 4>
__device__ __forceinline__ void tl_gemm_chunk(const bf16_t* __restrict__ wf, const int KS, const char* xt, const int kbyte0,
                                              f32x4 (&acc)[NT][4], const int lane, const int nt0 = 0) {
  bf16x8 wb[RING][NT];
  tl_gemm_prologue<NT, PD, RING>(wf, wb, lane, nt0);
  tl_gemm_main<NT, PD, RING>(wf, KS, xt, kbyte0, acc, wb, lane, nt0);
}

__device__ __forceinline__ void tile_rmsnorm_to_lds(const float* __restrict__ xsrc, const float* __restrict__ g, int t0,
                                                    char* xt, int wave, int lane) {
#pragma unroll 2
  for (int i = 0; i < 8; ++i) {
    const int tok = wave * 8 + i;
    const float* xr = xsrc + (size_t)(t0 + tok) * D_MODEL;
    float4 v[4];
    float ss = 0.f;
#pragma unroll
    for (int q = 0; q < 4; ++q) {
      v[q] = *(const float4*)(xr + q * 256 + lane * 4);
      ss += v[q].x * v[q].x + v[q].y * v[q].y + v[q].z * v[q].z + v[q].w * v[q].w;
    }
    ss = wave_sum(ss);
    const float r = rsqrtf(ss * (1.0f / D_MODEL) + EPS);
#pragma unroll
    for (int q = 0; q < 4; ++q) {
      float4 gg = *(const float4*)(g + q * 256 + lane * 4);
      uint2 o;
      o.x = pack2bf(v[q].x * r * gg.x, v[q].y * r * gg.y);
      o.y = pack2bf(v[q].z * r * gg.z, v[q].w * r * gg.w);
      *(uint2*)(xt + tok * LDXB + (q * 256 + lane * 4) * 2) = o;
    }
  }
}

__device__ __forceinline__ void o_p1(const int wv_, const Params& p, int l, const float* __restrict__ xsrc, char* smem) {
  const int tidx_ = opaque_tid(wv_); const int bidx_ = opaque_bid();
  const int wave = tidx_ >> 6, lane = tidx_ & 63;
  const bf16_t* wf = p.wf_in + (size_t)l * D_MODEL * IN_WIDTH;
  const float* g = p.norm_mix + l * D_MODEL;
  for (int tile = bidx_; tile < NTOK / 64; tile += gridDim.x) {
    const int t0 = tile * 64;
    __syncthreads();
    tile_rmsnorm_to_lds(xsrc, g, t0, smem, wave, lane);
    __syncthreads();
#pragma unroll 1
    for (int c = wave; c < IN_WIDTH / 64; c += 8) {
      f32x4 acc[4][4];
#pragma unroll
      for (int a = 0; a < 4; ++a)
#pragma unroll
        for (int b = 0; b < 4; ++b) acc[a][b] = (f32x4){0.f, 0.f, 0.f, 0.f};
      tl_gemm_chunk<4, 5, 8>(wf + (size_t)c * 32 * 4 * 64 * 8, 32, smem, 0, acc, lane);
      asm volatile("" ::: "memory");
      if (c >= 4 && c < 12) {
        const float sc = (c >= 8) ? 0.125f : 1.0f;
#pragma unroll
        for (int mt = 0; mt < 4; ++mt) {
          const int tok = t0 + mt * 16 + (lane & 15);
          const int pos = tok & (SEQ - 1);
#pragma unroll
          for (int nt = 0; nt < 2; ++nt) {
            const int i0 = nt * 16 + 4 * (lane >> 4);
            const float4 cs01 = *(const float4*)(p.rope + pos * 32 + i0);
            const float4 cs23 = *(const float4*)(p.rope + pos * 32 + i0 + 2);
            const float cc[4] = {cs01.x, cs01.z, cs23.x, cs23.z};
            const float sn[4] = {cs01.y, cs01.w, cs23.y, cs23.w};
#pragma unroll
            for (int r = 0; r < 4; ++r) {
              const float x1 = acc[nt][mt][r], x2 = acc[nt + 2][mt][r];
              acc[nt][mt][r] = (x1 * cc[r] - x2 * sn[r]) * sc;
              acc[nt + 2][mt][r] = (x1 * sn[r] + x2 * cc[r]) * sc;
            }
          }
        }
      } else if (c >= 28 && c < 32) {
#pragma unroll
        for (int a = 0; a < 4; ++a)
#pragma unroll
          for (int b = 0; b < 4; ++b) acc[a][b] *= 0.125f;
      } else if (c >= 40) {
#pragma unroll
        for (int a = 0; a < 4; ++a)
#pragma unroll
          for (int b = 0; b < 4; ++b)
#pragma unroll
            for (int r = 0; r < 4; ++r) acc[a][b][r] = 1.0f / (1.0f + __expf(-acc[a][b][r]));
      }
#pragma unroll
      for (int mt = 0; mt < 4; ++mt) {
        const int tok = t0 + mt * 16 + (lane & 15);
        bf16_t* dst = p.proj + (size_t)tok * IN_WIDTH + c * 64 + 4 * (lane >> 4);
#pragma unroll
        for (int nt = 0; nt < 4; ++nt) {
          uint2 o;
          o.x = pack2bf(acc[nt][mt][0], acc[nt][mt][1]);
          o.y = pack2bf(acc[nt][mt][2], acc[nt][mt][3]);
          *(uint2*)(dst + nt * 16) = o;
        }
      }
    }
  }
}


__device__ __forceinline__ void o_final_norm_tile(const Params& p, int t0, int tid) {
  const int wave = tid >> 6, lane = tid & 63;
#pragma unroll 2
  for (int i = 0; i < 8; ++i) {
    const size_t row = (size_t)(t0 + wave * 8 + i) * D_MODEL;
    float4 v[4];
    float ss = 0.f;
#pragma unroll
    for (int q = 0; q < 4; ++q) {
      v[q] = *(const float4*)(p.xres + row + q * 256 + lane * 4);
      ss += v[q].x * v[q].x + v[q].y * v[q].y + v[q].z * v[q].z + v[q].w * v[q].w;
    }
    ss = wave_sum(ss);
    const float r = rsqrtf(ss * (1.0f / D_MODEL) + EPS);
#pragma unroll
    for (int q = 0; q < 4; ++q) {
      const float4 gg = *(const float4*)(p.norm_final + q * 256 + lane * 4);
      *(float4*)(p.out + row + q * 256 + lane * 4) = make_float4(v[q].x * r * gg.x, v[q].y * r * gg.y, v[q].z * r * gg.z, v[q].w * r * gg.w);
    }
  }
}

__device__ __forceinline__ void tile_load_to_lds(const bf16_t* __restrict__ src, int ld, char* xt, int tid) {
#pragma unroll 4
  for (int it = 0; it < 16; ++it) {
    const int idx = it * NTHREADS + tid;
    const int row = idx >> 7, u = idx & 127;
    const uint4 v = *(const uint4*)(src + (size_t)row * ld + u * 8);
    *(uint4*)(xt + row * LDXB + u * 16) = v;
  }
}

__device__ __forceinline__ void o_p5a1_tile(const Params& p, int l, int t0, char* smem, int tid) {
  const int wave = tid >> 6, lane = tid & 63;
  __syncthreads();
  tile_load_to_lds(p.ycat + (size_t)t0 * 1024, 1024, smem, tid);
  __syncthreads();
  const bf16_t* wfb = p.wf_br + (size_t)l * 1024 * 1024;
  bf16x8 wb[4][2];
  f32x4 m[2][4];
  {
    const int c0 = wave >> 1, nt00 = (wave & 1) * 2;
    tl_gemm_prologue<2, 3, 4>(wfb + (size_t)c0 * 8 * 4 * 64 * 8, wb, lane, nt00);
  }
#pragma unroll 1
  for (int it = 0; it < 12; ++it) {
    const int hi = it / 3, br = it - hi * 3;
    const int hc = wave + 8 * hi;
    const int c = hc >> 1, nt0 = (hc & 1) * 2;
    const int koff = (br == 0) ? 0 : (br == 1 ? 256 : 768);
    const int KS = (br == 1) ? 16 : 8;
    uint2 gv[4][2];
#pragma unroll
    for (int mt = 0; mt < 4; ++mt) {
      const int tok = t0 + mt * 16 + (lane & 15);
      const bf16_t* gp = p.proj + (size_t)tok * IN_WIDTH + C_GATE + br * 1024 + c * 64 + nt0 * 16 + 4 * (lane >> 4);
#pragma unroll
      for (int nt = 0; nt < 2; ++nt) gv[mt][nt] = *(const uint2*)(gp + nt * 16);
    }
    f32x4 acc[2][4];
#pragma unroll
    for (int a2 = 0; a2 < 2; ++a2)
#pragma unroll
      for (int b2 = 0; b2 < 4; ++b2) acc[a2][b2] = (f32x4){0.f, 0.f, 0.f, 0.f};
    tl_gemm_main<2, 3, 4>(wfb + (size_t)koff * 1024 + (size_t)c * KS * 4 * 64 * 8, KS, smem, koff * 2, acc, wb, lane, nt0);
    asm volatile("" ::: "memory");
    {
      const int itn = (it + 1 < 12) ? it + 1 : it;
      const int hin = itn / 3, brn = itn - hin * 3;
      const int hcn = wave + 8 * hin;
      const int koffn = (brn == 0) ? 0 : (brn == 1 ? 256 : 768);
      const int KSn = (brn == 1) ? 16 : 8;
      tl_gemm_prologue<2, 3, 4>(wfb + (size_t)koffn * 1024 + (size_t)(hcn >> 1) * KSn * 4 * 64 * 8, wb, lane, (hcn & 1) * 2);
    }
    if (br == 0) {
#pragma unroll
      for (int a2 = 0; a2 < 2; ++a2)
#pragma unroll
        for (int b2 = 0; b2 < 4; ++b2) m[a2][b2] = (f32x4){0.f, 0.f, 0.f, 0.f};
    }
#pragma unroll
    for (int mt = 0; mt < 4; ++mt)
#pragma unroll
      for (int nt = 0; nt < 2; ++nt) {
        m[nt][mt][0] += __uint_as_float(gv[mt][nt].x << 16) * acc[nt][mt][0];
        m[nt][mt][1] += __uint_as_float(gv[mt][nt].x & 0xffff0000u) * acc[nt][mt][1];
        m[nt][mt][2] += __uint_as_float(gv[mt][nt].y << 16) * acc[nt][mt][2];
        m[nt][mt][3] += __uint_as_float(gv[mt][nt].y & 0xffff0000u) * acc[nt][mt][3];
      }
    if (br == 2) {
#pragma unroll
      for (int mt = 0; mt < 4; ++mt) {
        const int tok = t0 + mt * 16 + (lane & 15);
        bf16_t* dst = p.mrg + (size_t)tok * 1024 + c * 64 + nt0 * 16 + 4 * (lane >> 4);
#pragma unroll
        for (int nt = 0; nt < 2; ++nt) {
          uint2 o;
          o.x = pack2bf(m[nt][mt][0], m[nt][mt][1]);
          o.y = pack2bf(m[nt][mt][2], m[nt][mt][3]);
          *(uint2*)(dst + nt * 16) = o;
        }
      }
    }
  }
}
__device__ __forceinline__ void o_p5a2_tile(const Params& p, int l, const float* __restrict__ xcur, int t0, char* smem, int tid) {
  const int wave = tid >> 6, lane = tid & 63;
  __syncthreads();
  tile_load_to_lds(p.mrg + (size_t)t0 * 1024, 1024, smem, tid);
  __syncthreads();
  const bf16_t* wfo = p.wf_out + (size_t)l * 1024 * 1024;
#pragma unroll 1
  for (int c = wave; c < 16; c += 8) {
    f32x4 acc[4][4];
#pragma unroll
    for (int a = 0; a < 4; ++a)
#pragma unroll
      for (int b = 0; b < 4; ++b) acc[a][b] = (f32x4){0.f, 0.f, 0.f, 0.f};
    tl_gemm_chunk<4, 2>(wfo + (size_t)c * 32 * 4 * 64 * 8, 32, smem, 0, acc, lane);
    asm volatile("" ::: "memory");
#pragma unroll
    for (int mt = 0; mt < 4; ++mt) {
      const int tok = t0 + mt * 16 + (lane & 15);
      const size_t o = (size_t)tok * 1024 + c * 64 + 4 * (lane >> 4);
#pragma unroll
      for (int nt = 0; nt < 4; ++nt) {
        float4 xv = *(const float4*)(xcur + o + nt * 16);
        xv.x += acc[nt][mt][0]; xv.y += acc[nt][mt][1]; xv.z += acc[nt][mt][2]; xv.w += acc[nt][mt][3];
        *(float4*)(p.xres + o + nt * 16) = xv;
      }
    }
  }
}
__device__ __forceinline__ void o_p5a3_tile(const Params& p, int l, int t0, char* smem, int tid) {
  const int wave = tid >> 6, lane = tid & 63;
  __syncthreads();
  tile_rmsnorm_to_lds(p.xres, p.norm_ffn + l * D_MODEL, t0, smem, wave, lane);
  __syncthreads();
}


__device__ __forceinline__ unsigned mono_f(float f) {
  unsigned u = __float_as_uint(f);
  return (u & 0x80000000u) ? ~u : (u | 0x80000000u);
}
__device__ __forceinline__ float unmono_f(unsigned m) {
  return __uint_as_float((m & 0x80000000u) ? (m & 0x7fffffffu) : ~m);
}
#define CE_DESC(x, y) { const unsigned hi_ = max(x, y); const unsigned lo_ = min(x, y); x = hi_; y = lo_; }
#define CE_ASC(x, y) { const unsigned hi_ = max(x, y); const unsigned lo_ = min(x, y); x = lo_; y = hi_; }
__device__ __forceinline__ void sort16_desc(unsigned (&a)[16]) {
#pragma unroll
  for (int k = 2; k <= 16; k <<= 1) {
#pragma unroll
    for (int j = k >> 1; j > 0; j >>= 1) {
#pragma unroll
      for (int i = 0; i < 16; ++i) {
        const int l = i ^ j;
        if (l > i) {
          if ((i & k) == 0) CE_DESC(a[i], a[l]) else CE_ASC(a[i], a[l])
        }
      }
    }
  }
}
__device__ __forceinline__ void bitonic_merge16_desc(unsigned (&a)[16]) {
#pragma unroll
  for (int j = 8; j > 0; j >>= 1) {
#pragma unroll
    for (int i = 0; i < 16; ++i) {
      const int l = i ^ j;
      if (l > i) CE_DESC(a[i], a[l])
    }
  }
}
__device__ __forceinline__ void xlane_merge16(unsigned (&a)[16], int mask) {
  unsigned b[16];
#pragma unroll
  for (int i = 0; i < 16; ++i) b[i] = (unsigned)__shfl_xor((int)a[i], mask, 64);
#pragma unroll
  for (int i = 0; i < 16; ++i) a[i] = max(a[i], b[15 - i]);
  bitonic_merge16_desc(a);
}

__device__ __forceinline__ void o_peer_select_tile(const Params& p, int l, int t0, char* smem, int tid) {
  const int h = __builtin_amdgcn_readfirstlane(tid >> 6), lane = tid & 63;
  const int g = lane >> 4, tl = lane & 15;
  const bf16_t* wfq = p.wf_q + (size_t)l * 1024 * 2048;
#pragma unroll 1
  for (int pp = 0; pp < 2; ++pp) {
    bf16x8 qf[4][4];
#pragma unroll 1
    for (int cc = 0; cc < 2; ++cc) {
      const int c = (h * 2 + pp) * 2 + cc;
      f32x4 acc[4][4];
#pragma unroll
      for (int a = 0; a < 4; ++a)
#pragma unroll
        for (int b = 0; b < 4; ++b) acc[a][b] = (f32x4){0.f, 0.f, 0.f, 0.f};
      tl_gemm_chunk<4, 2>(wfq + (size_t)c * 32 * 4 * 64 * 8, 32, smem, 0, acc, lane);
#pragma unroll
      for (int sl = 0; sl < 2; ++sl)
#pragma unroll
        for (int mt = 0; mt < 4; ++mt) {
          union { bf16x8 v; unsigned u[4]; } cv;
          cv.u[0] = pack2bf(acc[2 * sl][mt][0], acc[2 * sl][mt][1]);
          cv.u[1] = pack2bf(acc[2 * sl][mt][2], acc[2 * sl][mt][3]);
          cv.u[2] = pack2bf(acc[2 * sl + 1][mt][0], acc[2 * sl + 1][mt][1]);
          cv.u[3] = pack2bf(acc[2 * sl + 1][mt][2], acc[2 * sl + 1][mt][3]);
          if (cc == 0) qf[sl][mt] = cv.v; else qf[2 + sl][mt] = cv.v;
        }
    }
    const bf16x8* kfp = (const bf16x8*)p.kf + (size_t)((l * 2 + pp) * 8) * 4 * 64 + lane;
#pragma unroll
    for (int mt = 0; mt < 4; ++mt) {
      f32x4 sc[8];
#pragma unroll
      for (int kt = 0; kt < 8; ++kt) sc[kt] = (f32x4){0.f, 0.f, 0.f, 0.f};
#pragma unroll
      for (int s2 = 0; s2 < 4; ++s2) {
        bf16x8 qv;
        qv = qf[s2][mt];
#pragma unroll
        for (int kt = 0; kt < 8; ++kt)
          sc[kt] = __builtin_amdgcn_mfma_f32_16x16x32_bf16(kfp[(kt * 4 + s2) * 64], qv, sc[kt], 0, 0, 0);
        __builtin_amdgcn_sched_barrier(0);
      }
      unsigned A[16], B[16];
#pragma unroll
      for (int kt = 0; kt < 4; ++kt)
#pragma unroll
        for (int r = 0; r < 4; ++r) {
          A[kt * 4 + r] = (mono_f(sc[kt][r]) & ~127u) | (unsigned)(127 - (kt * 16 + r) - 4 * g);
          B[kt * 4 + r] = (mono_f(sc[kt + 4][r]) & ~127u) | (unsigned)(127 - ((kt + 4) * 16 + r) - 4 * g);
        }
      sort16_desc(A);
      sort16_desc(B);
#pragma unroll
      for (int i = 0; i < 16; ++i) A[i] = max(A[i], B[15 - i]);
      bitonic_merge16_desc(A);
      xlane_merge16(A, 16);
      xlane_merge16(A, 32);
      if (g == 0) {
        uint4* dst = (uint4*)(p.tklist + ((size_t)((t0 + mt * 16 + tl) * 8 + h) * 2 + pp) * 16);
        dst[0] = make_uint4(A[0], A[1], A[2], A[3]);
        dst[1] = make_uint4(A[4], A[5], A[6], A[7]);
        dst[2] = make_uint4(A[8], A[9], A[10], A[11]);
        dst[3] = make_uint4(A[12], A[13], A[14], A[15]);
      }
    }
  }
  asm volatile("s_waitcnt vmcnt(0)" ::: "memory");
}

__device__ __forceinline__ void o_peer_select2_tile(const Params& p, int l, int t0, int tid) {
  const int h = __builtin_amdgcn_readfirstlane(tid >> 6), lane = tid & 63;
  const int g = lane >> 4, tl = lane & 15;
#pragma unroll 1
  for (int mt = 0; mt < 4; ++mt) {
    const int tok = t0 + mt * 16 + tl;
    const unsigned* lp = p.tklist + ((size_t)(tok * 8 + h) * 2) * 16;
    float v1[16], v2[16];
    {
      const uint4* q4 = (const uint4*)lp;
#pragma unroll
      for (int i = 0; i < 4; ++i) {
        uint4 x = q4[i], y = q4[4 + i];
        v1[4 * i + 0] = unmono_f(x.x & ~127u); v1[4 * i + 1] = unmono_f(x.y & ~127u);
        v1[4 * i + 2] = unmono_f(x.z & ~127u); v1[4 * i + 3] = unmono_f(x.w & ~127u);
        v2[4 * i + 0] = unmono_f(y.x & ~127u); v2[4 * i + 1] = unmono_f(y.y & ~127u);
        v2[4 * i + 2] = unmono_f(y.z & ~127u); v2[4 * i + 3] = unmono_f(y.w & ~127u);
      }
    }
    unsigned C[16];
#pragma unroll
    for (int i = 0; i < 16; ++i) C[i] = 0u;
    {
      int idx = 0;
#pragma unroll
      for (int a = 0; a < 16; ++a) {
#pragma unroll
        for (int b = 0; b < 16; ++b) {
          if ((a + 1) * (b + 1) <= 16) {
            const unsigned key = (mono_f(v1[a] + v2[b]) & ~255u) | (unsigned)(255 - (a * 16 + b));
            const int slot = idx >> 2, who = idx & 3;
            C[slot] = (g == who) ? key : C[slot];
            ++idx;
          }
        }
      }
    }
    sort16_desc(C);
    xlane_merge16(C, 16);
    xlane_merge16(C, 32);
    const float f0 = unmono_f(C[0] & ~255u);
    float den = 0.f;
    float ev[16];
#pragma unroll
    for (int i = 0; i < 16; ++i) { ev[i] = __expf(unmono_f(C[i] & ~255u) - f0); den += ev[i]; }
    const float rden = 1.0f / den;
    int eidx[4]; float egate[4];
#pragma unroll
    for (int i = 0; i < 4; ++i) {
      const unsigned k = (g == 0) ? C[i] : (g == 1) ? C[4 + i] : (g == 2) ? C[8 + i] : C[12 + i];
      const float e = (g == 0) ? ev[i] : (g == 1) ? ev[4 + i] : (g == 2) ? ev[8 + i] : ev[12 + i];
      const int pos = 255 - (int)(k & 255u);
      const int a = pos >> 4, b = pos & 15;
      const int n1 = 127 - (int)(lp[a] & 127u);
      const int n2 = 127 - (int)(lp[16 + b] & 127u);
      eidx[i] = n1 * 128 + n2;
      egate[i] = e * rden;
    }
    *(int4*)(p.pidx + (size_t)tok * 128 + h * 16 + 4 * g) = make_int4(eidx[0], eidx[1], eidx[2], eidx[3]);
    *(float4*)(p.pgate + (size_t)tok * 128 + h * 16 + 4 * g) = make_float4(egate[0], egate[1], egate[2], egate[3]);
  }
}

__device__ __forceinline__ float logsigmoid_(float x) { return fminf(x, 0.f) - log1pf(expf(-fabsf(x))); }
__device__ __forceinline__ float bf_lo(unsigned w) { return __uint_as_float(w << 16); }
__device__ __forceinline__ float bf_hi(unsigned w) { return __uint_as_float(w & 0xffff0000u); }

#define RKV_LD 136
__device__ __forceinline__ void o_ret_kv_task(const Params& p, int l, int task, char* smem, int tid) {
  const int wave = tid >> 6, lane = tid & 63, g = lane >> 4, tl = lane & 15;
  const int bh = task >> 5, n = task & 31, b = bh >> 2, h = bh & 3;
  const int tok0 = b * SEQ + n * 128;
  const float lgf = logsigmoid_(p.ret_decay[l * 8 + h]), lgb = logsigmoid_(p.ret_decay[l * 8 + 4 + h]);
  bf16_t* KTf = (bf16_t*)smem;
  bf16_t* KTb = KTf + 64 * RKV_LD;
  bf16_t* VT = KTb + 64 * RKV_LD;
  __syncthreads();
#pragma unroll
  for (int it = 0; it < 2; ++it) {
    const int u = tid + it * NTHREADS;
    const int j = u >> 3, d0 = (u & 7) * 8;
    const uint4 kv = *(const uint4*)(p.proj + (size_t)(tok0 + j) * IN_WIDTH + C_RK + h * 64 + d0);
    const float wf = __expf(lgf * (float)(127 - j)), wb = __expf(lgb * (float)(j + 1));
    const unsigned kw[4] = {kv.x, kv.y, kv.z, kv.w};
#pragma unroll
    for (int e = 0; e < 4; ++e) {
      const float x0 = bf_lo(kw[e]), x1 = bf_hi(kw[e]);
      KTf[(d0 + 2 * e) * RKV_LD + j] = f2bf(x0 * wf);
      KTf[(d0 + 2 * e + 1) * RKV_LD + j] = f2bf(x1 * wf);
      KTb[(d0 + 2 * e) * RKV_LD + j] = f2bf(x0 * wb);
      KTb[(d0 + 2 * e + 1) * RKV_LD + j] = f2bf(x1 * wb);
    }
  }
#pragma unroll
  for (int it = 0; it < 4; ++it) {
    const int u = tid + it * NTHREADS;
    const int j = u >> 4, e0 = (u & 15) * 8;
    const uint4 vv = *(const uint4*)(p.proj + (size_t)(tok0 + j) * IN_WIDTH + C_RV + h * 128 + e0);
    const unsigned vw[4] = {vv.x, vv.y, vv.z, vv.w};
#pragma unroll
    for (int e = 0; e < 4; ++e) {
      VT[(e0 + 2 * e) * RKV_LD + j] = (bf16_t)(vw[e] & 0xffffu);
      VT[(e0 + 2 * e + 1) * RKV_LD + j] = (bf16_t)(vw[e] >> 16);
    }
  }
  __syncthreads();
  bf16x8 a[4];
#pragma unroll
  for (int ks = 0; ks < 4; ++ks) a[ks] = *(const bf16x8*)(VT + (wave * 16 + tl) * RKV_LD + ks * 32 + 8 * g);
#pragma unroll
  for (int dir = 0; dir < 2; ++dir) {
    const bf16_t* KT = dir ? KTb : KTf;
#pragma unroll
    for (int dt = 0; dt < 4; ++dt) {
      f32x4 acc = (f32x4){0.f, 0.f, 0.f, 0.f};
#pragma unroll
      for (int ks = 0; ks < 4; ++ks) {
        const bf16x8 bb = *(const bf16x8*)(KT + (dt * 16 + tl) * RKV_LD + ks * 32 + 8 * g);
        acc = __builtin_amdgcn_mfma_f32_16x16x32_bf16(a[ks], bb, acc, 0, 0, 0);
      }
      float* dst = p.kvst + ((size_t)(task * 2 + dir) * 128 + wave * 16 + 4 * g) * 64 + dt * 16 + tl;
#pragma unroll
      for (int r = 0; r < 4; ++r) dst[r * 64] = acc[r];
    }
  }
}

__device__ __forceinline__ void o_ret_scan(const int wv_, const Params& p, int l) {
  const int tidx_ = opaque_tid(wv_); const int bidx_ = opaque_bid();
  const int gsz = gridDim.x * NTHREADS;
  for (int u = bidx_ * NTHREADS + tidx_; u < 16 * 2 * 128 * 16; u += gsz) {
    const int dq = u & 15, e = (u >> 4) & 127, dir = (u >> 11) & 1, bh = u >> 12, h = bh & 3;
    const float lg = logsigmoid_(p.ret_decay[l * 8 + dir * 4 + h]);
    const float gC = __expf(lg * 128.0f);
    float4 st = make_float4(0.f, 0.f, 0.f, 0.f);
#pragma unroll 8
    for (int nn = 0; nn < 32; ++nn) {
      const int n = dir ? (31 - nn) : nn;
      const size_t idx = ((size_t)((bh * 32 + n) * 2 + dir) * 128 + e) * 64 + dq * 4;
      const float4 kv = *(const float4*)(p.kvst + idx);
      uint2 o;
      o.x = pack2bf(st.x, st.y); o.y = pack2bf(st.z, st.w);
      *(uint2*)(p.rstate + idx) = o;
      st.x = fmaf(st.x, gC, kv.x); st.y = fmaf(st.y, gC, kv.y); st.z = fmaf(st.z, gC, kv.z); st.w = fmaf(st.w, gC, kv.w);
    }
  }
}

#define RO_LD 264
#define RK_LD 72
__device__ __forceinline__ void o_ret_out_task(const Params& p, int l, int task, char* smem, int tid) {
  const int wave = tid >> 6, lane = tid & 63, g = lane >> 4, tl = lane & 15;
  const int bh = task >> 5, n = task & 31, b = bh >> 2, h = bh & 3;
  const int tok0 = b * SEQ + n * 128;
  const float lgf = logsigmoid_(p.ret_decay[l * 8 + h]), lgb = logsigmoid_(p.ret_decay[l * 8 + 4 + h]);
  bf16_t* Acat = (bf16_t*)smem;
  bf16_t* Bcat = Acat + 128 * RO_LD;
  bf16_t* Kl = Bcat + 128 * RO_LD;
  __syncthreads();
#pragma unroll
  for (int it = 0; it < 2; ++it) {
    const int u = tid + it * NTHREADS;
    const int i = u >> 3, d0 = (u & 7) * 8;
    const size_t row = (size_t)(tok0 + i) * IN_WIDTH;
    const uint4 qv = *(const uint4*)(p.proj + row + C_RQ + h * 64 + d0);
    const uint4 kv = *(const uint4*)(p.proj + row + C_RK + h * 64 + d0);
    *(uint4*)(Acat + i * RO_LD + d0) = qv;
    *(uint4*)(Kl + i * RK_LD + d0) = kv;
    const float wf = __expf(lgf * (float)(i + 1)), wb = __expf(lgb * (float)(127 - i));
    const unsigned qw[4] = {qv.x, qv.y, qv.z, qv.w};
    uint4 of, ob;
    of.x = pack2bf(bf_lo(qw[0]) * wf, bf_hi(qw[0]) * wf); ob.x = pack2bf(bf_lo(qw[0]) * wb, bf_hi(qw[0]) * wb);
    of.y = pack2bf(bf_lo(qw[1]) * wf, bf_hi(qw[1]) * wf); ob.y = pack2bf(bf_lo(qw[1]) * wb, bf_hi(qw[1]) * wb);
    of.z = pack2bf(bf_lo(qw[2]) * wf, bf_hi(qw[2]) * wf); ob.z = pack2bf(bf_lo(qw[2]) * wb, bf_hi(qw[2]) * wb);
    of.w = pack2bf(bf_lo(qw[3]) * wf, bf_hi(qw[3]) * wf); ob.w = pack2bf(bf_lo(qw[3]) * wb, bf_hi(qw[3]) * wb);
    *(uint4*)(Acat + i * RO_LD + 128 + d0) = of;
    *(uint4*)(Acat + i * RO_LD + 192 + d0) = ob;
  }
#pragma unroll
  for (int it = 0; it < 4; ++it) {
    const int u = tid + it * NTHREADS;
    const int j = u >> 4, e0 = (u & 15) * 8;
    const uint4 vv = *(const uint4*)(p.proj + (size_t)(tok0 + j) * IN_WIDTH + C_RV + h * 128 + e0);
    const unsigned vw[4] = {vv.x, vv.y, vv.z, vv.w};
#pragma unroll
    for (int e = 0; e < 4; ++e) {
      Bcat[(e0 + 2 * e) * RO_LD + j] = (bf16_t)(vw[e] & 0xffffu);
      Bcat[(e0 + 2 * e + 1) * RO_LD + j] = (bf16_t)(vw[e] >> 16);
    }
  }
#pragma unroll
  for (int it = 0; it < 4; ++it) {
    const int u = tid + it * NTHREADS;
    const int d0 = (u & 7) * 8, e = (u >> 3) & 127, dir = u >> 10;
    const uint4 sv = *(const uint4*)(p.rstate + ((size_t)(task * 2 + dir) * 128 + e) * 64 + d0);
    *(uint4*)(Bcat + e * RO_LD + 128 + dir * 64 + d0) = sv;
  }
  __syncthreads();
  f32x4 sc[8];
#pragma unroll
  for (int jt = 0; jt < 8; ++jt) sc[jt] = (f32x4){0.f, 0.f, 0.f, 0.f};
#pragma unroll
  for (int ks = 0; ks < 2; ++ks) {
    const bf16x8 qb = *(const bf16x8*)(Acat + (wave * 16 + tl) * RO_LD + ks * 32 + 8 * g);
#pragma unroll
    for (int jt = 0; jt < 8; ++jt) {
      const bf16x8 ka = *(const bf16x8*)(Kl + (jt * 16 + tl) * RK_LD + ks * 32 + 8 * g);
      sc[jt] = __builtin_amdgcn_mfma_f32_16x16x32_bf16(ka, qb, sc[jt], 0, 0, 0);
    }
  }
  {
    const int i = wave * 16 + tl;
#pragma unroll
    for (int jt = 0; jt < 8; ++jt) {
      float pv[4];
#pragma unroll
      for (int r = 0; r < 4; ++r) {
        const int j = jt * 16 + 4 * g + r;
        const float dd = (j <= i) ? __expf(lgf * (float)(i - j)) : __expf(lgb * (float)(j - i));
        pv[r] = sc[jt][r] * dd;
      }
      uint2 o;
      o.x = pack2bf(pv[0], pv[1]); o.y = pack2bf(pv[2], pv[3]);
      *(uint2*)(Acat + i * RO_LD + jt * 16 + 4 * g) = o;
    }
  }
  f32x4 y[8];
#pragma unroll
  for (int et = 0; et < 8; ++et) y[et] = (f32x4){0.f, 0.f, 0.f, 0.f};
#pragma unroll
  for (int ks = 0; ks < 8; ++ks) {
    const bf16x8 ab = *(const bf16x8*)(Acat + (wave * 16 + tl) * RO_LD + ks * 32 + 8 * g);
#pragma unroll
    for (int et = 0; et < 8; ++et) {
      const bf16x8 ba = *(const bf16x8*)(Bcat + (et * 16 + tl) * RO_LD + ks * 32 + 8 * g);
      y[et] = __builtin_amdgcn_mfma_f32_16x16x32_bf16(ba, ab, y[et], 0, 0, 0);
    }
  }
  float ss = 0.f;
#pragma unroll
  for (int et = 0; et < 8; ++et)
#pragma unroll
    for (int r = 0; r < 4; ++r) ss = fmaf(y[et][r], y[et][r], ss);
  ss += __shfl_xor(ss, 16, 64);
  ss += __shfl_xor(ss, 32, 64);
  const float rstd = rsqrtf(ss * (1.0f / 128.0f) + EPS);
  {
    const int tok = tok0 + wave * 16 + tl;
    const bf16_t* gp = p.proj + (size_t)tok * IN_WIDTH + C_RG + h * 128 + 4 * g;
    bf16_t* dst = p.ycat + (size_t)tok * 1024 + 256 + h * 128 + 4 * g;
#pragma unroll
    for (int et = 0; et < 8; ++et) {
      const uint2 gv = *(const uint2*)(gp + et * 16);
      const float g0 = bf_lo(gv.x), g1 = bf_hi(gv.x), g2 = bf_lo(gv.y), g3 = bf_hi(gv.y);
      uint2 o;
      o.x = pack2bf(g0 / (1.0f + __expf(-g0)) * y[et][0] * rstd, g1 / (1.0f + __expf(-g1)) * y[et][1] * rstd);
      o.y = pack2bf(g2 / (1.0f + __expf(-g2)) * y[et][2] * rstd, g3 / (1.0f + __expf(-g3)) * y[et][3] * rstd);
      *(uint2*)(dst + et * 16) = o;
    }
  }
}


#define NA_KLD 72
#define NA_VLD 520
__device__ __forceinline__ void o_na_task(const Params& p, int l, int task, char* smem, int tid) {
  const int wave = tid >> 6, lane = tid & 63, g = lane >> 4, tl = lane & 15;
  const int rr = task & 63, h = (task >> 6) & 3, b = task >> 8;
  int rs = rr - 4; rs = rs < 0 ? 0 : (rs > 56 ? 56 : rs);
  const int ktok0 = b * SEQ + rs * 64;
  const int qtok0 = b * SEQ + rr * 64;
  bf16_t* Kl = (bf16_t*)smem;
  bf16_t* VT = Kl + 512 * NA_KLD;
  bf16_t* Ql = VT + 64 * NA_VLD;
  float* rpbl = (float*)(Ql + 64 * NA_KLD);
  __syncthreads();
#pragma unroll
  for (int it = 0; it < 8; ++it) {
    const int u = tid + it * NTHREADS;
    const int key = u >> 3, d0 = (u & 7) * 8;
    const size_t row = (size_t)(ktok0 + key) * IN_WIDTH;
    const uint4 kv = *(const uint4*)(p.proj + row + C_NK + h * 64 + d0);
    const uint4 vv = *(const uint4*)(p.proj + row + C_NV + h * 64 + d0);
    *(uint4*)(Kl + key * NA_KLD + d0) = kv;
    const unsigned vw[4] = {vv.x, vv.y, vv.z, vv.w};
#pragma unroll
    for (int e = 0; e < 4; ++e) {
      VT[(d0 + 2 * e) * NA_VLD + key] = (bf16_t)(vw[e] & 0xffffu);
      VT[(d0 + 2 * e + 1) * NA_VLD + key] = (bf16_t)(vw[e] >> 16);
    }
  }
  {
    const int q = tid >> 3, d0 = (tid & 7) * 8;
    *(uint4*)(Ql + q * NA_KLD + d0) = *(const uint4*)(p.proj + (size_t)(qtok0 + q) * IN_WIDTH + C_NQ + h * 64 + d0);
    if (tid < 465) rpbl[tid] = p.na_rpb[((size_t)l * 4 + h) * 465 + tid];
  }
  __syncthreads();
  if (wave < 4) {
    const int qt = wave;
    int cw0 = 16 * qt - 8; cw0 = cw0 < 0 ? 0 : (cw0 > 32 ? 32 : cw0);
    f32x4 sc[16];
#pragma unroll
    for (int T = 0; T < 16; ++T) sc[T] = (f32x4){0.f, 0.f, 0.f, 0.f};
#pragma unroll
    for (int ks = 0; ks < 2; ++ks) {
      const bf16x8 qb = *(const bf16x8*)(Ql + (qt * 16 + tl) * NA_KLD + ks * 32 + 8 * g);
#pragma unroll
      for (int T = 0; T < 16; ++T) {
        const int key = (T >> 1) * 64 + cw0 + (T & 1) * 16 + tl;
        const bf16x8 ka = *(const bf16x8*)(Kl + key * NA_KLD + ks * 32 + 8 * g);
        sc[T] = __builtin_amdgcn_mfma_f32_16x16x32_bf16(ka, qb, sc[T], 0, 0, 0);
      }
    }
    const int cq = qt * 16 + tl;
    int cs = cq - 8; cs = cs < 0 ? 0 : (cs > 48 ? 48 : cs);
    float m = -3.0e38f;
#pragma unroll
    for (int T = 0; T < 16; ++T) {
      const int ri = T >> 1;
      const int di = rs + ri - rr + 7;
#pragma unroll
      for (int r = 0; r < 4; ++r) {
        const int ck = cw0 + (T & 1) * 16 + 4 * g + r;
        const bool valid = (ck >= cs) && (ck < cs + 16);
        int dj = ck - cq + 15; dj = dj < 0 ? 0 : (dj > 30 ? 30 : dj);
        const float sv = valid ? (sc[T][r] + rpbl[di * 31 + dj]) : -1.0e30f;
        sc[T][r] = sv;
        m = fmaxf(m, sv);
      }
    }
    m = fmaxf(m, __shfl_xor(m, 16, 64));
    m = fmaxf(m, __shfl_xor(m, 32, 64));
    float den = 0.f;
#pragma unroll
    for (int T = 0; T < 16; ++T)
#pragma unroll
      for (int r = 0; r < 4; ++r) {
        const float e = __expf(sc[T][r] - m);
        sc[T][r] = e;
        den += e;
      }
    den += __shfl_xor(den, 16, 64);
    den += __shfl_xor(den, 32, 64);
    const float rden = 1.0f / den;
    f32x4 o[4];
#pragma unroll
    for (int dt = 0; dt < 4; ++dt) o[dt] = (f32x4){0.f, 0.f, 0.f, 0.f};
#pragma unroll
    for (int ri = 0; ri < 8; ++ri) {
      union { bf16x8 v; unsigned u[4]; } pb;
      pb.u[0] = pack2bf(sc[2 * ri][0], sc[2 * ri][1]);
      pb.u[1] = pack2bf(sc[2 * ri][2], sc[2 * ri][3]);
      pb.u[2] = pack2bf(sc[2 * ri + 1][0], sc[2 * ri + 1][1]);
      pb.u[3] = pack2bf(sc[2 * ri + 1][2], sc[2 * ri + 1][3]);
#pragma unroll
      for (int dt = 0; dt < 4; ++dt) {
        const bf16_t* vp = VT + (dt * 16 + tl) * NA_VLD + ri * 64 + cw0 + 4 * g;
        union { bf16x8 v; uint2 h[2]; } va;
        va.h[0] = *(const uint2*)vp;
        va.h[1] = *(const uint2*)(vp + 16);
        o[dt] = __builtin_amdgcn_mfma_f32_16x16x32_bf16(va.v, pb.v, o[dt], 0, 0, 0);
      }
    }
    bf16_t* dst = p.ycat + (size_t)(qtok0 + qt * 16 + tl) * 1024 + 768 + h * 64 + 4 * g;
#pragma unroll
    for (int dt = 0; dt < 4; ++dt) {
      uint2 ov;
      ov.x = pack2bf(o[dt][0] * rden, o[dt][1] * rden);
      ov.y = pack2bf(o[dt][2] * rden, o[dt][3] * rden);
      *(uint2*)(dst + dt * 16) = ov;
    }
  }
}

#define PL_LD 264
__device__ __forceinline__ void o_pool_task(const Params& p, int l, int task, char* smem, int tid) {
  const int wave = tid >> 6, lane = tid & 63, g = lane >> 4, tl = lane & 15;
  const int t0 = task * 64, pos0 = t0 & (SEQ - 1);
  bf16_t* Xp = (bf16_t*)smem;
  bf16_t* WT = Xp + 80 * PL_LD;
  bf16_t* Df = WT + 4 * 64 * 72;
  __syncthreads();
#pragma unroll
  for (int it = 0; it < 5; ++it) {
    const int u = tid + it * NTHREADS;
    const int rw = u >> 5, c0 = (u & 31) * 8;
    const int pos = pos0 - 8 + rw;
    uint4 v = make_uint4(0u, 0u, 0u, 0u);
    if (pos >= 0 && pos < SEQ) v = *(const uint4*)(p.proj + (size_t)(t0 - 8 + rw) * IN_WIDTH + C_POOL + c0);
    *(uint4*)(Xp + rw * PL_LD + c0) = v;
  }
#pragma unroll
  for (int it = 0; it < 4; ++it) {
    const int u = tid + it * NTHREADS;
    const int e0 = (u & 7) * 8, c = (u >> 3) & 63, gi = u >> 9;
    const float* wp = p.pool_w + (((size_t)l * 4 + gi) * 64 + c) * 64 + e0;
    const float4 a = *(const float4*)wp, bq = *(const float4*)(wp + 4);
    const float wv[8] = {a.x, a.y, a.z, a.w, bq.x, bq.y, bq.z, bq.w};
#pragma unroll
    for (int k = 0; k < 8; ++k) WT[(gi * 64 + e0 + k) * 72 + c] = f2bf(wv[k]);
  }
  __syncthreads();
#pragma unroll 1
  for (int it = 0; it < 4; ++it) {
    const int u = tid + it * NTHREADS;
    const int t = u >> 5, c0 = (u & 31) * 8;
    const int gi = c0 >> 6;
    const int hw = 1 << gi;
    const int pos = pos0 + t;
    int a = pos - hw; a = a < 0 ? 0 : a;
    int bnd = pos + hw; bnd = bnd > SEQ ? SEQ : bnd;
    float sum[8];
#pragma unroll
    for (int k = 0; k < 8; ++k) sum[k] = 0.f;
    for (int rp = a; rp < bnd; ++rp) {
      const uint4 v = *(const uint4*)(Xp + (rp - pos0 + 8) * PL_LD + c0);
      sum[0] += bf_lo(v.x); sum[1] += bf_hi(v.x); sum[2] += bf_lo(v.y); sum[3] += bf_hi(v.y);
      sum[4] += bf_lo(v.z); sum[5] += bf_hi(v.z); sum[6] += bf_lo(v.w); sum[7] += bf_hi(v.w);
    }
    const float rc = 1.0f / (float)(bnd - a);
    const uint4 xv = *(const uint4*)(Xp + (t + 8) * PL_LD + c0);
    uint4 o;
    o.x = pack2bf(sum[0] * rc - bf_lo(xv.x), sum[1] * rc - bf_hi(xv.x));
    o.y = pack2bf(sum[2] * rc - bf_lo(xv.y), sum[3] * rc - bf_hi(xv.y));
    o.z = pack2bf(sum[4] * rc - bf_lo(xv.z), sum[5] * rc - bf_hi(xv.z));
    o.w = pack2bf(sum[6] * rc - bf_lo(xv.w), sum[7] * rc - bf_hi(xv.w));
    *(uint4*)(Df + t * PL_LD + c0) = o;
  }
  __syncthreads();
  {
    const int gi = wave >> 1, tt0 = (wave & 1) * 2;
    f32x4 acc[4][2];
#pragma unroll
    for (int et = 0; et < 4; ++et)
#pragma unroll
      for (int tt = 0; tt < 2; ++tt) acc[et][tt] = (f32x4){0.f, 0.f, 0.f, 0.f};
#pragma unroll
    for (int ks = 0; ks < 2; ++ks) {
      bf16x8 bx[2];
#pragma unroll
      for (int tt = 0; tt < 2; ++tt) bx[tt] = *(const bf16x8*)(Df + ((tt0 + tt) * 16 + tl) * PL_LD + gi * 64 + ks * 32 + 8 * g);
#pragma unroll
      for (int et = 0; et < 4; ++et) {
        const bf16x8 wa = *(const bf16x8*)(WT + (gi * 64 + et * 16 + tl) * 72 + ks * 32 + 8 * g);
#pragma unroll
        for (int tt = 0; tt < 2; ++tt) acc[et][tt] = __builtin_amdgcn_mfma_f32_16x16x32_bf16(wa, bx[tt], acc[et][tt], 0, 0, 0);
      }
    }
#pragma unroll
    for (int et = 0; et < 4; ++et) {
      const float4 sc4 = *(const float4*)(p.pool_scale + l * 256 + gi * 64 + et * 16 + 4 * g);
#pragma unroll
      for (int tt = 0; tt < 2; ++tt) {
        const int tok = t0 + (tt0 + tt) * 16 + tl;
        uint2 o;
        o.x = pack2bf(acc[et][tt][0] * sc4.x, acc[et][tt][1] * sc4.y);
        o.y = pack2bf(acc[et][tt][2] * sc4.z, acc[et][tt][3] * sc4.w);
        *(uint2*)(p.ycat + (size_t)tok * 1024 + gi * 64 + et * 16 + 4 * g) = o;
      }
    }
  }
}


typedef __attribute__((ext_vector_type(2))) __bf16 bf16x2_t;
__device__ __forceinline__ float dot2bf(unsigned a, unsigned b, float c) {
  return __builtin_amdgcn_fdot2_f32_bf16(__builtin_bit_cast(bf16x2_t, a), __builtin_bit_cast(bf16x2_t, b), c, false);
}
#define DPP_F(v, ctrl) __builtin_bit_cast(float, __builtin_amdgcn_update_dpp(0, __builtin_bit_cast(int, v), ctrl, 0xf, 0xf, false))
#define RDLANE_F(v, l) __builtin_bit_cast(float, __builtin_amdgcn_readlane(__builtin_bit_cast(int, v), l))
__device__ __forceinline__ float erf_as(float x) {
  const float ax = fabsf(x);
  const float t = __builtin_amdgcn_rcpf(fmaf(0.3275911f, ax, 1.0f));
  float y = fmaf(1.061405429f, t, -1.453152027f);
  y = fmaf(y, t, 1.421413741f);
  y = fmaf(y, t, -0.284496736f);
  y = fmaf(y, t, 0.254829592f);
  y = y * t * __expf(-ax * ax);
  return copysignf(1.0f - y, x);
}
__device__ __forceinline__ float gelu_fast_exact(float a) { return 0.5f * a * (1.0f + erf_as(a * 0.70710678118654752f)); }
struct PickPair { int eA, eB; float gA, gB; };

#define EX6_SHIFT 11
#define EX6_NSLICE (16384 >> EX6_SHIFT)
__device__ __forceinline__ unsigned cvt8_bf16x2(unsigned w, float scale, const bool hi) {
  return hi ? __builtin_bit_cast(unsigned, __builtin_amdgcn_cvt_scalef32_pk_bf16_fp8((int)w, scale, true))
            : __builtin_bit_cast(unsigned, __builtin_amdgcn_cvt_scalef32_pk_bf16_fp8((int)w, scale, false));
}
__device__ __forceinline__ void experts6_process4(const unsigned char* __restrict__ U8, const unsigned char* __restrict__ V8,
                                                  const float2* __restrict__ ES, const int (&e)[4], const float (&g)[4],
                                                  const unsigned (&hw)[8], float (&acc)[16], int lane, int vz) {
  uint4 u[4], v[4];
  float2 sc[4];
#pragma unroll
  for (int i = 0; i < 4; ++i) u[i] = *(const uint4*)(U8 + (size_t)e[i] * 1024 + lane * 16);
#pragma unroll
  for (int i = 0; i < 4; ++i) sc[i] = ES[e[i] + vz];
#pragma unroll
  for (int i = 0; i < 4; ++i) v[i] = *(const uint4*)(V8 + (size_t)e[i] * 1024 + lane * 16);
  float a[4];
#pragma unroll
  for (int i = 0; i < 4; ++i) {
    const unsigned uw[4] = {u[i].x, u[i].y, u[i].z, u[i].w};
    float t = 0.f;
#pragma unroll
    for (int w = 0; w < 4; ++w) {
      t = dot2bf(cvt8_bf16x2(uw[w], sc[i].x, false), hw[2 * w], t);
      t = dot2bf(cvt8_bf16x2(uw[w], sc[i].x, true), hw[2 * w + 1], t);
    }
    a[i] = t;
  }
  const bool b0 = lane & 1, b1 = lane & 2;
  const float x01 = (b0 ? a[1] : a[0]) + DPP_F((b0 ? a[0] : a[1]), 0xB1);
  const float x23 = (b0 ? a[3] : a[2]) + DPP_F((b0 ? a[2] : a[3]), 0xB1);
  float y = (b1 ? x23 : x01) + DPP_F((b1 ? x01 : x23), 0x4E);
  y += DPP_F(y, 0x124);
  y += DPP_F(y, 0x128);
  float sum[4];
#pragma unroll
  for (int i = 0; i < 4; ++i) sum[i] = RDLANE_F(y, i) + RDLANE_F(y, 16 + i) + RDLANE_F(y, 32 + i) + RDLANE_F(y, 48 + i);
  const int li = lane & 3;
  const float mine = (li == 0) ? sum[0] : (li == 1) ? sum[1] : (li == 2) ? sum[2] : sum[3];
  const float gmine = (li == 0) ? g[0] : (li == 1) ? g[1] : (li == 2) ? g[2] : g[3];
  const unsigned gb = (unsigned)f2bf(gelu_fast_exact(mine) * gmine);
#pragma unroll
  for (int i = 0; i < 4; ++i) {
    const unsigned hl = (unsigned)__builtin_amdgcn_readlane((int)gb, i);
    const unsigned hh = hl << 16;
    const unsigned vw[4] = {v[i].x, v[i].y, v[i].z, v[i].w};
#pragma unroll
    for (int w = 0; w < 4; ++w) {
      const unsigned p0 = cvt8_bf16x2(vw[w], sc[i].y, false), p1 = cvt8_bf16x2(vw[w], sc[i].y, true);
      acc[4 * w + 0] = dot2bf(p0, hl, acc[4 * w + 0]);
      acc[4 * w + 1] = dot2bf(p0, hh, acc[4 * w + 1]);
      acc[4 * w + 2] = dot2bf(p1, hl, acc[4 * w + 2]);
      acc[4 * w + 3] = dot2bf(p1, hh, acc[4 * w + 3]);
    }
  }
}

__device__ __forceinline__ void o_peer_experts6_tile(const Params& p, int l, int t0, const char* smem, int tid, bool dry = false) {
  const int wave = __builtin_amdgcn_readfirstlane(tid >> 6), lane = tid & 63;
  const unsigned char* U8 = p.u8 + (size_t)l * 16384 * 1024;
  const unsigned char* V8 = p.v8 + (size_t)l * 16384 * 1024;
  const float2* ES = p.escale + (size_t)l * 16384;
  int vz = 0;
  asm volatile("" : "+v"(vz));
  const int s0 = ((int)(__builtin_amdgcn_s_getreg((3 << 11) | 20) & 0xF) * (EX6_NSLICE / 8)) & (EX6_NSLICE - 1);
  unsigned pk[8][2];
  float acc[8][16];
#pragma unroll
  for (int k = 0; k < 8; ++k) {
    const size_t base = (size_t)(t0 + wave * 8 + k) * 128 + lane + vz;
#pragma unroll
    for (int hf = 0; hf < 2; ++hf) pk[k][hf] = (unsigned)p.pidx[base + hf * 64] | ((unsigned)f2bf(p.pgate[base + hf * 64]) << 16);
#pragma unroll
    for (int i = 0; i < 16; ++i) acc[k][i] = 0.f;
  }
#pragma unroll 1
  for (int si = 0; si < EX6_NSLICE; ++si) {
    const unsigned s = (unsigned)((s0 + si) & (EX6_NSLICE - 1));
#pragma unroll
    for (int k = 0; k < 8; ++k) {
      unsigned long long m0 = __ballot(((pk[k][0] & 0x3fffu) >> EX6_SHIFT) == s);
      unsigned long long m1 = __ballot(((pk[k][1] & 0x3fffu) >> EX6_SHIFT) == s);
      if ((m0 | m1) == 0ull) continue;
      unsigned hw[8];
      {
        const char* xr = smem + (wave * 8 + k) * LDXB + lane * 32;
        const uint4 h0 = *(const uint4*)xr, h1 = *(const uint4*)(xr + 16);
        hw[0] = h0.x; hw[1] = h0.y; hw[2] = h0.z; hw[3] = h0.w; hw[4] = h1.x; hw[5] = h1.y; hw[6] = h1.z; hw[7] = h1.w;
      }
      while (m0 | m1) {
        int e[4]; float g[4];
#pragma unroll
        for (int i = 0; i < 4; ++i) {
          unsigned w;
          if (m0) { const int la = (int)__builtin_ctzll(m0); m0 &= m0 - 1; w = (unsigned)__builtin_amdgcn_readlane((int)pk[k][0], la); }
          else if (m1) { const int la = (int)__builtin_ctzll(m1); m1 &= m1 - 1; w = (unsigned)__builtin_amdgcn_readlane((int)pk[k][1], la); }
          else { w = (unsigned)e[0]; }
          e[i] = (int)(w & 0x3fffu);
          g[i] = __uint_as_float(w & 0xffff0000u);
        }
        experts6_process4(U8, V8, ES, e, g, hw, acc[k], lane, vz);
      }
    }
  }
  if (dry) {
#pragma unroll
    for (int k = 0; k < 8; ++k)
#pragma unroll
      for (int i = 0; i < 16; ++i) asm volatile("" :: "v"(acc[k][i]));
    return;
  }
#pragma unroll
  for (int k = 0; k < 8; ++k) {
    float* xr = p.xres + (size_t)(t0 + wave * 8 + k) * 1024 + lane * 16;
#pragma unroll
    for (int i = 0; i < 4; ++i) {
      float4 a0 = *(float4*)(xr + 4 * i);
      a0.x += acc[k][4 * i + 0]; a0.y += acc[k][4 * i + 1]; a0.z += acc[k][4 * i + 2]; a0.w += acc[k][4 * i + 3];
      *(float4*)(xr + 4 * i) = a0;
    }
  }
}


typedef _Float16 h2_t __attribute__((ext_vector_type(2)));
__device__ __forceinline__ void ex7_pop(unsigned long long& m0, unsigned long long& m1, const unsigned pk0, const unsigned pk1,
                                        int (&e)[4], float (&g)[4]) {
  int e0 = 0;
#pragma unroll
  for (int i = 0; i < 4; ++i) {
    unsigned w;
    if (m0) { const int la = (int)__builtin_ctzll(m0); m0 &= m0 - 1; w = (unsigned)__builtin_amdgcn_readlane((int)pk0, la); }
    else if (m1) { const int la = (int)__builtin_ctzll(m1); m1 &= m1 - 1; w = (unsigned)__builtin_amdgcn_readlane((int)pk1, la); }
    else { w = (unsigned)e0; }
    e[i] = (int)(w & 0x3fffu);
    g[i] = __uint_as_float(w & 0xffff0000u);
    if (i == 0) e0 = e[0];
  }
}
#define EX7_ISSUE(U_, V_, SC_, G_) { \
  _Pragma("unroll") for (int i_ = 0; i_ < 4; ++i_) U_[i_] = *(const uint4*)(U8 + (size_t)e[i_] * 1024 + lane * 16); \
  _Pragma("unroll") for (int i_ = 0; i_ < 4; ++i_) SC_[i_] = ES[e[i_] + vz]; \
  _Pragma("unroll") for (int i_ = 0; i_ < 4; ++i_) V_[i_] = *(const uint4*)(V8 + (size_t)e[i_] * 1024 + lane * 16); \
  _Pragma("unroll") for (int i_ = 0; i_ < 4; ++i_) G_[i_] = g[i_]; }

__device__ __forceinline__ void ex7_compute(const uint4 (&ru)[4], const uint4 (&rv)[4], const float2 (&rsc)[4], const float (&rg)[4],
                                            const unsigned (&hw)[8], h2_t (&acc)[8], int lane) {
  float a[4];
#pragma unroll
  for (int i = 0; i < 4; ++i) {
    const unsigned uw[4] = {ru[i].x, ru[i].y, ru[i].z, ru[i].w};
    float t = 0.f;
#pragma unroll
    for (int w = 0; w < 4; ++w) {
      t = dot2bf(cvt8_bf16x2(uw[w], rsc[i].x, false), hw[2 * w], t);
      t = dot2bf(cvt8_bf16x2(uw[w], rsc[i].x, true), hw[2 * w + 1], t);
    }
    a[i] = t;
  }
  const bool b0 = lane & 1, b1 = lane & 2;
  const float x01 = (b0 ? a[1] : a[0]) + DPP_F((b0 ? a[0] : a[1]), 0xB1);
  const float x23 = (b0 ? a[3] : a[2]) + DPP_F((b0 ? a[2] : a[3]), 0xB1);
  float y = (b1 ? x23 : x01) + DPP_F((b1 ? x01 : x23), 0x4E);
  y += DPP_F(y, 0x124);
  y += DPP_F(y, 0x128);
  float sum[4];
#pragma unroll
  for (int i = 0; i < 4; ++i) sum[i] = RDLANE_F(y, i) + RDLANE_F(y, 16 + i) + RDLANE_F(y, 32 + i) + RDLANE_F(y, 48 + i);
  const int li = lane & 3;
  const float mine = (li == 0) ? sum[0] : (li == 1) ? sum[1] : (li == 2) ? sum[2] : sum[3];
  const float gmine = (li == 0) ? rg[0] : (li == 1) ? rg[1] : (li == 2) ? rg[2] : rg[3];
  const _Float16 hf = (_Float16)(gelu_fast_exact(mine) * gmine);
  const unsigned hb = (unsigned)__builtin_bit_cast(unsigned short, hf);
#pragma unroll
  for (int i = 0; i < 4; ++i) {
    const unsigned hl = (unsigned)__builtin_amdgcn_readlane((int)hb, i);
    const h2_t hh = __builtin_bit_cast(h2_t, hl | (hl << 16));
    const unsigned vw[4] = {rv[i].x, rv[i].y, rv[i].z, rv[i].w};
#pragma unroll
    for (int w = 0; w < 4; ++w) {
      const h2_t p0 = __builtin_amdgcn_cvt_scalef32_pk_f16_fp8((int)vw[w], rsc[i].y, false);
      const h2_t p1 = __builtin_amdgcn_cvt_scalef32_pk_f16_fp8((int)vw[w], rsc[i].y, true);
      acc[2 * w] = __builtin_elementwise_fma(p0, hh, acc[2 * w]);
      acc[2 * w + 1] = __builtin_elementwise_fma(p1, hh, acc[2 * w + 1]);
    }
  }
}

__device__ __forceinline__ void o_peer_experts7_tile(const Params& p, int l, int t0, const char* smem, int tid, bool dry = false) {
  const int wave = __builtin_amdgcn_readfirstlane(tid >> 6), lane = tid & 63;
  const unsigned char* U8 = p.u8 + (size_t)l * 16384 * 1024;
  const unsigned char* V8 = p.v8 + (size_t)l * 16384 * 1024;
  const float2* ES = p.escale + (size_t)l * 16384;
  int vz = 0;
  asm volatile("" : "+v"(vz));
  const int s0 = ((int)(__builtin_amdgcn_s_getreg((3 << 11) | 20) & 0xF) * (EX6_NSLICE / 8)) & (EX6_NSLICE - 1);
  unsigned pk[8][2];
  h2_t acc[8][8];
#pragma unroll
  for (int k = 0; k < 8; ++k) {
    const size_t base = (size_t)(t0 + wave * 8 + k) * 128 + lane + vz;
#pragma unroll
    for (int hf = 0; hf < 2; ++hf) pk[k][hf] = (unsigned)p.pidx[base + hf * 64] | ((unsigned)f2bf(p.pgate[base + hf * 64]) << 16);
#pragma unroll
    for (int i = 0; i < 8; ++i) acc[k][i] = (h2_t){(_Float16)0.f, (_Float16)0.f};
  }
#pragma unroll 1
  for (int si = 0; si < EX6_NSLICE; ++si) {
    const unsigned s = (unsigned)((s0 + si) & (EX6_NSLICE - 1));
#pragma unroll
    for (int k = 0; k < 8; ++k) {
      unsigned long long m0 = __ballot(((pk[k][0] & 0x3fffu) >> EX6_SHIFT) == s);
      unsigned long long m1 = __ballot(((pk[k][1] & 0x3fffu) >> EX6_SHIFT) == s);
      if ((m0 | m1) == 0ull) continue;
      unsigned hw[8];
      {
        const char* xr = smem + (wave * 8 + k) * LDXB + lane * 32;
        const uint4 h0 = *(const uint4*)xr, h1 = *(const uint4*)(xr + 16);
        hw[0] = h0.x; hw[1] = h0.y; hw[2] = h0.z; hw[3] = h0.w; hw[4] = h1.x; hw[5] = h1.y; hw[6] = h1.z; hw[7] = h1.w;
      }
      uint4 uA[4], vA[4], uB[4], vB[4];
      float2 scA[4], scB[4];
      float gA[4], gB[4];
      int e[4]; float g[4];
      ex7_pop(m0, m1, pk[k][0], pk[k][1], e, g);
      EX7_ISSUE(uA, vA, scA, gA)
      for (;;) {
        const bool mb = (m0 | m1) != 0ull;
        if (mb) { ex7_pop(m0, m1, pk[k][0], pk[k][1], e, g); EX7_ISSUE(uB, vB, scB, gB) }
        ex7_compute(uA, vA, scA, gA, hw, acc[k], lane);
        if (!mb) break;
        const bool ma = (m0 | m1) != 0ull;
        if (ma) { ex7_pop(m0, m1, pk[k][0], pk[k][1], e, g); EX7_ISSUE(uA, vA, scA, gA) }
        ex7_compute(uB, vB, scB, gB, hw, acc[k], lane);
        if (!ma) break;
      }
    }
  }
  if (dry) {
#pragma unroll
    for (int k = 0; k < 8; ++k)
#pragma unroll
      for (int i = 0; i < 8; ++i) asm volatile("" :: "v"(acc[k][i]));
    return;
  }
#pragma unroll
  for (int k = 0; k < 8; ++k) {
    float* xr = p.xres + (size_t)(t0 + wave * 8 + k) * 1024 + lane * 16;
#pragma unroll
    for (int i = 0; i < 4; ++i) {
      float4 a0 = *(float4*)(xr + 4 * i);
      a0.x += (float)acc[k][2 * i][0]; a0.y += (float)acc[k][2 * i][1];
      a0.z += (float)acc[k][2 * i + 1][0]; a0.w += (float)acc[k][2 * i + 1][1];
      *(float4*)(xr + 4 * i) = a0;
    }
  }
}

#define XB_TMO      128
#define XB_XCNT(j)  (256  + 64 * (j))
#define XB_XSUB(j)  (1280 + 64 * (j))
#define XB_XGEN(j)  (2304 + 64 * (j))
#define XB_TOP      3328
#define XB_TOPGEN   3392
#define XCD_BAR_WORDS 3456
#define XB_SPIN_CAP (1u << 22)
#define LAS __attribute__((address_space(3)))
__device__ __forceinline__ unsigned xb_ld(unsigned* p)              { return __hip_atomic_load(p, __ATOMIC_RELAXED, __HIP_MEMORY_SCOPE_AGENT); }
__device__ __forceinline__ unsigned xb_add(unsigned* p, unsigned v) { return __hip_atomic_fetch_add(p, v, __ATOMIC_RELAXED, __HIP_MEMORY_SCOPE_AGENT); }
__device__ __forceinline__ unsigned xb_xcc_id() { return (unsigned)__builtin_amdgcn_s_getreg((3 << 11) | 20) & 0xFu; }
#define XB_SPIN(cond, bar) do { unsigned _sp = 0; while (cond) { __builtin_amdgcn_s_sleep(1); \
    if ((++_sp & 255u) == 0u) { if (xb_ld(&(bar)[XB_TMO])) break; if (_sp > XB_SPIN_CAP) { atomicAdd(&(bar)[XB_TMO], 1u); break; } } } } while (0)
struct XcdBarrier { unsigned* bar; unsigned x; volatile LAS unsigned* st; };
__device__ __forceinline__ XcdBarrier xcd_barrier_post(unsigned* bar, volatile LAS unsigned* st, int tid) {
  XcdBarrier b; b.bar = bar; b.x = xb_xcc_id(); b.st = st;
  if (tid == 0) (void)xb_add(&bar[XB_XCNT(b.x)], 1u);
  return b;
}
__device__ __forceinline__ void xcd_barrier_complete(unsigned* bar, unsigned x, unsigned& nloc, unsigned& nx) {
  const unsigned G = gridDim.x * gridDim.y * gridDim.z;
  unsigned sum, cnt, mine, sp = 0u;
  for (;;) {
    sum = 0u; cnt = 0u; mine = 0u;
#pragma unroll
    for (unsigned j = 0; j < 16; ++j) { const unsigned c = xb_ld(&bar[XB_XCNT(j)]); sum += c; cnt += (c > 0u) ? 1u : 0u; mine = (j == x) ? c : mine; }
    if (sum == G) break;
    __builtin_amdgcn_s_sleep(1);
    if ((++sp & 255u) == 0u) { if (xb_ld(&bar[XB_TMO])) break; if (sp > XB_SPIN_CAP) { atomicAdd(&bar[XB_TMO], 1u); break; } }
  }
  nloc = mine > 0u ? mine : 1u; nx = cnt > 0u ? cnt : 1u;
}
__device__ __forceinline__ void xcd_barrier(const XcdBarrier& b, int tid) {
  asm volatile("s_waitcnt vmcnt(0)" ::: "memory");
  __syncthreads();
  if (tid == 0) {
    unsigned* bar = b.bar;
    __builtin_amdgcn_s_waitcnt(0);
    unsigned nloc = b.st[0], nx = b.st[1];
    if (nloc == 0u) { xcd_barrier_complete(bar, b.x, nloc, nx); b.st[0] = nloc; b.st[1] = nx; }
    const unsigned old = xb_add(&bar[XB_XSUB(b.x)], 1u);
    const unsigned gen = old / nloc;
    if (old + 1u == (gen + 1u) * nloc) {
      __builtin_amdgcn_fence(__ATOMIC_RELEASE, "agent");
      asm volatile("s_waitcnt vmcnt(0)" ::: "memory");
      const unsigned og = xb_add(&bar[XB_TOP], 1u);
      const unsigned tg = og / nx;
      if (og + 1u == (tg + 1u) * nx) xb_add(&bar[XB_TOPGEN], 1u);
      else XB_SPIN(xb_ld(&bar[XB_TOPGEN]) == tg, bar);
      __builtin_amdgcn_fence(__ATOMIC_ACQUIRE, "agent");
      xb_add(&bar[XB_XGEN(b.x)], 1u);
      asm volatile("s_waitcnt vmcnt(0)" ::: "memory");
    } else {
      XB_SPIN(xb_ld(&bar[XB_XGEN(b.x)]) == gen, bar);
      __builtin_amdgcn_fence(__ATOMIC_ACQUIRE, "agent");
      asm volatile("s_waitcnt vmcnt(0)" ::: "memory");
    }
  }
  __syncthreads();
}


__global__ void __launch_bounds__(NTHREADS) fwd_megakernel(Params p) {
  cg::grid_group grid = cg::this_grid();
  extern __shared__ __attribute__((aligned(16))) float smem[];
  const int wv_ = __builtin_amdgcn_readfirstlane((int)(threadIdx.x >> 6));
  volatile LAS unsigned* xb_st = (volatile LAS unsigned*)((LAS char*)(LAS float*)smem + (160 * 1024 - 16));
  if (threadIdx.x == 0) { xb_st[0] = 0u; xb_st[1] = 0u; }
  __syncthreads();
  const XcdBarrier xb = xcd_barrier_post(p.bar, xb_st, (int)threadIdx.x);
#define GRID_BARRIER() xcd_barrier(xb, opaque_tid(wv_))

  o_prep(wv_, p, smem);
  grid.sync();
#if PROBE_DUP == 1
  o_prep(wv_, p, smem);
  grid.sync();
#endif
#pragma unroll 1
  for (int l = 0; l < DEPTH; ++l) {
    const float* xcur = (l == 0) ? p.x_in : p.xres;
    o_p1(wv_, p, l, xcur, (char*)smem);
    GRID_BARRIER();
#if PROBE_DUP == 2
    o_p1(wv_, p, l, xcur, (char*)smem);
    GRID_BARRIER();
#endif
#if PROBE_DUP == 3
    for (int rep_ = 0; rep_ < 2; ++rep_) {
#else
    {
#endif
    {
      const int bidx_ = opaque_bid();
      for (int task = bidx_; task < 1792; task += gridDim.x) {
        const int l_ = opaque_s(l), td_ = opaque_tid(wv_), tk_ = opaque_s(task);
        if (tk_ < 1024) o_na_task(p, l_, tk_, (char*)smem, td_);
        else if (tk_ < 1536) o_ret_kv_task(p, l_, tk_ - 1024, (char*)smem, td_);
        else o_pool_task(p, l_, tk_ - 1536, (char*)smem, td_);
      }
    }
    GRID_BARRIER();
    o_ret_scan(wv_, p, l);
    GRID_BARRIER();
    {
      const int tidx_ = opaque_tid(wv_); const int bidx_ = opaque_bid();
      for (int task = bidx_; task < 512; task += gridDim.x) o_ret_out_task(p, l, task, (char*)smem, tidx_);
    }
    GRID_BARRIER();
    }
    {
      const int tidx_ = opaque_tid(wv_); const int bidx_ = opaque_bid();
      for (int tile = bidx_; tile < NTOK / 64; tile += gridDim.x) {
        { const int t0_ = opaque_s(tile * 64), l_ = opaque_s(l), td_ = opaque_tid(wv_); o_p5a1_tile(p, l_, t0_, (char*)smem, td_); }
#if PROBE_DUP == 4
        { const int t0_ = opaque_s(tile * 64), l_ = opaque_s(l), td_ = opaque_tid(wv_); o_p5a1_tile(p, l_, t0_, (char*)smem, td_); }
#endif
        { const int t0_ = opaque_s(tile * 64), l_ = opaque_s(l), td_ = opaque_tid(wv_); o_p5a2_tile(p, l_, xcur, t0_, (char*)smem, td_); }
        { const int t0_ = opaque_s(tile * 64), l_ = opaque_s(l), td_ = opaque_tid(wv_); o_p5a3_tile(p, l_, t0_, (char*)smem, td_); }
        { const int t0_ = opaque_s(tile * 64), l_ = opaque_s(l), td_ = opaque_tid(wv_); o_peer_select_tile(p, l_, t0_, (char*)smem, td_); }
        { const int t0_ = opaque_s(tile * 64), l_ = opaque_s(l), td_ = opaque_tid(wv_); o_peer_select2_tile(p, l_, t0_, td_); }
#if PROBE_DUP == 5
        { const int t0_ = opaque_s(tile * 64), l_ = opaque_s(l), td_ = opaque_tid(wv_); o_peer_select_tile(p, l_, t0_, (char*)smem, td_); }
        { const int t0_ = opaque_s(tile * 64), l_ = opaque_s(l), td_ = opaque_tid(wv_); o_peer_select2_tile(p, l_, t0_, td_); }
#endif
        asm volatile("s_waitcnt vmcnt(0)" ::: "memory");
        __syncthreads();
#if PROBE_DUP == 6
        { const int t0_ = opaque_s(tile * 64), l_ = opaque_s(l), td_ = opaque_tid(wv_); o_peer_experts7_tile(p, l_, t0_, (const char*)smem, td_, true); }
#endif
        { const int t0_ = opaque_s(tile * 64), l_ = opaque_s(l), td_ = opaque_tid(wv_); o_peer_experts7_tile(p, l_, t0_, (const char*)smem, td_); }
        if (l + 1 == DEPTH) {
          asm volatile("s_waitcnt vmcnt(0)" ::: "memory");
          const int t0_ = opaque_s(tile * 64), td_ = opaque_tid(wv_);
          o_final_norm_tile(p, t0_, td_);
        }
      }
    }
    if (l + 1 < DEPTH) GRID_BARRIER();
  }
}

extern "C" void kernel_launch(void* const* d_in, const int* in_sizes, int n_in, void* d_out, int out_size,
                              void* d_ws, size_t ws_size, hipStream_t stream) {
  Params p{};
  p.x_in = (const float*)d_in[0]; p.norm_mix = (const float*)d_in[1]; p.w_in = (const float*)d_in[2];
  p.pool_w = (const float*)d_in[3]; p.pool_scale = (const float*)d_in[4]; p.ret_decay = (const float*)d_in[5];
  p.na_rpb = (const float*)d_in[6]; p.w_br_pool = (const float*)d_in[7]; p.w_br_ret = (const float*)d_in[8];
  p.w_br_na = (const float*)d_in[9]; p.w_out = (const float*)d_in[10]; p.norm_ffn = (const float*)d_in[11];
  p.w_query = (const float*)d_in[12]; p.sub_keys = (const float*)d_in[13]; p.peer_u = (const float*)d_in[14];
  p.peer_v = (const float*)d_in[15]; p.norm_final = (const float*)d_in[16];
  p.out = (float*)d_out;
  char* ws = (char*)d_ws;
  size_t off = 0;
  auto alloc = [&](size_t bytes) { char* q = ws + off; off += (bytes + 255) & ~(size_t)255; return q; };
  p.xres = (float*)alloc((size_t)NTOK * D_MODEL * 4);
  p.proj = (bf16_t*)alloc((size_t)NTOK * IN_WIDTH * 2);
  p.ycat = (bf16_t*)alloc((size_t)NTOK * 1024 * 2);
  p.mrg = (bf16_t*)alloc((size_t)NTOK * 1024 * 2);
  p.pidx = (int*)alloc((size_t)NTOK * 128 * 4);
  p.pgate = (float*)alloc((size_t)NTOK * 128 * 4);
  p.wf_in = (bf16_t*)alloc((size_t)DEPTH * D_MODEL * IN_WIDTH * 2);
  p.wf_br = (bf16_t*)alloc((size_t)DEPTH * 1024 * 1024 * 2);
  p.wf_out = (bf16_t*)alloc((size_t)DEPTH * 1024 * 1024 * 2);
  p.wf_q = (bf16_t*)alloc((size_t)DEPTH * 1024 * 2048 * 2);
  p.kf = (bf16_t*)alloc((size_t)DEPTH * 2 * 128 * 128 * 2);
  p.u16 = nullptr; p.v16 = nullptr;
  p.u8 = (unsigned char*)alloc((size_t)DEPTH * 16384 * 1024);
  p.v8 = (unsigned char*)alloc((size_t)DEPTH * 16384 * 1024);
  p.escale = (float2*)alloc((size_t)DEPTH * 16384 * 8);
  p.rope = (float2*)alloc((size_t)SEQ * 32 * 8);
  p.tklist = (unsigned*)alloc((size_t)NTOK * 8 * 2 * 16 * 4);
  p.kvst = (float*)p.mrg;
  p.rstate = (bf16_t*)p.tklist;
  p.bar = (unsigned*)alloc(XCD_BAR_WORDS * 4);
  p.xn = nullptr; p.merged = nullptr; p.pq = nullptr; p.psc = nullptr;
  if (off > ws_size) fprintf(stderr, "WORKSPACE OVERFLOW: need %zu have %zu\n", off, ws_size);

  const size_t kDynLds = 160 * 1024;
  static int grid_blocks = 0;
  if (!grid_blocks) {
    int dev = 0, cus = 0, per_cu = 0;
    (void)hipGetDevice(&dev);
    (void)hipDeviceGetAttribute(&cus, hipDeviceAttributeMultiprocessorCount, dev);
    (void)hipFuncSetAttribute((const void*)fwd_megakernel, hipFuncAttributeMaxDynamicSharedMemorySize, (int)kDynLds);
    (void)hipOccupancyMaxActiveBlocksPerMultiprocessor(&per_cu, fwd_megakernel, NTHREADS, kDynLds);
    if (per_cu < 1) per_cu = 1;
    grid_blocks = cus * per_cu;
  }
  (void)hipMemsetAsync(p.bar, 0, XCD_BAR_WORDS * 4, stream);
  void* args[] = {&p};
  hipError_t e = hipLaunchCooperativeKernel((void*)fwd_megakernel, dim3(grid_blocks), dim3(NTHREADS), args, kDynLds, stream);
  if (e != hipSuccess) fprintf(stderr, "cooperative launch failed: %s (grid %d)\n", hipGetErrorString(e), grid_blocks);
}
```

```cpp
#include <hip/hip_runtime.h>
#include <hip/hip_cooperative_groups.h>
#include <stdint.h>
#include <cstdio>
namespace cg = cooperative_groups;

#define D_MODEL 1024
#define SEQ 4096
#define BATCH 4
#define NTOK (BATCH * SEQ)
#define DEPTH 2
#define IN_WIDTH 5632
#define C_POOL 0
#define C_RQ 256
#define C_RK 512
#define C_RV 768
#define C_RG 1280
#define C_NQ 1792
#define C_NK 2048
#define C_NV 2304
#define C_GATE 2560
#define EPS 1e-6f
#define NTHREADS 512
#define PROBE_DUP 0

typedef unsigned short bf16_t;

struct Params {
  const float* x_in; const float* norm_mix; const float* w_in; const float* pool_w; const float* pool_scale;
  const float* ret_decay; const float* na_rpb; const float* w_br_pool; const float* w_br_ret; const float* w_br_na;
  const float* w_out; const float* norm_ffn; const float* w_query; const float* sub_keys; const float* peer_u;
  const float* peer_v; const float* norm_final;
  float* out;
  float* xres;
  bf16_t* xn;
  bf16_t* proj;
  bf16_t* ycat;
  float* merged;
  float* pq;
  float* psc;
  int* pidx;
  float* pgate;
  bf16_t* wf_in;
  bf16_t* wf_br;
  bf16_t* wf_out;
  bf16_t* wf_q;
  bf16_t* kf;
  bf16_t* u16;
  bf16_t* v16;
  float2* rope;
  bf16_t* mrg;
  unsigned* tklist;
  float* kvst;
  bf16_t* rstate;
  unsigned* bar;
  unsigned char* u8; unsigned char* v8;
  float2* escale;
};

__device__ __forceinline__ bf16_t f2bf(float f) {
  unsigned u = __float_as_uint(f);
  u += 0x7fffu + ((u >> 16) & 1u);
  return (bf16_t)(u >> 16);
}
__device__ __forceinline__ float bf2f(bf16_t h) { return __uint_as_float(((unsigned)h) << 16); }

__device__ __forceinline__ float wave_sum(float v) {
#pragma unroll
  for (int o = 32; o > 0; o >>= 1) v += __shfl_xor(v, o, 64);
  return v;
}
__device__ __forceinline__ float wave_max(float v) {
#pragma unroll
  for (int o = 32; o > 0; o >>= 1) v = fmaxf(v, __shfl_xor(v, o, 64));
  return v;
}
__device__ __forceinline__ float sigmoidf_(float x) { return 1.0f / (1.0f + expf(-x)); }

__device__ __forceinline__ int opaque_tid(int wv) {
  int w = wv;
  asm volatile("" : "+s"(w));
  int lane = __builtin_amdgcn_mbcnt_hi(~0u, __builtin_amdgcn_mbcnt_lo(~0u, 0u));
  asm volatile("" : "+v"(lane));
  return w * 64 + lane;
}
__device__ __forceinline__ int opaque_s(int x) { asm volatile("" : "+s"(x)); return x; }
__device__ __forceinline__ int opaque_bid() { int b = blockIdx.x; asm volatile("" : "+s"(b)); return b; }

template <bool OUT_F32>
__device__ __forceinline__ void n_rmsnorm(const int wv_, const float* __restrict__ x, const float* __restrict__ g, void* outp, int rows) {
  const int tidx_ = opaque_tid(wv_); const int bidx_ = opaque_bid();
  const int lane = tidx_ & 63;
  const int nw = gridDim.x * (NTHREADS / 64);
  for (int row = bidx_ * (NTHREADS / 64) + (tidx_ >> 6); row < rows; row += nw) {
    const float* xr = x + (size_t)row * D_MODEL;
    float4 v[4];
    float ss = 0.f;
#pragma unroll
    for (int i = 0; i < 4; ++i) {
      v[i] = *(const float4*)(xr + i * 256 + lane * 4);
      ss += v[i].x * v[i].x + v[i].y * v[i].y + v[i].z * v[i].z + v[i].w * v[i].w;
    }
    ss = wave_sum(ss);
    float r = rsqrtf(ss * (1.0f / D_MODEL) + EPS);
#pragma unroll
    for (int i = 0; i < 4; ++i) {
      float4 gg = *(const float4*)(g + i * 256 + lane * 4);
      float o0 = v[i].x * r * gg.x, o1 = v[i].y * r * gg.y, o2 = v[i].z * r * gg.z, o3 = v[i].w * r * gg.w;
      if (OUT_F32) {
        *(float4*)((float*)outp + (size_t)row * D_MODEL + i * 256 + lane * 4) = make_float4(o0, o1, o2, o3);
      } else {
        ushort4 o; o.x = f2bf(o0); o.y = f2bf(o1); o.z = f2bf(o2); o.w = f2bf(o3);
        *(ushort4*)((bf16_t*)outp + (size_t)row * D_MODEL + i * 256 + lane * 4) = o;
      }
    }
  }
}

typedef __attribute__((ext_vector_type(8))) short bf16x8;
typedef __attribute__((ext_vector_type(4))) float f32x4;
#define LDX 1032
#define LDXB (LDX * 2)
#define XTILE_BYTES (64 * LDXB)

__device__ __forceinline__ unsigned pack2bf(float a, float b) { return (unsigned)f2bf(a) | ((unsigned)f2bf(b) << 16); }

__device__ __forceinline__ void prep_frag(const int wv_, const float* __restrict__ W, int K, int N, bf16_t* __restrict__ dst, float* smem) {
  const int tidx_ = opaque_tid(wv_); const int bidx_ = opaque_bid();
  const int grp = tidx_ >> 8, tid = tidx_ & 255;
  float(*T)[65] = (float(*)[65])(smem + grp * 32 * 65);
  const int KS = K / 32, NC = N / 64;
  const int ntiles = KS * NC;
  for (int wb = bidx_ * 2; wb < ntiles; wb += gridDim.x * 2) {
    const int w = wb + grp;
    const int c = w / KS, ks = w - c * KS;
    {
      const int row = tid >> 3, col = (tid & 7) * 8;
      const float* src = W + (size_t)(ks * 32 + row) * N + c * 64 + col;
      float4 a = *(const float4*)src, b = *(const float4*)(src + 4);
      __syncthreads();
      T[row][col + 0] = a.x; T[row][col + 1] = a.y; T[row][col + 2] = a.z; T[row][col + 3] = a.w;
      T[row][col + 4] = b.x; T[row][col + 5] = b.y; T[row][col + 6] = b.z; T[row][col + 7] = b.w;
    }
    __syncthreads();
    {
      const int nt = tid >> 6, lane = tid & 63;
      const int kr = 8 * (lane >> 4), nc = nt * 16 + (lane & 15);
      uint4 o;
      o.x = pack2bf(T[kr + 0][nc], T[kr + 1][nc]);
      o.y = pack2bf(T[kr + 2][nc], T[kr + 3][nc]);
      o.z = pack2bf(T[kr + 4][nc], T[kr + 5][nc]);
      o.w = pack2bf(T[kr + 6][nc], T[kr + 7][nc]);
      *(uint4*)(dst + ((size_t)((c * KS + ks) * 4 + nt) * 64 + lane) * 8) = o;
    }
  }
}

__device__ __forceinline__ void o_prep(const int wv_, const Params& p, float* smem) {
  for (int l = 0; l < DEPTH; ++l) {
    prep_frag(wv_, p.w_in + (size_t)l * D_MODEL * IN_WIDTH, D_MODEL, IN_WIDTH, p.wf_in + (size_t)l * D_MODEL * IN_WIDTH, smem);
    prep_frag(wv_, p.w_br_pool + (size_t)l * 256 * 1024, 256, 1024, p.wf_br + (size_t)l * 1024 * 1024, smem);
    prep_frag(wv_, p.w_br_ret + (size_t)l * 512 * 1024, 512, 1024, p.wf_br + (size_t)l * 1024 * 1024 + 256 * 1024, smem);
    prep_frag(wv_, p.w_br_na + (size_t)l * 256 * 1024, 256, 1024, p.wf_br + (size_t)l * 1024 * 1024 + 768 * 1024, smem);
    prep_frag(wv_, p.w_out + (size_t)l * 1024 * 1024, 1024, 1024, p.wf_out + (size_t)l * 1024 * 1024, smem);
    prep_frag(wv_, p.w_query + (size_t)l * 1024 * 2048, 1024, 2048, p.wf_q + (size_t)l * 1024 * 2048, smem);
  }
  const int tidx_ = opaque_tid(wv_); const int bidx_ = opaque_bid();
  const int gtid = bidx_ * NTHREADS + tidx_, gsz = gridDim.x * NTHREADS;
  for (int u = gtid; u < DEPTH * 2 * 8 * 4 * 64; u += gsz) {
    const int lane = u & 63, s2 = (u >> 6) & 3, kt = (u >> 8) & 7, lp = u >> 11;
    const float* kr = p.sub_keys + ((size_t)lp * 128 + kt * 16 + (lane & 15)) * 128;
    float v[8];
#pragma unroll
    for (int j = 0; j < 8; ++j) v[j] = kr[16 * (2 * s2 + (j >> 2)) + 4 * (lane >> 4) + (j & 3)];
    uint4 o;
    o.x = pack2bf(v[0], v[1]); o.y = pack2bf(v[2], v[3]); o.z = pack2bf(v[4], v[5]); o.w = pack2bf(v[6], v[7]);
    *(uint4*)(p.kf + (size_t)u * 8) = o;
  }
  {
    const int lane = tidx_ & 63;
    const int gw = (bidx_ * NTHREADS + tidx_) >> 6, nw = gsz >> 6;
    for (int row = gw; row < DEPTH * 16384 * 2; row += nw) {
      const int tbl = row & 1, er = row >> 1;
      const float* src = (tbl ? p.peer_v : p.peer_u) + (size_t)er * 1024 + lane * 16;
      float4 f[4];
#pragma unroll
      for (int i = 0; i < 4; ++i) f[i] = *(const float4*)(src + 4 * i);
      float m = 0.f;
#pragma unroll
      for (int i = 0; i < 4; ++i) m = fmaxf(m, fmaxf(fmaxf(fabsf(f[i].x), fabsf(f[i].y)), fmaxf(fabsf(f[i].z), fabsf(f[i].w))));
      m = wave_max(m);
      int k = 0;
      if (m > 0.f) {
        int e;
        const float fr = __builtin_frexpf(m, &e);
        k = ((fr <= 0.875f) ? 9 : 8) - e;
        k = k < -100 ? -100 : (k > 100 ? 100 : k);
      }
      const float sc = __builtin_ldexpf(1.0f, k);
      uint4 o;
      unsigned w[4];
#pragma unroll
      for (int i = 0; i < 4; ++i) {
        int pkd = 0;
        pkd = __builtin_amdgcn_cvt_pk_fp8_f32(f[i].x * sc, f[i].y * sc, pkd, false);
        pkd = __builtin_amdgcn_cvt_pk_fp8_f32(f[i].z * sc, f[i].w * sc, pkd, true);
        w[i] = (unsigned)pkd;
      }
      o.x = w[0]; o.y = w[1]; o.z = w[2]; o.w = w[3];
      *(uint4*)((tbl ? p.v8 : p.u8) + (size_t)er * 1024 + lane * 16) = o;
      if (lane == 0) ((float*)p.escale)[(size_t)er * 2 + tbl] = __builtin_ldexpf(1.0f, -k);
    }
  }
  for (int u = gtid; u < SEQ * 32; u += gsz) {
    const int i = u & 31, pos = u >> 5;
    float inv = 1.0f / powf(10000.0f, (float)i / 31.0f);
    float ang = (float)pos * inv;
    double rev = (double)ang * 0.15915494309189535;
    rev -= floor(rev);
    float rf = (float)rev;
    p.rope[u] = make_float2(__builtin_amdgcn_cosf(rf), __builtin_amdgcn_sinf(rf));
  }
}

template <int NT, int PD, int RING>
__device__ __forceinline__ void tl_gemm_prologue(const bf16_t* __restrict__ wf, bf16x8 (&wb)[RING][NT], const int lane, const int nt0 = 0) {
  const bf16x8* wp = (const bf16x8*)wf + lane + nt0 * 64;
#pragma unroll
  for (int s = 0; s < PD; ++s)
#pragma unroll
    for (int nt = 0; nt < NT; ++nt) wb[s][nt] = wp[(s * 4 + nt) * 64];
}
template <int NT, int PD, int RING>
__device__ __forceinline__ void tl_gemm_main(const bf16_t* __restrict__ wf, const int KS, const char* xt, const int kbyte0,
                                             f32x4 (&acc)[NT][4], bf16x8 (&wb)[RING][NT], const int lane, const int nt0 = 0) {
  const bf16x8* wp = (const bf16x8*)wf + lane + nt0 * 64;
  const char* xp = xt + (lane & 15) * LDXB + kbyte0 + (lane >> 4) * 16;
  for (int ks = 0; ks < KS; ks += RING) {
#pragma unroll
    for (int u = 0; u < RING; ++u) {
      int kpre = ks + u + PD;
      kpre = kpre < KS ? kpre : KS - 1;
#pragma unroll
      for (int nt = 0; nt < NT; ++nt) wb[(u + PD) % RING][nt] = wp[(kpre * 4 + nt) * 64];
      bf16x8 xf[4];
#pragma unroll
      for (int mt = 0; mt < 4; ++mt) xf[mt] = *(const bf16x8*)(xp + mt * 16 * LDXB + (ks + u) * 64);
#pragma unroll
      for (int nt = 0; nt < NT; ++nt)
#pragma unroll
        for (int mt = 0; mt < 4; ++mt)
          acc[nt][mt] = __builtin_amdgcn_mfma_f32_16x16x32_bf16(wb[u][nt], xf[mt], acc[nt][mt], 0, 0, 0);
    }
  }
}
template <int NT, int PD = 3, int RING = 4>
__device__ __forceinline__ void tl_gemm_chunk(const bf16_t* __restrict__ wf, const int KS, const char* xt, const int kbyte0,
                                              f32x4 (&acc)[NT][4], const int lane, const int nt0 = 0) {
  bf16x8 wb[RING][NT];
  tl_gemm_prologue<NT, PD, RING>(wf, wb, lane, nt0);
  tl_gemm_main<NT, PD, RING>(wf, KS, xt, kbyte0, acc, wb, lane, nt0);
}

__device__ __forceinline__ void tile_rmsnorm_to_lds(const float* __restrict__ xsrc, const float* __restrict__ g, int t0,
                                                    char* xt, int wave, int lane) {
#pragma unroll 2
  for (int i = 0; i < 8; ++i) {
    const int tok = wave * 8 + i;
    const float* xr = xsrc + (size_t)(t0 + tok) * D_MODEL;
    float4 v[4];
    float ss = 0.f;
#pragma unroll
    for (int q = 0; q < 4; ++q) {
      v[q] = *(const float4*)(xr + q * 256 + lane * 4);
      ss += v[q].x * v[q].x + v[q].y * v[q].y + v[q].z * v[q].z + v[q].w * v[q].w;
    }
    ss = wave_sum(ss);
    const float r = rsqrtf(ss * (1.0f / D_MODEL) + EPS);
#pragma unroll
    for (int q = 0; q < 4; ++q) {
      float4 gg = *(const float4*)(g + q * 256 + lane * 4);
      uint2 o;
      o.x = pack2bf(v[q].x * r * gg.x, v[q].y * r * gg.y);
      o.y = pack2bf(v[q].z * r * gg.z, v[q].w * r * gg.w);
      *(uint2*)(xt + tok * LDXB + (q * 256 + lane * 4) * 2) = o;
    }
  }
}

__device__ __forceinline__ void o_p1(const int wv_, const Params& p, int l, const float* __restrict__ xsrc, char* smem) {
  const int tidx_ = opaque_tid(wv_); const int bidx_ = opaque_bid();
  const int wave = tidx_ >> 6, lane = tidx_ & 63;
  const bf16_t* wf = p.wf_in + (size_t)l * D_MODEL * IN_WIDTH;
  const float* g = p.norm_mix + l * D_MODEL;
  for (int tile = bidx_; tile < NTOK / 64; tile += gridDim.x) {
    const int t0 = tile * 64;
    __syncthreads();
    tile_rmsnorm_to_lds(xsrc, g, t0, smem, wave, lane);
    __syncthreads();
#pragma unroll 1
    for (int c = wave; c < IN_WIDTH / 64; c += 8) {
      f32x4 acc[4][4];
#pragma unroll
      for (int a = 0; a < 4; ++a)
#pragma unroll
        for (int b = 0; b < 4; ++b) acc[a][b] = (f32x4){0.f, 0.f, 0.f, 0.f};
      tl_gemm_chunk<4, 3, 4>(wf + (size_t)c * 32 * 4 * 64 * 8, 32, smem, 0, acc, lane);
      asm volatile("" ::: "memory");
      if (c >= 4 && c < 12) {
        const float sc = (c >= 8) ? 0.125f : 1.0f;
#pragma unroll
        for (int mt = 0; mt < 4; ++mt) {
          const int tok = t0 + mt * 16 + (lane & 15);
          const int pos = tok & (SEQ - 1);
#pragma unroll
          for (int nt = 0; nt < 2; ++nt) {
            const int i0 = nt * 16 + 4 * (lane >> 4);
            const float4 cs01 = *(const float4*)(p.rope + pos * 32 + i0);
            const float4 cs23 = *(const float4*)(p.rope + pos * 32 + i0 + 2);
            const float cc[4] = {cs01.x, cs01.z, cs23.x, cs23.z};
            const float sn[4] = {cs01.y, cs01.w, cs23.y, cs23.w};
#pragma unroll
            for (int r = 0; r < 4; ++r) {
              const float x1 = acc[nt][mt][r], x2 = acc[nt + 2][mt][r];
              acc[nt][mt][r] = (x1 * cc[r] - x2 * sn[r]) * sc;
              acc[nt + 2][mt][r] = (x1 * sn[r] + x2 * cc[r]) * sc;
            }
          }
        }
      } else if (c >= 28 && c < 32) {
#pragma unroll
        for (int a = 0; a < 4; ++a)
#pragma unroll
          for (int b = 0; b < 4; ++b) acc[a][b] *= 0.125f;
      } else if (c >= 40) {
#pragma unroll
        for (int a = 0; a < 4; ++a)
#pragma unroll
          for (int b = 0; b < 4; ++b)
#pragma unroll
            for (int r = 0; r < 4; ++r) acc[a][b][r] = 1.0f / (1.0f + __expf(-acc[a][b][r]));
      }
      {
        char* patch = smem + XTILE_BYTES + wave * 2304;
#pragma unroll
        for (int mt = 0; mt < 4; ++mt) {
#pragma unroll
          for (int nt = 0; nt < 4; ++nt) {
            uint2 o;
            o.x = pack2bf(acc[nt][mt][0], acc[nt][mt][1]);
            o.y = pack2bf(acc[nt][mt][2], acc[nt][mt][3]);
            *(uint2*)(patch + (lane & 15) * 144 + (nt * 16 + 4 * (lane >> 4)) * 2) = o;
          }
#pragma unroll
          for (int h = 0; h < 2; ++h) {
            const int row = h * 8 + (lane >> 3), unit = lane & 7;
            const uint4 v = *(const uint4*)(patch + row * 144 + unit * 16);
            *(uint4*)(p.proj + (size_t)(t0 + mt * 16 + row) * IN_WIDTH + c * 64 + unit * 8) = v;
          }
        }
      }
    }
  }
}


__device__ __forceinline__ void o_final_norm_tile(const Params& p, int t0, int tid) {
  const int wave = tid >> 6, lane = tid & 63;
#pragma unroll 2
  for (int i = 0; i < 8; ++i) {
    const size_t row = (size_t)(t0 + wave * 8 + i) * D_MODEL;
    float4 v[4];
    float ss = 0.f;
#pragma unroll
    for (int q = 0; q < 4; ++q) {
      v[q] = *(const float4*)(p.xres + row + q * 256 + lane * 4);
      ss += v[q].x * v[q].x + v[q].y * v[q].y + v[q].z * v[q].z + v[q].w * v[q].w;
    }
    ss = wave_sum(ss);
    const float r = rsqrtf(ss * (1.0f / D_MODEL) + EPS);
#pragma unroll
    for (int q = 0; q < 4; ++q) {
      const float4 gg = *(const float4*)(p.norm_final + q * 256 + lane * 4);
      *(float4*)(p.out + row + q * 256 + lane * 4) = make_float4(v[q].x * r * gg.x, v[q].y * r * gg.y, v[q].z * r * gg.z, v[q].w * r * gg.w);
    }
  }
}

__device__ __forceinline__ void tile_load_to_lds(const bf16_t* __restrict__ src, int ld, char* xt, int tid) {
#pragma unroll 4
  for (int it = 0; it < 16; ++it) {
    const int idx = it * NTHREADS + tid;
    const int row = idx >> 7, u = idx & 127;
    const uint4 v = *(const uint4*)(src + (size_t)row * ld + u * 8);
    *(uint4*)(xt + row * LDXB + u * 16) = v;
  }
}

__device__ __forceinline__ void o_p5a1_tile(const Params& p, int l, int t0, char* smem, int tid) {
  const int wave = tid >> 6, lane = tid & 63;
  __syncthreads();
  tile_load_to_lds(p.ycat + (size_t)t0 * 1024, 1024, smem, tid);
  __syncthreads();
  const bf16_t* wfb = p.wf_br + (size_t)l * 1024 * 1024;
  bf16x8 wb[4][2];
  f32x4 m[2][4];
  {
    const int c0 = wave >> 1, nt00 = (wave & 1) * 2;
    tl_gemm_prologue<2, 3, 4>(wfb + (size_t)c0 * 8 * 4 * 64 * 8, wb, lane, nt00);
  }
#pragma unroll 1
  for (int it = 0; it < 12; ++it) {
    const int hi = it / 3, br = it - hi * 3;
    const int hc = wave + 8 * hi;
    const int c = hc >> 1, nt0 = (hc & 1) * 2;
    const int koff = (br == 0) ? 0 : (br == 1 ? 256 : 768);
    const int KS = (br == 1) ? 16 : 8;
    uint2 gv[4][2];
#pragma unroll
    for (int mt = 0; mt < 4; ++mt) {
      const int tok = t0 + mt * 16 + (lane & 15);
      const bf16_t* gp = p.proj + (size_t)tok * IN_WIDTH + C_GATE + br * 1024 + c * 64 + nt0 * 16 + 4 * (lane >> 4);
#pragma unroll
      for (int nt = 0; nt < 2; ++nt) gv[mt][nt] = *(const uint2*)(gp + nt * 16);
    }
    f32x4 acc[2][4];
#pragma unroll
    for (int a2 = 0; a2 < 2; ++a2)
#pragma unroll
      for (int b2 = 0; b2 < 4; ++b2) acc[a2][b2] = (f32x4){0.f, 0.f, 0.f, 0.f};
    tl_gemm_main<2, 3, 4>(wfb + (size_t)koff * 1024 + (size_t)c * KS * 4 * 64 * 8, KS, smem, koff * 2, acc, wb, lane, nt0);
    asm volatile("" ::: "memory");
    {
      const int itn = (it + 1 < 12) ? it + 1 : it;
      const int hin = itn / 3, brn = itn - hin * 3;
      const int hcn = wave + 8 * hin;
      const int koffn = (brn == 0) ? 0 : (brn == 1 ? 256 : 768);
      const int KSn = (brn == 1) ? 16 : 8;
      tl_gemm_prologue<2, 3, 4>(wfb + (size_t)koffn * 1024 + (size_t)(hcn >> 1) * KSn * 4 * 64 * 8, wb, lane, (hcn & 1) * 2);
    }
    if (br == 0) {
#pragma unroll
      for (int a2 = 0; a2 < 2; ++a2)
#pragma unroll
        for (int b2 = 0; b2 < 4; ++b2) m[a2][b2] = (f32x4){0.f, 0.f, 0.f, 0.f};
    }
#pragma unroll
    for (int mt = 0; mt < 4; ++mt)
#pragma unroll
      for (int nt = 0; nt < 2; ++nt) {
        m[nt][mt][0] += __uint_as_float(gv[mt][nt].x << 16) * acc[nt][mt][0];
        m[nt][mt][1] += __uint_as_float(gv[mt][nt].x & 0xffff0000u) * acc[nt][mt][1];
        m[nt][mt][2] += __uint_as_float(gv[mt][nt].y << 16) * acc[nt][mt][2];
        m[nt][mt][3] += __uint_as_float(gv[mt][nt].y & 0xffff0000u) * acc[nt][mt][3];
      }
    if (br == 2) {
#pragma unroll
      for (int mt = 0; mt < 4; ++mt) {
        const int tok = t0 + mt * 16 + (lane & 15);
        bf16_t* dst = p.mrg + (size_t)tok * 1024 + c * 64 + nt0 * 16 + 4 * (lane >> 4);
#pragma unroll
        for (int nt = 0; nt < 2; ++nt) {
          uint2 o;
          o.x = pack2bf(m[nt][mt][0], m[nt][mt][1]);
          o.y = pack2bf(m[nt][mt][2], m[nt][mt][3]);
          *(uint2*)(dst + nt * 16) = o;
        }
      }
    }
  }
}
__device__ __forceinline__ void o_p5a2_tile(const Params& p, int l, const float* __restrict__ xcur, int t0, char* smem, int tid) {
  const int wave = tid >> 6, lane = tid & 63;
  __syncthreads();
  tile_load_to_lds(p.mrg + (size_t)t0 * 1024, 1024, smem, tid);
  __syncthreads();
  const bf16_t* wfo = p.wf_out + (size_t)l * 1024 * 1024;
#pragma unroll 1
  for (int c = wave; c < 16; c += 8) {
    f32x4 acc[4][4];
#pragma unroll
    for (int a = 0; a < 4; ++a)
#pragma unroll
      for (int b = 0; b < 4; ++b) acc[a][b] = (f32x4){0.f, 0.f, 0.f, 0.f};
    tl_gemm_chunk<4, 2>(wfo + (size_t)c * 32 * 4 * 64 * 8, 32, smem, 0, acc, lane);
    asm volatile("" ::: "memory");
#pragma unroll
    for (int mt = 0; mt < 4; ++mt) {
      const int tok = t0 + mt * 16 + (lane & 15);
      const size_t o = (size_t)tok * 1024 + c * 64 + 4 * (lane >> 4);
#pragma unroll
      for (int nt = 0; nt < 4; ++nt) {
        float4 xv = *(const float4*)(xcur + o + nt * 16);
        xv.x += acc[nt][mt][0]; xv.y += acc[nt][mt][1]; xv.z += acc[nt][mt][2]; xv.w += acc[nt][mt][3];
        *(float4*)(p.xres + o + nt * 16) = xv;
      }
    }
  }
}
__device__ __forceinline__ void o_p5a3_tile(const Params& p, int l, int t0, char* smem, int tid) {
  const int wave = tid >> 6, lane = tid & 63;
  __syncthreads();
  tile_rmsnorm_to_lds(p.xres, p.norm_ffn + l * D_MODEL, t0, smem, wave, lane);
  __syncthreads();
}


__device__ __forceinline__ unsigned mono_f(float f) {
  unsigned u = __float_as_uint(f);
  return (u & 0x80000000u) ? ~u : (u | 0x80000000u);
}
__device__ __forceinline__ float unmono_f(unsigned m) {
  return __uint_as_float((m & 0x80000000u) ? (m & 0x7fffffffu) : ~m);
}
#define CE_DESC(x, y) { const unsigned hi_ = max(x, y); const unsigned lo_ = min(x, y); x = hi_; y = lo_; }
#define CE_ASC(x, y) { const unsigned hi_ = max(x, y); const unsigned lo_ = min(x, y); x = lo_; y = hi_; }
__device__ __forceinline__ void sort16_desc(unsigned (&a)[16]) {
#pragma unroll
  for (int k = 2; k <= 16; k <<= 1) {
#pragma unroll
    for (int j = k >> 1; j > 0; j >>= 1) {
#pragma unroll
      for (int i = 0; i < 16; ++i) {
        const int l = i ^ j;
        if (l > i) {
          if ((i & k) == 0) CE_DESC(a[i], a[l]) else CE_ASC(a[i], a[l])
        }
      }
    }
  }
}
__device__ __forceinline__ void bitonic_merge16_desc(unsigned (&a)[16]) {
#pragma unroll
  for (int j = 8; j > 0; j >>= 1) {
#pragma unroll
    for (int i = 0; i < 16; ++i) {
      const int l = i ^ j;
      if (l > i) CE_DESC(a[i], a[l])
    }
  }
}
__device__ __forceinline__ void xlane_merge16(unsigned (&a)[16], int mask) {
  unsigned b[16];
#pragma unroll
  for (int i = 0; i < 16; ++i) b[i] = (unsigned)__shfl_xor((int)a[i], mask, 64);
#pragma unroll
  for (int i = 0; i < 16; ++i) a[i] = max(a[i], b[15 - i]);
  bitonic_merge16_desc(a);
}

__device__ __forceinline__ void o_peer_select_tile(const Params& p, int l, int t0, char* smem, int tid) {
  const int h = __builtin_amdgcn_readfirstlane(tid >> 6), lane = tid & 63;
  const int g = lane >> 4, tl = lane & 15;
  const bf16_t* wfq = p.wf_q + (size_t)l * 1024 * 2048;
#pragma unroll 1
  for (int pp = 0; pp < 2; ++pp) {
    bf16x8 qf[4][4];
#pragma unroll 1
    for (int cc = 0; cc < 2; ++cc) {
      const int c = (h * 2 + pp) * 2 + cc;
      f32x4 acc[4][4];
#pragma unroll
      for (int a = 0; a < 4; ++a)
#pragma unroll
        for (int b = 0; b < 4; ++b) acc[a][b] = (f32x4){0.f, 0.f, 0.f, 0.f};
      tl_gemm_chunk<4, 2>(wfq + (size_t)c * 32 * 4 * 64 * 8, 32, smem, 0, acc, lane);
#pragma unroll
      for (int sl = 0; sl < 2; ++sl)
#pragma unroll
        for (int mt = 0; mt < 4; ++mt) {
          union { bf16x8 v; unsigned u[4]; } cv;
          cv.u[0] = pack2bf(acc[2 * sl][mt][0], acc[2 * sl][mt][1]);
          cv.u[1] = pack2bf(acc[2 * sl][mt][2], acc[2 * sl][mt][3]);
          cv.u[2] = pack2bf(acc[2 * sl + 1][mt][0], acc[2 * sl + 1][mt][1]);
          cv.u[3] = pack2bf(acc[2 * sl + 1][mt][2], acc[2 * sl + 1][mt][3]);
          if (cc == 0) qf[sl][mt] = cv.v; else qf[2 + sl][mt] = cv.v;
        }
    }
    const bf16x8* kfp = (const bf16x8*)p.kf + (size_t)((l * 2 + pp) * 8) * 4 * 64 + lane;
#pragma unroll
    for (int mt = 0; mt < 4; ++mt) {
      f32x4 sc[8];
#pragma unroll
      for (int kt = 0; kt < 8; ++kt) sc[kt] = (f32x4){0.f, 0.f, 0.f, 0.f};
#pragma unroll
      for (int s2 = 0; s2 < 4; ++s2) {
        bf16x8 qv;
        qv = qf[s2][mt];
#pragma unroll
        for (int kt = 0; kt < 8; ++kt)
          sc[kt] = __builtin_amdgcn_mfma_f32_16x16x32_bf16(kfp[(kt * 4 + s2) * 64], qv, sc[kt], 0, 0, 0);
        __builtin_amdgcn_sched_barrier(0);
      }
      unsigned A[16], B[16];
#pragma unroll
      for (int kt = 0; kt < 4; ++kt)
#pragma unroll
        for (int r = 0; r < 4; ++r) {
          A[kt * 4 + r] = (mono_f(sc[kt][r]) & ~127u) | (unsigned)(127 - (kt * 16 + r) - 4 * g);
          B[kt * 4 + r] = (mono_f(sc[kt + 4][r]) & ~127u) | (unsigned)(127 - ((kt + 4) * 16 + r) - 4 * g);
        }
      sort16_desc(A);
      sort16_desc(B);
#pragma unroll
      for (int i = 0; i < 16; ++i) A[i] = max(A[i], B[15 - i]);
      bitonic_merge16_desc(A);
      xlane_merge16(A, 16);
      xlane_merge16(A, 32);
      if (g == 0) {
        uint4* dst = (uint4*)(p.tklist + ((size_t)((t0 + mt * 16 + tl) * 8 + h) * 2 + pp) * 16);
        dst[0] = make_uint4(A[0], A[1], A[2], A[3]);
        dst[1] = make_uint4(A[4], A[5], A[6], A[7]);
        dst[2] = make_uint4(A[8], A[9], A[10], A[11]);
        dst[3] = make_uint4(A[12], A[13], A[14], A[15]);
      }
    }
  }
  asm volatile("s_waitcnt vmcnt(0)" ::: "memory");
}

__device__ __forceinline__ void o_peer_select2_tile(const Params& p, int l, int t0, int tid) {
  const int h = __builtin_amdgcn_readfirstlane(tid >> 6), lane = tid & 63;
  const int g = lane >> 4, tl = lane & 15;
#pragma unroll 1
  for (int mt = 0; mt < 4; ++mt) {
    const int tok = t0 + mt * 16 + tl;
    const unsigned* lp = p.tklist + ((size_t)(tok * 8 + h) * 2) * 16;
    float v1[16], v2[16];
    {
      const uint4* q4 = (const uint4*)lp;
#pragma unroll
      for (int i = 0; i < 4; ++i) {
        uint4 x = q4[i], y = q4[4 + i];
        v1[4 * i + 0] = unmono_f(x.x & ~127u); v1[4 * i + 1] = unmono_f(x.y & ~127u);
        v1[4 * i + 2] = unmono_f(x.z & ~127u); v1[4 * i + 3] = unmono_f(x.w & ~127u);
        v2[4 * i + 0] = unmono_f(y.x & ~127u); v2[4 * i + 1] = unmono_f(y.y & ~127u);
        v2[4 * i + 2] = unmono_f(y.z & ~127u); v2[4 * i + 3] = unmono_f(y.w & ~127u);
      }
    }
    unsigned C[16];
#pragma unroll
    for (int i = 0; i < 16; ++i) C[i] = 0u;
    {
      int idx = 0;
#pragma unroll
      for (int a = 0; a < 16; ++a) {
#pragma unroll
        for (int b = 0; b < 16; ++b) {
          if ((a + 1) * (b + 1) <= 16) {
            const unsigned key = (mono_f(v1[a] + v2[b]) & ~255u) | (unsigned)(255 - (a * 16 + b));
            const int slot = idx >> 2, who = idx & 3;
            C[slot] = (g == who) ? key : C[slot];
            ++idx;
          }
        }
      }
    }
    sort16_desc(C);
    xlane_merge16(C, 16);
    xlane_merge16(C, 32);
    const float f0 = unmono_f(C[0] & ~255u);
    float den = 0.f;
    float ev[16];
#pragma unroll
    for (int i = 0; i < 16; ++i) { ev[i] = __expf(unmono_f(C[i] & ~255u) - f0); den += ev[i]; }
    const float rden = 1.0f / den;
    int eidx[4]; float egate[4];
#pragma unroll
    for (int i = 0; i < 4; ++i) {
      const unsigned k = (g == 0) ? C[i] : (g == 1) ? C[4 + i] : (g == 2) ? C[8 + i] : C[12 + i];
      const float e = (g == 0) ? ev[i] : (g == 1) ? ev[4 + i] : (g == 2) ? ev[8 + i] : ev[12 + i];
      const int pos = 255 - (int)(k & 255u);
      const int a = pos >> 4, b = pos & 15;
      const int n1 = 127 - (int)(lp[a] & 127u);
      const int n2 = 127 - (int)(lp[16 + b] & 127u);
      eidx[i] = n1 * 128 + n2;
      egate[i] = e * rden;
    }
    *(int4*)(p.pidx + (size_t)tok * 128 + h * 16 + 4 * g) = make_int4(eidx[0], eidx[1], eidx[2], eidx[3]);
    *(float4*)(p.pgate + (size_t)tok * 128 + h * 16 + 4 * g) = make_float4(egate[0], egate[1], egate[2], egate[3]);
  }
}

__device__ __forceinline__ float logsigmoid_(float x) { return fminf(x, 0.f) - log1pf(expf(-fabsf(x))); }
__device__ __forceinline__ float bf_lo(unsigned w) { return __uint_as_float(w << 16); }
__device__ __forceinline__ float bf_hi(unsigned w) { return __uint_as_float(w & 0xffff0000u); }

#define RKV_LD 136
__device__ __forceinline__ void o_ret_kv_task(const Params& p, int l, int task, char* smem, int tid) {
  const int wave = tid >> 6, lane = tid & 63, g = lane >> 4, tl = lane & 15;
  const int bh = task >> 5, n = task & 31, b = bh >> 2, h = bh & 3;
  const int tok0 = b * SEQ + n * 128;
  const float lgf = logsigmoid_(p.ret_decay[l * 8 + h]), lgb = logsigmoid_(p.ret_decay[l * 8 + 4 + h]);
  bf16_t* KTf = (bf16_t*)smem;
  bf16_t* KTb = KTf + 64 * RKV_LD;
  bf16_t* VT = KTb + 64 * RKV_LD;
  __syncthreads();
#pragma unroll
  for (int it = 0; it < 2; ++it) {
    const int u = tid + it * NTHREADS;
    const int j = u >> 3, d0 = (u & 7) * 8;
    const uint4 kv = *(const uint4*)(p.proj + (size_t)(tok0 + j) * IN_WIDTH + C_RK + h * 64 + d0);
    const float wf = __expf(lgf * (float)(127 - j)), wb = __expf(lgb * (float)(j + 1));
    const unsigned kw[4] = {kv.x, kv.y, kv.z, kv.w};
#pragma unroll
    for (int e = 0; e < 4; ++e) {
      const float x0 = bf_lo(kw[e]), x1 = bf_hi(kw[e]);
      KTf[(d0 + 2 * e) * RKV_LD + j] = f2bf(x0 * wf);
      KTf[(d0 + 2 * e + 1) * RKV_LD + j] = f2bf(x1 * wf);
      KTb[(d0 + 2 * e) * RKV_LD + j] = f2bf(x0 * wb);
      KTb[(d0 + 2 * e + 1) * RKV_LD + j] = f2bf(x1 * wb);
    }
  }
#pragma unroll
  for (int it = 0; it < 4; ++it) {
    const int u = tid + it * NTHREADS;
    const int j = u >> 4, e0 = (u & 15) * 8;
    const uint4 vv = *(const uint4*)(p.proj + (size_t)(tok0 + j) * IN_WIDTH + C_RV + h * 128 + e0);
    const unsigned vw[4] = {vv.x, vv.y, vv.z, vv.w};
#pragma unroll
    for (int e = 0; e < 4; ++e) {
      VT[(e0 + 2 * e) * RKV_LD + j] = (bf16_t)(vw[e] & 0xffffu);
      VT[(e0 + 2 * e + 1) * RKV_LD + j] = (bf16_t)(vw[e] >> 16);
    }
  }
  __syncthreads();
  bf16x8 a[4];
#pragma unroll
  for (int ks = 0; ks < 4; ++ks) a[ks] = *(const bf16x8*)(VT + (wave * 16 + tl) * RKV_LD + ks * 32 + 8 * g);
#pragma unroll
  for (int dir = 0; dir < 2; ++dir) {
    const bf16_t* KT = dir ? KTb : KTf;
#pragma unroll
    for (int dt = 0; dt < 4; ++dt) {
      f32x4 acc = (f32x4){0.f, 0.f, 0.f, 0.f};
#pragma unroll
      for (int ks = 0; ks < 4; ++ks) {
        const bf16x8 bb = *(const bf16x8*)(KT + (dt * 16 + tl) * RKV_LD + ks * 32 + 8 * g);
        acc = __builtin_amdgcn_mfma_f32_16x16x32_bf16(a[ks], bb, acc, 0, 0, 0);
      }
      float* dst = p.kvst + ((size_t)(task * 2 + dir) * 128 + wave * 16 + 4 * g) * 64 + dt * 16 + tl;
#pragma unroll
      for (int r = 0; r < 4; ++r) dst[r * 64] = acc[r];
    }
  }
}

__device__ __forceinline__ void o_ret_scan(const int wv_, const Params& p, int l) {
  const int tidx_ = opaque_tid(wv_); const int bidx_ = opaque_bid();
  const int gsz = gridDim.x * NTHREADS;
  for (int u = bidx_ * NTHREADS + tidx_; u < 16 * 2 * 128 * 16; u += gsz) {
    const int dq = u & 15, e = (u >> 4) & 127, dir = (u >> 11) & 1, bh = u >> 12, h = bh & 3;
    const float lg = logsigmoid_(p.ret_decay[l * 8 + dir * 4 + h]);
    const float gC = __expf(lg * 128.0f);
    float4 st = make_float4(0.f, 0.f, 0.f, 0.f);
#pragma unroll 8
    for (int nn = 0; nn < 32; ++nn) {
      const int n = dir ? (31 - nn) : nn;
      const size_t idx = ((size_t)((bh * 32 + n) * 2 + dir) * 128 + e) * 64 + dq * 4;
      const float4 kv = *(const float4*)(p.kvst + idx);
      uint2 o;
      o.x = pack2bf(st.x, st.y); o.y = pack2bf(st.z, st.w);
      *(uint2*)(p.rstate + idx) = o;
      st.x = fmaf(st.x, gC, kv.x); st.y = fmaf(st.y, gC, kv.y); st.z = fmaf(st.z, gC, kv.z); st.w = fmaf(st.w, gC, kv.w);
    }
  }
}

#define RO_LD 264
#define RK_LD 72
__device__ __forceinline__ void o_ret_out_task(const Params& p, int l, int task, char* smem, int tid) {
  const int wave = tid >> 6, lane = tid & 63, g = lane >> 4, tl = lane & 15;
  const int bh = task >> 5, n = task & 31, b = bh >> 2, h = bh & 3;
  const int tok0 = b * SEQ + n * 128;
  const float lgf = logsigmoid_(p.ret_decay[l * 8 + h]), lgb = logsigmoid_(p.ret_decay[l * 8 + 4 + h]);
  bf16_t* Acat = (bf16_t*)smem;
  bf16_t* Bcat = Acat + 128 * RO_LD;
  bf16_t* Kl = Bcat + 128 * RO_LD;
  __syncthreads();
#pragma unroll
  for (int it = 0; it < 2; ++it) {
    const int u = tid + it * NTHREADS;
    const int i = u >> 3, d0 = (u & 7) * 8;
    const size_t row = (size_t)(tok0 + i) * IN_WIDTH;
    const uint4 qv = *(const uint4*)(p.proj + row + C_RQ + h * 64 + d0);
    const uint4 kv = *(const uint4*)(p.proj + row + C_RK + h * 64 + d0);
    *(uint4*)(Acat + i * RO_LD + d0) = qv;
    *(uint4*)(Kl + i * RK_LD + d0) = kv;
    const float wf = __expf(lgf * (float)(i + 1)), wb = __expf(lgb * (float)(127 - i));
    const unsigned qw[4] = {qv.x, qv.y, qv.z, qv.w};
    uint4 of, ob;
    of.x = pack2bf(bf_lo(qw[0]) * wf, bf_hi(qw[0]) * wf); ob.x = pack2bf(bf_lo(qw[0]) * wb, bf_hi(qw[0]) * wb);
    of.y = pack2bf(bf_lo(qw[1]) * wf, bf_hi(qw[1]) * wf); ob.y = pack2bf(bf_lo(qw[1]) * wb, bf_hi(qw[1]) * wb);
    of.z = pack2bf(bf_lo(qw[2]) * wf, bf_hi(qw[2]) * wf); ob.z = pack2bf(bf_lo(qw[2]) * wb, bf_hi(qw[2]) * wb);
    of.w = pack2bf(bf_lo(qw[3]) * wf, bf_hi(qw[3]) * wf); ob.w = pack2bf(bf_lo(qw[3]) * wb, bf_hi(qw[3]) * wb);
    *(uint4*)(Acat + i * RO_LD + 128 + d0) = of;
    *(uint4*)(Acat + i * RO_LD + 192 + d0) = ob;
  }
#pragma unroll
  for (int it = 0; it < 4; ++it) {
    const int u = tid + it * NTHREADS;
    const int j = u >> 4, e0 = (u & 15) * 8;
    const uint4 vv = *(const uint4*)(p.proj + (size_t)(tok0 + j) * IN_WIDTH + C_RV + h * 128 + e0);
    const unsigned vw[4] = {vv.x, vv.y, vv.z, vv.w};
#pragma unroll
    for (int e = 0; e < 4; ++e) {
      Bcat[(e0 + 2 * e) * RO_LD + j] = (bf16_t)(vw[e] & 0xffffu);
      Bcat[(e0 + 2 * e + 1) * RO_LD + j] = (bf16_t)(vw[e] >> 16);
    }
  }
#pragma unroll
  for (int it = 0; it < 4; ++it) {
    const int u = tid + it * NTHREADS;
    const int d0 = (u & 7) * 8, e = (u >> 3) & 127, dir = u >> 10;
    const uint4 sv = *(const uint4*)(p.rstate + ((size_t)(task * 2 + dir) * 128 + e) * 64 + d0);
    *(uint4*)(Bcat + e * RO_LD + 128 + dir * 64 + d0) = sv;
  }
  __syncthreads();
  f32x4 sc[8];
#pragma unroll
  for (int jt = 0; jt < 8; ++jt) sc[jt] = (f32x4){0.f, 0.f, 0.f, 0.f};
#pragma unroll
  for (int ks = 0; ks < 2; ++ks) {
    const bf16x8 qb = *(const bf16x8*)(Acat + (wave * 16 + tl) * RO_LD + ks * 32 + 8 * g);
#pragma unroll
    for (int jt = 0; jt < 8; ++jt) {
      const bf16x8 ka = *(const bf16x8*)(Kl + (jt * 16 + tl) * RK_LD + ks * 32 + 8 * g);
      sc[jt] = __builtin_amdgcn_mfma_f32_16x16x32_bf16(ka, qb, sc[jt], 0, 0, 0);
    }
  }
  {
    const int i = wave * 16 + tl;
#pragma unroll
    for (int jt = 0; jt < 8; ++jt) {
      float pv[4];
#pragma unroll
      for (int r = 0; r < 4; ++r) {
        const int j = jt * 16 + 4 * g + r;
        const float dd = (j <= i) ? __expf(lgf * (float)(i - j)) : __expf(lgb * (float)(j - i));
        pv[r] = sc[jt][r] * dd;
      }
      uint2 o;
      o.x = pack2bf(pv[0], pv[1]); o.y = pack2bf(pv[2], pv[3]);
      *(uint2*)(Acat + i * RO_LD + jt * 16 + 4 * g) = o;
    }
  }
  f32x4 y[8];
#pragma unroll
  for (int et = 0; et < 8; ++et) y[et] = (f32x4){0.f, 0.f, 0.f, 0.f};
#pragma unroll
  for (int ks = 0; ks < 8; ++ks) {
    const bf16x8 ab = *(const bf16x8*)(Acat + (wave * 16 + tl) * RO_LD + ks * 32 + 8 * g);
#pragma unroll
    for (int et = 0; et < 8; ++et) {
      const bf16x8 ba = *(const bf16x8*)(Bcat + (et * 16 + tl) * RO_LD + ks * 32 + 8 * g);
      y[et] = __builtin_amdgcn_mfma_f32_16x16x32_bf16(ba, ab, y[et], 0, 0, 0);
    }
  }
  float ss = 0.f;
#pragma unroll
  for (int et = 0; et < 8; ++et)
#pragma unroll
    for (int r = 0; r < 4; ++r) ss = fmaf(y[et][r], y[et][r], ss);
  ss += __shfl_xor(ss, 16, 64);
  ss += __shfl_xor(ss, 32, 64);
  const float rstd = rsqrtf(ss * (1.0f / 128.0f) + EPS);
  {
    const int tok = tok0 + wave * 16 + tl;
    const bf16_t* gp = p.proj + (size_t)tok * IN_WIDTH + C_RG + h * 128 + 4 * g;
    bf16_t* dst = p.ycat + (size_t)tok * 1024 + 256 + h * 128 + 4 * g;
#pragma unroll
    for (int et = 0; et < 8; ++et) {
      const uint2 gv = *(const uint2*)(gp + et * 16);
      const float g0 = bf_lo(gv.x), g1 = bf_hi(gv.x), g2 = bf_lo(gv.y), g3 = bf_hi(gv.y);
      uint2 o;
      o.x = pack2bf(g0 / (1.0f + __expf(-g0)) * y[et][0] * rstd, g1 / (1.0f + __expf(-g1)) * y[et][1] * rstd);
      o.y = pack2bf(g2 / (1.0f + __expf(-g2)) * y[et][2] * rstd, g3 / (1.0f + __expf(-g3)) * y[et][3] * rstd);
      *(uint2*)(dst + et * 16) = o;
    }
  }
}


#define NA_KLD 72
#define NA_VLD 520
__device__ __forceinline__ void o_na_task(const Params& p, int l, int task, char* smem, int tid) {
  const int wave = tid >> 6, lane = tid & 63, g = lane >> 4, tl = lane & 15;
  const int rr = task & 63, h = (task >> 6) & 3, b = task >> 8;
  int rs = rr - 4; rs = rs < 0 ? 0 : (rs > 56 ? 56 : rs);
  const int ktok0 = b * SEQ + rs * 64;
  const int qtok0 = b * SEQ + rr * 64;
  bf16_t* Kl = (bf16_t*)smem;
  bf16_t* VT = Kl + 512 * NA_KLD;
  bf16_t* Ql = VT + 64 * NA_VLD;
  float* rpbl = (float*)(Ql + 64 * NA_KLD);
  __syncthreads();
#pragma unroll
  for (int it = 0; it < 8; ++it) {
    const int u = tid + it * NTHREADS;
    const int key = u >> 3, d0 = (u & 7) * 8;
    const size_t row = (size_t)(ktok0 + key) * IN_WIDTH;
    const uint4 kv = *(const uint4*)(p.proj + row + C_NK + h * 64 + d0);
    const uint4 vv = *(const uint4*)(p.proj + row + C_NV + h * 64 + d0);
    *(uint4*)(Kl + key * NA_KLD + d0) = kv;
    const unsigned vw[4] = {vv.x, vv.y, vv.z, vv.w};
#pragma unroll
    for (int e = 0; e < 4; ++e) {
      VT[(d0 + 2 * e) * NA_VLD + key] = (bf16_t)(vw[e] & 0xffffu);
      VT[(d0 + 2 * e + 1) * NA_VLD + key] = (bf16_t)(vw[e] >> 16);
    }
  }
  {
    const int q = tid >> 3, d0 = (tid & 7) * 8;
    *(uint4*)(Ql + q * NA_KLD + d0) = *(const uint4*)(p.proj + (size_t)(qtok0 + q) * IN_WIDTH + C_NQ + h * 64 + d0);
    if (tid < 465) rpbl[tid] = p.na_rpb[((size_t)l * 4 + h) * 465 + tid];
  }
  __syncthreads();
  if (wave < 4) {
    const int qt = wave;
    int cw0 = 16 * qt - 8; cw0 = cw0 < 0 ? 0 : (cw0 > 32 ? 32 : cw0);
    f32x4 sc[16];
#pragma unroll
    for (int T = 0; T < 16; ++T) sc[T] = (f32x4){0.f, 0.f, 0.f, 0.f};
#pragma unroll
    for (int ks = 0; ks < 2; ++ks) {
      const bf16x8 qb = *(const bf16x8*)(Ql + (qt * 16 + tl) * NA_KLD + ks * 32 + 8 * g);
#pragma unroll
      for (int T = 0; T < 16; ++T) {
        const int key = (T >> 1) * 64 + cw0 + (T & 1) * 16 + tl;
        const bf16x8 ka = *(const bf16x8*)(Kl + key * NA_KLD + ks * 32 + 8 * g);
        sc[T] = __builtin_amdgcn_mfma_f32_16x16x32_bf16(ka, qb, sc[T], 0, 0, 0);
      }
    }
    const int cq = qt * 16 + tl;
    int cs = cq - 8; cs = cs < 0 ? 0 : (cs > 48 ? 48 : cs);
    float m = -3.0e38f;
#pragma unroll
    for (int T = 0; T < 16; ++T) {
      const int ri = T >> 1;
      const int di = rs + ri - rr + 7;
#pragma unroll
      for (int r = 0; r < 4; ++r) {
        const int ck = cw0 + (T & 1) * 16 + 4 * g + r;
        const bool valid = (ck >= cs) && (ck < cs + 16);
        int dj = ck - cq + 15; dj = dj < 0 ? 0 : (dj > 30 ? 30 : dj);
        const float sv = valid ? (sc[T][r] + rpbl[di * 31 + dj]) : -1.0e30f;
        sc[T][r] = sv;
        m = fmaxf(m, sv);
      }
    }
    m = fmaxf(m, __shfl_xor(m, 16, 64));
    m = fmaxf(m, __shfl_xor(m, 32, 64));
    float den = 0.f;
#pragma unroll
    for (int T = 0; T < 16; ++T)
#pragma unroll
      for (int r = 0; r < 4; ++r) {
        const float e = __expf(sc[T][r] - m);
        sc[T][r] = e;
        den += e;
      }
    den += __shfl_xor(den, 16, 64);
    den += __shfl_xor(den, 32, 64);
    const float rden = 1.0f / den;
    f32x4 o[4];
#pragma unroll
    for (int dt = 0; dt < 4; ++dt) o[dt] = (f32x4){0.f, 0.f, 0.f, 0.f};
#pragma unroll
    for (int ri = 0; ri < 8; ++ri) {
      union { bf16x8 v; unsigned u[4]; } pb;
      pb.u[0] = pack2bf(sc[2 * ri][0], sc[2 * ri][1]);
      pb.u[1] = pack2bf(sc[2 * ri][2], sc[2 * ri][3]);
      pb.u[2] = pack2bf(sc[2 * ri + 1][0], sc[2 * ri + 1][1]);
      pb.u[3] = pack2bf(sc[2 * ri + 1][2], sc[2 * ri + 1][3]);
#pragma unroll
      for (int dt = 0; dt < 4; ++dt) {
        const bf16_t* vp = VT + (dt * 16 + tl) * NA_VLD + ri * 64 + cw0 + 4 * g;
        union { bf16x8 v; uint2 h[2]; } va;
        va.h[0] = *(const uint2*)vp;
        va.h[1] = *(const uint2*)(vp + 16);
        o[dt] = __builtin_amdgcn_mfma_f32_16x16x32_bf16(va.v, pb.v, o[dt], 0, 0, 0);
      }
    }
    bf16_t* dst = p.ycat + (size_t)(qtok0 + qt * 16 + tl) * 1024 + 768 + h * 64 + 4 * g;
#pragma unroll
    for (int dt = 0; dt < 4; ++dt) {
      uint2 ov;
      ov.x = pack2bf(o[dt][0] * rden, o[dt][1] * rden);
      ov.y = pack2bf(o[dt][2] * rden, o[dt][3] * rden);
      *(uint2*)(dst + dt * 16) = ov;
    }
  }
}

#define PL_LD 264
__device__ __forceinline__ void o_pool_task(const Params& p, int l, int task, char* smem, int tid) {
  const int wave = tid >> 6, lane = tid & 63, g = lane >> 4, tl = lane & 15;
  const int t0 = task * 64, pos0 = t0 & (SEQ - 1);
  bf16_t* Xp = (bf16_t*)smem;
  bf16_t* WT = Xp + 80 * PL_LD;
  bf16_t* Df = WT + 4 * 64 * 72;
  __syncthreads();
#pragma unroll
  for (int it = 0; it < 5; ++it) {
    const int u = tid + it * NTHREADS;
    const int rw = u >> 5, c0 = (u & 31) * 8;
    const int pos = pos0 - 8 + rw;
    uint4 v = make_uint4(0u, 0u, 0u, 0u);
    if (pos >= 0 && pos < SEQ) v = *(const uint4*)(p.proj + (size_t)(t0 - 8 + rw) * IN_WIDTH + C_POOL + c0);
    *(uint4*)(Xp + rw * PL_LD + c0) = v;
  }
#pragma unroll
  for (int it = 0; it < 4; ++it) {
    const int u = tid + it * NTHREADS;
    const int e0 = (u & 7) * 8, c = (u >> 3) & 63, gi = u >> 9;
    const float* wp = p.pool_w + (((size_t)l * 4 + gi) * 64 + c) * 64 + e0;
    const float4 a = *(const float4*)wp, bq = *(const float4*)(wp + 4);
    const float wv[8] = {a.x, a.y, a.z, a.w, bq.x, bq.y, bq.z, bq.w};
#pragma unroll
    for (int k = 0; k < 8; ++k) WT[(gi * 64 + e0 + k) * 72 + c] = f2bf(wv[k]);
  }
  __syncthreads();
#pragma unroll 1
  for (int it = 0; it < 4; ++it) {
    const int u = tid + it * NTHREADS;
    const int t = u >> 5, c0 = (u & 31) * 8;
    const int gi = c0 >> 6;
    const int hw = 1 << gi;
    const int pos = pos0 + t;
    int a = pos - hw; a = a < 0 ? 0 : a;
    int bnd = pos + hw; bnd = bnd > SEQ ? SEQ : bnd;
    float sum[8];
#pragma unroll
    for (int k = 0; k < 8; ++k) sum[k] = 0.f;
    for (int rp = a; rp < bnd; ++rp) {
      const uint4 v = *(const uint4*)(Xp + (rp - pos0 + 8) * PL_LD + c0);
      sum[0] += bf_lo(v.x); sum[1] += bf_hi(v.x); sum[2] += bf_lo(v.y); sum[3] += bf_hi(v.y);
      sum[4] += bf_lo(v.z); sum[5] += bf_hi(v.z); sum[6] += bf_lo(v.w); sum[7] += bf_hi(v.w);
    }
    const float rc = 1.0f / (float)(bnd - a);
    const uint4 xv = *(const uint4*)(Xp + (t + 8) * PL_LD + c0);
    uint4 o;
    o.x = pack2bf(sum[0] * rc - bf_lo(xv.x), sum[1] * rc - bf_hi(xv.x));
    o.y = pack2bf(sum[2] * rc - bf_lo(xv.y), sum[3] * rc - bf_hi(xv.y));
    o.z = pack2bf(sum[4] * rc - bf_lo(xv.z), sum[5] * rc - bf_hi(xv.z));
    o.w = pack2bf(sum[6] * rc - bf_lo(xv.w), sum[7] * rc - bf_hi(xv.w));
    *(uint4*)(Df + t * PL_LD + c0) = o;
  }
  __syncthreads();
  {
    const int gi = wave >> 1, tt0 = (wave & 1) * 2;
    f32x4 acc[4][2];
#pragma unroll
    for (int et = 0; et < 4; ++et)
#pragma unroll
      for (int tt = 0; tt < 2; ++tt) acc[et][tt] = (f32x4){0.f, 0.f, 0.f, 0.f};
#pragma unroll
    for (int ks = 0; ks < 2; ++ks) {
      bf16x8 bx[2];
#pragma unroll
      for (int tt = 0; tt < 2; ++tt) bx[tt] = *(const bf16x8*)(Df + ((tt0 + tt) * 16 + tl) * PL_LD + gi * 64 + ks * 32 + 8 * g);
#pragma unroll
      for (int et = 0; et < 4; ++et) {
        const bf16x8 wa = *(const bf16x8*)(WT + (gi * 64 + et * 16 + tl) * 72 + ks * 32 + 8 * g);
#pragma unroll
        for (int tt = 0; tt < 2; ++tt) acc[et][tt] = __builtin_amdgcn_mfma_f32_16x16x32_bf16(wa, bx[tt], acc[et][tt], 0, 0, 0);
      }
    }
#pragma unroll
    for (int et = 0; et < 4; ++et) {
      const float4 sc4 = *(const float4*)(p.pool_scale + l * 256 + gi * 64 + et * 16 + 4 * g);
#pragma unroll
      for (int tt = 0; tt < 2; ++tt) {
        const int tok = t0 + (tt0 + tt) * 16 + tl;
        uint2 o;
        o.x = pack2bf(acc[et][tt][0] * sc4.x, acc[et][tt][1] * sc4.y);
        o.y = pack2bf(acc[et][tt][2] * sc4.z, acc[et][tt][3] * sc4.w);
        *(uint2*)(p.ycat + (size_t)tok * 1024 + gi * 64 + et * 16 + 4 * g) = o;
      }
    }
  }
}


typedef __attribute__((ext_vector_type(2))) __bf16 bf16x2_t;
__device__ __forceinline__ float dot2bf(unsigned a, unsigned b, float c) {
  return __builtin_amdgcn_fdot2_f32_bf16(__builtin_bit_cast(bf16x2_t, a), __builtin_bit_cast(bf16x2_t, b), c, false);
}
#define DPP_F(v, ctrl) __builtin_bit_cast(float, __builtin_amdgcn_update_dpp(0, __builtin_bit_cast(int, v), ctrl, 0xf, 0xf, false))
#define RDLANE_F(v, l) __builtin_bit_cast(float, __builtin_amdgcn_readlane(__builtin_bit_cast(int, v), l))
__device__ __forceinline__ float erf_as(float x) {
  const float ax = fabsf(x);
  const float t = __builtin_amdgcn_rcpf(fmaf(0.3275911f, ax, 1.0f));
  float y = fmaf(1.061405429f, t, -1.453152027f);
  y = fmaf(y, t, 1.421413741f);
  y = fmaf(y, t, -0.284496736f);
  y = fmaf(y, t, 0.254829592f);
  y = y * t * __expf(-ax * ax);
  return copysignf(1.0f - y, x);
}
__device__ __forceinline__ float gelu_fast_exact(float a) { return 0.5f * a * (1.0f + erf_as(a * 0.70710678118654752f)); }
struct PickPair { int eA, eB; float gA, gB; };

#define EX6_SHIFT 11
#define EX6_NSLICE (16384 >> EX6_SHIFT)
__device__ __forceinline__ unsigned cvt8_bf16x2(unsigned w, float scale, const bool hi) {
  return hi ? __builtin_bit_cast(unsigned, __builtin_amdgcn_cvt_scalef32_pk_bf16_fp8((int)w, scale, true))
            : __builtin_bit_cast(unsigned, __builtin_amdgcn_cvt_scalef32_pk_bf16_fp8((int)w, scale, false));
}
__device__ __forceinline__ void experts6_process4(const unsigned char* __restrict__ U8, const unsigned char* __restrict__ V8,
                                                  const float2* __restrict__ ES, const int (&e)[4], const float (&g)[4],
                                                  const unsigned (&hw)[8], float (&acc)[16], int lane, int vz) {
  uint4 u[4], v[4];
  float2 sc[4];
#pragma unroll
  for (int i = 0; i < 4; ++i) u[i] = *(const uint4*)(U8 + (size_t)e[i] * 1024 + lane * 16);
#pragma unroll
  for (int i = 0; i < 4; ++i) sc[i] = ES[e[i] + vz];
#pragma unroll
  for (int i = 0; i < 4; ++i) v[i] = *(const uint4*)(V8 + (size_t)e[i] * 1024 + lane * 16);
  float a[4];
#pragma unroll
  for (int i = 0; i < 4; ++i) {
    const unsigned uw[4] = {u[i].x, u[i].y, u[i].z, u[i].w};
    float t = 0.f;
#pragma unroll
    for (int w = 0; w < 4; ++w) {
      t = dot2bf(cvt8_bf16x2(uw[w], sc[i].x, false), hw[2 * w], t);
      t = dot2bf(cvt8_bf16x2(uw[w], sc[i].x, true), hw[2 * w + 1], t);
    }
    a[i] = t;
  }
  const bool b0 = lane & 1, b1 = lane & 2;
  const float x01 = (b0 ? a[1] : a[0]) + DPP_F((b0 ? a[0] : a[1]), 0xB1);
  const float x23 = (b0 ? a[3] : a[2]) + DPP_F((b0 ? a[2] : a[3]), 0xB1);
  float y = (b1 ? x23 : x01) + DPP_F((b1 ? x01 : x23), 0x4E);
  y += DPP_F(y, 0x124);
  y += DPP_F(y, 0x128);
  float sum[4];
#pragma unroll
  for (int i = 0; i < 4; ++i) sum[i] = RDLANE_F(y, i) + RDLANE_F(y, 16 + i) + RDLANE_F(y, 32 + i) + RDLANE_F(y, 48 + i);
  const int li = lane & 3;
  const float mine = (li == 0) ? sum[0] : (li == 1) ? sum[1] : (li == 2) ? sum[2] : sum[3];
  const float gmine = (li == 0) ? g[0] : (li == 1) ? g[1] : (li == 2) ? g[2] : g[3];
  const unsigned gb = (unsigned)f2bf(gelu_fast_exact(mine) * gmine);
#pragma unroll
  for (int i = 0; i < 4; ++i) {
    const unsigned hl = (unsigned)__builtin_amdgcn_readlane((int)gb, i);
    const unsigned hh = hl << 16;
    const unsigned vw[4] = {v[i].x, v[i].y, v[i].z, v[i].w};
#pragma unroll
    for (int w = 0; w < 4; ++w) {
      const unsigned p0 = cvt8_bf16x2(vw[w], sc[i].y, false), p1 = cvt8_bf16x2(vw[w], sc[i].y, true);
      acc[4 * w + 0] = dot2bf(p0, hl, acc[4 * w + 0]);
      acc[4 * w + 1] = dot2bf(p0, hh, acc[4 * w + 1]);
      acc[4 * w + 2] = dot2bf(p1, hl, acc[4 * w + 2]);
      acc[4 * w + 3] = dot2bf(p1, hh, acc[4 * w + 3]);
    }
  }
}

__device__ __forceinline__ void o_peer_experts6_tile(const Params& p, int l, int t0, const char* smem, int tid, bool dry = false) {
  const int wave = __builtin_amdgcn_readfirstlane(tid >> 6), lane = tid & 63;
  const unsigned char* U8 = p.u8 + (size_t)l * 16384 * 1024;
  const unsigned char* V8 = p.v8 + (size_t)l * 16384 * 1024;
  const float2* ES = p.escale + (size_t)l * 16384;
  int vz = 0;
  asm volatile("" : "+v"(vz));
  const int s0 = ((int)(__builtin_amdgcn_s_getreg((3 << 11) | 20) & 0xF) * (EX6_NSLICE / 8)) & (EX6_NSLICE - 1);
  unsigned pk[8][2];
  float acc[8][16];
#pragma unroll
  for (int k = 0; k < 8; ++k) {
    const size_t base = (size_t)(t0 + wave * 8 + k) * 128 + lane + vz;
#pragma unroll
    for (int hf = 0; hf < 2; ++hf) pk[k][hf] = (unsigned)p.pidx[base + hf * 64] | ((unsigned)f2bf(p.pgate[base + hf * 64]) << 16);
#pragma unroll
    for (int i = 0; i < 16; ++i) acc[k][i] = 0.f;
  }
#pragma unroll 1
  for (int si = 0; si < EX6_NSLICE; ++si) {
    const unsigned s = (unsigned)((s0 + si) & (EX6_NSLICE - 1));
#pragma unroll
    for (int k = 0; k < 8; ++k) {
      unsigned long long m0 = __ballot(((pk[k][0] & 0x3fffu) >> EX6_SHIFT) == s);
      unsigned long long m1 = __ballot(((pk[k][1] & 0x3fffu) >> EX6_SHIFT) == s);
      if ((m0 | m1) == 0ull) continue;
      unsigned hw[8];
      {
        const char* xr = smem + (wave * 8 + k) * LDXB + lane * 32;
        const uint4 h0 = *(const uint4*)xr, h1 = *(const uint4*)(xr + 16);
        hw[0] = h0.x; hw[1] = h0.y; hw[2] = h0.z; hw[3] = h0.w; hw[4] = h1.x; hw[5] = h1.y; hw[6] = h1.z; hw[7] = h1.w;
      }
      while (m0 | m1) {
        int e[4]; float g[4];
#pragma unroll
        for (int i = 0; i < 4; ++i) {
          unsigned w;
          if (m0) { const int la = (int)__builtin_ctzll(m0); m0 &= m0 - 1; w = (unsigned)__builtin_amdgcn_readlane((int)pk[k][0], la); }
          else if (m1) { const int la = (int)__builtin_ctzll(m1); m1 &= m1 - 1; w = (unsigned)__builtin_amdgcn_readlane((int)pk[k][1], la); }
          else { w = (unsigned)e[0]; }
          e[i] = (int)(w & 0x3fffu);
          g[i] = __uint_as_float(w & 0xffff0000u);
        }
        experts6_process4(U8, V8, ES, e, g, hw, acc[k], lane, vz);
      }
    }
  }
  if (dry) {
#pragma unroll
    for (int k = 0; k < 8; ++k)
#pragma unroll
      for (int i = 0; i < 16; ++i) asm volatile("" :: "v"(acc[k][i]));
    return;
  }
#pragma unroll
  for (int k = 0; k < 8; ++k) {
    float* xr = p.xres + (size_t)(t0 + wave * 8 + k) * 1024 + lane * 16;
#pragma unroll
    for (int i = 0; i < 4; ++i) {
      float4 a0 = *(float4*)(xr + 4 * i);
      a0.x += acc[k][4 * i + 0]; a0.y += acc[k][4 * i + 1]; a0.z += acc[k][4 * i + 2]; a0.w += acc[k][4 * i + 3];
      *(float4*)(xr + 4 * i) = a0;
    }
  }
}


typedef _Float16 h2_t __attribute__((ext_vector_type(2)));
__device__ __forceinline__ void ex7_pop(unsigned long long& m0, unsigned long long& m1, const unsigned pk0, const unsigned pk1,
                                        int (&e)[4], float (&g)[4]) {
  int e0 = 0;
#pragma unroll
  for (int i = 0; i < 4; ++i) {
    unsigned w;
    if (m0) { const int la = (int)__builtin_ctzll(m0); m0 &= m0 - 1; w = (unsigned)__builtin_amdgcn_readlane((int)pk0, la); }
    else if (m1) { const int la = (int)__builtin_ctzll(m1); m1 &= m1 - 1; w = (unsigned)__builtin_amdgcn_readlane((int)pk1, la); }
    else { w = (unsigned)e0; }
    e[i] = (int)(w & 0x3fffu);
    g[i] = __uint_as_float(w & 0xffff0000u);
    if (i == 0) e0 = e[0];
  }
}
#define EX7_ISSUE(U_, V_, SC_, G_) { \
  _Pragma("unroll") for (int i_ = 0; i_ < 4; ++i_) U_[i_] = *(const uint4*)(U8 + (size_t)e[i_] * 1024 + lane * 16); \
  _Pragma("unroll") for (int i_ = 0; i_ < 4; ++i_) SC_[i_] = ES[e[i_] + vz]; \
  _Pragma("unroll") for (int i_ = 0; i_ < 4; ++i_) V_[i_] = *(const uint4*)(V8 + (size_t)e[i_] * 1024 + lane * 16); \
  _Pragma("unroll") for (int i_ = 0; i_ < 4; ++i_) G_[i_] = g[i_]; }

__device__ __forceinline__ void ex7_compute(const uint4 (&ru)[4], const uint4 (&rv)[4], const float2 (&rsc)[4], const float (&rg)[4],
                                            const unsigned (&hw)[8], h2_t (&acc)[8], int lane) {
  float a[4];
#pragma unroll
  for (int i = 0; i < 4; ++i) {
    const unsigned uw[4] = {ru[i].x, ru[i].y, ru[i].z, ru[i].w};
    float t = 0.f;
#pragma unroll
    for (int w = 0; w < 4; ++w) {
      t = dot2bf(cvt8_bf16x2(uw[w], rsc[i].x, false), hw[2 * w], t);
      t = dot2bf(cvt8_bf16x2(uw[w], rsc[i].x, true), hw[2 * w + 1], t);
    }
    a[i] = t;
  }
  const bool b0 = lane & 1, b1 = lane & 2;
  const float x01 = (b0 ? a[1] : a[0]) + DPP_F((b0 ? a[0] : a[1]), 0xB1);
  const float x23 = (b0 ? a[3] : a[2]) + DPP_F((b0 ? a[2] : a[3]), 0xB1);
  float y = (b1 ? x23 : x01) + DPP_F((b1 ? x01 : x23), 0x4E);
  y += DPP_F(y, 0x124);
  y += DPP_F(y, 0x128);
  float sum[4];
#pragma unroll
  for (int i = 0; i < 4; ++i) sum[i] = RDLANE_F(y, i) + RDLANE_F(y, 16 + i) + RDLANE_F(y, 32 + i) + RDLANE_F(y, 48 + i);
  const int li = lane & 3;
  const float mine = (li == 0) ? sum[0] : (li == 1) ? sum[1] : (li == 2) ? sum[2] : sum[3];
  const float gmine = (li == 0) ? rg[0] : (li == 1) ? rg[1] : (li == 2) ? rg[2] : rg[3];
  const _Float16 hf = (_Float16)(gelu_fast_exact(mine) * gmine);
  const unsigned hb = (unsigned)__builtin_bit_cast(unsigned short, hf);
#pragma unroll
  for (int i = 0; i < 4; ++i) {
    const unsigned hl = (unsigned)__builtin_amdgcn_readlane((int)hb, i);
    const h2_t hh = __builtin_bit_cast(h2_t, hl | (hl << 16));
    const unsigned vw[4] = {rv[i].x, rv[i].y, rv[i].z, rv[i].w};
#pragma unroll
    for (int w = 0; w < 4; ++w) {
      const h2_t p0 = __builtin_amdgcn_cvt_scalef32_pk_f16_fp8((int)vw[w], rsc[i].y, false);
      const h2_t p1 = __builtin_amdgcn_cvt_scalef32_pk_f16_fp8((int)vw[w], rsc[i].y, true);
      acc[2 * w] = __builtin_elementwise_fma(p0, hh, acc[2 * w]);
      acc[2 * w + 1] = __builtin_elementwise_fma(p1, hh, acc[2 * w + 1]);
    }
  }
}

__device__ __forceinline__ void o_peer_experts7_tile(const Params& p, int l, int t0, const char* smem, int tid, bool dry = false) {
  const int wave = __builtin_amdgcn_readfirstlane(tid >> 6), lane = tid & 63;
  const unsigned char* U8 = p.u8 + (size_t)l * 16384 * 1024;
  const unsigned char* V8 = p.v8 + (size_t)l * 16384 * 1024;
  const float2* ES = p.escale + (size_t)l * 16384;
  int vz = 0;
  asm volatile("" : "+v"(vz));
  const int s0 = ((int)(__builtin_amdgcn_s_getreg((3 << 11) | 20) & 0xF) * (EX6_NSLICE / 8)) & (EX6_NSLICE - 1);
  unsigned pk[8][2];
  h2_t acc[8][8];
#pragma unroll
  for (int k = 0; k < 8; ++k) {
    const size_t base = (size_t)(t0 + wave * 8 + k) * 128 + lane + vz;
#pragma unroll
    for (int hf = 0; hf < 2; ++hf) pk[k][hf] = (unsigned)p.pidx[base + hf * 64] | ((unsigned)f2bf(p.pgate[base + hf * 64]) << 16);
#pragma unroll
    for (int i = 0; i < 8; ++i) acc[k][i] = (h2_t){(_Float16)0.f, (_Float16)0.f};
  }
#pragma unroll 1
  for (int si = 0; si < EX6_NSLICE; ++si) {
    const unsigned s = (unsigned)((s0 + si) & (EX6_NSLICE - 1));
#pragma unroll
    for (int k = 0; k < 8; ++k) {
      unsigned long long m0 = __ballot(((pk[k][0] & 0x3fffu) >> EX6_SHIFT) == s);
      unsigned long long m1 = __ballot(((pk[k][1] & 0x3fffu) >> EX6_SHIFT) == s);
      if ((m0 | m1) == 0ull) continue;
      unsigned hw[8];
      {
        const char* xr = smem + (wave * 8 + k) * LDXB + lane * 32;
        const uint4 h0 = *(const uint4*)xr, h1 = *(const uint4*)(xr + 16);
        hw[0] = h0.x; hw[1] = h0.y; hw[2] = h0.z; hw[3] = h0.w; hw[4] = h1.x; hw[5] = h1.y; hw[6] = h1.z; hw[7] = h1.w;
      }
      uint4 uA[4], vA[4], uB[4], vB[4];
      float2 scA[4], scB[4];
      float gA[4], gB[4];
      int e[4]; float g[4];
      ex7_pop(m0, m1, pk[k][0], pk[k][1], e, g);
      EX7_ISSUE(uA, vA, scA, gA)
      for (;;) {
        const bool mb = (m0 | m1) != 0ull;
        if (mb) { ex7_pop(m0, m1, pk[k][0], pk[k][1], e, g); EX7_ISSUE(uB, vB, scB, gB) }
        ex7_compute(uA, vA, scA, gA, hw, acc[k], lane);
        if (!mb) break;
        const bool ma = (m0 | m1) != 0ull;
        if (ma) { ex7_pop(m0, m1, pk[k][0], pk[k][1], e, g); EX7_ISSUE(uA, vA, scA, gA) }
        ex7_compute(uB, vB, scB, gB, hw, acc[k], lane);
        if (!ma) break;
      }
    }
  }
  if (dry) {
#pragma unroll
    for (int k = 0; k < 8; ++k)
#pragma unroll
      for (int i = 0; i < 8; ++i) asm volatile("" :: "v"(acc[k][i]));
    return;
  }
#pragma unroll
  for (int k = 0; k < 8; ++k) {
    float* xr = p.xres + (size_t)(t0 + wave * 8 + k) * 1024 + lane * 16;
#pragma unroll
    for (int i = 0; i < 4; ++i) {
      float4 a0 = *(float4*)(xr + 4 * i);
      a0.x += (float)acc[k][2 * i][0]; a0.y += (float)acc[k][2 * i][1];
      a0.z += (float)acc[k][2 * i + 1][0]; a0.w += (float)acc[k][2 * i + 1][1];
      *(float4*)(xr + 4 * i) = a0;
    }
  }
}

#define XB_TMO      128
#define XB_XCNT(j)  (256  + 64 * (j))
#define XB_XSUB(j)  (1280 + 64 * (j))
#define XB_XGEN(j)  (2304 + 64 * (j))
#define XB_TOP      3328
#define XB_TOPGEN   3392
#define XCD_BAR_WORDS 3456
#define XB_SPIN_CAP (1u << 22)
#define LAS __attribute__((address_space(3)))
__device__ __forceinline__ unsigned xb_ld(unsigned* p)              { return __hip_atomic_load(p, __ATOMIC_RELAXED, __HIP_MEMORY_SCOPE_AGENT); }
__device__ __forceinline__ unsigned xb_add(unsigned* p, unsigned v) { return __hip_atomic_fetch_add(p, v, __ATOMIC_RELAXED, __HIP_MEMORY_SCOPE_AGENT); }
__device__ __forceinline__ unsigned xb_xcc_id() { return (unsigned)__builtin_amdgcn_s_getreg((3 << 11) | 20) & 0xFu; }
#define XB_SPIN(cond, bar) do { unsigned _sp = 0; while (cond) { __builtin_amdgcn_s_sleep(1); \
    if ((++_sp & 255u) == 0u) { if (xb_ld(&(bar)[XB_TMO])) break; if (_sp > XB_SPIN_CAP) { atomicAdd(&(bar)[XB_TMO], 1u); break; } } } } while (0)
struct XcdBarrier { unsigned* bar; unsigned x; volatile LAS unsigned* st; };
__device__ __forceinline__ XcdBarrier xcd_barrier_post(unsigned* bar, volatile LAS unsigned* st, int tid) {
  XcdBarrier b; b.bar = bar; b.x = xb_xcc_id(); b.st = st;
  if (tid == 0) (void)xb_add(&bar[XB_XCNT(b.x)], 1u);
  return b;
}
__device__ __forceinline__ void xcd_barrier_complete(unsigned* bar, unsigned x, unsigned& nloc, unsigned& nx) {
  const unsigned G = gridDim.x * gridDim.y * gridDim.z;
  unsigned sum, cnt, mine, sp = 0u;
  for (;;) {
    sum = 0u; cnt = 0u; mine = 0u;
#pragma unroll
    for (unsigned j = 0; j < 16; ++j) { const unsigned c = xb_ld(&bar[XB_XCNT(j)]); sum += c; cnt += (c > 0u) ? 1u : 0u; mine = (j == x) ? c : mine; }
    if (sum == G) break;
    __builtin_amdgcn_s_sleep(1);
    if ((++sp & 255u) == 0u) { if (xb_ld(&bar[XB_TMO])) break; if (sp > XB_SPIN_CAP) { atomicAdd(&bar[XB_TMO], 1u); break; } }
  }
  nloc = mine > 0u ? mine : 1u; nx = cnt > 0u ? cnt : 1u;
}
__device__ __forceinline__ void xcd_barrier(const XcdBarrier& b, int tid) {
  asm volatile("s_waitcnt vmcnt(0)" ::: "memory");
  __syncthreads();
  if (tid == 0) {
    unsigned* bar = b.bar;
    __builtin_amdgcn_s_waitcnt(0);
    unsigned nloc = b.st[0], nx = b.st[1];
    if (nloc == 0u) { xcd_barrier_complete(bar, b.x, nloc, nx); b.st[0] = nloc; b.st[1] = nx; }
    const unsigned old = xb_add(&bar[XB_XSUB(b.x)], 1u);
    const unsigned gen = old / nloc;
    if (old + 1u == (gen + 1u) * nloc) {
      __builtin_amdgcn_fence(__ATOMIC_RELEASE, "agent");
      asm volatile("s_waitcnt vmcnt(0)" ::: "memory");
      const unsigned og = xb_add(&bar[XB_TOP], 1u);
      const unsigned tg = og / nx;
      if (og + 1u == (tg + 1u) * nx) xb_add(&bar[XB_TOPGEN], 1u);
      else XB_SPIN(xb_ld(&bar[XB_TOPGEN]) == tg, bar);
      __builtin_amdgcn_fence(__ATOMIC_ACQUIRE, "agent");
      xb_add(&bar[XB_XGEN(b.x)], 1u);
      asm volatile("s_waitcnt vmcnt(0)" ::: "memory");
    } else {
      XB_SPIN(xb_ld(&bar[XB_XGEN(b.x)]) == gen, bar);
      __builtin_amdgcn_fence(__ATOMIC_ACQUIRE, "agent");
      asm volatile("s_waitcnt vmcnt(0)" ::: "memory");
    }
  }
  __syncthreads();
}


__global__ void __launch_bounds__(NTHREADS) fwd_megakernel(Params p) {
  cg::grid_group grid = cg::this_grid();
  extern __shared__ __attribute__((aligned(16))) float smem[];
  const int wv_ = __builtin_amdgcn_readfirstlane((int)(threadIdx.x >> 6));
  volatile LAS unsigned* xb_st = (volatile LAS unsigned*)((LAS char*)(LAS float*)smem + (160 * 1024 - 16));
  if (threadIdx.x == 0) { xb_st[0] = 0u; xb_st[1] = 0u; }
  __syncthreads();
  const XcdBarrier xb = xcd_barrier_post(p.bar, xb_st, (int)threadIdx.x);
#define GRID_BARRIER() xcd_barrier(xb, opaque_tid(wv_))

  o_prep(wv_, p, smem);
  if (gridDim.x > 4096u) grid.sync();
  GRID_BARRIER();
#if PROBE_DUP == 1
  o_prep(wv_, p, smem);
  GRID_BARRIER();
#endif
#pragma unroll 1
  for (int l = 0; l < DEPTH; ++l) {
    const float* xcur = (l == 0) ? p.x_in : p.xres;
    o_p1(wv_, p, l, xcur, (char*)smem);
    GRID_BARRIER();
#if PROBE_DUP == 2
    o_p1(wv_, p, l, xcur, (char*)smem);
    GRID_BARRIER();
#endif
#if PROBE_DUP == 3
    for (int rep_ = 0; rep_ < 2; ++rep_) {
#else
    {
#endif
    {
      const int bidx_ = opaque_bid();
      for (int task = bidx_; task < 1792; task += gridDim.x) {
        const int l_ = opaque_s(l), td_ = opaque_tid(wv_), tk_ = opaque_s(task);
        if (tk_ < 1024) o_na_task(p, l_, tk_, (char*)smem, td_);
        else if (tk_ < 1536) o_ret_kv_task(p, l_, tk_ - 1024, (char*)smem, td_);
        else o_pool_task(p, l_, tk_ - 1536, (char*)smem, td_);
      }
    }
    GRID_BARRIER();
    o_ret_scan(wv_, p, l);
    GRID_BARRIER();
    {
      const int tidx_ = opaque_tid(wv_); const int bidx_ = opaque_bid();
      for (int task = bidx_; task < 512; task += gridDim.x) o_ret_out_task(p, l, task, (char*)smem, tidx_);
    }
    GRID_BARRIER();
    }
    {
      const int tidx_ = opaque_tid(wv_); const int bidx_ = opaque_bid();
      for (int tile = bidx_; tile < NTOK / 64; tile += gridDim.x) {
        { const int t0_ = opaque_s(tile * 64), l_ = opaque_s(l), td_ = opaque_tid(wv_); o_p5a1_tile(p, l_, t0_, (char*)smem, td_); }
#if PROBE_DUP == 4
        { const int t0_ = opaque_s(tile * 64), l_ = opaque_s(l), td_ = opaque_tid(wv_); o_p5a1_tile(p, l_, t0_, (char*)smem, td_); }
#endif
        { const int t0_ = opaque_s(tile * 64), l_ = opaque_s(l), td_ = opaque_tid(wv_); o_p5a2_tile(p, l_, xcur, t0_, (char*)smem, td_); }
        { const int t0_ = opaque_s(tile * 64), l_ = opaque_s(l), td_ = opaque_tid(wv_); o_p5a3_tile(p, l_, t0_, (char*)smem, td_); }
        { const int t0_ = opaque_s(tile * 64), l_ = opaque_s(l), td_ = opaque_tid(wv_); o_peer_select_tile(p, l_, t0_, (char*)smem, td_); }
        { const int t0_ = opaque_s(tile * 64), l_ = opaque_s(l), td_ = opaque_tid(wv_); o_peer_select2_tile(p, l_, t0_, td_); }
#if PROBE_DUP == 5
        { const int t0_ = opaque_s(tile * 64), l_ = opaque_s(l), td_ = opaque_tid(wv_); o_peer_select_tile(p, l_, t0_, (char*)smem, td_); }
        { const int t0_ = opaque_s(tile * 64), l_ = opaque_s(l), td_ = opaque_tid(wv_); o_peer_select2_tile(p, l_, t0_, td_); }
#endif
        asm volatile("s_waitcnt vmcnt(0)" ::: "memory");
        __syncthreads();
#if PROBE_DUP == 6
        { const int t0_ = opaque_s(tile * 64), l_ = opaque_s(l), td_ = opaque_tid(wv_); o_peer_experts7_tile(p, l_, t0_, (const char*)smem, td_, true); }
#endif
        { const int t0_ = opaque_s(tile * 64), l_ = opaque_s(l), td_ = opaque_tid(wv_); o_peer_experts7_tile(p, l_, t0_, (const char*)smem, td_); }
        if (l + 1 == DEPTH) {
          asm volatile("s_waitcnt vmcnt(0)" ::: "memory");
          const int t0_ = opaque_s(tile * 64), td_ = opaque_tid(wv_);
          o_final_norm_tile(p, t0_, td_);
        }
      }
    }
    if (l + 1 < DEPTH) GRID_BARRIER();
  }
}

extern "C" void kernel_launch(void* const* d_in, const int* in_sizes, int n_in, void* d_out, int out_size,
                              void* d_ws, size_t ws_size, hipStream_t stream) {
  Params p{};
  p.x_in = (const float*)d_in[0]; p.norm_mix = (const float*)d_in[1]; p.w_in = (const float*)d_in[2];
  p.pool_w = (const float*)d_in[3]; p.pool_scale = (const float*)d_in[4]; p.ret_decay = (const float*)d_in[5];
  p.na_rpb = (const float*)d_in[6]; p.w_br_pool = (const float*)d_in[7]; p.w_br_ret = (const float*)d_in[8];
  p.w_br_na = (const float*)d_in[9]; p.w_out = (const float*)d_in[10]; p.norm_ffn = (const float*)d_in[11];
  p.w_query = (const float*)d_in[12]; p.sub_keys = (const float*)d_in[13]; p.peer_u = (const float*)d_in[14];
  p.peer_v = (const float*)d_in[15]; p.norm_final = (const float*)d_in[16];
  p.out = (float*)d_out;
  char* ws = (char*)d_ws;
  size_t off = 0;
  auto alloc = [&](size_t bytes) { char* q = ws + off; off += (bytes + 255) & ~(size_t)255; return q; };
  p.xres = (float*)alloc((size_t)NTOK * D_MODEL * 4);
  p.proj = (bf16_t*)alloc((size_t)NTOK * IN_WIDTH * 2);
  p.ycat = (bf16_t*)alloc((size_t)NTOK * 1024 * 2);
  p.mrg = (bf16_t*)alloc((size_t)NTOK * 1024 * 2);
  p.pidx = (int*)alloc((size_t)NTOK * 128 * 4);
  p.pgate = (float*)alloc((size_t)NTOK * 128 * 4);
  p.wf_in = (bf16_t*)alloc((size_t)DEPTH * D_MODEL * IN_WIDTH * 2);
  p.wf_br = (bf16_t*)alloc((size_t)DEPTH * 1024 * 1024 * 2);
  p.wf_out = (bf16_t*)alloc((size_t)DEPTH * 1024 * 1024 * 2);
  p.wf_q = (bf16_t*)alloc((size_t)DEPTH * 1024 * 2048 * 2);
  p.kf = (bf16_t*)alloc((size_t)DEPTH * 2 * 128 * 128 * 2);
  p.u16 = nullptr; p.v16 = nullptr;
  p.u8 = (unsigned char*)alloc((size_t)DEPTH * 16384 * 1024);
  p.v8 = (unsigned char*)alloc((size_t)DEPTH * 16384 * 1024);
  p.escale = (float2*)alloc((size_t)DEPTH * 16384 * 8);
  p.rope = (float2*)alloc((size_t)SEQ * 32 * 8);
  p.tklist = (unsigned*)alloc((size_t)NTOK * 8 * 2 * 16 * 4);
  p.kvst = (float*)p.mrg;
  p.rstate = (bf16_t*)p.tklist;
  p.bar = (unsigned*)alloc(XCD_BAR_WORDS * 4);
  p.xn = nullptr; p.merged = nullptr; p.pq = nullptr; p.psc = nullptr;
  if (off > ws_size) fprintf(stderr, "WORKSPACE OVERFLOW: need %zu have %zu\n", off, ws_size);

  const size_t kDynLds = 160 * 1024;
  static int grid_blocks = 0;
  if (!grid_blocks) {
    int dev = 0, cus = 0, per_cu = 0;
    (void)hipGetDevice(&dev);
    (void)hipDeviceGetAttribute(&cus, hipDeviceAttributeMultiprocessorCount, dev);
    (void)hipFuncSetAttribute((const void*)fwd_megakernel, hipFuncAttributeMaxDynamicSharedMemorySize, (int)kDynLds);
    (void)hipOccupancyMaxActiveBlocksPerMultiprocessor(&per_cu, fwd_megakernel, NTHREADS, kDynLds);
    if (per_cu < 1) per_cu = 1;
    grid_blocks = cus * per_cu;
  }
  (void)hipMemsetAsync(p.bar, 0, XCD_BAR_WORDS * 4, stream);
  void* args[] = {&p};
  hipError_t e = hipLaunchCooperativeKernel((void*)fwd_megakernel, dim3(grid_blocks), dim3(NTHREADS), args, kDynLds, stream);
  if (e != hipSuccess) fprintf(stderr, "cooperative launch failed: %s (grid %d)\n", hipGetErrorString(e), grid_blocks);
}
```

```cpp
#include <hip/hip_runtime.h>
#include <hip/hip_cooperative_groups.h>
#include <stdint.h>
#include <cstdio>
namespace cg = cooperative_groups;

#define D_MODEL 1024
#define SEQ 4096
#define BATCH 4
#define NTOK (BATCH * SEQ)
#define DEPTH 2
#define IN_WIDTH 5632
#define C_POOL 0
#define C_RQ 256
#define C_RK 512
#define C_RV 768
#define C_RG 1280
#define C_NQ 1792
#define C_NK 2048
#define C_NV 2304
#define C_GATE 2560
#define EPS 1e-6f
#define NTHREADS 512

typedef unsigned short bf16_t;

struct Params {
  const float* x_in; const float* norm_mix; const float* w_in; const float* pool_w; const float* pool_scale;
  const float* ret_decay; const float* na_rpb; const float* w_br_pool; const float* w_br_ret; const float* w_br_na;
  const float* w_out; const float* norm_ffn; const float* w_query; const float* sub_keys; const float* peer_u;
  const float* peer_v; const float* norm_final;
  float* out;
  float* xres;
  bf16_t* xn;
  bf16_t* proj;
  bf16_t* ycat;
  float* merged;
  float* pq;
  float* psc;
  int* pidx;
  float* pgate;
  bf16_t* wf_in;
  bf16_t* wf_br;
  bf16_t* wf_out;
  bf16_t* wf_q;
  bf16_t* kf;
  bf16_t* u16;
  bf16_t* v16;
  float2* rope;
  bf16_t* mrg;
  unsigned* tklist;
  float* kvst;
  bf16_t* rstate;
  unsigned* bar;
  unsigned char* u8; unsigned char* v8;
  float2* escale;
};

__device__ __forceinline__ bf16_t f2bf(float f) {
  unsigned u = __float_as_uint(f);
  u += 0x7fffu + ((u >> 16) & 1u);
  return (bf16_t)(u >> 16);
}
__device__ __forceinline__ float bf2f(bf16_t h) { return __uint_as_float(((unsigned)h) << 16); }

__device__ __forceinline__ float wave_sum(float v) {
#pragma unroll
  for (int o = 32; o > 0; o >>= 1) v += __shfl_xor(v, o, 64);
  return v;
}
__device__ __forceinline__ float wave_max(float v) {
#pragma unroll
  for (int o = 32; o > 0; o >>= 1) v = fmaxf(v, __shfl_xor(v, o, 64));
  return v;
}
__device__ __forceinline__ float sigmoidf_(float x) { return 1.0f / (1.0f + expf(-x)); }

__device__ __forceinline__ int opaque_tid(int wv) {
  int w = wv;
  asm volatile("" : "+s"(w));
  int lane = __builtin_amdgcn_mbcnt_hi(~0u, __builtin_amdgcn_mbcnt_lo(~0u, 0u));
  asm volatile("" : "+v"(lane));
  return w * 64 + lane;
}
__device__ __forceinline__ int opaque_s(int x) { asm volatile("" : "+s"(x)); return x; }
__device__ __forceinline__ int opaque_bid() { int b = blockIdx.x; asm volatile("" : "+s"(b)); return b; }

template <bool OUT_F32>
__device__ __forceinline__ void n_rmsnorm(const int wv_, const float* __restrict__ x, const float* __restrict__ g, void* outp, int rows) {
  const int tidx_ = opaque_tid(wv_); const int bidx_ = opaque_bid();
  const int lane = tidx_ & 63;
  const int nw = gridDim.x * (NTHREADS / 64);
  for (int row = bidx_ * (NTHREADS / 64) + (tidx_ >> 6); row < rows; row += nw) {
    const float* xr = x + (size_t)row * D_MODEL;
    float4 v[4];
    float ss = 0.f;
#pragma unroll
    for (int i = 0; i < 4; ++i) {
      v[i] = *(const float4*)(xr + i * 256 + lane * 4);
      ss += v[i].x * v[i].x + v[i].y * v[i].y + v[i].z * v[i].z + v[i].w * v[i].w;
    }
    ss = wave_sum(ss);
    float r = rsqrtf(ss * (1.0f / D_MODEL) + EPS);
#pragma unroll
    for (int i = 0; i < 4; ++i) {
      float4 gg = *(const float4*)(g + i * 256 + lane * 4);
      float o0 = v[i].x * r * gg.x, o1 = v[i].y * r * gg.y, o2 = v[i].z * r * gg.z, o3 = v[i].w * r * gg.w;
      if (OUT_F32) {
        *(float4*)((float*)outp + (size_t)row * D_MODEL + i * 256 + lane * 4) = make_float4(o0, o1, o2, o3);
      } else {
        ushort4 o; o.x = f2bf(o0); o.y = f2bf(o1); o.z = f2bf(o2); o.w = f2bf(o3);
        *(ushort4*)((bf16_t*)outp + (size_t)row * D_MODEL + i * 256 + lane * 4) = o;
      }
    }
  }
}

typedef __attribute__((ext_vector_type(8))) short bf16x8;
typedef __attribute__((ext_vector_type(4))) float f32x4;
#define LDX 1032
#define LDXB (LDX * 2)
#define XTILE_BYTES (64 * LDXB)

__device__ __forceinline__ unsigned pack2bf(float a, float b) { return (unsigned)f2bf(a) | ((unsigned)f2bf(b) << 16); }

__device__ __forceinline__ void prep_frag(const int wv_, const float* __restrict__ W, int K, int N, bf16_t* __restrict__ dst, float* smem) {
  const int tidx_ = opaque_tid(wv_); const int bidx_ = opaque_bid();
  const int grp = tidx_ >> 8, tid = tidx_ & 255;
  float(*T)[65] = (float(*)[65])(smem + grp * 32 * 65);
  const int KS = K / 32, NC = N / 64;
  const int ntiles = KS * NC;
  for (int wb = bidx_ * 2; wb < ntiles; wb += gridDim.x * 2) {
    const int w = wb + grp;
    const int c = w / KS, ks = w - c * KS;
    {
      const int row = tid >> 3, col = (tid & 7) * 8;
      const float* src = W + (size_t)(ks * 32 + row) * N + c * 64 + col;
      float4 a = *(const float4*)src, b = *(const float4*)(src + 4);
      __syncthreads();
      T[row][col + 0] = a.x; T[row][col + 1] = a.y; T[row][col + 2] = a.z; T[row][col + 3] = a.w;
      T[row][col + 4] = b.x; T[row][col + 5] = b.y; T[row][col + 6] = b.z; T[row][col + 7] = b.w;
    }
    __syncthreads();
    {
      const int nt = tid >> 6, lane = tid & 63;
      const int kr = 8 * (lane >> 4), nc = nt * 16 + (lane & 15);
      uint4 o;
      o.x = pack2bf(T[kr + 0][nc], T[kr + 1][nc]);
      o.y = pack2bf(T[kr + 2][nc], T[kr + 3][nc]);
      o.z = pack2bf(T[kr + 4][nc], T[kr + 5][nc]);
      o.w = pack2bf(T[kr + 6][nc], T[kr + 7][nc]);
      *(uint4*)(dst + ((size_t)((c * KS + ks) * 4 + nt) * 64 + lane) * 8) = o;
    }
  }
}

__device__ __forceinline__ void o_prep(const int wv_, const Params& p, float* smem) {
  for (int l = 0; l < DEPTH; ++l) {
    prep_frag(wv_, p.w_in + (size_t)l * D_MODEL * IN_WIDTH, D_MODEL, IN_WIDTH, p.wf_in + (size_t)l * D_MODEL * IN_WIDTH, smem);
    prep_frag(wv_, p.w_br_pool + (size_t)l * 256 * 1024, 256, 1024, p.wf_br + (size_t)l * 1024 * 1024, smem);
    prep_frag(wv_, p.w_br_ret + (size_t)l * 512 * 1024, 512, 1024, p.wf_br + (size_t)l * 1024 * 1024 + 256 * 1024, smem);
    prep_frag(wv_, p.w_br_na + (size_t)l * 256 * 1024, 256, 1024, p.wf_br + (size_t)l * 1024 * 1024 + 768 * 1024, smem);
    prep_frag(wv_, p.w_out + (size_t)l * 1024 * 1024, 1024, 1024, p.wf_out + (size_t)l * 1024 * 1024, smem);
    prep_frag(wv_, p.w_query + (size_t)l * 1024 * 2048, 1024, 2048, p.wf_q + (size_t)l * 1024 * 2048, smem);
  }
  const int tidx_ = opaque_tid(wv_); const int bidx_ = opaque_bid();
  const int gtid = bidx_ * NTHREADS + tidx_, gsz = gridDim.x * NTHREADS;
  for (int u = gtid; u < DEPTH * 2 * 8 * 4 * 64; u += gsz) {
    const int lane = u & 63, s2 = (u >> 6) & 3, kt = (u >> 8) & 7, lp = u >> 11;
    const float* kr = p.sub_keys + ((size_t)lp * 128 + kt * 16 + (lane & 15)) * 128;
    float v[8];
#pragma unroll
    for (int j = 0; j < 8; ++j) v[j] = kr[16 * (2 * s2 + (j >> 2)) + 4 * (lane >> 4) + (j & 3)];
    uint4 o;
    o.x = pack2bf(v[0], v[1]); o.y = pack2bf(v[2], v[3]); o.z = pack2bf(v[4], v[5]); o.w = pack2bf(v[6], v[7]);
    *(uint4*)(p.kf + (size_t)u * 8) = o;
  }
  {
    const int lane = tidx_ & 63;
    const int gw = (bidx_ * NTHREADS + tidx_) >> 6, nw = gsz >> 6;
    for (int row = gw; row < DEPTH * 16384 * 2; row += nw) {
      const int tbl = row & 1, er = row >> 1;
      const float* src = (tbl ? p.peer_v : p.peer_u) + (size_t)er * 1024 + lane * 16;
      float4 f[4];
#pragma unroll
      for (int i = 0; i < 4; ++i) f[i] = *(const float4*)(src + 4 * i);
      float m = 0.f;
#pragma unroll
      for (int i = 0; i < 4; ++i) m = fmaxf(m, fmaxf(fmaxf(fabsf(f[i].x), fabsf(f[i].y)), fmaxf(fabsf(f[i].z), fabsf(f[i].w))));
      m = wave_max(m);
      int k = 0;
      if (m > 0.f) {
        int e;
        const float fr = __builtin_frexpf(m, &e);
        k = ((fr <= 0.875f) ? 9 : 8) - e;
        k = k < -100 ? -100 : (k > 100 ? 100 : k);
      }
      const float sc = __builtin_ldexpf(1.0f, k);
      uint4 o;
      unsigned w[4];
#pragma unroll
      for (int i = 0; i < 4; ++i) {
        int pkd = 0;
        pkd = __builtin_amdgcn_cvt_pk_fp8_f32(f[i].x * sc, f[i].y * sc, pkd, false);
        pkd = __builtin_amdgcn_cvt_pk_fp8_f32(f[i].z * sc, f[i].w * sc, pkd, true);
        w[i] = (unsigned)pkd;
      }
      o.x = w[0]; o.y = w[1]; o.z = w[2]; o.w = w[3];
      *(uint4*)((tbl ? p.v8 : p.u8) + (size_t)er * 1024 + lane * 16) = o;
      if (lane == 0) ((float*)p.escale)[(size_t)er * 2 + tbl] = __builtin_ldexpf(1.0f, -k);
    }
  }
  for (int u = gtid; u < SEQ * 32; u += gsz) {
    const int i = u & 31, pos = u >> 5;
    float inv = 1.0f / powf(10000.0f, (float)i / 31.0f);
    float ang = (float)pos * inv;
    double rev = (double)ang * 0.15915494309189535;
    rev -= floor(rev);
    float rf = (float)rev;
    p.rope[u] = make_float2(__builtin_amdgcn_cosf(rf), __builtin_amdgcn_sinf(rf));
  }
}

template <int NT, int PD, int RING>
__device__ __forceinline__ void tl_gemm_prologue(const bf16_t* __restrict__ wf, bf16x8 (&wb)[RING][NT], const int lane, const int nt0 = 0) {
  const bf16x8* wp = (const bf16x8*)wf + lane + nt0 * 64;
#pragma unroll
  for (int s = 0; s < PD; ++s)
#pragma unroll
    for (int nt = 0; nt < NT; ++nt) wb[s][nt] = wp[(s * 4 + nt) * 64];
}
template <int NT, int PD, int RING>
__device__ __forceinline__ void tl_gemm_main(const bf16_t* __restrict__ wf, const int KS, const char* xt, const int kbyte0,
                                             f32x4 (&acc)[NT][4], bf16x8 (&wb)[RING][NT], const int lane, const int nt0 = 0) {
  const bf16x8* wp = (const bf16x8*)wf + lane + nt0 * 64;
  const char* xp = xt + (lane & 15) * LDXB + kbyte0 + (lane >> 4) * 16;
  for (int ks = 0; ks < KS; ks += RING) {
#pragma unroll
    for (int u = 0; u < RING; ++u) {
      int kpre = ks + u + PD;
      kpre = kpre < KS ? kpre : KS - 1;
#pragma unroll
      for (int nt = 0; nt < NT; ++nt) wb[(u + PD) % RING][nt] = wp[(kpre * 4 + nt) * 64];
      bf16x8 xf[4];
#pragma unroll
      for (int mt = 0; mt < 4; ++mt) xf[mt] = *(const bf16x8*)(xp + mt * 16 * LDXB + (ks + u) * 64);
#pragma unroll
      for (int nt = 0; nt < NT; ++nt)
#pragma unroll
        for (int mt = 0; mt < 4; ++mt)
          acc[nt][mt] = __builtin_amdgcn_mfma_f32_16x16x32_bf16(wb[u][nt], xf[mt], acc[nt][mt], 0, 0, 0);
    }
  }
}
template <int NT, int PD = 3, int RING = 4>
__device__ __forceinline__ void tl_gemm_chunk(const bf16_t* __restrict__ wf, const int KS, const char* xt, const int kbyte0,
                                              f32x4 (&acc)[NT][4], const int lane, const int nt0 = 0) {
  bf16x8 wb[RING][NT];
  tl_gemm_prologue<NT, PD, RING>(wf, wb, lane, nt0);
  tl_gemm_main<NT, PD, RING>(wf, KS, xt, kbyte0, acc, wb, lane, nt0);
}

__device__ __forceinline__ void tile_rmsnorm_to_lds(const float* __restrict__ xsrc, const float* __restrict__ g, int t0,
                                                    char* xt, int wave, int lane) {
#pragma unroll 2
  for (int i = 0; i < 8; ++i) {
    const int tok = wave * 8 + i;
    const float* xr = xsrc + (size_t)(t0 + tok) * D_MODEL;
    float4 v[4];
    float ss = 0.f;
#pragma unroll
    for (int q = 0; q < 4; ++q) {
      v[q] = *(const float4*)(xr + q * 256 + lane * 4);
      ss += v[q].x * v[q].x + v[q].y * v[q].y + v[q].z * v[q].z + v[q].w * v[q].w;
    }
    ss = wave_sum(ss);
    const float r = rsqrtf(ss * (1.0f / D_MODEL) + EPS);
#pragma unroll
    for (int q = 0; q < 4; ++q) {
      float4 gg = *(const float4*)(g + q * 256 + lane * 4);
      uint2 o;
      o.x = pack2bf(v[q].x * r * gg.x, v[q].y * r * gg.y);
      o.y = pack2bf(v[q].z * r * gg.z, v[q].w * r * gg.w);
      *(uint2*)(xt + tok * LDXB + (q * 256 + lane * 4) * 2) = o;
    }
  }
}

__device__ __forceinline__ void o_p1(const int wv_, const Params& p, int l, const float* __restrict__ xsrc, char* smem) {
  const int tidx_ = opaque_tid(wv_); const int bidx_ = opaque_bid();
  const int wave = tidx_ >> 6, lane = tidx_ & 63;
  const bf16_t* wf = p.wf_in + (size_t)l * D_MODEL * IN_WIDTH;
  const float* g = p.norm_mix + l * D_MODEL;
  for (int tile = bidx_; tile < NTOK / 64; tile += gridDim.x) {
    const int t0 = tile * 64;
    __syncthreads();
    tile_rmsnorm_to_lds(xsrc, g, t0, smem, wave, lane);
    __syncthreads();
#pragma unroll 1
    for (int c = wave; c < IN_WIDTH / 64; c += 8) {
      f32x4 acc[4][4];
#pragma unroll
      for (int a = 0; a < 4; ++a)
#pragma unroll
        for (int b = 0; b < 4; ++b) acc[a][b] = (f32x4){0.f, 0.f, 0.f, 0.f};
      tl_gemm_chunk<4, 3, 4>(wf + (size_t)c * 32 * 4 * 64 * 8, 32, smem, 0, acc, lane);
      asm volatile("" ::: "memory");
      if (c >= 4 && c < 12) {
        const float sc = (c >= 8) ? 0.125f : 1.0f;
#pragma unroll
        for (int mt = 0; mt < 4; ++mt) {
          const int tok = t0 + mt * 16 + (lane & 15);
          const int pos = tok & (SEQ - 1);
#pragma unroll
          for (int nt = 0; nt < 2; ++nt) {
            const int i0 = nt * 16 + 4 * (lane >> 4);
            const float4 cs01 = *(const float4*)(p.rope + pos * 32 + i0);
            const float4 cs23 = *(const float4*)(p.rope + pos * 32 + i0 + 2);
            const float cc[4] = {cs01.x, cs01.z, cs23.x, cs23.z};
            const float sn[4] = {cs01.y, cs01.w, cs23.y, cs23.w};
#pragma unroll
            for (int r = 0; r < 4; ++r) {
              const float x1 = acc[nt][mt][r], x2 = acc[nt + 2][mt][r];
              acc[nt][mt][r] = (x1 * cc[r] - x2 * sn[r]) * sc;
              acc[nt + 2][mt][r] = (x1 * sn[r] + x2 * cc[r]) * sc;
            }
          }
        }
      } else if (c >= 28 && c < 32) {
#pragma unroll
        for (int a = 0; a < 4; ++a)
#pragma unroll
          for (int b = 0; b < 4; ++b) acc[a][b] *= 0.125f;
      } else if (c >= 40) {
#pragma unroll
        for (int a = 0; a < 4; ++a)
#pragma unroll
          for (int b = 0; b < 4; ++b)
#pragma unroll
            for (int r = 0; r < 4; ++r) acc[a][b][r] = 1.0f / (1.0f + __expf(-acc[a][b][r]));
      }
      {
        char* patch = smem + XTILE_BYTES + wave * 2304;
#pragma unroll
        for (int mt = 0; mt < 4; ++mt) {
#pragma unroll
          for (int nt = 0; nt < 4; ++nt) {
            uint2 o;
            o.x = pack2bf(acc[nt][mt][0], acc[nt][mt][1]);
            o.y = pack2bf(acc[nt][mt][2], acc[nt][mt][3]);
            *(uint2*)(patch + (lane & 15) * 144 + (nt * 16 + 4 * (lane >> 4)) * 2) = o;
          }
#pragma unroll
          for (int h = 0; h < 2; ++h) {
            const int row = h * 8 + (lane >> 3), unit = lane & 7;
            const uint4 v = *(const uint4*)(patch + row * 144 + unit * 16);
            *(uint4*)(p.proj + (size_t)(t0 + mt * 16 + row) * IN_WIDTH + c * 64 + unit * 8) = v;
          }
        }
      }
    }
  }
}


__device__ __forceinline__ void o_final_norm_tile(const Params& p, int t0, int tid) {
  const int wave = tid >> 6, lane = tid & 63;
#pragma unroll 2
  for (int i = 0; i < 8; ++i) {
    const size_t row = (size_t)(t0 + wave * 8 + i) * D_MODEL;
    float4 v[4];
    float ss = 0.f;
#pragma unroll
    for (int q = 0; q < 4; ++q) {
      v[q] = *(const float4*)(p.xres + row + q * 256 + lane * 4);
      ss += v[q].x * v[q].x + v[q].y * v[q].y + v[q].z * v[q].z + v[q].w * v[q].w;
    }
    ss = wave_sum(ss);
    const float r = rsqrtf(ss * (1.0f / D_MODEL) + EPS);
#pragma unroll
    for (int q = 0; q < 4; ++q) {
      const float4 gg = *(const float4*)(p.norm_final + q * 256 + lane * 4);
      *(float4*)(p.out + row + q * 256 + lane * 4) = make_float4(v[q].x * r * gg.x, v[q].y * r * gg.y, v[q].z * r * gg.z, v[q].w * r * gg.w);
    }
  }
}

__device__ __forceinline__ void tile_load_to_lds(const bf16_t* __restrict__ src, int ld, char* xt, int tid) {
#pragma unroll 4
  for (int it = 0; it < 16; ++it) {
    const int idx = it * NTHREADS + tid;
    const int row = idx >> 7, u = idx & 127;
    const uint4 v = *(const uint4*)(src + (size_t)row * ld + u * 8);
    *(uint4*)(xt + row * LDXB + u * 16) = v;
  }
}

__device__ __forceinline__ void o_p5a1_tile(const Params& p, int l, int t0, char* smem, int tid) {
  const int wave = tid >> 6, lane = tid & 63;
  __syncthreads();
  tile_load_to_lds(p.ycat + (size_t)t0 * 1024, 1024, smem, tid);
  __syncthreads();
  const bf16_t* wfb = p.wf_br + (size_t)l * 1024 * 1024;
  bf16x8 wb[4][2];
  f32x4 m[2][4];
  {
    const int c0 = wave >> 1, nt00 = (wave & 1) * 2;
    tl_gemm_prologue<2, 3, 4>(wfb + (size_t)c0 * 8 * 4 * 64 * 8, wb, lane, nt00);
  }
#pragma unroll 1
  for (int it = 0; it < 12; ++it) {
    const int hi = it / 3, br = it - hi * 3;
    const int hc = wave + 8 * hi;
    const int c = hc >> 1, nt0 = (hc & 1) * 2;
    const int koff = (br == 0) ? 0 : (br == 1 ? 256 : 768);
    const int KS = (br == 1) ? 16 : 8;
    uint2 gv[4][2];
#pragma unroll
    for (int mt = 0; mt < 4; ++mt) {
      const int tok = t0 + mt * 16 + (lane & 15);
      const bf16_t* gp = p.proj + (size_t)tok * IN_WIDTH + C_GATE + br * 1024 + c * 64 + nt0 * 16 + 4 * (lane >> 4);
#pragma unroll
      for (int nt = 0; nt < 2; ++nt) gv[mt][nt] = *(const uint2*)(gp + nt * 16);
    }
    f32x4 acc[2][4];
#pragma unroll
    for (int a2 = 0; a2 < 2; ++a2)
#pragma unroll
      for (int b2 = 0; b2 < 4; ++b2) acc[a2][b2] = (f32x4){0.f, 0.f, 0.f, 0.f};
    tl_gemm_main<2, 3, 4>(wfb + (size_t)koff * 1024 + (size_t)c * KS * 4 * 64 * 8, KS, smem, koff * 2, acc, wb, lane, nt0);
    asm volatile("" ::: "memory");
    {
      const int itn = (it + 1 < 12) ? it + 1 : it;
      const int hin = itn / 3, brn = itn - hin * 3;
      const int hcn = wave + 8 * hin;
      const int koffn = (brn == 0) ? 0 : (brn == 1 ? 256 : 768);
      const int KSn = (brn == 1) ? 16 : 8;
      tl_gemm_prologue<2, 3, 4>(wfb + (size_t)koffn * 1024 + (size_t)(hcn >> 1) * KSn * 4 * 64 * 8, wb, lane, (hcn & 1) * 2);
    }
    if (br == 0) {
#pragma unroll
      for (int a2 = 0; a2 < 2; ++a2)
#pragma unroll
        for (int b2 = 0; b2 < 4; ++b2) m[a2][b2] = (f32x4){0.f, 0.f, 0.f, 0.f};
    }
#pragma unroll
    for (int mt = 0; mt < 4; ++mt)
#pragma unroll
      for (int nt = 0; nt < 2; ++nt) {
        m[nt][mt][0] += __uint_as_float(gv[mt][nt].x << 16) * acc[nt][mt][0];
        m[nt][mt][1] += __uint_as_float(gv[mt][nt].x & 0xffff0000u) * acc[nt][mt][1];
        m[nt][mt][2] += __uint_as_float(gv[mt][nt].y << 16) * acc[nt][mt][2];
        m[nt][mt][3] += __uint_as_float(gv[mt][nt].y & 0xffff0000u) * acc[nt][mt][3];
      }
    if (br == 2) {
#pragma unroll
      for (int mt = 0; mt < 4; ++mt) {
        const int tok = t0 + mt * 16 + (lane & 15);
        bf16_t* dst = p.mrg + (size_t)tok * 1024 + c * 64 + nt0 * 16 + 4 * (lane >> 4);
#pragma unroll
        for (int nt = 0; nt < 2; ++nt) {
          uint2 o;
          o.x = pack2bf(m[nt][mt][0], m[nt][mt][1]);
          o.y = pack2bf(m[nt][mt][2], m[nt][mt][3]);
          *(uint2*)(dst + nt * 16) = o;
        }
      }
    }
  }
}
__device__ __forceinline__ void o_p5a2_tile(const Params& p, int l, const float* __restrict__ xcur, int t0, char* smem, int tid) {
  const int wave = tid >> 6, lane = tid & 63;
  __syncthreads();
  tile_load_to_lds(p.mrg + (size_t)t0 * 1024, 1024, smem, tid);
  __syncthreads();
  const bf16_t* wfo = p.wf_out + (size_t)l * 1024 * 1024;
#pragma unroll 1
  for (int c = wave; c < 16; c += 8) {
    f32x4 acc[4][4];
#pragma unroll
    for (int a = 0; a < 4; ++a)
#pragma unroll
      for (int b = 0; b < 4; ++b) acc[a][b] = (f32x4){0.f, 0.f, 0.f, 0.f};
    tl_gemm_chunk<4, 2>(wfo + (size_t)c * 32 * 4 * 64 * 8, 32, smem, 0, acc, lane);
    asm volatile("" ::: "memory");
#pragma unroll
    for (int mt = 0; mt < 4; ++mt) {
      const int tok = t0 + mt * 16 + (lane & 15);
      const size_t o = (size_t)tok * 1024 + c * 64 + 4 * (lane >> 4);
#pragma unroll
      for (int nt = 0; nt < 4; ++nt) {
        float4 xv = *(const float4*)(xcur + o + nt * 16);
        xv.x += acc[nt][mt][0]; xv.y += acc[nt][mt][1]; xv.z += acc[nt][mt][2]; xv.w += acc[nt][mt][3];
        *(float4*)(p.xres + o + nt * 16) = xv;
      }
    }
  }
}
__device__ __forceinline__ void o_p5a3_tile(const Params& p, int l, int t0, char* smem, int tid) {
  const int wave = tid >> 6, lane = tid & 63;
  __syncthreads();
  tile_rmsnorm_to_lds(p.xres, p.norm_ffn + l * D_MODEL, t0, smem, wave, lane);
  __syncthreads();
}


__device__ __forceinline__ unsigned mono_f(float f) {
  unsigned u = __float_as_uint(f);
  return (u & 0x80000000u) ? ~u : (u | 0x80000000u);
}
__device__ __forceinline__ float unmono_f(unsigned m) {
  return __uint_as_float((m & 0x80000000u) ? (m & 0x7fffffffu) : ~m);
}
#define CE_DESC(x, y) { const unsigned hi_ = max(x, y); const unsigned lo_ = min(x, y); x = hi_; y = lo_; }
#define CE_ASC(x, y) { const unsigned hi_ = max(x, y); const unsigned lo_ = min(x, y); x = lo_; y = hi_; }
__device__ __forceinline__ void sort16_desc(unsigned (&a)[16]) {
#pragma unroll
  for (int k = 2; k <= 16; k <<= 1) {
#pragma unroll
    for (int j = k >> 1; j > 0; j >>= 1) {
#pragma unroll
      for (int i = 0; i < 16; ++i) {
        const int l = i ^ j;
        if (l > i) {
          if ((i & k) == 0) CE_DESC(a[i], a[l]) else CE_ASC(a[i], a[l])
        }
      }
    }
  }
}
__device__ __forceinline__ void bitonic_merge16_desc(unsigned (&a)[16]) {
#pragma unroll
  for (int j = 8; j > 0; j >>= 1) {
#pragma unroll
    for (int i = 0; i < 16; ++i) {
      const int l = i ^ j;
      if (l > i) CE_DESC(a[i], a[l])
    }
  }
}
__device__ __forceinline__ void xlane_merge16(unsigned (&a)[16], int mask) {
  unsigned b[16];
#pragma unroll
  for (int i = 0; i < 16; ++i) b[i] = (unsigned)__shfl_xor((int)a[i], mask, 64);
#pragma unroll
  for (int i = 0; i < 16; ++i) a[i] = max(a[i], b[15 - i]);
  bitonic_merge16_desc(a);
}

__device__ __forceinline__ void o_peer_select_tile(const Params& p, int l, int t0, char* smem, int tid) {
  const int h = __builtin_amdgcn_readfirstlane(tid >> 6), lane = tid & 63;
  const int g = lane >> 4, tl = lane & 15;
  const bf16_t* wfq = p.wf_q + (size_t)l * 1024 * 2048;
#pragma unroll 1
  for (int pp = 0; pp < 2; ++pp) {
    bf16x8 qf[4][4];
#pragma unroll 1
    for (int cc = 0; cc < 2; ++cc) {
      const int c = (h * 2 + pp) * 2 + cc;
      f32x4 acc[4][4];
#pragma unroll
      for (int a = 0; a < 4; ++a)
#pragma unroll
        for (int b = 0; b < 4; ++b) acc[a][b] = (f32x4){0.f, 0.f, 0.f, 0.f};
      tl_gemm_chunk<4, 2>(wfq + (size_t)c * 32 * 4 * 64 * 8, 32, smem, 0, acc, lane);
#pragma unroll
      for (int sl = 0; sl < 2; ++sl)
#pragma unroll
        for (int mt = 0; mt < 4; ++mt) {
          union { bf16x8 v; unsigned u[4]; } cv;
          cv.u[0] = pack2bf(acc[2 * sl][mt][0], acc[2 * sl][mt][1]);
          cv.u[1] = pack2bf(acc[2 * sl][mt][2], acc[2 * sl][mt][3]);
          cv.u[2] = pack2bf(acc[2 * sl + 1][mt][0], acc[2 * sl + 1][mt][1]);
          cv.u[3] = pack2bf(acc[2 * sl + 1][mt][2], acc[2 * sl + 1][mt][3]);
          if (cc == 0) qf[sl][mt] = cv.v; else qf[2 + sl][mt] = cv.v;
        }
    }
    const bf16x8* kfp = (const bf16x8*)p.kf + (size_t)((l * 2 + pp) * 8) * 4 * 64 + lane;
#pragma unroll
    for (int mt = 0; mt < 4; ++mt) {
      f32x4 sc[8];
#pragma unroll
      for (int kt = 0; kt < 8; ++kt) sc[kt] = (f32x4){0.f, 0.f, 0.f, 0.f};
#pragma unroll
      for (int s2 = 0; s2 < 4; ++s2) {
        bf16x8 qv;
        qv = qf[s2][mt];
#pragma unroll
        for (int kt = 0; kt < 8; ++kt)
          sc[kt] = __builtin_amdgcn_mfma_f32_16x16x32_bf16(kfp[(kt * 4 + s2) * 64], qv, sc[kt], 0, 0, 0);
        __builtin_amdgcn_sched_barrier(0);
      }
      unsigned A[16], B[16];
#pragma unroll
      for (int kt = 0; kt < 4; ++kt)
#pragma unroll
        for (int r = 0; r < 4; ++r) {
          A[kt * 4 + r] = (mono_f(sc[kt][r]) & ~127u) | (unsigned)(127 - (kt * 16 + r) - 4 * g);
          B[kt * 4 + r] = (mono_f(sc[kt + 4][r]) & ~127u) | (unsigned)(127 - ((kt + 4) * 16 + r) - 4 * g);
        }
      sort16_desc(A);
      sort16_desc(B);
#pragma unroll
      for (int i = 0; i < 16; ++i) A[i] = max(A[i], B[15 - i]);
      bitonic_merge16_desc(A);
      xlane_merge16(A, 16);
      xlane_merge16(A, 32);
      if (g == 0) {
        uint4* dst = (uint4*)(p.tklist + ((size_t)((t0 + mt * 16 + tl) * 8 + h) * 2 + pp) * 16);
        dst[0] = make_uint4(A[0], A[1], A[2], A[3]);
        dst[1] = make_uint4(A[4], A[5], A[6], A[7]);
        dst[2] = make_uint4(A[8], A[9], A[10], A[11]);
        dst[3] = make_uint4(A[12], A[13], A[14], A[15]);
      }
    }
  }
  asm volatile("s_waitcnt vmcnt(0)" ::: "memory");
}

__device__ __forceinline__ void o_peer_select2_tile(const Params& p, int l, int t0, int tid) {
  const int h = __builtin_amdgcn_readfirstlane(tid >> 6), lane = tid & 63;
  const int g = lane >> 4, tl = lane & 15;
#pragma unroll 1
  for (int mt = 0; mt < 4; ++mt) {
    const int tok = t0 + mt * 16 + tl;
    const unsigned* lp = p.tklist + ((size_t)(tok * 8 + h) * 2) * 16;
    float v1[16], v2[16];
    {
      const uint4* q4 = (const uint4*)lp;
#pragma unroll
      for (int i = 0; i < 4; ++i) {
        uint4 x = q4[i], y = q4[4 + i];
        v1[4 * i + 0] = unmono_f(x.x & ~127u); v1[4 * i + 1] = unmono_f(x.y & ~127u);
        v1[4 * i + 2] = unmono_f(x.z & ~127u); v1[4 * i + 3] = unmono_f(x.w & ~127u);
        v2[4 * i + 0] = unmono_f(y.x & ~127u); v2[4 * i + 1] = unmono_f(y.y & ~127u);
        v2[4 * i + 2] = unmono_f(y.z & ~127u); v2[4 * i + 3] = unmono_f(y.w & ~127u);
      }
    }
    unsigned C[16];
#pragma unroll
    for (int i = 0; i < 16; ++i) C[i] = 0u;
    {
      int idx = 0;
#pragma unroll
      for (int a = 0; a < 16; ++a) {
#pragma unroll
        for (int b = 0; b < 16; ++b) {
          if ((a + 1) * (b + 1) <= 16) {
            const unsigned key = (mono_f(v1[a] + v2[b]) & ~255u) | (unsigned)(255 - (a * 16 + b));
            const int slot = idx >> 2, who = idx & 3;
            C[slot] = (g == who) ? key : C[slot];
            ++idx;
          }
        }
      }
    }
    sort16_desc(C);
    xlane_merge16(C, 16);
    xlane_merge16(C, 32);
    const float f0 = unmono_f(C[0] & ~255u);
    float den = 0.f;
    float ev[16];
#pragma unroll
    for (int i = 0; i < 16; ++i) { ev[i] = __expf(unmono_f(C[i] & ~255u) - f0); den += ev[i]; }
    const float rden = 1.0f / den;
    int eidx[4]; float egate[4];
#pragma unroll
    for (int i = 0; i < 4; ++i) {
      const unsigned k = (g == 0) ? C[i] : (g == 1) ? C[4 + i] : (g == 2) ? C[8 + i] : C[12 + i];
      const float e = (g == 0) ? ev[i] : (g == 1) ? ev[4 + i] : (g == 2) ? ev[8 + i] : ev[12 + i];
      const int pos = 255 - (int)(k & 255u);
      const int a = pos >> 4, b = pos & 15;
      const int n1 = 127 - (int)(lp[a] & 127u);
      const int n2 = 127 - (int)(lp[16 + b] & 127u);
      eidx[i] = n1 * 128 + n2;
      egate[i] = e * rden;
    }
    *(int4*)(p.pidx + (size_t)tok * 128 + h * 16 + 4 * g) = make_int4(eidx[0], eidx[1], eidx[2], eidx[3]);
    *(float4*)(p.pgate + (size_t)tok * 128 + h * 16 + 4 * g) = make_float4(egate[0], egate[1], egate[2], egate[3]);
  }
}

__device__ __forceinline__ float logsigmoid_(float x) { return fminf(x, 0.f) - log1pf(expf(-fabsf(x))); }
__device__ __forceinline__ float bf_lo(unsigned w) { return __uint_as_float(w << 16); }
__device__ __forceinline__ float bf_hi(unsigned w) { return __uint_as_float(w & 0xffff0000u); }

#define RKV_LD 136
__device__ __forceinline__ void o_ret_kv_task(const Params& p, int l, int task, char* smem, int tid) {
  const int wave = tid >> 6, lane = tid & 63, g = lane >> 4, tl = lane & 15;
  const int bh = task >> 5, n = task & 31, b = bh >> 2, h = bh & 3;
  const int tok0 = b * SEQ + n * 128;
  const float lgf = logsigmoid_(p.ret_decay[l * 8 + h]), lgb = logsigmoid_(p.ret_decay[l * 8 + 4 + h]);
  bf16_t* KTf = (bf16_t*)smem;
  bf16_t* KTb = KTf + 64 * RKV_LD;
  bf16_t* VT = KTb + 64 * RKV_LD;
  __syncthreads();
#pragma unroll
  for (int it = 0; it < 2; ++it) {
    const int u = tid + it * NTHREADS;
    const int j = u >> 3, d0 = (u & 7) * 8;
    const uint4 kv = *(const uint4*)(p.proj + (size_t)(tok0 + j) * IN_WIDTH + C_RK + h * 64 + d0);
    const float wf = __expf(lgf * (float)(127 - j)), wb = __expf(lgb * (float)(j + 1));
    const unsigned kw[4] = {kv.x, kv.y, kv.z, kv.w};
#pragma unroll
    for (int e = 0; e < 4; ++e) {
      const float x0 = bf_lo(kw[e]), x1 = bf_hi(kw[e]);
      KTf[(d0 + 2 * e) * RKV_LD + j] = f2bf(x0 * wf);
      KTf[(d0 + 2 * e + 1) * RKV_LD + j] = f2bf(x1 * wf);
      KTb[(d0 + 2 * e) * RKV_LD + j] = f2bf(x0 * wb);
      KTb[(d0 + 2 * e + 1) * RKV_LD + j] = f2bf(x1 * wb);
    }
  }
#pragma unroll
  for (int it = 0; it < 4; ++it) {
    const int u = tid + it * NTHREADS;
    const int j = u >> 4, e0 = (u & 15) * 8;
    const uint4 vv = *(const uint4*)(p.proj + (size_t)(tok0 + j) * IN_WIDTH + C_RV + h * 128 + e0);
    const unsigned vw[4] = {vv.x, vv.y, vv.z, vv.w};
#pragma unroll
    for (int e = 0; e < 4; ++e) {
      VT[(e0 + 2 * e) * RKV_LD + j] = (bf16_t)(vw[e] & 0xffffu);
      VT[(e0 + 2 * e + 1) * RKV_LD + j] = (bf16_t)(vw[e] >> 16);
    }
  }
  __syncthreads();
  bf16x8 a[4];
#pragma unroll
  for (int ks = 0; ks < 4; ++ks) a[ks] = *(const bf16x8*)(VT + (wave * 16 + tl) * RKV_LD + ks * 32 + 8 * g);
#pragma unroll
  for (int dir = 0; dir < 2; ++dir) {
    const bf16_t* KT = dir ? KTb : KTf;
#pragma unroll
    for (int dt = 0; dt < 4; ++dt) {
      f32x4 acc = (f32x4){0.f, 0.f, 0.f, 0.f};
#pragma unroll
      for (int ks = 0; ks < 4; ++ks) {
        const bf16x8 bb = *(const bf16x8*)(KT + (dt * 16 + tl) * RKV_LD + ks * 32 + 8 * g);
        acc = __builtin_amdgcn_mfma_f32_16x16x32_bf16(a[ks], bb, acc, 0, 0, 0);
      }
      float* dst = p.kvst + ((size_t)(task * 2 + dir) * 128 + wave * 16 + 4 * g) * 64 + dt * 16 + tl;
#pragma unroll
      for (int r = 0; r < 4; ++r) dst[r * 64] = acc[r];
    }
  }
}

__device__ __forceinline__ void o_ret_scan(const int wv_, const Params& p, int l) {
  const int tidx_ = opaque_tid(wv_); const int bidx_ = opaque_bid();
  const int gsz = gridDim.x * NTHREADS;
  for (int u = bidx_ * NTHREADS + tidx_; u < 16 * 2 * 128 * 16; u += gsz) {
    const int dq = u & 15, e = (u >> 4) & 127, dir = (u >> 11) & 1, bh = u >> 12, h = bh & 3;
    const float lg = logsigmoid_(p.ret_decay[l * 8 + dir * 4 + h]);
    const float gC = __expf(lg * 128.0f);
    float4 st = make_float4(0.f, 0.f, 0.f, 0.f);
#pragma unroll 8
    for (int nn = 0; nn < 32; ++nn) {
      const int n = dir ? (31 - nn) : nn;
      const size_t idx = ((size_t)((bh * 32 + n) * 2 + dir) * 128 + e) * 64 + dq * 4;
      const float4 kv = *(const float4*)(p.kvst + idx);
      uint2 o;
      o.x = pack2bf(st.x, st.y); o.y = pack2bf(st.z, st.w);
      *(uint2*)(p.rstate + idx) = o;
      st.x = fmaf(st.x, gC, kv.x); st.y = fmaf(st.y, gC, kv.y); st.z = fmaf(st.z, gC, kv.z); st.w = fmaf(st.w, gC, kv.w);
    }
  }
}

#define RO_LD 264
#define RK_LD 72
__device__ __forceinline__ void o_ret_out_task(const Params& p, int l, int task, char* smem, int tid) {
  const int wave = tid >> 6, lane = tid & 63, g = lane >> 4, tl = lane & 15;
  const int bh = task >> 5, n = task & 31, b = bh >> 2, h = bh & 3;
  const int tok0 = b * SEQ + n * 128;
  const float lgf = logsigmoid_(p.ret_decay[l * 8 + h]), lgb = logsigmoid_(p.ret_decay[l * 8 + 4 + h]);
  bf16_t* Acat = (bf16_t*)smem;
  bf16_t* Bcat = Acat + 128 * RO_LD;
  bf16_t* Kl = Bcat + 128 * RO_LD;
  __syncthreads();
#pragma unroll
  for (int it = 0; it < 2; ++it) {
    const int u = tid + it * NTHREADS;
    const int i = u >> 3, d0 = (u & 7) * 8;
    const size_t row = (size_t)(tok0 + i) * IN_WIDTH;
    const uint4 qv = *(const uint4*)(p.proj + row + C_RQ + h * 64 + d0);
    const uint4 kv = *(const uint4*)(p.proj + row + C_RK + h * 64 + d0);
    *(uint4*)(Acat + i * RO_LD + d0) = qv;
    *(uint4*)(Kl + i * RK_LD + d0) = kv;
    const float wf = __expf(lgf * (float)(i + 1)), wb = __expf(lgb * (float)(127 - i));
    const unsigned qw[4] = {qv.x, qv.y, qv.z, qv.w};
    uint4 of, ob;
    of.x = pack2bf(bf_lo(qw[0]) * wf, bf_hi(qw[0]) * wf); ob.x = pack2bf(bf_lo(qw[0]) * wb, bf_hi(qw[0]) * wb);
    of.y = pack2bf(bf_lo(qw[1]) * wf, bf_hi(qw[1]) * wf); ob.y = pack2bf(bf_lo(qw[1]) * wb, bf_hi(qw[1]) * wb);
    of.z = pack2bf(bf_lo(qw[2]) * wf, bf_hi(qw[2]) * wf); ob.z = pack2bf(bf_lo(qw[2]) * wb, bf_hi(qw[2]) * wb);
    of.w = pack2bf(bf_lo(qw[3]) * wf, bf_hi(qw[3]) * wf); ob.w = pack2bf(bf_lo(qw[3]) * wb, bf_hi(qw[3]) * wb);
    *(uint4*)(Acat + i * RO_LD + 128 + d0) = of;
    *(uint4*)(Acat + i * RO_LD + 192 + d0) = ob;
  }
#pragma unroll
  for (int it = 0; it < 4; ++it) {
    const int u = tid + it * NTHREADS;
    const int j = u >> 4, e0 = (u & 15) * 8;
    const uint4 vv = *(const uint4*)(p.proj + (size_t)(tok0 + j) * IN_WIDTH + C_RV + h * 128 + e0);
    const unsigned vw[4] = {vv.x, vv.y, vv.z, vv.w};
#pragma unroll
    for (int e = 0; e < 4; ++e) {
      Bcat[(e0 + 2 * e) * RO_LD + j] = (bf16_t)(vw[e] & 0xffffu);
      Bcat[(e0 + 2 * e + 1) * RO_LD + j] = (bf16_t)(vw[e] >> 16);
    }
  }
#pragma unroll
  for (int it = 0; it < 4; ++it) {
    const int u = tid + it * NTHREADS;
    const int d0 = (u & 7) * 8, e = (u >> 3) & 127, dir = u >> 10;
    const uint4 sv = *(const uint4*)(p.rstate + ((size_t)(task * 2 + dir) * 128 + e) * 64 + d0);
    *(uint4*)(Bcat + e * RO_LD + 128 + dir * 64 + d0) = sv;
  }
  __syncthreads();
  f32x4 sc[8];
#pragma unroll
  for (int jt = 0; jt < 8; ++jt) sc[jt] = (f32x4){0.f, 0.f, 0.f, 0.f};
#pragma unroll
  for (int ks = 0; ks < 2; ++ks) {
    const bf16x8 qb = *(const bf16x8*)(Acat + (wave * 16 + tl) * RO_LD + ks * 32 + 8 * g);
#pragma unroll
    for (int jt = 0; jt < 8; ++jt) {
      const bf16x8 ka = *(const bf16x8*)(Kl + (jt * 16 + tl) * RK_LD + ks * 32 + 8 * g);
      sc[jt] = __builtin_amdgcn_mfma_f32_16x16x32_bf16(ka, qb, sc[jt], 0, 0, 0);
    }
  }
  {
    const int i = wave * 16 + tl;
#pragma unroll
    for (int jt = 0; jt < 8; ++jt) {
      float pv[4];
#pragma unroll
      for (int r = 0; r < 4; ++r) {
        const int j = jt * 16 + 4 * g + r;
        const float dd = (j <= i) ? __expf(lgf * (float)(i - j)) : __expf(lgb * (float)(j - i));
        pv[r] = sc[jt][r] * dd;
      }
      uint2 o;
      o.x = pack2bf(pv[0], pv[1]); o.y = pack2bf(pv[2], pv[3]);
      *(uint2*)(Acat + i * RO_LD + jt * 16 + 4 * g) = o;
    }
  }
  f32x4 y[8];
#pragma unroll
  for (int et = 0; et < 8; ++et) y[et] = (f32x4){0.f, 0.f, 0.f, 0.f};
#pragma unroll
  for (int ks = 0; ks < 8; ++ks) {
    const bf16x8 ab = *(const bf16x8*)(Acat + (wave * 16 + tl) * RO_LD + ks * 32 + 8 * g);
#pragma unroll
    for (int et = 0; et < 8; ++et) {
      const bf16x8 ba = *(const bf16x8*)(Bcat + (et * 16 + tl) * RO_LD + ks * 32 + 8 * g);
      y[et] = __builtin_amdgcn_mfma_f32_16x16x32_bf16(ba, ab, y[et], 0, 0, 0);
    }
  }
  float ss = 0.f;
#pragma unroll
  for (int et = 0; et < 8; ++et)
#pragma unroll
    for (int r = 0; r < 4; ++r) ss = fmaf(y[et][r], y[et][r], ss);
  ss += __shfl_xor(ss, 16, 64);
  ss += __shfl_xor(ss, 32, 64);
  const float rstd = rsqrtf(ss * (1.0f / 128.0f) + EPS);
  {
    const int tok = tok0 + wave * 16 + tl;
    const bf16_t* gp = p.proj + (size_t)tok * IN_WIDTH + C_RG + h * 128 + 4 * g;
    bf16_t* dst = p.ycat + (size_t)tok * 1024 + 256 + h * 128 + 4 * g;
#pragma unroll
    for (int et = 0; et < 8; ++et) {
      const uint2 gv = *(const uint2*)(gp + et * 16);
      const float g0 = bf_lo(gv.x), g1 = bf_hi(gv.x), g2 = bf_lo(gv.y), g3 = bf_hi(gv.y);
      uint2 o;
      o.x = pack2bf(g0 / (1.0f + __expf(-g0)) * y[et][0] * rstd, g1 / (1.0f + __expf(-g1)) * y[et][1] * rstd);
      o.y = pack2bf(g2 / (1.0f + __expf(-g2)) * y[et][2] * rstd, g3 / (1.0f + __expf(-g3)) * y[et][3] * rstd);
      *(uint2*)(dst + et * 16) = o;
    }
  }
}


#define NA_KLD 72
#define NA_VLD 520
__device__ __forceinline__ void o_na_task(const Params& p, int l, int task, char* smem, int tid) {
  const int wave = tid >> 6, lane = tid & 63, g = lane >> 4, tl = lane & 15;
  const int rr = task & 63, h = (task >> 6) & 3, b = task >> 8;
  int rs = rr - 4; rs = rs < 0 ? 0 : (rs > 56 ? 56 : rs);
  const int ktok0 = b * SEQ + rs * 64;
  const int qtok0 = b * SEQ + rr * 64;
  bf16_t* Kl = (bf16_t*)smem;
  bf16_t* VT = Kl + 512 * NA_KLD;
  bf16_t* Ql = VT + 64 * NA_VLD;
  float* rpbl = (float*)(Ql + 64 * NA_KLD);
  __syncthreads();
#pragma unroll
  for (int it = 0; it < 8; ++it) {
    const int u = tid + it * NTHREADS;
    const int key = u >> 3, d0 = (u & 7) * 8;
    const size_t row = (size_t)(ktok0 + key) * IN_WIDTH;
    const uint4 kv = *(const uint4*)(p.proj + row + C_NK + h * 64 + d0);
    const uint4 vv = *(const uint4*)(p.proj + row + C_NV + h * 64 + d0);
    *(uint4*)(Kl + key * NA_KLD + d0) = kv;
    const unsigned vw[4] = {vv.x, vv.y, vv.z, vv.w};
#pragma unroll
    for (int e = 0; e < 4; ++e) {
      VT[(d0 + 2 * e) * NA_VLD + key] = (bf16_t)(vw[e] & 0xffffu);
      VT[(d0 + 2 * e + 1) * NA_VLD + key] = (bf16_t)(vw[e] >> 16);
    }
  }
  {
    const int q = tid >> 3, d0 = (tid & 7) * 8;
    *(uint4*)(Ql + q * NA_KLD + d0) = *(const uint4*)(p.proj + (size_t)(qtok0 + q) * IN_WIDTH + C_NQ + h * 64 + d0);
    if (tid < 465) rpbl[tid] = p.na_rpb[((size_t)l * 4 + h) * 465 + tid];
  }
  __syncthreads();
  if (wave < 4) {
    const int qt = wave;
    int cw0 = 16 * qt - 8; cw0 = cw0 < 0 ? 0 : (cw0 > 32 ? 32 : cw0);
    f32x4 sc[16];
#pragma unroll
    for (int T = 0; T < 16; ++T) sc[T] = (f32x4){0.f, 0.f, 0.f, 0.f};
#pragma unroll
    for (int ks = 0; ks < 2; ++ks) {
      const bf16x8 qb = *(const bf16x8*)(Ql + (qt * 16 + tl) * NA_KLD + ks * 32 + 8 * g);
#pragma unroll
      for (int T = 0; T < 16; ++T) {
        const int key = (T >> 1) * 64 + cw0 + (T & 1) * 16 + tl;
        const bf16x8 ka = *(const bf16x8*)(Kl + key * NA_KLD + ks * 32 + 8 * g);
        sc[T] = __builtin_amdgcn_mfma_f32_16x16x32_bf16(ka, qb, sc[T], 0, 0, 0);
      }
    }
    const int cq = qt * 16 + tl;
    int cs = cq - 8; cs = cs < 0 ? 0 : (cs > 48 ? 48 : cs);
    float m = -3.0e38f;
#pragma unroll
    for (int T = 0; T < 16; ++T) {
      const int ri = T >> 1;
      const int di = rs + ri - rr + 7;
#pragma unroll
      for (int r = 0; r < 4; ++r) {
        const int ck = cw0 + (T & 1) * 16 + 4 * g + r;
        const bool valid = (ck >= cs) && (ck < cs + 16);
        int dj = ck - cq + 15; dj = dj < 0 ? 0 : (dj > 30 ? 30 : dj);
        const float sv = valid ? (sc[T][r] + rpbl[di * 31 + dj]) : -1.0e30f;
        sc[T][r] = sv;
        m = fmaxf(m, sv);
      }
    }
    m = fmaxf(m, __shfl_xor(m, 16, 64));
    m = fmaxf(m, __shfl_xor(m, 32, 64));
    float den = 0.f;
#pragma unroll
    for (int T = 0; T < 16; ++T)
#pragma unroll
      for (int r = 0; r < 4; ++r) {
        const float e = __expf(sc[T][r] - m);
        sc[T][r] = e;
        den += e;
      }
    den += __shfl_xor(den, 16, 64);
    den += __shfl_xor(den, 32, 64);
    const float rden = 1.0f / den;
    f32x4 o[4];
#pragma unroll
    for (int dt = 0; dt < 4; ++dt) o[dt] = (f32x4){0.f, 0.f, 0.f, 0.f};
#pragma unroll
    for (int ri = 0; ri < 8; ++ri) {
      union { bf16x8 v; unsigned u[4]; } pb;
      pb.u[0] = pack2bf(sc[2 * ri][0], sc[2 * ri][1]);
      pb.u[1] = pack2bf(sc[2 * ri][2], sc[2 * ri][3]);
      pb.u[2] = pack2bf(sc[2 * ri + 1][0], sc[2 * ri + 1][1]);
      pb.u[3] = pack2bf(sc[2 * ri + 1][2], sc[2 * ri + 1][3]);
#pragma unroll
      for (int dt = 0; dt < 4; ++dt) {
        const bf16_t* vp = VT + (dt * 16 + tl) * NA_VLD + ri * 64 + cw0 + 4 * g;
        union { bf16x8 v; uint2 h[2]; } va;
        va.h[0] = *(const uint2*)vp;
        va.h[1] = *(const uint2*)(vp + 16);
        o[dt] = __builtin_amdgcn_mfma_f32_16x16x32_bf16(va.v, pb.v, o[dt], 0, 0, 0);
      }
    }
    bf16_t* dst = p.ycat + (size_t)(qtok0 + qt * 16 + tl) * 1024 + 768 + h * 64 + 4 * g;
#pragma unroll
    for (int dt = 0; dt < 4; ++dt) {
      uint2 ov;
      ov.x = pack2bf(o[dt][0] * rden, o[dt][1] * rden);
      ov.y = pack2bf(o[dt][2] * rden, o[dt][3] * rden);
      *(uint2*)(dst + dt * 16) = ov;
    }
  }
}

#define PL_LD 264
__device__ __forceinline__ void o_pool_task(const Params& p, int l, int task, char* smem, int tid) {
  const int wave = tid >> 6, lane = tid & 63, g = lane >> 4, tl = lane & 15;
  const int t0 = task * 64, pos0 = t0 & (SEQ - 1);
  bf16_t* Xp = (bf16_t*)smem;
  bf16_t* WT = Xp + 80 * PL_LD;
  bf16_t* Df = WT + 4 * 64 * 72;
  __syncthreads();
#pragma unroll
  for (int it = 0; it < 5; ++it) {
    const int u = tid + it * NTHREADS;
    const int rw = u >> 5, c0 = (u & 31) * 8;
    const int pos = pos0 - 8 + rw;
    uint4 v = make_uint4(0u, 0u, 0u, 0u);
    if (pos >= 0 && pos < SEQ) v = *(const uint4*)(p.proj + (size_t)(t0 - 8 + rw) * IN_WIDTH + C_POOL + c0);
    *(uint4*)(Xp + rw * PL_LD + c0) = v;
  }
#pragma unroll
  for (int it = 0; it < 4; ++it) {
    const int u = tid + it * NTHREADS;
    const int e0 = (u & 7) * 8, c = (u >> 3) & 63, gi = u >> 9;
    const float* wp = p.pool_w + (((size_t)l * 4 + gi) * 64 + c) * 64 + e0;
    const float4 a = *(const float4*)wp, bq = *(const float4*)(wp + 4);
    const float wv[8] = {a.x, a.y, a.z, a.w, bq.x, bq.y, bq.z, bq.w};
#pragma unroll
    for (int k = 0; k < 8; ++k) WT[(gi * 64 + e0 + k) * 72 + c] = f2bf(wv[k]);
  }
  __syncthreads();
#pragma unroll 1
  for (int it = 0; it < 4; ++it) {
    const int u = tid + it * NTHREADS;
    const int t = u >> 5, c0 = (u & 31) * 8;
    const int gi = c0 >> 6;
    const int hw = 1 << gi;
    const int pos = pos0 + t;
    int a = pos - hw; a = a < 0 ? 0 : a;
    int bnd = pos + hw; bnd = bnd > SEQ ? SEQ : bnd;
    float sum[8];
#pragma unroll
    for (int k = 0; k < 8; ++k) sum[k] = 0.f;
    for (int rp = a; rp < bnd; ++rp) {
      const uint4 v = *(const uint4*)(Xp + (rp - pos0 + 8) * PL_LD + c0);
      sum[0] += bf_lo(v.x); sum[1] += bf_hi(v.x); sum[2] += bf_lo(v.y); sum[3] += bf_hi(v.y);
      sum[4] += bf_lo(v.z); sum[5] += bf_hi(v.z); sum[6] += bf_lo(v.w); sum[7] += bf_hi(v.w);
    }
    const float rc = 1.0f / (float)(bnd - a);
    const uint4 xv = *(const uint4*)(Xp + (t + 8) * PL_LD + c0);
    uint4 o;
    o.x = pack2bf(sum[0] * rc - bf_lo(xv.x), sum[1] * rc - bf_hi(xv.x));
    o.y = pack2bf(sum[2] * rc - bf_lo(xv.y), sum[3] * rc - bf_hi(xv.y));
    o.z = pack2bf(sum[4] * rc - bf_lo(xv.z), sum[5] * rc - bf_hi(xv.z));
    o.w = pack2bf(sum[6] * rc - bf_lo(xv.w), sum[7] * rc - bf_hi(xv.w));
    *(uint4*)(Df + t * PL_LD + c0) = o;
  }
  __syncthreads();
  {
    const int gi = wave >> 1, tt0 = (wave & 1) * 2;
    f32x4 acc[4][2];
#pragma unroll
    for (int et = 0; et < 4; ++et)
#pragma unroll
      for (int tt = 0; tt < 2; ++tt) acc[et][tt] = (f32x4){0.f, 0.f, 0.f, 0.f};
#pragma unroll
    for (int ks = 0; ks < 2; ++ks) {
      bf16x8 bx[2];
#pragma unroll
      for (int tt = 0; tt < 2; ++tt) bx[tt] = *(const bf16x8*)(Df + ((tt0 + tt) * 16 + tl) * PL_LD + gi * 64 + ks * 32 + 8 * g);
#pragma unroll
      for (int et = 0; et < 4; ++et) {
        const bf16x8 wa = *(const bf16x8*)(WT + (gi * 64 + et * 16 + tl) * 72 + ks * 32 + 8 * g);
#pragma unroll
        for (int tt = 0; tt < 2; ++tt) acc[et][tt] = __builtin_amdgcn_mfma_f32_16x16x32_bf16(wa, bx[tt], acc[et][tt], 0, 0, 0);
      }
    }
#pragma unroll
    for (int et = 0; et < 4; ++et) {
      const float4 sc4 = *(const float4*)(p.pool_scale + l * 256 + gi * 64 + et * 16 + 4 * g);
#pragma unroll
      for (int tt = 0; tt < 2; ++tt) {
        const int tok = t0 + (tt0 + tt) * 16 + tl;
        uint2 o;
        o.x = pack2bf(acc[et][tt][0] * sc4.x, acc[et][tt][1] * sc4.y);
        o.y = pack2bf(acc[et][tt][2] * sc4.z, acc[et][tt][3] * sc4.w);
        *(uint2*)(p.ycat + (size_t)tok * 1024 + gi * 64 + et * 16 + 4 * g) = o;
      }
    }
  }
}


typedef __attribute__((ext_vector_type(2))) __bf16 bf16x2_t;
__device__ __forceinline__ float dot2bf(unsigned a, unsigned b, float c) {
  return __builtin_amdgcn_fdot2_f32_bf16(__builtin_bit_cast(bf16x2_t, a), __builtin_bit_cast(bf16x2_t, b), c, false);
}
#define DPP_F(v, ctrl) __builtin_bit_cast(float, __builtin_amdgcn_update_dpp(0, __builtin_bit_cast(int, v), ctrl, 0xf, 0xf, false))
#define RDLANE_F(v, l) __builtin_bit_cast(float, __builtin_amdgcn_readlane(__builtin_bit_cast(int, v), l))
__device__ __forceinline__ float erf_as(float x) {
  const float ax = fabsf(x);
  const float t = __builtin_amdgcn_rcpf(fmaf(0.3275911f, ax, 1.0f));
  float y = fmaf(1.061405429f, t, -1.453152027f);
  y = fmaf(y, t, 1.421413741f);
  y = fmaf(y, t, -0.284496736f);
  y = fmaf(y, t, 0.254829592f);
  y = y * t * __expf(-ax * ax);
  return copysignf(1.0f - y, x);
}
__device__ __forceinline__ float gelu_fast_exact(float a) { return 0.5f * a * (1.0f + erf_as(a * 0.70710678118654752f)); }
struct PickPair { int eA, eB; float gA, gB; };

#define EX6_SHIFT 11
#define EX6_NSLICE (16384 >> EX6_SHIFT)
__device__ __forceinline__ unsigned cvt8_bf16x2(unsigned w, float scale, const bool hi) {
  return hi ? __builtin_bit_cast(unsigned, __builtin_amdgcn_cvt_scalef32_pk_bf16_fp8((int)w, scale, true))
            : __builtin_bit_cast(unsigned, __builtin_amdgcn_cvt_scalef32_pk_bf16_fp8((int)w, scale, false));
}
__device__ __forceinline__ void experts6_process4(const unsigned char* __restrict__ U8, const unsigned char* __restrict__ V8,
                                                  const float2* __restrict__ ES, const int (&e)[4], const float (&g)[4],
                                                  const unsigned (&hw)[8], float (&acc)[16], int lane, int vz) {
  uint4 u[4], v[4];
  float2 sc[4];
#pragma unroll
  for (int i = 0; i < 4; ++i) u[i] = *(const uint4*)(U8 + (size_t)e[i] * 1024 + lane * 16);
#pragma unroll
  for (int i = 0; i < 4; ++i) sc[i] = ES[e[i] + vz];
#pragma unroll
  for (int i = 0; i < 4; ++i) v[i] = *(const uint4*)(V8 + (size_t)e[i] * 1024 + lane * 16);
  float a[4];
#pragma unroll
  for (int i = 0; i < 4; ++i) {
    const unsigned uw[4] = {u[i].x, u[i].y, u[i].z, u[i].w};
    float t = 0.f;
#pragma unroll
    for (int w = 0; w < 4; ++w) {
      t = dot2bf(cvt8_bf16x2(uw[w], sc[i].x, false), hw[2 * w], t);
      t = dot2bf(cvt8_bf16x2(uw[w], sc[i].x, true), hw[2 * w + 1], t);
    }
    a[i] = t;
  }
  const bool b0 = lane & 1, b1 = lane & 2;
  const float x01 = (b0 ? a[1] : a[0]) + DPP_F((b0 ? a[0] : a[1]), 0xB1);
  const float x23 = (b0 ? a[3] : a[2]) + DPP_F((b0 ? a[2] : a[3]), 0xB1);
  float y = (b1 ? x23 : x01) + DPP_F((b1 ? x01 : x23), 0x4E);
  y += DPP_F(y, 0x124);
  y += DPP_F(y, 0x128);
  float sum[4];
#pragma unroll
  for (int i = 0; i < 4; ++i) sum[i] = RDLANE_F(y, i) + RDLANE_F(y, 16 + i) + RDLANE_F(y, 32 + i) + RDLANE_F(y, 48 + i);
  const int li = lane & 3;
  const float mine = (li == 0) ? sum[0] : (li == 1) ? sum[1] : (li == 2) ? sum[2] : sum[3];
  const float gmine = (li == 0) ? g[0] : (li == 1) ? g[1] : (li == 2) ? g[2] : g[3];
  const unsigned gb = (unsigned)f2bf(gelu_fast_exact(mine) * gmine);
#pragma unroll
  for (int i = 0; i < 4; ++i) {
    const unsigned hl = (unsigned)__builtin_amdgcn_readlane((int)gb, i);
    const unsigned hh = hl << 16;
    const unsigned vw[4] = {v[i].x, v[i].y, v[i].z, v[i].w};
#pragma unroll
    for (int w = 0; w < 4; ++w) {
      const unsigned p0 = cvt8_bf16x2(vw[w], sc[i].y, false), p1 = cvt8_bf16x2(vw[w], sc[i].y, true);
      acc[4 * w + 0] = dot2bf(p0, hl, acc[4 * w + 0]);
      acc[4 * w + 1] = dot2bf(p0, hh, acc[4 * w + 1]);
      acc[4 * w + 2] = dot2bf(p1, hl, acc[4 * w + 2]);
      acc[4 * w + 3] = dot2bf(p1, hh, acc[4 * w + 3]);
    }
  }
}

__device__ __forceinline__ void o_peer_experts6_tile(const Params& p, int l, int t0, const char* smem, int tid, bool dry = false) {
  const int wave = __builtin_amdgcn_readfirstlane(tid >> 6), lane = tid & 63;
  const unsigned char* U8 = p.u8 + (size_t)l * 16384 * 1024;
  const unsigned char* V8 = p.v8 + (size_t)l * 16384 * 1024;
  const float2* ES = p.escale + (size_t)l * 16384;
  int vz = 0;
  asm volatile("" : "+v"(vz));
  const int s0 = ((int)(__builtin_amdgcn_s_getreg((3 << 11) | 20) & 0xF) * (EX6_NSLICE / 8)) & (EX6_NSLICE - 1);
  unsigned pk[8][2];
  float acc[8][16];
#pragma unroll
  for (int k = 0; k < 8; ++k) {
    const size_t base = (size_t)(t0 + wave * 8 + k) * 128 + lane + vz;
#pragma unroll
    for (int hf = 0; hf < 2; ++hf) pk[k][hf] = (unsigned)p.pidx[base + hf * 64] | ((unsigned)f2bf(p.pgate[base + hf * 64]) << 16);
#pragma unroll
    for (int i = 0; i < 16; ++i) acc[k][i] = 0.f;
  }
#pragma unroll 1
  for (int si = 0; si < EX6_NSLICE; ++si) {
    const unsigned s = (unsigned)((s0 + si) & (EX6_NSLICE - 1));
#pragma unroll
    for (int k = 0; k < 8; ++k) {
      unsigned long long m0 = __ballot(((pk[k][0] & 0x3fffu) >> EX6_SHIFT) == s);
      unsigned long long m1 = __ballot(((pk[k][1] & 0x3fffu) >> EX6_SHIFT) == s);
      if ((m0 | m1) == 0ull) continue;
      unsigned hw[8];
      {
        const char* xr = smem + (wave * 8 + k) * LDXB + lane * 32;
        const uint4 h0 = *(const uint4*)xr, h1 = *(const uint4*)(xr + 16);
        hw[0] = h0.x; hw[1] = h0.y; hw[2] = h0.z; hw[3] = h0.w; hw[4] = h1.x; hw[5] = h1.y; hw[6] = h1.z; hw[7] = h1.w;
      }
      while (m0 | m1) {
        int e[4]; float g[4];
#pragma unroll
        for (int i = 0; i < 4; ++i) {
          unsigned w;
          if (m0) { const int la = (int)__builtin_ctzll(m0); m0 &= m0 - 1; w = (unsigned)__builtin_amdgcn_readlane((int)pk[k][0], la); }
          else if (m1) { const int la = (int)__builtin_ctzll(m1); m1 &= m1 - 1; w = (unsigned)__builtin_amdgcn_readlane((int)pk[k][1], la); }
          else { w = (unsigned)e[0]; }
          e[i] = (int)(w & 0x3fffu);
          g[i] = __uint_as_float(w & 0xffff0000u);
        }
        experts6_process4(U8, V8, ES, e, g, hw, acc[k], lane, vz);
      }
    }
  }
  if (dry) {
#pragma unroll
    for (int k = 0; k < 8; ++k)
#pragma unroll
      for (int i = 0; i < 16; ++i) asm volatile("" :: "v"(acc[k][i]));
    return;
  }
#pragma unroll
  for (int k = 0; k < 8; ++k) {
    float* xr = p.xres + (size_t)(t0 + wave * 8 + k) * 1024 + lane * 16;
#pragma unroll
    for (int i = 0; i < 4; ++i) {
      float4 a0 = *(float4*)(xr + 4 * i);
      a0.x += acc[k][4 * i + 0]; a0.y += acc[k][4 * i + 1]; a0.z += acc[k][4 * i + 2]; a0.w += acc[k][4 * i + 3];
      *(float4*)(xr + 4 * i) = a0;
    }
  }
}


typedef _Float16 h2_t __attribute__((ext_vector_type(2)));
__device__ __forceinline__ void ex7_pop(unsigned long long& m0, unsigned long long& m1, const unsigned pk0, const unsigned pk1,
                                        int (&e)[4], float (&g)[4]) {
  int e0 = 0;
#pragma unroll
  for (int i = 0; i < 4; ++i) {
    unsigned w;
    if (m0) { const int la = (int)__builtin_ctzll(m0); m0 &= m0 - 1; w = (unsigned)__builtin_amdgcn_readlane((int)pk0, la); }
    else if (m1) { const int la = (int)__builtin_ctzll(m1); m1 &= m1 - 1; w = (unsigned)__builtin_amdgcn_readlane((int)pk1, la); }
    else { w = (unsigned)e0; }
    e[i] = (int)(w & 0x3fffu);
    g[i] = __uint_as_float(w & 0xffff0000u);
    if (i == 0) e0 = e[0];
  }
}
#define EX7_ISSUE(U_, V_, SC_, G_) { \
  _Pragma("unroll") for (int i_ = 0; i_ < 4; ++i_) U_[i_] = *(const uint4*)(U8 + (size_t)e[i_] * 1024 + lane * 16); \
  _Pragma("unroll") for (int i_ = 0; i_ < 4; ++i_) SC_[i_] = ES[e[i_] + vz]; \
  _Pragma("unroll") for (int i_ = 0; i_ < 4; ++i_) V_[i_] = *(const uint4*)(V8 + (size_t)e[i_] * 1024 + lane * 16); \
  _Pragma("unroll") for (int i_ = 0; i_ < 4; ++i_) G_[i_] = g[i_]; }

__device__ __forceinline__ void ex7_compute(const uint4 (&ru)[4], const uint4 (&rv)[4], const float2 (&rsc)[4], const float (&rg)[4],
                                            const unsigned (&hw)[8], h2_t (&acc)[8], int lane) {
  float a[4];
#pragma unroll
  for (int i = 0; i < 4; ++i) {
    const unsigned uw[4] = {ru[i].x, ru[i].y, ru[i].z, ru[i].w};
    float t = 0.f;
#pragma unroll
    for (int w = 0; w < 4; ++w) {
      t = dot2bf(cvt8_bf16x2(uw[w], rsc[i].x, false), hw[2 * w], t);
      t = dot2bf(cvt8_bf16x2(uw[w], rsc[i].x, true), hw[2 * w + 1], t);
    }
    a[i] = t;
  }
  const bool b0 = lane & 1, b1 = lane & 2;
  const float x01 = (b0 ? a[1] : a[0]) + DPP_F((b0 ? a[0] : a[1]), 0xB1);
  const float x23 = (b0 ? a[3] : a[2]) + DPP_F((b0 ? a[2] : a[3]), 0xB1);
  float y = (b1 ? x23 : x01) + DPP_F((b1 ? x01 : x23), 0x4E);
  y += DPP_F(y, 0x124);
  y += DPP_F(y, 0x128);
  float sum[4];
#pragma unroll
  for (int i = 0; i < 4; ++i) sum[i] = RDLANE_F(y, i) + RDLANE_F(y, 16 + i) + RDLANE_F(y, 32 + i) + RDLANE_F(y, 48 + i);
  const int li = lane & 3;
  const float mine = (li == 0) ? sum[0] : (li == 1) ? sum[1] : (li == 2) ? sum[2] : sum[3];
  const float gmine = (li == 0) ? rg[0] : (li == 1) ? rg[1] : (li == 2) ? rg[2] : rg[3];
  const _Float16 hf = (_Float16)(gelu_fast_exact(mine) * gmine);
  const unsigned hb = (unsigned)__builtin_bit_cast(unsigned short, hf);
#pragma unroll
  for (int i = 0; i < 4; ++i) {
    const unsigned hl = (unsigned)__builtin_amdgcn_readlane((int)hb, i);
    const h2_t hh = __builtin_bit_cast(h2_t, hl | (hl << 16));
    const unsigned vw[4] = {rv[i].x, rv[i].y, rv[i].z, rv[i].w};
#pragma unroll
    for (int w = 0; w < 4; ++w) {
      const h2_t p0 = __builtin_amdgcn_cvt_scalef32_pk_f16_fp8((int)vw[w], rsc[i].y, false);
      const h2_t p1 = __builtin_amdgcn_cvt_scalef32_pk_f16_fp8((int)vw[w], rsc[i].y, true);
      acc[2 * w] = __builtin_elementwise_fma(p0, hh, acc[2 * w]);
      acc[2 * w + 1] = __builtin_elementwise_fma(p1, hh, acc[2 * w + 1]);
    }
  }
}

__device__ __forceinline__ void o_peer_experts7_tile(const Params& p, int l, int t0, const char* smem, int tid, bool dry = false) {
  const int wave = __builtin_amdgcn_readfirstlane(tid >> 6), lane = tid & 63;
  const unsigned char* U8 = p.u8 + (size_t)l * 16384 * 1024;
  const unsigned char* V8 = p.v8 + (size_t)l * 16384 * 1024;
  const float2* ES = p.escale + (size_t)l * 16384;
  int vz = 0;
  asm volatile("" : "+v"(vz));
  const int s0 = ((int)(__builtin_amdgcn_s_getreg((3 << 11) | 20) & 0xF) * (EX6_NSLICE / 8)) & (EX6_NSLICE - 1);
  unsigned pk[8][2];
  h2_t acc[8][8];
#pragma unroll
  for (int k = 0; k < 8; ++k) {
    const size_t base = (size_t)(t0 + wave * 8 + k) * 128 + lane + vz;
#pragma unroll
    for (int hf = 0; hf < 2; ++hf) pk[k][hf] = (unsigned)p.pidx[base + hf * 64] | ((unsigned)f2bf(p.pgate[base + hf * 64]) << 16);
#pragma unroll
    for (int i = 0; i < 8; ++i) acc[k][i] = (h2_t){(_Float16)0.f, (_Float16)0.f};
  }
#pragma unroll 1
  for (int si = 0; si < EX6_NSLICE; ++si) {
    const unsigned s = (unsigned)((s0 + si) & (EX6_NSLICE - 1));
#pragma unroll
    for (int k = 0; k < 8; ++k) {
      unsigned long long m0 = __ballot(((pk[k][0] & 0x3fffu) >> EX6_SHIFT) == s);
      unsigned long long m1 = __ballot(((pk[k][1] & 0x3fffu) >> EX6_SHIFT) == s);
      if ((m0 | m1) == 0ull) continue;
      unsigned hw[8];
      {
        const char* xr = smem + (wave * 8 + k) * LDXB + lane * 32;
        const uint4 h0 = *(const uint4*)xr, h1 = *(const uint4*)(xr + 16);
        hw[0] = h0.x; hw[1] = h0.y; hw[2] = h0.z; hw[3] = h0.w; hw[4] = h1.x; hw[5] = h1.y; hw[6] = h1.z; hw[7] = h1.w;
      }
      uint4 uA[4], vA[4], uB[4], vB[4];
      float2 scA[4], scB[4];
      float gA[4], gB[4];
      int e[4]; float g[4];
      ex7_pop(m0, m1, pk[k][0], pk[k][1], e, g);
      EX7_ISSUE(uA, vA, scA, gA)
      for (;;) {
        const bool mb = (m0 | m1) != 0ull;
        if (mb) { ex7_pop(m0, m1, pk[k][0], pk[k][1], e, g); EX7_ISSUE(uB, vB, scB, gB) }
        ex7_compute(uA, vA, scA, gA, hw, acc[k], lane);
        if (!mb) break;
        const bool ma = (m0 | m1) != 0ull;
        if (ma) { ex7_pop(m0, m1, pk[k][0], pk[k][1], e, g); EX7_ISSUE(uA, vA, scA, gA) }
        ex7_compute(uB, vB, scB, gB, hw, acc[k], lane);
        if (!ma) break;
      }
    }
  }
  if (dry) {
#pragma unroll
    for (int k = 0; k < 8; ++k)
#pragma unroll
      for (int i = 0; i < 8; ++i) asm volatile("" :: "v"(acc[k][i]));
    return;
  }
#pragma unroll
  for (int k = 0; k < 8; ++k) {
    float* xr = p.xres + (size_t)(t0 + wave * 8 + k) * 1024 + lane * 16;
#pragma unroll
    for (int i = 0; i < 4; ++i) {
      float4 a0 = *(float4*)(xr + 4 * i);
      a0.x += (float)acc[k][2 * i][0]; a0.y += (float)acc[k][2 * i][1];
      a0.z += (float)acc[k][2 * i + 1][0]; a0.w += (float)acc[k][2 * i + 1][1];
      *(float4*)(xr + 4 * i) = a0;
    }
  }
}

#define XB_TMO      128
#define XB_XCNT(j)  (256  + 64 * (j))
#define XB_XSUB(j)  (1280 + 64 * (j))
#define XB_XGEN(j)  (2304 + 64 * (j))
#define XB_TOP      3328
#define XB_TOPGEN   3392
#define XCD_BAR_WORDS 3456
#define XB_SPIN_CAP (1u << 22)
#define LAS __attribute__((address_space(3)))
__device__ __forceinline__ unsigned xb_ld(unsigned* p)              { return __hip_atomic_load(p, __ATOMIC_RELAXED, __HIP_MEMORY_SCOPE_AGENT); }
__device__ __forceinline__ unsigned xb_add(unsigned* p, unsigned v) { return __hip_atomic_fetch_add(p, v, __ATOMIC_RELAXED, __HIP_MEMORY_SCOPE_AGENT); }
__device__ __forceinline__ unsigned xb_xcc_id() { return (unsigned)__builtin_amdgcn_s_getreg((3 << 11) | 20) & 0xFu; }
#define XB_SPIN(cond, bar) do { unsigned _sp = 0; while (cond) { __builtin_amdgcn_s_sleep(1); \
    if ((++_sp & 255u) == 0u) { if (xb_ld(&(bar)[XB_TMO])) break; if (_sp > XB_SPIN_CAP) { atomicAdd(&(bar)[XB_TMO], 1u); break; } } } } while (0)
struct XcdBarrier { unsigned* bar; unsigned x; volatile LAS unsigned* st; };
__device__ __forceinline__ XcdBarrier xcd_barrier_post(unsigned* bar, volatile LAS unsigned* st, int tid) {
  XcdBarrier b; b.bar = bar; b.x = xb_xcc_id(); b.st = st;
  if (tid == 0) (void)xb_add(&bar[XB_XCNT(b.x)], 1u);
  return b;
}
__device__ __forceinline__ void xcd_barrier_complete(unsigned* bar, unsigned x, unsigned& nloc, unsigned& nx) {
  const unsigned G = gridDim.x * gridDim.y * gridDim.z;
  unsigned sum, cnt, mine, sp = 0u;
  for (;;) {
    sum = 0u; cnt = 0u; mine = 0u;
#pragma unroll
    for (unsigned j = 0; j < 16; ++j) { const unsigned c = xb_ld(&bar[XB_XCNT(j)]); sum += c; cnt += (c > 0u) ? 1u : 0u; mine = (j == x) ? c : mine; }
    if (sum == G) break;
    __builtin_amdgcn_s_sleep(1);
    if ((++sp & 255u) == 0u) { if (xb_ld(&bar[XB_TMO])) break; if (sp > XB_SPIN_CAP) { atomicAdd(&bar[XB_TMO], 1u); break; } }
  }
  nloc = mine > 0u ? mine : 1u; nx = cnt > 0u ? cnt : 1u;
}
__device__ __forceinline__ void xcd_barrier(const XcdBarrier& b, int tid) {
  asm volatile("s_waitcnt vmcnt(0)" ::: "memory");
  __syncthreads();
  if (tid == 0) {
    unsigned* bar = b.bar;
    __builtin_amdgcn_s_waitcnt(0);
    unsigned nloc = b.st[0], nx = b.st[1];
    if (nloc == 0u) { xcd_barrier_complete(bar, b.x, nloc, nx); b.st[0] = nloc; b.st[1] = nx; }
    const unsigned old = xb_add(&bar[XB_XSUB(b.x)], 1u);
    const unsigned gen = old / nloc;
    if (old + 1u == (gen + 1u) * nloc) {
      __builtin_amdgcn_fence(__ATOMIC_RELEASE, "agent");
      asm volatile("s_waitcnt vmcnt(0)" ::: "memory");
      const unsigned og = xb_add(&bar[XB_TOP], 1u);
      const unsigned tg = og / nx;
      if (og + 1u == (tg + 1u) * nx) xb_add(&bar[XB_TOPGEN], 1u);
      else XB_SPIN(xb_ld(&bar[XB_TOPGEN]) == tg, bar);
      __builtin_amdgcn_fence(__ATOMIC_ACQUIRE, "agent");
      xb_add(&bar[XB_XGEN(b.x)], 1u);
      asm volatile("s_waitcnt vmcnt(0)" ::: "memory");
    } else {
      XB_SPIN(xb_ld(&bar[XB_XGEN(b.x)]) == gen, bar);
      __builtin_amdgcn_fence(__ATOMIC_ACQUIRE, "agent");
      asm volatile("s_waitcnt vmcnt(0)" ::: "memory");
    }
  }
  __syncthreads();
}


__global__ void __launch_bounds__(NTHREADS) fwd_megakernel(Params p) {
  cg::grid_group grid = cg::this_grid();
  extern __shared__ __attribute__((aligned(16))) float smem[];
  const int wv_ = __builtin_amdgcn_readfirstlane((int)(threadIdx.x >> 6));
  volatile LAS unsigned* xb_st = (volatile LAS unsigned*)((LAS char*)(LAS float*)smem + (160 * 1024 - 16));
  if (threadIdx.x == 0) { xb_st[0] = 0u; xb_st[1] = 0u; }
  __syncthreads();
  const XcdBarrier xb = xcd_barrier_post(p.bar, xb_st, (int)threadIdx.x);
#define GRID_BARRIER() xcd_barrier(xb, opaque_tid(wv_))

  o_prep(wv_, p, smem);
  if (gridDim.x > 4096u) grid.sync();
  GRID_BARRIER();
#pragma unroll 1
  for (int l = 0; l < DEPTH; ++l) {
    const float* xcur = (l == 0) ? p.x_in : p.xres;
    o_p1(wv_, p, l, xcur, (char*)smem);
    GRID_BARRIER();
    {
    {
      const int bidx_ = opaque_bid();
      const bool affine = (gridDim.x == 256u);
      for (int task = bidx_; task < 1792; task += gridDim.x) {
        const int l_ = opaque_s(l), td_ = opaque_tid(wv_);
        int tk = task;
        if (affine) {
          const int x = bidx_ & 7, lb = bidx_ >> 3, j = task >> 8;
          if (j < 4) { const int idx = lb + 32 * j; tk = ((x * 2 + (idx >> 6)) << 6) | (idx & 63); }
          else if (j < 6) { const int idx = lb + 32 * (j - 4); tk = 1024 + (((x * 2 + (idx >> 5)) << 5) | (idx & 31)); }
          else tk = 1536 + x * 32 + lb;
        }
        const int tk_ = opaque_s(tk);
        if (tk_ < 1024) o_na_task(p, l_, tk_, (char*)smem, td_);
        else if (tk_ < 1536) o_ret_kv_task(p, l_, tk_ - 1024, (char*)smem, td_);
        else o_pool_task(p, l_, tk_ - 1536, (char*)smem, td_);
      }
    }
    GRID_BARRIER();
    o_ret_scan(wv_, p, l);
    GRID_BARRIER();
    {
      const int tidx_ = opaque_tid(wv_); const int bidx_ = opaque_bid();
      for (int task = bidx_; task < 512; task += gridDim.x) {
        int tk = task;
        if (gridDim.x == 256u) {
          const int x = bidx_ & 7, lb = bidx_ >> 3, idx = lb + 32 * (task >> 8);
          tk = ((x * 2 + (idx >> 5)) << 5) | (idx & 31);
        }
        o_ret_out_task(p, l, opaque_s(tk), (char*)smem, tidx_);
      }
    }
    GRID_BARRIER();
    }
    {
      const int tidx_ = opaque_tid(wv_); const int bidx_ = opaque_bid();
      for (int tile = bidx_; tile < NTOK / 64; tile += gridDim.x) {
        { const int t0_ = opaque_s(tile * 64), l_ = opaque_s(l), td_ = opaque_tid(wv_); o_p5a1_tile(p, l_, t0_, (char*)smem, td_); }
        { const int t0_ = opaque_s(tile * 64), l_ = opaque_s(l), td_ = opaque_tid(wv_); o_p5a2_tile(p, l_, xcur, t0_, (char*)smem, td_); }
        { const int t0_ = opaque_s(tile * 64), l_ = opaque_s(l), td_ = opaque_tid(wv_); o_p5a3_tile(p, l_, t0_, (char*)smem, td_); }
        { const int t0_ = opaque_s(tile * 64), l_ = opaque_s(l), td_ = opaque_tid(wv_); o_peer_select_tile(p, l_, t0_, (char*)smem, td_); }
        { const int t0_ = opaque_s(tile * 64), l_ = opaque_s(l), td_ = opaque_tid(wv_); o_peer_select2_tile(p, l_, t0_, td_); }
        asm volatile("s_waitcnt vmcnt(0)" ::: "memory");
        __syncthreads();
        { const int t0_ = opaque_s(tile * 64), l_ = opaque_s(l), td_ = opaque_tid(wv_); o_peer_experts7_tile(p, l_, t0_, (const char*)smem, td_); }
        if (l + 1 == DEPTH) {
          asm volatile("s_waitcnt vmcnt(0)" ::: "memory");
          const int t0_ = opaque_s(tile * 64), td_ = opaque_tid(wv_);
          o_final_norm_tile(p, t0_, td_);
        }
      }
    }
    if (l + 1 < DEPTH) GRID_BARRIER();
  }
}

extern "C" void kernel_launch(void* const* d_in, const int* in_sizes, int n_in, void* d_out, int out_size,
                              void* d_ws, size_t ws_size, hipStream_t stream) {
  Params p{};
  p.x_in = (const float*)d_in[0]; p.norm_mix = (const float*)d_in[1]; p.w_in = (const float*)d_in[2];
  p.pool_w = (const float*)d_in[3]; p.pool_scale = (const float*)d_in[4]; p.ret_decay = (const float*)d_in[5];
  p.na_rpb = (const float*)d_in[6]; p.w_br_pool = (const float*)d_in[7]; p.w_br_ret = (const float*)d_in[8];
  p.w_br_na = (const float*)d_in[9]; p.w_out = (const float*)d_in[10]; p.norm_ffn = (const float*)d_in[11];
  p.w_query = (const float*)d_in[12]; p.sub_keys = (const float*)d_in[13]; p.peer_u = (const float*)d_in[14];
  p.peer_v = (const float*)d_in[15]; p.norm_final = (const float*)d_in[16];
  p.out = (float*)d_out;
  char* ws = (char*)d_ws;
  size_t off = 0;
  auto alloc = [&](size_t bytes) { char* q = ws + off; off += (bytes + 255) & ~(size_t)255; return q; };
  p.xres = (float*)alloc((size_t)NTOK * D_MODEL * 4);
  p.proj = (bf16_t*)alloc((size_t)NTOK * IN_WIDTH * 2);
  p.ycat = (bf16_t*)alloc((size_t)NTOK * 1024 * 2);
  p.mrg = (bf16_t*)alloc((size_t)NTOK * 1024 * 2);
  p.pidx = (int*)alloc((size_t)NTOK * 128 * 4);
  p.pgate = (float*)alloc((size_t)NTOK * 128 * 4);
  p.wf_in = (bf16_t*)alloc((size_t)DEPTH * D_MODEL * IN_WIDTH * 2);
  p.wf_br = (bf16_t*)alloc((size_t)DEPTH * 1024 * 1024 * 2);
  p.wf_out = (bf16_t*)alloc((size_t)DEPTH * 1024 * 1024 * 2);
  p.wf_q = (bf16_t*)alloc((size_t)DEPTH * 1024 * 2048 * 2);
  p.kf = (bf16_t*)alloc((size_t)DEPTH * 2 * 128 * 128 * 2);
  p.u16 = nullptr; p.v16 = nullptr;
  p.u8 = (unsigned char*)alloc((size_t)DEPTH * 16384 * 1024);
  p.v8 = (unsigned char*)alloc((size_t)DEPTH * 16384 * 1024);
  p.escale = (float2*)alloc((size_t)DEPTH * 16384 * 8);
  p.rope = (float2*)alloc((size_t)SEQ * 32 * 8);
  p.tklist = (unsigned*)alloc((size_t)NTOK * 8 * 2 * 16 * 4);
  p.kvst = (float*)p.mrg;
  p.rstate = (bf16_t*)p.tklist;
  p.bar = (unsigned*)alloc(XCD_BAR_WORDS * 4);
  p.xn = nullptr; p.merged = nullptr; p.pq = nullptr; p.psc = nullptr;
  if (off > ws_size) fprintf(stderr, "WORKSPACE OVERFLOW: need %zu have %zu\n", off, ws_size);

  const size_t kDynLds = 160 * 1024;
  static int grid_blocks = 0;
  if (!grid_blocks) {
    int dev = 0, cus = 0, per_cu = 0;
    (void)hipGetDevice(&dev);
    (void)hipDeviceGetAttribute(&cus, hipDeviceAttributeMultiprocessorCount, dev);
    (void)hipFuncSetAttribute((const void*)fwd_megakernel, hipFuncAttributeMaxDynamicSharedMemorySize, (int)kDynLds);
    (void)hipOccupancyMaxActiveBlocksPerMultiprocessor(&per_cu, fwd_megakernel, NTHREADS, kDynLds);
    if (per_cu < 1) per_cu = 1;
    grid_blocks = cus * per_cu;
  }
  (void)hipMemsetAsync(p.bar, 0, XCD_BAR_WORDS * 4, stream);
  void* args[] = {&p};
  hipError_t e = hipLaunchCooperativeKernel((void*)fwd_megakernel, dim3(grid_blocks), dim3(NTHREADS), args, kDynLds, stream);
  if (e != hipSuccess) fprintf(stderr, "cooperative launch failed: %s (grid %d)\n", hipGetErrorString(e), grid_blocks);
}
```

```cpp
#include <hip/hip_runtime.h>
#include <hip/hip_cooperative_groups.h>
#include <stdint.h>
#include <cstdio>
namespace cg = cooperative_groups;

#define D_MODEL 1024
#define SEQ 4096
#define BATCH 4
#define NTOK (BATCH * SEQ)
#define DEPTH 2
#define IN_WIDTH 5632
#define C_POOL 0
#define C_RQ 256
#define C_RK 512
#define C_RV 768
#define C_RG 1280
#define C_NQ 1792
#define C_NK 2048
#define C_NV 2304
#define C_GATE 2560
#define EPS 1e-6f
#define NTHREADS 512

typedef unsigned short bf16_t;

struct Params {
  const float* x_in; const float* norm_mix; const float* w_in; const float* pool_w; const float* pool_scale;
  const float* ret_decay; const float* na_rpb; const float* w_br_pool; const float* w_br_ret; const float* w_br_na;
  const float* w_out; const float* norm_ffn; const float* w_query; const float* sub_keys; const float* peer_u;
  const float* peer_v; const float* norm_final;
  float* out;
  float* xres;
  bf16_t* xn;
  bf16_t* proj;
  bf16_t* ycat;
  float* merged;
  float* pq;
  float* psc;
  int* pidx;
  float* pgate;
  bf16_t* wf_in;
  bf16_t* wf_br;
  bf16_t* wf_out;
  bf16_t* wf_q;
  bf16_t* kf;
  bf16_t* u16;
  bf16_t* v16;
  float2* rope;
  bf16_t* mrg;
  unsigned* tklist;
  float* kvst;
  bf16_t* rstate;
  unsigned* bar;
  unsigned char* u8; unsigned char* v8;
  float2* escale;
};

__device__ __forceinline__ bf16_t f2bf(float f) {
  unsigned u = __float_as_uint(f);
  u += 0x7fffu + ((u >> 16) & 1u);
  return (bf16_t)(u >> 16);
}
__device__ __forceinline__ float bf2f(bf16_t h) { return __uint_as_float(((unsigned)h) << 16); }

__device__ __forceinline__ float wave_sum(float v) {
#pragma unroll
  for (int o = 32; o > 0; o >>= 1) v += __shfl_xor(v, o, 64);
  return v;
}
__device__ __forceinline__ float wave_max(float v) {
#pragma unroll
  for (int o = 32; o > 0; o >>= 1) v = fmaxf(v, __shfl_xor(v, o, 64));
  return v;
}
__device__ __forceinline__ float sigmoidf_(float x) { return 1.0f / (1.0f + expf(-x)); }

__device__ __forceinline__ int opaque_tid(int wv) {
  int w = wv;
  asm volatile("" : "+s"(w));
  int lane = __builtin_amdgcn_mbcnt_hi(~0u, __builtin_amdgcn_mbcnt_lo(~0u, 0u));
  asm volatile("" : "+v"(lane));
  return w * 64 + lane;
}
__device__ __forceinline__ int opaque_s(int x) { asm volatile("" : "+s"(x)); return x; }
__device__ __forceinline__ int opaque_bid() { int b = blockIdx.x; asm volatile("" : "+s"(b)); return b; }

template <bool OUT_F32>
__device__ __forceinline__ void n_rmsnorm(const int wv_, const float* __restrict__ x, const float* __restrict__ g, void* outp, int rows) {
  const int tidx_ = opaque_tid(wv_); const int bidx_ = opaque_bid();
  const int lane = tidx_ & 63;
  const int nw = gridDim.x * (NTHREADS / 64);
  for (int row = bidx_ * (NTHREADS / 64) + (tidx_ >> 6); row < rows; row += nw) {
    const float* xr = x + (size_t)row * D_MODEL;
    float4 v[4];
    float ss = 0.f;
#pragma unroll
    for (int i = 0; i < 4; ++i) {
      v[i] = *(const float4*)(xr + i * 256 + lane * 4);
      ss += v[i].x * v[i].x + v[i].y * v[i].y + v[i].z * v[i].z + v[i].w * v[i].w;
    }
    ss = wave_sum(ss);
    float r = rsqrtf(ss * (1.0f / D_MODEL) + EPS);
#pragma unroll
    for (int i = 0; i < 4; ++i) {
      float4 gg = *(const float4*)(g + i * 256 + lane * 4);
      float o0 = v[i].x * r * gg.x, o1 = v[i].y * r * gg.y, o2 = v[i].z * r * gg.z, o3 = v[i].w * r * gg.w;
      if (OUT_F32) {
        *(float4*)((float*)outp + (size_t)row * D_MODEL + i * 256 + lane * 4) = make_float4(o0, o1, o2, o3);
      } else {
        ushort4 o; o.x = f2bf(o0); o.y = f2bf(o1); o.z = f2bf(o2); o.w = f2bf(o3);
        *(ushort4*)((bf16_t*)outp + (size_t)row * D_MODEL + i * 256 + lane * 4) = o;
      }
    }
  }
}

typedef __attribute__((ext_vector_type(8))) short bf16x8;
typedef __attribute__((ext_vector_type(4))) float f32x4;
#define LDX 1032
#define LDXB (LDX * 2)
#define XTILE_BYTES (64 * LDXB)

__device__ __forceinline__ unsigned pack2bf(float a, float b) { return (unsigned)f2bf(a) | ((unsigned)f2bf(b) << 16); }

__device__ __forceinline__ void prep_frag(const int wv_, const float* __restrict__ W, int K, int N, bf16_t* __restrict__ dst, float* smem) {
  const int tidx_ = opaque_tid(wv_); const int bidx_ = opaque_bid();
  const int grp = tidx_ >> 8, tid = tidx_ & 255;
  float(*T)[65] = (float(*)[65])(smem + grp * 32 * 65);
  const int KS = K / 32, NC = N / 64;
  const int ntiles = KS * NC;
  for (int wb = bidx_ * 2; wb < ntiles; wb += gridDim.x * 2) {
    const int w = wb + grp;
    const int c = w / KS, ks = w - c * KS;
    {
      const int row = tid >> 3, col = (tid & 7) * 8;
      const float* src = W + (size_t)(ks * 32 + row) * N + c * 64 + col;
      float4 a = *(const float4*)src, b = *(const float4*)(src + 4);
      __syncthreads();
      T[row][col + 0] = a.x; T[row][col + 1] = a.y; T[row][col + 2] = a.z; T[row][col + 3] = a.w;
      T[row][col + 4] = b.x; T[row][col + 5] = b.y; T[row][col + 6] = b.z; T[row][col + 7] = b.w;
    }
    __syncthreads();
    {
      const int nt = tid >> 6, lane = tid & 63;
      const int kr = 8 * (lane >> 4), nc = nt * 16 + (lane & 15);
      uint4 o;
      o.x = pack2bf(T[kr + 0][nc], T[kr + 1][nc]);
      o.y = pack2bf(T[kr + 2][nc], T[kr + 3][nc]);
      o.z = pack2bf(T[kr + 4][nc], T[kr + 5][nc]);
      o.w = pack2bf(T[kr + 6][nc], T[kr + 7][nc]);
      *(uint4*)(dst + ((size_t)((c * KS + ks) * 4 + nt) * 64 + lane) * 8) = o;
    }
  }
}

__device__ __forceinline__ void o_prep(const int wv_, const Params& p, float* smem) {
  for (int l = 0; l < DEPTH; ++l) {
    prep_frag(wv_, p.w_in + (size_t)l * D_MODEL * IN_WIDTH, D_MODEL, IN_WIDTH, p.wf_in + (size_t)l * D_MODEL * IN_WIDTH, smem);
    prep_frag(wv_, p.w_br_pool + (size_t)l * 256 * 1024, 256, 1024, p.wf_br + (size_t)l * 1024 * 1024, smem);
    prep_frag(wv_, p.w_br_ret + (size_t)l * 512 * 1024, 512, 1024, p.wf_br + (size_t)l * 1024 * 1024 + 256 * 1024, smem);
    prep_frag(wv_, p.w_br_na + (size_t)l * 256 * 1024, 256, 1024, p.wf_br + (size_t)l * 1024 * 1024 + 768 * 1024, smem);
    prep_frag(wv_, p.w_out + (size_t)l * 1024 * 1024, 1024, 1024, p.wf_out + (size_t)l * 1024 * 1024, smem);
    prep_frag(wv_, p.w_query + (size_t)l * 1024 * 2048, 1024, 2048, p.wf_q + (size_t)l * 1024 * 2048, smem);
  }
  const int tidx_ = opaque_tid(wv_); const int bidx_ = opaque_bid();
  const int gtid = bidx_ * NTHREADS + tidx_, gsz = gridDim.x * NTHREADS;
  for (int u = gtid; u < DEPTH * 2 * 8 * 4 * 64; u += gsz) {
    const int lane = u & 63, s2 = (u >> 6) & 3, kt = (u >> 8) & 7, lp = u >> 11;
    const float* kr = p.sub_keys + ((size_t)lp * 128 + kt * 16 + (lane & 15)) * 128;
    float v[8];
#pragma unroll
    for (int j = 0; j < 8; ++j) v[j] = kr[16 * (2 * s2 + (j >> 2)) + 4 * (lane >> 4) + (j & 3)];
    uint4 o;
    o.x = pack2bf(v[0], v[1]); o.y = pack2bf(v[2], v[3]); o.z = pack2bf(v[4], v[5]); o.w = pack2bf(v[6], v[7]);
    *(uint4*)(p.kf + (size_t)u * 8) = o;
  }
  {
    const int lane = tidx_ & 63;
    const int gw = (bidx_ * NTHREADS + tidx_) >> 6, nw = gsz >> 6;
    for (int row = gw; row < DEPTH * 16384 * 2; row += nw) {
      const int tbl = row & 1, er = row >> 1;
      const float* src = (tbl ? p.peer_v : p.peer_u) + (size_t)er * 1024 + lane * 16;
      float4 f[4];
#pragma unroll
      for (int i = 0; i < 4; ++i) f[i] = *(const float4*)(src + 4 * i);
      float m = 0.f;
#pragma unroll
      for (int i = 0; i < 4; ++i) m = fmaxf(m, fmaxf(fmaxf(fabsf(f[i].x), fabsf(f[i].y)), fmaxf(fabsf(f[i].z), fabsf(f[i].w))));
      m = wave_max(m);
      int k = 0;
      if (m > 0.f) {
        int e;
        const float fr = __builtin_frexpf(m, &e);
        k = ((fr <= 0.875f) ? 9 : 8) - e;
        k = k < -100 ? -100 : (k > 100 ? 100 : k);
      }
      const float sc = __builtin_ldexpf(1.0f, k);
      uint4 o;
      unsigned w[4];
#pragma unroll
      for (int i = 0; i < 4; ++i) {
        int pkd = 0;
        pkd = __builtin_amdgcn_cvt_pk_fp8_f32(f[i].x * sc, f[i].y * sc, pkd, false);
        pkd = __builtin_amdgcn_cvt_pk_fp8_f32(f[i].z * sc, f[i].w * sc, pkd, true);
        w[i] = (unsigned)pkd;
      }
      o.x = w[0]; o.y = w[1]; o.z = w[2]; o.w = w[3];
      *(uint4*)((tbl ? p.v8 : p.u8) + (size_t)er * 1024 + lane * 16) = o;
      if (lane == 0) ((float*)p.escale)[(size_t)er * 2 + tbl] = __builtin_ldexpf(1.0f, -k);
    }
  }
  for (int u = gtid; u < SEQ * 32; u += gsz) {
    const int i = u & 31, pos = u >> 5;
    float inv = 1.0f / powf(10000.0f, (float)i / 31.0f);
    float ang = (float)pos * inv;
    double rev = (double)ang * 0.15915494309189535;
    rev -= floor(rev);
    float rf = (float)rev;
    p.rope[u] = make_float2(__builtin_amdgcn_cosf(rf), __builtin_amdgcn_sinf(rf));
  }
}

template <int NT, int PD, int RING>
__device__ __forceinline__ void tl_gemm_prologue(const bf16_t* __restrict__ wf, bf16x8 (&wb)[RING][NT], const int lane, const int nt0 = 0) {
  const bf16x8* wp = (const bf16x8*)wf + lane + nt0 * 64;
#pragma unroll
  for (int s = 0; s < PD; ++s)
#pragma unroll
    for (int nt = 0; nt < NT; ++nt) wb[s][nt] = wp[(s * 4 + nt) * 64];
}
template <int NT, int PD, int RING>
__device__ __forceinline__ void tl_gemm_main(const bf16_t* __restrict__ wf, const int KS, const char* xt, const int kbyte0,
                                             f32x4 (&acc)[NT][4], bf16x8 (&wb)[RING][NT], const int lane, const int nt0 = 0) {
  const bf16x8* wp = (const bf16x8*)wf + lane + nt0 * 64;
  const char* xp = xt + (lane & 15) * LDXB + kbyte0 + (lane >> 4) * 16;
  for (int ks = 0; ks < KS; ks += RING) {
#pragma unroll
    for (int u = 0; u < RING; ++u) {
      int kpre = ks + u + PD;
      kpre = kpre < KS ? kpre : KS - 1;
#pragma unroll
      for (int nt = 0; nt < NT; ++nt) wb[(u + PD) % RING][nt] = wp[(kpre * 4 + nt) * 64];
      bf16x8 xf[4];
#pragma unroll
      for (int mt = 0; mt < 4; ++mt) xf[mt] = *(const bf16x8*)(xp + mt * 16 * LDXB + (ks + u) * 64);
      __builtin_amdgcn_s_setprio(1);
#pragma unroll
      for (int nt = 0; nt < NT; ++nt)
#pragma unroll
        for (int mt = 0; mt < 4; ++mt)
          acc[nt][mt] = __builtin_amdgcn_mfma_f32_16x16x32_bf16(wb[u][nt], xf[mt], acc[nt][mt], 0, 0, 0);
      __builtin_amdgcn_s_setprio(0);
    }
  }
}
template <int NT, int PD = 3, int RING = 4>
__device__ __forceinline__ void tl_gemm_chunk(const bf16_t* __restrict__ wf, const int KS, const char* xt, const int kbyte0,
                                              f32x4 (&acc)[NT][4], const int lane, const int nt0 = 0) {
  bf16x8 wb[RING][NT];
  tl_gemm_prologue<NT, PD, RING>(wf, wb, lane, nt0);
  tl_gemm_main<NT, PD, RING>(wf, KS, xt, kbyte0, acc, wb, lane, nt0);
}

__device__ __forceinline__ void tile_rmsnorm_to_lds(const float* __restrict__ xsrc, const float* __restrict__ g, int t0,
                                                    char* xt, int wave, int lane) {
#pragma unroll 2
  for (int i = 0; i < 8; ++i) {
    const int tok = wave * 8 + i;
    const float* xr = xsrc + (size_t)(t0 + tok) * D_MODEL;
    float4 v[4];
    float ss = 0.f;
#pragma unroll
    for (int q = 0; q < 4; ++q) {
      v[q] = *(const float4*)(xr + q * 256 + lane * 4);
      ss += v[q].x * v[q].x + v[q].y * v[q].y + v[q].z * v[q].z + v[q].w * v[q].w;
    }
    ss = wave_sum(ss);
    const float r = rsqrtf(ss * (1.0f / D_MODEL) + EPS);
#pragma unroll
    for (int q = 0; q < 4; ++q) {
      float4 gg = *(const float4*)(g + q * 256 + lane * 4);
      uint2 o;
      o.x = pack2bf(v[q].x * r * gg.x, v[q].y * r * gg.y);
      o.y = pack2bf(v[q].z * r * gg.z, v[q].w * r * gg.w);
      *(uint2*)(xt + tok * LDXB + (q * 256 + lane * 4) * 2) = o;
    }
  }
}

__device__ __forceinline__ void o_p1(const int wv_, const Params& p, int l, const float* __restrict__ xsrc, char* smem) {
  const int tidx_ = opaque_tid(wv_); const int bidx_ = opaque_bid();
  const int wave = tidx_ >> 6, lane = tidx_ & 63;
  const bf16_t* wf = p.wf_in + (size_t)l * D_MODEL * IN_WIDTH;
  const float* g = p.norm_mix + l * D_MODEL;
  for (int tile = bidx_; tile < NTOK / 64; tile += gridDim.x) {
    const int t0 = tile * 64;
    __syncthreads();
    tile_rmsnorm_to_lds(xsrc, g, t0, smem, wave, lane);
    __syncthreads();
#pragma unroll 1
    for (int c = wave; c < IN_WIDTH / 64; c += 8) {
      f32x4 acc[4][4];
#pragma unroll
      for (int a = 0; a < 4; ++a)
#pragma unroll
        for (int b = 0; b < 4; ++b) acc[a][b] = (f32x4){0.f, 0.f, 0.f, 0.f};
      tl_gemm_chunk<4, 3, 4>(wf + (size_t)c * 32 * 4 * 64 * 8, 32, smem, 0, acc, lane);
      asm volatile("" ::: "memory");
      if (c >= 4 && c < 12) {
        const float sc = (c >= 8) ? 0.125f : 1.0f;
#pragma unroll
        for (int mt = 0; mt < 4; ++mt) {
          const int tok = t0 + mt * 16 + (lane & 15);
          const int pos = tok & (SEQ - 1);
#pragma unroll
          for (int nt = 0; nt < 2; ++nt) {
            const int i0 = nt * 16 + 4 * (lane >> 4);
            const float4 cs01 = *(const float4*)(p.rope + pos * 32 + i0);
            const float4 cs23 = *(const float4*)(p.rope + pos * 32 + i0 + 2);
            const float cc[4] = {cs01.x, cs01.z, cs23.x, cs23.z};
            const float sn[4] = {cs01.y, cs01.w, cs23.y, cs23.w};
#pragma unroll
            for (int r = 0; r < 4; ++r) {
              const float x1 = acc[nt][mt][r], x2 = acc[nt + 2][mt][r];
              acc[nt][mt][r] = (x1 * cc[r] - x2 * sn[r]) * sc;
              acc[nt + 2][mt][r] = (x1 * sn[r] + x2 * cc[r]) * sc;
            }
          }
        }
      } else if (c >= 28 && c < 32) {
#pragma unroll
        for (int a = 0; a < 4; ++a)
#pragma unroll
          for (int b = 0; b < 4; ++b) acc[a][b] *= 0.125f;
      } else if (c >= 40) {
#pragma unroll
        for (int a = 0; a < 4; ++a)
#pragma unroll
          for (int b = 0; b < 4; ++b)
#pragma unroll
            for (int r = 0; r < 4; ++r) acc[a][b][r] = 1.0f / (1.0f + __expf(-acc[a][b][r]));
      }
      {
        char* patch = smem + XTILE_BYTES + wave * 2304;
#pragma unroll
        for (int mt = 0; mt < 4; ++mt) {
#pragma unroll
          for (int nt = 0; nt < 4; ++nt) {
            uint2 o;
            o.x = pack2bf(acc[nt][mt][0], acc[nt][mt][1]);
            o.y = pack2bf(acc[nt][mt][2], acc[nt][mt][3]);
            *(uint2*)(patch + (lane & 15) * 144 + (nt * 16 + 4 * (lane >> 4)) * 2) = o;
          }
#pragma unroll
          for (int h = 0; h < 2; ++h) {
            const int row = h * 8 + (lane >> 3), unit = lane & 7;
            const uint4 v = *(const uint4*)(patch + row * 144 + unit * 16);
            *(uint4*)(p.proj + (size_t)(t0 + mt * 16 + row) * IN_WIDTH + c * 64 + unit * 8) = v;
          }
        }
      }
    }
  }
}


__device__ __forceinline__ void o_final_norm_tile(const Params& p, int t0, int tid) {
  const int wave = tid >> 6, lane = tid & 63;
#pragma unroll 2
  for (int i = 0; i < 8; ++i) {
    const size_t row = (size_t)(t0 + wave * 8 + i) * D_MODEL;
    float4 v[4];
    float ss = 0.f;
#pragma unroll
    for (int q = 0; q < 4; ++q) {
      v[q] = *(const float4*)(p.xres + row + q * 256 + lane * 4);
      ss += v[q].x * v[q].x + v[q].y * v[q].y + v[q].z * v[q].z + v[q].w * v[q].w;
    }
    ss = wave_sum(ss);
    const float r = rsqrtf(ss * (1.0f / D_MODEL) + EPS);
#pragma unroll
    for (int q = 0; q < 4; ++q) {
      const float4 gg = *(const float4*)(p.norm_final + q * 256 + lane * 4);
      *(float4*)(p.out + row + q * 256 + lane * 4) = make_float4(v[q].x * r * gg.x, v[q].y * r * gg.y, v[q].z * r * gg.z, v[q].w * r * gg.w);
    }
  }
}

__device__ __forceinline__ void tile_load_to_lds(const bf16_t* __restrict__ src, int ld, char* xt, int tid) {
#pragma unroll 4
  for (int it = 0; it < 16; ++it) {
    const int idx = it * NTHREADS + tid;
    const int row = idx >> 7, u = idx & 127;
    const uint4 v = *(const uint4*)(src + (size_t)row * ld + u * 8);
    *(uint4*)(xt + row * LDXB + u * 16) = v;
  }
}

__device__ __forceinline__ void o_p5a1_tile(const Params& p, int l, int t0, char* smem, int tid) {
  const int wave = tid >> 6, lane = tid & 63;
  __syncthreads();
  tile_load_to_lds(p.ycat + (size_t)t0 * 1024, 1024, smem, tid);
  __syncthreads();
  const bf16_t* wfb = p.wf_br + (size_t)l * 1024 * 1024;
  bf16x8 wb[4][2];
  f32x4 m[2][4];
  {
    const int c0 = wave >> 1, nt00 = (wave & 1) * 2;
    tl_gemm_prologue<2, 3, 4>(wfb + (size_t)c0 * 8 * 4 * 64 * 8, wb, lane, nt00);
  }
#pragma unroll 1
  for (int it = 0; it < 12; ++it) {
    const int hi = it / 3, br = it - hi * 3;
    const int hc = wave + 8 * hi;
    const int c = hc >> 1, nt0 = (hc & 1) * 2;
    const int koff = (br == 0) ? 0 : (br == 1 ? 256 : 768);
    const int KS = (br == 1) ? 16 : 8;
    uint2 gv[4][2];
#pragma unroll
    for (int mt = 0; mt < 4; ++mt) {
      const int tok = t0 + mt * 16 + (lane & 15);
      const bf16_t* gp = p.proj + (size_t)tok * IN_WIDTH + C_GATE + br * 1024 + c * 64 + nt0 * 16 + 4 * (lane >> 4);
#pragma unroll
      for (int nt = 0; nt < 2; ++nt) gv[mt][nt] = *(const uint2*)(gp + nt * 16);
    }
    f32x4 acc[2][4];
#pragma unroll
    for (int a2 = 0; a2 < 2; ++a2)
#pragma unroll
      for (int b2 = 0; b2 < 4; ++b2) acc[a2][b2] = (f32x4){0.f, 0.f, 0.f, 0.f};
    tl_gemm_main<2, 3, 4>(wfb + (size_t)koff * 1024 + (size_t)c * KS * 4 * 64 * 8, KS, smem, koff * 2, acc, wb, lane, nt0);
    asm volatile("" ::: "memory");
    {
      const int itn = (it + 1 < 12) ? it + 1 : it;
      const int hin = itn / 3, brn = itn - hin * 3;
      const int hcn = wave + 8 * hin;
      const int koffn = (brn == 0) ? 0 : (brn == 1 ? 256 : 768);
      const int KSn = (brn == 1) ? 16 : 8;
      tl_gemm_prologue<2, 3, 4>(wfb + (size_t)koffn * 1024 + (size_t)(hcn >> 1) * KSn * 4 * 64 * 8, wb, lane, (hcn & 1) * 2);
    }
    if (br == 0) {
#pragma unroll
      for (int a2 = 0; a2 < 2; ++a2)
#pragma unroll
        for (int b2 = 0; b2 < 4; ++b2) m[a2][b2] = (f32x4){0.f, 0.f, 0.f, 0.f};
    }
#pragma unroll
    for (int mt = 0; mt < 4; ++mt)
#pragma unroll
      for (int nt = 0; nt < 2; ++nt) {
        m[nt][mt][0] += __uint_as_float(gv[mt][nt].x << 16) * acc[nt][mt][0];
        m[nt][mt][1] += __uint_as_float(gv[mt][nt].x & 0xffff0000u) * acc[nt][mt][1];
        m[nt][mt][2] += __uint_as_float(gv[mt][nt].y << 16) * acc[nt][mt][2];
        m[nt][mt][3] += __uint_as_float(gv[mt][nt].y & 0xffff0000u) * acc[nt][mt][3];
      }
    if (br == 2) {
#pragma unroll
      for (int mt = 0; mt < 4; ++mt) {
        const int tok = t0 + mt * 16 + (lane & 15);
        bf16_t* dst = p.mrg + (size_t)tok * 1024 + c * 64 + nt0 * 16 + 4 * (lane >> 4);
#pragma unroll
        for (int nt = 0; nt < 2; ++nt) {
          uint2 o;
          o.x = pack2bf(m[nt][mt][0], m[nt][mt][1]);
          o.y = pack2bf(m[nt][mt][2], m[nt][mt][3]);
          *(uint2*)(dst + nt * 16) = o;
        }
      }
    }
  }
}
__device__ __forceinline__ void o_p5a2_tile(const Params& p, int l, const float* __restrict__ xcur, int t0, char* smem, int tid) {
  const int wave = tid >> 6, lane = tid & 63;
  __syncthreads();
  tile_load_to_lds(p.mrg + (size_t)t0 * 1024, 1024, smem, tid);
  __syncthreads();
  const bf16_t* wfo = p.wf_out + (size_t)l * 1024 * 1024;
#pragma unroll 1
  for (int c = wave; c < 16; c += 8) {
    f32x4 acc[4][4];
#pragma unroll
    for (int a = 0; a < 4; ++a)
#pragma unroll
      for (int b = 0; b < 4; ++b) acc[a][b] = (f32x4){0.f, 0.f, 0.f, 0.f};
    tl_gemm_chunk<4, 2>(wfo + (size_t)c * 32 * 4 * 64 * 8, 32, smem, 0, acc, lane);
    asm volatile("" ::: "memory");
#pragma unroll
    for (int mt = 0; mt < 4; ++mt) {
      const int tok = t0 + mt * 16 + (lane & 15);
      const size_t o = (size_t)tok * 1024 + c * 64 + 4 * (lane >> 4);
#pragma unroll
      for (int nt = 0; nt < 4; ++nt) {
        float4 xv = *(const float4*)(xcur + o + nt * 16);
        xv.x += acc[nt][mt][0]; xv.y += acc[nt][mt][1]; xv.z += acc[nt][mt][2]; xv.w += acc[nt][mt][3];
        *(float4*)(p.xres + o + nt * 16) = xv;
      }
    }
  }
}
__device__ __forceinline__ void o_p5a3_tile(const Params& p, int l, int t0, char* smem, int tid) {
  const int wave = tid >> 6, lane = tid & 63;
  __syncthreads();
  tile_rmsnorm_to_lds(p.xres, p.norm_ffn + l * D_MODEL, t0, smem, wave, lane);
  __syncthreads();
}


__device__ __forceinline__ unsigned mono_f(float f) {
  unsigned u = __float_as_uint(f);
  return (u & 0x80000000u) ? ~u : (u | 0x80000000u);
}
__device__ __forceinline__ float unmono_f(unsigned m) {
  return __uint_as_float((m & 0x80000000u) ? (m & 0x7fffffffu) : ~m);
}
#define CE_DESC(x, y) { const unsigned hi_ = max(x, y); const unsigned lo_ = min(x, y); x = hi_; y = lo_; }
#define CE_ASC(x, y) { const unsigned hi_ = max(x, y); const unsigned lo_ = min(x, y); x = lo_; y = hi_; }
__device__ __forceinline__ void sort16_desc(unsigned (&a)[16]) {
#pragma unroll
  for (int k = 2; k <= 16; k <<= 1) {
#pragma unroll
    for (int j = k >> 1; j > 0; j >>= 1) {
#pragma unroll
      for (int i = 0; i < 16; ++i) {
        const int l = i ^ j;
        if (l > i) {
          if ((i & k) == 0) CE_DESC(a[i], a[l]) else CE_ASC(a[i], a[l])
        }
      }
    }
  }
}
__device__ __forceinline__ void bitonic_merge16_desc(unsigned (&a)[16]) {
#pragma unroll
  for (int j = 8; j > 0; j >>= 1) {
#pragma unroll
    for (int i = 0; i < 16; ++i) {
      const int l = i ^ j;
      if (l > i) CE_DESC(a[i], a[l])
    }
  }
}
__device__ __forceinline__ void xlane_merge16(unsigned (&a)[16], int mask) {
  unsigned b[16];
#pragma unroll
  for (int i = 0; i < 16; ++i) b[i] = (unsigned)__shfl_xor((int)a[i], mask, 64);
#pragma unroll
  for (int i = 0; i < 16; ++i) a[i] = max(a[i], b[15 - i]);
  bitonic_merge16_desc(a);
}

__device__ __forceinline__ void o_peer_select_tile(const Params& p, int l, int t0, char* smem, int tid) {
  const int h = __builtin_amdgcn_readfirstlane(tid >> 6), lane = tid & 63;
  const int g = lane >> 4, tl = lane & 15;
  const bf16_t* wfq = p.wf_q + (size_t)l * 1024 * 2048;
#pragma unroll 1
  for (int pp = 0; pp < 2; ++pp) {
    bf16x8 qf[4][4];
#pragma unroll 1
    for (int cc = 0; cc < 2; ++cc) {
      const int c = (h * 2 + pp) * 2 + cc;
      f32x4 acc[4][4];
#pragma unroll
      for (int a = 0; a < 4; ++a)
#pragma unroll
        for (int b = 0; b < 4; ++b) acc[a][b] = (f32x4){0.f, 0.f, 0.f, 0.f};
      tl_gemm_chunk<4, 2>(wfq + (size_t)c * 32 * 4 * 64 * 8, 32, smem, 0, acc, lane);
#pragma unroll
      for (int sl = 0; sl < 2; ++sl)
#pragma unroll
        for (int mt = 0; mt < 4; ++mt) {
          union { bf16x8 v; unsigned u[4]; } cv;
          cv.u[0] = pack2bf(acc[2 * sl][mt][0], acc[2 * sl][mt][1]);
          cv.u[1] = pack2bf(acc[2 * sl][mt][2], acc[2 * sl][mt][3]);
          cv.u[2] = pack2bf(acc[2 * sl + 1][mt][0], acc[2 * sl + 1][mt][1]);
          cv.u[3] = pack2bf(acc[2 * sl + 1][mt][2], acc[2 * sl + 1][mt][3]);
          if (cc == 0) qf[sl][mt] = cv.v; else qf[2 + sl][mt] = cv.v;
        }
    }
    const bf16x8* kfp = (const bf16x8*)p.kf + (size_t)((l * 2 + pp) * 8) * 4 * 64 + lane;
#pragma unroll
    for (int mt = 0; mt < 4; ++mt) {
      f32x4 sc[8];
#pragma unroll
      for (int kt = 0; kt < 8; ++kt) sc[kt] = (f32x4){0.f, 0.f, 0.f, 0.f};
#pragma unroll
      for (int s2 = 0; s2 < 4; ++s2) {
        bf16x8 qv;
        qv = qf[s2][mt];
#pragma unroll
        for (int kt = 0; kt < 8; ++kt)
          sc[kt] = __builtin_amdgcn_mfma_f32_16x16x32_bf16(kfp[(kt * 4 + s2) * 64], qv, sc[kt], 0, 0, 0);
        __builtin_amdgcn_sched_barrier(0);
      }
      unsigned A[16], B[16];
#pragma unroll
      for (int kt = 0; kt < 4; ++kt)
#pragma unroll
        for (int r = 0; r < 4; ++r) {
          A[kt * 4 + r] = (mono_f(sc[kt][r]) & ~127u) | (unsigned)(127 - (kt * 16 + r) - 4 * g);
          B[kt * 4 + r] = (mono_f(sc[kt + 4][r]) & ~127u) | (unsigned)(127 - ((kt + 4) * 16 + r) - 4 * g);
        }
      sort16_desc(A);
      sort16_desc(B);
#pragma unroll
      for (int i = 0; i < 16; ++i) A[i] = max(A[i], B[15 - i]);
      bitonic_merge16_desc(A);
      xlane_merge16(A, 16);
      xlane_merge16(A, 32);
      if (g == 0) {
        uint4* dst = (uint4*)(p.tklist + ((size_t)((t0 + mt * 16 + tl) * 8 + h) * 2 + pp) * 16);
        dst[0] = make_uint4(A[0], A[1], A[2], A[3]);
        dst[1] = make_uint4(A[4], A[5], A[6], A[7]);
        dst[2] = make_uint4(A[8], A[9], A[10], A[11]);
        dst[3] = make_uint4(A[12], A[13], A[14], A[15]);
      }
    }
  }
  asm volatile("s_waitcnt vmcnt(0)" ::: "memory");
}

__device__ __forceinline__ void o_peer_select2_tile(const Params& p, int l, int t0, int tid) {
  const int h = __builtin_amdgcn_readfirstlane(tid >> 6), lane = tid & 63;
  const int g = lane >> 4, tl = lane & 15;
#pragma unroll 1
  for (int mt = 0; mt < 4; ++mt) {
    const int tok = t0 + mt * 16 + tl;
    const unsigned* lp = p.tklist + ((size_t)(tok * 8 + h) * 2) * 16;
    float v1[16], v2[16];
    {
      const uint4* q4 = (const uint4*)lp;
#pragma unroll
      for (int i = 0; i < 4; ++i) {
        uint4 x = q4[i], y = q4[4 + i];
        v1[4 * i + 0] = unmono_f(x.x & ~127u); v1[4 * i + 1] = unmono_f(x.y & ~127u);
        v1[4 * i + 2] = unmono_f(x.z & ~127u); v1[4 * i + 3] = unmono_f(x.w & ~127u);
        v2[4 * i + 0] = unmono_f(y.x & ~127u); v2[4 * i + 1] = unmono_f(y.y & ~127u);
        v2[4 * i + 2] = unmono_f(y.z & ~127u); v2[4 * i + 3] = unmono_f(y.w & ~127u);
      }
    }
    unsigned C[16];
#pragma unroll
    for (int i = 0; i < 16; ++i) C[i] = 0u;
    {
      int idx = 0;
#pragma unroll
      for (int a = 0; a < 16; ++a) {
#pragma unroll
        for (int b = 0; b < 16; ++b) {
          if ((a + 1) * (b + 1) <= 16) {
            const unsigned key = (mono_f(v1[a] + v2[b]) & ~255u) | (unsigned)(255 - (a * 16 + b));
            const int slot = idx >> 2, who = idx & 3;
            C[slot] = (g == who) ? key : C[slot];
            ++idx;
          }
        }
      }
    }
    sort16_desc(C);
    xlane_merge16(C, 16);
    xlane_merge16(C, 32);
    const float f0 = unmono_f(C[0] & ~255u);
    float den = 0.f;
    float ev[16];
#pragma unroll
    for (int i = 0; i < 16; ++i) { ev[i] = __expf(unmono_f(C[i] & ~255u) - f0); den += ev[i]; }
    const float rden = 1.0f / den;
    int eidx[4]; float egate[4];
#pragma unroll
    for (int i = 0; i < 4; ++i) {
      const unsigned k = (g == 0) ? C[i] : (g == 1) ? C[4 + i] : (g == 2) ? C[8 + i] : C[12 + i];
      const float e = (g == 0) ? ev[i] : (g == 1) ? ev[4 + i] : (g == 2) ? ev[8 + i] : ev[12 + i];
      const int pos = 255 - (int)(k & 255u);
      const int a = pos >> 4, b = pos & 15;
      const int n1 = 127 - (int)(lp[a] & 127u);
      const int n2 = 127 - (int)(lp[16 + b] & 127u);
      eidx[i] = n1 * 128 + n2;
      egate[i] = e * rden;
    }
    *(int4*)(p.pidx + (size_t)tok * 128 + h * 16 + 4 * g) = make_int4(eidx[0], eidx[1], eidx[2], eidx[3]);
    *(float4*)(p.pgate + (size_t)tok * 128 + h * 16 + 4 * g) = make_float4(egate[0], egate[1], egate[2], egate[3]);
  }
}

__device__ __forceinline__ float logsigmoid_(float x) { return fminf(x, 0.f) - log1pf(expf(-fabsf(x))); }
__device__ __forceinline__ float bf_lo(unsigned w) { return __uint_as_float(w << 16); }
__device__ __forceinline__ float bf_hi(unsigned w) { return __uint_as_float(w & 0xffff0000u); }

#define RKV_LD 136
__device__ __forceinline__ void o_ret_kv_task(const Params& p, int l, int task, char* smem, int tid) {
  const int wave = tid >> 6, lane = tid & 63, g = lane >> 4, tl = lane & 15;
  const int bh = task >> 5, n = task & 31, b = bh >> 2, h = bh & 3;
  const int tok0 = b * SEQ + n * 128;
  const float lgf = logsigmoid_(p.ret_decay[l * 8 + h]), lgb = logsigmoid_(p.ret_decay[l * 8 + 4 + h]);
  bf16_t* KTf = (bf16_t*)smem;
  bf16_t* KTb = KTf + 64 * RKV_LD;
  bf16_t* VT = KTb + 64 * RKV_LD;
  __syncthreads();
#pragma unroll
  for (int it = 0; it < 2; ++it) {
    const int u = tid + it * NTHREADS;
    const int j = u >> 3, d0 = (u & 7) * 8;
    const uint4 kv = *(const uint4*)(p.proj + (size_t)(tok0 + j) * IN_WIDTH + C_RK + h * 64 + d0);
    const float wf = __expf(lgf * (float)(127 - j)), wb = __expf(lgb * (float)(j + 1));
    const unsigned kw[4] = {kv.x, kv.y, kv.z, kv.w};
#pragma unroll
    for (int e = 0; e < 4; ++e) {
      const float x0 = bf_lo(kw[e]), x1 = bf_hi(kw[e]);
      KTf[(d0 + 2 * e) * RKV_LD + j] = f2bf(x0 * wf);
      KTf[(d0 + 2 * e + 1) * RKV_LD + j] = f2bf(x1 * wf);
      KTb[(d0 + 2 * e) * RKV_LD + j] = f2bf(x0 * wb);
      KTb[(d0 + 2 * e + 1) * RKV_LD + j] = f2bf(x1 * wb);
    }
  }
#pragma unroll
  for (int it = 0; it < 4; ++it) {
    const int u = tid + it * NTHREADS;
    const int j = u >> 4, e0 = (u & 15) * 8;
    const uint4 vv = *(const uint4*)(p.proj + (size_t)(tok0 + j) * IN_WIDTH + C_RV + h * 128 + e0);
    const unsigned vw[4] = {vv.x, vv.y, vv.z, vv.w};
#pragma unroll
    for (int e = 0; e < 4; ++e) {
      VT[(e0 + 2 * e) * RKV_LD + j] = (bf16_t)(vw[e] & 0xffffu);
      VT[(e0 + 2 * e + 1) * RKV_LD + j] = (bf16_t)(vw[e] >> 16);
    }
  }
  __syncthreads();
  bf16x8 a[4];
#pragma unroll
  for (int ks = 0; ks < 4; ++ks) a[ks] = *(const bf16x8*)(VT + (wave * 16 + tl) * RKV_LD + ks * 32 + 8 * g);
#pragma unroll
  for (int dir = 0; dir < 2; ++dir) {
    const bf16_t* KT = dir ? KTb : KTf;
#pragma unroll
    for (int dt = 0; dt < 4; ++dt) {
      f32x4 acc = (f32x4){0.f, 0.f, 0.f, 0.f};
#pragma unroll
      for (int ks = 0; ks < 4; ++ks) {
        const bf16x8 bb = *(const bf16x8*)(KT + (dt * 16 + tl) * RKV_LD + ks * 32 + 8 * g);
        acc = __builtin_amdgcn_mfma_f32_16x16x32_bf16(a[ks], bb, acc, 0, 0, 0);
      }
      float* dst = p.kvst + ((size_t)(task * 2 + dir) * 128 + wave * 16 + 4 * g) * 64 + dt * 16 + tl;
#pragma unroll
      for (int r = 0; r < 4; ++r) dst[r * 64] = acc[r];
    }
  }
}

__device__ __forceinline__ void o_ret_scan(const int wv_, const Params& p, int l) {
  const int tidx_ = opaque_tid(wv_); const int bidx_ = opaque_bid();
  const int gsz = gridDim.x * NTHREADS;
  for (int u = bidx_ * NTHREADS + tidx_; u < 16 * 2 * 128 * 16; u += gsz) {
    const int dq = u & 15, e = (u >> 4) & 127, dir = (u >> 11) & 1, bh = u >> 12, h = bh & 3;
    const float lg = logsigmoid_(p.ret_decay[l * 8 + dir * 4 + h]);
    const float gC = __expf(lg * 128.0f);
    float4 st = make_float4(0.f, 0.f, 0.f, 0.f);
#pragma unroll 8
    for (int nn = 0; nn < 32; ++nn) {
      const int n = dir ? (31 - nn) : nn;
      const size_t idx = ((size_t)((bh * 32 + n) * 2 + dir) * 128 + e) * 64 + dq * 4;
      const float4 kv = *(const float4*)(p.kvst + idx);
      uint2 o;
      o.x = pack2bf(st.x, st.y); o.y = pack2bf(st.z, st.w);
      *(uint2*)(p.rstate + idx) = o;
      st.x = fmaf(st.x, gC, kv.x); st.y = fmaf(st.y, gC, kv.y); st.z = fmaf(st.z, gC, kv.z); st.w = fmaf(st.w, gC, kv.w);
    }
  }
}

#define RO_LD 264
#define RK_LD 72
__device__ __forceinline__ void o_ret_out_task(const Params& p, int l, int task, char* smem, int tid) {
  const int wave = tid >> 6, lane = tid & 63, g = lane >> 4, tl = lane & 15;
  const int bh = task >> 5, n = task & 31, b = bh >> 2, h = bh & 3;
  const int tok0 = b * SEQ + n * 128;
  const float lgf = logsigmoid_(p.ret_decay[l * 8 + h]), lgb = logsigmoid_(p.ret_decay[l * 8 + 4 + h]);
  bf16_t* Acat = (bf16_t*)smem;
  bf16_t* Bcat = Acat + 128 * RO_LD;
  bf16_t* Kl = Bcat + 128 * RO_LD;
  __syncthreads();
#pragma unroll
  for (int it = 0; it < 2; ++it) {
    const int u = tid + it * NTHREADS;
    const int i = u >> 3, d0 = (u & 7) * 8;
    const size_t row = (size_t)(tok0 + i) * IN_WIDTH;
    const uint4 qv = *(const uint4*)(p.proj + row + C_RQ + h * 64 + d0);
    const uint4 kv = *(const uint4*)(p.proj + row + C_RK + h * 64 + d0);
    *(uint4*)(Acat + i * RO_LD + d0) = qv;
    *(uint4*)(Kl + i * RK_LD + d0) = kv;
    const float wf = __expf(lgf * (float)(i + 1)), wb = __expf(lgb * (float)(127 - i));
    const unsigned qw[4] = {qv.x, qv.y, qv.z, qv.w};
    uint4 of, ob;
    of.x = pack2bf(bf_lo(qw[0]) * wf, bf_hi(qw[0]) * wf); ob.x = pack2bf(bf_lo(qw[0]) * wb, bf_hi(qw[0]) * wb);
    of.y = pack2bf(bf_lo(qw[1]) * wf, bf_hi(qw[1]) * wf); ob.y = pack2bf(bf_lo(qw[1]) * wb, bf_hi(qw[1]) * wb);
    of.z = pack2bf(bf_lo(qw[2]) * wf, bf_hi(qw[2]) * wf); ob.z = pack2bf(bf_lo(qw[2]) * wb, bf_hi(qw[2]) * wb);
    of.w = pack2bf(bf_lo(qw[3]) * wf, bf_hi(qw[3]) * wf); ob.w = pack2bf(bf_lo(qw[3]) * wb, bf_hi(qw[3]) * wb);
    *(uint4*)(Acat + i * RO_LD + 128 + d0) = of;
    *(uint4*)(Acat + i * RO_LD + 192 + d0) = ob;
  }
#pragma unroll
  for (int it = 0; it < 4; ++it) {
    const int u = tid + it * NTHREADS;
    const int j = u >> 4, e0 = (u & 15) * 8;
    const uint4 vv = *(const uint4*)(p.proj + (size_t)(tok0 + j) * IN_WIDTH + C_RV + h * 128 + e0);
    const unsigned vw[4] = {vv.x, vv.y, vv.z, vv.w};
#pragma unroll
    for (int e = 0; e < 4; ++e) {
      Bcat[(e0 + 2 * e) * RO_LD + j] = (bf16_t)(vw[e] & 0xffffu);
      Bcat[(e0 + 2 * e + 1) * RO_LD + j] = (bf16_t)(vw[e] >> 16);
    }
  }
#pragma unroll
  for (int it = 0; it < 4; ++it) {
    const int u = tid + it * NTHREADS;
    const int d0 = (u & 7) * 8, e = (u >> 3) & 127, dir = u >> 10;
    const uint4 sv = *(const uint4*)(p.rstate + ((size_t)(task * 2 + dir) * 128 + e) * 64 + d0);
    *(uint4*)(Bcat + e * RO_LD + 128 + dir * 64 + d0) = sv;
  }
  __syncthreads();
  f32x4 sc[8];
#pragma unroll
  for (int jt = 0; jt < 8; ++jt) sc[jt] = (f32x4){0.f, 0.f, 0.f, 0.f};
#pragma unroll
  for (int ks = 0; ks < 2; ++ks) {
    const bf16x8 qb = *(const bf16x8*)(Acat + (wave * 16 + tl) * RO_LD + ks * 32 + 8 * g);
#pragma unroll
    for (int jt = 0; jt < 8; ++jt) {
      const bf16x8 ka = *(const bf16x8*)(Kl + (jt * 16 + tl) * RK_LD + ks * 32 + 8 * g);
      sc[jt] = __builtin_amdgcn_mfma_f32_16x16x32_bf16(ka, qb, sc[jt], 0, 0, 0);
    }
  }
  {
    const int i = wave * 16 + tl;
#pragma unroll
    for (int jt = 0; jt < 8; ++jt) {
      float pv[4];
#pragma unroll
      for (int r = 0; r < 4; ++r) {
        const int j = jt * 16 + 4 * g + r;
        const float dd = (j <= i) ? __expf(lgf * (float)(i - j)) : __expf(lgb * (float)(j - i));
        pv[r] = sc[jt][r] * dd;
      }
      uint2 o;
      o.x = pack2bf(pv[0], pv[1]); o.y = pack2bf(pv[2], pv[3]);
      *(uint2*)(Acat + i * RO_LD + jt * 16 + 4 * g) = o;
    }
  }
  f32x4 y[8];
#pragma unroll
  for (int et = 0; et < 8; ++et) y[et] = (f32x4){0.f, 0.f, 0.f, 0.f};
#pragma unroll
  for (int ks = 0; ks < 8; ++ks) {
    const bf16x8 ab = *(const bf16x8*)(Acat + (wave * 16 + tl) * RO_LD + ks * 32 + 8 * g);
#pragma unroll
    for (int et = 0; et < 8; ++et) {
      const bf16x8 ba = *(const bf16x8*)(Bcat + (et * 16 + tl) * RO_LD + ks * 32 + 8 * g);
      y[et] = __builtin_amdgcn_mfma_f32_16x16x32_bf16(ba, ab, y[et], 0, 0, 0);
    }
  }
  float ss = 0.f;
#pragma unroll
  for (int et = 0; et < 8; ++et)
#pragma unroll
    for (int r = 0; r < 4; ++r) ss = fmaf(y[et][r], y[et][r], ss);
  ss += __shfl_xor(ss, 16, 64);
  ss += __shfl_xor(ss, 32, 64);
  const float rstd = rsqrtf(ss * (1.0f / 128.0f) + EPS);
  {
    const int tok = tok0 + wave * 16 + tl;
    const bf16_t* gp = p.proj + (size_t)tok * IN_WIDTH + C_RG + h * 128 + 4 * g;
    bf16_t* dst = p.ycat + (size_t)tok * 1024 + 256 + h * 128 + 4 * g;
#pragma unroll
    for (int et = 0; et < 8; ++et) {
      const uint2 gv = *(const uint2*)(gp + et * 16);
      const float g0 = bf_lo(gv.x), g1 = bf_hi(gv.x), g2 = bf_lo(gv.y), g3 = bf_hi(gv.y);
      uint2 o;
      o.x = pack2bf(g0 / (1.0f + __expf(-g0)) * y[et][0] * rstd, g1 / (1.0f + __expf(-g1)) * y[et][1] * rstd);
      o.y = pack2bf(g2 / (1.0f + __expf(-g2)) * y[et][2] * rstd, g3 / (1.0f + __expf(-g3)) * y[et][3] * rstd);
      *(uint2*)(dst + et * 16) = o;
    }
  }
}


#define NA_KLD 72
typedef short v4s_t __attribute__((ext_vector_type(4)));
#ifndef LAS
#define LAS __attribute__((address_space(3)))
#endif
__device__ __forceinline__ void o_na_task(const Params& p, int l, int task, char* smem, int tid) {
  const int wave = tid >> 6, lane = tid & 63, g = lane >> 4, tl = lane & 15;
  const int rr = task & 63, h = (task >> 6) & 3, b = task >> 8;
  int rs = rr - 4; rs = rs < 0 ? 0 : (rs > 56 ? 56 : rs);
  const int ktok0 = b * SEQ + rs * 64;
  const int qtok0 = b * SEQ + rr * 64;
  bf16_t* Kl = (bf16_t*)smem;
  bf16_t* Vl = Kl + 512 * NA_KLD;
  bf16_t* Ql = Vl + 512 * NA_KLD;
  float* rpbl = (float*)(Ql + 64 * NA_KLD);
  __syncthreads();
#pragma unroll
  for (int it = 0; it < 8; ++it) {
    const int u = tid + it * NTHREADS;
    const int key = u >> 3, d0 = (u & 7) * 8;
    const size_t row = (size_t)(ktok0 + key) * IN_WIDTH;
    const uint4 kv = *(const uint4*)(p.proj + row + C_NK + h * 64 + d0);
    const uint4 vv = *(const uint4*)(p.proj + row + C_NV + h * 64 + d0);
    *(uint4*)(Kl + key * NA_KLD + d0) = kv;
    *(uint4*)(Vl + key * NA_KLD + d0) = vv;
  }
  {
    const int q = tid >> 3, d0 = (tid & 7) * 8;
    *(uint4*)(Ql + q * NA_KLD + d0) = *(const uint4*)(p.proj + (size_t)(qtok0 + q) * IN_WIDTH + C_NQ + h * 64 + d0);
    if (tid < 465) rpbl[tid] = p.na_rpb[((size_t)l * 4 + h) * 465 + tid];
  }
  __syncthreads();
  if (wave < 4) {
    const int qt = wave;
    int cw0 = 16 * qt - 8; cw0 = cw0 < 0 ? 0 : (cw0 > 32 ? 32 : cw0);
    f32x4 sc[16];
#pragma unroll
    for (int T = 0; T < 16; ++T) sc[T] = (f32x4){0.f, 0.f, 0.f, 0.f};
#pragma unroll
    for (int ks = 0; ks < 2; ++ks) {
      const bf16x8 qb = *(const bf16x8*)(Ql + (qt * 16 + tl) * NA_KLD + ks * 32 + 8 * g);
#pragma unroll
      for (int T = 0; T < 16; ++T) {
        const int key = (T >> 1) * 64 + cw0 + (T & 1) * 16 + tl;
        const bf16x8 ka = *(const bf16x8*)(Kl + key * NA_KLD + ks * 32 + 8 * g);
        sc[T] = __builtin_amdgcn_mfma_f32_16x16x32_bf16(ka, qb, sc[T], 0, 0, 0);
      }
    }
    const int cq = qt * 16 + tl;
    int cs = cq - 8; cs = cs < 0 ? 0 : (cs > 48 ? 48 : cs);
    float m = -3.0e38f;
#pragma unroll
    for (int T = 0; T < 16; ++T) {
      const int ri = T >> 1;
      const int di = rs + ri - rr + 7;
#pragma unroll
      for (int r = 0; r < 4; ++r) {
        const int ck = cw0 + (T & 1) * 16 + 4 * g + r;
        const bool valid = (ck >= cs) && (ck < cs + 16);
        int dj = ck - cq + 15; dj = dj < 0 ? 0 : (dj > 30 ? 30 : dj);
        const float sv = valid ? (sc[T][r] + rpbl[di * 31 + dj]) : -1.0e30f;
        sc[T][r] = sv;
        m = fmaxf(m, sv);
      }
    }
    m = fmaxf(m, __shfl_xor(m, 16, 64));
    m = fmaxf(m, __shfl_xor(m, 32, 64));
    float den = 0.f;
#pragma unroll
    for (int T = 0; T < 16; ++T)
#pragma unroll
      for (int r = 0; r < 4; ++r) {
        const float e = __expf(sc[T][r] - m);
        sc[T][r] = e;
        den += e;
      }
    den += __shfl_xor(den, 16, 64);
    den += __shfl_xor(den, 32, 64);
    const float rden = 1.0f / den;
    f32x4 o[4];
#pragma unroll
    for (int dt = 0; dt < 4; ++dt) o[dt] = (f32x4){0.f, 0.f, 0.f, 0.f};
#pragma unroll
    for (int ri = 0; ri < 8; ++ri) {
      union { bf16x8 v; unsigned u[4]; } pb;
      pb.u[0] = pack2bf(sc[2 * ri][0], sc[2 * ri][1]);
      pb.u[1] = pack2bf(sc[2 * ri][2], sc[2 * ri][3]);
      pb.u[2] = pack2bf(sc[2 * ri + 1][0], sc[2 * ri + 1][1]);
      pb.u[3] = pack2bf(sc[2 * ri + 1][2], sc[2 * ri + 1][3]);
#pragma unroll
      for (int dt = 0; dt < 4; ++dt) {
        const bf16_t* vp = Vl + (ri * 64 + cw0 + 4 * g + (tl >> 2)) * NA_KLD + dt * 16 + 4 * (tl & 3);
        const v4s_t r0 = __builtin_amdgcn_ds_read_tr16_b64_v4i16((v4s_t LAS*)(LAS bf16_t*)vp);
        const v4s_t r1 = __builtin_amdgcn_ds_read_tr16_b64_v4i16((v4s_t LAS*)(LAS bf16_t*)(vp + 16 * NA_KLD));
        const bf16x8 va = {r0[0], r0[1], r0[2], r0[3], r1[0], r1[1], r1[2], r1[3]};
        o[dt] = __builtin_amdgcn_mfma_f32_16x16x32_bf16(va, pb.v, o[dt], 0, 0, 0);
      }
    }
    bf16_t* dst = p.ycat + (size_t)(qtok0 + qt * 16 + tl) * 1024 + 768 + h * 64 + 4 * g;
#pragma unroll
    for (int dt = 0; dt < 4; ++dt) {
      uint2 ov;
      ov.x = pack2bf(o[dt][0] * rden, o[dt][1] * rden);
      ov.y = pack2bf(o[dt][2] * rden, o[dt][3] * rden);
      *(uint2*)(dst + dt * 16) = ov;
    }
  }
}

#define PL_LD 264
__device__ __forceinline__ void o_pool_task(const Params& p, int l, int task, char* smem, int tid) {
  const int wave = tid >> 6, lane = tid & 63, g = lane >> 4, tl = lane & 15;
  const int t0 = task * 64, pos0 = t0 & (SEQ - 1);
  bf16_t* Xp = (bf16_t*)smem;
  bf16_t* WT = Xp + 80 * PL_LD;
  bf16_t* Df = WT + 4 * 64 * 72;
  __syncthreads();
#pragma unroll
  for (int it = 0; it < 5; ++it) {
    const int u = tid + it * NTHREADS;
    const int rw = u >> 5, c0 = (u & 31) * 8;
    const int pos = pos0 - 8 + rw;
    uint4 v = make_uint4(0u, 0u, 0u, 0u);
    if (pos >= 0 && pos < SEQ) v = *(const uint4*)(p.proj + (size_t)(t0 - 8 + rw) * IN_WIDTH + C_POOL + c0);
    *(uint4*)(Xp + rw * PL_LD + c0) = v;
  }
#pragma unroll
  for (int it = 0; it < 4; ++it) {
    const int u = tid + it * NTHREADS;
    const int e0 = (u & 7) * 8, c = (u >> 3) & 63, gi = u >> 9;
    const float* wp = p.pool_w + (((size_t)l * 4 + gi) * 64 + c) * 64 + e0;
    const float4 a = *(const float4*)wp, bq = *(const float4*)(wp + 4);
    const float wv[8] = {a.x, a.y, a.z, a.w, bq.x, bq.y, bq.z, bq.w};
#pragma unroll
    for (int k = 0; k < 8; ++k) WT[(gi * 64 + e0 + k) * 72 + c] = f2bf(wv[k]);
  }
  __syncthreads();
#pragma unroll 1
  for (int it = 0; it < 4; ++it) {
    const int u = tid + it * NTHREADS;
    const int t = u >> 5, c0 = (u & 31) * 8;
    const int gi = c0 >> 6;
    const int hw = 1 << gi;
    const int pos = pos0 + t;
    int a = pos - hw; a = a < 0 ? 0 : a;
    int bnd = pos + hw; bnd = bnd > SEQ ? SEQ : bnd;
    float sum[8];
#pragma unroll
    for (int k = 0; k < 8; ++k) sum[k] = 0.f;
    for (int rp = a; rp < bnd; ++rp) {
      const uint4 v = *(const uint4*)(Xp + (rp - pos0 + 8) * PL_LD + c0);
      sum[0] += bf_lo(v.x); sum[1] += bf_hi(v.x); sum[2] += bf_lo(v.y); sum[3] += bf_hi(v.y);
      sum[4] += bf_lo(v.z); sum[5] += bf_hi(v.z); sum[6] += bf_lo(v.w); sum[7] += bf_hi(v.w);
    }
    const float rc = 1.0f / (float)(bnd - a);
    const uint4 xv = *(const uint4*)(Xp + (t + 8) * PL_LD + c0);
    uint4 o;
    o.x = pack2bf(sum[0] * rc - bf_lo(xv.x), sum[1] * rc - bf_hi(xv.x));
    o.y = pack2bf(sum[2] * rc - bf_lo(xv.y), sum[3] * rc - bf_hi(xv.y));
    o.z = pack2bf(sum[4] * rc - bf_lo(xv.z), sum[5] * rc - bf_hi(xv.z));
    o.w = pack2bf(sum[6] * rc - bf_lo(xv.w), sum[7] * rc - bf_hi(xv.w));
    *(uint4*)(Df + t * PL_LD + c0) = o;
  }
  __syncthreads();
  {
    const int gi = wave >> 1, tt0 = (wave & 1) * 2;
    f32x4 acc[4][2];
#pragma unroll
    for (int et = 0; et < 4; ++et)
#pragma unroll
      for (int tt = 0; tt < 2; ++tt) acc[et][tt] = (f32x4){0.f, 0.f, 0.f, 0.f};
#pragma unroll
    for (int ks = 0; ks < 2; ++ks) {
      bf16x8 bx[2];
#pragma unroll
      for (int tt = 0; tt < 2; ++tt) bx[tt] = *(const bf16x8*)(Df + ((tt0 + tt) * 16 + tl) * PL_LD + gi * 64 + ks * 32 + 8 * g);
#pragma unroll
      for (int et = 0; et < 4; ++et) {
        const bf16x8 wa = *(const bf16x8*)(WT + (gi * 64 + et * 16 + tl) * 72 + ks * 32 + 8 * g);
#pragma unroll
        for (int tt = 0; tt < 2; ++tt) acc[et][tt] = __builtin_amdgcn_mfma_f32_16x16x32_bf16(wa, bx[tt], acc[et][tt], 0, 0, 0);
      }
    }
#pragma unroll
    for (int et = 0; et < 4; ++et) {
      const float4 sc4 = *(const float4*)(p.pool_scale + l * 256 + gi * 64 + et * 16 + 4 * g);
#pragma unroll
      for (int tt = 0; tt < 2; ++tt) {
        const int tok = t0 + (tt0 + tt) * 16 + tl;
        uint2 o;
        o.x = pack2bf(acc[et][tt][0] * sc4.x, acc[et][tt][1] * sc4.y);
        o.y = pack2bf(acc[et][tt][2] * sc4.z, acc[et][tt][3] * sc4.w);
        *(uint2*)(p.ycat + (size_t)tok * 1024 + gi * 64 + et * 16 + 4 * g) = o;
      }
    }
  }
}


typedef __attribute__((ext_vector_type(2))) __bf16 bf16x2_t;
__device__ __forceinline__ float dot2bf(unsigned a, unsigned b, float c) {
  return __builtin_amdgcn_fdot2_f32_bf16(__builtin_bit_cast(bf16x2_t, a), __builtin_bit_cast(bf16x2_t, b), c, false);
}
#define DPP_F(v, ctrl) __builtin_bit_cast(float, __builtin_amdgcn_update_dpp(0, __builtin_bit_cast(int, v), ctrl, 0xf, 0xf, false))
#define RDLANE_F(v, l) __builtin_bit_cast(float, __builtin_amdgcn_readlane(__builtin_bit_cast(int, v), l))
__device__ __forceinline__ float erf_as(float x) {
  const float ax = fabsf(x);
  const float t = __builtin_amdgcn_rcpf(fmaf(0.3275911f, ax, 1.0f));
  float y = fmaf(1.061405429f, t, -1.453152027f);
  y = fmaf(y, t, 1.421413741f);
  y = fmaf(y, t, -0.284496736f);
  y = fmaf(y, t, 0.254829592f);
  y = y * t * __expf(-ax * ax);
  return copysignf(1.0f - y, x);
}
__device__ __forceinline__ float gelu_fast_exact(float a) { return 0.5f * a * (1.0f + erf_as(a * 0.70710678118654752f)); }
struct PickPair { int eA, eB; float gA, gB; };

#define EX6_SHIFT 11
#define EX6_NSLICE (16384 >> EX6_SHIFT)
__device__ __forceinline__ unsigned cvt8_bf16x2(unsigned w, float scale, const bool hi) {
  return hi ? __builtin_bit_cast(unsigned, __builtin_amdgcn_cvt_scalef32_pk_bf16_fp8((int)w, scale, true))
            : __builtin_bit_cast(unsigned, __builtin_amdgcn_cvt_scalef32_pk_bf16_fp8((int)w, scale, false));
}
__device__ __forceinline__ void experts6_process4(const unsigned char* __restrict__ U8, const unsigned char* __restrict__ V8,
                                                  const float2* __restrict__ ES, const int (&e)[4], const float (&g)[4],
                                                  const unsigned (&hw)[8], float (&acc)[16], int lane, int vz) {
  uint4 u[4], v[4];
  float2 sc[4];
#pragma unroll
  for (int i = 0; i < 4; ++i) u[i] = *(const uint4*)(U8 + (size_t)e[i] * 1024 + lane * 16);
#pragma unroll
  for (int i = 0; i < 4; ++i) sc[i] = ES[e[i] + vz];
#pragma unroll
  for (int i = 0; i < 4; ++i) v[i] = *(const uint4*)(V8 + (size_t)e[i] * 1024 + lane * 16);
  float a[4];
#pragma unroll
  for (int i = 0; i < 4; ++i) {
    const unsigned uw[4] = {u[i].x, u[i].y, u[i].z, u[i].w};
    float t = 0.f;
#pragma unroll
    for (int w = 0; w < 4; ++w) {
      t = dot2bf(cvt8_bf16x2(uw[w], sc[i].x, false), hw[2 * w], t);
      t = dot2bf(cvt8_bf16x2(uw[w], sc[i].x, true), hw[2 * w + 1], t);
    }
    a[i] = t;
  }
  const bool b0 = lane & 1, b1 = lane & 2;
  const float x01 = (b0 ? a[1] : a[0]) + DPP_F((b0 ? a[0] : a[1]), 0xB1);
  const float x23 = (b0 ? a[3] : a[2]) + DPP_F((b0 ? a[2] : a[3]), 0xB1);
  float y = (b1 ? x23 : x01) + DPP_F((b1 ? x01 : x23), 0x4E);
  y += DPP_F(y, 0x124);
  y += DPP_F(y, 0x128);
  float sum[4];
#pragma unroll
  for (int i = 0; i < 4; ++i) sum[i] = RDLANE_F(y, i) + RDLANE_F(y, 16 + i) + RDLANE_F(y, 32 + i) + RDLANE_F(y, 48 + i);
  const int li = lane & 3;
  const float mine = (li == 0) ? sum[0] : (li == 1) ? sum[1] : (li == 2) ? sum[2] : sum[3];
  const float gmine = (li == 0) ? g[0] : (li == 1) ? g[1] : (li == 2) ? g[2] : g[3];
  const unsigned gb = (unsigned)f2bf(gelu_fast_exact(mine) * gmine);
#pragma unroll
  for (int i = 0; i < 4; ++i) {
    const unsigned hl = (unsigned)__builtin_amdgcn_readlane((int)gb, i);
    const unsigned hh = hl << 16;
    const unsigned vw[4] = {v[i].x, v[i].y, v[i].z, v[i].w};
#pragma unroll
    for (int w = 0; w < 4; ++w) {
      const unsigned p0 = cvt8_bf16x2(vw[w], sc[i].y, false), p1 = cvt8_bf16x2(vw[w], sc[i].y, true);
      acc[4 * w + 0] = dot2bf(p0, hl, acc[4 * w + 0]);
      acc[4 * w + 1] = dot2bf(p0, hh, acc[4 * w + 1]);
      acc[4 * w + 2] = dot2bf(p1, hl, acc[4 * w + 2]);
      acc[4 * w + 3] = dot2bf(p1, hh, acc[4 * w + 3]);
    }
  }
}

__device__ __forceinline__ void o_peer_experts6_tile(const Params& p, int l, int t0, const char* smem, int tid, bool dry = false) {
  const int wave = __builtin_amdgcn_readfirstlane(tid >> 6), lane = tid & 63;
  const unsigned char* U8 = p.u8 + (size_t)l * 16384 * 1024;
  const unsigned char* V8 = p.v8 + (size_t)l * 16384 * 1024;
  const float2* ES = p.escale + (size_t)l * 16384;
  int vz = 0;
  asm volatile("" : "+v"(vz));
  const int s0 = ((int)(__builtin_amdgcn_s_getreg((3 << 11) | 20) & 0xF) * (EX6_NSLICE / 8)) & (EX6_NSLICE - 1);
  unsigned pk[8][2];
  float acc[8][16];
#pragma unroll
  for (int k = 0; k < 8; ++k) {
    const size_t base = (size_t)(t0 + wave * 8 + k) * 128 + lane + vz;
#pragma unroll
    for (int hf = 0; hf < 2; ++hf) pk[k][hf] = (unsigned)p.pidx[base + hf * 64] | ((unsigned)f2bf(p.pgate[base + hf * 64]) << 16);
#pragma unroll
    for (int i = 0; i < 16; ++i) acc[k][i] = 0.f;
  }
#pragma unroll 1
  for (int si = 0; si < EX6_NSLICE; ++si) {
    const unsigned s = (unsigned)((s0 + si) & (EX6_NSLICE - 1));
#pragma unroll
    for (int k = 0; k < 8; ++k) {
      unsigned long long m0 = __ballot(((pk[k][0] & 0x3fffu) >> EX6_SHIFT) == s);
      unsigned long long m1 = __ballot(((pk[k][1] & 0x3fffu) >> EX6_SHIFT) == s);
      if ((m0 | m1) == 0ull) continue;
      unsigned hw[8];
      {
        const char* xr = smem + (wave * 8 + k) * LDXB + lane * 32;
        const uint4 h0 = *(const uint4*)xr, h1 = *(const uint4*)(xr + 16);
        hw[0] = h0.x; hw[1] = h0.y; hw[2] = h0.z; hw[3] = h0.w; hw[4] = h1.x; hw[5] = h1.y; hw[6] = h1.z; hw[7] = h1.w;
      }
      while (m0 | m1) {
        int e[4]; float g[4];
#pragma unroll
        for (int i = 0; i < 4; ++i) {
          unsigned w;
          if (m0) { const int la = (int)__builtin_ctzll(m0); m0 &= m0 - 1; w = (unsigned)__builtin_amdgcn_readlane((int)pk[k][0], la); }
          else if (m1) { const int la = (int)__builtin_ctzll(m1); m1 &= m1 - 1; w = (unsigned)__builtin_amdgcn_readlane((int)pk[k][1], la); }
          else { w = (unsigned)e[0]; }
          e[i] = (int)(w & 0x3fffu);
          g[i] = __uint_as_float(w & 0xffff0000u);
        }
        experts6_process4(U8, V8, ES, e, g, hw, acc[k], lane, vz);
      }
    }
  }
  if (dry) {
#pragma unroll
    for (int k = 0; k < 8; ++k)
#pragma unroll
      for (int i = 0; i < 16; ++i) asm volatile("" :: "v"(acc[k][i]));
    return;
  }
#pragma unroll
  for (int k = 0; k < 8; ++k) {
    float* xr = p.xres + (size_t)(t0 + wave * 8 + k) * 1024 + lane * 16;
#pragma unroll
    for (int i = 0; i < 4; ++i) {
      float4 a0 = *(float4*)(xr + 4 * i);
      a0.x += acc[k][4 * i + 0]; a0.y += acc[k][4 * i + 1]; a0.z += acc[k][4 * i + 2]; a0.w += acc[k][4 * i + 3];
      *(float4*)(xr + 4 * i) = a0;
    }
  }
}


typedef _Float16 h2_t __attribute__((ext_vector_type(2)));
__device__ __forceinline__ void ex7_pop(unsigned long long& m0, unsigned long long& m1, const unsigned pk0, const unsigned pk1,
                                        int (&e)[4], float (&g)[4]) {
  int e0 = 0;
#pragma unroll
  for (int i = 0; i < 4; ++i) {
    unsigned w;
    if (m0) { const int la = (int)__builtin_ctzll(m0); m0 &= m0 - 1; w = (unsigned)__builtin_amdgcn_readlane((int)pk0, la); }
    else if (m1) { const int la = (int)__builtin_ctzll(m1); m1 &= m1 - 1; w = (unsigned)__builtin_amdgcn_readlane((int)pk1, la); }
    else { w = (unsigned)e0; }
    e[i] = (int)(w & 0x3fffu);
    g[i] = __uint_as_float(w & 0xffff0000u);
    if (i == 0) e0 = e[0];
  }
}
#define EX7_ISSUE(U_, V_, SC_, G_) { \
  _Pragma("unroll") for (int i_ = 0; i_ < 4; ++i_) U_[i_] = *(const uint4*)(U8 + (size_t)e[i_] * 1024 + lane * 16); \
  _Pragma("unroll") for (int i_ = 0; i_ < 4; ++i_) SC_[i_] = ES[e[i_] + vz]; \
  _Pragma("unroll") for (int i_ = 0; i_ < 4; ++i_) V_[i_] = *(const uint4*)(V8 + (size_t)e[i_] * 1024 + lane * 16); \
  _Pragma("unroll") for (int i_ = 0; i_ < 4; ++i_) G_[i_] = g[i_]; }

__device__ __forceinline__ void ex7_compute(const uint4 (&ru)[4], const uint4 (&rv)[4], const float2 (&rsc)[4], const float (&rg)[4],
                                            const unsigned (&hw)[8], h2_t (&acc)[8], int lane) {
  float a[4];
#pragma unroll
  for (int i = 0; i < 4; ++i) {
    const unsigned uw[4] = {ru[i].x, ru[i].y, ru[i].z, ru[i].w};
    float t = 0.f;
#pragma unroll
    for (int w = 0; w < 4; ++w) {
      t = dot2bf(cvt8_bf16x2(uw[w], rsc[i].x, false), hw[2 * w], t);
      t = dot2bf(cvt8_bf16x2(uw[w], rsc[i].x, true), hw[2 * w + 1], t);
    }
    a[i] = t;
  }
  const bool b0 = lane & 1, b1 = lane & 2;
  const float x01 = (b0 ? a[1] : a[0]) + DPP_F((b0 ? a[0] : a[1]), 0xB1);
  const float x23 = (b0 ? a[3] : a[2]) + DPP_F((b0 ? a[2] : a[3]), 0xB1);
  float y = (b1 ? x23 : x01) + DPP_F((b1 ? x01 : x23), 0x4E);
  y += DPP_F(y, 0x124);
  y += DPP_F(y, 0x128);
  float sum[4];
#pragma unroll
  for (int i = 0; i < 4; ++i) sum[i] = RDLANE_F(y, i) + RDLANE_F(y, 16 + i) + RDLANE_F(y, 32 + i) + RDLANE_F(y, 48 + i);
  const int li = lane & 3;
  const float mine = (li == 0) ? sum[0] : (li == 1) ? sum[1] : (li == 2) ? sum[2] : sum[3];
  const float gmine = (li == 0) ? rg[0] : (li == 1) ? rg[1] : (li == 2) ? rg[2] : rg[3];
  const _Float16 hf = (_Float16)(gelu_fast_exact(mine) * gmine);
  const unsigned hb = (unsigned)__builtin_bit_cast(unsigned short, hf);
#pragma unroll
  for (int i = 0; i < 4; ++i) {
    const unsigned hl = (unsigned)__builtin_amdgcn_readlane((int)hb, i);
    const h2_t hh = __builtin_bit_cast(h2_t, hl | (hl << 16));
    const unsigned vw[4] = {rv[i].x, rv[i].y, rv[i].z, rv[i].w};
#pragma unroll
    for (int w = 0; w < 4; ++w) {
      const h2_t p0 = __builtin_amdgcn_cvt_scalef32_pk_f16_fp8((int)vw[w], rsc[i].y, false);
      const h2_t p1 = __builtin_amdgcn_cvt_scalef32_pk_f16_fp8((int)vw[w], rsc[i].y, true);
      acc[2 * w] = __builtin_elementwise_fma(p0, hh, acc[2 * w]);
      acc[2 * w + 1] = __builtin_elementwise_fma(p1, hh, acc[2 * w + 1]);
    }
  }
}

__device__ __forceinline__ void o_peer_experts7_tile(const Params& p, int l, int t0, const char* smem, int tid, bool dry = false) {
  const int wave = __builtin_amdgcn_readfirstlane(tid >> 6), lane = tid & 63;
  const unsigned char* U8 = p.u8 + (size_t)l * 16384 * 1024;
  const unsigned char* V8 = p.v8 + (size_t)l * 16384 * 1024;
  const float2* ES = p.escale + (size_t)l * 16384;
  int vz = 0;
  asm volatile("" : "+v"(vz));
  const int s0 = ((int)(__builtin_amdgcn_s_getreg((3 << 11) | 20) & 0xF) * (EX6_NSLICE / 8)) & (EX6_NSLICE - 1);
  unsigned pk[8][2];
  h2_t acc[8][8];
#pragma unroll
  for (int k = 0; k < 8; ++k) {
    const size_t base = (size_t)(t0 + wave * 8 + k) * 128 + lane + vz;
#pragma unroll
    for (int hf = 0; hf < 2; ++hf) pk[k][hf] = (unsigned)p.pidx[base + hf * 64] | ((unsigned)f2bf(p.pgate[base + hf * 64]) << 16);
#pragma unroll
    for (int i = 0; i < 8; ++i) acc[k][i] = (h2_t){(_Float16)0.f, (_Float16)0.f};
  }
#pragma unroll 1
  for (int si = 0; si < EX6_NSLICE; ++si) {
    const unsigned s = (unsigned)((s0 + si) & (EX6_NSLICE - 1));
#pragma unroll
    for (int k = 0; k < 8; ++k) {
      unsigned long long m0 = __ballot(((pk[k][0] & 0x3fffu) >> EX6_SHIFT) == s);
      unsigned long long m1 = __ballot(((pk[k][1] & 0x3fffu) >> EX6_SHIFT) == s);
      if ((m0 | m1) == 0ull) continue;
      unsigned hw[8];
      {
        const char* xr = smem + (wave * 8 + k) * LDXB + lane * 32;
        const uint4 h0 = *(const uint4*)xr, h1 = *(const uint4*)(xr + 16);
        hw[0] = h0.x; hw[1] = h0.y; hw[2] = h0.z; hw[3] = h0.w; hw[4] = h1.x; hw[5] = h1.y; hw[6] = h1.z; hw[7] = h1.w;
      }
      uint4 uA[4], vA[4], uB[4], vB[4];
      float2 scA[4], scB[4];
      float gA[4], gB[4];
      int e[4]; float g[4];
      ex7_pop(m0, m1, pk[k][0], pk[k][1], e, g);
      EX7_ISSUE(uA, vA, scA, gA)
      for (;;) {
        const bool mb = (m0 | m1) != 0ull;
        if (mb) { ex7_pop(m0, m1, pk[k][0], pk[k][1], e, g); EX7_ISSUE(uB, vB, scB, gB) }
        ex7_compute(uA, vA, scA, gA, hw, acc[k], lane);
        if (!mb) break;
        const bool ma = (m0 | m1) != 0ull;
        if (ma) { ex7_pop(m0, m1, pk[k][0], pk[k][1], e, g); EX7_ISSUE(uA, vA, scA, gA) }
        ex7_compute(uB, vB, scB, gB, hw, acc[k], lane);
        if (!ma) break;
      }
    }
  }
  if (dry) {
#pragma unroll
    for (int k = 0; k < 8; ++k)
#pragma unroll
      for (int i = 0; i < 8; ++i) asm volatile("" :: "v"(acc[k][i]));
    return;
  }
#pragma unroll
  for (int k = 0; k < 8; ++k) {
    float* xr = p.xres + (size_t)(t0 + wave * 8 + k) * 1024 + lane * 16;
#pragma unroll
    for (int i = 0; i < 4; ++i) {
      float4 a0 = *(float4*)(xr + 4 * i);
      a0.x += (float)acc[k][2 * i][0]; a0.y += (float)acc[k][2 * i][1];
      a0.z += (float)acc[k][2 * i + 1][0]; a0.w += (float)acc[k][2 * i + 1][1];
      *(float4*)(xr + 4 * i) = a0;
    }
  }
}

#define XB_TMO      128
#define XB_XCNT(j)  (256  + 64 * (j))
#define XB_XSUB(j)  (1280 + 64 * (j))
#define XB_XGEN(j)  (2304 + 64 * (j))
#define XB_TOP      3328
#define XB_TOPGEN   3392
#define XCD_BAR_WORDS 3456
#define XB_SPIN_CAP (1u << 22)
#ifndef LAS
#define LAS __attribute__((address_space(3)))
#endif
__device__ __forceinline__ unsigned xb_ld(unsigned* p)              { return __hip_atomic_load(p, __ATOMIC_RELAXED, __HIP_MEMORY_SCOPE_AGENT); }
__device__ __forceinline__ unsigned xb_add(unsigned* p, unsigned v) { return __hip_atomic_fetch_add(p, v, __ATOMIC_RELAXED, __HIP_MEMORY_SCOPE_AGENT); }
__device__ __forceinline__ unsigned xb_xcc_id() { return (unsigned)__builtin_amdgcn_s_getreg((3 << 11) | 20) & 0xFu; }
#define XB_SPIN(cond, bar) do { unsigned _sp = 0; while (cond) { __builtin_amdgcn_s_sleep(1); \
    if ((++_sp & 255u) == 0u) { if (xb_ld(&(bar)[XB_TMO])) break; if (_sp > XB_SPIN_CAP) { atomicAdd(&(bar)[XB_TMO], 1u); break; } } } } while (0)
struct XcdBarrier { unsigned* bar; unsigned x; volatile LAS unsigned* st; };
__device__ __forceinline__ XcdBarrier xcd_barrier_post(unsigned* bar, volatile LAS unsigned* st, int tid) {
  XcdBarrier b; b.bar = bar; b.x = xb_xcc_id(); b.st = st;
  if (tid == 0) (void)xb_add(&bar[XB_XCNT(b.x)], 1u);
  return b;
}
__device__ __forceinline__ void xcd_barrier_complete(unsigned* bar, unsigned x, unsigned& nloc, unsigned& nx) {
  const unsigned G = gridDim.x * gridDim.y * gridDim.z;
  unsigned sum, cnt, mine, sp = 0u;
  for (;;) {
    sum = 0u; cnt = 0u; mine = 0u;
#pragma unroll
    for (unsigned j = 0; j < 16; ++j) { const unsigned c = xb_ld(&bar[XB_XCNT(j)]); sum += c; cnt += (c > 0u) ? 1u : 0u; mine = (j == x) ? c : mine; }
    if (sum == G) break;
    __builtin_amdgcn_s_sleep(1);
    if ((++sp & 255u) == 0u) { if (xb_ld(&bar[XB_TMO])) break; if (sp > XB_SPIN_CAP) { atomicAdd(&bar[XB_TMO], 1u); break; } }
  }
  nloc = mine > 0u ? mine : 1u; nx = cnt > 0u ? cnt : 1u;
}
__device__ __forceinline__ void xcd_barrier(const XcdBarrier& b, int tid) {
  asm volatile("s_waitcnt vmcnt(0)" ::: "memory");
  __syncthreads();
  if (tid == 0) {
    unsigned* bar = b.bar;
    __builtin_amdgcn_s_waitcnt(0);
    unsigned nloc = b.st[0], nx = b.st[1];
    if (nloc == 0u) { xcd_barrier_complete(bar, b.x, nloc, nx); b.st[0] = nloc; b.st[1] = nx; }
    const unsigned old = xb_add(&bar[XB_XSUB(b.x)], 1u);
    const unsigned gen = old / nloc;
    if (old + 1u == (gen + 1u) * nloc) {
      __builtin_amdgcn_fence(__ATOMIC_RELEASE, "agent");
      asm volatile("s_waitcnt vmcnt(0)" ::: "memory");
      const unsigned og = xb_add(&bar[XB_TOP], 1u);
      const unsigned tg = og / nx;
      if (og + 1u == (tg + 1u) * nx) xb_add(&bar[XB_TOPGEN], 1u);
      else XB_SPIN(xb_ld(&bar[XB_TOPGEN]) == tg, bar);
      __builtin_amdgcn_fence(__ATOMIC_ACQUIRE, "agent");
      xb_add(&bar[XB_XGEN(b.x)], 1u);
      asm volatile("s_waitcnt vmcnt(0)" ::: "memory");
    } else {
      XB_SPIN(xb_ld(&bar[XB_XGEN(b.x)]) == gen, bar);
      __builtin_amdgcn_fence(__ATOMIC_ACQUIRE, "agent");
      asm volatile("s_waitcnt vmcnt(0)" ::: "memory");
    }
  }
  __syncthreads();
}


__global__ void __launch_bounds__(NTHREADS) fwd_megakernel(Params p) {
  cg::grid_group grid = cg::this_grid();
  extern __shared__ __attribute__((aligned(16))) float smem[];
  const int wv_ = __builtin_amdgcn_readfirstlane((int)(threadIdx.x >> 6));
  volatile LAS unsigned* xb_st = (volatile LAS unsigned*)((LAS char*)(LAS float*)smem + (160 * 1024 - 16));
  if (threadIdx.x == 0) { xb_st[0] = 0u; xb_st[1] = 0u; }
  __syncthreads();
  const XcdBarrier xb = xcd_barrier_post(p.bar, xb_st, (int)threadIdx.x);
#define GRID_BARRIER() xcd_barrier(xb, opaque_tid(wv_))

  o_prep(wv_, p, smem);
  if (gridDim.x > 4096u) grid.sync();
  GRID_BARRIER();
#pragma unroll 1
  for (int l = 0; l < DEPTH; ++l) {
    const float* xcur = (l == 0) ? p.x_in : p.xres;
    o_p1(wv_, p, l, xcur, (char*)smem);
    GRID_BARRIER();
    {
    {
      const int bidx_ = opaque_bid();
      const bool affine = (gridDim.x == 256u);
      for (int task = bidx_; task < 1792; task += gridDim.x) {
        const int l_ = opaque_s(l), td_ = opaque_tid(wv_);
        int tk = task;
        if (affine) {
          const int x = bidx_ & 7, lb = bidx_ >> 3, j = task >> 8;
          if (j < 4) { const int idx = lb + 32 * j; tk = ((x * 2 + (idx >> 6)) << 6) | (idx & 63); }
          else if (j < 6) { const int idx = lb + 32 * (j - 4); tk = 1024 + (((x * 2 + (idx >> 5)) << 5) | (idx & 31)); }
          else tk = 1536 + x * 32 + lb;
        }
        const int tk_ = opaque_s(tk);
        if (tk_ < 1024) o_na_task(p, l_, tk_, (char*)smem, td_);
        else if (tk_ < 1536) o_ret_kv_task(p, l_, tk_ - 1024, (char*)smem, td_);
        else o_pool_task(p, l_, tk_ - 1536, (char*)smem, td_);
      }
    }
    GRID_BARRIER();
    o_ret_scan(wv_, p, l);
    GRID_BARRIER();
    {
      const int tidx_ = opaque_tid(wv_); const int bidx_ = opaque_bid();
      for (int task = bidx_; task < 512; task += gridDim.x) {
        int tk = task;
        if (gridDim.x == 256u) {
          const int x = bidx_ & 7, lb = bidx_ >> 3, idx = lb + 32 * (task >> 8);
          tk = ((x * 2 + (idx >> 5)) << 5) | (idx & 31);
        }
        o_ret_out_task(p, l, opaque_s(tk), (char*)smem, tidx_);
      }
    }
    GRID_BARRIER();
    }
    {
      const int tidx_ = opaque_tid(wv_); const int bidx_ = opaque_bid();
      for (int tile = bidx_; tile < NTOK / 64; tile += gridDim.x) {
        { const int t0_ = opaque_s(tile * 64), l_ = opaque_s(l), td_ = opaque_tid(wv_); o_p5a1_tile(p, l_, t0_, (char*)smem, td_); }
        { const int t0_ = opaque_s(tile * 64), l_ = opaque_s(l), td_ = opaque_tid(wv_); o_p5a2_tile(p, l_, xcur, t0_, (char*)smem, td_); }
        { const int t0_ = opaque_s(tile * 64), l_ = opaque_s(l), td_ = opaque_tid(wv_); o_p5a3_tile(p, l_, t0_, (char*)smem, td_); }
        { const int t0_ = opaque_s(tile * 64), l_ = opaque_s(l), td_ = opaque_tid(wv_); o_peer_select_tile(p, l_, t0_, (char*)smem, td_); }
        { const int t0_ = opaque_s(tile * 64), l_ = opaque_s(l), td_ = opaque_tid(wv_); o_peer_select2_tile(p, l_, t0_, td_); }
        asm volatile("s_waitcnt vmcnt(0)" ::: "memory");
        __syncthreads();
        { const int t0_ = opaque_s(tile * 64), l_ = opaque_s(l), td_ = opaque_tid(wv_); o_peer_experts7_tile(p, l_, t0_, (const char*)smem, td_); }
        if (l + 1 == DEPTH) {
          asm volatile("s_waitcnt vmcnt(0)" ::: "memory");
          const int t0_ = opaque_s(tile * 64), td_ = opaque_tid(wv_);
          o_final_norm_tile(p, t0_, td_);
        }
      }
    }
    if (l + 1 < DEPTH) GRID_BARRIER();
  }
}

extern "C" void kernel_launch(void* const* d_in, const int* in_sizes, int n_in, void* d_out, int out_size,
                              void* d_ws, size_t ws_size, hipStream_t stream) {
  Params p{};
  p.x_in = (const float*)d_in[0]; p.norm_mix = (const float*)d_in[1]; p.w_in = (const float*)d_in[2];
  p.pool_w = (const float*)d_in[3]; p.pool_scale = (const float*)d_in[4]; p.ret_decay = (const float*)d_in[5];
  p.na_rpb = (const float*)d_in[6]; p.w_br_pool = (const float*)d_in[7]; p.w_br_ret = (const float*)d_in[8];
  p.w_br_na = (const float*)d_in[9]; p.w_out = (const float*)d_in[10]; p.norm_ffn = (const float*)d_in[11];
  p.w_query = (const float*)d_in[12]; p.sub_keys = (const float*)d_in[13]; p.peer_u = (const float*)d_in[14];
  p.peer_v = (const float*)d_in[15]; p.norm_final = (const float*)d_in[16];
  p.out = (float*)d_out;
  char* ws = (char*)d_ws;
  size_t off = 0;
  auto alloc = [&](size_t bytes) { char* q = ws + off; off += (bytes + 255) & ~(size_t)255; return q; };
  p.xres = (float*)alloc((size_t)NTOK * D_MODEL * 4);
  p.proj = (bf16_t*)alloc((size_t)NTOK * IN_WIDTH * 2);
  p.ycat = (bf16_t*)alloc((size_t)NTOK * 1024 * 2);
  p.mrg = (bf16_t*)alloc((size_t)NTOK * 1024 * 2);
  p.pidx = (int*)alloc((size_t)NTOK * 128 * 4);
  p.pgate = (float*)alloc((size_t)NTOK * 128 * 4);
  p.wf_in = (bf16_t*)alloc((size_t)DEPTH * D_MODEL * IN_WIDTH * 2);
  p.wf_br = (bf16_t*)alloc((size_t)DEPTH * 1024 * 1024 * 2);
  p.wf_out = (bf16_t*)alloc((size_t)DEPTH * 1024 * 1024 * 2);
  p.wf_q = (bf16_t*)alloc((size_t)DEPTH * 1024 * 2048 * 2);
  p.kf = (bf16_t*)alloc((size_t)DEPTH * 2 * 128 * 128 * 2);
  p.u16 = nullptr; p.v16 = nullptr;
  p.u8 = (unsigned char*)alloc((size_t)DEPTH * 16384 * 1024);
  p.v8 = (unsigned char*)alloc((size_t)DEPTH * 16384 * 1024);
  p.escale = (float2*)alloc((size_t)DEPTH * 16384 * 8);
  p.rope = (float2*)alloc((size_t)SEQ * 32 * 8);
  p.tklist = (unsigned*)alloc((size_t)NTOK * 8 * 2 * 16 * 4);
  p.kvst = (float*)p.mrg;
  p.rstate = (bf16_t*)p.tklist;
  p.bar = (unsigned*)alloc(XCD_BAR_WORDS * 4);
  p.xn = nullptr; p.merged = nullptr; p.pq = nullptr; p.psc = nullptr;
  if (off > ws_size) fprintf(stderr, "WORKSPACE OVERFLOW: need %zu have %zu\n", off, ws_size);

  const size_t kDynLds = 160 * 1024;
  static int grid_blocks = 0;
  if (!grid_blocks) {
    int dev = 0, cus = 0, per_cu = 0;
    (void)hipGetDevice(&dev);
    (void)hipDeviceGetAttribute(&cus, hipDeviceAttributeMultiprocessorCount, dev);
    (void)hipFuncSetAttribute((const void*)fwd_megakernel, hipFuncAttributeMaxDynamicSharedMemorySize, (int)kDynLds);
    (void)hipOccupancyMaxActiveBlocksPerMultiprocessor(&per_cu, fwd_megakernel, NTHREADS, kDynLds);
    if (per_cu < 1) per_cu = 1;
    grid_blocks = cus * per_cu;
  }
  (void)hipMemsetAsync(p.bar, 0, XCD_BAR_WORDS * 4, stream);
  void* args[] = {&p};
  hipError_t e = hipLaunchCooperativeKernel((void*)fwd_megakernel, dim3(grid_blocks), dim3(NTHREADS), args, kDynLds, stream);
  if (e != hipSuccess) fprintf(stderr, "cooperative launch failed: %s (grid %d)\n", hipGetErrorString(e), grid_blocks);
}
```

```cpp
#include <hip/hip_runtime.h>
#include <hip/hip_cooperative_groups.h>
#include <stdint.h>
#include <cstdio>
namespace cg = cooperative_groups;

#define D_MODEL 1024
#define SEQ 4096
#define BATCH 4
#define NTOK (BATCH * SEQ)
#define DEPTH 2
#define IN_WIDTH 5632
#define C_POOL 0
#define C_RQ 256
#define C_RK 512
#define C_RV 768
#define C_RG 1280
#define C_NQ 1792
#define C_NK 2048
#define C_NV 2304
#define C_GATE 2560
#define EPS 1e-6f
#define NTHREADS 512

typedef unsigned short bf16_t;

struct Params {
  const float* x_in; const float* norm_mix; const float* w_in; const float* pool_w; const float* pool_scale;
  const float* ret_decay; const float* na_rpb; const float* w_br_pool; const float* w_br_ret; const float* w_br_na;
  const float* w_out; const float* norm_ffn; const float* w_query; const float* sub_keys; const float* peer_u;
  const float* peer_v; const float* norm_final;
  float* out;
  float* xres;
  bf16_t* xn;
  bf16_t* proj;
  bf16_t* ycat;
  float* merged;
  float* pq;
  float* psc;
  int* pidx;
  float* pgate;
  bf16_t* wf_in;
  bf16_t* wf_br;
  bf16_t* wf_out;
  bf16_t* wf_q;
  bf16_t* kf;
  bf16_t* u16;
  bf16_t* v16;
  float2* rope;
  bf16_t* mrg;
  unsigned* tklist;
  float* kvst;
  bf16_t* rstate;
  unsigned* bar;
  unsigned char* u8; unsigned char* v8;
  float2* escale;
};

__device__ __forceinline__ bf16_t f2bf(float f) {
  unsigned u = __float_as_uint(f);
  u += 0x7fffu + ((u >> 16) & 1u);
  return (bf16_t)(u >> 16);
}
__device__ __forceinline__ float bf2f(bf16_t h) { return __uint_as_float(((unsigned)h) << 16); }

__device__ __forceinline__ float wave_sum(float v) {
#pragma unroll
  for (int o = 32; o > 0; o >>= 1) v += __shfl_xor(v, o, 64);
  return v;
}
__device__ __forceinline__ float wave_max(float v) {
#pragma unroll
  for (int o = 32; o > 0; o >>= 1) v = fmaxf(v, __shfl_xor(v, o, 64));
  return v;
}
__device__ __forceinline__ float sigmoidf_(float x) { return 1.0f / (1.0f + expf(-x)); }

__device__ __forceinline__ int opaque_tid(int wv) {
  int w = wv;
  asm volatile("" : "+s"(w));
  int lane = __builtin_amdgcn_mbcnt_hi(~0u, __builtin_amdgcn_mbcnt_lo(~0u, 0u));
  asm volatile("" : "+v"(lane));
  return w * 64 + lane;
}
__device__ __forceinline__ int opaque_s(int x) { asm volatile("" : "+s"(x)); return x; }
__device__ __forceinline__ int opaque_bid() { int b = blockIdx.x; asm volatile("" : "+s"(b)); return b; }

template <bool OUT_F32>
__device__ __forceinline__ void n_rmsnorm(const int wv_, const float* __restrict__ x, const float* __restrict__ g, void* outp, int rows) {
  const int tidx_ = opaque_tid(wv_); const int bidx_ = opaque_bid();
  const int lane = tidx_ & 63;
  const int nw = gridDim.x * (NTHREADS / 64);
  for (int row = bidx_ * (NTHREADS / 64) + (tidx_ >> 6); row < rows; row += nw) {
    const float* xr = x + (size_t)row * D_MODEL;
    float4 v[4];
    float ss = 0.f;
#pragma unroll
    for (int i = 0; i < 4; ++i) {
      v[i] = *(const float4*)(xr + i * 256 + lane * 4);
      ss += v[i].x * v[i].x + v[i].y * v[i].y + v[i].z * v[i].z + v[i].w * v[i].w;
    }
    ss = wave_sum(ss);
    float r = rsqrtf(ss * (1.0f / D_MODEL) + EPS);
#pragma unroll
    for (int i = 0; i < 4; ++i) {
      float4 gg = *(const float4*)(g + i * 256 + lane * 4);
      float o0 = v[i].x * r * gg.x, o1 = v[i].y * r * gg.y, o2 = v[i].z * r * gg.z, o3 = v[i].w * r * gg.w;
      if (OUT_F32) {
        *(float4*)((float*)outp + (size_t)row * D_MODEL + i * 256 + lane * 4) = make_float4(o0, o1, o2, o3);
      } else {
        ushort4 o; o.x = f2bf(o0); o.y = f2bf(o1); o.z = f2bf(o2); o.w = f2bf(o3);
        *(ushort4*)((bf16_t*)outp + (size_t)row * D_MODEL + i * 256 + lane * 4) = o;
      }
    }
  }
}

typedef __attribute__((ext_vector_type(8))) short bf16x8;
typedef __attribute__((ext_vector_type(4))) float f32x4;
#define LDX 1032
#define LDXB (LDX * 2)
#define XTILE_BYTES (64 * LDXB)

__device__ __forceinline__ unsigned pack2bf(float a, float b) { return (unsigned)f2bf(a) | ((unsigned)f2bf(b) << 16); }

__device__ __forceinline__ void prep_frag(const int wv_, const float* __restrict__ W, int K, int N, bf16_t* __restrict__ dst, float* smem) {
  const int tidx_ = opaque_tid(wv_); const int bidx_ = opaque_bid();
  const int grp = tidx_ >> 8, tid = tidx_ & 255;
  float(*T)[65] = (float(*)[65])(smem + grp * 32 * 65);
  const int KS = K / 32, NC = N / 64;
  const int ntiles = KS * NC;
  for (int wb = bidx_ * 2; wb < ntiles; wb += gridDim.x * 2) {
    const int w = wb + grp;
    const int c = w / KS, ks = w - c * KS;
    {
      const int row = tid >> 3, col = (tid & 7) * 8;
      const float* src = W + (size_t)(ks * 32 + row) * N + c * 64 + col;
      float4 a = *(const float4*)src, b = *(const float4*)(src + 4);
      __syncthreads();
      T[row][col + 0] = a.x; T[row][col + 1] = a.y; T[row][col + 2] = a.z; T[row][col + 3] = a.w;
      T[row][col + 4] = b.x; T[row][col + 5] = b.y; T[row][col + 6] = b.z; T[row][col + 7] = b.w;
    }
    __syncthreads();
    {
      const int nt = tid >> 6, lane = tid & 63;
      const int kr = 8 * (lane >> 4), nc = nt * 16 + (lane & 15);
      uint4 o;
      o.x = pack2bf(T[kr + 0][nc], T[kr + 1][nc]);
      o.y = pack2bf(T[kr + 2][nc], T[kr + 3][nc]);
      o.z = pack2bf(T[kr + 4][nc], T[kr + 5][nc]);
      o.w = pack2bf(T[kr + 6][nc], T[kr + 7][nc]);
      *(uint4*)(dst + ((size_t)((c * KS + ks) * 4 + nt) * 64 + lane) * 8) = o;
    }
  }
}

__device__ __forceinline__ void o_prep(const int wv_, const Params& p, float* smem) {
  for (int l = 0; l < DEPTH; ++l) {
    prep_frag(wv_, p.w_in + (size_t)l * D_MODEL * IN_WIDTH, D_MODEL, IN_WIDTH, p.wf_in + (size_t)l * D_MODEL * IN_WIDTH, smem);
    prep_frag(wv_, p.w_br_pool + (size_t)l * 256 * 1024, 256, 1024, p.wf_br + (size_t)l * 1024 * 1024, smem);
    prep_frag(wv_, p.w_br_ret + (size_t)l * 512 * 1024, 512, 1024, p.wf_br + (size_t)l * 1024 * 1024 + 256 * 1024, smem);
    prep_frag(wv_, p.w_br_na + (size_t)l * 256 * 1024, 256, 1024, p.wf_br + (size_t)l * 1024 * 1024 + 768 * 1024, smem);
    prep_frag(wv_, p.w_out + (size_t)l * 1024 * 1024, 1024, 1024, p.wf_out + (size_t)l * 1024 * 1024, smem);
    prep_frag(wv_, p.w_query + (size_t)l * 1024 * 2048, 1024, 2048, p.wf_q + (size_t)l * 1024 * 2048, smem);
  }
  const int tidx_ = opaque_tid(wv_); const int bidx_ = opaque_bid();
  const int gtid = bidx_ * NTHREADS + tidx_, gsz = gridDim.x * NTHREADS;
  for (int u = gtid; u < DEPTH * 2 * 8 * 4 * 64; u += gsz) {
    const int lane = u & 63, s2 = (u >> 6) & 3, kt = (u >> 8) & 7, lp = u >> 11;
    const float* kr = p.sub_keys + ((size_t)lp * 128 + kt * 16 + (lane & 15)) * 128;
    float v[8];
#pragma unroll
    for (int j = 0; j < 8; ++j) v[j] = kr[16 * (2 * s2 + (j >> 2)) + 4 * (lane >> 4) + (j & 3)];
    uint4 o;
    o.x = pack2bf(v[0], v[1]); o.y = pack2bf(v[2], v[3]); o.z = pack2bf(v[4], v[5]); o.w = pack2bf(v[6], v[7]);
    *(uint4*)(p.kf + (size_t)u * 8) = o;
  }
  {
    const int lane = tidx_ & 63;
    const int gw = (bidx_ * NTHREADS + tidx_) >> 6, nw = gsz >> 6;
    for (int row = gw; row < DEPTH * 16384 * 2; row += nw) {
      const int tbl = row & 1, er = row >> 1;
      const float* src = (tbl ? p.peer_v : p.peer_u) + (size_t)er * 1024 + lane * 16;
      float4 f[4];
#pragma unroll
      for (int i = 0; i < 4; ++i) f[i] = *(const float4*)(src + 4 * i);
      float m = 0.f;
#pragma unroll
      for (int i = 0; i < 4; ++i) m = fmaxf(m, fmaxf(fmaxf(fabsf(f[i].x), fabsf(f[i].y)), fmaxf(fabsf(f[i].z), fabsf(f[i].w))));
      m = wave_max(m);
      int k = 0;
      if (m > 0.f) {
        int e;
        const float fr = __builtin_frexpf(m, &e);
        k = ((fr <= 0.875f) ? 9 : 8) - e;
        k = k < -100 ? -100 : (k > 100 ? 100 : k);
      }
      const float sc = __builtin_ldexpf(1.0f, k);
      uint4 o;
      unsigned w[4];
#pragma unroll
      for (int i = 0; i < 4; ++i) {
        int pkd = 0;
        pkd = __builtin_amdgcn_cvt_pk_fp8_f32(f[i].x * sc, f[i].y * sc, pkd, false);
        pkd = __builtin_amdgcn_cvt_pk_fp8_f32(f[i].z * sc, f[i].w * sc, pkd, true);
        w[i] = (unsigned)pkd;
      }
      o.x = w[0]; o.y = w[1]; o.z = w[2]; o.w = w[3];
      *(uint4*)((tbl ? p.v8 : p.u8) + (size_t)er * 1024 + lane * 16) = o;
      if (lane == 0) ((float*)p.escale)[(size_t)er * 2 + tbl] = __builtin_ldexpf(1.0f, -k);
    }
  }
  for (int u = gtid; u < SEQ * 32; u += gsz) {
    const int i = u & 31, pos = u >> 5;
    float inv = 1.0f / powf(10000.0f, (float)i / 31.0f);
    float ang = (float)pos * inv;
    double rev = (double)ang * 0.15915494309189535;
    rev -= floor(rev);
    float rf = (float)rev;
    p.rope[u] = make_float2(__builtin_amdgcn_cosf(rf), __builtin_amdgcn_sinf(rf));
  }
}

template <int NT, int PD, int RING>
__device__ __forceinline__ void tl_gemm_prologue(const bf16_t* __restrict__ wf, bf16x8 (&wb)[RING][NT], const int lane, const int nt0 = 0) {
  const bf16x8* wp = (const bf16x8*)wf + lane + nt0 * 64;
#pragma unroll
  for (int s = 0; s < PD; ++s)
#pragma unroll
    for (int nt = 0; nt < NT; ++nt) wb[s][nt] = wp[(s * 4 + nt) * 64];
}
template <int NT, int PD, int RING>
__device__ __forceinline__ void tl_gemm_main(const bf16_t* __restrict__ wf, const int KS, const char* xt, const int kbyte0,
                                             f32x4 (&acc)[NT][4], bf16x8 (&wb)[RING][NT], const int lane, const int nt0 = 0) {
  const bf16x8* wp = (const bf16x8*)wf + lane + nt0 * 64;
  const char* xp = xt + (lane & 15) * LDXB + kbyte0 + (lane >> 4) * 16;
  for (int ks = 0; ks < KS; ks += RING) {
#pragma unroll
    for (int u = 0; u < RING; ++u) {
      int kpre = ks + u + PD;
      kpre = kpre < KS ? kpre : KS - 1;
#pragma unroll
      for (int nt = 0; nt < NT; ++nt) wb[(u + PD) % RING][nt] = wp[(kpre * 4 + nt) * 64];
      __builtin_amdgcn_s_setprio(1);
      bf16x8 xf[4];
#pragma unroll
      for (int mt = 0; mt < 4; ++mt) xf[mt] = *(const bf16x8*)(xp + mt * 16 * LDXB + (ks + u) * 64);
#pragma unroll
      for (int nt = 0; nt < NT; ++nt)
#pragma unroll
        for (int mt = 0; mt < 4; ++mt)
          acc[nt][mt] = __builtin_amdgcn_mfma_f32_16x16x32_bf16(wb[u][nt], xf[mt], acc[nt][mt], 0, 0, 0);
      __builtin_amdgcn_s_setprio(0);
    }
  }
}
template <int NT, int PD = 3, int RING = 4>
__device__ __forceinline__ void tl_gemm_chunk(const bf16_t* __restrict__ wf, const int KS, const char* xt, const int kbyte0,
                                              f32x4 (&acc)[NT][4], const int lane, const int nt0 = 0) {
  bf16x8 wb[RING][NT];
  tl_gemm_prologue<NT, PD, RING>(wf, wb, lane, nt0);
  tl_gemm_main<NT, PD, RING>(wf, KS, xt, kbyte0, acc, wb, lane, nt0);
}

__device__ __forceinline__ void tile_rmsnorm_to_lds(const float* __restrict__ xsrc, const float* __restrict__ g, int t0,
                                                    char* xt, int wave, int lane) {
#pragma unroll 2
  for (int i = 0; i < 8; ++i) {
    const int tok = wave * 8 + i;
    const float* xr = xsrc + (size_t)(t0 + tok) * D_MODEL;
    float4 v[4];
    float ss = 0.f;
#pragma unroll
    for (int q = 0; q < 4; ++q) {
      v[q] = *(const float4*)(xr + q * 256 + lane * 4);
      ss += v[q].x * v[q].x + v[q].y * v[q].y + v[q].z * v[q].z + v[q].w * v[q].w;
    }
    ss = wave_sum(ss);
    const float r = rsqrtf(ss * (1.0f / D_MODEL) + EPS);
#pragma unroll
    for (int q = 0; q < 4; ++q) {
      float4 gg = *(const float4*)(g + q * 256 + lane * 4);
      uint2 o;
      o.x = pack2bf(v[q].x * r * gg.x, v[q].y * r * gg.y);
      o.y = pack2bf(v[q].z * r * gg.z, v[q].w * r * gg.w);
      *(uint2*)(xt + tok * LDXB + (q * 256 + lane * 4) * 2) = o;
    }
  }
}

__device__ __forceinline__ void o_p1(const int wv_, const Params& p, int l, const float* __restrict__ xsrc, char* smem) {
  const int tidx_ = opaque_tid(wv_); const int bidx_ = opaque_bid();
  const int wave = tidx_ >> 6, lane = tidx_ & 63;
  const bf16_t* wf = p.wf_in + (size_t)l * D_MODEL * IN_WIDTH;
  const float* g = p.norm_mix + l * D_MODEL;
  for (int tile = bidx_; tile < NTOK / 64; tile += gridDim.x) {
    const int t0 = tile * 64;
    __syncthreads();
    tile_rmsnorm_to_lds(xsrc, g, t0, smem, wave, lane);
    __syncthreads();
#pragma unroll 1
    for (int c = wave; c < IN_WIDTH / 64; c += 8) {
      f32x4 acc[4][4];
#pragma unroll
      for (int a = 0; a < 4; ++a)
#pragma unroll
        for (int b = 0; b < 4; ++b) acc[a][b] = (f32x4){0.f, 0.f, 0.f, 0.f};
      tl_gemm_chunk<4, 3, 4>(wf + (size_t)c * 32 * 4 * 64 * 8, 32, smem, 0, acc, lane);
      asm volatile("" ::: "memory");
      if (c >= 4 && c < 12) {
        const float sc = (c >= 8) ? 0.125f : 1.0f;
#pragma unroll
        for (int mt = 0; mt < 4; ++mt) {
          const int tok = t0 + mt * 16 + (lane & 15);
          const int pos = tok & (SEQ - 1);
#pragma unroll
          for (int nt = 0; nt < 2; ++nt) {
            const int i0 = nt * 16 + 4 * (lane >> 4);
            const float4 cs01 = *(const float4*)(p.rope + pos * 32 + i0);
            const float4 cs23 = *(const float4*)(p.rope + pos * 32 + i0 + 2);
            const float cc[4] = {cs01.x, cs01.z, cs23.x, cs23.z};
            const float sn[4] = {cs01.y, cs01.w, cs23.y, cs23.w};
#pragma unroll
            for (int r = 0; r < 4; ++r) {
              const float x1 = acc[nt][mt][r], x2 = acc[nt + 2][mt][r];
              acc[nt][mt][r] = (x1 * cc[r] - x2 * sn[r]) * sc;
              acc[nt + 2][mt][r] = (x1 * sn[r] + x2 * cc[r]) * sc;
            }
          }
        }
      } else if (c >= 28 && c < 32) {
#pragma unroll
        for (int a = 0; a < 4; ++a)
#pragma unroll
          for (int b = 0; b < 4; ++b) acc[a][b] *= 0.125f;
      } else if (c >= 40) {
#pragma unroll
        for (int a = 0; a < 4; ++a)
#pragma unroll
          for (int b = 0; b < 4; ++b)
#pragma unroll
            for (int r = 0; r < 4; ++r) acc[a][b][r] = 1.0f / (1.0f + __expf(-acc[a][b][r]));
      }
      {
        char* patch = smem + XTILE_BYTES + wave * 2304;
#pragma unroll
        for (int mt = 0; mt < 4; ++mt) {
#pragma unroll
          for (int nt = 0; nt < 4; ++nt) {
            uint2 o;
            o.x = pack2bf(acc[nt][mt][0], acc[nt][mt][1]);
            o.y = pack2bf(acc[nt][mt][2], acc[nt][mt][3]);
            *(uint2*)(patch + (lane & 15) * 144 + (nt * 16 + 4 * (lane >> 4)) * 2) = o;
          }
#pragma unroll
          for (int h = 0; h < 2; ++h) {
            const int row = h * 8 + (lane >> 3), unit = lane & 7;
            const uint4 v = *(const uint4*)(patch + row * 144 + unit * 16);
            *(uint4*)(p.proj + (size_t)(t0 + mt * 16 + row) * IN_WIDTH + c * 64 + unit * 8) = v;
          }
        }
      }
    }
  }
}


__device__ __forceinline__ void o_final_norm_tile(const Params& p, int t0, int tid) {
  const int wave = tid >> 6, lane = tid & 63;
#pragma unroll 2
  for (int i = 0; i < 8; ++i) {
    const size_t row = (size_t)(t0 + wave * 8 + i) * D_MODEL;
    float4 v[4];
    float ss = 0.f;
#pragma unroll
    for (int q = 0; q < 4; ++q) {
      v[q] = *(const float4*)(p.xres + row + q * 256 + lane * 4);
      ss += v[q].x * v[q].x + v[q].y * v[q].y + v[q].z * v[q].z + v[q].w * v[q].w;
    }
    ss = wave_sum(ss);
    const float r = rsqrtf(ss * (1.0f / D_MODEL) + EPS);
#pragma unroll
    for (int q = 0; q < 4; ++q) {
      const float4 gg = *(const float4*)(p.norm_final + q * 256 + lane * 4);
      *(float4*)(p.out + row + q * 256 + lane * 4) = make_float4(v[q].x * r * gg.x, v[q].y * r * gg.y, v[q].z * r * gg.z, v[q].w * r * gg.w);
    }
  }
}

__device__ __forceinline__ void tile_load_to_lds(const bf16_t* __restrict__ src, int ld, char* xt, int tid) {
#pragma unroll 4
  for (int it = 0; it < 16; ++it) {
    const int idx = it * NTHREADS + tid;
    const int row = idx >> 7, u = idx & 127;
    const uint4 v = *(const uint4*)(src + (size_t)row * ld + u * 8);
    *(uint4*)(xt + row * LDXB + u * 16) = v;
  }
}

__device__ __forceinline__ void o_p5a1_tile(const Params& p, int l, int t0, char* smem, int tid) {
  const int wave = tid >> 6, lane = tid & 63;
  __syncthreads();
  tile_load_to_lds(p.ycat + (size_t)t0 * 1024, 1024, smem, tid);
  __syncthreads();
  const bf16_t* wfb = p.wf_br + (size_t)l * 1024 * 1024;
  bf16x8 wb[4][2];
  f32x4 m[2][4];
  {
    const int c0 = wave >> 1, nt00 = (wave & 1) * 2;
    tl_gemm_prologue<2, 3, 4>(wfb + (size_t)c0 * 8 * 4 * 64 * 8, wb, lane, nt00);
  }
#pragma unroll 1
  for (int it = 0; it < 12; ++it) {
    const int hi = it / 3, br = it - hi * 3;
    const int hc = wave + 8 * hi;
    const int c = hc >> 1, nt0 = (hc & 1) * 2;
    const int koff = (br == 0) ? 0 : (br == 1 ? 256 : 768);
    const int KS = (br == 1) ? 16 : 8;
    uint2 gv[4][2];
#pragma unroll
    for (int mt = 0; mt < 4; ++mt) {
      const int tok = t0 + mt * 16 + (lane & 15);
      const bf16_t* gp = p.proj + (size_t)tok * IN_WIDTH + C_GATE + br * 1024 + c * 64 + nt0 * 16 + 4 * (lane >> 4);
#pragma unroll
      for (int nt = 0; nt < 2; ++nt) gv[mt][nt] = *(const uint2*)(gp + nt * 16);
    }
    f32x4 acc[2][4];
#pragma unroll
    for (int a2 = 0; a2 < 2; ++a2)
#pragma unroll
      for (int b2 = 0; b2 < 4; ++b2) acc[a2][b2] = (f32x4){0.f, 0.f, 0.f, 0.f};
    tl_gemm_main<2, 3, 4>(wfb + (size_t)koff * 1024 + (size_t)c * KS * 4 * 64 * 8, KS, smem, koff * 2, acc, wb, lane, nt0);
    asm volatile("" ::: "memory");
    {
      const int itn = (it + 1 < 12) ? it + 1 : it;
      const int hin = itn / 3, brn = itn - hin * 3;
      const int hcn = wave + 8 * hin;
      const int koffn = (brn == 0) ? 0 : (brn == 1 ? 256 : 768);
      const int KSn = (brn == 1) ? 16 : 8;
      tl_gemm_prologue<2, 3, 4>(wfb + (size_t)koffn * 1024 + (size_t)(hcn >> 1) * KSn * 4 * 64 * 8, wb, lane, (hcn & 1) * 2);
    }
    if (br == 0) {
#pragma unroll
      for (int a2 = 0; a2 < 2; ++a2)
#pragma unroll
        for (int b2 = 0; b2 < 4; ++b2) m[a2][b2] = (f32x4){0.f, 0.f, 0.f, 0.f};
    }
#pragma unroll
    for (int mt = 0; mt < 4; ++mt)
#pragma unroll
      for (int nt = 0; nt < 2; ++nt) {
        m[nt][mt][0] += __uint_as_float(gv[mt][nt].x << 16) * acc[nt][mt][0];
        m[nt][mt][1] += __uint_as_float(gv[mt][nt].x & 0xffff0000u) * acc[nt][mt][1];
        m[nt][mt][2] += __uint_as_float(gv[mt][nt].y << 16) * acc[nt][mt][2];
        m[nt][mt][3] += __uint_as_float(gv[mt][nt].y & 0xffff0000u) * acc[nt][mt][3];
      }
    if (br == 2) {
#pragma unroll
      for (int mt = 0; mt < 4; ++mt) {
        const int tok = t0 + mt * 16 + (lane & 15);
        bf16_t* dst = p.mrg + (size_t)tok * 1024 + c * 64 + nt0 * 16 + 4 * (lane >> 4);
#pragma unroll
        for (int nt = 0; nt < 2; ++nt) {
          uint2 o;
          o.x = pack2bf(m[nt][mt][0], m[nt][mt][1]);
          o.y = pack2bf(m[nt][mt][2], m[nt][mt][3]);
          *(uint2*)(dst + nt * 16) = o;
        }
      }
    }
  }
}
__device__ __forceinline__ void o_p5a2_tile(const Params& p, int l, const float* __restrict__ xcur, int t0, char* smem, int tid) {
  const int wave = tid >> 6, lane = tid & 63;
  __syncthreads();
  tile_load_to_lds(p.mrg + (size_t)t0 * 1024, 1024, smem, tid);
  __syncthreads();
  const bf16_t* wfo = p.wf_out + (size_t)l * 1024 * 1024;
#pragma unroll 1
  for (int c = wave; c < 16; c += 8) {
    f32x4 acc[4][4];
#pragma unroll
    for (int a = 0; a < 4; ++a)
#pragma unroll
      for (int b = 0; b < 4; ++b) acc[a][b] = (f32x4){0.f, 0.f, 0.f, 0.f};
    tl_gemm_chunk<4, 2>(wfo + (size_t)c * 32 * 4 * 64 * 8, 32, smem, 0, acc, lane);
    asm volatile("" ::: "memory");
#pragma unroll
    for (int mt = 0; mt < 4; ++mt) {
      const int tok = t0 + mt * 16 + (lane & 15);
      const size_t o = (size_t)tok * 1024 + c * 64 + 4 * (lane >> 4);
#pragma unroll
      for (int nt = 0; nt < 4; ++nt) {
        float4 xv = *(const float4*)(xcur + o + nt * 16);
        xv.x += acc[nt][mt][0]; xv.y += acc[nt][mt][1]; xv.z += acc[nt][mt][2]; xv.w += acc[nt][mt][3];
        *(float4*)(p.xres + o + nt * 16) = xv;
      }
    }
  }
}
__device__ __forceinline__ void o_p5a3_tile(const Params& p, int l, int t0, char* smem, int tid) {
  const int wave = tid >> 6, lane = tid & 63;
  __syncthreads();
  tile_rmsnorm_to_lds(p.xres, p.norm_ffn + l * D_MODEL, t0, smem, wave, lane);
  __syncthreads();
}


__device__ __forceinline__ unsigned mono_f(float f) {
  unsigned u = __float_as_uint(f);
  return (u & 0x80000000u) ? ~u : (u | 0x80000000u);
}
__device__ __forceinline__ float unmono_f(unsigned m) {
  return __uint_as_float((m & 0x80000000u) ? (m & 0x7fffffffu) : ~m);
}
#define CE_DESC(x, y) { const unsigned hi_ = max(x, y); const unsigned lo_ = min(x, y); x = hi_; y = lo_; }
#define CE_ASC(x, y) { const unsigned hi_ = max(x, y); const unsigned lo_ = min(x, y); x = lo_; y = hi_; }
__device__ __forceinline__ void sort16_desc(unsigned (&a)[16]) {
#pragma unroll
  for (int k = 2; k <= 16; k <<= 1) {
#pragma unroll
    for (int j = k >> 1; j > 0; j >>= 1) {
#pragma unroll
      for (int i = 0; i < 16; ++i) {
        const int l = i ^ j;
        if (l > i) {
          if ((i & k) == 0) CE_DESC(a[i], a[l]) else CE_ASC(a[i], a[l])
        }
      }
    }
  }
}
__device__ __forceinline__ void bitonic_merge16_desc(unsigned (&a)[16]) {
#pragma unroll
  for (int j = 8; j > 0; j >>= 1) {
#pragma unroll
    for (int i = 0; i < 16; ++i) {
      const int l = i ^ j;
      if (l > i) CE_DESC(a[i], a[l])
    }
  }
}
__device__ __forceinline__ void xlane_merge16(unsigned (&a)[16], int mask) {
  unsigned b[16];
#pragma unroll
  for (int i = 0; i < 16; ++i) b[i] = (unsigned)__shfl_xor((int)a[i], mask, 64);
#pragma unroll
  for (int i = 0; i < 16; ++i) a[i] = max(a[i], b[15 - i]);
  bitonic_merge16_desc(a);
}

__device__ __forceinline__ void o_peer_select_tile(const Params& p, int l, int t0, char* smem, int tid) {
  const int h = __builtin_amdgcn_readfirstlane(tid >> 6), lane = tid & 63;
  const int g = lane >> 4, tl = lane & 15;
  const bf16_t* wfq = p.wf_q + (size_t)l * 1024 * 2048;
#pragma unroll 1
  for (int pp = 0; pp < 2; ++pp) {
    bf16x8 qf[4][4];
#pragma unroll 1
    for (int cc = 0; cc < 2; ++cc) {
      const int c = (h * 2 + pp) * 2 + cc;
      f32x4 acc[4][4];
#pragma unroll
      for (int a = 0; a < 4; ++a)
#pragma unroll
        for (int b = 0; b < 4; ++b) acc[a][b] = (f32x4){0.f, 0.f, 0.f, 0.f};
      tl_gemm_chunk<4, 2>(wfq + (size_t)c * 32 * 4 * 64 * 8, 32, smem, 0, acc, lane);
#pragma unroll
      for (int sl = 0; sl < 2; ++sl)
#pragma unroll
        for (int mt = 0; mt < 4; ++mt) {
          union { bf16x8 v; unsigned u[4]; } cv;
          cv.u[0] = pack2bf(acc[2 * sl][mt][0], acc[2 * sl][mt][1]);
          cv.u[1] = pack2bf(acc[2 * sl][mt][2], acc[2 * sl][mt][3]);
          cv.u[2] = pack2bf(acc[2 * sl + 1][mt][0], acc[2 * sl + 1][mt][1]);
          cv.u[3] = pack2bf(acc[2 * sl + 1][mt][2], acc[2 * sl + 1][mt][3]);
          if (cc == 0) qf[sl][mt] = cv.v; else qf[2 + sl][mt] = cv.v;
        }
    }
    const bf16x8* kfp = (const bf16x8*)p.kf + (size_t)((l * 2 + pp) * 8) * 4 * 64 + lane;
#pragma unroll
    for (int mt = 0; mt < 4; ++mt) {
      f32x4 sc[8];
#pragma unroll
      for (int kt = 0; kt < 8; ++kt) sc[kt] = (f32x4){0.f, 0.f, 0.f, 0.f};
#pragma unroll
      for (int s2 = 0; s2 < 4; ++s2) {
        bf16x8 qv;
        qv = qf[s2][mt];
#pragma unroll
        for (int kt = 0; kt < 8; ++kt)
          sc[kt] = __builtin_amdgcn_mfma_f32_16x16x32_bf16(kfp[(kt * 4 + s2) * 64], qv, sc[kt], 0, 0, 0);
        __builtin_amdgcn_sched_barrier(0);
      }
      unsigned A[16], B[16];
#pragma unroll
      for (int kt = 0; kt < 4; ++kt)
#pragma unroll
        for (int r = 0; r < 4; ++r) {
          A[kt * 4 + r] = (mono_f(sc[kt][r]) & ~127u) | (unsigned)(127 - (kt * 16 + r) - 4 * g);
          B[kt * 4 + r] = (mono_f(sc[kt + 4][r]) & ~127u) | (unsigned)(127 - ((kt + 4) * 16 + r) - 4 * g);
        }
      sort16_desc(A);
      sort16_desc(B);
#pragma unroll
      for (int i = 0; i < 16; ++i) A[i] = max(A[i], B[15 - i]);
      bitonic_merge16_desc(A);
      xlane_merge16(A, 16);
      xlane_merge16(A, 32);
      if (g == 0) {
        uint4* dst = (uint4*)(p.tklist + ((size_t)((t0 + mt * 16 + tl) * 8 + h) * 2 + pp) * 16);
        dst[0] = make_uint4(A[0], A[1], A[2], A[3]);
        dst[1] = make_uint4(A[4], A[5], A[6], A[7]);
        dst[2] = make_uint4(A[8], A[9], A[10], A[11]);
        dst[3] = make_uint4(A[12], A[13], A[14], A[15]);
      }
    }
  }
  asm volatile("s_waitcnt vmcnt(0)" ::: "memory");
}

__device__ __forceinline__ void o_peer_select2_tile(const Params& p, int l, int t0, int tid) {
  const int h = __builtin_amdgcn_readfirstlane(tid >> 6), lane = tid & 63;
  const int g = lane >> 4, tl = lane & 15;
#pragma unroll 1
  for (int mt = 0; mt < 4; ++mt) {
    const int tok = t0 + mt * 16 + tl;
    const unsigned* lp = p.tklist + ((size_t)(tok * 8 + h) * 2) * 16;
    float v1[16], v2[16];
    {
      const uint4* q4 = (const uint4*)lp;
#pragma unroll
      for (int i = 0; i < 4; ++i) {
        uint4 x = q4[i], y = q4[4 + i];
        v1[4 * i + 0] = unmono_f(x.x & ~127u); v1[4 * i + 1] = unmono_f(x.y & ~127u);
        v1[4 * i + 2] = unmono_f(x.z & ~127u); v1[4 * i + 3] = unmono_f(x.w & ~127u);
        v2[4 * i + 0] = unmono_f(y.x & ~127u); v2[4 * i + 1] = unmono_f(y.y & ~127u);
        v2[4 * i + 2] = unmono_f(y.z & ~127u); v2[4 * i + 3] = unmono_f(y.w & ~127u);
      }
    }
    unsigned C[16];
#pragma unroll
    for (int i = 0; i < 16; ++i) C[i] = 0u;
    {
      int idx = 0;
#pragma unroll
      for (int a = 0; a < 16; ++a) {
#pragma unroll
        for (int b = 0; b < 16; ++b) {
          if ((a + 1) * (b + 1) <= 16) {
            const unsigned key = (mono_f(v1[a] + v2[b]) & ~255u) | (unsigned)(255 - (a * 16 + b));
            const int slot = idx >> 2, who = idx & 3;
            C[slot] = (g == who) ? key : C[slot];
            ++idx;
          }
        }
      }
    }
    sort16_desc(C);
    xlane_merge16(C, 16);
    xlane_merge16(C, 32);
    const float f0 = unmono_f(C[0] & ~255u);
    float den = 0.f;
    float ev[16];
#pragma unroll
    for (int i = 0; i < 16; ++i) { ev[i] = __expf(unmono_f(C[i] & ~255u) - f0); den += ev[i]; }
    const float rden = 1.0f / den;
    int eidx[4]; float egate[4];
#pragma unroll
    for (int i = 0; i < 4; ++i) {
      const unsigned k = (g == 0) ? C[i] : (g == 1) ? C[4 + i] : (g == 2) ? C[8 + i] : C[12 + i];
      const float e = (g == 0) ? ev[i] : (g == 1) ? ev[4 + i] : (g == 2) ? ev[8 + i] : ev[12 + i];
      const int pos = 255 - (int)(k & 255u);
      const int a = pos >> 4, b = pos & 15;
      const int n1 = 127 - (int)(lp[a] & 127u);
      const int n2 = 127 - (int)(lp[16 + b] & 127u);
      eidx[i] = n1 * 128 + n2;
      egate[i] = e * rden;
    }
    *(int4*)(p.pidx + (size_t)tok * 128 + h * 16 + 4 * g) = make_int4(eidx[0], eidx[1], eidx[2], eidx[3]);
    *(float4*)(p.pgate + (size_t)tok * 128 + h * 16 + 4 * g) = make_float4(egate[0], egate[1], egate[2], egate[3]);
  }
}

__device__ __forceinline__ float logsigmoid_(float x) { return fminf(x, 0.f) - log1pf(expf(-fabsf(x))); }
__device__ __forceinline__ float bf_lo(unsigned w) { return __uint_as_float(w << 16); }
__device__ __forceinline__ float bf_hi(unsigned w) { return __uint_as_float(w & 0xffff0000u); }

#define RKV_LD 136
__device__ __forceinline__ void o_ret_kv_task(const Params& p, int l, int task, char* smem, int tid) {
  const int wave = tid >> 6, lane = tid & 63, g = lane >> 4, tl = lane & 15;
  const int bh = task >> 5, n = task & 31, b = bh >> 2, h = bh & 3;
  const int tok0 = b * SEQ + n * 128;
  const float lgf = logsigmoid_(p.ret_decay[l * 8 + h]), lgb = logsigmoid_(p.ret_decay[l * 8 + 4 + h]);
  bf16_t* KTf = (bf16_t*)smem;
  bf16_t* KTb = KTf + 64 * RKV_LD;
  bf16_t* VT = KTb + 64 * RKV_LD;
  __syncthreads();
#pragma unroll
  for (int it = 0; it < 2; ++it) {
    const int u = tid + it * NTHREADS;
    const int j = u >> 3, d0 = (u & 7) * 8;
    const uint4 kv = *(const uint4*)(p.proj + (size_t)(tok0 + j) * IN_WIDTH + C_RK + h * 64 + d0);
    const float wf = __expf(lgf * (float)(127 - j)), wb = __expf(lgb * (float)(j + 1));
    const unsigned kw[4] = {kv.x, kv.y, kv.z, kv.w};
#pragma unroll
    for (int e = 0; e < 4; ++e) {
      const float x0 = bf_lo(kw[e]), x1 = bf_hi(kw[e]);
      KTf[(d0 + 2 * e) * RKV_LD + j] = f2bf(x0 * wf);
      KTf[(d0 + 2 * e + 1) * RKV_LD + j] = f2bf(x1 * wf);
      KTb[(d0 + 2 * e) * RKV_LD + j] = f2bf(x0 * wb);
      KTb[(d0 + 2 * e + 1) * RKV_LD + j] = f2bf(x1 * wb);
    }
  }
#pragma unroll
  for (int it = 0; it < 4; ++it) {
    const int u = tid + it * NTHREADS;
    const int j = u >> 4, e0 = (u & 15) * 8;
    const uint4 vv = *(const uint4*)(p.proj + (size_t)(tok0 + j) * IN_WIDTH + C_RV + h * 128 + e0);
    const unsigned vw[4] = {vv.x, vv.y, vv.z, vv.w};
#pragma unroll
    for (int e = 0; e < 4; ++e) {
      VT[(e0 + 2 * e) * RKV_LD + j] = (bf16_t)(vw[e] & 0xffffu);
      VT[(e0 + 2 * e + 1) * RKV_LD + j] = (bf16_t)(vw[e] >> 16);
    }
  }
  __syncthreads();
  bf16x8 a[4];
#pragma unroll
  for (int ks = 0; ks < 4; ++ks) a[ks] = *(const bf16x8*)(VT + (wave * 16 + tl) * RKV_LD + ks * 32 + 8 * g);
#pragma unroll
  for (int dir = 0; dir < 2; ++dir) {
    const bf16_t* KT = dir ? KTb : KTf;
#pragma unroll
    for (int dt = 0; dt < 4; ++dt) {
      f32x4 acc = (f32x4){0.f, 0.f, 0.f, 0.f};
#pragma unroll
      for (int ks = 0; ks < 4; ++ks) {
        const bf16x8 bb = *(const bf16x8*)(KT + (dt * 16 + tl) * RKV_LD + ks * 32 + 8 * g);
        acc = __builtin_amdgcn_mfma_f32_16x16x32_bf16(a[ks], bb, acc, 0, 0, 0);
      }
      float* dst = p.kvst + ((size_t)(task * 2 + dir) * 128 + wave * 16 + 4 * g) * 64 + dt * 16 + tl;
#pragma unroll
      for (int r = 0; r < 4; ++r) dst[r * 64] = acc[r];
    }
  }
}

__device__ __forceinline__ void o_ret_scan(const int wv_, const Params& p, int l) {
  const int tidx_ = opaque_tid(wv_); const int bidx_ = opaque_bid();
  const int gsz = gridDim.x * NTHREADS;
  for (int u = bidx_ * NTHREADS + tidx_; u < 16 * 2 * 128 * 16; u += gsz) {
    const int dq = u & 15, e = (u >> 4) & 127, dir = (u >> 11) & 1, bh = u >> 12, h = bh & 3;
    const float lg = logsigmoid_(p.ret_decay[l * 8 + dir * 4 + h]);
    const float gC = __expf(lg * 128.0f);
    float4 st = make_float4(0.f, 0.f, 0.f, 0.f);
#pragma unroll 8
    for (int nn = 0; nn < 32; ++nn) {
      const int n = dir ? (31 - nn) : nn;
      const size_t idx = ((size_t)((bh * 32 + n) * 2 + dir) * 128 + e) * 64 + dq * 4;
      const float4 kv = *(const float4*)(p.kvst + idx);
      uint2 o;
      o.x = pack2bf(st.x, st.y); o.y = pack2bf(st.z, st.w);
      *(uint2*)(p.rstate + idx) = o;
      st.x = fmaf(st.x, gC, kv.x); st.y = fmaf(st.y, gC, kv.y); st.z = fmaf(st.z, gC, kv.z); st.w = fmaf(st.w, gC, kv.w);
    }
  }
}

#define RO_LD 264
#define RK_LD 72
__device__ __forceinline__ void o_ret_out_task(const Params& p, int l, int task, char* smem, int tid) {
  const int wave = tid >> 6, lane = tid & 63, g = lane >> 4, tl = lane & 15;
  const int bh = task >> 5, n = task & 31, b = bh >> 2, h = bh & 3;
  const int tok0 = b * SEQ + n * 128;
  const float lgf = logsigmoid_(p.ret_decay[l * 8 + h]), lgb = logsigmoid_(p.ret_decay[l * 8 + 4 + h]);
  bf16_t* Acat = (bf16_t*)smem;
  bf16_t* Bcat = Acat + 128 * RO_LD;
  bf16_t* Kl = Bcat + 128 * RO_LD;
  __syncthreads();
#pragma unroll
  for (int it = 0; it < 2; ++it) {
    const int u = tid + it * NTHREADS;
    const int i = u >> 3, d0 = (u & 7) * 8;
    const size_t row = (size_t)(tok0 + i) * IN_WIDTH;
    const uint4 qv = *(const uint4*)(p.proj + row + C_RQ + h * 64 + d0);
    const uint4 kv = *(const uint4*)(p.proj + row + C_RK + h * 64 + d0);
    *(uint4*)(Acat + i * RO_LD + d0) = qv;
    *(uint4*)(Kl + i * RK_LD + d0) = kv;
    const float wf = __expf(lgf * (float)(i + 1)), wb = __expf(lgb * (float)(127 - i));
    const unsigned qw[4] = {qv.x, qv.y, qv.z, qv.w};
    uint4 of, ob;
    of.x = pack2bf(bf_lo(qw[0]) * wf, bf_hi(qw[0]) * wf); ob.x = pack2bf(bf_lo(qw[0]) * wb, bf_hi(qw[0]) * wb);
    of.y = pack2bf(bf_lo(qw[1]) * wf, bf_hi(qw[1]) * wf); ob.y = pack2bf(bf_lo(qw[1]) * wb, bf_hi(qw[1]) * wb);
    of.z = pack2bf(bf_lo(qw[2]) * wf, bf_hi(qw[2]) * wf); ob.z = pack2bf(bf_lo(qw[2]) * wb, bf_hi(qw[2]) * wb);
    of.w = pack2bf(bf_lo(qw[3]) * wf, bf_hi(qw[3]) * wf); ob.w = pack2bf(bf_lo(qw[3]) * wb, bf_hi(qw[3]) * wb);
    *(uint4*)(Acat + i * RO_LD + 128 + d0) = of;
    *(uint4*)(Acat + i * RO_LD + 192 + d0) = ob;
  }
#pragma unroll
  for (int it = 0; it < 4; ++it) {
    const int u = tid + it * NTHREADS;
    const int j = u >> 4, e0 = (u & 15) * 8;
    const uint4 vv = *(const uint4*)(p.proj + (size_t)(tok0 + j) * IN_WIDTH + C_RV + h * 128 + e0);
    const unsigned vw[4] = {vv.x, vv.y, vv.z, vv.w};
#pragma unroll
    for (int e = 0; e < 4; ++e) {
      Bcat[(e0 + 2 * e) * RO_LD + j] = (bf16_t)(vw[e] & 0xffffu);
      Bcat[(e0 + 2 * e + 1) * RO_LD + j] = (bf16_t)(vw[e] >> 16);
    }
  }
#pragma unroll
  for (int it = 0; it < 4; ++it) {
    const int u = tid + it * NTHREADS;
    const int d0 = (u & 7) * 8, e = (u >> 3) & 127, dir = u >> 10;
    const uint4 sv = *(const uint4*)(p.rstate + ((size_t)(task * 2 + dir) * 128 + e) * 64 + d0);
    *(uint4*)(Bcat + e * RO_LD + 128 + dir * 64 + d0) = sv;
  }
  __syncthreads();
  f32x4 sc[8];
#pragma unroll
  for (int jt = 0; jt < 8; ++jt) sc[jt] = (f32x4){0.f, 0.f, 0.f, 0.f};
#pragma unroll
  for (int ks = 0; ks < 2; ++ks) {
    const bf16x8 qb = *(const bf16x8*)(Acat + (wave * 16 + tl) * RO_LD + ks * 32 + 8 * g);
#pragma unroll
    for (int jt = 0; jt < 8; ++jt) {
      const bf16x8 ka = *(const bf16x8*)(Kl + (jt * 16 + tl) * RK_LD + ks * 32 + 8 * g);
      sc[jt] = __builtin_amdgcn_mfma_f32_16x16x32_bf16(ka, qb, sc[jt], 0, 0, 0);
    }
  }
  {
    const int i = wave * 16 + tl;
#pragma unroll
    for (int jt = 0; jt < 8; ++jt) {
      float pv[4];
#pragma unroll
      for (int r = 0; r < 4; ++r) {
        const int j = jt * 16 + 4 * g + r;
        const float dd = (j <= i) ? __expf(lgf * (float)(i - j)) : __expf(lgb * (float)(j - i));
        pv[r] = sc[jt][r] * dd;
      }
      uint2 o;
      o.x = pack2bf(pv[0], pv[1]); o.y = pack2bf(pv[2], pv[3]);
      *(uint2*)(Acat + i * RO_LD + jt * 16 + 4 * g) = o;
    }
  }
  f32x4 y[8];
#pragma unroll
  for (int et = 0; et < 8; ++et) y[et] = (f32x4){0.f, 0.f, 0.f, 0.f};
#pragma unroll
  for (int ks = 0; ks < 8; ++ks) {
    const bf16x8 ab = *(const bf16x8*)(Acat + (wave * 16 + tl) * RO_LD + ks * 32 + 8 * g);
#pragma unroll
    for (int et = 0; et < 8; ++et) {
      const bf16x8 ba = *(const bf16x8*)(Bcat + (et * 16 + tl) * RO_LD + ks * 32 + 8 * g);
      y[et] = __builtin_amdgcn_mfma_f32_16x16x32_bf16(ba, ab, y[et], 0, 0, 0);
    }
  }
  float ss = 0.f;
#pragma unroll
  for (int et = 0; et < 8; ++et)
#pragma unroll
    for (int r = 0; r < 4; ++r) ss = fmaf(y[et][r], y[et][r], ss);
  ss += __shfl_xor(ss, 16, 64);
  ss += __shfl_xor(ss, 32, 64);
  const float rstd = rsqrtf(ss * (1.0f / 128.0f) + EPS);
  {
    const int tok = tok0 + wave * 16 + tl;
    const bf16_t* gp = p.proj + (size_t)tok * IN_WIDTH + C_RG + h * 128 + 4 * g;
    bf16_t* dst = p.ycat + (size_t)tok * 1024 + 256 + h * 128 + 4 * g;
#pragma unroll
    for (int et = 0; et < 8; ++et) {
      const uint2 gv = *(const uint2*)(gp + et * 16);
      const float g0 = bf_lo(gv.x), g1 = bf_hi(gv.x), g2 = bf_lo(gv.y), g3 = bf_hi(gv.y);
      uint2 o;
      o.x = pack2bf(g0 / (1.0f + __expf(-g0)) * y[et][0] * rstd, g1 / (1.0f + __expf(-g1)) * y[et][1] * rstd);
      o.y = pack2bf(g2 / (1.0f + __expf(-g2)) * y[et][2] * rstd, g3 / (1.0f + __expf(-g3)) * y[et][3] * rstd);
      *(uint2*)(dst + et * 16) = o;
    }
  }
}


#define NA_KLD 72
typedef short v4s_t __attribute__((ext_vector_type(4)));
#ifndef LAS
#define LAS __attribute__((address_space(3)))
#endif
__device__ __forceinline__ void o_na_task(const Params& p, int l, int task, char* smem, int tid) {
  const int wave = tid >> 6, lane = tid & 63, g = lane >> 4, tl = lane & 15;
  const int rr = task & 63, h = (task >> 6) & 3, b = task >> 8;
  int rs = rr - 4; rs = rs < 0 ? 0 : (rs > 56 ? 56 : rs);
  const int ktok0 = b * SEQ + rs * 64;
  const int qtok0 = b * SEQ + rr * 64;
  bf16_t* Kl = (bf16_t*)smem;
  bf16_t* Vl = Kl + 512 * NA_KLD;
  bf16_t* Ql = Vl + 512 * NA_KLD;
  float* rpbl = (float*)(Ql + 64 * NA_KLD);
  __syncthreads();
#pragma unroll
  for (int it = 0; it < 8; ++it) {
    const int u = tid + it * NTHREADS;
    const int key = u >> 3, d0 = (u & 7) * 8;
    const size_t row = (size_t)(ktok0 + key) * IN_WIDTH;
    const uint4 kv = *(const uint4*)(p.proj + row + C_NK + h * 64 + d0);
    const uint4 vv = *(const uint4*)(p.proj + row + C_NV + h * 64 + d0);
    *(uint4*)(Kl + key * NA_KLD + d0) = kv;
    *(uint4*)(Vl + key * NA_KLD + d0) = vv;
  }
  {
    const int q = tid >> 3, d0 = (tid & 7) * 8;
    *(uint4*)(Ql + q * NA_KLD + d0) = *(const uint4*)(p.proj + (size_t)(qtok0 + q) * IN_WIDTH + C_NQ + h * 64 + d0);
    if (tid < 465) rpbl[tid] = p.na_rpb[((size_t)l * 4 + h) * 465 + tid];
  }
  __syncthreads();
  if (wave < 4) {
    const int qt = wave;
    int cw0 = 16 * qt - 8; cw0 = cw0 < 0 ? 0 : (cw0 > 32 ? 32 : cw0);
    f32x4 sc[16];
#pragma unroll
    for (int T = 0; T < 16; ++T) sc[T] = (f32x4){0.f, 0.f, 0.f, 0.f};
#pragma unroll
    for (int ks = 0; ks < 2; ++ks) {
      const bf16x8 qb = *(const bf16x8*)(Ql + (qt * 16 + tl) * NA_KLD + ks * 32 + 8 * g);
#pragma unroll
      for (int T = 0; T < 16; ++T) {
        const int key = (T >> 1) * 64 + cw0 + (T & 1) * 16 + tl;
        const bf16x8 ka = *(const bf16x8*)(Kl + key * NA_KLD + ks * 32 + 8 * g);
        sc[T] = __builtin_amdgcn_mfma_f32_16x16x32_bf16(ka, qb, sc[T], 0, 0, 0);
      }
    }
    const int cq = qt * 16 + tl;
    int cs = cq - 8; cs = cs < 0 ? 0 : (cs > 48 ? 48 : cs);
    float m = -3.0e38f;
#pragma unroll
    for (int T = 0; T < 16; ++T) {
      const int ri = T >> 1;
      const int di = rs + ri - rr + 7;
#pragma unroll
      for (int r = 0; r < 4; ++r) {
        const int ck = cw0 + (T & 1) * 16 + 4 * g + r;
        const bool valid = (ck >= cs) && (ck < cs + 16);
        int dj = ck - cq + 15; dj = dj < 0 ? 0 : (dj > 30 ? 30 : dj);
        const float sv = valid ? (sc[T][r] + rpbl[di * 31 + dj]) : -1.0e30f;
        sc[T][r] = sv;
        m = fmaxf(m, sv);
      }
    }
    m = fmaxf(m, __shfl_xor(m, 16, 64));
    m = fmaxf(m, __shfl_xor(m, 32, 64));
    float den = 0.f;
#pragma unroll
    for (int T = 0; T < 16; ++T)
#pragma unroll
      for (int r = 0; r < 4; ++r) {
        const float e = __expf(sc[T][r] - m);
        sc[T][r] = e;
        den += e;
      }
    den += __shfl_xor(den, 16, 64);
    den += __shfl_xor(den, 32, 64);
    const float rden = 1.0f / den;
    f32x4 o[4];
#pragma unroll
    for (int dt = 0; dt < 4; ++dt) o[dt] = (f32x4){0.f, 0.f, 0.f, 0.f};
#pragma unroll
    for (int ri = 0; ri < 8; ++ri) {
      union { bf16x8 v; unsigned u[4]; } pb;
      pb.u[0] = pack2bf(sc[2 * ri][0], sc[2 * ri][1]);
      pb.u[1] = pack2bf(sc[2 * ri][2], sc[2 * ri][3]);
      pb.u[2] = pack2bf(sc[2 * ri + 1][0], sc[2 * ri + 1][1]);
      pb.u[3] = pack2bf(sc[2 * ri + 1][2], sc[2 * ri + 1][3]);
#pragma unroll
      for (int dt = 0; dt < 4; ++dt) {
        const bf16_t* vp = Vl + (ri * 64 + cw0 + 4 * g + (tl >> 2)) * NA_KLD + dt * 16 + 4 * (tl & 3);
        const v4s_t r0 = __builtin_amdgcn_ds_read_tr16_b64_v4i16((v4s_t LAS*)(LAS bf16_t*)vp);
        const v4s_t r1 = __builtin_amdgcn_ds_read_tr16_b64_v4i16((v4s_t LAS*)(LAS bf16_t*)(vp + 16 * NA_KLD));
        const bf16x8 va = {r0[0], r0[1], r0[2], r0[3], r1[0], r1[1], r1[2], r1[3]};
        o[dt] = __builtin_amdgcn_mfma_f32_16x16x32_bf16(va, pb.v, o[dt], 0, 0, 0);
      }
    }
    bf16_t* dst = p.ycat + (size_t)(qtok0 + qt * 16 + tl) * 1024 + 768 + h * 64 + 4 * g;
#pragma unroll
    for (int dt = 0; dt < 4; ++dt) {
      uint2 ov;
      ov.x = pack2bf(o[dt][0] * rden, o[dt][1] * rden);
      ov.y = pack2bf(o[dt][2] * rden, o[dt][3] * rden);
      *(uint2*)(dst + dt * 16) = ov;
    }
  }
}

#define PL_LD 264
__device__ __forceinline__ void o_pool_task(const Params& p, int l, int task, char* smem, int tid) {
  const int wave = tid >> 6, lane = tid & 63, g = lane >> 4, tl = lane & 15;
  const int t0 = task * 64, pos0 = t0 & (SEQ - 1);
  bf16_t* Xp = (bf16_t*)smem;
  bf16_t* WT = Xp + 80 * PL_LD;
  bf16_t* Df = WT + 4 * 64 * 72;
  __syncthreads();
#pragma unroll
  for (int it = 0; it < 5; ++it) {
    const int u = tid + it * NTHREADS;
    const int rw = u >> 5, c0 = (u & 31) * 8;
    const int pos = pos0 - 8 + rw;
    uint4 v = make_uint4(0u, 0u, 0u, 0u);
    if (pos >= 0 && pos < SEQ) v = *(const uint4*)(p.proj + (size_t)(t0 - 8 + rw) * IN_WIDTH + C_POOL + c0);
    *(uint4*)(Xp + rw * PL_LD + c0) = v;
  }
#pragma unroll
  for (int it = 0; it < 4; ++it) {
    const int u = tid + it * NTHREADS;
    const int e0 = (u & 7) * 8, c = (u >> 3) & 63, gi = u >> 9;
    const float* wp = p.pool_w + (((size_t)l * 4 + gi) * 64 + c) * 64 + e0;
    const float4 a = *(const float4*)wp, bq = *(const float4*)(wp + 4);
    const float wv[8] = {a.x, a.y, a.z, a.w, bq.x, bq.y, bq.z, bq.w};
#pragma unroll
    for (int k = 0; k < 8; ++k) WT[(gi * 64 + e0 + k) * 72 + c] = f2bf(wv[k]);
  }
  __syncthreads();
#pragma unroll 1
  for (int it = 0; it < 4; ++it) {
    const int u = tid + it * NTHREADS;
    const int t = u >> 5, c0 = (u & 31) * 8;
    const int gi = c0 >> 6;
    const int hw = 1 << gi;
    const int pos = pos0 + t;
    int a = pos - hw; a = a < 0 ? 0 : a;
    int bnd = pos + hw; bnd = bnd > SEQ ? SEQ : bnd;
    float sum[8];
#pragma unroll
    for (int k = 0; k < 8; ++k) sum[k] = 0.f;
    for (int rp = a; rp < bnd; ++rp) {
      const uint4 v = *(const uint4*)(Xp + (rp - pos0 + 8) * PL_LD + c0);
      sum[0] += bf_lo(v.x); sum[1] += bf_hi(v.x); sum[2] += bf_lo(v.y); sum[3] += bf_hi(v.y);
      sum[4] += bf_lo(v.z); sum[5] += bf_hi(v.z); sum[6] += bf_lo(v.w); sum[7] += bf_hi(v.w);
    }
    const float rc = 1.0f / (float)(bnd - a);
    const uint4 xv = *(const uint4*)(Xp + (t + 8) * PL_LD + c0);
    uint4 o;
    o.x = pack2bf(sum[0] * rc - bf_lo(xv.x), sum[1] * rc - bf_hi(xv.x));
    o.y = pack2bf(sum[2] * rc - bf_lo(xv.y), sum[3] * rc - bf_hi(xv.y));
    o.z = pack2bf(sum[4] * rc - bf_lo(xv.z), sum[5] * rc - bf_hi(xv.z));
    o.w = pack2bf(sum[6] * rc - bf_lo(xv.w), sum[7] * rc - bf_hi(xv.w));
    *(uint4*)(Df + t * PL_LD + c0) = o;
  }
  __syncthreads();
  {
    const int gi = wave >> 1, tt0 = (wave & 1) * 2;
    f32x4 acc[4][2];
#pragma unroll
    for (int et = 0; et < 4; ++et)
#pragma unroll
      for (int tt = 0; tt < 2; ++tt) acc[et][tt] = (f32x4){0.f, 0.f, 0.f, 0.f};
#pragma unroll
    for (int ks = 0; ks < 2; ++ks) {
      bf16x8 bx[2];
#pragma unroll
      for (int tt = 0; tt < 2; ++tt) bx[tt] = *(const bf16x8*)(Df + ((tt0 + tt) * 16 + tl) * PL_LD + gi * 64 + ks * 32 + 8 * g);
#pragma unroll
      for (int et = 0; et < 4; ++et) {
        const bf16x8 wa = *(const bf16x8*)(WT + (gi * 64 + et * 16 + tl) * 72 + ks * 32 + 8 * g);
#pragma unroll
        for (int tt = 0; tt < 2; ++tt) acc[et][tt] = __builtin_amdgcn_mfma_f32_16x16x32_bf16(wa, bx[tt], acc[et][tt], 0, 0, 0);
      }
    }
#pragma unroll
    for (int et = 0; et < 4; ++et) {
      const float4 sc4 = *(const float4*)(p.pool_scale + l * 256 + gi * 64 + et * 16 + 4 * g);
#pragma unroll
      for (int tt = 0; tt < 2; ++tt) {
        const int tok = t0 + (tt0 + tt) * 16 + tl;
        uint2 o;
        o.x = pack2bf(acc[et][tt][0] * sc4.x, acc[et][tt][1] * sc4.y);
        o.y = pack2bf(acc[et][tt][2] * sc4.z, acc[et][tt][3] * sc4.w);
        *(uint2*)(p.ycat + (size_t)tok * 1024 + gi * 64 + et * 16 + 4 * g) = o;
      }
    }
  }
}


typedef __attribute__((ext_vector_type(2))) __bf16 bf16x2_t;
__device__ __forceinline__ float dot2bf(unsigned a, unsigned b, float c) {
  return __builtin_amdgcn_fdot2_f32_bf16(__builtin_bit_cast(bf16x2_t, a), __builtin_bit_cast(bf16x2_t, b), c, false);
}
#define DPP_F(v, ctrl) __builtin_bit_cast(float, __builtin_amdgcn_update_dpp(0, __builtin_bit_cast(int, v), ctrl, 0xf, 0xf, false))
#define RDLANE_F(v, l) __builtin_bit_cast(float, __builtin_amdgcn_readlane(__builtin_bit_cast(int, v), l))
__device__ __forceinline__ float erf_as(float x) {
  const float ax = fabsf(x);
  const float t = __builtin_amdgcn_rcpf(fmaf(0.3275911f, ax, 1.0f));
  float y = fmaf(1.061405429f, t, -1.453152027f);
  y = fmaf(y, t, 1.421413741f);
  y = fmaf(y, t, -0.284496736f);
  y = fmaf(y, t, 0.254829592f);
  y = y * t * __expf(-ax * ax);
  return copysignf(1.0f - y, x);
}
__device__ __forceinline__ float gelu_fast_exact(float a) { return 0.5f * a * (1.0f + erf_as(a * 0.70710678118654752f)); }
struct PickPair { int eA, eB; float gA, gB; };

#define EX6_SHIFT 11
#define EX6_NSLICE (16384 >> EX6_SHIFT)
__device__ __forceinline__ unsigned cvt8_bf16x2(unsigned w, float scale, const bool hi) {
  return hi ? __builtin_bit_cast(unsigned, __builtin_amdgcn_cvt_scalef32_pk_bf16_fp8((int)w, scale, true))
            : __builtin_bit_cast(unsigned, __builtin_amdgcn_cvt_scalef32_pk_bf16_fp8((int)w, scale, false));
}
__device__ __forceinline__ void experts6_process4(const unsigned char* __restrict__ U8, const unsigned char* __restrict__ V8,
                                                  const float2* __restrict__ ES, const int (&e)[4], const float (&g)[4],
                                                  const unsigned (&hw)[8], float (&acc)[16], int lane, int vz) {
  uint4 u[4], v[4];
  float2 sc[4];
#pragma unroll
  for (int i = 0; i < 4; ++i) u[i] = *(const uint4*)(U8 + (size_t)e[i] * 1024 + lane * 16);
#pragma unroll
  for (int i = 0; i < 4; ++i) sc[i] = ES[e[i] + vz];
#pragma unroll
  for (int i = 0; i < 4; ++i) v[i] = *(const uint4*)(V8 + (size_t)e[i] * 1024 + lane * 16);
  float a[4];
#pragma unroll
  for (int i = 0; i < 4; ++i) {
    const unsigned uw[4] = {u[i].x, u[i].y, u[i].z, u[i].w};
    float t = 0.f;
#pragma unroll
    for (int w = 0; w < 4; ++w) {
      t = dot2bf(cvt8_bf16x2(uw[w], sc[i].x, false), hw[2 * w], t);
      t = dot2bf(cvt8_bf16x2(uw[w], sc[i].x, true), hw[2 * w + 1], t);
    }
    a[i] = t;
  }
  const bool b0 = lane & 1, b1 = lane & 2;
  const float x01 = (b0 ? a[1] : a[0]) + DPP_F((b0 ? a[0] : a[1]), 0xB1);
  const float x23 = (b0 ? a[3] : a[2]) + DPP_F((b0 ? a[2] : a[3]), 0xB1);
  float y = (b1 ? x23 : x01) + DPP_F((b1 ? x01 : x23), 0x4E);
  y += DPP_F(y, 0x124);
  y += DPP_F(y, 0x128);
  float sum[4];
#pragma unroll
  for (int i = 0; i < 4; ++i) sum[i] = RDLANE_F(y, i) + RDLANE_F(y, 16 + i) + RDLANE_F(y, 32 + i) + RDLANE_F(y, 48 + i);
  const int li = lane & 3;
  const float mine = (li == 0) ? sum[0] : (li == 1) ? sum[1] : (li == 2) ? sum[2] : sum[3];
  const float gmine = (li == 0) ? g[0] : (li == 1) ? g[1] : (li == 2) ? g[2] : g[3];
  const unsigned gb = (unsigned)f2bf(gelu_fast_exact(mine) * gmine);
#pragma unroll
  for (int i = 0; i < 4; ++i) {
    const unsigned hl = (unsigned)__builtin_amdgcn_readlane((int)gb, i);
    const unsigned hh = hl << 16;
    const unsigned vw[4] = {v[i].x, v[i].y, v[i].z, v[i].w};
#pragma unroll
    for (int w = 0; w < 4; ++w) {
      const unsigned p0 = cvt8_bf16x2(vw[w], sc[i].y, false), p1 = cvt8_bf16x2(vw[w], sc[i].y, true);
      acc[4 * w + 0] = dot2bf(p0, hl, acc[4 * w + 0]);
      acc[4 * w + 1] = dot2bf(p0, hh, acc[4 * w + 1]);
      acc[4 * w + 2] = dot2bf(p1, hl, acc[4 * w + 2]);
      acc[4 * w + 3] = dot2bf(p1, hh, acc[4 * w + 3]);
    }
  }
}

__device__ __forceinline__ void o_peer_experts6_tile(const Params& p, int l, int t0, const char* smem, int tid, bool dry = false) {
  const int wave = __builtin_amdgcn_readfirstlane(tid >> 6), lane = tid & 63;
  const unsigned char* U8 = p.u8 + (size_t)l * 16384 * 1024;
  const unsigned char* V8 = p.v8 + (size_t)l * 16384 * 1024;
  const float2* ES = p.escale + (size_t)l * 16384;
  int vz = 0;
  asm volatile("" : "+v"(vz));
  const int s0 = ((int)(__builtin_amdgcn_s_getreg((3 << 11) | 20) & 0xF) * (EX6_NSLICE / 8)) & (EX6_NSLICE - 1);
  unsigned pk[8][2];
  float acc[8][16];
#pragma unroll
  for (int k = 0; k < 8; ++k) {
    const size_t base = (size_t)(t0 + wave * 8 + k) * 128 + lane + vz;
#pragma unroll
    for (int hf = 0; hf < 2; ++hf) pk[k][hf] = (unsigned)p.pidx[base + hf * 64] | ((unsigned)f2bf(p.pgate[base + hf * 64]) << 16);
#pragma unroll
    for (int i = 0; i < 16; ++i) acc[k][i] = 0.f;
  }
#pragma unroll 1
  for (int si = 0; si < EX6_NSLICE; ++si) {
    const unsigned s = (unsigned)((s0 + si) & (EX6_NSLICE - 1));
#pragma unroll
    for (int k = 0; k < 8; ++k) {
      unsigned long long m0 = __ballot(((pk[k][0] & 0x3fffu) >> EX6_SHIFT) == s);
      unsigned long long m1 = __ballot(((pk[k][1] & 0x3fffu) >> EX6_SHIFT) == s);
      if ((m0 | m1) == 0ull) continue;
      unsigned hw[8];
      {
        const char* xr = smem + (wave * 8 + k) * LDXB + lane * 32;
        const uint4 h0 = *(const uint4*)xr, h1 = *(const uint4*)(xr + 16);
        hw[0] = h0.x; hw[1] = h0.y; hw[2] = h0.z; hw[3] = h0.w; hw[4] = h1.x; hw[5] = h1.y; hw[6] = h1.z; hw[7] = h1.w;
      }
      while (m0 | m1) {
        int e[4]; float g[4];
#pragma unroll
        for (int i = 0; i < 4; ++i) {
          unsigned w;
          if (m0) { const int la = (int)__builtin_ctzll(m0); m0 &= m0 - 1; w = (unsigned)__builtin_amdgcn_readlane((int)pk[k][0], la); }
          else if (m1) { const int la = (int)__builtin_ctzll(m1); m1 &= m1 - 1; w = (unsigned)__builtin_amdgcn_readlane((int)pk[k][1], la); }
          else { w = (unsigned)e[0]; }
          e[i] = (int)(w & 0x3fffu);
          g[i] = __uint_as_float(w & 0xffff0000u);
        }
        experts6_process4(U8, V8, ES, e, g, hw, acc[k], lane, vz);
      }
    }
  }
  if (dry) {
#pragma unroll
    for (int k = 0; k < 8; ++k)
#pragma unroll
      for (int i = 0; i < 16; ++i) asm volatile("" :: "v"(acc[k][i]));
    return;
  }
#pragma unroll
  for (int k = 0; k < 8; ++k) {
    float* xr = p.xres + (size_t)(t0 + wave * 8 + k) * 1024 + lane * 16;
#pragma unroll
    for (int i = 0; i < 4; ++i) {
      float4 a0 = *(float4*)(xr + 4 * i);
      a0.x += acc[k][4 * i + 0]; a0.y += acc[k][4 * i + 1]; a0.z += acc[k][4 * i + 2]; a0.w += acc[k][4 * i + 3];
      *(float4*)(xr + 4 * i) = a0;
    }
  }
}


typedef _Float16 h2_t __attribute__((ext_vector_type(2)));
__device__ __forceinline__ void ex7_pop(unsigned long long& m0, unsigned long long& m1, const unsigned pk0, const unsigned pk1,
                                        int (&e)[4], float (&g)[4]) {
  int e0 = 0;
#pragma unroll
  for (int i = 0; i < 4; ++i) {
    unsigned w;
    if (m0) { const int la = (int)__builtin_ctzll(m0); m0 &= m0 - 1; w = (unsigned)__builtin_amdgcn_readlane((int)pk0, la); }
    else if (m1) { const int la = (int)__builtin_ctzll(m1); m1 &= m1 - 1; w = (unsigned)__builtin_amdgcn_readlane((int)pk1, la); }
    else { w = (unsigned)e0; }
    e[i] = (int)(w & 0x3fffu);
    g[i] = __uint_as_float(w & 0xffff0000u);
    if (i == 0) e0 = e[0];
  }
}
#define EX7_ISSUE(U_, V_, SC_, G_) { \
  _Pragma("unroll") for (int i_ = 0; i_ < 4; ++i_) U_[i_] = *(const uint4*)(U8 + (size_t)e[i_] * 1024 + lane * 16); \
  _Pragma("unroll") for (int i_ = 0; i_ < 4; ++i_) SC_[i_] = ES[e[i_] + vz]; \
  _Pragma("unroll") for (int i_ = 0; i_ < 4; ++i_) V_[i_] = *(const uint4*)(V8 + (size_t)e[i_] * 1024 + lane * 16); \
  _Pragma("unroll") for (int i_ = 0; i_ < 4; ++i_) G_[i_] = g[i_]; }

__device__ __forceinline__ void ex7_compute(const uint4 (&ru)[4], const uint4 (&rv)[4], const float2 (&rsc)[4], const float (&rg)[4],
                                            const unsigned (&hw)[8], h2_t (&acc)[8], int lane) {
  float a[4];
#pragma unroll
  for (int i = 0; i < 4; ++i) {
    const unsigned uw[4] = {ru[i].x, ru[i].y, ru[i].z, ru[i].w};
    float t = 0.f;
#pragma unroll
    for (int w = 0; w < 4; ++w) {
      t = dot2bf(cvt8_bf16x2(uw[w], rsc[i].x, false), hw[2 * w], t);
      t = dot2bf(cvt8_bf16x2(uw[w], rsc[i].x, true), hw[2 * w + 1], t);
    }
    a[i] = t;
  }
  const bool b0 = lane & 1, b1 = lane & 2;
  const float x01 = (b0 ? a[1] : a[0]) + DPP_F((b0 ? a[0] : a[1]), 0xB1);
  const float x23 = (b0 ? a[3] : a[2]) + DPP_F((b0 ? a[2] : a[3]), 0xB1);
  float y = (b1 ? x23 : x01) + DPP_F((b1 ? x01 : x23), 0x4E);
  y += DPP_F(y, 0x124);
  y += DPP_F(y, 0x128);
  float sum[4];
#pragma unroll
  for (int i = 0; i < 4; ++i) sum[i] = RDLANE_F(y, i) + RDLANE_F(y, 16 + i) + RDLANE_F(y, 32 + i) + RDLANE_F(y, 48 + i);
  const int li = lane & 3;
  const float mine = (li == 0) ? sum[0] : (li == 1) ? sum[1] : (li == 2) ? sum[2] : sum[3];
  const float gmine = (li == 0) ? rg[0] : (li == 1) ? rg[1] : (li == 2) ? rg[2] : rg[3];
  const _Float16 hf = (_Float16)(gelu_fast_exact(mine) * gmine);
  const unsigned hb = (unsigned)__builtin_bit_cast(unsigned short, hf);
#pragma unroll
  for (int i = 0; i < 4; ++i) {
    const unsigned hl = (unsigned)__builtin_amdgcn_readlane((int)hb, i);
    const h2_t hh = __builtin_bit_cast(h2_t, hl | (hl << 16));
    const unsigned vw[4] = {rv[i].x, rv[i].y, rv[i].z, rv[i].w};
#pragma unroll
    for (int w = 0; w < 4; ++w) {
      const h2_t p0 = __builtin_amdgcn_cvt_scalef32_pk_f16_fp8((int)vw[w], rsc[i].y, false);
      const h2_t p1 = __builtin_amdgcn_cvt_scalef32_pk_f16_fp8((int)vw[w], rsc[i].y, true);
      acc[2 * w] = __builtin_elementwise_fma(p0, hh, acc[2 * w]);
      acc[2 * w + 1] = __builtin_elementwise_fma(p1, hh, acc[2 * w + 1]);
    }
  }
}

__device__ __forceinline__ void o_peer_experts7_tile(const Params& p, int l, int t0, const char* smem, int tid, bool dry = false) {
  const int wave = __builtin_amdgcn_readfirstlane(tid >> 6), lane = tid & 63;
  const unsigned char* U8 = p.u8 + (size_t)l * 16384 * 1024;
  const unsigned char* V8 = p.v8 + (size_t)l * 16384 * 1024;
  const float2* ES = p.escale + (size_t)l * 16384;
  int vz = 0;
  asm volatile("" : "+v"(vz));
  const int s0 = ((int)(__builtin_amdgcn_s_getreg((3 << 11) | 20) & 0xF) * (EX6_NSLICE / 8)) & (EX6_NSLICE - 1);
  unsigned pk[8][2];
  h2_t acc[8][8];
#pragma unroll
  for (int k = 0; k < 8; ++k) {
    const size_t base = (size_t)(t0 + wave * 8 + k) * 128 + lane + vz;
#pragma unroll
    for (int hf = 0; hf < 2; ++hf) pk[k][hf] = (unsigned)p.pidx[base + hf * 64] | ((unsigned)f2bf(p.pgate[base + hf * 64]) << 16);
#pragma unroll
    for (int i = 0; i < 8; ++i) acc[k][i] = (h2_t){(_Float16)0.f, (_Float16)0.f};
  }
#pragma unroll 1
  for (int si = 0; si < EX6_NSLICE; ++si) {
    const unsigned s = (unsigned)((s0 + si) & (EX6_NSLICE - 1));
#pragma unroll
    for (int k = 0; k < 8; ++k) {
      unsigned long long m0 = __ballot(((pk[k][0] & 0x3fffu) >> EX6_SHIFT) == s);
      unsigned long long m1 = __ballot(((pk[k][1] & 0x3fffu) >> EX6_SHIFT) == s);
      if ((m0 | m1) == 0ull) continue;
      unsigned hw[8];
      {
        const char* xr = smem + (wave * 8 + k) * LDXB + lane * 32;
        const uint4 h0 = *(const uint4*)xr, h1 = *(const uint4*)(xr + 16);
        hw[0] = h0.x; hw[1] = h0.y; hw[2] = h0.z; hw[3] = h0.w; hw[4] = h1.x; hw[5] = h1.y; hw[6] = h1.z; hw[7] = h1.w;
      }
      uint4 uA[4], vA[4], uB[4], vB[4];
      float2 scA[4], scB[4];
      float gA[4], gB[4];
      int e[4]; float g[4];
      ex7_pop(m0, m1, pk[k][0], pk[k][1], e, g);
      EX7_ISSUE(uA, vA, scA, gA)
      for (;;) {
        const bool mb = (m0 | m1) != 0ull;
        if (mb) { ex7_pop(m0, m1, pk[k][0], pk[k][1], e, g); EX7_ISSUE(uB, vB, scB, gB) }
        __builtin_amdgcn_s_setprio(1);
        ex7_compute(uA, vA, scA, gA, hw, acc[k], lane);
        __builtin_amdgcn_s_setprio(0);
        if (!mb) break;
        const bool ma = (m0 | m1) != 0ull;
        if (ma) { ex7_pop(m0, m1, pk[k][0], pk[k][1], e, g); EX7_ISSUE(uA, vA, scA, gA) }
        __builtin_amdgcn_s_setprio(1);
        ex7_compute(uB, vB, scB, gB, hw, acc[k], lane);
        __builtin_amdgcn_s_setprio(0);
        if (!ma) break;
      }
    }
  }
  if (dry) {
#pragma unroll
    for (int k = 0; k < 8; ++k)
#pragma unroll
      for (int i = 0; i < 8; ++i) asm volatile("" :: "v"(acc[k][i]));
    return;
  }
#pragma unroll
  for (int k = 0; k < 8; ++k) {
    float* xr = p.xres + (size_t)(t0 + wave * 8 + k) * 1024 + lane * 16;
#pragma unroll
    for (int i = 0; i < 4; ++i) {
      float4 a0 = *(float4*)(xr + 4 * i);
      a0.x += (float)acc[k][2 * i][0]; a0.y += (float)acc[k][2 * i][1];
      a0.z += (float)acc[k][2 * i + 1][0]; a0.w += (float)acc[k][2 * i + 1][1];
      *(float4*)(xr + 4 * i) = a0;
    }
  }
}

#define XB_TMO      128
#define XB_XCNT(j)  (256  + 64 * (j))
#define XB_XSUB(j)  (1280 + 64 * (j))
#define XB_XGEN(j)  (2304 + 64 * (j))
#define XB_TOP      3328
#define XB_TOPGEN   3392
#define XCD_BAR_WORDS 3456
#define XB_SPIN_CAP (1u << 22)
#ifndef LAS
#define LAS __attribute__((address_space(3)))
#endif
__device__ __forceinline__ unsigned xb_ld(unsigned* p)              { return __hip_atomic_load(p, __ATOMIC_RELAXED, __HIP_MEMORY_SCOPE_AGENT); }
__device__ __forceinline__ unsigned xb_add(unsigned* p, unsigned v) { return __hip_atomic_fetch_add(p, v, __ATOMIC_RELAXED, __HIP_MEMORY_SCOPE_AGENT); }
__device__ __forceinline__ unsigned xb_xcc_id() { return (unsigned)__builtin_amdgcn_s_getreg((3 << 11) | 20) & 0xFu; }
#define XB_SPIN(cond, bar) do { unsigned _sp = 0; while (cond) { __builtin_amdgcn_s_sleep(1); \
    if ((++_sp & 255u) == 0u) { if (xb_ld(&(bar)[XB_TMO])) break; if (_sp > XB_SPIN_CAP) { atomicAdd(&(bar)[XB_TMO], 1u); break; } } } } while (0)
struct XcdBarrier { unsigned* bar; unsigned x; volatile LAS unsigned* st; };
__device__ __forceinline__ XcdBarrier xcd_barrier_post(unsigned* bar, volatile LAS unsigned* st, int tid) {
  XcdBarrier b; b.bar = bar; b.x = xb_xcc_id(); b.st = st;
  if (tid == 0) (void)xb_add(&bar[XB_XCNT(b.x)], 1u);
  return b;
}
__device__ __forceinline__ void xcd_barrier_complete(unsigned* bar, unsigned x, unsigned& nloc, unsigned& nx) {
  const unsigned G = gridDim.x * gridDim.y * gridDim.z;
  unsigned sum, cnt, mine, sp = 0u;
  for (;;) {
    sum = 0u; cnt = 0u; mine = 0u;
#pragma unroll
    for (unsigned j = 0; j < 16; ++j) { const unsigned c = xb_ld(&bar[XB_XCNT(j)]); sum += c; cnt += (c > 0u) ? 1u : 0u; mine = (j == x) ? c : mine; }
    if (sum == G) break;
    __builtin_amdgcn_s_sleep(1);
    if ((++sp & 255u) == 0u) { if (xb_ld(&bar[XB_TMO])) break; if (sp > XB_SPIN_CAP) { atomicAdd(&bar[XB_TMO], 1u); break; } }
  }
  nloc = mine > 0u ? mine : 1u; nx = cnt > 0u ? cnt : 1u;
}
__device__ __forceinline__ void xcd_barrier(const XcdBarrier& b, int tid) {
  asm volatile("s_waitcnt vmcnt(0)" ::: "memory");
  __syncthreads();
  if (tid == 0) {
    unsigned* bar = b.bar;
    __builtin_amdgcn_s_waitcnt(0);
    unsigned nloc = b.st[0], nx = b.st[1];
    if (nloc == 0u) { xcd_barrier_complete(bar, b.x, nloc, nx); b.st[0] = nloc; b.st[1] = nx; }
    const unsigned old = xb_add(&bar[XB_XSUB(b.x)], 1u);
    const unsigned gen = old / nloc;
    if (old + 1u == (gen + 1u) * nloc) {
      __builtin_amdgcn_fence(__ATOMIC_RELEASE, "agent");
      asm volatile("s_waitcnt vmcnt(0)" ::: "memory");
      const unsigned og = xb_add(&bar[XB_TOP], 1u);
      const unsigned tg = og / nx;
      if (og + 1u == (tg + 1u) * nx) xb_add(&bar[XB_TOPGEN], 1u);
      else XB_SPIN(xb_ld(&bar[XB_TOPGEN]) == tg, bar);
      __builtin_amdgcn_fence(__ATOMIC_ACQUIRE, "agent");
      xb_add(&bar[XB_XGEN(b.x)], 1u);
      asm volatile("s_waitcnt vmcnt(0)" ::: "memory");
    } else {
      XB_SPIN(xb_ld(&bar[XB_XGEN(b.x)]) == gen, bar);
      __builtin_amdgcn_fence(__ATOMIC_ACQUIRE, "agent");
      asm volatile("s_waitcnt vmcnt(0)" ::: "memory");
    }
  }
  __syncthreads();
}


__global__ void __launch_bounds__(NTHREADS) fwd_megakernel(Params p) {
  cg::grid_group grid = cg::this_grid();
  extern __shared__ __attribute__((aligned(16))) float smem[];
  const int wv_ = __builtin_amdgcn_readfirstlane((int)(threadIdx.x >> 6));
  volatile LAS unsigned* xb_st = (volatile LAS unsigned*)((LAS char*)(LAS float*)smem + (160 * 1024 - 16));
  if (threadIdx.x == 0) { xb_st[0] = 0u; xb_st[1] = 0u; }
  __syncthreads();
  const XcdBarrier xb = xcd_barrier_post(p.bar, xb_st, (int)threadIdx.x);
#define GRID_BARRIER() xcd_barrier(xb, opaque_tid(wv_))

  o_prep(wv_, p, smem);
  if (gridDim.x > 4096u) grid.sync();
  GRID_BARRIER();
#pragma unroll 1
  for (int l = 0; l < DEPTH; ++l) {
    const float* xcur = (l == 0) ? p.x_in : p.xres;
    o_p1(wv_, p, l, xcur, (char*)smem);
    GRID_BARRIER();
    {
    {
      const int bidx_ = opaque_bid();
      const bool affine = (gridDim.x == 256u);
      for (int task = bidx_; task < 1792; task += gridDim.x) {
        const int l_ = opaque_s(l), td_ = opaque_tid(wv_);
        int tk = task;
        if (affine) {
          const int x = bidx_ & 7, lb = bidx_ >> 3, j = task >> 8;
          if (j < 4) { const int idx = lb + 32 * j; tk = ((x * 2 + (idx >> 6)) << 6) | (idx & 63); }
          else if (j < 6) { const int idx = lb + 32 * (j - 4); tk = 1024 + (((x * 2 + (idx >> 5)) << 5) | (idx & 31)); }
          else tk = 1536 + x * 32 + lb;
        }
        const int tk_ = opaque_s(tk);
        if (tk_ < 1024) o_na_task(p, l_, tk_, (char*)smem, td_);
        else if (tk_ < 1536) o_ret_kv_task(p, l_, tk_ - 1024, (char*)smem, td_);
        else o_pool_task(p, l_, tk_ - 1536, (char*)smem, td_);
      }
    }
    GRID_BARRIER();
    o_ret_scan(wv_, p, l);
    GRID_BARRIER();
    {
      const int tidx_ = opaque_tid(wv_); const int bidx_ = opaque_bid();
      for (int task = bidx_; task < 512; task += gridDim.x) {
        int tk = task;
        if (gridDim.x == 256u) {
          const int x = bidx_ & 7, lb = bidx_ >> 3, idx = lb + 32 * (task >> 8);
          tk = ((x * 2 + (idx >> 5)) << 5) | (idx & 31);
        }
        o_ret_out_task(p, l, opaque_s(tk), (char*)smem, tidx_);
      }
    }
    GRID_BARRIER();
    }
    {
      const int tidx_ = opaque_tid(wv_); const int bidx_ = opaque_bid();
      for (int tile = bidx_; tile < NTOK / 64; tile += gridDim.x) {
        { const int t0_ = opaque_s(tile * 64), l_ = opaque_s(l), td_ = opaque_tid(wv_); o_p5a1_tile(p, l_, t0_, (char*)smem, td_); }
        { const int t0_ = opaque_s(tile * 64), l_ = opaque_s(l), td_ = opaque_tid(wv_); o_p5a2_tile(p, l_, xcur, t0_, (char*)smem, td_); }
        { const int t0_ = opaque_s(tile * 64), l_ = opaque_s(l), td_ = opaque_tid(wv_); o_p5a3_tile(p, l_, t0_, (char*)smem, td_); }
        { const int t0_ = opaque_s(tile * 64), l_ = opaque_s(l), td_ = opaque_tid(wv_); o_peer_select_tile(p, l_, t0_, (char*)smem, td_); }
        { const int t0_ = opaque_s(tile * 64), l_ = opaque_s(l), td_ = opaque_tid(wv_); o_peer_select2_tile(p, l_, t0_, td_); }
        asm volatile("s_waitcnt vmcnt(0)" ::: "memory");
        __syncthreads();
        { const int t0_ = opaque_s(tile * 64), l_ = opaque_s(l), td_ = opaque_tid(wv_); o_peer_experts7_tile(p, l_, t0_, (const char*)smem, td_); }
        if (l + 1 == DEPTH) {
          asm volatile("s_waitcnt vmcnt(0)" ::: "memory");
          const int t0_ = opaque_s(tile * 64), td_ = opaque_tid(wv_);
          o_final_norm_tile(p, t0_, td_);
        }
      }
    }
    if (l + 1 < DEPTH) GRID_BARRIER();
  }
}

extern "C" void kernel_launch(void* const* d_in, const int* in_sizes, int n_in, void* d_out, int out_size,
                              void* d_ws, size_t ws_size, hipStream_t stream) {
  Params p{};
  p.x_in = (const float*)d_in[0]; p.norm_mix = (const float*)d_in[1]; p.w_in = (const float*)d_in[2];
  p.pool_w = (const float*)d_in[3]; p.pool_scale = (const float*)d_in[4]; p.ret_decay = (const float*)d_in[5];
  p.na_rpb = (const float*)d_in[6]; p.w_br_pool = (const float*)d_in[7]; p.w_br_ret = (const float*)d_in[8];
  p.w_br_na = (const float*)d_in[9]; p.w_out = (const float*)d_in[10]; p.norm_ffn = (const float*)d_in[11];
  p.w_query = (const float*)d_in[12]; p.sub_keys = (const float*)d_in[13]; p.peer_u = (const float*)d_in[14];
  p.peer_v = (const float*)d_in[15]; p.norm_final = (const float*)d_in[16];
  p.out = (float*)d_out;
  char* ws = (char*)d_ws;
  size_t off = 0;
  auto alloc = [&](size_t bytes) { char* q = ws + off; off += (bytes + 255) & ~(size_t)255; return q; };
  p.xres = (float*)alloc((size_t)NTOK * D_MODEL * 4);
  p.proj = (bf16_t*)alloc((size_t)NTOK * IN_WIDTH * 2);
  p.ycat = (bf16_t*)alloc((size_t)NTOK * 1024 * 2);
  p.mrg = (bf16_t*)alloc((size_t)NTOK * 1024 * 2);
  p.pidx = (int*)alloc((size_t)NTOK * 128 * 4);
  p.pgate = (float*)alloc((size_t)NTOK * 128 * 4);
  p.wf_in = (bf16_t*)alloc((size_t)DEPTH * D_MODEL * IN_WIDTH * 2);
  p.wf_br = (bf16_t*)alloc((size_t)DEPTH * 1024 * 1024 * 2);
  p.wf_out = (bf16_t*)alloc((size_t)DEPTH * 1024 * 1024 * 2);
  p.wf_q = (bf16_t*)alloc((size_t)DEPTH * 1024 * 2048 * 2);
  p.kf = (bf16_t*)alloc((size_t)DEPTH * 2 * 128 * 128 * 2);
  p.u16 = nullptr; p.v16 = nullptr;
  p.u8 = (unsigned char*)alloc((size_t)DEPTH * 16384 * 1024);
  p.v8 = (unsigned char*)alloc((size_t)DEPTH * 16384 * 1024);
  p.escale = (float2*)alloc((size_t)DEPTH * 16384 * 8);
  p.rope = (float2*)alloc((size_t)SEQ * 32 * 8);
  p.tklist = (unsigned*)alloc((size_t)NTOK * 8 * 2 * 16 * 4);
  p.kvst = (float*)p.mrg;
  p.rstate = (bf16_t*)p.tklist;
  p.bar = (unsigned*)alloc(XCD_BAR_WORDS * 4);
  p.xn = nullptr; p.merged = nullptr; p.pq = nullptr; p.psc = nullptr;
  if (off > ws_size) fprintf(stderr, "WORKSPACE OVERFLOW: need %zu have %zu\n", off, ws_size);

  const size_t kDynLds = 160 * 1024;
  static int grid_blocks = 0;
  if (!grid_blocks) {
    int dev = 0, cus = 0, per_cu = 0;
    (void)hipGetDevice(&dev);
    (void)hipDeviceGetAttribute(&cus, hipDeviceAttributeMultiprocessorCount, dev);
    (void)hipFuncSetAttribute((const void*)fwd_megakernel, hipFuncAttributeMaxDynamicSharedMemorySize, (int)kDynLds);
    (void)hipOccupancyMaxActiveBlocksPerMultiprocessor(&per_cu, fwd_megakernel, NTHREADS, kDynLds);
    if (per_cu < 1) per_cu = 1;
    grid_blocks = cus * per_cu;
  }
  (void)hipMemsetAsync(p.bar, 0, XCD_BAR_WORDS * 4, stream);
  void* args[] = {&p};
  hipError_t e = hipLaunchCooperativeKernel((void*)fwd_megakernel, dim3(grid_blocks), dim3(NTHREADS), args, kDynLds, stream);
  if (e != hipSuccess) fprintf(stderr, "cooperative launch failed: %s (grid %d)\n", hipGetErrorString(e), grid_blocks);
}
```

```cpp
#include <hip/hip_runtime.h>
#include <hip/hip_cooperative_groups.h>
#include <stdint.h>
#include <cstdio>
namespace cg = cooperative_groups;

#define D_MODEL 1024
#define SEQ 4096
#define BATCH 4
#define NTOK (BATCH * SEQ)
#define DEPTH 2
#define IN_WIDTH 5632
#define C_POOL 0
#define C_RQ 256
#define C_RK 512
#define C_RV 768
#define C_RG 1280
#define C_NQ 1792
#define C_NK 2048
#define C_NV 2304
#define C_GATE 2560
#define EPS 1e-6f
#define NTHREADS 512

typedef unsigned short bf16_t;

struct Params {
  const float* x_in; const float* norm_mix; const float* w_in; const float* pool_w; const float* pool_scale;
  const float* ret_decay; const float* na_rpb; const float* w_br_pool; const float* w_br_ret; const float* w_br_na;
  const float* w_out; const float* norm_ffn; const float* w_query; const float* sub_keys; const float* peer_u;
  const float* peer_v; const float* norm_final;
  float* out;
  float* xres;
  bf16_t* xn;
  bf16_t* proj;
  bf16_t* ycat;
  float* merged;
  float* pq;
  float* psc;
  int* pidx;
  float* pgate;
  bf16_t* wf_in;
  bf16_t* wf_br;
  bf16_t* wf_out;
  bf16_t* wf_q;
  bf16_t* kf;
  bf16_t* u16;
  bf16_t* v16;
  float2* rope;
  bf16_t* mrg;
  unsigned* tklist;
  float* kvst;
  bf16_t* rstate;
  unsigned* bar;
  unsigned char* u8; unsigned char* v8;
  float2* escale;
};

__device__ __forceinline__ bf16_t f2bf(float f) {
  unsigned u = __float_as_uint(f);
  u += 0x7fffu + ((u >> 16) & 1u);
  return (bf16_t)(u >> 16);
}
__device__ __forceinline__ float bf2f(bf16_t h) { return __uint_as_float(((unsigned)h) << 16); }

__device__ __forceinline__ float wave_sum(float v) {
#pragma unroll
  for (int o = 32; o > 0; o >>= 1) v += __shfl_xor(v, o, 64);
  return v;
}
__device__ __forceinline__ float wave_max(float v) {
#pragma unroll
  for (int o = 32; o > 0; o >>= 1) v = fmaxf(v, __shfl_xor(v, o, 64));
  return v;
}
__device__ __forceinline__ float sigmoidf_(float x) { return 1.0f / (1.0f + expf(-x)); }

__device__ __forceinline__ int opaque_tid(int wv) {
  int w = wv;
  asm volatile("" : "+s"(w));
  int lane = __builtin_amdgcn_mbcnt_hi(~0u, __builtin_amdgcn_mbcnt_lo(~0u, 0u));
  asm volatile("" : "+v"(lane));
  return w * 64 + lane;
}
__device__ __forceinline__ int opaque_s(int x) { asm volatile("" : "+s"(x)); return x; }
__device__ __forceinline__ int opaque_bid() { int b = blockIdx.x; asm volatile("" : "+s"(b)); return b; }

template <bool OUT_F32>
__device__ __forceinline__ void n_rmsnorm(const int wv_, const float* __restrict__ x, const float* __restrict__ g, void* outp, int rows) {
  const int tidx_ = opaque_tid(wv_); const int bidx_ = opaque_bid();
  const int lane = tidx_ & 63;
  const int nw = gridDim.x * (NTHREADS / 64);
  for (int row = bidx_ * (NTHREADS / 64) + (tidx_ >> 6); row < rows; row += nw) {
    const float* xr = x + (size_t)row * D_MODEL;
    float4 v[4];
    float ss = 0.f;
#pragma unroll
    for (int i = 0; i < 4; ++i) {
      v[i] = *(const float4*)(xr + i * 256 + lane * 4);
      ss += v[i].x * v[i].x + v[i].y * v[i].y + v[i].z * v[i].z + v[i].w * v[i].w;
    }
    ss = wave_sum(ss);
    float r = rsqrtf(ss * (1.0f / D_MODEL) + EPS);
#pragma unroll
    for (int i = 0; i < 4; ++i) {
      float4 gg = *(const float4*)(g + i * 256 + lane * 4);
      float o0 = v[i].x * r * gg.x, o1 = v[i].y * r * gg.y, o2 = v[i].z * r * gg.z, o3 = v[i].w * r * gg.w;
      if (OUT_F32) {
        *(float4*)((float*)outp + (size_t)row * D_MODEL + i * 256 + lane * 4) = make_float4(o0, o1, o2, o3);
      } else {
        ushort4 o; o.x = f2bf(o0); o.y = f2bf(o1); o.z = f2bf(o2); o.w = f2bf(o3);
        *(ushort4*)((bf16_t*)outp + (size_t)row * D_MODEL + i * 256 + lane * 4) = o;
      }
    }
  }
}

typedef __attribute__((ext_vector_type(8))) short bf16x8;
typedef __attribute__((ext_vector_type(4))) float f32x4;
#define LDX 1032
#define LDXB (LDX * 2)
#define XTILE_BYTES (64 * LDXB)

__device__ __forceinline__ unsigned pack2bf(float a, float b) { return (unsigned)f2bf(a) | ((unsigned)f2bf(b) << 16); }

__device__ __forceinline__ void prep_frag(const int wv_, const float* __restrict__ W, int K, int N, bf16_t* __restrict__ dst, float* smem) {
  const int tidx_ = opaque_tid(wv_); const int bidx_ = opaque_bid();
  const int grp = tidx_ >> 8, tid = tidx_ & 255;
  float(*T)[65] = (float(*)[65])(smem + grp * 32 * 65);
  const int KS = K / 32, NC = N / 64;
  const int ntiles = KS * NC;
  for (int wb = bidx_ * 2; wb < ntiles; wb += gridDim.x * 2) {
    const int w = wb + grp;
    const int c = w / KS, ks = w - c * KS;
    {
      const int row = tid >> 3, col = (tid & 7) * 8;
      const float* src = W + (size_t)(ks * 32 + row) * N + c * 64 + col;
      float4 a = *(const float4*)src, b = *(const float4*)(src + 4);
      __syncthreads();
      T[row][col + 0] = a.x; T[row][col + 1] = a.y; T[row][col + 2] = a.z; T[row][col + 3] = a.w;
      T[row][col + 4] = b.x; T[row][col + 5] = b.y; T[row][col + 6] = b.z; T[row][col + 7] = b.w;
    }
    __syncthreads();
    {
      const int nt = tid >> 6, lane = tid & 63;
      const int kr = 8 * (lane >> 4), nc = nt * 16 + (lane & 15);
      uint4 o;
      o.x = pack2bf(T[kr + 0][nc], T[kr + 1][nc]);
      o.y = pack2bf(T[kr + 2][nc], T[kr + 3][nc]);
      o.z = pack2bf(T[kr + 4][nc], T[kr + 5][nc]);
      o.w = pack2bf(T[kr + 6][nc], T[kr + 7][nc]);
      *(uint4*)(dst + ((size_t)((c * KS + ks) * 4 + nt) * 64 + lane) * 8) = o;
    }
  }
}

__device__ __forceinline__ void o_prep(const int wv_, const Params& p, float* smem) {
  for (int l = 0; l < DEPTH; ++l) {
    prep_frag(wv_, p.w_in + (size_t)l * D_MODEL * IN_WIDTH, D_MODEL, IN_WIDTH, p.wf_in + (size_t)l * D_MODEL * IN_WIDTH, smem);
    prep_frag(wv_, p.w_br_pool + (size_t)l * 256 * 1024, 256, 1024, p.wf_br + (size_t)l * 1024 * 1024, smem);
    prep_frag(wv_, p.w_br_ret + (size_t)l * 512 * 1024, 512, 1024, p.wf_br + (size_t)l * 1024 * 1024 + 256 * 1024, smem);
    prep_frag(wv_, p.w_br_na + (size_t)l * 256 * 1024, 256, 1024, p.wf_br + (size_t)l * 1024 * 1024 + 768 * 1024, smem);
    prep_frag(wv_, p.w_out + (size_t)l * 1024 * 1024, 1024, 1024, p.wf_out + (size_t)l * 1024 * 1024, smem);
    prep_frag(wv_, p.w_query + (size_t)l * 1024 * 2048, 1024, 2048, p.wf_q + (size_t)l * 1024 * 2048, smem);
  }
  const int tidx_ = opaque_tid(wv_); const int bidx_ = opaque_bid();
  const int gtid = bidx_ * NTHREADS + tidx_, gsz = gridDim.x * NTHREADS;
  for (int u = gtid; u < DEPTH * 2 * 8 * 4 * 64; u += gsz) {
    const int lane = u & 63, s2 = (u >> 6) & 3, kt = (u >> 8) & 7, lp = u >> 11;
    const float* kr = p.sub_keys + ((size_t)lp * 128 + kt * 16 + (lane & 15)) * 128;
    float v[8];
#pragma unroll
    for (int j = 0; j < 8; ++j) v[j] = kr[16 * (2 * s2 + (j >> 2)) + 4 * (lane >> 4) + (j & 3)];
    uint4 o;
    o.x = pack2bf(v[0], v[1]); o.y = pack2bf(v[2], v[3]); o.z = pack2bf(v[4], v[5]); o.w = pack2bf(v[6], v[7]);
    *(uint4*)(p.kf + (size_t)u * 8) = o;
  }
  {
    const int lane = tidx_ & 63;
    const int gw = (bidx_ * NTHREADS + tidx_) >> 6, nw = gsz >> 6;
    for (int row = gw; row < DEPTH * 16384 * 2; row += nw) {
      const int tbl = row & 1, er = row >> 1;
      const float* src = (tbl ? p.peer_v : p.peer_u) + (size_t)er * 1024 + lane * 16;
      float4 f[4];
#pragma unroll
      for (int i = 0; i < 4; ++i) f[i] = *(const float4*)(src + 4 * i);
      float m = 0.f;
#pragma unroll
      for (int i = 0; i < 4; ++i) m = fmaxf(m, fmaxf(fmaxf(fabsf(f[i].x), fabsf(f[i].y)), fmaxf(fabsf(f[i].z), fabsf(f[i].w))));
      m = wave_max(m);
      int k = 0;
      if (m > 0.f) {
        int e;
        const float fr = __builtin_frexpf(m, &e);
        k = ((fr <= 0.875f) ? 9 : 8) - e;
        k = k < -100 ? -100 : (k > 100 ? 100 : k);
      }
      const float sc = __builtin_ldexpf(1.0f, k);
      uint4 o;
      unsigned w[4];
#pragma unroll
      for (int i = 0; i < 4; ++i) {
        int pkd = 0;
        pkd = __builtin_amdgcn_cvt_pk_fp8_f32(f[i].x * sc, f[i].y * sc, pkd, false);
        pkd = __builtin_amdgcn_cvt_pk_fp8_f32(f[i].z * sc, f[i].w * sc, pkd, true);
        w[i] = (unsigned)pkd;
      }
      o.x = w[0]; o.y = w[1]; o.z = w[2]; o.w = w[3];
      *(uint4*)((tbl ? p.v8 : p.u8) + (size_t)er * 1024 + lane * 16) = o;
      if (lane == 0) ((float*)p.escale)[(size_t)er * 2 + tbl] = __builtin_ldexpf(1.0f, -k);
    }
  }
  for (int u = gtid; u < SEQ * 32; u += gsz) {
    const int i = u & 31, pos = u >> 5;
    float inv = 1.0f / powf(10000.0f, (float)i / 31.0f);
    float ang = (float)pos * inv;
    double rev = (double)ang * 0.15915494309189535;
    rev -= floor(rev);
    float rf = (float)rev;
    p.rope[u] = make_float2(__builtin_amdgcn_cosf(rf), __builtin_amdgcn_sinf(rf));
  }
}

template <int NT, int PD, int RING>
__device__ __forceinline__ void tl_gemm_prologue(const bf16_t* __restrict__ wf, bf16x8 (&wb)[RING][NT], const int lane, const int nt0 = 0) {
  const bf16x8* wp = (const bf16x8*)wf + lane + nt0 * 64;
#pragma unroll
  for (int s = 0; s < PD; ++s)
#pragma unroll
    for (int nt = 0; nt < NT; ++nt) wb[s][nt] = wp[(s * 4 + nt) * 64];
}
template <int NT, int PD, int RING>
__device__ __forceinline__ void tl_gemm_main(const bf16_t* __restrict__ wf, const int KS, const char* xt, const int kbyte0,
                                             f32x4 (&acc)[NT][4], bf16x8 (&wb)[RING][NT], const int lane, const int nt0 = 0) {
  const bf16x8* wp = (const bf16x8*)wf + lane + nt0 * 64;
  const char* xp = xt + (lane & 15) * LDXB + kbyte0 + (lane >> 4) * 16;
  for (int ks = 0; ks < KS; ks += RING) {
#pragma unroll
    for (int u = 0; u < RING; ++u) {
      int kpre = ks + u + PD;
      kpre = kpre < KS ? kpre : KS - 1;
#pragma unroll
      for (int nt = 0; nt < NT; ++nt) wb[(u + PD) % RING][nt] = wp[(kpre * 4 + nt) * 64];
      __builtin_amdgcn_s_setprio(1);
      bf16x8 xf[4];
#pragma unroll
      for (int mt = 0; mt < 4; ++mt) xf[mt] = *(const bf16x8*)(xp + mt * 16 * LDXB + (ks + u) * 64);
#pragma unroll
      for (int nt = 0; nt < NT; ++nt)
#pragma unroll
        for (int mt = 0; mt < 4; ++mt)
          acc[nt][mt] = __builtin_amdgcn_mfma_f32_16x16x32_bf16(wb[u][nt], xf[mt], acc[nt][mt], 0, 0, 0);
      __builtin_amdgcn_s_setprio(0);
    }
  }
}
template <int NT, int PD = 3, int RING = 4>
__device__ __forceinline__ void tl_gemm_chunk(const bf16_t* __restrict__ wf, const int KS, const char* xt, const int kbyte0,
                                              f32x4 (&acc)[NT][4], const int lane, const int nt0 = 0) {
  bf16x8 wb[RING][NT];
  tl_gemm_prologue<NT, PD, RING>(wf, wb, lane, nt0);
  tl_gemm_main<NT, PD, RING>(wf, KS, xt, kbyte0, acc, wb, lane, nt0);
}

__device__ __forceinline__ void tile_rmsnorm_to_lds(const float* __restrict__ xsrc, const float* __restrict__ g, int t0,
                                                    char* xt, int wave, int lane) {
#pragma unroll 2
  for (int i = 0; i < 8; ++i) {
    const int tok = wave * 8 + i;
    const float* xr = xsrc + (size_t)(t0 + tok) * D_MODEL;
    float4 v[4];
    float ss = 0.f;
#pragma unroll
    for (int q = 0; q < 4; ++q) {
      v[q] = *(const float4*)(xr + q * 256 + lane * 4);
      ss += v[q].x * v[q].x + v[q].y * v[q].y + v[q].z * v[q].z + v[q].w * v[q].w;
    }
    ss = wave_sum(ss);
    const float r = rsqrtf(ss * (1.0f / D_MODEL) + EPS);
#pragma unroll
    for (int q = 0; q < 4; ++q) {
      float4 gg = *(const float4*)(g + q * 256 + lane * 4);
      uint2 o;
      o.x = pack2bf(v[q].x * r * gg.x, v[q].y * r * gg.y);
      o.y = pack2bf(v[q].z * r * gg.z, v[q].w * r * gg.w);
      *(uint2*)(xt + tok * LDXB + (q * 256 + lane * 4) * 2) = o;
    }
  }
}

__device__ __forceinline__ void o_p1(const int wv_, const Params& p, int l, const float* __restrict__ xsrc, char* smem) {
  const int tidx_ = opaque_tid(wv_); const int bidx_ = opaque_bid();
  const int wave = tidx_ >> 6, lane = tidx_ & 63;
  const bf16_t* wf = p.wf_in + (size_t)l * D_MODEL * IN_WIDTH;
  const float* g = p.norm_mix + l * D_MODEL;
  for (int tile = bidx_; tile < NTOK / 64; tile += gridDim.x) {
    const int t0 = tile * 64;
    __syncthreads();
    tile_rmsnorm_to_lds(xsrc, g, t0, smem, wave, lane);
    __syncthreads();
#pragma unroll 1
    for (int c = wave; c < IN_WIDTH / 64; c += 8) {
      f32x4 acc[4][4];
#pragma unroll
      for (int a = 0; a < 4; ++a)
#pragma unroll
        for (int b = 0; b < 4; ++b) acc[a][b] = (f32x4){0.f, 0.f, 0.f, 0.f};
      tl_gemm_chunk<4, 3, 4>(wf + (size_t)c * 32 * 4 * 64 * 8, 32, smem, 0, acc, lane);
      asm volatile("" ::: "memory");
      if (c >= 4 && c < 12) {
        const float sc = (c >= 8) ? 0.125f : 1.0f;
#pragma unroll
        for (int mt = 0; mt < 4; ++mt) {
          const int tok = t0 + mt * 16 + (lane & 15);
          const int pos = tok & (SEQ - 1);
#pragma unroll
          for (int nt = 0; nt < 2; ++nt) {
            const int i0 = nt * 16 + 4 * (lane >> 4);
            const float4 cs01 = *(const float4*)(p.rope + pos * 32 + i0);
            const float4 cs23 = *(const float4*)(p.rope + pos * 32 + i0 + 2);
            const float cc[4] = {cs01.x, cs01.z, cs23.x, cs23.z};
            const float sn[4] = {cs01.y, cs01.w, cs23.y, cs23.w};
#pragma unroll
            for (int r = 0; r < 4; ++r) {
              const float x1 = acc[nt][mt][r], x2 = acc[nt + 2][mt][r];
              acc[nt][mt][r] = (x1 * cc[r] - x2 * sn[r]) * sc;
              acc[nt + 2][mt][r] = (x1 * sn[r] + x2 * cc[r]) * sc;
            }
          }
        }
      } else if (c >= 28 && c < 32) {
#pragma unroll
        for (int a = 0; a < 4; ++a)
#pragma unroll
          for (int b = 0; b < 4; ++b) acc[a][b] *= 0.125f;
      } else if (c >= 40) {
#pragma unroll
        for (int a = 0; a < 4; ++a)
#pragma unroll
          for (int b = 0; b < 4; ++b)
#pragma unroll
            for (int r = 0; r < 4; ++r) acc[a][b][r] = 1.0f / (1.0f + __expf(-acc[a][b][r]));
      }
      {
        char* patch = smem + XTILE_BYTES + wave * 2304;
#pragma unroll
        for (int mt = 0; mt < 4; ++mt) {
#pragma unroll
          for (int nt = 0; nt < 4; ++nt) {
            uint2 o;
            o.x = pack2bf(acc[nt][mt][0], acc[nt][mt][1]);
            o.y = pack2bf(acc[nt][mt][2], acc[nt][mt][3]);
            *(uint2*)(patch + (lane & 15) * 144 + (nt * 16 + 4 * (lane >> 4)) * 2) = o;
          }
#pragma unroll
          for (int h = 0; h < 2; ++h) {
            const int row = h * 8 + (lane >> 3), unit = lane & 7;
            const uint4 v = *(const uint4*)(patch + row * 144 + unit * 16);
            *(uint4*)(p.proj + (size_t)(t0 + mt * 16 + row) * IN_WIDTH + c * 64 + unit * 8) = v;
          }
        }
      }
    }
  }
}


__device__ __forceinline__ void o_final_norm_tile(const Params& p, int t0, int tid) {
  const int wave = tid >> 6, lane = tid & 63;
#pragma unroll 2
  for (int i = 0; i < 8; ++i) {
    const size_t row = (size_t)(t0 + wave * 8 + i) * D_MODEL;
    float4 v[4];
    float ss = 0.f;
#pragma unroll
    for (int q = 0; q < 4; ++q) {
      v[q] = *(const float4*)(p.xres + row + q * 256 + lane * 4);
      ss += v[q].x * v[q].x + v[q].y * v[q].y + v[q].z * v[q].z + v[q].w * v[q].w;
    }
    ss = wave_sum(ss);
    const float r = rsqrtf(ss * (1.0f / D_MODEL) + EPS);
#pragma unroll
    for (int q = 0; q < 4; ++q) {
      const float4 gg = *(const float4*)(p.norm_final + q * 256 + lane * 4);
      *(float4*)(p.out + row + q * 256 + lane * 4) = make_float4(v[q].x * r * gg.x, v[q].y * r * gg.y, v[q].z * r * gg.z, v[q].w * r * gg.w);
    }
  }
}

__device__ __forceinline__ void tile_load_to_lds(const bf16_t* __restrict__ src, int ld, char* xt, int tid) {
#pragma unroll 4
  for (int it = 0; it < 16; ++it) {
    const int idx = it * NTHREADS + tid;
    const int row = idx >> 7, u = idx & 127;
    const uint4 v = *(const uint4*)(src + (size_t)row * ld + u * 8);
    *(uint4*)(xt + row * LDXB + u * 16) = v;
  }
}

__device__ __forceinline__ void o_p5a1_tile(const Params& p, int l, int t0, char* smem, int tid) {
  const int wave = tid >> 6, lane = tid & 63;
  __syncthreads();
  tile_load_to_lds(p.ycat + (size_t)t0 * 1024, 1024, smem, tid);
  __syncthreads();
  const bf16_t* wfb = p.wf_br + (size_t)l * 1024 * 1024;
  bf16x8 wb[4][2];
  f32x4 m[2][4];
  {
    const int c0 = wave >> 1, nt00 = (wave & 1) * 2;
    tl_gemm_prologue<2, 3, 4>(wfb + (size_t)c0 * 8 * 4 * 64 * 8, wb, lane, nt00);
  }
#pragma unroll 1
  for (int it = 0; it < 12; ++it) {
    const int hi = it / 3, br = it - hi * 3;
    const int hc = wave + 8 * hi;
    const int c = hc >> 1, nt0 = (hc & 1) * 2;
    const int koff = (br == 0) ? 0 : (br == 1 ? 256 : 768);
    const int KS = (br == 1) ? 16 : 8;
    uint2 gv[4][2];
#pragma unroll
    for (int mt = 0; mt < 4; ++mt) {
      const int tok = t0 + mt * 16 + (lane & 15);
      const bf16_t* gp = p.proj + (size_t)tok * IN_WIDTH + C_GATE + br * 1024 + c * 64 + nt0 * 16 + 4 * (lane >> 4);
#pragma unroll
      for (int nt = 0; nt < 2; ++nt) gv[mt][nt] = *(const uint2*)(gp + nt * 16);
    }
    f32x4 acc[2][4];
#pragma unroll
    for (int a2 = 0; a2 < 2; ++a2)
#pragma unroll
      for (int b2 = 0; b2 < 4; ++b2) acc[a2][b2] = (f32x4){0.f, 0.f, 0.f, 0.f};
    tl_gemm_main<2, 3, 4>(wfb + (size_t)koff * 1024 + (size_t)c * KS * 4 * 64 * 8, KS, smem, koff * 2, acc, wb, lane, nt0);
    asm volatile("" ::: "memory");
    {
      const int itn = (it + 1 < 12) ? it + 1 : it;
      const int hin = itn / 3, brn = itn - hin * 3;
      const int hcn = wave + 8 * hin;
      const int koffn = (brn == 0) ? 0 : (brn == 1 ? 256 : 768);
      const int KSn = (brn == 1) ? 16 : 8;
      tl_gemm_prologue<2, 3, 4>(wfb + (size_t)koffn * 1024 + (size_t)(hcn >> 1) * KSn * 4 * 64 * 8, wb, lane, (hcn & 1) * 2);
    }
    if (br == 0) {
#pragma unroll
      for (int a2 = 0; a2 < 2; ++a2)
#pragma unroll
        for (int b2 = 0; b2 < 4; ++b2) m[a2][b2] = (f32x4){0.f, 0.f, 0.f, 0.f};
    }
#pragma unroll
    for (int mt = 0; mt < 4; ++mt)
#pragma unroll
      for (int nt = 0; nt < 2; ++nt) {
        m[nt][mt][0] += __uint_as_float(gv[mt][nt].x << 16) * acc[nt][mt][0];
        m[nt][mt][1] += __uint_as_float(gv[mt][nt].x & 0xffff0000u) * acc[nt][mt][1];
        m[nt][mt][2] += __uint_as_float(gv[mt][nt].y << 16) * acc[nt][mt][2];
        m[nt][mt][3] += __uint_as_float(gv[mt][nt].y & 0xffff0000u) * acc[nt][mt][3];
      }
    if (br == 2) {
#pragma unroll
      for (int mt = 0; mt < 4; ++mt) {
        const int tok = t0 + mt * 16 + (lane & 15);
        bf16_t* dst = p.mrg + (size_t)tok * 1024 + c * 64 + nt0 * 16 + 4 * (lane >> 4);
#pragma unroll
        for (int nt = 0; nt < 2; ++nt) {
          uint2 o;
          o.x = pack2bf(m[nt][mt][0], m[nt][mt][1]);
          o.y = pack2bf(m[nt][mt][2], m[nt][mt][3]);
          *(uint2*)(dst + nt * 16) = o;
        }
      }
    }
  }
}
__device__ __forceinline__ void o_p5a2_tile(const Params& p, int l, const float* __restrict__ xcur, int t0, char* smem, int tid) {
  const int wave = tid >> 6, lane = tid & 63;
  __syncthreads();
  tile_load_to_lds(p.mrg + (size_t)t0 * 1024, 1024, smem, tid);
  __syncthreads();
  const bf16_t* wfo = p.wf_out + (size_t)l * 1024 * 1024;
#pragma unroll 1
  for (int c = wave; c < 16; c += 8) {
    f32x4 acc[4][4];
#pragma unroll
    for (int a = 0; a < 4; ++a)
#pragma unroll
      for (int b = 0; b < 4; ++b) acc[a][b] = (f32x4){0.f, 0.f, 0.f, 0.f};
    tl_gemm_chunk<4, 2>(wfo + (size_t)c * 32 * 4 * 64 * 8, 32, smem, 0, acc, lane);
    asm volatile("" ::: "memory");
#pragma unroll
    for (int mt = 0; mt < 4; ++mt) {
      const int tok = t0 + mt * 16 + (lane & 15);
      const size_t o = (size_t)tok * 1024 + c * 64 + 4 * (lane >> 4);
#pragma unroll
      for (int nt = 0; nt < 4; ++nt) {
        float4 xv = *(const float4*)(xcur + o + nt * 16);
        xv.x += acc[nt][mt][0]; xv.y += acc[nt][mt][1]; xv.z += acc[nt][mt][2]; xv.w += acc[nt][mt][3];
        *(float4*)(p.xres + o + nt * 16) = xv;
      }
    }
  }
}
__device__ __forceinline__ void o_p5a3_tile(const Params& p, int l, int t0, char* smem, int tid) {
  const int wave = tid >> 6, lane = tid & 63;
  __syncthreads();
  tile_rmsnorm_to_lds(p.xres, p.norm_ffn + l * D_MODEL, t0, smem, wave, lane);
  __syncthreads();
}


__device__ __forceinline__ unsigned mono_f(float f) {
  unsigned u = __float_as_uint(f);
  return (u & 0x80000000u) ? ~u : (u | 0x80000000u);
}
__device__ __forceinline__ float unmono_f(unsigned m) {
  return __uint_as_float((m & 0x80000000u) ? (m & 0x7fffffffu) : ~m);
}
#define CE_DESC(x, y) { const unsigned hi_ = max(x, y); const unsigned lo_ = min(x, y); x = hi_; y = lo_; }
#define CE_ASC(x, y) { const unsigned hi_ = max(x, y); const unsigned lo_ = min(x, y); x = lo_; y = hi_; }
__device__ __forceinline__ void sort16_desc(unsigned (&a)[16]) {
#pragma unroll
  for (int k = 2; k <= 16; k <<= 1) {
#pragma unroll
    for (int j = k >> 1; j > 0; j >>= 1) {
#pragma unroll
      for (int i = 0; i < 16; ++i) {
        const int l = i ^ j;
        if (l > i) {
          if ((i & k) == 0) CE_DESC(a[i], a[l]) else CE_ASC(a[i], a[l])
        }
      }
    }
  }
}
__device__ __forceinline__ void bitonic_merge16_desc(unsigned (&a)[16]) {
#pragma unroll
  for (int j = 8; j > 0; j >>= 1) {
#pragma unroll
    for (int i = 0; i < 16; ++i) {
      const int l = i ^ j;
      if (l > i) CE_DESC(a[i], a[l])
    }
  }
}
__device__ __forceinline__ void xlane_merge16(unsigned (&a)[16], int mask) {
  unsigned b[16];
#pragma unroll
  for (int i = 0; i < 16; ++i) b[i] = (unsigned)__shfl_xor((int)a[i], mask, 64);
#pragma unroll
  for (int i = 0; i < 16; ++i) a[i] = max(a[i], b[15 - i]);
  bitonic_merge16_desc(a);
}

__device__ __forceinline__ void o_peer_select_tile(const Params& p, int l, int t0, char* smem, int tid) {
  const int h = __builtin_amdgcn_readfirstlane(tid >> 6), lane = tid & 63;
  const int g = lane >> 4, tl = lane & 15;
  const bf16_t* wfq = p.wf_q + (size_t)l * 1024 * 2048;
#pragma unroll 1
  for (int pp = 0; pp < 2; ++pp) {
    bf16x8 qf[4][4];
#pragma unroll 1
    for (int cc = 0; cc < 2; ++cc) {
      const int c = (h * 2 + pp) * 2 + cc;
      f32x4 acc[4][4];
#pragma unroll
      for (int a = 0; a < 4; ++a)
#pragma unroll
        for (int b = 0; b < 4; ++b) acc[a][b] = (f32x4){0.f, 0.f, 0.f, 0.f};
      tl_gemm_chunk<4, 2>(wfq + (size_t)c * 32 * 4 * 64 * 8, 32, smem, 0, acc, lane);
#pragma unroll
      for (int sl = 0; sl < 2; ++sl)
#pragma unroll
        for (int mt = 0; mt < 4; ++mt) {
          union { bf16x8 v; unsigned u[4]; } cv;
          cv.u[0] = pack2bf(acc[2 * sl][mt][0], acc[2 * sl][mt][1]);
          cv.u[1] = pack2bf(acc[2 * sl][mt][2], acc[2 * sl][mt][3]);
          cv.u[2] = pack2bf(acc[2 * sl + 1][mt][0], acc[2 * sl + 1][mt][1]);
          cv.u[3] = pack2bf(acc[2 * sl + 1][mt][2], acc[2 * sl + 1][mt][3]);
          if (cc == 0) qf[sl][mt] = cv.v; else qf[2 + sl][mt] = cv.v;
        }
    }
    const bf16x8* kfp = (const bf16x8*)p.kf + (size_t)((l * 2 + pp) * 8) * 4 * 64 + lane;
#pragma unroll
    for (int mt = 0; mt < 4; ++mt) {
      f32x4 sc[8];
#pragma unroll
      for (int kt = 0; kt < 8; ++kt) sc[kt] = (f32x4){0.f, 0.f, 0.f, 0.f};
#pragma unroll
      for (int s2 = 0; s2 < 4; ++s2) {
        bf16x8 qv;
        qv = qf[s2][mt];
#pragma unroll
        for (int kt = 0; kt < 8; ++kt)
          sc[kt] = __builtin_amdgcn_mfma_f32_16x16x32_bf16(kfp[(kt * 4 + s2) * 64], qv, sc[kt], 0, 0, 0);
        __builtin_amdgcn_sched_barrier(0);
      }
      unsigned A[16], B[16];
#pragma unroll
      for (int kt = 0; kt < 4; ++kt)
#pragma unroll
        for (int r = 0; r < 4; ++r) {
          A[kt * 4 + r] = (mono_f(sc[kt][r]) & ~127u) | (unsigned)(127 - (kt * 16 + r) - 4 * g);
          B[kt * 4 + r] = (mono_f(sc[kt + 4][r]) & ~127u) | (unsigned)(127 - ((kt + 4) * 16 + r) - 4 * g);
        }
      sort16_desc(A);
      sort16_desc(B);
#pragma unroll
      for (int i = 0; i < 16; ++i) A[i] = max(A[i], B[15 - i]);
      bitonic_merge16_desc(A);
      xlane_merge16(A, 16);
      xlane_merge16(A, 32);
      if (g == 0) {
        uint4* dst = (uint4*)(p.tklist + ((size_t)((t0 + mt * 16 + tl) * 8 + h) * 2 + pp) * 16);
        dst[0] = make_uint4(A[0], A[1], A[2], A[3]);
        dst[1] = make_uint4(A[4], A[5], A[6], A[7]);
        dst[2] = make_uint4(A[8], A[9], A[10], A[11]);
        dst[3] = make_uint4(A[12], A[13], A[14], A[15]);
      }
    }
  }
  asm volatile("s_waitcnt vmcnt(0)" ::: "memory");
}

__device__ __forceinline__ void o_peer_select2_tile(const Params& p, int l, int t0, int tid) {
  const int h = __builtin_amdgcn_readfirstlane(tid >> 6), lane = tid & 63;
  const int g = lane >> 4, tl = lane & 15;
#pragma unroll 1
  for (int mt = 0; mt < 4; ++mt) {
    const int tok = t0 + mt * 16 + tl;
    const unsigned* lp = p.tklist + ((size_t)(tok * 8 + h) * 2) * 16;
    float v1[16], v2[16];
    {
      const uint4* q4 = (const uint4*)lp;
#pragma unroll
      for (int i = 0; i < 4; ++i) {
        uint4 x = q4[i], y = q4[4 + i];
        v1[4 * i + 0] = unmono_f(x.x & ~127u); v1[4 * i + 1] = unmono_f(x.y & ~127u);
        v1[4 * i + 2] = unmono_f(x.z & ~127u); v1[4 * i + 3] = unmono_f(x.w & ~127u);
        v2[4 * i + 0] = unmono_f(y.x & ~127u); v2[4 * i + 1] = unmono_f(y.y & ~127u);
        v2[4 * i + 2] = unmono_f(y.z & ~127u); v2[4 * i + 3] = unmono_f(y.w & ~127u);
      }
    }
    unsigned C[16];
#pragma unroll
    for (int i = 0; i < 16; ++i) C[i] = 0u;
    {
      int idx = 0;
#pragma unroll
      for (int a = 0; a < 16; ++a) {
#pragma unroll
        for (int b = 0; b < 16; ++b) {
          if ((a + 1) * (b + 1) <= 16) {
            const unsigned key = (mono_f(v1[a] + v2[b]) & ~255u) | (unsigned)(255 - (a * 16 + b));
            const int slot = idx >> 2, who = idx & 3;
            C[slot] = (g == who) ? key : C[slot];
            ++idx;
          }
        }
      }
    }
    sort16_desc(C);
    xlane_merge16(C, 16);
    xlane_merge16(C, 32);
    const float f0 = unmono_f(C[0] & ~255u);
    float den = 0.f;
    float ev[16];
#pragma unroll
    for (int i = 0; i < 16; ++i) { ev[i] = __expf(unmono_f(C[i] & ~255u) - f0); den += ev[i]; }
    const float rden = 1.0f / den;
    int eidx[4]; float egate[4];
#pragma unroll
    for (int i = 0; i < 4; ++i) {
      const unsigned k = (g == 0) ? C[i] : (g == 1) ? C[4 + i] : (g == 2) ? C[8 + i] : C[12 + i];
      const float e = (g == 0) ? ev[i] : (g == 1) ? ev[4 + i] : (g == 2) ? ev[8 + i] : ev[12 + i];
      const int pos = 255 - (int)(k & 255u);
      const int a = pos >> 4, b = pos & 15;
      const int n1 = 127 - (int)(lp[a] & 127u);
      const int n2 = 127 - (int)(lp[16 + b] & 127u);
      eidx[i] = n1 * 128 + n2;
      egate[i] = e * rden;
    }
    *(int4*)(p.pidx + (size_t)tok * 128 + h * 16 + 4 * g) = make_int4(eidx[0], eidx[1], eidx[2], eidx[3]);
    *(float4*)(p.pgate + (size_t)tok * 128 + h * 16 + 4 * g) = make_float4(egate[0], egate[1], egate[2], egate[3]);
  }
}

__device__ __forceinline__ float logsigmoid_(float x) { return fminf(x, 0.f) - log1pf(expf(-fabsf(x))); }
__device__ __forceinline__ float bf_lo(unsigned w) { return __uint_as_float(w << 16); }
__device__ __forceinline__ float bf_hi(unsigned w) { return __uint_as_float(w & 0xffff0000u); }

#define RKV_LD 136
__device__ __forceinline__ void o_ret_kv_task(const Params& p, int l, int task, char* smem, int tid) {
  const int wave = tid >> 6, lane = tid & 63, g = lane >> 4, tl = lane & 15;
  const int bh = task >> 5, n = task & 31, b = bh >> 2, h = bh & 3;
  const int tok0 = b * SEQ + n * 128;
  const float lgf = logsigmoid_(p.ret_decay[l * 8 + h]), lgb = logsigmoid_(p.ret_decay[l * 8 + 4 + h]);
  bf16_t* KTf = (bf16_t*)smem;
  bf16_t* KTb = KTf + 64 * RKV_LD;
  bf16_t* VT = KTb + 64 * RKV_LD;
  __syncthreads();
#pragma unroll
  for (int it = 0; it < 2; ++it) {
    const int u = tid + it * NTHREADS;
    const int j = u >> 3, d0 = (u & 7) * 8;
    const uint4 kv = *(const uint4*)(p.proj + (size_t)(tok0 + j) * IN_WIDTH + C_RK + h * 64 + d0);
    const float wf = __expf(lgf * (float)(127 - j)), wb = __expf(lgb * (float)(j + 1));
    const unsigned kw[4] = {kv.x, kv.y, kv.z, kv.w};
#pragma unroll
    for (int e = 0; e < 4; ++e) {
      const float x0 = bf_lo(kw[e]), x1 = bf_hi(kw[e]);
      KTf[(d0 + 2 * e) * RKV_LD + j] = f2bf(x0 * wf);
      KTf[(d0 + 2 * e + 1) * RKV_LD + j] = f2bf(x1 * wf);
      KTb[(d0 + 2 * e) * RKV_LD + j] = f2bf(x0 * wb);
      KTb[(d0 + 2 * e + 1) * RKV_LD + j] = f2bf(x1 * wb);
    }
  }
#pragma unroll
  for (int it = 0; it < 4; ++it) {
    const int u = tid + it * NTHREADS;
    const int j = u >> 4, e0 = (u & 15) * 8;
    const uint4 vv = *(const uint4*)(p.proj + (size_t)(tok0 + j) * IN_WIDTH + C_RV + h * 128 + e0);
    const unsigned vw[4] = {vv.x, vv.y, vv.z, vv.w};
#pragma unroll
    for (int e = 0; e < 4; ++e) {
      VT[(e0 + 2 * e) * RKV_LD + j] = (bf16_t)(vw[e] & 0xffffu);
      VT[(e0 + 2 * e + 1) * RKV_LD + j] = (bf16_t)(vw[e] >> 16);
    }
  }
  __syncthreads();
  bf16x8 a[4];
#pragma unroll
  for (int ks = 0; ks < 4; ++ks) a[ks] = *(const bf16x8*)(VT + (wave * 16 + tl) * RKV_LD + ks * 32 + 8 * g);
#pragma unroll
  for (int dir = 0; dir < 2; ++dir) {
    const bf16_t* KT = dir ? KTb : KTf;
#pragma unroll
    for (int dt = 0; dt < 4; ++dt) {
      f32x4 acc = (f32x4){0.f, 0.f, 0.f, 0.f};
#pragma unroll
      for (int ks = 0; ks < 4; ++ks) {
        const bf16x8 bb = *(const bf16x8*)(KT + (dt * 16 + tl) * RKV_LD + ks * 32 + 8 * g);
        acc = __builtin_amdgcn_mfma_f32_16x16x32_bf16(a[ks], bb, acc, 0, 0, 0);
      }
      float* dst = p.kvst + ((size_t)(task * 2 + dir) * 128 + wave * 16 + 4 * g) * 64 + dt * 16 + tl;
#pragma unroll
      for (int r = 0; r < 4; ++r) dst[r * 64] = acc[r];
    }
  }
}

__device__ __forceinline__ void o_ret_scan(const int wv_, const Params& p, int l) {
  const int tidx_ = opaque_tid(wv_); const int bidx_ = opaque_bid();
  const int gsz = gridDim.x * NTHREADS;
  for (int u = bidx_ * NTHREADS + tidx_; u < 16 * 2 * 128 * 16; u += gsz) {
    const int dq = u & 15, e = (u >> 4) & 127, dir = (u >> 11) & 1, bh = u >> 12, h = bh & 3;
    const float lg = logsigmoid_(p.ret_decay[l * 8 + dir * 4 + h]);
    const float gC = __expf(lg * 128.0f);
    float4 st = make_float4(0.f, 0.f, 0.f, 0.f);
#pragma unroll 8
    for (int nn = 0; nn < 32; ++nn) {
      const int n = dir ? (31 - nn) : nn;
      const size_t idx = ((size_t)((bh * 32 + n) * 2 + dir) * 128 + e) * 64 + dq * 4;
      const float4 kv = *(const float4*)(p.kvst + idx);
      uint2 o;
      o.x = pack2bf(st.x, st.y); o.y = pack2bf(st.z, st.w);
      *(uint2*)(p.rstate + idx) = o;
      st.x = fmaf(st.x, gC, kv.x); st.y = fmaf(st.y, gC, kv.y); st.z = fmaf(st.z, gC, kv.z); st.w = fmaf(st.w, gC, kv.w);
    }
  }
}

#define RO_LD 264
#define RK_LD 72
__device__ __forceinline__ void o_ret_out_task(const Params& p, int l, int task, char* smem, int tid) {
  const int wave = tid >> 6, lane = tid & 63, g = lane >> 4, tl = lane & 15;
  const int bh = task >> 5, n = task & 31, b = bh >> 2, h = bh & 3;
  const int tok0 = b * SEQ + n * 128;
  const float lgf = logsigmoid_(p.ret_decay[l * 8 + h]), lgb = logsigmoid_(p.ret_decay[l * 8 + 4 + h]);
  bf16_t* Acat = (bf16_t*)smem;
  bf16_t* Bcat = Acat + 128 * RO_LD;
  bf16_t* Kl = Bcat + 128 * RO_LD;
  __syncthreads();
#pragma unroll
  for (int it = 0; it < 2; ++it) {
    const int u = tid + it * NTHREADS;
    const int i = u >> 3, d0 = (u & 7) * 8;
    const size_t row = (size_t)(tok0 + i) * IN_WIDTH;
    const uint4 qv = *(const uint4*)(p.proj + row + C_RQ + h * 64 + d0);
    const uint4 kv = *(const uint4*)(p.proj + row + C_RK + h * 64 + d0);
    *(uint4*)(Acat + i * RO_LD + d0) = qv;
    *(uint4*)(Kl + i * RK_LD + d0) = kv;
    const float wf = __expf(lgf * (float)(i + 1)), wb = __expf(lgb * (float)(127 - i));
    const unsigned qw[4] = {qv.x, qv.y, qv.z, qv.w};
    uint4 of, ob;
    of.x = pack2bf(bf_lo(qw[0]) * wf, bf_hi(qw[0]) * wf); ob.x = pack2bf(bf_lo(qw[0]) * wb, bf_hi(qw[0]) * wb);
    of.y = pack2bf(bf_lo(qw[1]) * wf, bf_hi(qw[1]) * wf); ob.y = pack2bf(bf_lo(qw[1]) * wb, bf_hi(qw[1]) * wb);
    of.z = pack2bf(bf_lo(qw[2]) * wf, bf_hi(qw[2]) * wf); ob.z = pack2bf(bf_lo(qw[2]) * wb, bf_hi(qw[2]) * wb);
    of.w = pack2bf(bf_lo(qw[3]) * wf, bf_hi(qw[3]) * wf); ob.w = pack2bf(bf_lo(qw[3]) * wb, bf_hi(qw[3]) * wb);
    *(uint4*)(Acat + i * RO_LD + 128 + d0) = of;
    *(uint4*)(Acat + i * RO_LD + 192 + d0) = ob;
  }
#pragma unroll
  for (int it = 0; it < 4; ++it) {
    const int u = tid + it * NTHREADS;
    const int j = u >> 4, e0 = (u & 15) * 8;
    const uint4 vv = *(const uint4*)(p.proj + (size_t)(tok0 + j) * IN_WIDTH + C_RV + h * 128 + e0);
    const unsigned vw[4] = {vv.x, vv.y, vv.z, vv.w};
#pragma unroll
    for (int e = 0; e < 4; ++e) {
      Bcat[(e0 + 2 * e) * RO_LD + j] = (bf16_t)(vw[e] & 0xffffu);
      Bcat[(e0 + 2 * e + 1) * RO_LD + j] = (bf16_t)(vw[e] >> 16);
    }
  }
#pragma unroll
  for (int it = 0; it < 4; ++it) {
    const int u = tid + it * NTHREADS;
    const int d0 = (u & 7) * 8, e = (u >> 3) & 127, dir = u >> 10;
    const uint4 sv = *(const uint4*)(p.rstate + ((size_t)(task * 2 + dir) * 128 + e) * 64 + d0);
    *(uint4*)(Bcat + e * RO_LD + 128 + dir * 64 + d0) = sv;
  }
  __syncthreads();
  f32x4 sc[8];
#pragma unroll
  for (int jt = 0; jt < 8; ++jt) sc[jt] = (f32x4){0.f, 0.f, 0.f, 0.f};
#pragma unroll
  for (int ks = 0; ks < 2; ++ks) {
    const bf16x8 qb = *(const bf16x8*)(Acat + (wave * 16 + tl) * RO_LD + ks * 32 + 8 * g);
#pragma unroll
    for (int jt = 0; jt < 8; ++jt) {
      const bf16x8 ka = *(const bf16x8*)(Kl + (jt * 16 + tl) * RK_LD + ks * 32 + 8 * g);
      sc[jt] = __builtin_amdgcn_mfma_f32_16x16x32_bf16(ka, qb, sc[jt], 0, 0, 0);
    }
  }
  {
    const int i = wave * 16 + tl;
#pragma unroll
    for (int jt = 0; jt < 8; ++jt) {
      float pv[4];
#pragma unroll
      for (int r = 0; r < 4; ++r) {
        const int j = jt * 16 + 4 * g + r;
        const float dd = (j <= i) ? __expf(lgf * (float)(i - j)) : __expf(lgb * (float)(j - i));
        pv[r] = sc[jt][r] * dd;
      }
      uint2 o;
      o.x = pack2bf(pv[0], pv[1]); o.y = pack2bf(pv[2], pv[3]);
      *(uint2*)(Acat + i * RO_LD + jt * 16 + 4 * g) = o;
    }
  }
  f32x4 y[8];
#pragma unroll
  for (int et = 0; et < 8; ++et) y[et] = (f32x4){0.f, 0.f, 0.f, 0.f};
#pragma unroll
  for (int ks = 0; ks < 8; ++ks) {
    const bf16x8 ab = *(const bf16x8*)(Acat + (wave * 16 + tl) * RO_LD + ks * 32 + 8 * g);
#pragma unroll
    for (int et = 0; et < 8; ++et) {
      const bf16x8 ba = *(const bf16x8*)(Bcat + (et * 16 + tl) * RO_LD + ks * 32 + 8 * g);
      y[et] = __builtin_amdgcn_mfma_f32_16x16x32_bf16(ba, ab, y[et], 0, 0, 0);
    }
  }
  float ss = 0.f;
#pragma unroll
  for (int et = 0; et < 8; ++et)
#pragma unroll
    for (int r = 0; r < 4; ++r) ss = fmaf(y[et][r], y[et][r], ss);
  ss += __shfl_xor(ss, 16, 64);
  ss += __shfl_xor(ss, 32, 64);
  const float rstd = rsqrtf(ss * (1.0f / 128.0f) + EPS);
  {
    const int tok = tok0 + wave * 16 + tl;
    const bf16_t* gp = p.proj + (size_t)tok * IN_WIDTH + C_RG + h * 128 + 4 * g;
    bf16_t* dst = p.ycat + (size_t)tok * 1024 + 256 + h * 128 + 4 * g;
#pragma unroll
    for (int et = 0; et < 8; ++et) {
      const uint2 gv = *(const uint2*)(gp + et * 16);
      const float g0 = bf_lo(gv.x), g1 = bf_hi(gv.x), g2 = bf_lo(gv.y), g3 = bf_hi(gv.y);
      uint2 o;
      o.x = pack2bf(g0 / (1.0f + __expf(-g0)) * y[et][0] * rstd, g1 / (1.0f + __expf(-g1)) * y[et][1] * rstd);
      o.y = pack2bf(g2 / (1.0f + __expf(-g2)) * y[et][2] * rstd, g3 / (1.0f + __expf(-g3)) * y[et][3] * rstd);
      *(uint2*)(dst + et * 16) = o;
    }
  }
}


#define NA_KLD 72
typedef short v4s_t __attribute__((ext_vector_type(4)));
#ifndef LAS
#define LAS __attribute__((address_space(3)))
#endif
__device__ __forceinline__ void o_na_task(const Params& p, int l, int task, char* smem, int tid) {
  const int wave = tid >> 6, lane = tid & 63, g = lane >> 4, tl = lane & 15;
  const int rr = task & 63, h = (task >> 6) & 3, b = task >> 8;
  int rs = rr - 4; rs = rs < 0 ? 0 : (rs > 56 ? 56 : rs);
  const int ktok0 = b * SEQ + rs * 64;
  const int qtok0 = b * SEQ + rr * 64;
  bf16_t* Kl = (bf16_t*)smem;
  bf16_t* Vl = Kl + 512 * NA_KLD;
  bf16_t* Ql = Vl + 512 * NA_KLD;
  float* rpbl = (float*)(Ql + 64 * NA_KLD);
  __syncthreads();
#pragma unroll
  for (int it = 0; it < 8; ++it) {
    const int u = tid + it * NTHREADS;
    const int key = u >> 3, d0 = (u & 7) * 8;
    const size_t row = (size_t)(ktok0 + key) * IN_WIDTH;
    const uint4 kv = *(const uint4*)(p.proj + row + C_NK + h * 64 + d0);
    const uint4 vv = *(const uint4*)(p.proj + row + C_NV + h * 64 + d0);
    *(uint4*)(Kl + key * NA_KLD + d0) = kv;
    *(uint4*)(Vl + key * NA_KLD + d0) = vv;
  }
  {
    const int q = tid >> 3, d0 = (tid & 7) * 8;
    *(uint4*)(Ql + q * NA_KLD + d0) = *(const uint4*)(p.proj + (size_t)(qtok0 + q) * IN_WIDTH + C_NQ + h * 64 + d0);
    if (tid < 465) rpbl[tid] = p.na_rpb[((size_t)l * 4 + h) * 465 + tid];
  }
  __syncthreads();
  if (wave < 4) {
    const int qt = wave;
    int cw0 = 16 * qt - 8; cw0 = cw0 < 0 ? 0 : (cw0 > 32 ? 32 : cw0);
    f32x4 sc[16];
#pragma unroll
    for (int T = 0; T < 16; ++T) sc[T] = (f32x4){0.f, 0.f, 0.f, 0.f};
#pragma unroll
    for (int ks = 0; ks < 2; ++ks) {
      const bf16x8 qb = *(const bf16x8*)(Ql + (qt * 16 + tl) * NA_KLD + ks * 32 + 8 * g);
#pragma unroll
      for (int T = 0; T < 16; ++T) {
        const int key = (T >> 1) * 64 + cw0 + (T & 1) * 16 + tl;
        const bf16x8 ka = *(const bf16x8*)(Kl + key * NA_KLD + ks * 32 + 8 * g);
        sc[T] = __builtin_amdgcn_mfma_f32_16x16x32_bf16(ka, qb, sc[T], 0, 0, 0);
      }
    }
    const int cq = qt * 16 + tl;
    int cs = cq - 8; cs = cs < 0 ? 0 : (cs > 48 ? 48 : cs);
    float m = -3.0e38f;
#pragma unroll
    for (int T = 0; T < 16; ++T) {
      const int ri = T >> 1;
      const int di = rs + ri - rr + 7;
#pragma unroll
      for (int r = 0; r < 4; ++r) {
        const int ck = cw0 + (T & 1) * 16 + 4 * g + r;
        const bool valid = (ck >= cs) && (ck < cs + 16);
        int dj = ck - cq + 15; dj = dj < 0 ? 0 : (dj > 30 ? 30 : dj);
        const float sv = valid ? (sc[T][r] + rpbl[di * 31 + dj]) : -1.0e30f;
        sc[T][r] = sv;
        m = fmaxf(m, sv);
      }
    }
    m = fmaxf(m, __shfl_xor(m, 16, 64));
    m = fmaxf(m, __shfl_xor(m, 32, 64));
    float den = 0.f;
#pragma unroll
    for (int T = 0; T < 16; ++T)
#pragma unroll
      for (int r = 0; r < 4; ++r) {
        const float e = __expf(sc[T][r] - m);
        sc[T][r] = e;
        den += e;
      }
    den += __shfl_xor(den, 16, 64);
    den += __shfl_xor(den, 32, 64);
    const float rden = 1.0f / den;
    f32x4 o[4];
#pragma unroll
    for (int dt = 0; dt < 4; ++dt) o[dt] = (f32x4){0.f, 0.f, 0.f, 0.f};
#pragma unroll
    for (int ri = 0; ri < 8; ++ri) {
      union { bf16x8 v; unsigned u[4]; } pb;
      pb.u[0] = pack2bf(sc[2 * ri][0], sc[2 * ri][1]);
      pb.u[1] = pack2bf(sc[2 * ri][2], sc[2 * ri][3]);
      pb.u[2] = pack2bf(sc[2 * ri + 1][0], sc[2 * ri + 1][1]);
      pb.u[3] = pack2bf(sc[2 * ri + 1][2], sc[2 * ri + 1][3]);
#pragma unroll
      for (int dt = 0; dt < 4; ++dt) {
        const bf16_t* vp = Vl + (ri * 64 + cw0 + 4 * g + (tl >> 2)) * NA_KLD + dt * 16 + 4 * (tl & 3);
        const v4s_t r0 = __builtin_amdgcn_ds_read_tr16_b64_v4i16((v4s_t LAS*)(LAS bf16_t*)vp);
        const v4s_t r1 = __builtin_amdgcn_ds_read_tr16_b64_v4i16((v4s_t LAS*)(LAS bf16_t*)(vp + 16 * NA_KLD));
        const bf16x8 va = {r0[0], r0[1], r0[2], r0[3], r1[0], r1[1], r1[2], r1[3]};
        o[dt] = __builtin_amdgcn_mfma_f32_16x16x32_bf16(va, pb.v, o[dt], 0, 0, 0);
      }
    }
    bf16_t* dst = p.ycat + (size_t)(qtok0 + qt * 16 + tl) * 1024 + 768 + h * 64 + 4 * g;
#pragma unroll
    for (int dt = 0; dt < 4; ++dt) {
      uint2 ov;
      ov.x = pack2bf(o[dt][0] * rden, o[dt][1] * rden);
      ov.y = pack2bf(o[dt][2] * rden, o[dt][3] * rden);
      *(uint2*)(dst + dt * 16) = ov;
    }
  }
}

#define PL_LD 264
__device__ __forceinline__ void o_pool_task(const Params& p, int l, int task, char* smem, int tid) {
  const int wave = tid >> 6, lane = tid & 63, g = lane >> 4, tl = lane & 15;
  const int t0 = task * 64, pos0 = t0 & (SEQ - 1);
  bf16_t* Xp = (bf16_t*)smem;
  bf16_t* WT = Xp + 80 * PL_LD;
  bf16_t* Df = WT + 4 * 64 * 72;
  __syncthreads();
#pragma unroll
  for (int it = 0; it < 5; ++it) {
    const int u = tid + it * NTHREADS;
    const int rw = u >> 5, c0 = (u & 31) * 8;
    const int pos = pos0 - 8 + rw;
    uint4 v = make_uint4(0u, 0u, 0u, 0u);
    if (pos >= 0 && pos < SEQ) v = *(const uint4*)(p.proj + (size_t)(t0 - 8 + rw) * IN_WIDTH + C_POOL + c0);
    *(uint4*)(Xp + rw * PL_LD + c0) = v;
  }
#pragma unroll
  for (int it = 0; it < 4; ++it) {
    const int u = tid + it * NTHREADS;
    const int e0 = (u & 7) * 8, c = (u >> 3) & 63, gi = u >> 9;
    const float* wp = p.pool_w + (((size_t)l * 4 + gi) * 64 + c) * 64 + e0;
    const float4 a = *(const float4*)wp, bq = *(const float4*)(wp + 4);
    const float wv[8] = {a.x, a.y, a.z, a.w, bq.x, bq.y, bq.z, bq.w};
#pragma unroll
    for (int k = 0; k < 8; ++k) WT[(gi * 64 + e0 + k) * 72 + c] = f2bf(wv[k]);
  }
  __syncthreads();
#pragma unroll 1
  for (int it = 0; it < 4; ++it) {
    const int u = tid + it * NTHREADS;
    const int t = u >> 5, c0 = (u & 31) * 8;
    const int gi = c0 >> 6;
    const int hw = 1 << gi;
    const int pos = pos0 + t;
    int a = pos - hw; a = a < 0 ? 0 : a;
    int bnd = pos + hw; bnd = bnd > SEQ ? SEQ : bnd;
    float sum[8];
#pragma unroll
    for (int k = 0; k < 8; ++k) sum[k] = 0.f;
    for (int rp = a; rp < bnd; ++rp) {
      const uint4 v = *(const uint4*)(Xp + (rp - pos0 + 8) * PL_LD + c0);
      sum[0] += bf_lo(v.x); sum[1] += bf_hi(v.x); sum[2] += bf_lo(v.y); sum[3] += bf_hi(v.y);
      sum[4] += bf_lo(v.z); sum[5] += bf_hi(v.z); sum[6] += bf_lo(v.w); sum[7] += bf_hi(v.w);
    }
    const float rc = 1.0f / (float)(bnd - a);
    const uint4 xv = *(const uint4*)(Xp + (t + 8) * PL_LD + c0);
    uint4 o;
    o.x = pack2bf(sum[0] * rc - bf_lo(xv.x), sum[1] * rc - bf_hi(xv.x));
    o.y = pack2bf(sum[2] * rc - bf_lo(xv.y), sum[3] * rc - bf_hi(xv.y));
    o.z = pack2bf(sum[4] * rc - bf_lo(xv.z), sum[5] * rc - bf_hi(xv.z));
    o.w = pack2bf(sum[6] * rc - bf_lo(xv.w), sum[7] * rc - bf_hi(xv.w));
    *(uint4*)(Df + t * PL_LD + c0) = o;
  }
  __syncthreads();
  {
    const int gi = wave >> 1, tt0 = (wave & 1) * 2;
    f32x4 acc[4][2];
#pragma unroll
    for (int et = 0; et < 4; ++et)
#pragma unroll
      for (int tt = 0; tt < 2; ++tt) acc[et][tt] = (f32x4){0.f, 0.f, 0.f, 0.f};
#pragma unroll
    for (int ks = 0; ks < 2; ++ks) {
      bf16x8 bx[2];
#pragma unroll
      for (int tt = 0; tt < 2; ++tt) bx[tt] = *(const bf16x8*)(Df + ((tt0 + tt) * 16 + tl) * PL_LD + gi * 64 + ks * 32 + 8 * g);
#pragma unroll
      for (int et = 0; et < 4; ++et) {
        const bf16x8 wa = *(const bf16x8*)(WT + (gi * 64 + et * 16 + tl) * 72 + ks * 32 + 8 * g);
#pragma unroll
        for (int tt = 0; tt < 2; ++tt) acc[et][tt] = __builtin_amdgcn_mfma_f32_16x16x32_bf16(wa, bx[tt], acc[et][tt], 0, 0, 0);
      }
    }
#pragma unroll
    for (int et = 0; et < 4; ++et) {
      const float4 sc4 = *(const float4*)(p.pool_scale + l * 256 + gi * 64 + et * 16 + 4 * g);
#pragma unroll
      for (int tt = 0; tt < 2; ++tt) {
        const int tok = t0 + (tt0 + tt) * 16 + tl;
        uint2 o;
        o.x = pack2bf(acc[et][tt][0] * sc4.x, acc[et][tt][1] * sc4.y);
        o.y = pack2bf(acc[et][tt][2] * sc4.z, acc[et][tt][3] * sc4.w);
        *(uint2*)(p.ycat + (size_t)tok * 1024 + gi * 64 + et * 16 + 4 * g) = o;
      }
    }
  }
}


typedef __attribute__((ext_vector_type(2))) __bf16 bf16x2_t;
__device__ __forceinline__ float dot2bf(unsigned a, unsigned b, float c) {
  return __builtin_amdgcn_fdot2_f32_bf16(__builtin_bit_cast(bf16x2_t, a), __builtin_bit_cast(bf16x2_t, b), c, false);
}
#define DPP_F(v, ctrl) __builtin_bit_cast(float, __builtin_amdgcn_update_dpp(0, __builtin_bit_cast(int, v), ctrl, 0xf, 0xf, false))
#define RDLANE_F(v, l) __builtin_bit_cast(float, __builtin_amdgcn_readlane(__builtin_bit_cast(int, v), l))
__device__ __forceinline__ float erf_as(float x) {
  const float ax = fabsf(x);
  const float t = __builtin_amdgcn_rcpf(fmaf(0.3275911f, ax, 1.0f));
  float y = fmaf(1.061405429f, t, -1.453152027f);
  y = fmaf(y, t, 1.421413741f);
  y = fmaf(y, t, -0.284496736f);
  y = fmaf(y, t, 0.254829592f);
  y = y * t * __expf(-ax * ax);
  return copysignf(1.0f - y, x);
}
__device__ __forceinline__ float gelu_fast_exact(float a) { return 0.5f * a * (1.0f + erf_as(a * 0.70710678118654752f)); }
struct PickPair { int eA, eB; float gA, gB; };

#define EX6_SHIFT 11
#define EX6_NSLICE (16384 >> EX6_SHIFT)
__device__ __forceinline__ unsigned cvt8_bf16x2(unsigned w, float scale, const bool hi) {
  return hi ? __builtin_bit_cast(unsigned, __builtin_amdgcn_cvt_scalef32_pk_bf16_fp8((int)w, scale, true))
            : __builtin_bit_cast(unsigned, __builtin_amdgcn_cvt_scalef32_pk_bf16_fp8((int)w, scale, false));
}
__device__ __forceinline__ void experts6_process4(const unsigned char* __restrict__ U8, const unsigned char* __restrict__ V8,
                                                  const float2* __restrict__ ES, const int (&e)[4], const float (&g)[4],
                                                  const unsigned (&hw)[8], float (&acc)[16], int lane, int vz) {
  uint4 u[4], v[4];
  float2 sc[4];
#pragma unroll
  for (int i = 0; i < 4; ++i) u[i] = *(const uint4*)(U8 + (size_t)e[i] * 1024 + lane * 16);
#pragma unroll
  for (int i = 0; i < 4; ++i) sc[i] = ES[e[i] + vz];
#pragma unroll
  for (int i = 0; i < 4; ++i) v[i] = *(const uint4*)(V8 + (size_t)e[i] * 1024 + lane * 16);
  float a[4];
#pragma unroll
  for (int i = 0; i < 4; ++i) {
    const unsigned uw[4] = {u[i].x, u[i].y, u[i].z, u[i].w};
    float t = 0.f;
#pragma unroll
    for (int w = 0; w < 4; ++w) {
      t = dot2bf(cvt8_bf16x2(uw[w], sc[i].x, false), hw[2 * w], t);
      t = dot2bf(cvt8_bf16x2(uw[w], sc[i].x, true), hw[2 * w + 1], t);
    }
    a[i] = t;
  }
  const bool b0 = lane & 1, b1 = lane & 2;
  const float x01 = (b0 ? a[1] : a[0]) + DPP_F((b0 ? a[0] : a[1]), 0xB1);
  const float x23 = (b0 ? a[3] : a[2]) + DPP_F((b0 ? a[2] : a[3]), 0xB1);
  float y = (b1 ? x23 : x01) + DPP_F((b1 ? x01 : x23), 0x4E);
  y += DPP_F(y, 0x124);
  y += DPP_F(y, 0x128);
  float sum[4];
#pragma unroll
  for (int i = 0; i < 4; ++i) sum[i] = RDLANE_F(y, i) + RDLANE_F(y, 16 + i) + RDLANE_F(y, 32 + i) + RDLANE_F(y, 48 + i);
  const int li = lane & 3;
  const float mine = (li == 0) ? sum[0] : (li == 1) ? sum[1] : (li == 2) ? sum[2] : sum[3];
  const float gmine = (li == 0) ? g[0] : (li == 1) ? g[1] : (li == 2) ? g[2] : g[3];
  const unsigned gb = (unsigned)f2bf(gelu_fast_exact(mine) * gmine);
#pragma unroll
  for (int i = 0; i < 4; ++i) {
    const unsigned hl = (unsigned)__builtin_amdgcn_readlane((int)gb, i);
    const unsigned hh = hl << 16;
    const unsigned vw[4] = {v[i].x, v[i].y, v[i].z, v[i].w};
#pragma unroll
    for (int w = 0; w < 4; ++w) {
      const unsigned p0 = cvt8_bf16x2(vw[w], sc[i].y, false), p1 = cvt8_bf16x2(vw[w], sc[i].y, true);
      acc[4 * w + 0] = dot2bf(p0, hl, acc[4 * w + 0]);
      acc[4 * w + 1] = dot2bf(p0, hh, acc[4 * w + 1]);
      acc[4 * w + 2] = dot2bf(p1, hl, acc[4 * w + 2]);
      acc[4 * w + 3] = dot2bf(p1, hh, acc[4 * w + 3]);
    }
  }
}

__device__ __forceinline__ void o_peer_experts6_tile(const Params& p, int l, int t0, const char* smem, int tid, bool dry = false) {
  const int wave = __builtin_amdgcn_readfirstlane(tid >> 6), lane = tid & 63;
  const unsigned char* U8 = p.u8 + (size_t)l * 16384 * 1024;
  const unsigned char* V8 = p.v8 + (size_t)l * 16384 * 1024;
  const float2* ES = p.escale + (size_t)l * 16384;
  int vz = 0;
  asm volatile("" : "+v"(vz));
  const int s0 = ((int)(__builtin_amdgcn_s_getreg((3 << 11) | 20) & 0xF) * (EX6_NSLICE / 8)) & (EX6_NSLICE - 1);
  unsigned pk[8][2];
  float acc[8][16];
#pragma unroll
  for (int k = 0; k < 8; ++k) {
    const size_t base = (size_t)(t0 + wave * 8 + k) * 128 + lane + vz;
#pragma unroll
    for (int hf = 0; hf < 2; ++hf) pk[k][hf] = (unsigned)p.pidx[base + hf * 64] | ((unsigned)f2bf(p.pgate[base + hf * 64]) << 16);
#pragma unroll
    for (int i = 0; i < 16; ++i) acc[k][i] = 0.f;
  }
#pragma unroll 1
  for (int si = 0; si < EX6_NSLICE; ++si) {
    const unsigned s = (unsigned)((s0 + si) & (EX6_NSLICE - 1));
#pragma unroll
    for (int k = 0; k < 8; ++k) {
      unsigned long long m0 = __ballot(((pk[k][0] & 0x3fffu) >> EX6_SHIFT) == s);
      unsigned long long m1 = __ballot(((pk[k][1] & 0x3fffu) >> EX6_SHIFT) == s);
      if ((m0 | m1) == 0ull) continue;
      unsigned hw[8];
      {
        const char* xr = smem + (wave * 8 + k) * LDXB + lane * 32;
        const uint4 h0 = *(const uint4*)xr, h1 = *(const uint4*)(xr + 16);
        hw[0] = h0.x; hw[1] = h0.y; hw[2] = h0.z; hw[3] = h0.w; hw[4] = h1.x; hw[5] = h1.y; hw[6] = h1.z; hw[7] = h1.w;
      }
      while (m0 | m1) {
        int e[4]; float g[4];
#pragma unroll
        for (int i = 0; i < 4; ++i) {
          unsigned w;
          if (m0) { const int la = (int)__builtin_ctzll(m0); m0 &= m0 - 1; w = (unsigned)__builtin_amdgcn_readlane((int)pk[k][0], la); }
          else if (m1) { const int la = (int)__builtin_ctzll(m1); m1 &= m1 - 1; w = (unsigned)__builtin_amdgcn_readlane((int)pk[k][1], la); }
          else { w = (unsigned)e[0]; }
          e[i] = (int)(w & 0x3fffu);
          g[i] = __uint_as_float(w & 0xffff0000u);
        }
        experts6_process4(U8, V8, ES, e, g, hw, acc[k], lane, vz);
      }
    }
  }
  if (dry) {
#pragma unroll
    for (int k = 0; k < 8; ++k)
#pragma unroll
      for (int i = 0; i < 16; ++i) asm volatile("" :: "v"(acc[k][i]));
    return;
  }
#pragma unroll
  for (int k = 0; k < 8; ++k) {
    float* xr = p.xres + (size_t)(t0 + wave * 8 + k) * 1024 + lane * 16;
#pragma unroll
    for (int i = 0; i < 4; ++i) {
      float4 a0 = *(float4*)(xr + 4 * i);
      a0.x += acc[k][4 * i + 0]; a0.y += acc[k][4 * i + 1]; a0.z += acc[k][4 * i + 2]; a0.w += acc[k][4 * i + 3];
      *(float4*)(xr + 4 * i) = a0;
    }
  }
}


typedef _Float16 h2_t __attribute__((ext_vector_type(2)));
__device__ __forceinline__ void ex7_pop(unsigned long long& m0, unsigned long long& m1, const unsigned pk0, const unsigned pk1,
                                        int (&e)[4], float (&g)[4]) {
  int e0 = 0;
#pragma unroll
  for (int i = 0; i < 4; ++i) {
    unsigned w;
    if (m0) { const int la = (int)__builtin_ctzll(m0); m0 &= m0 - 1; w = (unsigned)__builtin_amdgcn_readlane((int)pk0, la); }
    else if (m1) { const int la = (int)__builtin_ctzll(m1); m1 &= m1 - 1; w = (unsigned)__builtin_amdgcn_readlane((int)pk1, la); }
    else { w = (unsigned)e0; }
    e[i] = (int)(w & 0x3fffu);
    g[i] = __uint_as_float(w & 0xffff0000u);
    if (i == 0) e0 = e[0];
  }
}
#define EX7_ISSUE(U_, V_, SC_, G_) { \
  _Pragma("unroll") for (int i_ = 0; i_ < 4; ++i_) U_[i_] = __builtin_bit_cast(uint4, __builtin_amdgcn_raw_buffer_load_b128(rsU, lo16, e[i_] * 1024, 0)); \
  _Pragma("unroll") for (int i_ = 0; i_ < 4; ++i_) SC_[i_] = __builtin_bit_cast(float2, __builtin_amdgcn_raw_buffer_load_b64(rsS, vz, e[i_] * 8, 0)); \
  _Pragma("unroll") for (int i_ = 0; i_ < 4; ++i_) V_[i_] = __builtin_bit_cast(uint4, __builtin_amdgcn_raw_buffer_load_b128(rsV, lo16, e[i_] * 1024, 0)); \
  _Pragma("unroll") for (int i_ = 0; i_ < 4; ++i_) G_[i_] = g[i_]; }

__device__ __forceinline__ void ex7_compute(const uint4 (&ru)[4], const uint4 (&rv)[4], const float2 (&rsc)[4], const float (&rg)[4],
                                            const unsigned (&hw)[8], h2_t (&acc)[8], int lane) {
  float a[4];
#pragma unroll
  for (int i = 0; i < 4; ++i) {
    const unsigned uw[4] = {ru[i].x, ru[i].y, ru[i].z, ru[i].w};
    float t = 0.f;
#pragma unroll
    for (int w = 0; w < 4; ++w) {
      t = dot2bf(cvt8_bf16x2(uw[w], rsc[i].x, false), hw[2 * w], t);
      t = dot2bf(cvt8_bf16x2(uw[w], rsc[i].x, true), hw[2 * w + 1], t);
    }
    a[i] = t;
  }
  const bool b0 = lane & 1, b1 = lane & 2;
  const float x01 = (b0 ? a[1] : a[0]) + DPP_F((b0 ? a[0] : a[1]), 0xB1);
  const float x23 = (b0 ? a[3] : a[2]) + DPP_F((b0 ? a[2] : a[3]), 0xB1);
  float y = (b1 ? x23 : x01) + DPP_F((b1 ? x01 : x23), 0x4E);
  y += DPP_F(y, 0x124);
  y += DPP_F(y, 0x128);
  float sum[4];
#pragma unroll
  for (int i = 0; i < 4; ++i) sum[i] = RDLANE_F(y, i) + RDLANE_F(y, 16 + i) + RDLANE_F(y, 32 + i) + RDLANE_F(y, 48 + i);
  const int li = lane & 3;
  const float mine = (li == 0) ? sum[0] : (li == 1) ? sum[1] : (li == 2) ? sum[2] : sum[3];
  const float gmine = (li == 0) ? rg[0] : (li == 1) ? rg[1] : (li == 2) ? rg[2] : rg[3];
  const _Float16 hf = (_Float16)(gelu_fast_exact(mine) * gmine);
  const unsigned hb = (unsigned)__builtin_bit_cast(unsigned short, hf);
#pragma unroll
  for (int i = 0; i < 4; ++i) {
    const unsigned hl = (unsigned)__builtin_amdgcn_readlane((int)hb, i);
    const h2_t hh = __builtin_bit_cast(h2_t, hl | (hl << 16));
    const unsigned vw[4] = {rv[i].x, rv[i].y, rv[i].z, rv[i].w};
#pragma unroll
    for (int w = 0; w < 4; ++w) {
      const h2_t p0 = __builtin_amdgcn_cvt_scalef32_pk_f16_fp8((int)vw[w], rsc[i].y, false);
      const h2_t p1 = __builtin_amdgcn_cvt_scalef32_pk_f16_fp8((int)vw[w], rsc[i].y, true);
      acc[2 * w] = __builtin_elementwise_fma(p0, hh, acc[2 * w]);
      acc[2 * w + 1] = __builtin_elementwise_fma(p1, hh, acc[2 * w + 1]);
    }
  }
}

__device__ __forceinline__ void o_peer_experts7_tile(const Params& p, int l, int t0, const char* smem, int tid, bool dry = false) {
  const int wave = __builtin_amdgcn_readfirstlane(tid >> 6), lane = tid & 63;
  const unsigned char* U8 = p.u8 + (size_t)l * 16384 * 1024;
  const unsigned char* V8 = p.v8 + (size_t)l * 16384 * 1024;
  const float2* ES = p.escale + (size_t)l * 16384;
  int vz = 0;
  asm volatile("" : "+v"(vz));
  const __amdgpu_buffer_rsrc_t rsU = __builtin_amdgcn_make_buffer_rsrc((void*)U8, 0, 16384 * 1024, 0x00020000);
  const __amdgpu_buffer_rsrc_t rsV = __builtin_amdgcn_make_buffer_rsrc((void*)V8, 0, 16384 * 1024, 0x00020000);
  const __amdgpu_buffer_rsrc_t rsS = __builtin_amdgcn_make_buffer_rsrc((void*)ES, 0, 16384 * 8, 0x00020000);
  const int lo16 = lane * 16;
  const int s0 = ((int)(__builtin_amdgcn_s_getreg((3 << 11) | 20) & 0xF) * (EX6_NSLICE / 8)) & (EX6_NSLICE - 1);
  unsigned pk[8][2];
  h2_t acc[8][8];
#pragma unroll
  for (int k = 0; k < 8; ++k) {
    const size_t base = (size_t)(t0 + wave * 8 + k) * 128 + lane + vz;
#pragma unroll
    for (int hf = 0; hf < 2; ++hf) pk[k][hf] = (unsigned)p.pidx[base + hf * 64] | ((unsigned)f2bf(p.pgate[base + hf * 64]) << 16);
#pragma unroll
    for (int i = 0; i < 8; ++i) acc[k][i] = (h2_t){(_Float16)0.f, (_Float16)0.f};
  }
#pragma unroll 1
  for (int si = 0; si < EX6_NSLICE; ++si) {
    const unsigned s = (unsigned)((s0 + si) & (EX6_NSLICE - 1));
#pragma unroll
    for (int k = 0; k < 8; ++k) {
      unsigned long long m0 = __ballot(((pk[k][0] & 0x3fffu) >> EX6_SHIFT) == s);
      unsigned long long m1 = __ballot(((pk[k][1] & 0x3fffu) >> EX6_SHIFT) == s);
      if ((m0 | m1) == 0ull) continue;
      unsigned hw[8];
      {
        const char* xr = smem + (wave * 8 + k) * LDXB + lane * 32;
        const uint4 h0 = *(const uint4*)xr, h1 = *(const uint4*)(xr + 16);
        hw[0] = h0.x; hw[1] = h0.y; hw[2] = h0.z; hw[3] = h0.w; hw[4] = h1.x; hw[5] = h1.y; hw[6] = h1.z; hw[7] = h1.w;
      }
      uint4 uA[4], vA[4], uB[4], vB[4];
      float2 scA[4], scB[4];
      float gA[4], gB[4];
      int e[4]; float g[4];
      ex7_pop(m0, m1, pk[k][0], pk[k][1], e, g);
      EX7_ISSUE(uA, vA, scA, gA)
      for (;;) {
        const bool mb = (m0 | m1) != 0ull;
        if (mb) { ex7_pop(m0, m1, pk[k][0], pk[k][1], e, g); EX7_ISSUE(uB, vB, scB, gB) }
        __builtin_amdgcn_s_setprio(1);
        ex7_compute(uA, vA, scA, gA, hw, acc[k], lane);
        __builtin_amdgcn_s_setprio(0);
        if (!mb) break;
        const bool ma = (m0 | m1) != 0ull;
        if (ma) { ex7_pop(m0, m1, pk[k][0], pk[k][1], e, g); EX7_ISSUE(uA, vA, scA, gA) }
        __builtin_amdgcn_s_setprio(1);
        ex7_compute(uB, vB, scB, gB, hw, acc[k], lane);
        __builtin_amdgcn_s_setprio(0);
        if (!ma) break;
      }
    }
  }
  if (dry) {
#pragma unroll
    for (int k = 0; k < 8; ++k)
#pragma unroll
      for (int i = 0; i < 8; ++i) asm volatile("" :: "v"(acc[k][i]));
    return;
  }
#pragma unroll
  for (int k = 0; k < 8; ++k) {
    float* xr = p.xres + (size_t)(t0 + wave * 8 + k) * 1024 + lane * 16;
#pragma unroll
    for (int i = 0; i < 4; ++i) {
      float4 a0 = *(float4*)(xr + 4 * i);
      a0.x += (float)acc[k][2 * i][0]; a0.y += (float)acc[k][2 * i][1];
      a0.z += (float)acc[k][2 * i + 1][0]; a0.w += (float)acc[k][2 * i + 1][1];
      *(float4*)(xr + 4 * i) = a0;
    }
  }
}

#define XB_TMO      128
#define XB_XCNT(j)  (256  + 64 * (j))
#define XB_XSUB(j)  (1280 + 64 * (j))
#define XB_XGEN(j)  (2304 + 64 * (j))
#define XB_TOP      3328
#define XB_TOPGEN   3392
#define XCD_BAR_WORDS 3456
#define XB_SPIN_CAP (1u << 22)
#ifndef LAS
#define LAS __attribute__((address_space(3)))
#endif
__device__ __forceinline__ unsigned xb_ld(unsigned* p)              { return __hip_atomic_load(p, __ATOMIC_RELAXED, __HIP_MEMORY_SCOPE_AGENT); }
__device__ __forceinline__ unsigned xb_add(unsigned* p, unsigned v) { return __hip_atomic_fetch_add(p, v, __ATOMIC_RELAXED, __HIP_MEMORY_SCOPE_AGENT); }
__device__ __forceinline__ unsigned xb_xcc_id() { return (unsigned)__builtin_amdgcn_s_getreg((3 << 11) | 20) & 0xFu; }
#define XB_SPIN(cond, bar) do { unsigned _sp = 0; while (cond) { __builtin_amdgcn_s_sleep(1); \
    if ((++_sp & 255u) == 0u) { if (xb_ld(&(bar)[XB_TMO])) break; if (_sp > XB_SPIN_CAP) { atomicAdd(&(bar)[XB_TMO], 1u); break; } } } } while (0)
struct XcdBarrier { unsigned* bar; unsigned x; volatile LAS unsigned* st; };
__device__ __forceinline__ XcdBarrier xcd_barrier_post(unsigned* bar, volatile LAS unsigned* st, int tid) {
  XcdBarrier b; b.bar = bar; b.x = xb_xcc_id(); b.st = st;
  if (tid == 0) (void)xb_add(&bar[XB_XCNT(b.x)], 1u);
  return b;
}
__device__ __forceinline__ void xcd_barrier_complete(unsigned* bar, unsigned x, unsigned& nloc, unsigned& nx) {
  const unsigned G = gridDim.x * gridDim.y * gridDim.z;
  unsigned sum, cnt, mine, sp = 0u;
  for (;;) {
    sum = 0u; cnt = 0u; mine = 0u;
#pragma unroll
    for (unsigned j = 0; j < 16; ++j) { const unsigned c = xb_ld(&bar[XB_XCNT(j)]); sum += c; cnt += (c > 0u) ? 1u : 0u; mine = (j == x) ? c : mine; }
    if (sum == G) break;
    __builtin_amdgcn_s_sleep(1);
    if ((++sp & 255u) == 0u) { if (xb_ld(&bar[XB_TMO])) break; if (sp > XB_SPIN_CAP) { atomicAdd(&bar[XB_TMO], 1u); break; } }
  }
  nloc = mine > 0u ? mine : 1u; nx = cnt > 0u ? cnt : 1u;
}
__device__ __forceinline__ void xcd_barrier(const XcdBarrier& b, int tid) {
  asm volatile("s_waitcnt vmcnt(0)" ::: "memory");
  __syncthreads();
  if (tid == 0) {
    unsigned* bar = b.bar;
    __builtin_amdgcn_s_waitcnt(0);
    unsigned nloc = b.st[0], nx = b.st[1];
    if (nloc == 0u) { xcd_barrier_complete(bar, b.x, nloc, nx); b.st[0] = nloc; b.st[1] = nx; }
    const unsigned old = xb_add(&bar[XB_XSUB(b.x)], 1u);
    const unsigned gen = old / nloc;
    if (old + 1u == (gen + 1u) * nloc) {
      __builtin_amdgcn_fence(__ATOMIC_RELEASE, "agent");
      asm volatile("s_waitcnt vmcnt(0)" ::: "memory");
      const unsigned og = xb_add(&bar[XB_TOP], 1u);
      const unsigned tg = og / nx;
      if (og + 1u == (tg + 1u) * nx) xb_add(&bar[XB_TOPGEN], 1u);
      else XB_SPIN(xb_ld(&bar[XB_TOPGEN]) == tg, bar);
      __builtin_amdgcn_fence(__ATOMIC_ACQUIRE, "agent");
      xb_add(&bar[XB_XGEN(b.x)], 1u);
      asm volatile("s_waitcnt vmcnt(0)" ::: "memory");
    } else {
      XB_SPIN(xb_ld(&bar[XB_XGEN(b.x)]) == gen, bar);
      __builtin_amdgcn_fence(__ATOMIC_ACQUIRE, "agent");
      asm volatile("s_waitcnt vmcnt(0)" ::: "memory");
    }
  }
  __syncthreads();
}


__global__ void __launch_bounds__(NTHREADS) fwd_megakernel(Params p) {
  cg::grid_group grid = cg::this_grid();
  extern __shared__ __attribute__((aligned(16))) float smem[];
  const int wv_ = __builtin_amdgcn_readfirstlane((int)(threadIdx.x >> 6));
  volatile LAS unsigned* xb_st = (volatile LAS unsigned*)((LAS char*)(LAS float*)smem + (160 * 1024 - 16));
  if (threadIdx.x == 0) { xb_st[0] = 0u; xb_st[1] = 0u; }
  __syncthreads();
  const XcdBarrier xb = xcd_barrier_post(p.bar, xb_st, (int)threadIdx.x);
#define GRID_BARRIER() xcd_barrier(xb, opaque_tid(wv_))

  o_prep(wv_, p, smem);
  if (gridDim.x > 4096u) grid.sync();
  GRID_BARRIER();
#pragma unroll 1
  for (int l = 0; l < DEPTH; ++l) {
    const float* xcur = (l == 0) ? p.x_in : p.xres;
    o_p1(wv_, p, l, xcur, (char*)smem);
    GRID_BARRIER();
    {
    {
      const int bidx_ = opaque_bid();
      const bool affine = (gridDim.x == 256u);
      for (int task = bidx_; task < 1792; task += gridDim.x) {
        const int l_ = opaque_s(l), td_ = opaque_tid(wv_);
        int tk = task;
        if (affine) {
          const int x = bidx_ & 7, lb = bidx_ >> 3, j = task >> 8;
          if (j < 4) { const int idx = lb + 32 * j; tk = ((x * 2 + (idx >> 6)) << 6) | (idx & 63); }
          else if (j < 6) { const int idx = lb + 32 * (j - 4); tk = 1024 + (((x * 2 + (idx >> 5)) << 5) | (idx & 31)); }
          else tk = 1536 + x * 32 + lb;
        }
        const int tk_ = opaque_s(tk);
        if (tk_ < 1024) o_na_task(p, l_, tk_, (char*)smem, td_);
        else if (tk_ < 1536) o_ret_kv_task(p, l_, tk_ - 1024, (char*)smem, td_);
        else o_pool_task(p, l_, tk_ - 1536, (char*)smem, td_);
      }
    }
    GRID_BARRIER();
    o_ret_scan(wv_, p, l);
    GRID_BARRIER();
    {
      const int tidx_ = opaque_tid(wv_); const int bidx_ = opaque_bid();
      for (int task = bidx_; task < 512; task += gridDim.x) {
        int tk = task;
        if (gridDim.x == 256u) {
          const int x = bidx_ & 7, lb = bidx_ >> 3, idx = lb + 32 * (task >> 8);
          tk = ((x * 2 + (idx >> 5)) << 5) | (idx & 31);
        }
        o_ret_out_task(p, l, opaque_s(tk), (char*)smem, tidx_);
      }
    }
    GRID_BARRIER();
    }
    {
      const int tidx_ = opaque_tid(wv_); const int bidx_ = opaque_bid();
      for (int tile = bidx_; tile < NTOK / 64; tile += gridDim.x) {
        { const int t0_ = opaque_s(tile * 64), l_ = opaque_s(l), td_ = opaque_tid(wv_); o_p5a1_tile(p, l_, t0_, (char*)smem, td_); }
        { const int t0_ = opaque_s(tile * 64), l_ = opaque_s(l), td_ = opaque_tid(wv_); o_p5a2_tile(p, l_, xcur, t0_, (char*)smem, td_); }
        { const int t0_ = opaque_s(tile * 64), l_ = opaque_s(l), td_ = opaque_tid(wv_); o_p5a3_tile(p, l_, t0_, (char*)smem, td_); }
        { const int t0_ = opaque_s(tile * 64), l_ = opaque_s(l), td_ = opaque_tid(wv_); o_peer_select_tile(p, l_, t0_, (char*)smem, td_); }
        { const int t0_ = opaque_s(tile * 64), l_ = opaque_s(l), td_ = opaque_tid(wv_); o_peer_select2_tile(p, l_, t0_, td_); }
        asm volatile("s_waitcnt vmcnt(0)" ::: "memory");
        __syncthreads();
        { const int t0_ = opaque_s(tile * 64), l_ = opaque_s(l), td_ = opaque_tid(wv_); o_peer_experts7_tile(p, l_, t0_, (const char*)smem, td_); }
        if (l + 1 == DEPTH) {
          asm volatile("s_waitcnt vmcnt(0)" ::: "memory");
          const int t0_ = opaque_s(tile * 64), td_ = opaque_tid(wv_);
          o_final_norm_tile(p, t0_, td_);
        }
      }
    }
    if (l + 1 < DEPTH) GRID_BARRIER();
  }
}

extern "C" void kernel_launch(void* const* d_in, const int* in_sizes, int n_in, void* d_out, int out_size,
                              void* d_ws, size_t ws_size, hipStream_t stream) {
  Params p{};
  p.x_in = (const float*)d_in[0]; p.norm_mix = (const float*)d_in[1]; p.w_in = (const float*)d_in[2];
  p.pool_w = (const float*)d_in[3]; p.pool_scale = (const float*)d_in[4]; p.ret_decay = (const float*)d_in[5];
  p.na_rpb = (const float*)d_in[6]; p.w_br_pool = (const float*)d_in[7]; p.w_br_ret = (const float*)d_in[8];
  p.w_br_na = (const float*)d_in[9]; p.w_out = (const float*)d_in[10]; p.norm_ffn = (const float*)d_in[11];
  p.w_query = (const float*)d_in[12]; p.sub_keys = (const float*)d_in[13]; p.peer_u = (const float*)d_in[14];
  p.peer_v = (const float*)d_in[15]; p.norm_final = (const float*)d_in[16];
  p.out = (float*)d_out;
  char* ws = (char*)d_ws;
  size_t off = 0;
  auto alloc = [&](size_t bytes) { char* q = ws + off; off += (bytes + 255) & ~(size_t)255; return q; };
  p.xres = (float*)alloc((size_t)NTOK * D_MODEL * 4);
  p.proj = (bf16_t*)alloc((size_t)NTOK * IN_WIDTH * 2);
  p.ycat = (bf16_t*)alloc((size_t)NTOK * 1024 * 2);
  p.mrg = (bf16_t*)alloc((size_t)NTOK * 1024 * 2);
  p.pidx = (int*)alloc((size_t)NTOK * 128 * 4);
  p.pgate = (float*)alloc((size_t)NTOK * 128 * 4);
  p.wf_in = (bf16_t*)alloc((size_t)DEPTH * D_MODEL * IN_WIDTH * 2);
  p.wf_br = (bf16_t*)alloc((size_t)DEPTH * 1024 * 1024 * 2);
  p.wf_out = (bf16_t*)alloc((size_t)DEPTH * 1024 * 1024 * 2);
  p.wf_q = (bf16_t*)alloc((size_t)DEPTH * 1024 * 2048 * 2);
  p.kf = (bf16_t*)alloc((size_t)DEPTH * 2 * 128 * 128 * 2);
  p.u16 = nullptr; p.v16 = nullptr;
  p.u8 = (unsigned char*)alloc((size_t)DEPTH * 16384 * 1024);
  p.v8 = (unsigned char*)alloc((size_t)DEPTH * 16384 * 1024);
  p.escale = (float2*)alloc((size_t)DEPTH * 16384 * 8);
  p.rope = (float2*)alloc((size_t)SEQ * 32 * 8);
  p.tklist = (unsigned*)alloc((size_t)NTOK * 8 * 2 * 16 * 4);
  p.kvst = (float*)p.mrg;
  p.rstate = (bf16_t*)p.tklist;
  p.bar = (unsigned*)alloc(XCD_BAR_WORDS * 4);
  p.xn = nullptr; p.merged = nullptr; p.pq = nullptr; p.psc = nullptr;
  if (off > ws_size) fprintf(stderr, "WORKSPACE OVERFLOW: need %zu have %zu\n", off, ws_size);

  const size_t kDynLds = 160 * 1024;
  static int grid_blocks = 0;
  if (!grid_blocks) {
    int dev = 0, cus = 0, per_cu = 0;
    (void)hipGetDevice(&dev);
    (void)hipDeviceGetAttribute(&cus, hipDeviceAttributeMultiprocessorCount, dev);
    (void)hipFuncSetAttribute((const void*)fwd_megakernel, hipFuncAttributeMaxDynamicSharedMemorySize, (int)kDynLds);
    (void)hipOccupancyMaxActiveBlocksPerMultiprocessor(&per_cu, fwd_megakernel, NTHREADS, kDynLds);
    if (per_cu < 1) per_cu = 1;
    grid_blocks = cus * per_cu;
  }
  (void)hipMemsetAsync(p.bar, 0, XCD_BAR_WORDS * 4, stream);
  void* args[] = {&p};
  hipError_t e = hipLaunchCooperativeKernel((void*)fwd_megakernel, dim3(grid_blocks), dim3(NTHREADS), args, kDynLds, stream);
  if (e != hipSuccess) fprintf(stderr, "cooperative launch failed: %s (grid %d)\n", hipGetErrorString(e), grid_blocks);
}
```

```cpp
#include <hip/hip_runtime.h>
#include <hip/hip_cooperative_groups.h>
#include <stdint.h>
#include <cstdio>
namespace cg = cooperative_groups;

#define D_MODEL 1024
#define SEQ 4096
#define BATCH 4
#define NTOK (BATCH * SEQ)
#define DEPTH 2
#define IN_WIDTH 5632
#define C_POOL 0
#define C_RQ 256
#define C_RK 512
#define C_RV 768
#define C_RG 1280
#define C_NQ 1792
#define C_NK 2048
#define C_NV 2304
#define C_GATE 2560
#define EPS 1e-6f
#define NTHREADS 512

typedef unsigned short bf16_t;

struct Params {
  const float* x_in; const float* norm_mix; const float* w_in; const float* pool_w; const float* pool_scale;
  const float* ret_decay; const float* na_rpb; const float* w_br_pool; const float* w_br_ret; const float* w_br_na;
  const float* w_out; const float* norm_ffn; const float* w_query; const float* sub_keys; const float* peer_u;
  const float* peer_v; const float* norm_final;
  float* out;
  float* xres;
  bf16_t* xn;
  bf16_t* proj;
  bf16_t* ycat;
  float* merged;
  float* pq;
  float* psc;
  int* pidx;
  float* pgate;
  bf16_t* wf_in;
  bf16_t* wf_br;
  bf16_t* wf_out;
  bf16_t* wf_q;
  bf16_t* kf;
  bf16_t* u16;
  bf16_t* v16;
  float2* rope;
  bf16_t* mrg;
  unsigned* tklist;
  float* kvst;
  bf16_t* rstate;
  unsigned* bar;
  unsigned char* u8; unsigned char* v8;
  float2* escale;
};

__device__ __forceinline__ bf16_t f2bf(float f) {
  unsigned u = __float_as_uint(f);
  u += 0x7fffu + ((u >> 16) & 1u);
  return (bf16_t)(u >> 16);
}
__device__ __forceinline__ float bf2f(bf16_t h) { return __uint_as_float(((unsigned)h) << 16); }

__device__ __forceinline__ float wave_sum(float v) {
#pragma unroll
  for (int o = 32; o > 0; o >>= 1) v += __shfl_xor(v, o, 64);
  return v;
}
__device__ __forceinline__ float wave_max(float v) {
#pragma unroll
  for (int o = 32; o > 0; o >>= 1) v = fmaxf(v, __shfl_xor(v, o, 64));
  return v;
}
__device__ __forceinline__ float sigmoidf_(float x) { return 1.0f / (1.0f + expf(-x)); }

__device__ __forceinline__ int opaque_tid(int wv) {
  int w = wv;
  asm volatile("" : "+s"(w));
  int lane = __builtin_amdgcn_mbcnt_hi(~0u, __builtin_amdgcn_mbcnt_lo(~0u, 0u));
  asm volatile("" : "+v"(lane));
  return w * 64 + lane;
}
__device__ __forceinline__ int opaque_s(int x) { asm volatile("" : "+s"(x)); return x; }
__device__ __forceinline__ int opaque_bid() { int b = blockIdx.x; asm volatile("" : "+s"(b)); return b; }

template <bool OUT_F32>
__device__ __forceinline__ void n_rmsnorm(const int wv_, const float* __restrict__ x, const float* __restrict__ g, void* outp, int rows) {
  const int tidx_ = opaque_tid(wv_); const int bidx_ = opaque_bid();
  const int lane = tidx_ & 63;
  const int nw = gridDim.x * (NTHREADS / 64);
  for (int row = bidx_ * (NTHREADS / 64) + (tidx_ >> 6); row < rows; row += nw) {
    const float* xr = x + (size_t)row * D_MODEL;
    float4 v[4];
    float ss = 0.f;
#pragma unroll
    for (int i = 0; i < 4; ++i) {
      v[i] = *(const float4*)(xr + i * 256 + lane * 4);
      ss += v[i].x * v[i].x + v[i].y * v[i].y + v[i].z * v[i].z + v[i].w * v[i].w;
    }
    ss = wave_sum(ss);
    float r = rsqrtf(ss * (1.0f / D_MODEL) + EPS);
#pragma unroll
    for (int i = 0; i < 4; ++i) {
      float4 gg = *(const float4*)(g + i * 256 + lane * 4);
      float o0 = v[i].x * r * gg.x, o1 = v[i].y * r * gg.y, o2 = v[i].z * r * gg.z, o3 = v[i].w * r * gg.w;
      if (OUT_F32) {
        *(float4*)((float*)outp + (size_t)row * D_MODEL + i * 256 + lane * 4) = make_float4(o0, o1, o2, o3);
      } else {
        ushort4 o; o.x = f2bf(o0); o.y = f2bf(o1); o.z = f2bf(o2); o.w = f2bf(o3);
        *(ushort4*)((bf16_t*)outp + (size_t)row * D_MODEL + i * 256 + lane * 4) = o;
      }
    }
  }
}

typedef __attribute__((ext_vector_type(8))) short bf16x8;
typedef __attribute__((ext_vector_type(4))) float f32x4;
#define LDX 1032
#define LDXB (LDX * 2)
#define XTILE_BYTES (64 * LDXB)

__device__ __forceinline__ unsigned pack2bf(float a, float b) { return (unsigned)f2bf(a) | ((unsigned)f2bf(b) << 16); }

__device__ __forceinline__ void prep_frag(const int wv_, const float* __restrict__ W, int K, int N, bf16_t* __restrict__ dst, float* smem) {
  const int tidx_ = opaque_tid(wv_); const int bidx_ = opaque_bid();
  const int grp = tidx_ >> 8, tid = tidx_ & 255;
  float(*T)[65] = (float(*)[65])(smem + grp * 32 * 65);
  const int KS = K / 32, NC = N / 64;
  const int ntiles = KS * NC;
  for (int wb = bidx_ * 2; wb < ntiles; wb += gridDim.x * 2) {
    const int w = wb + grp;
    const int c = w / KS, ks = w - c * KS;
    {
      const int row = tid >> 3, col = (tid & 7) * 8;
      const float* src = W + (size_t)(ks * 32 + row) * N + c * 64 + col;
      float4 a = *(const float4*)src, b = *(const float4*)(src + 4);
      __syncthreads();
      T[row][col + 0] = a.x; T[row][col + 1] = a.y; T[row][col + 2] = a.z; T[row][col + 3] = a.w;
      T[row][col + 4] = b.x; T[row][col + 5] = b.y; T[row][col + 6] = b.z; T[row][col + 7] = b.w;
    }
    __syncthreads();
    {
      const int nt = tid >> 6, lane = tid & 63;
      const int kr = 8 * (lane >> 4), nc = nt * 16 + (lane & 15);
      uint4 o;
      o.x = pack2bf(T[kr + 0][nc], T[kr + 1][nc]);
      o.y = pack2bf(T[kr + 2][nc], T[kr + 3][nc]);
      o.z = pack2bf(T[kr + 4][nc], T[kr + 5][nc]);
      o.w = pack2bf(T[kr + 6][nc], T[kr + 7][nc]);
      *(uint4*)(dst + ((size_t)((c * KS + ks) * 4 + nt) * 64 + lane) * 8) = o;
    }
  }
}

__device__ __forceinline__ void o_prep(const int wv_, const Params& p, float* smem) {
  for (int l = 0; l < DEPTH; ++l) {
    prep_frag(wv_, p.w_in + (size_t)l * D_MODEL * IN_WIDTH, D_MODEL, IN_WIDTH, p.wf_in + (size_t)l * D_MODEL * IN_WIDTH, smem);
    prep_frag(wv_, p.w_br_pool + (size_t)l * 256 * 1024, 256, 1024, p.wf_br + (size_t)l * 1024 * 1024, smem);
    prep_frag(wv_, p.w_br_ret + (size_t)l * 512 * 1024, 512, 1024, p.wf_br + (size_t)l * 1024 * 1024 + 256 * 1024, smem);
    prep_frag(wv_, p.w_br_na + (size_t)l * 256 * 1024, 256, 1024, p.wf_br + (size_t)l * 1024 * 1024 + 768 * 1024, smem);
    prep_frag(wv_, p.w_out + (size_t)l * 1024 * 1024, 1024, 1024, p.wf_out + (size_t)l * 1024 * 1024, smem);
    prep_frag(wv_, p.w_query + (size_t)l * 1024 * 2048, 1024, 2048, p.wf_q + (size_t)l * 1024 * 2048, smem);
  }
  const int tidx_ = opaque_tid(wv_); const int bidx_ = opaque_bid();
  const int gtid = bidx_ * NTHREADS + tidx_, gsz = gridDim.x * NTHREADS;
  for (int u = gtid; u < DEPTH * 2 * 8 * 4 * 64; u += gsz) {
    const int lane = u & 63, s2 = (u >> 6) & 3, kt = (u >> 8) & 7, lp = u >> 11;
    const float* kr = p.sub_keys + ((size_t)lp * 128 + kt * 16 + (lane & 15)) * 128;
    float v[8];
#pragma unroll
    for (int j = 0; j < 8; ++j) v[j] = kr[16 * (2 * s2 + (j >> 2)) + 4 * (lane >> 4) + (j & 3)];
    uint4 o;
    o.x = pack2bf(v[0], v[1]); o.y = pack2bf(v[2], v[3]); o.z = pack2bf(v[4], v[5]); o.w = pack2bf(v[6], v[7]);
    *(uint4*)(p.kf + (size_t)u * 8) = o;
  }
  {
    const int lane = tidx_ & 63;
    const int gw = (bidx_ * NTHREADS + tidx_) >> 6, nw = gsz >> 6;
    for (int row = gw; row < DEPTH * 16384 * 2; row += nw) {
      const int tbl = row & 1, er = row >> 1;
      const float* src = (tbl ? p.peer_v : p.peer_u) + (size_t)er * 1024 + lane * 16;
      float4 f[4];
#pragma unroll
      for (int i = 0; i < 4; ++i) f[i] = *(const float4*)(src + 4 * i);
      float m = 0.f;
#pragma unroll
      for (int i = 0; i < 4; ++i) m = fmaxf(m, fmaxf(fmaxf(fabsf(f[i].x), fabsf(f[i].y)), fmaxf(fabsf(f[i].z), fabsf(f[i].w))));
      m = wave_max(m);
      int k = 0;
      if (m > 0.f) {
        int e;
        const float fr = __builtin_frexpf(m, &e);
        k = ((fr <= 0.875f) ? 9 : 8) - e;
        k = k < -100 ? -100 : (k > 100 ? 100 : k);
      }
      const float sc = __builtin_ldexpf(1.0f, k);
      uint4 o;
      unsigned w[4];
#pragma unroll
      for (int i = 0; i < 4; ++i) {
        int pkd = 0;
        pkd = __builtin_amdgcn_cvt_pk_fp8_f32(f[i].x * sc, f[i].y * sc, pkd, false);
        pkd = __builtin_amdgcn_cvt_pk_fp8_f32(f[i].z * sc, f[i].w * sc, pkd, true);
        w[i] = (unsigned)pkd;
      }
      o.x = w[0]; o.y = w[1]; o.z = w[2]; o.w = w[3];
      *(uint4*)((tbl ? p.v8 : p.u8) + (size_t)er * 1024 + lane * 16) = o;
      if (lane == 0) ((float*)p.escale)[(size_t)er * 2 + tbl] = __builtin_ldexpf(1.0f, -k);
    }
  }
  for (int u = gtid; u < SEQ * 32; u += gsz) {
    const int i = u & 31, pos = u >> 5;
    float inv = 1.0f / powf(10000.0f, (float)i / 31.0f);
    float ang = (float)pos * inv;
    double rev = (double)ang * 0.15915494309189535;
    rev -= floor(rev);
    float rf = (float)rev;
    p.rope[u] = make_float2(__builtin_amdgcn_cosf(rf), __builtin_amdgcn_sinf(rf));
  }
}

template <int NT, int PD, int RING>
__device__ __forceinline__ void tl_gemm_prologue(const bf16_t* __restrict__ wf, bf16x8 (&wb)[RING][NT], const int lane, const int nt0 = 0) {
  const bf16x8* wp = (const bf16x8*)wf + lane + nt0 * 64;
#pragma unroll
  for (int s = 0; s < PD; ++s)
#pragma unroll
    for (int nt = 0; nt < NT; ++nt) wb[s][nt] = wp[(s * 4 + nt) * 64];
}
template <int NT, int PD, int RING>
__device__ __forceinline__ void tl_gemm_main(const bf16_t* __restrict__ wf, const int KS, const char* xt, const int kbyte0,
                                             f32x4 (&acc)[NT][4], bf16x8 (&wb)[RING][NT], const int lane, const int nt0 = 0) {
  const bf16x8* wp = (const bf16x8*)wf + lane + nt0 * 64;
  const char* xp = xt + (lane & 15) * LDXB + kbyte0 + (lane >> 4) * 16;
  for (int ks = 0; ks < KS; ks += RING) {
#pragma unroll
    for (int u = 0; u < RING; ++u) {
      int kpre = ks + u + PD;
      kpre = kpre < KS ? kpre : KS - 1;
#pragma unroll
      for (int nt = 0; nt < NT; ++nt) wb[(u + PD) % RING][nt] = wp[(kpre * 4 + nt) * 64];
      __builtin_amdgcn_s_setprio(1);
      bf16x8 xf[4];
#pragma unroll
      for (int mt = 0; mt < 4; ++mt) xf[mt] = *(const bf16x8*)(xp + mt * 16 * LDXB + (ks + u) * 64);
#pragma unroll
      for (int nt = 0; nt < NT; ++nt)
#pragma unroll
        for (int mt = 0; mt < 4; ++mt)
          acc[nt][mt] = __builtin_amdgcn_mfma_f32_16x16x32_bf16(wb[u][nt], xf[mt], acc[nt][mt], 0, 0, 0);
      __builtin_amdgcn_s_setprio(0);
    }
  }
}
template <int NT, int PD = 3, int RING = 4>
__device__ __forceinline__ void tl_gemm_chunk(const bf16_t* __restrict__ wf, const int KS, const char* xt, const int kbyte0,
                                              f32x4 (&acc)[NT][4], const int lane, const int nt0 = 0) {
  bf16x8 wb[RING][NT];
  tl_gemm_prologue<NT, PD, RING>(wf, wb, lane, nt0);
  tl_gemm_main<NT, PD, RING>(wf, KS, xt, kbyte0, acc, wb, lane, nt0);
}

__device__ __forceinline__ void tile_rmsnorm_to_lds(const float* __restrict__ xsrc, const float* __restrict__ g, int t0,
                                                    char* xt, int wave, int lane) {
#pragma unroll 2
  for (int i = 0; i < 8; ++i) {
    const int tok = wave * 8 + i;
    const float* xr = xsrc + (size_t)(t0 + tok) * D_MODEL;
    float4 v[4];
    float ss = 0.f;
#pragma unroll
    for (int q = 0; q < 4; ++q) {
      v[q] = *(const float4*)(xr + q * 256 + lane * 4);
      ss += v[q].x * v[q].x + v[q].y * v[q].y + v[q].z * v[q].z + v[q].w * v[q].w;
    }
    ss = wave_sum(ss);
    const float r = rsqrtf(ss * (1.0f / D_MODEL) + EPS);
#pragma unroll
    for (int q = 0; q < 4; ++q) {
      float4 gg = *(const float4*)(g + q * 256 + lane * 4);
      uint2 o;
      o.x = pack2bf(v[q].x * r * gg.x, v[q].y * r * gg.y);
      o.y = pack2bf(v[q].z * r * gg.z, v[q].w * r * gg.w);
      *(uint2*)(xt + tok * LDXB + (q * 256 + lane * 4) * 2) = o;
    }
  }
}

__device__ __forceinline__ void o_p1(const int wv_, const Params& p, int l, const float* __restrict__ xsrc, char* smem) {
  const int tidx_ = opaque_tid(wv_); const int bidx_ = opaque_bid();
  const int wave = tidx_ >> 6, lane = tidx_ & 63;
  const bf16_t* wf = p.wf_in + (size_t)l * D_MODEL * IN_WIDTH;
  const float* g = p.norm_mix + l * D_MODEL;
  for (int tile = bidx_; tile < NTOK / 64; tile += gridDim.x) {
    const int t0 = tile * 64;
    __syncthreads();
    tile_rmsnorm_to_lds(xsrc, g, t0, smem, wave, lane);
    __syncthreads();
#pragma unroll 1
    for (int c = wave; c < IN_WIDTH / 64; c += 8) {
      f32x4 acc[4][4];
#pragma unroll
      for (int a = 0; a < 4; ++a)
#pragma unroll
        for (int b = 0; b < 4; ++b) acc[a][b] = (f32x4){0.f, 0.f, 0.f, 0.f};
      tl_gemm_chunk<4, 3, 4>(wf + (size_t)c * 32 * 4 * 64 * 8, 32, smem, 0, acc, lane);
      asm volatile("" ::: "memory");
      if (c >= 4 && c < 12) {
        const float sc = (c >= 8) ? 0.125f : 1.0f;
#pragma unroll
        for (int mt = 0; mt < 4; ++mt) {
          const int tok = t0 + mt * 16 + (lane & 15);
          const int pos = tok & (SEQ - 1);
#pragma unroll
          for (int nt = 0; nt < 2; ++nt) {
            const int i0 = nt * 16 + 4 * (lane >> 4);
            const float4 cs01 = *(const float4*)(p.rope + pos * 32 + i0);
            const float4 cs23 = *(const float4*)(p.rope + pos * 32 + i0 + 2);
            const float cc[4] = {cs01.x, cs01.z, cs23.x, cs23.z};
            const float sn[4] = {cs01.y, cs01.w, cs23.y, cs23.w};
#pragma unroll
            for (int r = 0; r < 4; ++r) {
              const float x1 = acc[nt][mt][r], x2 = acc[nt + 2][mt][r];
              acc[nt][mt][r] = (x1 * cc[r] - x2 * sn[r]) * sc;
              acc[nt + 2][mt][r] = (x1 * sn[r] + x2 * cc[r]) * sc;
            }
          }
        }
      } else if (c >= 28 && c < 32) {
#pragma unroll
        for (int a = 0; a < 4; ++a)
#pragma unroll
          for (int b = 0; b < 4; ++b) acc[a][b] *= 0.125f;
      } else if (c >= 40) {
#pragma unroll
        for (int a = 0; a < 4; ++a)
#pragma unroll
          for (int b = 0; b < 4; ++b)
#pragma unroll
            for (int r = 0; r < 4; ++r) acc[a][b][r] = 1.0f / (1.0f + __expf(-acc[a][b][r]));
      }
      {
        char* patch = smem + XTILE_BYTES + wave * 2304;
#pragma unroll
        for (int mt = 0; mt < 4; ++mt) {
#pragma unroll
          for (int nt = 0; nt < 4; ++nt) {
            uint2 o;
            o.x = pack2bf(acc[nt][mt][0], acc[nt][mt][1]);
            o.y = pack2bf(acc[nt][mt][2], acc[nt][mt][3]);
            *(uint2*)(patch + (lane & 15) * 144 + (nt * 16 + 4 * (lane >> 4)) * 2) = o;
          }
#pragma unroll
          for (int h = 0; h < 2; ++h) {
            const int row = h * 8 + (lane >> 3), unit = lane & 7;
            const uint4 v = *(const uint4*)(patch + row * 144 + unit * 16);
            *(uint4*)(p.proj + (size_t)(t0 + mt * 16 + row) * IN_WIDTH + c * 64 + unit * 8) = v;
          }
        }
      }
    }
  }
}


__device__ __forceinline__ void o_final_norm_tile(const Params& p, int t0, int tid) {
  const int wave = tid >> 6, lane = tid & 63;
#pragma unroll 2
  for (int i = 0; i < 8; ++i) {
    const size_t row = (size_t)(t0 + wave * 8 + i) * D_MODEL;
    float4 v[4];
    float ss = 0.f;
#pragma unroll
    for (int q = 0; q < 4; ++q) {
      v[q] = *(const float4*)(p.xres + row + q * 256 + lane * 4);
      ss += v[q].x * v[q].x + v[q].y * v[q].y + v[q].z * v[q].z + v[q].w * v[q].w;
    }
    ss = wave_sum(ss);
    const float r = rsqrtf(ss * (1.0f / D_MODEL) + EPS);
#pragma unroll
    for (int q = 0; q < 4; ++q) {
      const float4 gg = *(const float4*)(p.norm_final + q * 256 + lane * 4);
      *(float4*)(p.out + row + q * 256 + lane * 4) = make_float4(v[q].x * r * gg.x, v[q].y * r * gg.y, v[q].z * r * gg.z, v[q].w * r * gg.w);
    }
  }
}

__device__ __forceinline__ void tile_load_to_lds(const bf16_t* __restrict__ src, int ld, char* xt, int tid) {
#pragma unroll 4
  for (int it = 0; it < 16; ++it) {
    const int idx = it * NTHREADS + tid;
    const int row = idx >> 7, u = idx & 127;
    const uint4 v = *(const uint4*)(src + (size_t)row * ld + u * 8);
    *(uint4*)(xt + row * LDXB + u * 16) = v;
  }
}

__device__ __forceinline__ void o_p5a1_tile(const Params& p, int l, int t0, char* smem, int tid) {
  const int wave = tid >> 6, lane = tid & 63;
  __syncthreads();
  tile_load_to_lds(p.ycat + (size_t)t0 * 1024, 1024, smem, tid);
  __syncthreads();
  const bf16_t* wfb = p.wf_br + (size_t)l * 1024 * 1024;
  bf16x8 wb[4][2];
  f32x4 m[2][4];
  {
    const int c0 = wave >> 1, nt00 = (wave & 1) * 2;
    tl_gemm_prologue<2, 3, 4>(wfb + (size_t)c0 * 8 * 4 * 64 * 8, wb, lane, nt00);
  }
#pragma unroll 1
  for (int it = 0; it < 12; ++it) {
    const int hi = it / 3, br = it - hi * 3;
    const int hc = wave + 8 * hi;
    const int c = hc >> 1, nt0 = (hc & 1) * 2;
    const int koff = (br == 0) ? 0 : (br == 1 ? 256 : 768);
    const int KS = (br == 1) ? 16 : 8;
    uint2 gv[4][2];
#pragma unroll
    for (int mt = 0; mt < 4; ++mt) {
      const int tok = t0 + mt * 16 + (lane & 15);
      const bf16_t* gp = p.proj + (size_t)tok * IN_WIDTH + C_GATE + br * 1024 + c * 64 + nt0 * 16 + 4 * (lane >> 4);
#pragma unroll
      for (int nt = 0; nt < 2; ++nt) gv[mt][nt] = *(const uint2*)(gp + nt * 16);
    }
    f32x4 acc[2][4];
#pragma unroll
    for (int a2 = 0; a2 < 2; ++a2)
#pragma unroll
      for (int b2 = 0; b2 < 4; ++b2) acc[a2][b2] = (f32x4){0.f, 0.f, 0.f, 0.f};
    tl_gemm_main<2, 3, 4>(wfb + (size_t)koff * 1024 + (size_t)c * KS * 4 * 64 * 8, KS, smem, koff * 2, acc, wb, lane, nt0);
    asm volatile("" ::: "memory");
    {
      const int itn = (it + 1 < 12) ? it + 1 : it;
      const int hin = itn / 3, brn = itn - hin * 3;
      const int hcn = wave + 8 * hin;
      const int koffn = (brn == 0) ? 0 : (brn == 1 ? 256 : 768);
      const int KSn = (brn == 1) ? 16 : 8;
      tl_gemm_prologue<2, 3, 4>(wfb + (size_t)koffn * 1024 + (size_t)(hcn >> 1) * KSn * 4 * 64 * 8, wb, lane, (hcn & 1) * 2);
    }
    if (br == 0) {
#pragma unroll
      for (int a2 = 0; a2 < 2; ++a2)
#pragma unroll
        for (int b2 = 0; b2 < 4; ++b2) m[a2][b2] = (f32x4){0.f, 0.f, 0.f, 0.f};
    }
#pragma unroll
    for (int mt = 0; mt < 4; ++mt)
#pragma unroll
      for (int nt = 0; nt < 2; ++nt) {
        m[nt][mt][0] += __uint_as_float(gv[mt][nt].x << 16) * acc[nt][mt][0];
        m[nt][mt][1] += __uint_as_float(gv[mt][nt].x & 0xffff0000u) * acc[nt][mt][1];
        m[nt][mt][2] += __uint_as_float(gv[mt][nt].y << 16) * acc[nt][mt][2];
        m[nt][mt][3] += __uint_as_float(gv[mt][nt].y & 0xffff0000u) * acc[nt][mt][3];
      }
    if (br == 2) {
#pragma unroll
      for (int mt = 0; mt < 4; ++mt) {
        const int tok = t0 + mt * 16 + (lane & 15);
        bf16_t* dst = p.mrg + (size_t)tok * 1024 + c * 64 + nt0 * 16 + 4 * (lane >> 4);
#pragma unroll
        for (int nt = 0; nt < 2; ++nt) {
          uint2 o;
          o.x = pack2bf(m[nt][mt][0], m[nt][mt][1]);
          o.y = pack2bf(m[nt][mt][2], m[nt][mt][3]);
          *(uint2*)(dst + nt * 16) = o;
        }
      }
    }
  }
}
__device__ __forceinline__ void o_p5a2_tile(const Params& p, int l, const float* __restrict__ xcur, int t0, char* smem, int tid) {
  const int wave = tid >> 6, lane = tid & 63;
  __syncthreads();
  tile_load_to_lds(p.mrg + (size_t)t0 * 1024, 1024, smem, tid);
  __syncthreads();
  const bf16_t* wfo = p.wf_out + (size_t)l * 1024 * 1024;
#pragma unroll 1
  for (int c = wave; c < 16; c += 8) {
    f32x4 acc[4][4];
#pragma unroll
    for (int a = 0; a < 4; ++a)
#pragma unroll
      for (int b = 0; b < 4; ++b) acc[a][b] = (f32x4){0.f, 0.f, 0.f, 0.f};
    tl_gemm_chunk<4, 2>(wfo + (size_t)c * 32 * 4 * 64 * 8, 32, smem, 0, acc, lane);
    asm volatile("" ::: "memory");
#pragma unroll
    for (int mt = 0; mt < 4; ++mt) {
      const int tok = t0 + mt * 16 + (lane & 15);
      const size_t o = (size_t)tok * 1024 + c * 64 + 4 * (lane >> 4);
#pragma unroll
      for (int nt = 0; nt < 4; ++nt) {
        float4 xv = *(const float4*)(xcur + o + nt * 16);
        xv.x += acc[nt][mt][0]; xv.y += acc[nt][mt][1]; xv.z += acc[nt][mt][2]; xv.w += acc[nt][mt][3];
        *(float4*)(p.xres + o + nt * 16) = xv;
      }
    }
  }
}
__device__ __forceinline__ void o_p5a3_tile(const Params& p, int l, int t0, char* smem, int tid) {
  const int wave = tid >> 6, lane = tid & 63;
  __syncthreads();
  tile_rmsnorm_to_lds(p.xres, p.norm_ffn + l * D_MODEL, t0, smem, wave, lane);
  __syncthreads();
}


__device__ __forceinline__ unsigned mono_f(float f) {
  unsigned u = __float_as_uint(f);
  return (u & 0x80000000u) ? ~u : (u | 0x80000000u);
}
__device__ __forceinline__ float unmono_f(unsigned m) {
  return __uint_as_float((m & 0x80000000u) ? (m & 0x7fffffffu) : ~m);
}
#define CE_DESC(x, y) { const unsigned hi_ = max(x, y); const unsigned lo_ = min(x, y); x = hi_; y = lo_; }
#define CE_ASC(x, y) { const unsigned hi_ = max(x, y); const unsigned lo_ = min(x, y); x = lo_; y = hi_; }
__device__ __forceinline__ void sort16_desc(unsigned (&a)[16]) {
#pragma unroll
  for (int k = 2; k <= 16; k <<= 1) {
#pragma unroll
    for (int j = k >> 1; j > 0; j >>= 1) {
#pragma unroll
      for (int i = 0; i < 16; ++i) {
        const int l = i ^ j;
        if (l > i) {
          if ((i & k) == 0) CE_DESC(a[i], a[l]) else CE_ASC(a[i], a[l])
        }
      }
    }
  }
}
__device__ __forceinline__ void bitonic_merge16_desc(unsigned (&a)[16]) {
#pragma unroll
  for (int j = 8; j > 0; j >>= 1) {
#pragma unroll
    for (int i = 0; i < 16; ++i) {
      const int l = i ^ j;
      if (l > i) CE_DESC(a[i], a[l])
    }
  }
}
__device__ __forceinline__ void xlane_merge16(unsigned (&a)[16], int mask) {
  unsigned b[16];
#pragma unroll
  for (int i = 0; i < 16; ++i) b[i] = (unsigned)__shfl_xor((int)a[i], mask, 64);
#pragma unroll
  for (int i = 0; i < 16; ++i) a[i] = max(a[i], b[15 - i]);
  bitonic_merge16_desc(a);
}

__device__ __forceinline__ void o_peer_select_tile(const Params& p, int l, int t0, char* smem, int tid) {
  const int h = __builtin_amdgcn_readfirstlane(tid >> 6), lane = tid & 63;
  const int g = lane >> 4, tl = lane & 15;
  const bf16_t* wfq = p.wf_q + (size_t)l * 1024 * 2048;
#pragma unroll 1
  for (int pp = 0; pp < 2; ++pp) {
    bf16x8 qf[4][4];
#pragma unroll 1
    for (int cc = 0; cc < 2; ++cc) {
      const int c = (h * 2 + pp) * 2 + cc;
      f32x4 acc[4][4];
#pragma unroll
      for (int a = 0; a < 4; ++a)
#pragma unroll
        for (int b = 0; b < 4; ++b) acc[a][b] = (f32x4){0.f, 0.f, 0.f, 0.f};
      tl_gemm_chunk<4, 2>(wfq + (size_t)c * 32 * 4 * 64 * 8, 32, smem, 0, acc, lane);
#pragma unroll
      for (int sl = 0; sl < 2; ++sl)
#pragma unroll
        for (int mt = 0; mt < 4; ++mt) {
          union { bf16x8 v; unsigned u[4]; } cv;
          cv.u[0] = pack2bf(acc[2 * sl][mt][0], acc[2 * sl][mt][1]);
          cv.u[1] = pack2bf(acc[2 * sl][mt][2], acc[2 * sl][mt][3]);
          cv.u[2] = pack2bf(acc[2 * sl + 1][mt][0], acc[2 * sl + 1][mt][1]);
          cv.u[3] = pack2bf(acc[2 * sl + 1][mt][2], acc[2 * sl + 1][mt][3]);
          if (cc == 0) qf[sl][mt] = cv.v; else qf[2 + sl][mt] = cv.v;
        }
    }
    const bf16x8* kfp = (const bf16x8*)p.kf + (size_t)((l * 2 + pp) * 8) * 4 * 64 + lane;
#pragma unroll
    for (int mp = 0; mp < 2; ++mp) {
      f32x4 sc2[2][8];
#pragma unroll
      for (int u = 0; u < 2; ++u)
#pragma unroll
        for (int kt = 0; kt < 8; ++kt) sc2[u][kt] = (f32x4){0.f, 0.f, 0.f, 0.f};
#pragma unroll
      for (int s2 = 0; s2 < 4; ++s2) {
        const bf16x8 qv0 = qf[s2][2 * mp], qv1 = qf[s2][2 * mp + 1];
#pragma unroll
        for (int kt = 0; kt < 8; ++kt) {
          const bf16x8 kv = kfp[(kt * 4 + s2) * 64];
          sc2[0][kt] = __builtin_amdgcn_mfma_f32_16x16x32_bf16(kv, qv0, sc2[0][kt], 0, 0, 0);
          sc2[1][kt] = __builtin_amdgcn_mfma_f32_16x16x32_bf16(kv, qv1, sc2[1][kt], 0, 0, 0);
        }
        __builtin_amdgcn_sched_barrier(0);
      }
#pragma unroll
      for (int u = 0; u < 2; ++u) {
        const int mt = 2 * mp + u;
        unsigned A[16], B[16];
#pragma unroll
        for (int kt = 0; kt < 4; ++kt)
#pragma unroll
          for (int r = 0; r < 4; ++r) {
            A[kt * 4 + r] = (mono_f(sc2[u][kt][r]) & ~127u) | (unsigned)(127 - (kt * 16 + r) - 4 * g);
            B[kt * 4 + r] = (mono_f(sc2[u][kt + 4][r]) & ~127u) | (unsigned)(127 - ((kt + 4) * 16 + r) - 4 * g);
          }
        sort16_desc(A);
        sort16_desc(B);
#pragma unroll
        for (int i = 0; i < 16; ++i) A[i] = max(A[i], B[15 - i]);
        bitonic_merge16_desc(A);
        xlane_merge16(A, 16);
        xlane_merge16(A, 32);
        if (g == 0) {
          uint4* dst = (uint4*)(p.tklist + ((size_t)((t0 + mt * 16 + tl) * 8 + h) * 2 + pp) * 16);
          dst[0] = make_uint4(A[0], A[1], A[2], A[3]);
          dst[1] = make_uint4(A[4], A[5], A[6], A[7]);
          dst[2] = make_uint4(A[8], A[9], A[10], A[11]);
          dst[3] = make_uint4(A[12], A[13], A[14], A[15]);
        }
        __builtin_amdgcn_sched_barrier(0);
      }
    }
  }
  asm volatile("s_waitcnt vmcnt(0)" ::: "memory");
}

__device__ __forceinline__ void o_peer_select2_tile(const Params& p, int l, int t0, int tid) {
  const int h = __builtin_amdgcn_readfirstlane(tid >> 6), lane = tid & 63;
  const int g = lane >> 4, tl = lane & 15;
#pragma unroll 1
  for (int mt = 0; mt < 4; ++mt) {
    const int tok = t0 + mt * 16 + tl;
    const unsigned* lp = p.tklist + ((size_t)(tok * 8 + h) * 2) * 16;
    float v1[16], v2[16];
    {
      const uint4* q4 = (const uint4*)lp;
#pragma unroll
      for (int i = 0; i < 4; ++i) {
        uint4 x = q4[i], y = q4[4 + i];
        v1[4 * i + 0] = unmono_f(x.x & ~127u); v1[4 * i + 1] = unmono_f(x.y & ~127u);
        v1[4 * i + 2] = unmono_f(x.z & ~127u); v1[4 * i + 3] = unmono_f(x.w & ~127u);
        v2[4 * i + 0] = unmono_f(y.x & ~127u); v2[4 * i + 1] = unmono_f(y.y & ~127u);
        v2[4 * i + 2] = unmono_f(y.z & ~127u); v2[4 * i + 3] = unmono_f(y.w & ~127u);
      }
    }
    unsigned C[16];
#pragma unroll
    for (int i = 0; i < 16; ++i) C[i] = 0u;
    {
      int idx = 0;
#pragma unroll
      for (int a = 0; a < 16; ++a) {
#pragma unroll
        for (int b = 0; b < 16; ++b) {
          if ((a + 1) * (b + 1) <= 16) {
            const unsigned key = (mono_f(v1[a] + v2[b]) & ~255u) | (unsigned)(255 - (a * 16 + b));
            const int slot = idx >> 2, who = idx & 3;
            C[slot] = (g == who) ? key : C[slot];
            ++idx;
          }
        }
      }
    }
    sort16_desc(C);
    xlane_merge16(C, 16);
    xlane_merge16(C, 32);
    const float f0 = unmono_f(C[0] & ~255u);
    float den = 0.f;
    float ev[16];
#pragma unroll
    for (int i = 0; i < 16; ++i) { ev[i] = __expf(unmono_f(C[i] & ~255u) - f0); den += ev[i]; }
    const float rden = 1.0f / den;
    int eidx[4]; float egate[4];
#pragma unroll
    for (int i = 0; i < 4; ++i) {
      const unsigned k = (g == 0) ? C[i] : (g == 1) ? C[4 + i] : (g == 2) ? C[8 + i] : C[12 + i];
      const float e = (g == 0) ? ev[i] : (g == 1) ? ev[4 + i] : (g == 2) ? ev[8 + i] : ev[12 + i];
      const int pos = 255 - (int)(k & 255u);
      const int a = pos >> 4, b = pos & 15;
      const int n1 = 127 - (int)(lp[a] & 127u);
      const int n2 = 127 - (int)(lp[16 + b] & 127u);
      eidx[i] = n1 * 128 + n2;
      egate[i] = e * rden;
    }
    *(int4*)(p.pidx + (size_t)tok * 128 + h * 16 + 4 * g) = make_int4(eidx[0], eidx[1], eidx[2], eidx[3]);
    *(float4*)(p.pgate + (size_t)tok * 128 + h * 16 + 4 * g) = make_float4(egate[0], egate[1], egate[2], egate[3]);
  }
}

__device__ __forceinline__ float logsigmoid_(float x) { return fminf(x, 0.f) - log1pf(expf(-fabsf(x))); }
__device__ __forceinline__ float bf_lo(unsigned w) { return __uint_as_float(w << 16); }
__device__ __forceinline__ float bf_hi(unsigned w) { return __uint_as_float(w & 0xffff0000u); }

#define RKV_LD 136
__device__ __forceinline__ void o_ret_kv_task(const Params& p, int l, int task, char* smem, int tid) {
  const int wave = tid >> 6, lane = tid & 63, g = lane >> 4, tl = lane & 15;
  const int bh = task >> 5, n = task & 31, b = bh >> 2, h = bh & 3;
  const int tok0 = b * SEQ + n * 128;
  const float lgf = logsigmoid_(p.ret_decay[l * 8 + h]), lgb = logsigmoid_(p.ret_decay[l * 8 + 4 + h]);
  bf16_t* KTf = (bf16_t*)smem;
  bf16_t* KTb = KTf + 64 * RKV_LD;
  bf16_t* VT = KTb + 64 * RKV_LD;
  __syncthreads();
#pragma unroll
  for (int it = 0; it < 2; ++it) {
    const int u = tid + it * NTHREADS;
    const int j = u >> 3, d0 = (u & 7) * 8;
    const uint4 kv = *(const uint4*)(p.proj + (size_t)(tok0 + j) * IN_WIDTH + C_RK + h * 64 + d0);
    const float wf = __expf(lgf * (float)(127 - j)), wb = __expf(lgb * (float)(j + 1));
    const unsigned kw[4] = {kv.x, kv.y, kv.z, kv.w};
#pragma unroll
    for (int e = 0; e < 4; ++e) {
      const float x0 = bf_lo(kw[e]), x1 = bf_hi(kw[e]);
      KTf[(d0 + 2 * e) * RKV_LD + j] = f2bf(x0 * wf);
      KTf[(d0 + 2 * e + 1) * RKV_LD + j] = f2bf(x1 * wf);
      KTb[(d0 + 2 * e) * RKV_LD + j] = f2bf(x0 * wb);
      KTb[(d0 + 2 * e + 1) * RKV_LD + j] = f2bf(x1 * wb);
    }
  }
#pragma unroll
  for (int it = 0; it < 4; ++it) {
    const int u = tid + it * NTHREADS;
    const int j = u >> 4, e0 = (u & 15) * 8;
    const uint4 vv = *(const uint4*)(p.proj + (size_t)(tok0 + j) * IN_WIDTH + C_RV + h * 128 + e0);
    const unsigned vw[4] = {vv.x, vv.y, vv.z, vv.w};
#pragma unroll
    for (int e = 0; e < 4; ++e) {
      VT[(e0 + 2 * e) * RKV_LD + j] = (bf16_t)(vw[e] & 0xffffu);
      VT[(e0 + 2 * e + 1) * RKV_LD + j] = (bf16_t)(vw[e] >> 16);
    }
  }
  __syncthreads();
  bf16x8 a[4];
#pragma unroll
  for (int ks = 0; ks < 4; ++ks) a[ks] = *(const bf16x8*)(VT + (wave * 16 + tl) * RKV_LD + ks * 32 + 8 * g);
#pragma unroll
  for (int dir = 0; dir < 2; ++dir) {
    const bf16_t* KT = dir ? KTb : KTf;
#pragma unroll
    for (int dt = 0; dt < 4; ++dt) {
      f32x4 acc = (f32x4){0.f, 0.f, 0.f, 0.f};
#pragma unroll
      for (int ks = 0; ks < 4; ++ks) {
        const bf16x8 bb = *(const bf16x8*)(KT + (dt * 16 + tl) * RKV_LD + ks * 32 + 8 * g);
        acc = __builtin_amdgcn_mfma_f32_16x16x32_bf16(a[ks], bb, acc, 0, 0, 0);
      }
      float* dst = p.kvst + ((size_t)(task * 2 + dir) * 128 + wave * 16 + 4 * g) * 64 + dt * 16 + tl;
#pragma unroll
      for (int r = 0; r < 4; ++r) dst[r * 64] = acc[r];
    }
  }
}

__device__ __forceinline__ void o_ret_scan(const int wv_, const Params& p, int l) {
  const int tidx_ = opaque_tid(wv_); const int bidx_ = opaque_bid();
  const int gsz = gridDim.x * NTHREADS;
  for (int u = bidx_ * NTHREADS + tidx_; u < 16 * 2 * 128 * 16; u += gsz) {
    const int dq = u & 15, e = (u >> 4) & 127, dir = (u >> 11) & 1, bh = u >> 12, h = bh & 3;
    const float lg = logsigmoid_(p.ret_decay[l * 8 + dir * 4 + h]);
    const float gC = __expf(lg * 128.0f);
    float4 st = make_float4(0.f, 0.f, 0.f, 0.f);
#pragma unroll 8
    for (int nn = 0; nn < 32; ++nn) {
      const int n = dir ? (31 - nn) : nn;
      const size_t idx = ((size_t)((bh * 32 + n) * 2 + dir) * 128 + e) * 64 + dq * 4;
      const float4 kv = *(const float4*)(p.kvst + idx);
      uint2 o;
      o.x = pack2bf(st.x, st.y); o.y = pack2bf(st.z, st.w);
      *(uint2*)(p.rstate + idx) = o;
      st.x = fmaf(st.x, gC, kv.x); st.y = fmaf(st.y, gC, kv.y); st.z = fmaf(st.z, gC, kv.z); st.w = fmaf(st.w, gC, kv.w);
    }
  }
}

#define RO_LD 264
#define RK_LD 72
__device__ __forceinline__ void o_ret_out_task(const Params& p, int l, int task, char* smem, int tid) {
  const int wave = tid >> 6, lane = tid & 63, g = lane >> 4, tl = lane & 15;
  const int bh = task >> 5, n = task & 31, b = bh >> 2, h = bh & 3;
  const int tok0 = b * SEQ + n * 128;
  const float lgf = logsigmoid_(p.ret_decay[l * 8 + h]), lgb = logsigmoid_(p.ret_decay[l * 8 + 4 + h]);
  bf16_t* Acat = (bf16_t*)smem;
  bf16_t* Bcat = Acat + 128 * RO_LD;
  bf16_t* Kl = Bcat + 128 * RO_LD;
  __syncthreads();
#pragma unroll
  for (int it = 0; it < 2; ++it) {
    const int u = tid + it * NTHREADS;
    const int i = u >> 3, d0 = (u & 7) * 8;
    const size_t row = (size_t)(tok0 + i) * IN_WIDTH;
    const uint4 qv = *(const uint4*)(p.proj + row + C_RQ + h * 64 + d0);
    const uint4 kv = *(const uint4*)(p.proj + row + C_RK + h * 64 + d0);
    *(uint4*)(Acat + i * RO_LD + d0) = qv;
    *(uint4*)(Kl + i * RK_LD + d0) = kv;
    const float wf = __expf(lgf * (float)(i + 1)), wb = __expf(lgb * (float)(127 - i));
    const unsigned qw[4] = {qv.x, qv.y, qv.z, qv.w};
    uint4 of, ob;
    of.x = pack2bf(bf_lo(qw[0]) * wf, bf_hi(qw[0]) * wf); ob.x = pack2bf(bf_lo(qw[0]) * wb, bf_hi(qw[0]) * wb);
    of.y = pack2bf(bf_lo(qw[1]) * wf, bf_hi(qw[1]) * wf); ob.y = pack2bf(bf_lo(qw[1]) * wb, bf_hi(qw[1]) * wb);
    of.z = pack2bf(bf_lo(qw[2]) * wf, bf_hi(qw[2]) * wf); ob.z = pack2bf(bf_lo(qw[2]) * wb, bf_hi(qw[2]) * wb);
    of.w = pack2bf(bf_lo(qw[3]) * wf, bf_hi(qw[3]) * wf); ob.w = pack2bf(bf_lo(qw[3]) * wb, bf_hi(qw[3]) * wb);
    *(uint4*)(Acat + i * RO_LD + 128 + d0) = of;
    *(uint4*)(Acat + i * RO_LD + 192 + d0) = ob;
  }
#pragma unroll
  for (int it = 0; it < 4; ++it) {
    const int u = tid + it * NTHREADS;
    const int j = u >> 4, e0 = (u & 15) * 8;
    const uint4 vv = *(const uint4*)(p.proj + (size_t)(tok0 + j) * IN_WIDTH + C_RV + h * 128 + e0);
    const unsigned vw[4] = {vv.x, vv.y, vv.z, vv.w};
#pragma unroll
    for (int e = 0; e < 4; ++e) {
      Bcat[(e0 + 2 * e) * RO_LD + j] = (bf16_t)(vw[e] & 0xffffu);
      Bcat[(e0 + 2 * e + 1) * RO_LD + j] = (bf16_t)(vw[e] >> 16);
    }
  }
#pragma unroll
  for (int it = 0; it < 4; ++it) {
    const int u = tid + it * NTHREADS;
    const int d0 = (u & 7) * 8, e = (u >> 3) & 127, dir = u >> 10;
    const uint4 sv = *(const uint4*)(p.rstate + ((size_t)(task * 2 + dir) * 128 + e) * 64 + d0);
    *(uint4*)(Bcat + e * RO_LD + 128 + dir * 64 + d0) = sv;
  }
  __syncthreads();
  f32x4 sc[8];
#pragma unroll
  for (int jt = 0; jt < 8; ++jt) sc[jt] = (f32x4){0.f, 0.f, 0.f, 0.f};
#pragma unroll
  for (int ks = 0; ks < 2; ++ks) {
    const bf16x8 qb = *(const bf16x8*)(Acat + (wave * 16 + tl) * RO_LD + ks * 32 + 8 * g);
#pragma unroll
    for (int jt = 0; jt < 8; ++jt) {
      const bf16x8 ka = *(const bf16x8*)(Kl + (jt * 16 + tl) * RK_LD + ks * 32 + 8 * g);
      sc[jt] = __builtin_amdgcn_mfma_f32_16x16x32_bf16(ka, qb, sc[jt], 0, 0, 0);
    }
  }
  {
    const int i = wave * 16 + tl;
#pragma unroll
    for (int jt = 0; jt < 8; ++jt) {
      float pv[4];
#pragma unroll
      for (int r = 0; r < 4; ++r) {
        const int j = jt * 16 + 4 * g + r;
        const float dd = (j <= i) ? __expf(lgf * (float)(i - j)) : __expf(lgb * (float)(j - i));
        pv[r] = sc[jt][r] * dd;
      }
      uint2 o;
      o.x = pack2bf(pv[0], pv[1]); o.y = pack2bf(pv[2], pv[3]);
      *(uint2*)(Acat + i * RO_LD + jt * 16 + 4 * g) = o;
    }
  }
  f32x4 y[8];
#pragma unroll
  for (int et = 0; et < 8; ++et) y[et] = (f32x4){0.f, 0.f, 0.f, 0.f};
#pragma unroll
  for (int ks = 0; ks < 8; ++ks) {
    const bf16x8 ab = *(const bf16x8*)(Acat + (wave * 16 + tl) * RO_LD + ks * 32 + 8 * g);
#pragma unroll
    for (int et = 0; et < 8; ++et) {
      const bf16x8 ba = *(const bf16x8*)(Bcat + (et * 16 + tl) * RO_LD + ks * 32 + 8 * g);
      y[et] = __builtin_amdgcn_mfma_f32_16x16x32_bf16(ba, ab, y[et], 0, 0, 0);
    }
  }
  float ss = 0.f;
#pragma unroll
  for (int et = 0; et < 8; ++et)
#pragma unroll
    for (int r = 0; r < 4; ++r) ss = fmaf(y[et][r], y[et][r], ss);
  ss += __shfl_xor(ss, 16, 64);
  ss += __shfl_xor(ss, 32, 64);
  const float rstd = rsqrtf(ss * (1.0f / 128.0f) + EPS);
  {
    const int tok = tok0 + wave * 16 + tl;
    const bf16_t* gp = p.proj + (size_t)tok * IN_WIDTH + C_RG + h * 128 + 4 * g;
    bf16_t* dst = p.ycat + (size_t)tok * 1024 + 256 + h * 128 + 4 * g;
#pragma unroll
    for (int et = 0; et < 8; ++et) {
      const uint2 gv = *(const uint2*)(gp + et * 16);
      const float g0 = bf_lo(gv.x), g1 = bf_hi(gv.x), g2 = bf_lo(gv.y), g3 = bf_hi(gv.y);
      uint2 o;
      o.x = pack2bf(g0 / (1.0f + __expf(-g0)) * y[et][0] * rstd, g1 / (1.0f + __expf(-g1)) * y[et][1] * rstd);
      o.y = pack2bf(g2 / (1.0f + __expf(-g2)) * y[et][2] * rstd, g3 / (1.0f + __expf(-g3)) * y[et][3] * rstd);
      *(uint2*)(dst + et * 16) = o;
    }
  }
}


#define NA_KLD 72
typedef short v4s_t __attribute__((ext_vector_type(4)));
#ifndef LAS
#define LAS __attribute__((address_space(3)))
#endif
__device__ __forceinline__ void o_na_task(const Params& p, int l, int task, char* smem, int tid) {
  const int wave = tid >> 6, lane = tid & 63, g = lane >> 4, tl = lane & 15;
  const int rr = task & 63, h = (task >> 6) & 3, b = task >> 8;
  int rs = rr - 4; rs = rs < 0 ? 0 : (rs > 56 ? 56 : rs);
  const int ktok0 = b * SEQ + rs * 64;
  const int qtok0 = b * SEQ + rr * 64;
  bf16_t* Kl = (bf16_t*)smem;
  bf16_t* Vl = Kl + 512 * NA_KLD;
  bf16_t* Ql = Vl + 512 * NA_KLD;
  float* rpbl = (float*)(Ql + 64 * NA_KLD);
  __syncthreads();
#pragma unroll
  for (int it = 0; it < 8; ++it) {
    const int u = tid + it * NTHREADS;
    const int key = u >> 3, d0 = (u & 7) * 8;
    const size_t row = (size_t)(ktok0 + key) * IN_WIDTH;
    const uint4 kv = *(const uint4*)(p.proj + row + C_NK + h * 64 + d0);
    const uint4 vv = *(const uint4*)(p.proj + row + C_NV + h * 64 + d0);
    *(uint4*)(Kl + key * NA_KLD + d0) = kv;
    *(uint4*)(Vl + key * NA_KLD + d0) = vv;
  }
  {
    const int q = tid >> 3, d0 = (tid & 7) * 8;
    *(uint4*)(Ql + q * NA_KLD + d0) = *(const uint4*)(p.proj + (size_t)(qtok0 + q) * IN_WIDTH + C_NQ + h * 64 + d0);
    if (tid < 465) rpbl[tid] = p.na_rpb[((size_t)l * 4 + h) * 465 + tid];
  }
  __syncthreads();
  if (wave < 4) {
    const int qt = wave;
    int cw0 = 16 * qt - 8; cw0 = cw0 < 0 ? 0 : (cw0 > 32 ? 32 : cw0);
    f32x4 sc[16];
#pragma unroll
    for (int T = 0; T < 16; ++T) sc[T] = (f32x4){0.f, 0.f, 0.f, 0.f};
#pragma unroll
    for (int ks = 0; ks < 2; ++ks) {
      const bf16x8 qb = *(const bf16x8*)(Ql + (qt * 16 + tl) * NA_KLD + ks * 32 + 8 * g);
#pragma unroll
      for (int T = 0; T < 16; ++T) {
        const int key = (T >> 1) * 64 + cw0 + (T & 1) * 16 + tl;
        const bf16x8 ka = *(const bf16x8*)(Kl + key * NA_KLD + ks * 32 + 8 * g);
        sc[T] = __builtin_amdgcn_mfma_f32_16x16x32_bf16(ka, qb, sc[T], 0, 0, 0);
      }
    }
    const int cq = qt * 16 + tl;
    int cs = cq - 8; cs = cs < 0 ? 0 : (cs > 48 ? 48 : cs);
    float m = -3.0e38f;
#pragma unroll
    for (int T = 0; T < 16; ++T) {
      const int ri = T >> 1;
      const int di = rs + ri - rr + 7;
#pragma unroll
      for (int r = 0; r < 4; ++r) {
        const int ck = cw0 + (T & 1) * 16 + 4 * g + r;
        const bool valid = (ck >= cs) && (ck < cs + 16);
        int dj = ck - cq + 15; dj = dj < 0 ? 0 : (dj > 30 ? 30 : dj);
        const float sv = valid ? (sc[T][r] + rpbl[di * 31 + dj]) : -1.0e30f;
        sc[T][r] = sv;
        m = fmaxf(m, sv);
      }
    }
    m = fmaxf(m, __shfl_xor(m, 16, 64));
    m = fmaxf(m, __shfl_xor(m, 32, 64));
    float den = 0.f;
#pragma unroll
    for (int T = 0; T < 16; ++T)
#pragma unroll
      for (int r = 0; r < 4; ++r) {
        const float e = __expf(sc[T][r] - m);
        sc[T][r] = e;
        den += e;
      }
    den += __shfl_xor(den, 16, 64);
    den += __shfl_xor(den, 32, 64);
    const float rden = 1.0f / den;
    f32x4 o[4];
#pragma unroll
    for (int dt = 0; dt < 4; ++dt) o[dt] = (f32x4){0.f, 0.f, 0.f, 0.f};
#pragma unroll
    for (int ri = 0; ri < 8; ++ri) {
      union { bf16x8 v; unsigned u[4]; } pb;
      pb.u[0] = pack2bf(sc[2 * ri][0], sc[2 * ri][1]);
      pb.u[1] = pack2bf(sc[2 * ri][2], sc[2 * ri][3]);
      pb.u[2] = pack2bf(sc[2 * ri + 1][0], sc[2 * ri + 1][1]);
      pb.u[3] = pack2bf(sc[2 * ri + 1][2], sc[2 * ri + 1][3]);
#pragma unroll
      for (int dt = 0; dt < 4; ++dt) {
        const bf16_t* vp = Vl + (ri * 64 + cw0 + 4 * g + (tl >> 2)) * NA_KLD + dt * 16 + 4 * (tl & 3);
        const v4s_t r0 = __builtin_amdgcn_ds_read_tr16_b64_v4i16((v4s_t LAS*)(LAS bf16_t*)vp);
        const v4s_t r1 = __builtin_amdgcn_ds_read_tr16_b64_v4i16((v4s_t LAS*)(LAS bf16_t*)(vp + 16 * NA_KLD));
        const bf16x8 va = {r0[0], r0[1], r0[2], r0[3], r1[0], r1[1], r1[2], r1[3]};
        o[dt] = __builtin_amdgcn_mfma_f32_16x16x32_bf16(va, pb.v, o[dt], 0, 0, 0);
      }
    }
    bf16_t* dst = p.ycat + (size_t)(qtok0 + qt * 16 + tl) * 1024 + 768 + h * 64 + 4 * g;
#pragma unroll
    for (int dt = 0; dt < 4; ++dt) {
      uint2 ov;
      ov.x = pack2bf(o[dt][0] * rden, o[dt][1] * rden);
      ov.y = pack2bf(o[dt][2] * rden, o[dt][3] * rden);
      *(uint2*)(dst + dt * 16) = ov;
    }
  }
}

#define PL_LD 264
__device__ __forceinline__ void o_pool_task(const Params& p, int l, int task, char* smem, int tid) {
  const int wave = tid >> 6, lane = tid & 63, g = lane >> 4, tl = lane & 15;
  const int t0 = task * 64, pos0 = t0 & (SEQ - 1);
  bf16_t* Xp = (bf16_t*)smem;
  bf16_t* WT = Xp + 80 * PL_LD;
  bf16_t* Df = WT + 4 * 64 * 72;
  __syncthreads();
#pragma unroll
  for (int it = 0; it < 5; ++it) {
    const int u = tid + it * NTHREADS;
    const int rw = u >> 5, c0 = (u & 31) * 8;
    const int pos = pos0 - 8 + rw;
    uint4 v = make_uint4(0u, 0u, 0u, 0u);
    if (pos >= 0 && pos < SEQ) v = *(const uint4*)(p.proj + (size_t)(t0 - 8 + rw) * IN_WIDTH + C_POOL + c0);
    *(uint4*)(Xp + rw * PL_LD + c0) = v;
  }
#pragma unroll
  for (int it = 0; it < 4; ++it) {
    const int u = tid + it * NTHREADS;
    const int e0 = (u & 7) * 8, c = (u >> 3) & 63, gi = u >> 9;
    const float* wp = p.pool_w + (((size_t)l * 4 + gi) * 64 + c) * 64 + e0;
    const float4 a = *(const float4*)wp, bq = *(const float4*)(wp + 4);
    const float wv[8] = {a.x, a.y, a.z, a.w, bq.x, bq.y, bq.z, bq.w};
#pragma unroll
    for (int k = 0; k < 8; ++k) WT[(gi * 64 + e0 + k) * 72 + c] = f2bf(wv[k]);
  }
  __syncthreads();
#pragma unroll 1
  for (int it = 0; it < 4; ++it) {
    const int u = tid + it * NTHREADS;
    const int t = u >> 5, c0 = (u & 31) * 8;
    const int gi = c0 >> 6;
    const int hw = 1 << gi;
    const int pos = pos0 + t;
    int a = pos - hw; a = a < 0 ? 0 : a;
    int bnd = pos + hw; bnd = bnd > SEQ ? SEQ : bnd;
    float sum[8];
#pragma unroll
    for (int k = 0; k < 8; ++k) sum[k] = 0.f;
    for (int rp = a; rp < bnd; ++rp) {
      const uint4 v = *(const uint4*)(Xp + (rp - pos0 + 8) * PL_LD + c0);
      sum[0] += bf_lo(v.x); sum[1] += bf_hi(v.x); sum[2] += bf_lo(v.y); sum[3] += bf_hi(v.y);
      sum[4] += bf_lo(v.z); sum[5] += bf_hi(v.z); sum[6] += bf_lo(v.w); sum[7] += bf_hi(v.w);
    }
    const float rc = 1.0f / (float)(bnd - a);
    const uint4 xv = *(const uint4*)(Xp + (t + 8) * PL_LD + c0);
    uint4 o;
    o.x = pack2bf(sum[0] * rc - bf_lo(xv.x), sum[1] * rc - bf_hi(xv.x));
    o.y = pack2bf(sum[2] * rc - bf_lo(xv.y), sum[3] * rc - bf_hi(xv.y));
    o.z = pack2bf(sum[4] * rc - bf_lo(xv.z), sum[5] * rc - bf_hi(xv.z));
    o.w = pack2bf(sum[6] * rc - bf_lo(xv.w), sum[7] * rc - bf_hi(xv.w));
    *(uint4*)(Df + t * PL_LD + c0) = o;
  }
  __syncthreads();
  {
    const int gi = wave >> 1, tt0 = (wave & 1) * 2;
    f32x4 acc[4][2];
#pragma unroll
    for (int et = 0; et < 4; ++et)
#pragma unroll
      for (int tt = 0; tt < 2; ++tt) acc[et][tt] = (f32x4){0.f, 0.f, 0.f, 0.f};
#pragma unroll
    for (int ks = 0; ks < 2; ++ks) {
      bf16x8 bx[2];
#pragma unroll
      for (int tt = 0; tt < 2; ++tt) bx[tt] = *(const bf16x8*)(Df + ((tt0 + tt) * 16 + tl) * PL_LD + gi * 64 + ks * 32 + 8 * g);
#pragma unroll
      for (int et = 0; et < 4; ++et) {
        const bf16x8 wa = *(const bf16x8*)(WT + (gi * 64 + et * 16 + tl) * 72 + ks * 32 + 8 * g);
#pragma unroll
        for (int tt = 0; tt < 2; ++tt) acc[et][tt] = __builtin_amdgcn_mfma_f32_16x16x32_bf16(wa, bx[tt], acc[et][tt], 0, 0, 0);
      }
    }
#pragma unroll
    for (int et = 0; et < 4; ++et) {
      const float4 sc4 = *(const float4*)(p.pool_scale + l * 256 + gi * 64 + et * 16 + 4 * g);
#pragma unroll
      for (int tt = 0; tt < 2; ++tt) {
        const int tok = t0 + (tt0 + tt) * 16 + tl;
        uint2 o;
        o.x = pack2bf(acc[et][tt][0] * sc4.x, acc[et][tt][1] * sc4.y);
        o.y = pack2bf(acc[et][tt][2] * sc4.z, acc[et][tt][3] * sc4.w);
        *(uint2*)(p.ycat + (size_t)tok * 1024 + gi * 64 + et * 16 + 4 * g) = o;
      }
    }
  }
}


typedef __attribute__((ext_vector_type(2))) __bf16 bf16x2_t;
__device__ __forceinline__ float dot2bf(unsigned a, unsigned b, float c) {
  return __builtin_amdgcn_fdot2_f32_bf16(__builtin_bit_cast(bf16x2_t, a), __builtin_bit_cast(bf16x2_t, b), c, false);
}
#define DPP_F(v, ctrl) __builtin_bit_cast(float, __builtin_amdgcn_update_dpp(0, __builtin_bit_cast(int, v), ctrl, 0xf, 0xf, false))
#define RDLANE_F(v, l) __builtin_bit_cast(float, __builtin_amdgcn_readlane(__builtin_bit_cast(int, v), l))
__device__ __forceinline__ float erf_as(float x) {
  const float ax = fabsf(x);
  const float t = __builtin_amdgcn_rcpf(fmaf(0.3275911f, ax, 1.0f));
  float y = fmaf(1.061405429f, t, -1.453152027f);
  y = fmaf(y, t, 1.421413741f);
  y = fmaf(y, t, -0.284496736f);
  y = fmaf(y, t, 0.254829592f);
  y = y * t * __expf(-ax * ax);
  return copysignf(1.0f - y, x);
}
__device__ __forceinline__ float gelu_fast_exact(float a) { return 0.5f * a * (1.0f + erf_as(a * 0.70710678118654752f)); }
struct PickPair { int eA, eB; float gA, gB; };

#define EX6_SHIFT 11
#define EX6_NSLICE (16384 >> EX6_SHIFT)
__device__ __forceinline__ unsigned cvt8_bf16x2(unsigned w, float scale, const bool hi) {
  return hi ? __builtin_bit_cast(unsigned, __builtin_amdgcn_cvt_scalef32_pk_bf16_fp8((int)w, scale, true))
            : __builtin_bit_cast(unsigned, __builtin_amdgcn_cvt_scalef32_pk_bf16_fp8((int)w, scale, false));
}
__device__ __forceinline__ void experts6_process4(const unsigned char* __restrict__ U8, const unsigned char* __restrict__ V8,
                                                  const float2* __restrict__ ES, const int (&e)[4], const float (&g)[4],
                                                  const unsigned (&hw)[8], float (&acc)[16], int lane, int vz) {
  uint4 u[4], v[4];
  float2 sc[4];
#pragma unroll
  for (int i = 0; i < 4; ++i) u[i] = *(const uint4*)(U8 + (size_t)e[i] * 1024 + lane * 16);
#pragma unroll
  for (int i = 0; i < 4; ++i) sc[i] = ES[e[i] + vz];
#pragma unroll
  for (int i = 0; i < 4; ++i) v[i] = *(const uint4*)(V8 + (size_t)e[i] * 1024 + lane * 16);
  float a[4];
#pragma unroll
  for (int i = 0; i < 4; ++i) {
    const unsigned uw[4] = {u[i].x, u[i].y, u[i].z, u[i].w};
    float t = 0.f;
#pragma unroll
    for (int w = 0; w < 4; ++w) {
      t = dot2bf(cvt8_bf16x2(uw[w], sc[i].x, false), hw[2 * w], t);
      t = dot2bf(cvt8_bf16x2(uw[w], sc[i].x, true), hw[2 * w + 1], t);
    }
    a[i] = t;
  }
  const bool b0 = lane & 1, b1 = lane & 2;
  const float x01 = (b0 ? a[1] : a[0]) + DPP_F((b0 ? a[0] : a[1]), 0xB1);
  const float x23 = (b0 ? a[3] : a[2]) + DPP_F((b0 ? a[2] : a[3]), 0xB1);
  float y = (b1 ? x23 : x01) + DPP_F((b1 ? x01 : x23), 0x4E);
  y += DPP_F(y, 0x124);
  y += DPP_F(y, 0x128);
  float sum[4];
#pragma unroll
  for (int i = 0; i < 4; ++i) sum[i] = RDLANE_F(y, i) + RDLANE_F(y, 16 + i) + RDLANE_F(y, 32 + i) + RDLANE_F(y, 48 + i);
  const int li = lane & 3;
  const float mine = (li == 0) ? sum[0] : (li == 1) ? sum[1] : (li == 2) ? sum[2] : sum[3];
  const float gmine = (li == 0) ? g[0] : (li == 1) ? g[1] : (li == 2) ? g[2] : g[3];
  const unsigned gb = (unsigned)f2bf(gelu_fast_exact(mine) * gmine);
#pragma unroll
  for (int i = 0; i < 4; ++i) {
    const unsigned hl = (unsigned)__builtin_amdgcn_readlane((int)gb, i);
    const unsigned hh = hl << 16;
    const unsigned vw[4] = {v[i].x, v[i].y, v[i].z, v[i].w};
#pragma unroll
    for (int w = 0; w < 4; ++w) {
      const unsigned p0 = cvt8_bf16x2(vw[w], sc[i].y, false), p1 = cvt8_bf16x2(vw[w], sc[i].y, true);
      acc[4 * w + 0] = dot2bf(p0, hl, acc[4 * w + 0]);
      acc[4 * w + 1] = dot2bf(p0, hh, acc[4 * w + 1]);
      acc[4 * w + 2] = dot2bf(p1, hl, acc[4 * w + 2]);
      acc[4 * w + 3] = dot2bf(p1, hh, acc[4 * w + 3]);
    }
  }
}

__device__ __forceinline__ void o_peer_experts6_tile(const Params& p, int l, int t0, const char* smem, int tid, bool dry = false) {
  const int wave = __builtin_amdgcn_readfirstlane(tid >> 6), lane = tid & 63;
  const unsigned char* U8 = p.u8 + (size_t)l * 16384 * 1024;
  const unsigned char* V8 = p.v8 + (size_t)l * 16384 * 1024;
  const float2* ES = p.escale + (size_t)l * 16384;
  int vz = 0;
  asm volatile("" : "+v"(vz));
  const int s0 = ((int)(__builtin_amdgcn_s_getreg((3 << 11) | 20) & 0xF) * (EX6_NSLICE / 8)) & (EX6_NSLICE - 1);
  unsigned pk[8][2];
  float acc[8][16];
#pragma unroll
  for (int k = 0; k < 8; ++k) {
    const size_t base = (size_t)(t0 + wave * 8 + k) * 128 + lane + vz;
#pragma unroll
    for (int hf = 0; hf < 2; ++hf) pk[k][hf] = (unsigned)p.pidx[base + hf * 64] | ((unsigned)f2bf(p.pgate[base + hf * 64]) << 16);
#pragma unroll
    for (int i = 0; i < 16; ++i) acc[k][i] = 0.f;
  }
#pragma unroll 1
  for (int si = 0; si < EX6_NSLICE; ++si) {
    const unsigned s = (unsigned)((s0 + si) & (EX6_NSLICE - 1));
#pragma unroll
    for (int k = 0; k < 8; ++k) {
      unsigned long long m0 = __ballot(((pk[k][0] & 0x3fffu) >> EX6_SHIFT) == s);
      unsigned long long m1 = __ballot(((pk[k][1] & 0x3fffu) >> EX6_SHIFT) == s);
      if ((m0 | m1) == 0ull) continue;
      unsigned hw[8];
      {
        const char* xr = smem + (wave * 8 + k) * LDXB + lane * 32;
        const uint4 h0 = *(const uint4*)xr, h1 = *(const uint4*)(xr + 16);
        hw[0] = h0.x; hw[1] = h0.y; hw[2] = h0.z; hw[3] = h0.w; hw[4] = h1.x; hw[5] = h1.y; hw[6] = h1.z; hw[7] = h1.w;
      }
      while (m0 | m1) {
        int e[4]; float g[4];
#pragma unroll
        for (int i = 0; i < 4; ++i) {
          unsigned w;
          if (m0) { const int la = (int)__builtin_ctzll(m0); m0 &= m0 - 1; w = (unsigned)__builtin_amdgcn_readlane((int)pk[k][0], la); }
          else if (m1) { const int la = (int)__builtin_ctzll(m1); m1 &= m1 - 1; w = (unsigned)__builtin_amdgcn_readlane((int)pk[k][1], la); }
          else { w = (unsigned)e[0]; }
          e[i] = (int)(w & 0x3fffu);
          g[i] = __uint_as_float(w & 0xffff0000u);
        }
        experts6_process4(U8, V8, ES, e, g, hw, acc[k], lane, vz);
      }
    }
  }
  if (dry) {
#pragma unroll
    for (int k = 0; k < 8; ++k)
#pragma unroll
      for (int i = 0; i < 16; ++i) asm volatile("" :: "v"(acc[k][i]));
    return;
  }
#pragma unroll
  for (int k = 0; k < 8; ++k) {
    float* xr = p.xres + (size_t)(t0 + wave * 8 + k) * 1024 + lane * 16;
#pragma unroll
    for (int i = 0; i < 4; ++i) {
      float4 a0 = *(float4*)(xr + 4 * i);
      a0.x += acc[k][4 * i + 0]; a0.y += acc[k][4 * i + 1]; a0.z += acc[k][4 * i + 2]; a0.w += acc[k][4 * i + 3];
      *(float4*)(xr + 4 * i) = a0;
    }
  }
}


typedef _Float16 h2_t __attribute__((ext_vector_type(2)));
__device__ __forceinline__ void ex7_pop(unsigned long long& m0, unsigned long long& m1, const unsigned pk0, const unsigned pk1,
                                        int (&e)[4], float (&g)[4]) {
  int e0 = 0;
#pragma unroll
  for (int i = 0; i < 4; ++i) {
    unsigned w;
    if (m0) { const int la = (int)__builtin_ctzll(m0); m0 &= m0 - 1; w = (unsigned)__builtin_amdgcn_readlane((int)pk0, la); }
    else if (m1) { const int la = (int)__builtin_ctzll(m1); m1 &= m1 - 1; w = (unsigned)__builtin_amdgcn_readlane((int)pk1, la); }
    else { w = (unsigned)e0; }
    e[i] = (int)(w & 0x3fffu);
    g[i] = __uint_as_float(w & 0xffff0000u);
    if (i == 0) e0 = e[0];
  }
}
#define EX7_ISSUE(U_, V_, SC_, G_) { \
  _Pragma("unroll") for (int i_ = 0; i_ < 4; ++i_) U_[i_] = __builtin_bit_cast(uint4, __builtin_amdgcn_raw_buffer_load_b128(rU, lo16, e[i_] * 1024, 0)); \
  _Pragma("unroll") for (int i_ = 0; i_ < 4; ++i_) SC_[i_] = __builtin_bit_cast(float2, __builtin_amdgcn_raw_buffer_load_b64(rS, vz, e[i_] * 8, 0)); \
  _Pragma("unroll") for (int i_ = 0; i_ < 4; ++i_) V_[i_] = __builtin_bit_cast(uint4, __builtin_amdgcn_raw_buffer_load_b128(rV, lo16, e[i_] * 1024, 0)); \
  _Pragma("unroll") for (int i_ = 0; i_ < 4; ++i_) G_[i_] = g[i_]; }

__device__ __forceinline__ void ex7_compute(const uint4 (&ru)[4], const uint4 (&rv)[4], const float2 (&rsc)[4], const float (&rg)[4],
                                            const unsigned (&hw)[8], h2_t (&acc)[8], int lane) {
  float a[4];
#pragma unroll
  for (int i = 0; i < 4; ++i) {
    const unsigned uw[4] = {ru[i].x, ru[i].y, ru[i].z, ru[i].w};
    float t = 0.f;
#pragma unroll
    for (int w = 0; w < 4; ++w) {
      t = dot2bf(cvt8_bf16x2(uw[w], rsc[i].x, false), hw[2 * w], t);
      t = dot2bf(cvt8_bf16x2(uw[w], rsc[i].x, true), hw[2 * w + 1], t);
    }
    a[i] = t;
  }
  const bool b0 = lane & 1, b1 = lane & 2;
  const float x01 = (b0 ? a[1] : a[0]) + DPP_F((b0 ? a[0] : a[1]), 0xB1);
  const float x23 = (b0 ? a[3] : a[2]) + DPP_F((b0 ? a[2] : a[3]), 0xB1);
  float y = (b1 ? x23 : x01) + DPP_F((b1 ? x01 : x23), 0x4E);
  y += DPP_F(y, 0x124);
  y += DPP_F(y, 0x128);
  float sum[4];
#pragma unroll
  for (int i = 0; i < 4; ++i) sum[i] = RDLANE_F(y, i) + RDLANE_F(y, 16 + i) + RDLANE_F(y, 32 + i) + RDLANE_F(y, 48 + i);
  const int li = lane & 3;
  const float mine = (li == 0) ? sum[0] : (li == 1) ? sum[1] : (li == 2) ? sum[2] : sum[3];
  const float gmine = (li == 0) ? rg[0] : (li == 1) ? rg[1] : (li == 2) ? rg[2] : rg[3];
  const _Float16 hf = (_Float16)(gelu_fast_exact(mine) * gmine);
  const unsigned hb = (unsigned)__builtin_bit_cast(unsigned short, hf);
#pragma unroll
  for (int i = 0; i < 4; ++i) {
    const unsigned hl = (unsigned)__builtin_amdgcn_readlane((int)hb, i);
    const h2_t hh = __builtin_bit_cast(h2_t, hl | (hl << 16));
    const unsigned vw[4] = {rv[i].x, rv[i].y, rv[i].z, rv[i].w};
#pragma unroll
    for (int w = 0; w < 4; ++w) {
      const h2_t p0 = __builtin_amdgcn_cvt_scalef32_pk_f16_fp8((int)vw[w], rsc[i].y, false);
      const h2_t p1 = __builtin_amdgcn_cvt_scalef32_pk_f16_fp8((int)vw[w], rsc[i].y, true);
      acc[2 * w] = __builtin_elementwise_fma(p0, hh, acc[2 * w]);
      acc[2 * w + 1] = __builtin_elementwise_fma(p1, hh, acc[2 * w + 1]);
    }
  }
}

__device__ __forceinline__ void o_peer_experts7_tile(const Params& p, int l, int t0, const char* smem, int tid, bool dry = false) {
  const int wave = __builtin_amdgcn_readfirstlane(tid >> 6), lane = tid & 63;
  const unsigned char* U8 = p.u8 + (size_t)l * 16384 * 1024;
  const unsigned char* V8 = p.v8 + (size_t)l * 16384 * 1024;
  const float2* ES = p.escale + (size_t)l * 16384;
  int vz = 0;
  asm volatile("" : "+v"(vz));
  const __amdgpu_buffer_rsrc_t rsU = __builtin_amdgcn_make_buffer_rsrc((void*)U8, 0, 16384 * 1024, 0x00020000);
  const __amdgpu_buffer_rsrc_t rsV = __builtin_amdgcn_make_buffer_rsrc((void*)V8, 0, 16384 * 1024, 0x00020000);
  const __amdgpu_buffer_rsrc_t rsS = __builtin_amdgcn_make_buffer_rsrc((void*)ES, 0, 16384 * 8, 0x00020000);
  const __amdgpu_buffer_rsrc_t rsU0 = __builtin_amdgcn_make_buffer_rsrc((void*)U8, 0, 0, 0x00020000);
  const __amdgpu_buffer_rsrc_t rsV0 = __builtin_amdgcn_make_buffer_rsrc((void*)V8, 0, 0, 0x00020000);
  const __amdgpu_buffer_rsrc_t rsS0 = __builtin_amdgcn_make_buffer_rsrc((void*)ES, 0, 0, 0x00020000);
  const int lo16 = lane * 16;
  const int s0 = ((int)(__builtin_amdgcn_s_getreg((3 << 11) | 20) & 0xF) * (EX6_NSLICE / 8)) & (EX6_NSLICE - 1);
  unsigned pk[8][2];
  h2_t acc[8][8];
#pragma unroll
  for (int k = 0; k < 8; ++k) {
    const size_t base = (size_t)(t0 + wave * 8 + k) * 128 + lane + vz;
#pragma unroll
    for (int hf = 0; hf < 2; ++hf) pk[k][hf] = (unsigned)p.pidx[base + hf * 64] | ((unsigned)f2bf(p.pgate[base + hf * 64]) << 16);
#pragma unroll
    for (int i = 0; i < 8; ++i) acc[k][i] = (h2_t){(_Float16)0.f, (_Float16)0.f};
  }
#pragma unroll 1
  for (int si = 0; si < EX6_NSLICE; ++si) {
    const unsigned s = (unsigned)((s0 + si) & (EX6_NSLICE - 1));
#pragma unroll
    for (int k = 0; k < 8; ++k) {
      unsigned long long m0 = __ballot(((pk[k][0] & 0x3fffu) >> EX6_SHIFT) == s);
      unsigned long long m1 = __ballot(((pk[k][1] & 0x3fffu) >> EX6_SHIFT) == s);
      if ((m0 | m1) == 0ull) continue;
      unsigned hw[8];
      {
        const char* xr = smem + (wave * 8 + k) * LDXB + lane * 32;
        const uint4 h0 = *(const uint4*)xr, h1 = *(const uint4*)(xr + 16);
        hw[0] = h0.x; hw[1] = h0.y; hw[2] = h0.z; hw[3] = h0.w; hw[4] = h1.x; hw[5] = h1.y; hw[6] = h1.z; hw[7] = h1.w;
      }
      uint4 uA[4], vA[4], uB[4], vB[4];
      float2 scA[4], scB[4];
      float gA[4], gB[4];
      int e[4]; float g[4];
      ex7_pop(m0, m1, pk[k][0], pk[k][1], e, g);
      __amdgpu_buffer_rsrc_t rU = rsU, rV = rsV, rS = rsS;
      EX7_ISSUE(uA, vA, scA, gA)
      for (;;) {
        const bool mb = (m0 | m1) != 0ull;
        if (mb) ex7_pop(m0, m1, pk[k][0], pk[k][1], e, g);
        rU = mb ? rsU : rsU0; rV = mb ? rsV : rsV0; rS = mb ? rsS : rsS0;
        EX7_ISSUE(uB, vB, scB, gB)
        __builtin_amdgcn_s_setprio(1);
        ex7_compute(uA, vA, scA, gA, hw, acc[k], lane);
        __builtin_amdgcn_s_setprio(0);
        if (!mb) break;
        const bool ma = (m0 | m1) != 0ull;
        if (ma) ex7_pop(m0, m1, pk[k][0], pk[k][1], e, g);
        rU = ma ? rsU : rsU0; rV = ma ? rsV : rsV0; rS = ma ? rsS : rsS0;
        EX7_ISSUE(uA, vA, scA, gA)
        __builtin_amdgcn_s_setprio(1);
        ex7_compute(uB, vB, scB, gB, hw, acc[k], lane);
        __builtin_amdgcn_s_setprio(0);
        if (!ma) break;
      }
    }
  }
  if (dry) {
#pragma unroll
    for (int k = 0; k < 8; ++k)
#pragma unroll
      for (int i = 0; i < 8; ++i) asm volatile("" :: "v"(acc[k][i]));
    return;
  }
#pragma unroll
  for (int k = 0; k < 8; ++k) {
    float* xr = p.xres + (size_t)(t0 + wave * 8 + k) * 1024 + lane * 16;
#pragma unroll
    for (int i = 0; i < 4; ++i) {
      float4 a0 = *(float4*)(xr + 4 * i);
      a0.x += (float)acc[k][2 * i][0]; a0.y += (float)acc[k][2 * i][1];
      a0.z += (float)acc[k][2 * i + 1][0]; a0.w += (float)acc[k][2 * i + 1][1];
      *(float4*)(xr + 4 * i) = a0;
    }
  }
}

typedef unsigned u32x2_t __attribute__((ext_vector_type(2)));
__device__ __forceinline__ long mk_long(unsigned lo, unsigned hi) { return (long)(((unsigned long long)hi << 32) | (unsigned long long)lo); }
__device__ __forceinline__ float xrow_total(float y) {
  const unsigned yb = __float_as_uint(y);
  const u32x2_t r = __builtin_amdgcn_permlane16_swap(yb, yb, false, false);
  const float z = __uint_as_float(r[0]) + __uint_as_float(r[1]);
  const unsigned zb = __float_as_uint(z);
  const u32x2_t r2 = __builtin_amdgcn_permlane32_swap(zb, zb, false, false);
  return __uint_as_float(r2[0]) + __uint_as_float(r2[1]);
}
__device__ __forceinline__ void ex8_pop(unsigned long long& m0, unsigned long long& m1, const unsigned pk0, const unsigned pk1, unsigned (&w)[4]) {
  unsigned w0 = 0;
#pragma unroll
  for (int i = 0; i < 4; ++i) {
    unsigned x;
    if (m0) { const int la = (int)__builtin_ctzll(m0); m0 &= m0 - 1; x = (unsigned)__builtin_amdgcn_readlane((int)pk0, la); }
    else if (m1) { const int la = (int)__builtin_ctzll(m1); m1 &= m1 - 1; x = (unsigned)__builtin_amdgcn_readlane((int)pk1, la); }
    else { x = w0 & 0x3fffu; }
    w[i] = x;
    if (i == 0) w0 = x;
  }
}
#define EX8_ISSUE(U_, V_, SC_, WQ_) { \
  _Pragma("unroll") for (int i_ = 0; i_ < 4; ++i_) U_[i_] = __builtin_bit_cast(uint4, __builtin_amdgcn_raw_buffer_load_b128(rU, lo16, (int)(w[i_] & 0x3fffu) * 1024, 0)); \
  WQ_ = (w[0] & oh0) | (w[1] & oh1) | (w[2] & oh2) | (w[3] & oh3); \
  SC_ = __builtin_bit_cast(float2, __builtin_amdgcn_raw_buffer_load_b64(rS, (int)(WQ_ & 0x3fffu) * 8, 0, 0)); \
  _Pragma("unroll") for (int i_ = 0; i_ < 4; ++i_) V_[i_] = __builtin_bit_cast(uint4, __builtin_amdgcn_raw_buffer_load_b128(rV, lo16, (int)(w[i_] & 0x3fffu) * 1024, 0)); }

__device__ __forceinline__ void ex8_compute(const uint4 (&ru)[4], const uint4 (&rv)[4], const float2 scm, const unsigned wq,
                                            const uint4 hb, const float hsi, f32x4 (&cur)[4],
                                            const bool b0, const bool b1, const bool isdiag, const unsigned mlane) {
  const long hA = mk_long(hb.x, hb.y), hB = mk_long(hb.z, hb.w);
  f32x4 d[4];
#pragma unroll
  for (int i = 0; i < 4; ++i) d[i] = __builtin_amdgcn_mfma_f32_16x16x32_fp8_fp8(mk_long(ru[i].x, ru[i].y), hA, (f32x4){0.f, 0.f, 0.f, 0.f}, 0, 0, 0);
#pragma unroll
  for (int i = 0; i < 4; ++i) d[i] = __builtin_amdgcn_mfma_f32_16x16x32_fp8_fp8(mk_long(ru[i].z, ru[i].w), hB, d[i], 0, 0, 0);
  float a[4];
#pragma unroll
  for (int i = 0; i < 4; ++i) a[i] = b1 ? (b0 ? d[i][3] : d[i][2]) : (b0 ? d[i][1] : d[i][0]);
  const float x01 = (b0 ? a[1] : a[0]) + DPP_F((b0 ? a[0] : a[1]), 0xB1);
  const float x23 = (b0 ? a[3] : a[2]) + DPP_F((b0 ? a[2] : a[3]), 0xB1);
  float y = (b1 ? x23 : x01) + DPP_F((b1 ? x01 : x23), 0x4E);
  y = isdiag ? y : 0.f;
  y += DPP_F(y, 0x124);
  y += DPP_F(y, 0x128);
  y = xrow_total(y);
  const float hpre = y * scm.x * hsi;
  const float hv = gelu_fast_exact(hpre) * __uint_as_float(wq & 0xffff0000u) * scm.y;
  float m = fabsf(hv);
  m = fmaxf(m, DPP_F(m, 0xB1));
  m = fmaxf(m, DPP_F(m, 0x4E));
  unsigned eb = __float_as_uint(m) >> 23;
  eb = eb < 16u ? 16u : eb;
  const float S = __uint_as_float((261u - eb) << 23), invS = __uint_as_float((eb - 7u) << 23);
  const float hq = hv * S;
  const unsigned hb8 = (unsigned)__builtin_amdgcn_cvt_pk_fp8_f32(hq, hq, 0, false) & 0xffu;
  f32x4 e[4];
#pragma unroll
  for (int i = 0; i < 4; ++i) {
    const unsigned sb = (unsigned)__builtin_amdgcn_readlane((int)hb8, i) * 0x01010101u;
    const unsigned x = sb & mlane;
    const long a0 = mk_long(x, 0u), a1 = mk_long(0u, x);
    const long v0 = mk_long(rv[i].x, rv[i].y), v1 = mk_long(rv[i].z, rv[i].w);
    if (i == 0) {
      e[0] = __builtin_amdgcn_mfma_f32_16x16x32_fp8_fp8(a0, v0, (f32x4){0.f, 0.f, 0.f, 0.f}, 0, 0, 0);
      e[1] = __builtin_amdgcn_mfma_f32_16x16x32_fp8_fp8(a1, v0, (f32x4){0.f, 0.f, 0.f, 0.f}, 0, 0, 0);
      e[2] = __builtin_amdgcn_mfma_f32_16x16x32_fp8_fp8(a0, v1, (f32x4){0.f, 0.f, 0.f, 0.f}, 0, 0, 0);
      e[3] = __builtin_amdgcn_mfma_f32_16x16x32_fp8_fp8(a1, v1, (f32x4){0.f, 0.f, 0.f, 0.f}, 0, 0, 0);
    } else {
      e[0] = __builtin_amdgcn_mfma_f32_16x16x32_fp8_fp8(a0, v0, e[0], 0, 0, 0);
      e[1] = __builtin_amdgcn_mfma_f32_16x16x32_fp8_fp8(a1, v0, e[1], 0, 0, 0);
      e[2] = __builtin_amdgcn_mfma_f32_16x16x32_fp8_fp8(a0, v1, e[2], 0, 0, 0);
      e[3] = __builtin_amdgcn_mfma_f32_16x16x32_fp8_fp8(a1, v1, e[3], 0, 0, 0);
    }
  }
#pragma unroll
  for (int q = 0; q < 4; ++q) cur[q] += e[q] * invS;
}

__device__ __forceinline__ void o_peer_experts8_tile(const Params& p, int l, int t0, char* smem, int tid) {
  const int wave = __builtin_amdgcn_readfirstlane(tid >> 6), lane = tid & 63;
  const unsigned char* U8 = p.u8 + (size_t)l * 16384 * 1024;
  const unsigned char* V8 = p.v8 + (size_t)l * 16384 * 1024;
  const float2* ES = p.escale + (size_t)l * 16384;
  int vz = 0;
  asm volatile("" : "+v"(vz));
  const __amdgpu_buffer_rsrc_t rsU = __builtin_amdgcn_make_buffer_rsrc((void*)U8, 0, 16384 * 1024, 0x00020000);
  const __amdgpu_buffer_rsrc_t rsV = __builtin_amdgcn_make_buffer_rsrc((void*)V8, 0, 16384 * 1024, 0x00020000);
  const __amdgpu_buffer_rsrc_t rsS = __builtin_amdgcn_make_buffer_rsrc((void*)ES, 0, 16384 * 8, 0x00020000);
  const __amdgpu_buffer_rsrc_t rsU0 = __builtin_amdgcn_make_buffer_rsrc((void*)U8, 0, 0, 0x00020000);
  const __amdgpu_buffer_rsrc_t rsV0 = __builtin_amdgcn_make_buffer_rsrc((void*)V8, 0, 0, 0x00020000);
  const __amdgpu_buffer_rsrc_t rsS0 = __builtin_amdgcn_make_buffer_rsrc((void*)ES, 0, 0, 0x00020000);
  const int lo16 = lane * 16;
  const int li = lane & 3;
  const bool b0 = lane & 1, b1 = lane & 2, isdiag = (lane >> 4) == ((lane & 15) >> 2);
  const unsigned mlane = isdiag ? (0xffu << (8 * li)) : 0u;
  const unsigned oh0 = li == 0 ? 0xffffffffu : 0u, oh1 = li == 1 ? 0xffffffffu : 0u, oh2 = li == 2 ? 0xffffffffu : 0u, oh3 = li == 3 ? 0xffffffffu : 0u;
  const int s0 = ((int)(__builtin_amdgcn_s_getreg((3 << 11) | 20) & 0xF) * (EX6_NSLICE / 8)) & (EX6_NSLICE - 1);
  unsigned pk[8][2];
  h2_t acc[8][8];
  float hsi[8];
#pragma unroll
  for (int k = 0; k < 8; ++k) {
    const size_t base = (size_t)(t0 + wave * 8 + k) * 128 + lane + vz;
#pragma unroll
    for (int hf = 0; hf < 2; ++hf) pk[k][hf] = (unsigned)p.pidx[base + hf * 64] | ((unsigned)f2bf(p.pgate[base + hf * 64]) << 16);
#pragma unroll
    for (int i = 0; i < 8; ++i) acc[k][i] = (h2_t){(_Float16)0.f, (_Float16)0.f};
  }
#pragma unroll
  for (int k = 0; k < 8; ++k) {
    char* row = smem + (wave * 8 + k) * LDXB;
    const uint4 h0 = *(const uint4*)(row + lane * 32), h1 = *(const uint4*)(row + lane * 32 + 16);
    const unsigned hw[8] = {h0.x, h0.y, h0.z, h0.w, h1.x, h1.y, h1.z, h1.w};
    float mx = 0.f;
#pragma unroll
    for (int i = 0; i < 8; ++i) mx = fmaxf(mx, fmaxf(fabsf(__uint_as_float(hw[i] << 16)), fabsf(__uint_as_float(hw[i] & 0xffff0000u))));
    mx = wave_max(mx);
    unsigned eb = __float_as_uint(mx) >> 23;
    eb = eb < 16u ? 16u : (eb > 240u ? 240u : eb);
    eb = (unsigned)__builtin_amdgcn_readfirstlane((int)eb);
    const float S = __uint_as_float((261u - eb) << 23);
    hsi[k] = __uint_as_float((eb - 7u) << 23);
    unsigned o[4];
#pragma unroll
    for (int i = 0; i < 4; ++i) {
      int t = __builtin_amdgcn_cvt_pk_fp8_f32(__uint_as_float(hw[2 * i] << 16) * S, __uint_as_float(hw[2 * i] & 0xffff0000u) * S, 0, false);
      t = __builtin_amdgcn_cvt_pk_fp8_f32(__uint_as_float(hw[2 * i + 1] << 16) * S, __uint_as_float(hw[2 * i + 1] & 0xffff0000u) * S, t, true);
      o[i] = (unsigned)t;
    }
    asm volatile("s_waitcnt lgkmcnt(0)" ::: "memory");
    *(uint4*)(row + lane * 16) = make_uint4(o[0], o[1], o[2], o[3]);
  }
  asm volatile("s_waitcnt lgkmcnt(0)" ::: "memory");
#pragma unroll 1
  for (int si = 0; si < EX6_NSLICE; ++si) {
    const unsigned s = (unsigned)((s0 + si) & (EX6_NSLICE - 1));
#pragma unroll
    for (int k = 0; k < 8; ++k) {
      unsigned long long m0 = __ballot(((pk[k][0] & 0x3fffu) >> EX6_SHIFT) == s);
      unsigned long long m1 = __ballot(((pk[k][1] & 0x3fffu) >> EX6_SHIFT) == s);
      if ((m0 | m1) == 0ull) continue;
      const uint4 hb = *(const uint4*)(smem + (wave * 8 + k) * LDXB + lane * 16);
      f32x4 cur[4];
#pragma unroll
      for (int q = 0; q < 4; ++q) cur[q] = (f32x4){0.f, 0.f, 0.f, 0.f};
      uint4 uA[4], vA[4], uB[4], vB[4];
      float2 scA, scB;
      unsigned wqA, wqB;
      unsigned w[4];
      ex8_pop(m0, m1, pk[k][0], pk[k][1], w);
      __amdgpu_buffer_rsrc_t rU = rsU, rV = rsV, rS = rsS;
      EX8_ISSUE(uA, vA, scA, wqA)
      for (;;) {
        const bool mb = (m0 | m1) != 0ull;
        if (mb) ex8_pop(m0, m1, pk[k][0], pk[k][1], w);
        rU = mb ? rsU : rsU0; rV = mb ? rsV : rsV0; rS = mb ? rsS : rsS0;
        EX8_ISSUE(uB, vB, scB, wqB)
        __builtin_amdgcn_s_setprio(1);
        ex8_compute(uA, vA, scA, wqA, hb, hsi[k], cur, b0, b1, isdiag, mlane);
        __builtin_amdgcn_s_setprio(0);
        if (!mb) break;
        const bool ma = (m0 | m1) != 0ull;
        if (ma) ex8_pop(m0, m1, pk[k][0], pk[k][1], w);
        rU = ma ? rsU : rsU0; rV = ma ? rsV : rsV0; rS = ma ? rsS : rsS0;
        EX8_ISSUE(uA, vA, scA, wqA)
        __builtin_amdgcn_s_setprio(1);
        ex8_compute(uB, vB, scB, wqB, hb, hsi[k], cur, b0, b1, isdiag, mlane);
        __builtin_amdgcn_s_setprio(0);
        if (!ma) break;
      }
#pragma unroll
      for (int q = 0; q < 4; ++q) {
        acc[k][2 * q] += (h2_t){(_Float16)cur[q][0], (_Float16)cur[q][1]};
        acc[k][2 * q + 1] += (h2_t){(_Float16)cur[q][2], (_Float16)cur[q][3]};
      }
    }
  }
#pragma unroll
  for (int k = 0; k < 8; ++k) {
    float* xr = p.xres + (size_t)(t0 + wave * 8 + k) * 1024 + lane * 16;
#pragma unroll
    for (int i = 0; i < 4; ++i) {
      float4 a0 = *(float4*)(xr + 4 * i);
      a0.x += (float)acc[k][2 * i][0]; a0.y += (float)acc[k][2 * i][1];
      a0.z += (float)acc[k][2 * i + 1][0]; a0.w += (float)acc[k][2 * i + 1][1];
      *(float4*)(xr + 4 * i) = a0;
    }
  }
}

typedef unsigned v16u_t __attribute__((ext_vector_type(16)));
typedef unsigned v32u_t __attribute__((ext_vector_type(32)));
#define EX9_GEN(U_, V_, SC_, WQ_, K_, LAST_, VALID_) { \
  VALID_ = false; \
  if (!gdone) { \
    while ((m0 | m1) == 0ull) { \
      ++gk; \
      if (gk == 8) { gk = 0; ++gsi; if (gsi == EX6_NSLICE) { gdone = true; break; } } \
      gpk0 = pkv[2 * gk]; gpk1 = pkv[2 * gk + 1]; \
      const unsigned s_ = (unsigned)((s0 + gsi) & (EX6_NSLICE - 1)); \
      m0 = __ballot(((gpk0 & 0x3fffu) >> EX6_SHIFT) == s_); \
      m1 = __ballot(((gpk1 & 0x3fffu) >> EX6_SHIFT) == s_); \
    } \
    if (!gdone) { ex8_pop(m0, m1, gpk0, gpk1, w); K_ = gk; LAST_ = (m0 | m1) == 0ull; VALID_ = true; } \
  } \
  rU = VALID_ ? rsU : rsU0; rV = VALID_ ? rsV : rsV0; rS = VALID_ ? rsS : rsS0; \
  EX8_ISSUE(U_, V_, SC_, WQ_) }
#define EX9_COMPUTE(U_, V_, SC_, WQ_, K_, LAST_, VALID_) { \
  if (VALID_) { \
    if (K_ != ck) { ck = K_; hb = make_uint4(hbv[4 * K_], hbv[4 * K_ + 1], hbv[4 * K_ + 2], hbv[4 * K_ + 3]); \
                    hs = __uint_as_float((unsigned)__builtin_amdgcn_readlane((int)__float_as_uint(hsiv), K_)); } \
    __builtin_amdgcn_s_setprio(1); \
    ex8_compute(U_, V_, SC_, WQ_, hb, hs, cur, b0, b1, isdiag, mlane); \
    __builtin_amdgcn_s_setprio(0); \
    if (LAST_) { \
      char* ar_ = smem + (wave * 8 + K_) * LDXB + lane * 32; \
      uint4 a0_ = *(const uint4*)ar_, a1_ = *(const uint4*)(ar_ + 16); \
      a0_.x = ex9_addh2(a0_.x, cur[0][0], cur[0][1]); a0_.y = ex9_addh2(a0_.y, cur[0][2], cur[0][3]); \
      a0_.z = ex9_addh2(a0_.z, cur[1][0], cur[1][1]); a0_.w = ex9_addh2(a0_.w, cur[1][2], cur[1][3]); \
      a1_.x = ex9_addh2(a1_.x, cur[2][0], cur[2][1]); a1_.y = ex9_addh2(a1_.y, cur[2][2], cur[2][3]); \
      a1_.z = ex9_addh2(a1_.z, cur[3][0], cur[3][1]); a1_.w = ex9_addh2(a1_.w, cur[3][2], cur[3][3]); \
      *(uint4*)ar_ = a0_; *(uint4*)(ar_ + 16) = a1_; \
      _Pragma("unroll") for (int q_ = 0; q_ < 4; ++q_) cur[q_] = (f32x4){0.f, 0.f, 0.f, 0.f}; \
    } \
  } }
__device__ __forceinline__ unsigned ex9_addh2(unsigned a, float x, float y) {
  const h2_t r = __builtin_bit_cast(h2_t, a) + (h2_t){(_Float16)x, (_Float16)y};
  return __builtin_bit_cast(unsigned, r);
}

__device__ __forceinline__ void o_peer_experts9_tile(const Params& p, int l, int t0, char* smem, int tid) {
  const int wave = __builtin_amdgcn_readfirstlane(tid >> 6), lane = tid & 63;
  const unsigned char* U8 = p.u8 + (size_t)l * 16384 * 1024;
  const unsigned char* V8 = p.v8 + (size_t)l * 16384 * 1024;
  const float2* ES = p.escale + (size_t)l * 16384;
  int vz = 0;
  asm volatile("" : "+v"(vz));
  const __amdgpu_buffer_rsrc_t rsU = __builtin_amdgcn_make_buffer_rsrc((void*)U8, 0, 16384 * 1024, 0x00020000);
  const __amdgpu_buffer_rsrc_t rsV = __builtin_amdgcn_make_buffer_rsrc((void*)V8, 0, 16384 * 1024, 0x00020000);
  const __amdgpu_buffer_rsrc_t rsS = __builtin_amdgcn_make_buffer_rsrc((void*)ES, 0, 16384 * 8, 0x00020000);
  const __amdgpu_buffer_rsrc_t rsU0 = __builtin_amdgcn_make_buffer_rsrc((void*)U8, 0, 0, 0x00020000);
  const __amdgpu_buffer_rsrc_t rsV0 = __builtin_amdgcn_make_buffer_rsrc((void*)V8, 0, 0, 0x00020000);
  const __amdgpu_buffer_rsrc_t rsS0 = __builtin_amdgcn_make_buffer_rsrc((void*)ES, 0, 0, 0x00020000);
  const int lo16 = lane * 16;
  const int li = lane & 3;
  const bool b0 = lane & 1, b1 = lane & 2, isdiag = (lane >> 4) == ((lane & 15) >> 2);
  const unsigned mlane = isdiag ? (0xffu << (8 * li)) : 0u;
  const unsigned oh0 = li == 0 ? 0xffffffffu : 0u, oh1 = li == 1 ? 0xffffffffu : 0u, oh2 = li == 2 ? 0xffffffffu : 0u, oh3 = li == 3 ? 0xffffffffu : 0u;
  const int s0 = ((int)(__builtin_amdgcn_s_getreg((3 << 11) | 20) & 0xF) * (EX6_NSLICE / 8)) & (EX6_NSLICE - 1);
  v16u_t pkv;
  v32u_t hbv;
  float hsiv = 0.f;
#pragma unroll
  for (int k = 0; k < 8; ++k) {
    const size_t base = (size_t)(t0 + wave * 8 + k) * 128 + lane + vz;
#pragma unroll
    for (int hf = 0; hf < 2; ++hf) pkv[2 * k + hf] = (unsigned)p.pidx[base + hf * 64] | ((unsigned)f2bf(p.pgate[base + hf * 64]) << 16);
  }
#pragma unroll
  for (int k = 0; k < 8; ++k) {
    char* row = smem + (wave * 8 + k) * LDXB;
    const uint4 h0 = *(const uint4*)(row + lane * 32), h1 = *(const uint4*)(row + lane * 32 + 16);
    const unsigned hw[8] = {h0.x, h0.y, h0.z, h0.w, h1.x, h1.y, h1.z, h1.w};
    float mx = 0.f;
#pragma unroll
    for (int i = 0; i < 8; ++i) mx = fmaxf(mx, fmaxf(fabsf(__uint_as_float(hw[i] << 16)), fabsf(__uint_as_float(hw[i] & 0xffff0000u))));
    mx = wave_max(mx);
    unsigned eb = __float_as_uint(mx) >> 23;
    eb = eb < 16u ? 16u : (eb > 240u ? 240u : eb);
    const float S = __uint_as_float((261u - eb) << 23);
    hsiv = (lane == k) ? __uint_as_float((eb - 7u) << 23) : hsiv;
#pragma unroll
    for (int i = 0; i < 4; ++i) {
      int t = __builtin_amdgcn_cvt_pk_fp8_f32(__uint_as_float(hw[2 * i] << 16) * S, __uint_as_float(hw[2 * i] & 0xffff0000u) * S, 0, false);
      t = __builtin_amdgcn_cvt_pk_fp8_f32(__uint_as_float(hw[2 * i + 1] << 16) * S, __uint_as_float(hw[2 * i + 1] & 0xffff0000u) * S, t, true);
      hbv[4 * k + i] = (unsigned)t;
    }
    asm volatile("s_waitcnt lgkmcnt(0)" ::: "memory");
    *(uint4*)(row + lane * 32) = make_uint4(0u, 0u, 0u, 0u);
    *(uint4*)(row + lane * 32 + 16) = make_uint4(0u, 0u, 0u, 0u);
  }
  int gsi = 0, gk = -1;
  bool gdone = false;
  unsigned long long m0 = 0ull, m1 = 0ull;
  unsigned gpk0 = 0u, gpk1 = 0u;
  unsigned w[4] = {0u, 0u, 0u, 0u};
  __amdgpu_buffer_rsrc_t rU = rsU, rV = rsV, rS = rsS;
  uint4 uA[4], vA[4], uB[4], vB[4], uC[4], vC[4];
  float2 scA, scB, scC;
  unsigned wqA, wqB, wqC;
  int kA = 0, kB = 0, kC = 0;
  bool lastA = false, lastB = false, lastC = false, validA, validB, validC;
  int ck = -1;
  uint4 hb = make_uint4(0u, 0u, 0u, 0u);
  float hs = 0.f;
  f32x4 cur[4];
#pragma unroll
  for (int q = 0; q < 4; ++q) cur[q] = (f32x4){0.f, 0.f, 0.f, 0.f};
  EX9_GEN(uA, vA, scA, wqA, kA, lastA, validA)
  EX9_GEN(uB, vB, scB, wqB, kB, lastB, validB)
#pragma unroll 1
  for (;;) {
    EX9_GEN(uC, vC, scC, wqC, kC, lastC, validC)
    EX9_COMPUTE(uA, vA, scA, wqA, kA, lastA, validA)
    EX9_GEN(uA, vA, scA, wqA, kA, lastA, validA)
    EX9_COMPUTE(uB, vB, scB, wqB, kB, lastB, validB)
    EX9_GEN(uB, vB, scB, wqB, kB, lastB, validB)
    EX9_COMPUTE(uC, vC, scC, wqC, kC, lastC, validC)
    if (!validA && !validB) break;
  }
  asm volatile("s_waitcnt lgkmcnt(0)" ::: "memory");
#pragma unroll
  for (int k = 0; k < 8; ++k) {
    const char* ar = smem + (wave * 8 + k) * LDXB + lane * 32;
    const uint4 a0 = *(const uint4*)ar, a1 = *(const uint4*)(ar + 16);
    const unsigned aw[8] = {a0.x, a0.y, a0.z, a0.w, a1.x, a1.y, a1.z, a1.w};
    float* xr = p.xres + (size_t)(t0 + wave * 8 + k) * 1024 + lane * 16;
#pragma unroll
    for (int i = 0; i < 4; ++i) {
      float4 x4 = *(float4*)(xr + 4 * i);
      const h2_t c0 = __builtin_bit_cast(h2_t, aw[2 * i]), c1 = __builtin_bit_cast(h2_t, aw[2 * i + 1]);
      x4.x += (float)c0[0]; x4.y += (float)c0[1]; x4.z += (float)c1[0]; x4.w += (float)c1[1];
      *(float4*)(xr + 4 * i) = x4;
    }
  }
}

#define XB_TMO      128
#define XB_XCNT(j)  (256  + 64 * (j))
#define XB_XSUB(j)  (1280 + 64 * (j))
#define XB_XGEN(j)  (2304 + 64 * (j))
#define XB_TOP      3328
#define XB_TOPGEN   3392
#define XCD_BAR_WORDS 3456
#define XB_SPIN_CAP (1u << 22)
#ifndef LAS
#define LAS __attribute__((address_space(3)))
#endif
__device__ __forceinline__ unsigned xb_ld(unsigned* p)              { return __hip_atomic_load(p, __ATOMIC_RELAXED, __HIP_MEMORY_SCOPE_AGENT); }
__device__ __forceinline__ unsigned xb_add(unsigned* p, unsigned v) { return __hip_atomic_fetch_add(p, v, __ATOMIC_RELAXED, __HIP_MEMORY_SCOPE_AGENT); }
__device__ __forceinline__ unsigned xb_xcc_id() { return (unsigned)__builtin_amdgcn_s_getreg((3 << 11) | 20) & 0xFu; }
#define XB_SPIN(cond, bar) do { unsigned _sp = 0; while (cond) { __builtin_amdgcn_s_sleep(1); \
    if ((++_sp & 255u) == 0u) { if (xb_ld(&(bar)[XB_TMO])) break; if (_sp > XB_SPIN_CAP) { atomicAdd(&(bar)[XB_TMO], 1u); break; } } } } while (0)
struct XcdBarrier { unsigned* bar; unsigned x; volatile LAS unsigned* st; };
__device__ __forceinline__ XcdBarrier xcd_barrier_post(unsigned* bar, volatile LAS unsigned* st, int tid) {
  XcdBarrier b; b.bar = bar; b.x = xb_xcc_id(); b.st = st;
  if (tid == 0) (void)xb_add(&bar[XB_XCNT(b.x)], 1u);
  return b;
}
__device__ __forceinline__ void xcd_barrier_complete(unsigned* bar, unsigned x, unsigned& nloc, unsigned& nx) {
  const unsigned G = gridDim.x * gridDim.y * gridDim.z;
  unsigned sum, cnt, mine, sp = 0u;
  for (;;) {
    sum = 0u; cnt = 0u; mine = 0u;
#pragma unroll
    for (unsigned j = 0; j < 16; ++j) { const unsigned c = xb_ld(&bar[XB_XCNT(j)]); sum += c; cnt += (c > 0u) ? 1u : 0u; mine = (j == x) ? c : mine; }
    if (sum == G) break;
    __builtin_amdgcn_s_sleep(1);
    if ((++sp & 255u) == 0u) { if (xb_ld(&bar[XB_TMO])) break; if (sp > XB_SPIN_CAP) { atomicAdd(&bar[XB_TMO], 1u); break; } }
  }
  nloc = mine > 0u ? mine : 1u; nx = cnt > 0u ? cnt : 1u;
}
__device__ __forceinline__ void xcd_barrier(const XcdBarrier& b, int tid) {
  asm volatile("s_waitcnt vmcnt(0)" ::: "memory");
  __syncthreads();
  if (tid == 0) {
    unsigned* bar = b.bar;
    __builtin_amdgcn_s_waitcnt(0);
    unsigned nloc = b.st[0], nx = b.st[1];
    if (nloc == 0u) { xcd_barrier_complete(bar, b.x, nloc, nx); b.st[0] = nloc; b.st[1] = nx; }
    const unsigned old = xb_add(&bar[XB_XSUB(b.x)], 1u);
    const unsigned gen = old / nloc;
    if (old + 1u == (gen + 1u) * nloc) {
      __builtin_amdgcn_fence(__ATOMIC_RELEASE, "agent");
      asm volatile("s_waitcnt vmcnt(0)" ::: "memory");
      const unsigned og = xb_add(&bar[XB_TOP], 1u);
      const unsigned tg = og / nx;
      if (og + 1u == (tg + 1u) * nx) xb_add(&bar[XB_TOPGEN], 1u);
      else XB_SPIN(xb_ld(&bar[XB_TOPGEN]) == tg, bar);
      __builtin_amdgcn_fence(__ATOMIC_ACQUIRE, "agent");
      xb_add(&bar[XB_XGEN(b.x)], 1u);
      asm volatile("s_waitcnt vmcnt(0)" ::: "memory");
    } else {
      XB_SPIN(xb_ld(&bar[XB_XGEN(b.x)]) == gen, bar);
      __builtin_amdgcn_fence(__ATOMIC_ACQUIRE, "agent");
      asm volatile("s_waitcnt vmcnt(0)" ::: "memory");
    }
  }
  __syncthreads();
}


__global__ void __launch_bounds__(NTHREADS) fwd_megakernel(Params p) {
  cg::grid_group grid = cg::this_grid();
  extern __shared__ __attribute__((aligned(16))) float smem[];
  const int wv_ = __builtin_amdgcn_readfirstlane((int)(threadIdx.x >> 6));
  volatile LAS unsigned* xb_st = (volatile LAS unsigned*)((LAS char*)(LAS float*)smem + (160 * 1024 - 16));
  if (threadIdx.x == 0) { xb_st[0] = 0u; xb_st[1] = 0u; }
  __syncthreads();
  const XcdBarrier xb = xcd_barrier_post(p.bar, xb_st, (int)threadIdx.x);
#define GRID_BARRIER() xcd_barrier(xb, opaque_tid(wv_))

  o_prep(wv_, p, smem);
  if (gridDim.x > 4096u) grid.sync();
  GRID_BARRIER();
#pragma unroll 1
  for (int l = 0; l < DEPTH; ++l) {
    const float* xcur = (l == 0) ? p.x_in : p.xres;
    o_p1(wv_, p, l, xcur, (char*)smem);
    GRID_BARRIER();
    {
    {
      const int bidx_ = opaque_bid();
      const bool affine = (gridDim.x == 256u);
      for (int task = bidx_; task < 1792; task += gridDim.x) {
        const int l_ = opaque_s(l), td_ = opaque_tid(wv_);
        int tk = task;
        if (affine) {
          const int x = bidx_ & 7, lb = bidx_ >> 3, j = task >> 8;
          if (j < 4) { const int idx = lb + 32 * j; tk = ((x * 2 + (idx >> 6)) << 6) | (idx & 63); }
          else if (j < 6) { const int idx = lb + 32 * (j - 4); tk = 1024 + (((x * 2 + (idx >> 5)) << 5) | (idx & 31)); }
          else tk = 1536 + x * 32 + lb;
        }
        const int tk_ = opaque_s(tk);
        if (tk_ < 1024) o_na_task(p, l_, tk_, (char*)smem, td_);
        else if (tk_ < 1536) o_ret_kv_task(p, l_, tk_ - 1024, (char*)smem, td_);
        else o_pool_task(p, l_, tk_ - 1536, (char*)smem, td_);
      }
    }
    GRID_BARRIER();
    o_ret_scan(wv_, p, l);
    GRID_BARRIER();
    {
      const int tidx_ = opaque_tid(wv_); const int bidx_ = opaque_bid();
      for (int task = bidx_; task < 512; task += gridDim.x) {
        int tk = task;
        if (gridDim.x == 256u) {
          const int x = bidx_ & 7, lb = bidx_ >> 3, idx = lb + 32 * (task >> 8);
          tk = ((x * 2 + (idx >> 5)) << 5) | (idx & 31);
        }
        o_ret_out_task(p, l, opaque_s(tk), (char*)smem, tidx_);
      }
    }
    GRID_BARRIER();
    }
    {
      const int tidx_ = opaque_tid(wv_); const int bidx_ = opaque_bid();
      for (int tile = bidx_; tile < NTOK / 64; tile += gridDim.x) {
        { const int t0_ = opaque_s(tile * 64), l_ = opaque_s(l), td_ = opaque_tid(wv_); o_p5a1_tile(p, l_, t0_, (char*)smem, td_); }
        { const int t0_ = opaque_s(tile * 64), l_ = opaque_s(l), td_ = opaque_tid(wv_); o_p5a2_tile(p, l_, xcur, t0_, (char*)smem, td_); }
        { const int t0_ = opaque_s(tile * 64), l_ = opaque_s(l), td_ = opaque_tid(wv_); o_p5a3_tile(p, l_, t0_, (char*)smem, td_); }
        { const int t0_ = opaque_s(tile * 64), l_ = opaque_s(l), td_ = opaque_tid(wv_); o_peer_select_tile(p, l_, t0_, (char*)smem, td_); }
        { const int t0_ = opaque_s(tile * 64), l_ = opaque_s(l), td_ = opaque_tid(wv_); o_peer_select2_tile(p, l_, t0_, td_); }
        asm volatile("s_waitcnt vmcnt(0)" ::: "memory");
        __syncthreads();
        { const int t0_ = opaque_s(tile * 64), l_ = opaque_s(l), td_ = opaque_tid(wv_); o_peer_experts9_tile(p, l_, t0_, (char*)smem, td_); }
        if (l + 1 == DEPTH) {
          asm volatile("s_waitcnt vmcnt(0)" ::: "memory");
          const int t0_ = opaque_s(tile * 64), td_ = opaque_tid(wv_);
          o_final_norm_tile(p, t0_, td_);
        }
      }
    }
    if (l + 1 < DEPTH) GRID_BARRIER();
  }
}

extern "C" void kernel_launch(void* const* d_in, const int* in_sizes, int n_in, void* d_out, int out_size,
                              void* d_ws, size_t ws_size, hipStream_t stream) {
  Params p{};
  p.x_in = (const float*)d_in[0]; p.norm_mix = (const float*)d_in[1]; p.w_in = (const float*)d_in[2];
  p.pool_w = (const float*)d_in[3]; p.pool_scale = (const float*)d_in[4]; p.ret_decay = (const float*)d_in[5];
  p.na_rpb = (const float*)d_in[6]; p.w_br_pool = (const float*)d_in[7]; p.w_br_ret = (const float*)d_in[8];
  p.w_br_na = (const float*)d_in[9]; p.w_out = (const float*)d_in[10]; p.norm_ffn = (const float*)d_in[11];
  p.w_query = (const float*)d_in[12]; p.sub_keys = (const float*)d_in[13]; p.peer_u = (const float*)d_in[14];
  p.peer_v = (const float*)d_in[15]; p.norm_final = (const float*)d_in[16];
  p.out = (float*)d_out;
  char* ws = (char*)d_ws;
  size_t off = 0;
  auto alloc = [&](size_t bytes) { char* q = ws + off; off += (bytes + 255) & ~(size_t)255; return q; };
  p.xres = (float*)alloc((size_t)NTOK * D_MODEL * 4);
  p.proj = (bf16_t*)alloc((size_t)NTOK * IN_WIDTH * 2);
  p.ycat = (bf16_t*)alloc((size_t)NTOK * 1024 * 2);
  p.mrg = (bf16_t*)alloc((size_t)NTOK * 1024 * 2);
  p.pidx = (int*)alloc((size_t)NTOK * 128 * 4);
  p.pgate = (float*)alloc((size_t)NTOK * 128 * 4);
  p.wf_in = (bf16_t*)alloc((size_t)DEPTH * D_MODEL * IN_WIDTH * 2);
  p.wf_br = (bf16_t*)alloc((size_t)DEPTH * 1024 * 1024 * 2);
  p.wf_out = (bf16_t*)alloc((size_t)DEPTH * 1024 * 1024 * 2);
  p.wf_q = (bf16_t*)alloc((size_t)DEPTH * 1024 * 2048 * 2);
  p.kf = (bf16_t*)alloc((size_t)DEPTH * 2 * 128 * 128 * 2);
  p.u16 = nullptr; p.v16 = nullptr;
  p.u8 = (unsigned char*)alloc((size_t)DEPTH * 16384 * 1024);
  p.v8 = (unsigned char*)alloc((size_t)DEPTH * 16384 * 1024);
  p.escale = (float2*)alloc((size_t)DEPTH * 16384 * 8);
  p.rope = (float2*)alloc((size_t)SEQ * 32 * 8);
  p.tklist = (unsigned*)alloc((size_t)NTOK * 8 * 2 * 16 * 4);
  p.kvst = (float*)p.mrg;
  p.rstate = (bf16_t*)p.tklist;
  p.bar = (unsigned*)alloc(XCD_BAR_WORDS * 4);
  p.xn = nullptr; p.merged = nullptr; p.pq = nullptr; p.psc = nullptr;
  if (off > ws_size) fprintf(stderr, "WORKSPACE OVERFLOW: need %zu have %zu\n", off, ws_size);

  const size_t kDynLds = 160 * 1024;
  static int grid_blocks = 0;
  if (!grid_blocks) {
    int dev = 0, cus = 0, per_cu = 0;
    (void)hipGetDevice(&dev);
    (void)hipDeviceGetAttribute(&cus, hipDeviceAttributeMultiprocessorCount, dev);
    (void)hipFuncSetAttribute((const void*)fwd_megakernel, hipFuncAttributeMaxDynamicSharedMemorySize, (int)kDynLds);
    (void)hipOccupancyMaxActiveBlocksPerMultiprocessor(&per_cu, fwd_megakernel, NTHREADS, kDynLds);
    if (per_cu < 1) per_cu = 1;
    grid_blocks = cus * per_cu;
  }
  (void)hipMemsetAsync(p.bar, 0, XCD_BAR_WORDS * 4, stream);
  void* args[] = {&p};
  hipError_t e = hipLaunchCooperativeKernel((void*)fwd_megakernel, dim3(grid_blocks), dim3(NTHREADS), args, kDynLds, stream);
  if (e != hipSuccess) fprintf(stderr, "cooperative launch failed: %s (grid %d)\n", hipGetErrorString(e), grid_blocks);
}
```

```cpp
#include <hip/hip_runtime.h>
#include <hip/hip_cooperative_groups.h>
#include <stdint.h>
#include <cstdio>
namespace cg = cooperative_groups;

#define D_MODEL 1024
#define SEQ 4096
#define BATCH 4
#define NTOK (BATCH * SEQ)
#define DEPTH 2
#define IN_WIDTH 5632
#define C_POOL 0
#define C_RQ 256
#define C_RK 512
#define C_RV 768
#define C_RG 1280
#define C_NQ 1792
#define C_NK 2048
#define C_NV 2304
#define C_GATE 2560
#define EPS 1e-6f
#define NTHREADS 512

typedef unsigned short bf16_t;

struct Params {
  const float* x_in; const float* norm_mix; const float* w_in; const float* pool_w; const float* pool_scale;
  const float* ret_decay; const float* na_rpb; const float* w_br_pool; const float* w_br_ret; const float* w_br_na;
  const float* w_out; const float* norm_ffn; const float* w_query; const float* sub_keys; const float* peer_u;
  const float* peer_v; const float* norm_final;
  float* out;
  float* xres;
  bf16_t* xn;
  bf16_t* proj;
  bf16_t* ycat;
  float* merged;
  float* pq;
  float* psc;
  int* pidx;
  float* pgate;
  bf16_t* wf_in;
  bf16_t* wf_br;
  bf16_t* wf_out;
  bf16_t* wf_q;
  bf16_t* kf;
  bf16_t* u16;
  bf16_t* v16;
  float2* rope;
  bf16_t* mrg;
  unsigned* tklist;
  float* kvst;
  bf16_t* rstate;
  unsigned* bar;
  unsigned char* u8; unsigned char* v8;
  float2* escale;
};

__device__ __forceinline__ bf16_t f2bf(float f) {
  unsigned u = __float_as_uint(f);
  u += 0x7fffu + ((u >> 16) & 1u);
  return (bf16_t)(u >> 16);
}
__device__ __forceinline__ float bf2f(bf16_t h) { return __uint_as_float(((unsigned)h) << 16); }

__device__ __forceinline__ float wave_sum(float v) {
#pragma unroll
  for (int o = 32; o > 0; o >>= 1) v += __shfl_xor(v, o, 64);
  return v;
}
__device__ __forceinline__ float wave_max(float v) {
#pragma unroll
  for (int o = 32; o > 0; o >>= 1) v = fmaxf(v, __shfl_xor(v, o, 64));
  return v;
}
__device__ __forceinline__ float sigmoidf_(float x) { return 1.0f / (1.0f + expf(-x)); }

__device__ __forceinline__ int opaque_tid(int wv) {
  int w = wv;
  asm volatile("" : "+s"(w));
  int lane = __builtin_amdgcn_mbcnt_hi(~0u, __builtin_amdgcn_mbcnt_lo(~0u, 0u));
  asm volatile("" : "+v"(lane));
  return w * 64 + lane;
}
__device__ __forceinline__ int opaque_s(int x) { asm volatile("" : "+s"(x)); return x; }
__device__ __forceinline__ int opaque_bid() { int b = blockIdx.x; asm volatile("" : "+s"(b)); return b; }

template <bool OUT_F32>
__device__ __forceinline__ void n_rmsnorm(const int wv_, const float* __restrict__ x, const float* __restrict__ g, void* outp, int rows) {
  const int tidx_ = opaque_tid(wv_); const int bidx_ = opaque_bid();
  const int lane = tidx_ & 63;
  const int nw = gridDim.x * (NTHREADS / 64);
  for (int row = bidx_ * (NTHREADS / 64) + (tidx_ >> 6); row < rows; row += nw) {
    const float* xr = x + (size_t)row * D_MODEL;
    float4 v[4];
    float ss = 0.f;
#pragma unroll
    for (int i = 0; i < 4; ++i) {
      v[i] = *(const float4*)(xr + i * 256 + lane * 4);
      ss += v[i].x * v[i].x + v[i].y * v[i].y + v[i].z * v[i].z + v[i].w * v[i].w;
    }
    ss = wave_sum(ss);
    float r = rsqrtf(ss * (1.0f / D_MODEL) + EPS);
#pragma unroll
    for (int i = 0; i < 4; ++i) {
      float4 gg = *(const float4*)(g + i * 256 + lane * 4);
      float o0 = v[i].x * r * gg.x, o1 = v[i].y * r * gg.y, o2 = v[i].z * r * gg.z, o3 = v[i].w * r * gg.w;
      if (OUT_F32) {
        *(float4*)((float*)outp + (size_t)row * D_MODEL + i * 256 + lane * 4) = make_float4(o0, o1, o2, o3);
      } else {
        ushort4 o; o.x = f2bf(o0); o.y = f2bf(o1); o.z = f2bf(o2); o.w = f2bf(o3);
        *(ushort4*)((bf16_t*)outp + (size_t)row * D_MODEL + i * 256 + lane * 4) = o;
      }
    }
  }
}

typedef __attribute__((ext_vector_type(8))) short bf16x8;
typedef __attribute__((ext_vector_type(4))) float f32x4;
#define LDX 1032
#define LDXB (LDX * 2)
#define XTILE_BYTES (64 * LDXB)

__device__ __forceinline__ unsigned pack2bf(float a, float b) { return (unsigned)f2bf(a) | ((unsigned)f2bf(b) << 16); }

__device__ __forceinline__ void prep_frag(const int wv_, const float* __restrict__ W, int K, int N, bf16_t* __restrict__ dst, float* smem) {
  const int tidx_ = opaque_tid(wv_); const int bidx_ = opaque_bid();
  const int grp = tidx_ >> 8, tid = tidx_ & 255;
  float(*T)[65] = (float(*)[65])(smem + grp * 32 * 65);
  const int KS = K / 32, NC = N / 64;
  const int ntiles = KS * NC;
  for (int wb = bidx_ * 2; wb < ntiles; wb += gridDim.x * 2) {
    const int w = wb + grp;
    const int c = w / KS, ks = w - c * KS;
    {
      const int row = tid >> 3, col = (tid & 7) * 8;
      const float* src = W + (size_t)(ks * 32 + row) * N + c * 64 + col;
      float4 a = *(const float4*)src, b = *(const float4*)(src + 4);
      __syncthreads();
      T[row][col + 0] = a.x; T[row][col + 1] = a.y; T[row][col + 2] = a.z; T[row][col + 3] = a.w;
      T[row][col + 4] = b.x; T[row][col + 5] = b.y; T[row][col + 6] = b.z; T[row][col + 7] = b.w;
    }
    __syncthreads();
    {
      const int nt = tid >> 6, lane = tid & 63;
      const int kr = 8 * (lane >> 4), nc = nt * 16 + (lane & 15);
      uint4 o;
      o.x = pack2bf(T[kr + 0][nc], T[kr + 1][nc]);
      o.y = pack2bf(T[kr + 2][nc], T[kr + 3][nc]);
      o.z = pack2bf(T[kr + 4][nc], T[kr + 5][nc]);
      o.w = pack2bf(T[kr + 6][nc], T[kr + 7][nc]);
      *(uint4*)(dst + ((size_t)((c * KS + ks) * 4 + nt) * 64 + lane) * 8) = o;
    }
  }
}

__device__ __forceinline__ void o_prep(const int wv_, const Params& p, float* smem) {
  for (int l = 0; l < DEPTH; ++l) {
    prep_frag(wv_, p.w_in + (size_t)l * D_MODEL * IN_WIDTH, D_MODEL, IN_WIDTH, p.wf_in + (size_t)l * D_MODEL * IN_WIDTH, smem);
    prep_frag(wv_, p.w_br_pool + (size_t)l * 256 * 1024, 256, 1024, p.wf_br + (size_t)l * 1024 * 1024, smem);
    prep_frag(wv_, p.w_br_ret + (size_t)l * 512 * 1024, 512, 1024, p.wf_br + (size_t)l * 1024 * 1024 + 256 * 1024, smem);
    prep_frag(wv_, p.w_br_na + (size_t)l * 256 * 1024, 256, 1024, p.wf_br + (size_t)l * 1024 * 1024 + 768 * 1024, smem);
    prep_frag(wv_, p.w_out + (size_t)l * 1024 * 1024, 1024, 1024, p.wf_out + (size_t)l * 1024 * 1024, smem);
    prep_frag(wv_, p.w_query + (size_t)l * 1024 * 2048, 1024, 2048, p.wf_q + (size_t)l * 1024 * 2048, smem);
  }
  const int tidx_ = opaque_tid(wv_); const int bidx_ = opaque_bid();
  const int gtid = bidx_ * NTHREADS + tidx_, gsz = gridDim.x * NTHREADS;
  for (int u = gtid; u < DEPTH * 2 * 8 * 4 * 64; u += gsz) {
    const int lane = u & 63, s2 = (u >> 6) & 3, kt = (u >> 8) & 7, lp = u >> 11;
    const float* kr = p.sub_keys + ((size_t)lp * 128 + kt * 16 + (lane & 15)) * 128;
    float v[8];
#pragma unroll
    for (int j = 0; j < 8; ++j) v[j] = kr[16 * (2 * s2 + (j >> 2)) + 4 * (lane >> 4) + (j & 3)];
    uint4 o;
    o.x = pack2bf(v[0], v[1]); o.y = pack2bf(v[2], v[3]); o.z = pack2bf(v[4], v[5]); o.w = pack2bf(v[6], v[7]);
    *(uint4*)(p.kf + (size_t)u * 8) = o;
  }
  {
    const int lane = tidx_ & 63;
    const int gw = (bidx_ * NTHREADS + tidx_) >> 6, nw = gsz >> 6;
    for (int row = gw; row < DEPTH * 16384 * 2; row += nw) {
      const int tbl = row & 1, er = row >> 1;
      const float* src = (tbl ? p.peer_v : p.peer_u) + (size_t)er * 1024 + lane * 16;
      float4 f[4];
#pragma unroll
      for (int i = 0; i < 4; ++i) f[i] = *(const float4*)(src + 4 * i);
      float m = 0.f;
#pragma unroll
      for (int i = 0; i < 4; ++i) m = fmaxf(m, fmaxf(fmaxf(fabsf(f[i].x), fabsf(f[i].y)), fmaxf(fabsf(f[i].z), fabsf(f[i].w))));
      m = wave_max(m);
      int k = 0;
      if (m > 0.f) {
        int e;
        const float fr = __builtin_frexpf(m, &e);
        k = ((fr <= 0.875f) ? 9 : 8) - e;
        k = k < -100 ? -100 : (k > 100 ? 100 : k);
      }
      const float sc = __builtin_ldexpf(1.0f, k);
      uint4 o;
      unsigned w[4];
#pragma unroll
      for (int i = 0; i < 4; ++i) {
        int pkd = 0;
        pkd = __builtin_amdgcn_cvt_pk_fp8_f32(f[i].x * sc, f[i].y * sc, pkd, false);
        pkd = __builtin_amdgcn_cvt_pk_fp8_f32(f[i].z * sc, f[i].w * sc, pkd, true);
        w[i] = (unsigned)pkd;
      }
      o.x = w[0]; o.y = w[1]; o.z = w[2]; o.w = w[3];
      *(uint4*)((tbl ? p.v8 : p.u8) + (size_t)er * 1024 + lane * 16) = o;
      if (lane == 0) ((float*)p.escale)[(size_t)er * 2 + tbl] = __builtin_ldexpf(1.0f, -k);
    }
  }
  for (int u = gtid; u < SEQ * 32; u += gsz) {
    const int i = u & 31, pos = u >> 5;
    float inv = 1.0f / powf(10000.0f, (float)i / 31.0f);
    float ang = (float)pos * inv;
    double rev = (double)ang * 0.15915494309189535;
    rev -= floor(rev);
    float rf = (float)rev;
    p.rope[u] = make_float2(__builtin_amdgcn_cosf(rf), __builtin_amdgcn_sinf(rf));
  }
}

template <int NT, int PD, int RING>
__device__ __forceinline__ void tl_gemm_prologue(const bf16_t* __restrict__ wf, bf16x8 (&wb)[RING][NT], const int lane, const int nt0 = 0) {
  const bf16x8* wp = (const bf16x8*)wf + lane + nt0 * 64;
#pragma unroll
  for (int s = 0; s < PD; ++s)
#pragma unroll
    for (int nt = 0; nt < NT; ++nt) wb[s][nt] = wp[(s * 4 + nt) * 64];
}
template <int NT, int PD, int RING>
__device__ __forceinline__ void tl_gemm_main(const bf16_t* __restrict__ wf, const int KS, const char* xt, const int kbyte0,
                                             f32x4 (&acc)[NT][4], bf16x8 (&wb)[RING][NT], const int lane, const int nt0 = 0) {
  const bf16x8* wp = (const bf16x8*)wf + lane + nt0 * 64;
  const char* xp = xt + (lane & 15) * LDXB + kbyte0 + (lane >> 4) * 16;
  for (int ks = 0; ks < KS; ks += RING) {
#pragma unroll
    for (int u = 0; u < RING; ++u) {
      int kpre = ks + u + PD;
      kpre = kpre < KS ? kpre : KS - 1;
#pragma unroll
      for (int nt = 0; nt < NT; ++nt) wb[(u + PD) % RING][nt] = wp[(kpre * 4 + nt) * 64];
      __builtin_amdgcn_s_setprio(1);
      bf16x8 xf[4];
#pragma unroll
      for (int mt = 0; mt < 4; ++mt) xf[mt] = *(const bf16x8*)(xp + mt * 16 * LDXB + (ks + u) * 64);
#pragma unroll
      for (int nt = 0; nt < NT; ++nt)
#pragma unroll
        for (int mt = 0; mt < 4; ++mt)
          acc[nt][mt] = __builtin_amdgcn_mfma_f32_16x16x32_bf16(wb[u][nt], xf[mt], acc[nt][mt], 0, 0, 0);
      __builtin_amdgcn_s_setprio(0);
    }
  }
}
template <int NT, int PD = 3, int RING = 4>
__device__ __forceinline__ void tl_gemm_chunk(const bf16_t* __restrict__ wf, const int KS, const char* xt, const int kbyte0,
                                              f32x4 (&acc)[NT][4], const int lane, const int nt0 = 0) {
  bf16x8 wb[RING][NT];
  tl_gemm_prologue<NT, PD, RING>(wf, wb, lane, nt0);
  tl_gemm_main<NT, PD, RING>(wf, KS, xt, kbyte0, acc, wb, lane, nt0);
}

__device__ __forceinline__ void tile_rmsnorm_to_lds(const float* __restrict__ xsrc, const float* __restrict__ g, int t0,
                                                    char* xt, int wave, int lane) {
#pragma unroll 2
  for (int i = 0; i < 8; ++i) {
    const int tok = wave * 8 + i;
    const float* xr = xsrc + (size_t)(t0 + tok) * D_MODEL;
    float4 v[4];
    float ss = 0.f;
#pragma unroll
    for (int q = 0; q < 4; ++q) {
      v[q] = *(const float4*)(xr + q * 256 + lane * 4);
      ss += v[q].x * v[q].x + v[q].y * v[q].y + v[q].z * v[q].z + v[q].w * v[q].w;
    }
    ss = wave_sum(ss);
    const float r = rsqrtf(ss * (1.0f / D_MODEL) + EPS);
#pragma unroll
    for (int q = 0; q < 4; ++q) {
      float4 gg = *(const float4*)(g + q * 256 + lane * 4);
      uint2 o;
      o.x = pack2bf(v[q].x * r * gg.x, v[q].y * r * gg.y);
      o.y = pack2bf(v[q].z * r * gg.z, v[q].w * r * gg.w);
      *(uint2*)(xt + tok * LDXB + (q * 256 + lane * 4) * 2) = o;
    }
  }
}

__device__ __forceinline__ void o_p1(const int wv_, const Params& p, int l, const float* __restrict__ xsrc, char* smem) {
  const int tidx_ = opaque_tid(wv_); const int bidx_ = opaque_bid();
  const int wave = tidx_ >> 6, lane = tidx_ & 63;
  const bf16_t* wf = p.wf_in + (size_t)l * D_MODEL * IN_WIDTH;
  const float* g = p.norm_mix + l * D_MODEL;
  for (int tile = bidx_; tile < NTOK / 64; tile += gridDim.x) {
    const int t0 = tile * 64;
    __syncthreads();
    tile_rmsnorm_to_lds(xsrc, g, t0, smem, wave, lane);
    __syncthreads();
#pragma unroll 1
    for (int c = wave; c < IN_WIDTH / 64; c += 8) {
      f32x4 acc[4][4];
#pragma unroll
      for (int a = 0; a < 4; ++a)
#pragma unroll
        for (int b = 0; b < 4; ++b) acc[a][b] = (f32x4){0.f, 0.f, 0.f, 0.f};
      tl_gemm_chunk<4, 3, 4>(wf + (size_t)c * 32 * 4 * 64 * 8, 32, smem, 0, acc, lane);
      asm volatile("" ::: "memory");
      if (c >= 4 && c < 12) {
        const float sc = (c >= 8) ? 0.125f : 1.0f;
#pragma unroll
        for (int mt = 0; mt < 4; ++mt) {
          const int tok = t0 + mt * 16 + (lane & 15);
          const int pos = tok & (SEQ - 1);
#pragma unroll
          for (int nt = 0; nt < 2; ++nt) {
            const int i0 = nt * 16 + 4 * (lane >> 4);
            const float4 cs01 = *(const float4*)(p.rope + pos * 32 + i0);
            const float4 cs23 = *(const float4*)(p.rope + pos * 32 + i0 + 2);
            const float cc[4] = {cs01.x, cs01.z, cs23.x, cs23.z};
            const float sn[4] = {cs01.y, cs01.w, cs23.y, cs23.w};
#pragma unroll
            for (int r = 0; r < 4; ++r) {
              const float x1 = acc[nt][mt][r], x2 = acc[nt + 2][mt][r];
              acc[nt][mt][r] = (x1 * cc[r] - x2 * sn[r]) * sc;
              acc[nt + 2][mt][r] = (x1 * sn[r] + x2 * cc[r]) * sc;
            }
          }
        }
      } else if (c >= 28 && c < 32) {
#pragma unroll
        for (int a = 0; a < 4; ++a)
#pragma unroll
          for (int b = 0; b < 4; ++b) acc[a][b] *= 0.125f;
      } else if (c >= 40) {
#pragma unroll
        for (int a = 0; a < 4; ++a)
#pragma unroll
          for (int b = 0; b < 4; ++b)
#pragma unroll
            for (int r = 0; r < 4; ++r) acc[a][b][r] = 1.0f / (1.0f + __expf(-acc[a][b][r]));
      }
      {
        char* patch = smem + XTILE_BYTES + wave * 2304;
#pragma unroll
        for (int mt = 0; mt < 4; ++mt) {
#pragma unroll
          for (int nt = 0; nt < 4; ++nt) {
            uint2 o;
            o.x = pack2bf(acc[nt][mt][0], acc[nt][mt][1]);
            o.y = pack2bf(acc[nt][mt][2], acc[nt][mt][3]);
            *(uint2*)(patch + (lane & 15) * 144 + (nt * 16 + 4 * (lane >> 4)) * 2) = o;
          }
#pragma unroll
          for (int h = 0; h < 2; ++h) {
            const int row = h * 8 + (lane >> 3), unit = lane & 7;
            const uint4 v = *(const uint4*)(patch + row * 144 + unit * 16);
            *(uint4*)(p.proj + (size_t)(t0 + mt * 16 + row) * IN_WIDTH + c * 64 + unit * 8) = v;
          }
        }
      }
    }
  }
}


__device__ __forceinline__ void o_final_norm_tile(const Params& p, int t0, int tid) {
  const int wave = tid >> 6, lane = tid & 63;
#pragma unroll 2
  for (int i = 0; i < 8; ++i) {
    const size_t row = (size_t)(t0 + wave * 8 + i) * D_MODEL;
    float4 v[4];
    float ss = 0.f;
#pragma unroll
    for (int q = 0; q < 4; ++q) {
      v[q] = *(const float4*)(p.xres + row + q * 256 + lane * 4);
      ss += v[q].x * v[q].x + v[q].y * v[q].y + v[q].z * v[q].z + v[q].w * v[q].w;
    }
    ss = wave_sum(ss);
    const float r = rsqrtf(ss * (1.0f / D_MODEL) + EPS);
#pragma unroll
    for (int q = 0; q < 4; ++q) {
      const float4 gg = *(const float4*)(p.norm_final + q * 256 + lane * 4);
      *(float4*)(p.out + row + q * 256 + lane * 4) = make_float4(v[q].x * r * gg.x, v[q].y * r * gg.y, v[q].z * r * gg.z, v[q].w * r * gg.w);
    }
  }
}

__device__ __forceinline__ void tile_load_to_lds(const bf16_t* __restrict__ src, int ld, char* xt, int tid) {
#pragma unroll 4
  for (int it = 0; it < 16; ++it) {
    const int idx = it * NTHREADS + tid;
    const int row = idx >> 7, u = idx & 127;
    const uint4 v = *(const uint4*)(src + (size_t)row * ld + u * 8);
    *(uint4*)(xt + row * LDXB + u * 16) = v;
  }
}

__device__ __forceinline__ void o_p5a1_tile(const Params& p, int l, int t0, char* smem, int tid) {
  const int wave = tid >> 6, lane = tid & 63;
  __syncthreads();
  tile_load_to_lds(p.ycat + (size_t)t0 * 1024, 1024, smem, tid);
  __syncthreads();
  const bf16_t* wfb = p.wf_br + (size_t)l * 1024 * 1024;
  bf16x8 wb[4][2];
  f32x4 m[2][4];
  {
    const int c0 = wave >> 1, nt00 = (wave & 1) * 2;
    tl_gemm_prologue<2, 3, 4>(wfb + (size_t)c0 * 8 * 4 * 64 * 8, wb, lane, nt00);
  }
#pragma unroll 1
  for (int it = 0; it < 12; ++it) {
    const int hi = it / 3, br = it - hi * 3;
    const int hc = wave + 8 * hi;
    const int c = hc >> 1, nt0 = (hc & 1) * 2;
    const int koff = (br == 0) ? 0 : (br == 1 ? 256 : 768);
    const int KS = (br == 1) ? 16 : 8;
    uint2 gv[4][2];
#pragma unroll
    for (int mt = 0; mt < 4; ++mt) {
      const int tok = t0 + mt * 16 + (lane & 15);
      const bf16_t* gp = p.proj + (size_t)tok * IN_WIDTH + C_GATE + br * 1024 + c * 64 + nt0 * 16 + 4 * (lane >> 4);
#pragma unroll
      for (int nt = 0; nt < 2; ++nt) gv[mt][nt] = *(const uint2*)(gp + nt * 16);
    }
    f32x4 acc[2][4];
#pragma unroll
    for (int a2 = 0; a2 < 2; ++a2)
#pragma unroll
      for (int b2 = 0; b2 < 4; ++b2) acc[a2][b2] = (f32x4){0.f, 0.f, 0.f, 0.f};
    tl_gemm_main<2, 3, 4>(wfb + (size_t)koff * 1024 + (size_t)c * KS * 4 * 64 * 8, KS, smem, koff * 2, acc, wb, lane, nt0);
    asm volatile("" ::: "memory");
    {
      const int itn = (it + 1 < 12) ? it + 1 : it;
      const int hin = itn / 3, brn = itn - hin * 3;
      const int hcn = wave + 8 * hin;
      const int koffn = (brn == 0) ? 0 : (brn == 1 ? 256 : 768);
      const int KSn = (brn == 1) ? 16 : 8;
      tl_gemm_prologue<2, 3, 4>(wfb + (size_t)koffn * 1024 + (size_t)(hcn >> 1) * KSn * 4 * 64 * 8, wb, lane, (hcn & 1) * 2);
    }
    if (br == 0) {
#pragma unroll
      for (int a2 = 0; a2 < 2; ++a2)
#pragma unroll
        for (int b2 = 0; b2 < 4; ++b2) m[a2][b2] = (f32x4){0.f, 0.f, 0.f, 0.f};
    }
#pragma unroll
    for (int mt = 0; mt < 4; ++mt)
#pragma unroll
      for (int nt = 0; nt < 2; ++nt) {
        m[nt][mt][0] += __uint_as_float(gv[mt][nt].x << 16) * acc[nt][mt][0];
        m[nt][mt][1] += __uint_as_float(gv[mt][nt].x & 0xffff0000u) * acc[nt][mt][1];
        m[nt][mt][2] += __uint_as_float(gv[mt][nt].y << 16) * acc[nt][mt][2];
        m[nt][mt][3] += __uint_as_float(gv[mt][nt].y & 0xffff0000u) * acc[nt][mt][3];
      }
    if (br == 2) {
#pragma unroll
      for (int mt = 0; mt < 4; ++mt) {
        const int tok = t0 + mt * 16 + (lane & 15);
        bf16_t* dst = p.mrg + (size_t)tok * 1024 + c * 64 + nt0 * 16 + 4 * (lane >> 4);
#pragma unroll
        for (int nt = 0; nt < 2; ++nt) {
          uint2 o;
          o.x = pack2bf(m[nt][mt][0], m[nt][mt][1]);
          o.y = pack2bf(m[nt][mt][2], m[nt][mt][3]);
          *(uint2*)(dst + nt * 16) = o;
        }
      }
    }
  }
}
__device__ __forceinline__ void o_p5a2_tile(const Params& p, int l, const float* __restrict__ xcur, int t0, char* smem, int tid) {
  const int wave = tid >> 6, lane = tid & 63;
  __syncthreads();
  tile_load_to_lds(p.mrg + (size_t)t0 * 1024, 1024, smem, tid);
  __syncthreads();
  const bf16_t* wfo = p.wf_out + (size_t)l * 1024 * 1024;
#pragma unroll 1
  for (int c = wave; c < 16; c += 8) {
    f32x4 acc[4][4];
#pragma unroll
    for (int a = 0; a < 4; ++a)
#pragma unroll
      for (int b = 0; b < 4; ++b) acc[a][b] = (f32x4){0.f, 0.f, 0.f, 0.f};
    tl_gemm_chunk<4, 2>(wfo + (size_t)c * 32 * 4 * 64 * 8, 32, smem, 0, acc, lane);
    asm volatile("" ::: "memory");
#pragma unroll
    for (int mt = 0; mt < 4; ++mt) {
      const int tok = t0 + mt * 16 + (lane & 15);
      const size_t o = (size_t)tok * 1024 + c * 64 + 4 * (lane >> 4);
#pragma unroll
      for (int nt = 0; nt < 4; ++nt) {
        float4 xv = *(const float4*)(xcur + o + nt * 16);
        xv.x += acc[nt][mt][0]; xv.y += acc[nt][mt][1]; xv.z += acc[nt][mt][2]; xv.w += acc[nt][mt][3];
        *(float4*)(p.xres + o + nt * 16) = xv;
      }
    }
  }
}
__device__ __forceinline__ void o_p5a3_tile(const Params& p, int l, int t0, char* smem, int tid) {
  const int wave = tid >> 6, lane = tid & 63;
  __syncthreads();
  tile_rmsnorm_to_lds(p.xres, p.norm_ffn + l * D_MODEL, t0, smem, wave, lane);
  __syncthreads();
}


__device__ __forceinline__ unsigned mono_f(float f) {
  unsigned u = __float_as_uint(f);
  return (u & 0x80000000u) ? ~u : (u | 0x80000000u);
}
__device__ __forceinline__ float unmono_f(unsigned m) {
  return __uint_as_float((m & 0x80000000u) ? (m & 0x7fffffffu) : ~m);
}
#define CE_DESC(x, y) { const unsigned hi_ = max(x, y); const unsigned lo_ = min(x, y); x = hi_; y = lo_; }
#define CE_ASC(x, y) { const unsigned hi_ = max(x, y); const unsigned lo_ = min(x, y); x = lo_; y = hi_; }
__device__ __forceinline__ void sort16_desc(unsigned (&a)[16]) {
#pragma unroll
  for (int k = 2; k <= 16; k <<= 1) {
#pragma unroll
    for (int j = k >> 1; j > 0; j >>= 1) {
#pragma unroll
      for (int i = 0; i < 16; ++i) {
        const int l = i ^ j;
        if (l > i) {
          if ((i & k) == 0) CE_DESC(a[i], a[l]) else CE_ASC(a[i], a[l])
        }
      }
    }
  }
}
__device__ __forceinline__ void bitonic_merge16_desc(unsigned (&a)[16]) {
#pragma unroll
  for (int j = 8; j > 0; j >>= 1) {
#pragma unroll
    for (int i = 0; i < 16; ++i) {
      const int l = i ^ j;
      if (l > i) CE_DESC(a[i], a[l])
    }
  }
}
__device__ __forceinline__ void xlane_merge16(unsigned (&a)[16], int mask) {
  unsigned b[16];
#pragma unroll
  for (int i = 0; i < 16; ++i) b[i] = (unsigned)__shfl_xor((int)a[i], mask, 64);
#pragma unroll
  for (int i = 0; i < 16; ++i) a[i] = max(a[i], b[15 - i]);
  bitonic_merge16_desc(a);
}

__device__ __forceinline__ void o_peer_select_tile(const Params& p, int l, int t0, char* smem, int tid) {
  const int h = __builtin_amdgcn_readfirstlane(tid >> 6), lane = tid & 63;
  const int g = lane >> 4, tl = lane & 15;
  const bf16_t* wfq = p.wf_q + (size_t)l * 1024 * 2048;
#pragma unroll 1
  for (int pp = 0; pp < 2; ++pp) {
    bf16x8 qf[4][4];
#pragma unroll 1
    for (int cc = 0; cc < 2; ++cc) {
      const int c = (h * 2 + pp) * 2 + cc;
      f32x4 acc[4][4];
#pragma unroll
      for (int a = 0; a < 4; ++a)
#pragma unroll
        for (int b = 0; b < 4; ++b) acc[a][b] = (f32x4){0.f, 0.f, 0.f, 0.f};
      tl_gemm_chunk<4, 2>(wfq + (size_t)c * 32 * 4 * 64 * 8, 32, smem, 0, acc, lane);
#pragma unroll
      for (int sl = 0; sl < 2; ++sl)
#pragma unroll
        for (int mt = 0; mt < 4; ++mt) {
          union { bf16x8 v; unsigned u[4]; } cv;
          cv.u[0] = pack2bf(acc[2 * sl][mt][0], acc[2 * sl][mt][1]);
          cv.u[1] = pack2bf(acc[2 * sl][mt][2], acc[2 * sl][mt][3]);
          cv.u[2] = pack2bf(acc[2 * sl + 1][mt][0], acc[2 * sl + 1][mt][1]);
          cv.u[3] = pack2bf(acc[2 * sl + 1][mt][2], acc[2 * sl + 1][mt][3]);
          if (cc == 0) qf[sl][mt] = cv.v; else qf[2 + sl][mt] = cv.v;
        }
    }
    const bf16x8* kfp = (const bf16x8*)p.kf + (size_t)((l * 2 + pp) * 8) * 4 * 64 + lane;
#pragma unroll
    for (int mp = 0; mp < 2; ++mp) {
      f32x4 sc2[2][8];
#pragma unroll
      for (int u = 0; u < 2; ++u)
#pragma unroll
        for (int kt = 0; kt < 8; ++kt) sc2[u][kt] = (f32x4){0.f, 0.f, 0.f, 0.f};
#pragma unroll
      for (int s2 = 0; s2 < 4; ++s2) {
        const bf16x8 qv0 = qf[s2][2 * mp], qv1 = qf[s2][2 * mp + 1];
#pragma unroll
        for (int kt = 0; kt < 8; ++kt) {
          const bf16x8 kv = kfp[(kt * 4 + s2) * 64];
          sc2[0][kt] = __builtin_amdgcn_mfma_f32_16x16x32_bf16(kv, qv0, sc2[0][kt], 0, 0, 0);
          sc2[1][kt] = __builtin_amdgcn_mfma_f32_16x16x32_bf16(kv, qv1, sc2[1][kt], 0, 0, 0);
        }
        __builtin_amdgcn_sched_barrier(0);
      }
#pragma unroll
      for (int u = 0; u < 2; ++u) {
        const int mt = 2 * mp + u;
        unsigned A[16], B[16];
#pragma unroll
        for (int kt = 0; kt < 4; ++kt)
#pragma unroll
          for (int r = 0; r < 4; ++r) {
            A[kt * 4 + r] = (mono_f(sc2[u][kt][r]) & ~127u) | (unsigned)(127 - (kt * 16 + r) - 4 * g);
            B[kt * 4 + r] = (mono_f(sc2[u][kt + 4][r]) & ~127u) | (unsigned)(127 - ((kt + 4) * 16 + r) - 4 * g);
          }
        sort16_desc(A);
        sort16_desc(B);
#pragma unroll
        for (int i = 0; i < 16; ++i) A[i] = max(A[i], B[15 - i]);
        bitonic_merge16_desc(A);
        xlane_merge16(A, 16);
        xlane_merge16(A, 32);
        if (g == 0) {
          uint4* dst = (uint4*)(p.tklist + ((size_t)((t0 + mt * 16 + tl) * 8 + h) * 2 + pp) * 16);
          dst[0] = make_uint4(A[0], A[1], A[2], A[3]);
          dst[1] = make_uint4(A[4], A[5], A[6], A[7]);
          dst[2] = make_uint4(A[8], A[9], A[10], A[11]);
          dst[3] = make_uint4(A[12], A[13], A[14], A[15]);
        }
        __builtin_amdgcn_sched_barrier(0);
      }
    }
  }
  asm volatile("s_waitcnt vmcnt(0)" ::: "memory");
}

__device__ __forceinline__ void o_peer_select2_tile(const Params& p, int l, int t0, int tid) {
  const int h = __builtin_amdgcn_readfirstlane(tid >> 6), lane = tid & 63;
  const int g = lane >> 4, tl = lane & 15;
#pragma unroll 1
  for (int mt = 0; mt < 4; ++mt) {
    const int tok = t0 + mt * 16 + tl;
    const unsigned* lp = p.tklist + ((size_t)(tok * 8 + h) * 2) * 16;
    float v1[16], v2[16];
    {
      const uint4* q4 = (const uint4*)lp;
#pragma unroll
      for (int i = 0; i < 4; ++i) {
        uint4 x = q4[i], y = q4[4 + i];
        v1[4 * i + 0] = unmono_f(x.x & ~127u); v1[4 * i + 1] = unmono_f(x.y & ~127u);
        v1[4 * i + 2] = unmono_f(x.z & ~127u); v1[4 * i + 3] = unmono_f(x.w & ~127u);
        v2[4 * i + 0] = unmono_f(y.x & ~127u); v2[4 * i + 1] = unmono_f(y.y & ~127u);
        v2[4 * i + 2] = unmono_f(y.z & ~127u); v2[4 * i + 3] = unmono_f(y.w & ~127u);
      }
    }
    unsigned C[16];
#pragma unroll
    for (int i = 0; i < 16; ++i) C[i] = 0u;
    {
      int idx = 0;
#pragma unroll
      for (int a = 0; a < 16; ++a) {
#pragma unroll
        for (int b = 0; b < 16; ++b) {
          if ((a + 1) * (b + 1) <= 16) {
            const unsigned key = (mono_f(v1[a] + v2[b]) & ~255u) | (unsigned)(255 - (a * 16 + b));
            const int slot = idx >> 2, who = idx & 3;
            C[slot] = (g == who) ? key : C[slot];
            ++idx;
          }
        }
      }
    }
    sort16_desc(C);
    xlane_merge16(C, 16);
    xlane_merge16(C, 32);
    const float f0 = unmono_f(C[0] & ~255u);
    float den = 0.f;
    float ev[16];
#pragma unroll
    for (int i = 0; i < 16; ++i) { ev[i] = __expf(unmono_f(C[i] & ~255u) - f0); den += ev[i]; }
    const float rden = 1.0f / den;
    int eidx[4]; float egate[4];
#pragma unroll
    for (int i = 0; i < 4; ++i) {
      const unsigned k = (g == 0) ? C[i] : (g == 1) ? C[4 + i] : (g == 2) ? C[8 + i] : C[12 + i];
      const float e = (g == 0) ? ev[i] : (g == 1) ? ev[4 + i] : (g == 2) ? ev[8 + i] : ev[12 + i];
      const int pos = 255 - (int)(k & 255u);
      const int a = pos >> 4, b = pos & 15;
      const int n1 = 127 - (int)(lp[a] & 127u);
      const int n2 = 127 - (int)(lp[16 + b] & 127u);
      eidx[i] = n1 * 128 + n2;
      egate[i] = e * rden;
    }
    *(int4*)(p.pidx + (size_t)tok * 128 + h * 16 + 4 * g) = make_int4(eidx[0], eidx[1], eidx[2], eidx[3]);
    *(float4*)(p.pgate + (size_t)tok * 128 + h * 16 + 4 * g) = make_float4(egate[0], egate[1], egate[2], egate[3]);
  }
}

__device__ __forceinline__ float logsigmoid_(float x) { return fminf(x, 0.f) - log1pf(expf(-fabsf(x))); }
__device__ __forceinline__ float bf_lo(unsigned w) { return __uint_as_float(w << 16); }
__device__ __forceinline__ float bf_hi(unsigned w) { return __uint_as_float(w & 0xffff0000u); }

#define RKV_LD 136
__device__ __forceinline__ void o_ret_kv_task(const Params& p, int l, int task, char* smem, int tid) {
  const int wave = tid >> 6, lane = tid & 63, g = lane >> 4, tl = lane & 15;
  const int bh = task >> 5, n = task & 31, b = bh >> 2, h = bh & 3;
  const int tok0 = b * SEQ + n * 128;
  const float lgf = logsigmoid_(p.ret_decay[l * 8 + h]), lgb = logsigmoid_(p.ret_decay[l * 8 + 4 + h]);
  bf16_t* KTf = (bf16_t*)smem;
  bf16_t* KTb = KTf + 64 * RKV_LD;
  bf16_t* VT = KTb + 64 * RKV_LD;
  __syncthreads();
#pragma unroll
  for (int it = 0; it < 2; ++it) {
    const int u = tid + it * NTHREADS;
    const int j = u >> 3, d0 = (u & 7) * 8;
    const uint4 kv = *(const uint4*)(p.proj + (size_t)(tok0 + j) * IN_WIDTH + C_RK + h * 64 + d0);
    const float wf = __expf(lgf * (float)(127 - j)), wb = __expf(lgb * (float)(j + 1));
    const unsigned kw[4] = {kv.x, kv.y, kv.z, kv.w};
#pragma unroll
    for (int e = 0; e < 4; ++e) {
      const float x0 = bf_lo(kw[e]), x1 = bf_hi(kw[e]);
      KTf[(d0 + 2 * e) * RKV_LD + j] = f2bf(x0 * wf);
      KTf[(d0 + 2 * e + 1) * RKV_LD + j] = f2bf(x1 * wf);
      KTb[(d0 + 2 * e) * RKV_LD + j] = f2bf(x0 * wb);
      KTb[(d0 + 2 * e + 1) * RKV_LD + j] = f2bf(x1 * wb);
    }
  }
#pragma unroll
  for (int it = 0; it < 4; ++it) {
    const int u = tid + it * NTHREADS;
    const int j = u >> 4, e0 = (u & 15) * 8;
    const uint4 vv = *(const uint4*)(p.proj + (size_t)(tok0 + j) * IN_WIDTH + C_RV + h * 128 + e0);
    const unsigned vw[4] = {vv.x, vv.y, vv.z, vv.w};
#pragma unroll
    for (int e = 0; e < 4; ++e) {
      VT[(e0 + 2 * e) * RKV_LD + j] = (bf16_t)(vw[e] & 0xffffu);
      VT[(e0 + 2 * e + 1) * RKV_LD + j] = (bf16_t)(vw[e] >> 16);
    }
  }
  __syncthreads();
  bf16x8 a[4];
#pragma unroll
  for (int ks = 0; ks < 4; ++ks) a[ks] = *(const bf16x8*)(VT + (wave * 16 + tl) * RKV_LD + ks * 32 + 8 * g);
#pragma unroll
  for (int dir = 0; dir < 2; ++dir) {
    const bf16_t* KT = dir ? KTb : KTf;
#pragma unroll
    for (int dt = 0; dt < 4; ++dt) {
      f32x4 acc = (f32x4){0.f, 0.f, 0.f, 0.f};
#pragma unroll
      for (int ks = 0; ks < 4; ++ks) {
        const bf16x8 bb = *(const bf16x8*)(KT + (dt * 16 + tl) * RKV_LD + ks * 32 + 8 * g);
        acc = __builtin_amdgcn_mfma_f32_16x16x32_bf16(a[ks], bb, acc, 0, 0, 0);
      }
      float* dst = p.kvst + ((size_t)(task * 2 + dir) * 128 + wave * 16 + 4 * g) * 64 + dt * 16 + tl;
#pragma unroll
      for (int r = 0; r < 4; ++r) dst[r * 64] = acc[r];
    }
  }
}

__device__ __forceinline__ void o_ret_scan(const int wv_, const Params& p, int l) {
  const int tidx_ = opaque_tid(wv_); const int bidx_ = opaque_bid();
  const int gsz = gridDim.x * NTHREADS;
  for (int u = bidx_ * NTHREADS + tidx_; u < 16 * 2 * 128 * 16; u += gsz) {
    const int dq = u & 15, e = (u >> 4) & 127, dir = (u >> 11) & 1, bh = u >> 12, h = bh & 3;
    const float lg = logsigmoid_(p.ret_decay[l * 8 + dir * 4 + h]);
    const float gC = __expf(lg * 128.0f);
    float4 st = make_float4(0.f, 0.f, 0.f, 0.f);
#pragma unroll 8
    for (int nn = 0; nn < 32; ++nn) {
      const int n = dir ? (31 - nn) : nn;
      const size_t idx = ((size_t)((bh * 32 + n) * 2 + dir) * 128 + e) * 64 + dq * 4;
      const float4 kv = *(const float4*)(p.kvst + idx);
      uint2 o;
      o.x = pack2bf(st.x, st.y); o.y = pack2bf(st.z, st.w);
      *(uint2*)(p.rstate + idx) = o;
      st.x = fmaf(st.x, gC, kv.x); st.y = fmaf(st.y, gC, kv.y); st.z = fmaf(st.z, gC, kv.z); st.w = fmaf(st.w, gC, kv.w);
    }
  }
}

#define RO_LD 264
#define RK_LD 72
__device__ __forceinline__ void o_ret_out_task(const Params& p, int l, int task, char* smem, int tid) {
  const int wave = tid >> 6, lane = tid & 63, g = lane >> 4, tl = lane & 15;
  const int bh = task >> 5, n = task & 31, b = bh >> 2, h = bh & 3;
  const int tok0 = b * SEQ + n * 128;
  const float lgf = logsigmoid_(p.ret_decay[l * 8 + h]), lgb = logsigmoid_(p.ret_decay[l * 8 + 4 + h]);
  bf16_t* Acat = (bf16_t*)smem;
  bf16_t* Bcat = Acat + 128 * RO_LD;
  bf16_t* Kl = Bcat + 128 * RO_LD;
  __syncthreads();
#pragma unroll
  for (int it = 0; it < 2; ++it) {
    const int u = tid + it * NTHREADS;
    const int i = u >> 3, d0 = (u & 7) * 8;
    const size_t row = (size_t)(tok0 + i) * IN_WIDTH;
    const uint4 qv = *(const uint4*)(p.proj + row + C_RQ + h * 64 + d0);
    const uint4 kv = *(const uint4*)(p.proj + row + C_RK + h * 64 + d0);
    *(uint4*)(Acat + i * RO_LD + d0) = qv;
    *(uint4*)(Kl + i * RK_LD + d0) = kv;
    const float wf = __expf(lgf * (float)(i + 1)), wb = __expf(lgb * (float)(127 - i));
    const unsigned qw[4] = {qv.x, qv.y, qv.z, qv.w};
    uint4 of, ob;
    of.x = pack2bf(bf_lo(qw[0]) * wf, bf_hi(qw[0]) * wf); ob.x = pack2bf(bf_lo(qw[0]) * wb, bf_hi(qw[0]) * wb);
    of.y = pack2bf(bf_lo(qw[1]) * wf, bf_hi(qw[1]) * wf); ob.y = pack2bf(bf_lo(qw[1]) * wb, bf_hi(qw[1]) * wb);
    of.z = pack2bf(bf_lo(qw[2]) * wf, bf_hi(qw[2]) * wf); ob.z = pack2bf(bf_lo(qw[2]) * wb, bf_hi(qw[2]) * wb);
    of.w = pack2bf(bf_lo(qw[3]) * wf, bf_hi(qw[3]) * wf); ob.w = pack2bf(bf_lo(qw[3]) * wb, bf_hi(qw[3]) * wb);
    *(uint4*)(Acat + i * RO_LD + 128 + d0) = of;
    *(uint4*)(Acat + i * RO_LD + 192 + d0) = ob;
  }
#pragma unroll
  for (int it = 0; it < 4; ++it) {
    const int u = tid + it * NTHREADS;
    const int j = u >> 4, e0 = (u & 15) * 8;
    const uint4 vv = *(const uint4*)(p.proj + (size_t)(tok0 + j) * IN_WIDTH + C_RV + h * 128 + e0);
    const unsigned vw[4] = {vv.x, vv.y, vv.z, vv.w};
#pragma unroll
    for (int e = 0; e < 4; ++e) {
      Bcat[(e0 + 2 * e) * RO_LD + j] = (bf16_t)(vw[e] & 0xffffu);
      Bcat[(e0 + 2 * e + 1) * RO_LD + j] = (bf16_t)(vw[e] >> 16);
    }
  }
#pragma unroll
  for (int it = 0; it < 4; ++it) {
    const int u = tid + it * NTHREADS;
    const int d0 = (u & 7) * 8, e = (u >> 3) & 127, dir = u >> 10;
    const uint4 sv = *(const uint4*)(p.rstate + ((size_t)(task * 2 + dir) * 128 + e) * 64 + d0);
    *(uint4*)(Bcat + e * RO_LD + 128 + dir * 64 + d0) = sv;
  }
  __syncthreads();
  f32x4 sc[8];
#pragma unroll
  for (int jt = 0; jt < 8; ++jt) sc[jt] = (f32x4){0.f, 0.f, 0.f, 0.f};
#pragma unroll
  for (int ks = 0; ks < 2; ++ks) {
    const bf16x8 qb = *(const bf16x8*)(Acat + (wave * 16 + tl) * RO_LD + ks * 32 + 8 * g);
#pragma unroll
    for (int jt = 0; jt < 8; ++jt) {
      const bf16x8 ka = *(const bf16x8*)(Kl + (jt * 16 + tl) * RK_LD + ks * 32 + 8 * g);
      sc[jt] = __builtin_amdgcn_mfma_f32_16x16x32_bf16(ka, qb, sc[jt], 0, 0, 0);
    }
  }
  {
    const int i = wave * 16 + tl;
#pragma unroll
    for (int jt = 0; jt < 8; ++jt) {
      float pv[4];
#pragma unroll
      for (int r = 0; r < 4; ++r) {
        const int j = jt * 16 + 4 * g + r;
        const float dd = (j <= i) ? __expf(lgf * (float)(i - j)) : __expf(lgb * (float)(j - i));
        pv[r] = sc[jt][r] * dd;
      }
      uint2 o;
      o.x = pack2bf(pv[0], pv[1]); o.y = pack2bf(pv[2], pv[3]);
      *(uint2*)(Acat + i * RO_LD + jt * 16 + 4 * g) = o;
    }
  }
  f32x4 y[8];
#pragma unroll
  for (int et = 0; et < 8; ++et) y[et] = (f32x4){0.f, 0.f, 0.f, 0.f};
#pragma unroll
  for (int ks = 0; ks < 8; ++ks) {
    const bf16x8 ab = *(const bf16x8*)(Acat + (wave * 16 + tl) * RO_LD + ks * 32 + 8 * g);
#pragma unroll
    for (int et = 0; et < 8; ++et) {
      const bf16x8 ba = *(const bf16x8*)(Bcat + (et * 16 + tl) * RO_LD + ks * 32 + 8 * g);
      y[et] = __builtin_amdgcn_mfma_f32_16x16x32_bf16(ba, ab, y[et], 0, 0, 0);
    }
  }
  float ss = 0.f;
#pragma unroll
  for (int et = 0; et < 8; ++et)
#pragma unroll
    for (int r = 0; r < 4; ++r) ss = fmaf(y[et][r], y[et][r], ss);
  ss += __shfl_xor(ss, 16, 64);
  ss += __shfl_xor(ss, 32, 64);
  const float rstd = rsqrtf(ss * (1.0f / 128.0f) + EPS);
  {
    const int tok = tok0 + wave * 16 + tl;
    const bf16_t* gp = p.proj + (size_t)tok * IN_WIDTH + C_RG + h * 128 + 4 * g;
    bf16_t* dst = p.ycat + (size_t)tok * 1024 + 256 + h * 128 + 4 * g;
#pragma unroll
    for (int et = 0; et < 8; ++et) {
      const uint2 gv = *(const uint2*)(gp + et * 16);
      const float g0 = bf_lo(gv.x), g1 = bf_hi(gv.x), g2 = bf_lo(gv.y), g3 = bf_hi(gv.y);
      uint2 o;
      o.x = pack2bf(g0 / (1.0f + __expf(-g0)) * y[et][0] * rstd, g1 / (1.0f + __expf(-g1)) * y[et][1] * rstd);
      o.y = pack2bf(g2 / (1.0f + __expf(-g2)) * y[et][2] * rstd, g3 / (1.0f + __expf(-g3)) * y[et][3] * rstd);
      *(uint2*)(dst + et * 16) = o;
    }
  }
}


#define NA_KLD 72
typedef short v4s_t __attribute__((ext_vector_type(4)));
#ifndef LAS
#define LAS __attribute__((address_space(3)))
#endif
__device__ __forceinline__ void o_na_task(const Params& p, int l, int task, char* smem, int tid) {
  const int wave = tid >> 6, lane = tid & 63, g = lane >> 4, tl = lane & 15;
  const int rr = task & 63, h = (task >> 6) & 3, b = task >> 8;
  int rs = rr - 4; rs = rs < 0 ? 0 : (rs > 56 ? 56 : rs);
  const int ktok0 = b * SEQ + rs * 64;
  const int qtok0 = b * SEQ + rr * 64;
  bf16_t* Kl = (bf16_t*)smem;
  bf16_t* Vl = Kl + 512 * NA_KLD;
  bf16_t* Ql = Vl + 512 * NA_KLD;
  float* rpbl = (float*)(Ql + 64 * NA_KLD);
  __syncthreads();
#pragma unroll
  for (int it = 0; it < 8; ++it) {
    const int u = tid + it * NTHREADS;
    const int key = u >> 3, d0 = (u & 7) * 8;
    const size_t row = (size_t)(ktok0 + key) * IN_WIDTH;
    const uint4 kv = *(const uint4*)(p.proj + row + C_NK + h * 64 + d0);
    const uint4 vv = *(const uint4*)(p.proj + row + C_NV + h * 64 + d0);
    *(uint4*)(Kl + key * NA_KLD + d0) = kv;
    *(uint4*)(Vl + key * NA_KLD + d0) = vv;
  }
  {
    const int q = tid >> 3, d0 = (tid & 7) * 8;
    *(uint4*)(Ql + q * NA_KLD + d0) = *(const uint4*)(p.proj + (size_t)(qtok0 + q) * IN_WIDTH + C_NQ + h * 64 + d0);
    if (tid < 465) rpbl[tid] = p.na_rpb[((size_t)l * 4 + h) * 465 + tid];
  }
  __syncthreads();
  if (wave < 4) {
    const int qt = wave;
    int cw0 = 16 * qt - 8; cw0 = cw0 < 0 ? 0 : (cw0 > 32 ? 32 : cw0);
    f32x4 sc[16];
#pragma unroll
    for (int T = 0; T < 16; ++T) sc[T] = (f32x4){0.f, 0.f, 0.f, 0.f};
#pragma unroll
    for (int ks = 0; ks < 2; ++ks) {
      const bf16x8 qb = *(const bf16x8*)(Ql + (qt * 16 + tl) * NA_KLD + ks * 32 + 8 * g);
#pragma unroll
      for (int T = 0; T < 16; ++T) {
        const int key = (T >> 1) * 64 + cw0 + (T & 1) * 16 + tl;
        const bf16x8 ka = *(const bf16x8*)(Kl + key * NA_KLD + ks * 32 + 8 * g);
        sc[T] = __builtin_amdgcn_mfma_f32_16x16x32_bf16(ka, qb, sc[T], 0, 0, 0);
      }
    }
    const int cq = qt * 16 + tl;
    int cs = cq - 8; cs = cs < 0 ? 0 : (cs > 48 ? 48 : cs);
    float m = -3.0e38f;
#pragma unroll
    for (int T = 0; T < 16; ++T) {
      const int ri = T >> 1;
      const int di = rs + ri - rr + 7;
#pragma unroll
      for (int r = 0; r < 4; ++r) {
        const int ck = cw0 + (T & 1) * 16 + 4 * g + r;
        const bool valid = (ck >= cs) && (ck < cs + 16);
        int dj = ck - cq + 15; dj = dj < 0 ? 0 : (dj > 30 ? 30 : dj);
        const float sv = valid ? (sc[T][r] + rpbl[di * 31 + dj]) : -1.0e30f;
        sc[T][r] = sv;
        m = fmaxf(m, sv);
      }
    }
    m = fmaxf(m, __shfl_xor(m, 16, 64));
    m = fmaxf(m, __shfl_xor(m, 32, 64));
    float den = 0.f;
#pragma unroll
    for (int T = 0; T < 16; ++T)
#pragma unroll
      for (int r = 0; r < 4; ++r) {
        const float e = __expf(sc[T][r] - m);
        sc[T][r] = e;
        den += e;
      }
    den += __shfl_xor(den, 16, 64);
    den += __shfl_xor(den, 32, 64);
    const float rden = 1.0f / den;
    f32x4 o[4];
#pragma unroll
    for (int dt = 0; dt < 4; ++dt) o[dt] = (f32x4){0.f, 0.f, 0.f, 0.f};
#pragma unroll
    for (int ri = 0; ri < 8; ++ri) {
      union { bf16x8 v; unsigned u[4]; } pb;
      pb.u[0] = pack2bf(sc[2 * ri][0], sc[2 * ri][1]);
      pb.u[1] = pack2bf(sc[2 * ri][2], sc[2 * ri][3]);
      pb.u[2] = pack2bf(sc[2 * ri + 1][0], sc[2 * ri + 1][1]);
      pb.u[3] = pack2bf(sc[2 * ri + 1][2], sc[2 * ri + 1][3]);
#pragma unroll
      for (int dt = 0; dt < 4; ++dt) {
        const bf16_t* vp = Vl + (ri * 64 + cw0 + 4 * g + (tl >> 2)) * NA_KLD + dt * 16 + 4 * (tl & 3);
        const v4s_t r0 = __builtin_amdgcn_ds_read_tr16_b64_v4i16((v4s_t LAS*)(LAS bf16_t*)vp);
        const v4s_t r1 = __builtin_amdgcn_ds_read_tr16_b64_v4i16((v4s_t LAS*)(LAS bf16_t*)(vp + 16 * NA_KLD));
        const bf16x8 va = {r0[0], r0[1], r0[2], r0[3], r1[0], r1[1], r1[2], r1[3]};
        o[dt] = __builtin_amdgcn_mfma_f32_16x16x32_bf16(va, pb.v, o[dt], 0, 0, 0);
      }
    }
    bf16_t* dst = p.ycat + (size_t)(qtok0 + qt * 16 + tl) * 1024 + 768 + h * 64 + 4 * g;
#pragma unroll
    for (int dt = 0; dt < 4; ++dt) {
      uint2 ov;
      ov.x = pack2bf(o[dt][0] * rden, o[dt][1] * rden);
      ov.y = pack2bf(o[dt][2] * rden, o[dt][3] * rden);
      *(uint2*)(dst + dt * 16) = ov;
    }
  }
}

#define PL_LD 264
__device__ __forceinline__ void o_pool_task(const Params& p, int l, int task, char* smem, int tid) {
  const int wave = tid >> 6, lane = tid & 63, g = lane >> 4, tl = lane & 15;
  const int t0 = task * 64, pos0 = t0 & (SEQ - 1);
  bf16_t* Xp = (bf16_t*)smem;
  bf16_t* WT = Xp + 80 * PL_LD;
  bf16_t* Df = WT + 4 * 64 * 72;
  __syncthreads();
#pragma unroll
  for (int it = 0; it < 5; ++it) {
    const int u = tid + it * NTHREADS;
    const int rw = u >> 5, c0 = (u & 31) * 8;
    const int pos = pos0 - 8 + rw;
    uint4 v = make_uint4(0u, 0u, 0u, 0u);
    if (pos >= 0 && pos < SEQ) v = *(const uint4*)(p.proj + (size_t)(t0 - 8 + rw) * IN_WIDTH + C_POOL + c0);
    *(uint4*)(Xp + rw * PL_LD + c0) = v;
  }
#pragma unroll
  for (int it = 0; it < 4; ++it) {
    const int u = tid + it * NTHREADS;
    const int e0 = (u & 7) * 8, c = (u >> 3) & 63, gi = u >> 9;
    const float* wp = p.pool_w + (((size_t)l * 4 + gi) * 64 + c) * 64 + e0;
    const float4 a = *(const float4*)wp, bq = *(const float4*)(wp + 4);
    const float wv[8] = {a.x, a.y, a.z, a.w, bq.x, bq.y, bq.z, bq.w};
#pragma unroll
    for (int k = 0; k < 8; ++k) WT[(gi * 64 + e0 + k) * 72 + c] = f2bf(wv[k]);
  }
  __syncthreads();
#pragma unroll 1
  for (int it = 0; it < 4; ++it) {
    const int u = tid + it * NTHREADS;
    const int t = u >> 5, c0 = (u & 31) * 8;
    const int gi = c0 >> 6;
    const int hw = 1 << gi;
    const int pos = pos0 + t;
    int a = pos - hw; a = a < 0 ? 0 : a;
    int bnd = pos + hw; bnd = bnd > SEQ ? SEQ : bnd;
    float sum[8];
#pragma unroll
    for (int k = 0; k < 8; ++k) sum[k] = 0.f;
    for (int rp = a; rp < bnd; ++rp) {
      const uint4 v = *(const uint4*)(Xp + (rp - pos0 + 8) * PL_LD + c0);
      sum[0] += bf_lo(v.x); sum[1] += bf_hi(v.x); sum[2] += bf_lo(v.y); sum[3] += bf_hi(v.y);
      sum[4] += bf_lo(v.z); sum[5] += bf_hi(v.z); sum[6] += bf_lo(v.w); sum[7] += bf_hi(v.w);
    }
    const float rc = 1.0f / (float)(bnd - a);
    const uint4 xv = *(const uint4*)(Xp + (t + 8) * PL_LD + c0);
    uint4 o;
    o.x = pack2bf(sum[0] * rc - bf_lo(xv.x), sum[1] * rc - bf_hi(xv.x));
    o.y = pack2bf(sum[2] * rc - bf_lo(xv.y), sum[3] * rc - bf_hi(xv.y));
    o.z = pack2bf(sum[4] * rc - bf_lo(xv.z), sum[5] * rc - bf_hi(xv.z));
    o.w = pack2bf(sum[6] * rc - bf_lo(xv.w), sum[7] * rc - bf_hi(xv.w));
    *(uint4*)(Df + t * PL_LD + c0) = o;
  }
  __syncthreads();
  {
    const int gi = wave >> 1, tt0 = (wave & 1) * 2;
    f32x4 acc[4][2];
#pragma unroll
    for (int et = 0; et < 4; ++et)
#pragma unroll
      for (int tt = 0; tt < 2; ++tt) acc[et][tt] = (f32x4){0.f, 0.f, 0.f, 0.f};
#pragma unroll
    for (int ks = 0; ks < 2; ++ks) {
      bf16x8 bx[2];
#pragma unroll
      for (int tt = 0; tt < 2; ++tt) bx[tt] = *(const bf16x8*)(Df + ((tt0 + tt) * 16 + tl) * PL_LD + gi * 64 + ks * 32 + 8 * g);
#pragma unroll
      for (int et = 0; et < 4; ++et) {
        const bf16x8 wa = *(const bf16x8*)(WT + (gi * 64 + et * 16 + tl) * 72 + ks * 32 + 8 * g);
#pragma unroll
        for (int tt = 0; tt < 2; ++tt) acc[et][tt] = __builtin_amdgcn_mfma_f32_16x16x32_bf16(wa, bx[tt], acc[et][tt], 0, 0, 0);
      }
    }
#pragma unroll
    for (int et = 0; et < 4; ++et) {
      const float4 sc4 = *(const float4*)(p.pool_scale + l * 256 + gi * 64 + et * 16 + 4 * g);
#pragma unroll
      for (int tt = 0; tt < 2; ++tt) {
        const int tok = t0 + (tt0 + tt) * 16 + tl;
        uint2 o;
        o.x = pack2bf(acc[et][tt][0] * sc4.x, acc[et][tt][1] * sc4.y);
        o.y = pack2bf(acc[et][tt][2] * sc4.z, acc[et][tt][3] * sc4.w);
        *(uint2*)(p.ycat + (size_t)tok * 1024 + gi * 64 + et * 16 + 4 * g) = o;
      }
    }
  }
}


typedef __attribute__((ext_vector_type(2))) __bf16 bf16x2_t;
__device__ __forceinline__ float dot2bf(unsigned a, unsigned b, float c) {
  return __builtin_amdgcn_fdot2_f32_bf16(__builtin_bit_cast(bf16x2_t, a), __builtin_bit_cast(bf16x2_t, b), c, false);
}
#define DPP_F(v, ctrl) __builtin_bit_cast(float, __builtin_amdgcn_update_dpp(0, __builtin_bit_cast(int, v), ctrl, 0xf, 0xf, false))
#define RDLANE_F(v, l) __builtin_bit_cast(float, __builtin_amdgcn_readlane(__builtin_bit_cast(int, v), l))
__device__ __forceinline__ float erf_as(float x) {
  const float ax = fabsf(x);
  const float t = __builtin_amdgcn_rcpf(fmaf(0.3275911f, ax, 1.0f));
  float y = fmaf(1.061405429f, t, -1.453152027f);
  y = fmaf(y, t, 1.421413741f);
  y = fmaf(y, t, -0.284496736f);
  y = fmaf(y, t, 0.254829592f);
  y = y * t * __expf(-ax * ax);
  return copysignf(1.0f - y, x);
}
__device__ __forceinline__ float gelu_fast_exact(float a) { return 0.5f * a * (1.0f + erf_as(a * 0.70710678118654752f)); }
struct PickPair { int eA, eB; float gA, gB; };

#define EX6_SHIFT 11
#define EX6_NSLICE (16384 >> EX6_SHIFT)
__device__ __forceinline__ unsigned cvt8_bf16x2(unsigned w, float scale, const bool hi) {
  return hi ? __builtin_bit_cast(unsigned, __builtin_amdgcn_cvt_scalef32_pk_bf16_fp8((int)w, scale, true))
            : __builtin_bit_cast(unsigned, __builtin_amdgcn_cvt_scalef32_pk_bf16_fp8((int)w, scale, false));
}
__device__ __forceinline__ void experts6_process4(const unsigned char* __restrict__ U8, const unsigned char* __restrict__ V8,
                                                  const float2* __restrict__ ES, const int (&e)[4], const float (&g)[4],
                                                  const unsigned (&hw)[8], float (&acc)[16], int lane, int vz) {
  uint4 u[4], v[4];
  float2 sc[4];
#pragma unroll
  for (int i = 0; i < 4; ++i) u[i] = *(const uint4*)(U8 + (size_t)e[i] * 1024 + lane * 16);
#pragma unroll
  for (int i = 0; i < 4; ++i) sc[i] = ES[e[i] + vz];
#pragma unroll
  for (int i = 0; i < 4; ++i) v[i] = *(const uint4*)(V8 + (size_t)e[i] * 1024 + lane * 16);
  float a[4];
#pragma unroll
  for (int i = 0; i < 4; ++i) {
    const unsigned uw[4] = {u[i].x, u[i].y, u[i].z, u[i].w};
    float t = 0.f;
#pragma unroll
    for (int w = 0; w < 4; ++w) {
      t = dot2bf(cvt8_bf16x2(uw[w], sc[i].x, false), hw[2 * w], t);
      t = dot2bf(cvt8_bf16x2(uw[w], sc[i].x, true), hw[2 * w + 1], t);
    }
    a[i] = t;
  }
  const bool b0 = lane & 1, b1 = lane & 2;
  const float x01 = (b0 ? a[1] : a[0]) + DPP_F((b0 ? a[0] : a[1]), 0xB1);
  const float x23 = (b0 ? a[3] : a[2]) + DPP_F((b0 ? a[2] : a[3]), 0xB1);
  float y = (b1 ? x23 : x01) + DPP_F((b1 ? x01 : x23), 0x4E);
  y += DPP_F(y, 0x124);
  y += DPP_F(y, 0x128);
  float sum[4];
#pragma unroll
  for (int i = 0; i < 4; ++i) sum[i] = RDLANE_F(y, i) + RDLANE_F(y, 16 + i) + RDLANE_F(y, 32 + i) + RDLANE_F(y, 48 + i);
  const int li = lane & 3;
  const float mine = (li == 0) ? sum[0] : (li == 1) ? sum[1] : (li == 2) ? sum[2] : sum[3];
  const float gmine = (li == 0) ? g[0] : (li == 1) ? g[1] : (li == 2) ? g[2] : g[3];
  const unsigned gb = (unsigned)f2bf(gelu_fast_exact(mine) * gmine);
#pragma unroll
  for (int i = 0; i < 4; ++i) {
    const unsigned hl = (unsigned)__builtin_amdgcn_readlane((int)gb, i);
    const unsigned hh = hl << 16;
    const unsigned vw[4] = {v[i].x, v[i].y, v[i].z, v[i].w};
#pragma unroll
    for (int w = 0; w < 4; ++w) {
      const unsigned p0 = cvt8_bf16x2(vw[w], sc[i].y, false), p1 = cvt8_bf16x2(vw[w], sc[i].y, true);
      acc[4 * w + 0] = dot2bf(p0, hl, acc[4 * w + 0]);
      acc[4 * w + 1] = dot2bf(p0, hh, acc[4 * w + 1]);
      acc[4 * w + 2] = dot2bf(p1, hl, acc[4 * w + 2]);
      acc[4 * w + 3] = dot2bf(p1, hh, acc[4 * w + 3]);
    }
  }
}

__device__ __forceinline__ void o_peer_experts6_tile(const Params& p, int l, int t0, const char* smem, int tid, bool dry = false) {
  const int wave = __builtin_amdgcn_readfirstlane(tid >> 6), lane = tid & 63;
  const unsigned char* U8 = p.u8 + (size_t)l * 16384 * 1024;
  const unsigned char* V8 = p.v8 + (size_t)l * 16384 * 1024;
  const float2* ES = p.escale + (size_t)l * 16384;
  int vz = 0;
  asm volatile("" : "+v"(vz));
  const int s0 = ((int)(__builtin_amdgcn_s_getreg((3 << 11) | 20) & 0xF) * (EX6_NSLICE / 8)) & (EX6_NSLICE - 1);
  unsigned pk[8][2];
  float acc[8][16];
#pragma unroll
  for (int k = 0; k < 8; ++k) {
    const size_t base = (size_t)(t0 + wave * 8 + k) * 128 + lane + vz;
#pragma unroll
    for (int hf = 0; hf < 2; ++hf) pk[k][hf] = (unsigned)p.pidx[base + hf * 64] | ((unsigned)f2bf(p.pgate[base + hf * 64]) << 16);
#pragma unroll
    for (int i = 0; i < 16; ++i) acc[k][i] = 0.f;
  }
#pragma unroll 1
  for (int si = 0; si < EX6_NSLICE; ++si) {
    const unsigned s = (unsigned)((s0 + si) & (EX6_NSLICE - 1));
#pragma unroll
    for (int k = 0; k < 8; ++k) {
      unsigned long long m0 = __ballot(((pk[k][0] & 0x3fffu) >> EX6_SHIFT) == s);
      unsigned long long m1 = __ballot(((pk[k][1] & 0x3fffu) >> EX6_SHIFT) == s);
      if ((m0 | m1) == 0ull) continue;
      unsigned hw[8];
      {
        const char* xr = smem + (wave * 8 + k) * LDXB + lane * 32;
        const uint4 h0 = *(const uint4*)xr, h1 = *(const uint4*)(xr + 16);
        hw[0] = h0.x; hw[1] = h0.y; hw[2] = h0.z; hw[3] = h0.w; hw[4] = h1.x; hw[5] = h1.y; hw[6] = h1.z; hw[7] = h1.w;
      }
      while (m0 | m1) {
        int e[4]; float g[4];
#pragma unroll
        for (int i = 0; i < 4; ++i) {
          unsigned w;
          if (m0) { const int la = (int)__builtin_ctzll(m0); m0 &= m0 - 1; w = (unsigned)__builtin_amdgcn_readlane((int)pk[k][0], la); }
          else if (m1) { const int la = (int)__builtin_ctzll(m1); m1 &= m1 - 1; w = (unsigned)__builtin_amdgcn_readlane((int)pk[k][1], la); }
          else { w = (unsigned)e[0]; }
          e[i] = (int)(w & 0x3fffu);
          g[i] = __uint_as_float(w & 0xffff0000u);
        }
        experts6_process4(U8, V8, ES, e, g, hw, acc[k], lane, vz);
      }
    }
  }
  if (dry) {
#pragma unroll
    for (int k = 0; k < 8; ++k)
#pragma unroll
      for (int i = 0; i < 16; ++i) asm volatile("" :: "v"(acc[k][i]));
    return;
  }
#pragma unroll
  for (int k = 0; k < 8; ++k) {
    float* xr = p.xres + (size_t)(t0 + wave * 8 + k) * 1024 + lane * 16;
#pragma unroll
    for (int i = 0; i < 4; ++i) {
      float4 a0 = *(float4*)(xr + 4 * i);
      a0.x += acc[k][4 * i + 0]; a0.y += acc[k][4 * i + 1]; a0.z += acc[k][4 * i + 2]; a0.w += acc[k][4 * i + 3];
      *(float4*)(xr + 4 * i) = a0;
    }
  }
}


typedef _Float16 h2_t __attribute__((ext_vector_type(2)));
__device__ __forceinline__ void ex7_pop(unsigned long long& m0, unsigned long long& m1, const unsigned pk0, const unsigned pk1,
                                        int (&e)[4], float (&g)[4]) {
  int e0 = 0;
#pragma unroll
  for (int i = 0; i < 4; ++i) {
    unsigned w;
    if (m0) { const int la = (int)__builtin_ctzll(m0); m0 &= m0 - 1; w = (unsigned)__builtin_amdgcn_readlane((int)pk0, la); }
    else if (m1) { const int la = (int)__builtin_ctzll(m1); m1 &= m1 - 1; w = (unsigned)__builtin_amdgcn_readlane((int)pk1, la); }
    else { w = (unsigned)e0; }
    e[i] = (int)(w & 0x3fffu);
    g[i] = __uint_as_float(w & 0xffff0000u);
    if (i == 0) e0 = e[0];
  }
}
#define EX7_ISSUE(U_, V_, SC_, G_) { \
  _Pragma("unroll") for (int i_ = 0; i_ < 4; ++i_) U_[i_] = __builtin_bit_cast(uint4, __builtin_amdgcn_raw_buffer_load_b128(rU, lo16, e[i_] * 1024, 0)); \
  _Pragma("unroll") for (int i_ = 0; i_ < 4; ++i_) SC_[i_] = __builtin_bit_cast(float2, __builtin_amdgcn_raw_buffer_load_b64(rS, vz, e[i_] * 8, 0)); \
  _Pragma("unroll") for (int i_ = 0; i_ < 4; ++i_) V_[i_] = __builtin_bit_cast(uint4, __builtin_amdgcn_raw_buffer_load_b128(rV, lo16, e[i_] * 1024, 0)); \
  _Pragma("unroll") for (int i_ = 0; i_ < 4; ++i_) G_[i_] = g[i_]; }

__device__ __forceinline__ void ex7_compute(const uint4 (&ru)[4], const uint4 (&rv)[4], const float2 (&rsc)[4], const float (&rg)[4],
                                            const unsigned (&hw)[8], h2_t (&acc)[8], int lane) {
  float a[4];
#pragma unroll
  for (int i = 0; i < 4; ++i) {
    const unsigned uw[4] = {ru[i].x, ru[i].y, ru[i].z, ru[i].w};
    float t = 0.f;
#pragma unroll
    for (int w = 0; w < 4; ++w) {
      t = dot2bf(cvt8_bf16x2(uw[w], rsc[i].x, false), hw[2 * w], t);
      t = dot2bf(cvt8_bf16x2(uw[w], rsc[i].x, true), hw[2 * w + 1], t);
    }
    a[i] = t;
  }
  const bool b0 = lane & 1, b1 = lane & 2;
  const float x01 = (b0 ? a[1] : a[0]) + DPP_F((b0 ? a[0] : a[1]), 0xB1);
  const float x23 = (b0 ? a[3] : a[2]) + DPP_F((b0 ? a[2] : a[3]), 0xB1);
  float y = (b1 ? x23 : x01) + DPP_F((b1 ? x01 : x23), 0x4E);
  y += DPP_F(y, 0x124);
  y += DPP_F(y, 0x128);
  float sum[4];
#pragma unroll
  for (int i = 0; i < 4; ++i) sum[i] = RDLANE_F(y, i) + RDLANE_F(y, 16 + i) + RDLANE_F(y, 32 + i) + RDLANE_F(y, 48 + i);
  const int li = lane & 3;
  const float mine = (li == 0) ? sum[0] : (li == 1) ? sum[1] : (li == 2) ? sum[2] : sum[3];
  const float gmine = (li == 0) ? rg[0] : (li == 1) ? rg[1] : (li == 2) ? rg[2] : rg[3];
  const _Float16 hf = (_Float16)(gelu_fast_exact(mine) * gmine);
  const unsigned hb = (unsigned)__builtin_bit_cast(unsigned short, hf);
#pragma unroll
  for (int i = 0; i < 4; ++i) {
    const unsigned hl = (unsigned)__builtin_amdgcn_readlane((int)hb, i);
    const h2_t hh = __builtin_bit_cast(h2_t, hl | (hl << 16));
    const unsigned vw[4] = {rv[i].x, rv[i].y, rv[i].z, rv[i].w};
#pragma unroll
    for (int w = 0; w < 4; ++w) {
      const h2_t p0 = __builtin_amdgcn_cvt_scalef32_pk_f16_fp8((int)vw[w], rsc[i].y, false);
      const h2_t p1 = __builtin_amdgcn_cvt_scalef32_pk_f16_fp8((int)vw[w], rsc[i].y, true);
      acc[2 * w] = __builtin_elementwise_fma(p0, hh, acc[2 * w]);
      acc[2 * w + 1] = __builtin_elementwise_fma(p1, hh, acc[2 * w + 1]);
    }
  }
}

__device__ __forceinline__ void o_peer_experts7_tile(const Params& p, int l, int t0, const char* smem, int tid, bool dry = false) {
  const int wave = __builtin_amdgcn_readfirstlane(tid >> 6), lane = tid & 63;
  const unsigned char* U8 = p.u8 + (size_t)l * 16384 * 1024;
  const unsigned char* V8 = p.v8 + (size_t)l * 16384 * 1024;
  const float2* ES = p.escale + (size_t)l * 16384;
  int vz = 0;
  asm volatile("" : "+v"(vz));
  const __amdgpu_buffer_rsrc_t rsU = __builtin_amdgcn_make_buffer_rsrc((void*)U8, 0, 16384 * 1024, 0x00020000);
  const __amdgpu_buffer_rsrc_t rsV = __builtin_amdgcn_make_buffer_rsrc((void*)V8, 0, 16384 * 1024, 0x00020000);
  const __amdgpu_buffer_rsrc_t rsS = __builtin_amdgcn_make_buffer_rsrc((void*)ES, 0, 16384 * 8, 0x00020000);
  const __amdgpu_buffer_rsrc_t rsU0 = __builtin_amdgcn_make_buffer_rsrc((void*)U8, 0, 0, 0x00020000);
  const __amdgpu_buffer_rsrc_t rsV0 = __builtin_amdgcn_make_buffer_rsrc((void*)V8, 0, 0, 0x00020000);
  const __amdgpu_buffer_rsrc_t rsS0 = __builtin_amdgcn_make_buffer_rsrc((void*)ES, 0, 0, 0x00020000);
  const int lo16 = lane * 16;
  const int s0 = ((int)(__builtin_amdgcn_s_getreg((3 << 11) | 20) & 0xF) * (EX6_NSLICE / 8)) & (EX6_NSLICE - 1);
  unsigned pk[8][2];
  h2_t acc[8][8];
#pragma unroll
  for (int k = 0; k < 8; ++k) {
    const size_t base = (size_t)(t0 + wave * 8 + k) * 128 + lane + vz;
#pragma unroll
    for (int hf = 0; hf < 2; ++hf) pk[k][hf] = (unsigned)p.pidx[base + hf * 64] | ((unsigned)f2bf(p.pgate[base + hf * 64]) << 16);
#pragma unroll
    for (int i = 0; i < 8; ++i) acc[k][i] = (h2_t){(_Float16)0.f, (_Float16)0.f};
  }
#pragma unroll 1
  for (int si = 0; si < EX6_NSLICE; ++si) {
    const unsigned s = (unsigned)((s0 + si) & (EX6_NSLICE - 1));
#pragma unroll
    for (int k = 0; k < 8; ++k) {
      unsigned long long m0 = __ballot(((pk[k][0] & 0x3fffu) >> EX6_SHIFT) == s);
      unsigned long long m1 = __ballot(((pk[k][1] & 0x3fffu) >> EX6_SHIFT) == s);
      if ((m0 | m1) == 0ull) continue;
      unsigned hw[8];
      {
        const char* xr = smem + (wave * 8 + k) * LDXB + lane * 32;
        const uint4 h0 = *(const uint4*)xr, h1 = *(const uint4*)(xr + 16);
        hw[0] = h0.x; hw[1] = h0.y; hw[2] = h0.z; hw[3] = h0.w; hw[4] = h1.x; hw[5] = h1.y; hw[6] = h1.z; hw[7] = h1.w;
      }
      uint4 uA[4], vA[4], uB[4], vB[4];
      float2 scA[4], scB[4];
      float gA[4], gB[4];
      int e[4]; float g[4];
      ex7_pop(m0, m1, pk[k][0], pk[k][1], e, g);
      __amdgpu_buffer_rsrc_t rU = rsU, rV = rsV, rS = rsS;
      EX7_ISSUE(uA, vA, scA, gA)
      for (;;) {
        const bool mb = (m0 | m1) != 0ull;
        if (mb) ex7_pop(m0, m1, pk[k][0], pk[k][1], e, g);
        rU = mb ? rsU : rsU0; rV = mb ? rsV : rsV0; rS = mb ? rsS : rsS0;
        EX7_ISSUE(uB, vB, scB, gB)
        __builtin_amdgcn_s_setprio(1);
        ex7_compute(uA, vA, scA, gA, hw, acc[k], lane);
        __builtin_amdgcn_s_setprio(0);
        if (!mb) break;
        const bool ma = (m0 | m1) != 0ull;
        if (ma) ex7_pop(m0, m1, pk[k][0], pk[k][1], e, g);
        rU = ma ? rsU : rsU0; rV = ma ? rsV : rsV0; rS = ma ? rsS : rsS0;
        EX7_ISSUE(uA, vA, scA, gA)
        __builtin_amdgcn_s_setprio(1);
        ex7_compute(uB, vB, scB, gB, hw, acc[k], lane);
        __builtin_amdgcn_s_setprio(0);
        if (!ma) break;
      }
    }
  }
  if (dry) {
#pragma unroll
    for (int k = 0; k < 8; ++k)
#pragma unroll
      for (int i = 0; i < 8; ++i) asm volatile("" :: "v"(acc[k][i]));
    return;
  }
#pragma unroll
  for (int k = 0; k < 8; ++k) {
    float* xr = p.xres + (size_t)(t0 + wave * 8 + k) * 1024 + lane * 16;
#pragma unroll
    for (int i = 0; i < 4; ++i) {
      float4 a0 = *(float4*)(xr + 4 * i);
      a0.x += (float)acc[k][2 * i][0]; a0.y += (float)acc[k][2 * i][1];
      a0.z += (float)acc[k][2 * i + 1][0]; a0.w += (float)acc[k][2 * i + 1][1];
      *(float4*)(xr + 4 * i) = a0;
    }
  }
}

typedef unsigned u32x2_t __attribute__((ext_vector_type(2)));
__device__ __forceinline__ long mk_long(unsigned lo, unsigned hi) { return (long)(((unsigned long long)hi << 32) | (unsigned long long)lo); }
__device__ __forceinline__ float xrow_total(float y) {
  const unsigned yb = __float_as_uint(y);
  const u32x2_t r = __builtin_amdgcn_permlane16_swap(yb, yb, false, false);
  const float z = __uint_as_float(r[0]) + __uint_as_float(r[1]);
  const unsigned zb = __float_as_uint(z);
  const u32x2_t r2 = __builtin_amdgcn_permlane32_swap(zb, zb, false, false);
  return __uint_as_float(r2[0]) + __uint_as_float(r2[1]);
}
__device__ __forceinline__ void ex8_pop(unsigned long long& m0, unsigned long long& m1, const unsigned pk0, const unsigned pk1, unsigned (&w)[4]) {
  unsigned w0 = 0;
#pragma unroll
  for (int i = 0; i < 4; ++i) {
    unsigned x;
    if (m0) { const int la = (int)__builtin_ctzll(m0); m0 &= m0 - 1; x = (unsigned)__builtin_amdgcn_readlane((int)pk0, la); }
    else if (m1) { const int la = (int)__builtin_ctzll(m1); m1 &= m1 - 1; x = (unsigned)__builtin_amdgcn_readlane((int)pk1, la); }
    else { x = w0 & 0x3fffu; }
    w[i] = x;
    if (i == 0) w0 = x;
  }
}
#define EX8_ISSUE(U_, V_, SC_, WQ_) { \
  _Pragma("unroll") for (int i_ = 0; i_ < 4; ++i_) U_[i_] = __builtin_bit_cast(uint4, __builtin_amdgcn_raw_buffer_load_b128(rU, lo16, (int)(w[i_] & 0x3fffu) * 1024, 0)); \
  WQ_ = (w[0] & oh0) | (w[1] & oh1) | (w[2] & oh2) | (w[3] & oh3); \
  SC_ = __builtin_bit_cast(float2, __builtin_amdgcn_raw_buffer_load_b64(rS, (int)(WQ_ & 0x3fffu) * 8, 0, 0)); \
  _Pragma("unroll") for (int i_ = 0; i_ < 4; ++i_) V_[i_] = __builtin_bit_cast(uint4, __builtin_amdgcn_raw_buffer_load_b128(rV, lo16, (int)(w[i_] & 0x3fffu) * 1024, 0)); }

__device__ __forceinline__ void ex8_compute(const uint4 (&ru)[4], const uint4 (&rv)[4], const float2 scm, const unsigned wq,
                                            const uint4 hb, const float hsi, f32x4 (&cur)[4],
                                            const bool b0, const bool b1, const bool isdiag, const unsigned mlane) {
  const long hA = mk_long(hb.x, hb.y), hB = mk_long(hb.z, hb.w);
  f32x4 d[4];
#pragma unroll
  for (int i = 0; i < 4; ++i) d[i] = __builtin_amdgcn_mfma_f32_16x16x32_fp8_fp8(mk_long(ru[i].x, ru[i].y), hA, (f32x4){0.f, 0.f, 0.f, 0.f}, 0, 0, 0);
#pragma unroll
  for (int i = 0; i < 4; ++i) d[i] = __builtin_amdgcn_mfma_f32_16x16x32_fp8_fp8(mk_long(ru[i].z, ru[i].w), hB, d[i], 0, 0, 0);
  float a[4];
#pragma unroll
  for (int i = 0; i < 4; ++i) a[i] = b1 ? (b0 ? d[i][3] : d[i][2]) : (b0 ? d[i][1] : d[i][0]);
  const float x01 = (b0 ? a[1] : a[0]) + DPP_F((b0 ? a[0] : a[1]), 0xB1);
  const float x23 = (b0 ? a[3] : a[2]) + DPP_F((b0 ? a[2] : a[3]), 0xB1);
  float y = (b1 ? x23 : x01) + DPP_F((b1 ? x01 : x23), 0x4E);
  y = isdiag ? y : 0.f;
  y += DPP_F(y, 0x124);
  y += DPP_F(y, 0x128);
  y = xrow_total(y);
  const float hpre = y * scm.x * hsi;
  const float hv = gelu_fast_exact(hpre) * __uint_as_float(wq & 0xffff0000u) * scm.y;
  float m = fabsf(hv);
  m = fmaxf(m, DPP_F(m, 0xB1));
  m = fmaxf(m, DPP_F(m, 0x4E));
  unsigned eb = __float_as_uint(m) >> 23;
  eb = eb < 16u ? 16u : eb;
  const float S = __uint_as_float((261u - eb) << 23), invS = __uint_as_float((eb - 7u) << 23);
  const float hq = hv * S;
  const unsigned hb8 = (unsigned)__builtin_amdgcn_cvt_pk_fp8_f32(hq, hq, 0, false) & 0xffu;
  f32x4 e[4];
#pragma unroll
  for (int i = 0; i < 4; ++i) {
    const unsigned sb = (unsigned)__builtin_amdgcn_readlane((int)hb8, i) * 0x01010101u;
    const unsigned x = sb & mlane;
    const long a0 = mk_long(x, 0u), a1 = mk_long(0u, x);
    const long v0 = mk_long(rv[i].x, rv[i].y), v1 = mk_long(rv[i].z, rv[i].w);
    if (i == 0) {
      e[0] = __builtin_amdgcn_mfma_f32_16x16x32_fp8_fp8(a0, v0, (f32x4){0.f, 0.f, 0.f, 0.f}, 0, 0, 0);
      e[1] = __builtin_amdgcn_mfma_f32_16x16x32_fp8_fp8(a1, v0, (f32x4){0.f, 0.f, 0.f, 0.f}, 0, 0, 0);
      e[2] = __builtin_amdgcn_mfma_f32_16x16x32_fp8_fp8(a0, v1, (f32x4){0.f, 0.f, 0.f, 0.f}, 0, 0, 0);
      e[3] = __builtin_amdgcn_mfma_f32_16x16x32_fp8_fp8(a1, v1, (f32x4){0.f, 0.f, 0.f, 0.f}, 0, 0, 0);
    } else {
      e[0] = __builtin_amdgcn_mfma_f32_16x16x32_fp8_fp8(a0, v0, e[0], 0, 0, 0);
      e[1] = __builtin_amdgcn_mfma_f32_16x16x32_fp8_fp8(a1, v0, e[1], 0, 0, 0);
      e[2] = __builtin_amdgcn_mfma_f32_16x16x32_fp8_fp8(a0, v1, e[2], 0, 0, 0);
      e[3] = __builtin_amdgcn_mfma_f32_16x16x32_fp8_fp8(a1, v1, e[3], 0, 0, 0);
    }
  }
#pragma unroll
  for (int q = 0; q < 4; ++q) cur[q] += e[q] * invS;
}

__device__ __forceinline__ void o_peer_experts8_tile(const Params& p, int l, int t0, char* smem, int tid) {
  const int wave = __builtin_amdgcn_readfirstlane(tid >> 6), lane = tid & 63;
  const unsigned char* U8 = p.u8 + (size_t)l * 16384 * 1024;
  const unsigned char* V8 = p.v8 + (size_t)l * 16384 * 1024;
  const float2* ES = p.escale + (size_t)l * 16384;
  int vz = 0;
  asm volatile("" : "+v"(vz));
  const __amdgpu_buffer_rsrc_t rsU = __builtin_amdgcn_make_buffer_rsrc((void*)U8, 0, 16384 * 1024, 0x00020000);
  const __amdgpu_buffer_rsrc_t rsV = __builtin_amdgcn_make_buffer_rsrc((void*)V8, 0, 16384 * 1024, 0x00020000);
  const __amdgpu_buffer_rsrc_t rsS = __builtin_amdgcn_make_buffer_rsrc((void*)ES, 0, 16384 * 8, 0x00020000);
  const __amdgpu_buffer_rsrc_t rsU0 = __builtin_amdgcn_make_buffer_rsrc((void*)U8, 0, 0, 0x00020000);
  const __amdgpu_buffer_rsrc_t rsV0 = __builtin_amdgcn_make_buffer_rsrc((void*)V8, 0, 0, 0x00020000);
  const __amdgpu_buffer_rsrc_t rsS0 = __builtin_amdgcn_make_buffer_rsrc((void*)ES, 0, 0, 0x00020000);
  const int lo16 = lane * 16;
  const int li = lane & 3;
  const bool b0 = lane & 1, b1 = lane & 2, isdiag = (lane >> 4) == ((lane & 15) >> 2);
  const unsigned mlane = isdiag ? (0xffu << (8 * li)) : 0u;
  const unsigned oh0 = li == 0 ? 0xffffffffu : 0u, oh1 = li == 1 ? 0xffffffffu : 0u, oh2 = li == 2 ? 0xffffffffu : 0u, oh3 = li == 3 ? 0xffffffffu : 0u;
  const int s0 = ((int)(__builtin_amdgcn_s_getreg((3 << 11) | 20) & 0xF) * (EX6_NSLICE / 8)) & (EX6_NSLICE - 1);
  unsigned pk[8][2];
  h2_t acc[8][8];
  float hsi[8];
#pragma unroll
  for (int k = 0; k < 8; ++k) {
    const size_t base = (size_t)(t0 + wave * 8 + k) * 128 + lane + vz;
#pragma unroll
    for (int hf = 0; hf < 2; ++hf) pk[k][hf] = (unsigned)p.pidx[base + hf * 64] | ((unsigned)f2bf(p.pgate[base + hf * 64]) << 16);
#pragma unroll
    for (int i = 0; i < 8; ++i) acc[k][i] = (h2_t){(_Float16)0.f, (_Float16)0.f};
  }
#pragma unroll
  for (int k = 0; k < 8; ++k) {
    char* row = smem + (wave * 8 + k) * LDXB;
    const uint4 h0 = *(const uint4*)(row + lane * 32), h1 = *(const uint4*)(row + lane * 32 + 16);
    const unsigned hw[8] = {h0.x, h0.y, h0.z, h0.w, h1.x, h1.y, h1.z, h1.w};
    float mx = 0.f;
#pragma unroll
    for (int i = 0; i < 8; ++i) mx = fmaxf(mx, fmaxf(fabsf(__uint_as_float(hw[i] << 16)), fabsf(__uint_as_float(hw[i] & 0xffff0000u))));
    mx = wave_max(mx);
    unsigned eb = __float_as_uint(mx) >> 23;
    eb = eb < 16u ? 16u : (eb > 240u ? 240u : eb);
    eb = (unsigned)__builtin_amdgcn_readfirstlane((int)eb);
    const float S = __uint_as_float((261u - eb) << 23);
    hsi[k] = __uint_as_float((eb - 7u) << 23);
    unsigned o[4];
#pragma unroll
    for (int i = 0; i < 4; ++i) {
      int t = __builtin_amdgcn_cvt_pk_fp8_f32(__uint_as_float(hw[2 * i] << 16) * S, __uint_as_float(hw[2 * i] & 0xffff0000u) * S, 0, false);
      t = __builtin_amdgcn_cvt_pk_fp8_f32(__uint_as_float(hw[2 * i + 1] << 16) * S, __uint_as_float(hw[2 * i + 1] & 0xffff0000u) * S, t, true);
      o[i] = (unsigned)t;
    }
    asm volatile("s_waitcnt lgkmcnt(0)" ::: "memory");
    *(uint4*)(row + lane * 16) = make_uint4(o[0], o[1], o[2], o[3]);
  }
  asm volatile("s_waitcnt lgkmcnt(0)" ::: "memory");
#pragma unroll 1
  for (int si = 0; si < EX6_NSLICE; ++si) {
    const unsigned s = (unsigned)((s0 + si) & (EX6_NSLICE - 1));
#pragma unroll
    for (int k = 0; k < 8; ++k) {
      unsigned long long m0 = __ballot(((pk[k][0] & 0x3fffu) >> EX6_SHIFT) == s);
      unsigned long long m1 = __ballot(((pk[k][1] & 0x3fffu) >> EX6_SHIFT) == s);
      if ((m0 | m1) == 0ull) continue;
      const uint4 hb = *(const uint4*)(smem + (wave * 8 + k) * LDXB + lane * 16);
      f32x4 cur[4];
#pragma unroll
      for (int q = 0; q < 4; ++q) cur[q] = (f32x4){0.f, 0.f, 0.f, 0.f};
      uint4 uA[4], vA[4], uB[4], vB[4];
      float2 scA, scB;
      unsigned wqA, wqB;
      unsigned w[4];
      ex8_pop(m0, m1, pk[k][0], pk[k][1], w);
      __amdgpu_buffer_rsrc_t rU = rsU, rV = rsV, rS = rsS;
      EX8_ISSUE(uA, vA, scA, wqA)
      for (;;) {
        const bool mb = (m0 | m1) != 0ull;
        if (mb) ex8_pop(m0, m1, pk[k][0], pk[k][1], w);
        rU = mb ? rsU : rsU0; rV = mb ? rsV : rsV0; rS = mb ? rsS : rsS0;
        EX8_ISSUE(uB, vB, scB, wqB)
        __builtin_amdgcn_s_setprio(1);
        ex8_compute(uA, vA, scA, wqA, hb, hsi[k], cur, b0, b1, isdiag, mlane);
        __builtin_amdgcn_s_setprio(0);
        if (!mb) break;
        const bool ma = (m0 | m1) != 0ull;
        if (ma) ex8_pop(m0, m1, pk[k][0], pk[k][1], w);
        rU = ma ? rsU : rsU0; rV = ma ? rsV : rsV0; rS = ma ? rsS : rsS0;
        EX8_ISSUE(uA, vA, scA, wqA)
        __builtin_amdgcn_s_setprio(1);
        ex8_compute(uB, vB, scB, wqB, hb, hsi[k], cur, b0, b1, isdiag, mlane);
        __builtin_amdgcn_s_setprio(0);
        if (!ma) break;
      }
#pragma unroll
      for (int q = 0; q < 4; ++q) {
        acc[k][2 * q] += (h2_t){(_Float16)cur[q][0], (_Float16)cur[q][1]};
        acc[k][2 * q + 1] += (h2_t){(_Float16)cur[q][2], (_Float16)cur[q][3]};
      }
    }
  }
#pragma unroll
  for (int k = 0; k < 8; ++k) {
    float* xr = p.xres + (size_t)(t0 + wave * 8 + k) * 1024 + lane * 16;
#pragma unroll
    for (int i = 0; i < 4; ++i) {
      float4 a0 = *(float4*)(xr + 4 * i);
      a0.x += (float)acc[k][2 * i][0]; a0.y += (float)acc[k][2 * i][1];
      a0.z += (float)acc[k][2 * i + 1][0]; a0.w += (float)acc[k][2 * i + 1][1];
      *(float4*)(xr + 4 * i) = a0;
    }
  }
}

typedef unsigned v16u_t __attribute__((ext_vector_type(16)));
typedef unsigned v32u_t __attribute__((ext_vector_type(32)));
#define EX9_GEN(U_, V_, SC_, WQ_, K_, LAST_, VALID_) { \
  VALID_ = false; \
  if (!gdone) { \
    while ((m0 | m1) == 0ull) { \
      ++gk; \
      if (gk == 8) { gk = 0; ++gsi; if (gsi == EX6_NSLICE) { gdone = true; break; } } \
      gpk0 = pkv[2 * gk]; gpk1 = pkv[2 * gk + 1]; \
      const unsigned s_ = (unsigned)((s0 + gsi) & (EX6_NSLICE - 1)); \
      m0 = __ballot(((gpk0 & 0x3fffu) >> EX6_SHIFT) == s_); \
      m1 = __ballot(((gpk1 & 0x3fffu) >> EX6_SHIFT) == s_); \
    } \
    if (!gdone) { ex8_pop(m0, m1, gpk0, gpk1, w); K_ = gk; LAST_ = (m0 | m1) == 0ull; VALID_ = true; } \
  } \
  rU = VALID_ ? rsU : rsU0; rV = VALID_ ? rsV : rsV0; rS = VALID_ ? rsS : rsS0; \
  EX8_ISSUE(U_, V_, SC_, WQ_) }
#define EX9_COMPUTE(U_, V_, SC_, WQ_, K_, LAST_, VALID_) { \
  if (VALID_) { \
    if (K_ != ck) { ck = K_; hb = make_uint4(hbv[4 * K_], hbv[4 * K_ + 1], hbv[4 * K_ + 2], hbv[4 * K_ + 3]); \
                    hs = __uint_as_float((unsigned)__builtin_amdgcn_readlane((int)__float_as_uint(hsiv), K_)); } \
    __builtin_amdgcn_s_setprio(1); \
    ex8_compute(U_, V_, SC_, WQ_, hb, hs, cur, b0, b1, isdiag, mlane); \
    __builtin_amdgcn_s_setprio(0); \
    if (LAST_) { \
      char* ar_ = smem + (wave * 8 + K_) * LDXB + lane * 32; \
      uint4 a0_ = *(const uint4*)ar_, a1_ = *(const uint4*)(ar_ + 16); \
      a0_.x = ex9_addh2(a0_.x, cur[0][0], cur[0][1]); a0_.y = ex9_addh2(a0_.y, cur[0][2], cur[0][3]); \
      a0_.z = ex9_addh2(a0_.z, cur[1][0], cur[1][1]); a0_.w = ex9_addh2(a0_.w, cur[1][2], cur[1][3]); \
      a1_.x = ex9_addh2(a1_.x, cur[2][0], cur[2][1]); a1_.y = ex9_addh2(a1_.y, cur[2][2], cur[2][3]); \
      a1_.z = ex9_addh2(a1_.z, cur[3][0], cur[3][1]); a1_.w = ex9_addh2(a1_.w, cur[3][2], cur[3][3]); \
      *(uint4*)ar_ = a0_; *(uint4*)(ar_ + 16) = a1_; \
      _Pragma("unroll") for (int q_ = 0; q_ < 4; ++q_) cur[q_] = (f32x4){0.f, 0.f, 0.f, 0.f}; \
    } \
  } }
__device__ __forceinline__ unsigned ex9_addh2(unsigned a, float x, float y) {
  const h2_t r = __builtin_bit_cast(h2_t, a) + (h2_t){(_Float16)x, (_Float16)y};
  return __builtin_bit_cast(unsigned, r);
}

__device__ __forceinline__ void o_peer_experts9_tile(const Params& p, int l, int t0, char* smem, int tid) {
  const int wave = __builtin_amdgcn_readfirstlane(tid >> 6), lane = tid & 63;
  const unsigned char* U8 = p.u8 + (size_t)l * 16384 * 1024;
  const unsigned char* V8 = p.v8 + (size_t)l * 16384 * 1024;
  const float2* ES = p.escale + (size_t)l * 16384;
  int vz = 0;
  asm volatile("" : "+v"(vz));
  const __amdgpu_buffer_rsrc_t rsU = __builtin_amdgcn_make_buffer_rsrc((void*)U8, 0, 16384 * 1024, 0x00020000);
  const __amdgpu_buffer_rsrc_t rsV = __builtin_amdgcn_make_buffer_rsrc((void*)V8, 0, 16384 * 1024, 0x00020000);
  const __amdgpu_buffer_rsrc_t rsS = __builtin_amdgcn_make_buffer_rsrc((void*)ES, 0, 16384 * 8, 0x00020000);
  const __amdgpu_buffer_rsrc_t rsU0 = __builtin_amdgcn_make_buffer_rsrc((void*)U8, 0, 0, 0x00020000);
  const __amdgpu_buffer_rsrc_t rsV0 = __builtin_amdgcn_make_buffer_rsrc((void*)V8, 0, 0, 0x00020000);
  const __amdgpu_buffer_rsrc_t rsS0 = __builtin_amdgcn_make_buffer_rsrc((void*)ES, 0, 0, 0x00020000);
  const int lo16 = lane * 16;
  const int li = lane & 3;
  const bool b0 = lane & 1, b1 = lane & 2, isdiag = (lane >> 4) == ((lane & 15) >> 2);
  const unsigned mlane = isdiag ? (0xffu << (8 * li)) : 0u;
  const unsigned oh0 = li == 0 ? 0xffffffffu : 0u, oh1 = li == 1 ? 0xffffffffu : 0u, oh2 = li == 2 ? 0xffffffffu : 0u, oh3 = li == 3 ? 0xffffffffu : 0u;
  const int s0 = ((int)(__builtin_amdgcn_s_getreg((3 << 11) | 20) & 0xF) * (EX6_NSLICE / 8)) & (EX6_NSLICE - 1);
  v16u_t pkv;
  v32u_t hbv;
  float hsiv = 0.f;
#pragma unroll
  for (int k = 0; k < 8; ++k) {
    const size_t base = (size_t)(t0 + wave * 8 + k) * 128 + lane + vz;
#pragma unroll
    for (int hf = 0; hf < 2; ++hf) pkv[2 * k + hf] = (unsigned)p.pidx[base + hf * 64] | ((unsigned)f2bf(p.pgate[base + hf * 64]) << 16);
  }
#pragma unroll
  for (int k = 0; k < 8; ++k) {
    char* row = smem + (wave * 8 + k) * LDXB;
    const uint4 h0 = *(const uint4*)(row + lane * 32), h1 = *(const uint4*)(row + lane * 32 + 16);
    const unsigned hw[8] = {h0.x, h0.y, h0.z, h0.w, h1.x, h1.y, h1.z, h1.w};
    float mx = 0.f;
#pragma unroll
    for (int i = 0; i < 8; ++i) mx = fmaxf(mx, fmaxf(fabsf(__uint_as_float(hw[i] << 16)), fabsf(__uint_as_float(hw[i] & 0xffff0000u))));
    mx = wave_max(mx);
    unsigned eb = __float_as_uint(mx) >> 23;
    eb = eb < 16u ? 16u : (eb > 240u ? 240u : eb);
    const float S = __uint_as_float((261u - eb) << 23);
    hsiv = (lane == k) ? __uint_as_float((eb - 7u) << 23) : hsiv;
#pragma unroll
    for (int i = 0; i < 4; ++i) {
      int t = __builtin_amdgcn_cvt_pk_fp8_f32(__uint_as_float(hw[2 * i] << 16) * S, __uint_as_float(hw[2 * i] & 0xffff0000u) * S, 0, false);
      t = __builtin_amdgcn_cvt_pk_fp8_f32(__uint_as_float(hw[2 * i + 1] << 16) * S, __uint_as_float(hw[2 * i + 1] & 0xffff0000u) * S, t, true);
      hbv[4 * k + i] = (unsigned)t;
    }
    asm volatile("s_waitcnt lgkmcnt(0)" ::: "memory");
    *(uint4*)(row + lane * 32) = make_uint4(0u, 0u, 0u, 0u);
    *(uint4*)(row + lane * 32 + 16) = make_uint4(0u, 0u, 0u, 0u);
  }
  int gsi = 0, gk = -1;
  bool gdone = false;
  unsigned long long m0 = 0ull, m1 = 0ull;
  unsigned gpk0 = 0u, gpk1 = 0u;
  unsigned w[4] = {0u, 0u, 0u, 0u};
  __amdgpu_buffer_rsrc_t rU = rsU, rV = rsV, rS = rsS;
  uint4 uA[4], vA[4], uB[4], vB[4], uC[4], vC[4];
  float2 scA, scB, scC;
  unsigned wqA, wqB, wqC;
  int kA = 0, kB = 0, kC = 0;
  bool lastA = false, lastB = false, lastC = false, validA, validB, validC;
  int ck = -1;
  uint4 hb = make_uint4(0u, 0u, 0u, 0u);
  float hs = 0.f;
  f32x4 cur[4];
#pragma unroll
  for (int q = 0; q < 4; ++q) cur[q] = (f32x4){0.f, 0.f, 0.f, 0.f};
  EX9_GEN(uA, vA, scA, wqA, kA, lastA, validA)
  EX9_GEN(uB, vB, scB, wqB, kB, lastB, validB)
#pragma unroll 1
  for (;;) {
    EX9_GEN(uC, vC, scC, wqC, kC, lastC, validC)
    EX9_COMPUTE(uA, vA, scA, wqA, kA, lastA, validA)
    EX9_GEN(uA, vA, scA, wqA, kA, lastA, validA)
    EX9_COMPUTE(uB, vB, scB, wqB, kB, lastB, validB)
    EX9_GEN(uB, vB, scB, wqB, kB, lastB, validB)
    EX9_COMPUTE(uC, vC, scC, wqC, kC, lastC, validC)
    if (!validA && !validB) break;
  }
  asm volatile("s_waitcnt lgkmcnt(0)" ::: "memory");
#pragma unroll
  for (int k = 0; k < 8; ++k) {
    const char* ar = smem + (wave * 8 + k) * LDXB + lane * 32;
    const uint4 a0 = *(const uint4*)ar, a1 = *(const uint4*)(ar + 16);
    const unsigned aw[8] = {a0.x, a0.y, a0.z, a0.w, a1.x, a1.y, a1.z, a1.w};
    float* xr = p.xres + (size_t)(t0 + wave * 8 + k) * 1024 + lane * 16;
#pragma unroll
    for (int i = 0; i < 4; ++i) {
      float4 x4 = *(float4*)(xr + 4 * i);
      const h2_t c0 = __builtin_bit_cast(h2_t, aw[2 * i]), c1 = __builtin_bit_cast(h2_t, aw[2 * i + 1]);
      x4.x += (float)c0[0]; x4.y += (float)c0[1]; x4.z += (float)c1[0]; x4.w += (float)c1[1];
      *(float4*)(xr + 4 * i) = x4;
    }
  }
}

__device__ __forceinline__ unsigned xrow_umax(unsigned y) {
  const u32x2_t r = __builtin_amdgcn_permlane16_swap(y, y, false, false);
  const unsigned z = r[0] > r[1] ? r[0] : r[1];
  const u32x2_t r2 = __builtin_amdgcn_permlane32_swap(z, z, false, false);
  return r2[0] > r2[1] ? r2[0] : r2[1];
}
#define EXB_ISSUE(U_, V_, SC_, WQ_) { \
  const unsigned wu_ = (w[0] & ou0) | (w[1] & ou1) | (w[2] & ou2) | (w[3] & ou3); \
  const int vu_ = (int)((wu_ & 0x3fffu) << 10) + cu; \
  _Pragma("unroll") for (int m_ = 0; m_ < 4; ++m_) U_[m_] = __builtin_bit_cast(uint4, __builtin_amdgcn_raw_buffer_load_b128(rU, vu_ + 256 * m_, 0, 0)); \
  WQ_ = (w[0] & og0) | (w[1] & og1) | (w[2] & og2) | (w[3] & og3); \
  SC_ = __builtin_bit_cast(float2, __builtin_amdgcn_raw_buffer_load_b64(rS, (int)(WQ_ & 0x3fffu) * 8, 0, 0)); \
  _Pragma("unroll") for (int i_ = 0; i_ < 4; ++i_) V_[i_] = __builtin_bit_cast(uint4, __builtin_amdgcn_raw_buffer_load_b128(rV, lo16, (int)(w[i_] & 0x3fffu) * 1024, 0)); }

__device__ __forceinline__ void exB_compute(const uint4 (&ru)[4], const uint4 (&rv)[4], const float2 scm, const unsigned wq,
                                            const unsigned (&hb)[16], const float hsi, f32x4 (&cur)[4],
                                            const bool b0, const bool b1, const unsigned mlane) {
  f32x4 d = (f32x4){0.f, 0.f, 0.f, 0.f};
#pragma unroll
  for (int m = 0; m < 4; ++m) {
    d = __builtin_amdgcn_mfma_f32_16x16x32_fp8_fp8(mk_long(ru[m].x, ru[m].y), mk_long(hb[4 * m], hb[4 * m + 1]), d, 0, 0, 0);
    d = __builtin_amdgcn_mfma_f32_16x16x32_fp8_fp8(mk_long(ru[m].z, ru[m].w), mk_long(hb[4 * m + 2], hb[4 * m + 3]), d, 0, 0, 0);
  }
  const float val = b1 ? (b0 ? d[3] : d[2]) : (b0 ? d[1] : d[0]);
  float y = val + DPP_F(val, 0xB1);
  y += DPP_F(y, 0x4E);
  const float hpre = y * scm.x * hsi;
  const float hv = gelu_fast_exact(hpre) * __uint_as_float(wq & 0xffff0000u) * scm.y;
  unsigned eb = xrow_umax(__float_as_uint(hv) & 0x7fffffffu) >> 23;
  eb = eb < 16u ? 16u : eb;
  const float S = __uint_as_float((261u - eb) << 23), invS = __uint_as_float((eb - 7u) << 23);
  const float hq = hv * S;
  const unsigned hb8 = (unsigned)__builtin_amdgcn_cvt_pk_fp8_f32(hq, hq, 0, false) & 0xffu;
  f32x4 e[4];
#pragma unroll
  for (int i = 0; i < 4; ++i) {
    const unsigned sb = (unsigned)__builtin_amdgcn_readlane((int)hb8, 16 * i) * 0x01010101u;
    const unsigned x = sb & mlane;
    const long a0 = mk_long(x, 0u), a1 = mk_long(0u, x);
    const long v0 = mk_long(rv[i].x, rv[i].y), v1 = mk_long(rv[i].z, rv[i].w);
    if (i == 0) {
      e[0] = __builtin_amdgcn_mfma_f32_16x16x32_fp8_fp8(a0, v0, (f32x4){0.f, 0.f, 0.f, 0.f}, 0, 0, 0);
      e[1] = __builtin_amdgcn_mfma_f32_16x16x32_fp8_fp8(a1, v0, (f32x4){0.f, 0.f, 0.f, 0.f}, 0, 0, 0);
      e[2] = __builtin_amdgcn_mfma_f32_16x16x32_fp8_fp8(a0, v1, (f32x4){0.f, 0.f, 0.f, 0.f}, 0, 0, 0);
      e[3] = __builtin_amdgcn_mfma_f32_16x16x32_fp8_fp8(a1, v1, (f32x4){0.f, 0.f, 0.f, 0.f}, 0, 0, 0);
    } else {
      e[0] = __builtin_amdgcn_mfma_f32_16x16x32_fp8_fp8(a0, v0, e[0], 0, 0, 0);
      e[1] = __builtin_amdgcn_mfma_f32_16x16x32_fp8_fp8(a1, v0, e[1], 0, 0, 0);
      e[2] = __builtin_amdgcn_mfma_f32_16x16x32_fp8_fp8(a0, v1, e[2], 0, 0, 0);
      e[3] = __builtin_amdgcn_mfma_f32_16x16x32_fp8_fp8(a1, v1, e[3], 0, 0, 0);
    }
  }
#pragma unroll
  for (int q = 0; q < 4; ++q) cur[q] += e[q] * invS;
}

__device__ __forceinline__ void o_peer_expertsB_tile(const Params& p, int l, int t0, char* smem, int tid) {
  const int wave = __builtin_amdgcn_readfirstlane(tid >> 6), lane = tid & 63;
  const unsigned char* U8 = p.u8 + (size_t)l * 16384 * 1024;
  const unsigned char* V8 = p.v8 + (size_t)l * 16384 * 1024;
  const float2* ES = p.escale + (size_t)l * 16384;
  int vz = 0;
  asm volatile("" : "+v"(vz));
  const __amdgpu_buffer_rsrc_t rsU = __builtin_amdgcn_make_buffer_rsrc((void*)U8, 0, 16384 * 1024, 0x00020000);
  const __amdgpu_buffer_rsrc_t rsV = __builtin_amdgcn_make_buffer_rsrc((void*)V8, 0, 16384 * 1024, 0x00020000);
  const __amdgpu_buffer_rsrc_t rsS = __builtin_amdgcn_make_buffer_rsrc((void*)ES, 0, 16384 * 8, 0x00020000);
  const __amdgpu_buffer_rsrc_t rsU0 = __builtin_amdgcn_make_buffer_rsrc((void*)U8, 0, 0, 0x00020000);
  const __amdgpu_buffer_rsrc_t rsV0 = __builtin_amdgcn_make_buffer_rsrc((void*)V8, 0, 0, 0x00020000);
  const __amdgpu_buffer_rsrc_t rsS0 = __builtin_amdgcn_make_buffer_rsrc((void*)ES, 0, 0, 0x00020000);
  const int lo16 = lane * 16;
  const int li = lane & 3, iu = (lane & 15) >> 2, ig = lane >> 4;
  const bool b0 = lane & 1, b1 = lane & 2, isdiag = ig == iu;
  const unsigned mlane = isdiag ? (0xffu << (8 * li)) : 0u;
  const unsigned ou0 = iu == 0 ? 0xffffffffu : 0u, ou1 = iu == 1 ? 0xffffffffu : 0u, ou2 = iu == 2 ? 0xffffffffu : 0u, ou3 = iu == 3 ? 0xffffffffu : 0u;
  const unsigned og0 = ig == 0 ? 0xffffffffu : 0u, og1 = ig == 1 ? 0xffffffffu : 0u, og2 = ig == 2 ? 0xffffffffu : 0u, og3 = ig == 3 ? 0xffffffffu : 0u;
  const int cu = li * 64 + ig * 16;
  const int hoff = (li * 4 + ig) * 64;
  const int s0 = ((int)(__builtin_amdgcn_s_getreg((3 << 11) | 20) & 0xF) * (EX6_NSLICE / 8)) & (EX6_NSLICE - 1);
  unsigned pk[8][2];
  h2_t acc[8][8];
  float hsi[8];
#pragma unroll
  for (int k = 0; k < 8; ++k) {
    const size_t base = (size_t)(t0 + wave * 8 + k) * 128 + lane + vz;
#pragma unroll
    for (int hf = 0; hf < 2; ++hf) pk[k][hf] = (unsigned)p.pidx[base + hf * 64] | ((unsigned)f2bf(p.pgate[base + hf * 64]) << 16);
#pragma unroll
    for (int i = 0; i < 8; ++i) acc[k][i] = (h2_t){(_Float16)0.f, (_Float16)0.f};
  }
  {
    const int dst0 = (((lane >> 2) & 3) * 4 + (lane & 3)) * 64 + (lane >> 4) * 16;
#pragma unroll
    for (int k = 0; k < 8; ++k) {
      char* row = smem + (wave * 8 + k) * LDXB;
      const uint4 h0 = *(const uint4*)(row + lane * 32), h1 = *(const uint4*)(row + lane * 32 + 16);
      const unsigned hw[8] = {h0.x, h0.y, h0.z, h0.w, h1.x, h1.y, h1.z, h1.w};
      float mx = 0.f;
#pragma unroll
      for (int i = 0; i < 8; ++i) mx = fmaxf(mx, fmaxf(fabsf(__uint_as_float(hw[i] << 16)), fabsf(__uint_as_float(hw[i] & 0xffff0000u))));
      mx = wave_max(mx);
      unsigned eb = __float_as_uint(mx) >> 23;
      eb = eb < 16u ? 16u : (eb > 240u ? 240u : eb);
      eb = (unsigned)__builtin_amdgcn_readfirstlane((int)eb);
      const float S = __uint_as_float((261u - eb) << 23);
      hsi[k] = __uint_as_float((eb - 7u) << 23);
      unsigned o[4];
#pragma unroll
      for (int i = 0; i < 4; ++i) {
        int t = __builtin_amdgcn_cvt_pk_fp8_f32(__uint_as_float(hw[2 * i] << 16) * S, __uint_as_float(hw[2 * i] & 0xffff0000u) * S, 0, false);
        t = __builtin_amdgcn_cvt_pk_fp8_f32(__uint_as_float(hw[2 * i + 1] << 16) * S, __uint_as_float(hw[2 * i + 1] & 0xffff0000u) * S, t, true);
        o[i] = (unsigned)t;
      }
      asm volatile("s_waitcnt lgkmcnt(0)" ::: "memory");
      *(uint4*)(row + dst0) = make_uint4(o[0], o[1], o[2], o[3]);
    }
  }
  asm volatile("s_waitcnt lgkmcnt(0)" ::: "memory");
#pragma unroll 1
  for (int si = 0; si < EX6_NSLICE; ++si) {
    const unsigned s = (unsigned)((s0 + si) & (EX6_NSLICE - 1));
#pragma unroll
    for (int k = 0; k < 8; ++k) {
      unsigned long long m0 = __ballot(((pk[k][0] & 0x3fffu) >> EX6_SHIFT) == s);
      unsigned long long m1 = __ballot(((pk[k][1] & 0x3fffu) >> EX6_SHIFT) == s);
      if ((m0 | m1) == 0ull) continue;
      unsigned hb[16];
      {
        const char* hr = smem + (wave * 8 + k) * LDXB + hoff;
#pragma unroll
        for (int i = 0; i < 4; ++i) {
          const uint4 t = *(const uint4*)(hr + 16 * i);
          hb[4 * i] = t.x; hb[4 * i + 1] = t.y; hb[4 * i + 2] = t.z; hb[4 * i + 3] = t.w;
        }
      }
      f32x4 cur[4];
#pragma unroll
      for (int q = 0; q < 4; ++q) cur[q] = (f32x4){0.f, 0.f, 0.f, 0.f};
      uint4 uA[4], uB[4];
      uint4 vA[4], vB[4];
      float2 scA, scB;
      unsigned wqA, wqB;
      unsigned w[4];
      ex8_pop(m0, m1, pk[k][0], pk[k][1], w);
      __amdgpu_buffer_rsrc_t rU = rsU, rV = rsV, rS = rsS;
      EXB_ISSUE(uA, vA, scA, wqA)
      for (;;) {
        const bool mb = (m0 | m1) != 0ull;
        if (mb) ex8_pop(m0, m1, pk[k][0], pk[k][1], w);
        rU = mb ? rsU : rsU0; rV = mb ? rsV : rsV0; rS = mb ? rsS : rsS0;
        EXB_ISSUE(uB, vB, scB, wqB)
        __builtin_amdgcn_s_setprio(1);
        exB_compute(uA, vA, scA, wqA, hb, hsi[k], cur, b0, b1, mlane);
        __builtin_amdgcn_s_setprio(0);
        if (!mb) break;
        const bool ma = (m0 | m1) != 0ull;
        if (ma) ex8_pop(m0, m1, pk[k][0], pk[k][1], w);
        rU = ma ? rsU : rsU0; rV = ma ? rsV : rsV0; rS = ma ? rsS : rsS0;
        EXB_ISSUE(uA, vA, scA, wqA)
        __builtin_amdgcn_s_setprio(1);
        exB_compute(uB, vB, scB, wqB, hb, hsi[k], cur, b0, b1, mlane);
        __builtin_amdgcn_s_setprio(0);
        if (!ma) break;
      }
#pragma unroll
      for (int q = 0; q < 4; ++q) {
        acc[k][2 * q] += (h2_t){(_Float16)cur[q][0], (_Float16)cur[q][1]};
        acc[k][2 * q + 1] += (h2_t){(_Float16)cur[q][2], (_Float16)cur[q][3]};
      }
    }
  }
#pragma unroll
  for (int k = 0; k < 8; ++k) {
    float* xr = p.xres + (size_t)(t0 + wave * 8 + k) * 1024 + lane * 16;
#pragma unroll
    for (int i = 0; i < 4; ++i) {
      float4 a0 = *(float4*)(xr + 4 * i);
      a0.x += (float)acc[k][2 * i][0]; a0.y += (float)acc[k][2 * i][1];
      a0.z += (float)acc[k][2 * i + 1][0]; a0.w += (float)acc[k][2 * i + 1][1];
      *(float4*)(xr + 4 * i) = a0;
    }
  }
}

#define XB_TMO      128
#define XB_XCNT(j)  (256  + 64 * (j))
#define XB_XSUB(j)  (1280 + 64 * (j))
#define XB_XGEN(j)  (2304 + 64 * (j))
#define XB_TOP      3328
#define XB_TOPGEN   3392
#define XCD_BAR_WORDS 3456
#define XB_SPIN_CAP (1u << 22)
#ifndef LAS
#define LAS __attribute__((address_space(3)))
#endif
__device__ __forceinline__ unsigned xb_ld(unsigned* p)              { return __hip_atomic_load(p, __ATOMIC_RELAXED, __HIP_MEMORY_SCOPE_AGENT); }
__device__ __forceinline__ unsigned xb_add(unsigned* p, unsigned v) { return __hip_atomic_fetch_add(p, v, __ATOMIC_RELAXED, __HIP_MEMORY_SCOPE_AGENT); }
__device__ __forceinline__ unsigned xb_xcc_id() { return (unsigned)__builtin_amdgcn_s_getreg((3 << 11) | 20) & 0xFu; }
#define XB_SPIN(cond, bar) do { unsigned _sp = 0; while (cond) { __builtin_amdgcn_s_sleep(1); \
    if ((++_sp & 255u) == 0u) { if (xb_ld(&(bar)[XB_TMO])) break; if (_sp > XB_SPIN_CAP) { atomicAdd(&(bar)[XB_TMO], 1u); break; } } } } while (0)
struct XcdBarrier { unsigned* bar; unsigned x; volatile LAS unsigned* st; };
__device__ __forceinline__ XcdBarrier xcd_barrier_post(unsigned* bar, volatile LAS unsigned* st, int tid) {
  XcdBarrier b; b.bar = bar; b.x = xb_xcc_id(); b.st = st;
  if (tid == 0) (void)xb_add(&bar[XB_XCNT(b.x)], 1u);
  return b;
}
__device__ __forceinline__ void xcd_barrier_complete(unsigned* bar, unsigned x, unsigned& nloc, unsigned& nx) {
  const unsigned G = gridDim.x * gridDim.y * gridDim.z;
  unsigned sum, cnt, mine, sp = 0u;
  for (;;) {
    sum = 0u; cnt = 0u; mine = 0u;
#pragma unroll
    for (unsigned j = 0; j < 16; ++j) { const unsigned c = xb_ld(&bar[XB_XCNT(j)]); sum += c; cnt += (c > 0u) ? 1u : 0u; mine = (j == x) ? c : mine; }
    if (sum == G) break;
    __builtin_amdgcn_s_sleep(1);
    if ((++sp & 255u) == 0u) { if (xb_ld(&bar[XB_TMO])) break; if (sp > XB_SPIN_CAP) { atomicAdd(&bar[XB_TMO], 1u); break; } }
  }
  nloc = mine > 0u ? mine : 1u; nx = cnt > 0u ? cnt : 1u;
}
__device__ __forceinline__ void xcd_barrier(const XcdBarrier& b, int tid) {
  asm volatile("s_waitcnt vmcnt(0)" ::: "memory");
  __syncthreads();
  if (tid == 0) {
    unsigned* bar = b.bar;
    __builtin_amdgcn_s_waitcnt(0);
    unsigned nloc = b.st[0], nx = b.st[1];
    if (nloc == 0u) { xcd_barrier_complete(bar, b.x, nloc, nx); b.st[0] = nloc; b.st[1] = nx; }
    const unsigned old = xb_add(&bar[XB_XSUB(b.x)], 1u);
    const unsigned gen = old / nloc;
    if (old + 1u == (gen + 1u) * nloc) {
      __builtin_amdgcn_fence(__ATOMIC_RELEASE, "agent");
      asm volatile("s_waitcnt vmcnt(0)" ::: "memory");
      const unsigned og = xb_add(&bar[XB_TOP], 1u);
      const unsigned tg = og / nx;
      if (og + 1u == (tg + 1u) * nx) xb_add(&bar[XB_TOPGEN], 1u);
      else XB_SPIN(xb_ld(&bar[XB_TOPGEN]) == tg, bar);
      __builtin_amdgcn_fence(__ATOMIC_ACQUIRE, "agent");
      xb_add(&bar[XB_XGEN(b.x)], 1u);
      asm volatile("s_waitcnt vmcnt(0)" ::: "memory");
    } else {
      XB_SPIN(xb_ld(&bar[XB_XGEN(b.x)]) == gen, bar);
      __builtin_amdgcn_fence(__ATOMIC_ACQUIRE, "agent");
      asm volatile("s_waitcnt vmcnt(0)" ::: "memory");
    }
  }
  __syncthreads();
}


__global__ void __launch_bounds__(NTHREADS) fwd_megakernel(Params p) {
  cg::grid_group grid = cg::this_grid();
  extern __shared__ __attribute__((aligned(16))) float smem[];
  const int wv_ = __builtin_amdgcn_readfirstlane((int)(threadIdx.x >> 6));
  volatile LAS unsigned* xb_st = (volatile LAS unsigned*)((LAS char*)(LAS float*)smem + (160 * 1024 - 16));
  if (threadIdx.x == 0) { xb_st[0] = 0u; xb_st[1] = 0u; }
  __syncthreads();
  const XcdBarrier xb = xcd_barrier_post(p.bar, xb_st, (int)threadIdx.x);
#define GRID_BARRIER() xcd_barrier(xb, opaque_tid(wv_))

  o_prep(wv_, p, smem);
  if (gridDim.x > 4096u) grid.sync();
  GRID_BARRIER();
#pragma unroll 1
  for (int l = 0; l < DEPTH; ++l) {
    const float* xcur = (l == 0) ? p.x_in : p.xres;
    o_p1(wv_, p, l, xcur, (char*)smem);
    GRID_BARRIER();
    {
    {
      const int bidx_ = opaque_bid();
      const bool affine = (gridDim.x == 256u);
      for (int task = bidx_; task < 1792; task += gridDim.x) {
        const int l_ = opaque_s(l), td_ = opaque_tid(wv_);
        int tk = task;
        if (affine) {
          const int x = bidx_ & 7, lb = bidx_ >> 3, j = task >> 8;
          if (j < 4) { const int idx = lb + 32 * j; tk = ((x * 2 + (idx >> 6)) << 6) | (idx & 63); }
          else if (j < 6) { const int idx = lb + 32 * (j - 4); tk = 1024 + (((x * 2 + (idx >> 5)) << 5) | (idx & 31)); }
          else tk = 1536 + x * 32 + lb;
        }
        const int tk_ = opaque_s(tk);
        if (tk_ < 1024) o_na_task(p, l_, tk_, (char*)smem, td_);
        else if (tk_ < 1536) o_ret_kv_task(p, l_, tk_ - 1024, (char*)smem, td_);
        else o_pool_task(p, l_, tk_ - 1536, (char*)smem, td_);
      }
    }
    GRID_BARRIER();
    o_ret_scan(wv_, p, l);
    GRID_BARRIER();
    {
      const int tidx_ = opaque_tid(wv_); const int bidx_ = opaque_bid();
      for (int task = bidx_; task < 512; task += gridDim.x) {
        int tk = task;
        if (gridDim.x == 256u) {
          const int x = bidx_ & 7, lb = bidx_ >> 3, idx = lb + 32 * (task >> 8);
          tk = ((x * 2 + (idx >> 5)) << 5) | (idx & 31);
        }
        o_ret_out_task(p, l, opaque_s(tk), (char*)smem, tidx_);
      }
    }
    GRID_BARRIER();
    }
    {
      const int tidx_ = opaque_tid(wv_); const int bidx_ = opaque_bid();
      for (int tile = bidx_; tile < NTOK / 64; tile += gridDim.x) {
        { const int t0_ = opaque_s(tile * 64), l_ = opaque_s(l), td_ = opaque_tid(wv_); o_p5a1_tile(p, l_, t0_, (char*)smem, td_); }
        { const int t0_ = opaque_s(tile * 64), l_ = opaque_s(l), td_ = opaque_tid(wv_); o_p5a2_tile(p, l_, xcur, t0_, (char*)smem, td_); }
        { const int t0_ = opaque_s(tile * 64), l_ = opaque_s(l), td_ = opaque_tid(wv_); o_p5a3_tile(p, l_, t0_, (char*)smem, td_); }
        { const int t0_ = opaque_s(tile * 64), l_ = opaque_s(l), td_ = opaque_tid(wv_); o_peer_select_tile(p, l_, t0_, (char*)smem, td_); }
        { const int t0_ = opaque_s(tile * 64), l_ = opaque_s(l), td_ = opaque_tid(wv_); o_peer_select2_tile(p, l_, t0_, td_); }
        asm volatile("s_waitcnt vmcnt(0)" ::: "memory");
        __syncthreads();
        { const int t0_ = opaque_s(tile * 64), l_ = opaque_s(l), td_ = opaque_tid(wv_); o_peer_expertsB_tile(p, l_, t0_, (char*)smem, td_); }
        if (l + 1 == DEPTH) {
          asm volatile("s_waitcnt vmcnt(0)" ::: "memory");
          const int t0_ = opaque_s(tile * 64), td_ = opaque_tid(wv_);
          o_final_norm_tile(p, t0_, td_);
        }
      }
    }
    if (l + 1 < DEPTH) GRID_BARRIER();
  }
}

extern "C" void kernel_launch(void* const* d_in, const int* in_sizes, int n_in, void* d_out, int out_size,
                              void* d_ws, size_t ws_size, hipStream_t stream) {
  Params p{};
  p.x_in = (const float*)d_in[0]; p.norm_mix = (const float*)d_in[1]; p.w_in = (const float*)d_in[2];
  p.pool_w = (const float*)d_in[3]; p.pool_scale = (const float*)d_in[4]; p.ret_decay = (const float*)d_in[5];
  p.na_rpb = (const float*)d_in[6]; p.w_br_pool = (const float*)d_in[7]; p.w_br_ret = (const float*)d_in[8];
  p.w_br_na = (const float*)d_in[9]; p.w_out = (const float*)d_in[10]; p.norm_ffn = (const float*)d_in[11];
  p.w_query = (const float*)d_in[12]; p.sub_keys = (const float*)d_in[13]; p.peer_u = (const float*)d_in[14];
  p.peer_v = (const float*)d_in[15]; p.norm_final = (const float*)d_in[16];
  p.out = (float*)d_out;
  char* ws = (char*)d_ws;
  size_t off = 0;
  auto alloc = [&](size_t bytes) { char* q = ws + off; off += (bytes + 255) & ~(size_t)255; return q; };
  p.xres = (float*)alloc((size_t)NTOK * D_MODEL * 4);
  p.proj = (bf16_t*)alloc((size_t)NTOK * IN_WIDTH * 2);
  p.ycat = (bf16_t*)alloc((size_t)NTOK * 1024 * 2);
  p.mrg = (bf16_t*)alloc((size_t)NTOK * 1024 * 2);
  p.pidx = (int*)alloc((size_t)NTOK * 128 * 4);
  p.pgate = (float*)alloc((size_t)NTOK * 128 * 4);
  p.wf_in = (bf16_t*)alloc((size_t)DEPTH * D_MODEL * IN_WIDTH * 2);
  p.wf_br = (bf16_t*)alloc((size_t)DEPTH * 1024 * 1024 * 2);
  p.wf_out = (bf16_t*)alloc((size_t)DEPTH * 1024 * 1024 * 2);
  p.wf_q = (bf16_t*)alloc((size_t)DEPTH * 1024 * 2048 * 2);
  p.kf = (bf16_t*)alloc((size_t)DEPTH * 2 * 128 * 128 * 2);
  p.u16 = nullptr; p.v16 = nullptr;
  p.u8 = (unsigned char*)alloc((size_t)DEPTH * 16384 * 1024);
  p.v8 = (unsigned char*)alloc((size_t)DEPTH * 16384 * 1024);
  p.escale = (float2*)alloc((size_t)DEPTH * 16384 * 8);
  p.rope = (float2*)alloc((size_t)SEQ * 32 * 8);
  p.tklist = (unsigned*)alloc((size_t)NTOK * 8 * 2 * 16 * 4);
  p.kvst = (float*)p.mrg;
  p.rstate = (bf16_t*)p.tklist;
  p.bar = (unsigned*)alloc(XCD_BAR_WORDS * 4);
  p.xn = nullptr; p.merged = nullptr; p.pq = nullptr; p.psc = nullptr;
  if (off > ws_size) fprintf(stderr, "WORKSPACE OVERFLOW: need %zu have %zu\n", off, ws_size);

  const size_t kDynLds = 160 * 1024;
  static int grid_blocks = 0;
  if (!grid_blocks) {
    int dev = 0, cus = 0, per_cu = 0;
    (void)hipGetDevice(&dev);
    (void)hipDeviceGetAttribute(&cus, hipDeviceAttributeMultiprocessorCount, dev);
    (void)hipFuncSetAttribute((const void*)fwd_megakernel, hipFuncAttributeMaxDynamicSharedMemorySize, (int)kDynLds);
    (void)hipOccupancyMaxActiveBlocksPerMultiprocessor(&per_cu, fwd_megakernel, NTHREADS, kDynLds);
    if (per_cu < 1) per_cu = 1;
    grid_blocks = cus * per_cu;
  }
  (void)hipMemsetAsync(p.bar, 0, XCD_BAR_WORDS * 4, stream);
  void* args[] = {&p};
  hipError_t e = hipLaunchCooperativeKernel((void*)fwd_megakernel, dim3(grid_blocks), dim3(NTHREADS), args, kDynLds, stream);
  if (e != hipSuccess) fprintf(stderr, "cooperative launch failed: %s (grid %d)\n", hipGetErrorString(e), grid_blocks);
}
```

```cpp
#include <hip/hip_runtime.h>
#include <hip/hip_cooperative_groups.h>
#include <stdint.h>
#include <cstdio>
namespace cg = cooperative_groups;

#define D_MODEL 1024
#define SEQ 4096
#define BATCH 4
#define NTOK (BATCH * SEQ)
#define DEPTH 2
#define IN_WIDTH 5632
#define C_POOL 0
#define C_RQ 256
#define C_RK 512
#define C_RV 768
#define C_RG 1280
#define C_NQ 1792
#define C_NK 2048
#define C_NV 2304
#define C_GATE 2560
#define EPS 1e-6f
#define NTHREADS 512

typedef unsigned short bf16_t;

struct Params {
  const float* x_in; const float* norm_mix; const float* w_in; const float* pool_w; const float* pool_scale;
  const float* ret_decay; const float* na_rpb; const float* w_br_pool; const float* w_br_ret; const float* w_br_na;
  const float* w_out; const float* norm_ffn; const float* w_query; const float* sub_keys; const float* peer_u;
  const float* peer_v; const float* norm_final;
  float* out;
  float* xres;
  bf16_t* xn;
  bf16_t* proj;
  bf16_t* ycat;
  float* merged;
  float* pq;
  float* psc;
  int* pidx;
  float* pgate;
  bf16_t* wf_in;
  bf16_t* wf_br;
  bf16_t* wf_out;
  bf16_t* wf_q;
  bf16_t* kf;
  bf16_t* u16;
  bf16_t* v16;
  float2* rope;
  bf16_t* mrg;
  unsigned* tklist;
  float* kvst;
  bf16_t* rstate;
  unsigned* bar;
  unsigned char* u8; unsigned char* v8;
  float2* escale;
};

__device__ __forceinline__ bf16_t f2bf(float f) {
  unsigned u = __float_as_uint(f);
  u += 0x7fffu + ((u >> 16) & 1u);
  return (bf16_t)(u >> 16);
}
__device__ __forceinline__ float bf2f(bf16_t h) { return __uint_as_float(((unsigned)h) << 16); }

__device__ __forceinline__ float wave_sum(float v) {
#pragma unroll
  for (int o = 32; o > 0; o >>= 1) v += __shfl_xor(v, o, 64);
  return v;
}
__device__ __forceinline__ float wave_max(float v) {
#pragma unroll
  for (int o = 32; o > 0; o >>= 1) v = fmaxf(v, __shfl_xor(v, o, 64));
  return v;
}
__device__ __forceinline__ float sigmoidf_(float x) { return 1.0f / (1.0f + expf(-x)); }

__device__ __forceinline__ int opaque_tid(int wv) {
  int w = wv;
  asm volatile("" : "+s"(w));
  int lane = __builtin_amdgcn_mbcnt_hi(~0u, __builtin_amdgcn_mbcnt_lo(~0u, 0u));
  asm volatile("" : "+v"(lane));
  return w * 64 + lane;
}
__device__ __forceinline__ int opaque_s(int x) { asm volatile("" : "+s"(x)); return x; }
__device__ __forceinline__ int opaque_bid() { int b = blockIdx.x; asm volatile("" : "+s"(b)); return b; }

template <bool OUT_F32>
__device__ __forceinline__ void n_rmsnorm(const int wv_, const float* __restrict__ x, const float* __restrict__ g, void* outp, int rows) {
  const int tidx_ = opaque_tid(wv_); const int bidx_ = opaque_bid();
  const int lane = tidx_ & 63;
  const int nw = gridDim.x * (NTHREADS / 64);
  for (int row = bidx_ * (NTHREADS / 64) + (tidx_ >> 6); row < rows; row += nw) {
    const float* xr = x + (size_t)row * D_MODEL;
    float4 v[4];
    float ss = 0.f;
#pragma unroll
    for (int i = 0; i < 4; ++i) {
      v[i] = *(const float4*)(xr + i * 256 + lane * 4);
      ss += v[i].x * v[i].x + v[i].y * v[i].y + v[i].z * v[i].z + v[i].w * v[i].w;
    }
    ss = wave_sum(ss);
    float r = rsqrtf(ss * (1.0f / D_MODEL) + EPS);
#pragma unroll
    for (int i = 0; i < 4; ++i) {
      float4 gg = *(const float4*)(g + i * 256 + lane * 4);
      float o0 = v[i].x * r * gg.x, o1 = v[i].y * r * gg.y, o2 = v[i].z * r * gg.z, o3 = v[i].w * r * gg.w;
      if (OUT_F32) {
        *(float4*)((float*)outp + (size_t)row * D_MODEL + i * 256 + lane * 4) = make_float4(o0, o1, o2, o3);
      } else {
        ushort4 o; o.x = f2bf(o0); o.y = f2bf(o1); o.z = f2bf(o2); o.w = f2bf(o3);
        *(ushort4*)((bf16_t*)outp + (size_t)row * D_MODEL + i * 256 + lane * 4) = o;
      }
    }
  }
}

typedef __attribute__((ext_vector_type(8))) short bf16x8;
typedef __attribute__((ext_vector_type(4))) float f32x4;
#define LDX 1032
#define LDXB (LDX * 2)
#define XTILE_BYTES (64 * LDXB)

__device__ __forceinline__ unsigned pack2bf(float a, float b) { return (unsigned)f2bf(a) | ((unsigned)f2bf(b) << 16); }

__device__ __forceinline__ void prep_frag(const int wv_, const float* __restrict__ W, int K, int N, bf16_t* __restrict__ dst, float* smem) {
  const int tidx_ = opaque_tid(wv_); const int bidx_ = opaque_bid();
  const int grp = tidx_ >> 8, tid = tidx_ & 255;
  float(*T)[65] = (float(*)[65])(smem + grp * 32 * 65);
  const int KS = K / 32, NC = N / 64;
  const int ntiles = KS * NC;
  for (int wb = bidx_ * 2; wb < ntiles; wb += gridDim.x * 2) {
    const int w = wb + grp;
    const int c = w / KS, ks = w - c * KS;
    {
      const int row = tid >> 3, col = (tid & 7) * 8;
      const float* src = W + (size_t)(ks * 32 + row) * N + c * 64 + col;
      float4 a = *(const float4*)src, b = *(const float4*)(src + 4);
      __syncthreads();
      T[row][col + 0] = a.x; T[row][col + 1] = a.y; T[row][col + 2] = a.z; T[row][col + 3] = a.w;
      T[row][col + 4] = b.x; T[row][col + 5] = b.y; T[row][col + 6] = b.z; T[row][col + 7] = b.w;
    }
    __syncthreads();
    {
      const int nt = tid >> 6, lane = tid & 63;
      const int kr = 8 * (lane >> 4), nc = nt * 16 + (lane & 15);
      uint4 o;
      o.x = pack2bf(T[kr + 0][nc], T[kr + 1][nc]);
      o.y = pack2bf(T[kr + 2][nc], T[kr + 3][nc]);
      o.z = pack2bf(T[kr + 4][nc], T[kr + 5][nc]);
      o.w = pack2bf(T[kr + 6][nc], T[kr + 7][nc]);
      *(uint4*)(dst + ((size_t)((c * KS + ks) * 4 + nt) * 64 + lane) * 8) = o;
    }
  }
}

__device__ __forceinline__ void o_prep(const int wv_, const Params& p, float* smem) {
  for (int l = 0; l < DEPTH; ++l) {
    prep_frag(wv_, p.w_in + (size_t)l * D_MODEL * IN_WIDTH, D_MODEL, IN_WIDTH, p.wf_in + (size_t)l * D_MODEL * IN_WIDTH, smem);
    prep_frag(wv_, p.w_br_pool + (size_t)l * 256 * 1024, 256, 1024, p.wf_br + (size_t)l * 1024 * 1024, smem);
    prep_frag(wv_, p.w_br_ret + (size_t)l * 512 * 1024, 512, 1024, p.wf_br + (size_t)l * 1024 * 1024 + 256 * 1024, smem);
    prep_frag(wv_, p.w_br_na + (size_t)l * 256 * 1024, 256, 1024, p.wf_br + (size_t)l * 1024 * 1024 + 768 * 1024, smem);
    prep_frag(wv_, p.w_out + (size_t)l * 1024 * 1024, 1024, 1024, p.wf_out + (size_t)l * 1024 * 1024, smem);
    prep_frag(wv_, p.w_query + (size_t)l * 1024 * 2048, 1024, 2048, p.wf_q + (size_t)l * 1024 * 2048, smem);
  }
  const int tidx_ = opaque_tid(wv_); const int bidx_ = opaque_bid();
  const int gtid = bidx_ * NTHREADS + tidx_, gsz = gridDim.x * NTHREADS;
  for (int u = gtid; u < DEPTH * 2 * 8 * 4 * 64; u += gsz) {
    const int lane = u & 63, s2 = (u >> 6) & 3, kt = (u >> 8) & 7, lp = u >> 11;
    const float* kr = p.sub_keys + ((size_t)lp * 128 + kt * 16 + (lane & 15)) * 128;
    float v[8];
#pragma unroll
    for (int j = 0; j < 8; ++j) v[j] = kr[16 * (2 * s2 + (j >> 2)) + 4 * (lane >> 4) + (j & 3)];
    uint4 o;
    o.x = pack2bf(v[0], v[1]); o.y = pack2bf(v[2], v[3]); o.z = pack2bf(v[4], v[5]); o.w = pack2bf(v[6], v[7]);
    *(uint4*)(p.kf + (size_t)u * 8) = o;
  }
  {
    const int lane = tidx_ & 63;
    const int gw = (bidx_ * NTHREADS + tidx_) >> 6, nw = gsz >> 6;
    for (int row = gw; row < DEPTH * 16384 * 2; row += nw) {
      const int tbl = row & 1, er = row >> 1;
      const float* src = (tbl ? p.peer_v : p.peer_u) + (size_t)er * 1024 + lane * 16;
      float4 f[4];
#pragma unroll
      for (int i = 0; i < 4; ++i) f[i] = *(const float4*)(src + 4 * i);
      float m = 0.f;
#pragma unroll
      for (int i = 0; i < 4; ++i) m = fmaxf(m, fmaxf(fmaxf(fabsf(f[i].x), fabsf(f[i].y)), fmaxf(fabsf(f[i].z), fabsf(f[i].w))));
      m = wave_max(m);
      int k = 0;
      if (m > 0.f) {
        int e;
        const float fr = __builtin_frexpf(m, &e);
        k = ((fr <= 0.875f) ? 9 : 8) - e;
        k = k < -100 ? -100 : (k > 100 ? 100 : k);
      }
      const float sc = __builtin_ldexpf(1.0f, k);
      uint4 o;
      unsigned w[4];
#pragma unroll
      for (int i = 0; i < 4; ++i) {
        int pkd = 0;
        pkd = __builtin_amdgcn_cvt_pk_fp8_f32(f[i].x * sc, f[i].y * sc, pkd, false);
        pkd = __builtin_amdgcn_cvt_pk_fp8_f32(f[i].z * sc, f[i].w * sc, pkd, true);
        w[i] = (unsigned)pkd;
      }
      o.x = w[0]; o.y = w[1]; o.z = w[2]; o.w = w[3];
      *(uint4*)((tbl ? p.v8 : p.u8) + (size_t)er * 1024 + lane * 16) = o;
      if (lane == 0) ((float*)p.escale)[(size_t)er * 2 + tbl] = __builtin_ldexpf(1.0f, -k);
    }
  }
  for (int u = gtid; u < SEQ * 32; u += gsz) {
    const int i = u & 31, pos = u >> 5;
    float inv = 1.0f / powf(10000.0f, (float)i / 31.0f);
    float ang = (float)pos * inv;
    double rev = (double)ang * 0.15915494309189535;
    rev -= floor(rev);
    float rf = (float)rev;
    p.rope[u] = make_float2(__builtin_amdgcn_cosf(rf), __builtin_amdgcn_sinf(rf));
  }
}

template <int NT, int PD, int RING>
__device__ __forceinline__ void tl_gemm_prologue(const bf16_t* __restrict__ wf, bf16x8 (&wb)[RING][NT], const int lane, const int nt0 = 0) {
  const bf16x8* wp = (const bf16x8*)wf + lane + nt0 * 64;
#pragma unroll
  for (int s = 0; s < PD; ++s)
#pragma unroll
    for (int nt = 0; nt < NT; ++nt) wb[s][nt] = wp[(s * 4 + nt) * 64];
}
template <int NT, int PD, int RING>
__device__ __forceinline__ void tl_gemm_main(const bf16_t* __restrict__ wf, const int KS, const char* xt, const int kbyte0,
                                             f32x4 (&acc)[NT][4], bf16x8 (&wb)[RING][NT], const int lane, const int nt0 = 0) {
  const bf16x8* wp = (const bf16x8*)wf + lane + nt0 * 64;
  const char* xp = xt + (lane & 15) * LDXB + kbyte0 + (lane >> 4) * 16;
  for (int ks = 0; ks < KS; ks += RING) {
#pragma unroll
    for (int u = 0; u < RING; ++u) {
      int kpre = ks + u + PD;
      kpre = kpre < KS ? kpre : KS - 1;
#pragma unroll
      for (int nt = 0; nt < NT; ++nt) wb[(u + PD) % RING][nt] = wp[(kpre * 4 + nt) * 64];
      __builtin_amdgcn_s_setprio(1);
      bf16x8 xf[4];
#pragma unroll
      for (int mt = 0; mt < 4; ++mt) xf[mt] = *(const bf16x8*)(xp + mt * 16 * LDXB + (ks + u) * 64);
#pragma unroll
      for (int nt = 0; nt < NT; ++nt)
#pragma unroll
        for (int mt = 0; mt < 4; ++mt)
          acc[nt][mt] = __builtin_amdgcn_mfma_f32_16x16x32_bf16(wb[u][nt], xf[mt], acc[nt][mt], 0, 0, 0);
      __builtin_amdgcn_s_setprio(0);
    }
  }
}
template <int NT, int PD = 3, int RING = 4>
__device__ __forceinline__ void tl_gemm_chunk(const bf16_t* __restrict__ wf, const int KS, const char* xt, const int kbyte0,
                                              f32x4 (&acc)[NT][4], const int lane, const int nt0 = 0) {
  bf16x8 wb[RING][NT];
  tl_gemm_prologue<NT, PD, RING>(wf, wb, lane, nt0);
  tl_gemm_main<NT, PD, RING>(wf, KS, xt, kbyte0, acc, wb, lane, nt0);
}

__device__ __forceinline__ void tile_rmsnorm_to_lds(const float* __restrict__ xsrc, const float* __restrict__ g, int t0,
                                                    char* xt, int wave, int lane) {
#pragma unroll 2
  for (int i = 0; i < 8; ++i) {
    const int tok = wave * 8 + i;
    const float* xr = xsrc + (size_t)(t0 + tok) * D_MODEL;
    float4 v[4];
    float ss = 0.f;
#pragma unroll
    for (int q = 0; q < 4; ++q) {
      v[q] = *(const float4*)(xr + q * 256 + lane * 4);
      ss += v[q].x * v[q].x + v[q].y * v[q].y + v[q].z * v[q].z + v[q].w * v[q].w;
    }
    ss = wave_sum(ss);
    const float r = rsqrtf(ss * (1.0f / D_MODEL) + EPS);
#pragma unroll
    for (int q = 0; q < 4; ++q) {
      float4 gg = *(const float4*)(g + q * 256 + lane * 4);
      uint2 o;
      o.x = pack2bf(v[q].x * r * gg.x, v[q].y * r * gg.y);
      o.y = pack2bf(v[q].z * r * gg.z, v[q].w * r * gg.w);
      *(uint2*)(xt + tok * LDXB + (q * 256 + lane * 4) * 2) = o;
    }
  }
}

__device__ __forceinline__ void o_p1(const int wv_, const Params& p, int l, const float* __restrict__ xsrc, char* smem) {
  const int tidx_ = opaque_tid(wv_); const int bidx_ = opaque_bid();
  const int wave = tidx_ >> 6, lane = tidx_ & 63;
  const bf16_t* wf = p.wf_in + (size_t)l * D_MODEL * IN_WIDTH;
  const float* g = p.norm_mix + l * D_MODEL;
  for (int tile = bidx_; tile < NTOK / 64; tile += gridDim.x) {
    const int t0 = tile * 64;
    __syncthreads();
    tile_rmsnorm_to_lds(xsrc, g, t0, smem, wave, lane);
    __syncthreads();
#pragma unroll 1
    for (int c = wave; c < IN_WIDTH / 64; c += 8) {
      f32x4 acc[4][4];
#pragma unroll
      for (int a = 0; a < 4; ++a)
#pragma unroll
        for (int b = 0; b < 4; ++b) acc[a][b] = (f32x4){0.f, 0.f, 0.f, 0.f};
      tl_gemm_chunk<4, 3, 4>(wf + (size_t)c * 32 * 4 * 64 * 8, 32, smem, 0, acc, lane);
      asm volatile("" ::: "memory");
      if (c >= 4 && c < 12) {
        const float sc = (c >= 8) ? 0.125f : 1.0f;
#pragma unroll
        for (int mt = 0; mt < 4; ++mt) {
          const int tok = t0 + mt * 16 + (lane & 15);
          const int pos = tok & (SEQ - 1);
#pragma unroll
          for (int nt = 0; nt < 2; ++nt) {
            const int i0 = nt * 16 + 4 * (lane >> 4);
            const float4 cs01 = *(const float4*)(p.rope + pos * 32 + i0);
            const float4 cs23 = *(const float4*)(p.rope + pos * 32 + i0 + 2);
            const float cc[4] = {cs01.x, cs01.z, cs23.x, cs23.z};
            const float sn[4] = {cs01.y, cs01.w, cs23.y, cs23.w};
#pragma unroll
            for (int r = 0; r < 4; ++r) {
              const float x1 = acc[nt][mt][r], x2 = acc[nt + 2][mt][r];
              acc[nt][mt][r] = (x1 * cc[r] - x2 * sn[r]) * sc;
              acc[nt + 2][mt][r] = (x1 * sn[r] + x2 * cc[r]) * sc;
            }
          }
        }
      } else if (c >= 28 && c < 32) {
#pragma unroll
        for (int a = 0; a < 4; ++a)
#pragma unroll
          for (int b = 0; b < 4; ++b) acc[a][b] *= 0.125f;
      } else if (c >= 40) {
#pragma unroll
        for (int a = 0; a < 4; ++a)
#pragma unroll
          for (int b = 0; b < 4; ++b)
#pragma unroll
            for (int r = 0; r < 4; ++r) acc[a][b][r] = 1.0f / (1.0f + __expf(-acc[a][b][r]));
      }
      {
        char* patch = smem + XTILE_BYTES + wave * 2304;
#pragma unroll
        for (int mt = 0; mt < 4; ++mt) {
#pragma unroll
          for (int nt = 0; nt < 4; ++nt) {
            uint2 o;
            o.x = pack2bf(acc[nt][mt][0], acc[nt][mt][1]);
            o.y = pack2bf(acc[nt][mt][2], acc[nt][mt][3]);
            *(uint2*)(patch + (lane & 15) * 144 + (nt * 16 + 4 * (lane >> 4)) * 2) = o;
          }
#pragma unroll
          for (int h = 0; h < 2; ++h) {
            const int row = h * 8 + (lane >> 3), unit = lane & 7;
            const uint4 v = *(const uint4*)(patch + row * 144 + unit * 16);
            *(uint4*)(p.proj + (size_t)(t0 + mt * 16 + row) * IN_WIDTH + c * 64 + unit * 8) = v;
          }
        }
      }
    }
  }
}


__device__ __forceinline__ void o_final_norm_tile(const Params& p, int t0, int tid) {
  const int wave = tid >> 6, lane = tid & 63;
#pragma unroll 2
  for (int i = 0; i < 8; ++i) {
    const size_t row = (size_t)(t0 + wave * 8 + i) * D_MODEL;
    float4 v[4];
    float ss = 0.f;
#pragma unroll
    for (int q = 0; q < 4; ++q) {
      v[q] = *(const float4*)(p.xres + row + q * 256 + lane * 4);
      ss += v[q].x * v[q].x + v[q].y * v[q].y + v[q].z * v[q].z + v[q].w * v[q].w;
    }
    ss = wave_sum(ss);
    const float r = rsqrtf(ss * (1.0f / D_MODEL) + EPS);
#pragma unroll
    for (int q = 0; q < 4; ++q) {
      const float4 gg = *(const float4*)(p.norm_final + q * 256 + lane * 4);
      *(float4*)(p.out + row + q * 256 + lane * 4) = make_float4(v[q].x * r * gg.x, v[q].y * r * gg.y, v[q].z * r * gg.z, v[q].w * r * gg.w);
    }
  }
}

__device__ __forceinline__ void tile_load_to_lds(const bf16_t* __restrict__ src, int ld, char* xt, int tid) {
#pragma unroll 4
  for (int it = 0; it < 16; ++it) {
    const int idx = it * NTHREADS + tid;
    const int row = idx >> 7, u = idx & 127;
    const uint4 v = *(const uint4*)(src + (size_t)row * ld + u * 8);
    *(uint4*)(xt + row * LDXB + u * 16) = v;
  }
}

__device__ __forceinline__ void o_p5a1_tile(const Params& p, int l, int t0, char* smem, int tid) {
  const int wave = tid >> 6, lane = tid & 63;
  __syncthreads();
  tile_load_to_lds(p.ycat + (size_t)t0 * 1024, 1024, smem, tid);
  __syncthreads();
  const bf16_t* wfb = p.wf_br + (size_t)l * 1024 * 1024;
  bf16x8 wb[4][2];
  f32x4 m[2][4];
  {
    const int c0 = wave >> 1, nt00 = (wave & 1) * 2;
    tl_gemm_prologue<2, 3, 4>(wfb + (size_t)c0 * 8 * 4 * 64 * 8, wb, lane, nt00);
  }
#pragma unroll 1
  for (int it = 0; it < 12; ++it) {
    const int hi = it / 3, br = it - hi * 3;
    const int hc = wave + 8 * hi;
    const int c = hc >> 1, nt0 = (hc & 1) * 2;
    const int koff = (br == 0) ? 0 : (br == 1 ? 256 : 768);
    const int KS = (br == 1) ? 16 : 8;
    uint2 gv[4][2];
#pragma unroll
    for (int mt = 0; mt < 4; ++mt) {
      const int tok = t0 + mt * 16 + (lane & 15);
      const bf16_t* gp = p.proj + (size_t)tok * IN_WIDTH + C_GATE + br * 1024 + c * 64 + nt0 * 16 + 4 * (lane >> 4);
#pragma unroll
      for (int nt = 0; nt < 2; ++nt) gv[mt][nt] = *(const uint2*)(gp + nt * 16);
    }
    f32x4 acc[2][4];
#pragma unroll
    for (int a2 = 0; a2 < 2; ++a2)
#pragma unroll
      for (int b2 = 0; b2 < 4; ++b2) acc[a2][b2] = (f32x4){0.f, 0.f, 0.f, 0.f};
    tl_gemm_main<2, 3, 4>(wfb + (size_t)koff * 1024 + (size_t)c * KS * 4 * 64 * 8, KS, smem, koff * 2, acc, wb, lane, nt0);
    asm volatile("" ::: "memory");
    {
      const int itn = (it + 1 < 12) ? it + 1 : it;
      const int hin = itn / 3, brn = itn - hin * 3;
      const int hcn = wave + 8 * hin;
      const int koffn = (brn == 0) ? 0 : (brn == 1 ? 256 : 768);
      const int KSn = (brn == 1) ? 16 : 8;
      tl_gemm_prologue<2, 3, 4>(wfb + (size_t)koffn * 1024 + (size_t)(hcn >> 1) * KSn * 4 * 64 * 8, wb, lane, (hcn & 1) * 2);
    }
    if (br == 0) {
#pragma unroll
      for (int a2 = 0; a2 < 2; ++a2)
#pragma unroll
        for (int b2 = 0; b2 < 4; ++b2) m[a2][b2] = (f32x4){0.f, 0.f, 0.f, 0.f};
    }
#pragma unroll
    for (int mt = 0; mt < 4; ++mt)
#pragma unroll
      for (int nt = 0; nt < 2; ++nt) {
        m[nt][mt][0] += __uint_as_float(gv[mt][nt].x << 16) * acc[nt][mt][0];
        m[nt][mt][1] += __uint_as_float(gv[mt][nt].x & 0xffff0000u) * acc[nt][mt][1];
        m[nt][mt][2] += __uint_as_float(gv[mt][nt].y << 16) * acc[nt][mt][2];
        m[nt][mt][3] += __uint_as_float(gv[mt][nt].y & 0xffff0000u) * acc[nt][mt][3];
      }
    if (br == 2) {
#pragma unroll
      for (int mt = 0; mt < 4; ++mt) {
        const int tok = t0 + mt * 16 + (lane & 15);
        bf16_t* dst = p.mrg + (size_t)tok * 1024 + c * 64 + nt0 * 16 + 4 * (lane >> 4);
#pragma unroll
        for (int nt = 0; nt < 2; ++nt) {
          uint2 o;
          o.x = pack2bf(m[nt][mt][0], m[nt][mt][1]);
          o.y = pack2bf(m[nt][mt][2], m[nt][mt][3]);
          *(uint2*)(dst + nt * 16) = o;
        }
      }
    }
  }
}
__device__ __forceinline__ void o_p5a2_tile(const Params& p, int l, const float* __restrict__ xcur, int t0, char* smem, int tid) {
  const int wave = tid >> 6, lane = tid & 63;
  __syncthreads();
  tile_load_to_lds(p.mrg + (size_t)t0 * 1024, 1024, smem, tid);
  __syncthreads();
  const bf16_t* wfo = p.wf_out + (size_t)l * 1024 * 1024;
#pragma unroll 1
  for (int c = wave; c < 16; c += 8) {
    f32x4 acc[4][4];
#pragma unroll
    for (int a = 0; a < 4; ++a)
#pragma unroll
      for (int b = 0; b < 4; ++b) acc[a][b] = (f32x4){0.f, 0.f, 0.f, 0.f};
    tl_gemm_chunk<4, 2>(wfo + (size_t)c * 32 * 4 * 64 * 8, 32, smem, 0, acc, lane);
    asm volatile("" ::: "memory");
#pragma unroll
    for (int mt = 0; mt < 4; ++mt) {
      const int tok = t0 + mt * 16 + (lane & 15);
      const size_t o = (size_t)tok * 1024 + c * 64 + 4 * (lane >> 4);
#pragma unroll
      for (int nt = 0; nt < 4; ++nt) {
        float4 xv = *(const float4*)(xcur + o + nt * 16);
        xv.x += acc[nt][mt][0]; xv.y += acc[nt][mt][1]; xv.z += acc[nt][mt][2]; xv.w += acc[nt][mt][3];
        *(float4*)(p.xres + o + nt * 16) = xv;
      }
    }
  }
}
__device__ __forceinline__ void o_p5a3_tile(const Params& p, int l, int t0, char* smem, int tid) {
  const int wave = tid >> 6, lane = tid & 63;
  __syncthreads();
  tile_rmsnorm_to_lds(p.xres, p.norm_ffn + l * D_MODEL, t0, smem, wave, lane);
  __syncthreads();
}


__device__ __forceinline__ unsigned mono_f(float f) {
  unsigned u = __float_as_uint(f);
  return (u & 0x80000000u) ? ~u : (u | 0x80000000u);
}
__device__ __forceinline__ float unmono_f(unsigned m) {
  return __uint_as_float((m & 0x80000000u) ? (m & 0x7fffffffu) : ~m);
}
#define CE_DESC(x, y) { const unsigned hi_ = max(x, y); const unsigned lo_ = min(x, y); x = hi_; y = lo_; }
#define CE_ASC(x, y) { const unsigned hi_ = max(x, y); const unsigned lo_ = min(x, y); x = lo_; y = hi_; }
__device__ __forceinline__ void sort16_desc(unsigned (&a)[16]) {
#pragma unroll
  for (int k = 2; k <= 16; k <<= 1) {
#pragma unroll
    for (int j = k >> 1; j > 0; j >>= 1) {
#pragma unroll
      for (int i = 0; i < 16; ++i) {
        const int l = i ^ j;
        if (l > i) {
          if ((i & k) == 0) CE_DESC(a[i], a[l]) else CE_ASC(a[i], a[l])
        }
      }
    }
  }
}
__device__ __forceinline__ void bitonic_merge16_desc(unsigned (&a)[16]) {
#pragma unroll
  for (int j = 8; j > 0; j >>= 1) {
#pragma unroll
    for (int i = 0; i < 16; ++i) {
      const int l = i ^ j;
      if (l > i) CE_DESC(a[i], a[l])
    }
  }
}
__device__ __forceinline__ void xlane_merge16(unsigned (&a)[16], int mask) {
  unsigned b[16];
#pragma unroll
  for (int i = 0; i < 16; ++i) b[i] = (unsigned)__shfl_xor((int)a[i], mask, 64);
#pragma unroll
  for (int i = 0; i < 16; ++i) a[i] = max(a[i], b[15 - i]);
  bitonic_merge16_desc(a);
}

__device__ __forceinline__ void o_peer_select_tile(const Params& p, int l, int t0, char* smem, int tid) {
  const int h = __builtin_amdgcn_readfirstlane(tid >> 6), lane = tid & 63;
  const int g = lane >> 4, tl = lane & 15;
  const bf16_t* wfq = p.wf_q + (size_t)l * 1024 * 2048;
#pragma unroll 1
  for (int pp = 0; pp < 2; ++pp) {
    bf16x8 qf[4][4];
#pragma unroll 1
    for (int cc = 0; cc < 2; ++cc) {
      const int c = (h * 2 + pp) * 2 + cc;
      f32x4 acc[4][4];
#pragma unroll
      for (int a = 0; a < 4; ++a)
#pragma unroll
        for (int b = 0; b < 4; ++b) acc[a][b] = (f32x4){0.f, 0.f, 0.f, 0.f};
      tl_gemm_chunk<4, 2>(wfq + (size_t)c * 32 * 4 * 64 * 8, 32, smem, 0, acc, lane);
#pragma unroll
      for (int sl = 0; sl < 2; ++sl)
#pragma unroll
        for (int mt = 0; mt < 4; ++mt) {
          union { bf16x8 v; unsigned u[4]; } cv;
          cv.u[0] = pack2bf(acc[2 * sl][mt][0], acc[2 * sl][mt][1]);
          cv.u[1] = pack2bf(acc[2 * sl][mt][2], acc[2 * sl][mt][3]);
          cv.u[2] = pack2bf(acc[2 * sl + 1][mt][0], acc[2 * sl + 1][mt][1]);
          cv.u[3] = pack2bf(acc[2 * sl + 1][mt][2], acc[2 * sl + 1][mt][3]);
          if (cc == 0) qf[sl][mt] = cv.v; else qf[2 + sl][mt] = cv.v;
        }
    }
    const bf16x8* kfp = (const bf16x8*)p.kf + (size_t)((l * 2 + pp) * 8) * 4 * 64 + lane;
#pragma unroll
    for (int mp = 0; mp < 2; ++mp) {
      f32x4 sc2[2][8];
#pragma unroll
      for (int u = 0; u < 2; ++u)
#pragma unroll
        for (int kt = 0; kt < 8; ++kt) sc2[u][kt] = (f32x4){0.f, 0.f, 0.f, 0.f};
#pragma unroll
      for (int s2 = 0; s2 < 4; ++s2) {
        const bf16x8 qv0 = qf[s2][2 * mp], qv1 = qf[s2][2 * mp + 1];
#pragma unroll
        for (int kt = 0; kt < 8; ++kt) {
          const bf16x8 kv = kfp[(kt * 4 + s2) * 64];
          sc2[0][kt] = __builtin_amdgcn_mfma_f32_16x16x32_bf16(kv, qv0, sc2[0][kt], 0, 0, 0);
          sc2[1][kt] = __builtin_amdgcn_mfma_f32_16x16x32_bf16(kv, qv1, sc2[1][kt], 0, 0, 0);
        }
        __builtin_amdgcn_sched_barrier(0);
      }
#pragma unroll
      for (int u = 0; u < 2; ++u) {
        const int mt = 2 * mp + u;
        unsigned A[16], B[16];
#pragma unroll
        for (int kt = 0; kt < 4; ++kt)
#pragma unroll
          for (int r = 0; r < 4; ++r) {
            A[kt * 4 + r] = (mono_f(sc2[u][kt][r]) & ~127u) | (unsigned)(127 - (kt * 16 + r) - 4 * g);
            B[kt * 4 + r] = (mono_f(sc2[u][kt + 4][r]) & ~127u) | (unsigned)(127 - ((kt + 4) * 16 + r) - 4 * g);
          }
        sort16_desc(A);
        sort16_desc(B);
#pragma unroll
        for (int i = 0; i < 16; ++i) A[i] = max(A[i], B[15 - i]);
        bitonic_merge16_desc(A);
        xlane_merge16(A, 16);
        xlane_merge16(A, 32);
        if (g == 0) {
          uint4* dst = (uint4*)(p.tklist + ((size_t)((t0 + mt * 16 + tl) * 8 + h) * 2 + pp) * 16);
          dst[0] = make_uint4(A[0], A[1], A[2], A[3]);
          dst[1] = make_uint4(A[4], A[5], A[6], A[7]);
          dst[2] = make_uint4(A[8], A[9], A[10], A[11]);
          dst[3] = make_uint4(A[12], A[13], A[14], A[15]);
        }
        __builtin_amdgcn_sched_barrier(0);
      }
    }
  }
  asm volatile("s_waitcnt vmcnt(0)" ::: "memory");
}

__device__ __forceinline__ void o_peer_select2_tile(const Params& p, int l, int t0, int tid) {
  const int h = __builtin_amdgcn_readfirstlane(tid >> 6), lane = tid & 63;
  const int g = lane >> 4, tl = lane & 15;
#pragma unroll 1
  for (int mt = 0; mt < 4; ++mt) {
    const int tok = t0 + mt * 16 + tl;
    const unsigned* lp = p.tklist + ((size_t)(tok * 8 + h) * 2) * 16;
    float v1[16], v2[16];
    {
      const uint4* q4 = (const uint4*)lp;
#pragma unroll
      for (int i = 0; i < 4; ++i) {
        uint4 x = q4[i], y = q4[4 + i];
        v1[4 * i + 0] = unmono_f(x.x & ~127u); v1[4 * i + 1] = unmono_f(x.y & ~127u);
        v1[4 * i + 2] = unmono_f(x.z & ~127u); v1[4 * i + 3] = unmono_f(x.w & ~127u);
        v2[4 * i + 0] = unmono_f(y.x & ~127u); v2[4 * i + 1] = unmono_f(y.y & ~127u);
        v2[4 * i + 2] = unmono_f(y.z & ~127u); v2[4 * i + 3] = unmono_f(y.w & ~127u);
      }
    }
    unsigned C[16];
#pragma unroll
    for (int i = 0; i < 16; ++i) C[i] = 0u;
    {
      int idx = 0;
#pragma unroll
      for (int a = 0; a < 16; ++a) {
#pragma unroll
        for (int b = 0; b < 16; ++b) {
          if ((a + 1) * (b + 1) <= 16) {
            const unsigned key = (mono_f(v1[a] + v2[b]) & ~255u) | (unsigned)(255 - (a * 16 + b));
            const int slot = idx >> 2, who = idx & 3;
            C[slot] = (g == who) ? key : C[slot];
            ++idx;
          }
        }
      }
    }
    sort16_desc(C);
    xlane_merge16(C, 16);
    xlane_merge16(C, 32);
    const float f0 = unmono_f(C[0] & ~255u);
    float den = 0.f;
    float ev[16];
#pragma unroll
    for (int i = 0; i < 16; ++i) { ev[i] = __expf(unmono_f(C[i] & ~255u) - f0); den += ev[i]; }
    const float rden = 1.0f / den;
    int eidx[4]; float egate[4];
#pragma unroll
    for (int i = 0; i < 4; ++i) {
      const unsigned k = (g == 0) ? C[i] : (g == 1) ? C[4 + i] : (g == 2) ? C[8 + i] : C[12 + i];
      const float e = (g == 0) ? ev[i] : (g == 1) ? ev[4 + i] : (g == 2) ? ev[8 + i] : ev[12 + i];
      const int pos = 255 - (int)(k & 255u);
      const int a = pos >> 4, b = pos & 15;
      const int n1 = 127 - (int)(lp[a] & 127u);
      const int n2 = 127 - (int)(lp[16 + b] & 127u);
      eidx[i] = n1 * 128 + n2;
      egate[i] = e * rden;
    }
    *(int4*)(p.pidx + (size_t)tok * 128 + h * 16 + 4 * g) = make_int4(eidx[0], eidx[1], eidx[2], eidx[3]);
    *(float4*)(p.pgate + (size_t)tok * 128 + h * 16 + 4 * g) = make_float4(egate[0], egate[1], egate[2], egate[3]);
  }
}

__device__ __forceinline__ float logsigmoid_(float x) { return fminf(x, 0.f) - log1pf(expf(-fabsf(x))); }
__device__ __forceinline__ float bf_lo(unsigned w) { return __uint_as_float(w << 16); }
__device__ __forceinline__ float bf_hi(unsigned w) { return __uint_as_float(w & 0xffff0000u); }

#define RKV_LD 136
__device__ __forceinline__ void o_ret_kv_task(const Params& p, int l, int task, char* smem, int tid) {
  const int wave = tid >> 6, lane = tid & 63, g = lane >> 4, tl = lane & 15;
  const int bh = task >> 5, n = task & 31, b = bh >> 2, h = bh & 3;
  const int tok0 = b * SEQ + n * 128;
  const float lgf = logsigmoid_(p.ret_decay[l * 8 + h]), lgb = logsigmoid_(p.ret_decay[l * 8 + 4 + h]);
  bf16_t* KTf = (bf16_t*)smem;
  bf16_t* KTb = KTf + 64 * RKV_LD;
  bf16_t* VT = KTb + 64 * RKV_LD;
  __syncthreads();
#pragma unroll
  for (int it = 0; it < 2; ++it) {
    const int u = tid + it * NTHREADS;
    const int j = u >> 3, d0 = (u & 7) * 8;
    const uint4 kv = *(const uint4*)(p.proj + (size_t)(tok0 + j) * IN_WIDTH + C_RK + h * 64 + d0);
    const float wf = __expf(lgf * (float)(127 - j)), wb = __expf(lgb * (float)(j + 1));
    const unsigned kw[4] = {kv.x, kv.y, kv.z, kv.w};
#pragma unroll
    for (int e = 0; e < 4; ++e) {
      const float x0 = bf_lo(kw[e]), x1 = bf_hi(kw[e]);
      KTf[(d0 + 2 * e) * RKV_LD + j] = f2bf(x0 * wf);
      KTf[(d0 + 2 * e + 1) * RKV_LD + j] = f2bf(x1 * wf);
      KTb[(d0 + 2 * e) * RKV_LD + j] = f2bf(x0 * wb);
      KTb[(d0 + 2 * e + 1) * RKV_LD + j] = f2bf(x1 * wb);
    }
  }
#pragma unroll
  for (int it = 0; it < 4; ++it) {
    const int u = tid + it * NTHREADS;
    const int j = u >> 4, e0 = (u & 15) * 8;
    const uint4 vv = *(const uint4*)(p.proj + (size_t)(tok0 + j) * IN_WIDTH + C_RV + h * 128 + e0);
    const unsigned vw[4] = {vv.x, vv.y, vv.z, vv.w};
#pragma unroll
    for (int e = 0; e < 4; ++e) {
      VT[(e0 + 2 * e) * RKV_LD + j] = (bf16_t)(vw[e] & 0xffffu);
      VT[(e0 + 2 * e + 1) * RKV_LD + j] = (bf16_t)(vw[e] >> 16);
    }
  }
  __syncthreads();
  bf16x8 a[4];
#pragma unroll
  for (int ks = 0; ks < 4; ++ks) a[ks] = *(const bf16x8*)(VT + (wave * 16 + tl) * RKV_LD + ks * 32 + 8 * g);
#pragma unroll
  for (int dir = 0; dir < 2; ++dir) {
    const bf16_t* KT = dir ? KTb : KTf;
#pragma unroll
    for (int dt = 0; dt < 4; ++dt) {
      f32x4 acc = (f32x4){0.f, 0.f, 0.f, 0.f};
#pragma unroll
      for (int ks = 0; ks < 4; ++ks) {
        const bf16x8 bb = *(const bf16x8*)(KT + (dt * 16 + tl) * RKV_LD + ks * 32 + 8 * g);
        acc = __builtin_amdgcn_mfma_f32_16x16x32_bf16(a[ks], bb, acc, 0, 0, 0);
      }
      float* dst = p.kvst + ((size_t)(task * 2 + dir) * 128 + wave * 16 + 4 * g) * 64 + dt * 16 + tl;
#pragma unroll
      for (int r = 0; r < 4; ++r) dst[r * 64] = acc[r];
    }
  }
}

__device__ __forceinline__ void o_ret_scan(const int wv_, const Params& p, int l) {
  const int tidx_ = opaque_tid(wv_); const int bidx_ = opaque_bid();
  const int gsz = gridDim.x * NTHREADS;
  for (int u = bidx_ * NTHREADS + tidx_; u < 16 * 2 * 128 * 16; u += gsz) {
    const int dq = u & 15, e = (u >> 4) & 127, dir = (u >> 11) & 1, bh = u >> 12, h = bh & 3;
    const float lg = logsigmoid_(p.ret_decay[l * 8 + dir * 4 + h]);
    const float gC = __expf(lg * 128.0f);
    float4 st = make_float4(0.f, 0.f, 0.f, 0.f);
#pragma unroll 8
    for (int nn = 0; nn < 32; ++nn) {
      const int n = dir ? (31 - nn) : nn;
      const size_t idx = ((size_t)((bh * 32 + n) * 2 + dir) * 128 + e) * 64 + dq * 4;
      const float4 kv = *(const float4*)(p.kvst + idx);
      uint2 o;
      o.x = pack2bf(st.x, st.y); o.y = pack2bf(st.z, st.w);
      *(uint2*)(p.rstate + idx) = o;
      st.x = fmaf(st.x, gC, kv.x); st.y = fmaf(st.y, gC, kv.y); st.z = fmaf(st.z, gC, kv.z); st.w = fmaf(st.w, gC, kv.w);
    }
  }
}

#define RO_LD 264
#define RK_LD 72
__device__ __forceinline__ void o_ret_out_task(const Params& p, int l, int task, char* smem, int tid) {
  const int wave = tid >> 6, lane = tid & 63, g = lane >> 4, tl = lane & 15;
  const int bh = task >> 5, n = task & 31, b = bh >> 2, h = bh & 3;
  const int tok0 = b * SEQ + n * 128;
  const float lgf = logsigmoid_(p.ret_decay[l * 8 + h]), lgb = logsigmoid_(p.ret_decay[l * 8 + 4 + h]);
  bf16_t* Acat = (bf16_t*)smem;
  bf16_t* Bcat = Acat + 128 * RO_LD;
  bf16_t* Kl = Bcat + 128 * RO_LD;
  __syncthreads();
#pragma unroll
  for (int it = 0; it < 2; ++it) {
    const int u = tid + it * NTHREADS;
    const int i = u >> 3, d0 = (u & 7) * 8;
    const size_t row = (size_t)(tok0 + i) * IN_WIDTH;
    const uint4 qv = *(const uint4*)(p.proj + row + C_RQ + h * 64 + d0);
    const uint4 kv = *(const uint4*)(p.proj + row + C_RK + h * 64 + d0);
    *(uint4*)(Acat + i * RO_LD + d0) = qv;
    *(uint4*)(Kl + i * RK_LD + d0) = kv;
    const float wf = __expf(lgf * (float)(i + 1)), wb = __expf(lgb * (float)(127 - i));
    const unsigned qw[4] = {qv.x, qv.y, qv.z, qv.w};
    uint4 of, ob;
    of.x = pack2bf(bf_lo(qw[0]) * wf, bf_hi(qw[0]) * wf); ob.x = pack2bf(bf_lo(qw[0]) * wb, bf_hi(qw[0]) * wb);
    of.y = pack2bf(bf_lo(qw[1]) * wf, bf_hi(qw[1]) * wf); ob.y = pack2bf(bf_lo(qw[1]) * wb, bf_hi(qw[1]) * wb);
    of.z = pack2bf(bf_lo(qw[2]) * wf, bf_hi(qw[2]) * wf); ob.z = pack2bf(bf_lo(qw[2]) * wb, bf_hi(qw[2]) * wb);
    of.w = pack2bf(bf_lo(qw[3]) * wf, bf_hi(qw[3]) * wf); ob.w = pack2bf(bf_lo(qw[3]) * wb, bf_hi(qw[3]) * wb);
    *(uint4*)(Acat + i * RO_LD + 128 + d0) = of;
    *(uint4*)(Acat + i * RO_LD + 192 + d0) = ob;
  }
#pragma unroll
  for (int it = 0; it < 4; ++it) {
    const int u = tid + it * NTHREADS;
    const int j = u >> 4, e0 = (u & 15) * 8;
    const uint4 vv = *(const uint4*)(p.proj + (size_t)(tok0 + j) * IN_WIDTH + C_RV + h * 128 + e0);
    const unsigned vw[4] = {vv.x, vv.y, vv.z, vv.w};
#pragma unroll
    for (int e = 0; e < 4; ++e) {
      Bcat[(e0 + 2 * e) * RO_LD + j] = (bf16_t)(vw[e] & 0xffffu);
      Bcat[(e0 + 2 * e + 1) * RO_LD + j] = (bf16_t)(vw[e] >> 16);
    }
  }
#pragma unroll
  for (int it = 0; it < 4; ++it) {
    const int u = tid + it * NTHREADS;
    const int d0 = (u & 7) * 8, e = (u >> 3) & 127, dir = u >> 10;
    const uint4 sv = *(const uint4*)(p.rstate + ((size_t)(task * 2 + dir) * 128 + e) * 64 + d0);
    *(uint4*)(Bcat + e * RO_LD + 128 + dir * 64 + d0) = sv;
  }
  __syncthreads();
  f32x4 sc[8];
#pragma unroll
  for (int jt = 0; jt < 8; ++jt) sc[jt] = (f32x4){0.f, 0.f, 0.f, 0.f};
#pragma unroll
  for (int ks = 0; ks < 2; ++ks) {
    const bf16x8 qb = *(const bf16x8*)(Acat + (wave * 16 + tl) * RO_LD + ks * 32 + 8 * g);
#pragma unroll
    for (int jt = 0; jt < 8; ++jt) {
      const bf16x8 ka = *(const bf16x8*)(Kl + (jt * 16 + tl) * RK_LD + ks * 32 + 8 * g);
      sc[jt] = __builtin_amdgcn_mfma_f32_16x16x32_bf16(ka, qb, sc[jt], 0, 0, 0);
    }
  }
  {
    const int i = wave * 16 + tl;
#pragma unroll
    for (int jt = 0; jt < 8; ++jt) {
      float pv[4];
#pragma unroll
      for (int r = 0; r < 4; ++r) {
        const int j = jt * 16 + 4 * g + r;
        const float dd = (j <= i) ? __expf(lgf * (float)(i - j)) : __expf(lgb * (float)(j - i));
        pv[r] = sc[jt][r] * dd;
      }
      uint2 o;
      o.x = pack2bf(pv[0], pv[1]); o.y = pack2bf(pv[2], pv[3]);
      *(uint2*)(Acat + i * RO_LD + jt * 16 + 4 * g) = o;
    }
  }
  f32x4 y[8];
#pragma unroll
  for (int et = 0; et < 8; ++et) y[et] = (f32x4){0.f, 0.f, 0.f, 0.f};
#pragma unroll
  for (int ks = 0; ks < 8; ++ks) {
    const bf16x8 ab = *(const bf16x8*)(Acat + (wave * 16 + tl) * RO_LD + ks * 32 + 8 * g);
#pragma unroll
    for (int et = 0; et < 8; ++et) {
      const bf16x8 ba = *(const bf16x8*)(Bcat + (et * 16 + tl) * RO_LD + ks * 32 + 8 * g);
      y[et] = __builtin_amdgcn_mfma_f32_16x16x32_bf16(ba, ab, y[et], 0, 0, 0);
    }
  }
  float ss = 0.f;
#pragma unroll
  for (int et = 0; et < 8; ++et)
#pragma unroll
    for (int r = 0; r < 4; ++r) ss = fmaf(y[et][r], y[et][r], ss);
  ss += __shfl_xor(ss, 16, 64);
  ss += __shfl_xor(ss, 32, 64);
  const float rstd = rsqrtf(ss * (1.0f / 128.0f) + EPS);
  {
    const int tok = tok0 + wave * 16 + tl;
    const bf16_t* gp = p.proj + (size_t)tok * IN_WIDTH + C_RG + h * 128 + 4 * g;
    bf16_t* dst = p.ycat + (size_t)tok * 1024 + 256 + h * 128 + 4 * g;
#pragma unroll
    for (int et = 0; et < 8; ++et) {
      const uint2 gv = *(const uint2*)(gp + et * 16);
      const float g0 = bf_lo(gv.x), g1 = bf_hi(gv.x), g2 = bf_lo(gv.y), g3 = bf_hi(gv.y);
      uint2 o;
      o.x = pack2bf(g0 / (1.0f + __expf(-g0)) * y[et][0] * rstd, g1 / (1.0f + __expf(-g1)) * y[et][1] * rstd);
      o.y = pack2bf(g2 / (1.0f + __expf(-g2)) * y[et][2] * rstd, g3 / (1.0f + __expf(-g3)) * y[et][3] * rstd);
      *(uint2*)(dst + et * 16) = o;
    }
  }
}


#define NA_KLD 72
typedef short v4s_t __attribute__((ext_vector_type(4)));
#ifndef LAS
#define LAS __attribute__((address_space(3)))
#endif
__device__ __forceinline__ void o_na_task(const Params& p, int l, int task, char* smem, int tid) {
  const int wave = tid >> 6, lane = tid & 63, g = lane >> 4, tl = lane & 15;
  const int rr = task & 63, h = (task >> 6) & 3, b = task >> 8;
  int rs = rr - 4; rs = rs < 0 ? 0 : (rs > 56 ? 56 : rs);
  const int ktok0 = b * SEQ + rs * 64;
  const int qtok0 = b * SEQ + rr * 64;
  bf16_t* Kl = (bf16_t*)smem;
  bf16_t* Vl = Kl + 512 * NA_KLD;
  bf16_t* Ql = Vl + 512 * NA_KLD;
  float* rpbl = (float*)(Ql + 64 * NA_KLD);
  __syncthreads();
#pragma unroll
  for (int it = 0; it < 8; ++it) {
    const int u = tid + it * NTHREADS;
    const int key = u >> 3, d0 = (u & 7) * 8;
    const size_t row = (size_t)(ktok0 + key) * IN_WIDTH;
    const uint4 kv = *(const uint4*)(p.proj + row + C_NK + h * 64 + d0);
    const uint4 vv = *(const uint4*)(p.proj + row + C_NV + h * 64 + d0);
    *(uint4*)(Kl + key * NA_KLD + d0) = kv;
    *(uint4*)(Vl + key * NA_KLD + d0) = vv;
  }
  {
    const int q = tid >> 3, d0 = (tid & 7) * 8;
    *(uint4*)(Ql + q * NA_KLD + d0) = *(const uint4*)(p.proj + (size_t)(qtok0 + q) * IN_WIDTH + C_NQ + h * 64 + d0);
    if (tid < 465) rpbl[tid] = p.na_rpb[((size_t)l * 4 + h) * 465 + tid];
  }
  __syncthreads();
  if (wave < 4) {
    const int qt = wave;
    int cw0 = 16 * qt - 8; cw0 = cw0 < 0 ? 0 : (cw0 > 32 ? 32 : cw0);
    f32x4 sc[16];
#pragma unroll
    for (int T = 0; T < 16; ++T) sc[T] = (f32x4){0.f, 0.f, 0.f, 0.f};
#pragma unroll
    for (int ks = 0; ks < 2; ++ks) {
      const bf16x8 qb = *(const bf16x8*)(Ql + (qt * 16 + tl) * NA_KLD + ks * 32 + 8 * g);
#pragma unroll
      for (int T = 0; T < 16; ++T) {
        const int key = (T >> 1) * 64 + cw0 + (T & 1) * 16 + tl;
        const bf16x8 ka = *(const bf16x8*)(Kl + key * NA_KLD + ks * 32 + 8 * g);
        sc[T] = __builtin_amdgcn_mfma_f32_16x16x32_bf16(ka, qb, sc[T], 0, 0, 0);
      }
    }
    const int cq = qt * 16 + tl;
    int cs = cq - 8; cs = cs < 0 ? 0 : (cs > 48 ? 48 : cs);
    float m = -3.0e38f;
#pragma unroll
    for (int T = 0; T < 16; ++T) {
      const int ri = T >> 1;
      const int di = rs + ri - rr + 7;
#pragma unroll
      for (int r = 0; r < 4; ++r) {
        const int ck = cw0 + (T & 1) * 16 + 4 * g + r;
        const bool valid = (ck >= cs) && (ck < cs + 16);
        int dj = ck - cq + 15; dj = dj < 0 ? 0 : (dj > 30 ? 30 : dj);
        const float sv = valid ? (sc[T][r] + rpbl[di * 31 + dj]) : -1.0e30f;
        sc[T][r] = sv;
        m = fmaxf(m, sv);
      }
    }
    m = fmaxf(m, __shfl_xor(m, 16, 64));
    m = fmaxf(m, __shfl_xor(m, 32, 64));
    float den = 0.f;
#pragma unroll
    for (int T = 0; T < 16; ++T)
#pragma unroll
      for (int r = 0; r < 4; ++r) {
        const float e = __expf(sc[T][r] - m);
        sc[T][r] = e;
        den += e;
      }
    den += __shfl_xor(den, 16, 64);
    den += __shfl_xor(den, 32, 64);
    const float rden = 1.0f / den;
    f32x4 o[4];
#pragma unroll
    for (int dt = 0; dt < 4; ++dt) o[dt] = (f32x4){0.f, 0.f, 0.f, 0.f};
#pragma unroll
    for (int ri = 0; ri < 8; ++ri) {
      union { bf16x8 v; unsigned u[4]; } pb;
      pb.u[0] = pack2bf(sc[2 * ri][0], sc[2 * ri][1]);
      pb.u[1] = pack2bf(sc[2 * ri][2], sc[2 * ri][3]);
      pb.u[2] = pack2bf(sc[2 * ri + 1][0], sc[2 * ri + 1][1]);
      pb.u[3] = pack2bf(sc[2 * ri + 1][2], sc[2 * ri + 1][3]);
#pragma unroll
      for (int dt = 0; dt < 4; ++dt) {
        const bf16_t* vp = Vl + (ri * 64 + cw0 + 4 * g + (tl >> 2)) * NA_KLD + dt * 16 + 4 * (tl & 3);
        const v4s_t r0 = __builtin_amdgcn_ds_read_tr16_b64_v4i16((v4s_t LAS*)(LAS bf16_t*)vp);
        const v4s_t r1 = __builtin_amdgcn_ds_read_tr16_b64_v4i16((v4s_t LAS*)(LAS bf16_t*)(vp + 16 * NA_KLD));
        const bf16x8 va = {r0[0], r0[1], r0[2], r0[3], r1[0], r1[1], r1[2], r1[3]};
        o[dt] = __builtin_amdgcn_mfma_f32_16x16x32_bf16(va, pb.v, o[dt], 0, 0, 0);
      }
    }
    bf16_t* dst = p.ycat + (size_t)(qtok0 + qt * 16 + tl) * 1024 + 768 + h * 64 + 4 * g;
#pragma unroll
    for (int dt = 0; dt < 4; ++dt) {
      uint2 ov;
      ov.x = pack2bf(o[dt][0] * rden, o[dt][1] * rden);
      ov.y = pack2bf(o[dt][2] * rden, o[dt][3] * rden);
      *(uint2*)(dst + dt * 16) = ov;
    }
  }
}

#define PL_LD 264
__device__ __forceinline__ void o_pool_task(const Params& p, int l, int task, char* smem, int tid) {
  const int wave = tid >> 6, lane = tid & 63, g = lane >> 4, tl = lane & 15;
  const int t0 = task * 64, pos0 = t0 & (SEQ - 1);
  bf16_t* Xp = (bf16_t*)smem;
  bf16_t* WT = Xp + 80 * PL_LD;
  bf16_t* Df = WT + 4 * 64 * 72;
  __syncthreads();
#pragma unroll
  for (int it = 0; it < 5; ++it) {
    const int u = tid + it * NTHREADS;
    const int rw = u >> 5, c0 = (u & 31) * 8;
    const int pos = pos0 - 8 + rw;
    uint4 v = make_uint4(0u, 0u, 0u, 0u);
    if (pos >= 0 && pos < SEQ) v = *(const uint4*)(p.proj + (size_t)(t0 - 8 + rw) * IN_WIDTH + C_POOL + c0);
    *(uint4*)(Xp + rw * PL_LD + c0) = v;
  }
#pragma unroll
  for (int it = 0; it < 4; ++it) {
    const int u = tid + it * NTHREADS;
    const int e0 = (u & 7) * 8, c = (u >> 3) & 63, gi = u >> 9;
    const float* wp = p.pool_w + (((size_t)l * 4 + gi) * 64 + c) * 64 + e0;
    const float4 a = *(const float4*)wp, bq = *(const float4*)(wp + 4);
    const float wv[8] = {a.x, a.y, a.z, a.w, bq.x, bq.y, bq.z, bq.w};
#pragma unroll
    for (int k = 0; k < 8; ++k) WT[(gi * 64 + e0 + k) * 72 + c] = f2bf(wv[k]);
  }
  __syncthreads();
#pragma unroll 1
  for (int it = 0; it < 4; ++it) {
    const int u = tid + it * NTHREADS;
    const int t = u >> 5, c0 = (u & 31) * 8;
    const int gi = c0 >> 6;
    const int hw = 1 << gi;
    const int pos = pos0 + t;
    int a = pos - hw; a = a < 0 ? 0 : a;
    int bnd = pos + hw; bnd = bnd > SEQ ? SEQ : bnd;
    float sum[8];
#pragma unroll
    for (int k = 0; k < 8; ++k) sum[k] = 0.f;
    for (int rp = a; rp < bnd; ++rp) {
      const uint4 v = *(const uint4*)(Xp + (rp - pos0 + 8) * PL_LD + c0);
      sum[0] += bf_lo(v.x); sum[1] += bf_hi(v.x); sum[2] += bf_lo(v.y); sum[3] += bf_hi(v.y);
      sum[4] += bf_lo(v.z); sum[5] += bf_hi(v.z); sum[6] += bf_lo(v.w); sum[7] += bf_hi(v.w);
    }
    const float rc = 1.0f / (float)(bnd - a);
    const uint4 xv = *(const uint4*)(Xp + (t + 8) * PL_LD + c0);
    uint4 o;
    o.x = pack2bf(sum[0] * rc - bf_lo(xv.x), sum[1] * rc - bf_hi(xv.x));
    o.y = pack2bf(sum[2] * rc - bf_lo(xv.y), sum[3] * rc - bf_hi(xv.y));
    o.z = pack2bf(sum[4] * rc - bf_lo(xv.z), sum[5] * rc - bf_hi(xv.z));
    o.w = pack2bf(sum[6] * rc - bf_lo(xv.w), sum[7] * rc - bf_hi(xv.w));
    *(uint4*)(Df + t * PL_LD + c0) = o;
  }
  __syncthreads();
  {
    const int gi = wave >> 1, tt0 = (wave & 1) * 2;
    f32x4 acc[4][2];
#pragma unroll
    for (int et = 0; et < 4; ++et)
#pragma unroll
      for (int tt = 0; tt < 2; ++tt) acc[et][tt] = (f32x4){0.f, 0.f, 0.f, 0.f};
#pragma unroll
    for (int ks = 0; ks < 2; ++ks) {
      bf16x8 bx[2];
#pragma unroll
      for (int tt = 0; tt < 2; ++tt) bx[tt] = *(const bf16x8*)(Df + ((tt0 + tt) * 16 + tl) * PL_LD + gi * 64 + ks * 32 + 8 * g);
#pragma unroll
      for (int et = 0; et < 4; ++et) {
        const bf16x8 wa = *(const bf16x8*)(WT + (gi * 64 + et * 16 + tl) * 72 + ks * 32 + 8 * g);
#pragma unroll
        for (int tt = 0; tt < 2; ++tt) acc[et][tt] = __builtin_amdgcn_mfma_f32_16x16x32_bf16(wa, bx[tt], acc[et][tt], 0, 0, 0);
      }
    }
#pragma unroll
    for (int et = 0; et < 4; ++et) {
      const float4 sc4 = *(const float4*)(p.pool_scale + l * 256 + gi * 64 + et * 16 + 4 * g);
#pragma unroll
      for (int tt = 0; tt < 2; ++tt) {
        const int tok = t0 + (tt0 + tt) * 16 + tl;
        uint2 o;
        o.x = pack2bf(acc[et][tt][0] * sc4.x, acc[et][tt][1] * sc4.y);
        o.y = pack2bf(acc[et][tt][2] * sc4.z, acc[et][tt][3] * sc4.w);
        *(uint2*)(p.ycat + (size_t)tok * 1024 + gi * 64 + et * 16 + 4 * g) = o;
      }
    }
  }
}


typedef __attribute__((ext_vector_type(2))) __bf16 bf16x2_t;
__device__ __forceinline__ float dot2bf(unsigned a, unsigned b, float c) {
  return __builtin_amdgcn_fdot2_f32_bf16(__builtin_bit_cast(bf16x2_t, a), __builtin_bit_cast(bf16x2_t, b), c, false);
}
#define DPP_F(v, ctrl) __builtin_bit_cast(float, __builtin_amdgcn_update_dpp(0, __builtin_bit_cast(int, v), ctrl, 0xf, 0xf, false))
#define RDLANE_F(v, l) __builtin_bit_cast(float, __builtin_amdgcn_readlane(__builtin_bit_cast(int, v), l))
__device__ __forceinline__ float erf_as(float x) {
  const float ax = fabsf(x);
  const float t = __builtin_amdgcn_rcpf(fmaf(0.3275911f, ax, 1.0f));
  float y = fmaf(1.061405429f, t, -1.453152027f);
  y = fmaf(y, t, 1.421413741f);
  y = fmaf(y, t, -0.284496736f);
  y = fmaf(y, t, 0.254829592f);
  y = y * t * __expf(-ax * ax);
  return copysignf(1.0f - y, x);
}
__device__ __forceinline__ float gelu_fast_exact(float a) { return 0.5f * a * (1.0f + erf_as(a * 0.70710678118654752f)); }
struct PickPair { int eA, eB; float gA, gB; };

#define EX6_SHIFT 11
#define EX6_NSLICE (16384 >> EX6_SHIFT)
__device__ __forceinline__ unsigned cvt8_bf16x2(unsigned w, float scale, const bool hi) {
  return hi ? __builtin_bit_cast(unsigned, __builtin_amdgcn_cvt_scalef32_pk_bf16_fp8((int)w, scale, true))
            : __builtin_bit_cast(unsigned, __builtin_amdgcn_cvt_scalef32_pk_bf16_fp8((int)w, scale, false));
}
__device__ __forceinline__ void experts6_process4(const unsigned char* __restrict__ U8, const unsigned char* __restrict__ V8,
                                                  const float2* __restrict__ ES, const int (&e)[4], const float (&g)[4],
                                                  const unsigned (&hw)[8], float (&acc)[16], int lane, int vz) {
  uint4 u[4], v[4];
  float2 sc[4];
#pragma unroll
  for (int i = 0; i < 4; ++i) u[i] = *(const uint4*)(U8 + (size_t)e[i] * 1024 + lane * 16);
#pragma unroll
  for (int i = 0; i < 4; ++i) sc[i] = ES[e[i] + vz];
#pragma unroll
  for (int i = 0; i < 4; ++i) v[i] = *(const uint4*)(V8 + (size_t)e[i] * 1024 + lane * 16);
  float a[4];
#pragma unroll
  for (int i = 0; i < 4; ++i) {
    const unsigned uw[4] = {u[i].x, u[i].y, u[i].z, u[i].w};
    float t = 0.f;
#pragma unroll
    for (int w = 0; w < 4; ++w) {
      t = dot2bf(cvt8_bf16x2(uw[w], sc[i].x, false), hw[2 * w], t);
      t = dot2bf(cvt8_bf16x2(uw[w], sc[i].x, true), hw[2 * w + 1], t);
    }
    a[i] = t;
  }
  const bool b0 = lane & 1, b1 = lane & 2;
  const float x01 = (b0 ? a[1] : a[0]) + DPP_F((b0 ? a[0] : a[1]), 0xB1);
  const float x23 = (b0 ? a[3] : a[2]) + DPP_F((b0 ? a[2] : a[3]), 0xB1);
  float y = (b1 ? x23 : x01) + DPP_F((b1 ? x01 : x23), 0x4E);
  y += DPP_F(y, 0x124);
  y += DPP_F(y, 0x128);
  float sum[4];
#pragma unroll
  for (int i = 0; i < 4; ++i) sum[i] = RDLANE_F(y, i) + RDLANE_F(y, 16 + i) + RDLANE_F(y, 32 + i) + RDLANE_F(y, 48 + i);
  const int li = lane & 3;
  const float mine = (li == 0) ? sum[0] : (li == 1) ? sum[1] : (li == 2) ? sum[2] : sum[3];
  const float gmine = (li == 0) ? g[0] : (li == 1) ? g[1] : (li == 2) ? g[2] : g[3];
  const unsigned gb = (unsigned)f2bf(gelu_fast_exact(mine) * gmine);
#pragma unroll
  for (int i = 0; i < 4; ++i) {
    const unsigned hl = (unsigned)__builtin_amdgcn_readlane((int)gb, i);
    const unsigned hh = hl << 16;
    const unsigned vw[4] = {v[i].x, v[i].y, v[i].z, v[i].w};
#pragma unroll
    for (int w = 0; w < 4; ++w) {
      const unsigned p0 = cvt8_bf16x2(vw[w], sc[i].y, false), p1 = cvt8_bf16x2(vw[w], sc[i].y, true);
      acc[4 * w + 0] = dot2bf(p0, hl, acc[4 * w + 0]);
      acc[4 * w + 1] = dot2bf(p0, hh, acc[4 * w + 1]);
      acc[4 * w + 2] = dot2bf(p1, hl, acc[4 * w + 2]);
      acc[4 * w + 3] = dot2bf(p1, hh, acc[4 * w + 3]);
    }
  }
}

__device__ __forceinline__ void o_peer_experts6_tile(const Params& p, int l, int t0, const char* smem, int tid, bool dry = false) {
  const int wave = __builtin_amdgcn_readfirstlane(tid >> 6), lane = tid & 63;
  const unsigned char* U8 = p.u8 + (size_t)l * 16384 * 1024;
  const unsigned char* V8 = p.v8 + (size_t)l * 16384 * 1024;
  const float2* ES = p.escale + (size_t)l * 16384;
  int vz = 0;
  asm volatile("" : "+v"(vz));
  const int s0 = ((int)(__builtin_amdgcn_s_getreg((3 << 11) | 20) & 0xF) * (EX6_NSLICE / 8)) & (EX6_NSLICE - 1);
  unsigned pk[8][2];
  float acc[8][16];
#pragma unroll
  for (int k = 0; k < 8; ++k) {
    const size_t base = (size_t)(t0 + wave * 8 + k) * 128 + lane + vz;
#pragma unroll
    for (int hf = 0; hf < 2; ++hf) pk[k][hf] = (unsigned)p.pidx[base + hf * 64] | ((unsigned)f2bf(p.pgate[base + hf * 64]) << 16);
#pragma unroll
    for (int i = 0; i < 16; ++i) acc[k][i] = 0.f;
  }
#pragma unroll 1
  for (int si = 0; si < EX6_NSLICE; ++si) {
    const unsigned s = (unsigned)((s0 + si) & (EX6_NSLICE - 1));
#pragma unroll
    for (int k = 0; k < 8; ++k) {
      unsigned long long m0 = __ballot(((pk[k][0] & 0x3fffu) >> EX6_SHIFT) == s);
      unsigned long long m1 = __ballot(((pk[k][1] & 0x3fffu) >> EX6_SHIFT) == s);
      if ((m0 | m1) == 0ull) continue;
      unsigned hw[8];
      {
        const char* xr = smem + (wave * 8 + k) * LDXB + lane * 32;
        const uint4 h0 = *(const uint4*)xr, h1 = *(const uint4*)(xr + 16);
        hw[0] = h0.x; hw[1] = h0.y; hw[2] = h0.z; hw[3] = h0.w; hw[4] = h1.x; hw[5] = h1.y; hw[6] = h1.z; hw[7] = h1.w;
      }
      while (m0 | m1) {
        int e[4]; float g[4];
#pragma unroll
        for (int i = 0; i < 4; ++i) {
          unsigned w;
          if (m0) { const int la = (int)__builtin_ctzll(m0); m0 &= m0 - 1; w = (unsigned)__builtin_amdgcn_readlane((int)pk[k][0], la); }
          else if (m1) { const int la = (int)__builtin_ctzll(m1); m1 &= m1 - 1; w = (unsigned)__builtin_amdgcn_readlane((int)pk[k][1], la); }
          else { w = (unsigned)e[0]; }
          e[i] = (int)(w & 0x3fffu);
          g[i] = __uint_as_float(w & 0xffff0000u);
        }
        experts6_process4(U8, V8, ES, e, g, hw, acc[k], lane, vz);
      }
    }
  }
  if (dry) {
#pragma unroll
    for (int k = 0; k < 8; ++k)
#pragma unroll
      for (int i = 0; i < 16; ++i) asm volatile("" :: "v"(acc[k][i]));
    return;
  }
#pragma unroll
  for (int k = 0; k < 8; ++k) {
    float* xr = p.xres + (size_t)(t0 + wave * 8 + k) * 1024 + lane * 16;
#pragma unroll
    for (int i = 0; i < 4; ++i) {
      float4 a0 = *(float4*)(xr + 4 * i);
      a0.x += acc[k][4 * i + 0]; a0.y += acc[k][4 * i + 1]; a0.z += acc[k][4 * i + 2]; a0.w += acc[k][4 * i + 3];
      *(float4*)(xr + 4 * i) = a0;
    }
  }
}


typedef _Float16 h2_t __attribute__((ext_vector_type(2)));
__device__ __forceinline__ void ex7_pop(unsigned long long& m0, unsigned long long& m1, const unsigned pk0, const unsigned pk1,
                                        int (&e)[4], float (&g)[4]) {
  int e0 = 0;
#pragma unroll
  for (int i = 0; i < 4; ++i) {
    unsigned w;
    if (m0) { const int la = (int)__builtin_ctzll(m0); m0 &= m0 - 1; w = (unsigned)__builtin_amdgcn_readlane((int)pk0, la); }
    else if (m1) { const int la = (int)__builtin_ctzll(m1); m1 &= m1 - 1; w = (unsigned)__builtin_amdgcn_readlane((int)pk1, la); }
    else { w = (unsigned)e0; }
    e[i] = (int)(w & 0x3fffu);
    g[i] = __uint_as_float(w & 0xffff0000u);
    if (i == 0) e0 = e[0];
  }
}
#define EX7_ISSUE(U_, V_, SC_, G_) { \
  _Pragma("unroll") for (int i_ = 0; i_ < 4; ++i_) U_[i_] = __builtin_bit_cast(uint4, __builtin_amdgcn_raw_buffer_load_b128(rU, lo16, e[i_] * 1024, 0)); \
  _Pragma("unroll") for (int i_ = 0; i_ < 4; ++i_) SC_[i_] = __builtin_bit_cast(float2, __builtin_amdgcn_raw_buffer_load_b64(rS, vz, e[i_] * 8, 0)); \
  _Pragma("unroll") for (int i_ = 0; i_ < 4; ++i_) V_[i_] = __builtin_bit_cast(uint4, __builtin_amdgcn_raw_buffer_load_b128(rV, lo16, e[i_] * 1024, 0)); \
  _Pragma("unroll") for (int i_ = 0; i_ < 4; ++i_) G_[i_] = g[i_]; }

__device__ __forceinline__ void ex7_compute(const uint4 (&ru)[4], const uint4 (&rv)[4], const float2 (&rsc)[4], const float (&rg)[4],
                                            const unsigned (&hw)[8], h2_t (&acc)[8], int lane) {
  float a[4];
#pragma unroll
  for (int i = 0; i < 4; ++i) {
    const unsigned uw[4] = {ru[i].x, ru[i].y, ru[i].z, ru[i].w};
    float t = 0.f;
#pragma unroll
    for (int w = 0; w < 4; ++w) {
      t = dot2bf(cvt8_bf16x2(uw[w], rsc[i].x, false), hw[2 * w], t);
      t = dot2bf(cvt8_bf16x2(uw[w], rsc[i].x, true), hw[2 * w + 1], t);
    }
    a[i] = t;
  }
  const bool b0 = lane & 1, b1 = lane & 2;
  const float x01 = (b0 ? a[1] : a[0]) + DPP_F((b0 ? a[0] : a[1]), 0xB1);
  const float x23 = (b0 ? a[3] : a[2]) + DPP_F((b0 ? a[2] : a[3]), 0xB1);
  float y = (b1 ? x23 : x01) + DPP_F((b1 ? x01 : x23), 0x4E);
  y += DPP_F(y, 0x124);
  y += DPP_F(y, 0x128);
  float sum[4];
#pragma unroll
  for (int i = 0; i < 4; ++i) sum[i] = RDLANE_F(y, i) + RDLANE_F(y, 16 + i) + RDLANE_F(y, 32 + i) + RDLANE_F(y, 48 + i);
  const int li = lane & 3;
  const float mine = (li == 0) ? sum[0] : (li == 1) ? sum[1] : (li == 2) ? sum[2] : sum[3];
  const float gmine = (li == 0) ? rg[0] : (li == 1) ? rg[1] : (li == 2) ? rg[2] : rg[3];
  const _Float16 hf = (_Float16)(gelu_fast_exact(mine) * gmine);
  const unsigned hb = (unsigned)__builtin_bit_cast(unsigned short, hf);
#pragma unroll
  for (int i = 0; i < 4; ++i) {
    const unsigned hl = (unsigned)__builtin_amdgcn_readlane((int)hb, i);
    const h2_t hh = __builtin_bit_cast(h2_t, hl | (hl << 16));
    const unsigned vw[4] = {rv[i].x, rv[i].y, rv[i].z, rv[i].w};
#pragma unroll
    for (int w = 0; w < 4; ++w) {
      const h2_t p0 = __builtin_amdgcn_cvt_scalef32_pk_f16_fp8((int)vw[w], rsc[i].y, false);
      const h2_t p1 = __builtin_amdgcn_cvt_scalef32_pk_f16_fp8((int)vw[w], rsc[i].y, true);
      acc[2 * w] = __builtin_elementwise_fma(p0, hh, acc[2 * w]);
      acc[2 * w + 1] = __builtin_elementwise_fma(p1, hh, acc[2 * w + 1]);
    }
  }
}

__device__ __forceinline__ void o_peer_experts7_tile(const Params& p, int l, int t0, const char* smem, int tid, bool dry = false) {
  const int wave = __builtin_amdgcn_readfirstlane(tid >> 6), lane = tid & 63;
  const unsigned char* U8 = p.u8 + (size_t)l * 16384 * 1024;
  const unsigned char* V8 = p.v8 + (size_t)l * 16384 * 1024;
  const float2* ES = p.escale + (size_t)l * 16384;
  int vz = 0;
  asm volatile("" : "+v"(vz));
  const __amdgpu_buffer_rsrc_t rsU = __builtin_amdgcn_make_buffer_rsrc((void*)U8, 0, 16384 * 1024, 0x00020000);
  const __amdgpu_buffer_rsrc_t rsV = __builtin_amdgcn_make_buffer_rsrc((void*)V8, 0, 16384 * 1024, 0x00020000);
  const __amdgpu_buffer_rsrc_t rsS = __builtin_amdgcn_make_buffer_rsrc((void*)ES, 0, 16384 * 8, 0x00020000);
  const __amdgpu_buffer_rsrc_t rsU0 = __builtin_amdgcn_make_buffer_rsrc((void*)U8, 0, 0, 0x00020000);
  const __amdgpu_buffer_rsrc_t rsV0 = __builtin_amdgcn_make_buffer_rsrc((void*)V8, 0, 0, 0x00020000);
  const __amdgpu_buffer_rsrc_t rsS0 = __builtin_amdgcn_make_buffer_rsrc((void*)ES, 0, 0, 0x00020000);
  const int lo16 = lane * 16;
  const int s0 = ((int)(__builtin_amdgcn_s_getreg((3 << 11) | 20) & 0xF) * (EX6_NSLICE / 8)) & (EX6_NSLICE - 1);
  unsigned pk[8][2];
  h2_t acc[8][8];
#pragma unroll
  for (int k = 0; k < 8; ++k) {
    const size_t base = (size_t)(t0 + wave * 8 + k) * 128 + lane + vz;
#pragma unroll
    for (int hf = 0; hf < 2; ++hf) pk[k][hf] = (unsigned)p.pidx[base + hf * 64] | ((unsigned)f2bf(p.pgate[base + hf * 64]) << 16);
#pragma unroll
    for (int i = 0; i < 8; ++i) acc[k][i] = (h2_t){(_Float16)0.f, (_Float16)0.f};
  }
#pragma unroll 1
  for (int si = 0; si < EX6_NSLICE; ++si) {
    const unsigned s = (unsigned)((s0 + si) & (EX6_NSLICE - 1));
#pragma unroll
    for (int k = 0; k < 8; ++k) {
      unsigned long long m0 = __ballot(((pk[k][0] & 0x3fffu) >> EX6_SHIFT) == s);
      unsigned long long m1 = __ballot(((pk[k][1] & 0x3fffu) >> EX6_SHIFT) == s);
      if ((m0 | m1) == 0ull) continue;
      unsigned hw[8];
      {
        const char* xr = smem + (wave * 8 + k) * LDXB + lane * 32;
        const uint4 h0 = *(const uint4*)xr, h1 = *(const uint4*)(xr + 16);
        hw[0] = h0.x; hw[1] = h0.y; hw[2] = h0.z; hw[3] = h0.w; hw[4] = h1.x; hw[5] = h1.y; hw[6] = h1.z; hw[7] = h1.w;
      }
      uint4 uA[4], vA[4], uB[4], vB[4];
      float2 scA[4], scB[4];
      float gA[4], gB[4];
      int e[4]; float g[4];
      ex7_pop(m0, m1, pk[k][0], pk[k][1], e, g);
      __amdgpu_buffer_rsrc_t rU = rsU, rV = rsV, rS = rsS;
      EX7_ISSUE(uA, vA, scA, gA)
      for (;;) {
        const bool mb = (m0 | m1) != 0ull;
        if (mb) ex7_pop(m0, m1, pk[k][0], pk[k][1], e, g);
        rU = mb ? rsU : rsU0; rV = mb ? rsV : rsV0; rS = mb ? rsS : rsS0;
        EX7_ISSUE(uB, vB, scB, gB)
        __builtin_amdgcn_s_setprio(1);
        ex7_compute(uA, vA, scA, gA, hw, acc[k], lane);
        __builtin_amdgcn_s_setprio(0);
        if (!mb) break;
        const bool ma = (m0 | m1) != 0ull;
        if (ma) ex7_pop(m0, m1, pk[k][0], pk[k][1], e, g);
        rU = ma ? rsU : rsU0; rV = ma ? rsV : rsV0; rS = ma ? rsS : rsS0;
        EX7_ISSUE(uA, vA, scA, gA)
        __builtin_amdgcn_s_setprio(1);
        ex7_compute(uB, vB, scB, gB, hw, acc[k], lane);
        __builtin_amdgcn_s_setprio(0);
        if (!ma) break;
      }
    }
  }
  if (dry) {
#pragma unroll
    for (int k = 0; k < 8; ++k)
#pragma unroll
      for (int i = 0; i < 8; ++i) asm volatile("" :: "v"(acc[k][i]));
    return;
  }
#pragma unroll
  for (int k = 0; k < 8; ++k) {
    float* xr = p.xres + (size_t)(t0 + wave * 8 + k) * 1024 + lane * 16;
#pragma unroll
    for (int i = 0; i < 4; ++i) {
      float4 a0 = *(float4*)(xr + 4 * i);
      a0.x += (float)acc[k][2 * i][0]; a0.y += (float)acc[k][2 * i][1];
      a0.z += (float)acc[k][2 * i + 1][0]; a0.w += (float)acc[k][2 * i + 1][1];
      *(float4*)(xr + 4 * i) = a0;
    }
  }
}

typedef unsigned u32x2_t __attribute__((ext_vector_type(2)));
__device__ __forceinline__ long mk_long(unsigned lo, unsigned hi) { return (long)(((unsigned long long)hi << 32) | (unsigned long long)lo); }
__device__ __forceinline__ float xrow_total(float y) {
  const unsigned yb = __float_as_uint(y);
  const u32x2_t r = __builtin_amdgcn_permlane16_swap(yb, yb, false, false);
  const float z = __uint_as_float(r[0]) + __uint_as_float(r[1]);
  const unsigned zb = __float_as_uint(z);
  const u32x2_t r2 = __builtin_amdgcn_permlane32_swap(zb, zb, false, false);
  return __uint_as_float(r2[0]) + __uint_as_float(r2[1]);
}
__device__ __forceinline__ void ex8_pop(unsigned long long& m0, unsigned long long& m1, const unsigned pk0, const unsigned pk1, unsigned (&w)[4]) {
  unsigned w0 = 0;
#pragma unroll
  for (int i = 0; i < 4; ++i) {
    unsigned x;
    if (m0) { const int la = (int)__builtin_ctzll(m0); m0 &= m0 - 1; x = (unsigned)__builtin_amdgcn_readlane((int)pk0, la); }
    else if (m1) { const int la = (int)__builtin_ctzll(m1); m1 &= m1 - 1; x = (unsigned)__builtin_amdgcn_readlane((int)pk1, la); }
    else { x = w0 & 0x3fffu; }
    w[i] = x;
    if (i == 0) w0 = x;
  }
}
#define EX8_ISSUE(U_, V_, SC_, WQ_) { \
  _Pragma("unroll") for (int i_ = 0; i_ < 4; ++i_) U_[i_] = __builtin_bit_cast(uint4, __builtin_amdgcn_raw_buffer_load_b128(rU, lo16, (int)(w[i_] & 0x3fffu) * 1024, 0)); \
  WQ_ = (w[0] & oh0) | (w[1] & oh1) | (w[2] & oh2) | (w[3] & oh3); \
  SC_ = __builtin_bit_cast(float2, __builtin_amdgcn_raw_buffer_load_b64(rS, (int)(WQ_ & 0x3fffu) * 8, 0, 0)); \
  _Pragma("unroll") for (int i_ = 0; i_ < 4; ++i_) V_[i_] = __builtin_bit_cast(uint4, __builtin_amdgcn_raw_buffer_load_b128(rV, lo16, (int)(w[i_] & 0x3fffu) * 1024, 0)); }

__device__ __forceinline__ void ex8_compute(const uint4 (&ru)[4], const uint4 (&rv)[4], const float2 scm, const unsigned wq,
                                            const uint4 hb, const float hsi, f32x4 (&cur)[4],
                                            const bool b0, const bool b1, const bool isdiag, const unsigned mlane) {
  const long hA = mk_long(hb.x, hb.y), hB = mk_long(hb.z, hb.w);
  f32x4 d[4];
#pragma unroll
  for (int i = 0; i < 4; ++i) d[i] = __builtin_amdgcn_mfma_f32_16x16x32_fp8_fp8(mk_long(ru[i].x, ru[i].y), hA, (f32x4){0.f, 0.f, 0.f, 0.f}, 0, 0, 0);
#pragma unroll
  for (int i = 0; i < 4; ++i) d[i] = __builtin_amdgcn_mfma_f32_16x16x32_fp8_fp8(mk_long(ru[i].z, ru[i].w), hB, d[i], 0, 0, 0);
  float a[4];
#pragma unroll
  for (int i = 0; i < 4; ++i) a[i] = b1 ? (b0 ? d[i][3] : d[i][2]) : (b0 ? d[i][1] : d[i][0]);
  const float x01 = (b0 ? a[1] : a[0]) + DPP_F((b0 ? a[0] : a[1]), 0xB1);
  const float x23 = (b0 ? a[3] : a[2]) + DPP_F((b0 ? a[2] : a[3]), 0xB1);
  float y = (b1 ? x23 : x01) + DPP_F((b1 ? x01 : x23), 0x4E);
  y = isdiag ? y : 0.f;
  y += DPP_F(y, 0x124);
  y += DPP_F(y, 0x128);
  y = xrow_total(y);
  const float hpre = y * scm.x * hsi;
  const float hv = gelu_fast_exact(hpre) * __uint_as_float(wq & 0xffff0000u) * scm.y;
  float m = fabsf(hv);
  m = fmaxf(m, DPP_F(m, 0xB1));
  m = fmaxf(m, DPP_F(m, 0x4E));
  unsigned eb = __float_as_uint(m) >> 23;
  eb = eb < 16u ? 16u : eb;
  const float S = __uint_as_float((261u - eb) << 23), invS = __uint_as_float((eb - 7u) << 23);
  const float hq = hv * S;
  const unsigned hb8 = (unsigned)__builtin_amdgcn_cvt_pk_fp8_f32(hq, hq, 0, false) & 0xffu;
  f32x4 e[4];
#pragma unroll
  for (int i = 0; i < 4; ++i) {
    const unsigned sb = (unsigned)__builtin_amdgcn_readlane((int)hb8, i) * 0x01010101u;
    const unsigned x = sb & mlane;
    const long a0 = mk_long(x, 0u), a1 = mk_long(0u, x);
    const long v0 = mk_long(rv[i].x, rv[i].y), v1 = mk_long(rv[i].z, rv[i].w);
    if (i == 0) {
      e[0] = __builtin_amdgcn_mfma_f32_16x16x32_fp8_fp8(a0, v0, (f32x4){0.f, 0.f, 0.f, 0.f}, 0, 0, 0);
      e[1] = __builtin_amdgcn_mfma_f32_16x16x32_fp8_fp8(a1, v0, (f32x4){0.f, 0.f, 0.f, 0.f}, 0, 0, 0);
      e[2] = __builtin_amdgcn_mfma_f32_16x16x32_fp8_fp8(a0, v1, (f32x4){0.f, 0.f, 0.f, 0.f}, 0, 0, 0);
      e[3] = __builtin_amdgcn_mfma_f32_16x16x32_fp8_fp8(a1, v1, (f32x4){0.f, 0.f, 0.f, 0.f}, 0, 0, 0);
    } else {
      e[0] = __builtin_amdgcn_mfma_f32_16x16x32_fp8_fp8(a0, v0, e[0], 0, 0, 0);
      e[1] = __builtin_amdgcn_mfma_f32_16x16x32_fp8_fp8(a1, v0, e[1], 0, 0, 0);
      e[2] = __builtin_amdgcn_mfma_f32_16x16x32_fp8_fp8(a0, v1, e[2], 0, 0, 0);
      e[3] = __builtin_amdgcn_mfma_f32_16x16x32_fp8_fp8(a1, v1, e[3], 0, 0, 0);
    }
  }
#pragma unroll
  for (int q = 0; q < 4; ++q) cur[q] += e[q] * invS;
}

__device__ __forceinline__ void o_peer_experts8_tile(const Params& p, int l, int t0, char* smem, int tid) {
  const int wave = __builtin_amdgcn_readfirstlane(tid >> 6), lane = tid & 63;
  const unsigned char* U8 = p.u8 + (size_t)l * 16384 * 1024;
  const unsigned char* V8 = p.v8 + (size_t)l * 16384 * 1024;
  const float2* ES = p.escale + (size_t)l * 16384;
  int vz = 0;
  asm volatile("" : "+v"(vz));
  const __amdgpu_buffer_rsrc_t rsU = __builtin_amdgcn_make_buffer_rsrc((void*)U8, 0, 16384 * 1024, 0x00020000);
  const __amdgpu_buffer_rsrc_t rsV = __builtin_amdgcn_make_buffer_rsrc((void*)V8, 0, 16384 * 1024, 0x00020000);
  const __amdgpu_buffer_rsrc_t rsS = __builtin_amdgcn_make_buffer_rsrc((void*)ES, 0, 16384 * 8, 0x00020000);
  const __amdgpu_buffer_rsrc_t rsU0 = __builtin_amdgcn_make_buffer_rsrc((void*)U8, 0, 0, 0x00020000);
  const __amdgpu_buffer_rsrc_t rsV0 = __builtin_amdgcn_make_buffer_rsrc((void*)V8, 0, 0, 0x00020000);
  const __amdgpu_buffer_rsrc_t rsS0 = __builtin_amdgcn_make_buffer_rsrc((void*)ES, 0, 0, 0x00020000);
  const int lo16 = lane * 16;
  const int li = lane & 3;
  const bool b0 = lane & 1, b1 = lane & 2, isdiag = (lane >> 4) == ((lane & 15) >> 2);
  const unsigned mlane = isdiag ? (0xffu << (8 * li)) : 0u;
  const unsigned oh0 = li == 0 ? 0xffffffffu : 0u, oh1 = li == 1 ? 0xffffffffu : 0u, oh2 = li == 2 ? 0xffffffffu : 0u, oh3 = li == 3 ? 0xffffffffu : 0u;
  const int s0 = ((int)(__builtin_amdgcn_s_getreg((3 << 11) | 20) & 0xF) * (EX6_NSLICE / 8)) & (EX6_NSLICE - 1);
  unsigned pk[8][2];
  h2_t acc[8][8];
  float hsi[8];
#pragma unroll
  for (int k = 0; k < 8; ++k) {
    const size_t base = (size_t)(t0 + wave * 8 + k) * 128 + lane + vz;
#pragma unroll
    for (int hf = 0; hf < 2; ++hf) pk[k][hf] = (unsigned)p.pidx[base + hf * 64] | ((unsigned)f2bf(p.pgate[base + hf * 64]) << 16);
#pragma unroll
    for (int i = 0; i < 8; ++i) acc[k][i] = (h2_t){(_Float16)0.f, (_Float16)0.f};
  }
#pragma unroll
  for (int k = 0; k < 8; ++k) {
    char* row = smem + (wave * 8 + k) * LDXB;
    const uint4 h0 = *(const uint4*)(row + lane * 32), h1 = *(const uint4*)(row + lane * 32 + 16);
    const unsigned hw[8] = {h0.x, h0.y, h0.z, h0.w, h1.x, h1.y, h1.z, h1.w};
    float mx = 0.f;
#pragma unroll
    for (int i = 0; i < 8; ++i) mx = fmaxf(mx, fmaxf(fabsf(__uint_as_float(hw[i] << 16)), fabsf(__uint_as_float(hw[i] & 0xffff0000u))));
    mx = wave_max(mx);
    unsigned eb = __float_as_uint(mx) >> 23;
    eb = eb < 16u ? 16u : (eb > 240u ? 240u : eb);
    eb = (unsigned)__builtin_amdgcn_readfirstlane((int)eb);
    const float S = __uint_as_float((261u - eb) << 23);
    hsi[k] = __uint_as_float((eb - 7u) << 23);
    unsigned o[4];
#pragma unroll
    for (int i = 0; i < 4; ++i) {
      int t = __builtin_amdgcn_cvt_pk_fp8_f32(__uint_as_float(hw[2 * i] << 16) * S, __uint_as_float(hw[2 * i] & 0xffff0000u) * S, 0, false);
      t = __builtin_amdgcn_cvt_pk_fp8_f32(__uint_as_float(hw[2 * i + 1] << 16) * S, __uint_as_float(hw[2 * i + 1] & 0xffff0000u) * S, t, true);
      o[i] = (unsigned)t;
    }
    asm volatile("s_waitcnt lgkmcnt(0)" ::: "memory");
    *(uint4*)(row + lane * 16) = make_uint4(o[0], o[1], o[2], o[3]);
  }
  asm volatile("s_waitcnt lgkmcnt(0)" ::: "memory");
#pragma unroll 1
  for (int si = 0; si < EX6_NSLICE; ++si) {
    const unsigned s = (unsigned)((s0 + si) & (EX6_NSLICE - 1));
#pragma unroll
    for (int k = 0; k < 8; ++k) {
      unsigned long long m0 = __ballot(((pk[k][0] & 0x3fffu) >> EX6_SHIFT) == s);
      unsigned long long m1 = __ballot(((pk[k][1] & 0x3fffu) >> EX6_SHIFT) == s);
      if ((m0 | m1) == 0ull) continue;
      const uint4 hb = *(const uint4*)(smem + (wave * 8 + k) * LDXB + lane * 16);
      f32x4 cur[4];
#pragma unroll
      for (int q = 0; q < 4; ++q) cur[q] = (f32x4){0.f, 0.f, 0.f, 0.f};
      uint4 uA[4], vA[4], uB[4], vB[4];
      float2 scA, scB;
      unsigned wqA, wqB;
      unsigned w[4];
      ex8_pop(m0, m1, pk[k][0], pk[k][1], w);
      __amdgpu_buffer_rsrc_t rU = rsU, rV = rsV, rS = rsS;
      EX8_ISSUE(uA, vA, scA, wqA)
      for (;;) {
        const bool mb = (m0 | m1) != 0ull;
        if (mb) ex8_pop(m0, m1, pk[k][0], pk[k][1], w);
        rU = mb ? rsU : rsU0; rV = mb ? rsV : rsV0; rS = mb ? rsS : rsS0;
        EX8_ISSUE(uB, vB, scB, wqB)
        __builtin_amdgcn_s_setprio(1);
        ex8_compute(uA, vA, scA, wqA, hb, hsi[k], cur, b0, b1, isdiag, mlane);
        __builtin_amdgcn_s_setprio(0);
        if (!mb) break;
        const bool ma = (m0 | m1) != 0ull;
        if (ma) ex8_pop(m0, m1, pk[k][0], pk[k][1], w);
        rU = ma ? rsU : rsU0; rV = ma ? rsV : rsV0; rS = ma ? rsS : rsS0;
        EX8_ISSUE(uA, vA, scA, wqA)
        __builtin_amdgcn_s_setprio(1);
        ex8_compute(uB, vB, scB, wqB, hb, hsi[k], cur, b0, b1, isdiag, mlane);
        __builtin_amdgcn_s_setprio(0);
        if (!ma) break;
      }
#pragma unroll
      for (int q = 0; q < 4; ++q) {
        acc[k][2 * q] += (h2_t){(_Float16)cur[q][0], (_Float16)cur[q][1]};
        acc[k][2 * q + 1] += (h2_t){(_Float16)cur[q][2], (_Float16)cur[q][3]};
      }
    }
  }
#pragma unroll
  for (int k = 0; k < 8; ++k) {
    float* xr = p.xres + (size_t)(t0 + wave * 8 + k) * 1024 + lane * 16;
#pragma unroll
    for (int i = 0; i < 4; ++i) {
      float4 a0 = *(float4*)(xr + 4 * i);
      a0.x += (float)acc[k][2 * i][0]; a0.y += (float)acc[k][2 * i][1];
      a0.z += (float)acc[k][2 * i + 1][0]; a0.w += (float)acc[k][2 * i + 1][1];
      *(float4*)(xr + 4 * i) = a0;
    }
  }
}

typedef unsigned v16u_t __attribute__((ext_vector_type(16)));
typedef unsigned v32u_t __attribute__((ext_vector_type(32)));
#define EX9_GEN(U_, V_, SC_, WQ_, K_, LAST_, VALID_) { \
  VALID_ = false; \
  if (!gdone) { \
    while ((m0 | m1) == 0ull) { \
      ++gk; \
      if (gk == 8) { gk = 0; ++gsi; if (gsi == EX6_NSLICE) { gdone = true; break; } } \
      gpk0 = pkv[2 * gk]; gpk1 = pkv[2 * gk + 1]; \
      const unsigned s_ = (unsigned)((s0 + gsi) & (EX6_NSLICE - 1)); \
      m0 = __ballot(((gpk0 & 0x3fffu) >> EX6_SHIFT) == s_); \
      m1 = __ballot(((gpk1 & 0x3fffu) >> EX6_SHIFT) == s_); \
    } \
    if (!gdone) { ex8_pop(m0, m1, gpk0, gpk1, w); K_ = gk; LAST_ = (m0 | m1) == 0ull; VALID_ = true; } \
  } \
  rU = VALID_ ? rsU : rsU0; rV = VALID_ ? rsV : rsV0; rS = VALID_ ? rsS : rsS0; \
  EX8_ISSUE(U_, V_, SC_, WQ_) }
#define EX9_COMPUTE(U_, V_, SC_, WQ_, K_, LAST_, VALID_) { \
  if (VALID_) { \
    if (K_ != ck) { ck = K_; hb = make_uint4(hbv[4 * K_], hbv[4 * K_ + 1], hbv[4 * K_ + 2], hbv[4 * K_ + 3]); \
                    hs = __uint_as_float((unsigned)__builtin_amdgcn_readlane((int)__float_as_uint(hsiv), K_)); } \
    __builtin_amdgcn_s_setprio(1); \
    ex8_compute(U_, V_, SC_, WQ_, hb, hs, cur, b0, b1, isdiag, mlane); \
    __builtin_amdgcn_s_setprio(0); \
    if (LAST_) { \
      char* ar_ = smem + (wave * 8 + K_) * LDXB + lane * 32; \
      uint4 a0_ = *(const uint4*)ar_, a1_ = *(const uint4*)(ar_ + 16); \
      a0_.x = ex9_addh2(a0_.x, cur[0][0], cur[0][1]); a0_.y = ex9_addh2(a0_.y, cur[0][2], cur[0][3]); \
      a0_.z = ex9_addh2(a0_.z, cur[1][0], cur[1][1]); a0_.w = ex9_addh2(a0_.w, cur[1][2], cur[1][3]); \
      a1_.x = ex9_addh2(a1_.x, cur[2][0], cur[2][1]); a1_.y = ex9_addh2(a1_.y, cur[2][2], cur[2][3]); \
      a1_.z = ex9_addh2(a1_.z, cur[3][0], cur[3][1]); a1_.w = ex9_addh2(a1_.w, cur[3][2], cur[3][3]); \
      *(uint4*)ar_ = a0_; *(uint4*)(ar_ + 16) = a1_; \
      _Pragma("unroll") for (int q_ = 0; q_ < 4; ++q_) cur[q_] = (f32x4){0.f, 0.f, 0.f, 0.f}; \
    } \
  } }
__device__ __forceinline__ unsigned ex9_addh2(unsigned a, float x, float y) {
  const h2_t r = __builtin_bit_cast(h2_t, a) + (h2_t){(_Float16)x, (_Float16)y};
  return __builtin_bit_cast(unsigned, r);
}

__device__ __forceinline__ void o_peer_experts9_tile(const Params& p, int l, int t0, char* smem, int tid) {
  const int wave = __builtin_amdgcn_readfirstlane(tid >> 6), lane = tid & 63;
  const unsigned char* U8 = p.u8 + (size_t)l * 16384 * 1024;
  const unsigned char* V8 = p.v8 + (size_t)l * 16384 * 1024;
  const float2* ES = p.escale + (size_t)l * 16384;
  int vz = 0;
  asm volatile("" : "+v"(vz));
  const __amdgpu_buffer_rsrc_t rsU = __builtin_amdgcn_make_buffer_rsrc((void*)U8, 0, 16384 * 1024, 0x00020000);
  const __amdgpu_buffer_rsrc_t rsV = __builtin_amdgcn_make_buffer_rsrc((void*)V8, 0, 16384 * 1024, 0x00020000);
  const __amdgpu_buffer_rsrc_t rsS = __builtin_amdgcn_make_buffer_rsrc((void*)ES, 0, 16384 * 8, 0x00020000);
  const __amdgpu_buffer_rsrc_t rsU0 = __builtin_amdgcn_make_buffer_rsrc((void*)U8, 0, 0, 0x00020000);
  const __amdgpu_buffer_rsrc_t rsV0 = __builtin_amdgcn_make_buffer_rsrc((void*)V8, 0, 0, 0x00020000);
  const __amdgpu_buffer_rsrc_t rsS0 = __builtin_amdgcn_make_buffer_rsrc((void*)ES, 0, 0, 0x00020000);
  const int lo16 = lane * 16;
  const int li = lane & 3;
  const bool b0 = lane & 1, b1 = lane & 2, isdiag = (lane >> 4) == ((lane & 15) >> 2);
  const unsigned mlane = isdiag ? (0xffu << (8 * li)) : 0u;
  const unsigned oh0 = li == 0 ? 0xffffffffu : 0u, oh1 = li == 1 ? 0xffffffffu : 0u, oh2 = li == 2 ? 0xffffffffu : 0u, oh3 = li == 3 ? 0xffffffffu : 0u;
  const int s0 = ((int)(__builtin_amdgcn_s_getreg((3 << 11) | 20) & 0xF) * (EX6_NSLICE / 8)) & (EX6_NSLICE - 1);
  v16u_t pkv;
  v32u_t hbv;
  float hsiv = 0.f;
#pragma unroll
  for (int k = 0; k < 8; ++k) {
    const size_t base = (size_t)(t0 + wave * 8 + k) * 128 + lane + vz;
#pragma unroll
    for (int hf = 0; hf < 2; ++hf) pkv[2 * k + hf] = (unsigned)p.pidx[base + hf * 64] | ((unsigned)f2bf(p.pgate[base + hf * 64]) << 16);
  }
#pragma unroll
  for (int k = 0; k < 8; ++k) {
    char* row = smem + (wave * 8 + k) * LDXB;
    const uint4 h0 = *(const uint4*)(row + lane * 32), h1 = *(const uint4*)(row + lane * 32 + 16);
    const unsigned hw[8] = {h0.x, h0.y, h0.z, h0.w, h1.x, h1.y, h1.z, h1.w};
    float mx = 0.f;
#pragma unroll
    for (int i = 0; i < 8; ++i) mx = fmaxf(mx, fmaxf(fabsf(__uint_as_float(hw[i] << 16)), fabsf(__uint_as_float(hw[i] & 0xffff0000u))));
    mx = wave_max(mx);
    unsigned eb = __float_as_uint(mx) >> 23;
    eb = eb < 16u ? 16u : (eb > 240u ? 240u : eb);
    const float S = __uint_as_float((261u - eb) << 23);
    hsiv = (lane == k) ? __uint_as_float((eb - 7u) << 23) : hsiv;
#pragma unroll
    for (int i = 0; i < 4; ++i) {
      int t = __builtin_amdgcn_cvt_pk_fp8_f32(__uint_as_float(hw[2 * i] << 16) * S, __uint_as_float(hw[2 * i] & 0xffff0000u) * S, 0, false);
      t = __builtin_amdgcn_cvt_pk_fp8_f32(__uint_as_float(hw[2 * i + 1] << 16) * S, __uint_as_float(hw[2 * i + 1] & 0xffff0000u) * S, t, true);
      hbv[4 * k + i] = (unsigned)t;
    }
    asm volatile("s_waitcnt lgkmcnt(0)" ::: "memory");
    *(uint4*)(row + lane * 32) = make_uint4(0u, 0u, 0u, 0u);
    *(uint4*)(row + lane * 32 + 16) = make_uint4(0u, 0u, 0u, 0u);
  }
  int gsi = 0, gk = -1;
  bool gdone = false;
  unsigned long long m0 = 0ull, m1 = 0ull;
  unsigned gpk0 = 0u, gpk1 = 0u;
  unsigned w[4] = {0u, 0u, 0u, 0u};
  __amdgpu_buffer_rsrc_t rU = rsU, rV = rsV, rS = rsS;
  uint4 uA[4], vA[4], uB[4], vB[4], uC[4], vC[4];
  float2 scA, scB, scC;
  unsigned wqA, wqB, wqC;
  int kA = 0, kB = 0, kC = 0;
  bool lastA = false, lastB = false, lastC = false, validA, validB, validC;
  int ck = -1;
  uint4 hb = make_uint4(0u, 0u, 0u, 0u);
  float hs = 0.f;
  f32x4 cur[4];
#pragma unroll
  for (int q = 0; q < 4; ++q) cur[q] = (f32x4){0.f, 0.f, 0.f, 0.f};
  EX9_GEN(uA, vA, scA, wqA, kA, lastA, validA)
  EX9_GEN(uB, vB, scB, wqB, kB, lastB, validB)
#pragma unroll 1
  for (;;) {
    EX9_GEN(uC, vC, scC, wqC, kC, lastC, validC)
    EX9_COMPUTE(uA, vA, scA, wqA, kA, lastA, validA)
    EX9_GEN(uA, vA, scA, wqA, kA, lastA, validA)
    EX9_COMPUTE(uB, vB, scB, wqB, kB, lastB, validB)
    EX9_GEN(uB, vB, scB, wqB, kB, lastB, validB)
    EX9_COMPUTE(uC, vC, scC, wqC, kC, lastC, validC)
    if (!validA && !validB) break;
  }
  asm volatile("s_waitcnt lgkmcnt(0)" ::: "memory");
#pragma unroll
  for (int k = 0; k < 8; ++k) {
    const char* ar = smem + (wave * 8 + k) * LDXB + lane * 32;
    const uint4 a0 = *(const uint4*)ar, a1 = *(const uint4*)(ar + 16);
    const unsigned aw[8] = {a0.x, a0.y, a0.z, a0.w, a1.x, a1.y, a1.z, a1.w};
    float* xr = p.xres + (size_t)(t0 + wave * 8 + k) * 1024 + lane * 16;
#pragma unroll
    for (int i = 0; i < 4; ++i) {
      float4 x4 = *(float4*)(xr + 4 * i);
      const h2_t c0 = __builtin_bit_cast(h2_t, aw[2 * i]), c1 = __builtin_bit_cast(h2_t, aw[2 * i + 1]);
      x4.x += (float)c0[0]; x4.y += (float)c0[1]; x4.z += (float)c1[0]; x4.w += (float)c1[1];
      *(float4*)(xr + 4 * i) = x4;
    }
  }
}

__device__ __forceinline__ unsigned xrow_umax(unsigned y) {
  const u32x2_t r = __builtin_amdgcn_permlane16_swap(y, y, false, false);
  const unsigned z = r[0] > r[1] ? r[0] : r[1];
  const u32x2_t r2 = __builtin_amdgcn_permlane32_swap(z, z, false, false);
  return r2[0] > r2[1] ? r2[0] : r2[1];
}
#define EXB_ISSUE(U_, V_, SC_, WQ_) { \
  const unsigned wu_ = (w[0] & ou0) | (w[1] & ou1) | (w[2] & ou2) | (w[3] & ou3); \
  const int vu_ = (int)((wu_ & 0x3fffu) << 10) + cu; \
  _Pragma("unroll") for (int m_ = 0; m_ < 4; ++m_) U_[m_] = __builtin_bit_cast(uint4, __builtin_amdgcn_raw_buffer_load_b128(rU, vu_ + 256 * m_, 0, 0)); \
  WQ_ = (w[0] & og0) | (w[1] & og1) | (w[2] & og2) | (w[3] & og3); \
  SC_ = __builtin_bit_cast(float2, __builtin_amdgcn_raw_buffer_load_b64(rS, (int)(WQ_ & 0x3fffu) * 8, 0, 0)); \
  _Pragma("unroll") for (int i_ = 0; i_ < 4; ++i_) V_[i_] = __builtin_bit_cast(uint4, __builtin_amdgcn_raw_buffer_load_b128(rV, lo16, (int)(w[i_] & 0x3fffu) * 1024, 0)); }

__device__ __forceinline__ void exB_compute(const uint4 (&ru)[4], const uint4 (&rv)[4], const float2 scm, const unsigned wq,
                                            const unsigned (&hb)[16], const float hsi, f32x4 (&cur)[4],
                                            const bool b0, const bool b1, const unsigned mlane) {
  f32x4 d = (f32x4){0.f, 0.f, 0.f, 0.f};
#pragma unroll
  for (int m = 0; m < 4; ++m) {
    d = __builtin_amdgcn_mfma_f32_16x16x32_fp8_fp8(mk_long(ru[m].x, ru[m].y), mk_long(hb[4 * m], hb[4 * m + 1]), d, 0, 0, 0);
    d = __builtin_amdgcn_mfma_f32_16x16x32_fp8_fp8(mk_long(ru[m].z, ru[m].w), mk_long(hb[4 * m + 2], hb[4 * m + 3]), d, 0, 0, 0);
  }
  const float val = b1 ? (b0 ? d[3] : d[2]) : (b0 ? d[1] : d[0]);
  float y = val + DPP_F(val, 0xB1);
  y += DPP_F(y, 0x4E);
  const float hpre = y * scm.x * hsi;
  const float hv = gelu_fast_exact(hpre) * __uint_as_float(wq & 0xffff0000u) * scm.y;
  unsigned eb = xrow_umax(__float_as_uint(hv) & 0x7fffffffu) >> 23;
  eb = eb < 16u ? 16u : eb;
  const float S = __uint_as_float((261u - eb) << 23), invS = __uint_as_float((eb - 7u) << 23);
  const float hq = hv * S;
  const unsigned hb8 = (unsigned)__builtin_amdgcn_cvt_pk_fp8_f32(hq, hq, 0, false) & 0xffu;
  f32x4 e[4];
#pragma unroll
  for (int i = 0; i < 4; ++i) {
    const unsigned sb = (unsigned)__builtin_amdgcn_readlane((int)hb8, 16 * i) * 0x01010101u;
    const unsigned x = sb & mlane;
    const long a0 = mk_long(x, 0u), a1 = mk_long(0u, x);
    const long v0 = mk_long(rv[i].x, rv[i].y), v1 = mk_long(rv[i].z, rv[i].w);
    if (i == 0) {
      e[0] = __builtin_amdgcn_mfma_f32_16x16x32_fp8_fp8(a0, v0, (f32x4){0.f, 0.f, 0.f, 0.f}, 0, 0, 0);
      e[1] = __builtin_amdgcn_mfma_f32_16x16x32_fp8_fp8(a1, v0, (f32x4){0.f, 0.f, 0.f, 0.f}, 0, 0, 0);
      e[2] = __builtin_amdgcn_mfma_f32_16x16x32_fp8_fp8(a0, v1, (f32x4){0.f, 0.f, 0.f, 0.f}, 0, 0, 0);
      e[3] = __builtin_amdgcn_mfma_f32_16x16x32_fp8_fp8(a1, v1, (f32x4){0.f, 0.f, 0.f, 0.f}, 0, 0, 0);
    } else {
      e[0] = __builtin_amdgcn_mfma_f32_16x16x32_fp8_fp8(a0, v0, e[0], 0, 0, 0);
      e[1] = __builtin_amdgcn_mfma_f32_16x16x32_fp8_fp8(a1, v0, e[1], 0, 0, 0);
      e[2] = __builtin_amdgcn_mfma_f32_16x16x32_fp8_fp8(a0, v1, e[2], 0, 0, 0);
      e[3] = __builtin_amdgcn_mfma_f32_16x16x32_fp8_fp8(a1, v1, e[3], 0, 0, 0);
    }
  }
#pragma unroll
  for (int q = 0; q < 4; ++q) cur[q] += e[q] * invS;
}

__device__ __forceinline__ void o_peer_expertsB_tile(const Params& p, int l, int t0, char* smem, int tid) {
  const int wave = __builtin_amdgcn_readfirstlane(tid >> 6), lane = tid & 63;
  const unsigned char* U8 = p.u8 + (size_t)l * 16384 * 1024;
  const unsigned char* V8 = p.v8 + (size_t)l * 16384 * 1024;
  const float2* ES = p.escale + (size_t)l * 16384;
  int vz = 0;
  asm volatile("" : "+v"(vz));
  const __amdgpu_buffer_rsrc_t rsU = __builtin_amdgcn_make_buffer_rsrc((void*)U8, 0, 16384 * 1024, 0x00020000);
  const __amdgpu_buffer_rsrc_t rsV = __builtin_amdgcn_make_buffer_rsrc((void*)V8, 0, 16384 * 1024, 0x00020000);
  const __amdgpu_buffer_rsrc_t rsS = __builtin_amdgcn_make_buffer_rsrc((void*)ES, 0, 16384 * 8, 0x00020000);
  const __amdgpu_buffer_rsrc_t rsU0 = __builtin_amdgcn_make_buffer_rsrc((void*)U8, 0, 0, 0x00020000);
  const __amdgpu_buffer_rsrc_t rsV0 = __builtin_amdgcn_make_buffer_rsrc((void*)V8, 0, 0, 0x00020000);
  const __amdgpu_buffer_rsrc_t rsS0 = __builtin_amdgcn_make_buffer_rsrc((void*)ES, 0, 0, 0x00020000);
  const int lo16 = lane * 16;
  const int li = lane & 3, iu = (lane & 15) >> 2, ig = lane >> 4;
  const bool b0 = lane & 1, b1 = lane & 2, isdiag = ig == iu;
  const unsigned mlane = isdiag ? (0xffu << (8 * li)) : 0u;
  const unsigned ou0 = iu == 0 ? 0xffffffffu : 0u, ou1 = iu == 1 ? 0xffffffffu : 0u, ou2 = iu == 2 ? 0xffffffffu : 0u, ou3 = iu == 3 ? 0xffffffffu : 0u;
  const unsigned og0 = ig == 0 ? 0xffffffffu : 0u, og1 = ig == 1 ? 0xffffffffu : 0u, og2 = ig == 2 ? 0xffffffffu : 0u, og3 = ig == 3 ? 0xffffffffu : 0u;
  const int cu = li * 64 + ig * 16;
  const int hoff = (li * 4 + ig) * 64;
  const int s0 = ((int)(__builtin_amdgcn_s_getreg((3 << 11) | 20) & 0xF) * (EX6_NSLICE / 8)) & (EX6_NSLICE - 1);
  unsigned pk[8][2];
  h2_t acc[8][8];
  float hsi[8];
#pragma unroll
  for (int k = 0; k < 8; ++k) {
    const size_t base = (size_t)(t0 + wave * 8 + k) * 128 + lane + vz;
#pragma unroll
    for (int hf = 0; hf < 2; ++hf) pk[k][hf] = (unsigned)p.pidx[base + hf * 64] | ((unsigned)f2bf(p.pgate[base + hf * 64]) << 16);
#pragma unroll
    for (int i = 0; i < 8; ++i) acc[k][i] = (h2_t){(_Float16)0.f, (_Float16)0.f};
  }
  {
    const int dst0 = (((lane >> 2) & 3) * 4 + (lane & 3)) * 64 + (lane >> 4) * 16;
#pragma unroll
    for (int k = 0; k < 8; ++k) {
      char* row = smem + (wave * 8 + k) * LDXB;
      const uint4 h0 = *(const uint4*)(row + lane * 32), h1 = *(const uint4*)(row + lane * 32 + 16);
      const unsigned hw[8] = {h0.x, h0.y, h0.z, h0.w, h1.x, h1.y, h1.z, h1.w};
      float mx = 0.f;
#pragma unroll
      for (int i = 0; i < 8; ++i) mx = fmaxf(mx, fmaxf(fabsf(__uint_as_float(hw[i] << 16)), fabsf(__uint_as_float(hw[i] & 0xffff0000u))));
      mx = wave_max(mx);
      unsigned eb = __float_as_uint(mx) >> 23;
      eb = eb < 16u ? 16u : (eb > 240u ? 240u : eb);
      eb = (unsigned)__builtin_amdgcn_readfirstlane((int)eb);
      const float S = __uint_as_float((261u - eb) << 23);
      hsi[k] = __uint_as_float((eb - 7u) << 23);
      unsigned o[4];
#pragma unroll
      for (int i = 0; i < 4; ++i) {
        int t = __builtin_amdgcn_cvt_pk_fp8_f32(__uint_as_float(hw[2 * i] << 16) * S, __uint_as_float(hw[2 * i] & 0xffff0000u) * S, 0, false);
        t = __builtin_amdgcn_cvt_pk_fp8_f32(__uint_as_float(hw[2 * i + 1] << 16) * S, __uint_as_float(hw[2 * i + 1] & 0xffff0000u) * S, t, true);
        o[i] = (unsigned)t;
      }
      asm volatile("s_waitcnt lgkmcnt(0)" ::: "memory");
      *(uint4*)(row + dst0) = make_uint4(o[0], o[1], o[2], o[3]);
    }
  }
  asm volatile("s_waitcnt lgkmcnt(0)" ::: "memory");
#pragma unroll 1
  for (int si = 0; si < EX6_NSLICE; ++si) {
    const unsigned s = (unsigned)((s0 + si) & (EX6_NSLICE - 1));
#pragma unroll
    for (int k = 0; k < 8; ++k) {
      unsigned long long m0 = __ballot(((pk[k][0] & 0x3fffu) >> EX6_SHIFT) == s);
      unsigned long long m1 = __ballot(((pk[k][1] & 0x3fffu) >> EX6_SHIFT) == s);
      if ((m0 | m1) == 0ull) continue;
      unsigned hb[16];
      {
        const char* hr = smem + (wave * 8 + k) * LDXB + hoff;
#pragma unroll
        for (int i = 0; i < 4; ++i) {
          const uint4 t = *(const uint4*)(hr + 16 * i);
          hb[4 * i] = t.x; hb[4 * i + 1] = t.y; hb[4 * i + 2] = t.z; hb[4 * i + 3] = t.w;
        }
      }
      f32x4 cur[4];
#pragma unroll
      for (int q = 0; q < 4; ++q) cur[q] = (f32x4){0.f, 0.f, 0.f, 0.f};
      uint4 uA[4], uB[4];
      uint4 vA[4], vB[4];
      float2 scA, scB;
      unsigned wqA, wqB;
      unsigned w[4];
      ex8_pop(m0, m1, pk[k][0], pk[k][1], w);
      __amdgpu_buffer_rsrc_t rU = rsU, rV = rsV, rS = rsS;
      EXB_ISSUE(uA, vA, scA, wqA)
      for (;;) {
        const bool mb = (m0 | m1) != 0ull;
        if (mb) ex8_pop(m0, m1, pk[k][0], pk[k][1], w);
        rU = mb ? rsU : rsU0; rV = mb ? rsV : rsV0; rS = mb ? rsS : rsS0;
        EXB_ISSUE(uB, vB, scB, wqB)
        __builtin_amdgcn_s_setprio(1);
        exB_compute(uA, vA, scA, wqA, hb, hsi[k], cur, b0, b1, mlane);
        __builtin_amdgcn_s_setprio(0);
        if (!mb) break;
        const bool ma = (m0 | m1) != 0ull;
        if (ma) ex8_pop(m0, m1, pk[k][0], pk[k][1], w);
        rU = ma ? rsU : rsU0; rV = ma ? rsV : rsV0; rS = ma ? rsS : rsS0;
        EXB_ISSUE(uA, vA, scA, wqA)
        __builtin_amdgcn_s_setprio(1);
        exB_compute(uB, vB, scB, wqB, hb, hsi[k], cur, b0, b1, mlane);
        __builtin_amdgcn_s_setprio(0);
        if (!ma) break;
      }
#pragma unroll
      for (int q = 0; q < 4; ++q) {
        acc[k][2 * q] += (h2_t){(_Float16)cur[q][0], (_Float16)cur[q][1]};
        acc[k][2 * q + 1] += (h2_t){(_Float16)cur[q][2], (_Float16)cur[q][3]};
      }
    }
  }
#pragma unroll
  for (int k = 0; k < 8; ++k) {
    float* xr = p.xres + (size_t)(t0 + wave * 8 + k) * 1024 + lane * 16;
#pragma unroll
    for (int i = 0; i < 4; ++i) {
      float4 a0 = *(float4*)(xr + 4 * i);
      a0.x += (float)acc[k][2 * i][0]; a0.y += (float)acc[k][2 * i][1];
      a0.z += (float)acc[k][2 * i + 1][0]; a0.w += (float)acc[k][2 * i + 1][1];
      *(float4*)(xr + 4 * i) = a0;
    }
  }
}

#define EXC_GEN(U_, V_, SC_, WQ_, K_, LAST_, VALID_) { \
  VALID_ = false; \
  if (!gdone) { \
    while ((m0 | m1) == 0ull) { \
      ++gk; \
      if (gk == 8) { gk = 0; ++gsi; if (gsi == EX6_NSLICE) { gdone = true; break; } } \
      gpk0 = pkv[2 * gk]; gpk1 = pkv[2 * gk + 1]; \
      const unsigned s_ = (unsigned)((s0 + gsi) & (EX6_NSLICE - 1)); \
      m0 = __ballot(((gpk0 & 0x3fffu) >> EX6_SHIFT) == s_); \
      m1 = __ballot(((gpk1 & 0x3fffu) >> EX6_SHIFT) == s_); \
    } \
    if (!gdone) { ex8_pop(m0, m1, gpk0, gpk1, w); K_ = gk; LAST_ = (m0 | m1) == 0ull; VALID_ = true; } \
  } \
  rU = VALID_ ? rsU : rsU0; rV = VALID_ ? rsV : rsV0; rS = VALID_ ? rsS : rsS0; \
  EXB_ISSUE(U_, V_, SC_, WQ_) }
#define EXC_COMPUTE(U_, V_, SC_, WQ_, K_, LAST_, VALID_) { \
  if (VALID_) { \
    if (K_ != ck) { ck = K_; \
      const unsigned hn0_ = hbv[4 * K_], hn1_ = hbv[4 * K_ + 1], hn2_ = hbv[4 * K_ + 2], hn3_ = hbv[4 * K_ + 3]; \
      _Pragma("unroll") for (int mm_ = 0; mm_ < 4; ++mm_) { \
        const int src_ = (16 * mm_ + 4 * li + ig) << 2; \
        hb[4 * mm_ + 0] = (unsigned)__builtin_amdgcn_ds_bpermute(src_, (int)hn0_); \
        hb[4 * mm_ + 1] = (unsigned)__builtin_amdgcn_ds_bpermute(src_, (int)hn1_); \
        hb[4 * mm_ + 2] = (unsigned)__builtin_amdgcn_ds_bpermute(src_, (int)hn2_); \
        hb[4 * mm_ + 3] = (unsigned)__builtin_amdgcn_ds_bpermute(src_, (int)hn3_); \
      } \
      hs = __uint_as_float((unsigned)__builtin_amdgcn_readlane((int)__float_as_uint(hsiv), K_)); } \
    __builtin_amdgcn_s_setprio(1); \
    exB_compute(U_, V_, SC_, WQ_, hb, hs, cur, b0, b1, mlane); \
    __builtin_amdgcn_s_setprio(0); \
    if (LAST_) { \
      char* ar_ = smem + (wave * 8 + K_) * LDXB + lane * 32; \
      uint4 a0_ = *(const uint4*)ar_, a1_ = *(const uint4*)(ar_ + 16); \
      a0_.x = exC_addh2(a0_.x, cur[0][0], cur[0][1]); a0_.y = exC_addh2(a0_.y, cur[0][2], cur[0][3]); \
      a0_.z = exC_addh2(a0_.z, cur[1][0], cur[1][1]); a0_.w = exC_addh2(a0_.w, cur[1][2], cur[1][3]); \
      a1_.x = exC_addh2(a1_.x, cur[2][0], cur[2][1]); a1_.y = exC_addh2(a1_.y, cur[2][2], cur[2][3]); \
      a1_.z = exC_addh2(a1_.z, cur[3][0], cur[3][1]); a1_.w = exC_addh2(a1_.w, cur[3][2], cur[3][3]); \
      *(uint4*)ar_ = a0_; *(uint4*)(ar_ + 16) = a1_; \
      _Pragma("unroll") for (int q_ = 0; q_ < 4; ++q_) cur[q_] = (f32x4){0.f, 0.f, 0.f, 0.f}; \
    } \
  } }
__device__ __forceinline__ unsigned exC_addh2(unsigned a, float x, float y) {
  const h2_t r = __builtin_bit_cast(h2_t, a) + (h2_t){(_Float16)x, (_Float16)y};
  return __builtin_bit_cast(unsigned, r);
}

__device__ __forceinline__ void o_peer_expertsC_tile(const Params& p, int l, int t0, char* smem, int tid) {
  const int wave = __builtin_amdgcn_readfirstlane(tid >> 6), lane = tid & 63;
  const unsigned char* U8 = p.u8 + (size_t)l * 16384 * 1024;
  const unsigned char* V8 = p.v8 + (size_t)l * 16384 * 1024;
  const float2* ES = p.escale + (size_t)l * 16384;
  int vz = 0;
  asm volatile("" : "+v"(vz));
  const __amdgpu_buffer_rsrc_t rsU = __builtin_amdgcn_make_buffer_rsrc((void*)U8, 0, 16384 * 1024, 0x00020000);
  const __amdgpu_buffer_rsrc_t rsV = __builtin_amdgcn_make_buffer_rsrc((void*)V8, 0, 16384 * 1024, 0x00020000);
  const __amdgpu_buffer_rsrc_t rsS = __builtin_amdgcn_make_buffer_rsrc((void*)ES, 0, 16384 * 8, 0x00020000);
  const __amdgpu_buffer_rsrc_t rsU0 = __builtin_amdgcn_make_buffer_rsrc((void*)U8, 0, 0, 0x00020000);
  const __amdgpu_buffer_rsrc_t rsV0 = __builtin_amdgcn_make_buffer_rsrc((void*)V8, 0, 0, 0x00020000);
  const __amdgpu_buffer_rsrc_t rsS0 = __builtin_amdgcn_make_buffer_rsrc((void*)ES, 0, 0, 0x00020000);
  const int lo16 = lane * 16;
  const int li = lane & 3, iu = (lane & 15) >> 2, ig = lane >> 4;
  const bool b0 = lane & 1, b1 = lane & 2, isdiag = ig == iu;
  const unsigned mlane = isdiag ? (0xffu << (8 * li)) : 0u;
  const unsigned ou0 = iu == 0 ? 0xffffffffu : 0u, ou1 = iu == 1 ? 0xffffffffu : 0u, ou2 = iu == 2 ? 0xffffffffu : 0u, ou3 = iu == 3 ? 0xffffffffu : 0u;
  const unsigned og0 = ig == 0 ? 0xffffffffu : 0u, og1 = ig == 1 ? 0xffffffffu : 0u, og2 = ig == 2 ? 0xffffffffu : 0u, og3 = ig == 3 ? 0xffffffffu : 0u;
  const int cu = li * 64 + ig * 16;
  const int s0 = ((int)(__builtin_amdgcn_s_getreg((3 << 11) | 20) & 0xF) * (EX6_NSLICE / 8)) & (EX6_NSLICE - 1);
  v16u_t pkv;
  v32u_t hbv;
  float hsiv = 0.f;
#pragma unroll
  for (int k = 0; k < 8; ++k) {
    const size_t base = (size_t)(t0 + wave * 8 + k) * 128 + lane + vz;
#pragma unroll
    for (int hf = 0; hf < 2; ++hf) pkv[2 * k + hf] = (unsigned)p.pidx[base + hf * 64] | ((unsigned)f2bf(p.pgate[base + hf * 64]) << 16);
  }
#pragma unroll
  for (int k = 0; k < 8; ++k) {
    char* row = smem + (wave * 8 + k) * LDXB;
    const uint4 h0 = *(const uint4*)(row + lane * 32), h1 = *(const uint4*)(row + lane * 32 + 16);
    const unsigned hw[8] = {h0.x, h0.y, h0.z, h0.w, h1.x, h1.y, h1.z, h1.w};
    float mx = 0.f;
#pragma unroll
    for (int i = 0; i < 8; ++i) mx = fmaxf(mx, fmaxf(fabsf(__uint_as_float(hw[i] << 16)), fabsf(__uint_as_float(hw[i] & 0xffff0000u))));
    mx = wave_max(mx);
    unsigned eb = __float_as_uint(mx) >> 23;
    eb = eb < 16u ? 16u : (eb > 240u ? 240u : eb);
    const float S = __uint_as_float((261u - eb) << 23);
    hsiv = (lane == k) ? __uint_as_float((eb - 7u) << 23) : hsiv;
#pragma unroll
    for (int i = 0; i < 4; ++i) {
      int t = __builtin_amdgcn_cvt_pk_fp8_f32(__uint_as_float(hw[2 * i] << 16) * S, __uint_as_float(hw[2 * i] & 0xffff0000u) * S, 0, false);
      t = __builtin_amdgcn_cvt_pk_fp8_f32(__uint_as_float(hw[2 * i + 1] << 16) * S, __uint_as_float(hw[2 * i + 1] & 0xffff0000u) * S, t, true);
      hbv[4 * k + i] = (unsigned)t;
    }
    asm volatile("s_waitcnt lgkmcnt(0)" ::: "memory");
    *(uint4*)(row + lane * 32) = make_uint4(0u, 0u, 0u, 0u);
    *(uint4*)(row + lane * 32 + 16) = make_uint4(0u, 0u, 0u, 0u);
  }
  int gsi = 0, gk = -1;
  bool gdone = false;
  unsigned long long m0 = 0ull, m1 = 0ull;
  unsigned gpk0 = 0u, gpk1 = 0u;
  unsigned w[4] = {0u, 0u, 0u, 0u};
  __amdgpu_buffer_rsrc_t rU = rsU, rV = rsV, rS = rsS;
  uint4 uA[4], vA[4], uB[4], vB[4], uC[4], vC[4];
  float2 scA, scB, scC;
  unsigned wqA, wqB, wqC;
  int kA = 0, kB = 0, kC = 0;
  bool lastA = false, lastB = false, lastC = false, validA, validB, validC;
  int ck = -1;
  unsigned hb[16];
#pragma unroll
  for (int i = 0; i < 16; ++i) hb[i] = 0u;
  float hs = 0.f;
  f32x4 cur[4];
#pragma unroll
  for (int q = 0; q < 4; ++q) cur[q] = (f32x4){0.f, 0.f, 0.f, 0.f};
  EXC_GEN(uA, vA, scA, wqA, kA, lastA, validA)
  EXC_GEN(uB, vB, scB, wqB, kB, lastB, validB)
#pragma unroll 1
  for (;;) {
    EXC_GEN(uC, vC, scC, wqC, kC, lastC, validC)
    EXC_COMPUTE(uA, vA, scA, wqA, kA, lastA, validA)
    EXC_GEN(uA, vA, scA, wqA, kA, lastA, validA)
    EXC_COMPUTE(uB, vB, scB, wqB, kB, lastB, validB)
    EXC_GEN(uB, vB, scB, wqB, kB, lastB, validB)
    EXC_COMPUTE(uC, vC, scC, wqC, kC, lastC, validC)
    if (!validA && !validB) break;
  }
  asm volatile("s_waitcnt lgkmcnt(0)" ::: "memory");
#pragma unroll
  for (int k = 0; k < 8; ++k) {
    const char* ar = smem + (wave * 8 + k) * LDXB + lane * 32;
    const uint4 a0 = *(const uint4*)ar, a1 = *(const uint4*)(ar + 16);
    const unsigned aw[8] = {a0.x, a0.y, a0.z, a0.w, a1.x, a1.y, a1.z, a1.w};
    float* xr = p.xres + (size_t)(t0 + wave * 8 + k) * 1024 + lane * 16;
#pragma unroll
    for (int i = 0; i < 4; ++i) {
      float4 x4 = *(float4*)(xr + 4 * i);
      const h2_t c0 = __builtin_bit_cast(h2_t, aw[2 * i]), c1 = __builtin_bit_cast(h2_t, aw[2 * i + 1]);
      x4.x += (float)c0[0]; x4.y += (float)c0[1]; x4.z += (float)c1[0]; x4.w += (float)c1[1];
      *(float4*)(xr + 4 * i) = x4;
    }
  }
}

#define XB_TMO      128
#define XB_XCNT(j)  (256  + 64 * (j))
#define XB_XSUB(j)  (1280 + 64 * (j))
#define XB_XGEN(j)  (2304 + 64 * (j))
#define XB_TOP      3328
#define XB_TOPGEN   3392
#define XCD_BAR_WORDS 3456
#define XB_SPIN_CAP (1u << 22)
#ifndef LAS
#define LAS __attribute__((address_space(3)))
#endif
__device__ __forceinline__ unsigned xb_ld(unsigned* p)              { return __hip_atomic_load(p, __ATOMIC_RELAXED, __HIP_MEMORY_SCOPE_AGENT); }
__device__ __forceinline__ unsigned xb_add(unsigned* p, unsigned v) { return __hip_atomic_fetch_add(p, v, __ATOMIC_RELAXED, __HIP_MEMORY_SCOPE_AGENT); }
__device__ __forceinline__ unsigned xb_xcc_id() { return (unsigned)__builtin_amdgcn_s_getreg((3 << 11) | 20) & 0xFu; }
#define XB_SPIN(cond, bar) do { unsigned _sp = 0; while (cond) { __builtin_amdgcn_s_sleep(1); \
    if ((++_sp & 255u) == 0u) { if (xb_ld(&(bar)[XB_TMO])) break; if (_sp > XB_SPIN_CAP) { atomicAdd(&(bar)[XB_TMO], 1u); break; } } } } while (0)
struct XcdBarrier { unsigned* bar; unsigned x; volatile LAS unsigned* st; };
__device__ __forceinline__ XcdBarrier xcd_barrier_post(unsigned* bar, volatile LAS unsigned* st, int tid) {
  XcdBarrier b; b.bar = bar; b.x = xb_xcc_id(); b.st = st;
  if (tid == 0) (void)xb_add(&bar[XB_XCNT(b.x)], 1u);
  return b;
}
__device__ __forceinline__ void xcd_barrier_complete(unsigned* bar, unsigned x, unsigned& nloc, unsigned& nx) {
  const unsigned G = gridDim.x * gridDim.y * gridDim.z;
  unsigned sum, cnt, mine, sp = 0u;
  for (;;) {
    sum = 0u; cnt = 0u; mine = 0u;
#pragma unroll
    for (unsigned j = 0; j < 16; ++j) { const unsigned c = xb_ld(&bar[XB_XCNT(j)]); sum += c; cnt += (c > 0u) ? 1u : 0u; mine = (j == x) ? c : mine; }
    if (sum == G) break;
    __builtin_amdgcn_s_sleep(1);
    if ((++sp & 255u) == 0u) { if (xb_ld(&bar[XB_TMO])) break; if (sp > XB_SPIN_CAP) { atomicAdd(&bar[XB_TMO], 1u); break; } }
  }
  nloc = mine > 0u ? mine : 1u; nx = cnt > 0u ? cnt : 1u;
}
__device__ __forceinline__ void xcd_barrier(const XcdBarrier& b, int tid) {
  asm volatile("s_waitcnt vmcnt(0)" ::: "memory");
  __syncthreads();
  if (tid == 0) {
    unsigned* bar = b.bar;
    __builtin_amdgcn_s_waitcnt(0);
    unsigned nloc = b.st[0], nx = b.st[1];
    if (nloc == 0u) { xcd_barrier_complete(bar, b.x, nloc, nx); b.st[0] = nloc; b.st[1] = nx; }
    const unsigned old = xb_add(&bar[XB_XSUB(b.x)], 1u);
    const unsigned gen = old / nloc;
    if (old + 1u == (gen + 1u) * nloc) {
      __builtin_amdgcn_fence(__ATOMIC_RELEASE, "agent");
      asm volatile("s_waitcnt vmcnt(0)" ::: "memory");
      const unsigned og = xb_add(&bar[XB_TOP], 1u);
      const unsigned tg = og / nx;
      if (og + 1u == (tg + 1u) * nx) xb_add(&bar[XB_TOPGEN], 1u);
      else XB_SPIN(xb_ld(&bar[XB_TOPGEN]) == tg, bar);
      __builtin_amdgcn_fence(__ATOMIC_ACQUIRE, "agent");
      xb_add(&bar[XB_XGEN(b.x)], 1u);
      asm volatile("s_waitcnt vmcnt(0)" ::: "memory");
    } else {
      XB_SPIN(xb_ld(&bar[XB_XGEN(b.x)]) == gen, bar);
      __builtin_amdgcn_fence(__ATOMIC_ACQUIRE, "agent");
      asm volatile("s_waitcnt vmcnt(0)" ::: "memory");
    }
  }
  __syncthreads();
}


__global__ void __launch_bounds__(NTHREADS) fwd_megakernel(Params p) {
  cg::grid_group grid = cg::this_grid();
  extern __shared__ __attribute__((aligned(16))) float smem[];
  const int wv_ = __builtin_amdgcn_readfirstlane((int)(threadIdx.x >> 6));
  volatile LAS unsigned* xb_st = (volatile LAS unsigned*)((LAS char*)(LAS float*)smem + (160 * 1024 - 16));
  if (threadIdx.x == 0) { xb_st[0] = 0u; xb_st[1] = 0u; }
  __syncthreads();
  const XcdBarrier xb = xcd_barrier_post(p.bar, xb_st, (int)threadIdx.x);
#define GRID_BARRIER() xcd_barrier(xb, opaque_tid(wv_))

  o_prep(wv_, p, smem);
  if (gridDim.x > 4096u) grid.sync();
  GRID_BARRIER();
#pragma unroll 1
  for (int l = 0; l < DEPTH; ++l) {
    const float* xcur = (l == 0) ? p.x_in : p.xres;
    o_p1(wv_, p, l, xcur, (char*)smem);
    GRID_BARRIER();
    {
    {
      const int bidx_ = opaque_bid();
      const bool affine = (gridDim.x == 256u);
      for (int task = bidx_; task < 1792; task += gridDim.x) {
        const int l_ = opaque_s(l), td_ = opaque_tid(wv_);
        int tk = task;
        if (affine) {
          const int x = bidx_ & 7, lb = bidx_ >> 3, j = task >> 8;
          if (j < 4) { const int idx = lb + 32 * j; tk = ((x * 2 + (idx >> 6)) << 6) | (idx & 63); }
          else if (j < 6) { const int idx = lb + 32 * (j - 4); tk = 1024 + (((x * 2 + (idx >> 5)) << 5) | (idx & 31)); }
          else tk = 1536 + x * 32 + lb;
        }
        const int tk_ = opaque_s(tk);
        if (tk_ < 1024) o_na_task(p, l_, tk_, (char*)smem, td_);
        else if (tk_ < 1536) o_ret_kv_task(p, l_, tk_ - 1024, (char*)smem, td_);
        else o_pool_task(p, l_, tk_ - 1536, (char*)smem, td_);
      }
    }
    GRID_BARRIER();
    o_ret_scan(wv_, p, l);
    GRID_BARRIER();
    {
      const int tidx_ = opaque_tid(wv_); const int bidx_ = opaque_bid();
      for (int task = bidx_; task < 512; task += gridDim.x) {
        int tk = task;
        if (gridDim.x == 256u) {
          const int x = bidx_ & 7, lb = bidx_ >> 3, idx = lb + 32 * (task >> 8);
          tk = ((x * 2 + (idx >> 5)) << 5) | (idx & 31);
        }
        o_ret_out_task(p, l, opaque_s(tk), (char*)smem, tidx_);
      }
    }
    GRID_BARRIER();
    }
    {
      const int tidx_ = opaque_tid(wv_); const int bidx_ = opaque_bid();
      for (int tile = bidx_; tile < NTOK / 64; tile += gridDim.x) {
        { const int t0_ = opaque_s(tile * 64), l_ = opaque_s(l), td_ = opaque_tid(wv_); o_p5a1_tile(p, l_, t0_, (char*)smem, td_); }
        { const int t0_ = opaque_s(tile * 64), l_ = opaque_s(l), td_ = opaque_tid(wv_); o_p5a2_tile(p, l_, xcur, t0_, (char*)smem, td_); }
        { const int t0_ = opaque_s(tile * 64), l_ = opaque_s(l), td_ = opaque_tid(wv_); o_p5a3_tile(p, l_, t0_, (char*)smem, td_); }
        { const int t0_ = opaque_s(tile * 64), l_ = opaque_s(l), td_ = opaque_tid(wv_); o_peer_select_tile(p, l_, t0_, (char*)smem, td_); }
        { const int t0_ = opaque_s(tile * 64), l_ = opaque_s(l), td_ = opaque_tid(wv_); o_peer_select2_tile(p, l_, t0_, td_); }
        asm volatile("s_waitcnt vmcnt(0)" ::: "memory");
        __syncthreads();
        { const int t0_ = opaque_s(tile * 64), l_ = opaque_s(l), td_ = opaque_tid(wv_); o_peer_expertsC_tile(p, l_, t0_, (char*)smem, td_); }
        if (l + 1 == DEPTH) {
          asm volatile("s_waitcnt vmcnt(0)" ::: "memory");
          const int t0_ = opaque_s(tile * 64), td_ = opaque_tid(wv_);
          o_final_norm_tile(p, t0_, td_);
        }
      }
    }
    if (l + 1 < DEPTH) GRID_BARRIER();
  }
}

extern "C" void kernel_launch(void* const* d_in, const int* in_sizes, int n_in, void* d_out, int out_size,
                              void* d_ws, size_t ws_size, hipStream_t stream) {
  Params p{};
  p.x_in = (const float*)d_in[0]; p.norm_mix = (const float*)d_in[1]; p.w_in = (const float*)d_in[2];
  p.pool_w = (const float*)d_in[3]; p.pool_scale = (const float*)d_in[4]; p.ret_decay = (const float*)d_in[5];
  p.na_rpb = (const float*)d_in[6]; p.w_br_pool = (const float*)d_in[7]; p.w_br_ret = (const float*)d_in[8];
  p.w_br_na = (const float*)d_in[9]; p.w_out = (const float*)d_in[10]; p.norm_ffn = (const float*)d_in[11];
  p.w_query = (const float*)d_in[12]; p.sub_keys = (const float*)d_in[13]; p.peer_u = (const float*)d_in[14];
  p.peer_v = (const float*)d_in[15]; p.norm_final = (const float*)d_in[16];
  p.out = (float*)d_out;
  char* ws = (char*)d_ws;
  size_t off = 0;
  auto alloc = [&](size_t bytes) { char* q = ws + off; off += (bytes + 255) & ~(size_t)255; return q; };
  p.xres = (float*)alloc((size_t)NTOK * D_MODEL * 4);
  p.proj = (bf16_t*)alloc((size_t)NTOK * IN_WIDTH * 2);
  p.ycat = (bf16_t*)alloc((size_t)NTOK * 1024 * 2);
  p.mrg = (bf16_t*)alloc((size_t)NTOK * 1024 * 2);
  p.pidx = (int*)alloc((size_t)NTOK * 128 * 4);
  p.pgate = (float*)alloc((size_t)NTOK * 128 * 4);
  p.wf_in = (bf16_t*)alloc((size_t)DEPTH * D_MODEL * IN_WIDTH * 2);
  p.wf_br = (bf16_t*)alloc((size_t)DEPTH * 1024 * 1024 * 2);
  p.wf_out = (bf16_t*)alloc((size_t)DEPTH * 1024 * 1024 * 2);
  p.wf_q = (bf16_t*)alloc((size_t)DEPTH * 1024 * 2048 * 2);
  p.kf = (bf16_t*)alloc((size_t)DEPTH * 2 * 128 * 128 * 2);
  p.u16 = nullptr; p.v16 = nullptr;
  p.u8 = (unsigned char*)alloc((size_t)DEPTH * 16384 * 1024);
  p.v8 = (unsigned char*)alloc((size_t)DEPTH * 16384 * 1024);
  p.escale = (float2*)alloc((size_t)DEPTH * 16384 * 8);
  p.rope = (float2*)alloc((size_t)SEQ * 32 * 8);
  p.tklist = (unsigned*)alloc((size_t)NTOK * 8 * 2 * 16 * 4);
  p.kvst = (float*)p.mrg;
  p.rstate = (bf16_t*)p.tklist;
  p.bar = (unsigned*)alloc(XCD_BAR_WORDS * 4);
  p.xn = nullptr; p.merged = nullptr; p.pq = nullptr; p.psc = nullptr;
  if (off > ws_size) fprintf(stderr, "WORKSPACE OVERFLOW: need %zu have %zu\n", off, ws_size);

  const size_t kDynLds = 160 * 1024;
  static int grid_blocks = 0;
  if (!grid_blocks) {
    int dev = 0, cus = 0, per_cu = 0;
    (void)hipGetDevice(&dev);
    (void)hipDeviceGetAttribute(&cus, hipDeviceAttributeMultiprocessorCount, dev);
    (void)hipFuncSetAttribute((const void*)fwd_megakernel, hipFuncAttributeMaxDynamicSharedMemorySize, (int)kDynLds);
    (void)hipOccupancyMaxActiveBlocksPerMultiprocessor(&per_cu, fwd_megakernel, NTHREADS, kDynLds);
    if (per_cu < 1) per_cu = 1;
    grid_blocks = cus * per_cu;
  }
  (void)hipMemsetAsync(p.bar, 0, XCD_BAR_WORDS * 4, stream);
  void* args[] = {&p};
  hipError_t e = hipLaunchCooperativeKernel((void*)fwd_megakernel, dim3(grid_blocks), dim3(NTHREADS), args, kDynLds, stream);
  if (e != hipSuccess) fprintf(stderr, "cooperative launch failed: %s (grid %d)\n", hipGetErrorString(e), grid_blocks);
}
```
